# Optimizing an MI355X kernel written in HIP

```python
import math
import jax, jax.numpy as jnp
from jax import lax
import numpy as np

D_MODEL = 1024
BATCH = 8
SEQ = 4096
DEPTH = 1

HEAD_DIM = 64
N_HEADS_MOBA = 8
N_HEADS_FOX = 8
MOBA_WIDTH = N_HEADS_MOBA * HEAD_DIM
FOX_WIDTH = N_HEADS_FOX * HEAD_DIM
MIX_WIDTH = MOBA_WIDTH + FOX_WIDTH
IN_WIDTH = 3 * MOBA_WIDTH + 3 * FOX_WIDTH + N_HEADS_FOX
MOBA_BLOCK = 256
MOBA_TOPK = 3
MOBA_QCHUNK = 64
FOX_QBLOCK = 128
N_BUCKETS = 32
MAX_DISTANCE = 128
N_MEM = 256
XATTN_HEADS = 4
XATTN_HEAD_DIM = D_MODEL // XATTN_HEADS
PEER_HEADS = 8
PEER_NKEYS = 128
PEER_N_EXPERTS = PEER_NKEYS * PEER_NKEYS
PEER_TOPK = 16
PEER_DKEY = 128
PEER_TOKEN_CHUNK = 128
EPS = 1e-6
NEG_INF = -1e30

kernel_name = "hymba_moba_fox_peer_layer"


def rmsnorm(x, g):
    xf = x.astype(jnp.float32)
    y = xf * lax.rsqrt(jnp.mean(xf * xf, axis=-1, keepdims=True) + EPS)
    return (y * g.astype(jnp.float32)).astype(x.dtype)


def t5_bucket(dist):
    max_exact = N_BUCKETS // 2
    d = jnp.maximum(dist, 0)
    df = jnp.maximum(d, 1).astype(jnp.float32)
    large = max_exact + (jnp.log(df / max_exact) / math.log(MAX_DISTANCE / max_exact)
                         * (N_BUCKETS - max_exact)).astype(jnp.int32)
    large = jnp.minimum(large, N_BUCKETS - 1)
    return jnp.where(d < max_exact, d, large)


def moba_attention(q, k, v, rel_bias):
    B, S, H, Dh = q.shape
    scale = Dh ** -0.5
    pad = (-S) % MOBA_BLOCK
    kp = jnp.pad(k, ((0, 0), (0, pad), (0, 0), (0, 0)))
    vp = jnp.pad(v, ((0, 0), (0, pad), (0, 0), (0, 0)))
    nblk = (S + pad) // MOBA_BLOCK
    kk = min(MOBA_TOPK, nblk)
    kh = kp.reshape(B, nblk, MOBA_BLOCK, H, Dh).transpose(0, 3, 1, 2, 4)
    vh = vp.reshape(B, nblk, MOBA_BLOCK, H, Dh).transpose(0, 3, 1, 2, 4)
    kmean = jnp.mean(kh.astype(jnp.float32), axis=3).astype(q.dtype)
    nq = S // MOBA_QCHUNK
    qc = q.reshape(B * nq, MOBA_QCHUNK, H, Dh)
    b_idx = jnp.repeat(jnp.arange(B, dtype=jnp.int32), nq)
    c_idx = jnp.tile(jnp.arange(nq, dtype=jnp.int32), B)
    head_ix = jnp.arange(H)
    offs = jnp.arange(MOBA_BLOCK, dtype=jnp.int32)
    blk = jnp.arange(nblk, dtype=jnp.int32)

    def one_chunk(args):
        qb, b, c = args
        kb, vb, km = kh[b], vh[b], kmean[b]
        t = c * MOBA_QCHUNK + jnp.arange(MOBA_QCHUNK, dtype=jnp.int32)
        i = (c * MOBA_QCHUNK) // MOBA_BLOCK
        bs = jnp.einsum('qhd,hnd->qhn', qb, km).astype(jnp.float32)
        bs = jnp.where(blk[None, None, :] < i, bs, NEG_INF)
        _, sel = lax.top_k(bs, kk)
        sel_valid = jnp.arange(kk)[None, None, :] < i
        ks = kb[head_ix[None, :, None], sel]
        vs = vb[head_ix[None, :, None], sel]
        s_sel = jnp.einsum('qhd,qhrld->qhrl', qb, ks).astype(jnp.float32) * scale
        kpos_sel = sel[..., None] * MOBA_BLOCK + offs
        bias_sel = rel_bias[t5_bucket(t[:, None, None, None] - kpos_sel),
                            head_ix[None, :, None, None]].astype(jnp.float32)
        s_sel = jnp.where(sel_valid[..., None], s_sel + bias_sel, NEG_INF)
        ko = lax.dynamic_index_in_dim(kb, i, axis=1, keepdims=False)
        vo = lax.dynamic_index_in_dim(vb, i, axis=1, keepdims=False)
        s_own = jnp.einsum('qhd,hld->qhl', qb, ko).astype(jnp.float32) * scale
        dist_own = t[:, None] - (i * MOBA_BLOCK + offs)[None, :]
        bias_own = rel_bias[t5_bucket(dist_own)].astype(jnp.float32).transpose(0, 2, 1)
        s_own = jnp.where((dist_own >= 0)[:, None, :], s_own + bias_own, NEG_INF)
        qn = qb.shape[0]
        logits = jnp.concatenate([s_sel.reshape(qn, H, kk * MOBA_BLOCK), s_own], axis=-1)
        p = jax.nn.softmax(logits, axis=-1).astype(v.dtype)
        p_sel = p[..., :kk * MOBA_BLOCK].reshape(qn, H, kk, MOBA_BLOCK)
        p_own = p[..., kk * MOBA_BLOCK:]
        return (jnp.einsum('qhrl,qhrld->qhd', p_sel, vs)
                + jnp.einsum('qhl,hld->qhd', p_own, vo))

    out = lax.map(one_chunk, (qc, b_idx, c_idx))
    return out.reshape(B, S, H, Dh)


def forgetting_attention(q, k, v, f_logit):
    B, S, H, Dh = q.shape
    scale = Dh ** -0.5
    c = jnp.cumsum(jax.nn.log_sigmoid(f_logit.astype(jnp.float32)), axis=1)
    cT = c.transpose(0, 2, 1)
    nqb = S // FOX_QBLOCK
    qb = q.reshape(B, nqb, FOX_QBLOCK, H, Dh).transpose(1, 0, 2, 3, 4)
    cb = c.reshape(B, nqb, FOX_QBLOCK, H).transpose(1, 0, 3, 2)
    kpos = jnp.arange(S, dtype=jnp.int32)

    def one_block(args):
        qq, cq, j = args
        s = jnp.einsum('bqhd,bkhd->bhqk', qq, k).astype(jnp.float32) * scale
        decay = cq[..., None] - cT[:, :, None, :]
        tpos = j * FOX_QBLOCK + jnp.arange(FOX_QBLOCK, dtype=jnp.int32)
        mask = kpos[None, :] <= tpos[:, None]
        s = jnp.where(mask, s + decay, NEG_INF)
        p = jax.nn.softmax(s, axis=-1).astype(v.dtype)
        return jnp.einsum('bhqk,bkhd->bqhd', p, v)

    out = lax.map(one_block, (qb, cb, jnp.arange(nqb, dtype=jnp.int32)))
    return out.transpose(1, 0, 2, 3, 4).reshape(B, S, H, Dh)


def hybrid_mixer(h, w_in, b_forget, rel_bias, g_moba_out, g_fox_out, w_out):
    B, S, _ = h.shape
    proj = h @ w_in
    cuts = np.cumsum([MOBA_WIDTH] * 3 + [FOX_WIDTH] * 3).tolist()
    qm, km, vm, qf, kf, vf, fl = jnp.split(proj, cuts, axis=-1)
    hd = lambda a, n: a.reshape(B, S, n, HEAD_DIM)
    o_a = moba_attention(hd(qm, N_HEADS_MOBA), hd(km, N_HEADS_MOBA), hd(vm, N_HEADS_MOBA), rel_bias)
    o_b = forgetting_attention(hd(qf, N_HEADS_FOX), hd(kf, N_HEADS_FOX), hd(vf, N_HEADS_FOX),
                               fl + b_forget)
    o = jnp.concatenate([rmsnorm(o_a.reshape(B, S, MOBA_WIDTH), g_moba_out),
                         rmsnorm(o_b.reshape(B, S, FOX_WIDTH), g_fox_out)], axis=-1)
    return o @ w_out


def memory_cross_attention(h, mem_n, w_q, w_k, w_v, w_o):
    B, S, _ = h.shape
    M = mem_n.shape[1]
    q = (h @ w_q).reshape(B, S, XATTN_HEADS, XATTN_HEAD_DIM)
    k = (mem_n @ w_k).reshape(B, M, XATTN_HEADS, XATTN_HEAD_DIM)
    v = (mem_n @ w_v).reshape(B, M, XATTN_HEADS, XATTN_HEAD_DIM)
    s = jnp.einsum('bshd,bmhd->bhsm', q, k).astype(jnp.float32) * XATTN_HEAD_DIM ** -0.5
    p = jax.nn.softmax(s, axis=-1).astype(v.dtype)
    o = jnp.einsum('bhsm,bmhd->bshd', p, v).reshape(B, S, D_MODEL)
    return o @ w_o


def peer_ffn(h, w_query, sub_keys_1, sub_keys_2, expert_down, expert_up):
    B, S, D = h.shape
    T = B * S
    hc = h.reshape(T // PEER_TOKEN_CHUNK, PEER_TOKEN_CHUNK, D)
    half = PEER_DKEY // 2

    def one_chunk(xc):
        C = xc.shape[0]
        qr = (xc @ w_query).reshape(C, PEER_HEADS, 2, half)
        s1 = jnp.einsum('chd,hnd->chn', qr[:, :, 0], sub_keys_1).astype(jnp.float32)
        s2 = jnp.einsum('chd,hnd->chn', qr[:, :, 1], sub_keys_2).astype(jnp.float32)
        v1, i1 = lax.top_k(s1, PEER_TOPK)
        v2, i2 = lax.top_k(s2, PEER_TOPK)
        cand = (v1[..., :, None] + v2[..., None, :]).reshape(C, PEER_HEADS, PEER_TOPK * PEER_TOPK)
        cand_idx = (i1[..., :, None] * PEER_NKEYS + i2[..., None, :]).reshape(
            C, PEER_HEADS, PEER_TOPK * PEER_TOPK)
        top_s, pos = lax.top_k(cand, PEER_TOPK)
        eidx = jnp.take_along_axis(cand_idx, pos, axis=-1)
        g = jax.nn.softmax(top_s, axis=-1)
        u = expert_down[eidx]
        a = jax.nn.gelu(jnp.einsum('cd,chkd->chk', xc, u).astype(jnp.float32), approximate=False)
        vv = expert_up[eidx]
        return jnp.einsum('chk,chkd->cd', (g * a).astype(vv.dtype), vv)

    return lax.map(one_chunk, hc).reshape(B, S, D)


def setup_inputs(seed: int = 0) -> dict:
    key = jax.random.key(seed)
    ks = jax.random.split(key, 24)
    nrm = lambda k, shape, s: jax.random.normal(k, shape, jnp.float32) * s
    gain = lambda k, shape: 1.0 + 0.01 * jax.random.normal(k, shape, jnp.float32)
    L = DEPTH
    return {
        "x": nrm(ks[0], (BATCH, SEQ, D_MODEL), 1.0),
        "mem": nrm(ks[1], (BATCH, N_MEM, D_MODEL), 1.0),
        "norm_mix": gain(ks[2], (L, D_MODEL)),
        "w_in": nrm(ks[3], (L, D_MODEL, IN_WIDTH), D_MODEL ** -0.5),
        "b_forget": 2.0 + 0.1 * jax.random.normal(ks[4], (L, N_HEADS_FOX), jnp.float32),
        "rel_bias": nrm(ks[5], (N_BUCKETS, N_HEADS_MOBA), 0.5),
        "g_moba_out": gain(ks[6], (L, MOBA_WIDTH)),
        "g_fox_out": gain(ks[7], (L, FOX_WIDTH)),
        "w_out": nrm(ks[8], (L, MIX_WIDTH, D_MODEL), MIX_WIDTH ** -0.5),
        "norm_xattn": gain(ks[9], (L, D_MODEL)),
        "norm_mem": gain(ks[10], (L, D_MODEL)),
        "w_xq": nrm(ks[11], (L, D_MODEL, D_MODEL), D_MODEL ** -0.5),
        "w_xk": nrm(ks[12], (L, D_MODEL, D_MODEL), D_MODEL ** -0.5),
        "w_xv": nrm(ks[13], (L, D_MODEL, D_MODEL), D_MODEL ** -0.5),
        "w_xo": nrm(ks[14], (L, D_MODEL, D_MODEL), D_MODEL ** -0.5),
        "norm_ffn": gain(ks[15], (L, D_MODEL)),
        "w_peer_query": nrm(ks[16], (L, D_MODEL, PEER_HEADS * PEER_DKEY), D_MODEL ** -0.5),
        "peer_subkeys_1": nrm(ks[17], (L, PEER_HEADS, PEER_NKEYS, PEER_DKEY // 2), (PEER_DKEY // 2) ** -0.5),
        "peer_subkeys_2": nrm(ks[18], (L, PEER_HEADS, PEER_NKEYS, PEER_DKEY // 2), (PEER_DKEY // 2) ** -0.5),
        "peer_expert_down": nrm(ks[19], (L, PEER_N_EXPERTS, D_MODEL), D_MODEL ** -0.5),
        "peer_expert_up": nrm(ks[20], (L, PEER_N_EXPERTS, D_MODEL), PEER_HEADS ** -0.5),
        "norm_final": gain(ks[21], (D_MODEL,)),
    }


def reference(x, mem, norm_mix, w_in, b_forget, rel_bias, g_moba_out, g_fox_out, w_out,
              norm_xattn, norm_mem, w_xq, w_xk, w_xv, w_xo, norm_ffn, w_peer_query,
              peer_subkeys_1, peer_subkeys_2, peer_expert_down, peer_expert_up, norm_final):
    for l in range(DEPTH):
        h = rmsnorm(x, norm_mix[l])
        x = x + hybrid_mixer(h, w_in[l], b_forget[l], rel_bias, g_moba_out[l], g_fox_out[l], w_out[l])
        h = rmsnorm(x, norm_xattn[l])
        mem_n = rmsnorm(mem, norm_mem[l])
        x = x + memory_cross_attention(h, mem_n, w_xq[l], w_xk[l], w_xv[l], w_xo[l])
        h = rmsnorm(x, norm_ffn[l])
        x = x + peer_ffn(h, w_peer_query[l], peer_subkeys_1[l], peer_subkeys_2[l],
                         peer_expert_down[l], peer_expert_up[l])
    return rmsnorm(x, norm_final)
```

```cpp
#include <hip/hip_runtime.h>
#include <hip/hip_cooperative_groups.h>
#include <cstdio>
#include <cstdint>
namespace cg = cooperative_groups;

#ifndef MK_N_LAUNCHES
#define MK_N_LAUNCHES 1
#endif

typedef unsigned short bf16_t;
typedef short bf16x8 __attribute__((ext_vector_type(8)));
typedef float f32x4 __attribute__((ext_vector_type(4)));
typedef unsigned u32x4 __attribute__((ext_vector_type(4)));
typedef unsigned u32x2 __attribute__((ext_vector_type(2)));

constexpr int NB = 8, SEQ = 4096, DM = 1024, NT = NB * SEQ;
constexpr int NQKV = 3072, INW = 3080;
constexpr int NMEM = 256, NMROWS = NB * NMEM;
constexpr int NEXP = 16384;
constexpr float EPS = 1e-6f;
constexpr int NPHASE = 13;
constexpr int LDS_BYTES = 147456;

constexpr size_t MiB = 1u << 20;
constexpr size_t WS_WIN_T = 2 * MiB;
constexpr size_t WS_WOUT_T = 8 * MiB;
constexpr size_t WS_WXQ_T = 10 * MiB;
constexpr size_t WS_WXKV_T = 12 * MiB;
constexpr size_t WS_WXO_T = 16 * MiB;
constexpr size_t WS_WPQ_T = 18 * MiB;
constexpr size_t WS_MEMN = 22 * MiB;
constexpr size_t WS_KX = 26 * MiB;
constexpr size_t WS_VXT = 30 * MiB;
constexpr size_t WS_FLOG = 34 * MiB;
constexpr size_t WS_CUM = 35 * MiB;
constexpr size_t WS_KMEAN = 36 * MiB;
constexpr size_t WS_EXD = 40 * MiB;
constexpr size_t WS_EXU = 72 * MiB;
constexpr size_t WS_HB = 104 * MiB;
constexpr size_t WS_QKV = 168 * MiB;
constexpr size_t WS_OAB = 360 * MiB;
constexpr size_t WS_QX = 168 * MiB;
constexpr size_t WS_OX = 232 * MiB;
constexpr size_t WS_PQ = 232 * MiB;
constexpr size_t WS_EIDX = 424 * MiB;
constexpr size_t WS_GATE = 440 * MiB;
constexpr size_t WS_END = 456 * MiB;

struct Args {
  const float* in[22];
  float* out;
  unsigned char* ws;
  int ph_lo, ph_hi;
};

__device__ __forceinline__ unsigned f2bf(float f) { unsigned u = __float_as_uint(f); return (u + 0x7fffu + ((u >> 16) & 1u)) >> 16; }
__device__ __forceinline__ unsigned pk2(float lo, float hi) { return f2bf(lo) | (f2bf(hi) << 16); }
__device__ __forceinline__ float bf2f(unsigned short b) { return __uint_as_float(((unsigned)b) << 16); }
__device__ __forceinline__ float bflo(unsigned w) { return __uint_as_float(w << 16); }
__device__ __forceinline__ float bfhi(unsigned w) { return __uint_as_float(w & 0xffff0000u); }
__device__ __forceinline__ float wave_sum(float v) {
#pragma unroll
  for (int o = 1; o < 64; o <<= 1) v += __shfl_xor(v, o);
  return v;
}
__device__ __forceinline__ void unpack8(const u32x4 w, float* f) {
  f[0] = bflo(w.x); f[1] = bfhi(w.x); f[2] = bflo(w.y); f[3] = bfhi(w.y);
  f[4] = bflo(w.z); f[5] = bfhi(w.z); f[6] = bflo(w.w); f[7] = bfhi(w.w);
}

__device__ const unsigned char T5_BUCKET[128] = {
  0, 1, 2, 3, 4, 5, 6, 7, 8, 9, 10, 11, 12, 13, 14, 15, 16, 16, 16, 17, 17, 18, 18, 18, 19, 19, 19, 20, 20, 20, 20, 21,
  21, 21, 21, 22, 22, 22, 22, 22, 23, 23, 23, 23, 23, 23, 24, 24, 24, 24, 24, 24, 25, 25, 25, 25, 25, 25, 25, 26, 26, 26, 26, 26,
  26, 26, 26, 27, 27, 27, 27, 27, 27, 27, 27, 27, 27, 28, 28, 28, 28, 28, 28, 28, 28, 28, 28, 29, 29, 29, 29, 29, 29, 29, 29, 29,
  29, 29, 29, 30, 30, 30, 30, 30, 30, 30, 30, 30, 30, 30, 30, 30, 30, 31, 31, 31, 31, 31, 31, 31, 31, 31, 31, 31, 31, 31, 31, 31};

__device__ __forceinline__ void transpose_item(const float* W, int ldw, const float* gain, bf16_t* WT, int K, int row_off, float* scr, int kb, int nb, int lane) {
  const int k0 = 64 * kb, n0 = 32 * nb;
#pragma unroll 8
  for (int i = 0; i < 32; ++i) {
    const int kk = 2 * i + (lane >> 5);
    const float g = gain ? gain[k0 + kk] : 1.f;
    scr[kk * 33 + (lane & 31)] = W[(size_t)(k0 + kk) * ldw + n0 + (lane & 31)] * g;
  }
  __builtin_amdgcn_wave_barrier();
  const int c = lane & 7;
#pragma unroll
  for (int j = 0; j < 4; ++j) {
    const int n = (lane >> 3) + 8 * j; const float* s = scr + (8 * c) * 33 + n;
    u32x4 o; o.x = pk2(s[0 * 33], s[1 * 33]); o.y = pk2(s[2 * 33], s[3 * 33]); o.z = pk2(s[4 * 33], s[5 * 33]); o.w = pk2(s[6 * 33], s[7 * 33]);
    *(u32x4*)(WT + (size_t)(row_off + n0 + n) * K + k0 + 8 * c) = o;
  }
  __builtin_amdgcn_wave_barrier();
}

__device__ __forceinline__ void rms_row_to_bf16(const float* xrow, bf16_t* orow, int lane) {
  const f32x4* xr = (const f32x4*)xrow + lane;
  f32x4 v[4]; float s = 0.f;
#pragma unroll
  for (int j = 0; j < 4; ++j) { v[j] = xr[64 * j]; s += (v[j].x * v[j].x + v[j].y * v[j].y) + (v[j].z * v[j].z + v[j].w * v[j].w); }
  const float rstd = rsqrtf(wave_sum(s) * (1.f / DM) + EPS);
  u32x2* o = (u32x2*)orow + lane;
#pragma unroll
  for (int j = 0; j < 4; ++j) { u32x2 w; w.x = pk2(v[j].x * rstd, v[j].y * rstd); w.y = pk2(v[j].z * rstd, v[j].w * rstd); o[64 * j] = w; }
}

__device__ __forceinline__ void phase_prep(const Args& a, unsigned char* lds, int gw, int ngw, int wave, int lane, int tid) {
  unsigned char* ws = a.ws;
  float* scr = (float*)(lds + wave * 8448);
  const int I_IN = 16 * 96, I_SQ = 16 * 32;
  const int NITEMS = I_IN + 6 * I_SQ;
  for (int it = gw; it < NITEMS; it += ngw) {
    int r = it;
    if (r < I_IN) { transpose_item(a.in[3], INW, a.in[2], (bf16_t*)(ws + WS_WIN_T), DM, 0, scr, r / 96, r % 96, lane); continue; } r -= I_IN;
    const int which = r / I_SQ; r %= I_SQ; const int kb = r / 32, nb = r % 32;
    if (which == 0) { const float* g = (kb < 8) ? a.in[6] : (a.in[7] - 512); transpose_item(a.in[8], DM, g, (bf16_t*)(ws + WS_WOUT_T), DM, 0, scr, kb, nb, lane); }
    else if (which == 1) transpose_item(a.in[11], DM, a.in[9], (bf16_t*)(ws + WS_WXQ_T), DM, 0, scr, kb, nb, lane);
    else if (which == 2) transpose_item(a.in[12], DM, a.in[10], (bf16_t*)(ws + WS_WXKV_T), DM, 0, scr, kb, nb, lane);
    else if (which == 3) transpose_item(a.in[13], DM, a.in[10], (bf16_t*)(ws + WS_WXKV_T), DM, 1024, scr, kb, nb, lane);
    else if (which == 4) transpose_item(a.in[14], DM, nullptr, (bf16_t*)(ws + WS_WXO_T), DM, 0, scr, kb, nb, lane);
    else transpose_item(a.in[16], DM, a.in[15], (bf16_t*)(ws + WS_WPQ_T), DM, 0, scr, kb, nb, lane);
  }
  {
    const size_t n8 = (size_t)NEXP * DM / 8;
    const size_t gt = (size_t)blockIdx.x * 512 + tid, ngt = (size_t)gridDim.x * 512;
    for (int tb = 0; tb < 2; ++tb) {
      const f32x4* src = (const f32x4*)a.in[19 + tb]; u32x4* dst = (u32x4*)(ws + (tb ? WS_EXU : WS_EXD));
      for (size_t i = gt; i < n8; i += ngt) {
        const f32x4 p = src[2 * i], q = src[2 * i + 1];
        u32x4 o; o.x = pk2(p.x, p.y); o.y = pk2(p.z, p.w); o.z = pk2(q.x, q.y); o.w = pk2(q.z, q.w);
        dst[i] = o;
      }
    }
  }
  for (int r = gw; r < NMROWS; r += ngw) rms_row_to_bf16(a.in[1] + (size_t)r * DM, (bf16_t*)(ws + WS_MEMN) + (size_t)r * DM, lane);
  __syncthreads();
  float* wf = (float*)(lds + 69632);
  for (int k = tid; k < DM; k += 512) {
    const float g = a.in[2][k]; const f32x4* wp = (const f32x4*)(a.in[3] + (size_t)k * INW + NQKV);
    const f32x4 p = wp[0], q = wp[1];
    f32x4* d = (f32x4*)(wf + k * 8); d[0] = p * g; d[1] = q * g;
  }
  __syncthreads();
  float* flog = (float*)(ws + WS_FLOG);
  for (int r = gw; r < NT; r += ngw) {
    const f32x4* xr = (const f32x4*)(a.in[0] + (size_t)r * DM) + lane;
    f32x4 v[4]; float s = 0.f; float fa[8];
#pragma unroll
    for (int j = 0; j < 8; ++j) fa[j] = 0.f;
#pragma unroll
    for (int j = 0; j < 4; ++j) {
      v[j] = xr[64 * j]; s += (v[j].x * v[j].x + v[j].y * v[j].y) + (v[j].z * v[j].z + v[j].w * v[j].w);
#pragma unroll
      for (int c = 0; c < 4; ++c) {
        const float xv = v[j][c]; const f32x4* wp = (const f32x4*)(wf + (256 * j + 4 * lane + c) * 8);
        const f32x4 p = wp[0], q = wp[1];
        fa[0] += xv * p.x; fa[1] += xv * p.y; fa[2] += xv * p.z; fa[3] += xv * p.w;
        fa[4] += xv * q.x; fa[5] += xv * q.y; fa[6] += xv * q.z; fa[7] += xv * q.w;
      }
    }
    const float rstd = rsqrtf(wave_sum(s) * (1.f / DM) + EPS);
    float mine = 0.f;
#pragma unroll
    for (int j = 0; j < 8; ++j) { const float t = wave_sum(fa[j]); if (lane == j) mine = t; }
    if (lane < 8) {
      const float z = mine * rstd + a.in[4][lane];
      flog[(size_t)r * 8 + lane] = fminf(z, 0.f) - log1pf(expf(-fabsf(z)));
    }
    u32x2* o = (u32x2*)((bf16_t*)(ws + WS_HB) + (size_t)r * DM) + lane;
#pragma unroll
    for (int j = 0; j < 4; ++j) { u32x2 w; w.x = pk2(v[j].x * rstd, v[j].y * rstd); w.y = pk2(v[j].z * rstd, v[j].w * rstd); o[64 * j] = w; }
  }
}

template <class Epi>
__device__ __forceinline__ void gemm_naive(const bf16_t* A, int lda, const bf16_t* Bt, int ldb, int M, int N, int K, const Epi& E, int gw, int ngw, int lane) {
  const int fr = lane & 15, fq = lane >> 4;
  const int tn = N / 64, ntile = (M / 64) * tn;
  for (int tile = gw; tile < ntile; tile += ngw) {
    const int pm = tile / tn, pn = tile % tn;
    f32x4 acc[4][4];
#pragma unroll
    for (int m = 0; m < 4; ++m)
#pragma unroll
      for (int n = 0; n < 4; ++n) acc[m][n] = (f32x4){0.f, 0.f, 0.f, 0.f};
    const bf16_t* Ap = A + (size_t)(pm * 64 + fr) * lda + fq * 8;
    const bf16_t* Bp = Bt + (size_t)(pn * 64 + fr) * ldb + fq * 8;
    for (int k0 = 0; k0 < K; k0 += 32) {
      bf16x8 af[4], bfr[4];
#pragma unroll
      for (int m = 0; m < 4; ++m) af[m] = *(const bf16x8*)(Ap + (size_t)m * 16 * lda + k0);
#pragma unroll
      for (int n = 0; n < 4; ++n) bfr[n] = *(const bf16x8*)(Bp + (size_t)n * 16 * ldb + k0);
#pragma unroll
      for (int m = 0; m < 4; ++m)
#pragma unroll
        for (int n = 0; n < 4; ++n) acc[m][n] = __builtin_amdgcn_mfma_f32_16x16x32_bf16(bfr[n], af[m], acc[m][n], 0, 0, 0);
    }
#pragma unroll
    for (int m = 0; m < 4; ++m)
#pragma unroll
      for (int n = 0; n < 4; ++n) E.store(pm * 64 + m * 16 + fr, pn * 64 + n * 16 + 4 * fq, acc[m][n]);
  }
}

struct EpiBf16 { bf16_t* O; int ldo;
  __device__ __forceinline__ void store(int row, int col, f32x4 v) const { u32x2 w; w.x = pk2(v.x, v.y); w.y = pk2(v.z, v.w); *(u32x2*)(O + (size_t)row * ldo + col) = w; } };
struct EpiF32 { float* O; int ldo;
  __device__ __forceinline__ void store(int row, int col, f32x4 v) const { *(f32x4*)(O + (size_t)row * ldo + col) = v; } };
struct EpiResid { const float* base; float* out;
  __device__ __forceinline__ void store(int row, int col, f32x4 v) const { const size_t o = (size_t)row * DM + col; const f32x4 b = *(const f32x4*)(base + o); *(f32x4*)(out + o) = b + v; } };
struct EpiKV { bf16_t* KX; bf16_t* VXT;
  __device__ __forceinline__ void store(int row, int col, f32x4 v) const {
    if (col < 1024) { u32x2 w; w.x = pk2(v.x, v.y); w.y = pk2(v.z, v.w); *(u32x2*)(KX + (size_t)row * DM + col) = w; }
    else { const int b = row >> 8, m = row & 255;
#pragma unroll
      for (int r = 0; r < 4; ++r) { const int d = col - 1024 + r; VXT[((size_t)(b * 4 + (d >> 8)) * 256 + (d & 255)) * 256 + m] = (bf16_t)f2bf(v[r]); } } } };

__device__ __forceinline__ void phase_scan(const Args& a, int gw, int ngw, int lane, int tid) {
  unsigned char* ws = a.ws;
  const float* flog = (const float*)(ws + WS_FLOG); float* cum = (float*)(ws + WS_CUM);
  for (int p = gw; p < 64; p += ngw) {
    const int b = p >> 3, j = p & 7;
    const float* src = flog + ((size_t)b * SEQ + lane * 64) * 8 + j;
    float tot = 0.f;
    for (int i = 0; i < 64; ++i) tot += src[i * 8];
    float inc = tot;
#pragma unroll
    for (int o = 1; o < 64; o <<= 1) { const float t = __shfl_up(inc, o); if (lane >= o) inc += t; }
    float run = inc - tot;
    float* dst = cum + ((size_t)(b * 8 + j)) * SEQ + lane * 64;
    for (int i = 0; i < 64; ++i) { run += src[i * 8]; dst[i] = run; }
  }
  const bf16_t* qkv = (const bf16_t*)(ws + WS_QKV); float* kmean = (float*)(ws + WS_KMEAN);
  const int gt = blockIdx.x * 512 + tid, ngt = gridDim.x * 512;
  for (int o = gt; o < NB * 16 * 512; o += ngt) {
    const int c = o & 511, blk = (o >> 9) & 15, b = o >> 13;
    const bf16_t* p = qkv + ((size_t)b * SEQ + blk * 256) * NQKV + 512 + c;
    float s = 0.f;
    for (int r = 0; r < 256; ++r) s += bf2f(p[(size_t)r * NQKV]);
    kmean[o] = s * (1.f / 256.f);
  }
}

template <int MODE>
__device__ __forceinline__ void attn_naive_unit(const Args& a, unsigned char* lds, int b, int h, int sb, int tid) {
  unsigned char* ws = a.ws;
  const bf16_t* qkv = (const bf16_t*)(ws + WS_QKV);
  const int qoff = MODE ? 1536 : 0, koff = qoff + 512, voff = qoff + 1024;
  float* Ks = (float*)lds; float* Vs = Ks + 64 * 64; float* ck = Vs + 64 * 64; float* biasd = ck + 64;
  const int t = sb * 512 + tid; const size_t row = (size_t)b * SEQ + t;
  float q[64], o[64];
  {
    const u32x4* qp = (const u32x4*)(qkv + row * NQKV + qoff + h * 64);
#pragma unroll
    for (int c = 0; c < 8; ++c) { const u32x4 w = qp[c]; unpack8(w, q + 8 * c); }
#pragma unroll
    for (int d = 0; d < 64; ++d) { q[d] *= 0.125f; o[d] = 0.f; }
  }
  float m = -1e30f, l = 0.f;
  unsigned selmask = 0u; const int own = t >> 8;
  float cq = 0.f, bfar = 0.f;
  __syncthreads();
  if (MODE == 0) {
    if (tid < 128) biasd[tid] = a.in[5][T5_BUCKET[tid] * 8 + h];
    bfar = a.in[5][31 * 8 + h];
    const float* km = (const float*)(ws + WS_KMEAN) + ((size_t)b * 16) * 512 + h * 64;
    float v0 = -3e38f, v1 = -3e38f, v2 = -3e38f; int i0 = -1, i1 = -1, i2 = -1;
    for (int n = 0; n < 2 * sb + 1; ++n) {
      if (n < own) {
        const float* kp = km + (size_t)n * 512; float s = 0.f;
#pragma unroll
        for (int d = 0; d < 64; ++d) s += q[d] * kp[d];
        if (s > v0) { v2 = v1; i2 = i1; v1 = v0; i1 = i0; v0 = s; i0 = n; }
        else if (s > v1) { v2 = v1; i2 = i1; v1 = s; i1 = n; }
        else if (s > v2) { v2 = s; i2 = n; }
      }
    }
    if (i0 >= 0) selmask |= 1u << i0;
    if (i1 >= 0) selmask |= 1u << i1;
    if (i2 >= 0) selmask |= 1u << i2;
  } else {
    cq = ((const float*)(ws + WS_CUM))[((size_t)(b * 8 + h)) * SEQ + t];
  }
  const int ntile = 8 * (sb + 1);
  for (int kt = 0; kt < ntile; ++kt) {
    __syncthreads();
    {
      const int r = tid >> 3, ch = tid & 7;
      const bf16_t* kp = qkv + ((size_t)b * SEQ + kt * 64 + r) * NQKV + h * 64 + ch * 8;
      const u32x4 kw = *(const u32x4*)(kp + koff), vw = *(const u32x4*)(kp + voff);
      unpack8(kw, Ks + r * 64 + ch * 8); unpack8(vw, Vs + r * 64 + ch * 8);
      if (MODE == 1 && tid < 64) ck[tid] = ((const float*)(ws + WS_CUM))[((size_t)(b * 8 + h)) * SEQ + kt * 64 + tid];
    }
    __syncthreads();
    const int kb = kt >> 2;
    bool act;
    if (MODE == 0) act = (kb == own) || (kb < own && ((selmask >> kb) & 1u));
    else act = (kt * 64 <= t);
    if (act) {
      for (int jj = 0; jj < 64; ++jj) {
        const int sp = kt * 64 + jj;
        if (sp > t) break;
        const f32x4* kr = (const f32x4*)(Ks + jj * 64);
        float s = 0.f;
#pragma unroll
        for (int c = 0; c < 16; ++c) { const f32x4 kv = kr[c]; s += q[4 * c] * kv.x + q[4 * c + 1] * kv.y + q[4 * c + 2] * kv.z + q[4 * c + 3] * kv.w; }
        if (MODE == 0) { const int dist = t - sp; s += (dist < 128) ? biasd[dist] : bfar; }
        else s += cq - ck[jj];
        if (s > m) { const float f = __expf(m - s); l *= f;
#pragma unroll
          for (int d = 0; d < 64; ++d) o[d] *= f;
          m = s; }
        const float p = __expf(s - m); l += p;
        const f32x4* vr = (const f32x4*)(Vs + jj * 64);
#pragma unroll
        for (int c = 0; c < 16; ++c) { const f32x4 vv = vr[c]; o[4 * c] += p * vv.x; o[4 * c + 1] += p * vv.y; o[4 * c + 2] += p * vv.z; o[4 * c + 3] += p * vv.w; }
      }
    }
  }
  const float il = 1.f / l;
  u32x4* op = (u32x4*)((bf16_t*)(ws + WS_OAB) + row * DM + (MODE ? 512 : 0) + h * 64);
#pragma unroll
  for (int c = 0; c < 8; ++c) { u32x4 w; w.x = pk2(o[8 * c] * il, o[8 * c + 1] * il); w.y = pk2(o[8 * c + 2] * il, o[8 * c + 3] * il); w.z = pk2(o[8 * c + 4] * il, o[8 * c + 5] * il); w.w = pk2(o[8 * c + 6] * il, o[8 * c + 7] * il); op[c] = w; }
}

__device__ __forceinline__ void phase_attn(const Args& a, unsigned char* lds, int tid) {
  for (int u = blockIdx.x; u < 1024; u += gridDim.x) {
    const int sb = 7 - (u >> 7), r = u & 127, mode = r & 1, bh = r >> 1;
    if (mode == 0) attn_naive_unit<0>(a, lds, bh >> 3, bh & 7, sb, tid);
    else attn_naive_unit<1>(a, lds, bh >> 3, bh & 7, sb, tid);
  }
}

__device__ __forceinline__ void phase_onorm(const Args& a, int gw, int ngw, int lane) {
  bf16_t* oab = (bf16_t*)(a.ws + WS_OAB);
  for (int r = gw; r < NT; r += ngw) {
    u32x4* p = (u32x4*)(oab + (size_t)r * DM) + 2 * lane;
    const u32x4 w0 = p[0], w1 = p[1]; float f[16]; unpack8(w0, f); unpack8(w1, f + 8);
    float s = 0.f;
#pragma unroll
    for (int i = 0; i < 16; ++i) s += f[i] * f[i];
#pragma unroll
    for (int o = 1; o < 32; o <<= 1) s += __shfl_xor(s, o);
    const float rstd = rsqrtf(s * (1.f / 512.f) + EPS);
    u32x4 o0, o1;
    o0.x = pk2(f[0] * rstd, f[1] * rstd); o0.y = pk2(f[2] * rstd, f[3] * rstd); o0.z = pk2(f[4] * rstd, f[5] * rstd); o0.w = pk2(f[6] * rstd, f[7] * rstd);
    o1.x = pk2(f[8] * rstd, f[9] * rstd); o1.y = pk2(f[10] * rstd, f[11] * rstd); o1.z = pk2(f[12] * rstd, f[13] * rstd); o1.w = pk2(f[14] * rstd, f[15] * rstd);
    p[0] = o0; p[1] = o1;
  }
}

__device__ __forceinline__ void phase_rms(const Args& a, int gw, int ngw, int lane) {
  for (int r = gw; r < NT; r += ngw) rms_row_to_bf16(a.out + (size_t)r * DM, (bf16_t*)(a.ws + WS_HB) + (size_t)r * DM, lane);
}

__device__ __forceinline__ void phase_xattn(const Args& a, unsigned char* lds, int gw, int ngw, int wave, int lane) {
  unsigned char* ws = a.ws;
  const bf16_t* qx = (const bf16_t*)(ws + WS_QX); const bf16_t* kx = (const bf16_t*)(ws + WS_KX); const bf16_t* vxt = (const bf16_t*)(ws + WS_VXT);
  bf16_t* ox = (bf16_t*)(ws + WS_OX);
  bf16_t* P = (bf16_t*)(lds + wave * 8192);
  const int fr = lane & 15, fq = lane >> 4;
  for (int u = gw; u < (NT / 16) * 4; u += ngw) {
    const int hd = u & 3, r0 = (u >> 2) * 16, b = r0 / SEQ;
    f32x4 acc[16];
#pragma unroll
    for (int i = 0; i < 16; ++i) acc[i] = (f32x4){0.f, 0.f, 0.f, 0.f};
    const bf16_t* Ap = qx + (size_t)(r0 + fr) * DM + hd * 256 + fq * 8;
    const bf16_t* Bp = kx + (size_t)(b * 256 + fr) * DM + hd * 256 + fq * 8;
    for (int ks = 0; ks < 8; ++ks) {
      const bf16x8 af = *(const bf16x8*)(Ap + ks * 32);
#pragma unroll
      for (int ct = 0; ct < 16; ++ct) { const bf16x8 bfr = *(const bf16x8*)(Bp + (size_t)ct * 16 * DM + ks * 32); acc[ct] = __builtin_amdgcn_mfma_f32_16x16x32_bf16(af, bfr, acc[ct], 0, 0, 0); }
    }
    float mx[4], sm[4];
#pragma unroll
    for (int r = 0; r < 4; ++r) { float m = acc[0][r];
#pragma unroll
      for (int ct = 1; ct < 16; ++ct) m = fmaxf(m, acc[ct][r]);
#pragma unroll
      for (int o = 1; o < 16; o <<= 1) m = fmaxf(m, __shfl_xor(m, o));
      mx[r] = m; sm[r] = 0.f; }
#pragma unroll
    for (int ct = 0; ct < 16; ++ct)
#pragma unroll
      for (int r = 0; r < 4; ++r) { const float p = __expf((acc[ct][r] - mx[r]) * 0.0625f); acc[ct][r] = p; sm[r] += p; }
#pragma unroll
    for (int r = 0; r < 4; ++r) {
#pragma unroll
      for (int o = 1; o < 16; o <<= 1) sm[r] += __shfl_xor(sm[r], o);
      sm[r] = 1.f / sm[r]; }
    __builtin_amdgcn_wave_barrier();
#pragma unroll
    for (int ct = 0; ct < 16; ++ct)
#pragma unroll
      for (int r = 0; r < 4; ++r) P[(4 * fq + r) * 256 + ct * 16 + fr] = (bf16_t)f2bf(acc[ct][r] * sm[r]);
    __builtin_amdgcn_wave_barrier();
    asm volatile("s_waitcnt lgkmcnt(0)" ::: "memory");
#pragma unroll
    for (int i = 0; i < 16; ++i) acc[i] = (f32x4){0.f, 0.f, 0.f, 0.f};
    const bf16_t* Vp = vxt + ((size_t)(b * 4 + hd) * 256 + fr) * 256 + fq * 8;
    for (int ks = 0; ks < 8; ++ks) {
      const bf16x8 pf = *(const bf16x8*)(P + fr * 256 + ks * 32 + fq * 8);
#pragma unroll
      for (int dt = 0; dt < 16; ++dt) { const bf16x8 vf = *(const bf16x8*)(Vp + (size_t)dt * 16 * 256 + ks * 32); acc[dt] = __builtin_amdgcn_mfma_f32_16x16x32_bf16(pf, vf, acc[dt], 0, 0, 0); }
    }
#pragma unroll
    for (int dt = 0; dt < 16; ++dt)
#pragma unroll
      for (int r = 0; r < 4; ++r) ox[(size_t)(r0 + 4 * fq + r) * DM + hd * 256 + dt * 16 + fr] = (bf16_t)f2bf(acc[dt][r]);
    __builtin_amdgcn_wave_barrier();
  }
}

__device__ __forceinline__ unsigned fkey(float s, unsigned idx, unsigned mask) { unsigned u = __float_as_uint(s); u ^= (unsigned)((int)u >> 31) | 0x80000000u; return (u & ~mask) | (mask - idx); }
__device__ __forceinline__ float keyval(unsigned k, unsigned mask) { unsigned u = k & ~mask; u = (u & 0x80000000u) ? (u ^ 0x80000000u) : ~u; return __uint_as_float(u); }
#define KEY_INSERT(KA, key_) do { unsigned k__ = (key_); \
  _Pragma("unroll") for (int s_ = 0; s_ < 16; ++s_) { const unsigned hi_ = max(k__, KA[s_]); k__ = min(k__, KA[s_]); KA[s_] = hi_; } } while (0)

__device__ __forceinline__ void phase_topk(const Args& a, unsigned char* lds, int tid) {
  unsigned char* ws = a.ws;
  const float* pq = (const float*)(ws + WS_PQ);
  int* eidx = (int*)(ws + WS_EIDX); float* gate = (float*)(ws + WS_GATE);
  float* K1 = (float*)lds; float* K2 = K1 + 128 * 64; unsigned* KL = (unsigned*)(lds + 65536);
  for (int u = blockIdx.x; u < 8 * (NT / 512); u += gridDim.x) {
    const int h = u & 7, t = (u >> 3) * 512 + tid;
    __syncthreads();
    for (int i = tid; i < 128 * 64 / 4; i += 512) { ((f32x4*)K1)[i] = ((const f32x4*)(a.in[17] + (size_t)h * 8192))[i]; ((f32x4*)K2)[i] = ((const f32x4*)(a.in[18] + (size_t)h * 8192))[i]; }
    __syncthreads();
    unsigned ka[16], kb[16], kc[16];
#pragma unroll
    for (int k = 0; k < 16; ++k) { ka[k] = 0u; kb[k] = 0u; kc[k] = 0u; }
    float q[64];
    const f32x4* qp = (const f32x4*)(pq + (size_t)t * DM + h * 128);
#pragma unroll
    for (int c = 0; c < 16; ++c) { const f32x4 w = qp[c]; q[4 * c] = w.x; q[4 * c + 1] = w.y; q[4 * c + 2] = w.z; q[4 * c + 3] = w.w; }
    for (int n = 0; n < 128; ++n) {
      const f32x4* kr = (const f32x4*)(K1 + n * 64); float s = 0.f;
#pragma unroll
      for (int c = 0; c < 16; ++c) { const f32x4 kv = kr[c]; s += q[4 * c] * kv.x + q[4 * c + 1] * kv.y + q[4 * c + 2] * kv.z + q[4 * c + 3] * kv.w; }
      KEY_INSERT(ka, fkey(s, (unsigned)n, 127u));
    }
#pragma unroll
    for (int c = 0; c < 16; ++c) { const f32x4 w = qp[16 + c]; q[4 * c] = w.x; q[4 * c + 1] = w.y; q[4 * c + 2] = w.z; q[4 * c + 3] = w.w; }
    for (int n = 0; n < 128; ++n) {
      const f32x4* kr = (const f32x4*)(K2 + n * 64); float s = 0.f;
#pragma unroll
      for (int c = 0; c < 16; ++c) { const f32x4 kv = kr[c]; s += q[4 * c] * kv.x + q[4 * c + 1] * kv.y + q[4 * c + 2] * kv.z + q[4 * c + 3] * kv.w; }
      KEY_INSERT(kb, fkey(s, (unsigned)n, 127u));
    }
#pragma unroll
    for (int x = 0; x < 16; ++x)
#pragma unroll
      for (int y = 0; y < 16; ++y)
        if ((x + 1) * (y + 1) <= 16) { KEY_INSERT(kc, fkey(keyval(ka[x], 127u) + keyval(kb[y], 127u), (unsigned)(x * 16 + y), 255u)); }
#pragma unroll
    for (int k = 0; k < 16; ++k) { KL[k * 512 + tid] = ka[k]; KL[(16 + k) * 512 + tid] = kb[k]; }
    float val[16]; int id[16]; float sum = 0.f;
#pragma unroll
    for (int k = 0; k < 16; ++k) {
      const unsigned flat = 255u - (kc[k] & 255u);
      const unsigned k1 = KL[(flat >> 4) * 512 + tid], k2 = KL[(16 + (flat & 15u)) * 512 + tid];
      val[k] = keyval(k1, 127u) + keyval(k2, 127u);
      id[k] = (int)((127u - (k1 & 127u)) * 128u + (127u - (k2 & 127u)));
    }
    const float vmax = val[0];
#pragma unroll
    for (int k = 0; k < 16; ++k) { val[k] = __expf(val[k] - vmax); sum += val[k]; }
    const float inv = 1.f / sum;
    int* ep = eidx + (size_t)t * 128 + h * 16; float* gp = gate + (size_t)t * 128 + h * 16;
#pragma unroll
    for (int k = 0; k < 16; ++k) { ep[k] = id[k]; gp[k] = val[k] * inv; }
  }
}

__device__ __forceinline__ float gelu_erf(float v) { return 0.5f * v * (1.f + erff(v * 0.70710678118654752f)); }

__device__ __forceinline__ void phase_experts(const Args& a, int gw, int ngw, int lane) {
  unsigned char* ws = a.ws;
  const int* eidx = (const int*)(ws + WS_EIDX); const float* gate = (const float*)(ws + WS_GATE);
  const bf16_t* exd = (const bf16_t*)(ws + WS_EXD); const bf16_t* exu = (const bf16_t*)(ws + WS_EXU);
  for (int t = gw; t < NT; t += ngw) {
    f32x4* xr = (f32x4*)(a.out + (size_t)t * DM) + lane;
    f32x4 x[4], hg[4], acc[4]; float s = 0.f;
#pragma unroll
    for (int j = 0; j < 4; ++j) { x[j] = xr[64 * j]; s += (x[j].x * x[j].x + x[j].y * x[j].y) + (x[j].z * x[j].z + x[j].w * x[j].w); acc[j] = (f32x4){0.f, 0.f, 0.f, 0.f}; }
    const float rstd = rsqrtf(wave_sum(s) * (1.f / DM) + EPS);
#pragma unroll
    for (int j = 0; j < 4; ++j) { const f32x4 g = ((const f32x4*)a.in[15])[64 * j + lane]; hg[j] = x[j] * rstd * g; }
    const int e0 = eidx[(size_t)t * 128 + lane], e1 = eidx[(size_t)t * 128 + 64 + lane];
    const float g0 = gate[(size_t)t * 128 + lane], g1 = gate[(size_t)t * 128 + 64 + lane];
    for (int e = 0; e < 128; e += 4) {
      float dot[4]; int id[4];
#pragma unroll
      for (int i = 0; i < 4; ++i) {
        const int ee = e + i;
        id[i] = (ee < 64) ? __shfl(e0, ee) : __shfl(e1, ee - 64);
        const u32x2* up = (const u32x2*)(exd + (size_t)id[i] * DM) + lane;
        float d = 0.f;
#pragma unroll
        for (int j = 0; j < 4; ++j) { const u32x2 w = up[64 * j]; d += hg[j].x * bflo(w.x) + hg[j].y * bfhi(w.x) + hg[j].z * bflo(w.y) + hg[j].w * bfhi(w.y); }
        dot[i] = d;
      }
#pragma unroll
      for (int i = 0; i < 4; ++i) {
        const int ee = e + i;
        const float gg = (ee < 64) ? __shfl(g0, ee) : __shfl(g1, ee - 64);
        const float w = gg * gelu_erf(wave_sum(dot[i]));
        const u32x2* vp = (const u32x2*)(exu + (size_t)id[i] * DM) + lane;
#pragma unroll
        for (int j = 0; j < 4; ++j) { const u32x2 q = vp[64 * j]; acc[j].x += w * bflo(q.x); acc[j].y += w * bfhi(q.x); acc[j].z += w * bflo(q.y); acc[j].w += w * bfhi(q.y); }
      }
    }
    float s2 = 0.f;
#pragma unroll
    for (int j = 0; j < 4; ++j) { x[j] = x[j] + acc[j]; s2 += (x[j].x * x[j].x + x[j].y * x[j].y) + (x[j].z * x[j].z + x[j].w * x[j].w); }
    const float r2 = rsqrtf(wave_sum(s2) * (1.f / DM) + EPS);
#pragma unroll
    for (int j = 0; j < 4; ++j) { const f32x4 g = ((const f32x4*)a.in[21])[64 * j + lane]; xr[64 * j] = x[j] * r2 * g; }
  }
}

__global__ void __launch_bounds__(512) mega(Args a) {
  extern __shared__ __attribute__((aligned(16))) unsigned char lds[];
  cg::grid_group grid = cg::this_grid();
  const int tid = threadIdx.x, lane = tid & 63, wave = tid >> 6;
  const int gw = blockIdx.x * 8 + wave, ngw = gridDim.x * 8;
  unsigned char* ws = a.ws;
  const int lo = a.ph_lo, hi = a.ph_hi;
#define IN(k) (lo <= (k) && (k) < hi)
#define SEAM(k) do { if (IN(k) && IN((k) + 1)) grid.sync(); } while (0)
  if (IN(0)) { phase_prep(a, lds, gw, ngw, wave, lane, tid); } SEAM(0);
  if (IN(1)) {
    gemm_naive((const bf16_t*)(ws + WS_HB), DM, (const bf16_t*)(ws + WS_WIN_T), DM, NT, NQKV, DM, EpiBf16{(bf16_t*)(ws + WS_QKV), NQKV}, gw, ngw, lane);
    gemm_naive((const bf16_t*)(ws + WS_MEMN), DM, (const bf16_t*)(ws + WS_WXKV_T), DM, NMROWS, 2048, DM, EpiKV{(bf16_t*)(ws + WS_KX), (bf16_t*)(ws + WS_VXT)}, gw, ngw, lane);
  } SEAM(1);
  if (IN(2)) { phase_scan(a, gw, ngw, lane, tid); } SEAM(2);
  if (IN(3)) { phase_attn(a, lds, tid); } SEAM(3);
  if (IN(4)) { phase_onorm(a, gw, ngw, lane); } SEAM(4);
  if (IN(5)) { gemm_naive((const bf16_t*)(ws + WS_OAB), DM, (const bf16_t*)(ws + WS_WOUT_T), DM, NT, DM, DM, EpiResid{a.in[0], a.out}, gw, ngw, lane); } SEAM(5);
  if (IN(6)) { phase_rms(a, gw, ngw, lane); } SEAM(6);
  if (IN(7)) { gemm_naive((const bf16_t*)(ws + WS_HB), DM, (const bf16_t*)(ws + WS_WXQ_T), DM, NT, DM, DM, EpiBf16{(bf16_t*)(ws + WS_QX), DM}, gw, ngw, lane); } SEAM(7);
  if (IN(8)) { phase_xattn(a, lds, gw, ngw, wave, lane); } SEAM(8);
  if (IN(9)) { gemm_naive((const bf16_t*)(ws + WS_OX), DM, (const bf16_t*)(ws + WS_WXO_T), DM, NT, DM, DM, EpiResid{a.out, a.out}, gw, ngw, lane); } SEAM(9);
  if (IN(10)) { phase_rms(a, gw, ngw, lane); } SEAM(10);
  if (IN(11)) { gemm_naive((const bf16_t*)(ws + WS_HB), DM, (const bf16_t*)(ws + WS_WPQ_T), DM, NT, DM, DM, EpiF32{(float*)(ws + WS_PQ), DM}, gw, ngw, lane); } SEAM(11);
  if (IN(12)) { phase_topk(a, lds, tid); } SEAM(12);
  if (IN(13)) { phase_experts(a, gw, ngw, lane); }
#undef IN
#undef SEAM
}

extern "C" void kernel_launch(void* const* d_in, const int* in_sizes, int n_in, void* d_out, int out_size, void* d_ws, size_t ws_size, hipStream_t stream) {
  static int grid = 0;
  if (grid == 0) {
    if (n_in != 22 || out_size != NT * DM || ws_size < WS_END) { fprintf(stderr, "kernel_launch: unexpected shapes (n_in %d out %d ws %zu)\n", n_in, out_size, ws_size); grid = -1; return; }
    int dev = 0, cus = 0, per_cu = 0;
    (void)hipGetDevice(&dev);
    (void)hipDeviceGetAttribute(&cus, hipDeviceAttributeMultiprocessorCount, dev);
    (void)hipFuncSetAttribute((const void*)mega, hipFuncAttributeMaxDynamicSharedMemorySize, LDS_BYTES);
    (void)hipOccupancyMaxActiveBlocksPerMultiprocessor(&per_cu, (const void*)mega, 512, LDS_BYTES);
    if (per_cu < 1) per_cu = 1;
    grid = cus * per_cu;
  }
  if (grid < 0) return;
  Args a{};
  for (int i = 0; i < 22; ++i) a.in[i] = (const float*)d_in[i];
  a.out = (float*)d_out; a.ws = (unsigned char*)d_ws;
#if MK_N_LAUNCHES == 1
  a.ph_lo = 0; a.ph_hi = NPHASE + 1;
  void* args[] = {&a};
  hipError_t e = hipLaunchCooperativeKernel((const void*)mega, dim3(grid), dim3(512), args, LDS_BYTES, stream);
  if (e != hipSuccess) fprintf(stderr, "cooperative launch failed: %s (grid %d)\n", hipGetErrorString(e), grid);
#else
  for (int p = 0; p <= NPHASE; ++p) { a.ph_lo = p; a.ph_hi = p + 1; hipLaunchKernelGGL(mega, dim3(grid), dim3(512), LDS_BYTES, stream, a); }
#endif
}
```

```cpp
#include <hip/hip_runtime.h>
#include <hip/hip_cooperative_groups.h>
#include <cstdio>
#include <cstdint>
namespace cg = cooperative_groups;

#ifndef USE_PG8
#define USE_PG8 1
#endif
#ifndef USE_ATT2
#define USE_ATT2 1
#endif
#ifndef MK_N_LAUNCHES
#define MK_N_LAUNCHES 1
#endif

typedef unsigned short bf16_t;
typedef short bf16x8 __attribute__((ext_vector_type(8)));
typedef float f32x4 __attribute__((ext_vector_type(4)));
typedef unsigned u32x4 __attribute__((ext_vector_type(4)));
typedef unsigned u32x2 __attribute__((ext_vector_type(2)));

constexpr int NB = 8, SEQ = 4096, DM = 1024, NT = NB * SEQ;
constexpr int NQKV = 3072, INW = 3080;
constexpr int NMEM = 256, NMROWS = NB * NMEM;
constexpr int NEXP = 16384;
constexpr float EPS = 1e-6f;
constexpr int NPHASE = 13;
constexpr int LDS_BYTES = 147456;

constexpr size_t MiB = 1u << 20;
constexpr size_t WS_WIN_T = 2 * MiB;
constexpr size_t WS_WOUT_T = 8 * MiB;
constexpr size_t WS_WXQ_T = 10 * MiB;
constexpr size_t WS_WXKV_T = 12 * MiB;
constexpr size_t WS_WXO_T = 16 * MiB;
constexpr size_t WS_WPQ_T = 18 * MiB;
constexpr size_t WS_MEMN = 22 * MiB;
constexpr size_t WS_KX = 26 * MiB;
constexpr size_t WS_VXT = 30 * MiB;
constexpr size_t WS_FLOG = 34 * MiB;
constexpr size_t WS_CUM = 35 * MiB;
constexpr size_t WS_KMEAN = 36 * MiB;
constexpr size_t WS_EXD = 40 * MiB;
constexpr size_t WS_EXU = 72 * MiB;
constexpr size_t WS_HB = 104 * MiB;
constexpr size_t WS_QKV = 168 * MiB;
constexpr size_t WS_OAB = 360 * MiB;
constexpr size_t WS_QX = 168 * MiB;
constexpr size_t WS_OX = 232 * MiB;
constexpr size_t WS_PQ = 232 * MiB;
constexpr size_t WS_EIDX = 424 * MiB;
constexpr size_t WS_GATE = 440 * MiB;
constexpr size_t WS_END = 456 * MiB;

struct Args {
  const float* in[22];
  float* out;
  unsigned char* ws;
  int ph_lo, ph_hi;
};

__device__ __forceinline__ unsigned f2bf(float f) { unsigned u = __float_as_uint(f); return (u + 0x7fffu + ((u >> 16) & 1u)) >> 16; }
__device__ __forceinline__ unsigned pk2(float lo, float hi) { return f2bf(lo) | (f2bf(hi) << 16); }
__device__ __forceinline__ float bf2f(unsigned short b) { return __uint_as_float(((unsigned)b) << 16); }
__device__ __forceinline__ float bflo(unsigned w) { return __uint_as_float(w << 16); }
__device__ __forceinline__ float bfhi(unsigned w) { return __uint_as_float(w & 0xffff0000u); }
__device__ __forceinline__ float wave_sum(float v) {
#pragma unroll
  for (int o = 1; o < 64; o <<= 1) v += __shfl_xor(v, o);
  return v;
}
__device__ __forceinline__ void unpack8(const u32x4 w, float* f) {
  f[0] = bflo(w.x); f[1] = bfhi(w.x); f[2] = bflo(w.y); f[3] = bfhi(w.y);
  f[4] = bflo(w.z); f[5] = bfhi(w.z); f[6] = bflo(w.w); f[7] = bfhi(w.w);
}

__device__ const unsigned char T5_BUCKET[128] = {
  0, 1, 2, 3, 4, 5, 6, 7, 8, 9, 10, 11, 12, 13, 14, 15, 16, 16, 16, 17, 17, 18, 18, 18, 19, 19, 19, 20, 20, 20, 20, 21,
  21, 21, 21, 22, 22, 22, 22, 22, 23, 23, 23, 23, 23, 23, 24, 24, 24, 24, 24, 24, 25, 25, 25, 25, 25, 25, 25, 26, 26, 26, 26, 26,
  26, 26, 26, 27, 27, 27, 27, 27, 27, 27, 27, 27, 27, 28, 28, 28, 28, 28, 28, 28, 28, 28, 28, 29, 29, 29, 29, 29, 29, 29, 29, 29,
  29, 29, 29, 30, 30, 30, 30, 30, 30, 30, 30, 30, 30, 30, 30, 30, 30, 31, 31, 31, 31, 31, 31, 31, 31, 31, 31, 31, 31, 31, 31, 31};

__device__ __forceinline__ void transpose_item(const float* W, int ldw, const float* gain, bf16_t* WT, int K, int row_off, float* scr, int kb, int nb, int lane) {
  const int k0 = 64 * kb, n0 = 32 * nb;
#pragma unroll 8
  for (int i = 0; i < 32; ++i) {
    const int kk = 2 * i + (lane >> 5);
    const float g = gain ? gain[k0 + kk] : 1.f;
    scr[kk * 33 + (lane & 31)] = W[(size_t)(k0 + kk) * ldw + n0 + (lane & 31)] * g;
  }
  __builtin_amdgcn_wave_barrier();
  const int c = lane & 7;
#pragma unroll
  for (int j = 0; j < 4; ++j) {
    const int n = (lane >> 3) + 8 * j; const float* s = scr + (8 * c) * 33 + n;
    u32x4 o; o.x = pk2(s[0 * 33], s[1 * 33]); o.y = pk2(s[2 * 33], s[3 * 33]); o.z = pk2(s[4 * 33], s[5 * 33]); o.w = pk2(s[6 * 33], s[7 * 33]);
    *(u32x4*)(WT + (size_t)(row_off + n0 + n) * K + k0 + 8 * c) = o;
  }
  __builtin_amdgcn_wave_barrier();
}

__device__ __forceinline__ void rms_row_to_bf16(const float* xrow, bf16_t* orow, int lane) {
  const f32x4* xr = (const f32x4*)xrow + lane;
  f32x4 v[4]; float s = 0.f;
#pragma unroll
  for (int j = 0; j < 4; ++j) { v[j] = xr[64 * j]; s += (v[j].x * v[j].x + v[j].y * v[j].y) + (v[j].z * v[j].z + v[j].w * v[j].w); }
  const float rstd = rsqrtf(wave_sum(s) * (1.f / DM) + EPS);
  u32x2* o = (u32x2*)orow + lane;
#pragma unroll
  for (int j = 0; j < 4; ++j) { u32x2 w; w.x = pk2(v[j].x * rstd, v[j].y * rstd); w.y = pk2(v[j].z * rstd, v[j].w * rstd); o[64 * j] = w; }
}

__device__ __forceinline__ void phase_prep(const Args& a, unsigned char* lds, int gw, int ngw, int wave, int lane, int tid) {
  unsigned char* ws = a.ws;
  if (blockIdx.x == 0 && tid < 128) ((unsigned*)ws)[tid] = 0u;
  float* scr = (float*)(lds + wave * 8448);
  const int I_IN = 16 * 96, I_SQ = 16 * 32;
  const int NITEMS = I_IN + 6 * I_SQ;
  for (int it = gw; it < NITEMS; it += ngw) {
    int r = it;
    if (r < I_IN) { transpose_item(a.in[3], INW, a.in[2], (bf16_t*)(ws + WS_WIN_T), DM, 0, scr, r / 96, r % 96, lane); continue; } r -= I_IN;
    const int which = r / I_SQ; r %= I_SQ; const int kb = r / 32, nb = r % 32;
    if (which == 0) { const float* g = (kb < 8) ? a.in[6] : (a.in[7] - 512); transpose_item(a.in[8], DM, g, (bf16_t*)(ws + WS_WOUT_T), DM, 0, scr, kb, nb, lane); }
    else if (which == 1) transpose_item(a.in[11], DM, a.in[9], (bf16_t*)(ws + WS_WXQ_T), DM, 0, scr, kb, nb, lane);
    else if (which == 2) transpose_item(a.in[12], DM, a.in[10], (bf16_t*)(ws + WS_WXKV_T), DM, 0, scr, kb, nb, lane);
    else if (which == 3) transpose_item(a.in[13], DM, a.in[10], (bf16_t*)(ws + WS_WXKV_T), DM, 1024, scr, kb, nb, lane);
    else if (which == 4) transpose_item(a.in[14], DM, nullptr, (bf16_t*)(ws + WS_WXO_T), DM, 0, scr, kb, nb, lane);
    else transpose_item(a.in[16], DM, a.in[15], (bf16_t*)(ws + WS_WPQ_T), DM, 0, scr, kb, nb, lane);
  }
  {
    const size_t n8 = (size_t)NEXP * DM / 8;
    const size_t gt = (size_t)blockIdx.x * 512 + tid, ngt = (size_t)gridDim.x * 512;
    for (int tb = 0; tb < 2; ++tb) {
      const f32x4* src = (const f32x4*)a.in[19 + tb]; u32x4* dst = (u32x4*)(ws + (tb ? WS_EXU : WS_EXD));
      for (size_t i = gt; i < n8; i += ngt) {
        const f32x4 p = src[2 * i], q = src[2 * i + 1];
        u32x4 o; o.x = pk2(p.x, p.y); o.y = pk2(p.z, p.w); o.z = pk2(q.x, q.y); o.w = pk2(q.z, q.w);
        dst[i] = o;
      }
    }
  }
  for (int r = gw; r < NMROWS; r += ngw) rms_row_to_bf16(a.in[1] + (size_t)r * DM, (bf16_t*)(ws + WS_MEMN) + (size_t)r * DM, lane);
  __syncthreads();
  float* wf = (float*)(lds + 69632);
  for (int k = tid; k < DM; k += 512) {
    const float g = a.in[2][k]; const f32x4* wp = (const f32x4*)(a.in[3] + (size_t)k * INW + NQKV);
    const f32x4 p = wp[0], q = wp[1];
    f32x4* d = (f32x4*)(wf + k * 8); d[0] = p * g; d[1] = q * g;
  }
  __syncthreads();
  float* flog = (float*)(ws + WS_FLOG);
  for (int r = gw; r < NT; r += ngw) {
    const f32x4* xr = (const f32x4*)(a.in[0] + (size_t)r * DM) + lane;
    f32x4 v[4]; float s = 0.f; float fa[8];
#pragma unroll
    for (int j = 0; j < 8; ++j) fa[j] = 0.f;
#pragma unroll
    for (int j = 0; j < 4; ++j) {
      v[j] = xr[64 * j]; s += (v[j].x * v[j].x + v[j].y * v[j].y) + (v[j].z * v[j].z + v[j].w * v[j].w);
#pragma unroll
      for (int c = 0; c < 4; ++c) {
        const float xv = v[j][c]; const f32x4* wp = (const f32x4*)(wf + (256 * j + 4 * lane + c) * 8);
        const f32x4 p = wp[0], q = wp[1];
        fa[0] += xv * p.x; fa[1] += xv * p.y; fa[2] += xv * p.z; fa[3] += xv * p.w;
        fa[4] += xv * q.x; fa[5] += xv * q.y; fa[6] += xv * q.z; fa[7] += xv * q.w;
      }
    }
    const float rstd = rsqrtf(wave_sum(s) * (1.f / DM) + EPS);
    float mine = 0.f;
#pragma unroll
    for (int j = 0; j < 8; ++j) { const float t = wave_sum(fa[j]); if (lane == j) mine = t; }
    if (lane < 8) {
      const float z = mine * rstd + a.in[4][lane];
      flog[(size_t)r * 8 + lane] = fminf(z, 0.f) - log1pf(expf(-fabsf(z)));
    }
    u32x2* o = (u32x2*)((bf16_t*)(ws + WS_HB) + (size_t)r * DM) + lane;
#pragma unroll
    for (int j = 0; j < 4; ++j) { u32x2 w; w.x = pk2(v[j].x * rstd, v[j].y * rstd); w.y = pk2(v[j].z * rstd, v[j].w * rstd); o[64 * j] = w; }
  }
}

template <class Epi>
__device__ __forceinline__ void gemm_naive(const bf16_t* A, int lda, const bf16_t* Bt, int ldb, int M, int N, int K, const Epi& E, int gw, int ngw, int lane) {
  const int fr = lane & 15, fq = lane >> 4;
  const int tn = N / 64, ntile = (M / 64) * tn;
  for (int tile = gw; tile < ntile; tile += ngw) {
    const int pm = tile / tn, pn = tile % tn;
    f32x4 acc[4][4];
#pragma unroll
    for (int m = 0; m < 4; ++m)
#pragma unroll
      for (int n = 0; n < 4; ++n) acc[m][n] = (f32x4){0.f, 0.f, 0.f, 0.f};
    const bf16_t* Ap = A + (size_t)(pm * 64 + fr) * lda + fq * 8;
    const bf16_t* Bp = Bt + (size_t)(pn * 64 + fr) * ldb + fq * 8;
    for (int k0 = 0; k0 < K; k0 += 32) {
      bf16x8 af[4], bfr[4];
#pragma unroll
      for (int m = 0; m < 4; ++m) af[m] = *(const bf16x8*)(Ap + (size_t)m * 16 * lda + k0);
#pragma unroll
      for (int n = 0; n < 4; ++n) bfr[n] = *(const bf16x8*)(Bp + (size_t)n * 16 * ldb + k0);
#pragma unroll
      for (int m = 0; m < 4; ++m)
#pragma unroll
        for (int n = 0; n < 4; ++n) acc[m][n] = __builtin_amdgcn_mfma_f32_16x16x32_bf16(bfr[n], af[m], acc[m][n], 0, 0, 0);
    }
#pragma unroll
    for (int m = 0; m < 4; ++m)
#pragma unroll
      for (int n = 0; n < 4; ++n) E.store(pm * 64 + m * 16 + fr, pn * 64 + n * 16 + 4 * fq, acc[m][n]);
  }
}

struct EpiBf16 { bf16_t* O; int ldo;
  __device__ __forceinline__ void store(int row, int col, f32x4 v) const { u32x2 w; w.x = pk2(v.x, v.y); w.y = pk2(v.z, v.w); *(u32x2*)(O + (size_t)row * ldo + col) = w; } };
struct EpiQKV { bf16_t* O;
  __device__ __forceinline__ void store(int row, int col, f32x4 v) const { const float sc = (col < 512 || (col >= 1536 && col < 2048)) ? 0.18033688011112042f : 1.f;
    u32x2 w; w.x = pk2(v.x * sc, v.y * sc); w.y = pk2(v.z * sc, v.w * sc); *(u32x2*)(O + (size_t)row * NQKV + col) = w; } };
struct EpiF32 { float* O; int ldo;
  __device__ __forceinline__ void store(int row, int col, f32x4 v) const { *(f32x4*)(O + (size_t)row * ldo + col) = v; } };
struct EpiResid { const float* base; float* out;
  __device__ __forceinline__ void store(int row, int col, f32x4 v) const { const size_t o = (size_t)row * DM + col; const f32x4 b = *(const f32x4*)(base + o); *(f32x4*)(out + o) = b + v; } };
struct EpiKV { bf16_t* KX; bf16_t* VXT;
  __device__ __forceinline__ void store(int row, int col, f32x4 v) const {
    if (col < 1024) { u32x2 w; w.x = pk2(v.x, v.y); w.y = pk2(v.z, v.w); *(u32x2*)(KX + (size_t)row * DM + col) = w; }
    else { const int b = row >> 8, m = row & 255;
#pragma unroll
      for (int r = 0; r < 4; ++r) { const int d = col - 1024 + r; VXT[((size_t)(b * 4 + (d >> 8)) * 256 + (d & 255)) * 256 + m] = (bf16_t)f2bf(v[r]); } } } };

__device__ __forceinline__ void phase_scan(const Args& a, int gw, int ngw, int lane, int tid) {
  unsigned char* ws = a.ws;
  const float* flog = (const float*)(ws + WS_FLOG); float* cum = (float*)(ws + WS_CUM);
  for (int p = gw; p < 64; p += ngw) {
    const int b = p >> 3, j = p & 7;
    const float* src = flog + ((size_t)b * SEQ + lane * 64) * 8 + j;
    float tot = 0.f;
    for (int i = 0; i < 64; ++i) tot += src[i * 8];
    float inc = tot;
#pragma unroll
    for (int o = 1; o < 64; o <<= 1) { const float t = __shfl_up(inc, o); if (lane >= o) inc += t; }
    float run = inc - tot;
    float* dst = cum + ((size_t)(b * 8 + j)) * SEQ + lane * 64;
    for (int i = 0; i < 64; ++i) { run += src[i * 8]; dst[i] = run * 1.4426950408889634f; }
  }
  const bf16_t* qkv = (const bf16_t*)(ws + WS_QKV); float* kmean = (float*)(ws + WS_KMEAN);
  {
    unsigned* kn2 = (unsigned*)(ws + 256);
    for (int item = gw; item < 64 * 16; item += ngw) {
      const int bh = item >> 4, ch = item & 15, b = bh >> 3, h = bh & 7; float m = 0.f;
      for (int rr = 0; rr < 4; ++rr) {
        const u32x4* kp = (const u32x4*)(qkv + ((size_t)b * SEQ + ch * 256 + lane * 4 + rr) * NQKV + 2048 + h * 64); float s = 0.f;
#pragma unroll
        for (int c = 0; c < 8; ++c) { float f[8]; unpack8(kp[c], f);
#pragma unroll
          for (int i = 0; i < 8; ++i) s += f[i] * f[i]; }
        m = fmaxf(m, s);
      }
#pragma unroll
      for (int o = 1; o < 64; o <<= 1) m = fmaxf(m, __shfl_xor(m, o));
      if (lane == 0) atomicMax(kn2 + bh, __float_as_uint(m));
    }
  }
  const int gt = blockIdx.x * 512 + tid, ngt = gridDim.x * 512;
  for (int o = gt; o < NB * 16 * 512; o += ngt) {
    const int c = o & 511, blk = (o >> 9) & 15, b = o >> 13;
    const bf16_t* p = qkv + ((size_t)b * SEQ + blk * 256) * NQKV + 512 + c;
    float s = 0.f;
    for (int r = 0; r < 256; ++r) s += bf2f(p[(size_t)r * NQKV]);
    kmean[o] = s * (1.f / 256.f);
  }
}

template <int MODE>
__device__ __forceinline__ void attn_naive_unit(const Args& a, unsigned char* lds, int b, int h, int sb, int tid) {
  unsigned char* ws = a.ws;
  const bf16_t* qkv = (const bf16_t*)(ws + WS_QKV);
  const int qoff = MODE ? 1536 : 0, koff = qoff + 512, voff = qoff + 1024;
  float* Ks = (float*)lds; float* Vs = Ks + 64 * 64; float* ck = Vs + 64 * 64; float* biasd = ck + 64;
  const int t = sb * 512 + tid; const size_t row = (size_t)b * SEQ + t;
  float q[64], o[64];
  {
    const u32x4* qp = (const u32x4*)(qkv + row * NQKV + qoff + h * 64);
#pragma unroll
    for (int c = 0; c < 8; ++c) { const u32x4 w = qp[c]; unpack8(w, q + 8 * c); }
#pragma unroll
    for (int d = 0; d < 64; ++d) { q[d] *= 0.6931471805599453f; o[d] = 0.f; }
  }
  float m = -1e30f, l = 0.f;
  unsigned selmask = 0u; const int own = t >> 8;
  float cq = 0.f, bfar = 0.f;
  __syncthreads();
  if (MODE == 0) {
    if (tid < 128) biasd[tid] = a.in[5][T5_BUCKET[tid] * 8 + h];
    bfar = a.in[5][31 * 8 + h];
    const float* km = (const float*)(ws + WS_KMEAN) + ((size_t)b * 16) * 512 + h * 64;
    float v0 = -3e38f, v1 = -3e38f, v2 = -3e38f; int i0 = -1, i1 = -1, i2 = -1;
    for (int n = 0; n < 2 * sb + 1; ++n) {
      if (n < own) {
        const float* kp = km + (size_t)n * 512; float s = 0.f;
#pragma unroll
        for (int d = 0; d < 64; ++d) s += q[d] * kp[d];
        if (s > v0) { v2 = v1; i2 = i1; v1 = v0; i1 = i0; v0 = s; i0 = n; }
        else if (s > v1) { v2 = v1; i2 = i1; v1 = s; i1 = n; }
        else if (s > v2) { v2 = s; i2 = n; }
      }
    }
    if (i0 >= 0) selmask |= 1u << i0;
    if (i1 >= 0) selmask |= 1u << i1;
    if (i2 >= 0) selmask |= 1u << i2;
  } else {
    cq = ((const float*)(ws + WS_CUM))[((size_t)(b * 8 + h)) * SEQ + t];
  }
  const int ntile = 8 * (sb + 1);
  for (int kt = 0; kt < ntile; ++kt) {
    __syncthreads();
    {
      const int r = tid >> 3, ch = tid & 7;
      const bf16_t* kp = qkv + ((size_t)b * SEQ + kt * 64 + r) * NQKV + h * 64 + ch * 8;
      const u32x4 kw = *(const u32x4*)(kp + koff), vw = *(const u32x4*)(kp + voff);
      unpack8(kw, Ks + r * 64 + ch * 8); unpack8(vw, Vs + r * 64 + ch * 8);
      if (MODE == 1 && tid < 64) ck[tid] = ((const float*)(ws + WS_CUM))[((size_t)(b * 8 + h)) * SEQ + kt * 64 + tid];
    }
    __syncthreads();
    const int kb = kt >> 2;
    bool act;
    if (MODE == 0) act = (kb == own) || (kb < own && ((selmask >> kb) & 1u));
    else act = (kt * 64 <= t);
    if (act) {
      for (int jj = 0; jj < 64; ++jj) {
        const int sp = kt * 64 + jj;
        if (sp > t) break;
        const f32x4* kr = (const f32x4*)(Ks + jj * 64);
        float s = 0.f;
#pragma unroll
        for (int c = 0; c < 16; ++c) { const f32x4 kv = kr[c]; s += q[4 * c] * kv.x + q[4 * c + 1] * kv.y + q[4 * c + 2] * kv.z + q[4 * c + 3] * kv.w; }
        if (MODE == 0) { const int dist = t - sp; s += (dist < 128) ? biasd[dist] : bfar; }
        else s += (cq - ck[jj]) * 0.6931471805599453f;
        if (s > m) { const float f = __expf(m - s); l *= f;
#pragma unroll
          for (int d = 0; d < 64; ++d) o[d] *= f;
          m = s; }
        const float p = __expf(s - m); l += p;
        const f32x4* vr = (const f32x4*)(Vs + jj * 64);
#pragma unroll
        for (int c = 0; c < 16; ++c) { const f32x4 vv = vr[c]; o[4 * c] += p * vv.x; o[4 * c + 1] += p * vv.y; o[4 * c + 2] += p * vv.z; o[4 * c + 3] += p * vv.w; }
      }
    }
  }
  const float il = 1.f / l;
  u32x4* op = (u32x4*)((bf16_t*)(ws + WS_OAB) + row * DM + (MODE ? 512 : 0) + h * 64);
#pragma unroll
  for (int c = 0; c < 8; ++c) { u32x4 w; w.x = pk2(o[8 * c] * il, o[8 * c + 1] * il); w.y = pk2(o[8 * c + 2] * il, o[8 * c + 3] * il); w.z = pk2(o[8 * c + 4] * il, o[8 * c + 5] * il); w.w = pk2(o[8 * c + 6] * il, o[8 * c + 7] * il); op[c] = w; }
}

__device__ __forceinline__ void phase_attn(const Args& a, unsigned char* lds, int tid) {
  for (int u = blockIdx.x; u < 1024; u += gridDim.x) {
    const int sb = 7 - (u >> 7), r = u & 127, mode = r & 1, bh = r >> 1;
    if (mode == 0) attn_naive_unit<0>(a, lds, bh >> 3, bh & 7, sb, tid);
    else attn_naive_unit<1>(a, lds, bh >> 3, bh & 7, sb, tid);
  }
}

namespace att {
typedef float f32x16 __attribute__((ext_vector_type(16)));
typedef short s16x4 __attribute__((ext_vector_type(4)));
typedef short v4i16_t __attribute__((ext_vector_type(4)));
typedef __attribute__((address_space(3))) const char* lds_cptr;
typedef float f32x2_t __attribute__((ext_vector_type(2))); typedef __bf16 bf16x2_t __attribute__((ext_vector_type(2)));
constexpr int PITCH = NQKV;
constexpr float LOG2E = 1.4426950408889634f;
constexpr float C2 = 0.125f * LOG2E;
constexpr int L_K = 0, L_V = 16384, L_WSF = 32768, L_OST = 34816, L_C2 = 67584, L_KM = 83968, L_BT = 88064, L_MISC = 88704;
__device__ __forceinline__ int crow(int r, int hi) { return (r & 3) + 8 * (r >> 2) + 4 * hi; }
__device__ __forceinline__ unsigned cvtpk(float lo, float hi) { f32x2_t v = {lo, hi}; bf16x2_t b = __builtin_convertvector(v, bf16x2_t); return __builtin_bit_cast(unsigned, b); }
__device__ __forceinline__ s16x4 vtr(lds_cptr p) { return __builtin_bit_cast(s16x4, __builtin_amdgcn_ds_read_tr16_b64_v4i16((__attribute__((address_space(3))) v4i16_t*)p)); }
__device__ __forceinline__ float xhalf_max(float m) { auto rr = __builtin_amdgcn_permlane32_swap(__float_as_uint(m), __float_as_uint(m), false, false); return fmaxf(__uint_as_float(rr[0]), __uint_as_float(rr[1])); }
__device__ __forceinline__ float xhalf_sum(float m) { auto rr = __builtin_amdgcn_permlane32_swap(__float_as_uint(m), __float_as_uint(m), false, false); return __uint_as_float(rr[0]) + __uint_as_float(rr[1]); }

template <int MODE>
__device__ __forceinline__ void unit(const Args& a, unsigned char* lds, int b, int h, int qb, int tid) {
  unsigned char* ws = a.ws;
  const int lane = tid & 63, r32 = lane & 31, hi = lane >> 5; const int wid = __builtin_amdgcn_readfirstlane(tid >> 6);
  const bf16_t* qkv = (const bf16_t*)(ws + WS_QKV);
  const int qoff = MODE ? 1536 : 0;
  const size_t rowbase = (size_t)b * SEQ; const int q0 = qb * 256;
  const bf16_t* Qw = qkv + (rowbase + q0 + wid * 32) * PITCH + qoff + h * 64;
  const bf16_t* Kh = qkv + rowbase * PITCH + qoff + 512 + h * 64;
  const bf16_t* Vh = qkv + rowbase * PITCH + qoff + 1024 + h * 64;
  float* wsf = (float*)(lds + L_WSF) + wid * 64;
  float* c2s = (float*)(lds + L_C2); float* kms = (float*)(lds + L_KM); float* bts = (float*)(lds + L_BT); unsigned* misc = (unsigned*)(lds + L_MISC);
  const int NTL = 4 * (qb + 1);
  __syncthreads();
  if (MODE == 0) {
    const float* km = (const float*)(ws + WS_KMEAN) + (size_t)b * 16 * 512 + h * 64;
    for (int i = tid; i < 16 * 64; i += 512) kms[i] = km[(size_t)(i >> 6) * 512 + (i & 63)];
    if (tid < 128) bts[tid] = a.in[5][T5_BUCKET[tid] * 8 + h] * LOG2E;
    if (tid == 128) bts[128] = a.in[5][31 * 8 + h] * LOG2E;
  } else {
    const float* cg = (const float*)(ws + WS_CUM) + (size_t)(b * 8 + h) * SEQ;
    for (int i = tid; i < 256 * (qb + 1); i += 512) c2s[i] = cg[i];
    if (tid == 0) misc[0] = 0u;
  }
  bf16x8 qr[4];
#pragma unroll
  for (int d0 = 0; d0 < 4; ++d0) qr[d0] = *(const bf16x8*)(Qw + (size_t)r32 * PITCH + d0 * 16 + hi * 8);
  __syncthreads();
  unsigned selmask = 0u; float cq2 = 0.f, far2 = 0.f, mhat = -1e30f; int t0 = 0;
  if (MODE == 0) {
    far2 = bts[128];
    float v0 = -3e38f, v1 = -3e38f, v2 = -3e38f; int i0 = -1, i1 = -1, i2 = -1;
    for (int n = 0; n < qb; ++n) {
      float s = 0.f;
#pragma unroll
      for (int d0 = 0; d0 < 4; ++d0)
#pragma unroll
        for (int j = 0; j < 8; ++j) s += bf2f((unsigned short)qr[d0][j]) * kms[n * 64 + d0 * 16 + hi * 8 + j];
      s = xhalf_sum(s);
      if (s > v0) { v2 = v1; i2 = i1; v1 = v0; i1 = i0; v0 = s; i0 = n; }
      else if (s > v1) { v2 = v1; i2 = i1; v1 = s; i1 = n; }
      else if (s > v2) { v2 = s; i2 = n; }
    }
    if (i0 >= 0) selmask |= 1u << i0;
    if (i1 >= 0) selmask |= 1u << i1;
    if (i2 >= 0) selmask |= 1u << i2;
  } else {
    cq2 = c2s[q0 + wid * 32 + r32];
    float s = 0.f;
#pragma unroll
    for (int d0 = 0; d0 < 4; ++d0)
#pragma unroll
      for (int j = 0; j < 8; ++j) { const float f = bf2f((unsigned short)qr[d0][j]); s += f * f; }
    s = xhalf_sum(s);
    atomicMax(&misc[0], __float_as_uint(s));
    __syncthreads();
    const float kn2 = __uint_as_float(((const unsigned*)(ws + 256))[b * 8 + h]);
    const float qkb = sqrtf(__uint_as_float(misc[0]) * kn2) * 1.0001f + 1e-3f;
    mhat = -qkb;
    const int j = lane; bool skip = false;
    if (j < NTL) skip = (2.f * qkb + c2s[q0] - c2s[64 * j + 63]) < -150.f;
    t0 = __popcll(__ballot(skip));
    if (t0 > NTL - 1) t0 = NTL - 1;
  }
  const bf16_t* ksrc = Kh + (size_t)lane * PITCH + wid * 8;
  const bf16_t* vsrc = Vh + (size_t)(16 * (wid & 3) + (lane >> 2)) * PITCH + (wid >> 2) * 32 + (lane & 3) * 8;
  unsigned char* kdst = lds + L_K + wid * 1024 + lane * 16; unsigned char* vdst = lds + L_V + wid * 1024 + lane * 16;
  const lds_cptr lds3 = (lds_cptr)lds;
  const lds_cptr vp0 = lds3 + L_V + ((lane >> 4) & 1) * 32 + (lane & 3) * 8 + (4 * hi + ((lane & 15) >> 2)) * 64;
  u32x4 kreg = *(const u32x4*)(ksrc + (size_t)t0 * 64 * PITCH), vreg = *(const u32x4*)(vsrc + (size_t)t0 * 64 * PITCH);
  *(u32x4*)(kdst + (t0 & 1) * 8192) = kreg; *(u32x4*)(vdst + (t0 & 1) * 8192) = vreg;
  f32x16 o[2]; o[0] = f32x16{}; o[1] = f32x16{};
  float l = 0.f;
  const int qrel = wid * 32 + r32, qpos = q0 + qrel;
  __syncthreads();
  for (int t = t0; t < NTL; ++t) {
    const int buf = (t & 1) * 8192;
    if (t + 1 < NTL) { kreg = *(const u32x4*)(ksrc + (size_t)(t + 1) * 64 * PITCH); vreg = *(const u32x4*)(vsrc + (size_t)(t + 1) * 64 * PITCH); }
    const int jb = t - (NTL - 4);
    const bool compute = !(jb >= 0 && 64 * jb > wid * 32 + 31);
    if (compute) {
      f32x16 p0, p1;
      if (MODE == 0) {
        const int nb = t >> 2;
        const bool near = (jb >= 0) || (t >= NTL - 6 && wid < 4);
        if (near) {
#pragma unroll
          for (int r = 0; r < 16; ++r) { const int d = qpos - (64 * t + crow(r, hi));
            p0[r] = bts[min(max(d, 0), 128)]; p1[r] = bts[min(max(d - 32, 0), 128)]; }
        } else {
#pragma unroll
          for (int r = 0; r < 16; ++r) { p0[r] = far2; p1[r] = far2; }
        }
        if (jb < 0 && !((selmask >> nb) & 1u)) {
#pragma unroll
          for (int r = 0; r < 16; ++r) { p0[r] = -INFINITY; p1[r] = -INFINITY; }
        }
      } else {
#pragma unroll
        for (int g = 0; g < 4; ++g) {
          const f32x4 ca = *(const f32x4*)(c2s + 64 * t + 8 * g + 4 * hi), cb = *(const f32x4*)(c2s + 64 * t + 32 + 8 * g + 4 * hi);
#pragma unroll
          for (int i = 0; i < 4; ++i) { p0[4 * g + i] = cq2 - ca[i]; p1[4 * g + i] = cq2 - cb[i]; }
        }
      }
      {
        const lds_cptr kb = lds3 + L_K + buf + hi * 1024 + r32 * 16;
#pragma unroll
        for (int d0 = 0; d0 < 4; ++d0) {
          const bf16x8 b0 = *(const __attribute__((address_space(3))) bf16x8*)(kb + d0 * 2048);
          const bf16x8 b1 = *(const __attribute__((address_space(3))) bf16x8*)(kb + d0 * 2048 + 512);
          p0 = __builtin_amdgcn_mfma_f32_32x32x16_bf16(b0, qr[d0], p0, 0, 0, 0);
          p1 = __builtin_amdgcn_mfma_f32_32x32x16_bf16(b1, qr[d0], p1, 0, 0, 0);
        }
      }
      if (jb >= 0) {
        const int kb0 = 64 * jb + 4 * hi;
#pragma unroll
        for (int r = 0; r < 16; ++r) { const int kv = kb0 + (r & 3) + 8 * (r >> 2); if (kv > qrel) p0[r] = -INFINITY; if (kv + 32 > qrel) p1[r] = -INFINITY; }
      }
      float rm = fmaxf(p0[0], p1[0]);
#pragma unroll
      for (int r = 1; r < 16; ++r) rm = fmaxf(rm, fmaxf(p0[r], p1[r]));
      rm = xhalf_max(rm);
      const float mnew = fmaxf(mhat, rm);
      if (__any(mnew > mhat)) {
        const float alpha = __builtin_amdgcn_exp2f(mhat - mnew);
        l *= alpha; mhat = mnew;
        if (hi == 0) wsf[r32] = alpha;
        __builtin_amdgcn_wave_barrier();
#pragma unroll
        for (int r = 0; r < 16; ++r) { const float f = wsf[crow(r, hi)]; o[0][r] *= f; o[1][r] *= f; }
        __builtin_amdgcn_wave_barrier();
      }
      float sacc = 0.f;
#pragma unroll
      for (int r = 0; r < 16; ++r) { p0[r] = __builtin_amdgcn_exp2f(p0[r] - mhat); p1[r] = __builtin_amdgcn_exp2f(p1[r] - mhat); sacc += p0[r] + p1[r]; }
      l += sacc;
      u32x4 pw0, pw1, pw2, pw3;
      pw0 = (u32x4){cvtpk(p0[0], p0[1]), cvtpk(p0[2], p0[3]), cvtpk(p0[4], p0[5]), cvtpk(p0[6], p0[7])};
      pw1 = (u32x4){cvtpk(p0[8], p0[9]), cvtpk(p0[10], p0[11]), cvtpk(p0[12], p0[13]), cvtpk(p0[14], p0[15])};
      pw2 = (u32x4){cvtpk(p1[0], p1[1]), cvtpk(p1[2], p1[3]), cvtpk(p1[4], p1[5]), cvtpk(p1[6], p1[7])};
      pw3 = (u32x4){cvtpk(p1[8], p1[9]), cvtpk(p1[10], p1[11]), cvtpk(p1[12], p1[13]), cvtpk(p1[14], p1[15])};
      const lds_cptr vp = vp0 + buf;
#pragma unroll
      for (int d0 = 0; d0 < 2; ++d0) {
#define ATT_VF(ks) ({ const s16x4 lo_ = vtr(vp + d0 * 4096 + (ks) * 1024), hi_ = vtr(vp + d0 * 4096 + (ks) * 1024 + 512); (bf16x8){lo_[0], lo_[1], lo_[2], lo_[3], hi_[0], hi_[1], hi_[2], hi_[3]}; })
        o[d0] = __builtin_amdgcn_mfma_f32_32x32x16_bf16(__builtin_bit_cast(bf16x8, pw0), ATT_VF(0), o[d0], 0, 0, 0);
        o[d0] = __builtin_amdgcn_mfma_f32_32x32x16_bf16(__builtin_bit_cast(bf16x8, pw1), ATT_VF(1), o[d0], 0, 0, 0);
        o[d0] = __builtin_amdgcn_mfma_f32_32x32x16_bf16(__builtin_bit_cast(bf16x8, pw2), ATT_VF(2), o[d0], 0, 0, 0);
        o[d0] = __builtin_amdgcn_mfma_f32_32x32x16_bf16(__builtin_bit_cast(bf16x8, pw3), ATT_VF(3), o[d0], 0, 0, 0);
#undef ATT_VF
      }
    }
    if (t + 1 < NTL) { *(u32x4*)(kdst + ((t + 1) & 1) * 8192) = kreg; *(u32x4*)(vdst + ((t + 1) & 1) * 8192) = vreg; }
    __syncthreads();
  }
  l = xhalf_sum(l);
  if (hi == 0) wsf[32 + r32] = l;
  __builtin_amdgcn_wave_barrier();
  bf16_t* stg = (bf16_t*)(lds + L_OST) + wid * 2048;
#pragma unroll
  for (int r = 0; r < 16; ++r) { const int orow = crow(r, hi); const float rl = 1.f / wsf[32 + orow];
    stg[orow * 64 + r32] = (bf16_t)f2bf(o[0][r] * rl); stg[orow * 64 + 32 + r32] = (bf16_t)f2bf(o[1][r] * rl); }
  __builtin_amdgcn_wave_barrier();
  bf16_t* Ow = (bf16_t*)(ws + WS_OAB) + (rowbase + q0 + wid * 32) * DM + (MODE ? 512 : 0) + h * 64;
#pragma unroll
  for (int i = 0; i < 4; ++i) { const int row = i * 8 + (lane >> 3), ch = lane & 7; const u32x4 v = *(const u32x4*)(stg + row * 64 + ch * 8); *(u32x4*)(Ow + (size_t)row * DM + ch * 8) = v; }
}
}

__device__ __forceinline__ void phase_attn2(const Args& a, unsigned char* lds, int tid) {
  unsigned* ctr = (unsigned*)(a.ws + 0);
  unsigned* slot = (unsigned*)(lds + att::L_MISC + 64);
  for (;;) {
    __syncthreads();
    if (tid == 0) slot[0] = atomicAdd(ctr, 1u);
    __syncthreads();
    const unsigned u = slot[0];
    if (u >= 2048u) break;
    const int qb = 15 - (int)(u >> 7), r = u & 127, mode = r & 1, bh = r >> 1;
    if (mode == 0) att::unit<0>(a, lds, bh >> 3, bh & 7, qb, tid);
    else att::unit<1>(a, lds, bh >> 3, bh & 7, qb, tid);
  }
}

__device__ __forceinline__ void phase_onorm(const Args& a, int gw, int ngw, int lane) {
  bf16_t* oab = (bf16_t*)(a.ws + WS_OAB);
  for (int r = gw; r < NT; r += ngw) {
    u32x4* p = (u32x4*)(oab + (size_t)r * DM) + 2 * lane;
    const u32x4 w0 = p[0], w1 = p[1]; float f[16]; unpack8(w0, f); unpack8(w1, f + 8);
    float s = 0.f;
#pragma unroll
    for (int i = 0; i < 16; ++i) s += f[i] * f[i];
#pragma unroll
    for (int o = 1; o < 32; o <<= 1) s += __shfl_xor(s, o);
    const float rstd = rsqrtf(s * (1.f / 512.f) + EPS);
    u32x4 o0, o1;
    o0.x = pk2(f[0] * rstd, f[1] * rstd); o0.y = pk2(f[2] * rstd, f[3] * rstd); o0.z = pk2(f[4] * rstd, f[5] * rstd); o0.w = pk2(f[6] * rstd, f[7] * rstd);
    o1.x = pk2(f[8] * rstd, f[9] * rstd); o1.y = pk2(f[10] * rstd, f[11] * rstd); o1.z = pk2(f[12] * rstd, f[13] * rstd); o1.w = pk2(f[14] * rstd, f[15] * rstd);
    p[0] = o0; p[1] = o1;
  }
}

__device__ __forceinline__ void phase_rms(const Args& a, int gw, int ngw, int lane) {
  for (int r = gw; r < NT; r += ngw) rms_row_to_bf16(a.out + (size_t)r * DM, (bf16_t*)(a.ws + WS_HB) + (size_t)r * DM, lane);
}

__device__ __forceinline__ void phase_xattn(const Args& a, unsigned char* lds, int gw, int ngw, int wave, int lane) {
  unsigned char* ws = a.ws;
  const bf16_t* qx = (const bf16_t*)(ws + WS_QX); const bf16_t* kx = (const bf16_t*)(ws + WS_KX); const bf16_t* vxt = (const bf16_t*)(ws + WS_VXT);
  bf16_t* ox = (bf16_t*)(ws + WS_OX);
  bf16_t* P = (bf16_t*)(lds + wave * 8192);
  const int fr = lane & 15, fq = lane >> 4;
  for (int u = gw; u < (NT / 16) * 4; u += ngw) {
    const int hd = u & 3, r0 = (u >> 2) * 16, b = r0 / SEQ;
    f32x4 acc[16];
#pragma unroll
    for (int i = 0; i < 16; ++i) acc[i] = (f32x4){0.f, 0.f, 0.f, 0.f};
    const bf16_t* Ap = qx + (size_t)(r0 + fr) * DM + hd * 256 + fq * 8;
    const bf16_t* Bp = kx + (size_t)(b * 256 + fr) * DM + hd * 256 + fq * 8;
    for (int ks = 0; ks < 8; ++ks) {
      const bf16x8 af = *(const bf16x8*)(Ap + ks * 32);
#pragma unroll
      for (int ct = 0; ct < 16; ++ct) { const bf16x8 bfr = *(const bf16x8*)(Bp + (size_t)ct * 16 * DM + ks * 32); acc[ct] = __builtin_amdgcn_mfma_f32_16x16x32_bf16(af, bfr, acc[ct], 0, 0, 0); }
    }
    float mx[4], sm[4];
#pragma unroll
    for (int r = 0; r < 4; ++r) { float m = acc[0][r];
#pragma unroll
      for (int ct = 1; ct < 16; ++ct) m = fmaxf(m, acc[ct][r]);
#pragma unroll
      for (int o = 1; o < 16; o <<= 1) m = fmaxf(m, __shfl_xor(m, o));
      mx[r] = m; sm[r] = 0.f; }
#pragma unroll
    for (int ct = 0; ct < 16; ++ct)
#pragma unroll
      for (int r = 0; r < 4; ++r) { const float p = __expf((acc[ct][r] - mx[r]) * 0.0625f); acc[ct][r] = p; sm[r] += p; }
#pragma unroll
    for (int r = 0; r < 4; ++r) {
#pragma unroll
      for (int o = 1; o < 16; o <<= 1) sm[r] += __shfl_xor(sm[r], o);
      sm[r] = 1.f / sm[r]; }
    __builtin_amdgcn_wave_barrier();
#pragma unroll
    for (int ct = 0; ct < 16; ++ct)
#pragma unroll
      for (int r = 0; r < 4; ++r) P[(4 * fq + r) * 256 + ct * 16 + fr] = (bf16_t)f2bf(acc[ct][r] * sm[r]);
    __builtin_amdgcn_wave_barrier();
    asm volatile("s_waitcnt lgkmcnt(0)" ::: "memory");
#pragma unroll
    for (int i = 0; i < 16; ++i) acc[i] = (f32x4){0.f, 0.f, 0.f, 0.f};
    const bf16_t* Vp = vxt + ((size_t)(b * 4 + hd) * 256 + fr) * 256 + fq * 8;
    for (int ks = 0; ks < 8; ++ks) {
      const bf16x8 pf = *(const bf16x8*)(P + fr * 256 + ks * 32 + fq * 8);
#pragma unroll
      for (int dt = 0; dt < 16; ++dt) { const bf16x8 vf = *(const bf16x8*)(Vp + (size_t)dt * 16 * 256 + ks * 32); acc[dt] = __builtin_amdgcn_mfma_f32_16x16x32_bf16(pf, vf, acc[dt], 0, 0, 0); }
    }
#pragma unroll
    for (int dt = 0; dt < 16; ++dt)
#pragma unroll
      for (int r = 0; r < 4; ++r) ox[(size_t)(r0 + 4 * fq + r) * DM + hd * 256 + dt * 16 + fr] = (bf16_t)f2bf(acc[dt][r]);
    __builtin_amdgcn_wave_barrier();
  }
}

__device__ __forceinline__ unsigned fkey(float s, unsigned idx, unsigned mask) { unsigned u = __float_as_uint(s); u ^= (unsigned)((int)u >> 31) | 0x80000000u; return (u & ~mask) | (mask - idx); }
__device__ __forceinline__ float keyval(unsigned k, unsigned mask) { unsigned u = k & ~mask; u = (u & 0x80000000u) ? (u ^ 0x80000000u) : ~u; return __uint_as_float(u); }
#define KEY_INSERT(KA, key_) do { unsigned k__ = (key_); \
  _Pragma("unroll") for (int s_ = 0; s_ < 16; ++s_) { const unsigned hi_ = max(k__, KA[s_]); k__ = min(k__, KA[s_]); KA[s_] = hi_; } } while (0)

__device__ __forceinline__ void phase_topk(const Args& a, unsigned char* lds, int tid) {
  unsigned char* ws = a.ws;
  const float* pq = (const float*)(ws + WS_PQ);
  int* eidx = (int*)(ws + WS_EIDX); float* gate = (float*)(ws + WS_GATE);
  float* K1 = (float*)lds; float* K2 = K1 + 128 * 64; unsigned* KL = (unsigned*)(lds + 65536);
  for (int u = blockIdx.x; u < 8 * (NT / 512); u += gridDim.x) {
    const int h = u & 7, t = (u >> 3) * 512 + tid;
    __syncthreads();
    for (int i = tid; i < 128 * 64 / 4; i += 512) { ((f32x4*)K1)[i] = ((const f32x4*)(a.in[17] + (size_t)h * 8192))[i]; ((f32x4*)K2)[i] = ((const f32x4*)(a.in[18] + (size_t)h * 8192))[i]; }
    __syncthreads();
    unsigned ka[16], kb[16], kc[16];
#pragma unroll
    for (int k = 0; k < 16; ++k) { ka[k] = 0u; kb[k] = 0u; kc[k] = 0u; }
    float q[64];
    const f32x4* qp = (const f32x4*)(pq + (size_t)t * DM + h * 128);
#pragma unroll
    for (int c = 0; c < 16; ++c) { const f32x4 w = qp[c]; q[4 * c] = w.x; q[4 * c + 1] = w.y; q[4 * c + 2] = w.z; q[4 * c + 3] = w.w; }
    for (int n = 0; n < 128; ++n) {
      const f32x4* kr = (const f32x4*)(K1 + n * 64); float s = 0.f;
#pragma unroll
      for (int c = 0; c < 16; ++c) { const f32x4 kv = kr[c]; s += q[4 * c] * kv.x + q[4 * c + 1] * kv.y + q[4 * c + 2] * kv.z + q[4 * c + 3] * kv.w; }
      KEY_INSERT(ka, fkey(s, (unsigned)n, 127u));
    }
#pragma unroll
    for (int c = 0; c < 16; ++c) { const f32x4 w = qp[16 + c]; q[4 * c] = w.x; q[4 * c + 1] = w.y; q[4 * c + 2] = w.z; q[4 * c + 3] = w.w; }
    for (int n = 0; n < 128; ++n) {
      const f32x4* kr = (const f32x4*)(K2 + n * 64); float s = 0.f;
#pragma unroll
      for (int c = 0; c < 16; ++c) { const f32x4 kv = kr[c]; s += q[4 * c] * kv.x + q[4 * c + 1] * kv.y + q[4 * c + 2] * kv.z + q[4 * c + 3] * kv.w; }
      KEY_INSERT(kb, fkey(s, (unsigned)n, 127u));
    }
#pragma unroll
    for (int x = 0; x < 16; ++x)
#pragma unroll
      for (int y = 0; y < 16; ++y)
        if ((x + 1) * (y + 1) <= 16) { KEY_INSERT(kc, fkey(keyval(ka[x], 127u) + keyval(kb[y], 127u), (unsigned)(x * 16 + y), 255u)); }
#pragma unroll
    for (int k = 0; k < 16; ++k) { KL[k * 512 + tid] = ka[k]; KL[(16 + k) * 512 + tid] = kb[k]; }
    float val[16]; int id[16]; float sum = 0.f;
#pragma unroll
    for (int k = 0; k < 16; ++k) {
      const unsigned flat = 255u - (kc[k] & 255u);
      const unsigned k1 = KL[(flat >> 4) * 512 + tid], k2 = KL[(16 + (flat & 15u)) * 512 + tid];
      val[k] = keyval(k1, 127u) + keyval(k2, 127u);
      id[k] = (int)((127u - (k1 & 127u)) * 128u + (127u - (k2 & 127u)));
    }
    const float vmax = val[0];
#pragma unroll
    for (int k = 0; k < 16; ++k) { val[k] = __expf(val[k] - vmax); sum += val[k]; }
    const float inv = 1.f / sum;
    int* ep = eidx + (size_t)t * 128 + h * 16; float* gp = gate + (size_t)t * 128 + h * 16;
#pragma unroll
    for (int k = 0; k < 16; ++k) { ep[k] = id[k]; gp[k] = val[k] * inv; }
  }
}

__device__ __forceinline__ float gelu_erf(float v) { return 0.5f * v * (1.f + erff(v * 0.70710678118654752f)); }

__device__ __forceinline__ void phase_experts(const Args& a, int gw, int ngw, int lane) {
  unsigned char* ws = a.ws;
  const int* eidx = (const int*)(ws + WS_EIDX); const float* gate = (const float*)(ws + WS_GATE);
  const bf16_t* exd = (const bf16_t*)(ws + WS_EXD); const bf16_t* exu = (const bf16_t*)(ws + WS_EXU);
  for (int t = gw; t < NT; t += ngw) {
    f32x4* xr = (f32x4*)(a.out + (size_t)t * DM) + lane;
    f32x4 x[4], hg[4], acc[4]; float s = 0.f;
#pragma unroll
    for (int j = 0; j < 4; ++j) { x[j] = xr[64 * j]; s += (x[j].x * x[j].x + x[j].y * x[j].y) + (x[j].z * x[j].z + x[j].w * x[j].w); acc[j] = (f32x4){0.f, 0.f, 0.f, 0.f}; }
    const float rstd = rsqrtf(wave_sum(s) * (1.f / DM) + EPS);
#pragma unroll
    for (int j = 0; j < 4; ++j) { const f32x4 g = ((const f32x4*)a.in[15])[64 * j + lane]; hg[j] = x[j] * rstd * g; }
    const int e0 = eidx[(size_t)t * 128 + lane], e1 = eidx[(size_t)t * 128 + 64 + lane];
    const float g0 = gate[(size_t)t * 128 + lane], g1 = gate[(size_t)t * 128 + 64 + lane];
    for (int e = 0; e < 128; e += 4) {
      float dot[4]; int id[4];
#pragma unroll
      for (int i = 0; i < 4; ++i) {
        const int ee = e + i;
        id[i] = (ee < 64) ? __shfl(e0, ee) : __shfl(e1, ee - 64);
        const u32x2* up = (const u32x2*)(exd + (size_t)id[i] * DM) + lane;
        float d = 0.f;
#pragma unroll
        for (int j = 0; j < 4; ++j) { const u32x2 w = up[64 * j]; d += hg[j].x * bflo(w.x) + hg[j].y * bfhi(w.x) + hg[j].z * bflo(w.y) + hg[j].w * bfhi(w.y); }
        dot[i] = d;
      }
#pragma unroll
      for (int i = 0; i < 4; ++i) {
        const int ee = e + i;
        const float gg = (ee < 64) ? __shfl(g0, ee) : __shfl(g1, ee - 64);
        const float w = gg * gelu_erf(wave_sum(dot[i]));
        const u32x2* vp = (const u32x2*)(exu + (size_t)id[i] * DM) + lane;
#pragma unroll
        for (int j = 0; j < 4; ++j) { const u32x2 q = vp[64 * j]; acc[j].x += w * bflo(q.x); acc[j].y += w * bfhi(q.x); acc[j].z += w * bflo(q.y); acc[j].w += w * bfhi(q.y); }
      }
    }
    float s2 = 0.f;
#pragma unroll
    for (int j = 0; j < 4; ++j) { x[j] = x[j] + acc[j]; s2 += (x[j].x * x[j].x + x[j].y * x[j].y) + (x[j].z * x[j].z + x[j].w * x[j].w); }
    const float r2 = rsqrtf(wave_sum(s2) * (1.f / DM) + EPS);
#pragma unroll
    for (int j = 0; j < 4; ++j) { const f32x4 g = ((const f32x4*)a.in[21])[64 * j + lane]; xr[64 * j] = x[j] * r2 * g; }
  }
}

namespace pg8 {
#define PG8_LAS __attribute__((address_space(3)))
typedef unsigned short bf16_t;
typedef short bf16x8 __attribute__((ext_vector_type(8)));
typedef float f32x4 __attribute__((ext_vector_type(4)));
typedef unsigned u32x4 __attribute__((ext_vector_type(4)));
constexpr int BM = 256, BK = 64, HALF = 128, HTB = HALF * BK * 2  , STAGE_BYTES = 8 * HTB, NXCD = 8, WGM = 8;

__host__ __device__ __forceinline__ int lds_byte(int r, int c) { const int st = (r >> 4) * 2 + (c >> 5), rr = r & 15, cc = c & 31, ob = rr * 64 + cc * 2; return st * 1024 + (ob ^ (((ob >> 9) & 1) << 5)); }
__host__ __device__ __forceinline__ void stage_rc(int b, int& R, int& C) { const int st = b / 1024, sb = b % 1024, swz = sb ^ (((sb >> 9) & 1) << 5); R = (st >> 1) * 16 + swz / 64; C = (st & 1) * 32 + (swz % 64) / 2; }
__host__ __device__ __forceinline__ int perm32(int rho) { const int n = rho >> 4, i = rho & 15; return 8 * (i >> 2) + 4 * n + (i & 3); }

struct Unit { int pm, pn; };
struct Gemm { const bf16_t* A; const bf16_t* Bt; int M, N, K; };

struct StaticOrder {
    int nM, nN, nwg, G, c;
    __host__ __device__ void init(int M, int N, int G_, int c_) { nM = M / BM; nN = N / BM; nwg = nM * nN; G = G_; c = c_; }
    __host__ __device__ bool next(int i, Unit& u) const {
        const long L = (long)i * G + c; if (L >= nwg) return false;
        int wgid = (int)L; { const int q = nwg / NXCD, r = nwg % NXCD, xcd = wgid % NXCD, off = wgid / NXCD; wgid = (xcd < r ? xcd * (q + 1) : r * (q + 1) + (xcd - r) * q) + off; }
        const int nig = WGM * nN, gid = wgid / nig, fm = gid * WGM, gsz = (nM - fm) < WGM ? (nM - fm) : WGM;
        u.pm = fm + ((wgid % nig) % gsz); u.pn = (wgid % nig) / gsz; return true;
    }
    __device__ __forceinline__ void a_ready(const Unit&) const {}
    __device__ __forceinline__ void done(const Unit&) const {}
};

template <class St> struct EpiAdapt {
    static constexpr bool PERM = false, AFTER_DRAIN = false; St st;
    __device__ __forceinline__ void operator()(const f32x4 (&acc)[2][2][4][2], const Unit& u, int wr, int wc, int fr, int fq) const {
#pragma unroll
        for (int ai = 0; ai < 2; ++ai)
#pragma unroll
            for (int m = 0; m < 4; ++m)
#pragma unroll
                for (int bj = 0; bj < 2; ++bj)
#pragma unroll
                    for (int n = 0; n < 2; ++n) st.store(u.pm * BM + ai * HALF + wr * 64 + m * 16 + fr, u.pn * BM + bj * HALF + wc * 32 + n * 16 + 4 * fq, acc[ai][bj][m][n]);
    }
};

template <class Epi, class Sched, bool ALIGN_EPI = false, bool SP2 = false>
__device__ __forceinline__ void gemm_phase(PG8_LAS unsigned char* lds, const Gemm g, const Sched& S, const Epi& E) {
    const int tid = threadIdx.x, wid = __builtin_amdgcn_readfirstlane(tid >> 6), lane = tid & 63, wr = wid >> 2, wc = wid & 3, fr = lane & 15, fq = lane >> 4;
    const int K = g.K, nt = K / BK;
    unsigned voffA[2], voffB[2];
#pragma unroll
    for (int i = 0; i < 2; ++i) { int R, C; stage_rc(tid * 16 + i * 8192, R, C); const int Rb = Epi::PERM ? ((R & ~31) + perm32(R & 31)) : R;
        voffA[i] = (unsigned)(R * K + C) * 2u; voffB[i] = (unsigned)(Rb * K + C) * 2u; }
    const size_t kstep = (size_t)(BK * 2);
    const size_t hstep = (size_t)HALF * K * 2;
    const size_t tstep = 2 * hstep;
    const unsigned ldsw = (unsigned)wid * 1024u;
    const int aoff = lds_byte(wr * 64 + fr, fq * 8), boff = lds_byte(wc * 32 + fr, fq * 8);
#define PG8_SA(b, h) (((b) * 2 + (h)) * HTB)
#define PG8_SB(b, h) ((4 + (b) * 2 + (h)) * HTB)
#define PG8_STAGE(bufoff, gbase, voff) do { _Pragma("unroll") for (int _i = 0; _i < 2; ++_i) \
        __builtin_amdgcn_global_load_lds((const unsigned*)((const char*)(gbase) + (voff)[_i]), (PG8_LAS unsigned*)(lds + (bufoff) + ldsw + _i * 8192), 16, 0, 0); } while (0)
#define PG8_LDA(dst, b, h) do { _Pragma("unroll") for (int m = 0; m < 4; ++m) _Pragma("unroll") for (int k = 0; k < 2; ++k) dst[m][k] = *(const PG8_LAS bf16x8*)(lds + PG8_SA(b, h) + aoff + m * 2048 + k * 1024); } while (0)
#define PG8_LDB(dst, b, h) do { _Pragma("unroll") for (int n = 0; n < 2; ++n) _Pragma("unroll") for (int k = 0; k < 2; ++k) dst[n][k] = *(const PG8_LAS bf16x8*)(lds + PG8_SB(b, h) + boff + n * 2048 + k * 1024); } while (0)
#define PG8_MMA(ai, bj, At, Bt) do { __builtin_amdgcn_s_setprio(1); _Pragma("unroll") for (int m = 0; m < 4; ++m) _Pragma("unroll") for (int n = 0; n < 2; ++n) _Pragma("unroll") for (int k = 0; k < 2; ++k) \
        acc[ai][bj][m][n] = __builtin_amdgcn_mfma_f32_16x16x32_bf16(Bt[n][k], At[m][k], acc[ai][bj][m][n], 0, 0, 0); __builtin_amdgcn_s_setprio(0); } while (0)
#define PG8_WAIT_V(n) asm volatile("s_waitcnt vmcnt(" #n ")" ::: "memory")
#define PG8_WAIT_L(n) asm volatile("s_waitcnt lgkmcnt(" #n ")" ::: "memory")
#define PG8_BAR __builtin_amdgcn_s_barrier()
#define PG8_SCHED __builtin_amdgcn_sched_barrier(0)
    Unit cur, nxt; int ui = 0;
    if (!S.next(0, cur)) return;
    f32x4 acc[2][2][4][2];
#pragma unroll
    for (int a = 0; a < 2; ++a)
#pragma unroll
        for (int b = 0; b < 2; ++b)
#pragma unroll
            for (int m = 0; m < 4; ++m)
#pragma unroll
                for (int n = 0; n < 2; ++n) acc[a][b][m][n] = (f32x4){0.f, 0.f, 0.f, 0.f};
    bf16x8 At[4][2], B0[2][2], B1[2][2];
    const char* cA = (const char*)g.A + (size_t)cur.pm * tstep; const char* cB = (const char*)g.Bt + (size_t)cur.pn * tstep;
    S.a_ready(cur);
    if constexpr (SP2) {
        PG8_STAGE(PG8_SB(0, 0), cB, voffB); PG8_STAGE(PG8_SB(0, 1), cB + hstep, voffB); PG8_STAGE(PG8_SA(0, 0), cA, voffA); PG8_STAGE(PG8_SA(0, 1), cA + hstep, voffA);
        if (wr == 1) PG8_BAR;
        PG8_WAIT_V(2); PG8_BAR;
        PG8_STAGE(PG8_SB(1, 0), cB + kstep, voffB); PG8_STAGE(PG8_SA(1, 0), cA + kstep, voffA); PG8_STAGE(PG8_SB(1, 1), cB + hstep + kstep, voffB);
        PG8_WAIT_V(6); PG8_BAR;
    } else {
        PG8_STAGE(PG8_SB(0, 0), cB, voffB); PG8_STAGE(PG8_SA(0, 0), cA, voffA); PG8_STAGE(PG8_SB(0, 1), cB + hstep, voffB); PG8_STAGE(PG8_SA(0, 1), cA + hstep, voffA);
        if (wr == 1) PG8_BAR;
        PG8_WAIT_V(4); PG8_BAR;
        PG8_STAGE(PG8_SB(1, 0), cB + kstep, voffB); PG8_STAGE(PG8_SA(1, 0), cA + kstep, voffA); PG8_STAGE(PG8_SB(1, 1), cB + hstep + kstep, voffB);
        PG8_WAIT_V(6); PG8_BAR;
    }
    for (;;) {
        const bool has_next = S.next(ui + 1, nxt);
        const char* nA = has_next ? (const char*)g.A + (size_t)nxt.pm * tstep : cA; const char* nB = has_next ? (const char*)g.Bt + (size_t)nxt.pn * tstep : cB;
        for (int t = 0; t < nt; t += 2) {
            const bool last = (t == nt - 2);
            const char* a1 = cA + (size_t)(t + 1) * kstep;
            const char* a2 = last ? nA : cA + (size_t)(t + 2) * kstep; const char* b2 = last ? nB : cB + (size_t)(t + 2) * kstep;
            const char* a3 = a2 + kstep; const char* b3 = b2 + kstep;
            if (last && has_next) S.a_ready(nxt);
            if constexpr (SP2) {
            PG8_LDB(B0, 0, 0); PG8_LDB(B1, 0, 1); PG8_SCHED; PG8_LDA(At, 0, 0); PG8_STAGE(PG8_SA(1, 1), a1 + hstep, voffA);
            PG8_WAIT_V(8); PG8_WAIT_L(0); PG8_BAR; PG8_MMA(0, 0, At, B0); PG8_MMA(0, 1, At, B1); PG8_BAR; PG8_SCHED;
            PG8_LDA(At, 0, 1); PG8_STAGE(PG8_SB(0, 0), b2, voffB); PG8_STAGE(PG8_SB(0, 1), b2 + hstep, voffB); PG8_STAGE(PG8_SA(0, 0), a2, voffA);
            PG8_WAIT_V(8); PG8_WAIT_L(0); PG8_BAR; PG8_MMA(1, 0, At, B0); PG8_MMA(1, 1, At, B1); PG8_BAR; PG8_SCHED;
            PG8_LDB(B0, 1, 0); PG8_LDB(B1, 1, 1); PG8_SCHED; PG8_LDA(At, 1, 0); PG8_STAGE(PG8_SA(0, 1), a2 + hstep, voffA);
            PG8_WAIT_V(8); PG8_WAIT_L(0); PG8_BAR; PG8_MMA(0, 0, At, B0); PG8_MMA(0, 1, At, B1); PG8_BAR; PG8_SCHED;
            PG8_LDA(At, 1, 1); PG8_STAGE(PG8_SB(1, 0), b3, voffB); PG8_STAGE(PG8_SB(1, 1), b3 + hstep, voffB); PG8_STAGE(PG8_SA(1, 0), a3, voffA);
            PG8_WAIT_V(8); PG8_WAIT_L(0); PG8_BAR; PG8_MMA(1, 0, At, B0); PG8_MMA(1, 1, At, B1); PG8_BAR; PG8_SCHED;
            } else {
            PG8_LDB(B0, 0, 0); PG8_SCHED; PG8_LDA(At, 0, 0); PG8_STAGE(PG8_SA(1, 1), a1 + hstep, voffA);
            PG8_WAIT_L(8); PG8_BAR; PG8_WAIT_L(0); PG8_MMA(0, 0, At, B0); PG8_BAR; PG8_SCHED;
            PG8_LDB(B1, 0, 1); PG8_STAGE(PG8_SB(0, 0), b2, voffB);
            PG8_BAR; PG8_WAIT_L(0); PG8_MMA(0, 1, At, B1); PG8_BAR;
            PG8_LDA(At, 0, 1); PG8_STAGE(PG8_SA(0, 0), a2, voffA);
            PG8_BAR; PG8_WAIT_L(0); PG8_MMA(1, 0, At, B0); PG8_BAR; PG8_SCHED;
            PG8_STAGE(PG8_SB(0, 1), b2 + hstep, voffB);
            PG8_WAIT_V(6); PG8_BAR; PG8_MMA(1, 1, At, B1); PG8_BAR;
            PG8_LDB(B0, 1, 0); PG8_SCHED; PG8_LDA(At, 1, 0); PG8_STAGE(PG8_SA(0, 1), a2 + hstep, voffA);
            PG8_WAIT_L(8); PG8_BAR; PG8_WAIT_L(0); PG8_MMA(0, 0, At, B0); PG8_BAR; PG8_SCHED;
            PG8_LDB(B1, 1, 1); PG8_STAGE(PG8_SB(1, 0), b3, voffB);
            PG8_BAR; PG8_WAIT_L(0); PG8_MMA(0, 1, At, B1); PG8_BAR;
            PG8_LDA(At, 1, 1); PG8_STAGE(PG8_SA(1, 0), a3, voffA);
            PG8_BAR; PG8_WAIT_L(0); PG8_MMA(1, 0, At, B0); PG8_BAR; PG8_SCHED;
            PG8_STAGE(PG8_SB(1, 1), b3 + hstep, voffB);
            PG8_WAIT_V(6); PG8_BAR; PG8_MMA(1, 1, At, B1); PG8_BAR;
            }
        }
        if constexpr (ALIGN_EPI) { if (wr == 0) PG8_BAR; }
        if constexpr (!Epi::AFTER_DRAIN) { E(acc, cur, wr, wc, fr, fq); S.done(cur); }
        if (!has_next) break;
#pragma unroll
        for (int a = 0; a < 2; ++a)
#pragma unroll
            for (int b = 0; b < 2; ++b)
#pragma unroll
                for (int m = 0; m < 4; ++m)
#pragma unroll
                    for (int n = 0; n < 2; ++n) acc[a][b][m][n] = (f32x4){0.f, 0.f, 0.f, 0.f};
        cur = nxt; cA = nA; cB = nB; ++ui;
        if constexpr (ALIGN_EPI) { if (wr == 1) PG8_BAR; }
    }
    PG8_WAIT_V(0);
    if constexpr (!ALIGN_EPI) { if (wr == 0) PG8_BAR; }
    PG8_BAR;
    if constexpr (Epi::AFTER_DRAIN) { E.fused(acc, cur, wr, wc, fr, fq, lds, wid, lane); S.done(cur); }
#undef PG8_SA
#undef PG8_SB
#undef PG8_STAGE
#undef PG8_LDA
#undef PG8_LDB
#undef PG8_MMA
#undef PG8_WAIT_V
#undef PG8_WAIT_L
#undef PG8_BAR
#undef PG8_SCHED
}
}


template <class St>
__device__ __forceinline__ void run_gemm(unsigned char* lds, const bf16_t* A, const bf16_t* Bt, int M, int N, int K, const St& st, int gw, int ngw, int lane) {
#if USE_PG8
  pg8::Gemm g{A, Bt, M, N, K}; pg8::StaticOrder S; S.init(M, N, (int)gridDim.x, (int)blockIdx.x);
  pg8::EpiAdapt<St> E{st};
  pg8::gemm_phase<pg8::EpiAdapt<St>, pg8::StaticOrder, true, true>((PG8_LAS unsigned char*)lds, g, S, E);
#else
  gemm_naive(A, K, Bt, K, M, N, K, st, gw, ngw, lane);
#endif
}

__global__ void __launch_bounds__(512, 2) mega(Args a) {
  extern __shared__ __attribute__((aligned(16))) unsigned char lds[];
  cg::grid_group grid = cg::this_grid();
  const int tid = threadIdx.x, lane = tid & 63, wave = tid >> 6;
  const int gw = blockIdx.x * 8 + wave, ngw = gridDim.x * 8;
  unsigned char* ws = a.ws;
  const int lo = a.ph_lo, hi = a.ph_hi;
#define IN(k) (lo <= (k) && (k) < hi)
#define SEAM(k) do { if (IN(k) && IN((k) + 1)) grid.sync(); } while (0)
  if (IN(0)) { phase_prep(a, lds, gw, ngw, wave, lane, tid); } SEAM(0);
  if (IN(1)) {
    run_gemm(lds, (const bf16_t*)(ws + WS_HB), (const bf16_t*)(ws + WS_WIN_T), NT, NQKV, DM, EpiQKV{(bf16_t*)(ws + WS_QKV)}, gw, ngw, lane);
    run_gemm(lds, (const bf16_t*)(ws + WS_MEMN), (const bf16_t*)(ws + WS_WXKV_T), NMROWS, 2048, DM, EpiKV{(bf16_t*)(ws + WS_KX), (bf16_t*)(ws + WS_VXT)}, gw, ngw, lane);
  } SEAM(1);
  if (IN(2)) { phase_scan(a, gw, ngw, lane, tid); } SEAM(2);
  if (IN(3)) {
#if USE_ATT2
    phase_attn2(a, lds, tid);
#else
    phase_attn(a, lds, tid);
#endif
  } SEAM(3);
  if (IN(4)) { phase_onorm(a, gw, ngw, lane); } SEAM(4);
  if (IN(5)) { run_gemm(lds, (const bf16_t*)(ws + WS_OAB), (const bf16_t*)(ws + WS_WOUT_T), NT, DM, DM, EpiResid{a.in[0], a.out}, gw, ngw, lane); } SEAM(5);
  if (IN(6)) { phase_rms(a, gw, ngw, lane); } SEAM(6);
  if (IN(7)) { run_gemm(lds, (const bf16_t*)(ws + WS_HB), (const bf16_t*)(ws + WS_WXQ_T), NT, DM, DM, EpiBf16{(bf16_t*)(ws + WS_QX), DM}, gw, ngw, lane); } SEAM(7);
  if (IN(8)) { phase_xattn(a, lds, gw, ngw, wave, lane); } SEAM(8);
  if (IN(9)) { run_gemm(lds, (const bf16_t*)(ws + WS_OX), (const bf16_t*)(ws + WS_WXO_T), NT, DM, DM, EpiResid{a.out, a.out}, gw, ngw, lane); } SEAM(9);
  if (IN(10)) { phase_rms(a, gw, ngw, lane); } SEAM(10);
  if (IN(11)) { run_gemm(lds, (const bf16_t*)(ws + WS_HB), (const bf16_t*)(ws + WS_WPQ_T), NT, DM, DM, EpiF32{(float*)(ws + WS_PQ), DM}, gw, ngw, lane); } SEAM(11);
  if (IN(12)) { phase_topk(a, lds, tid); } SEAM(12);
  if (IN(13)) { phase_experts(a, gw, ngw, lane); }
#undef IN
#undef SEAM
}

extern "C" void kernel_launch(void* const* d_in, const int* in_sizes, int n_in, void* d_out, int out_size, void* d_ws, size_t ws_size, hipStream_t stream) {
  static int grid = 0;
  if (grid == 0) {
    if (n_in != 22 || out_size != NT * DM || ws_size < WS_END) { fprintf(stderr, "kernel_launch: unexpected shapes (n_in %d out %d ws %zu)\n", n_in, out_size, ws_size); grid = -1; return; }
    int dev = 0, cus = 0, per_cu = 0;
    (void)hipGetDevice(&dev);
    (void)hipDeviceGetAttribute(&cus, hipDeviceAttributeMultiprocessorCount, dev);
    (void)hipFuncSetAttribute((const void*)mega, hipFuncAttributeMaxDynamicSharedMemorySize, LDS_BYTES);
    (void)hipOccupancyMaxActiveBlocksPerMultiprocessor(&per_cu, (const void*)mega, 512, LDS_BYTES);
    if (per_cu < 1) per_cu = 1;
    grid = cus * per_cu;
  }
  if (grid < 0) return;
  Args a{};
  for (int i = 0; i < 22; ++i) a.in[i] = (const float*)d_in[i];
  a.out = (float*)d_out; a.ws = (unsigned char*)d_ws;
#if MK_N_LAUNCHES == 1
  a.ph_lo = 0; a.ph_hi = NPHASE + 1;
  void* args[] = {&a};
  hipError_t e = hipLaunchCooperativeKernel((const void*)mega, dim3(grid), dim3(512), args, LDS_BYTES, stream);
  if (e != hipSuccess) fprintf(stderr, "cooperative launch failed: %s (grid %d)\n", hipGetErrorString(e), grid);
#else
  for (int p = 0; p <= NPHASE; ++p) { a.ph_lo = p; a.ph_hi = p + 1; hipLaunchKernelGGL(mega, dim3(grid), dim3(512), LDS_BYTES, stream, a); }
#endif
}
```

```cpp
#include <hip/hip_runtime.h>
#include <hip/hip_cooperative_groups.h>
#include <cstdio>
#include <cstdint>
namespace cg = cooperative_groups;

#ifndef USE_PG8
#define USE_PG8 1
#endif
#ifndef USE_ATT2
#define USE_ATT2 1
#endif
#ifndef PROBE_REP
#define PROBE_REP -1
#endif
#ifndef MK_N_LAUNCHES
#define MK_N_LAUNCHES 1
#endif

typedef unsigned short bf16_t;
typedef short bf16x8 __attribute__((ext_vector_type(8)));
typedef float f32x4 __attribute__((ext_vector_type(4)));
typedef unsigned u32x4 __attribute__((ext_vector_type(4)));
typedef unsigned u32x2 __attribute__((ext_vector_type(2)));

constexpr int NB = 8, SEQ = 4096, DM = 1024, NT = NB * SEQ;
constexpr int NQKV = 3072, INW = 3080;
constexpr int NMEM = 256, NMROWS = NB * NMEM;
constexpr int NEXP = 16384;
constexpr float EPS = 1e-6f;
constexpr int NPHASE = 13;
constexpr int LDS_BYTES = 147456;

constexpr size_t MiB = 1u << 20;
constexpr size_t WS_BAR = 65536;
constexpr size_t CTL_ZERO_BYTES = 131072;
constexpr size_t WS_WIN_T = 2 * MiB;
constexpr size_t WS_WOUT_T = 8 * MiB;
constexpr size_t WS_WXQ_T = 10 * MiB;
constexpr size_t WS_WXKV_T = 12 * MiB;
constexpr size_t WS_WXO_T = 16 * MiB;
constexpr size_t WS_WPQ_T = 18 * MiB;
constexpr size_t WS_MEMN = 22 * MiB;
constexpr size_t WS_KX = 26 * MiB;
constexpr size_t WS_VXT = 30 * MiB;
constexpr size_t WS_FLOG = 34 * MiB;
constexpr size_t WS_CUM = 35 * MiB;
constexpr size_t WS_KMEAN = 36 * MiB;
constexpr size_t WS_ESC = 38 * MiB;
constexpr size_t WS_EXD = 40 * MiB;
constexpr size_t WS_EXU = 72 * MiB;
constexpr size_t WS_HB = 104 * MiB;
constexpr size_t WS_QKV = 168 * MiB;
constexpr size_t WS_OAB = 360 * MiB;
constexpr size_t WS_QX = 168 * MiB;
constexpr size_t WS_OX = 232 * MiB;
constexpr size_t WS_PQ = 232 * MiB;
constexpr size_t WS_EIDX = 424 * MiB;
constexpr size_t WS_GATE = 440 * MiB;
constexpr size_t WS_END = 456 * MiB;

struct Args {
  const float* in[22];
  float* out;
  unsigned char* ws;
  int ph_lo, ph_hi;
};

__device__ __forceinline__ unsigned f2bf(float f) { unsigned u = __float_as_uint(f); return (u + 0x7fffu + ((u >> 16) & 1u)) >> 16; }
__device__ __forceinline__ unsigned pk2(float lo, float hi) { return f2bf(lo) | (f2bf(hi) << 16); }
__device__ __forceinline__ float bf2f(unsigned short b) { return __uint_as_float(((unsigned)b) << 16); }
__device__ __forceinline__ float bflo(unsigned w) { return __uint_as_float(w << 16); }
__device__ __forceinline__ float bfhi(unsigned w) { return __uint_as_float(w & 0xffff0000u); }
__device__ __forceinline__ float wave_sum(float v) {
#pragma unroll
  for (int o = 1; o < 64; o <<= 1) v += __shfl_xor(v, o);
  return v;
}
__device__ __forceinline__ void unpack8(const u32x4 w, float* f) {
  f[0] = bflo(w.x); f[1] = bfhi(w.x); f[2] = bflo(w.y); f[3] = bfhi(w.y);
  f[4] = bflo(w.z); f[5] = bfhi(w.z); f[6] = bflo(w.w); f[7] = bfhi(w.w);
}

__device__ const unsigned char T5_BUCKET[128] = {
  0, 1, 2, 3, 4, 5, 6, 7, 8, 9, 10, 11, 12, 13, 14, 15, 16, 16, 16, 17, 17, 18, 18, 18, 19, 19, 19, 20, 20, 20, 20, 21,
  21, 21, 21, 22, 22, 22, 22, 22, 23, 23, 23, 23, 23, 23, 24, 24, 24, 24, 24, 24, 25, 25, 25, 25, 25, 25, 25, 26, 26, 26, 26, 26,
  26, 26, 26, 27, 27, 27, 27, 27, 27, 27, 27, 27, 27, 28, 28, 28, 28, 28, 28, 28, 28, 28, 28, 29, 29, 29, 29, 29, 29, 29, 29, 29,
  29, 29, 29, 30, 30, 30, 30, 30, 30, 30, 30, 30, 30, 30, 30, 30, 30, 31, 31, 31, 31, 31, 31, 31, 31, 31, 31, 31, 31, 31, 31, 31};

__device__ __forceinline__ void transpose_item(const float* W, int ldw, const float* gain, bf16_t* WT, int K, int row_off, float* scr, int kb, int nb, int lane) {
  const int k0 = 64 * kb, n0 = 32 * nb;
#pragma unroll 8
  for (int i = 0; i < 32; ++i) {
    const int kk = 2 * i + (lane >> 5);
    const float g = gain ? gain[k0 + kk] : 1.f;
    scr[kk * 33 + (lane & 31)] = W[(size_t)(k0 + kk) * ldw + n0 + (lane & 31)] * g;
  }
  __builtin_amdgcn_wave_barrier();
  const int c = lane & 7;
#pragma unroll
  for (int j = 0; j < 4; ++j) {
    const int n = (lane >> 3) + 8 * j; const float* s = scr + (8 * c) * 33 + n;
    u32x4 o; o.x = pk2(s[0 * 33], s[1 * 33]); o.y = pk2(s[2 * 33], s[3 * 33]); o.z = pk2(s[4 * 33], s[5 * 33]); o.w = pk2(s[6 * 33], s[7 * 33]);
    *(u32x4*)(WT + (size_t)(row_off + n0 + n) * K + k0 + 8 * c) = o;
  }
  __builtin_amdgcn_wave_barrier();
}

__device__ __forceinline__ void rms_row_to_bf16(const float* xrow, bf16_t* orow, int lane) {
  const f32x4* xr = (const f32x4*)xrow + lane;
  f32x4 v[4]; float s = 0.f;
#pragma unroll
  for (int j = 0; j < 4; ++j) { v[j] = xr[64 * j]; s += (v[j].x * v[j].x + v[j].y * v[j].y) + (v[j].z * v[j].z + v[j].w * v[j].w); }
  const float rstd = rsqrtf(wave_sum(s) * (1.f / DM) + EPS);
  u32x2* o = (u32x2*)orow + lane;
#pragma unroll
  for (int j = 0; j < 4; ++j) { u32x2 w; w.x = pk2(v[j].x * rstd, v[j].y * rstd); w.y = pk2(v[j].z * rstd, v[j].w * rstd); o[64 * j] = w; }
}

__device__ __forceinline__ void phase_prep(const Args& a, unsigned char* lds, int gw, int ngw, int wave, int lane, int tid) {
  unsigned char* ws = a.ws;
  float* scr = (float*)(lds + wave * 8448);
  const int I_IN = 16 * 96, I_SQ = 16 * 32;
  const int NITEMS = I_IN + 6 * I_SQ;
  for (int it = gw; it < NITEMS; it += ngw) {
    int r = it;
    if (r < I_IN) { transpose_item(a.in[3], INW, a.in[2], (bf16_t*)(ws + WS_WIN_T), DM, 0, scr, r / 96, r % 96, lane); continue; } r -= I_IN;
    const int which = r / I_SQ; r %= I_SQ; const int kb = r / 32, nb = r % 32;
    if (which == 0) { const float* g = (kb < 8) ? a.in[6] : (a.in[7] - 512); transpose_item(a.in[8], DM, g, (bf16_t*)(ws + WS_WOUT_T), DM, 0, scr, kb, nb, lane); }
    else if (which == 1) transpose_item(a.in[11], DM, a.in[9], (bf16_t*)(ws + WS_WXQ_T), DM, 0, scr, kb, nb, lane);
    else if (which == 2) transpose_item(a.in[12], DM, a.in[10], (bf16_t*)(ws + WS_WXKV_T), DM, 0, scr, kb, nb, lane);
    else if (which == 3) transpose_item(a.in[13], DM, a.in[10], (bf16_t*)(ws + WS_WXKV_T), DM, 1024, scr, kb, nb, lane);
    else if (which == 4) transpose_item(a.in[14], DM, nullptr, (bf16_t*)(ws + WS_WXO_T), DM, 0, scr, kb, nb, lane);
    else transpose_item(a.in[16], DM, a.in[15], (bf16_t*)(ws + WS_WPQ_T), DM, 0, scr, kb, nb, lane);
  }
  for (int r = gw; r < 2 * NEXP; r += ngw) {
    const int tb = r >= NEXP, e = r - tb * NEXP;
    const f32x4* src = (const f32x4*)(a.in[19 + tb] + (size_t)e * DM) + 4 * lane;
    f32x4 v[4]; float am = 0.f;
#pragma unroll
    for (int k = 0; k < 4; ++k) { v[k] = src[k]; am = fmaxf(am, fmaxf(fmaxf(fabsf(v[k].x), fabsf(v[k].y)), fmaxf(fabsf(v[k].z), fabsf(v[k].w)))); }
#pragma unroll
    for (int o = 1; o < 64; o <<= 1) am = fmaxf(am, __shfl_xor(am, o));
    const float sc = am > 0.f ? 440.f / am : 1.f;
    u32x4 o;
#pragma unroll
    for (int k = 0; k < 4; ++k) { int w = __builtin_amdgcn_cvt_pk_fp8_f32(v[k].x * sc, v[k].y * sc, 0, false); w = __builtin_amdgcn_cvt_pk_fp8_f32(v[k].z * sc, v[k].w * sc, w, true); o[k] = (unsigned)w; }
    *((u32x4*)(ws + (tb ? WS_EXU : WS_EXD) + (size_t)e * DM) + lane) = o;
    if (lane == 0) ((float*)(ws + WS_ESC))[r] = am > 0.f ? am / 440.f : 1.f;
  }
  for (int r = gw; r < NMROWS; r += ngw) rms_row_to_bf16(a.in[1] + (size_t)r * DM, (bf16_t*)(ws + WS_MEMN) + (size_t)r * DM, lane);
  __syncthreads();
  float* wf = (float*)(lds + 69632);
  for (int k = tid; k < DM; k += 512) {
    const float g = a.in[2][k]; const f32x4* wp = (const f32x4*)(a.in[3] + (size_t)k * INW + NQKV);
    const f32x4 p = wp[0], q = wp[1];
    f32x4* d = (f32x4*)(wf + k * 8); d[0] = p * g; d[1] = q * g;
  }
  __syncthreads();
  float* flog = (float*)(ws + WS_FLOG);
  for (int r = gw; r < NT; r += ngw) {
    const f32x4* xr = (const f32x4*)(a.in[0] + (size_t)r * DM) + lane;
    f32x4 v[4]; float s = 0.f; float fa[8];
#pragma unroll
    for (int j = 0; j < 8; ++j) fa[j] = 0.f;
#pragma unroll
    for (int j = 0; j < 4; ++j) {
      v[j] = xr[64 * j]; s += (v[j].x * v[j].x + v[j].y * v[j].y) + (v[j].z * v[j].z + v[j].w * v[j].w);
#pragma unroll
      for (int c = 0; c < 4; ++c) {
        const float xv = v[j][c]; const f32x4* wp = (const f32x4*)(wf + (256 * j + 4 * lane + c) * 8);
        const f32x4 p = wp[0], q = wp[1];
        fa[0] += xv * p.x; fa[1] += xv * p.y; fa[2] += xv * p.z; fa[3] += xv * p.w;
        fa[4] += xv * q.x; fa[5] += xv * q.y; fa[6] += xv * q.z; fa[7] += xv * q.w;
      }
    }
    const float rstd = rsqrtf(wave_sum(s) * (1.f / DM) + EPS);
    float mine = 0.f;
#pragma unroll
    for (int j = 0; j < 8; ++j) { const float t = wave_sum(fa[j]); if (lane == j) mine = t; }
    if (lane < 8) {
      const float z = mine * rstd + a.in[4][lane];
      flog[(size_t)r * 8 + lane] = fminf(z, 0.f) - log1pf(expf(-fabsf(z)));
    }
    u32x2* o = (u32x2*)((bf16_t*)(ws + WS_HB) + (size_t)r * DM) + lane;
#pragma unroll
    for (int j = 0; j < 4; ++j) { u32x2 w; w.x = pk2(v[j].x * rstd, v[j].y * rstd); w.y = pk2(v[j].z * rstd, v[j].w * rstd); o[64 * j] = w; }
  }
}

template <class Epi>
__device__ __forceinline__ void gemm_naive(const bf16_t* A, int lda, const bf16_t* Bt, int ldb, int M, int N, int K, const Epi& E, int gw, int ngw, int lane) {
  const int fr = lane & 15, fq = lane >> 4;
  const int tn = N / 64, ntile = (M / 64) * tn;
  for (int tile = gw; tile < ntile; tile += ngw) {
    const int pm = tile / tn, pn = tile % tn;
    f32x4 acc[4][4];
#pragma unroll
    for (int m = 0; m < 4; ++m)
#pragma unroll
      for (int n = 0; n < 4; ++n) acc[m][n] = (f32x4){0.f, 0.f, 0.f, 0.f};
    const bf16_t* Ap = A + (size_t)(pm * 64 + fr) * lda + fq * 8;
    const bf16_t* Bp = Bt + (size_t)(pn * 64 + fr) * ldb + fq * 8;
    for (int k0 = 0; k0 < K; k0 += 32) {
      bf16x8 af[4], bfr[4];
#pragma unroll
      for (int m = 0; m < 4; ++m) af[m] = *(const bf16x8*)(Ap + (size_t)m * 16 * lda + k0);
#pragma unroll
      for (int n = 0; n < 4; ++n) bfr[n] = *(const bf16x8*)(Bp + (size_t)n * 16 * ldb + k0);
#pragma unroll
      for (int m = 0; m < 4; ++m)
#pragma unroll
        for (int n = 0; n < 4; ++n) acc[m][n] = __builtin_amdgcn_mfma_f32_16x16x32_bf16(bfr[n], af[m], acc[m][n], 0, 0, 0);
    }
#pragma unroll
    for (int m = 0; m < 4; ++m)
#pragma unroll
      for (int n = 0; n < 4; ++n) E.store(pm * 64 + m * 16 + fr, pn * 64 + n * 16 + 4 * fq, acc[m][n]);
  }
}

struct EpiBf16 { bf16_t* O; int ldo;
  __device__ __forceinline__ void store(int row, int col, f32x4 v) const { u32x2 w; w.x = pk2(v.x, v.y); w.y = pk2(v.z, v.w); *(u32x2*)(O + (size_t)row * ldo + col) = w; } };
struct EpiQKV { bf16_t* O;
  __device__ __forceinline__ void store(int row, int col, f32x4 v) const { const float sc = (col < 512 || (col >= 1536 && col < 2048)) ? 0.18033688011112042f : 1.f;
    u32x2 w; w.x = pk2(v.x * sc, v.y * sc); w.y = pk2(v.z * sc, v.w * sc); *(u32x2*)(O + (size_t)row * NQKV + col) = w; } };
struct EpiF32 { float* O; int ldo;
  __device__ __forceinline__ void store(int row, int col, f32x4 v) const { *(f32x4*)(O + (size_t)row * ldo + col) = v; } };
struct EpiResid { const float* base; float* out;
  __device__ __forceinline__ void store(int row, int col, f32x4 v) const { const size_t o = (size_t)row * DM + col; const f32x4 b = *(const f32x4*)(base + o); *(f32x4*)(out + o) = b + v; } };
struct EpiKV { bf16_t* KX; bf16_t* VXT;
  __device__ __forceinline__ void store(int row, int col, f32x4 v) const {
    if (col < 1024) { u32x2 w; w.x = pk2(v.x, v.y); w.y = pk2(v.z, v.w); *(u32x2*)(KX + (size_t)row * DM + col) = w; }
    else { const int b = row >> 8, m = row & 255;
#pragma unroll
      for (int r = 0; r < 4; ++r) { const int d = col - 1024 + r; VXT[((size_t)(b * 4 + (d >> 8)) * 256 + (d & 255)) * 256 + m] = (bf16_t)f2bf(v[r]); } } } };

__device__ __forceinline__ void phase_scan(const Args& a, int gw, int ngw, int lane, int tid) {
  unsigned char* ws = a.ws;
  const float* flog = (const float*)(ws + WS_FLOG); float* cum = (float*)(ws + WS_CUM);
  for (int p = gw; p < 64; p += ngw) {
    const int b = p >> 3, j = p & 7;
    const float* src = flog + ((size_t)b * SEQ + lane * 64) * 8 + j;
    float tot = 0.f;
    for (int i = 0; i < 64; ++i) tot += src[i * 8];
    float inc = tot;
#pragma unroll
    for (int o = 1; o < 64; o <<= 1) { const float t = __shfl_up(inc, o); if (lane >= o) inc += t; }
    float run = inc - tot;
    float* dst = cum + ((size_t)(b * 8 + j)) * SEQ + lane * 64;
    for (int i = 0; i < 64; ++i) { run += src[i * 8]; dst[i] = run * 1.4426950408889634f; }
  }
  const bf16_t* qkv = (const bf16_t*)(ws + WS_QKV); float* kmean = (float*)(ws + WS_KMEAN);
  {
    unsigned* kn2 = (unsigned*)(ws + 256);
    for (int item = gw; item < 64 * 16; item += ngw) {
      const int bh = item >> 4, ch = item & 15, b = bh >> 3, h = bh & 7; float m = 0.f;
      for (int rr = 0; rr < 4; ++rr) {
        const u32x4* kp = (const u32x4*)(qkv + ((size_t)b * SEQ + ch * 256 + lane * 4 + rr) * NQKV + 2048 + h * 64); float s = 0.f;
#pragma unroll
        for (int c = 0; c < 8; ++c) { float f[8]; unpack8(kp[c], f);
#pragma unroll
          for (int i = 0; i < 8; ++i) s += f[i] * f[i]; }
        m = fmaxf(m, s);
      }
#pragma unroll
      for (int o = 1; o < 64; o <<= 1) m = fmaxf(m, __shfl_xor(m, o));
      if (lane == 0) atomicMax(kn2 + bh, __float_as_uint(m));
    }
  }
  const int gt = blockIdx.x * 512 + tid, ngt = gridDim.x * 512;
  for (int o = gt; o < NB * 16 * 512; o += ngt) {
    const int c = o & 511, blk = (o >> 9) & 15, b = o >> 13;
    const bf16_t* p = qkv + ((size_t)b * SEQ + blk * 256) * NQKV + 512 + c;
    float s = 0.f;
    for (int r = 0; r < 256; ++r) s += bf2f(p[(size_t)r * NQKV]);
    kmean[o] = s * (1.f / 256.f);
  }
}

template <int MODE>
__device__ __forceinline__ void attn_naive_unit(const Args& a, unsigned char* lds, int b, int h, int sb, int tid) {
  unsigned char* ws = a.ws;
  const bf16_t* qkv = (const bf16_t*)(ws + WS_QKV);
  const int qoff = MODE ? 1536 : 0, koff = qoff + 512, voff = qoff + 1024;
  float* Ks = (float*)lds; float* Vs = Ks + 64 * 64; float* ck = Vs + 64 * 64; float* biasd = ck + 64;
  const int t = sb * 512 + tid; const size_t row = (size_t)b * SEQ + t;
  float q[64], o[64];
  {
    const u32x4* qp = (const u32x4*)(qkv + row * NQKV + qoff + h * 64);
#pragma unroll
    for (int c = 0; c < 8; ++c) { const u32x4 w = qp[c]; unpack8(w, q + 8 * c); }
#pragma unroll
    for (int d = 0; d < 64; ++d) { q[d] *= 0.6931471805599453f; o[d] = 0.f; }
  }
  float m = -1e30f, l = 0.f;
  unsigned selmask = 0u; const int own = t >> 8;
  float cq = 0.f, bfar = 0.f;
  __syncthreads();
  if (MODE == 0) {
    if (tid < 128) biasd[tid] = a.in[5][T5_BUCKET[tid] * 8 + h];
    bfar = a.in[5][31 * 8 + h];
    const float* km = (const float*)(ws + WS_KMEAN) + ((size_t)b * 16) * 512 + h * 64;
    float v0 = -3e38f, v1 = -3e38f, v2 = -3e38f; int i0 = -1, i1 = -1, i2 = -1;
    for (int n = 0; n < 2 * sb + 1; ++n) {
      if (n < own) {
        const float* kp = km + (size_t)n * 512; float s = 0.f;
#pragma unroll
        for (int d = 0; d < 64; ++d) s += q[d] * kp[d];
        if (s > v0) { v2 = v1; i2 = i1; v1 = v0; i1 = i0; v0 = s; i0 = n; }
        else if (s > v1) { v2 = v1; i2 = i1; v1 = s; i1 = n; }
        else if (s > v2) { v2 = s; i2 = n; }
      }
    }
    if (i0 >= 0) selmask |= 1u << i0;
    if (i1 >= 0) selmask |= 1u << i1;
    if (i2 >= 0) selmask |= 1u << i2;
  } else {
    cq = ((const float*)(ws + WS_CUM))[((size_t)(b * 8 + h)) * SEQ + t];
  }
  const int ntile = 8 * (sb + 1);
  for (int kt = 0; kt < ntile; ++kt) {
    __syncthreads();
    {
      const int r = tid >> 3, ch = tid & 7;
      const bf16_t* kp = qkv + ((size_t)b * SEQ + kt * 64 + r) * NQKV + h * 64 + ch * 8;
      const u32x4 kw = *(const u32x4*)(kp + koff), vw = *(const u32x4*)(kp + voff);
      unpack8(kw, Ks + r * 64 + ch * 8); unpack8(vw, Vs + r * 64 + ch * 8);
      if (MODE == 1 && tid < 64) ck[tid] = ((const float*)(ws + WS_CUM))[((size_t)(b * 8 + h)) * SEQ + kt * 64 + tid];
    }
    __syncthreads();
    const int kb = kt >> 2;
    bool act;
    if (MODE == 0) act = (kb == own) || (kb < own && ((selmask >> kb) & 1u));
    else act = (kt * 64 <= t);
    if (act) {
      for (int jj = 0; jj < 64; ++jj) {
        const int sp = kt * 64 + jj;
        if (sp > t) break;
        const f32x4* kr = (const f32x4*)(Ks + jj * 64);
        float s = 0.f;
#pragma unroll
        for (int c = 0; c < 16; ++c) { const f32x4 kv = kr[c]; s += q[4 * c] * kv.x + q[4 * c + 1] * kv.y + q[4 * c + 2] * kv.z + q[4 * c + 3] * kv.w; }
        if (MODE == 0) { const int dist = t - sp; s += (dist < 128) ? biasd[dist] : bfar; }
        else s += (cq - ck[jj]) * 0.6931471805599453f;
        if (s > m) { const float f = __expf(m - s); l *= f;
#pragma unroll
          for (int d = 0; d < 64; ++d) o[d] *= f;
          m = s; }
        const float p = __expf(s - m); l += p;
        const f32x4* vr = (const f32x4*)(Vs + jj * 64);
#pragma unroll
        for (int c = 0; c < 16; ++c) { const f32x4 vv = vr[c]; o[4 * c] += p * vv.x; o[4 * c + 1] += p * vv.y; o[4 * c + 2] += p * vv.z; o[4 * c + 3] += p * vv.w; }
      }
    }
  }
  const float il = 1.f / l;
  u32x4* op = (u32x4*)((bf16_t*)(ws + WS_OAB) + row * DM + (MODE ? 512 : 0) + h * 64);
#pragma unroll
  for (int c = 0; c < 8; ++c) { u32x4 w; w.x = pk2(o[8 * c] * il, o[8 * c + 1] * il); w.y = pk2(o[8 * c + 2] * il, o[8 * c + 3] * il); w.z = pk2(o[8 * c + 4] * il, o[8 * c + 5] * il); w.w = pk2(o[8 * c + 6] * il, o[8 * c + 7] * il); op[c] = w; }
}

__device__ __forceinline__ void phase_attn(const Args& a, unsigned char* lds, int tid) {
  for (int u = blockIdx.x; u < 1024; u += gridDim.x) {
    const int sb = 7 - (u >> 7), r = u & 127, mode = r & 1, bh = r >> 1;
    if (mode == 0) attn_naive_unit<0>(a, lds, bh >> 3, bh & 7, sb, tid);
    else attn_naive_unit<1>(a, lds, bh >> 3, bh & 7, sb, tid);
  }
}

namespace att {
typedef float f32x16 __attribute__((ext_vector_type(16)));
typedef short s16x4 __attribute__((ext_vector_type(4)));
typedef short v4i16_t __attribute__((ext_vector_type(4)));
typedef __attribute__((address_space(3))) const char* lds_cptr;
typedef float f32x2_t __attribute__((ext_vector_type(2))); typedef __bf16 bf16x2_t __attribute__((ext_vector_type(2)));
constexpr int PITCH = NQKV;
constexpr float LOG2E = 1.4426950408889634f;
constexpr float C2 = 0.125f * LOG2E;
constexpr int L_K = 0, L_V = 16384, L_WSF = 32768, L_OST = 34816, L_C2 = 67584, L_KM = 83968, L_BT = 88064, L_MISC = 88704;
__device__ __forceinline__ int crow(int r, int hi) { return (r & 3) + 8 * (r >> 2) + 4 * hi; }
__device__ __forceinline__ unsigned cvtpk(float lo, float hi) { f32x2_t v = {lo, hi}; bf16x2_t b = __builtin_convertvector(v, bf16x2_t); return __builtin_bit_cast(unsigned, b); }
__device__ __forceinline__ s16x4 vtr(lds_cptr p) { return __builtin_bit_cast(s16x4, __builtin_amdgcn_ds_read_tr16_b64_v4i16((__attribute__((address_space(3))) v4i16_t*)p)); }
__device__ __forceinline__ float xhalf_max(float m) { auto rr = __builtin_amdgcn_permlane32_swap(__float_as_uint(m), __float_as_uint(m), false, false); return fmaxf(__uint_as_float(rr[0]), __uint_as_float(rr[1])); }
__device__ __forceinline__ float xhalf_sum(float m) { auto rr = __builtin_amdgcn_permlane32_swap(__float_as_uint(m), __float_as_uint(m), false, false); return __uint_as_float(rr[0]) + __uint_as_float(rr[1]); }

template <int MODE>
__device__ __forceinline__ void unit(const Args& a, unsigned char* lds, int b, int h, int qb, int tid) {
  unsigned char* ws = a.ws;
  const int lane = tid & 63, r32 = lane & 31, hi = lane >> 5; const int wid = __builtin_amdgcn_readfirstlane(tid >> 6);
  const bf16_t* qkv = (const bf16_t*)(ws + WS_QKV);
  const int qoff = MODE ? 1536 : 0;
  const size_t rowbase = (size_t)b * SEQ; const int q0 = qb * 256;
  const bf16_t* Qw = qkv + (rowbase + q0 + wid * 32) * PITCH + qoff + h * 64;
  const bf16_t* Kh = qkv + rowbase * PITCH + qoff + 512 + h * 64;
  const bf16_t* Vh = qkv + rowbase * PITCH + qoff + 1024 + h * 64;
  float* wsf = (float*)(lds + L_WSF) + wid * 64;
  float* c2s = (float*)(lds + L_C2); float* kms = (float*)(lds + L_KM); float* bts = (float*)(lds + L_BT); unsigned* misc = (unsigned*)(lds + L_MISC);
  const int NTL = 4 * (qb + 1);
  __syncthreads();
  if (MODE == 0) {
    const float* km = (const float*)(ws + WS_KMEAN) + (size_t)b * 16 * 512 + h * 64;
    for (int i = tid; i < 16 * 64; i += 512) kms[i] = km[(size_t)(i >> 6) * 512 + (i & 63)];
    if (tid < 128) bts[tid] = a.in[5][T5_BUCKET[tid] * 8 + h] * LOG2E;
    if (tid == 128) bts[128] = a.in[5][31 * 8 + h] * LOG2E;
  } else {
    const float* cg = (const float*)(ws + WS_CUM) + (size_t)(b * 8 + h) * SEQ;
    for (int i = tid; i < 256 * (qb + 1); i += 512) c2s[i] = cg[i];
    if (tid == 0) misc[0] = 0u;
  }
  bf16x8 qr[4];
#pragma unroll
  for (int d0 = 0; d0 < 4; ++d0) qr[d0] = *(const bf16x8*)(Qw + (size_t)r32 * PITCH + d0 * 16 + hi * 8);
  __syncthreads();
  unsigned selmask = 0u; float cq2 = 0.f, far2 = 0.f, mhat = -1e30f; int t0 = 0;
  if (MODE == 0) {
    far2 = bts[128];
    float v0 = -3e38f, v1 = -3e38f, v2 = -3e38f; int i0 = -1, i1 = -1, i2 = -1;
    for (int n = 0; n < qb; ++n) {
      float s = 0.f;
#pragma unroll
      for (int d0 = 0; d0 < 4; ++d0)
#pragma unroll
        for (int j = 0; j < 8; ++j) s += bf2f((unsigned short)qr[d0][j]) * kms[n * 64 + d0 * 16 + hi * 8 + j];
      s = xhalf_sum(s);
      if (s > v0) { v2 = v1; i2 = i1; v1 = v0; i1 = i0; v0 = s; i0 = n; }
      else if (s > v1) { v2 = v1; i2 = i1; v1 = s; i1 = n; }
      else if (s > v2) { v2 = s; i2 = n; }
    }
    if (i0 >= 0) selmask |= 1u << i0;
    if (i1 >= 0) selmask |= 1u << i1;
    if (i2 >= 0) selmask |= 1u << i2;
  } else {
    cq2 = c2s[q0 + wid * 32 + r32];
    float s = 0.f;
#pragma unroll
    for (int d0 = 0; d0 < 4; ++d0)
#pragma unroll
      for (int j = 0; j < 8; ++j) { const float f = bf2f((unsigned short)qr[d0][j]); s += f * f; }
    s = xhalf_sum(s);
    atomicMax(&misc[0], __float_as_uint(s));
    __syncthreads();
    const float kn2 = __uint_as_float(((const unsigned*)(ws + 256))[b * 8 + h]);
    const float qkb = sqrtf(__uint_as_float(misc[0]) * kn2) * 1.0001f + 1e-3f;
    mhat = -qkb;
    const int j = lane; bool skip = false;
    if (j < NTL) skip = (2.f * qkb + c2s[q0] - c2s[64 * j + 63]) < -150.f;
    t0 = __popcll(__ballot(skip));
    if (t0 > NTL - 1) t0 = NTL - 1;
  }
  const bf16_t* ksrc = Kh + (size_t)lane * PITCH + wid * 8;
  const bf16_t* vsrc = Vh + (size_t)(16 * (wid & 3) + (lane >> 2)) * PITCH + (wid >> 2) * 32 + (lane & 3) * 8;
  unsigned char* kdst = lds + L_K + wid * 1024 + lane * 16; unsigned char* vdst = lds + L_V + wid * 1024 + lane * 16;
  const lds_cptr lds3 = (lds_cptr)lds;
  const lds_cptr vp0 = lds3 + L_V + ((lane >> 4) & 1) * 32 + (lane & 3) * 8 + (4 * hi + ((lane & 15) >> 2)) * 64;
  u32x4 kreg = *(const u32x4*)(ksrc + (size_t)t0 * 64 * PITCH), vreg = *(const u32x4*)(vsrc + (size_t)t0 * 64 * PITCH);
  *(u32x4*)(kdst + (t0 & 1) * 8192) = kreg; *(u32x4*)(vdst + (t0 & 1) * 8192) = vreg;
  f32x16 o[2]; o[0] = f32x16{}; o[1] = f32x16{};
  float l = 0.f;
  const int qrel = wid * 32 + r32, qpos = q0 + qrel;
  __syncthreads();
  for (int t = t0; t < NTL; ++t) {
    const int buf = (t & 1) * 8192;
    if (t + 1 < NTL) { kreg = *(const u32x4*)(ksrc + (size_t)(t + 1) * 64 * PITCH); vreg = *(const u32x4*)(vsrc + (size_t)(t + 1) * 64 * PITCH); }
    const int jb = t - (NTL - 4);
    const bool compute = !(jb >= 0 && 64 * jb > wid * 32 + 31);
    if (compute) {
      f32x16 p0, p1;
      if (MODE == 0) {
        const int nb = t >> 2;
        const bool near = (jb >= 0) || (t >= NTL - 6 && wid < 4);
        if (near) {
#pragma unroll
          for (int r = 0; r < 16; ++r) { const int d = qpos - (64 * t + crow(r, hi));
            p0[r] = bts[min(max(d, 0), 128)]; p1[r] = bts[min(max(d - 32, 0), 128)]; }
        } else {
#pragma unroll
          for (int r = 0; r < 16; ++r) { p0[r] = far2; p1[r] = far2; }
        }
        if (jb < 0 && !((selmask >> nb) & 1u)) {
#pragma unroll
          for (int r = 0; r < 16; ++r) { p0[r] = -INFINITY; p1[r] = -INFINITY; }
        }
      } else {
#pragma unroll
        for (int g = 0; g < 4; ++g) {
          const f32x4 ca = *(const f32x4*)(c2s + 64 * t + 8 * g + 4 * hi), cb = *(const f32x4*)(c2s + 64 * t + 32 + 8 * g + 4 * hi);
#pragma unroll
          for (int i = 0; i < 4; ++i) { p0[4 * g + i] = cq2 - ca[i]; p1[4 * g + i] = cq2 - cb[i]; }
        }
      }
      {
        const lds_cptr kb = lds3 + L_K + buf + hi * 1024 + r32 * 16;
#pragma unroll
        for (int d0 = 0; d0 < 4; ++d0) {
          const bf16x8 b0 = *(const __attribute__((address_space(3))) bf16x8*)(kb + d0 * 2048);
          const bf16x8 b1 = *(const __attribute__((address_space(3))) bf16x8*)(kb + d0 * 2048 + 512);
          p0 = __builtin_amdgcn_mfma_f32_32x32x16_bf16(b0, qr[d0], p0, 0, 0, 0);
          p1 = __builtin_amdgcn_mfma_f32_32x32x16_bf16(b1, qr[d0], p1, 0, 0, 0);
        }
      }
      if (jb >= 0) {
        const int kb0 = 64 * jb + 4 * hi;
#pragma unroll
        for (int r = 0; r < 16; ++r) { const int kv = kb0 + (r & 3) + 8 * (r >> 2); if (kv > qrel) p0[r] = -INFINITY; if (kv + 32 > qrel) p1[r] = -INFINITY; }
      }
      float rm = fmaxf(p0[0], p1[0]);
#pragma unroll
      for (int r = 1; r < 16; ++r) rm = fmaxf(rm, fmaxf(p0[r], p1[r]));
      rm = xhalf_max(rm);
      const float mnew = fmaxf(mhat, rm);
      if (__any(mnew > mhat)) {
        const float alpha = __builtin_amdgcn_exp2f(mhat - mnew);
        l *= alpha; mhat = mnew;
        if (hi == 0) wsf[r32] = alpha;
        __builtin_amdgcn_wave_barrier();
#pragma unroll
        for (int r = 0; r < 16; ++r) { const float f = wsf[crow(r, hi)]; o[0][r] *= f; o[1][r] *= f; }
        __builtin_amdgcn_wave_barrier();
      }
      float sacc = 0.f;
#pragma unroll
      for (int r = 0; r < 16; ++r) { p0[r] = __builtin_amdgcn_exp2f(p0[r] - mhat); p1[r] = __builtin_amdgcn_exp2f(p1[r] - mhat); sacc += p0[r] + p1[r]; }
      l += sacc;
      u32x4 pw0, pw1, pw2, pw3;
      pw0 = (u32x4){cvtpk(p0[0], p0[1]), cvtpk(p0[2], p0[3]), cvtpk(p0[4], p0[5]), cvtpk(p0[6], p0[7])};
      pw1 = (u32x4){cvtpk(p0[8], p0[9]), cvtpk(p0[10], p0[11]), cvtpk(p0[12], p0[13]), cvtpk(p0[14], p0[15])};
      pw2 = (u32x4){cvtpk(p1[0], p1[1]), cvtpk(p1[2], p1[3]), cvtpk(p1[4], p1[5]), cvtpk(p1[6], p1[7])};
      pw3 = (u32x4){cvtpk(p1[8], p1[9]), cvtpk(p1[10], p1[11]), cvtpk(p1[12], p1[13]), cvtpk(p1[14], p1[15])};
      const lds_cptr vp = vp0 + buf;
#pragma unroll
      for (int d0 = 0; d0 < 2; ++d0) {
#define ATT_VF(ks) ({ const s16x4 lo_ = vtr(vp + d0 * 4096 + (ks) * 1024), hi_ = vtr(vp + d0 * 4096 + (ks) * 1024 + 512); (bf16x8){lo_[0], lo_[1], lo_[2], lo_[3], hi_[0], hi_[1], hi_[2], hi_[3]}; })
        o[d0] = __builtin_amdgcn_mfma_f32_32x32x16_bf16(__builtin_bit_cast(bf16x8, pw0), ATT_VF(0), o[d0], 0, 0, 0);
        o[d0] = __builtin_amdgcn_mfma_f32_32x32x16_bf16(__builtin_bit_cast(bf16x8, pw1), ATT_VF(1), o[d0], 0, 0, 0);
        o[d0] = __builtin_amdgcn_mfma_f32_32x32x16_bf16(__builtin_bit_cast(bf16x8, pw2), ATT_VF(2), o[d0], 0, 0, 0);
        o[d0] = __builtin_amdgcn_mfma_f32_32x32x16_bf16(__builtin_bit_cast(bf16x8, pw3), ATT_VF(3), o[d0], 0, 0, 0);
#undef ATT_VF
      }
    }
    if (t + 1 < NTL) { *(u32x4*)(kdst + ((t + 1) & 1) * 8192) = kreg; *(u32x4*)(vdst + ((t + 1) & 1) * 8192) = vreg; }
    __syncthreads();
  }
  l = xhalf_sum(l);
  if (hi == 0) wsf[32 + r32] = l;
  __builtin_amdgcn_wave_barrier();
  bf16_t* stg = (bf16_t*)(lds + L_OST) + wid * 2048;
#pragma unroll
  for (int r = 0; r < 16; ++r) { const int orow = crow(r, hi); const float rl = 1.f / wsf[32 + orow];
    stg[orow * 64 + r32] = (bf16_t)f2bf(o[0][r] * rl); stg[orow * 64 + 32 + r32] = (bf16_t)f2bf(o[1][r] * rl); }
  __builtin_amdgcn_wave_barrier();
  bf16_t* Ow = (bf16_t*)(ws + WS_OAB) + (rowbase + q0 + wid * 32) * DM + (MODE ? 512 : 0) + h * 64;
#pragma unroll
  for (int i = 0; i < 4; ++i) { const int row = i * 8 + (lane >> 3), ch = lane & 7; const u32x4 v = *(const u32x4*)(stg + row * 64 + ch * 8); *(u32x4*)(Ow + (size_t)row * DM + ch * 8) = v; }
}
}

__device__ __forceinline__ void phase_attn2(const Args& a, unsigned char* lds, int tid) {
  unsigned* ctr = (unsigned*)(a.ws + 0);
  unsigned* slot = (unsigned*)(lds + att::L_MISC + 64);
  for (;;) {
    __syncthreads();
    if (tid == 0) slot[0] = atomicAdd(ctr, 1u);
    __syncthreads();
    const unsigned u = slot[0];
    if (u >= 2048u) break;
    const int qb = 15 - (int)(u >> 7), r = u & 127, mode = r & 1, bh = r >> 1;
    if (mode == 0) att::unit<0>(a, lds, bh >> 3, bh & 7, qb, tid);
    else att::unit<1>(a, lds, bh >> 3, bh & 7, qb, tid);
  }
}

__device__ __forceinline__ void phase_onorm(const Args& a, int gw, int ngw, int lane) {
  bf16_t* oab = (bf16_t*)(a.ws + WS_OAB);
  for (int r = gw; r < NT; r += ngw) {
    u32x4* p = (u32x4*)(oab + (size_t)r * DM) + 2 * lane;
    const u32x4 w0 = p[0], w1 = p[1]; float f[16]; unpack8(w0, f); unpack8(w1, f + 8);
    float s = 0.f;
#pragma unroll
    for (int i = 0; i < 16; ++i) s += f[i] * f[i];
#pragma unroll
    for (int o = 1; o < 32; o <<= 1) s += __shfl_xor(s, o);
    const float rstd = rsqrtf(s * (1.f / 512.f) + EPS);
    u32x4 o0, o1;
    o0.x = pk2(f[0] * rstd, f[1] * rstd); o0.y = pk2(f[2] * rstd, f[3] * rstd); o0.z = pk2(f[4] * rstd, f[5] * rstd); o0.w = pk2(f[6] * rstd, f[7] * rstd);
    o1.x = pk2(f[8] * rstd, f[9] * rstd); o1.y = pk2(f[10] * rstd, f[11] * rstd); o1.z = pk2(f[12] * rstd, f[13] * rstd); o1.w = pk2(f[14] * rstd, f[15] * rstd);
    p[0] = o0; p[1] = o1;
  }
}

__device__ __forceinline__ void phase_rms(const Args& a, int gw, int ngw, int lane) {
  for (int r = gw; r < NT; r += ngw) rms_row_to_bf16(a.out + (size_t)r * DM, (bf16_t*)(a.ws + WS_HB) + (size_t)r * DM, lane);
}

__device__ __forceinline__ void phase_xattn(const Args& a, unsigned char* lds, int gw, int ngw, int wave, int lane) {
  unsigned char* ws = a.ws;
  const bf16_t* qx = (const bf16_t*)(ws + WS_QX); const bf16_t* kx = (const bf16_t*)(ws + WS_KX); const bf16_t* vxt = (const bf16_t*)(ws + WS_VXT);
  bf16_t* ox = (bf16_t*)(ws + WS_OX);
  bf16_t* P = (bf16_t*)(lds + wave * 8192);
  const int fr = lane & 15, fq = lane >> 4;
  for (int u = gw; u < (NT / 16) * 4; u += ngw) {
    const int hd = u & 3, r0 = (u >> 2) * 16, b = r0 / SEQ;
    f32x4 acc[16];
#pragma unroll
    for (int i = 0; i < 16; ++i) acc[i] = (f32x4){0.f, 0.f, 0.f, 0.f};
    const bf16_t* Ap = qx + (size_t)(r0 + fr) * DM + hd * 256 + fq * 8;
    const bf16_t* Bp = kx + (size_t)(b * 256 + fr) * DM + hd * 256 + fq * 8;
    for (int ks = 0; ks < 8; ++ks) {
      const bf16x8 af = *(const bf16x8*)(Ap + ks * 32);
#pragma unroll
      for (int ct = 0; ct < 16; ++ct) { const bf16x8 bfr = *(const bf16x8*)(Bp + (size_t)ct * 16 * DM + ks * 32); acc[ct] = __builtin_amdgcn_mfma_f32_16x16x32_bf16(af, bfr, acc[ct], 0, 0, 0); }
    }
    float mx[4], sm[4];
#pragma unroll
    for (int r = 0; r < 4; ++r) { float m = acc[0][r];
#pragma unroll
      for (int ct = 1; ct < 16; ++ct) m = fmaxf(m, acc[ct][r]);
#pragma unroll
      for (int o = 1; o < 16; o <<= 1) m = fmaxf(m, __shfl_xor(m, o));
      mx[r] = m; sm[r] = 0.f; }
#pragma unroll
    for (int ct = 0; ct < 16; ++ct)
#pragma unroll
      for (int r = 0; r < 4; ++r) { const float p = __expf((acc[ct][r] - mx[r]) * 0.0625f); acc[ct][r] = p; sm[r] += p; }
#pragma unroll
    for (int r = 0; r < 4; ++r) {
#pragma unroll
      for (int o = 1; o < 16; o <<= 1) sm[r] += __shfl_xor(sm[r], o);
      sm[r] = 1.f / sm[r]; }
    __builtin_amdgcn_wave_barrier();
#pragma unroll
    for (int ct = 0; ct < 16; ++ct)
#pragma unroll
      for (int r = 0; r < 4; ++r) P[(4 * fq + r) * 256 + ct * 16 + fr] = (bf16_t)f2bf(acc[ct][r] * sm[r]);
    __builtin_amdgcn_wave_barrier();
    asm volatile("s_waitcnt lgkmcnt(0)" ::: "memory");
#pragma unroll
    for (int i = 0; i < 16; ++i) acc[i] = (f32x4){0.f, 0.f, 0.f, 0.f};
    const bf16_t* Vp = vxt + ((size_t)(b * 4 + hd) * 256 + fr) * 256 + fq * 8;
    for (int ks = 0; ks < 8; ++ks) {
      const bf16x8 pf = *(const bf16x8*)(P + fr * 256 + ks * 32 + fq * 8);
#pragma unroll
      for (int dt = 0; dt < 16; ++dt) { const bf16x8 vf = *(const bf16x8*)(Vp + (size_t)dt * 16 * 256 + ks * 32); acc[dt] = __builtin_amdgcn_mfma_f32_16x16x32_bf16(pf, vf, acc[dt], 0, 0, 0); }
    }
#pragma unroll
    for (int dt = 0; dt < 16; ++dt)
#pragma unroll
      for (int r = 0; r < 4; ++r) ox[(size_t)(r0 + 4 * fq + r) * DM + hd * 256 + dt * 16 + fr] = (bf16_t)f2bf(acc[dt][r]);
    __builtin_amdgcn_wave_barrier();
  }
}

__device__ __forceinline__ unsigned fkey(float s, unsigned idx, unsigned mask) { unsigned u = __float_as_uint(s); u ^= (unsigned)((int)u >> 31) | 0x80000000u; return (u & ~mask) | (mask - idx); }
__device__ __forceinline__ float keyval(unsigned k, unsigned mask) { unsigned u = k & ~mask; u = (u & 0x80000000u) ? (u ^ 0x80000000u) : ~u; return __uint_as_float(u); }
#define KEY_INSERT(KA, key_) do { unsigned k__ = (key_); \
  _Pragma("unroll") for (int s_ = 0; s_ < 16; ++s_) { const unsigned hi_ = max(k__, KA[s_]); k__ = min(k__, KA[s_]); KA[s_] = hi_; } } while (0)

__device__ __forceinline__ void phase_topk(const Args& a, unsigned char* lds, int tid) {
  unsigned char* ws = a.ws;
  const float* pq = (const float*)(ws + WS_PQ);
  int* eidx = (int*)(ws + WS_EIDX); float* gate = (float*)(ws + WS_GATE);
  float* K1 = (float*)lds; float* K2 = K1 + 128 * 64; unsigned* KL = (unsigned*)(lds + 65536);
  for (int u = blockIdx.x; u < 8 * (NT / 512); u += gridDim.x) {
    const int h = u & 7, t = (u >> 3) * 512 + tid;
    __syncthreads();
    for (int i = tid; i < 128 * 64 / 4; i += 512) { ((f32x4*)K1)[i] = ((const f32x4*)(a.in[17] + (size_t)h * 8192))[i]; ((f32x4*)K2)[i] = ((const f32x4*)(a.in[18] + (size_t)h * 8192))[i]; }
    __syncthreads();
    unsigned ka[16], kb[16], kc[16];
#pragma unroll
    for (int k = 0; k < 16; ++k) { ka[k] = 0u; kb[k] = 0u; kc[k] = 0u; }
    float q[64];
    const f32x4* qp = (const f32x4*)(pq + (size_t)t * DM + h * 128);
#pragma unroll
    for (int c = 0; c < 16; ++c) { const f32x4 w = qp[c]; q[4 * c] = w.x; q[4 * c + 1] = w.y; q[4 * c + 2] = w.z; q[4 * c + 3] = w.w; }
    for (int n = 0; n < 128; ++n) {
      const f32x4* kr = (const f32x4*)(K1 + n * 64); float s = 0.f;
#pragma unroll
      for (int c = 0; c < 16; ++c) { const f32x4 kv = kr[c]; s += q[4 * c] * kv.x + q[4 * c + 1] * kv.y + q[4 * c + 2] * kv.z + q[4 * c + 3] * kv.w; }
      KEY_INSERT(ka, fkey(s, (unsigned)n, 127u));
    }
#pragma unroll
    for (int c = 0; c < 16; ++c) { const f32x4 w = qp[16 + c]; q[4 * c] = w.x; q[4 * c + 1] = w.y; q[4 * c + 2] = w.z; q[4 * c + 3] = w.w; }
    for (int n = 0; n < 128; ++n) {
      const f32x4* kr = (const f32x4*)(K2 + n * 64); float s = 0.f;
#pragma unroll
      for (int c = 0; c < 16; ++c) { const f32x4 kv = kr[c]; s += q[4 * c] * kv.x + q[4 * c + 1] * kv.y + q[4 * c + 2] * kv.z + q[4 * c + 3] * kv.w; }
      KEY_INSERT(kb, fkey(s, (unsigned)n, 127u));
    }
#pragma unroll
    for (int x = 0; x < 16; ++x)
#pragma unroll
      for (int y = 0; y < 16; ++y)
        if ((x + 1) * (y + 1) <= 16) { KEY_INSERT(kc, fkey(keyval(ka[x], 127u) + keyval(kb[y], 127u), (unsigned)(x * 16 + y), 255u)); }
#pragma unroll
    for (int k = 0; k < 16; ++k) { KL[k * 512 + tid] = ka[k]; KL[(16 + k) * 512 + tid] = kb[k]; }
    float val[16]; int id[16]; float sum = 0.f;
#pragma unroll
    for (int k = 0; k < 16; ++k) {
      const unsigned flat = 255u - (kc[k] & 255u);
      const unsigned k1 = KL[(flat >> 4) * 512 + tid], k2 = KL[(16 + (flat & 15u)) * 512 + tid];
      val[k] = keyval(k1, 127u) + keyval(k2, 127u);
      id[k] = (int)((127u - (k1 & 127u)) * 128u + (127u - (k2 & 127u)));
    }
    const float vmax = val[0];
#pragma unroll
    for (int k = 0; k < 16; ++k) { val[k] = __expf(val[k] - vmax); sum += val[k]; }
    const float inv = 1.f / sum;
    int* ep = eidx + (size_t)t * 128 + h * 16; float* gp = gate + (size_t)t * 128 + h * 16;
#pragma unroll
    for (int k = 0; k < 16; ++k) { ep[k] = id[k]; gp[k] = val[k] * inv; }
  }
}

__device__ __forceinline__ float gelu_erf(float v) { return 0.5f * v * (1.f + erff(v * 0.70710678118654752f)); }

__device__ __forceinline__ void phase_experts(const Args& a, int gw, int ngw, int lane, float* outp) {
  unsigned char* ws = a.ws;
  const int* eidx = (const int*)(ws + WS_EIDX); const float* gate = (const float*)(ws + WS_GATE);
  const unsigned char* exd = ws + WS_EXD; const unsigned char* exu = ws + WS_EXU; const float* esc = (const float*)(ws + WS_ESC);
  for (int t = gw; t < NT; t += ngw) {
    const f32x4* xr = (const f32x4*)(a.out + (size_t)t * DM) + 4 * lane;
    f32x4 x[4], acc[4]; float hg[16]; float s = 0.f;
#pragma unroll
    for (int k = 0; k < 4; ++k) { x[k] = xr[k]; s += (x[k].x * x[k].x + x[k].y * x[k].y) + (x[k].z * x[k].z + x[k].w * x[k].w); acc[k] = (f32x4){0.f, 0.f, 0.f, 0.f}; }
    const float rstd = rsqrtf(wave_sum(s) * (1.f / DM) + EPS);
#pragma unroll
    for (int k = 0; k < 4; ++k) { const f32x4 g = ((const f32x4*)a.in[15])[4 * lane + k]; const f32x4 hv = x[k] * rstd * g; hg[4 * k] = hv.x; hg[4 * k + 1] = hv.y; hg[4 * k + 2] = hv.z; hg[4 * k + 3] = hv.w; }
    const int e0 = eidx[(size_t)t * 128 + lane], e1 = eidx[(size_t)t * 128 + 64 + lane];
    const float sd0 = esc[e0], sd1 = esc[e1];
    const float gu0 = gate[(size_t)t * 128 + lane] * esc[NEXP + e0], gu1 = gate[(size_t)t * 128 + 64 + lane] * esc[NEXP + e1];
    for (int e = 0; e < 128; e += 8) {
      u32x4 ur[8], vr[8]; float dot[8];
#pragma unroll
      for (int i = 0; i < 8; ++i) {
        const int ee = e + i; const int id = (e < 64) ? __shfl(e0, ee) : __shfl(e1, ee - 64);
        ur[i] = *((const u32x4*)(exd + (size_t)id * DM) + lane);
        vr[i] = *((const u32x4*)(exu + (size_t)id * DM) + lane);
      }
#pragma unroll
      for (int i = 0; i < 8; ++i) {
        float d = 0.f;
#pragma unroll
        for (int k = 0; k < 4; ++k) { const auto lo = __builtin_amdgcn_cvt_pk_f32_fp8((int)ur[i][k], false); const auto hi = __builtin_amdgcn_cvt_pk_f32_fp8((int)ur[i][k], true);
          d += hg[4 * k] * lo[0] + hg[4 * k + 1] * lo[1] + hg[4 * k + 2] * hi[0] + hg[4 * k + 3] * hi[1]; }
        dot[i] = wave_sum(d);
      }
#pragma unroll
      for (int i = 0; i < 8; ++i) {
        const int ee = e + i;
        const float sd = (e < 64) ? __shfl(sd0, ee) : __shfl(sd1, ee - 64);
        const float gu = (e < 64) ? __shfl(gu0, ee) : __shfl(gu1, ee - 64);
        const float w = gu * gelu_erf(dot[i] * sd);
#pragma unroll
        for (int k = 0; k < 4; ++k) { const auto lo = __builtin_amdgcn_cvt_pk_f32_fp8((int)vr[i][k], false); const auto hi = __builtin_amdgcn_cvt_pk_f32_fp8((int)vr[i][k], true);
          acc[k].x += w * lo[0]; acc[k].y += w * lo[1]; acc[k].z += w * hi[0]; acc[k].w += w * hi[1]; }
      }
    }
    float s2 = 0.f;
#pragma unroll
    for (int k = 0; k < 4; ++k) { x[k] = x[k] + acc[k]; s2 += (x[k].x * x[k].x + x[k].y * x[k].y) + (x[k].z * x[k].z + x[k].w * x[k].w); }
    const float r2 = rsqrtf(wave_sum(s2) * (1.f / DM) + EPS);
    f32x4* orow = (f32x4*)(outp + (size_t)t * DM) + 4 * lane;
#pragma unroll
    for (int k = 0; k < 4; ++k) { const f32x4 g = ((const f32x4*)a.in[21])[4 * lane + k]; orow[k] = x[k] * r2 * g; }
  }
}

namespace pg8 {
#define PG8_LAS __attribute__((address_space(3)))
typedef unsigned short bf16_t;
typedef short bf16x8 __attribute__((ext_vector_type(8)));
typedef float f32x4 __attribute__((ext_vector_type(4)));
typedef unsigned u32x4 __attribute__((ext_vector_type(4)));
constexpr int BM = 256, BK = 64, HALF = 128, HTB = HALF * BK * 2  , STAGE_BYTES = 8 * HTB, NXCD = 8, WGM = 8;

__host__ __device__ __forceinline__ int lds_byte(int r, int c) { const int st = (r >> 4) * 2 + (c >> 5), rr = r & 15, cc = c & 31, ob = rr * 64 + cc * 2; return st * 1024 + (ob ^ (((ob >> 9) & 1) << 5)); }
__host__ __device__ __forceinline__ void stage_rc(int b, int& R, int& C) { const int st = b / 1024, sb = b % 1024, swz = sb ^ (((sb >> 9) & 1) << 5); R = (st >> 1) * 16 + swz / 64; C = (st & 1) * 32 + (swz % 64) / 2; }
__host__ __device__ __forceinline__ int perm32(int rho) { const int n = rho >> 4, i = rho & 15; return 8 * (i >> 2) + 4 * n + (i & 3); }

struct Unit { int pm, pn; };
struct Gemm { const bf16_t* A; const bf16_t* Bt; int M, N, K; };

struct StaticOrder {
    int nM, nN, nwg, G, c;
    __host__ __device__ void init(int M, int N, int G_, int c_) { nM = M / BM; nN = N / BM; nwg = nM * nN; G = G_; c = c_; }
    __host__ __device__ bool next(int i, Unit& u) const {
        const long L = (long)i * G + c; if (L >= nwg) return false;
        int wgid = (int)L; { const int q = nwg / NXCD, r = nwg % NXCD, xcd = wgid % NXCD, off = wgid / NXCD; wgid = (xcd < r ? xcd * (q + 1) : r * (q + 1) + (xcd - r) * q) + off; }
        const int nig = WGM * nN, gid = wgid / nig, fm = gid * WGM, gsz = (nM - fm) < WGM ? (nM - fm) : WGM;
        u.pm = fm + ((wgid % nig) % gsz); u.pn = (wgid % nig) / gsz; return true;
    }
    __device__ __forceinline__ void a_ready(const Unit&) const {}
    __device__ __forceinline__ void done(const Unit&) const {}
};

template <class St> struct EpiAdapt {
    static constexpr bool PERM = false, AFTER_DRAIN = false; St st;
    __device__ __forceinline__ void operator()(const f32x4 (&acc)[2][2][4][2], const Unit& u, int wr, int wc, int fr, int fq) const {
#pragma unroll
        for (int ai = 0; ai < 2; ++ai)
#pragma unroll
            for (int m = 0; m < 4; ++m)
#pragma unroll
                for (int bj = 0; bj < 2; ++bj)
#pragma unroll
                    for (int n = 0; n < 2; ++n) st.store(u.pm * BM + ai * HALF + wr * 64 + m * 16 + fr, u.pn * BM + bj * HALF + wc * 32 + n * 16 + 4 * fq, acc[ai][bj][m][n]);
    }
};

template <class Epi, class Sched, bool ALIGN_EPI = false, bool SP2 = false>
__device__ __forceinline__ void gemm_phase(PG8_LAS unsigned char* lds, const Gemm g, const Sched& S, const Epi& E) {
    const int tid = threadIdx.x, wid = __builtin_amdgcn_readfirstlane(tid >> 6), lane = tid & 63, wr = wid >> 2, wc = wid & 3, fr = lane & 15, fq = lane >> 4;
    const int K = g.K, nt = K / BK;
    unsigned voffA[2], voffB[2];
#pragma unroll
    for (int i = 0; i < 2; ++i) { int R, C; stage_rc(tid * 16 + i * 8192, R, C); const int Rb = Epi::PERM ? ((R & ~31) + perm32(R & 31)) : R;
        voffA[i] = (unsigned)(R * K + C) * 2u; voffB[i] = (unsigned)(Rb * K + C) * 2u; }
    const size_t kstep = (size_t)(BK * 2);
    const size_t hstep = (size_t)HALF * K * 2;
    const size_t tstep = 2 * hstep;
    const unsigned ldsw = (unsigned)wid * 1024u;
    const int aoff = lds_byte(wr * 64 + fr, fq * 8), boff = lds_byte(wc * 32 + fr, fq * 8);
#define PG8_SA(b, h) (((b) * 2 + (h)) * HTB)
#define PG8_SB(b, h) ((4 + (b) * 2 + (h)) * HTB)
#define PG8_STAGE(bufoff, gbase, voff) do { _Pragma("unroll") for (int _i = 0; _i < 2; ++_i) \
        __builtin_amdgcn_global_load_lds((const unsigned*)((const char*)(gbase) + (voff)[_i]), (PG8_LAS unsigned*)(lds + (bufoff) + ldsw + _i * 8192), 16, 0, 0); } while (0)
#define PG8_LDA(dst, b, h) do { _Pragma("unroll") for (int m = 0; m < 4; ++m) _Pragma("unroll") for (int k = 0; k < 2; ++k) dst[m][k] = *(const PG8_LAS bf16x8*)(lds + PG8_SA(b, h) + aoff + m * 2048 + k * 1024); } while (0)
#define PG8_LDB(dst, b, h) do { _Pragma("unroll") for (int n = 0; n < 2; ++n) _Pragma("unroll") for (int k = 0; k < 2; ++k) dst[n][k] = *(const PG8_LAS bf16x8*)(lds + PG8_SB(b, h) + boff + n * 2048 + k * 1024); } while (0)
#define PG8_MMA(ai, bj, At, Bt) do { __builtin_amdgcn_s_setprio(1); _Pragma("unroll") for (int m = 0; m < 4; ++m) _Pragma("unroll") for (int n = 0; n < 2; ++n) _Pragma("unroll") for (int k = 0; k < 2; ++k) \
        acc[ai][bj][m][n] = __builtin_amdgcn_mfma_f32_16x16x32_bf16(Bt[n][k], At[m][k], acc[ai][bj][m][n], 0, 0, 0); __builtin_amdgcn_s_setprio(0); } while (0)
#define PG8_WAIT_V(n) asm volatile("s_waitcnt vmcnt(" #n ")" ::: "memory")
#define PG8_WAIT_L(n) asm volatile("s_waitcnt lgkmcnt(" #n ")" ::: "memory")
#define PG8_BAR __builtin_amdgcn_s_barrier()
#define PG8_SCHED __builtin_amdgcn_sched_barrier(0)
    Unit cur, nxt; int ui = 0;
    if (!S.next(0, cur)) return;
    f32x4 acc[2][2][4][2];
#pragma unroll
    for (int a = 0; a < 2; ++a)
#pragma unroll
        for (int b = 0; b < 2; ++b)
#pragma unroll
            for (int m = 0; m < 4; ++m)
#pragma unroll
                for (int n = 0; n < 2; ++n) acc[a][b][m][n] = (f32x4){0.f, 0.f, 0.f, 0.f};
    bf16x8 At[4][2], B0[2][2], B1[2][2];
    const char* cA = (const char*)g.A + (size_t)cur.pm * tstep; const char* cB = (const char*)g.Bt + (size_t)cur.pn * tstep;
    S.a_ready(cur);
    if constexpr (SP2) {
        PG8_STAGE(PG8_SB(0, 0), cB, voffB); PG8_STAGE(PG8_SB(0, 1), cB + hstep, voffB); PG8_STAGE(PG8_SA(0, 0), cA, voffA); PG8_STAGE(PG8_SA(0, 1), cA + hstep, voffA);
        if (wr == 1) PG8_BAR;
        PG8_WAIT_V(2); PG8_BAR;
        PG8_STAGE(PG8_SB(1, 0), cB + kstep, voffB); PG8_STAGE(PG8_SA(1, 0), cA + kstep, voffA); PG8_STAGE(PG8_SB(1, 1), cB + hstep + kstep, voffB);
        PG8_WAIT_V(6); PG8_BAR;
    } else {
        PG8_STAGE(PG8_SB(0, 0), cB, voffB); PG8_STAGE(PG8_SA(0, 0), cA, voffA); PG8_STAGE(PG8_SB(0, 1), cB + hstep, voffB); PG8_STAGE(PG8_SA(0, 1), cA + hstep, voffA);
        if (wr == 1) PG8_BAR;
        PG8_WAIT_V(4); PG8_BAR;
        PG8_STAGE(PG8_SB(1, 0), cB + kstep, voffB); PG8_STAGE(PG8_SA(1, 0), cA + kstep, voffA); PG8_STAGE(PG8_SB(1, 1), cB + hstep + kstep, voffB);
        PG8_WAIT_V(6); PG8_BAR;
    }
    for (;;) {
        const bool has_next = S.next(ui + 1, nxt);
        const char* nA = has_next ? (const char*)g.A + (size_t)nxt.pm * tstep : cA; const char* nB = has_next ? (const char*)g.Bt + (size_t)nxt.pn * tstep : cB;
        for (int t = 0; t < nt; t += 2) {
            const bool last = (t == nt - 2);
            const char* a1 = cA + (size_t)(t + 1) * kstep;
            const char* a2 = last ? nA : cA + (size_t)(t + 2) * kstep; const char* b2 = last ? nB : cB + (size_t)(t + 2) * kstep;
            const char* a3 = a2 + kstep; const char* b3 = b2 + kstep;
            if (last && has_next) S.a_ready(nxt);
            if constexpr (SP2) {
            PG8_LDB(B0, 0, 0); PG8_LDB(B1, 0, 1); PG8_SCHED; PG8_LDA(At, 0, 0); PG8_STAGE(PG8_SA(1, 1), a1 + hstep, voffA);
            PG8_WAIT_V(8); PG8_WAIT_L(0); PG8_BAR; PG8_MMA(0, 0, At, B0); PG8_MMA(0, 1, At, B1); PG8_BAR; PG8_SCHED;
            PG8_LDA(At, 0, 1); PG8_STAGE(PG8_SB(0, 0), b2, voffB); PG8_STAGE(PG8_SB(0, 1), b2 + hstep, voffB); PG8_STAGE(PG8_SA(0, 0), a2, voffA);
            PG8_WAIT_V(8); PG8_WAIT_L(0); PG8_BAR; PG8_MMA(1, 0, At, B0); PG8_MMA(1, 1, At, B1); PG8_BAR; PG8_SCHED;
            PG8_LDB(B0, 1, 0); PG8_LDB(B1, 1, 1); PG8_SCHED; PG8_LDA(At, 1, 0); PG8_STAGE(PG8_SA(0, 1), a2 + hstep, voffA);
            PG8_WAIT_V(8); PG8_WAIT_L(0); PG8_BAR; PG8_MMA(0, 0, At, B0); PG8_MMA(0, 1, At, B1); PG8_BAR; PG8_SCHED;
            PG8_LDA(At, 1, 1); PG8_STAGE(PG8_SB(1, 0), b3, voffB); PG8_STAGE(PG8_SB(1, 1), b3 + hstep, voffB); PG8_STAGE(PG8_SA(1, 0), a3, voffA);
            PG8_WAIT_V(8); PG8_WAIT_L(0); PG8_BAR; PG8_MMA(1, 0, At, B0); PG8_MMA(1, 1, At, B1); PG8_BAR; PG8_SCHED;
            } else {
            PG8_LDB(B0, 0, 0); PG8_SCHED; PG8_LDA(At, 0, 0); PG8_STAGE(PG8_SA(1, 1), a1 + hstep, voffA);
            PG8_WAIT_L(8); PG8_BAR; PG8_WAIT_L(0); PG8_MMA(0, 0, At, B0); PG8_BAR; PG8_SCHED;
            PG8_LDB(B1, 0, 1); PG8_STAGE(PG8_SB(0, 0), b2, voffB);
            PG8_BAR; PG8_WAIT_L(0); PG8_MMA(0, 1, At, B1); PG8_BAR;
            PG8_LDA(At, 0, 1); PG8_STAGE(PG8_SA(0, 0), a2, voffA);
            PG8_BAR; PG8_WAIT_L(0); PG8_MMA(1, 0, At, B0); PG8_BAR; PG8_SCHED;
            PG8_STAGE(PG8_SB(0, 1), b2 + hstep, voffB);
            PG8_WAIT_V(6); PG8_BAR; PG8_MMA(1, 1, At, B1); PG8_BAR;
            PG8_LDB(B0, 1, 0); PG8_SCHED; PG8_LDA(At, 1, 0); PG8_STAGE(PG8_SA(0, 1), a2 + hstep, voffA);
            PG8_WAIT_L(8); PG8_BAR; PG8_WAIT_L(0); PG8_MMA(0, 0, At, B0); PG8_BAR; PG8_SCHED;
            PG8_LDB(B1, 1, 1); PG8_STAGE(PG8_SB(1, 0), b3, voffB);
            PG8_BAR; PG8_WAIT_L(0); PG8_MMA(0, 1, At, B1); PG8_BAR;
            PG8_LDA(At, 1, 1); PG8_STAGE(PG8_SA(1, 0), a3, voffA);
            PG8_BAR; PG8_WAIT_L(0); PG8_MMA(1, 0, At, B0); PG8_BAR; PG8_SCHED;
            PG8_STAGE(PG8_SB(1, 1), b3 + hstep, voffB);
            PG8_WAIT_V(6); PG8_BAR; PG8_MMA(1, 1, At, B1); PG8_BAR;
            }
        }
        if constexpr (ALIGN_EPI) { if (wr == 0) PG8_BAR; }
        if constexpr (!Epi::AFTER_DRAIN) { E(acc, cur, wr, wc, fr, fq); S.done(cur); }
        if (!has_next) break;
#pragma unroll
        for (int a = 0; a < 2; ++a)
#pragma unroll
            for (int b = 0; b < 2; ++b)
#pragma unroll
                for (int m = 0; m < 4; ++m)
#pragma unroll
                    for (int n = 0; n < 2; ++n) acc[a][b][m][n] = (f32x4){0.f, 0.f, 0.f, 0.f};
        cur = nxt; cA = nA; cB = nB; ++ui;
        if constexpr (ALIGN_EPI) { if (wr == 1) PG8_BAR; }
    }
    PG8_WAIT_V(0);
    if constexpr (!ALIGN_EPI) { if (wr == 0) PG8_BAR; }
    PG8_BAR;
    if constexpr (Epi::AFTER_DRAIN) { E.fused(acc, cur, wr, wc, fr, fq, lds, wid, lane); S.done(cur); }
#undef PG8_SA
#undef PG8_SB
#undef PG8_STAGE
#undef PG8_LDA
#undef PG8_LDB
#undef PG8_MMA
#undef PG8_WAIT_V
#undef PG8_WAIT_L
#undef PG8_BAR
#undef PG8_SCHED
}
}


template <class St>
__device__ __forceinline__ void run_gemm(unsigned char* lds, const bf16_t* A, const bf16_t* Bt, int M, int N, int K, const St& st, int gw, int ngw, int lane) {
#if USE_PG8
  pg8::Gemm g{A, Bt, M, N, K}; pg8::StaticOrder S; S.init(M, N, (int)gridDim.x, (int)blockIdx.x);
  pg8::EpiAdapt<St> E{st};
  pg8::gemm_phase<pg8::EpiAdapt<St>, pg8::StaticOrder, true, true>((PG8_LAS unsigned char*)lds, g, S, E);
#else
  gemm_naive(A, K, Bt, K, M, N, K, st, gw, ngw, lane);
#endif
}

#define GAS __attribute__((address_space(1)))
#define LAS __attribute__((address_space(3)))
#define XB_TMO      128
#define XB_XCNT(j)  (256  + 64 * (j))
#define XB_XSUB(j)  (1280 + 64 * (j))
#define XB_XGEN(j)  (2304 + 64 * (j))
#define XB_TOP      3328
#define XB_TOPGEN   3392
#define XCD_BAR_WORDS 3456
#define XB_SPIN_CAP (1u << 18)

__device__ __forceinline__ unsigned xb_ld(unsigned* p)              { return __hip_atomic_load(p, __ATOMIC_RELAXED, __HIP_MEMORY_SCOPE_AGENT); }
__device__ __forceinline__ unsigned xb_add(unsigned* p, unsigned v) { return __hip_atomic_fetch_add(p, v, __ATOMIC_RELAXED, __HIP_MEMORY_SCOPE_AGENT); }
__device__ __forceinline__ unsigned xb_xcc_id() { return (unsigned)__builtin_amdgcn_s_getreg((3 << 11) | 20) & 0xFu; }
#define XB_SPIN(cond, bar) do { unsigned _sp = 0; while (cond) { __builtin_amdgcn_s_sleep(1); \
    if ((++_sp & 255u) == 0u) { if (xb_ld(&(bar)[XB_TMO])) break; if (_sp > XB_SPIN_CAP) { atomicAdd(&(bar)[XB_TMO], 1u); break; } } } } while (0)

struct XcdBarrier {
    unsigned* bar; unsigned x;
    volatile LAS unsigned* st;
};

__device__ __forceinline__ XcdBarrier xcd_barrier_post(unsigned* bar, volatile LAS unsigned* st) {
    XcdBarrier b; b.bar = bar; b.x = xb_xcc_id(); b.st = st;
    if (threadIdx.x == 0) (void)xb_add(&bar[XB_XCNT(b.x)], 1u);
    return b;
}
__device__ __forceinline__ void xcd_barrier_complete(unsigned* bar, unsigned x, unsigned& nloc, unsigned& nx) {
    const unsigned G = gridDim.x * gridDim.y * gridDim.z;
    unsigned sum, cnt, mine, sp = 0u;
    for (;;) {
        sum = 0u; cnt = 0u; mine = 0u;
#pragma unroll
        for (unsigned j = 0; j < 16; ++j) { const unsigned c = xb_ld(&bar[XB_XCNT(j)]); sum += c; cnt += (c > 0u) ? 1u : 0u; mine = (j == x) ? c : mine; }
        if (sum == G) break;
        __builtin_amdgcn_s_sleep(1);
        if ((++sp & 255u) == 0u) { if (xb_ld(&bar[XB_TMO])) break; if (sp > XB_SPIN_CAP) { atomicAdd(&bar[XB_TMO], 1u); break; } }
    }
    nloc = mine > 0u ? mine : 1u; nx = cnt > 0u ? cnt : 1u;
}

__device__ __forceinline__ void xcd_barrier(const XcdBarrier& b) {
    asm volatile("s_waitcnt vmcnt(0)" ::: "memory");
    __syncthreads();
    if (threadIdx.x == 0) {
        unsigned* bar = b.bar;
        __builtin_amdgcn_s_waitcnt(0);
        unsigned nloc = b.st[0], nx = b.st[1];
        if (nloc == 0u) { xcd_barrier_complete(bar, b.x, nloc, nx); b.st[0] = nloc; b.st[1] = nx; }
        const unsigned old = xb_add(&bar[XB_XSUB(b.x)], 1u);
        const unsigned gen = old / nloc;
        if (old + 1u == (gen + 1u) * nloc) {
            __builtin_amdgcn_fence(__ATOMIC_RELEASE, "agent");
            asm volatile("s_waitcnt vmcnt(0)" ::: "memory");
            const unsigned og = xb_add(&bar[XB_TOP], 1u);
            const unsigned tg = og / nx;
            if (og + 1u == (tg + 1u) * nx) xb_add(&bar[XB_TOPGEN], 1u);
            else XB_SPIN(xb_ld(&bar[XB_TOPGEN]) == tg, bar);
            __builtin_amdgcn_fence(__ATOMIC_ACQUIRE, "agent");
            xb_add(&bar[XB_XGEN(b.x)], 1u);
            asm volatile("s_waitcnt vmcnt(0)" ::: "memory");
        } else {
            XB_SPIN(xb_ld(&bar[XB_XGEN(b.x)]) == gen, bar);
            __builtin_amdgcn_fence(__ATOMIC_ACQUIRE, "agent");
            asm volatile("s_waitcnt vmcnt(0)" ::: "memory");
        }
    }
    __syncthreads();
}

__global__ void __launch_bounds__(512, 2) mega(Args a) {
  extern __shared__ __attribute__((aligned(16))) unsigned char lds[];
  cg::grid_group grid = cg::this_grid();
  const int tid = threadIdx.x, lane = tid & 63, wave = tid >> 6;
  const int gw = blockIdx.x * 8 + wave, ngw = gridDim.x * 8;
  unsigned char* ws = a.ws;
  const int lo = a.ph_lo, hi = a.ph_hi;
#define IN(k) (lo <= (k) && (k) < hi)
  volatile LAS unsigned* MISC = (volatile LAS unsigned*)((LAS unsigned char*)lds + 131072 + 320);
  if (tid < 32) MISC[tid] = 0u;
  __syncthreads();
  XcdBarrier bar; bar.bar = (unsigned*)(ws + WS_BAR); bar.x = 0; bar.st = nullptr;
  if (hi - lo > 1) bar = xcd_barrier_post((unsigned*)(ws + WS_BAR), MISC + 8);
#define SEAM(k) do { if (IN(k) && IN((k) + 1)) { if ((k) == 0) grid.sync(); else xcd_barrier(bar); } } while (0)
#if PROBE_REP == 0
  if (IN(0)) { phase_prep(a, lds, gw, ngw, wave, lane, tid); grid.sync(); }
#endif
  if (IN(0)) { phase_prep(a, lds, gw, ngw, wave, lane, tid); } SEAM(0);
  if (IN(1)) {
    run_gemm(lds, (const bf16_t*)(ws + WS_HB), (const bf16_t*)(ws + WS_WIN_T), NT, NQKV, DM, EpiQKV{(bf16_t*)(ws + WS_QKV)}, gw, ngw, lane);
    run_gemm(lds, (const bf16_t*)(ws + WS_MEMN), (const bf16_t*)(ws + WS_WXKV_T), NMROWS, 2048, DM, EpiKV{(bf16_t*)(ws + WS_KX), (bf16_t*)(ws + WS_VXT)}, gw, ngw, lane);
  } SEAM(1);
  if (IN(2)) { phase_scan(a, gw, ngw, lane, tid); } SEAM(2);
  if (IN(3)) {
#if USE_ATT2
    phase_attn2(a, lds, tid);
#else
    phase_attn(a, lds, tid);
#endif
  } SEAM(3);
  if (IN(4)) { phase_onorm(a, gw, ngw, lane); } SEAM(4);
  if (IN(5)) { run_gemm(lds, (const bf16_t*)(ws + WS_OAB), (const bf16_t*)(ws + WS_WOUT_T), NT, DM, DM, EpiResid{a.in[0], a.out}, gw, ngw, lane); } SEAM(5);
  if (IN(6)) { phase_rms(a, gw, ngw, lane); } SEAM(6);
  if (IN(7)) { run_gemm(lds, (const bf16_t*)(ws + WS_HB), (const bf16_t*)(ws + WS_WXQ_T), NT, DM, DM, EpiBf16{(bf16_t*)(ws + WS_QX), DM}, gw, ngw, lane); } SEAM(7);
#if PROBE_REP == 8
  if (IN(8)) { phase_xattn(a, lds, gw, ngw, wave, lane); grid.sync(); }
#endif
  if (IN(8)) { phase_xattn(a, lds, gw, ngw, wave, lane); } SEAM(8);
  if (IN(9)) { run_gemm(lds, (const bf16_t*)(ws + WS_OX), (const bf16_t*)(ws + WS_WXO_T), NT, DM, DM, EpiResid{a.out, a.out}, gw, ngw, lane); } SEAM(9);
  if (IN(10)) { phase_rms(a, gw, ngw, lane); } SEAM(10);
  if (IN(11)) { run_gemm(lds, (const bf16_t*)(ws + WS_HB), (const bf16_t*)(ws + WS_WPQ_T), NT, DM, DM, EpiF32{(float*)(ws + WS_PQ), DM}, gw, ngw, lane); } SEAM(11);
#if PROBE_REP == 12
  if (IN(12)) { phase_topk(a, lds, tid); grid.sync(); }
#endif
  if (IN(12)) { phase_topk(a, lds, tid); } SEAM(12);
  #if PROBE_REP == 13
  if (IN(13)) { phase_experts(a, gw, ngw, lane, (float*)(ws + WS_QKV)); grid.sync(); }
#endif
  if (IN(13)) { phase_experts(a, gw, ngw, lane, a.out); }
#undef IN
#undef SEAM
}

extern "C" void kernel_launch(void* const* d_in, const int* in_sizes, int n_in, void* d_out, int out_size, void* d_ws, size_t ws_size, hipStream_t stream) {
  static int grid = 0;
  if (grid == 0) {
    if (n_in != 22 || out_size != NT * DM || ws_size < WS_END) { fprintf(stderr, "kernel_launch: unexpected shapes (n_in %d out %d ws %zu)\n", n_in, out_size, ws_size); grid = -1; return; }
    int dev = 0, cus = 0, per_cu = 0;
    (void)hipGetDevice(&dev);
    (void)hipDeviceGetAttribute(&cus, hipDeviceAttributeMultiprocessorCount, dev);
    (void)hipFuncSetAttribute((const void*)mega, hipFuncAttributeMaxDynamicSharedMemorySize, LDS_BYTES);
    (void)hipOccupancyMaxActiveBlocksPerMultiprocessor(&per_cu, (const void*)mega, 512, LDS_BYTES);
    if (per_cu < 1) per_cu = 1;
    grid = cus * per_cu;
  }
  if (grid < 0) return;
  (void)hipMemsetAsync(d_ws, 0, CTL_ZERO_BYTES, stream);
  Args a{};
  for (int i = 0; i < 22; ++i) a.in[i] = (const float*)d_in[i];
  a.out = (float*)d_out; a.ws = (unsigned char*)d_ws;
#if MK_N_LAUNCHES == 1
  a.ph_lo = 0; a.ph_hi = NPHASE + 1;
  void* args[] = {&a};
  hipError_t e = hipLaunchCooperativeKernel((const void*)mega, dim3(grid), dim3(512), args, LDS_BYTES, stream);
  if (e != hipSuccess) fprintf(stderr, "cooperative launch failed: %s (grid %d)\n", hipGetErrorString(e), grid);
#else
  for (int p = 0; p <= NPHASE; ++p) { a.ph_lo = p; a.ph_hi = p + 1; hipLaunchKernelGGL(mega, dim3(grid), dim3(512), LDS_BYTES, stream, a); }
#endif
}
```

```cpp
#include <hip/hip_runtime.h>
#include <hip/hip_cooperative_groups.h>
#include <cstdio>
#include <cstdint>
namespace cg = cooperative_groups;

#ifndef USE_PG8
#define USE_PG8 1
#endif
#ifndef USE_ATT2
#define USE_ATT2 1
#endif
#ifndef PROBE_REP
#define PROBE_REP -1
#endif
#ifndef MK_N_LAUNCHES
#define MK_N_LAUNCHES 1
#endif

typedef unsigned short bf16_t;
typedef short bf16x8 __attribute__((ext_vector_type(8)));
typedef float f32x4 __attribute__((ext_vector_type(4)));
typedef unsigned u32x4 __attribute__((ext_vector_type(4)));
typedef unsigned u32x2 __attribute__((ext_vector_type(2)));

constexpr int NB = 8, SEQ = 4096, DM = 1024, NT = NB * SEQ;
constexpr int NQKV = 3072, INW = 3080;
constexpr int NMEM = 256, NMROWS = NB * NMEM;
constexpr int NEXP = 16384;
constexpr float EPS = 1e-6f;
constexpr int NPHASE = 13;
constexpr int LDS_BYTES = 147456;

constexpr size_t MiB = 1u << 20;
constexpr size_t WS_BAR = 65536;
constexpr size_t WS_SS1 = 131072;
constexpr size_t WS_SS2 = 262144;
constexpr size_t CTL_ZERO_BYTES = 393216;
constexpr size_t WS_WIN_T = 2 * MiB;
constexpr size_t WS_WOUT_T = 8 * MiB;
constexpr size_t WS_WXQ_T = 10 * MiB;
constexpr size_t WS_WXKV_T = 12 * MiB;
constexpr size_t WS_WXO_T = 16 * MiB;
constexpr size_t WS_WPQ_T = 18 * MiB;
constexpr size_t WS_MEMN = 22 * MiB;
constexpr size_t WS_KX = 26 * MiB;
constexpr size_t WS_VXT = 30 * MiB;
constexpr size_t WS_FLOG = 34 * MiB;
constexpr size_t WS_CUM = 35 * MiB;
constexpr size_t WS_KMEAN = 36 * MiB;
constexpr size_t WS_ESC = 38 * MiB;
constexpr size_t WS_EXD = 40 * MiB;
constexpr size_t WS_EXU = 72 * MiB;
constexpr size_t WS_HB = 104 * MiB;
constexpr size_t WS_QKV = 168 * MiB;
constexpr size_t WS_OAB = 360 * MiB;
constexpr size_t WS_QX = 168 * MiB;
constexpr size_t WS_OX = 232 * MiB;
constexpr size_t WS_PQ = 232 * MiB;
constexpr size_t WS_EIDX = 424 * MiB;
constexpr size_t WS_GATE = 440 * MiB;
constexpr size_t WS_END = 456 * MiB;

struct Args {
  const float* in[22];
  float* out;
  unsigned char* ws;
  int ph_lo, ph_hi;
};

__device__ __forceinline__ unsigned f2bf(float f) { unsigned u = __float_as_uint(f); return (u + 0x7fffu + ((u >> 16) & 1u)) >> 16; }
__device__ __forceinline__ unsigned pk2(float lo, float hi) { return f2bf(lo) | (f2bf(hi) << 16); }
__device__ __forceinline__ float bf2f(unsigned short b) { return __uint_as_float(((unsigned)b) << 16); }
__device__ __forceinline__ float bflo(unsigned w) { return __uint_as_float(w << 16); }
__device__ __forceinline__ float bfhi(unsigned w) { return __uint_as_float(w & 0xffff0000u); }
__device__ __forceinline__ float wave_sum(float v) {
#pragma unroll
  for (int o = 1; o < 64; o <<= 1) v += __shfl_xor(v, o);
  return v;
}
__device__ __forceinline__ void unpack8(const u32x4 w, float* f) {
  f[0] = bflo(w.x); f[1] = bfhi(w.x); f[2] = bflo(w.y); f[3] = bfhi(w.y);
  f[4] = bflo(w.z); f[5] = bfhi(w.z); f[6] = bflo(w.w); f[7] = bfhi(w.w);
}

__device__ const unsigned char T5_BUCKET[128] = {
  0, 1, 2, 3, 4, 5, 6, 7, 8, 9, 10, 11, 12, 13, 14, 15, 16, 16, 16, 17, 17, 18, 18, 18, 19, 19, 19, 20, 20, 20, 20, 21,
  21, 21, 21, 22, 22, 22, 22, 22, 23, 23, 23, 23, 23, 23, 24, 24, 24, 24, 24, 24, 25, 25, 25, 25, 25, 25, 25, 26, 26, 26, 26, 26,
  26, 26, 26, 27, 27, 27, 27, 27, 27, 27, 27, 27, 27, 28, 28, 28, 28, 28, 28, 28, 28, 28, 28, 29, 29, 29, 29, 29, 29, 29, 29, 29,
  29, 29, 29, 30, 30, 30, 30, 30, 30, 30, 30, 30, 30, 30, 30, 30, 30, 31, 31, 31, 31, 31, 31, 31, 31, 31, 31, 31, 31, 31, 31, 31};

__device__ __forceinline__ void transpose_item(const float* W, int ldw, const float* gain, bf16_t* WT, int K, int row_off, float* scr, int kb, int nb, int lane) {
  const int k0 = 64 * kb, n0 = 32 * nb;
#pragma unroll 8
  for (int i = 0; i < 32; ++i) {
    const int kk = 2 * i + (lane >> 5);
    const float g = gain ? gain[k0 + kk] : 1.f;
    scr[kk * 33 + (lane & 31)] = W[(size_t)(k0 + kk) * ldw + n0 + (lane & 31)] * g;
  }
  __builtin_amdgcn_wave_barrier();
  const int c = lane & 7;
#pragma unroll
  for (int j = 0; j < 4; ++j) {
    const int n = (lane >> 3) + 8 * j; const float* s = scr + (8 * c) * 33 + n;
    u32x4 o; o.x = pk2(s[0 * 33], s[1 * 33]); o.y = pk2(s[2 * 33], s[3 * 33]); o.z = pk2(s[4 * 33], s[5 * 33]); o.w = pk2(s[6 * 33], s[7 * 33]);
    *(u32x4*)(WT + (size_t)(row_off + n0 + n) * K + k0 + 8 * c) = o;
  }
  __builtin_amdgcn_wave_barrier();
}

__device__ __forceinline__ void rms_row_to_bf16(const float* xrow, bf16_t* orow, int lane) {
  const f32x4* xr = (const f32x4*)xrow + lane;
  f32x4 v[4]; float s = 0.f;
#pragma unroll
  for (int j = 0; j < 4; ++j) { v[j] = xr[64 * j]; s += (v[j].x * v[j].x + v[j].y * v[j].y) + (v[j].z * v[j].z + v[j].w * v[j].w); }
  const float rstd = rsqrtf(wave_sum(s) * (1.f / DM) + EPS);
  u32x2* o = (u32x2*)orow + lane;
#pragma unroll
  for (int j = 0; j < 4; ++j) { u32x2 w; w.x = pk2(v[j].x * rstd, v[j].y * rstd); w.y = pk2(v[j].z * rstd, v[j].w * rstd); o[64 * j] = w; }
}

__device__ __forceinline__ void phase_prep(const Args& a, unsigned char* lds, int gw, int ngw, int wave, int lane, int tid) {
  unsigned char* ws = a.ws;
  float* scr = (float*)(lds + wave * 8448);
  const int I_IN = 16 * 96, I_SQ = 16 * 32;
  const int NITEMS = I_IN + 6 * I_SQ;
  for (int it = gw; it < NITEMS; it += ngw) {
    int r = it;
    if (r < I_IN) { transpose_item(a.in[3], INW, a.in[2], (bf16_t*)(ws + WS_WIN_T), DM, 0, scr, r / 96, r % 96, lane); continue; } r -= I_IN;
    const int which = r / I_SQ; r %= I_SQ; const int kb = r / 32, nb = r % 32;
    if (which == 0) { const float* g = (kb < 8) ? a.in[6] : (a.in[7] - 512); transpose_item(a.in[8], DM, g, (bf16_t*)(ws + WS_WOUT_T), DM, 0, scr, kb, nb, lane); }
    else if (which == 1) transpose_item(a.in[11], DM, a.in[9], (bf16_t*)(ws + WS_WXQ_T), DM, 0, scr, kb, nb, lane);
    else if (which == 2) transpose_item(a.in[12], DM, a.in[10], (bf16_t*)(ws + WS_WXKV_T), DM, 0, scr, kb, nb, lane);
    else if (which == 3) transpose_item(a.in[13], DM, a.in[10], (bf16_t*)(ws + WS_WXKV_T), DM, 1024, scr, kb, nb, lane);
    else if (which == 4) transpose_item(a.in[14], DM, nullptr, (bf16_t*)(ws + WS_WXO_T), DM, 0, scr, kb, nb, lane);
    else transpose_item(a.in[16], DM, a.in[15], (bf16_t*)(ws + WS_WPQ_T), DM, 0, scr, kb, nb, lane);
  }
  for (int r = gw; r < 2 * NEXP; r += ngw) {
    const int tb = r >= NEXP, e = r - tb * NEXP;
    const f32x4* src = (const f32x4*)(a.in[19 + tb] + (size_t)e * DM) + 4 * lane;
    f32x4 v[4]; float am = 0.f;
#pragma unroll
    for (int k = 0; k < 4; ++k) { v[k] = src[k]; am = fmaxf(am, fmaxf(fmaxf(fabsf(v[k].x), fabsf(v[k].y)), fmaxf(fabsf(v[k].z), fabsf(v[k].w)))); }
#pragma unroll
    for (int o = 1; o < 64; o <<= 1) am = fmaxf(am, __shfl_xor(am, o));
    const float sc = am > 0.f ? 440.f / am : 1.f;
    u32x4 o;
#pragma unroll
    for (int k = 0; k < 4; ++k) { int w = __builtin_amdgcn_cvt_pk_fp8_f32(v[k].x * sc, v[k].y * sc, 0, false); w = __builtin_amdgcn_cvt_pk_fp8_f32(v[k].z * sc, v[k].w * sc, w, true); o[k] = (unsigned)w; }
    *((u32x4*)(ws + (tb ? WS_EXU : WS_EXD) + (size_t)e * DM) + lane) = o;
    if (lane == 0) ((float*)(ws + WS_ESC))[r] = am > 0.f ? am / 440.f : 1.f;
  }
  for (int r = gw; r < NMROWS; r += ngw) rms_row_to_bf16(a.in[1] + (size_t)r * DM, (bf16_t*)(ws + WS_MEMN) + (size_t)r * DM, lane);
  __syncthreads();
  float* wf = (float*)(lds + 69632);
  for (int k = tid; k < DM; k += 512) {
    const float g = a.in[2][k]; const f32x4* wp = (const f32x4*)(a.in[3] + (size_t)k * INW + NQKV);
    const f32x4 p = wp[0], q = wp[1];
    f32x4* d = (f32x4*)(wf + k * 8); d[0] = p * g; d[1] = q * g;
  }
  __syncthreads();
  float* flog = (float*)(ws + WS_FLOG);
  for (int r = gw; r < NT; r += ngw) {
    const f32x4* xr = (const f32x4*)(a.in[0] + (size_t)r * DM) + lane;
    f32x4 v[4]; float s = 0.f; float fa[8];
#pragma unroll
    for (int j = 0; j < 8; ++j) fa[j] = 0.f;
#pragma unroll
    for (int j = 0; j < 4; ++j) {
      v[j] = xr[64 * j]; s += (v[j].x * v[j].x + v[j].y * v[j].y) + (v[j].z * v[j].z + v[j].w * v[j].w);
#pragma unroll
      for (int c = 0; c < 4; ++c) {
        const float xv = v[j][c]; const f32x4* wp = (const f32x4*)(wf + (256 * j + 4 * lane + c) * 8);
        const f32x4 p = wp[0], q = wp[1];
        fa[0] += xv * p.x; fa[1] += xv * p.y; fa[2] += xv * p.z; fa[3] += xv * p.w;
        fa[4] += xv * q.x; fa[5] += xv * q.y; fa[6] += xv * q.z; fa[7] += xv * q.w;
      }
    }
    const float rstd = rsqrtf(wave_sum(s) * (1.f / DM) + EPS);
    float mine = 0.f;
#pragma unroll
    for (int j = 0; j < 8; ++j) { const float t = wave_sum(fa[j]); if (lane == j) mine = t; }
    if (lane < 8) {
      const float z = mine * rstd + a.in[4][lane];
      flog[(size_t)r * 8 + lane] = fminf(z, 0.f) - log1pf(expf(-fabsf(z)));
    }
    u32x2* o = (u32x2*)((bf16_t*)(ws + WS_HB) + (size_t)r * DM) + lane;
#pragma unroll
    for (int j = 0; j < 4; ++j) { u32x2 w; w.x = pk2(v[j].x * rstd, v[j].y * rstd); w.y = pk2(v[j].z * rstd, v[j].w * rstd); o[64 * j] = w; }
  }
}

template <class Epi>
__device__ __forceinline__ void gemm_naive(const bf16_t* A, int lda, const bf16_t* Bt, int ldb, int M, int N, int K, const Epi& E, int gw, int ngw, int lane) {
  const int fr = lane & 15, fq = lane >> 4;
  const int tn = N / 64, ntile = (M / 64) * tn;
  for (int tile = gw; tile < ntile; tile += ngw) {
    const int pm = tile / tn, pn = tile % tn;
    f32x4 acc[4][4];
#pragma unroll
    for (int m = 0; m < 4; ++m)
#pragma unroll
      for (int n = 0; n < 4; ++n) acc[m][n] = (f32x4){0.f, 0.f, 0.f, 0.f};
    const bf16_t* Ap = A + (size_t)(pm * 64 + fr) * lda + fq * 8;
    const bf16_t* Bp = Bt + (size_t)(pn * 64 + fr) * ldb + fq * 8;
    for (int k0 = 0; k0 < K; k0 += 32) {
      bf16x8 af[4], bfr[4];
#pragma unroll
      for (int m = 0; m < 4; ++m) af[m] = *(const bf16x8*)(Ap + (size_t)m * 16 * lda + k0);
#pragma unroll
      for (int n = 0; n < 4; ++n) bfr[n] = *(const bf16x8*)(Bp + (size_t)n * 16 * ldb + k0);
#pragma unroll
      for (int m = 0; m < 4; ++m)
#pragma unroll
        for (int n = 0; n < 4; ++n) acc[m][n] = __builtin_amdgcn_mfma_f32_16x16x32_bf16(bfr[n], af[m], acc[m][n], 0, 0, 0);
    }
#pragma unroll
    for (int m = 0; m < 4; ++m)
#pragma unroll
      for (int n = 0; n < 4; ++n) E.store(pm * 64 + m * 16 + fr, pn * 64 + n * 16 + 4 * fq, acc[m][n]);
  }
}

struct EpiBf16 { bf16_t* O; int ldo;
  __device__ __forceinline__ void store(int row, int col, f32x4 v) const { u32x2 w; w.x = pk2(v.x, v.y); w.y = pk2(v.z, v.w); *(u32x2*)(O + (size_t)row * ldo + col) = w; } };
struct EpiQKV { bf16_t* O;
  __device__ __forceinline__ void store(int row, int col, f32x4 v) const { const float sc = (col < 512 || (col >= 1536 && col < 2048)) ? 0.18033688011112042f : 1.f;
    u32x2 w; w.x = pk2(v.x * sc, v.y * sc); w.y = pk2(v.z * sc, v.w * sc); *(u32x2*)(O + (size_t)row * NQKV + col) = w; } };
struct EpiBf16S { bf16_t* O; int ldo; const float* ss;
  __device__ __forceinline__ void store(int row, int col, f32x4 v) const { const float r = rsqrtf(ss[row] * (1.f / DM) + EPS); u32x2 w; w.x = pk2(v.x * r, v.y * r); w.y = pk2(v.z * r, v.w * r); *(u32x2*)(O + (size_t)row * ldo + col) = w; } };
struct EpiF32S { float* O; int ldo; const float* ss;
  __device__ __forceinline__ void store(int row, int col, f32x4 v) const { const float r = rsqrtf(ss[row] * (1.f / DM) + EPS); *(f32x4*)(O + (size_t)row * ldo + col) = v * r; } };
struct EpiF32 { float* O; int ldo;
  __device__ __forceinline__ void store(int row, int col, f32x4 v) const { *(f32x4*)(O + (size_t)row * ldo + col) = v; } };
struct EpiResid { const float* base; float* out;
  __device__ __forceinline__ void store(int row, int col, f32x4 v) const { const size_t o = (size_t)row * DM + col; const f32x4 b = *(const f32x4*)(base + o); *(f32x4*)(out + o) = b + v; } };
struct EpiKV { bf16_t* KX; bf16_t* VXT;
  __device__ __forceinline__ void store(int row, int col, f32x4 v) const {
    if (col < 1024) { u32x2 w; w.x = pk2(v.x, v.y); w.y = pk2(v.z, v.w); *(u32x2*)(KX + (size_t)row * DM + col) = w; }
    else { const int b = row >> 8, m = row & 255;
#pragma unroll
      for (int r = 0; r < 4; ++r) { const int d = col - 1024 + r; VXT[((size_t)(b * 4 + (d >> 8)) * 256 + (d & 255)) * 256 + m] = (bf16_t)f2bf(v[r]); } } } };

__device__ __forceinline__ void phase_scan(const Args& a, int gw, int ngw, int lane, int tid) {
  unsigned char* ws = a.ws;
  const float* flog = (const float*)(ws + WS_FLOG); float* cum = (float*)(ws + WS_CUM);
  for (int p = gw; p < 64; p += ngw) {
    const int b = p >> 3, j = p & 7;
    const float* src = flog + ((size_t)b * SEQ + lane * 64) * 8 + j;
    float tot = 0.f;
    for (int i = 0; i < 64; ++i) tot += src[i * 8];
    float inc = tot;
#pragma unroll
    for (int o = 1; o < 64; o <<= 1) { const float t = __shfl_up(inc, o); if (lane >= o) inc += t; }
    float run = inc - tot;
    float* dst = cum + ((size_t)(b * 8 + j)) * SEQ + lane * 64;
    for (int i = 0; i < 64; ++i) { run += src[i * 8]; dst[i] = run * 1.4426950408889634f; }
  }
  const bf16_t* qkv = (const bf16_t*)(ws + WS_QKV); float* kmean = (float*)(ws + WS_KMEAN);
  {
    unsigned* kn2 = (unsigned*)(ws + 256);
    for (int item = gw; item < 64 * 16; item += ngw) {
      const int bh = item >> 4, ch = item & 15, b = bh >> 3, h = bh & 7; float m = 0.f;
      for (int rr = 0; rr < 4; ++rr) {
        const u32x4* kp = (const u32x4*)(qkv + ((size_t)b * SEQ + ch * 256 + lane * 4 + rr) * NQKV + 2048 + h * 64); float s = 0.f;
#pragma unroll
        for (int c = 0; c < 8; ++c) { float f[8]; unpack8(kp[c], f);
#pragma unroll
          for (int i = 0; i < 8; ++i) s += f[i] * f[i]; }
        m = fmaxf(m, s);
      }
#pragma unroll
      for (int o = 1; o < 64; o <<= 1) m = fmaxf(m, __shfl_xor(m, o));
      if (lane == 0) atomicMax(kn2 + bh, __float_as_uint(m));
    }
  }
  const int gt = blockIdx.x * 512 + tid, ngt = gridDim.x * 512;
  for (int o = gt; o < NB * 16 * 512; o += ngt) {
    const int c = o & 511, blk = (o >> 9) & 15, b = o >> 13;
    const bf16_t* p = qkv + ((size_t)b * SEQ + blk * 256) * NQKV + 512 + c;
    float s = 0.f;
    for (int r = 0; r < 256; ++r) s += bf2f(p[(size_t)r * NQKV]);
    kmean[o] = s * (1.f / 256.f);
  }
}

template <int MODE>
__device__ __forceinline__ void attn_naive_unit(const Args& a, unsigned char* lds, int b, int h, int sb, int tid) {
  unsigned char* ws = a.ws;
  const bf16_t* qkv = (const bf16_t*)(ws + WS_QKV);
  const int qoff = MODE ? 1536 : 0, koff = qoff + 512, voff = qoff + 1024;
  float* Ks = (float*)lds; float* Vs = Ks + 64 * 64; float* ck = Vs + 64 * 64; float* biasd = ck + 64;
  const int t = sb * 512 + tid; const size_t row = (size_t)b * SEQ + t;
  float q[64], o[64];
  {
    const u32x4* qp = (const u32x4*)(qkv + row * NQKV + qoff + h * 64);
#pragma unroll
    for (int c = 0; c < 8; ++c) { const u32x4 w = qp[c]; unpack8(w, q + 8 * c); }
#pragma unroll
    for (int d = 0; d < 64; ++d) { q[d] *= 0.6931471805599453f; o[d] = 0.f; }
  }
  float m = -1e30f, l = 0.f;
  unsigned selmask = 0u; const int own = t >> 8;
  float cq = 0.f, bfar = 0.f;
  __syncthreads();
  if (MODE == 0) {
    if (tid < 128) biasd[tid] = a.in[5][T5_BUCKET[tid] * 8 + h];
    bfar = a.in[5][31 * 8 + h];
    const float* km = (const float*)(ws + WS_KMEAN) + ((size_t)b * 16) * 512 + h * 64;
    float v0 = -3e38f, v1 = -3e38f, v2 = -3e38f; int i0 = -1, i1 = -1, i2 = -1;
    for (int n = 0; n < 2 * sb + 1; ++n) {
      if (n < own) {
        const float* kp = km + (size_t)n * 512; float s = 0.f;
#pragma unroll
        for (int d = 0; d < 64; ++d) s += q[d] * kp[d];
        if (s > v0) { v2 = v1; i2 = i1; v1 = v0; i1 = i0; v0 = s; i0 = n; }
        else if (s > v1) { v2 = v1; i2 = i1; v1 = s; i1 = n; }
        else if (s > v2) { v2 = s; i2 = n; }
      }
    }
    if (i0 >= 0) selmask |= 1u << i0;
    if (i1 >= 0) selmask |= 1u << i1;
    if (i2 >= 0) selmask |= 1u << i2;
  } else {
    cq = ((const float*)(ws + WS_CUM))[((size_t)(b * 8 + h)) * SEQ + t];
  }
  const int ntile = 8 * (sb + 1);
  for (int kt = 0; kt < ntile; ++kt) {
    __syncthreads();
    {
      const int r = tid >> 3, ch = tid & 7;
      const bf16_t* kp = qkv + ((size_t)b * SEQ + kt * 64 + r) * NQKV + h * 64 + ch * 8;
      const u32x4 kw = *(const u32x4*)(kp + koff), vw = *(const u32x4*)(kp + voff);
      unpack8(kw, Ks + r * 64 + ch * 8); unpack8(vw, Vs + r * 64 + ch * 8);
      if (MODE == 1 && tid < 64) ck[tid] = ((const float*)(ws + WS_CUM))[((size_t)(b * 8 + h)) * SEQ + kt * 64 + tid];
    }
    __syncthreads();
    const int kb = kt >> 2;
    bool act;
    if (MODE == 0) act = (kb == own) || (kb < own && ((selmask >> kb) & 1u));
    else act = (kt * 64 <= t);
    if (act) {
      for (int jj = 0; jj < 64; ++jj) {
        const int sp = kt * 64 + jj;
        if (sp > t) break;
        const f32x4* kr = (const f32x4*)(Ks + jj * 64);
        float s = 0.f;
#pragma unroll
        for (int c = 0; c < 16; ++c) { const f32x4 kv = kr[c]; s += q[4 * c] * kv.x + q[4 * c + 1] * kv.y + q[4 * c + 2] * kv.z + q[4 * c + 3] * kv.w; }
        if (MODE == 0) { const int dist = t - sp; s += (dist < 128) ? biasd[dist] : bfar; }
        else s += (cq - ck[jj]) * 0.6931471805599453f;
        if (s > m) { const float f = __expf(m - s); l *= f;
#pragma unroll
          for (int d = 0; d < 64; ++d) o[d] *= f;
          m = s; }
        const float p = __expf(s - m); l += p;
        const f32x4* vr = (const f32x4*)(Vs + jj * 64);
#pragma unroll
        for (int c = 0; c < 16; ++c) { const f32x4 vv = vr[c]; o[4 * c] += p * vv.x; o[4 * c + 1] += p * vv.y; o[4 * c + 2] += p * vv.z; o[4 * c + 3] += p * vv.w; }
      }
    }
  }
  const float il = 1.f / l;
  u32x4* op = (u32x4*)((bf16_t*)(ws + WS_OAB) + row * DM + (MODE ? 512 : 0) + h * 64);
#pragma unroll
  for (int c = 0; c < 8; ++c) { u32x4 w; w.x = pk2(o[8 * c] * il, o[8 * c + 1] * il); w.y = pk2(o[8 * c + 2] * il, o[8 * c + 3] * il); w.z = pk2(o[8 * c + 4] * il, o[8 * c + 5] * il); w.w = pk2(o[8 * c + 6] * il, o[8 * c + 7] * il); op[c] = w; }
}

__device__ __forceinline__ void phase_attn(const Args& a, unsigned char* lds, int tid) {
  for (int u = blockIdx.x; u < 1024; u += gridDim.x) {
    const int sb = 7 - (u >> 7), r = u & 127, mode = r & 1, bh = r >> 1;
    if (mode == 0) attn_naive_unit<0>(a, lds, bh >> 3, bh & 7, sb, tid);
    else attn_naive_unit<1>(a, lds, bh >> 3, bh & 7, sb, tid);
  }
}

namespace att {
typedef float f32x16 __attribute__((ext_vector_type(16)));
typedef short s16x4 __attribute__((ext_vector_type(4)));
typedef short v4i16_t __attribute__((ext_vector_type(4)));
typedef __attribute__((address_space(3))) const char* lds_cptr;
typedef float f32x2_t __attribute__((ext_vector_type(2))); typedef __bf16 bf16x2_t __attribute__((ext_vector_type(2)));
constexpr int PITCH = NQKV;
constexpr float LOG2E = 1.4426950408889634f;
constexpr float C2 = 0.125f * LOG2E;
constexpr int L_K = 0, L_V = 16384, L_WSF = 32768, L_OST = 34816, L_C2 = 67584, L_KM = 83968, L_BT = 88064, L_MISC = 88704;
__device__ __forceinline__ int crow(int r, int hi) { return (r & 3) + 8 * (r >> 2) + 4 * hi; }
__device__ __forceinline__ unsigned cvtpk(float lo, float hi) { f32x2_t v = {lo, hi}; bf16x2_t b = __builtin_convertvector(v, bf16x2_t); return __builtin_bit_cast(unsigned, b); }
__device__ __forceinline__ s16x4 vtr(lds_cptr p) { return __builtin_bit_cast(s16x4, __builtin_amdgcn_ds_read_tr16_b64_v4i16((__attribute__((address_space(3))) v4i16_t*)p)); }
__device__ __forceinline__ float xhalf_max(float m) { auto rr = __builtin_amdgcn_permlane32_swap(__float_as_uint(m), __float_as_uint(m), false, false); return fmaxf(__uint_as_float(rr[0]), __uint_as_float(rr[1])); }
__device__ __forceinline__ float xhalf_sum(float m) { auto rr = __builtin_amdgcn_permlane32_swap(__float_as_uint(m), __float_as_uint(m), false, false); return __uint_as_float(rr[0]) + __uint_as_float(rr[1]); }

template <int MODE>
__device__ __forceinline__ void unit(const Args& a, unsigned char* lds, int b, int h, int qb, int tid) {
  unsigned char* ws = a.ws;
  const int lane = tid & 63, r32 = lane & 31, hi = lane >> 5; const int wid = __builtin_amdgcn_readfirstlane(tid >> 6);
  const bf16_t* qkv = (const bf16_t*)(ws + WS_QKV);
  const int qoff = MODE ? 1536 : 0;
  const size_t rowbase = (size_t)b * SEQ; const int q0 = qb * 256;
  const bf16_t* Qw = qkv + (rowbase + q0 + wid * 32) * PITCH + qoff + h * 64;
  const bf16_t* Kh = qkv + rowbase * PITCH + qoff + 512 + h * 64;
  const bf16_t* Vh = qkv + rowbase * PITCH + qoff + 1024 + h * 64;
  float* wsf = (float*)(lds + L_WSF) + wid * 64;
  float* c2s = (float*)(lds + L_C2); float* kms = (float*)(lds + L_KM); float* bts = (float*)(lds + L_BT); unsigned* misc = (unsigned*)(lds + L_MISC);
  const int NTL = 4 * (qb + 1);
  __syncthreads();
  if (MODE == 0) {
    const float* km = (const float*)(ws + WS_KMEAN) + (size_t)b * 16 * 512 + h * 64;
    for (int i = tid; i < 16 * 64; i += 512) kms[i] = km[(size_t)(i >> 6) * 512 + (i & 63)];
    if (tid < 128) bts[tid] = a.in[5][T5_BUCKET[tid] * 8 + h] * LOG2E;
    if (tid == 128) bts[128] = a.in[5][31 * 8 + h] * LOG2E;
  } else {
    const float* cg = (const float*)(ws + WS_CUM) + (size_t)(b * 8 + h) * SEQ;
    for (int i = tid; i < 256 * (qb + 1); i += 512) c2s[i] = cg[i];
    if (tid == 0) misc[0] = 0u;
  }
  bf16x8 qr[4];
#pragma unroll
  for (int d0 = 0; d0 < 4; ++d0) qr[d0] = *(const bf16x8*)(Qw + (size_t)r32 * PITCH + d0 * 16 + hi * 8);
  __syncthreads();
  unsigned selmask = 0u; float cq2 = 0.f, far2 = 0.f, mhat = -1e30f; int t0 = 0;
  if (MODE == 0) {
    far2 = bts[128];
    float v0 = -3e38f, v1 = -3e38f, v2 = -3e38f; int i0 = -1, i1 = -1, i2 = -1;
    for (int n = 0; n < qb; ++n) {
      float s = 0.f;
#pragma unroll
      for (int d0 = 0; d0 < 4; ++d0)
#pragma unroll
        for (int j = 0; j < 8; ++j) s += bf2f((unsigned short)qr[d0][j]) * kms[n * 64 + d0 * 16 + hi * 8 + j];
      s = xhalf_sum(s);
      if (s > v0) { v2 = v1; i2 = i1; v1 = v0; i1 = i0; v0 = s; i0 = n; }
      else if (s > v1) { v2 = v1; i2 = i1; v1 = s; i1 = n; }
      else if (s > v2) { v2 = s; i2 = n; }
    }
    if (i0 >= 0) selmask |= 1u << i0;
    if (i1 >= 0) selmask |= 1u << i1;
    if (i2 >= 0) selmask |= 1u << i2;
  } else {
    cq2 = c2s[q0 + wid * 32 + r32];
    float s = 0.f;
#pragma unroll
    for (int d0 = 0; d0 < 4; ++d0)
#pragma unroll
      for (int j = 0; j < 8; ++j) { const float f = bf2f((unsigned short)qr[d0][j]); s += f * f; }
    s = xhalf_sum(s);
    atomicMax(&misc[0], __float_as_uint(s));
    __syncthreads();
    const float kn2 = __uint_as_float(((const unsigned*)(ws + 256))[b * 8 + h]);
    const float qkb = sqrtf(__uint_as_float(misc[0]) * kn2) * 1.0001f + 1e-3f;
    mhat = -qkb;
    const int j = lane; bool skip = false;
    if (j < NTL) skip = (2.f * qkb + c2s[q0] - c2s[64 * j + 63]) < -150.f;
    t0 = __popcll(__ballot(skip));
    if (t0 > NTL - 1) t0 = NTL - 1;
  }
  const bf16_t* ksrc = Kh + (size_t)lane * PITCH + wid * 8;
  const bf16_t* vsrc = Vh + (size_t)(16 * (wid & 3) + (lane >> 2)) * PITCH + (wid >> 2) * 32 + (lane & 3) * 8;
  unsigned char* kdst = lds + L_K + wid * 1024 + lane * 16; unsigned char* vdst = lds + L_V + wid * 1024 + lane * 16;
  const lds_cptr lds3 = (lds_cptr)lds;
  const lds_cptr vp0 = lds3 + L_V + ((lane >> 4) & 1) * 32 + (lane & 3) * 8 + (4 * hi + ((lane & 15) >> 2)) * 64;
  u32x4 kreg = *(const u32x4*)(ksrc + (size_t)t0 * 64 * PITCH), vreg = *(const u32x4*)(vsrc + (size_t)t0 * 64 * PITCH);
  *(u32x4*)(kdst + (t0 & 1) * 8192) = kreg; *(u32x4*)(vdst + (t0 & 1) * 8192) = vreg;
  f32x16 o[2]; o[0] = f32x16{}; o[1] = f32x16{};
  float l = 0.f;
  const int qrel = wid * 32 + r32, qpos = q0 + qrel;
  __syncthreads();
  for (int t = t0; t < NTL; ++t) {
    const int buf = (t & 1) * 8192;
    if (t + 1 < NTL) { kreg = *(const u32x4*)(ksrc + (size_t)(t + 1) * 64 * PITCH); vreg = *(const u32x4*)(vsrc + (size_t)(t + 1) * 64 * PITCH); }
    const int jb = t - (NTL - 4);
    const bool compute = !(jb >= 0 && 64 * jb > wid * 32 + 31);
    if (compute) {
      f32x16 p0, p1;
      if (MODE == 0) {
        const int nb = t >> 2;
        const bool near = (jb >= 0) || (t >= NTL - 6 && wid < 4);
        if (near) {
#pragma unroll
          for (int r = 0; r < 16; ++r) { const int d = qpos - (64 * t + crow(r, hi));
            p0[r] = bts[min(max(d, 0), 128)]; p1[r] = bts[min(max(d - 32, 0), 128)]; }
        } else {
#pragma unroll
          for (int r = 0; r < 16; ++r) { p0[r] = far2; p1[r] = far2; }
        }
        if (jb < 0 && !((selmask >> nb) & 1u)) {
#pragma unroll
          for (int r = 0; r < 16; ++r) { p0[r] = -INFINITY; p1[r] = -INFINITY; }
        }
      } else {
#pragma unroll
        for (int g = 0; g < 4; ++g) {
          const f32x4 ca = *(const f32x4*)(c2s + 64 * t + 8 * g + 4 * hi), cb = *(const f32x4*)(c2s + 64 * t + 32 + 8 * g + 4 * hi);
#pragma unroll
          for (int i = 0; i < 4; ++i) { p0[4 * g + i] = cq2 - ca[i]; p1[4 * g + i] = cq2 - cb[i]; }
        }
      }
      {
        const lds_cptr kb = lds3 + L_K + buf + hi * 1024 + r32 * 16;
#pragma unroll
        for (int d0 = 0; d0 < 4; ++d0) {
          const bf16x8 b0 = *(const __attribute__((address_space(3))) bf16x8*)(kb + d0 * 2048);
          const bf16x8 b1 = *(const __attribute__((address_space(3))) bf16x8*)(kb + d0 * 2048 + 512);
          p0 = __builtin_amdgcn_mfma_f32_32x32x16_bf16(b0, qr[d0], p0, 0, 0, 0);
          p1 = __builtin_amdgcn_mfma_f32_32x32x16_bf16(b1, qr[d0], p1, 0, 0, 0);
        }
      }
      if (jb >= 0) {
        const int kb0 = 64 * jb + 4 * hi;
#pragma unroll
        for (int r = 0; r < 16; ++r) { const int kv = kb0 + (r & 3) + 8 * (r >> 2); if (kv > qrel) p0[r] = -INFINITY; if (kv + 32 > qrel) p1[r] = -INFINITY; }
      }
      float rm = fmaxf(p0[0], p1[0]);
#pragma unroll
      for (int r = 1; r < 16; ++r) rm = fmaxf(rm, fmaxf(p0[r], p1[r]));
      rm = xhalf_max(rm);
      const float mnew = fmaxf(mhat, rm);
      if (__any(mnew > mhat)) {
        const float alpha = __builtin_amdgcn_exp2f(mhat - mnew);
        l *= alpha; mhat = mnew;
        if (hi == 0) wsf[r32] = alpha;
        __builtin_amdgcn_wave_barrier();
#pragma unroll
        for (int r = 0; r < 16; ++r) { const float f = wsf[crow(r, hi)]; o[0][r] *= f; o[1][r] *= f; }
        __builtin_amdgcn_wave_barrier();
      }
      float sacc = 0.f;
#pragma unroll
      for (int r = 0; r < 16; ++r) { p0[r] = __builtin_amdgcn_exp2f(p0[r] - mhat); p1[r] = __builtin_amdgcn_exp2f(p1[r] - mhat); sacc += p0[r] + p1[r]; }
      l += sacc;
      u32x4 pw0, pw1, pw2, pw3;
      pw0 = (u32x4){cvtpk(p0[0], p0[1]), cvtpk(p0[2], p0[3]), cvtpk(p0[4], p0[5]), cvtpk(p0[6], p0[7])};
      pw1 = (u32x4){cvtpk(p0[8], p0[9]), cvtpk(p0[10], p0[11]), cvtpk(p0[12], p0[13]), cvtpk(p0[14], p0[15])};
      pw2 = (u32x4){cvtpk(p1[0], p1[1]), cvtpk(p1[2], p1[3]), cvtpk(p1[4], p1[5]), cvtpk(p1[6], p1[7])};
      pw3 = (u32x4){cvtpk(p1[8], p1[9]), cvtpk(p1[10], p1[11]), cvtpk(p1[12], p1[13]), cvtpk(p1[14], p1[15])};
      const lds_cptr vp = vp0 + buf;
#pragma unroll
      for (int d0 = 0; d0 < 2; ++d0) {
#define ATT_VF(ks) ({ const s16x4 lo_ = vtr(vp + d0 * 4096 + (ks) * 1024), hi_ = vtr(vp + d0 * 4096 + (ks) * 1024 + 512); (bf16x8){lo_[0], lo_[1], lo_[2], lo_[3], hi_[0], hi_[1], hi_[2], hi_[3]}; })
        o[d0] = __builtin_amdgcn_mfma_f32_32x32x16_bf16(__builtin_bit_cast(bf16x8, pw0), ATT_VF(0), o[d0], 0, 0, 0);
        o[d0] = __builtin_amdgcn_mfma_f32_32x32x16_bf16(__builtin_bit_cast(bf16x8, pw1), ATT_VF(1), o[d0], 0, 0, 0);
        o[d0] = __builtin_amdgcn_mfma_f32_32x32x16_bf16(__builtin_bit_cast(bf16x8, pw2), ATT_VF(2), o[d0], 0, 0, 0);
        o[d0] = __builtin_amdgcn_mfma_f32_32x32x16_bf16(__builtin_bit_cast(bf16x8, pw3), ATT_VF(3), o[d0], 0, 0, 0);
#undef ATT_VF
      }
    }
    if (t + 1 < NTL) { *(u32x4*)(kdst + ((t + 1) & 1) * 8192) = kreg; *(u32x4*)(vdst + ((t + 1) & 1) * 8192) = vreg; }
    __syncthreads();
  }
  l = xhalf_sum(l);
  if (hi == 0) wsf[32 + r32] = l;
  __builtin_amdgcn_wave_barrier();
  bf16_t* stg = (bf16_t*)(lds + L_OST) + wid * 2048;
#pragma unroll
  for (int r = 0; r < 16; ++r) { const int orow = crow(r, hi); const float rl = 1.f / wsf[32 + orow];
    stg[orow * 64 + r32] = (bf16_t)f2bf(o[0][r] * rl); stg[orow * 64 + 32 + r32] = (bf16_t)f2bf(o[1][r] * rl); }
  __builtin_amdgcn_wave_barrier();
  bf16_t* Ow = (bf16_t*)(ws + WS_OAB) + (rowbase + q0 + wid * 32) * DM + (MODE ? 512 : 0) + h * 64;
#pragma unroll
  for (int i = 0; i < 4; ++i) { const int row = i * 8 + (lane >> 3), ch = lane & 7; const u32x4 v = *(const u32x4*)(stg + row * 64 + ch * 8); *(u32x4*)(Ow + (size_t)row * DM + ch * 8) = v; }
}
}

__device__ __forceinline__ void phase_attn2(const Args& a, unsigned char* lds, int tid) {
  unsigned* ctr = (unsigned*)(a.ws + 0);
  unsigned* slot = (unsigned*)(lds + att::L_MISC + 64);
  for (;;) {
    __syncthreads();
    if (tid == 0) slot[0] = atomicAdd(ctr, 1u);
    __syncthreads();
    const unsigned u = slot[0];
    if (u >= 2048u) break;
    const int qb = 15 - (int)(u >> 7), r = u & 127, mode = r & 1, bh = r >> 1;
    if (mode == 0) att::unit<0>(a, lds, bh >> 3, bh & 7, qb, tid);
    else att::unit<1>(a, lds, bh >> 3, bh & 7, qb, tid);
  }
}

__device__ __forceinline__ void phase_onorm(const Args& a, int gw, int ngw, int lane) {
  bf16_t* oab = (bf16_t*)(a.ws + WS_OAB);
  for (int r = gw; r < NT; r += ngw) {
    u32x4* p = (u32x4*)(oab + (size_t)r * DM) + 2 * lane;
    const u32x4 w0 = p[0], w1 = p[1]; float f[16]; unpack8(w0, f); unpack8(w1, f + 8);
    float s = 0.f;
#pragma unroll
    for (int i = 0; i < 16; ++i) s += f[i] * f[i];
#pragma unroll
    for (int o = 1; o < 32; o <<= 1) s += __shfl_xor(s, o);
    const float rstd = rsqrtf(s * (1.f / 512.f) + EPS);
    u32x4 o0, o1;
    o0.x = pk2(f[0] * rstd, f[1] * rstd); o0.y = pk2(f[2] * rstd, f[3] * rstd); o0.z = pk2(f[4] * rstd, f[5] * rstd); o0.w = pk2(f[6] * rstd, f[7] * rstd);
    o1.x = pk2(f[8] * rstd, f[9] * rstd); o1.y = pk2(f[10] * rstd, f[11] * rstd); o1.z = pk2(f[12] * rstd, f[13] * rstd); o1.w = pk2(f[14] * rstd, f[15] * rstd);
    p[0] = o0; p[1] = o1;
  }
}

__device__ __forceinline__ void phase_rms(const Args& a, int gw, int ngw, int lane) {
  for (int r = gw; r < NT; r += ngw) rms_row_to_bf16(a.out + (size_t)r * DM, (bf16_t*)(a.ws + WS_HB) + (size_t)r * DM, lane);
}

__device__ __forceinline__ void phase_xattn(const Args& a, unsigned char* lds, int gw, int ngw, int wave, int lane) {
  unsigned char* ws = a.ws;
  const bf16_t* qx = (const bf16_t*)(ws + WS_QX); const bf16_t* kx = (const bf16_t*)(ws + WS_KX); const bf16_t* vxt = (const bf16_t*)(ws + WS_VXT);
  bf16_t* ox = (bf16_t*)(ws + WS_OX);
  bf16_t* P = (bf16_t*)(lds + wave * 8192);
  const int fr = lane & 15, fq = lane >> 4;
  for (int u = gw; u < (NT / 16) * 4; u += ngw) {
    const int hd = u & 3, r0 = (u >> 2) * 16, b = r0 / SEQ;
    f32x4 acc[16];
#pragma unroll
    for (int i = 0; i < 16; ++i) acc[i] = (f32x4){0.f, 0.f, 0.f, 0.f};
    const bf16_t* Ap = qx + (size_t)(r0 + fr) * DM + hd * 256 + fq * 8;
    const bf16_t* Bp = kx + (size_t)(b * 256 + fr) * DM + hd * 256 + fq * 8;
    for (int ks = 0; ks < 8; ++ks) {
      const bf16x8 af = *(const bf16x8*)(Ap + ks * 32);
#pragma unroll
      for (int ct = 0; ct < 16; ++ct) { const bf16x8 bfr = *(const bf16x8*)(Bp + (size_t)ct * 16 * DM + ks * 32); acc[ct] = __builtin_amdgcn_mfma_f32_16x16x32_bf16(af, bfr, acc[ct], 0, 0, 0); }
    }
    float mx[4], sm[4];
#pragma unroll
    for (int r = 0; r < 4; ++r) { float m = acc[0][r];
#pragma unroll
      for (int ct = 1; ct < 16; ++ct) m = fmaxf(m, acc[ct][r]);
#pragma unroll
      for (int o = 1; o < 16; o <<= 1) m = fmaxf(m, __shfl_xor(m, o));
      mx[r] = m; sm[r] = 0.f; }
#pragma unroll
    for (int ct = 0; ct < 16; ++ct)
#pragma unroll
      for (int r = 0; r < 4; ++r) { const float p = __expf((acc[ct][r] - mx[r]) * 0.0625f); acc[ct][r] = p; sm[r] += p; }
#pragma unroll
    for (int r = 0; r < 4; ++r) {
#pragma unroll
      for (int o = 1; o < 16; o <<= 1) sm[r] += __shfl_xor(sm[r], o);
      sm[r] = 1.f / sm[r]; }
    __builtin_amdgcn_wave_barrier();
#pragma unroll
    for (int ct = 0; ct < 16; ++ct)
#pragma unroll
      for (int r = 0; r < 4; ++r) P[(4 * fq + r) * 256 + ct * 16 + fr] = (bf16_t)f2bf(acc[ct][r] * sm[r]);
    __builtin_amdgcn_wave_barrier();
    asm volatile("s_waitcnt lgkmcnt(0)" ::: "memory");
#pragma unroll
    for (int i = 0; i < 16; ++i) acc[i] = (f32x4){0.f, 0.f, 0.f, 0.f};
    const bf16_t* Vp = vxt + ((size_t)(b * 4 + hd) * 256 + fr) * 256 + fq * 8;
    for (int ks = 0; ks < 8; ++ks) {
      const bf16x8 pf = *(const bf16x8*)(P + fr * 256 + ks * 32 + fq * 8);
#pragma unroll
      for (int dt = 0; dt < 16; ++dt) { const bf16x8 vf = *(const bf16x8*)(Vp + (size_t)dt * 16 * 256 + ks * 32); acc[dt] = __builtin_amdgcn_mfma_f32_16x16x32_bf16(pf, vf, acc[dt], 0, 0, 0); }
    }
#pragma unroll
    for (int dt = 0; dt < 16; ++dt)
#pragma unroll
      for (int r = 0; r < 4; ++r) ox[(size_t)(r0 + 4 * fq + r) * DM + hd * 256 + dt * 16 + fr] = (bf16_t)f2bf(acc[dt][r]);
    __builtin_amdgcn_wave_barrier();
  }
}

__device__ __forceinline__ unsigned fkey(float s, unsigned idx, unsigned mask) { unsigned u = __float_as_uint(s); u ^= (unsigned)((int)u >> 31) | 0x80000000u; return (u & ~mask) | (mask - idx); }
__device__ __forceinline__ float keyval(unsigned k, unsigned mask) { unsigned u = k & ~mask; u = (u & 0x80000000u) ? (u ^ 0x80000000u) : ~u; return __uint_as_float(u); }
#define KEY_INSERT(KA, key_) do { unsigned k__ = (key_); \
  _Pragma("unroll") for (int s_ = 0; s_ < 16; ++s_) { const unsigned hi_ = max(k__, KA[s_]); k__ = min(k__, KA[s_]); KA[s_] = hi_; } } while (0)

__device__ __forceinline__ void phase_topk(const Args& a, unsigned char* lds, int tid) {
  unsigned char* ws = a.ws;
  const float* pq = (const float*)(ws + WS_PQ);
  int* eidx = (int*)(ws + WS_EIDX); float* gate = (float*)(ws + WS_GATE);
  float* K1 = (float*)lds; float* K2 = K1 + 128 * 64; unsigned* KL = (unsigned*)(lds + 65536);
  for (int u = blockIdx.x; u < 8 * (NT / 512); u += gridDim.x) {
    const int h = u & 7, t = (u >> 3) * 512 + tid;
    __syncthreads();
    for (int i = tid; i < 128 * 64 / 4; i += 512) { ((f32x4*)K1)[i] = ((const f32x4*)(a.in[17] + (size_t)h * 8192))[i]; ((f32x4*)K2)[i] = ((const f32x4*)(a.in[18] + (size_t)h * 8192))[i]; }
    __syncthreads();
    unsigned ka[16], kb[16], kc[16];
#pragma unroll
    for (int k = 0; k < 16; ++k) { ka[k] = 0u; kb[k] = 0u; kc[k] = 0u; }
    float q[64];
    const f32x4* qp = (const f32x4*)(pq + (size_t)t * DM + h * 128);
#pragma unroll
    for (int c = 0; c < 16; ++c) { const f32x4 w = qp[c]; q[4 * c] = w.x; q[4 * c + 1] = w.y; q[4 * c + 2] = w.z; q[4 * c + 3] = w.w; }
    for (int n = 0; n < 128; ++n) {
      const f32x4* kr = (const f32x4*)(K1 + n * 64); float s = 0.f;
#pragma unroll
      for (int c = 0; c < 16; ++c) { const f32x4 kv = kr[c]; s += q[4 * c] * kv.x + q[4 * c + 1] * kv.y + q[4 * c + 2] * kv.z + q[4 * c + 3] * kv.w; }
      KEY_INSERT(ka, fkey(s, (unsigned)n, 127u));
    }
#pragma unroll
    for (int c = 0; c < 16; ++c) { const f32x4 w = qp[16 + c]; q[4 * c] = w.x; q[4 * c + 1] = w.y; q[4 * c + 2] = w.z; q[4 * c + 3] = w.w; }
    for (int n = 0; n < 128; ++n) {
      const f32x4* kr = (const f32x4*)(K2 + n * 64); float s = 0.f;
#pragma unroll
      for (int c = 0; c < 16; ++c) { const f32x4 kv = kr[c]; s += q[4 * c] * kv.x + q[4 * c + 1] * kv.y + q[4 * c + 2] * kv.z + q[4 * c + 3] * kv.w; }
      KEY_INSERT(kb, fkey(s, (unsigned)n, 127u));
    }
#pragma unroll
    for (int x = 0; x < 16; ++x)
#pragma unroll
      for (int y = 0; y < 16; ++y)
        if ((x + 1) * (y + 1) <= 16) { KEY_INSERT(kc, fkey(keyval(ka[x], 127u) + keyval(kb[y], 127u), (unsigned)(x * 16 + y), 255u)); }
#pragma unroll
    for (int k = 0; k < 16; ++k) { KL[k * 512 + tid] = ka[k]; KL[(16 + k) * 512 + tid] = kb[k]; }
    float val[16]; int id[16]; float sum = 0.f;
#pragma unroll
    for (int k = 0; k < 16; ++k) {
      const unsigned flat = 255u - (kc[k] & 255u);
      const unsigned k1 = KL[(flat >> 4) * 512 + tid], k2 = KL[(16 + (flat & 15u)) * 512 + tid];
      val[k] = keyval(k1, 127u) + keyval(k2, 127u);
      id[k] = (int)((127u - (k1 & 127u)) * 128u + (127u - (k2 & 127u)));
    }
    const float vmax = val[0];
#pragma unroll
    for (int k = 0; k < 16; ++k) { val[k] = __expf(val[k] - vmax); sum += val[k]; }
    const float inv = 1.f / sum;
    int* ep = eidx + (size_t)t * 128 + h * 16; float* gp = gate + (size_t)t * 128 + h * 16;
#pragma unroll
    for (int k = 0; k < 16; ++k) { ep[k] = id[k]; gp[k] = val[k] * inv; }
  }
}

__device__ __forceinline__ float gelu_erf(float v) { return 0.5f * v * (1.f + erff(v * 0.70710678118654752f)); }

__device__ __forceinline__ void phase_experts(const Args& a, int gw, int ngw, int lane, float* outp) {
  unsigned char* ws = a.ws;
  const int* eidx = (const int*)(ws + WS_EIDX); const float* gate = (const float*)(ws + WS_GATE);
  const unsigned char* exd = ws + WS_EXD; const unsigned char* exu = ws + WS_EXU; const float* esc = (const float*)(ws + WS_ESC);
  for (int t = gw; t < NT; t += ngw) {
    const f32x4* xr = (const f32x4*)(a.out + (size_t)t * DM) + 4 * lane;
    f32x4 x[4], acc[4]; float hg[16]; float s = 0.f;
#pragma unroll
    for (int k = 0; k < 4; ++k) { x[k] = xr[k]; s += (x[k].x * x[k].x + x[k].y * x[k].y) + (x[k].z * x[k].z + x[k].w * x[k].w); acc[k] = (f32x4){0.f, 0.f, 0.f, 0.f}; }
    const float rstd = rsqrtf(wave_sum(s) * (1.f / DM) + EPS);
#pragma unroll
    for (int k = 0; k < 4; ++k) { const f32x4 g = ((const f32x4*)a.in[15])[4 * lane + k]; const f32x4 hv = x[k] * rstd * g; hg[4 * k] = hv.x; hg[4 * k + 1] = hv.y; hg[4 * k + 2] = hv.z; hg[4 * k + 3] = hv.w; }
    const int e0 = eidx[(size_t)t * 128 + lane], e1 = eidx[(size_t)t * 128 + 64 + lane];
    const float sd0 = esc[e0], sd1 = esc[e1];
    const float gu0 = gate[(size_t)t * 128 + lane] * esc[NEXP + e0], gu1 = gate[(size_t)t * 128 + 64 + lane] * esc[NEXP + e1];
    for (int e = 0; e < 128; e += 8) {
      u32x4 ur[8], vr[8]; float dot[8];
#pragma unroll
      for (int i = 0; i < 8; ++i) {
        const int ee = e + i; const int id = (e < 64) ? __shfl(e0, ee) : __shfl(e1, ee - 64);
        ur[i] = *((const u32x4*)(exd + (size_t)id * DM) + lane);
        vr[i] = *((const u32x4*)(exu + (size_t)id * DM) + lane);
      }
#pragma unroll
      for (int i = 0; i < 8; ++i) {
        float d = 0.f;
#pragma unroll
        for (int k = 0; k < 4; ++k) { const auto lo = __builtin_amdgcn_cvt_pk_f32_fp8((int)ur[i][k], false); const auto hi = __builtin_amdgcn_cvt_pk_f32_fp8((int)ur[i][k], true);
          d += hg[4 * k] * lo[0] + hg[4 * k + 1] * lo[1] + hg[4 * k + 2] * hi[0] + hg[4 * k + 3] * hi[1]; }
        dot[i] = wave_sum(d);
      }
#pragma unroll
      for (int i = 0; i < 8; ++i) {
        const int ee = e + i;
        const float sd = (e < 64) ? __shfl(sd0, ee) : __shfl(sd1, ee - 64);
        const float gu = (e < 64) ? __shfl(gu0, ee) : __shfl(gu1, ee - 64);
        const float w = gu * gelu_erf(dot[i] * sd);
#pragma unroll
        for (int k = 0; k < 4; ++k) { const auto lo = __builtin_amdgcn_cvt_pk_f32_fp8((int)vr[i][k], false); const auto hi = __builtin_amdgcn_cvt_pk_f32_fp8((int)vr[i][k], true);
          acc[k].x += w * lo[0]; acc[k].y += w * lo[1]; acc[k].z += w * hi[0]; acc[k].w += w * hi[1]; }
      }
    }
    float s2 = 0.f;
#pragma unroll
    for (int k = 0; k < 4; ++k) { x[k] = x[k] + acc[k]; s2 += (x[k].x * x[k].x + x[k].y * x[k].y) + (x[k].z * x[k].z + x[k].w * x[k].w); }
    const float r2 = rsqrtf(wave_sum(s2) * (1.f / DM) + EPS);
    f32x4* orow = (f32x4*)(outp + (size_t)t * DM) + 4 * lane;
#pragma unroll
    for (int k = 0; k < 4; ++k) { const f32x4 g = ((const f32x4*)a.in[21])[4 * lane + k]; orow[k] = x[k] * r2 * g; }
  }
}

namespace pg8 {
#define PG8_LAS __attribute__((address_space(3)))
typedef unsigned short bf16_t;
typedef short bf16x8 __attribute__((ext_vector_type(8)));
typedef float f32x4 __attribute__((ext_vector_type(4)));
typedef unsigned u32x4 __attribute__((ext_vector_type(4)));
constexpr int BM = 256, BK = 64, HALF = 128, HTB = HALF * BK * 2  , STAGE_BYTES = 8 * HTB, NXCD = 8, WGM = 8;

__host__ __device__ __forceinline__ int lds_byte(int r, int c) { const int st = (r >> 4) * 2 + (c >> 5), rr = r & 15, cc = c & 31, ob = rr * 64 + cc * 2; return st * 1024 + (ob ^ (((ob >> 9) & 1) << 5)); }
__host__ __device__ __forceinline__ void stage_rc(int b, int& R, int& C) { const int st = b / 1024, sb = b % 1024, swz = sb ^ (((sb >> 9) & 1) << 5); R = (st >> 1) * 16 + swz / 64; C = (st & 1) * 32 + (swz % 64) / 2; }
__host__ __device__ __forceinline__ int perm32(int rho) { const int n = rho >> 4, i = rho & 15; return 8 * (i >> 2) + 4 * n + (i & 3); }

struct Unit { int pm, pn; };
struct Gemm { const bf16_t* A; const bf16_t* Bt; int M, N, K; };

struct StaticOrder {
    int nM, nN, nwg, G, c;
    __host__ __device__ void init(int M, int N, int G_, int c_) { nM = M / BM; nN = N / BM; nwg = nM * nN; G = G_; c = c_; }
    __host__ __device__ bool next(int i, Unit& u) const {
        const long L = (long)i * G + c; if (L >= nwg) return false;
        int wgid = (int)L; { const int q = nwg / NXCD, r = nwg % NXCD, xcd = wgid % NXCD, off = wgid / NXCD; wgid = (xcd < r ? xcd * (q + 1) : r * (q + 1) + (xcd - r) * q) + off; }
        const int nig = WGM * nN, gid = wgid / nig, fm = gid * WGM, gsz = (nM - fm) < WGM ? (nM - fm) : WGM;
        u.pm = fm + ((wgid % nig) % gsz); u.pn = (wgid % nig) / gsz; return true;
    }
    __device__ __forceinline__ void a_ready(const Unit&) const {}
    __device__ __forceinline__ void done(const Unit&) const {}
};

template <class St> struct EpiAdapt {
    static constexpr bool PERM = false, AFTER_DRAIN = false; St st;
    __device__ __forceinline__ void operator()(const f32x4 (&acc)[2][2][4][2], const Unit& u, int wr, int wc, int fr, int fq) const {
#pragma unroll
        for (int ai = 0; ai < 2; ++ai)
#pragma unroll
            for (int m = 0; m < 4; ++m)
#pragma unroll
                for (int bj = 0; bj < 2; ++bj)
#pragma unroll
                    for (int n = 0; n < 2; ++n) st.store(u.pm * BM + ai * HALF + wr * 64 + m * 16 + fr, u.pn * BM + bj * HALF + wc * 32 + n * 16 + 4 * fq, acc[ai][bj][m][n]);
    }
};

struct EpiResidSS {
    static constexpr bool PERM = false, AFTER_DRAIN = false; const float* base; float* out; bf16_t* hb; float* ss;
    __device__ __forceinline__ void operator()(const f32x4 (&acc)[2][2][4][2], const Unit& u, int wr, int wc, int fr, int fq) const {
#pragma unroll
        for (int ai = 0; ai < 2; ++ai)
#pragma unroll
            for (int m = 0; m < 4; ++m) {
                const int row = u.pm * BM + ai * HALF + wr * 64 + m * 16 + fr; float s = 0.f;
#pragma unroll
                for (int bj = 0; bj < 2; ++bj)
#pragma unroll
                    for (int n = 0; n < 2; ++n) {
                        const size_t o = (size_t)row * 1024 + u.pn * BM + bj * HALF + wc * 32 + n * 16 + 4 * fq;
                        const f32x4 v = *(const f32x4*)(base + o) + acc[ai][bj][m][n];
                        *(f32x4*)(out + o) = v;
                        typedef unsigned u32x2v __attribute__((ext_vector_type(2)));
                        { const float f0 = v.x, f1 = v.y, f2 = v.z, f3 = v.w; *(u32x2v*)(hb + o) = (u32x2v){::pk2(f0, f1), ::pk2(f2, f3)}; }
                        s += (v.x * v.x + v.y * v.y) + (v.z * v.z + v.w * v.w);
                    }
                s += __shfl_xor(s, 16); s += __shfl_xor(s, 32);
                if (fq == 0) atomicAdd(ss + row, s);
            }
    }
};
template <class Epi, class Sched, bool ALIGN_EPI = false, bool SP2 = false>
__device__ __forceinline__ void gemm_phase(PG8_LAS unsigned char* lds, const Gemm g, const Sched& S, const Epi& E) {
    const int tid = threadIdx.x, wid = __builtin_amdgcn_readfirstlane(tid >> 6), lane = tid & 63, wr = wid >> 2, wc = wid & 3, fr = lane & 15, fq = lane >> 4;
    const int K = g.K, nt = K / BK;
    unsigned voffA[2], voffB[2];
#pragma unroll
    for (int i = 0; i < 2; ++i) { int R, C; stage_rc(tid * 16 + i * 8192, R, C); const int Rb = Epi::PERM ? ((R & ~31) + perm32(R & 31)) : R;
        voffA[i] = (unsigned)(R * K + C) * 2u; voffB[i] = (unsigned)(Rb * K + C) * 2u; }
    const size_t kstep = (size_t)(BK * 2);
    const size_t hstep = (size_t)HALF * K * 2;
    const size_t tstep = 2 * hstep;
    const unsigned ldsw = (unsigned)wid * 1024u;
    const int aoff = lds_byte(wr * 64 + fr, fq * 8), boff = lds_byte(wc * 32 + fr, fq * 8);
#define PG8_SA(b, h) (((b) * 2 + (h)) * HTB)
#define PG8_SB(b, h) ((4 + (b) * 2 + (h)) * HTB)
#define PG8_STAGE(bufoff, gbase, voff) do { _Pragma("unroll") for (int _i = 0; _i < 2; ++_i) \
        __builtin_amdgcn_global_load_lds((const unsigned*)((const char*)(gbase) + (voff)[_i]), (PG8_LAS unsigned*)(lds + (bufoff) + ldsw + _i * 8192), 16, 0, 0); } while (0)
#define PG8_LDA(dst, b, h) do { _Pragma("unroll") for (int m = 0; m < 4; ++m) _Pragma("unroll") for (int k = 0; k < 2; ++k) dst[m][k] = *(const PG8_LAS bf16x8*)(lds + PG8_SA(b, h) + aoff + m * 2048 + k * 1024); } while (0)
#define PG8_LDB(dst, b, h) do { _Pragma("unroll") for (int n = 0; n < 2; ++n) _Pragma("unroll") for (int k = 0; k < 2; ++k) dst[n][k] = *(const PG8_LAS bf16x8*)(lds + PG8_SB(b, h) + boff + n * 2048 + k * 1024); } while (0)
#define PG8_MMA(ai, bj, At, Bt) do { __builtin_amdgcn_s_setprio(1); _Pragma("unroll") for (int m = 0; m < 4; ++m) _Pragma("unroll") for (int n = 0; n < 2; ++n) _Pragma("unroll") for (int k = 0; k < 2; ++k) \
        acc[ai][bj][m][n] = __builtin_amdgcn_mfma_f32_16x16x32_bf16(Bt[n][k], At[m][k], acc[ai][bj][m][n], 0, 0, 0); __builtin_amdgcn_s_setprio(0); } while (0)
#define PG8_WAIT_V(n) asm volatile("s_waitcnt vmcnt(" #n ")" ::: "memory")
#define PG8_WAIT_L(n) asm volatile("s_waitcnt lgkmcnt(" #n ")" ::: "memory")
#define PG8_BAR __builtin_amdgcn_s_barrier()
#define PG8_SCHED __builtin_amdgcn_sched_barrier(0)
    Unit cur, nxt; int ui = 0;
    if (!S.next(0, cur)) return;
    f32x4 acc[2][2][4][2];
#pragma unroll
    for (int a = 0; a < 2; ++a)
#pragma unroll
        for (int b = 0; b < 2; ++b)
#pragma unroll
            for (int m = 0; m < 4; ++m)
#pragma unroll
                for (int n = 0; n < 2; ++n) acc[a][b][m][n] = (f32x4){0.f, 0.f, 0.f, 0.f};
    bf16x8 At[4][2], B0[2][2], B1[2][2];
    const char* cA = (const char*)g.A + (size_t)cur.pm * tstep; const char* cB = (const char*)g.Bt + (size_t)cur.pn * tstep;
    S.a_ready(cur);
    if constexpr (SP2) {
        PG8_STAGE(PG8_SB(0, 0), cB, voffB); PG8_STAGE(PG8_SB(0, 1), cB + hstep, voffB); PG8_STAGE(PG8_SA(0, 0), cA, voffA); PG8_STAGE(PG8_SA(0, 1), cA + hstep, voffA);
        if (wr == 1) PG8_BAR;
        PG8_WAIT_V(2); PG8_BAR;
        PG8_STAGE(PG8_SB(1, 0), cB + kstep, voffB); PG8_STAGE(PG8_SA(1, 0), cA + kstep, voffA); PG8_STAGE(PG8_SB(1, 1), cB + hstep + kstep, voffB);
        PG8_WAIT_V(6); PG8_BAR;
    } else {
        PG8_STAGE(PG8_SB(0, 0), cB, voffB); PG8_STAGE(PG8_SA(0, 0), cA, voffA); PG8_STAGE(PG8_SB(0, 1), cB + hstep, voffB); PG8_STAGE(PG8_SA(0, 1), cA + hstep, voffA);
        if (wr == 1) PG8_BAR;
        PG8_WAIT_V(4); PG8_BAR;
        PG8_STAGE(PG8_SB(1, 0), cB + kstep, voffB); PG8_STAGE(PG8_SA(1, 0), cA + kstep, voffA); PG8_STAGE(PG8_SB(1, 1), cB + hstep + kstep, voffB);
        PG8_WAIT_V(6); PG8_BAR;
    }
    for (;;) {
        const bool has_next = S.next(ui + 1, nxt);
        const char* nA = has_next ? (const char*)g.A + (size_t)nxt.pm * tstep : cA; const char* nB = has_next ? (const char*)g.Bt + (size_t)nxt.pn * tstep : cB;
        for (int t = 0; t < nt; t += 2) {
            const bool last = (t == nt - 2);
            const char* a1 = cA + (size_t)(t + 1) * kstep;
            const char* a2 = last ? nA : cA + (size_t)(t + 2) * kstep; const char* b2 = last ? nB : cB + (size_t)(t + 2) * kstep;
            const char* a3 = a2 + kstep; const char* b3 = b2 + kstep;
            if (last && has_next) S.a_ready(nxt);
            if constexpr (SP2) {
            PG8_LDB(B0, 0, 0); PG8_LDB(B1, 0, 1); PG8_SCHED; PG8_LDA(At, 0, 0); PG8_STAGE(PG8_SA(1, 1), a1 + hstep, voffA);
            PG8_WAIT_V(8); PG8_WAIT_L(0); PG8_BAR; PG8_MMA(0, 0, At, B0); PG8_MMA(0, 1, At, B1); PG8_BAR; PG8_SCHED;
            PG8_LDA(At, 0, 1); PG8_STAGE(PG8_SB(0, 0), b2, voffB); PG8_STAGE(PG8_SB(0, 1), b2 + hstep, voffB); PG8_STAGE(PG8_SA(0, 0), a2, voffA);
            PG8_WAIT_V(8); PG8_WAIT_L(0); PG8_BAR; PG8_MMA(1, 0, At, B0); PG8_MMA(1, 1, At, B1); PG8_BAR; PG8_SCHED;
            PG8_LDB(B0, 1, 0); PG8_LDB(B1, 1, 1); PG8_SCHED; PG8_LDA(At, 1, 0); PG8_STAGE(PG8_SA(0, 1), a2 + hstep, voffA);
            PG8_WAIT_V(8); PG8_WAIT_L(0); PG8_BAR; PG8_MMA(0, 0, At, B0); PG8_MMA(0, 1, At, B1); PG8_BAR; PG8_SCHED;
            PG8_LDA(At, 1, 1); PG8_STAGE(PG8_SB(1, 0), b3, voffB); PG8_STAGE(PG8_SB(1, 1), b3 + hstep, voffB); PG8_STAGE(PG8_SA(1, 0), a3, voffA);
            PG8_WAIT_V(8); PG8_WAIT_L(0); PG8_BAR; PG8_MMA(1, 0, At, B0); PG8_MMA(1, 1, At, B1); PG8_BAR; PG8_SCHED;
            } else {
            PG8_LDB(B0, 0, 0); PG8_SCHED; PG8_LDA(At, 0, 0); PG8_STAGE(PG8_SA(1, 1), a1 + hstep, voffA);
            PG8_WAIT_L(8); PG8_BAR; PG8_WAIT_L(0); PG8_MMA(0, 0, At, B0); PG8_BAR; PG8_SCHED;
            PG8_LDB(B1, 0, 1); PG8_STAGE(PG8_SB(0, 0), b2, voffB);
            PG8_BAR; PG8_WAIT_L(0); PG8_MMA(0, 1, At, B1); PG8_BAR;
            PG8_LDA(At, 0, 1); PG8_STAGE(PG8_SA(0, 0), a2, voffA);
            PG8_BAR; PG8_WAIT_L(0); PG8_MMA(1, 0, At, B0); PG8_BAR; PG8_SCHED;
            PG8_STAGE(PG8_SB(0, 1), b2 + hstep, voffB);
            PG8_WAIT_V(6); PG8_BAR; PG8_MMA(1, 1, At, B1); PG8_BAR;
            PG8_LDB(B0, 1, 0); PG8_SCHED; PG8_LDA(At, 1, 0); PG8_STAGE(PG8_SA(0, 1), a2 + hstep, voffA);
            PG8_WAIT_L(8); PG8_BAR; PG8_WAIT_L(0); PG8_MMA(0, 0, At, B0); PG8_BAR; PG8_SCHED;
            PG8_LDB(B1, 1, 1); PG8_STAGE(PG8_SB(1, 0), b3, voffB);
            PG8_BAR; PG8_WAIT_L(0); PG8_MMA(0, 1, At, B1); PG8_BAR;
            PG8_LDA(At, 1, 1); PG8_STAGE(PG8_SA(1, 0), a3, voffA);
            PG8_BAR; PG8_WAIT_L(0); PG8_MMA(1, 0, At, B0); PG8_BAR; PG8_SCHED;
            PG8_STAGE(PG8_SB(1, 1), b3 + hstep, voffB);
            PG8_WAIT_V(6); PG8_BAR; PG8_MMA(1, 1, At, B1); PG8_BAR;
            }
        }
        if constexpr (ALIGN_EPI) { if (wr == 0) PG8_BAR; }
        if constexpr (!Epi::AFTER_DRAIN) { E(acc, cur, wr, wc, fr, fq); S.done(cur); }
        if (!has_next) break;
#pragma unroll
        for (int a = 0; a < 2; ++a)
#pragma unroll
            for (int b = 0; b < 2; ++b)
#pragma unroll
                for (int m = 0; m < 4; ++m)
#pragma unroll
                    for (int n = 0; n < 2; ++n) acc[a][b][m][n] = (f32x4){0.f, 0.f, 0.f, 0.f};
        cur = nxt; cA = nA; cB = nB; ++ui;
        if constexpr (ALIGN_EPI) { if (wr == 1) PG8_BAR; }
    }
    PG8_WAIT_V(0);
    if constexpr (!ALIGN_EPI) { if (wr == 0) PG8_BAR; }
    PG8_BAR;
    if constexpr (Epi::AFTER_DRAIN) { E.fused(acc, cur, wr, wc, fr, fq, lds, wid, lane); S.done(cur); }
#undef PG8_SA
#undef PG8_SB
#undef PG8_STAGE
#undef PG8_LDA
#undef PG8_LDB
#undef PG8_MMA
#undef PG8_WAIT_V
#undef PG8_WAIT_L
#undef PG8_BAR
#undef PG8_SCHED
}
}


template <class Epi>
__device__ __forceinline__ void run_gemm_raw(unsigned char* lds, const bf16_t* A, const bf16_t* Bt, int M, int N, int K, const Epi& E) {
  pg8::Gemm g{A, Bt, M, N, K}; pg8::StaticOrder S; S.init(M, N, (int)gridDim.x, (int)blockIdx.x);
  pg8::gemm_phase<Epi, pg8::StaticOrder, true, true>((PG8_LAS unsigned char*)lds, g, S, E);
}
template <class St>
__device__ __forceinline__ void run_gemm(unsigned char* lds, const bf16_t* A, const bf16_t* Bt, int M, int N, int K, const St& st, int gw, int ngw, int lane) {
#if USE_PG8
  pg8::Gemm g{A, Bt, M, N, K}; pg8::StaticOrder S; S.init(M, N, (int)gridDim.x, (int)blockIdx.x);
  pg8::EpiAdapt<St> E{st};
  pg8::gemm_phase<pg8::EpiAdapt<St>, pg8::StaticOrder, true, true>((PG8_LAS unsigned char*)lds, g, S, E);
#else
  gemm_naive(A, K, Bt, K, M, N, K, st, gw, ngw, lane);
#endif
}

#define GAS __attribute__((address_space(1)))
#define LAS __attribute__((address_space(3)))
#define XB_TMO      128
#define XB_XCNT(j)  (256  + 64 * (j))
#define XB_XSUB(j)  (1280 + 64 * (j))
#define XB_XGEN(j)  (2304 + 64 * (j))
#define XB_TOP      3328
#define XB_TOPGEN   3392
#define XCD_BAR_WORDS 3456
#define XB_SPIN_CAP (1u << 18)

__device__ __forceinline__ unsigned xb_ld(unsigned* p)              { return __hip_atomic_load(p, __ATOMIC_RELAXED, __HIP_MEMORY_SCOPE_AGENT); }
__device__ __forceinline__ unsigned xb_add(unsigned* p, unsigned v) { return __hip_atomic_fetch_add(p, v, __ATOMIC_RELAXED, __HIP_MEMORY_SCOPE_AGENT); }
__device__ __forceinline__ unsigned xb_xcc_id() { return (unsigned)__builtin_amdgcn_s_getreg((3 << 11) | 20) & 0xFu; }
#define XB_SPIN(cond, bar) do { unsigned _sp = 0; while (cond) { __builtin_amdgcn_s_sleep(1); \
    if ((++_sp & 255u) == 0u) { if (xb_ld(&(bar)[XB_TMO])) break; if (_sp > XB_SPIN_CAP) { atomicAdd(&(bar)[XB_TMO], 1u); break; } } } } while (0)

struct XcdBarrier {
    unsigned* bar; unsigned x;
    volatile LAS unsigned* st;
};

__device__ __forceinline__ XcdBarrier xcd_barrier_post(unsigned* bar, volatile LAS unsigned* st) {
    XcdBarrier b; b.bar = bar; b.x = xb_xcc_id(); b.st = st;
    if (threadIdx.x == 0) (void)xb_add(&bar[XB_XCNT(b.x)], 1u);
    return b;
}
__device__ __forceinline__ void xcd_barrier_complete(unsigned* bar, unsigned x, unsigned& nloc, unsigned& nx) {
    const unsigned G = gridDim.x * gridDim.y * gridDim.z;
    unsigned sum, cnt, mine, sp = 0u;
    for (;;) {
        sum = 0u; cnt = 0u; mine = 0u;
#pragma unroll
        for (unsigned j = 0; j < 16; ++j) { const unsigned c = xb_ld(&bar[XB_XCNT(j)]); sum += c; cnt += (c > 0u) ? 1u : 0u; mine = (j == x) ? c : mine; }
        if (sum == G) break;
        __builtin_amdgcn_s_sleep(1);
        if ((++sp & 255u) == 0u) { if (xb_ld(&bar[XB_TMO])) break; if (sp > XB_SPIN_CAP) { atomicAdd(&bar[XB_TMO], 1u); break; } }
    }
    nloc = mine > 0u ? mine : 1u; nx = cnt > 0u ? cnt : 1u;
}

__device__ __forceinline__ void xcd_barrier(const XcdBarrier& b) {
    asm volatile("s_waitcnt vmcnt(0)" ::: "memory");
    __syncthreads();
    if (threadIdx.x == 0) {
        unsigned* bar = b.bar;
        __builtin_amdgcn_s_waitcnt(0);
        unsigned nloc = b.st[0], nx = b.st[1];
        if (nloc == 0u) { xcd_barrier_complete(bar, b.x, nloc, nx); b.st[0] = nloc; b.st[1] = nx; }
        const unsigned old = xb_add(&bar[XB_XSUB(b.x)], 1u);
        const unsigned gen = old / nloc;
        if (old + 1u == (gen + 1u) * nloc) {
            __builtin_amdgcn_fence(__ATOMIC_RELEASE, "agent");
            asm volatile("s_waitcnt vmcnt(0)" ::: "memory");
            const unsigned og = xb_add(&bar[XB_TOP], 1u);
            const unsigned tg = og / nx;
            if (og + 1u == (tg + 1u) * nx) xb_add(&bar[XB_TOPGEN], 1u);
            else XB_SPIN(xb_ld(&bar[XB_TOPGEN]) == tg, bar);
            __builtin_amdgcn_fence(__ATOMIC_ACQUIRE, "agent");
            xb_add(&bar[XB_XGEN(b.x)], 1u);
            asm volatile("s_waitcnt vmcnt(0)" ::: "memory");
        } else {
            XB_SPIN(xb_ld(&bar[XB_XGEN(b.x)]) == gen, bar);
            __builtin_amdgcn_fence(__ATOMIC_ACQUIRE, "agent");
            asm volatile("s_waitcnt vmcnt(0)" ::: "memory");
        }
    }
    __syncthreads();
}

__global__ void __launch_bounds__(512, 2) mega(Args a) {
  extern __shared__ __attribute__((aligned(16))) unsigned char lds[];
  cg::grid_group grid = cg::this_grid();
  const int tid = threadIdx.x, lane = tid & 63, wave = tid >> 6;
  const int gw = blockIdx.x * 8 + wave, ngw = gridDim.x * 8;
  unsigned char* ws = a.ws;
  const int lo = a.ph_lo, hi = a.ph_hi;
#define IN(k) (lo <= (k) && (k) < hi)
  volatile LAS unsigned* MISC = (volatile LAS unsigned*)((LAS unsigned char*)lds + 131072 + 320);
  if (tid < 32) MISC[tid] = 0u;
  __syncthreads();
  XcdBarrier bar; bar.bar = (unsigned*)(ws + WS_BAR); bar.x = 0; bar.st = nullptr;
  if (hi - lo > 1) bar = xcd_barrier_post((unsigned*)(ws + WS_BAR), MISC + 8);
#define SEAM(k) do { if (IN(k) && IN((k) + 1)) { if ((k) == 0) grid.sync(); else xcd_barrier(bar); } } while (0)
#if PROBE_REP == 0
  if (IN(0)) { phase_prep(a, lds, gw, ngw, wave, lane, tid); grid.sync(); }
#endif
  if (IN(0)) { phase_prep(a, lds, gw, ngw, wave, lane, tid); } SEAM(0);
#if PROBE_REP == 1
  if (IN(1)) {
    run_gemm(lds, (const bf16_t*)(ws + WS_HB), (const bf16_t*)(ws + WS_WIN_T), NT, NQKV, DM, EpiQKV{(bf16_t*)(ws + WS_QKV)}, gw, ngw, lane);
    run_gemm(lds, (const bf16_t*)(ws + WS_MEMN), (const bf16_t*)(ws + WS_WXKV_T), NMROWS, 2048, DM, EpiKV{(bf16_t*)(ws + WS_KX), (bf16_t*)(ws + WS_VXT)}, gw, ngw, lane);
    xcd_barrier(bar); }
#endif
#if PROBE_REP == 2
  if (IN(2)) { phase_scan(a, gw, ngw, lane, tid); xcd_barrier(bar); phase_rms(a, gw, ngw, lane); xcd_barrier(bar); phase_rms(a, gw, ngw, lane); xcd_barrier(bar); }
#endif
  if (IN(1)) {
    run_gemm(lds, (const bf16_t*)(ws + WS_HB), (const bf16_t*)(ws + WS_WIN_T), NT, NQKV, DM, EpiQKV{(bf16_t*)(ws + WS_QKV)}, gw, ngw, lane);
    run_gemm(lds, (const bf16_t*)(ws + WS_MEMN), (const bf16_t*)(ws + WS_WXKV_T), NMROWS, 2048, DM, EpiKV{(bf16_t*)(ws + WS_KX), (bf16_t*)(ws + WS_VXT)}, gw, ngw, lane);
  } SEAM(1);
  if (IN(2)) { phase_scan(a, gw, ngw, lane, tid); } SEAM(2);
#if PROBE_REP == 3
  if (IN(3)) { phase_attn2(a, lds, tid); xcd_barrier(bar); if (blockIdx.x == 0 && tid == 0) *(unsigned*)(ws) = 0u; xcd_barrier(bar); }
#endif
  if (IN(3)) {
#if USE_ATT2
    phase_attn2(a, lds, tid);
#else
    phase_attn(a, lds, tid);
#endif
  } SEAM(3);
  if (IN(4)) { phase_onorm(a, gw, ngw, lane); } SEAM(4);
  if (IN(5)) { run_gemm_raw(lds, (const bf16_t*)(ws + WS_OAB), (const bf16_t*)(ws + WS_WOUT_T), NT, DM, DM, pg8::EpiResidSS{a.in[0], a.out, (bf16_t*)(ws + WS_HB), (float*)(ws + WS_SS1)}); }
  if (IN(5) && IN(7)) xcd_barrier(bar);
  if (IN(7)) { run_gemm(lds, (const bf16_t*)(ws + WS_HB), (const bf16_t*)(ws + WS_WXQ_T), NT, DM, DM, EpiBf16S{(bf16_t*)(ws + WS_QX), DM, (const float*)(ws + WS_SS1)}, gw, ngw, lane); } SEAM(7);
#if PROBE_REP == 8
  if (IN(8)) { phase_xattn(a, lds, gw, ngw, wave, lane); grid.sync(); }
#endif
  if (IN(8)) { phase_xattn(a, lds, gw, ngw, wave, lane); } SEAM(8);
  if (IN(9)) { run_gemm_raw(lds, (const bf16_t*)(ws + WS_OX), (const bf16_t*)(ws + WS_WXO_T), NT, DM, DM, pg8::EpiResidSS{a.out, a.out, (bf16_t*)(ws + WS_HB), (float*)(ws + WS_SS2)}); }
  if (IN(9) && IN(11)) xcd_barrier(bar);
  if (IN(11)) { run_gemm(lds, (const bf16_t*)(ws + WS_HB), (const bf16_t*)(ws + WS_WPQ_T), NT, DM, DM, EpiF32S{(float*)(ws + WS_PQ), DM, (const float*)(ws + WS_SS2)}, gw, ngw, lane); } SEAM(11);
#if PROBE_REP == 12
  if (IN(12)) { phase_topk(a, lds, tid); grid.sync(); }
#endif
  if (IN(12)) { phase_topk(a, lds, tid); } SEAM(12);
  #if PROBE_REP == 13
  if (IN(13)) { phase_experts(a, gw, ngw, lane, (float*)(ws + WS_QKV)); grid.sync(); }
#endif
  if (IN(13)) { phase_experts(a, gw, ngw, lane, a.out); }
#undef IN
#undef SEAM
}

extern "C" void kernel_launch(void* const* d_in, const int* in_sizes, int n_in, void* d_out, int out_size, void* d_ws, size_t ws_size, hipStream_t stream) {
  static int grid = 0;
  if (grid == 0) {
    if (n_in != 22 || out_size != NT * DM || ws_size < WS_END) { fprintf(stderr, "kernel_launch: unexpected shapes (n_in %d out %d ws %zu)\n", n_in, out_size, ws_size); grid = -1; return; }
    int dev = 0, cus = 0, per_cu = 0;
    (void)hipGetDevice(&dev);
    (void)hipDeviceGetAttribute(&cus, hipDeviceAttributeMultiprocessorCount, dev);
    (void)hipFuncSetAttribute((const void*)mega, hipFuncAttributeMaxDynamicSharedMemorySize, LDS_BYTES);
    (void)hipOccupancyMaxActiveBlocksPerMultiprocessor(&per_cu, (const void*)mega, 512, LDS_BYTES);
    if (per_cu < 1) per_cu = 1;
    grid = cus * per_cu;
  }
  if (grid < 0) return;
  (void)hipMemsetAsync(d_ws, 0, CTL_ZERO_BYTES, stream);
  Args a{};
  for (int i = 0; i < 22; ++i) a.in[i] = (const float*)d_in[i];
  a.out = (float*)d_out; a.ws = (unsigned char*)d_ws;
#if MK_N_LAUNCHES == 1
  a.ph_lo = 0; a.ph_hi = NPHASE + 1;
  void* args[] = {&a};
  hipError_t e = hipLaunchCooperativeKernel((const void*)mega, dim3(grid), dim3(512), args, LDS_BYTES, stream);
  if (e != hipSuccess) fprintf(stderr, "cooperative launch failed: %s (grid %d)\n", hipGetErrorString(e), grid);
#else
  for (int p = 0; p <= NPHASE; ++p) { a.ph_lo = p; a.ph_hi = p + 1; hipLaunchKernelGGL(mega, dim3(grid), dim3(512), LDS_BYTES, stream, a); }
#endif
}
```

```cpp
#include <hip/hip_runtime.h>
#include <hip/hip_cooperative_groups.h>
#include <cstdio>
#include <cstdint>
namespace cg = cooperative_groups;

#ifndef USE_PG8
#define USE_PG8 1
#endif
#ifndef USE_ATT2
#define USE_ATT2 1
#endif
#ifndef PROBE_REP
#define PROBE_REP -1
#endif
#ifndef MK_N_LAUNCHES
#define MK_N_LAUNCHES 1
#endif

typedef unsigned short bf16_t;
typedef short bf16x8 __attribute__((ext_vector_type(8)));
typedef float f32x4 __attribute__((ext_vector_type(4)));
typedef unsigned u32x4 __attribute__((ext_vector_type(4)));
typedef unsigned u32x2 __attribute__((ext_vector_type(2)));

constexpr int NB = 8, SEQ = 4096, DM = 1024, NT = NB * SEQ;
constexpr int NQKV = 3072, INW = 3080;
constexpr int NMEM = 256, NMROWS = NB * NMEM;
constexpr int NEXP = 16384;
constexpr float EPS = 1e-6f;
constexpr int NPHASE = 13;
constexpr int LDS_BYTES = 147456;

constexpr size_t MiB = 1u << 20;
constexpr size_t WS_BAR = 65536;
constexpr size_t WS_SS1 = 131072;
constexpr size_t WS_SS2 = 262144;
constexpr size_t CTL_ZERO_BYTES = 393216;
constexpr size_t WS_WIN_T = 2 * MiB;
constexpr size_t WS_WOUT_T = 8 * MiB;
constexpr size_t WS_WXQ_T = 10 * MiB;
constexpr size_t WS_WXKV_T = 12 * MiB;
constexpr size_t WS_WXO_T = 16 * MiB;
constexpr size_t WS_WPQ_T = 18 * MiB;
constexpr size_t WS_SK = 21 * MiB;
constexpr size_t WS_MEMN = 22 * MiB;
constexpr size_t WS_KX = 26 * MiB;
constexpr size_t WS_VXT = 30 * MiB;
constexpr size_t WS_FLOG = 34 * MiB;
constexpr size_t WS_CUM = 35 * MiB;
constexpr size_t WS_KMEAN = 36 * MiB;
constexpr size_t WS_ESC = 38 * MiB;
constexpr size_t WS_EXD = 40 * MiB;
constexpr size_t WS_EXU = 72 * MiB;
constexpr size_t WS_HB = 104 * MiB;
constexpr size_t WS_QKV = 168 * MiB;
constexpr size_t WS_OAB = 360 * MiB;
constexpr size_t WS_QX = 168 * MiB;
constexpr size_t WS_OX = 232 * MiB;
constexpr size_t WS_PQ = 232 * MiB;
constexpr size_t WS_EIDX = 424 * MiB;
constexpr size_t WS_GATE = 440 * MiB;
constexpr size_t WS_END = 456 * MiB;

struct Args {
  const float* in[22];
  float* out;
  unsigned char* ws;
  int ph_lo, ph_hi;
};

__device__ __forceinline__ unsigned f2bf(float f) { unsigned u = __float_as_uint(f); return (u + 0x7fffu + ((u >> 16) & 1u)) >> 16; }
__device__ __forceinline__ unsigned pk2(float lo, float hi) { return f2bf(lo) | (f2bf(hi) << 16); }
__device__ __forceinline__ float bf2f(unsigned short b) { return __uint_as_float(((unsigned)b) << 16); }
__device__ __forceinline__ float bflo(unsigned w) { return __uint_as_float(w << 16); }
__device__ __forceinline__ float bfhi(unsigned w) { return __uint_as_float(w & 0xffff0000u); }
__device__ __forceinline__ float wave_sum(float v) {
#pragma unroll
  for (int o = 1; o < 64; o <<= 1) v += __shfl_xor(v, o);
  return v;
}
__device__ __forceinline__ void unpack8(const u32x4 w, float* f) {
  f[0] = bflo(w.x); f[1] = bfhi(w.x); f[2] = bflo(w.y); f[3] = bfhi(w.y);
  f[4] = bflo(w.z); f[5] = bfhi(w.z); f[6] = bflo(w.w); f[7] = bfhi(w.w);
}

__device__ const unsigned char T5_BUCKET[128] = {
  0, 1, 2, 3, 4, 5, 6, 7, 8, 9, 10, 11, 12, 13, 14, 15, 16, 16, 16, 17, 17, 18, 18, 18, 19, 19, 19, 20, 20, 20, 20, 21,
  21, 21, 21, 22, 22, 22, 22, 22, 23, 23, 23, 23, 23, 23, 24, 24, 24, 24, 24, 24, 25, 25, 25, 25, 25, 25, 25, 26, 26, 26, 26, 26,
  26, 26, 26, 27, 27, 27, 27, 27, 27, 27, 27, 27, 27, 28, 28, 28, 28, 28, 28, 28, 28, 28, 28, 29, 29, 29, 29, 29, 29, 29, 29, 29,
  29, 29, 29, 30, 30, 30, 30, 30, 30, 30, 30, 30, 30, 30, 30, 30, 30, 31, 31, 31, 31, 31, 31, 31, 31, 31, 31, 31, 31, 31, 31, 31};

__device__ __forceinline__ void transpose_item(const float* W, int ldw, const float* gain, bf16_t* WT, int K, int row_off, float* scr, int kb, int nb, int lane) {
  const int k0 = 64 * kb, n0 = 32 * nb;
#pragma unroll 8
  for (int i = 0; i < 32; ++i) {
    const int kk = 2 * i + (lane >> 5);
    const float g = gain ? gain[k0 + kk] : 1.f;
    scr[kk * 33 + (lane & 31)] = W[(size_t)(k0 + kk) * ldw + n0 + (lane & 31)] * g;
  }
  __builtin_amdgcn_wave_barrier();
  const int c = lane & 7;
#pragma unroll
  for (int j = 0; j < 4; ++j) {
    const int n = (lane >> 3) + 8 * j; const float* s = scr + (8 * c) * 33 + n;
    u32x4 o; o.x = pk2(s[0 * 33], s[1 * 33]); o.y = pk2(s[2 * 33], s[3 * 33]); o.z = pk2(s[4 * 33], s[5 * 33]); o.w = pk2(s[6 * 33], s[7 * 33]);
    *(u32x4*)(WT + (size_t)(row_off + n0 + n) * K + k0 + 8 * c) = o;
  }
  __builtin_amdgcn_wave_barrier();
}

__device__ __forceinline__ void rms_row_to_bf16(const float* xrow, bf16_t* orow, int lane) {
  const f32x4* xr = (const f32x4*)xrow + lane;
  f32x4 v[4]; float s = 0.f;
#pragma unroll
  for (int j = 0; j < 4; ++j) { v[j] = xr[64 * j]; s += (v[j].x * v[j].x + v[j].y * v[j].y) + (v[j].z * v[j].z + v[j].w * v[j].w); }
  const float rstd = rsqrtf(wave_sum(s) * (1.f / DM) + EPS);
  u32x2* o = (u32x2*)orow + lane;
#pragma unroll
  for (int j = 0; j < 4; ++j) { u32x2 w; w.x = pk2(v[j].x * rstd, v[j].y * rstd); w.y = pk2(v[j].z * rstd, v[j].w * rstd); o[64 * j] = w; }
}

__device__ __forceinline__ void phase_prep(const Args& a, unsigned char* lds, int gw, int ngw, int wave, int lane, int tid) {
  unsigned char* ws = a.ws;
  float* scr = (float*)(lds + wave * 8448);
  const int I_IN = 16 * 96, I_SQ = 16 * 32;
  const int NITEMS = I_IN + 6 * I_SQ;
  for (int it = gw; it < NITEMS; it += ngw) {
    int r = it;
    if (r < I_IN) { transpose_item(a.in[3], INW, a.in[2], (bf16_t*)(ws + WS_WIN_T), DM, 0, scr, r / 96, r % 96, lane); continue; } r -= I_IN;
    const int which = r / I_SQ; r %= I_SQ; const int kb = r / 32, nb = r % 32;
    if (which == 0) { const float* g = (kb < 8) ? a.in[6] : (a.in[7] - 512); transpose_item(a.in[8], DM, g, (bf16_t*)(ws + WS_WOUT_T), DM, 0, scr, kb, nb, lane); }
    else if (which == 1) transpose_item(a.in[11], DM, a.in[9], (bf16_t*)(ws + WS_WXQ_T), DM, 0, scr, kb, nb, lane);
    else if (which == 2) transpose_item(a.in[12], DM, a.in[10], (bf16_t*)(ws + WS_WXKV_T), DM, 0, scr, kb, nb, lane);
    else if (which == 3) transpose_item(a.in[13], DM, a.in[10], (bf16_t*)(ws + WS_WXKV_T), DM, 1024, scr, kb, nb, lane);
    else if (which == 4) transpose_item(a.in[14], DM, nullptr, (bf16_t*)(ws + WS_WXO_T), DM, 0, scr, kb, nb, lane);
    else transpose_item(a.in[16], DM, a.in[15], (bf16_t*)(ws + WS_WPQ_T), DM, 0, scr, kb, nb, lane);
  }
  for (int r = gw; r < 2 * NEXP; r += ngw) {
    const int tb = r >= NEXP, e = r - tb * NEXP;
    const f32x4* src = (const f32x4*)(a.in[19 + tb] + (size_t)e * DM) + 4 * lane;
    f32x4 v[4]; float am = 0.f;
#pragma unroll
    for (int k = 0; k < 4; ++k) { v[k] = src[k]; am = fmaxf(am, fmaxf(fmaxf(fabsf(v[k].x), fabsf(v[k].y)), fmaxf(fabsf(v[k].z), fabsf(v[k].w)))); }
#pragma unroll
    for (int o = 1; o < 64; o <<= 1) am = fmaxf(am, __shfl_xor(am, o));
    const float sc = am > 0.f ? 440.f / am : 1.f;
    u32x4 o;
#pragma unroll
    for (int k = 0; k < 4; ++k) { int w = __builtin_amdgcn_cvt_pk_fp8_f32(v[k].x * sc, v[k].y * sc, 0, false); w = __builtin_amdgcn_cvt_pk_fp8_f32(v[k].z * sc, v[k].w * sc, w, true); o[k] = (unsigned)w; }
    *((u32x4*)(ws + (tb ? WS_EXU : WS_EXD) + (size_t)e * DM) + lane) = o;
    if (lane == 0) ((float*)(ws + WS_ESC))[r] = am > 0.f ? am / 440.f : 1.f;
  }
  for (int i = blockIdx.x * 512 + tid; i < 2 * 65536; i += gridDim.x * 512) ((bf16_t*)(ws + WS_SK))[i] = (bf16_t)f2bf(a.in[17 + (i >> 16)][i & 65535]);
  for (int r = gw; r < NMROWS; r += ngw) rms_row_to_bf16(a.in[1] + (size_t)r * DM, (bf16_t*)(ws + WS_MEMN) + (size_t)r * DM, lane);
  __syncthreads();
  float* wf = (float*)(lds + 69632);
  for (int k = tid; k < DM; k += 512) {
    const float g = a.in[2][k]; const f32x4* wp = (const f32x4*)(a.in[3] + (size_t)k * INW + NQKV);
    const f32x4 p = wp[0], q = wp[1];
    f32x4* d = (f32x4*)(wf + k * 8); d[0] = p * g; d[1] = q * g;
  }
  __syncthreads();
  float* flog = (float*)(ws + WS_FLOG);
  for (int r = gw; r < NT; r += ngw) {
    const f32x4* xr = (const f32x4*)(a.in[0] + (size_t)r * DM) + lane;
    f32x4 v[4]; float s = 0.f; float fa[8];
#pragma unroll
    for (int j = 0; j < 8; ++j) fa[j] = 0.f;
#pragma unroll
    for (int j = 0; j < 4; ++j) {
      v[j] = xr[64 * j]; s += (v[j].x * v[j].x + v[j].y * v[j].y) + (v[j].z * v[j].z + v[j].w * v[j].w);
#pragma unroll
      for (int c = 0; c < 4; ++c) {
        const float xv = v[j][c]; const f32x4* wp = (const f32x4*)(wf + (256 * j + 4 * lane + c) * 8);
        const f32x4 p = wp[0], q = wp[1];
        fa[0] += xv * p.x; fa[1] += xv * p.y; fa[2] += xv * p.z; fa[3] += xv * p.w;
        fa[4] += xv * q.x; fa[5] += xv * q.y; fa[6] += xv * q.z; fa[7] += xv * q.w;
      }
    }
    const float rstd = rsqrtf(wave_sum(s) * (1.f / DM) + EPS);
    float mine = 0.f;
#pragma unroll
    for (int j = 0; j < 8; ++j) { const float t = wave_sum(fa[j]); if (lane == j) mine = t; }
    if (lane < 8) {
      const float z = mine * rstd + a.in[4][lane];
      flog[(size_t)r * 8 + lane] = fminf(z, 0.f) - log1pf(expf(-fabsf(z)));
    }
    u32x2* o = (u32x2*)((bf16_t*)(ws + WS_HB) + (size_t)r * DM) + lane;
#pragma unroll
    for (int j = 0; j < 4; ++j) { u32x2 w; w.x = pk2(v[j].x * rstd, v[j].y * rstd); w.y = pk2(v[j].z * rstd, v[j].w * rstd); o[64 * j] = w; }
  }
}

template <class Epi>
__device__ __forceinline__ void gemm_naive(const bf16_t* A, int lda, const bf16_t* Bt, int ldb, int M, int N, int K, const Epi& E, int gw, int ngw, int lane) {
  const int fr = lane & 15, fq = lane >> 4;
  const int tn = N / 64, ntile = (M / 64) * tn;
  for (int tile = gw; tile < ntile; tile += ngw) {
    const int pm = tile / tn, pn = tile % tn;
    f32x4 acc[4][4];
#pragma unroll
    for (int m = 0; m < 4; ++m)
#pragma unroll
      for (int n = 0; n < 4; ++n) acc[m][n] = (f32x4){0.f, 0.f, 0.f, 0.f};
    const bf16_t* Ap = A + (size_t)(pm * 64 + fr) * lda + fq * 8;
    const bf16_t* Bp = Bt + (size_t)(pn * 64 + fr) * ldb + fq * 8;
    for (int k0 = 0; k0 < K; k0 += 32) {
      bf16x8 af[4], bfr[4];
#pragma unroll
      for (int m = 0; m < 4; ++m) af[m] = *(const bf16x8*)(Ap + (size_t)m * 16 * lda + k0);
#pragma unroll
      for (int n = 0; n < 4; ++n) bfr[n] = *(const bf16x8*)(Bp + (size_t)n * 16 * ldb + k0);
#pragma unroll
      for (int m = 0; m < 4; ++m)
#pragma unroll
        for (int n = 0; n < 4; ++n) acc[m][n] = __builtin_amdgcn_mfma_f32_16x16x32_bf16(bfr[n], af[m], acc[m][n], 0, 0, 0);
    }
#pragma unroll
    for (int m = 0; m < 4; ++m)
#pragma unroll
      for (int n = 0; n < 4; ++n) E.store(pm * 64 + m * 16 + fr, pn * 64 + n * 16 + 4 * fq, acc[m][n]);
  }
}

struct EpiBf16 { bf16_t* O; int ldo;
  __device__ __forceinline__ void store(int row, int col, f32x4 v) const { u32x2 w; w.x = pk2(v.x, v.y); w.y = pk2(v.z, v.w); *(u32x2*)(O + (size_t)row * ldo + col) = w; } };
struct EpiQKV { bf16_t* O;
  __device__ __forceinline__ void store(int row, int col, f32x4 v) const { const float sc = (col < 512 || (col >= 1536 && col < 2048)) ? 0.18033688011112042f : 1.f;
    u32x2 w; w.x = pk2(v.x * sc, v.y * sc); w.y = pk2(v.z * sc, v.w * sc); *(u32x2*)(O + (size_t)row * NQKV + col) = w; } };
struct EpiBf16S { bf16_t* O; int ldo; const float* ss;
  __device__ __forceinline__ void store(int row, int col, f32x4 v) const { const float r = rsqrtf(ss[row] * (1.f / DM) + EPS); u32x2 w; w.x = pk2(v.x * r, v.y * r); w.y = pk2(v.z * r, v.w * r); *(u32x2*)(O + (size_t)row * ldo + col) = w; } };
struct EpiF32S { float* O; int ldo; const float* ss;
  __device__ __forceinline__ void store(int row, int col, f32x4 v) const { const float r = rsqrtf(ss[row] * (1.f / DM) + EPS); *(f32x4*)(O + (size_t)row * ldo + col) = v * r; } };
struct EpiF32 { float* O; int ldo;
  __device__ __forceinline__ void store(int row, int col, f32x4 v) const { *(f32x4*)(O + (size_t)row * ldo + col) = v; } };
struct EpiResid { const float* base; float* out;
  __device__ __forceinline__ void store(int row, int col, f32x4 v) const { const size_t o = (size_t)row * DM + col; const f32x4 b = *(const f32x4*)(base + o); *(f32x4*)(out + o) = b + v; } };
struct EpiKV { bf16_t* KX; bf16_t* VXT;
  __device__ __forceinline__ void store(int row, int col, f32x4 v) const {
    if (col < 1024) { u32x2 w; w.x = pk2(v.x, v.y); w.y = pk2(v.z, v.w); *(u32x2*)(KX + (size_t)row * DM + col) = w; }
    else { const int b = row >> 8, m = row & 255;
#pragma unroll
      for (int r = 0; r < 4; ++r) { const int d = col - 1024 + r; VXT[((size_t)(b * 4 + (d >> 8)) * 256 + (d & 255)) * 256 + m] = (bf16_t)f2bf(v[r]); } } } };

__device__ __forceinline__ void phase_scan(const Args& a, int gw, int ngw, int lane, int tid) {
  unsigned char* ws = a.ws;
  const float* flog = (const float*)(ws + WS_FLOG); float* cum = (float*)(ws + WS_CUM);
  for (int p = gw; p < 64; p += ngw) {
    const int b = p >> 3, j = p & 7;
    const float* src = flog + ((size_t)b * SEQ + lane * 64) * 8 + j;
    float tot = 0.f;
    for (int i = 0; i < 64; ++i) tot += src[i * 8];
    float inc = tot;
#pragma unroll
    for (int o = 1; o < 64; o <<= 1) { const float t = __shfl_up(inc, o); if (lane >= o) inc += t; }
    float run = inc - tot;
    float* dst = cum + ((size_t)(b * 8 + j)) * SEQ + lane * 64;
    for (int i = 0; i < 64; ++i) { run += src[i * 8]; dst[i] = run * 1.4426950408889634f; }
  }
  const bf16_t* qkv = (const bf16_t*)(ws + WS_QKV); float* kmean = (float*)(ws + WS_KMEAN);
  {
    unsigned* kn2 = (unsigned*)(ws + 256);
    for (int item = gw; item < 64 * 16; item += ngw) {
      const int bh = item >> 4, ch = item & 15, b = bh >> 3, h = bh & 7; float m = 0.f;
      for (int rr = 0; rr < 4; ++rr) {
        const u32x4* kp = (const u32x4*)(qkv + ((size_t)b * SEQ + ch * 256 + lane * 4 + rr) * NQKV + 2048 + h * 64); float s = 0.f;
#pragma unroll
        for (int c = 0; c < 8; ++c) { float f[8]; unpack8(kp[c], f);
#pragma unroll
          for (int i = 0; i < 8; ++i) s += f[i] * f[i]; }
        m = fmaxf(m, s);
      }
#pragma unroll
      for (int o = 1; o < 64; o <<= 1) m = fmaxf(m, __shfl_xor(m, o));
      if (lane == 0) atomicMax(kn2 + bh, __float_as_uint(m));
    }
  }
  const int gt = blockIdx.x * 512 + tid, ngt = gridDim.x * 512;
  for (int o = gt; o < NB * 16 * 512; o += ngt) {
    const int c = o & 511, blk = (o >> 9) & 15, b = o >> 13;
    const bf16_t* p = qkv + ((size_t)b * SEQ + blk * 256) * NQKV + 512 + c;
    float s = 0.f;
    for (int r = 0; r < 256; ++r) s += bf2f(p[(size_t)r * NQKV]);
    kmean[o] = s * (1.f / 256.f);
  }
}

template <int MODE>
__device__ __forceinline__ void attn_naive_unit(const Args& a, unsigned char* lds, int b, int h, int sb, int tid) {
  unsigned char* ws = a.ws;
  const bf16_t* qkv = (const bf16_t*)(ws + WS_QKV);
  const int qoff = MODE ? 1536 : 0, koff = qoff + 512, voff = qoff + 1024;
  float* Ks = (float*)lds; float* Vs = Ks + 64 * 64; float* ck = Vs + 64 * 64; float* biasd = ck + 64;
  const int t = sb * 512 + tid; const size_t row = (size_t)b * SEQ + t;
  float q[64], o[64];
  {
    const u32x4* qp = (const u32x4*)(qkv + row * NQKV + qoff + h * 64);
#pragma unroll
    for (int c = 0; c < 8; ++c) { const u32x4 w = qp[c]; unpack8(w, q + 8 * c); }
#pragma unroll
    for (int d = 0; d < 64; ++d) { q[d] *= 0.6931471805599453f; o[d] = 0.f; }
  }
  float m = -1e30f, l = 0.f;
  unsigned selmask = 0u; const int own = t >> 8;
  float cq = 0.f, bfar = 0.f;
  __syncthreads();
  if (MODE == 0) {
    if (tid < 128) biasd[tid] = a.in[5][T5_BUCKET[tid] * 8 + h];
    bfar = a.in[5][31 * 8 + h];
    const float* km = (const float*)(ws + WS_KMEAN) + ((size_t)b * 16) * 512 + h * 64;
    float v0 = -3e38f, v1 = -3e38f, v2 = -3e38f; int i0 = -1, i1 = -1, i2 = -1;
    for (int n = 0; n < 2 * sb + 1; ++n) {
      if (n < own) {
        const float* kp = km + (size_t)n * 512; float s = 0.f;
#pragma unroll
        for (int d = 0; d < 64; ++d) s += q[d] * kp[d];
        if (s > v0) { v2 = v1; i2 = i1; v1 = v0; i1 = i0; v0 = s; i0 = n; }
        else if (s > v1) { v2 = v1; i2 = i1; v1 = s; i1 = n; }
        else if (s > v2) { v2 = s; i2 = n; }
      }
    }
    if (i0 >= 0) selmask |= 1u << i0;
    if (i1 >= 0) selmask |= 1u << i1;
    if (i2 >= 0) selmask |= 1u << i2;
  } else {
    cq = ((const float*)(ws + WS_CUM))[((size_t)(b * 8 + h)) * SEQ + t];
  }
  const int ntile = 8 * (sb + 1);
  for (int kt = 0; kt < ntile; ++kt) {
    __syncthreads();
    {
      const int r = tid >> 3, ch = tid & 7;
      const bf16_t* kp = qkv + ((size_t)b * SEQ + kt * 64 + r) * NQKV + h * 64 + ch * 8;
      const u32x4 kw = *(const u32x4*)(kp + koff), vw = *(const u32x4*)(kp + voff);
      unpack8(kw, Ks + r * 64 + ch * 8); unpack8(vw, Vs + r * 64 + ch * 8);
      if (MODE == 1 && tid < 64) ck[tid] = ((const float*)(ws + WS_CUM))[((size_t)(b * 8 + h)) * SEQ + kt * 64 + tid];
    }
    __syncthreads();
    const int kb = kt >> 2;
    bool act;
    if (MODE == 0) act = (kb == own) || (kb < own && ((selmask >> kb) & 1u));
    else act = (kt * 64 <= t);
    if (act) {
      for (int jj = 0; jj < 64; ++jj) {
        const int sp = kt * 64 + jj;
        if (sp > t) break;
        const f32x4* kr = (const f32x4*)(Ks + jj * 64);
        float s = 0.f;
#pragma unroll
        for (int c = 0; c < 16; ++c) { const f32x4 kv = kr[c]; s += q[4 * c] * kv.x + q[4 * c + 1] * kv.y + q[4 * c + 2] * kv.z + q[4 * c + 3] * kv.w; }
        if (MODE == 0) { const int dist = t - sp; s += (dist < 128) ? biasd[dist] : bfar; }
        else s += (cq - ck[jj]) * 0.6931471805599453f;
        if (s > m) { const float f = __expf(m - s); l *= f;
#pragma unroll
          for (int d = 0; d < 64; ++d) o[d] *= f;
          m = s; }
        const float p = __expf(s - m); l += p;
        const f32x4* vr = (const f32x4*)(Vs + jj * 64);
#pragma unroll
        for (int c = 0; c < 16; ++c) { const f32x4 vv = vr[c]; o[4 * c] += p * vv.x; o[4 * c + 1] += p * vv.y; o[4 * c + 2] += p * vv.z; o[4 * c + 3] += p * vv.w; }
      }
    }
  }
  const float il = 1.f / l;
  u32x4* op = (u32x4*)((bf16_t*)(ws + WS_OAB) + row * DM + (MODE ? 512 : 0) + h * 64);
#pragma unroll
  for (int c = 0; c < 8; ++c) { u32x4 w; w.x = pk2(o[8 * c] * il, o[8 * c + 1] * il); w.y = pk2(o[8 * c + 2] * il, o[8 * c + 3] * il); w.z = pk2(o[8 * c + 4] * il, o[8 * c + 5] * il); w.w = pk2(o[8 * c + 6] * il, o[8 * c + 7] * il); op[c] = w; }
}

__device__ __forceinline__ void phase_attn(const Args& a, unsigned char* lds, int tid) {
  for (int u = blockIdx.x; u < 1024; u += gridDim.x) {
    const int sb = 7 - (u >> 7), r = u & 127, mode = r & 1, bh = r >> 1;
    if (mode == 0) attn_naive_unit<0>(a, lds, bh >> 3, bh & 7, sb, tid);
    else attn_naive_unit<1>(a, lds, bh >> 3, bh & 7, sb, tid);
  }
}

namespace att {
typedef float f32x16 __attribute__((ext_vector_type(16)));
typedef short s16x4 __attribute__((ext_vector_type(4)));
typedef short v4i16_t __attribute__((ext_vector_type(4)));
typedef __attribute__((address_space(3))) const char* lds_cptr;
typedef float f32x2_t __attribute__((ext_vector_type(2))); typedef __bf16 bf16x2_t __attribute__((ext_vector_type(2)));
constexpr int PITCH = NQKV;
constexpr float LOG2E = 1.4426950408889634f;
constexpr float C2 = 0.125f * LOG2E;
constexpr int L_K = 0, L_V = 16384, L_WSF = 32768, L_OST = 34816, L_C2 = 67584, L_KM = 83968, L_BT = 88064, L_MISC = 88704;
__device__ __forceinline__ int crow(int r, int hi) { return (r & 3) + 8 * (r >> 2) + 4 * hi; }
__device__ __forceinline__ unsigned cvtpk(float lo, float hi) { f32x2_t v = {lo, hi}; bf16x2_t b = __builtin_convertvector(v, bf16x2_t); return __builtin_bit_cast(unsigned, b); }
__device__ __forceinline__ s16x4 vtr(lds_cptr p) { return __builtin_bit_cast(s16x4, __builtin_amdgcn_ds_read_tr16_b64_v4i16((__attribute__((address_space(3))) v4i16_t*)p)); }
__device__ __forceinline__ float xhalf_max(float m) { auto rr = __builtin_amdgcn_permlane32_swap(__float_as_uint(m), __float_as_uint(m), false, false); return fmaxf(__uint_as_float(rr[0]), __uint_as_float(rr[1])); }
__device__ __forceinline__ float xhalf_sum(float m) { auto rr = __builtin_amdgcn_permlane32_swap(__float_as_uint(m), __float_as_uint(m), false, false); return __uint_as_float(rr[0]) + __uint_as_float(rr[1]); }

template <int MODE>
__device__ __forceinline__ void unit(const Args& a, unsigned char* lds, int b, int h, int qb, int tid) {
  unsigned char* ws = a.ws;
  const int lane = tid & 63, r32 = lane & 31, hi = lane >> 5; const int wid = __builtin_amdgcn_readfirstlane(tid >> 6);
  const bf16_t* qkv = (const bf16_t*)(ws + WS_QKV);
  const int qoff = MODE ? 1536 : 0;
  const size_t rowbase = (size_t)b * SEQ; const int q0 = qb * 256;
  const bf16_t* Qw = qkv + (rowbase + q0 + wid * 32) * PITCH + qoff + h * 64;
  const bf16_t* Kh = qkv + rowbase * PITCH + qoff + 512 + h * 64;
  const bf16_t* Vh = qkv + rowbase * PITCH + qoff + 1024 + h * 64;
  float* wsf = (float*)(lds + L_WSF) + wid * 64;
  float* c2s = (float*)(lds + L_C2); float* kms = (float*)(lds + L_KM); float* bts = (float*)(lds + L_BT); unsigned* misc = (unsigned*)(lds + L_MISC);
  const int NTL = 4 * (qb + 1);
  __syncthreads();
  if (MODE == 0) {
    const float* km = (const float*)(ws + WS_KMEAN) + (size_t)b * 16 * 512 + h * 64;
    for (int i = tid; i < 16 * 64; i += 512) kms[i] = km[(size_t)(i >> 6) * 512 + (i & 63)];
    if (tid < 128) bts[tid] = a.in[5][T5_BUCKET[tid] * 8 + h] * LOG2E;
    if (tid == 128) bts[128] = a.in[5][31 * 8 + h] * LOG2E;
  } else {
    const float* cg = (const float*)(ws + WS_CUM) + (size_t)(b * 8 + h) * SEQ;
    for (int i = tid; i < 256 * (qb + 1); i += 512) c2s[i] = cg[i];
    if (tid == 0) misc[0] = 0u;
  }
  bf16x8 qr[4];
#pragma unroll
  for (int d0 = 0; d0 < 4; ++d0) qr[d0] = *(const bf16x8*)(Qw + (size_t)r32 * PITCH + d0 * 16 + hi * 8);
  __syncthreads();
  unsigned selmask = 0u; float cq2 = 0.f, far2 = 0.f, mhat = -1e30f; int t0 = 0;
  if (MODE == 0) {
    far2 = bts[128];
    float v0 = -3e38f, v1 = -3e38f, v2 = -3e38f; int i0 = -1, i1 = -1, i2 = -1;
    for (int n = 0; n < qb; ++n) {
      float s = 0.f;
#pragma unroll
      for (int d0 = 0; d0 < 4; ++d0)
#pragma unroll
        for (int j = 0; j < 8; ++j) s += bf2f((unsigned short)qr[d0][j]) * kms[n * 64 + d0 * 16 + hi * 8 + j];
      s = xhalf_sum(s);
      if (s > v0) { v2 = v1; i2 = i1; v1 = v0; i1 = i0; v0 = s; i0 = n; }
      else if (s > v1) { v2 = v1; i2 = i1; v1 = s; i1 = n; }
      else if (s > v2) { v2 = s; i2 = n; }
    }
    if (i0 >= 0) selmask |= 1u << i0;
    if (i1 >= 0) selmask |= 1u << i1;
    if (i2 >= 0) selmask |= 1u << i2;
  } else {
    cq2 = c2s[q0 + wid * 32 + r32];
    float s = 0.f;
#pragma unroll
    for (int d0 = 0; d0 < 4; ++d0)
#pragma unroll
      for (int j = 0; j < 8; ++j) { const float f = bf2f((unsigned short)qr[d0][j]); s += f * f; }
    s = xhalf_sum(s);
    atomicMax(&misc[0], __float_as_uint(s));
    __syncthreads();
    const float kn2 = __uint_as_float(((const unsigned*)(ws + 256))[b * 8 + h]);
    const float qkb = sqrtf(__uint_as_float(misc[0]) * kn2) * 1.0001f + 1e-3f;
    mhat = -qkb;
    const int j = lane; bool skip = false;
    if (j < NTL) skip = (2.f * qkb + c2s[q0] - c2s[64 * j + 63]) < -150.f;
    t0 = __popcll(__ballot(skip));
    if (t0 > NTL - 1) t0 = NTL - 1;
  }
  const bf16_t* ksrc = Kh + (size_t)lane * PITCH + wid * 8;
  const bf16_t* vsrc = Vh + (size_t)(16 * (wid & 3) + (lane >> 2)) * PITCH + (wid >> 2) * 32 + (lane & 3) * 8;
  unsigned char* kdst = lds + L_K + wid * 1024 + lane * 16; unsigned char* vdst = lds + L_V + wid * 1024 + lane * 16;
  const lds_cptr lds3 = (lds_cptr)lds;
  const lds_cptr vp0 = lds3 + L_V + ((lane >> 4) & 1) * 32 + (lane & 3) * 8 + (4 * hi + ((lane & 15) >> 2)) * 64;
  u32x4 kreg = *(const u32x4*)(ksrc + (size_t)t0 * 64 * PITCH), vreg = *(const u32x4*)(vsrc + (size_t)t0 * 64 * PITCH);
  *(u32x4*)(kdst + (t0 & 1) * 8192) = kreg; *(u32x4*)(vdst + (t0 & 1) * 8192) = vreg;
  f32x16 o[2]; o[0] = f32x16{}; o[1] = f32x16{};
  float l = 0.f;
  const int qrel = wid * 32 + r32, qpos = q0 + qrel;
  __syncthreads();
  for (int t = t0; t < NTL; ++t) {
    const int buf = (t & 1) * 8192;
    if (t + 1 < NTL) { kreg = *(const u32x4*)(ksrc + (size_t)(t + 1) * 64 * PITCH); vreg = *(const u32x4*)(vsrc + (size_t)(t + 1) * 64 * PITCH); }
    const int jb = t - (NTL - 4);
    const bool compute = !(jb >= 0 && 64 * jb > wid * 32 + 31);
    if (compute) {
      f32x16 p0, p1;
      if (MODE == 0) {
        const int nb = t >> 2;
        const bool near = (jb >= 0) || (t >= NTL - 6 && wid < 4);
        if (near) {
#pragma unroll
          for (int r = 0; r < 16; ++r) { const int d = qpos - (64 * t + crow(r, hi));
            p0[r] = bts[min(max(d, 0), 128)]; p1[r] = bts[min(max(d - 32, 0), 128)]; }
        } else {
#pragma unroll
          for (int r = 0; r < 16; ++r) { p0[r] = far2; p1[r] = far2; }
        }
        if (jb < 0 && !((selmask >> nb) & 1u)) {
#pragma unroll
          for (int r = 0; r < 16; ++r) { p0[r] = -INFINITY; p1[r] = -INFINITY; }
        }
      } else {
#pragma unroll
        for (int g = 0; g < 4; ++g) {
          const f32x4 ca = *(const f32x4*)(c2s + 64 * t + 8 * g + 4 * hi), cb = *(const f32x4*)(c2s + 64 * t + 32 + 8 * g + 4 * hi);
#pragma unroll
          for (int i = 0; i < 4; ++i) { p0[4 * g + i] = cq2 - ca[i]; p1[4 * g + i] = cq2 - cb[i]; }
        }
      }
      {
        const lds_cptr kb = lds3 + L_K + buf + hi * 1024 + r32 * 16;
#pragma unroll
        for (int d0 = 0; d0 < 4; ++d0) {
          const bf16x8 b0 = *(const __attribute__((address_space(3))) bf16x8*)(kb + d0 * 2048);
          const bf16x8 b1 = *(const __attribute__((address_space(3))) bf16x8*)(kb + d0 * 2048 + 512);
          p0 = __builtin_amdgcn_mfma_f32_32x32x16_bf16(b0, qr[d0], p0, 0, 0, 0);
          p1 = __builtin_amdgcn_mfma_f32_32x32x16_bf16(b1, qr[d0], p1, 0, 0, 0);
        }
      }
      if (jb >= 0) {
        const int kb0 = 64 * jb + 4 * hi;
#pragma unroll
        for (int r = 0; r < 16; ++r) { const int kv = kb0 + (r & 3) + 8 * (r >> 2); if (kv > qrel) p0[r] = -INFINITY; if (kv + 32 > qrel) p1[r] = -INFINITY; }
      }
      float rm = fmaxf(p0[0], p1[0]);
#pragma unroll
      for (int r = 1; r < 16; ++r) rm = fmaxf(rm, fmaxf(p0[r], p1[r]));
      rm = xhalf_max(rm);
      const float mnew = fmaxf(mhat, rm);
      if (__any(mnew > mhat)) {
        const float alpha = __builtin_amdgcn_exp2f(mhat - mnew);
        l *= alpha; mhat = mnew;
        if (hi == 0) wsf[r32] = alpha;
        __builtin_amdgcn_wave_barrier();
#pragma unroll
        for (int r = 0; r < 16; ++r) { const float f = wsf[crow(r, hi)]; o[0][r] *= f; o[1][r] *= f; }
        __builtin_amdgcn_wave_barrier();
      }
      float sacc = 0.f;
#pragma unroll
      for (int r = 0; r < 16; ++r) { p0[r] = __builtin_amdgcn_exp2f(p0[r] - mhat); p1[r] = __builtin_amdgcn_exp2f(p1[r] - mhat); sacc += p0[r] + p1[r]; }
      l += sacc;
      u32x4 pw0, pw1, pw2, pw3;
      pw0 = (u32x4){cvtpk(p0[0], p0[1]), cvtpk(p0[2], p0[3]), cvtpk(p0[4], p0[5]), cvtpk(p0[6], p0[7])};
      pw1 = (u32x4){cvtpk(p0[8], p0[9]), cvtpk(p0[10], p0[11]), cvtpk(p0[12], p0[13]), cvtpk(p0[14], p0[15])};
      pw2 = (u32x4){cvtpk(p1[0], p1[1]), cvtpk(p1[2], p1[3]), cvtpk(p1[4], p1[5]), cvtpk(p1[6], p1[7])};
      pw3 = (u32x4){cvtpk(p1[8], p1[9]), cvtpk(p1[10], p1[11]), cvtpk(p1[12], p1[13]), cvtpk(p1[14], p1[15])};
      const lds_cptr vp = vp0 + buf;
#pragma unroll
      for (int d0 = 0; d0 < 2; ++d0) {
#define ATT_VF(ks) ({ const s16x4 lo_ = vtr(vp + d0 * 4096 + (ks) * 1024), hi_ = vtr(vp + d0 * 4096 + (ks) * 1024 + 512); (bf16x8){lo_[0], lo_[1], lo_[2], lo_[3], hi_[0], hi_[1], hi_[2], hi_[3]}; })
        o[d0] = __builtin_amdgcn_mfma_f32_32x32x16_bf16(__builtin_bit_cast(bf16x8, pw0), ATT_VF(0), o[d0], 0, 0, 0);
        o[d0] = __builtin_amdgcn_mfma_f32_32x32x16_bf16(__builtin_bit_cast(bf16x8, pw1), ATT_VF(1), o[d0], 0, 0, 0);
        o[d0] = __builtin_amdgcn_mfma_f32_32x32x16_bf16(__builtin_bit_cast(bf16x8, pw2), ATT_VF(2), o[d0], 0, 0, 0);
        o[d0] = __builtin_amdgcn_mfma_f32_32x32x16_bf16(__builtin_bit_cast(bf16x8, pw3), ATT_VF(3), o[d0], 0, 0, 0);
#undef ATT_VF
      }
    }
    if (t + 1 < NTL) { *(u32x4*)(kdst + ((t + 1) & 1) * 8192) = kreg; *(u32x4*)(vdst + ((t + 1) & 1) * 8192) = vreg; }
    __syncthreads();
  }
  l = xhalf_sum(l);
  if (hi == 0) wsf[32 + r32] = l;
  __builtin_amdgcn_wave_barrier();
  bf16_t* stg = (bf16_t*)(lds + L_OST) + wid * 2048;
#pragma unroll
  for (int r = 0; r < 16; ++r) { const int orow = crow(r, hi); const float rl = 1.f / wsf[32 + orow];
    stg[orow * 64 + r32] = (bf16_t)f2bf(o[0][r] * rl); stg[orow * 64 + 32 + r32] = (bf16_t)f2bf(o[1][r] * rl); }
  __builtin_amdgcn_wave_barrier();
  bf16_t* Ow = (bf16_t*)(ws + WS_OAB) + (rowbase + q0 + wid * 32) * DM + (MODE ? 512 : 0) + h * 64;
#pragma unroll
  for (int i = 0; i < 4; ++i) { const int row = i * 8 + (lane >> 3), ch = lane & 7; const u32x4 v = *(const u32x4*)(stg + row * 64 + ch * 8); *(u32x4*)(Ow + (size_t)row * DM + ch * 8) = v; }
}
}

__device__ __forceinline__ void phase_attn2(const Args& a, unsigned char* lds, int tid) {
  unsigned* ctr = (unsigned*)(a.ws + 0);
  unsigned* slot = (unsigned*)(lds + att::L_MISC + 64);
  for (;;) {
    __syncthreads();
    if (tid == 0) slot[0] = atomicAdd(ctr, 1u);
    __syncthreads();
    const unsigned u = slot[0];
    if (u >= 2048u) break;
    const int qb = 15 - (int)(u >> 7), r = u & 127, mode = r & 1, bh = r >> 1;
    if (mode == 0) att::unit<0>(a, lds, bh >> 3, bh & 7, qb, tid);
    else att::unit<1>(a, lds, bh >> 3, bh & 7, qb, tid);
  }
}

__device__ __forceinline__ void phase_onorm(const Args& a, int gw, int ngw, int lane) {
  bf16_t* oab = (bf16_t*)(a.ws + WS_OAB);
  for (int r = gw; r < NT; r += ngw) {
    u32x4* p = (u32x4*)(oab + (size_t)r * DM) + 2 * lane;
    const u32x4 w0 = p[0], w1 = p[1]; float f[16]; unpack8(w0, f); unpack8(w1, f + 8);
    float s = 0.f;
#pragma unroll
    for (int i = 0; i < 16; ++i) s += f[i] * f[i];
#pragma unroll
    for (int o = 1; o < 32; o <<= 1) s += __shfl_xor(s, o);
    const float rstd = rsqrtf(s * (1.f / 512.f) + EPS);
    u32x4 o0, o1;
    o0.x = pk2(f[0] * rstd, f[1] * rstd); o0.y = pk2(f[2] * rstd, f[3] * rstd); o0.z = pk2(f[4] * rstd, f[5] * rstd); o0.w = pk2(f[6] * rstd, f[7] * rstd);
    o1.x = pk2(f[8] * rstd, f[9] * rstd); o1.y = pk2(f[10] * rstd, f[11] * rstd); o1.z = pk2(f[12] * rstd, f[13] * rstd); o1.w = pk2(f[14] * rstd, f[15] * rstd);
    p[0] = o0; p[1] = o1;
  }
}

__device__ __forceinline__ void phase_rms(const Args& a, int gw, int ngw, int lane) {
  for (int r = gw; r < NT; r += ngw) rms_row_to_bf16(a.out + (size_t)r * DM, (bf16_t*)(a.ws + WS_HB) + (size_t)r * DM, lane);
}

__device__ __forceinline__ void phase_xattn(const Args& a, unsigned char* lds, int gw, int ngw, int wave, int lane) {
  unsigned char* ws = a.ws;
  const bf16_t* qx = (const bf16_t*)(ws + WS_QX); const bf16_t* kx = (const bf16_t*)(ws + WS_KX); const bf16_t* vxt = (const bf16_t*)(ws + WS_VXT);
  bf16_t* ox = (bf16_t*)(ws + WS_OX);
  bf16_t* P = (bf16_t*)(lds + wave * 8192);
  const int fr = lane & 15, fq = lane >> 4;
  for (int u = gw; u < (NT / 16) * 4; u += ngw) {
    const int hd = u & 3, r0 = (u >> 2) * 16, b = r0 / SEQ;
    f32x4 acc[16];
#pragma unroll
    for (int i = 0; i < 16; ++i) acc[i] = (f32x4){0.f, 0.f, 0.f, 0.f};
    const bf16_t* Ap = qx + (size_t)(r0 + fr) * DM + hd * 256 + fq * 8;
    const bf16_t* Bp = kx + (size_t)(b * 256 + fr) * DM + hd * 256 + fq * 8;
    for (int ks = 0; ks < 8; ++ks) {
      const bf16x8 af = *(const bf16x8*)(Ap + ks * 32);
#pragma unroll
      for (int ct = 0; ct < 16; ++ct) { const bf16x8 bfr = *(const bf16x8*)(Bp + (size_t)ct * 16 * DM + ks * 32); acc[ct] = __builtin_amdgcn_mfma_f32_16x16x32_bf16(af, bfr, acc[ct], 0, 0, 0); }
    }
    float mx[4], sm[4];
#pragma unroll
    for (int r = 0; r < 4; ++r) { float m = acc[0][r];
#pragma unroll
      for (int ct = 1; ct < 16; ++ct) m = fmaxf(m, acc[ct][r]);
#pragma unroll
      for (int o = 1; o < 16; o <<= 1) m = fmaxf(m, __shfl_xor(m, o));
      mx[r] = m; sm[r] = 0.f; }
#pragma unroll
    for (int ct = 0; ct < 16; ++ct)
#pragma unroll
      for (int r = 0; r < 4; ++r) { const float p = __expf((acc[ct][r] - mx[r]) * 0.0625f); acc[ct][r] = p; sm[r] += p; }
#pragma unroll
    for (int r = 0; r < 4; ++r) {
#pragma unroll
      for (int o = 1; o < 16; o <<= 1) sm[r] += __shfl_xor(sm[r], o);
      sm[r] = 1.f / sm[r]; }
    __builtin_amdgcn_wave_barrier();
#pragma unroll
    for (int ct = 0; ct < 16; ++ct)
#pragma unroll
      for (int r = 0; r < 4; ++r) P[(4 * fq + r) * 256 + ct * 16 + fr] = (bf16_t)f2bf(acc[ct][r] * sm[r]);
    __builtin_amdgcn_wave_barrier();
    asm volatile("s_waitcnt lgkmcnt(0)" ::: "memory");
#pragma unroll
    for (int i = 0; i < 16; ++i) acc[i] = (f32x4){0.f, 0.f, 0.f, 0.f};
    const bf16_t* Vp = vxt + ((size_t)(b * 4 + hd) * 256 + fr) * 256 + fq * 8;
    for (int ks = 0; ks < 8; ++ks) {
      const bf16x8 pf = *(const bf16x8*)(P + fr * 256 + ks * 32 + fq * 8);
#pragma unroll
      for (int dt = 0; dt < 16; ++dt) { const bf16x8 vf = *(const bf16x8*)(Vp + (size_t)dt * 16 * 256 + ks * 32); acc[dt] = __builtin_amdgcn_mfma_f32_16x16x32_bf16(pf, vf, acc[dt], 0, 0, 0); }
    }
#pragma unroll
    for (int dt = 0; dt < 16; ++dt)
#pragma unroll
      for (int r = 0; r < 4; ++r) ox[(size_t)(r0 + 4 * fq + r) * DM + hd * 256 + dt * 16 + fr] = (bf16_t)f2bf(acc[dt][r]);
    __builtin_amdgcn_wave_barrier();
  }
}

namespace xa {
using att::f32x16; using att::s16x4; using att::lds_cptr; using att::crow; using att::cvtpk; using att::vtr; using att::xhalf_max; using att::xhalf_sum;
constexpr int L_WSF = 65536;
__device__ __forceinline__ void unit(const Args& a, unsigned char* lds, int b, int hd, int qb, int tid) {
  unsigned char* ws = a.ws;
  const int lane = tid & 63, r32 = lane & 31, hi = lane >> 5; const int wid = __builtin_amdgcn_readfirstlane(tid >> 6);
  const bf16_t* qrow = (const bf16_t*)(ws + WS_QX) + ((size_t)b * SEQ + qb * 256 + wid * 32 + r32) * DM + hd * 256;
  const bf16_t* kvb = (const bf16_t*)(ws + WS_KX) + (size_t)b * 256 * 2048 + hd * 256;
  const bf16_t* ksrc = kvb + (size_t)lane * 2048 + wid * 8;
  const bf16_t* vsrc = kvb + 1024 + (size_t)(16 * (wid & 3) + (lane >> 2)) * 2048 + (wid >> 2) * 32 + (lane & 3) * 8;
  unsigned char* sdst = lds + wid * 1024 + lane * 16;
  const lds_cptr lds3 = (lds_cptr)lds;
  const lds_cptr kp0 = lds3 + hi * 1024 + r32 * 16;
  const lds_cptr vp0 = lds3 + ((lane >> 4) & 1) * 32 + (lane & 3) * 8 + (4 * hi + ((lane & 15) >> 2)) * 64;
  float* wsf = (float*)(lds + L_WSF) + wid * 64;
  u32x4 sreg[4];
#define XA_LOADK(c) do { _Pragma("unroll") for (int kt = 0; kt < 4; ++kt) sreg[kt] = *(const u32x4*)(ksrc + (size_t)kt * 64 * 2048 + (c) * 64); } while (0)
#define XA_LOADV(vt) do { _Pragma("unroll") for (int dq = 0; dq < 4; ++dq) sreg[dq] = *(const u32x4*)(vsrc + (size_t)(vt) * 64 * 2048 + dq * 64); } while (0)
#define XA_WRITE(buf) do { _Pragma("unroll") for (int i = 0; i < 4; ++i) *(u32x4*)(sdst + (buf) * 32768 + i * 8192) = sreg[i]; } while (0)
  __syncthreads();
  XA_LOADK(0); XA_WRITE(0);
  f32x16 acc[8];
#pragma unroll
  for (int j = 0; j < 8; ++j) acc[j] = f32x16{};
  __syncthreads();
#pragma unroll
  for (int c = 0; c < 4; ++c) {
    if (c < 3) XA_LOADK(c + 1); else XA_LOADV(0);
    bf16x8 qf[4];
#pragma unroll
    for (int d0 = 0; d0 < 4; ++d0) qf[d0] = *(const bf16x8*)(qrow + c * 64 + d0 * 16 + hi * 8);
    const lds_cptr kp = kp0 + (c & 1) * 32768;
#pragma unroll
    for (int d0 = 0; d0 < 4; ++d0)
#pragma unroll
      for (int j = 0; j < 8; ++j) {
        const bf16x8 kf = *(const __attribute__((address_space(3))) bf16x8*)(kp + (j >> 1) * 8192 + d0 * 2048 + (j & 1) * 512);
        acc[j] = __builtin_amdgcn_mfma_f32_32x32x16_bf16(kf, qf[d0], acc[j], 0, 0, 0);
      }
    XA_WRITE((c + 1) & 1);
    __syncthreads();
  }
  float m = acc[0][0];
#pragma unroll
  for (int j = 0; j < 8; ++j)
#pragma unroll
    for (int r = 0; r < 16; ++r) m = fmaxf(m, acc[j][r]);
  m = xhalf_max(m);
  constexpr float CS = 1.4426950408889634f / 16.f;
  float l = 0.f; u32x4 pw[16];
#pragma unroll
  for (int j = 0; j < 8; ++j) {
#pragma unroll
    for (int r = 0; r < 16; ++r) { const float p = __builtin_amdgcn_exp2f((acc[j][r] - m) * CS); acc[j][r] = p; l += p; }
    pw[2 * j] = (u32x4){cvtpk(acc[j][0], acc[j][1]), cvtpk(acc[j][2], acc[j][3]), cvtpk(acc[j][4], acc[j][5]), cvtpk(acc[j][6], acc[j][7])};
    pw[2 * j + 1] = (u32x4){cvtpk(acc[j][8], acc[j][9]), cvtpk(acc[j][10], acc[j][11]), cvtpk(acc[j][12], acc[j][13]), cvtpk(acc[j][14], acc[j][15])};
  }
  l = xhalf_sum(l);
#pragma unroll
  for (int j = 0; j < 8; ++j) acc[j] = f32x16{};
#pragma unroll
  for (int vt = 0; vt < 4; ++vt) {
    if (vt < 3) XA_LOADV(vt + 1);
    const lds_cptr vp = vp0 + (vt & 1) * 32768;
#pragma unroll
    for (int ks = 0; ks < 4; ++ks)
#pragma unroll
      for (int db = 0; db < 8; ++db) {
        const s16x4 lo_ = vtr(vp + (db >> 1) * 8192 + (db & 1) * 4096 + ks * 1024), hi_ = vtr(vp + (db >> 1) * 8192 + (db & 1) * 4096 + ks * 1024 + 512);
        const bf16x8 vf = (bf16x8){lo_[0], lo_[1], lo_[2], lo_[3], hi_[0], hi_[1], hi_[2], hi_[3]};
        acc[db] = __builtin_amdgcn_mfma_f32_32x32x16_bf16(__builtin_bit_cast(bf16x8, pw[4 * vt + ks]), vf, acc[db], 0, 0, 0);
      }
    if (vt < 3) XA_WRITE((vt + 1) & 1);
    __syncthreads();
  }
  if (hi == 0) wsf[r32] = l;
  __builtin_amdgcn_wave_barrier();
  float rl[16];
#pragma unroll
  for (int r = 0; r < 16; ++r) rl[r] = 1.f / wsf[crow(r, hi)];
  bf16_t* stg = (bf16_t*)(lds + wid * 8192);
  bf16_t* orow0 = (bf16_t*)(ws + WS_OX) + ((size_t)b * SEQ + qb * 256 + wid * 32) * DM + hd * 256;
#pragma unroll
  for (int hf = 0; hf < 2; ++hf) {
#pragma unroll
    for (int db = 0; db < 4; ++db)
#pragma unroll
      for (int r = 0; r < 16; ++r) stg[crow(r, hi) * 128 + db * 32 + r32] = (bf16_t)f2bf(acc[hf * 4 + db][r] * rl[r]);
    __builtin_amdgcn_wave_barrier();
#pragma unroll
    for (int i = 0; i < 8; ++i) { const int row = i * 4 + (lane >> 4), ch = lane & 15; const u32x4 v = *(const u32x4*)(stg + row * 128 + ch * 8); *(u32x4*)(orow0 + (size_t)row * DM + hf * 128 + ch * 8) = v; }
    __builtin_amdgcn_wave_barrier();
  }
#undef XA_LOADK
#undef XA_LOADV
#undef XA_WRITE
}
}

__device__ __forceinline__ void phase_xattn2(const Args& a, unsigned char* lds, int tid) {
  for (int u = blockIdx.x; u < NB * 4 * 16; u += gridDim.x) { const int qb = u & 15, hd = (u >> 4) & 3, b = u >> 6; xa::unit(a, lds, b, hd, qb, tid); }
}

__device__ __forceinline__ unsigned fkey(float s, unsigned idx, unsigned mask) { unsigned u = __float_as_uint(s); u ^= (unsigned)((int)u >> 31) | 0x80000000u; return (u & ~mask) | (mask - idx); }
__device__ __forceinline__ float keyval(unsigned k, unsigned mask) { unsigned u = k & ~mask; u = (u & 0x80000000u) ? (u ^ 0x80000000u) : ~u; return __uint_as_float(u); }
#define KEY_INSERT(KA, key_) do { unsigned k__ = (key_); \
  _Pragma("unroll") for (int s_ = 0; s_ < 16; ++s_) { const unsigned hi_ = max(k__, KA[s_]); k__ = min(k__, KA[s_]); KA[s_] = hi_; } } while (0)

__device__ __forceinline__ void phase_topk(const Args& a, unsigned char* lds, int tid) {
  unsigned char* ws = a.ws;
  const float* pq = (const float*)(ws + WS_PQ);
  int* eidx = (int*)(ws + WS_EIDX); float* gate = (float*)(ws + WS_GATE);
  float* K1 = (float*)lds; float* K2 = K1 + 128 * 64; unsigned* KL = (unsigned*)(lds + 65536);
  for (int u = blockIdx.x; u < 8 * (NT / 512); u += gridDim.x) {
    const int h = u & 7, t = (u >> 3) * 512 + tid;
    __syncthreads();
    for (int i = tid; i < 128 * 64 / 4; i += 512) { ((f32x4*)K1)[i] = ((const f32x4*)(a.in[17] + (size_t)h * 8192))[i]; ((f32x4*)K2)[i] = ((const f32x4*)(a.in[18] + (size_t)h * 8192))[i]; }
    __syncthreads();
    unsigned ka[16], kb[16], kc[16];
#pragma unroll
    for (int k = 0; k < 16; ++k) { ka[k] = 0u; kb[k] = 0u; kc[k] = 0u; }
    float q[64];
    const f32x4* qp = (const f32x4*)(pq + (size_t)t * DM + h * 128);
#pragma unroll
    for (int c = 0; c < 16; ++c) { const f32x4 w = qp[c]; q[4 * c] = w.x; q[4 * c + 1] = w.y; q[4 * c + 2] = w.z; q[4 * c + 3] = w.w; }
    for (int n = 0; n < 128; ++n) {
      const f32x4* kr = (const f32x4*)(K1 + n * 64); float s = 0.f;
#pragma unroll
      for (int c = 0; c < 16; ++c) { const f32x4 kv = kr[c]; s += q[4 * c] * kv.x + q[4 * c + 1] * kv.y + q[4 * c + 2] * kv.z + q[4 * c + 3] * kv.w; }
      KEY_INSERT(ka, fkey(s, (unsigned)n, 127u));
    }
#pragma unroll
    for (int c = 0; c < 16; ++c) { const f32x4 w = qp[16 + c]; q[4 * c] = w.x; q[4 * c + 1] = w.y; q[4 * c + 2] = w.z; q[4 * c + 3] = w.w; }
    for (int n = 0; n < 128; ++n) {
      const f32x4* kr = (const f32x4*)(K2 + n * 64); float s = 0.f;
#pragma unroll
      for (int c = 0; c < 16; ++c) { const f32x4 kv = kr[c]; s += q[4 * c] * kv.x + q[4 * c + 1] * kv.y + q[4 * c + 2] * kv.z + q[4 * c + 3] * kv.w; }
      KEY_INSERT(kb, fkey(s, (unsigned)n, 127u));
    }
#pragma unroll
    for (int x = 0; x < 16; ++x)
#pragma unroll
      for (int y = 0; y < 16; ++y)
        if ((x + 1) * (y + 1) <= 16) { KEY_INSERT(kc, fkey(keyval(ka[x], 127u) + keyval(kb[y], 127u), (unsigned)(x * 16 + y), 255u)); }
#pragma unroll
    for (int k = 0; k < 16; ++k) { KL[k * 512 + tid] = ka[k]; KL[(16 + k) * 512 + tid] = kb[k]; }
    float val[16]; int id[16]; float sum = 0.f;
#pragma unroll
    for (int k = 0; k < 16; ++k) {
      const unsigned flat = 255u - (kc[k] & 255u);
      const unsigned k1 = KL[(flat >> 4) * 512 + tid], k2 = KL[(16 + (flat & 15u)) * 512 + tid];
      val[k] = keyval(k1, 127u) + keyval(k2, 127u);
      id[k] = (int)((127u - (k1 & 127u)) * 128u + (127u - (k2 & 127u)));
    }
    const float vmax = val[0];
#pragma unroll
    for (int k = 0; k < 16; ++k) { val[k] = __expf(val[k] - vmax); sum += val[k]; }
    const float inv = 1.f / sum;
    int* ep = eidx + (size_t)t * 128 + h * 16; float* gp = gate + (size_t)t * 128 + h * 16;
#pragma unroll
    for (int k = 0; k < 16; ++k) { ep[k] = id[k]; gp[k] = val[k] * inv; }
  }
}


namespace tk {
typedef float f32x16 __attribute__((ext_vector_type(16)));
__device__ __forceinline__ void ce(unsigned& a, unsigned& b) { const unsigned h = max(a, b), l = min(a, b); a = h; b = l; }
__device__ __forceinline__ void sort16(unsigned (&v)[16]) {
#pragma unroll
  for (int k = 2; k <= 16; k <<= 1)
#pragma unroll
    for (int j = k >> 1; j > 0; j >>= 1)
#pragma unroll
      for (int i = 0; i < 16; ++i) { const int l = i ^ j; if (l > i) { if ((i & k) == 0) ce(v[i], v[l]); else ce(v[l], v[i]); } }
}
__device__ __forceinline__ void topmerge(unsigned (&a)[16], const unsigned (&b)[16]) {
#pragma unroll
  for (int i = 0; i < 16; ++i) a[i] = max(a[i], b[15 - i]);
#pragma unroll
  for (int j = 8; j > 0; j >>= 1)
#pragma unroll
    for (int i = 0; i < 16; ++i) { const int l = i ^ j; if (l > i) ce(a[i], a[l]); }
}
__device__ __forceinline__ unsigned xswap(unsigned v, int hi) { auto rr = __builtin_amdgcn_permlane32_swap(v, v, false, false); return hi ? rr[0] : rr[1]; }
__device__ __forceinline__ void half_list(unsigned (&L)[16], const bf16_t* skh, const bf16_t* qrow, int r32, int hi) {
  f32x16 acc[4];
#pragma unroll
  for (int i = 0; i < 4; ++i) acc[i] = f32x16{};
#pragma unroll
  for (int ks = 0; ks < 4; ++ks) {
    const bf16x8 qf = *(const bf16x8*)(qrow + ks * 16 + hi * 8);
#pragma unroll
    for (int tl = 0; tl < 4; ++tl) { const bf16x8 kf = *(const bf16x8*)(skh + (size_t)(tl * 32 + r32) * 64 + ks * 16 + hi * 8); acc[tl] = __builtin_amdgcn_mfma_f32_32x32x16_bf16(kf, qf, acc[tl], 0, 0, 0); }
  }
  unsigned g[4][16];
#pragma unroll
  for (int tl = 0; tl < 4; ++tl)
#pragma unroll
    for (int r = 0; r < 16; ++r) g[tl][r] = fkey(acc[tl][r], (unsigned)(32 * tl + (r & 3) + 8 * (r >> 2) + 4 * hi), 127u);
  sort16(g[0]); sort16(g[1]); sort16(g[2]); sort16(g[3]);
  topmerge(g[0], g[1]); topmerge(g[2], g[3]); topmerge(g[0], g[2]);
  unsigned p[16];
#pragma unroll
  for (int k = 0; k < 16; ++k) p[k] = xswap(g[0][k], hi);
  topmerge(g[0], p);
#pragma unroll
  for (int k = 0; k < 16; ++k) L[k] = g[0][k];
}
}

__device__ __forceinline__ void phase_topk2(const Args& a, unsigned char* lds, int wave, int lane) {
  unsigned char* ws = a.ws;
  const bf16_t* pq = (const bf16_t*)(ws + WS_PQ); const bf16_t* sk = (const bf16_t*)(ws + WS_SK);
  int* eidx = (int*)(ws + WS_EIDX); float* gate = (float*)(ws + WS_GATE);
  const int r32 = lane & 31, hi = lane >> 5, h = wave;
  unsigned* KL = (unsigned*)(lds + wave * 4096);
  for (int tt = blockIdx.x; tt < NT / 32; tt += gridDim.x) {
    const int t = tt * 32 + r32;
    unsigned ka[16], kb[16], kc[16];
    tk::half_list(ka, sk + (size_t)(0 * 8 + h) * 8192, pq + (size_t)t * DM + h * 128, r32, hi);
    tk::half_list(kb, sk + (size_t)(1 * 8 + h) * 8192, pq + (size_t)t * DM + h * 128 + 64, r32, hi);
    float va[16], vb[16];
#pragma unroll
    for (int k = 0; k < 16; ++k) { va[k] = keyval(ka[k], 127u); vb[k] = keyval(kb[k], 127u); }
#pragma unroll
    for (int y = 0; y < 16; ++y) kc[y] = hi ? 0u : fkey(va[0] + vb[y], (unsigned)y, 255u);
#define TK_CAND(xa, ya, xb, yb) do { const unsigned kA_ = fkey(va[xa] + vb[ya], (unsigned)((xa) * 16 + (ya)), 255u), kB_ = fkey(va[xb] + vb[yb], (unsigned)((xb) * 16 + (yb)), 255u); KEY_INSERT(kc, hi ? kB_ : kA_); } while (0)
    TK_CAND(1, 0, 1, 1);
    TK_CAND(1, 2, 1, 3);
    TK_CAND(1, 4, 1, 5);
    TK_CAND(1, 6, 1, 7);
    TK_CAND(2, 0, 2, 1);
    TK_CAND(2, 2, 2, 3);
    TK_CAND(2, 4, 3, 0);
    TK_CAND(3, 1, 3, 2);
    TK_CAND(3, 3, 4, 0);
    TK_CAND(4, 1, 4, 2);
    TK_CAND(5, 0, 5, 1);
    TK_CAND(6, 0, 6, 1);
    TK_CAND(7, 0, 7, 1);
    TK_CAND(8, 0, 9, 0);
    TK_CAND(10, 0, 11, 0);
    TK_CAND(12, 0, 13, 0);
    TK_CAND(14, 0, 15, 0);
#undef TK_CAND
    { unsigned p[16];
#pragma unroll
      for (int k = 0; k < 16; ++k) p[k] = tk::xswap(kc[k], hi);
      tk::topmerge(kc, p); }
    if (hi == 0) {
#pragma unroll
      for (int k = 0; k < 16; ++k) { KL[k * 32 + r32] = ka[k]; KL[(16 + k) * 32 + r32] = kb[k]; }
    }
    __builtin_amdgcn_wave_barrier();
    const float vmax = va[0] + vb[0];
    float pv[8]; int id[8]; float s = 0.f;
#pragma unroll
    for (int j = 0; j < 8; ++j) {
      unsigned klo_ = kc[j], khi_ = kc[8 + j]; asm volatile("" : "+v"(klo_), "+v"(khi_));
      const unsigned key = hi ? khi_ : klo_;
      const unsigned flat = 255u - (key & 255u);
      const unsigned k1 = KL[(flat >> 4) * 32 + r32], k2 = KL[(16 + (flat & 15u)) * 32 + r32];
      pv[j] = __expf(keyval(k1, 127u) + keyval(k2, 127u) - vmax); s += pv[j];
      id[j] = (int)((127u - (k1 & 127u)) * 128u + (127u - (k2 & 127u)));
    }
    __builtin_amdgcn_wave_barrier();
    const float inv = 1.f / att::xhalf_sum(s);
    u32x4* ep = (u32x4*)(eidx + (size_t)t * 128 + h * 16 + hi * 8); f32x4* gp = (f32x4*)(gate + (size_t)t * 128 + h * 16 + hi * 8);
    ep[0] = (u32x4){(unsigned)id[0], (unsigned)id[1], (unsigned)id[2], (unsigned)id[3]}; ep[1] = (u32x4){(unsigned)id[4], (unsigned)id[5], (unsigned)id[6], (unsigned)id[7]};
    gp[0] = (f32x4){pv[0] * inv, pv[1] * inv, pv[2] * inv, pv[3] * inv}; gp[1] = (f32x4){pv[4] * inv, pv[5] * inv, pv[6] * inv, pv[7] * inv};
  }
}

__device__ __forceinline__ float gelu_erf(float v) { return 0.5f * v * (1.f + erff(v * 0.70710678118654752f)); }

__device__ __forceinline__ void phase_experts(const Args& a, int gw, int ngw, int lane, float* outp) {
  unsigned char* ws = a.ws;
  const int* eidx = (const int*)(ws + WS_EIDX); const float* gate = (const float*)(ws + WS_GATE);
  const unsigned char* exd = ws + WS_EXD; const unsigned char* exu = ws + WS_EXU; const float* esc = (const float*)(ws + WS_ESC);
  for (int t = gw; t < NT; t += ngw) {
    const f32x4* xr = (const f32x4*)(a.out + (size_t)t * DM) + 4 * lane;
    f32x4 x[4], acc[4]; float hg[16]; float s = 0.f;
#pragma unroll
    for (int k = 0; k < 4; ++k) { x[k] = xr[k]; s += (x[k].x * x[k].x + x[k].y * x[k].y) + (x[k].z * x[k].z + x[k].w * x[k].w); acc[k] = (f32x4){0.f, 0.f, 0.f, 0.f}; }
    const float rstd = rsqrtf(wave_sum(s) * (1.f / DM) + EPS);
#pragma unroll
    for (int k = 0; k < 4; ++k) { const f32x4 g = ((const f32x4*)a.in[15])[4 * lane + k]; const f32x4 hv = x[k] * rstd * g; hg[4 * k] = hv.x; hg[4 * k + 1] = hv.y; hg[4 * k + 2] = hv.z; hg[4 * k + 3] = hv.w; }
    const int e0 = eidx[(size_t)t * 128 + lane], e1 = eidx[(size_t)t * 128 + 64 + lane];
    const float sd0 = esc[e0], sd1 = esc[e1];
    const float gu0 = gate[(size_t)t * 128 + lane] * esc[NEXP + e0], gu1 = gate[(size_t)t * 128 + 64 + lane] * esc[NEXP + e1];
    for (int e = 0; e < 128; e += 8) {
      u32x4 ur[8], vr[8]; float dot[8];
#pragma unroll
      for (int i = 0; i < 8; ++i) {
        const int ee = e + i; const int id = (e < 64) ? __shfl(e0, ee) : __shfl(e1, ee - 64);
        ur[i] = *((const u32x4*)(exd + (size_t)id * DM) + lane);
        vr[i] = *((const u32x4*)(exu + (size_t)id * DM) + lane);
      }
#pragma unroll
      for (int i = 0; i < 8; ++i) {
        float d = 0.f;
#pragma unroll
        for (int k = 0; k < 4; ++k) { const auto lo = __builtin_amdgcn_cvt_pk_f32_fp8((int)ur[i][k], false); const auto hi = __builtin_amdgcn_cvt_pk_f32_fp8((int)ur[i][k], true);
          d += hg[4 * k] * lo[0] + hg[4 * k + 1] * lo[1] + hg[4 * k + 2] * hi[0] + hg[4 * k + 3] * hi[1]; }
        dot[i] = wave_sum(d);
      }
#pragma unroll
      for (int i = 0; i < 8; ++i) {
        const int ee = e + i;
        const float sd = (e < 64) ? __shfl(sd0, ee) : __shfl(sd1, ee - 64);
        const float gu = (e < 64) ? __shfl(gu0, ee) : __shfl(gu1, ee - 64);
        const float w = gu * gelu_erf(dot[i] * sd);
#pragma unroll
        for (int k = 0; k < 4; ++k) { const auto lo = __builtin_amdgcn_cvt_pk_f32_fp8((int)vr[i][k], false); const auto hi = __builtin_amdgcn_cvt_pk_f32_fp8((int)vr[i][k], true);
          acc[k].x += w * lo[0]; acc[k].y += w * lo[1]; acc[k].z += w * hi[0]; acc[k].w += w * hi[1]; }
      }
    }
    float s2 = 0.f;
#pragma unroll
    for (int k = 0; k < 4; ++k) { x[k] = x[k] + acc[k]; s2 += (x[k].x * x[k].x + x[k].y * x[k].y) + (x[k].z * x[k].z + x[k].w * x[k].w); }
    const float r2 = rsqrtf(wave_sum(s2) * (1.f / DM) + EPS);
    f32x4* orow = (f32x4*)(outp + (size_t)t * DM) + 4 * lane;
#pragma unroll
    for (int k = 0; k < 4; ++k) { const f32x4 g = ((const f32x4*)a.in[21])[4 * lane + k]; orow[k] = x[k] * r2 * g; }
  }
}

namespace pg8 {
#define PG8_LAS __attribute__((address_space(3)))
typedef unsigned short bf16_t;
typedef short bf16x8 __attribute__((ext_vector_type(8)));
typedef float f32x4 __attribute__((ext_vector_type(4)));
typedef unsigned u32x4 __attribute__((ext_vector_type(4)));
constexpr int BM = 256, BK = 64, HALF = 128, HTB = HALF * BK * 2  , STAGE_BYTES = 8 * HTB, NXCD = 8, WGM = 8;

__host__ __device__ __forceinline__ int lds_byte(int r, int c) { const int st = (r >> 4) * 2 + (c >> 5), rr = r & 15, cc = c & 31, ob = rr * 64 + cc * 2; return st * 1024 + (ob ^ (((ob >> 9) & 1) << 5)); }
__host__ __device__ __forceinline__ void stage_rc(int b, int& R, int& C) { const int st = b / 1024, sb = b % 1024, swz = sb ^ (((sb >> 9) & 1) << 5); R = (st >> 1) * 16 + swz / 64; C = (st & 1) * 32 + (swz % 64) / 2; }
__host__ __device__ __forceinline__ int perm32(int rho) { const int n = rho >> 4, i = rho & 15; return 8 * (i >> 2) + 4 * n + (i & 3); }

struct Unit { int pm, pn; };
struct Gemm { const bf16_t* A; const bf16_t* Bt; int M, N, K; };

struct StaticOrder {
    int nM, nN, nwg, G, c;
    __host__ __device__ void init(int M, int N, int G_, int c_) { nM = M / BM; nN = N / BM; nwg = nM * nN; G = G_; c = c_; }
    __host__ __device__ bool next(int i, Unit& u) const {
        const long L = (long)i * G + c; if (L >= nwg) return false;
        int wgid = (int)L; { const int q = nwg / NXCD, r = nwg % NXCD, xcd = wgid % NXCD, off = wgid / NXCD; wgid = (xcd < r ? xcd * (q + 1) : r * (q + 1) + (xcd - r) * q) + off; }
        const int nig = WGM * nN, gid = wgid / nig, fm = gid * WGM, gsz = (nM - fm) < WGM ? (nM - fm) : WGM;
        u.pm = fm + ((wgid % nig) % gsz); u.pn = (wgid % nig) / gsz; return true;
    }
    __device__ __forceinline__ void a_ready(const Unit&) const {}
    __device__ __forceinline__ void done(const Unit&) const {}
};

template <class St> struct EpiAdapt {
    static constexpr bool PERM = false, AFTER_DRAIN = false; St st;
    __device__ __forceinline__ void operator()(const f32x4 (&acc)[2][2][4][2], const Unit& u, int wr, int wc, int fr, int fq) const {
#pragma unroll
        for (int ai = 0; ai < 2; ++ai)
#pragma unroll
            for (int m = 0; m < 4; ++m)
#pragma unroll
                for (int bj = 0; bj < 2; ++bj)
#pragma unroll
                    for (int n = 0; n < 2; ++n) st.store(u.pm * BM + ai * HALF + wr * 64 + m * 16 + fr, u.pn * BM + bj * HALF + wc * 32 + n * 16 + 4 * fq, acc[ai][bj][m][n]);
    }
};

struct EpiResidSS {
    static constexpr bool PERM = false, AFTER_DRAIN = false; const float* base; float* out; bf16_t* hb; float* ss;
    __device__ __forceinline__ void operator()(const f32x4 (&acc)[2][2][4][2], const Unit& u, int wr, int wc, int fr, int fq) const {
#pragma unroll
        for (int ai = 0; ai < 2; ++ai)
#pragma unroll
            for (int m = 0; m < 4; ++m) {
                const int row = u.pm * BM + ai * HALF + wr * 64 + m * 16 + fr; float s = 0.f;
#pragma unroll
                for (int bj = 0; bj < 2; ++bj)
#pragma unroll
                    for (int n = 0; n < 2; ++n) {
                        const size_t o = (size_t)row * 1024 + u.pn * BM + bj * HALF + wc * 32 + n * 16 + 4 * fq;
                        const f32x4 v = *(const f32x4*)(base + o) + acc[ai][bj][m][n];
                        *(f32x4*)(out + o) = v;
                        typedef unsigned u32x2v __attribute__((ext_vector_type(2)));
                        { const float f0 = v.x, f1 = v.y, f2 = v.z, f3 = v.w; *(u32x2v*)(hb + o) = (u32x2v){::pk2(f0, f1), ::pk2(f2, f3)}; }
                        s += (v.x * v.x + v.y * v.y) + (v.z * v.z + v.w * v.w);
                    }
                s += __shfl_xor(s, 16); s += __shfl_xor(s, 32);
                if (fq == 0) atomicAdd(ss + row, s);
            }
    }
};
template <class Epi, class Sched, bool ALIGN_EPI = false, bool SP2 = false>
__device__ __forceinline__ void gemm_phase(PG8_LAS unsigned char* lds, const Gemm g, const Sched& S, const Epi& E) {
    const int tid = threadIdx.x, wid = __builtin_amdgcn_readfirstlane(tid >> 6), lane = tid & 63, wr = wid >> 2, wc = wid & 3, fr = lane & 15, fq = lane >> 4;
    const int K = g.K, nt = K / BK;
    unsigned voffA[2], voffB[2];
#pragma unroll
    for (int i = 0; i < 2; ++i) { int R, C; stage_rc(tid * 16 + i * 8192, R, C); const int Rb = Epi::PERM ? ((R & ~31) + perm32(R & 31)) : R;
        voffA[i] = (unsigned)(R * K + C) * 2u; voffB[i] = (unsigned)(Rb * K + C) * 2u; }
    const size_t kstep = (size_t)(BK * 2);
    const size_t hstep = (size_t)HALF * K * 2;
    const size_t tstep = 2 * hstep;
    const unsigned ldsw = (unsigned)wid * 1024u;
    const int aoff = lds_byte(wr * 64 + fr, fq * 8), boff = lds_byte(wc * 32 + fr, fq * 8);
#define PG8_SA(b, h) (((b) * 2 + (h)) * HTB)
#define PG8_SB(b, h) ((4 + (b) * 2 + (h)) * HTB)
#define PG8_STAGE(bufoff, gbase, voff) do { _Pragma("unroll") for (int _i = 0; _i < 2; ++_i) \
        __builtin_amdgcn_global_load_lds((const unsigned*)((const char*)(gbase) + (voff)[_i]), (PG8_LAS unsigned*)(lds + (bufoff) + ldsw + _i * 8192), 16, 0, 0); } while (0)
#define PG8_LDA(dst, b, h) do { _Pragma("unroll") for (int m = 0; m < 4; ++m) _Pragma("unroll") for (int k = 0; k < 2; ++k) dst[m][k] = *(const PG8_LAS bf16x8*)(lds + PG8_SA(b, h) + aoff + m * 2048 + k * 1024); } while (0)
#define PG8_LDB(dst, b, h) do { _Pragma("unroll") for (int n = 0; n < 2; ++n) _Pragma("unroll") for (int k = 0; k < 2; ++k) dst[n][k] = *(const PG8_LAS bf16x8*)(lds + PG8_SB(b, h) + boff + n * 2048 + k * 1024); } while (0)
#define PG8_MMA(ai, bj, At, Bt) do { __builtin_amdgcn_s_setprio(1); _Pragma("unroll") for (int m = 0; m < 4; ++m) _Pragma("unroll") for (int n = 0; n < 2; ++n) _Pragma("unroll") for (int k = 0; k < 2; ++k) \
        acc[ai][bj][m][n] = __builtin_amdgcn_mfma_f32_16x16x32_bf16(Bt[n][k], At[m][k], acc[ai][bj][m][n], 0, 0, 0); __builtin_amdgcn_s_setprio(0); } while (0)
#define PG8_WAIT_V(n) asm volatile("s_waitcnt vmcnt(" #n ")" ::: "memory")
#define PG8_WAIT_L(n) asm volatile("s_waitcnt lgkmcnt(" #n ")" ::: "memory")
#define PG8_BAR __builtin_amdgcn_s_barrier()
#define PG8_SCHED __builtin_amdgcn_sched_barrier(0)
    Unit cur, nxt; int ui = 0;
    if (!S.next(0, cur)) return;
    f32x4 acc[2][2][4][2];
#pragma unroll
    for (int a = 0; a < 2; ++a)
#pragma unroll
        for (int b = 0; b < 2; ++b)
#pragma unroll
            for (int m = 0; m < 4; ++m)
#pragma unroll
                for (int n = 0; n < 2; ++n) acc[a][b][m][n] = (f32x4){0.f, 0.f, 0.f, 0.f};
    bf16x8 At[4][2], B0[2][2], B1[2][2];
    const char* cA = (const char*)g.A + (size_t)cur.pm * tstep; const char* cB = (const char*)g.Bt + (size_t)cur.pn * tstep;
    S.a_ready(cur);
    if constexpr (SP2) {
        PG8_STAGE(PG8_SB(0, 0), cB, voffB); PG8_STAGE(PG8_SB(0, 1), cB + hstep, voffB); PG8_STAGE(PG8_SA(0, 0), cA, voffA); PG8_STAGE(PG8_SA(0, 1), cA + hstep, voffA);
        if (wr == 1) PG8_BAR;
        PG8_WAIT_V(2); PG8_BAR;
        PG8_STAGE(PG8_SB(1, 0), cB + kstep, voffB); PG8_STAGE(PG8_SA(1, 0), cA + kstep, voffA); PG8_STAGE(PG8_SB(1, 1), cB + hstep + kstep, voffB);
        PG8_WAIT_V(6); PG8_BAR;
    } else {
        PG8_STAGE(PG8_SB(0, 0), cB, voffB); PG8_STAGE(PG8_SA(0, 0), cA, voffA); PG8_STAGE(PG8_SB(0, 1), cB + hstep, voffB); PG8_STAGE(PG8_SA(0, 1), cA + hstep, voffA);
        if (wr == 1) PG8_BAR;
        PG8_WAIT_V(4); PG8_BAR;
        PG8_STAGE(PG8_SB(1, 0), cB + kstep, voffB); PG8_STAGE(PG8_SA(1, 0), cA + kstep, voffA); PG8_STAGE(PG8_SB(1, 1), cB + hstep + kstep, voffB);
        PG8_WAIT_V(6); PG8_BAR;
    }
    for (;;) {
        const bool has_next = S.next(ui + 1, nxt);
        const char* nA = has_next ? (const char*)g.A + (size_t)nxt.pm * tstep : cA; const char* nB = has_next ? (const char*)g.Bt + (size_t)nxt.pn * tstep : cB;
        for (int t = 0; t < nt; t += 2) {
            const bool last = (t == nt - 2);
            const char* a1 = cA + (size_t)(t + 1) * kstep;
            const char* a2 = last ? nA : cA + (size_t)(t + 2) * kstep; const char* b2 = last ? nB : cB + (size_t)(t + 2) * kstep;
            const char* a3 = a2 + kstep; const char* b3 = b2 + kstep;
            if (last && has_next) S.a_ready(nxt);
            if constexpr (SP2) {
            PG8_LDB(B0, 0, 0); PG8_LDB(B1, 0, 1); PG8_SCHED; PG8_LDA(At, 0, 0); PG8_STAGE(PG8_SA(1, 1), a1 + hstep, voffA);
            PG8_WAIT_V(8); PG8_WAIT_L(0); PG8_BAR; PG8_MMA(0, 0, At, B0); PG8_MMA(0, 1, At, B1); PG8_BAR; PG8_SCHED;
            PG8_LDA(At, 0, 1); PG8_STAGE(PG8_SB(0, 0), b2, voffB); PG8_STAGE(PG8_SB(0, 1), b2 + hstep, voffB); PG8_STAGE(PG8_SA(0, 0), a2, voffA);
            PG8_WAIT_V(8); PG8_WAIT_L(0); PG8_BAR; PG8_MMA(1, 0, At, B0); PG8_MMA(1, 1, At, B1); PG8_BAR; PG8_SCHED;
            PG8_LDB(B0, 1, 0); PG8_LDB(B1, 1, 1); PG8_SCHED; PG8_LDA(At, 1, 0); PG8_STAGE(PG8_SA(0, 1), a2 + hstep, voffA);
            PG8_WAIT_V(8); PG8_WAIT_L(0); PG8_BAR; PG8_MMA(0, 0, At, B0); PG8_MMA(0, 1, At, B1); PG8_BAR; PG8_SCHED;
            PG8_LDA(At, 1, 1); PG8_STAGE(PG8_SB(1, 0), b3, voffB); PG8_STAGE(PG8_SB(1, 1), b3 + hstep, voffB); PG8_STAGE(PG8_SA(1, 0), a3, voffA);
            PG8_WAIT_V(8); PG8_WAIT_L(0); PG8_BAR; PG8_MMA(1, 0, At, B0); PG8_MMA(1, 1, At, B1); PG8_BAR; PG8_SCHED;
            } else {
            PG8_LDB(B0, 0, 0); PG8_SCHED; PG8_LDA(At, 0, 0); PG8_STAGE(PG8_SA(1, 1), a1 + hstep, voffA);
            PG8_WAIT_L(8); PG8_BAR; PG8_WAIT_L(0); PG8_MMA(0, 0, At, B0); PG8_BAR; PG8_SCHED;
            PG8_LDB(B1, 0, 1); PG8_STAGE(PG8_SB(0, 0), b2, voffB);
            PG8_BAR; PG8_WAIT_L(0); PG8_MMA(0, 1, At, B1); PG8_BAR;
            PG8_LDA(At, 0, 1); PG8_STAGE(PG8_SA(0, 0), a2, voffA);
            PG8_BAR; PG8_WAIT_L(0); PG8_MMA(1, 0, At, B0); PG8_BAR; PG8_SCHED;
            PG8_STAGE(PG8_SB(0, 1), b2 + hstep, voffB);
            PG8_WAIT_V(6); PG8_BAR; PG8_MMA(1, 1, At, B1); PG8_BAR;
            PG8_LDB(B0, 1, 0); PG8_SCHED; PG8_LDA(At, 1, 0); PG8_STAGE(PG8_SA(0, 1), a2 + hstep, voffA);
            PG8_WAIT_L(8); PG8_BAR; PG8_WAIT_L(0); PG8_MMA(0, 0, At, B0); PG8_BAR; PG8_SCHED;
            PG8_LDB(B1, 1, 1); PG8_STAGE(PG8_SB(1, 0), b3, voffB);
            PG8_BAR; PG8_WAIT_L(0); PG8_MMA(0, 1, At, B1); PG8_BAR;
            PG8_LDA(At, 1, 1); PG8_STAGE(PG8_SA(1, 0), a3, voffA);
            PG8_BAR; PG8_WAIT_L(0); PG8_MMA(1, 0, At, B0); PG8_BAR; PG8_SCHED;
            PG8_STAGE(PG8_SB(1, 1), b3 + hstep, voffB);
            PG8_WAIT_V(6); PG8_BAR; PG8_MMA(1, 1, At, B1); PG8_BAR;
            }
        }
        if constexpr (ALIGN_EPI) { if (wr == 0) PG8_BAR; }
        if constexpr (!Epi::AFTER_DRAIN) { E(acc, cur, wr, wc, fr, fq); S.done(cur); }
        if (!has_next) break;
#pragma unroll
        for (int a = 0; a < 2; ++a)
#pragma unroll
            for (int b = 0; b < 2; ++b)
#pragma unroll
                for (int m = 0; m < 4; ++m)
#pragma unroll
                    for (int n = 0; n < 2; ++n) acc[a][b][m][n] = (f32x4){0.f, 0.f, 0.f, 0.f};
        cur = nxt; cA = nA; cB = nB; ++ui;
        if constexpr (ALIGN_EPI) { if (wr == 1) PG8_BAR; }
    }
    PG8_WAIT_V(0);
    if constexpr (!ALIGN_EPI) { if (wr == 0) PG8_BAR; }
    PG8_BAR;
    if constexpr (Epi::AFTER_DRAIN) { E.fused(acc, cur, wr, wc, fr, fq, lds, wid, lane); S.done(cur); }
#undef PG8_SA
#undef PG8_SB
#undef PG8_STAGE
#undef PG8_LDA
#undef PG8_LDB
#undef PG8_MMA
#undef PG8_WAIT_V
#undef PG8_WAIT_L
#undef PG8_BAR
#undef PG8_SCHED
}
}


template <class Epi>
__device__ __forceinline__ void run_gemm_raw(unsigned char* lds, const bf16_t* A, const bf16_t* Bt, int M, int N, int K, const Epi& E) {
  pg8::Gemm g{A, Bt, M, N, K}; pg8::StaticOrder S; S.init(M, N, (int)gridDim.x, (int)blockIdx.x);
  pg8::gemm_phase<Epi, pg8::StaticOrder, true, true>((PG8_LAS unsigned char*)lds, g, S, E);
}
template <class St>
__device__ __forceinline__ void run_gemm(unsigned char* lds, const bf16_t* A, const bf16_t* Bt, int M, int N, int K, const St& st, int gw, int ngw, int lane) {
#if USE_PG8
  pg8::Gemm g{A, Bt, M, N, K}; pg8::StaticOrder S; S.init(M, N, (int)gridDim.x, (int)blockIdx.x);
  pg8::EpiAdapt<St> E{st};
  pg8::gemm_phase<pg8::EpiAdapt<St>, pg8::StaticOrder, true, true>((PG8_LAS unsigned char*)lds, g, S, E);
#else
  gemm_naive(A, K, Bt, K, M, N, K, st, gw, ngw, lane);
#endif
}

#define GAS __attribute__((address_space(1)))
#define LAS __attribute__((address_space(3)))
#define XB_TMO      128
#define XB_XCNT(j)  (256  + 64 * (j))
#define XB_XSUB(j)  (1280 + 64 * (j))
#define XB_XGEN(j)  (2304 + 64 * (j))
#define XB_TOP      3328
#define XB_TOPGEN   3392
#define XCD_BAR_WORDS 3456
#define XB_SPIN_CAP (1u << 18)

__device__ __forceinline__ unsigned xb_ld(unsigned* p)              { return __hip_atomic_load(p, __ATOMIC_RELAXED, __HIP_MEMORY_SCOPE_AGENT); }
__device__ __forceinline__ unsigned xb_add(unsigned* p, unsigned v) { return __hip_atomic_fetch_add(p, v, __ATOMIC_RELAXED, __HIP_MEMORY_SCOPE_AGENT); }
__device__ __forceinline__ unsigned xb_xcc_id() { return (unsigned)__builtin_amdgcn_s_getreg((3 << 11) | 20) & 0xFu; }
#define XB_SPIN(cond, bar) do { unsigned _sp = 0; while (cond) { __builtin_amdgcn_s_sleep(1); \
    if ((++_sp & 255u) == 0u) { if (xb_ld(&(bar)[XB_TMO])) break; if (_sp > XB_SPIN_CAP) { atomicAdd(&(bar)[XB_TMO], 1u); break; } } } } while (0)

struct XcdBarrier {
    unsigned* bar; unsigned x;
    volatile LAS unsigned* st;
};

__device__ __forceinline__ XcdBarrier xcd_barrier_post(unsigned* bar, volatile LAS unsigned* st) {
    XcdBarrier b; b.bar = bar; b.x = xb_xcc_id(); b.st = st;
    if (threadIdx.x == 0) (void)xb_add(&bar[XB_XCNT(b.x)], 1u);
    return b;
}
__device__ __forceinline__ void xcd_barrier_complete(unsigned* bar, unsigned x, unsigned& nloc, unsigned& nx) {
    const unsigned G = gridDim.x * gridDim.y * gridDim.z;
    unsigned sum, cnt, mine, sp = 0u;
    for (;;) {
        sum = 0u; cnt = 0u; mine = 0u;
#pragma unroll
        for (unsigned j = 0; j < 16; ++j) { const unsigned c = xb_ld(&bar[XB_XCNT(j)]); sum += c; cnt += (c > 0u) ? 1u : 0u; mine = (j == x) ? c : mine; }
        if (sum == G) break;
        __builtin_amdgcn_s_sleep(1);
        if ((++sp & 255u) == 0u) { if (xb_ld(&bar[XB_TMO])) break; if (sp > XB_SPIN_CAP) { atomicAdd(&bar[XB_TMO], 1u); break; } }
    }
    nloc = mine > 0u ? mine : 1u; nx = cnt > 0u ? cnt : 1u;
}

__device__ __forceinline__ void xcd_barrier(const XcdBarrier& b) {
    asm volatile("s_waitcnt vmcnt(0)" ::: "memory");
    __syncthreads();
    if (threadIdx.x == 0) {
        unsigned* bar = b.bar;
        __builtin_amdgcn_s_waitcnt(0);
        unsigned nloc = b.st[0], nx = b.st[1];
        if (nloc == 0u) { xcd_barrier_complete(bar, b.x, nloc, nx); b.st[0] = nloc; b.st[1] = nx; }
        const unsigned old = xb_add(&bar[XB_XSUB(b.x)], 1u);
        const unsigned gen = old / nloc;
        if (old + 1u == (gen + 1u) * nloc) {
            __builtin_amdgcn_fence(__ATOMIC_RELEASE, "agent");
            asm volatile("s_waitcnt vmcnt(0)" ::: "memory");
            const unsigned og = xb_add(&bar[XB_TOP], 1u);
            const unsigned tg = og / nx;
            if (og + 1u == (tg + 1u) * nx) xb_add(&bar[XB_TOPGEN], 1u);
            else XB_SPIN(xb_ld(&bar[XB_TOPGEN]) == tg, bar);
            __builtin_amdgcn_fence(__ATOMIC_ACQUIRE, "agent");
            xb_add(&bar[XB_XGEN(b.x)], 1u);
            asm volatile("s_waitcnt vmcnt(0)" ::: "memory");
        } else {
            XB_SPIN(xb_ld(&bar[XB_XGEN(b.x)]) == gen, bar);
            __builtin_amdgcn_fence(__ATOMIC_ACQUIRE, "agent");
            asm volatile("s_waitcnt vmcnt(0)" ::: "memory");
        }
    }
    __syncthreads();
}

__global__ void __launch_bounds__(512, 2) mega(Args a) {
  extern __shared__ __attribute__((aligned(16))) unsigned char lds[];
  cg::grid_group grid = cg::this_grid();
  const int tid = threadIdx.x, lane = tid & 63, wave = tid >> 6;
  const int gw = blockIdx.x * 8 + wave, ngw = gridDim.x * 8;
  unsigned char* ws = a.ws;
  const int lo = a.ph_lo, hi = a.ph_hi;
#define IN(k) (lo <= (k) && (k) < hi)
  volatile LAS unsigned* MISC = (volatile LAS unsigned*)((LAS unsigned char*)lds + 131072 + 320);
  if (tid < 32) MISC[tid] = 0u;
  __syncthreads();
  XcdBarrier bar; bar.bar = (unsigned*)(ws + WS_BAR); bar.x = 0; bar.st = nullptr;
  if (hi - lo > 1) bar = xcd_barrier_post((unsigned*)(ws + WS_BAR), MISC + 8);
#define SEAM(k) do { if (IN(k) && IN((k) + 1)) { if ((k) == 0) grid.sync(); else xcd_barrier(bar); } } while (0)
#if PROBE_REP == 0
  if (IN(0)) { phase_prep(a, lds, gw, ngw, wave, lane, tid); grid.sync(); }
#endif
  if (IN(0)) { phase_prep(a, lds, gw, ngw, wave, lane, tid); } SEAM(0);
#if PROBE_REP == 1
  if (IN(1)) {
    run_gemm(lds, (const bf16_t*)(ws + WS_HB), (const bf16_t*)(ws + WS_WIN_T), NT, NQKV, DM, EpiQKV{(bf16_t*)(ws + WS_QKV)}, gw, ngw, lane);
    run_gemm(lds, (const bf16_t*)(ws + WS_MEMN), (const bf16_t*)(ws + WS_WXKV_T), NMROWS, 2048, DM, EpiBf16{(bf16_t*)(ws + WS_KX), 2048}, gw, ngw, lane);
    xcd_barrier(bar); }
#endif
#if PROBE_REP == 2
  if (IN(2)) { phase_scan(a, gw, ngw, lane, tid); xcd_barrier(bar); phase_rms(a, gw, ngw, lane); xcd_barrier(bar); phase_rms(a, gw, ngw, lane); xcd_barrier(bar); }
#endif
  if (IN(1)) {
    run_gemm(lds, (const bf16_t*)(ws + WS_HB), (const bf16_t*)(ws + WS_WIN_T), NT, NQKV, DM, EpiQKV{(bf16_t*)(ws + WS_QKV)}, gw, ngw, lane);
    run_gemm(lds, (const bf16_t*)(ws + WS_MEMN), (const bf16_t*)(ws + WS_WXKV_T), NMROWS, 2048, DM, EpiBf16{(bf16_t*)(ws + WS_KX), 2048}, gw, ngw, lane);
  } SEAM(1);
  if (IN(2)) { phase_scan(a, gw, ngw, lane, tid); } SEAM(2);
#if PROBE_REP == 3
  if (IN(3)) { phase_attn2(a, lds, tid); xcd_barrier(bar); if (blockIdx.x == 0 && tid == 0) *(unsigned*)(ws) = 0u; xcd_barrier(bar); }
#endif
  if (IN(3)) {
#if USE_ATT2
    phase_attn2(a, lds, tid);
#else
    phase_attn(a, lds, tid);
#endif
  } SEAM(3);
  if (IN(4)) { phase_onorm(a, gw, ngw, lane); } SEAM(4);
  if (IN(5)) { run_gemm_raw(lds, (const bf16_t*)(ws + WS_OAB), (const bf16_t*)(ws + WS_WOUT_T), NT, DM, DM, pg8::EpiResidSS{a.in[0], a.out, (bf16_t*)(ws + WS_HB), (float*)(ws + WS_SS1)}); }
  if (IN(5) && IN(7)) xcd_barrier(bar);
  if (IN(7)) { run_gemm(lds, (const bf16_t*)(ws + WS_HB), (const bf16_t*)(ws + WS_WXQ_T), NT, DM, DM, EpiBf16S{(bf16_t*)(ws + WS_QX), DM, (const float*)(ws + WS_SS1)}, gw, ngw, lane); } SEAM(7);
#if PROBE_REP == 8
  if (IN(8)) { phase_xattn(a, lds, gw, ngw, wave, lane); grid.sync(); }
#endif
  if (IN(8)) { phase_xattn2(a, lds, tid); } SEAM(8);
  if (IN(9)) { run_gemm_raw(lds, (const bf16_t*)(ws + WS_OX), (const bf16_t*)(ws + WS_WXO_T), NT, DM, DM, pg8::EpiResidSS{a.out, a.out, (bf16_t*)(ws + WS_HB), (float*)(ws + WS_SS2)}); }
  if (IN(9) && IN(11)) xcd_barrier(bar);
  if (IN(11)) { run_gemm(lds, (const bf16_t*)(ws + WS_HB), (const bf16_t*)(ws + WS_WPQ_T), NT, DM, DM, EpiBf16S{(bf16_t*)(ws + WS_PQ), DM, (const float*)(ws + WS_SS2)}, gw, ngw, lane); } SEAM(11);
#if PROBE_REP == 12
  if (IN(12)) { phase_topk(a, lds, tid); grid.sync(); }
#endif
  if (IN(12)) { phase_topk2(a, lds, wave, lane); } SEAM(12);
  #if PROBE_REP == 13
  if (IN(13)) { phase_experts(a, gw, ngw, lane, (float*)(ws + WS_QKV)); grid.sync(); }
#endif
  if (IN(13)) { phase_experts(a, gw, ngw, lane, a.out); }
#undef IN
#undef SEAM
}

extern "C" void kernel_launch(void* const* d_in, const int* in_sizes, int n_in, void* d_out, int out_size, void* d_ws, size_t ws_size, hipStream_t stream) {
  static int grid = 0;
  if (grid == 0) {
    if (n_in != 22 || out_size != NT * DM || ws_size < WS_END) { fprintf(stderr, "kernel_launch: unexpected shapes (n_in %d out %d ws %zu)\n", n_in, out_size, ws_size); grid = -1; return; }
    int dev = 0, cus = 0, per_cu = 0;
    (void)hipGetDevice(&dev);
    (void)hipDeviceGetAttribute(&cus, hipDeviceAttributeMultiprocessorCount, dev);
    (void)hipFuncSetAttribute((const void*)mega, hipFuncAttributeMaxDynamicSharedMemorySize, LDS_BYTES);
    (void)hipOccupancyMaxActiveBlocksPerMultiprocessor(&per_cu, (const void*)mega, 512, LDS_BYTES);
    if (per_cu < 1) per_cu = 1;
    grid = cus * per_cu;
  }
  if (grid < 0) return;
  (void)hipMemsetAsync(d_ws, 0, CTL_ZERO_BYTES, stream);
  Args a{};
  for (int i = 0; i < 22; ++i) a.in[i] = (const float*)d_in[i];
  a.out = (float*)d_out; a.ws = (unsigned char*)d_ws;
#if MK_N_LAUNCHES == 1
  a.ph_lo = 0; a.ph_hi = NPHASE + 1;
  void* args[] = {&a};
  hipError_t e = hipLaunchCooperativeKernel((const void*)mega, dim3(grid), dim3(512), args, LDS_BYTES, stream);
  if (e != hipSuccess) fprintf(stderr, "cooperative launch failed: %s (grid %d)\n", hipGetErrorString(e), grid);
#else
  for (int p = 0; p <= NPHASE; ++p) { a.ph_lo = p; a.ph_hi = p + 1; hipLaunchKernelGGL(mega, dim3(grid), dim3(512), LDS_BYTES, stream, a); }
#endif
}
```

```cpp
#include <hip/hip_runtime.h>
#include <hip/hip_cooperative_groups.h>
#include <cstdio>
#include <cstdint>
namespace cg = cooperative_groups;

#ifndef USE_PG8
#define USE_PG8 1
#endif
#ifndef USE_ATT2
#define USE_ATT2 1
#endif
#ifndef PROBE_REP
#define PROBE_REP -1
#endif
#ifndef MK_N_LAUNCHES
#define MK_N_LAUNCHES 1
#endif

typedef unsigned short bf16_t;
typedef short bf16x8 __attribute__((ext_vector_type(8)));
typedef float f32x4 __attribute__((ext_vector_type(4)));
typedef unsigned u32x4 __attribute__((ext_vector_type(4)));
typedef unsigned u32x2 __attribute__((ext_vector_type(2)));
typedef float v32f __attribute__((ext_vector_type(32)));
typedef float v16f __attribute__((ext_vector_type(16)));
typedef unsigned v6u __attribute__((ext_vector_type(6)));

constexpr int NB = 8, SEQ = 4096, DM = 1024, NT = NB * SEQ;
constexpr int NQKV = 3072, INW = 3080;
constexpr int NMEM = 256, NMROWS = NB * NMEM;
constexpr int NEXP = 16384;
constexpr float EPS = 1e-6f;
constexpr int NPHASE = 13;
constexpr int LDS_BYTES = 147456;

constexpr size_t MiB = 1u << 20;
constexpr size_t WS_BAR = 65536;
constexpr size_t WS_SS1 = 131072;
constexpr size_t WS_SS2 = 262144;
constexpr size_t CTL_ZERO_BYTES = 393216;
constexpr size_t WS_WIN_T = 2 * MiB;
constexpr size_t WS_WOUT_T = 8 * MiB;
constexpr size_t WS_WXQ_T = 10 * MiB;
constexpr size_t WS_WXKV_T = 12 * MiB;
constexpr size_t WS_WXO_T = 16 * MiB;
constexpr size_t WS_WPQ_T = 18 * MiB;
constexpr size_t WS_SK = 21 * MiB;
constexpr size_t WS_MEMN = 22 * MiB;
constexpr size_t WS_KX = 26 * MiB;
constexpr size_t WS_VXT = 30 * MiB;
constexpr size_t WS_FLOG = 34 * MiB;
constexpr size_t WS_CUM = 35 * MiB;
constexpr size_t WS_KMEAN = 36 * MiB;
constexpr size_t WS_ESC = 38 * MiB;
constexpr size_t WS_EXD = 40 * MiB;
constexpr size_t WS_EXU = 72 * MiB;
constexpr size_t WS_HB = 104 * MiB;
constexpr size_t WS_QKV = 168 * MiB;
constexpr size_t WS_OAB = 360 * MiB;
constexpr size_t WS_QX = 168 * MiB;
constexpr size_t WS_OX = 232 * MiB;
constexpr size_t WS_PQ = 232 * MiB;
constexpr size_t WS_EIDX = 424 * MiB;
constexpr size_t WS_GATE = 440 * MiB;
constexpr size_t WS_END = 456 * MiB;

struct Args {
  const float* in[22];
  float* out;
  unsigned char* ws;
  int ph_lo, ph_hi;
};

__device__ __forceinline__ unsigned f2bf(float f) { unsigned u = __float_as_uint(f); return (u + 0x7fffu + ((u >> 16) & 1u)) >> 16; }
__device__ __forceinline__ unsigned pk2(float lo, float hi) { return f2bf(lo) | (f2bf(hi) << 16); }
__device__ __forceinline__ float bf2f(unsigned short b) { return __uint_as_float(((unsigned)b) << 16); }
__device__ __forceinline__ float bflo(unsigned w) { return __uint_as_float(w << 16); }
__device__ __forceinline__ float bfhi(unsigned w) { return __uint_as_float(w & 0xffff0000u); }
__device__ __forceinline__ float wave_sum(float v) {
#pragma unroll
  for (int o = 1; o < 64; o <<= 1) v += __shfl_xor(v, o);
  return v;
}
__device__ __forceinline__ void unpack8(const u32x4 w, float* f) {
  f[0] = bflo(w.x); f[1] = bfhi(w.x); f[2] = bflo(w.y); f[3] = bfhi(w.y);
  f[4] = bflo(w.z); f[5] = bfhi(w.z); f[6] = bflo(w.w); f[7] = bfhi(w.w);
}

__device__ const unsigned char T5_BUCKET[128] = {
  0, 1, 2, 3, 4, 5, 6, 7, 8, 9, 10, 11, 12, 13, 14, 15, 16, 16, 16, 17, 17, 18, 18, 18, 19, 19, 19, 20, 20, 20, 20, 21,
  21, 21, 21, 22, 22, 22, 22, 22, 23, 23, 23, 23, 23, 23, 24, 24, 24, 24, 24, 24, 25, 25, 25, 25, 25, 25, 25, 26, 26, 26, 26, 26,
  26, 26, 26, 27, 27, 27, 27, 27, 27, 27, 27, 27, 27, 28, 28, 28, 28, 28, 28, 28, 28, 28, 28, 29, 29, 29, 29, 29, 29, 29, 29, 29,
  29, 29, 29, 30, 30, 30, 30, 30, 30, 30, 30, 30, 30, 30, 30, 30, 30, 31, 31, 31, 31, 31, 31, 31, 31, 31, 31, 31, 31, 31, 31, 31};

__device__ __forceinline__ void transpose_item(const float* W, int ldw, const float* gain, bf16_t* WT, int K, int row_off, float* scr, int kb, int nb, int lane) {
  const int k0 = 64 * kb, n0 = 32 * nb;
#pragma unroll 8
  for (int i = 0; i < 32; ++i) {
    const int kk = 2 * i + (lane >> 5);
    const float g = gain ? gain[k0 + kk] : 1.f;
    scr[kk * 33 + (lane & 31)] = W[(size_t)(k0 + kk) * ldw + n0 + (lane & 31)] * g;
  }
  __builtin_amdgcn_wave_barrier();
  const int c = lane & 7;
#pragma unroll
  for (int j = 0; j < 4; ++j) {
    const int n = (lane >> 3) + 8 * j; const float* s = scr + (8 * c) * 33 + n;
    u32x4 o; o.x = pk2(s[0 * 33], s[1 * 33]); o.y = pk2(s[2 * 33], s[3 * 33]); o.z = pk2(s[4 * 33], s[5 * 33]); o.w = pk2(s[6 * 33], s[7 * 33]);
    *(u32x4*)(WT + (size_t)(row_off + n0 + n) * K + k0 + 8 * c) = o;
  }
  __builtin_amdgcn_wave_barrier();
}

__device__ __forceinline__ void rms_row_to_bf16(const float* xrow, bf16_t* orow, int lane) {
  const f32x4* xr = (const f32x4*)xrow + lane;
  f32x4 v[4]; float s = 0.f;
#pragma unroll
  for (int j = 0; j < 4; ++j) { v[j] = xr[64 * j]; s += (v[j].x * v[j].x + v[j].y * v[j].y) + (v[j].z * v[j].z + v[j].w * v[j].w); }
  const float rstd = rsqrtf(wave_sum(s) * (1.f / DM) + EPS);
  u32x2* o = (u32x2*)orow + lane;
#pragma unroll
  for (int j = 0; j < 4; ++j) { u32x2 w; w.x = pk2(v[j].x * rstd, v[j].y * rstd); w.y = pk2(v[j].z * rstd, v[j].w * rstd); o[64 * j] = w; }
}

__device__ __forceinline__ void phase_prep(const Args& a, unsigned char* lds, int gw, int ngw, int wave, int lane, int tid) {
  unsigned char* ws = a.ws;
  float* scr = (float*)(lds + wave * 8448);
  const int I_IN = 16 * 96, I_SQ = 16 * 32;
  const int NITEMS = I_IN + 6 * I_SQ;
  for (int it = gw; it < NITEMS; it += ngw) {
    int r = it;
    if (r < I_IN) { transpose_item(a.in[3], INW, a.in[2], (bf16_t*)(ws + WS_WIN_T), DM, 0, scr, r / 96, r % 96, lane); continue; } r -= I_IN;
    const int which = r / I_SQ; r %= I_SQ; const int kb = r / 32, nb = r % 32;
    if (which == 0) { const float* g = (kb < 8) ? a.in[6] : (a.in[7] - 512); transpose_item(a.in[8], DM, g, (bf16_t*)(ws + WS_WOUT_T), DM, 0, scr, kb, nb, lane); }
    else if (which == 1) transpose_item(a.in[11], DM, a.in[9], (bf16_t*)(ws + WS_WXQ_T), DM, 0, scr, kb, nb, lane);
    else if (which == 2) transpose_item(a.in[12], DM, a.in[10], (bf16_t*)(ws + WS_WXKV_T), DM, 0, scr, kb, nb, lane);
    else if (which == 3) transpose_item(a.in[13], DM, a.in[10], (bf16_t*)(ws + WS_WXKV_T), DM, 1024, scr, kb, nb, lane);
    else if (which == 4) transpose_item(a.in[14], DM, nullptr, (bf16_t*)(ws + WS_WXO_T), DM, 0, scr, kb, nb, lane);
    else transpose_item(a.in[16], DM, a.in[15], (bf16_t*)(ws + WS_WPQ_T), DM, 0, scr, kb, nb, lane);
  }
  for (int it = gw; it < NEXP; it += ngw) {
    const int hi = lane >> 5, l32 = lane & 31; const int r = 2 * it + hi;
    const int tb = r >= NEXP, e = r - tb * NEXP;
    const f32x4* src = (const f32x4*)(a.in[19 + tb] + (size_t)e * DM) + 8 * l32;
    v16f xa, xb; float am = 0.f;
#pragma unroll
    for (int k = 0; k < 4; ++k) { const f32x4 p = src[k], q = src[4 + k];
      xa[2 * k] = p.x; xb[2 * k] = p.y; xa[2 * k + 1] = p.z; xb[2 * k + 1] = p.w; xa[8 + 2 * k] = q.x; xb[8 + 2 * k] = q.y; xa[8 + 2 * k + 1] = q.z; xb[8 + 2 * k + 1] = q.w;
      am = fmaxf(am, fmaxf(fmaxf(fabsf(p.x), fabsf(p.y)), fmaxf(fabsf(p.z), fabsf(p.w)))); am = fmaxf(am, fmaxf(fmaxf(fabsf(q.x), fabsf(q.y)), fmaxf(fabsf(q.z), fabsf(q.w)))); }
#pragma unroll
    for (int o = 1; o < 32; o <<= 1) am = fmaxf(am, __shfl_xor(am, o));
    const float sc = am > 0.f ? 7.0f / am : 1.f;
    xa = xa * sc; xb = xb * sc;
    const v6u w = __builtin_amdgcn_cvt_scalef32_2xpk16_fp6_f32(xa, xb, 1.0f);
    u32x2* dst = (u32x2*)(ws + (tb ? WS_EXU : WS_EXD) + (size_t)e * 768 + 24 * l32);
    dst[0] = (u32x2){w[0], w[1]}; dst[1] = (u32x2){w[2], w[3]}; dst[2] = (u32x2){w[4], w[5]};
    if (l32 == 0) ((float*)(ws + WS_ESC))[r] = am > 0.f ? am / 7.0f : 1.f;
  }
  for (int i = blockIdx.x * 512 + tid; i < 2 * 65536; i += gridDim.x * 512) ((bf16_t*)(ws + WS_SK))[i] = (bf16_t)f2bf(a.in[17 + (i >> 16)][i & 65535]);
  for (int r = gw; r < NMROWS; r += ngw) rms_row_to_bf16(a.in[1] + (size_t)r * DM, (bf16_t*)(ws + WS_MEMN) + (size_t)r * DM, lane);
  __syncthreads();
  float* wf = (float*)(lds + 69632);
  for (int k = tid; k < DM; k += 512) {
    const float g = a.in[2][k]; const f32x4* wp = (const f32x4*)(a.in[3] + (size_t)k * INW + NQKV);
    const f32x4 p = wp[0], q = wp[1];
    f32x4* d = (f32x4*)(wf + k * 8); d[0] = p * g; d[1] = q * g;
  }
  __syncthreads();
  float* flog = (float*)(ws + WS_FLOG);
  for (int r = gw; r < NT; r += ngw) {
    const f32x4* xr = (const f32x4*)(a.in[0] + (size_t)r * DM) + lane;
    f32x4 v[4]; float s = 0.f; float fa[8];
#pragma unroll
    for (int j = 0; j < 8; ++j) fa[j] = 0.f;
#pragma unroll
    for (int j = 0; j < 4; ++j) {
      v[j] = xr[64 * j]; s += (v[j].x * v[j].x + v[j].y * v[j].y) + (v[j].z * v[j].z + v[j].w * v[j].w);
#pragma unroll
      for (int c = 0; c < 4; ++c) {
        const float xv = v[j][c]; const f32x4* wp = (const f32x4*)(wf + (256 * j + 4 * lane + c) * 8);
        const f32x4 p = wp[0], q = wp[1];
        fa[0] += xv * p.x; fa[1] += xv * p.y; fa[2] += xv * p.z; fa[3] += xv * p.w;
        fa[4] += xv * q.x; fa[5] += xv * q.y; fa[6] += xv * q.z; fa[7] += xv * q.w;
      }
    }
    const float rstd = rsqrtf(wave_sum(s) * (1.f / DM) + EPS);
    float mine = 0.f;
#pragma unroll
    for (int j = 0; j < 8; ++j) { const float t = wave_sum(fa[j]); if (lane == j) mine = t; }
    if (lane < 8) {
      const float z = mine * rstd + a.in[4][lane];
      flog[(size_t)r * 8 + lane] = fminf(z, 0.f) - log1pf(expf(-fabsf(z)));
    }
    u32x2* o = (u32x2*)((bf16_t*)(ws + WS_HB) + (size_t)r * DM) + lane;
#pragma unroll
    for (int j = 0; j < 4; ++j) { u32x2 w; w.x = pk2(v[j].x * rstd, v[j].y * rstd); w.y = pk2(v[j].z * rstd, v[j].w * rstd); o[64 * j] = w; }
  }
}

template <class Epi>
__device__ __forceinline__ void gemm_naive(const bf16_t* A, int lda, const bf16_t* Bt, int ldb, int M, int N, int K, const Epi& E, int gw, int ngw, int lane) {
  const int fr = lane & 15, fq = lane >> 4;
  const int tn = N / 64, ntile = (M / 64) * tn;
  for (int tile = gw; tile < ntile; tile += ngw) {
    const int pm = tile / tn, pn = tile % tn;
    f32x4 acc[4][4];
#pragma unroll
    for (int m = 0; m < 4; ++m)
#pragma unroll
      for (int n = 0; n < 4; ++n) acc[m][n] = (f32x4){0.f, 0.f, 0.f, 0.f};
    const bf16_t* Ap = A + (size_t)(pm * 64 + fr) * lda + fq * 8;
    const bf16_t* Bp = Bt + (size_t)(pn * 64 + fr) * ldb + fq * 8;
    for (int k0 = 0; k0 < K; k0 += 32) {
      bf16x8 af[4], bfr[4];
#pragma unroll
      for (int m = 0; m < 4; ++m) af[m] = *(const bf16x8*)(Ap + (size_t)m * 16 * lda + k0);
#pragma unroll
      for (int n = 0; n < 4; ++n) bfr[n] = *(const bf16x8*)(Bp + (size_t)n * 16 * ldb + k0);
#pragma unroll
      for (int m = 0; m < 4; ++m)
#pragma unroll
        for (int n = 0; n < 4; ++n) acc[m][n] = __builtin_amdgcn_mfma_f32_16x16x32_bf16(bfr[n], af[m], acc[m][n], 0, 0, 0);
    }
#pragma unroll
    for (int m = 0; m < 4; ++m)
#pragma unroll
      for (int n = 0; n < 4; ++n) E.store(pm * 64 + m * 16 + fr, pn * 64 + n * 16 + 4 * fq, acc[m][n]);
  }
}

struct EpiBf16 { bf16_t* O; int ldo;
  __device__ __forceinline__ void store(int row, int col, f32x4 v) const { u32x2 w; w.x = pk2(v.x, v.y); w.y = pk2(v.z, v.w); *(u32x2*)(O + (size_t)row * ldo + col) = w; } };
struct EpiQKV { bf16_t* O;
  __device__ __forceinline__ void store(int row, int col, f32x4 v) const { const float sc = (col < 512 || (col >= 1536 && col < 2048)) ? 0.18033688011112042f : 1.f;
    u32x2 w; w.x = pk2(v.x * sc, v.y * sc); w.y = pk2(v.z * sc, v.w * sc); *(u32x2*)(O + (size_t)row * NQKV + col) = w; } };
struct EpiBf16S { bf16_t* O; int ldo; const float* ss;
  __device__ __forceinline__ void store(int row, int col, f32x4 v) const { const float r = rsqrtf(ss[row] * (1.f / DM) + EPS); u32x2 w; w.x = pk2(v.x * r, v.y * r); w.y = pk2(v.z * r, v.w * r); *(u32x2*)(O + (size_t)row * ldo + col) = w; } };
struct EpiF32S { float* O; int ldo; const float* ss;
  __device__ __forceinline__ void store(int row, int col, f32x4 v) const { const float r = rsqrtf(ss[row] * (1.f / DM) + EPS); *(f32x4*)(O + (size_t)row * ldo + col) = v * r; } };
struct EpiF32 { float* O; int ldo;
  __device__ __forceinline__ void store(int row, int col, f32x4 v) const { *(f32x4*)(O + (size_t)row * ldo + col) = v; } };
struct EpiResid { const float* base; float* out;
  __device__ __forceinline__ void store(int row, int col, f32x4 v) const { const size_t o = (size_t)row * DM + col; const f32x4 b = *(const f32x4*)(base + o); *(f32x4*)(out + o) = b + v; } };
struct EpiKV { bf16_t* KX; bf16_t* VXT;
  __device__ __forceinline__ void store(int row, int col, f32x4 v) const {
    if (col < 1024) { u32x2 w; w.x = pk2(v.x, v.y); w.y = pk2(v.z, v.w); *(u32x2*)(KX + (size_t)row * DM + col) = w; }
    else { const int b = row >> 8, m = row & 255;
#pragma unroll
      for (int r = 0; r < 4; ++r) { const int d = col - 1024 + r; VXT[((size_t)(b * 4 + (d >> 8)) * 256 + (d & 255)) * 256 + m] = (bf16_t)f2bf(v[r]); } } } };

__device__ __forceinline__ void phase_scan(const Args& a, int gw, int ngw, int lane, int tid) {
  unsigned char* ws = a.ws;
  const float* flog = (const float*)(ws + WS_FLOG); float* cum = (float*)(ws + WS_CUM);
  for (int p = gw; p < 64; p += ngw) {
    const int b = p >> 3, j = p & 7;
    const float* src = flog + ((size_t)b * SEQ + lane * 64) * 8 + j;
    float tot = 0.f;
    for (int i = 0; i < 64; ++i) tot += src[i * 8];
    float inc = tot;
#pragma unroll
    for (int o = 1; o < 64; o <<= 1) { const float t = __shfl_up(inc, o); if (lane >= o) inc += t; }
    float run = inc - tot;
    float* dst = cum + ((size_t)(b * 8 + j)) * SEQ + lane * 64;
    for (int i = 0; i < 64; ++i) { run += src[i * 8]; dst[i] = run * 1.4426950408889634f; }
  }
  const bf16_t* qkv = (const bf16_t*)(ws + WS_QKV); float* kmean = (float*)(ws + WS_KMEAN);
  {
    unsigned* kn2 = (unsigned*)(ws + 256);
    for (int item = gw; item < 64 * 16; item += ngw) {
      const int bh = item >> 4, ch = item & 15, b = bh >> 3, h = bh & 7; float m = 0.f;
      for (int rr = 0; rr < 4; ++rr) {
        const u32x4* kp = (const u32x4*)(qkv + ((size_t)b * SEQ + ch * 256 + lane * 4 + rr) * NQKV + 2048 + h * 64); float s = 0.f;
#pragma unroll
        for (int c = 0; c < 8; ++c) { float f[8]; unpack8(kp[c], f);
#pragma unroll
          for (int i = 0; i < 8; ++i) s += f[i] * f[i]; }
        m = fmaxf(m, s);
      }
#pragma unroll
      for (int o = 1; o < 64; o <<= 1) m = fmaxf(m, __shfl_xor(m, o));
      if (lane == 0) atomicMax(kn2 + bh, __float_as_uint(m));
    }
  }
  const int gt = blockIdx.x * 512 + tid, ngt = gridDim.x * 512;
  for (int o = gt; o < NB * 16 * 512; o += ngt) {
    const int c = o & 511, blk = (o >> 9) & 15, b = o >> 13;
    const bf16_t* p = qkv + ((size_t)b * SEQ + blk * 256) * NQKV + 512 + c;
    float s = 0.f;
    for (int r = 0; r < 256; ++r) s += bf2f(p[(size_t)r * NQKV]);
    kmean[o] = s * (1.f / 256.f);
  }
}

template <int MODE>
__device__ __forceinline__ void attn_naive_unit(const Args& a, unsigned char* lds, int b, int h, int sb, int tid) {
  unsigned char* ws = a.ws;
  const bf16_t* qkv = (const bf16_t*)(ws + WS_QKV);
  const int qoff = MODE ? 1536 : 0, koff = qoff + 512, voff = qoff + 1024;
  float* Ks = (float*)lds; float* Vs = Ks + 64 * 64; float* ck = Vs + 64 * 64; float* biasd = ck + 64;
  const int t = sb * 512 + tid; const size_t row = (size_t)b * SEQ + t;
  float q[64], o[64];
  {
    const u32x4* qp = (const u32x4*)(qkv + row * NQKV + qoff + h * 64);
#pragma unroll
    for (int c = 0; c < 8; ++c) { const u32x4 w = qp[c]; unpack8(w, q + 8 * c); }
#pragma unroll
    for (int d = 0; d < 64; ++d) { q[d] *= 0.6931471805599453f; o[d] = 0.f; }
  }
  float m = -1e30f, l = 0.f;
  unsigned selmask = 0u; const int own = t >> 8;
  float cq = 0.f, bfar = 0.f;
  __syncthreads();
  if (MODE == 0) {
    if (tid < 128) biasd[tid] = a.in[5][T5_BUCKET[tid] * 8 + h];
    bfar = a.in[5][31 * 8 + h];
    const float* km = (const float*)(ws + WS_KMEAN) + ((size_t)b * 16) * 512 + h * 64;
    float v0 = -3e38f, v1 = -3e38f, v2 = -3e38f; int i0 = -1, i1 = -1, i2 = -1;
    for (int n = 0; n < 2 * sb + 1; ++n) {
      if (n < own) {
        const float* kp = km + (size_t)n * 512; float s = 0.f;
#pragma unroll
        for (int d = 0; d < 64; ++d) s += q[d] * kp[d];
        if (s > v0) { v2 = v1; i2 = i1; v1 = v0; i1 = i0; v0 = s; i0 = n; }
        else if (s > v1) { v2 = v1; i2 = i1; v1 = s; i1 = n; }
        else if (s > v2) { v2 = s; i2 = n; }
      }
    }
    if (i0 >= 0) selmask |= 1u << i0;
    if (i1 >= 0) selmask |= 1u << i1;
    if (i2 >= 0) selmask |= 1u << i2;
  } else {
    cq = ((const float*)(ws + WS_CUM))[((size_t)(b * 8 + h)) * SEQ + t];
  }
  const int ntile = 8 * (sb + 1);
  for (int kt = 0; kt < ntile; ++kt) {
    __syncthreads();
    {
      const int r = tid >> 3, ch = tid & 7;
      const bf16_t* kp = qkv + ((size_t)b * SEQ + kt * 64 + r) * NQKV + h * 64 + ch * 8;
      const u32x4 kw = *(const u32x4*)(kp + koff), vw = *(const u32x4*)(kp + voff);
      unpack8(kw, Ks + r * 64 + ch * 8); unpack8(vw, Vs + r * 64 + ch * 8);
      if (MODE == 1 && tid < 64) ck[tid] = ((const float*)(ws + WS_CUM))[((size_t)(b * 8 + h)) * SEQ + kt * 64 + tid];
    }
    __syncthreads();
    const int kb = kt >> 2;
    bool act;
    if (MODE == 0) act = (kb == own) || (kb < own && ((selmask >> kb) & 1u));
    else act = (kt * 64 <= t);
    if (act) {
      for (int jj = 0; jj < 64; ++jj) {
        const int sp = kt * 64 + jj;
        if (sp > t) break;
        const f32x4* kr = (const f32x4*)(Ks + jj * 64);
        float s = 0.f;
#pragma unroll
        for (int c = 0; c < 16; ++c) { const f32x4 kv = kr[c]; s += q[4 * c] * kv.x + q[4 * c + 1] * kv.y + q[4 * c + 2] * kv.z + q[4 * c + 3] * kv.w; }
        if (MODE == 0) { const int dist = t - sp; s += (dist < 128) ? biasd[dist] : bfar; }
        else s += (cq - ck[jj]) * 0.6931471805599453f;
        if (s > m) { const float f = __expf(m - s); l *= f;
#pragma unroll
          for (int d = 0; d < 64; ++d) o[d] *= f;
          m = s; }
        const float p = __expf(s - m); l += p;
        const f32x4* vr = (const f32x4*)(Vs + jj * 64);
#pragma unroll
        for (int c = 0; c < 16; ++c) { const f32x4 vv = vr[c]; o[4 * c] += p * vv.x; o[4 * c + 1] += p * vv.y; o[4 * c + 2] += p * vv.z; o[4 * c + 3] += p * vv.w; }
      }
    }
  }
  const float il = 1.f / l;
  u32x4* op = (u32x4*)((bf16_t*)(ws + WS_OAB) + row * DM + (MODE ? 512 : 0) + h * 64);
#pragma unroll
  for (int c = 0; c < 8; ++c) { u32x4 w; w.x = pk2(o[8 * c] * il, o[8 * c + 1] * il); w.y = pk2(o[8 * c + 2] * il, o[8 * c + 3] * il); w.z = pk2(o[8 * c + 4] * il, o[8 * c + 5] * il); w.w = pk2(o[8 * c + 6] * il, o[8 * c + 7] * il); op[c] = w; }
}

__device__ __forceinline__ void phase_attn(const Args& a, unsigned char* lds, int tid) {
  for (int u = blockIdx.x; u < 1024; u += gridDim.x) {
    const int sb = 7 - (u >> 7), r = u & 127, mode = r & 1, bh = r >> 1;
    if (mode == 0) attn_naive_unit<0>(a, lds, bh >> 3, bh & 7, sb, tid);
    else attn_naive_unit<1>(a, lds, bh >> 3, bh & 7, sb, tid);
  }
}

namespace att {
typedef float f32x16 __attribute__((ext_vector_type(16)));
typedef short s16x4 __attribute__((ext_vector_type(4)));
typedef short v4i16_t __attribute__((ext_vector_type(4)));
typedef __attribute__((address_space(3))) const char* lds_cptr;
typedef float f32x2_t __attribute__((ext_vector_type(2))); typedef __bf16 bf16x2_t __attribute__((ext_vector_type(2)));
constexpr int PITCH = NQKV;
constexpr float LOG2E = 1.4426950408889634f;
constexpr float C2 = 0.125f * LOG2E;
constexpr int L_K = 0, L_V = 16384, L_WSF = 32768, L_OST = 34816, L_C2 = 67584, L_KM = 83968, L_BT = 88064, L_MISC = 88704;
__device__ __forceinline__ int crow(int r, int hi) { return (r & 3) + 8 * (r >> 2) + 4 * hi; }
__device__ __forceinline__ unsigned cvtpk(float lo, float hi) { f32x2_t v = {lo, hi}; bf16x2_t b = __builtin_convertvector(v, bf16x2_t); return __builtin_bit_cast(unsigned, b); }
__device__ __forceinline__ s16x4 vtr(lds_cptr p) { return __builtin_bit_cast(s16x4, __builtin_amdgcn_ds_read_tr16_b64_v4i16((__attribute__((address_space(3))) v4i16_t*)p)); }
__device__ __forceinline__ float xhalf_max(float m) { auto rr = __builtin_amdgcn_permlane32_swap(__float_as_uint(m), __float_as_uint(m), false, false); return fmaxf(__uint_as_float(rr[0]), __uint_as_float(rr[1])); }
__device__ __forceinline__ float xhalf_sum(float m) { auto rr = __builtin_amdgcn_permlane32_swap(__float_as_uint(m), __float_as_uint(m), false, false); return __uint_as_float(rr[0]) + __uint_as_float(rr[1]); }

template <int MODE>
__device__ __forceinline__ void unit(const Args& a, unsigned char* lds, int b, int h, int qb, int tid) {
  unsigned char* ws = a.ws;
  const int lane = tid & 63, r32 = lane & 31, hi = lane >> 5; const int wid = __builtin_amdgcn_readfirstlane(tid >> 6);
  const bf16_t* qkv = (const bf16_t*)(ws + WS_QKV);
  const int qoff = MODE ? 1536 : 0;
  const size_t rowbase = (size_t)b * SEQ; const int q0 = qb * 256;
  const bf16_t* Qw = qkv + (rowbase + q0 + wid * 32) * PITCH + qoff + h * 64;
  const bf16_t* Kh = qkv + rowbase * PITCH + qoff + 512 + h * 64;
  const bf16_t* Vh = qkv + rowbase * PITCH + qoff + 1024 + h * 64;
  float* wsf = (float*)(lds + L_WSF) + wid * 64;
  float* c2s = (float*)(lds + L_C2); float* kms = (float*)(lds + L_KM); float* bts = (float*)(lds + L_BT); unsigned* misc = (unsigned*)(lds + L_MISC);
  const int NTL = 4 * (qb + 1);
  __syncthreads();
  if (MODE == 0) {
    const float* km = (const float*)(ws + WS_KMEAN) + (size_t)b * 16 * 512 + h * 64;
    for (int i = tid; i < 16 * 64; i += 512) kms[i] = km[(size_t)(i >> 6) * 512 + (i & 63)];
    if (tid < 128) bts[tid] = a.in[5][T5_BUCKET[tid] * 8 + h] * LOG2E;
    if (tid == 128) bts[128] = a.in[5][31 * 8 + h] * LOG2E;
  } else {
    const float* cg = (const float*)(ws + WS_CUM) + (size_t)(b * 8 + h) * SEQ;
    for (int i = tid; i < 256 * (qb + 1); i += 512) c2s[i] = cg[i];
    if (tid == 0) misc[0] = 0u;
  }
  bf16x8 qr[4];
#pragma unroll
  for (int d0 = 0; d0 < 4; ++d0) qr[d0] = *(const bf16x8*)(Qw + (size_t)r32 * PITCH + d0 * 16 + hi * 8);
  __syncthreads();
  unsigned selmask = 0u; float cq2 = 0.f, far2 = 0.f, mhat = -1e30f; int t0 = 0;
  if (MODE == 0) {
    far2 = bts[128];
    float v0 = -3e38f, v1 = -3e38f, v2 = -3e38f; int i0 = -1, i1 = -1, i2 = -1;
    for (int n = 0; n < qb; ++n) {
      float s = 0.f;
#pragma unroll
      for (int d0 = 0; d0 < 4; ++d0)
#pragma unroll
        for (int j = 0; j < 8; ++j) s += bf2f((unsigned short)qr[d0][j]) * kms[n * 64 + d0 * 16 + hi * 8 + j];
      s = xhalf_sum(s);
      if (s > v0) { v2 = v1; i2 = i1; v1 = v0; i1 = i0; v0 = s; i0 = n; }
      else if (s > v1) { v2 = v1; i2 = i1; v1 = s; i1 = n; }
      else if (s > v2) { v2 = s; i2 = n; }
    }
    if (i0 >= 0) selmask |= 1u << i0;
    if (i1 >= 0) selmask |= 1u << i1;
    if (i2 >= 0) selmask |= 1u << i2;
  } else {
    cq2 = c2s[q0 + wid * 32 + r32];
    float s = 0.f;
#pragma unroll
    for (int d0 = 0; d0 < 4; ++d0)
#pragma unroll
      for (int j = 0; j < 8; ++j) { const float f = bf2f((unsigned short)qr[d0][j]); s += f * f; }
    s = xhalf_sum(s);
    atomicMax(&misc[0], __float_as_uint(s));
    __syncthreads();
    const float kn2 = __uint_as_float(((const unsigned*)(ws + 256))[b * 8 + h]);
    const float qkb = sqrtf(__uint_as_float(misc[0]) * kn2) * 1.0001f + 1e-3f;
    mhat = -qkb;
    const int j = lane; bool skip = false;
    if (j < NTL) skip = (2.f * qkb + c2s[q0] - c2s[64 * j + 63]) < -150.f;
    t0 = __popcll(__ballot(skip));
    if (t0 > NTL - 1) t0 = NTL - 1;
  }
  const bf16_t* ksrc = Kh + (size_t)lane * PITCH + wid * 8;
  const bf16_t* vsrc = Vh + (size_t)(16 * (wid & 3) + (lane >> 2)) * PITCH + (wid >> 2) * 32 + (lane & 3) * 8;
  unsigned char* kdst = lds + L_K + wid * 1024 + lane * 16; unsigned char* vdst = lds + L_V + wid * 1024 + lane * 16;
  const lds_cptr lds3 = (lds_cptr)lds;
  const lds_cptr vp0 = lds3 + L_V + ((lane >> 4) & 1) * 32 + (lane & 3) * 8 + (4 * hi + ((lane & 15) >> 2)) * 64;
  u32x4 kreg = *(const u32x4*)(ksrc + (size_t)t0 * 64 * PITCH), vreg = *(const u32x4*)(vsrc + (size_t)t0 * 64 * PITCH);
  *(u32x4*)(kdst + (t0 & 1) * 8192) = kreg; *(u32x4*)(vdst + (t0 & 1) * 8192) = vreg;
  f32x16 o[2]; o[0] = f32x16{}; o[1] = f32x16{};
  float l = 0.f;
  const int qrel = wid * 32 + r32, qpos = q0 + qrel;
  __syncthreads();
  for (int t = t0; t < NTL; ++t) {
    const int buf = (t & 1) * 8192;
    if (t + 1 < NTL) { kreg = *(const u32x4*)(ksrc + (size_t)(t + 1) * 64 * PITCH); vreg = *(const u32x4*)(vsrc + (size_t)(t + 1) * 64 * PITCH); }
    const int jb = t - (NTL - 4);
    const bool compute = !(jb >= 0 && 64 * jb > wid * 32 + 31);
    if (compute) {
      f32x16 p0, p1;
      if (MODE == 0) {
        const int nb = t >> 2;
        const bool near = (jb >= 0) || (t >= NTL - 6 && wid < 4);
        if (near) {
#pragma unroll
          for (int r = 0; r < 16; ++r) { const int d = qpos - (64 * t + crow(r, hi));
            p0[r] = bts[min(max(d, 0), 128)]; p1[r] = bts[min(max(d - 32, 0), 128)]; }
        } else {
#pragma unroll
          for (int r = 0; r < 16; ++r) { p0[r] = far2; p1[r] = far2; }
        }
        if (jb < 0 && !((selmask >> nb) & 1u)) {
#pragma unroll
          for (int r = 0; r < 16; ++r) { p0[r] = -INFINITY; p1[r] = -INFINITY; }
        }
      } else {
#pragma unroll
        for (int g = 0; g < 4; ++g) {
          const f32x4 ca = *(const f32x4*)(c2s + 64 * t + 8 * g + 4 * hi), cb = *(const f32x4*)(c2s + 64 * t + 32 + 8 * g + 4 * hi);
#pragma unroll
          for (int i = 0; i < 4; ++i) { p0[4 * g + i] = cq2 - ca[i]; p1[4 * g + i] = cq2 - cb[i]; }
        }
      }
      {
        const lds_cptr kb = lds3 + L_K + buf + hi * 1024 + r32 * 16;
#pragma unroll
        for (int d0 = 0; d0 < 4; ++d0) {
          const bf16x8 b0 = *(const __attribute__((address_space(3))) bf16x8*)(kb + d0 * 2048);
          const bf16x8 b1 = *(const __attribute__((address_space(3))) bf16x8*)(kb + d0 * 2048 + 512);
          p0 = __builtin_amdgcn_mfma_f32_32x32x16_bf16(b0, qr[d0], p0, 0, 0, 0);
          p1 = __builtin_amdgcn_mfma_f32_32x32x16_bf16(b1, qr[d0], p1, 0, 0, 0);
        }
      }
      if (jb >= 0) {
        const int kb0 = 64 * jb + 4 * hi;
#pragma unroll
        for (int r = 0; r < 16; ++r) { const int kv = kb0 + (r & 3) + 8 * (r >> 2); if (kv > qrel) p0[r] = -INFINITY; if (kv + 32 > qrel) p1[r] = -INFINITY; }
      }
      float rm = fmaxf(p0[0], p1[0]);
#pragma unroll
      for (int r = 1; r < 16; ++r) rm = fmaxf(rm, fmaxf(p0[r], p1[r]));
      rm = xhalf_max(rm);
      const float mnew = fmaxf(mhat, rm);
      if (__any(mnew > mhat)) {
        const float alpha = __builtin_amdgcn_exp2f(mhat - mnew);
        l *= alpha; mhat = mnew;
        if (hi == 0) wsf[r32] = alpha;
        __builtin_amdgcn_wave_barrier();
#pragma unroll
        for (int r = 0; r < 16; ++r) { const float f = wsf[crow(r, hi)]; o[0][r] *= f; o[1][r] *= f; }
        __builtin_amdgcn_wave_barrier();
      }
      float sacc = 0.f;
#pragma unroll
      for (int r = 0; r < 16; ++r) { p0[r] = __builtin_amdgcn_exp2f(p0[r] - mhat); p1[r] = __builtin_amdgcn_exp2f(p1[r] - mhat); sacc += p0[r] + p1[r]; }
      l += sacc;
      u32x4 pw0, pw1, pw2, pw3;
      pw0 = (u32x4){cvtpk(p0[0], p0[1]), cvtpk(p0[2], p0[3]), cvtpk(p0[4], p0[5]), cvtpk(p0[6], p0[7])};
      pw1 = (u32x4){cvtpk(p0[8], p0[9]), cvtpk(p0[10], p0[11]), cvtpk(p0[12], p0[13]), cvtpk(p0[14], p0[15])};
      pw2 = (u32x4){cvtpk(p1[0], p1[1]), cvtpk(p1[2], p1[3]), cvtpk(p1[4], p1[5]), cvtpk(p1[6], p1[7])};
      pw3 = (u32x4){cvtpk(p1[8], p1[9]), cvtpk(p1[10], p1[11]), cvtpk(p1[12], p1[13]), cvtpk(p1[14], p1[15])};
      const lds_cptr vp = vp0 + buf;
#pragma unroll
      for (int d0 = 0; d0 < 2; ++d0) {
#define ATT_VF(ks) ({ const s16x4 lo_ = vtr(vp + d0 * 4096 + (ks) * 1024), hi_ = vtr(vp + d0 * 4096 + (ks) * 1024 + 512); (bf16x8){lo_[0], lo_[1], lo_[2], lo_[3], hi_[0], hi_[1], hi_[2], hi_[3]}; })
        o[d0] = __builtin_amdgcn_mfma_f32_32x32x16_bf16(__builtin_bit_cast(bf16x8, pw0), ATT_VF(0), o[d0], 0, 0, 0);
        o[d0] = __builtin_amdgcn_mfma_f32_32x32x16_bf16(__builtin_bit_cast(bf16x8, pw1), ATT_VF(1), o[d0], 0, 0, 0);
        o[d0] = __builtin_amdgcn_mfma_f32_32x32x16_bf16(__builtin_bit_cast(bf16x8, pw2), ATT_VF(2), o[d0], 0, 0, 0);
        o[d0] = __builtin_amdgcn_mfma_f32_32x32x16_bf16(__builtin_bit_cast(bf16x8, pw3), ATT_VF(3), o[d0], 0, 0, 0);
#undef ATT_VF
      }
    }
    if (t + 1 < NTL) { *(u32x4*)(kdst + ((t + 1) & 1) * 8192) = kreg; *(u32x4*)(vdst + ((t + 1) & 1) * 8192) = vreg; }
    __syncthreads();
  }
  l = xhalf_sum(l);
  if (hi == 0) wsf[32 + r32] = l;
  __builtin_amdgcn_wave_barrier();
  bf16_t* stg = (bf16_t*)(lds + L_OST) + wid * 2048;
#pragma unroll
  for (int r = 0; r < 16; ++r) { const int orow = crow(r, hi); const float rl = 1.f / wsf[32 + orow];
    stg[orow * 64 + r32] = (bf16_t)f2bf(o[0][r] * rl); stg[orow * 64 + 32 + r32] = (bf16_t)f2bf(o[1][r] * rl); }
  __builtin_amdgcn_wave_barrier();
  bf16_t* Ow = (bf16_t*)(ws + WS_OAB) + (rowbase + q0 + wid * 32) * DM + (MODE ? 512 : 0) + h * 64;
#pragma unroll
  for (int i = 0; i < 4; ++i) { const int row = i * 8 + (lane >> 3), ch = lane & 7; const u32x4 v = *(const u32x4*)(stg + row * 64 + ch * 8); *(u32x4*)(Ow + (size_t)row * DM + ch * 8) = v; }
}
}

__device__ __forceinline__ void phase_attn2(const Args& a, unsigned char* lds, int tid) {
  unsigned* ctr = (unsigned*)(a.ws + 0);
  unsigned* slot = (unsigned*)(lds + att::L_MISC + 64);
  for (;;) {
    __syncthreads();
    if (tid == 0) slot[0] = atomicAdd(ctr, 1u);
    __syncthreads();
    const unsigned u = slot[0];
    if (u >= 2048u) break;
    const int qb = 15 - (int)(u >> 7), r = u & 127, mode = r & 1, bh = r >> 1;
    if (mode == 0) att::unit<0>(a, lds, bh >> 3, bh & 7, qb, tid);
    else att::unit<1>(a, lds, bh >> 3, bh & 7, qb, tid);
  }
}

__device__ __forceinline__ void phase_onorm(const Args& a, int gw, int ngw, int lane) {
  bf16_t* oab = (bf16_t*)(a.ws + WS_OAB);
  for (int r = gw; r < NT; r += ngw) {
    u32x4* p = (u32x4*)(oab + (size_t)r * DM) + 2 * lane;
    const u32x4 w0 = p[0], w1 = p[1]; float f[16]; unpack8(w0, f); unpack8(w1, f + 8);
    float s = 0.f;
#pragma unroll
    for (int i = 0; i < 16; ++i) s += f[i] * f[i];
#pragma unroll
    for (int o = 1; o < 32; o <<= 1) s += __shfl_xor(s, o);
    const float rstd = rsqrtf(s * (1.f / 512.f) + EPS);
    u32x4 o0, o1;
    o0.x = pk2(f[0] * rstd, f[1] * rstd); o0.y = pk2(f[2] * rstd, f[3] * rstd); o0.z = pk2(f[4] * rstd, f[5] * rstd); o0.w = pk2(f[6] * rstd, f[7] * rstd);
    o1.x = pk2(f[8] * rstd, f[9] * rstd); o1.y = pk2(f[10] * rstd, f[11] * rstd); o1.z = pk2(f[12] * rstd, f[13] * rstd); o1.w = pk2(f[14] * rstd, f[15] * rstd);
    p[0] = o0; p[1] = o1;
  }
}

__device__ __forceinline__ void phase_rms(const Args& a, int gw, int ngw, int lane) {
  for (int r = gw; r < NT; r += ngw) rms_row_to_bf16(a.out + (size_t)r * DM, (bf16_t*)(a.ws + WS_HB) + (size_t)r * DM, lane);
}

__device__ __forceinline__ void phase_xattn(const Args& a, unsigned char* lds, int gw, int ngw, int wave, int lane) {
  unsigned char* ws = a.ws;
  const bf16_t* qx = (const bf16_t*)(ws + WS_QX); const bf16_t* kx = (const bf16_t*)(ws + WS_KX); const bf16_t* vxt = (const bf16_t*)(ws + WS_VXT);
  bf16_t* ox = (bf16_t*)(ws + WS_OX);
  bf16_t* P = (bf16_t*)(lds + wave * 8192);
  const int fr = lane & 15, fq = lane >> 4;
  for (int u = gw; u < (NT / 16) * 4; u += ngw) {
    const int hd = u & 3, r0 = (u >> 2) * 16, b = r0 / SEQ;
    f32x4 acc[16];
#pragma unroll
    for (int i = 0; i < 16; ++i) acc[i] = (f32x4){0.f, 0.f, 0.f, 0.f};
    const bf16_t* Ap = qx + (size_t)(r0 + fr) * DM + hd * 256 + fq * 8;
    const bf16_t* Bp = kx + (size_t)(b * 256 + fr) * DM + hd * 256 + fq * 8;
    for (int ks = 0; ks < 8; ++ks) {
      const bf16x8 af = *(const bf16x8*)(Ap + ks * 32);
#pragma unroll
      for (int ct = 0; ct < 16; ++ct) { const bf16x8 bfr = *(const bf16x8*)(Bp + (size_t)ct * 16 * DM + ks * 32); acc[ct] = __builtin_amdgcn_mfma_f32_16x16x32_bf16(af, bfr, acc[ct], 0, 0, 0); }
    }
    float mx[4], sm[4];
#pragma unroll
    for (int r = 0; r < 4; ++r) { float m = acc[0][r];
#pragma unroll
      for (int ct = 1; ct < 16; ++ct) m = fmaxf(m, acc[ct][r]);
#pragma unroll
      for (int o = 1; o < 16; o <<= 1) m = fmaxf(m, __shfl_xor(m, o));
      mx[r] = m; sm[r] = 0.f; }
#pragma unroll
    for (int ct = 0; ct < 16; ++ct)
#pragma unroll
      for (int r = 0; r < 4; ++r) { const float p = __expf((acc[ct][r] - mx[r]) * 0.0625f); acc[ct][r] = p; sm[r] += p; }
#pragma unroll
    for (int r = 0; r < 4; ++r) {
#pragma unroll
      for (int o = 1; o < 16; o <<= 1) sm[r] += __shfl_xor(sm[r], o);
      sm[r] = 1.f / sm[r]; }
    __builtin_amdgcn_wave_barrier();
#pragma unroll
    for (int ct = 0; ct < 16; ++ct)
#pragma unroll
      for (int r = 0; r < 4; ++r) P[(4 * fq + r) * 256 + ct * 16 + fr] = (bf16_t)f2bf(acc[ct][r] * sm[r]);
    __builtin_amdgcn_wave_barrier();
    asm volatile("s_waitcnt lgkmcnt(0)" ::: "memory");
#pragma unroll
    for (int i = 0; i < 16; ++i) acc[i] = (f32x4){0.f, 0.f, 0.f, 0.f};
    const bf16_t* Vp = vxt + ((size_t)(b * 4 + hd) * 256 + fr) * 256 + fq * 8;
    for (int ks = 0; ks < 8; ++ks) {
      const bf16x8 pf = *(const bf16x8*)(P + fr * 256 + ks * 32 + fq * 8);
#pragma unroll
      for (int dt = 0; dt < 16; ++dt) { const bf16x8 vf = *(const bf16x8*)(Vp + (size_t)dt * 16 * 256 + ks * 32); acc[dt] = __builtin_amdgcn_mfma_f32_16x16x32_bf16(pf, vf, acc[dt], 0, 0, 0); }
    }
#pragma unroll
    for (int dt = 0; dt < 16; ++dt)
#pragma unroll
      for (int r = 0; r < 4; ++r) ox[(size_t)(r0 + 4 * fq + r) * DM + hd * 256 + dt * 16 + fr] = (bf16_t)f2bf(acc[dt][r]);
    __builtin_amdgcn_wave_barrier();
  }
}

namespace xa {
using att::f32x16; using att::s16x4; using att::lds_cptr; using att::crow; using att::cvtpk; using att::vtr; using att::xhalf_max; using att::xhalf_sum;
constexpr int L_WSF = 65536;
__device__ __forceinline__ void unit(const Args& a, unsigned char* lds, int b, int hd, int qb, int tid) {
  unsigned char* ws = a.ws;
  const int lane = tid & 63, r32 = lane & 31, hi = lane >> 5; const int wid = __builtin_amdgcn_readfirstlane(tid >> 6);
  const bf16_t* qrow = (const bf16_t*)(ws + WS_QX) + ((size_t)b * SEQ + qb * 256 + wid * 32 + r32) * DM + hd * 256;
  const bf16_t* kvb = (const bf16_t*)(ws + WS_KX) + (size_t)b * 256 * 2048 + hd * 256;
  const bf16_t* ksrc = kvb + (size_t)lane * 2048 + wid * 8;
  const bf16_t* vsrc = kvb + 1024 + (size_t)(16 * (wid & 3) + (lane >> 2)) * 2048 + (wid >> 2) * 32 + (lane & 3) * 8;
  unsigned char* sdst = lds + wid * 1024 + lane * 16;
  const lds_cptr lds3 = (lds_cptr)lds;
  const lds_cptr kp0 = lds3 + hi * 1024 + r32 * 16;
  const lds_cptr vp0 = lds3 + ((lane >> 4) & 1) * 32 + (lane & 3) * 8 + (4 * hi + ((lane & 15) >> 2)) * 64;
  float* wsf = (float*)(lds + L_WSF) + wid * 64;
  u32x4 sreg[4];
#define XA_LOADK(c) do { _Pragma("unroll") for (int kt = 0; kt < 4; ++kt) sreg[kt] = *(const u32x4*)(ksrc + (size_t)kt * 64 * 2048 + (c) * 64); } while (0)
#define XA_LOADV(vt) do { _Pragma("unroll") for (int dq = 0; dq < 4; ++dq) sreg[dq] = *(const u32x4*)(vsrc + (size_t)(vt) * 64 * 2048 + dq * 64); } while (0)
#define XA_WRITE(buf) do { _Pragma("unroll") for (int i = 0; i < 4; ++i) *(u32x4*)(sdst + (buf) * 32768 + i * 8192) = sreg[i]; } while (0)
  __syncthreads();
  XA_LOADK(0); XA_WRITE(0);
  f32x16 acc[8];
#pragma unroll
  for (int j = 0; j < 8; ++j) acc[j] = f32x16{};
  __syncthreads();
#pragma unroll
  for (int c = 0; c < 4; ++c) {
    if (c < 3) XA_LOADK(c + 1); else XA_LOADV(0);
    bf16x8 qf[4];
#pragma unroll
    for (int d0 = 0; d0 < 4; ++d0) qf[d0] = *(const bf16x8*)(qrow + c * 64 + d0 * 16 + hi * 8);
    const lds_cptr kp = kp0 + (c & 1) * 32768;
#pragma unroll
    for (int d0 = 0; d0 < 4; ++d0)
#pragma unroll
      for (int j = 0; j < 8; ++j) {
        const bf16x8 kf = *(const __attribute__((address_space(3))) bf16x8*)(kp + (j >> 1) * 8192 + d0 * 2048 + (j & 1) * 512);
        acc[j] = __builtin_amdgcn_mfma_f32_32x32x16_bf16(kf, qf[d0], acc[j], 0, 0, 0);
      }
    XA_WRITE((c + 1) & 1);
    __syncthreads();
  }
  float m = acc[0][0];
#pragma unroll
  for (int j = 0; j < 8; ++j)
#pragma unroll
    for (int r = 0; r < 16; ++r) m = fmaxf(m, acc[j][r]);
  m = xhalf_max(m);
  constexpr float CS = 1.4426950408889634f / 16.f;
  float l = 0.f; u32x4 pw[16];
#pragma unroll
  for (int j = 0; j < 8; ++j) {
#pragma unroll
    for (int r = 0; r < 16; ++r) { const float p = __builtin_amdgcn_exp2f((acc[j][r] - m) * CS); acc[j][r] = p; l += p; }
    pw[2 * j] = (u32x4){cvtpk(acc[j][0], acc[j][1]), cvtpk(acc[j][2], acc[j][3]), cvtpk(acc[j][4], acc[j][5]), cvtpk(acc[j][6], acc[j][7])};
    pw[2 * j + 1] = (u32x4){cvtpk(acc[j][8], acc[j][9]), cvtpk(acc[j][10], acc[j][11]), cvtpk(acc[j][12], acc[j][13]), cvtpk(acc[j][14], acc[j][15])};
  }
  l = xhalf_sum(l);
#pragma unroll
  for (int j = 0; j < 8; ++j) acc[j] = f32x16{};
#pragma unroll
  for (int vt = 0; vt < 4; ++vt) {
    if (vt < 3) XA_LOADV(vt + 1);
    const lds_cptr vp = vp0 + (vt & 1) * 32768;
#pragma unroll
    for (int ks = 0; ks < 4; ++ks)
#pragma unroll
      for (int db = 0; db < 8; ++db) {
        const s16x4 lo_ = vtr(vp + (db >> 1) * 8192 + (db & 1) * 4096 + ks * 1024), hi_ = vtr(vp + (db >> 1) * 8192 + (db & 1) * 4096 + ks * 1024 + 512);
        const bf16x8 vf = (bf16x8){lo_[0], lo_[1], lo_[2], lo_[3], hi_[0], hi_[1], hi_[2], hi_[3]};
        acc[db] = __builtin_amdgcn_mfma_f32_32x32x16_bf16(__builtin_bit_cast(bf16x8, pw[4 * vt + ks]), vf, acc[db], 0, 0, 0);
      }
    if (vt < 3) XA_WRITE((vt + 1) & 1);
    __syncthreads();
  }
  if (hi == 0) wsf[r32] = l;
  __builtin_amdgcn_wave_barrier();
  float rl[16];
#pragma unroll
  for (int r = 0; r < 16; ++r) rl[r] = 1.f / wsf[crow(r, hi)];
  bf16_t* stg = (bf16_t*)(lds + wid * 8192);
  bf16_t* orow0 = (bf16_t*)(ws + WS_OX) + ((size_t)b * SEQ + qb * 256 + wid * 32) * DM + hd * 256;
#pragma unroll
  for (int hf = 0; hf < 2; ++hf) {
#pragma unroll
    for (int db = 0; db < 4; ++db)
#pragma unroll
      for (int r = 0; r < 16; ++r) stg[crow(r, hi) * 128 + db * 32 + r32] = (bf16_t)f2bf(acc[hf * 4 + db][r] * rl[r]);
    __builtin_amdgcn_wave_barrier();
#pragma unroll
    for (int i = 0; i < 8; ++i) { const int row = i * 4 + (lane >> 4), ch = lane & 15; const u32x4 v = *(const u32x4*)(stg + row * 128 + ch * 8); *(u32x4*)(orow0 + (size_t)row * DM + hf * 128 + ch * 8) = v; }
    __builtin_amdgcn_wave_barrier();
  }
#undef XA_LOADK
#undef XA_LOADV
#undef XA_WRITE
}
}

__device__ __forceinline__ void phase_xattn2(const Args& a, unsigned char* lds, int tid) {
  for (int u = blockIdx.x; u < NB * 4 * 16; u += gridDim.x) { const int qb = u & 15, hd = (u >> 4) & 3, b = u >> 6; xa::unit(a, lds, b, hd, qb, tid); }
}

__device__ __forceinline__ unsigned fkey(float s, unsigned idx, unsigned mask) { unsigned u = __float_as_uint(s); u ^= (unsigned)((int)u >> 31) | 0x80000000u; return (u & ~mask) | (mask - idx); }
__device__ __forceinline__ float keyval(unsigned k, unsigned mask) { unsigned u = k & ~mask; u = (u & 0x80000000u) ? (u ^ 0x80000000u) : ~u; return __uint_as_float(u); }
#define KEY_INSERT(KA, key_) do { unsigned k__ = (key_); \
  _Pragma("unroll") for (int s_ = 0; s_ < 16; ++s_) { const unsigned hi_ = max(k__, KA[s_]); k__ = min(k__, KA[s_]); KA[s_] = hi_; } } while (0)

__device__ __forceinline__ void phase_topk(const Args& a, unsigned char* lds, int tid) {
  unsigned char* ws = a.ws;
  const float* pq = (const float*)(ws + WS_PQ);
  int* eidx = (int*)(ws + WS_EIDX); float* gate = (float*)(ws + WS_GATE);
  float* K1 = (float*)lds; float* K2 = K1 + 128 * 64; unsigned* KL = (unsigned*)(lds + 65536);
  for (int u = blockIdx.x; u < 8 * (NT / 512); u += gridDim.x) {
    const int h = u & 7, t = (u >> 3) * 512 + tid;
    __syncthreads();
    for (int i = tid; i < 128 * 64 / 4; i += 512) { ((f32x4*)K1)[i] = ((const f32x4*)(a.in[17] + (size_t)h * 8192))[i]; ((f32x4*)K2)[i] = ((const f32x4*)(a.in[18] + (size_t)h * 8192))[i]; }
    __syncthreads();
    unsigned ka[16], kb[16], kc[16];
#pragma unroll
    for (int k = 0; k < 16; ++k) { ka[k] = 0u; kb[k] = 0u; kc[k] = 0u; }
    float q[64];
    const f32x4* qp = (const f32x4*)(pq + (size_t)t * DM + h * 128);
#pragma unroll
    for (int c = 0; c < 16; ++c) { const f32x4 w = qp[c]; q[4 * c] = w.x; q[4 * c + 1] = w.y; q[4 * c + 2] = w.z; q[4 * c + 3] = w.w; }
    for (int n = 0; n < 128; ++n) {
      const f32x4* kr = (const f32x4*)(K1 + n * 64); float s = 0.f;
#pragma unroll
      for (int c = 0; c < 16; ++c) { const f32x4 kv = kr[c]; s += q[4 * c] * kv.x + q[4 * c + 1] * kv.y + q[4 * c + 2] * kv.z + q[4 * c + 3] * kv.w; }
      KEY_INSERT(ka, fkey(s, (unsigned)n, 127u));
    }
#pragma unroll
    for (int c = 0; c < 16; ++c) { const f32x4 w = qp[16 + c]; q[4 * c] = w.x; q[4 * c + 1] = w.y; q[4 * c + 2] = w.z; q[4 * c + 3] = w.w; }
    for (int n = 0; n < 128; ++n) {
      const f32x4* kr = (const f32x4*)(K2 + n * 64); float s = 0.f;
#pragma unroll
      for (int c = 0; c < 16; ++c) { const f32x4 kv = kr[c]; s += q[4 * c] * kv.x + q[4 * c + 1] * kv.y + q[4 * c + 2] * kv.z + q[4 * c + 3] * kv.w; }
      KEY_INSERT(kb, fkey(s, (unsigned)n, 127u));
    }
#pragma unroll
    for (int x = 0; x < 16; ++x)
#pragma unroll
      for (int y = 0; y < 16; ++y)
        if ((x + 1) * (y + 1) <= 16) { KEY_INSERT(kc, fkey(keyval(ka[x], 127u) + keyval(kb[y], 127u), (unsigned)(x * 16 + y), 255u)); }
#pragma unroll
    for (int k = 0; k < 16; ++k) { KL[k * 512 + tid] = ka[k]; KL[(16 + k) * 512 + tid] = kb[k]; }
    float val[16]; int id[16]; float sum = 0.f;
#pragma unroll
    for (int k = 0; k < 16; ++k) {
      const unsigned flat = 255u - (kc[k] & 255u);
      const unsigned k1 = KL[(flat >> 4) * 512 + tid], k2 = KL[(16 + (flat & 15u)) * 512 + tid];
      val[k] = keyval(k1, 127u) + keyval(k2, 127u);
      id[k] = (int)((127u - (k1 & 127u)) * 128u + (127u - (k2 & 127u)));
    }
    const float vmax = val[0];
#pragma unroll
    for (int k = 0; k < 16; ++k) { val[k] = __expf(val[k] - vmax); sum += val[k]; }
    const float inv = 1.f / sum;
    int* ep = eidx + (size_t)t * 128 + h * 16; float* gp = gate + (size_t)t * 128 + h * 16;
#pragma unroll
    for (int k = 0; k < 16; ++k) { ep[k] = id[k]; gp[k] = val[k] * inv; }
  }
}


namespace tk {
typedef float f32x16 __attribute__((ext_vector_type(16)));
__device__ __forceinline__ void ce(unsigned& a, unsigned& b) { const unsigned h = max(a, b), l = min(a, b); a = h; b = l; }
__device__ __forceinline__ void sort16(unsigned (&v)[16]) {
#pragma unroll
  for (int k = 2; k <= 16; k <<= 1)
#pragma unroll
    for (int j = k >> 1; j > 0; j >>= 1)
#pragma unroll
      for (int i = 0; i < 16; ++i) { const int l = i ^ j; if (l > i) { if ((i & k) == 0) ce(v[i], v[l]); else ce(v[l], v[i]); } }
}
__device__ __forceinline__ void topmerge(unsigned (&a)[16], const unsigned (&b)[16]) {
#pragma unroll
  for (int i = 0; i < 16; ++i) a[i] = max(a[i], b[15 - i]);
#pragma unroll
  for (int j = 8; j > 0; j >>= 1)
#pragma unroll
    for (int i = 0; i < 16; ++i) { const int l = i ^ j; if (l > i) ce(a[i], a[l]); }
}
__device__ __forceinline__ unsigned xswap(unsigned v, int hi) { auto rr = __builtin_amdgcn_permlane32_swap(v, v, false, false); return hi ? rr[0] : rr[1]; }
__device__ __forceinline__ void half_list(unsigned (&L)[16], const bf16_t* skh, const bf16_t* qrow, int r32, int hi) {
  f32x16 acc[4];
#pragma unroll
  for (int i = 0; i < 4; ++i) acc[i] = f32x16{};
#pragma unroll
  for (int ks = 0; ks < 4; ++ks) {
    const bf16x8 qf = *(const bf16x8*)(qrow + ks * 16 + hi * 8);
#pragma unroll
    for (int tl = 0; tl < 4; ++tl) { const bf16x8 kf = *(const bf16x8*)(skh + (size_t)(tl * 32 + r32) * 64 + ks * 16 + hi * 8); acc[tl] = __builtin_amdgcn_mfma_f32_32x32x16_bf16(kf, qf, acc[tl], 0, 0, 0); }
  }
  unsigned g[4][16];
#pragma unroll
  for (int tl = 0; tl < 4; ++tl)
#pragma unroll
    for (int r = 0; r < 16; ++r) g[tl][r] = fkey(acc[tl][r], (unsigned)(32 * tl + (r & 3) + 8 * (r >> 2) + 4 * hi), 127u);
  sort16(g[0]); sort16(g[1]); sort16(g[2]); sort16(g[3]);
  topmerge(g[0], g[1]); topmerge(g[2], g[3]); topmerge(g[0], g[2]);
  unsigned p[16];
#pragma unroll
  for (int k = 0; k < 16; ++k) p[k] = xswap(g[0][k], hi);
  topmerge(g[0], p);
#pragma unroll
  for (int k = 0; k < 16; ++k) L[k] = g[0][k];
}
}

__device__ __forceinline__ void phase_topk2(const Args& a, unsigned char* lds, int wave, int lane) {
  unsigned char* ws = a.ws;
  const bf16_t* pq = (const bf16_t*)(ws + WS_PQ); const bf16_t* sk = (const bf16_t*)(ws + WS_SK);
  int* eidx = (int*)(ws + WS_EIDX); float* gate = (float*)(ws + WS_GATE);
  const int r32 = lane & 31, hi = lane >> 5, h = wave;
  unsigned* KL = (unsigned*)(lds + wave * 4096);
  for (int tt = blockIdx.x; tt < NT / 32; tt += gridDim.x) {
    const int t = tt * 32 + r32;
    unsigned ka[16], kb[16], kc[16];
    tk::half_list(ka, sk + (size_t)(0 * 8 + h) * 8192, pq + (size_t)t * DM + h * 128, r32, hi);
    tk::half_list(kb, sk + (size_t)(1 * 8 + h) * 8192, pq + (size_t)t * DM + h * 128 + 64, r32, hi);
    float va[16], vb[16];
#pragma unroll
    for (int k = 0; k < 16; ++k) { va[k] = keyval(ka[k], 127u); vb[k] = keyval(kb[k], 127u); }
#pragma unroll
    for (int y = 0; y < 16; ++y) kc[y] = hi ? 0u : fkey(va[0] + vb[y], (unsigned)y, 255u);
#define TK_CAND(xa, ya, xb, yb) do { const unsigned kA_ = fkey(va[xa] + vb[ya], (unsigned)((xa) * 16 + (ya)), 255u), kB_ = fkey(va[xb] + vb[yb], (unsigned)((xb) * 16 + (yb)), 255u); KEY_INSERT(kc, hi ? kB_ : kA_); } while (0)
    TK_CAND(1, 0, 1, 1);
    TK_CAND(1, 2, 1, 3);
    TK_CAND(1, 4, 1, 5);
    TK_CAND(1, 6, 1, 7);
    TK_CAND(2, 0, 2, 1);
    TK_CAND(2, 2, 2, 3);
    TK_CAND(2, 4, 3, 0);
    TK_CAND(3, 1, 3, 2);
    TK_CAND(3, 3, 4, 0);
    TK_CAND(4, 1, 4, 2);
    TK_CAND(5, 0, 5, 1);
    TK_CAND(6, 0, 6, 1);
    TK_CAND(7, 0, 7, 1);
    TK_CAND(8, 0, 9, 0);
    TK_CAND(10, 0, 11, 0);
    TK_CAND(12, 0, 13, 0);
    TK_CAND(14, 0, 15, 0);
#undef TK_CAND
    { unsigned p[16];
#pragma unroll
      for (int k = 0; k < 16; ++k) p[k] = tk::xswap(kc[k], hi);
      tk::topmerge(kc, p); }
    if (hi == 0) {
#pragma unroll
      for (int k = 0; k < 16; ++k) { KL[k * 32 + r32] = ka[k]; KL[(16 + k) * 32 + r32] = kb[k]; }
    }
    __builtin_amdgcn_wave_barrier();
    const float vmax = va[0] + vb[0];
    float pv[8]; int id[8]; float s = 0.f;
#pragma unroll
    for (int j = 0; j < 8; ++j) {
      unsigned klo_ = kc[j], khi_ = kc[8 + j]; asm volatile("" : "+v"(klo_), "+v"(khi_));
      const unsigned key = hi ? khi_ : klo_;
      const unsigned flat = 255u - (key & 255u);
      const unsigned k1 = KL[(flat >> 4) * 32 + r32], k2 = KL[(16 + (flat & 15u)) * 32 + r32];
      pv[j] = __expf(keyval(k1, 127u) + keyval(k2, 127u) - vmax); s += pv[j];
      id[j] = (int)((127u - (k1 & 127u)) * 128u + (127u - (k2 & 127u)));
    }
    __builtin_amdgcn_wave_barrier();
    const float inv = 1.f / att::xhalf_sum(s);
    u32x4* ep = (u32x4*)(eidx + (size_t)t * 128 + h * 16 + hi * 8); f32x4* gp = (f32x4*)(gate + (size_t)t * 128 + h * 16 + hi * 8);
    ep[0] = (u32x4){(unsigned)id[0], (unsigned)id[1], (unsigned)id[2], (unsigned)id[3]}; ep[1] = (u32x4){(unsigned)id[4], (unsigned)id[5], (unsigned)id[6], (unsigned)id[7]};
    gp[0] = (f32x4){pv[0] * inv, pv[1] * inv, pv[2] * inv, pv[3] * inv}; gp[1] = (f32x4){pv[4] * inv, pv[5] * inv, pv[6] * inv, pv[7] * inv};
  }
}

__device__ __forceinline__ float gelu_erf(float v) { return 0.5f * v * (1.f + erff(v * 0.70710678118654752f)); }

#ifndef EXG
#define EXG 4
#endif
__device__ __forceinline__ void phase_experts(const Args& a, int gw, int ngw, int lane, float* outp) {
  unsigned char* ws = a.ws;
  const int* eidx = (const int*)(ws + WS_EIDX); const float* gate = (const float*)(ws + WS_GATE);
  const unsigned char* exd = ws + WS_EXD; const unsigned char* exu = ws + WS_EXU; const float* esc = (const float*)(ws + WS_ESC);
  const int l32 = lane & 31, hi = lane >> 5;
  for (int t = gw; t < NT; t += ngw) {
    const f32x4* xr = (const f32x4*)(a.out + (size_t)t * DM) + 8 * l32;
    float hg[32], acc[32]; float s = 0.f;
#pragma unroll
    for (int k = 0; k < 8; ++k) { const f32x4 x = xr[k]; s += (x.x * x.x + x.y * x.y) + (x.z * x.z + x.w * x.w); hg[4 * k] = x.x; hg[4 * k + 1] = x.y; hg[4 * k + 2] = x.z; hg[4 * k + 3] = x.w; }
#pragma unroll
    for (int o = 1; o < 32; o <<= 1) s += __shfl_xor(s, o);
    const float rstd = rsqrtf(s * (1.f / DM) + EPS);
#pragma unroll
    for (int k = 0; k < 8; ++k) { const f32x4 g = ((const f32x4*)a.in[15])[8 * l32 + k]; hg[4 * k] *= rstd * g.x; hg[4 * k + 1] *= rstd * g.y; hg[4 * k + 2] *= rstd * g.z; hg[4 * k + 3] *= rstd * g.w; }
#pragma unroll
    for (int i = 0; i < 32; ++i) acc[i] = 0.f;
    const int e0 = eidx[(size_t)t * 128 + lane], e1 = eidx[(size_t)t * 128 + 64 + lane];
    const float sd0 = esc[e0], sd1 = esc[e1];
    const float gu0 = gate[(size_t)t * 128 + lane] * esc[NEXP + e0], gu1 = gate[(size_t)t * 128 + 64 + lane] * esc[NEXP + e1];
    for (int e = 0; e < 128; e += 2 * EXG) {
      u32x2 ur[EXG][3], vr[EXG][3];
#pragma unroll
      for (int i = 0; i < EXG; ++i) {
        const int pi = (e & 63) + 2 * i + hi; const int id = (e < 64) ? __shfl(e0, pi) : __shfl(e1, pi);
        const u32x2* up = (const u32x2*)(exd + (size_t)id * 768 + 24 * l32); const u32x2* vp = (const u32x2*)(exu + (size_t)id * 768 + 24 * l32);
        ur[i][0] = up[0]; ur[i][1] = up[1]; ur[i][2] = up[2]; vr[i][0] = vp[0]; vr[i][1] = vp[1]; vr[i][2] = vp[2];
      }
#pragma unroll
      for (int i = 0; i < EXG; ++i) {
        const int pi = (e & 63) + 2 * i + hi;
        const v32f u = __builtin_amdgcn_cvt_scalef32_pk32_f32_fp6((v6u){ur[i][0].x, ur[i][0].y, ur[i][1].x, ur[i][1].y, ur[i][2].x, ur[i][2].y}, 1.0f);
        float d = 0.f;
#pragma unroll
        for (int k = 0; k < 32; ++k) d += hg[k] * u[k];
#pragma unroll
        for (int o = 1; o < 32; o <<= 1) d += __shfl_xor(d, o);
        const float sd = (e < 64) ? __shfl(sd0, pi) : __shfl(sd1, pi);
        const float gu = (e < 64) ? __shfl(gu0, pi) : __shfl(gu1, pi);
        const float w = gu * gelu_erf(d * sd);
        const v32f v = __builtin_amdgcn_cvt_scalef32_pk32_f32_fp6((v6u){vr[i][0].x, vr[i][0].y, vr[i][1].x, vr[i][1].y, vr[i][2].x, vr[i][2].y}, 1.0f);
#pragma unroll
        for (int k = 0; k < 32; ++k) acc[k] += w * v[k];
      }
    }
    float s2 = 0.f;
#pragma unroll
    for (int k = 0; k < 8; ++k) { const f32x4 x = xr[k];
      acc[4 * k] = x.x + att::xhalf_sum(acc[4 * k]); acc[4 * k + 1] = x.y + att::xhalf_sum(acc[4 * k + 1]); acc[4 * k + 2] = x.z + att::xhalf_sum(acc[4 * k + 2]); acc[4 * k + 3] = x.w + att::xhalf_sum(acc[4 * k + 3]);
      s2 += (acc[4 * k] * acc[4 * k] + acc[4 * k + 1] * acc[4 * k + 1]) + (acc[4 * k + 2] * acc[4 * k + 2] + acc[4 * k + 3] * acc[4 * k + 3]); }
#pragma unroll
    for (int o = 1; o < 32; o <<= 1) s2 += __shfl_xor(s2, o);
    const float r2 = rsqrtf(s2 * (1.f / DM) + EPS);
    f32x4* orow = (f32x4*)(outp + (size_t)t * DM) + 8 * l32;
#pragma unroll
    for (int k = 0; k < 8; ++k) { const f32x4 g = ((const f32x4*)a.in[21])[8 * l32 + k];
      const f32x4 o = (f32x4){acc[4 * k] * r2 * g.x, acc[4 * k + 1] * r2 * g.y, acc[4 * k + 2] * r2 * g.z, acc[4 * k + 3] * r2 * g.w};
      if ((k >> 2) == hi) orow[k] = o; }
  }
}

namespace pg8 {
#define PG8_LAS __attribute__((address_space(3)))
typedef unsigned short bf16_t;
typedef short bf16x8 __attribute__((ext_vector_type(8)));
typedef float f32x4 __attribute__((ext_vector_type(4)));
typedef unsigned u32x4 __attribute__((ext_vector_type(4)));
constexpr int BM = 256, BK = 64, HALF = 128, HTB = HALF * BK * 2  , STAGE_BYTES = 8 * HTB, NXCD = 8, WGM = 8;

__host__ __device__ __forceinline__ int lds_byte(int r, int c) { const int st = (r >> 4) * 2 + (c >> 5), rr = r & 15, cc = c & 31, ob = rr * 64 + cc * 2; return st * 1024 + (ob ^ (((ob >> 9) & 1) << 5)); }
__host__ __device__ __forceinline__ void stage_rc(int b, int& R, int& C) { const int st = b / 1024, sb = b % 1024, swz = sb ^ (((sb >> 9) & 1) << 5); R = (st >> 1) * 16 + swz / 64; C = (st & 1) * 32 + (swz % 64) / 2; }
__host__ __device__ __forceinline__ int perm32(int rho) { const int n = rho >> 4, i = rho & 15; return 8 * (i >> 2) + 4 * n + (i & 3); }

struct Unit { int pm, pn; };
struct Gemm { const bf16_t* A; const bf16_t* Bt; int M, N, K; };

struct StaticOrder {
    int nM, nN, nwg, G, c;
    __host__ __device__ void init(int M, int N, int G_, int c_) { nM = M / BM; nN = N / BM; nwg = nM * nN; G = G_; c = c_; }
    __host__ __device__ bool next(int i, Unit& u) const {
        const long L = (long)i * G + c; if (L >= nwg) return false;
        int wgid = (int)L; { const int q = nwg / NXCD, r = nwg % NXCD, xcd = wgid % NXCD, off = wgid / NXCD; wgid = (xcd < r ? xcd * (q + 1) : r * (q + 1) + (xcd - r) * q) + off; }
        const int nig = WGM * nN, gid = wgid / nig, fm = gid * WGM, gsz = (nM - fm) < WGM ? (nM - fm) : WGM;
        u.pm = fm + ((wgid % nig) % gsz); u.pn = (wgid % nig) / gsz; return true;
    }
    __device__ __forceinline__ void a_ready(const Unit&) const {}
    __device__ __forceinline__ void done(const Unit&) const {}
};

template <class St> struct EpiAdapt {
    static constexpr bool PERM = false, AFTER_DRAIN = false; St st;
    __device__ __forceinline__ void operator()(const f32x4 (&acc)[2][2][4][2], const Unit& u, int wr, int wc, int fr, int fq) const {
#pragma unroll
        for (int ai = 0; ai < 2; ++ai)
#pragma unroll
            for (int m = 0; m < 4; ++m)
#pragma unroll
                for (int bj = 0; bj < 2; ++bj)
#pragma unroll
                    for (int n = 0; n < 2; ++n) st.store(u.pm * BM + ai * HALF + wr * 64 + m * 16 + fr, u.pn * BM + bj * HALF + wc * 32 + n * 16 + 4 * fq, acc[ai][bj][m][n]);
    }
};

struct EpiResidSS {
    static constexpr bool PERM = false, AFTER_DRAIN = false; const float* base; float* out; bf16_t* hb; float* ss;
    __device__ __forceinline__ void operator()(const f32x4 (&acc)[2][2][4][2], const Unit& u, int wr, int wc, int fr, int fq) const {
#pragma unroll
        for (int ai = 0; ai < 2; ++ai)
#pragma unroll
            for (int m = 0; m < 4; ++m) {
                const int row = u.pm * BM + ai * HALF + wr * 64 + m * 16 + fr; float s = 0.f;
#pragma unroll
                for (int bj = 0; bj < 2; ++bj)
#pragma unroll
                    for (int n = 0; n < 2; ++n) {
                        const size_t o = (size_t)row * 1024 + u.pn * BM + bj * HALF + wc * 32 + n * 16 + 4 * fq;
                        const f32x4 v = *(const f32x4*)(base + o) + acc[ai][bj][m][n];
                        *(f32x4*)(out + o) = v;
                        typedef unsigned u32x2v __attribute__((ext_vector_type(2)));
                        { const float f0 = v.x, f1 = v.y, f2 = v.z, f3 = v.w; *(u32x2v*)(hb + o) = (u32x2v){::pk2(f0, f1), ::pk2(f2, f3)}; }
                        s += (v.x * v.x + v.y * v.y) + (v.z * v.z + v.w * v.w);
                    }
                s += __shfl_xor(s, 16); s += __shfl_xor(s, 32);
                if (fq == 0) atomicAdd(ss + row, s);
            }
    }
};
template <class Epi, class Sched, bool ALIGN_EPI = false, bool SP2 = false>
__device__ __forceinline__ void gemm_phase(PG8_LAS unsigned char* lds, const Gemm g, const Sched& S, const Epi& E) {
    const int tid = threadIdx.x, wid = __builtin_amdgcn_readfirstlane(tid >> 6), lane = tid & 63, wr = wid >> 2, wc = wid & 3, fr = lane & 15, fq = lane >> 4;
    const int K = g.K, nt = K / BK;
    unsigned voffA[2], voffB[2];
#pragma unroll
    for (int i = 0; i < 2; ++i) { int R, C; stage_rc(tid * 16 + i * 8192, R, C); const int Rb = Epi::PERM ? ((R & ~31) + perm32(R & 31)) : R;
        voffA[i] = (unsigned)(R * K + C) * 2u; voffB[i] = (unsigned)(Rb * K + C) * 2u; }
    const size_t kstep = (size_t)(BK * 2);
    const size_t hstep = (size_t)HALF * K * 2;
    const size_t tstep = 2 * hstep;
    const unsigned ldsw = (unsigned)wid * 1024u;
    const int aoff = lds_byte(wr * 64 + fr, fq * 8), boff = lds_byte(wc * 32 + fr, fq * 8);
#define PG8_SA(b, h) (((b) * 2 + (h)) * HTB)
#define PG8_SB(b, h) ((4 + (b) * 2 + (h)) * HTB)
#define PG8_STAGE(bufoff, gbase, voff) do { _Pragma("unroll") for (int _i = 0; _i < 2; ++_i) \
        __builtin_amdgcn_global_load_lds((const unsigned*)((const char*)(gbase) + (voff)[_i]), (PG8_LAS unsigned*)(lds + (bufoff) + ldsw + _i * 8192), 16, 0, 0); } while (0)
#define PG8_LDA(dst, b, h) do { _Pragma("unroll") for (int m = 0; m < 4; ++m) _Pragma("unroll") for (int k = 0; k < 2; ++k) dst[m][k] = *(const PG8_LAS bf16x8*)(lds + PG8_SA(b, h) + aoff + m * 2048 + k * 1024); } while (0)
#define PG8_LDB(dst, b, h) do { _Pragma("unroll") for (int n = 0; n < 2; ++n) _Pragma("unroll") for (int k = 0; k < 2; ++k) dst[n][k] = *(const PG8_LAS bf16x8*)(lds + PG8_SB(b, h) + boff + n * 2048 + k * 1024); } while (0)
#define PG8_MMA(ai, bj, At, Bt) do { __builtin_amdgcn_s_setprio(1); _Pragma("unroll") for (int m = 0; m < 4; ++m) _Pragma("unroll") for (int n = 0; n < 2; ++n) _Pragma("unroll") for (int k = 0; k < 2; ++k) \
        acc[ai][bj][m][n] = __builtin_amdgcn_mfma_f32_16x16x32_bf16(Bt[n][k], At[m][k], acc[ai][bj][m][n], 0, 0, 0); __builtin_amdgcn_s_setprio(0); } while (0)
#define PG8_WAIT_V(n) asm volatile("s_waitcnt vmcnt(" #n ")" ::: "memory")
#define PG8_WAIT_L(n) asm volatile("s_waitcnt lgkmcnt(" #n ")" ::: "memory")
#define PG8_BAR __builtin_amdgcn_s_barrier()
#define PG8_SCHED __builtin_amdgcn_sched_barrier(0)
    Unit cur, nxt; int ui = 0;
    if (!S.next(0, cur)) return;
    f32x4 acc[2][2][4][2];
#pragma unroll
    for (int a = 0; a < 2; ++a)
#pragma unroll
        for (int b = 0; b < 2; ++b)
#pragma unroll
            for (int m = 0; m < 4; ++m)
#pragma unroll
                for (int n = 0; n < 2; ++n) acc[a][b][m][n] = (f32x4){0.f, 0.f, 0.f, 0.f};
    bf16x8 At[4][2], B0[2][2], B1[2][2];
    const char* cA = (const char*)g.A + (size_t)cur.pm * tstep; const char* cB = (const char*)g.Bt + (size_t)cur.pn * tstep;
    S.a_ready(cur);
    if constexpr (SP2) {
        PG8_STAGE(PG8_SB(0, 0), cB, voffB); PG8_STAGE(PG8_SB(0, 1), cB + hstep, voffB); PG8_STAGE(PG8_SA(0, 0), cA, voffA); PG8_STAGE(PG8_SA(0, 1), cA + hstep, voffA);
        if (wr == 1) PG8_BAR;
        PG8_WAIT_V(2); PG8_BAR;
        PG8_STAGE(PG8_SB(1, 0), cB + kstep, voffB); PG8_STAGE(PG8_SA(1, 0), cA + kstep, voffA); PG8_STAGE(PG8_SB(1, 1), cB + hstep + kstep, voffB);
        PG8_WAIT_V(6); PG8_BAR;
    } else {
        PG8_STAGE(PG8_SB(0, 0), cB, voffB); PG8_STAGE(PG8_SA(0, 0), cA, voffA); PG8_STAGE(PG8_SB(0, 1), cB + hstep, voffB); PG8_STAGE(PG8_SA(0, 1), cA + hstep, voffA);
        if (wr == 1) PG8_BAR;
        PG8_WAIT_V(4); PG8_BAR;
        PG8_STAGE(PG8_SB(1, 0), cB + kstep, voffB); PG8_STAGE(PG8_SA(1, 0), cA + kstep, voffA); PG8_STAGE(PG8_SB(1, 1), cB + hstep + kstep, voffB);
        PG8_WAIT_V(6); PG8_BAR;
    }
    for (;;) {
        const bool has_next = S.next(ui + 1, nxt);
        const char* nA = has_next ? (const char*)g.A + (size_t)nxt.pm * tstep : cA; const char* nB = has_next ? (const char*)g.Bt + (size_t)nxt.pn * tstep : cB;
        for (int t = 0; t < nt; t += 2) {
            const bool last = (t == nt - 2);
            const char* a1 = cA + (size_t)(t + 1) * kstep;
            const char* a2 = last ? nA : cA + (size_t)(t + 2) * kstep; const char* b2 = last ? nB : cB + (size_t)(t + 2) * kstep;
            const char* a3 = a2 + kstep; const char* b3 = b2 + kstep;
            if (last && has_next) S.a_ready(nxt);
            if constexpr (SP2) {
            PG8_LDB(B0, 0, 0); PG8_LDB(B1, 0, 1); PG8_SCHED; PG8_LDA(At, 0, 0); PG8_STAGE(PG8_SA(1, 1), a1 + hstep, voffA);
            PG8_WAIT_V(8); PG8_WAIT_L(0); PG8_BAR; PG8_MMA(0, 0, At, B0); PG8_MMA(0, 1, At, B1); PG8_BAR; PG8_SCHED;
            PG8_LDA(At, 0, 1); PG8_STAGE(PG8_SB(0, 0), b2, voffB); PG8_STAGE(PG8_SB(0, 1), b2 + hstep, voffB); PG8_STAGE(PG8_SA(0, 0), a2, voffA);
            PG8_WAIT_V(8); PG8_WAIT_L(0); PG8_BAR; PG8_MMA(1, 0, At, B0); PG8_MMA(1, 1, At, B1); PG8_BAR; PG8_SCHED;
            PG8_LDB(B0, 1, 0); PG8_LDB(B1, 1, 1); PG8_SCHED; PG8_LDA(At, 1, 0); PG8_STAGE(PG8_SA(0, 1), a2 + hstep, voffA);
            PG8_WAIT_V(8); PG8_WAIT_L(0); PG8_BAR; PG8_MMA(0, 0, At, B0); PG8_MMA(0, 1, At, B1); PG8_BAR; PG8_SCHED;
            PG8_LDA(At, 1, 1); PG8_STAGE(PG8_SB(1, 0), b3, voffB); PG8_STAGE(PG8_SB(1, 1), b3 + hstep, voffB); PG8_STAGE(PG8_SA(1, 0), a3, voffA);
            PG8_WAIT_V(8); PG8_WAIT_L(0); PG8_BAR; PG8_MMA(1, 0, At, B0); PG8_MMA(1, 1, At, B1); PG8_BAR; PG8_SCHED;
            } else {
            PG8_LDB(B0, 0, 0); PG8_SCHED; PG8_LDA(At, 0, 0); PG8_STAGE(PG8_SA(1, 1), a1 + hstep, voffA);
            PG8_WAIT_L(8); PG8_BAR; PG8_WAIT_L(0); PG8_MMA(0, 0, At, B0); PG8_BAR; PG8_SCHED;
            PG8_LDB(B1, 0, 1); PG8_STAGE(PG8_SB(0, 0), b2, voffB);
            PG8_BAR; PG8_WAIT_L(0); PG8_MMA(0, 1, At, B1); PG8_BAR;
            PG8_LDA(At, 0, 1); PG8_STAGE(PG8_SA(0, 0), a2, voffA);
            PG8_BAR; PG8_WAIT_L(0); PG8_MMA(1, 0, At, B0); PG8_BAR; PG8_SCHED;
            PG8_STAGE(PG8_SB(0, 1), b2 + hstep, voffB);
            PG8_WAIT_V(6); PG8_BAR; PG8_MMA(1, 1, At, B1); PG8_BAR;
            PG8_LDB(B0, 1, 0); PG8_SCHED; PG8_LDA(At, 1, 0); PG8_STAGE(PG8_SA(0, 1), a2 + hstep, voffA);
            PG8_WAIT_L(8); PG8_BAR; PG8_WAIT_L(0); PG8_MMA(0, 0, At, B0); PG8_BAR; PG8_SCHED;
            PG8_LDB(B1, 1, 1); PG8_STAGE(PG8_SB(1, 0), b3, voffB);
            PG8_BAR; PG8_WAIT_L(0); PG8_MMA(0, 1, At, B1); PG8_BAR;
            PG8_LDA(At, 1, 1); PG8_STAGE(PG8_SA(1, 0), a3, voffA);
            PG8_BAR; PG8_WAIT_L(0); PG8_MMA(1, 0, At, B0); PG8_BAR; PG8_SCHED;
            PG8_STAGE(PG8_SB(1, 1), b3 + hstep, voffB);
            PG8_WAIT_V(6); PG8_BAR; PG8_MMA(1, 1, At, B1); PG8_BAR;
            }
        }
        if constexpr (ALIGN_EPI) { if (wr == 0) PG8_BAR; }
        if constexpr (!Epi::AFTER_DRAIN) { E(acc, cur, wr, wc, fr, fq); S.done(cur); }
        if (!has_next) break;
#pragma unroll
        for (int a = 0; a < 2; ++a)
#pragma unroll
            for (int b = 0; b < 2; ++b)
#pragma unroll
                for (int m = 0; m < 4; ++m)
#pragma unroll
                    for (int n = 0; n < 2; ++n) acc[a][b][m][n] = (f32x4){0.f, 0.f, 0.f, 0.f};
        cur = nxt; cA = nA; cB = nB; ++ui;
        if constexpr (ALIGN_EPI) { if (wr == 1) PG8_BAR; }
    }
    PG8_WAIT_V(0);
    if constexpr (!ALIGN_EPI) { if (wr == 0) PG8_BAR; }
    PG8_BAR;
    if constexpr (Epi::AFTER_DRAIN) { E.fused(acc, cur, wr, wc, fr, fq, lds, wid, lane); S.done(cur); }
#undef PG8_SA
#undef PG8_SB
#undef PG8_STAGE
#undef PG8_LDA
#undef PG8_LDB
#undef PG8_MMA
#undef PG8_WAIT_V
#undef PG8_WAIT_L
#undef PG8_BAR
#undef PG8_SCHED
}
}


template <class Epi>
__device__ __forceinline__ void run_gemm_raw(unsigned char* lds, const bf16_t* A, const bf16_t* Bt, int M, int N, int K, const Epi& E) {
  pg8::Gemm g{A, Bt, M, N, K}; pg8::StaticOrder S; S.init(M, N, (int)gridDim.x, (int)blockIdx.x);
  pg8::gemm_phase<Epi, pg8::StaticOrder, true, true>((PG8_LAS unsigned char*)lds, g, S, E);
}
template <class St>
__device__ __forceinline__ void run_gemm(unsigned char* lds, const bf16_t* A, const bf16_t* Bt, int M, int N, int K, const St& st, int gw, int ngw, int lane) {
#if USE_PG8
  pg8::Gemm g{A, Bt, M, N, K}; pg8::StaticOrder S; S.init(M, N, (int)gridDim.x, (int)blockIdx.x);
  pg8::EpiAdapt<St> E{st};
  pg8::gemm_phase<pg8::EpiAdapt<St>, pg8::StaticOrder, true, true>((PG8_LAS unsigned char*)lds, g, S, E);
#else
  gemm_naive(A, K, Bt, K, M, N, K, st, gw, ngw, lane);
#endif
}

#define GAS __attribute__((address_space(1)))
#define LAS __attribute__((address_space(3)))
#define XB_TMO      128
#define XB_XCNT(j)  (256  + 64 * (j))
#define XB_XSUB(j)  (1280 + 64 * (j))
#define XB_XGEN(j)  (2304 + 64 * (j))
#define XB_TOP      3328
#define XB_TOPGEN   3392
#define XCD_BAR_WORDS 3456
#define XB_SPIN_CAP (1u << 18)

__device__ __forceinline__ unsigned xb_ld(unsigned* p)              { return __hip_atomic_load(p, __ATOMIC_RELAXED, __HIP_MEMORY_SCOPE_AGENT); }
__device__ __forceinline__ unsigned xb_add(unsigned* p, unsigned v) { return __hip_atomic_fetch_add(p, v, __ATOMIC_RELAXED, __HIP_MEMORY_SCOPE_AGENT); }
__device__ __forceinline__ unsigned xb_xcc_id() { return (unsigned)__builtin_amdgcn_s_getreg((3 << 11) | 20) & 0xFu; }
#define XB_SPIN(cond, bar) do { unsigned _sp = 0; while (cond) { __builtin_amdgcn_s_sleep(1); \
    if ((++_sp & 255u) == 0u) { if (xb_ld(&(bar)[XB_TMO])) break; if (_sp > XB_SPIN_CAP) { atomicAdd(&(bar)[XB_TMO], 1u); break; } } } } while (0)

struct XcdBarrier {
    unsigned* bar; unsigned x;
    volatile LAS unsigned* st;
};

__device__ __forceinline__ XcdBarrier xcd_barrier_post(unsigned* bar, volatile LAS unsigned* st) {
    XcdBarrier b; b.bar = bar; b.x = xb_xcc_id(); b.st = st;
    if (threadIdx.x == 0) (void)xb_add(&bar[XB_XCNT(b.x)], 1u);
    return b;
}
__device__ __forceinline__ void xcd_barrier_complete(unsigned* bar, unsigned x, unsigned& nloc, unsigned& nx) {
    const unsigned G = gridDim.x * gridDim.y * gridDim.z;
    unsigned sum, cnt, mine, sp = 0u;
    for (;;) {
        sum = 0u; cnt = 0u; mine = 0u;
#pragma unroll
        for (unsigned j = 0; j < 16; ++j) { const unsigned c = xb_ld(&bar[XB_XCNT(j)]); sum += c; cnt += (c > 0u) ? 1u : 0u; mine = (j == x) ? c : mine; }
        if (sum == G) break;
        __builtin_amdgcn_s_sleep(1);
        if ((++sp & 255u) == 0u) { if (xb_ld(&bar[XB_TMO])) break; if (sp > XB_SPIN_CAP) { atomicAdd(&bar[XB_TMO], 1u); break; } }
    }
    nloc = mine > 0u ? mine : 1u; nx = cnt > 0u ? cnt : 1u;
}

__device__ __forceinline__ void xcd_barrier(const XcdBarrier& b) {
    asm volatile("s_waitcnt vmcnt(0)" ::: "memory");
    __syncthreads();
    if (threadIdx.x == 0) {
        unsigned* bar = b.bar;
        __builtin_amdgcn_s_waitcnt(0);
        unsigned nloc = b.st[0], nx = b.st[1];
        if (nloc == 0u) { xcd_barrier_complete(bar, b.x, nloc, nx); b.st[0] = nloc; b.st[1] = nx; }
        const unsigned old = xb_add(&bar[XB_XSUB(b.x)], 1u);
        const unsigned gen = old / nloc;
        if (old + 1u == (gen + 1u) * nloc) {
            __builtin_amdgcn_fence(__ATOMIC_RELEASE, "agent");
            asm volatile("s_waitcnt vmcnt(0)" ::: "memory");
            const unsigned og = xb_add(&bar[XB_TOP], 1u);
            const unsigned tg = og / nx;
            if (og + 1u == (tg + 1u) * nx) xb_add(&bar[XB_TOPGEN], 1u);
            else XB_SPIN(xb_ld(&bar[XB_TOPGEN]) == tg, bar);
            __builtin_amdgcn_fence(__ATOMIC_ACQUIRE, "agent");
            xb_add(&bar[XB_XGEN(b.x)], 1u);
            asm volatile("s_waitcnt vmcnt(0)" ::: "memory");
        } else {
            XB_SPIN(xb_ld(&bar[XB_XGEN(b.x)]) == gen, bar);
            __builtin_amdgcn_fence(__ATOMIC_ACQUIRE, "agent");
            asm volatile("s_waitcnt vmcnt(0)" ::: "memory");
        }
    }
    __syncthreads();
}

__global__ void __launch_bounds__(512, 2) mega(Args a) {
  extern __shared__ __attribute__((aligned(16))) unsigned char lds[];
  cg::grid_group grid = cg::this_grid();
  const int tid = threadIdx.x, lane = tid & 63, wave = tid >> 6;
  const int gw = blockIdx.x * 8 + wave, ngw = gridDim.x * 8;
  unsigned char* ws = a.ws;
  const int lo = a.ph_lo, hi = a.ph_hi;
#define IN(k) (lo <= (k) && (k) < hi)
  volatile LAS unsigned* MISC = (volatile LAS unsigned*)((LAS unsigned char*)lds + 131072 + 320);
  if (tid < 32) MISC[tid] = 0u;
  __syncthreads();
  XcdBarrier bar; bar.bar = (unsigned*)(ws + WS_BAR); bar.x = 0; bar.st = nullptr;
  if (hi - lo > 1) bar = xcd_barrier_post((unsigned*)(ws + WS_BAR), MISC + 8);
#define SEAM(k) do { if (IN(k) && IN((k) + 1)) { if ((k) == 0) grid.sync(); else xcd_barrier(bar); } } while (0)
#if PROBE_REP == 0
  if (IN(0)) { phase_prep(a, lds, gw, ngw, wave, lane, tid); grid.sync(); }
#endif
  if (IN(0)) { phase_prep(a, lds, gw, ngw, wave, lane, tid); } SEAM(0);
#if PROBE_REP == 1
  if (IN(1)) {
    run_gemm(lds, (const bf16_t*)(ws + WS_HB), (const bf16_t*)(ws + WS_WIN_T), NT, NQKV, DM, EpiQKV{(bf16_t*)(ws + WS_QKV)}, gw, ngw, lane);
    run_gemm(lds, (const bf16_t*)(ws + WS_MEMN), (const bf16_t*)(ws + WS_WXKV_T), NMROWS, 2048, DM, EpiBf16{(bf16_t*)(ws + WS_KX), 2048}, gw, ngw, lane);
    xcd_barrier(bar); }
#endif
#if PROBE_REP == 2
  if (IN(2)) { phase_scan(a, gw, ngw, lane, tid); xcd_barrier(bar); phase_rms(a, gw, ngw, lane); xcd_barrier(bar); phase_rms(a, gw, ngw, lane); xcd_barrier(bar); }
#endif
  if (IN(1)) {
    run_gemm(lds, (const bf16_t*)(ws + WS_HB), (const bf16_t*)(ws + WS_WIN_T), NT, NQKV, DM, EpiQKV{(bf16_t*)(ws + WS_QKV)}, gw, ngw, lane);
    run_gemm(lds, (const bf16_t*)(ws + WS_MEMN), (const bf16_t*)(ws + WS_WXKV_T), NMROWS, 2048, DM, EpiBf16{(bf16_t*)(ws + WS_KX), 2048}, gw, ngw, lane);
  } SEAM(1);
  if (IN(2)) { phase_scan(a, gw, ngw, lane, tid); } SEAM(2);
#if PROBE_REP == 3
  if (IN(3)) { phase_attn2(a, lds, tid); xcd_barrier(bar); if (blockIdx.x == 0 && tid == 0) *(unsigned*)(ws) = 0u; xcd_barrier(bar); }
#endif
  if (IN(3)) {
#if USE_ATT2
    phase_attn2(a, lds, tid);
#else
    phase_attn(a, lds, tid);
#endif
  } SEAM(3);
  if (IN(4)) { phase_onorm(a, gw, ngw, lane); } SEAM(4);
  if (IN(5)) { run_gemm_raw(lds, (const bf16_t*)(ws + WS_OAB), (const bf16_t*)(ws + WS_WOUT_T), NT, DM, DM, pg8::EpiResidSS{a.in[0], a.out, (bf16_t*)(ws + WS_HB), (float*)(ws + WS_SS1)}); }
  if (IN(5) && IN(7)) xcd_barrier(bar);
  if (IN(7)) { run_gemm(lds, (const bf16_t*)(ws + WS_HB), (const bf16_t*)(ws + WS_WXQ_T), NT, DM, DM, EpiBf16S{(bf16_t*)(ws + WS_QX), DM, (const float*)(ws + WS_SS1)}, gw, ngw, lane); } SEAM(7);
#if PROBE_REP == 8
  if (IN(8)) { phase_xattn(a, lds, gw, ngw, wave, lane); grid.sync(); }
#endif
  if (IN(8)) { phase_xattn2(a, lds, tid); } SEAM(8);
  if (IN(9)) { run_gemm_raw(lds, (const bf16_t*)(ws + WS_OX), (const bf16_t*)(ws + WS_WXO_T), NT, DM, DM, pg8::EpiResidSS{a.out, a.out, (bf16_t*)(ws + WS_HB), (float*)(ws + WS_SS2)}); }
  if (IN(9) && IN(11)) xcd_barrier(bar);
  if (IN(11)) { run_gemm(lds, (const bf16_t*)(ws + WS_HB), (const bf16_t*)(ws + WS_WPQ_T), NT, DM, DM, EpiBf16S{(bf16_t*)(ws + WS_PQ), DM, (const float*)(ws + WS_SS2)}, gw, ngw, lane); } SEAM(11);
#if PROBE_REP == 12
  if (IN(12)) { phase_topk(a, lds, tid); grid.sync(); }
#endif
  if (IN(12)) { phase_topk2(a, lds, wave, lane); } SEAM(12);
  #if PROBE_REP == 13
  if (IN(13)) { phase_experts(a, gw, ngw, lane, (float*)(ws + WS_QKV)); grid.sync(); }
#endif
  if (IN(13)) { phase_experts(a, gw, ngw, lane, a.out); }
#undef IN
#undef SEAM
}

extern "C" void kernel_launch(void* const* d_in, const int* in_sizes, int n_in, void* d_out, int out_size, void* d_ws, size_t ws_size, hipStream_t stream) {
  static int grid = 0;
  if (grid == 0) {
    if (n_in != 22 || out_size != NT * DM || ws_size < WS_END) { fprintf(stderr, "kernel_launch: unexpected shapes (n_in %d out %d ws %zu)\n", n_in, out_size, ws_size); grid = -1; return; }
    int dev = 0, cus = 0, per_cu = 0;
    (void)hipGetDevice(&dev);
    (void)hipDeviceGetAttribute(&cus, hipDeviceAttributeMultiprocessorCount, dev);
    (void)hipFuncSetAttribute((const void*)mega, hipFuncAttributeMaxDynamicSharedMemorySize, LDS_BYTES);
    (void)hipOccupancyMaxActiveBlocksPerMultiprocessor(&per_cu, (const void*)mega, 512, LDS_BYTES);
    if (per_cu < 1) per_cu = 1;
    grid = cus * per_cu;
  }
  if (grid < 0) return;
  (void)hipMemsetAsync(d_ws, 0, CTL_ZERO_BYTES, stream);
  Args a{};
  for (int i = 0; i < 22; ++i) a.in[i] = (const float*)d_in[i];
  a.out = (float*)d_out; a.ws = (unsigned char*)d_ws;
#if MK_N_LAUNCHES == 1
  a.ph_lo = 0; a.ph_hi = NPHASE + 1;
  void* args[] = {&a};
  hipError_t e = hipLaunchCooperativeKernel((const void*)mega, dim3(grid), dim3(512), args, LDS_BYTES, stream);
  if (e != hipSuccess) fprintf(stderr, "cooperative launch failed: %s (grid %d)\n", hipGetErrorString(e), grid);
#else
  for (int p = 0; p <= NPHASE; ++p) { a.ph_lo = p; a.ph_hi = p + 1; hipLaunchKernelGGL(mega, dim3(grid), dim3(512), LDS_BYTES, stream, a); }
#endif
}
```

```cpp
#include <hip/hip_runtime.h>
#include <hip/hip_cooperative_groups.h>
#include <cstdio>
#include <cstdint>
namespace cg = cooperative_groups;

#ifndef USE_PG8
#define USE_PG8 1
#endif
#ifndef USE_ATT2
#define USE_ATT2 1
#endif
#ifndef PROBE_REP
#define PROBE_REP -1
#endif
#ifndef REP_DOWN
#define REP_DOWN 1
#endif
#ifndef REP_UP
#define REP_UP 1
#endif
#ifndef MK_N_LAUNCHES
#define MK_N_LAUNCHES 1
#endif

typedef unsigned short bf16_t;
typedef short bf16x8 __attribute__((ext_vector_type(8)));
typedef float f32x4 __attribute__((ext_vector_type(4)));
typedef unsigned u32x4 __attribute__((ext_vector_type(4)));
typedef unsigned u32x2 __attribute__((ext_vector_type(2)));
typedef float v32f __attribute__((ext_vector_type(32)));
typedef float v16f __attribute__((ext_vector_type(16)));
typedef unsigned v6u __attribute__((ext_vector_type(6)));

constexpr int NB = 8, SEQ = 4096, DM = 1024, NT = NB * SEQ;
constexpr int NQKV = 3072, INW = 3080;
constexpr int NMEM = 256, NMROWS = NB * NMEM;
constexpr int NEXP = 16384;
constexpr float EPS = 1e-6f;
constexpr int NPHASE = 13;
constexpr int LDS_BYTES = 147456;

constexpr size_t MiB = 1u << 20;
constexpr size_t WS_BAR = 65536;
constexpr size_t WS_SS1 = 131072;
constexpr size_t WS_SS2 = 262144;
constexpr size_t WS_SS3 = 393216;
constexpr size_t WS_XCTR = 512;
constexpr size_t CTL_ZERO_BYTES = 524288;
constexpr size_t WS_WIN_T = 2 * MiB;
constexpr size_t WS_WOUT_T = 8 * MiB;
constexpr size_t WS_WXQ_T = 10 * MiB;
constexpr size_t WS_WXKV_T = 12 * MiB;
constexpr size_t WS_WXO_T = 16 * MiB;
constexpr size_t WS_WPQ_T = 18 * MiB;
constexpr size_t WS_SK = 21 * MiB;
constexpr size_t WS_MEMN = 22 * MiB;
constexpr size_t WS_KX = 26 * MiB;
constexpr size_t WS_VXT = 30 * MiB;
constexpr size_t WS_FLOG = 34 * MiB;
constexpr size_t WS_CUM = 35 * MiB;
constexpr size_t WS_KMEAN = 36 * MiB;
constexpr size_t WS_ESC = 38 * MiB;
constexpr size_t WS_EXD = 40 * MiB;
constexpr size_t WS_EXU = 72 * MiB;
constexpr size_t WS_HB = 104 * MiB;
constexpr size_t WS_QKV = 168 * MiB;
constexpr size_t WS_OAB = 360 * MiB;
constexpr size_t WS_QX = 168 * MiB;
constexpr size_t WS_OX = 232 * MiB;
constexpr size_t WS_PQ = 232 * MiB;
constexpr size_t WS_EIDX = 424 * MiB;
constexpr size_t WS_GATE = 440 * MiB;
constexpr size_t WS_W = 456 * MiB;
constexpr size_t WS_END = 472 * MiB;

struct Args {
  const float* in[22];
  float* out;
  unsigned char* ws;
  int ph_lo, ph_hi;
  int rep_down, rep_up;
};

struct XcdBarrier;
__device__ __forceinline__ unsigned f2bf(float f) { unsigned u = __float_as_uint(f); return (u + 0x7fffu + ((u >> 16) & 1u)) >> 16; }
__device__ __forceinline__ unsigned pk2(float lo, float hi) { return f2bf(lo) | (f2bf(hi) << 16); }
__device__ __forceinline__ float bf2f(unsigned short b) { return __uint_as_float(((unsigned)b) << 16); }
__device__ __forceinline__ float bflo(unsigned w) { return __uint_as_float(w << 16); }
__device__ __forceinline__ float bfhi(unsigned w) { return __uint_as_float(w & 0xffff0000u); }
__device__ __forceinline__ float wave_sum(float v) {
#pragma unroll
  for (int o = 1; o < 64; o <<= 1) v += __shfl_xor(v, o);
  return v;
}
template <int O> __device__ __forceinline__ float swz_xor(float v) { return __int_as_float(__builtin_amdgcn_ds_swizzle(__float_as_int(v), (O << 10) | 0x1f)); }
__device__ __forceinline__ float half_sum32(float v) { v += swz_xor<1>(v); v += swz_xor<2>(v); v += swz_xor<4>(v); v += swz_xor<8>(v); v += swz_xor<16>(v); return v; }
__device__ __forceinline__ void unpack8(const u32x4 w, float* f) {
  f[0] = bflo(w.x); f[1] = bfhi(w.x); f[2] = bflo(w.y); f[3] = bfhi(w.y);
  f[4] = bflo(w.z); f[5] = bfhi(w.z); f[6] = bflo(w.w); f[7] = bfhi(w.w);
}

__device__ const unsigned char T5_BUCKET[128] = {
  0, 1, 2, 3, 4, 5, 6, 7, 8, 9, 10, 11, 12, 13, 14, 15, 16, 16, 16, 17, 17, 18, 18, 18, 19, 19, 19, 20, 20, 20, 20, 21,
  21, 21, 21, 22, 22, 22, 22, 22, 23, 23, 23, 23, 23, 23, 24, 24, 24, 24, 24, 24, 25, 25, 25, 25, 25, 25, 25, 26, 26, 26, 26, 26,
  26, 26, 26, 27, 27, 27, 27, 27, 27, 27, 27, 27, 27, 28, 28, 28, 28, 28, 28, 28, 28, 28, 28, 29, 29, 29, 29, 29, 29, 29, 29, 29,
  29, 29, 29, 30, 30, 30, 30, 30, 30, 30, 30, 30, 30, 30, 30, 30, 30, 31, 31, 31, 31, 31, 31, 31, 31, 31, 31, 31, 31, 31, 31, 31};

__device__ __forceinline__ void transpose_item(const float* W, int ldw, const float* gain, bf16_t* WT, int K, int row_off, float* scr, int kb, int nb, int lane) {
  const int k0 = 64 * kb, n0 = 32 * nb;
#pragma unroll 8
  for (int i = 0; i < 32; ++i) {
    const int kk = 2 * i + (lane >> 5);
    const float g = gain ? gain[k0 + kk] : 1.f;
    scr[kk * 33 + (lane & 31)] = W[(size_t)(k0 + kk) * ldw + n0 + (lane & 31)] * g;
  }
  __builtin_amdgcn_wave_barrier();
  const int c = lane & 7;
#pragma unroll
  for (int j = 0; j < 4; ++j) {
    const int n = (lane >> 3) + 8 * j; const float* s = scr + (8 * c) * 33 + n;
    u32x4 o; o.x = pk2(s[0 * 33], s[1 * 33]); o.y = pk2(s[2 * 33], s[3 * 33]); o.z = pk2(s[4 * 33], s[5 * 33]); o.w = pk2(s[6 * 33], s[7 * 33]);
    *(u32x4*)(WT + (size_t)(row_off + n0 + n) * K + k0 + 8 * c) = o;
  }
  __builtin_amdgcn_wave_barrier();
}

__device__ __forceinline__ void rms_row_to_bf16(const float* xrow, bf16_t* orow, int lane) {
  const f32x4* xr = (const f32x4*)xrow + lane;
  f32x4 v[4]; float s = 0.f;
#pragma unroll
  for (int j = 0; j < 4; ++j) { v[j] = xr[64 * j]; s += (v[j].x * v[j].x + v[j].y * v[j].y) + (v[j].z * v[j].z + v[j].w * v[j].w); }
  const float rstd = rsqrtf(wave_sum(s) * (1.f / DM) + EPS);
  u32x2* o = (u32x2*)orow + lane;
#pragma unroll
  for (int j = 0; j < 4; ++j) { u32x2 w; w.x = pk2(v[j].x * rstd, v[j].y * rstd); w.y = pk2(v[j].z * rstd, v[j].w * rstd); o[64 * j] = w; }
}

__device__ __forceinline__ void phase_prep(const Args& a, unsigned char* lds, int gw, int ngw, int wave, int lane, int tid) {
  unsigned char* ws = a.ws;
  float* scr = (float*)(lds + wave * 8448);
  const int I_IN = 16 * 96, I_SQ = 16 * 32;
  const int NITEMS = I_IN + 6 * I_SQ;
  for (int it = gw; it < NITEMS; it += ngw) {
    int r = it;
    if (r < I_IN) { transpose_item(a.in[3], INW, a.in[2], (bf16_t*)(ws + WS_WIN_T), DM, 0, scr, r / 96, r % 96, lane); continue; } r -= I_IN;
    const int which = r / I_SQ; r %= I_SQ; const int kb = r / 32, nb = r % 32;
    if (which == 0) { const float* g = (kb < 8) ? a.in[6] : (a.in[7] - 512); transpose_item(a.in[8], DM, g, (bf16_t*)(ws + WS_WOUT_T), DM, 0, scr, kb, nb, lane); }
    else if (which == 1) transpose_item(a.in[11], DM, a.in[9], (bf16_t*)(ws + WS_WXQ_T), DM, 0, scr, kb, nb, lane);
    else if (which == 2) transpose_item(a.in[12], DM, a.in[10], (bf16_t*)(ws + WS_WXKV_T), DM, 0, scr, kb, nb, lane);
    else if (which == 3) transpose_item(a.in[13], DM, a.in[10], (bf16_t*)(ws + WS_WXKV_T), DM, 1024, scr, kb, nb, lane);
    else if (which == 4) transpose_item(a.in[14], DM, nullptr, (bf16_t*)(ws + WS_WXO_T), DM, 0, scr, kb, nb, lane);
    else transpose_item(a.in[16], DM, a.in[15], (bf16_t*)(ws + WS_WPQ_T), DM, 0, scr, kb, nb, lane);
  }
  for (int it = gw; it < NEXP; it += ngw) {
    const int hi = lane >> 5, l32 = lane & 31; const int r = 2 * it + hi;
    const int tb = r >= NEXP, e = r - tb * NEXP;
    const f32x4* src = (const f32x4*)(a.in[19 + tb] + (size_t)e * DM) + 8 * l32;
    v16f xa, xb; float am = 0.f;
#pragma unroll
    for (int k = 0; k < 4; ++k) { const f32x4 p = src[k], q = src[4 + k];
      xa[2 * k] = p.x; xb[2 * k] = p.y; xa[2 * k + 1] = p.z; xb[2 * k + 1] = p.w; xa[8 + 2 * k] = q.x; xb[8 + 2 * k] = q.y; xa[8 + 2 * k + 1] = q.z; xb[8 + 2 * k + 1] = q.w;
      am = fmaxf(am, fmaxf(fmaxf(fabsf(p.x), fabsf(p.y)), fmaxf(fabsf(p.z), fabsf(p.w)))); am = fmaxf(am, fmaxf(fmaxf(fabsf(q.x), fabsf(q.y)), fmaxf(fabsf(q.z), fabsf(q.w)))); }
#pragma unroll
    for (int o = 1; o < 32; o <<= 1) am = fmaxf(am, __shfl_xor(am, o));
    const float sc = am > 0.f ? 7.0f / am : 1.f;
    xa = xa * sc; xb = xb * sc;
    const v6u w = __builtin_amdgcn_cvt_scalef32_2xpk16_fp6_f32(xa, xb, 1.0f);
    u32x2* dst = tb ? (u32x2*)(ws + WS_EXU + (size_t)(l32 >> 2) * (NEXP * 128) + (size_t)e * 128 + 24 * (l32 & 3)) : (u32x2*)(ws + WS_EXD + (size_t)e * 768 + 24 * l32);
    dst[0] = (u32x2){w[0], w[1]}; dst[1] = (u32x2){w[2], w[3]}; dst[2] = (u32x2){w[4], w[5]};
    if (l32 == 0) ((float*)(ws + WS_ESC))[r] = am > 0.f ? am / 7.0f : 1.f;
  }
  for (int i = blockIdx.x * 512 + tid; i < 2 * 65536; i += gridDim.x * 512) ((bf16_t*)(ws + WS_SK))[i] = (bf16_t)f2bf(a.in[17 + (i >> 16)][i & 65535]);
  for (int r = gw; r < NMROWS; r += ngw) rms_row_to_bf16(a.in[1] + (size_t)r * DM, (bf16_t*)(ws + WS_MEMN) + (size_t)r * DM, lane);
  __syncthreads();
  float* wf = (float*)(lds + 69632);
  for (int k = tid; k < DM; k += 512) {
    const float g = a.in[2][k]; const f32x4* wp = (const f32x4*)(a.in[3] + (size_t)k * INW + NQKV);
    const f32x4 p = wp[0], q = wp[1];
    wf[k] = p.x * g; wf[1024 + k] = p.y * g; wf[2048 + k] = p.z * g; wf[3072 + k] = p.w * g; wf[4096 + k] = q.x * g; wf[5120 + k] = q.y * g; wf[6144 + k] = q.z * g; wf[7168 + k] = q.w * g;
  }
  __syncthreads();
  float* flog = (float*)(ws + WS_FLOG);
  for (int r = gw; r < NT; r += ngw) {
    const f32x4* xr = (const f32x4*)(a.in[0] + (size_t)r * DM) + lane;
    f32x4 v[4]; float s = 0.f; float fa[8];
#pragma unroll
    for (int j = 0; j < 8; ++j) fa[j] = 0.f;
#pragma unroll
    for (int j = 0; j < 4; ++j) {
      v[j] = xr[64 * j]; s += (v[j].x * v[j].x + v[j].y * v[j].y) + (v[j].z * v[j].z + v[j].w * v[j].w);
#pragma unroll
      for (int jj = 0; jj < 8; ++jj) { const f32x4 w4 = *(const f32x4*)(wf + jj * 1024 + 256 * j + 4 * lane); fa[jj] += (v[j].x * w4.x + v[j].y * w4.y) + (v[j].z * w4.z + v[j].w * w4.w); }
    }
    const float rstd = rsqrtf(wave_sum(s) * (1.f / DM) + EPS);
    float mine = 0.f;
#pragma unroll
    for (int j = 0; j < 8; ++j) { const float t = wave_sum(fa[j]); if (lane == j) mine = t; }
    if (lane < 8) {
      const float z = mine * rstd + a.in[4][lane];
      flog[(size_t)r * 8 + lane] = fminf(z, 0.f) - log1pf(expf(-fabsf(z)));
    }
    u32x2* o = (u32x2*)((bf16_t*)(ws + WS_HB) + (size_t)r * DM) + lane;
#pragma unroll
    for (int j = 0; j < 4; ++j) { u32x2 w; w.x = pk2(v[j].x * rstd, v[j].y * rstd); w.y = pk2(v[j].z * rstd, v[j].w * rstd); o[64 * j] = w; }
  }
}

template <class Epi>
__device__ __forceinline__ void gemm_naive(const bf16_t* A, int lda, const bf16_t* Bt, int ldb, int M, int N, int K, const Epi& E, int gw, int ngw, int lane) {
  const int fr = lane & 15, fq = lane >> 4;
  const int tn = N / 64, ntile = (M / 64) * tn;
  for (int tile = gw; tile < ntile; tile += ngw) {
    const int pm = tile / tn, pn = tile % tn;
    f32x4 acc[4][4];
#pragma unroll
    for (int m = 0; m < 4; ++m)
#pragma unroll
      for (int n = 0; n < 4; ++n) acc[m][n] = (f32x4){0.f, 0.f, 0.f, 0.f};
    const bf16_t* Ap = A + (size_t)(pm * 64 + fr) * lda + fq * 8;
    const bf16_t* Bp = Bt + (size_t)(pn * 64 + fr) * ldb + fq * 8;
    for (int k0 = 0; k0 < K; k0 += 32) {
      bf16x8 af[4], bfr[4];
#pragma unroll
      for (int m = 0; m < 4; ++m) af[m] = *(const bf16x8*)(Ap + (size_t)m * 16 * lda + k0);
#pragma unroll
      for (int n = 0; n < 4; ++n) bfr[n] = *(const bf16x8*)(Bp + (size_t)n * 16 * ldb + k0);
#pragma unroll
      for (int m = 0; m < 4; ++m)
#pragma unroll
        for (int n = 0; n < 4; ++n) acc[m][n] = __builtin_amdgcn_mfma_f32_16x16x32_bf16(bfr[n], af[m], acc[m][n], 0, 0, 0);
    }
#pragma unroll
    for (int m = 0; m < 4; ++m)
#pragma unroll
      for (int n = 0; n < 4; ++n) E.store(pm * 64 + m * 16 + fr, pn * 64 + n * 16 + 4 * fq, acc[m][n]);
  }
}

struct EpiBf16 { bf16_t* O; int ldo;
  __device__ __forceinline__ void store8(int row, int col, f32x4 a, f32x4 b) const { u32x4 w; w.x = pk2(a.x, a.y); w.y = pk2(a.z, a.w); w.z = pk2(b.x, b.y); w.w = pk2(b.z, b.w); *(u32x4*)(O + (size_t)row * ldo + col) = w; }
  __device__ __forceinline__ void store(int row, int col, f32x4 v) const { u32x2 w; w.x = pk2(v.x, v.y); w.y = pk2(v.z, v.w); *(u32x2*)(O + (size_t)row * ldo + col) = w; } };
struct EpiQKV { bf16_t* O;
  __device__ __forceinline__ void store8(int row, int col, f32x4 a, f32x4 b) const { const float sc = (col < 512 || (col >= 1536 && col < 2048)) ? 0.18033688011112042f : 1.f;
    u32x4 w; w.x = pk2(a.x * sc, a.y * sc); w.y = pk2(a.z * sc, a.w * sc); w.z = pk2(b.x * sc, b.y * sc); w.w = pk2(b.z * sc, b.w * sc); *(u32x4*)(O + (size_t)row * NQKV + col) = w; }
  __device__ __forceinline__ void store(int row, int col, f32x4 v) const { const float sc = (col < 512 || (col >= 1536 && col < 2048)) ? 0.18033688011112042f : 1.f;
    u32x2 w; w.x = pk2(v.x * sc, v.y * sc); w.y = pk2(v.z * sc, v.w * sc); *(u32x2*)(O + (size_t)row * NQKV + col) = w; } };
struct EpiBf16S { bf16_t* O; int ldo; const float* ss;
  __device__ __forceinline__ void store8(int row, int col, f32x4 a, f32x4 b) const { const float r = rsqrtf(ss[row] * (1.f / DM) + EPS);
    u32x4 w; w.x = pk2(a.x * r, a.y * r); w.y = pk2(a.z * r, a.w * r); w.z = pk2(b.x * r, b.y * r); w.w = pk2(b.z * r, b.w * r); *(u32x4*)(O + (size_t)row * ldo + col) = w; }
  __device__ __forceinline__ void store(int row, int col, f32x4 v) const { const float r = rsqrtf(ss[row] * (1.f / DM) + EPS); u32x2 w; w.x = pk2(v.x * r, v.y * r); w.y = pk2(v.z * r, v.w * r); *(u32x2*)(O + (size_t)row * ldo + col) = w; } };
struct EpiF32S { float* O; int ldo; const float* ss;
  __device__ __forceinline__ void store(int row, int col, f32x4 v) const { const float r = rsqrtf(ss[row] * (1.f / DM) + EPS); *(f32x4*)(O + (size_t)row * ldo + col) = v * r; } };
struct EpiF32 { float* O; int ldo;
  __device__ __forceinline__ void store(int row, int col, f32x4 v) const { *(f32x4*)(O + (size_t)row * ldo + col) = v; } };
struct EpiResid { const float* base; float* out;
  __device__ __forceinline__ void store(int row, int col, f32x4 v) const { const size_t o = (size_t)row * DM + col; const f32x4 b = *(const f32x4*)(base + o); *(f32x4*)(out + o) = b + v; } };
struct EpiKV { bf16_t* KX; bf16_t* VXT;
  __device__ __forceinline__ void store(int row, int col, f32x4 v) const {
    if (col < 1024) { u32x2 w; w.x = pk2(v.x, v.y); w.y = pk2(v.z, v.w); *(u32x2*)(KX + (size_t)row * DM + col) = w; }
    else { const int b = row >> 8, m = row & 255;
#pragma unroll
      for (int r = 0; r < 4; ++r) { const int d = col - 1024 + r; VXT[((size_t)(b * 4 + (d >> 8)) * 256 + (d & 255)) * 256 + m] = (bf16_t)f2bf(v[r]); } } } };

__device__ __forceinline__ void phase_scan(const Args& a, int gw, int ngw, int lane, int tid) {
  unsigned char* ws = a.ws;
  const float* flog = (const float*)(ws + WS_FLOG); float* cum = (float*)(ws + WS_CUM);
  for (int p = gw; p < 64; p += ngw) {
    const int b = p >> 3, j = p & 7;
    const float* src = flog + ((size_t)b * SEQ + lane * 64) * 8 + j;
    float tot = 0.f;
    for (int i = 0; i < 64; ++i) tot += src[i * 8];
    float inc = tot;
#pragma unroll
    for (int o = 1; o < 64; o <<= 1) { const float t = __shfl_up(inc, o); if (lane >= o) inc += t; }
    float run = inc - tot;
    float* dst = cum + ((size_t)(b * 8 + j)) * SEQ + lane * 64;
    for (int i = 0; i < 64; ++i) { run += src[i * 8]; dst[i] = run * 1.4426950408889634f; }
  }
  const bf16_t* qkv = (const bf16_t*)(ws + WS_QKV); float* kmean = (float*)(ws + WS_KMEAN);
  {
    unsigned* kn2 = (unsigned*)(ws + 256);
    for (int item = gw; item < 64 * 16; item += ngw) {
      const int bh = item >> 4, ch = item & 15, b = bh >> 3, h = bh & 7; float m = 0.f;
      for (int rr = 0; rr < 4; ++rr) {
        const u32x4* kp = (const u32x4*)(qkv + ((size_t)b * SEQ + ch * 256 + lane * 4 + rr) * NQKV + 2048 + h * 64); float s = 0.f;
#pragma unroll
        for (int c = 0; c < 8; ++c) { float f[8]; unpack8(kp[c], f);
#pragma unroll
          for (int i = 0; i < 8; ++i) s += f[i] * f[i]; }
        m = fmaxf(m, s);
      }
#pragma unroll
      for (int o = 1; o < 64; o <<= 1) m = fmaxf(m, __shfl_xor(m, o));
      if (lane == 0) atomicMax(kn2 + bh, __float_as_uint(m));
    }
  }
  const int gt = blockIdx.x * 512 + tid, ngt = gridDim.x * 512;
  for (int o = gt; o < NB * 16 * 512; o += ngt) {
    const int c = o & 511, blk = (o >> 9) & 15, b = o >> 13;
    const bf16_t* p = qkv + ((size_t)b * SEQ + blk * 256) * NQKV + 512 + c;
    float s = 0.f;
    for (int r = 0; r < 256; ++r) s += bf2f(p[(size_t)r * NQKV]);
    kmean[o] = s * (1.f / 256.f);
  }
}

template <int MODE>
__device__ __forceinline__ void attn_naive_unit(const Args& a, unsigned char* lds, int b, int h, int sb, int tid) {
  unsigned char* ws = a.ws;
  const bf16_t* qkv = (const bf16_t*)(ws + WS_QKV);
  const int qoff = MODE ? 1536 : 0, koff = qoff + 512, voff = qoff + 1024;
  float* Ks = (float*)lds; float* Vs = Ks + 64 * 64; float* ck = Vs + 64 * 64; float* biasd = ck + 64;
  const int t = sb * 512 + tid; const size_t row = (size_t)b * SEQ + t;
  float q[64], o[64];
  {
    const u32x4* qp = (const u32x4*)(qkv + row * NQKV + qoff + h * 64);
#pragma unroll
    for (int c = 0; c < 8; ++c) { const u32x4 w = qp[c]; unpack8(w, q + 8 * c); }
#pragma unroll
    for (int d = 0; d < 64; ++d) { q[d] *= 0.6931471805599453f; o[d] = 0.f; }
  }
  float m = -1e30f, l = 0.f;
  unsigned selmask = 0u; const int own = t >> 8;
  float cq = 0.f, bfar = 0.f;
  __syncthreads();
  if (MODE == 0) {
    if (tid < 128) biasd[tid] = a.in[5][T5_BUCKET[tid] * 8 + h];
    bfar = a.in[5][31 * 8 + h];
    const float* km = (const float*)(ws + WS_KMEAN) + ((size_t)b * 16) * 512 + h * 64;
    float v0 = -3e38f, v1 = -3e38f, v2 = -3e38f; int i0 = -1, i1 = -1, i2 = -1;
    for (int n = 0; n < 2 * sb + 1; ++n) {
      if (n < own) {
        const float* kp = km + (size_t)n * 512; float s = 0.f;
#pragma unroll
        for (int d = 0; d < 64; ++d) s += q[d] * kp[d];
        if (s > v0) { v2 = v1; i2 = i1; v1 = v0; i1 = i0; v0 = s; i0 = n; }
        else if (s > v1) { v2 = v1; i2 = i1; v1 = s; i1 = n; }
        else if (s > v2) { v2 = s; i2 = n; }
      }
    }
    if (i0 >= 0) selmask |= 1u << i0;
    if (i1 >= 0) selmask |= 1u << i1;
    if (i2 >= 0) selmask |= 1u << i2;
  } else {
    cq = ((const float*)(ws + WS_CUM))[((size_t)(b * 8 + h)) * SEQ + t];
  }
  const int ntile = 8 * (sb + 1);
  for (int kt = 0; kt < ntile; ++kt) {
    __syncthreads();
    {
      const int r = tid >> 3, ch = tid & 7;
      const bf16_t* kp = qkv + ((size_t)b * SEQ + kt * 64 + r) * NQKV + h * 64 + ch * 8;
      const u32x4 kw = *(const u32x4*)(kp + koff), vw = *(const u32x4*)(kp + voff);
      unpack8(kw, Ks + r * 64 + ch * 8); unpack8(vw, Vs + r * 64 + ch * 8);
      if (MODE == 1 && tid < 64) ck[tid] = ((const float*)(ws + WS_CUM))[((size_t)(b * 8 + h)) * SEQ + kt * 64 + tid];
    }
    __syncthreads();
    const int kb = kt >> 2;
    bool act;
    if (MODE == 0) act = (kb == own) || (kb < own && ((selmask >> kb) & 1u));
    else act = (kt * 64 <= t);
    if (act) {
      for (int jj = 0; jj < 64; ++jj) {
        const int sp = kt * 64 + jj;
        if (sp > t) break;
        const f32x4* kr = (const f32x4*)(Ks + jj * 64);
        float s = 0.f;
#pragma unroll
        for (int c = 0; c < 16; ++c) { const f32x4 kv = kr[c]; s += q[4 * c] * kv.x + q[4 * c + 1] * kv.y + q[4 * c + 2] * kv.z + q[4 * c + 3] * kv.w; }
        if (MODE == 0) { const int dist = t - sp; s += (dist < 128) ? biasd[dist] : bfar; }
        else s += (cq - ck[jj]) * 0.6931471805599453f;
        if (s > m) { const float f = __expf(m - s); l *= f;
#pragma unroll
          for (int d = 0; d < 64; ++d) o[d] *= f;
          m = s; }
        const float p = __expf(s - m); l += p;
        const f32x4* vr = (const f32x4*)(Vs + jj * 64);
#pragma unroll
        for (int c = 0; c < 16; ++c) { const f32x4 vv = vr[c]; o[4 * c] += p * vv.x; o[4 * c + 1] += p * vv.y; o[4 * c + 2] += p * vv.z; o[4 * c + 3] += p * vv.w; }
      }
    }
  }
  const float il = 1.f / l;
  u32x4* op = (u32x4*)((bf16_t*)(ws + WS_OAB) + row * DM + (MODE ? 512 : 0) + h * 64);
#pragma unroll
  for (int c = 0; c < 8; ++c) { u32x4 w; w.x = pk2(o[8 * c] * il, o[8 * c + 1] * il); w.y = pk2(o[8 * c + 2] * il, o[8 * c + 3] * il); w.z = pk2(o[8 * c + 4] * il, o[8 * c + 5] * il); w.w = pk2(o[8 * c + 6] * il, o[8 * c + 7] * il); op[c] = w; }
}

__device__ __forceinline__ void phase_attn(const Args& a, unsigned char* lds, int tid) {
  for (int u = blockIdx.x; u < 1024; u += gridDim.x) {
    const int sb = 7 - (u >> 7), r = u & 127, mode = r & 1, bh = r >> 1;
    if (mode == 0) attn_naive_unit<0>(a, lds, bh >> 3, bh & 7, sb, tid);
    else attn_naive_unit<1>(a, lds, bh >> 3, bh & 7, sb, tid);
  }
}

namespace att {
typedef float f32x16 __attribute__((ext_vector_type(16)));
typedef short s16x4 __attribute__((ext_vector_type(4)));
typedef short v4i16_t __attribute__((ext_vector_type(4)));
typedef __attribute__((address_space(3))) const char* lds_cptr;
typedef float f32x2_t __attribute__((ext_vector_type(2))); typedef __bf16 bf16x2_t __attribute__((ext_vector_type(2)));
constexpr int PITCH = NQKV;
constexpr float LOG2E = 1.4426950408889634f;
constexpr float C2 = 0.125f * LOG2E;
constexpr int L_K = 0, L_V = 16384, L_WSF = 32768, L_OST = 34816, L_C2 = 67584, L_KM = 83968, L_BT = 88064, L_MISC = 88704;
__device__ __forceinline__ int crow(int r, int hi) { return (r & 3) + 8 * (r >> 2) + 4 * hi; }
__device__ __forceinline__ unsigned cvtpk(float lo, float hi) { f32x2_t v = {lo, hi}; bf16x2_t b = __builtin_convertvector(v, bf16x2_t); return __builtin_bit_cast(unsigned, b); }
__device__ __forceinline__ s16x4 vtr(lds_cptr p) { return __builtin_bit_cast(s16x4, __builtin_amdgcn_ds_read_tr16_b64_v4i16((__attribute__((address_space(3))) v4i16_t*)p)); }
__device__ __forceinline__ float xhalf_max(float m) { auto rr = __builtin_amdgcn_permlane32_swap(__float_as_uint(m), __float_as_uint(m), false, false); return fmaxf(__uint_as_float(rr[0]), __uint_as_float(rr[1])); }
__device__ __forceinline__ float xhalf_sum(float m) { auto rr = __builtin_amdgcn_permlane32_swap(__float_as_uint(m), __float_as_uint(m), false, false); return __uint_as_float(rr[0]) + __uint_as_float(rr[1]); }

template <int MODE>
__device__ __forceinline__ void unit(const Args& a, unsigned char* lds, int b, int h, int qb, int tid) {
  unsigned char* ws = a.ws;
  const int lane = tid & 63, r32 = lane & 31, hi = lane >> 5; const int wid = __builtin_amdgcn_readfirstlane(tid >> 6);
  const bf16_t* qkv = (const bf16_t*)(ws + WS_QKV);
  const int qoff = MODE ? 1536 : 0;
  const size_t rowbase = (size_t)b * SEQ; const int q0 = qb * 256;
  const bf16_t* Qw = qkv + (rowbase + q0 + wid * 32) * PITCH + qoff + h * 64;
  const bf16_t* Kh = qkv + rowbase * PITCH + qoff + 512 + h * 64;
  const bf16_t* Vh = qkv + rowbase * PITCH + qoff + 1024 + h * 64;
  float* wsf = (float*)(lds + L_WSF) + wid * 64;
  float* c2s = (float*)(lds + L_C2); float* kms = (float*)(lds + L_KM); float* bts = (float*)(lds + L_BT); unsigned* misc = (unsigned*)(lds + L_MISC);
  const int NTL = 4 * (qb + 1);
  __syncthreads();
  if (MODE == 0) {
    const float* km = (const float*)(ws + WS_KMEAN) + (size_t)b * 16 * 512 + h * 64;
    for (int i = tid; i < 16 * 64; i += 512) kms[i] = km[(size_t)(i >> 6) * 512 + (i & 63)];
    if (tid < 128) bts[tid] = a.in[5][T5_BUCKET[tid] * 8 + h] * LOG2E;
    if (tid == 128) bts[128] = a.in[5][31 * 8 + h] * LOG2E;
  } else {
    const float* cg = (const float*)(ws + WS_CUM) + (size_t)(b * 8 + h) * SEQ;
    for (int i = tid; i < 256 * (qb + 1); i += 512) c2s[i] = cg[i];
    if (tid == 0) misc[0] = 0u;
  }
  bf16x8 qr[4];
#pragma unroll
  for (int d0 = 0; d0 < 4; ++d0) qr[d0] = *(const bf16x8*)(Qw + (size_t)r32 * PITCH + d0 * 16 + hi * 8);
  __syncthreads();
  unsigned selmask = 0u; float cq2 = 0.f, far2 = 0.f, mhat = -1e30f; int t0 = 0;
  if (MODE == 0) {
    far2 = bts[128];
    float v0 = -3e38f, v1 = -3e38f, v2 = -3e38f; int i0 = -1, i1 = -1, i2 = -1;
    for (int n = 0; n < qb; ++n) {
      float s = 0.f;
#pragma unroll
      for (int d0 = 0; d0 < 4; ++d0)
#pragma unroll
        for (int j = 0; j < 8; ++j) s += bf2f((unsigned short)qr[d0][j]) * kms[n * 64 + d0 * 16 + hi * 8 + j];
      s = xhalf_sum(s);
      if (s > v0) { v2 = v1; i2 = i1; v1 = v0; i1 = i0; v0 = s; i0 = n; }
      else if (s > v1) { v2 = v1; i2 = i1; v1 = s; i1 = n; }
      else if (s > v2) { v2 = s; i2 = n; }
    }
    if (i0 >= 0) selmask |= 1u << i0;
    if (i1 >= 0) selmask |= 1u << i1;
    if (i2 >= 0) selmask |= 1u << i2;
  } else {
    cq2 = c2s[q0 + wid * 32 + r32];
    float s = 0.f;
#pragma unroll
    for (int d0 = 0; d0 < 4; ++d0)
#pragma unroll
      for (int j = 0; j < 8; ++j) { const float f = bf2f((unsigned short)qr[d0][j]); s += f * f; }
    s = xhalf_sum(s);
    atomicMax(&misc[0], __float_as_uint(s));
    __syncthreads();
    const float kn2 = __uint_as_float(((const unsigned*)(ws + 256))[b * 8 + h]);
    const float qkb = sqrtf(__uint_as_float(misc[0]) * kn2) * 1.0001f + 1e-3f;
    mhat = -qkb;
    const int j = lane; bool skip = false;
    if (j < NTL) skip = (2.f * qkb + c2s[q0] - c2s[64 * j + 63]) < -150.f;
    t0 = __popcll(__ballot(skip));
    if (t0 > NTL - 1) t0 = NTL - 1;
  }
  const bf16_t* ksrc = Kh + (size_t)lane * PITCH + wid * 8;
  const bf16_t* vsrc = Vh + (size_t)(16 * (wid & 3) + (lane >> 2)) * PITCH + (wid >> 2) * 32 + (lane & 3) * 8;
  unsigned char* kdst = lds + L_K + wid * 1024 + lane * 16; unsigned char* vdst = lds + L_V + wid * 1024 + lane * 16;
  const lds_cptr lds3 = (lds_cptr)lds;
  const lds_cptr vp0 = lds3 + L_V + ((lane >> 4) & 1) * 32 + (lane & 3) * 8 + (4 * hi + ((lane & 15) >> 2)) * 64;
  u32x4 kreg = *(const u32x4*)(ksrc + (size_t)t0 * 64 * PITCH), vreg = *(const u32x4*)(vsrc + (size_t)t0 * 64 * PITCH);
  *(u32x4*)(kdst + (t0 & 1) * 8192) = kreg; *(u32x4*)(vdst + (t0 & 1) * 8192) = vreg;
  f32x16 o[2]; o[0] = f32x16{}; o[1] = f32x16{};
  float l = 0.f;
  const int qrel = wid * 32 + r32, qpos = q0 + qrel;
  __syncthreads();
  for (int t = t0; t < NTL; ++t) {
    const int buf = (t & 1) * 8192;
    if (t + 1 < NTL) { kreg = *(const u32x4*)(ksrc + (size_t)(t + 1) * 64 * PITCH); vreg = *(const u32x4*)(vsrc + (size_t)(t + 1) * 64 * PITCH); }
    const int jb = t - (NTL - 4);
    const bool compute = !(jb >= 0 && 64 * jb > wid * 32 + 31);
    if (compute) {
      f32x16 p0, p1;
      if (MODE == 0) {
        const int nb = t >> 2;
        const bool near = (jb >= 0) || (t >= NTL - 6 && wid < 4);
        if (near) {
#pragma unroll
          for (int r = 0; r < 16; ++r) { const int d = qpos - (64 * t + crow(r, hi));
            p0[r] = bts[min(max(d, 0), 128)]; p1[r] = bts[min(max(d - 32, 0), 128)]; }
        } else {
#pragma unroll
          for (int r = 0; r < 16; ++r) { p0[r] = far2; p1[r] = far2; }
        }
        if (jb < 0 && !((selmask >> nb) & 1u)) {
#pragma unroll
          for (int r = 0; r < 16; ++r) { p0[r] = -INFINITY; p1[r] = -INFINITY; }
        }
      } else {
#pragma unroll
        for (int g = 0; g < 4; ++g) {
          const f32x4 ca = *(const f32x4*)(c2s + 64 * t + 8 * g + 4 * hi), cb = *(const f32x4*)(c2s + 64 * t + 32 + 8 * g + 4 * hi);
#pragma unroll
          for (int i = 0; i < 4; ++i) { p0[4 * g + i] = cq2 - ca[i]; p1[4 * g + i] = cq2 - cb[i]; }
        }
      }
      {
        const lds_cptr kb = lds3 + L_K + buf + hi * 1024 + r32 * 16;
#pragma unroll
        for (int d0 = 0; d0 < 4; ++d0) {
          const bf16x8 b0 = *(const __attribute__((address_space(3))) bf16x8*)(kb + d0 * 2048);
          const bf16x8 b1 = *(const __attribute__((address_space(3))) bf16x8*)(kb + d0 * 2048 + 512);
          p0 = __builtin_amdgcn_mfma_f32_32x32x16_bf16(b0, qr[d0], p0, 0, 0, 0);
          p1 = __builtin_amdgcn_mfma_f32_32x32x16_bf16(b1, qr[d0], p1, 0, 0, 0);
        }
      }
      if (jb >= 0) {
        const int kb0 = 64 * jb + 4 * hi;
#pragma unroll
        for (int r = 0; r < 16; ++r) { const int kv = kb0 + (r & 3) + 8 * (r >> 2); if (kv > qrel) p0[r] = -INFINITY; if (kv + 32 > qrel) p1[r] = -INFINITY; }
      }
      float rm = fmaxf(p0[0], p1[0]);
#pragma unroll
      for (int r = 1; r < 16; ++r) rm = fmaxf(rm, fmaxf(p0[r], p1[r]));
      rm = xhalf_max(rm);
      const float mnew = fmaxf(mhat, rm);
      if (__any(mnew > mhat)) {
        const float alpha = __builtin_amdgcn_exp2f(mhat - mnew);
        l *= alpha; mhat = mnew;
        if (hi == 0) wsf[r32] = alpha;
        __builtin_amdgcn_wave_barrier();
#pragma unroll
        for (int r = 0; r < 16; ++r) { const float f = wsf[crow(r, hi)]; o[0][r] *= f; o[1][r] *= f; }
        __builtin_amdgcn_wave_barrier();
      }
      float sacc = 0.f;
#pragma unroll
      for (int r = 0; r < 16; ++r) { p0[r] = __builtin_amdgcn_exp2f(p0[r] - mhat); p1[r] = __builtin_amdgcn_exp2f(p1[r] - mhat); sacc += p0[r] + p1[r]; }
      l += sacc;
      u32x4 pw0, pw1, pw2, pw3;
      pw0 = (u32x4){cvtpk(p0[0], p0[1]), cvtpk(p0[2], p0[3]), cvtpk(p0[4], p0[5]), cvtpk(p0[6], p0[7])};
      pw1 = (u32x4){cvtpk(p0[8], p0[9]), cvtpk(p0[10], p0[11]), cvtpk(p0[12], p0[13]), cvtpk(p0[14], p0[15])};
      pw2 = (u32x4){cvtpk(p1[0], p1[1]), cvtpk(p1[2], p1[3]), cvtpk(p1[4], p1[5]), cvtpk(p1[6], p1[7])};
      pw3 = (u32x4){cvtpk(p1[8], p1[9]), cvtpk(p1[10], p1[11]), cvtpk(p1[12], p1[13]), cvtpk(p1[14], p1[15])};
      const lds_cptr vp = vp0 + buf;
#pragma unroll
      for (int d0 = 0; d0 < 2; ++d0) {
#define ATT_VF(ks) ({ const s16x4 lo_ = vtr(vp + d0 * 4096 + (ks) * 1024), hi_ = vtr(vp + d0 * 4096 + (ks) * 1024 + 512); (bf16x8){lo_[0], lo_[1], lo_[2], lo_[3], hi_[0], hi_[1], hi_[2], hi_[3]}; })
        o[d0] = __builtin_amdgcn_mfma_f32_32x32x16_bf16(__builtin_bit_cast(bf16x8, pw0), ATT_VF(0), o[d0], 0, 0, 0);
        o[d0] = __builtin_amdgcn_mfma_f32_32x32x16_bf16(__builtin_bit_cast(bf16x8, pw1), ATT_VF(1), o[d0], 0, 0, 0);
        o[d0] = __builtin_amdgcn_mfma_f32_32x32x16_bf16(__builtin_bit_cast(bf16x8, pw2), ATT_VF(2), o[d0], 0, 0, 0);
        o[d0] = __builtin_amdgcn_mfma_f32_32x32x16_bf16(__builtin_bit_cast(bf16x8, pw3), ATT_VF(3), o[d0], 0, 0, 0);
#undef ATT_VF
      }
    }
    if (t + 1 < NTL) { *(u32x4*)(kdst + ((t + 1) & 1) * 8192) = kreg; *(u32x4*)(vdst + ((t + 1) & 1) * 8192) = vreg; }
    __syncthreads();
  }
  l = xhalf_sum(l);
  if (hi == 0) wsf[32 + r32] = l;
  __builtin_amdgcn_wave_barrier();
  bf16_t* stg = (bf16_t*)(lds + L_OST) + wid * 2048;
#pragma unroll
  for (int r = 0; r < 16; ++r) { const int orow = crow(r, hi); const float rl = 1.f / wsf[32 + orow];
    stg[orow * 64 + r32] = (bf16_t)f2bf(o[0][r] * rl); stg[orow * 64 + 32 + r32] = (bf16_t)f2bf(o[1][r] * rl); }
  __builtin_amdgcn_wave_barrier();
  bf16_t* Ow = (bf16_t*)(ws + WS_OAB) + (rowbase + q0 + wid * 32) * DM + (MODE ? 512 : 0) + h * 64;
#pragma unroll
  for (int i = 0; i < 4; ++i) { const int row = i * 8 + (lane >> 3), ch = lane & 7; const u32x4 v = *(const u32x4*)(stg + row * 64 + ch * 8); *(u32x4*)(Ow + (size_t)row * DM + ch * 8) = v; }
}
}

__device__ __forceinline__ void phase_attn2(const Args& a, unsigned char* lds, int tid) {
  unsigned* ctr = (unsigned*)(a.ws + 0);
  unsigned* slot = (unsigned*)(lds + att::L_MISC + 64);
  for (;;) {
    __syncthreads();
    if (tid == 0) slot[0] = atomicAdd(ctr, 1u);
    __syncthreads();
    const unsigned u = slot[0];
    if (u >= 2048u) break;
    const int qb = 15 - (int)(u >> 7), r = u & 127, mode = r & 1, bh = r >> 1;
    if (mode == 0) att::unit<0>(a, lds, bh >> 3, bh & 7, qb, tid);
    else att::unit<1>(a, lds, bh >> 3, bh & 7, qb, tid);
  }
}

__device__ __forceinline__ void phase_onorm(const Args& a, int gw, int ngw, int lane) {
  bf16_t* oab = (bf16_t*)(a.ws + WS_OAB);
  for (int r = gw; r < NT; r += ngw) {
    u32x4* p = (u32x4*)(oab + (size_t)r * DM) + 2 * lane;
    const u32x4 w0 = p[0], w1 = p[1]; float f[16]; unpack8(w0, f); unpack8(w1, f + 8);
    float s = 0.f;
#pragma unroll
    for (int i = 0; i < 16; ++i) s += f[i] * f[i];
#pragma unroll
    for (int o = 1; o < 32; o <<= 1) s += __shfl_xor(s, o);
    const float rstd = rsqrtf(s * (1.f / 512.f) + EPS);
    u32x4 o0, o1;
    o0.x = pk2(f[0] * rstd, f[1] * rstd); o0.y = pk2(f[2] * rstd, f[3] * rstd); o0.z = pk2(f[4] * rstd, f[5] * rstd); o0.w = pk2(f[6] * rstd, f[7] * rstd);
    o1.x = pk2(f[8] * rstd, f[9] * rstd); o1.y = pk2(f[10] * rstd, f[11] * rstd); o1.z = pk2(f[12] * rstd, f[13] * rstd); o1.w = pk2(f[14] * rstd, f[15] * rstd);
    p[0] = o0; p[1] = o1;
  }
}

__device__ __forceinline__ void phase_rms(const Args& a, int gw, int ngw, int lane) {
  for (int r = gw; r < NT; r += ngw) rms_row_to_bf16(a.out + (size_t)r * DM, (bf16_t*)(a.ws + WS_HB) + (size_t)r * DM, lane);
}

__device__ __forceinline__ void phase_xattn(const Args& a, unsigned char* lds, int gw, int ngw, int wave, int lane) {
  unsigned char* ws = a.ws;
  const bf16_t* qx = (const bf16_t*)(ws + WS_QX); const bf16_t* kx = (const bf16_t*)(ws + WS_KX); const bf16_t* vxt = (const bf16_t*)(ws + WS_VXT);
  bf16_t* ox = (bf16_t*)(ws + WS_OX);
  bf16_t* P = (bf16_t*)(lds + wave * 8192);
  const int fr = lane & 15, fq = lane >> 4;
  for (int u = gw; u < (NT / 16) * 4; u += ngw) {
    const int hd = u & 3, r0 = (u >> 2) * 16, b = r0 / SEQ;
    f32x4 acc[16];
#pragma unroll
    for (int i = 0; i < 16; ++i) acc[i] = (f32x4){0.f, 0.f, 0.f, 0.f};
    const bf16_t* Ap = qx + (size_t)(r0 + fr) * DM + hd * 256 + fq * 8;
    const bf16_t* Bp = kx + (size_t)(b * 256 + fr) * DM + hd * 256 + fq * 8;
    for (int ks = 0; ks < 8; ++ks) {
      const bf16x8 af = *(const bf16x8*)(Ap + ks * 32);
#pragma unroll
      for (int ct = 0; ct < 16; ++ct) { const bf16x8 bfr = *(const bf16x8*)(Bp + (size_t)ct * 16 * DM + ks * 32); acc[ct] = __builtin_amdgcn_mfma_f32_16x16x32_bf16(af, bfr, acc[ct], 0, 0, 0); }
    }
    float mx[4], sm[4];
#pragma unroll
    for (int r = 0; r < 4; ++r) { float m = acc[0][r];
#pragma unroll
      for (int ct = 1; ct < 16; ++ct) m = fmaxf(m, acc[ct][r]);
#pragma unroll
      for (int o = 1; o < 16; o <<= 1) m = fmaxf(m, __shfl_xor(m, o));
      mx[r] = m; sm[r] = 0.f; }
#pragma unroll
    for (int ct = 0; ct < 16; ++ct)
#pragma unroll
      for (int r = 0; r < 4; ++r) { const float p = __expf((acc[ct][r] - mx[r]) * 0.0625f); acc[ct][r] = p; sm[r] += p; }
#pragma unroll
    for (int r = 0; r < 4; ++r) {
#pragma unroll
      for (int o = 1; o < 16; o <<= 1) sm[r] += __shfl_xor(sm[r], o);
      sm[r] = 1.f / sm[r]; }
    __builtin_amdgcn_wave_barrier();
#pragma unroll
    for (int ct = 0; ct < 16; ++ct)
#pragma unroll
      for (int r = 0; r < 4; ++r) P[(4 * fq + r) * 256 + ct * 16 + fr] = (bf16_t)f2bf(acc[ct][r] * sm[r]);
    __builtin_amdgcn_wave_barrier();
    asm volatile("s_waitcnt lgkmcnt(0)" ::: "memory");
#pragma unroll
    for (int i = 0; i < 16; ++i) acc[i] = (f32x4){0.f, 0.f, 0.f, 0.f};
    const bf16_t* Vp = vxt + ((size_t)(b * 4 + hd) * 256 + fr) * 256 + fq * 8;
    for (int ks = 0; ks < 8; ++ks) {
      const bf16x8 pf = *(const bf16x8*)(P + fr * 256 + ks * 32 + fq * 8);
#pragma unroll
      for (int dt = 0; dt < 16; ++dt) { const bf16x8 vf = *(const bf16x8*)(Vp + (size_t)dt * 16 * 256 + ks * 32); acc[dt] = __builtin_amdgcn_mfma_f32_16x16x32_bf16(pf, vf, acc[dt], 0, 0, 0); }
    }
#pragma unroll
    for (int dt = 0; dt < 16; ++dt)
#pragma unroll
      for (int r = 0; r < 4; ++r) ox[(size_t)(r0 + 4 * fq + r) * DM + hd * 256 + dt * 16 + fr] = (bf16_t)f2bf(acc[dt][r]);
    __builtin_amdgcn_wave_barrier();
  }
}

namespace xa {
using att::f32x16; using att::s16x4; using att::lds_cptr; using att::crow; using att::cvtpk; using att::vtr; using att::xhalf_max; using att::xhalf_sum;
constexpr int L_WSF = 65536;
__device__ __forceinline__ void unit(const Args& a, unsigned char* lds, int b, int hd, int qb, int tid) {
  unsigned char* ws = a.ws;
  const int lane = tid & 63, r32 = lane & 31, hi = lane >> 5; const int wid = __builtin_amdgcn_readfirstlane(tid >> 6);
  const bf16_t* qrow = (const bf16_t*)(ws + WS_QX) + ((size_t)b * SEQ + qb * 256 + wid * 32 + r32) * DM + hd * 256;
  const bf16_t* kvb = (const bf16_t*)(ws + WS_KX) + (size_t)b * 256 * 2048 + hd * 256;
  const bf16_t* ksrc = kvb + (size_t)lane * 2048 + wid * 8;
  const bf16_t* vsrc = kvb + 1024 + (size_t)(16 * (wid & 3) + (lane >> 2)) * 2048 + (wid >> 2) * 32 + (lane & 3) * 8;
  unsigned char* sdst = lds + wid * 1024 + lane * 16;
  const lds_cptr lds3 = (lds_cptr)lds;
  const lds_cptr kp0 = lds3 + hi * 1024 + r32 * 16;
  const lds_cptr vp0 = lds3 + ((lane >> 4) & 1) * 32 + (lane & 3) * 8 + (4 * hi + ((lane & 15) >> 2)) * 64;
  float* wsf = (float*)(lds + L_WSF) + wid * 64;
  u32x4 sreg[4];
#define XA_LOADK(c) do { _Pragma("unroll") for (int kt = 0; kt < 4; ++kt) sreg[kt] = *(const u32x4*)(ksrc + (size_t)kt * 64 * 2048 + (c) * 64); } while (0)
#define XA_LOADV(vt) do { _Pragma("unroll") for (int dq = 0; dq < 4; ++dq) sreg[dq] = *(const u32x4*)(vsrc + (size_t)(vt) * 64 * 2048 + dq * 64); } while (0)
#define XA_WRITE(buf) do { _Pragma("unroll") for (int i = 0; i < 4; ++i) *(u32x4*)(sdst + (buf) * 32768 + i * 8192) = sreg[i]; } while (0)
  __syncthreads();
  XA_LOADK(0); XA_WRITE(0);
  f32x16 acc[8];
#pragma unroll
  for (int j = 0; j < 8; ++j) acc[j] = f32x16{};
  __syncthreads();
#pragma unroll
  for (int c = 0; c < 4; ++c) {
    if (c < 3) XA_LOADK(c + 1); else XA_LOADV(0);
    bf16x8 qf[4];
#pragma unroll
    for (int d0 = 0; d0 < 4; ++d0) qf[d0] = *(const bf16x8*)(qrow + c * 64 + d0 * 16 + hi * 8);
    const lds_cptr kp = kp0 + (c & 1) * 32768;
#pragma unroll
    for (int d0 = 0; d0 < 4; ++d0)
#pragma unroll
      for (int j = 0; j < 8; ++j) {
        const bf16x8 kf = *(const __attribute__((address_space(3))) bf16x8*)(kp + (j >> 1) * 8192 + d0 * 2048 + (j & 1) * 512);
        acc[j] = __builtin_amdgcn_mfma_f32_32x32x16_bf16(kf, qf[d0], acc[j], 0, 0, 0);
      }
    XA_WRITE((c + 1) & 1);
    __syncthreads();
  }
  float m = acc[0][0];
#pragma unroll
  for (int j = 0; j < 8; ++j)
#pragma unroll
    for (int r = 0; r < 16; ++r) m = fmaxf(m, acc[j][r]);
  m = xhalf_max(m);
  constexpr float CS = 1.4426950408889634f / 16.f;
  float l = 0.f; u32x4 pw[16];
#pragma unroll
  for (int j = 0; j < 8; ++j) {
#pragma unroll
    for (int r = 0; r < 16; ++r) { const float p = __builtin_amdgcn_exp2f((acc[j][r] - m) * CS); acc[j][r] = p; l += p; }
    pw[2 * j] = (u32x4){cvtpk(acc[j][0], acc[j][1]), cvtpk(acc[j][2], acc[j][3]), cvtpk(acc[j][4], acc[j][5]), cvtpk(acc[j][6], acc[j][7])};
    pw[2 * j + 1] = (u32x4){cvtpk(acc[j][8], acc[j][9]), cvtpk(acc[j][10], acc[j][11]), cvtpk(acc[j][12], acc[j][13]), cvtpk(acc[j][14], acc[j][15])};
  }
  l = xhalf_sum(l);
#pragma unroll
  for (int j = 0; j < 8; ++j) acc[j] = f32x16{};
#pragma unroll
  for (int vt = 0; vt < 4; ++vt) {
    if (vt < 3) XA_LOADV(vt + 1);
    const lds_cptr vp = vp0 + (vt & 1) * 32768;
#pragma unroll
    for (int ks = 0; ks < 4; ++ks)
#pragma unroll
      for (int db = 0; db < 8; ++db) {
        const s16x4 lo_ = vtr(vp + (db >> 1) * 8192 + (db & 1) * 4096 + ks * 1024), hi_ = vtr(vp + (db >> 1) * 8192 + (db & 1) * 4096 + ks * 1024 + 512);
        const bf16x8 vf = (bf16x8){lo_[0], lo_[1], lo_[2], lo_[3], hi_[0], hi_[1], hi_[2], hi_[3]};
        acc[db] = __builtin_amdgcn_mfma_f32_32x32x16_bf16(__builtin_bit_cast(bf16x8, pw[4 * vt + ks]), vf, acc[db], 0, 0, 0);
      }
    if (vt < 3) XA_WRITE((vt + 1) & 1);
    __syncthreads();
  }
  if (hi == 0) wsf[r32] = l;
  __builtin_amdgcn_wave_barrier();
  float rl[16];
#pragma unroll
  for (int r = 0; r < 16; ++r) rl[r] = 1.f / wsf[crow(r, hi)];
  bf16_t* stg = (bf16_t*)(lds + wid * 8192);
  bf16_t* orow0 = (bf16_t*)(ws + WS_OX) + ((size_t)b * SEQ + qb * 256 + wid * 32) * DM + hd * 256;
#pragma unroll
  for (int hf = 0; hf < 2; ++hf) {
#pragma unroll
    for (int db = 0; db < 4; ++db)
#pragma unroll
      for (int r = 0; r < 16; ++r) stg[crow(r, hi) * 128 + db * 32 + r32] = (bf16_t)f2bf(acc[hf * 4 + db][r] * rl[r]);
    __builtin_amdgcn_wave_barrier();
#pragma unroll
    for (int i = 0; i < 8; ++i) { const int row = i * 4 + (lane >> 4), ch = lane & 15; const u32x4 v = *(const u32x4*)(stg + row * 128 + ch * 8); *(u32x4*)(orow0 + (size_t)row * DM + hf * 128 + ch * 8) = v; }
    __builtin_amdgcn_wave_barrier();
  }
#undef XA_LOADK
#undef XA_LOADV
#undef XA_WRITE
}
}

__device__ __forceinline__ void phase_xattn2(const Args& a, unsigned char* lds, int tid) {
  for (int u = blockIdx.x; u < NB * 4 * 16; u += gridDim.x) { const int qb = u & 15, hd = (u >> 4) & 3, b = u >> 6; xa::unit(a, lds, b, hd, qb, tid); }
}

__device__ __forceinline__ unsigned fkey(float s, unsigned idx, unsigned mask) { unsigned u = __float_as_uint(s); u ^= (unsigned)((int)u >> 31) | 0x80000000u; return (u & ~mask) | (mask - idx); }
__device__ __forceinline__ float keyval(unsigned k, unsigned mask) { unsigned u = k & ~mask; u = (u & 0x80000000u) ? (u ^ 0x80000000u) : ~u; return __uint_as_float(u); }
#define KEY_INSERT(KA, key_) do { unsigned k__ = (key_); \
  _Pragma("unroll") for (int s_ = 0; s_ < 16; ++s_) { const unsigned hi_ = max(k__, KA[s_]); k__ = min(k__, KA[s_]); KA[s_] = hi_; } } while (0)

__device__ __forceinline__ void phase_topk(const Args& a, unsigned char* lds, int tid) {
  unsigned char* ws = a.ws;
  const float* pq = (const float*)(ws + WS_PQ);
  int* eidx = (int*)(ws + WS_EIDX); float* gate = (float*)(ws + WS_GATE);
  float* K1 = (float*)lds; float* K2 = K1 + 128 * 64; unsigned* KL = (unsigned*)(lds + 65536);
  for (int u = blockIdx.x; u < 8 * (NT / 512); u += gridDim.x) {
    const int h = u & 7, t = (u >> 3) * 512 + tid;
    __syncthreads();
    for (int i = tid; i < 128 * 64 / 4; i += 512) { ((f32x4*)K1)[i] = ((const f32x4*)(a.in[17] + (size_t)h * 8192))[i]; ((f32x4*)K2)[i] = ((const f32x4*)(a.in[18] + (size_t)h * 8192))[i]; }
    __syncthreads();
    unsigned ka[16], kb[16], kc[16];
#pragma unroll
    for (int k = 0; k < 16; ++k) { ka[k] = 0u; kb[k] = 0u; kc[k] = 0u; }
    float q[64];
    const f32x4* qp = (const f32x4*)(pq + (size_t)t * DM + h * 128);
#pragma unroll
    for (int c = 0; c < 16; ++c) { const f32x4 w = qp[c]; q[4 * c] = w.x; q[4 * c + 1] = w.y; q[4 * c + 2] = w.z; q[4 * c + 3] = w.w; }
    for (int n = 0; n < 128; ++n) {
      const f32x4* kr = (const f32x4*)(K1 + n * 64); float s = 0.f;
#pragma unroll
      for (int c = 0; c < 16; ++c) { const f32x4 kv = kr[c]; s += q[4 * c] * kv.x + q[4 * c + 1] * kv.y + q[4 * c + 2] * kv.z + q[4 * c + 3] * kv.w; }
      KEY_INSERT(ka, fkey(s, (unsigned)n, 127u));
    }
#pragma unroll
    for (int c = 0; c < 16; ++c) { const f32x4 w = qp[16 + c]; q[4 * c] = w.x; q[4 * c + 1] = w.y; q[4 * c + 2] = w.z; q[4 * c + 3] = w.w; }
    for (int n = 0; n < 128; ++n) {
      const f32x4* kr = (const f32x4*)(K2 + n * 64); float s = 0.f;
#pragma unroll
      for (int c = 0; c < 16; ++c) { const f32x4 kv = kr[c]; s += q[4 * c] * kv.x + q[4 * c + 1] * kv.y + q[4 * c + 2] * kv.z + q[4 * c + 3] * kv.w; }
      KEY_INSERT(kb, fkey(s, (unsigned)n, 127u));
    }
#pragma unroll
    for (int x = 0; x < 16; ++x)
#pragma unroll
      for (int y = 0; y < 16; ++y)
        if ((x + 1) * (y + 1) <= 16) { KEY_INSERT(kc, fkey(keyval(ka[x], 127u) + keyval(kb[y], 127u), (unsigned)(x * 16 + y), 255u)); }
#pragma unroll
    for (int k = 0; k < 16; ++k) { KL[k * 512 + tid] = ka[k]; KL[(16 + k) * 512 + tid] = kb[k]; }
    float val[16]; int id[16]; float sum = 0.f;
#pragma unroll
    for (int k = 0; k < 16; ++k) {
      const unsigned flat = 255u - (kc[k] & 255u);
      const unsigned k1 = KL[(flat >> 4) * 512 + tid], k2 = KL[(16 + (flat & 15u)) * 512 + tid];
      val[k] = keyval(k1, 127u) + keyval(k2, 127u);
      id[k] = (int)((127u - (k1 & 127u)) * 128u + (127u - (k2 & 127u)));
    }
    const float vmax = val[0];
#pragma unroll
    for (int k = 0; k < 16; ++k) { val[k] = __expf(val[k] - vmax); sum += val[k]; }
    const float inv = 1.f / sum;
    int* ep = eidx + (size_t)t * 128 + h * 16; float* gp = gate + (size_t)t * 128 + h * 16;
#pragma unroll
    for (int k = 0; k < 16; ++k) { ep[k] = id[k]; gp[k] = val[k] * inv; }
  }
}


namespace tk {
typedef float f32x16 __attribute__((ext_vector_type(16)));
__device__ __forceinline__ void ce(unsigned& a, unsigned& b) { const unsigned h = max(a, b), l = min(a, b); a = h; b = l; }
__device__ __forceinline__ void sort16(unsigned (&v)[16]) {
#pragma unroll
  for (int k = 2; k <= 16; k <<= 1)
#pragma unroll
    for (int j = k >> 1; j > 0; j >>= 1)
#pragma unroll
      for (int i = 0; i < 16; ++i) { const int l = i ^ j; if (l > i) { if ((i & k) == 0) ce(v[i], v[l]); else ce(v[l], v[i]); } }
}
__device__ __forceinline__ void topmerge(unsigned (&a)[16], const unsigned (&b)[16]) {
#pragma unroll
  for (int i = 0; i < 16; ++i) a[i] = max(a[i], b[15 - i]);
#pragma unroll
  for (int j = 8; j > 0; j >>= 1)
#pragma unroll
    for (int i = 0; i < 16; ++i) { const int l = i ^ j; if (l > i) ce(a[i], a[l]); }
}
__device__ __forceinline__ unsigned xswap(unsigned v, int hi) { auto rr = __builtin_amdgcn_permlane32_swap(v, v, false, false); return hi ? rr[0] : rr[1]; }
__device__ __forceinline__ void half_list(unsigned (&L)[16], const bf16_t* skh, const bf16_t* qrow, int r32, int hi) {
  f32x16 acc[4];
#pragma unroll
  for (int i = 0; i < 4; ++i) acc[i] = f32x16{};
#pragma unroll
  for (int ks = 0; ks < 4; ++ks) {
    const bf16x8 qf = *(const bf16x8*)(qrow + ks * 16 + hi * 8);
#pragma unroll
    for (int tl = 0; tl < 4; ++tl) { const bf16x8 kf = *(const bf16x8*)(skh + (size_t)(tl * 32 + r32) * 64 + ks * 16 + hi * 8); acc[tl] = __builtin_amdgcn_mfma_f32_32x32x16_bf16(kf, qf, acc[tl], 0, 0, 0); }
  }
  unsigned g[4][16];
#pragma unroll
  for (int tl = 0; tl < 4; ++tl)
#pragma unroll
    for (int r = 0; r < 16; ++r) g[tl][r] = fkey(acc[tl][r], (unsigned)(32 * tl + (r & 3) + 8 * (r >> 2) + 4 * hi), 127u);
  sort16(g[0]); sort16(g[1]); sort16(g[2]); sort16(g[3]);
  topmerge(g[0], g[1]); topmerge(g[2], g[3]); topmerge(g[0], g[2]);
  unsigned p[16];
#pragma unroll
  for (int k = 0; k < 16; ++k) p[k] = xswap(g[0][k], hi);
  topmerge(g[0], p);
#pragma unroll
  for (int k = 0; k < 16; ++k) L[k] = g[0][k];
}
}

__device__ __forceinline__ void phase_topk2(const Args& a, unsigned char* lds, int wave, int lane) {
  unsigned char* ws = a.ws;
  const bf16_t* pq = (const bf16_t*)(ws + WS_PQ); const bf16_t* sk = (const bf16_t*)(ws + WS_SK);
  int* eidx = (int*)(ws + WS_EIDX); float* gate = (float*)(ws + WS_GATE);
  const int r32 = lane & 31, hi = lane >> 5, h = wave;
  unsigned* KL = (unsigned*)(lds + wave * 4096);
  for (int tt = blockIdx.x; tt < NT / 32; tt += gridDim.x) {
    const int t = tt * 32 + r32;
    unsigned ka[16], kb[16], kc[16];
    tk::half_list(ka, sk + (size_t)(0 * 8 + h) * 8192, pq + (size_t)t * DM + h * 128, r32, hi);
    tk::half_list(kb, sk + (size_t)(1 * 8 + h) * 8192, pq + (size_t)t * DM + h * 128 + 64, r32, hi);
    float va[16], vb[16];
#pragma unroll
    for (int k = 0; k < 16; ++k) { va[k] = keyval(ka[k], 127u); vb[k] = keyval(kb[k], 127u); }
#pragma unroll
    for (int y = 0; y < 16; ++y) kc[y] = hi ? 0u : fkey(va[0] + vb[y], (unsigned)y, 255u);
#define TK_CAND(xa, ya, xb, yb) do { const unsigned kA_ = fkey(va[xa] + vb[ya], (unsigned)((xa) * 16 + (ya)), 255u), kB_ = fkey(va[xb] + vb[yb], (unsigned)((xb) * 16 + (yb)), 255u); KEY_INSERT(kc, hi ? kB_ : kA_); } while (0)
    TK_CAND(1, 0, 1, 1);
    TK_CAND(1, 2, 1, 3);
    TK_CAND(1, 4, 1, 5);
    TK_CAND(1, 6, 1, 7);
    TK_CAND(2, 0, 2, 1);
    TK_CAND(2, 2, 2, 3);
    TK_CAND(2, 4, 3, 0);
    TK_CAND(3, 1, 3, 2);
    TK_CAND(3, 3, 4, 0);
    TK_CAND(4, 1, 4, 2);
    TK_CAND(5, 0, 5, 1);
    TK_CAND(6, 0, 6, 1);
    TK_CAND(7, 0, 7, 1);
    TK_CAND(8, 0, 9, 0);
    TK_CAND(10, 0, 11, 0);
    TK_CAND(12, 0, 13, 0);
    TK_CAND(14, 0, 15, 0);
#undef TK_CAND
    { unsigned p[16];
#pragma unroll
      for (int k = 0; k < 16; ++k) p[k] = tk::xswap(kc[k], hi);
      tk::topmerge(kc, p); }
    if (hi == 0) {
#pragma unroll
      for (int k = 0; k < 16; ++k) { KL[k * 32 + r32] = ka[k]; KL[(16 + k) * 32 + r32] = kb[k]; }
    }
    __builtin_amdgcn_wave_barrier();
    const float vmax = va[0] + vb[0];
    float pv[8]; int id[8]; float s = 0.f;
#pragma unroll
    for (int j = 0; j < 8; ++j) {
      unsigned klo_ = kc[j], khi_ = kc[8 + j]; asm volatile("" : "+v"(klo_), "+v"(khi_));
      const unsigned key = hi ? khi_ : klo_;
      const unsigned flat = 255u - (key & 255u);
      const unsigned k1 = KL[(flat >> 4) * 32 + r32], k2 = KL[(16 + (flat & 15u)) * 32 + r32];
      pv[j] = __expf(keyval(k1, 127u) + keyval(k2, 127u) - vmax); s += pv[j];
      id[j] = (int)((127u - (k1 & 127u)) * 128u + (127u - (k2 & 127u)));
    }
    __builtin_amdgcn_wave_barrier();
    const float inv = 1.f / att::xhalf_sum(s);
    u32x4* ep = (u32x4*)(eidx + (size_t)t * 128 + h * 16 + hi * 8); f32x4* gp = (f32x4*)(gate + (size_t)t * 128 + h * 16 + hi * 8);
    ep[0] = (u32x4){(unsigned)id[0], (unsigned)id[1], (unsigned)id[2], (unsigned)id[3]}; ep[1] = (u32x4){(unsigned)id[4], (unsigned)id[5], (unsigned)id[6], (unsigned)id[7]};
    gp[0] = (f32x4){pv[0] * inv, pv[1] * inv, pv[2] * inv, pv[3] * inv}; gp[1] = (f32x4){pv[4] * inv, pv[5] * inv, pv[6] * inv, pv[7] * inv};
  }
}

__device__ __forceinline__ float gelu_erf(float v) { return 0.5f * v * (1.f + erff(v * 0.70710678118654752f)); }

__device__ __forceinline__ float gelu_as(float v) {
  const float av = fabsf(v), t = __builtin_amdgcn_rcpf(av * 0.2316418882f + 1.0f);
  float q = t * 0.5307027145f + (-0.7265760135f); q = q * t + 0.7107068705f; q = q * t + (-0.142248368f); q = q * t + 0.127414796f; q = q * t;
  const float m = v * (q * __builtin_amdgcn_exp2f((v * v) * (-0.72134752044f)));
  return v < 0.f ? m : v - m;
}
#define PIN16(A, O) asm volatile("" : "+v"(A[O]), "+v"(A[O + 1]), "+v"(A[O + 2]), "+v"(A[O + 3]), "+v"(A[O + 4]), "+v"(A[O + 5]), "+v"(A[O + 6]), "+v"(A[O + 7]), "+v"(A[O + 8]), "+v"(A[O + 9]), "+v"(A[O + 10]), "+v"(A[O + 11]), "+v"(A[O + 12]), "+v"(A[O + 13]), "+v"(A[O + 14]), "+v"(A[O + 15]))
#define PIN6(R) asm volatile("" : "+v"(R[0].x), "+v"(R[0].y), "+v"(R[1].x), "+v"(R[1].y), "+v"(R[2].x), "+v"(R[2].y))
__device__ __forceinline__ void phase_exp_down(const Args& a, int gw, int ngw, int lane) {
  unsigned char* ws = a.ws;
  const int* eidx = (const int*)(ws + WS_EIDX); const float* gate = (const float*)(ws + WS_GATE); float* wout = (float*)(ws + WS_W);
  const unsigned char* exd = ws + WS_EXD; const float* esc = (const float*)(ws + WS_ESC);
  const int l32 = lane & 31, hi = lane >> 5;
  const bool b4 = (l32 & 16) != 0, b3 = (l32 & 8) != 0, b2 = (l32 & 4) != 0;
  for (int t = gw; t < NT; t += ngw) {
    const int e0 = eidx[(size_t)t * 128 + lane], e1 = eidx[(size_t)t * 128 + 64 + lane];
    const float sd0 = esc[e0], sd1 = esc[e1];
    const float gu0 = gate[(size_t)t * 128 + lane] * esc[NEXP + e0], gu1 = gate[(size_t)t * 128 + 64 + lane] * esc[NEXP + e1];
    const f32x4* xr = (const f32x4*)(a.out + (size_t)t * DM) + 8 * l32;
    float hg[32]; float s = 0.f;
#pragma unroll
    for (int k = 0; k < 8; ++k) { const f32x4 x = xr[k]; s += (x.x * x.x + x.y * x.y) + (x.z * x.z + x.w * x.w); hg[4 * k] = x.x; hg[4 * k + 1] = x.y; hg[4 * k + 2] = x.z; hg[4 * k + 3] = x.w; }
    s = half_sum32(s);
    const float rstd = rsqrtf(s * (1.f / DM) + EPS);
#pragma unroll
    for (int k = 0; k < 8; ++k) { const f32x4 g = ((const f32x4*)a.in[15])[8 * l32 + k]; hg[4 * k] *= rstd * g.x; hg[4 * k + 1] *= rstd * g.y; hg[4 * k + 2] *= rstd * g.z; hg[4 * k + 3] *= rstd * g.w; }
    float w0 = 0.f, w1 = 0.f;
    for (int e = 0; e < 128; e += 16) {
      u32x2 ur[8][3];
#pragma unroll
      for (int i = 0; i < 8; ++i) {
        const int pi = (e & 63) + 2 * i + hi; const int id = (e < 64) ? __shfl(e0, pi) : __shfl(e1, pi);
        const u32x2* up = (const u32x2*)(exd + (size_t)id * 768 + 24 * l32);
        ur[i][0] = up[0]; ur[i][1] = up[1]; ur[i][2] = up[2];
      }
      float d[8];
#pragma unroll
      for (int i = 0; i < 8; ++i) {
        const v32f u = __builtin_amdgcn_cvt_scalef32_pk32_f32_fp6((v6u){ur[i][0].x, ur[i][0].y, ur[i][1].x, ur[i][1].y, ur[i][2].x, ur[i][2].y}, 1.0f);
        float q = 0.f;
#pragma unroll
        for (int k = 0; k < 32; ++k) q += hg[k] * u[k];
        d[i] = q;
        __builtin_amdgcn_sched_barrier(0);
      }
      float r[4];
#pragma unroll
      for (int j = 0; j < 4; ++j) r[j] = (b4 ? d[j + 4] : d[j]) + swz_xor<16>(b4 ? d[j] : d[j + 4]);
      const float q0 = (b3 ? r[2] : r[0]) + swz_xor<8>(b3 ? r[0] : r[2]);
      const float q1 = (b3 ? r[3] : r[1]) + swz_xor<8>(b3 ? r[1] : r[3]);
      float q = (b2 ? q1 : q0) + swz_xor<4>(b2 ? q0 : q1);
      q += swz_xor<2>(q); q += swz_xor<1>(q);
      const int pr = (e & 63) + 2 * (l32 >> 2) + hi;
      const float sd = (e < 64) ? __shfl(sd0, pr) : __shfl(sd1, pr);
      const float gu = (e < 64) ? __shfl(gu0, pr) : __shfl(gu1, pr);
      const float wl = gu * gelu_as(q * sd);
      const float wsrc = __shfl(wl, ((lane & 1) << 5) | (((lane - (e & 63)) >> 1 & 7) << 2));
      if (lane >= (e & 63) && lane < (e & 63) + 16) { if (e < 64) w0 = wsrc; else w1 = wsrc; }
    }
    wout[(size_t)t * 128 + lane] = w0; wout[(size_t)t * 128 + 64 + lane] = w1;
  }
}

__device__ __forceinline__ void exp_up_item(const Args& a, unsigned char* lds, int xs, int item, int wave, int lane, float* xout, float* ssout) {
  unsigned char* ws = a.ws;
  const int* eidx = (const int*)(ws + WS_EIDX); const float* wgt = (const float*)(ws + WS_W);
  const unsigned char* ups = ws + WS_EXU + (size_t)xs * (NEXP * 128);
  unsigned* L = (unsigned*)(lds + wave * 16640);
  const int g = lane >> 2, c = lane & 3, t0 = item * 128 + wave * 16;
  __builtin_amdgcn_wave_barrier();
#pragma unroll 4
  for (int tk = 0; tk < 16; ++tk) {
    const size_t o = (size_t)(t0 + tk) * 128;
    L[tk * 260 + lane] = (unsigned)eidx[o + lane]; L[tk * 260 + 64 + lane] = (unsigned)eidx[o + 64 + lane];
    L[tk * 260 + 128 + lane] = __float_as_uint(wgt[o + lane]); L[tk * 260 + 192 + lane] = __float_as_uint(wgt[o + 64 + lane]);
  }
  __builtin_amdgcn_wave_barrier();
  float acc[32];
#pragma unroll
  for (int i = 0; i < 32; ++i) acc[i] = 0.f;
  const unsigned* Lg = L + g * 260;
#pragma unroll 1
  for (int p = 0; p < 128; p += 8) {
    u32x2 vr[8][3];
#pragma unroll
    for (int u = 0; u < 8; ++u) {
      const u32x2* vp = (const u32x2*)(ups + (size_t)Lg[p + u] * 128 + 24 * c);
      vr[u][0] = vp[0]; vr[u][1] = vp[1]; vr[u][2] = vp[2];
    }
#pragma unroll
    for (int u = 0; u < 8; ++u) {
      const float w = __uint_as_float(Lg[128 + p + u]);
      PIN6(vr[u]);
      const v32f v = __builtin_amdgcn_cvt_scalef32_pk32_f32_fp6((v6u){vr[u][0].x, vr[u][0].y, vr[u][1].x, vr[u][1].y, vr[u][2].x, vr[u][2].y}, 1.0f);
#pragma unroll
      for (int k = 0; k < 32; ++k) acc[k] += w * v[k];
      PIN16(acc, 0); PIN16(acc, 16);
    }
  }
  const f32x4* xr = (const f32x4*)(a.out + (size_t)(t0 + g) * DM + xs * 128 + c * 32); f32x4* xw = (f32x4*)(xout + (size_t)(t0 + g) * DM + xs * 128 + c * 32);
  float s = 0.f;
#pragma unroll
  for (int k = 0; k < 8; ++k) { f32x4 x = xr[k]; x.x += acc[4 * k]; x.y += acc[4 * k + 1]; x.z += acc[4 * k + 2]; x.w += acc[4 * k + 3]; xw[k] = x; s += (x.x * x.x + x.y * x.y) + (x.z * x.z + x.w * x.w); }
  s += swz_xor<1>(s); s += swz_xor<2>(s);
  if (c == 0) atomicAdd(ssout + t0 + g, s);
}
__device__ __forceinline__ void phase_exp_up(const Args& a, unsigned char* lds, const XcdBarrier& bar, int tid, int wave, int lane, unsigned* ctr, float* xout, float* ssout);
struct UpBuf { u32x2 r[8][3]; };
__device__ __forceinline__ void up2_load(UpBuf& B, const unsigned char* ups, const unsigned* Lg, int ch, int c) {
  const unsigned char* base = ups + (size_t)(ch >> 4) * (NEXP * 128) + 24 * c; const int p = (ch & 15) * 8;
#pragma unroll
  for (int u = 0; u < 8; ++u) { const u32x2* vp = (const u32x2*)(base + (size_t)Lg[p + u] * 128); B.r[u][0] = vp[0]; B.r[u][1] = vp[1]; B.r[u][2] = vp[2]; }
}
__device__ __forceinline__ void up2_math(UpBuf& B, const unsigned* Lg, int ch, float (&acc)[32]) {
  const int p = (ch & 15) * 8;
#pragma unroll
  for (int u = 0; u < 8; ++u) {
    const float w = __uint_as_float(Lg[128 + p + u]);
    PIN6(B.r[u]);
    const v32f v = __builtin_amdgcn_cvt_scalef32_pk32_f32_fp6((v6u){B.r[u][0].x, B.r[u][0].y, B.r[u][1].x, B.r[u][1].y, B.r[u][2].x, B.r[u][2].y}, 1.0f);
#pragma unroll
    for (int k = 0; k < 32; ++k) acc[k] += w * v[k];
    PIN16(acc, 0); PIN16(acc, 16);
  }
}
__device__ __forceinline__ void up2_slice_end(const Args& a, int t, int xs, int c, float (&acc)[32], float& ssum) {
  f32x4* xr = (f32x4*)(a.out + (size_t)t * DM + xs * 128 + c * 32);
#pragma unroll
  for (int k = 0; k < 8; ++k) { f32x4 x = xr[k]; x.x += acc[4 * k]; x.y += acc[4 * k + 1]; x.z += acc[4 * k + 2]; x.w += acc[4 * k + 3]; xr[k] = x; ssum += (x.x * x.x + x.y * x.y) + (x.z * x.z + x.w * x.w);
    acc[4 * k] = 0.f; acc[4 * k + 1] = 0.f; acc[4 * k + 2] = 0.f; acc[4 * k + 3] = 0.f; }
}
__device__ __forceinline__ void phase_exp_up2(const Args& a, unsigned char* lds, int wave, int lane) {
  unsigned char* ws = a.ws;
  const int* eidx = (const int*)(ws + WS_EIDX); const float* wgt = (const float*)(ws + WS_W);
  const unsigned char* ups = ws + WS_EXU;
  unsigned* L = (unsigned*)(lds + wave * 16640);
  const int g = lane >> 2, c = lane & 3;
  for (int blk = blockIdx.x; blk < NT / 128; blk += gridDim.x) {
    const int t0 = blk * 128 + wave * 16, t = t0 + g;
    __builtin_amdgcn_wave_barrier();
#pragma unroll 4
    for (int tk = 0; tk < 16; ++tk) {
      const size_t o = (size_t)(t0 + tk) * 128;
      L[tk * 260 + lane] = (unsigned)eidx[o + lane]; L[tk * 260 + 64 + lane] = (unsigned)eidx[o + 64 + lane];
      L[tk * 260 + 128 + lane] = __float_as_uint(wgt[o + lane]); L[tk * 260 + 192 + lane] = __float_as_uint(wgt[o + 64 + lane]);
    }
    __builtin_amdgcn_wave_barrier();
    const unsigned* Lg = L + g * 260;
    float acc[32]; float ssum = 0.f;
#pragma unroll
    for (int i = 0; i < 32; ++i) acc[i] = 0.f;
    UpBuf A, B;
    up2_load(A, ups, Lg, 0, c);
#pragma unroll 1
    for (int ch = 0; ch < 128; ch += 2) {
      up2_load(B, ups, Lg, ch + 1, c);
      up2_math(A, Lg, ch, acc);
      if (ch + 2 < 128) up2_load(A, ups, Lg, ch + 2, c);
      up2_math(B, Lg, ch + 1, acc);
      if ((ch & 15) == 14) up2_slice_end(a, t, ch >> 4, c, acc, ssum);
    }
    ssum += swz_xor<1>(ssum); ssum += swz_xor<2>(ssum);
    const float r2 = rsqrtf(ssum * (1.f / DM) + EPS);
    asm volatile("s_waitcnt vmcnt(0)" ::: "memory");
    __builtin_amdgcn_fence(__ATOMIC_ACQUIRE, "agent");
#pragma unroll 2
    for (int xs = 0; xs < 8; ++xs) {
      f32x4* xr = (f32x4*)(a.out + (size_t)t * DM + xs * 128 + c * 32); const f32x4* gp = (const f32x4*)(a.in[21] + xs * 128 + c * 32);
#pragma unroll
      for (int k = 0; k < 8; ++k) xr[k] = xr[k] * r2 * gp[k];
    }
  }
}

__device__ __forceinline__ void phase_final(const Args& a, int gw, int ngw, int lane) {
  const float* ss = (const float*)(a.ws + WS_SS3);
  for (int r = gw; r < NT; r += ngw) {
    const float r2 = rsqrtf(ss[r] * (1.f / DM) + EPS);
    f32x4* xr = (f32x4*)(a.out + (size_t)r * DM) + lane;
#pragma unroll
    for (int j = 0; j < 4; ++j) { const f32x4 g = ((const f32x4*)a.in[21])[64 * j + lane]; xr[64 * j] = xr[64 * j] * r2 * g; }
  }
}

namespace pg8 {
#define PG8_LAS __attribute__((address_space(3)))
typedef unsigned short bf16_t;
typedef short bf16x8 __attribute__((ext_vector_type(8)));
typedef float f32x4 __attribute__((ext_vector_type(4)));
typedef unsigned u32x4 __attribute__((ext_vector_type(4)));
constexpr int BM = 256, BK = 64, HALF = 128, HTB = HALF * BK * 2  , STAGE_BYTES = 8 * HTB, NXCD = 8, WGM = 8;

__host__ __device__ __forceinline__ int lds_byte(int r, int c) { const int st = (r >> 4) * 2 + (c >> 5), rr = r & 15, cc = c & 31, ob = rr * 64 + cc * 2; return st * 1024 + (ob ^ (((ob >> 9) & 1) << 5)); }
__host__ __device__ __forceinline__ void stage_rc(int b, int& R, int& C) { const int st = b / 1024, sb = b % 1024, swz = sb ^ (((sb >> 9) & 1) << 5); R = (st >> 1) * 16 + swz / 64; C = (st & 1) * 32 + (swz % 64) / 2; }
__host__ __device__ __forceinline__ int perm32(int rho) { const int n = rho >> 4, i = rho & 15; return 8 * (i >> 2) + 4 * n + (i & 3); }

struct Unit { int pm, pn; };
struct Gemm { const bf16_t* A; const bf16_t* Bt; int M, N, K; };

struct StaticOrder {
    int nM, nN, nwg, G, c;
    __host__ __device__ void init(int M, int N, int G_, int c_) { nM = M / BM; nN = N / BM; nwg = nM * nN; G = G_; c = c_; }
    __host__ __device__ bool next(int i, Unit& u) const {
        const long L = (long)i * G + c; if (L >= nwg) return false;
        int wgid = (int)L; { const int q = nwg / NXCD, r = nwg % NXCD, xcd = wgid % NXCD, off = wgid / NXCD; wgid = (xcd < r ? xcd * (q + 1) : r * (q + 1) + (xcd - r) * q) + off; }
        const int nig = WGM * nN, gid = wgid / nig, fm = gid * WGM, gsz = (nM - fm) < WGM ? (nM - fm) : WGM;
        u.pm = fm + ((wgid % nig) % gsz); u.pn = (wgid % nig) / gsz; return true;
    }
    __device__ __forceinline__ void a_ready(const Unit&) const {}
    __device__ __forceinline__ void done(const Unit&) const {}
};

template <class St> struct EpiAdapt8 {
    static constexpr bool PERM = true, AFTER_DRAIN = false; St st;
    __device__ __forceinline__ void operator()(const f32x4 (&acc)[2][2][4][2], const Unit& u, int wr, int wc, int fr, int fq) const {
#pragma unroll
        for (int ai = 0; ai < 2; ++ai)
#pragma unroll
            for (int m = 0; m < 4; ++m)
#pragma unroll
                for (int bj = 0; bj < 2; ++bj) st.store8(u.pm * BM + ai * HALF + wr * 64 + m * 16 + fr, u.pn * BM + bj * HALF + wc * 32 + 8 * fq, acc[ai][bj][m][0], acc[ai][bj][m][1]);
    }
};
template <class St> struct EpiAdapt {
    static constexpr bool PERM = false, AFTER_DRAIN = false; St st;
    __device__ __forceinline__ void operator()(const f32x4 (&acc)[2][2][4][2], const Unit& u, int wr, int wc, int fr, int fq) const {
#pragma unroll
        for (int ai = 0; ai < 2; ++ai)
#pragma unroll
            for (int m = 0; m < 4; ++m)
#pragma unroll
                for (int bj = 0; bj < 2; ++bj)
#pragma unroll
                    for (int n = 0; n < 2; ++n) st.store(u.pm * BM + ai * HALF + wr * 64 + m * 16 + fr, u.pn * BM + bj * HALF + wc * 32 + n * 16 + 4 * fq, acc[ai][bj][m][n]);
    }
};

struct EpiResidSS {
    static constexpr bool PERM = false, AFTER_DRAIN = false; const float* base; float* out; bf16_t* hb; float* ss;
    __device__ __forceinline__ void operator()(const f32x4 (&acc)[2][2][4][2], const Unit& u, int wr, int wc, int fr, int fq) const {
#pragma unroll
        for (int ai = 0; ai < 2; ++ai)
#pragma unroll
            for (int m = 0; m < 4; ++m) {
                const int row = u.pm * BM + ai * HALF + wr * 64 + m * 16 + fr; float s = 0.f;
#pragma unroll
                for (int bj = 0; bj < 2; ++bj)
#pragma unroll
                    for (int n = 0; n < 2; ++n) {
                        const size_t o = (size_t)row * 1024 + u.pn * BM + bj * HALF + wc * 32 + n * 16 + 4 * fq;
                        const f32x4 v = *(const f32x4*)(base + o) + acc[ai][bj][m][n];
                        *(f32x4*)(out + o) = v;
                        typedef unsigned u32x2v __attribute__((ext_vector_type(2)));
                        { const float f0 = v.x, f1 = v.y, f2 = v.z, f3 = v.w; *(u32x2v*)(hb + o) = (u32x2v){::pk2(f0, f1), ::pk2(f2, f3)}; }
                        s += (v.x * v.x + v.y * v.y) + (v.z * v.z + v.w * v.w);
                    }
                s += __shfl_xor(s, 16); s += __shfl_xor(s, 32);
                if (fq == 0) atomicAdd(ss + row, s);
            }
    }
};
template <class Epi, class Sched, bool ALIGN_EPI = false, bool SP2 = false>
__device__ __forceinline__ void gemm_phase(PG8_LAS unsigned char* lds, const Gemm g, const Sched& S, const Epi& E) {
    const int tid = threadIdx.x, wid = __builtin_amdgcn_readfirstlane(tid >> 6), lane = tid & 63, wr = wid >> 2, wc = wid & 3, fr = lane & 15, fq = lane >> 4;
    const int K = g.K, nt = K / BK;
    unsigned voffA[2], voffB[2];
#pragma unroll
    for (int i = 0; i < 2; ++i) { int R, C; stage_rc(tid * 16 + i * 8192, R, C); const int Rb = Epi::PERM ? ((R & ~31) + perm32(R & 31)) : R;
        voffA[i] = (unsigned)(R * K + C) * 2u; voffB[i] = (unsigned)(Rb * K + C) * 2u; }
    const size_t kstep = (size_t)(BK * 2);
    const size_t hstep = (size_t)HALF * K * 2;
    const size_t tstep = 2 * hstep;
    const unsigned ldsw = (unsigned)wid * 1024u;
    const int aoff = lds_byte(wr * 64 + fr, fq * 8), boff = lds_byte(wc * 32 + fr, fq * 8);
#define PG8_SA(b, h) (((b) * 2 + (h)) * HTB)
#define PG8_SB(b, h) ((4 + (b) * 2 + (h)) * HTB)
#define PG8_STAGE(bufoff, gbase, voff) do { _Pragma("unroll") for (int _i = 0; _i < 2; ++_i) \
        __builtin_amdgcn_global_load_lds((const unsigned*)((const char*)(gbase) + (voff)[_i]), (PG8_LAS unsigned*)(lds + (bufoff) + ldsw + _i * 8192), 16, 0, 0); } while (0)
#define PG8_LDA(dst, b, h) do { _Pragma("unroll") for (int m = 0; m < 4; ++m) _Pragma("unroll") for (int k = 0; k < 2; ++k) dst[m][k] = *(const PG8_LAS bf16x8*)(lds + PG8_SA(b, h) + aoff + m * 2048 + k * 1024); } while (0)
#define PG8_LDB(dst, b, h) do { _Pragma("unroll") for (int n = 0; n < 2; ++n) _Pragma("unroll") for (int k = 0; k < 2; ++k) dst[n][k] = *(const PG8_LAS bf16x8*)(lds + PG8_SB(b, h) + boff + n * 2048 + k * 1024); } while (0)
#define PG8_MMA(ai, bj, At, Bt) do { __builtin_amdgcn_s_setprio(1); _Pragma("unroll") for (int m = 0; m < 4; ++m) _Pragma("unroll") for (int n = 0; n < 2; ++n) _Pragma("unroll") for (int k = 0; k < 2; ++k) \
        acc[ai][bj][m][n] = __builtin_amdgcn_mfma_f32_16x16x32_bf16(Bt[n][k], At[m][k], acc[ai][bj][m][n], 0, 0, 0); __builtin_amdgcn_s_setprio(0); } while (0)
#define PG8_WAIT_V(n) asm volatile("s_waitcnt vmcnt(" #n ")" ::: "memory")
#define PG8_WAIT_L(n) asm volatile("s_waitcnt lgkmcnt(" #n ")" ::: "memory")
#define PG8_BAR __builtin_amdgcn_s_barrier()
#define PG8_SCHED __builtin_amdgcn_sched_barrier(0)
    Unit cur, nxt; int ui = 0;
    if (!S.next(0, cur)) return;
    f32x4 acc[2][2][4][2];
#pragma unroll
    for (int a = 0; a < 2; ++a)
#pragma unroll
        for (int b = 0; b < 2; ++b)
#pragma unroll
            for (int m = 0; m < 4; ++m)
#pragma unroll
                for (int n = 0; n < 2; ++n) acc[a][b][m][n] = (f32x4){0.f, 0.f, 0.f, 0.f};
    bf16x8 At[4][2], B0[2][2], B1[2][2];
    const char* cA = (const char*)g.A + (size_t)cur.pm * tstep; const char* cB = (const char*)g.Bt + (size_t)cur.pn * tstep;
    S.a_ready(cur);
    if constexpr (SP2) {
        PG8_STAGE(PG8_SB(0, 0), cB, voffB); PG8_STAGE(PG8_SB(0, 1), cB + hstep, voffB); PG8_STAGE(PG8_SA(0, 0), cA, voffA); PG8_STAGE(PG8_SA(0, 1), cA + hstep, voffA);
        if (wr == 1) PG8_BAR;
        PG8_WAIT_V(2); PG8_BAR;
        PG8_STAGE(PG8_SB(1, 0), cB + kstep, voffB); PG8_STAGE(PG8_SA(1, 0), cA + kstep, voffA); PG8_STAGE(PG8_SB(1, 1), cB + hstep + kstep, voffB);
        PG8_WAIT_V(6); PG8_BAR;
    } else {
        PG8_STAGE(PG8_SB(0, 0), cB, voffB); PG8_STAGE(PG8_SA(0, 0), cA, voffA); PG8_STAGE(PG8_SB(0, 1), cB + hstep, voffB); PG8_STAGE(PG8_SA(0, 1), cA + hstep, voffA);
        if (wr == 1) PG8_BAR;
        PG8_WAIT_V(4); PG8_BAR;
        PG8_STAGE(PG8_SB(1, 0), cB + kstep, voffB); PG8_STAGE(PG8_SA(1, 0), cA + kstep, voffA); PG8_STAGE(PG8_SB(1, 1), cB + hstep + kstep, voffB);
        PG8_WAIT_V(6); PG8_BAR;
    }
    for (;;) {
        const bool has_next = S.next(ui + 1, nxt);
        const char* nA = has_next ? (const char*)g.A + (size_t)nxt.pm * tstep : cA; const char* nB = has_next ? (const char*)g.Bt + (size_t)nxt.pn * tstep : cB;
        for (int t = 0; t < nt; t += 2) {
            const bool last = (t == nt - 2);
            const char* a1 = cA + (size_t)(t + 1) * kstep;
            const char* a2 = last ? nA : cA + (size_t)(t + 2) * kstep; const char* b2 = last ? nB : cB + (size_t)(t + 2) * kstep;
            const char* a3 = a2 + kstep; const char* b3 = b2 + kstep;
            if (last && has_next) S.a_ready(nxt);
            if constexpr (SP2) {
            PG8_LDB(B0, 0, 0); PG8_LDB(B1, 0, 1); PG8_SCHED; PG8_LDA(At, 0, 0); PG8_STAGE(PG8_SA(1, 1), a1 + hstep, voffA);
            PG8_WAIT_V(8); PG8_WAIT_L(0); PG8_BAR; PG8_MMA(0, 0, At, B0); PG8_MMA(0, 1, At, B1); PG8_BAR; PG8_SCHED;
            PG8_LDA(At, 0, 1); PG8_STAGE(PG8_SB(0, 0), b2, voffB); PG8_STAGE(PG8_SB(0, 1), b2 + hstep, voffB); PG8_STAGE(PG8_SA(0, 0), a2, voffA);
            PG8_WAIT_V(8); PG8_WAIT_L(0); PG8_BAR; PG8_MMA(1, 0, At, B0); PG8_MMA(1, 1, At, B1); PG8_BAR; PG8_SCHED;
            PG8_LDB(B0, 1, 0); PG8_LDB(B1, 1, 1); PG8_SCHED; PG8_LDA(At, 1, 0); PG8_STAGE(PG8_SA(0, 1), a2 + hstep, voffA);
            PG8_WAIT_V(8); PG8_WAIT_L(0); PG8_BAR; PG8_MMA(0, 0, At, B0); PG8_MMA(0, 1, At, B1); PG8_BAR; PG8_SCHED;
            PG8_LDA(At, 1, 1); PG8_STAGE(PG8_SB(1, 0), b3, voffB); PG8_STAGE(PG8_SB(1, 1), b3 + hstep, voffB); PG8_STAGE(PG8_SA(1, 0), a3, voffA);
            PG8_WAIT_V(8); PG8_WAIT_L(0); PG8_BAR; PG8_MMA(1, 0, At, B0); PG8_MMA(1, 1, At, B1); PG8_BAR; PG8_SCHED;
            } else {
            PG8_LDB(B0, 0, 0); PG8_SCHED; PG8_LDA(At, 0, 0); PG8_STAGE(PG8_SA(1, 1), a1 + hstep, voffA);
            PG8_WAIT_L(8); PG8_BAR; PG8_WAIT_L(0); PG8_MMA(0, 0, At, B0); PG8_BAR; PG8_SCHED;
            PG8_LDB(B1, 0, 1); PG8_STAGE(PG8_SB(0, 0), b2, voffB);
            PG8_BAR; PG8_WAIT_L(0); PG8_MMA(0, 1, At, B1); PG8_BAR;
            PG8_LDA(At, 0, 1); PG8_STAGE(PG8_SA(0, 0), a2, voffA);
            PG8_BAR; PG8_WAIT_L(0); PG8_MMA(1, 0, At, B0); PG8_BAR; PG8_SCHED;
            PG8_STAGE(PG8_SB(0, 1), b2 + hstep, voffB);
            PG8_WAIT_V(6); PG8_BAR; PG8_MMA(1, 1, At, B1); PG8_BAR;
            PG8_LDB(B0, 1, 0); PG8_SCHED; PG8_LDA(At, 1, 0); PG8_STAGE(PG8_SA(0, 1), a2 + hstep, voffA);
            PG8_WAIT_L(8); PG8_BAR; PG8_WAIT_L(0); PG8_MMA(0, 0, At, B0); PG8_BAR; PG8_SCHED;
            PG8_LDB(B1, 1, 1); PG8_STAGE(PG8_SB(1, 0), b3, voffB);
            PG8_BAR; PG8_WAIT_L(0); PG8_MMA(0, 1, At, B1); PG8_BAR;
            PG8_LDA(At, 1, 1); PG8_STAGE(PG8_SA(1, 0), a3, voffA);
            PG8_BAR; PG8_WAIT_L(0); PG8_MMA(1, 0, At, B0); PG8_BAR; PG8_SCHED;
            PG8_STAGE(PG8_SB(1, 1), b3 + hstep, voffB);
            PG8_WAIT_V(6); PG8_BAR; PG8_MMA(1, 1, At, B1); PG8_BAR;
            }
        }
        if constexpr (ALIGN_EPI) { if (wr == 0) PG8_BAR; }
        if constexpr (!Epi::AFTER_DRAIN) { E(acc, cur, wr, wc, fr, fq); S.done(cur); }
        if (!has_next) break;
#pragma unroll
        for (int a = 0; a < 2; ++a)
#pragma unroll
            for (int b = 0; b < 2; ++b)
#pragma unroll
                for (int m = 0; m < 4; ++m)
#pragma unroll
                    for (int n = 0; n < 2; ++n) acc[a][b][m][n] = (f32x4){0.f, 0.f, 0.f, 0.f};
        cur = nxt; cA = nA; cB = nB; ++ui;
        if constexpr (ALIGN_EPI) { if (wr == 1) PG8_BAR; }
    }
    PG8_WAIT_V(0);
    if constexpr (!ALIGN_EPI) { if (wr == 0) PG8_BAR; }
    PG8_BAR;
    if constexpr (Epi::AFTER_DRAIN) { E.fused(acc, cur, wr, wc, fr, fq, lds, wid, lane); S.done(cur); }
#undef PG8_SA
#undef PG8_SB
#undef PG8_STAGE
#undef PG8_LDA
#undef PG8_LDB
#undef PG8_MMA
#undef PG8_WAIT_V
#undef PG8_WAIT_L
#undef PG8_BAR
#undef PG8_SCHED
}
}


template <class Epi>
__device__ __forceinline__ void run_gemm_raw(unsigned char* lds, const bf16_t* A, const bf16_t* Bt, int M, int N, int K, const Epi& E) {
  pg8::Gemm g{A, Bt, M, N, K}; pg8::StaticOrder S; S.init(M, N, (int)gridDim.x, (int)blockIdx.x);
  pg8::gemm_phase<Epi, pg8::StaticOrder, true, true>((PG8_LAS unsigned char*)lds, g, S, E);
}
template <class St>
__device__ __forceinline__ void run_gemm8(unsigned char* lds, const bf16_t* A, const bf16_t* Bt, int M, int N, int K, const St& st) {
  pg8::Gemm g{A, Bt, M, N, K}; pg8::StaticOrder S; S.init(M, N, (int)gridDim.x, (int)blockIdx.x);
  pg8::EpiAdapt8<St> E{st};
  pg8::gemm_phase<pg8::EpiAdapt8<St>, pg8::StaticOrder, true, true>((PG8_LAS unsigned char*)lds, g, S, E);
}
template <class St>
__device__ __forceinline__ void run_gemm(unsigned char* lds, const bf16_t* A, const bf16_t* Bt, int M, int N, int K, const St& st, int gw, int ngw, int lane) {
#if USE_PG8
  pg8::Gemm g{A, Bt, M, N, K}; pg8::StaticOrder S; S.init(M, N, (int)gridDim.x, (int)blockIdx.x);
  pg8::EpiAdapt<St> E{st};
  pg8::gemm_phase<pg8::EpiAdapt<St>, pg8::StaticOrder, true, true>((PG8_LAS unsigned char*)lds, g, S, E);
#else
  gemm_naive(A, K, Bt, K, M, N, K, st, gw, ngw, lane);
#endif
}

#define GAS __attribute__((address_space(1)))
#define LAS __attribute__((address_space(3)))
#define XB_TMO      128
#define XB_XCNT(j)  (256  + 64 * (j))
#define XB_XSUB(j)  (1280 + 64 * (j))
#define XB_XGEN(j)  (2304 + 64 * (j))
#define XB_TOP      3328
#define XB_TOPGEN   3392
#define XCD_BAR_WORDS 3456
#define XB_SPIN_CAP (1u << 18)

__device__ __forceinline__ unsigned xb_ld(unsigned* p)              { return __hip_atomic_load(p, __ATOMIC_RELAXED, __HIP_MEMORY_SCOPE_AGENT); }
__device__ __forceinline__ unsigned xb_add(unsigned* p, unsigned v) { return __hip_atomic_fetch_add(p, v, __ATOMIC_RELAXED, __HIP_MEMORY_SCOPE_AGENT); }
__device__ __forceinline__ unsigned xb_xcc_id() { return (unsigned)__builtin_amdgcn_s_getreg((3 << 11) | 20) & 0xFu; }
#define XB_SPIN(cond, bar) do { unsigned _sp = 0; while (cond) { __builtin_amdgcn_s_sleep(1); \
    if ((++_sp & 255u) == 0u) { if (xb_ld(&(bar)[XB_TMO])) break; if (_sp > XB_SPIN_CAP) { atomicAdd(&(bar)[XB_TMO], 1u); break; } } } } while (0)

struct XcdBarrier {
    unsigned* bar; unsigned x;
    volatile LAS unsigned* st;
};

__device__ __forceinline__ XcdBarrier xcd_barrier_post(unsigned* bar, volatile LAS unsigned* st) {
    XcdBarrier b; b.bar = bar; b.x = xb_xcc_id(); b.st = st;
    if (threadIdx.x == 0) (void)xb_add(&bar[XB_XCNT(b.x)], 1u);
    return b;
}
__device__ __forceinline__ void xcd_barrier_complete(unsigned* bar, unsigned x, unsigned& nloc, unsigned& nx) {
    const unsigned G = gridDim.x * gridDim.y * gridDim.z;
    unsigned sum, cnt, mine, sp = 0u;
    for (;;) {
        sum = 0u; cnt = 0u; mine = 0u;
#pragma unroll
        for (unsigned j = 0; j < 16; ++j) { const unsigned c = xb_ld(&bar[XB_XCNT(j)]); sum += c; cnt += (c > 0u) ? 1u : 0u; mine = (j == x) ? c : mine; }
        if (sum == G) break;
        __builtin_amdgcn_s_sleep(1);
        if ((++sp & 255u) == 0u) { if (xb_ld(&bar[XB_TMO])) break; if (sp > XB_SPIN_CAP) { atomicAdd(&bar[XB_TMO], 1u); break; } }
    }
    nloc = mine > 0u ? mine : 1u; nx = cnt > 0u ? cnt : 1u;
}

__device__ __forceinline__ void xcd_barrier(const XcdBarrier& b) {
    asm volatile("s_waitcnt vmcnt(0)" ::: "memory");
    __syncthreads();
    if (threadIdx.x == 0) {
        unsigned* bar = b.bar;
        __builtin_amdgcn_s_waitcnt(0);
        unsigned nloc = b.st[0], nx = b.st[1];
        if (nloc == 0u) { xcd_barrier_complete(bar, b.x, nloc, nx); b.st[0] = nloc; b.st[1] = nx; }
        const unsigned old = xb_add(&bar[XB_XSUB(b.x)], 1u);
        const unsigned gen = old / nloc;
        if (old + 1u == (gen + 1u) * nloc) {
            __builtin_amdgcn_fence(__ATOMIC_RELEASE, "agent");
            asm volatile("s_waitcnt vmcnt(0)" ::: "memory");
            const unsigned og = xb_add(&bar[XB_TOP], 1u);
            const unsigned tg = og / nx;
            if (og + 1u == (tg + 1u) * nx) xb_add(&bar[XB_TOPGEN], 1u);
            else XB_SPIN(xb_ld(&bar[XB_TOPGEN]) == tg, bar);
            __builtin_amdgcn_fence(__ATOMIC_ACQUIRE, "agent");
            xb_add(&bar[XB_XGEN(b.x)], 1u);
            asm volatile("s_waitcnt vmcnt(0)" ::: "memory");
        } else {
            XB_SPIN(xb_ld(&bar[XB_XGEN(b.x)]) == gen, bar);
            __builtin_amdgcn_fence(__ATOMIC_ACQUIRE, "agent");
            asm volatile("s_waitcnt vmcnt(0)" ::: "memory");
        }
    }
    __syncthreads();
}

__device__ __forceinline__ void phase_exp_up(const Args& a, unsigned char* lds, const XcdBarrier& bar, int tid, int wave, int lane, unsigned* ctr, float* xout, float* ssout) {
  unsigned* slot = (unsigned*)(lds + 8 * 16640);
  const int x0 = (int)(xb_xcc_id() & 7u);
  for (int k = 0; k < 8; ++k) {
    const int xs = (x0 + k) & 7;
    for (;;) {
      __syncthreads();
      if (tid == 0) slot[0] = atomicAdd(ctr + 16 * xs, 1u);
      __syncthreads();
      const unsigned item = slot[0];
      if (item >= (unsigned)(NT / 128)) break;
      exp_up_item(a, lds, xs, (int)item, wave, lane, xout, ssout);
    }
  }
}

__global__ void __launch_bounds__(512, 2) mega(Args a) {
  extern __shared__ __attribute__((aligned(16))) unsigned char lds[];
  cg::grid_group grid = cg::this_grid();
  const int tid = threadIdx.x, lane = tid & 63, wave = tid >> 6;
  const int gw = blockIdx.x * 8 + wave, ngw = gridDim.x * 8;
  unsigned char* ws = a.ws;
  const int lo = a.ph_lo, hi = a.ph_hi;
#define IN(k) (lo <= (k) && (k) < hi)
  volatile LAS unsigned* MISC = (volatile LAS unsigned*)((LAS unsigned char*)lds + 146944);
  if (tid < 32) MISC[tid] = 0u;
  __syncthreads();
  XcdBarrier bar; bar.bar = (unsigned*)(ws + WS_BAR); bar.x = 0; bar.st = nullptr;
  if (hi - lo > 1) bar = xcd_barrier_post((unsigned*)(ws + WS_BAR), MISC + 8);
#define SEAM(k) do { if (IN(k) && IN((k) + 1)) { if ((k) == 0) grid.sync(); else xcd_barrier(bar); } } while (0)
#if PROBE_REP == 0
  if (IN(0)) { phase_prep(a, lds, gw, ngw, wave, lane, tid); grid.sync(); }
#endif
  if (IN(0)) { phase_prep(a, lds, gw, ngw, wave, lane, tid); } SEAM(0);
#if PROBE_REP == 1
  if (IN(1)) {
    run_gemm8(lds, (const bf16_t*)(ws + WS_HB), (const bf16_t*)(ws + WS_WIN_T), NT, NQKV, DM, EpiQKV{(bf16_t*)(ws + WS_QKV)});
    run_gemm8(lds, (const bf16_t*)(ws + WS_MEMN), (const bf16_t*)(ws + WS_WXKV_T), NMROWS, 2048, DM, EpiBf16{(bf16_t*)(ws + WS_KX), 2048});
    xcd_barrier(bar); }
#endif
#if PROBE_REP == 2
  if (IN(2)) { phase_scan(a, gw, ngw, lane, tid); xcd_barrier(bar); phase_rms(a, gw, ngw, lane); xcd_barrier(bar); phase_rms(a, gw, ngw, lane); xcd_barrier(bar); }
#endif
  if (IN(1)) {
    run_gemm8(lds, (const bf16_t*)(ws + WS_HB), (const bf16_t*)(ws + WS_WIN_T), NT, NQKV, DM, EpiQKV{(bf16_t*)(ws + WS_QKV)});
    run_gemm8(lds, (const bf16_t*)(ws + WS_MEMN), (const bf16_t*)(ws + WS_WXKV_T), NMROWS, 2048, DM, EpiBf16{(bf16_t*)(ws + WS_KX), 2048});
  } SEAM(1);
  if (IN(2)) { phase_scan(a, gw, ngw, lane, tid); } SEAM(2);
#if PROBE_REP == 3
  if (IN(3)) { phase_attn2(a, lds, tid); xcd_barrier(bar); if (blockIdx.x == 0 && tid == 0) *(unsigned*)(ws) = 0u; xcd_barrier(bar); }
#endif
  if (IN(3)) {
#if USE_ATT2
    phase_attn2(a, lds, tid);
#else
    phase_attn(a, lds, tid);
#endif
  } SEAM(3);
  if (IN(4)) { phase_onorm(a, gw, ngw, lane); } SEAM(4);
  if (IN(5)) { run_gemm_raw(lds, (const bf16_t*)(ws + WS_OAB), (const bf16_t*)(ws + WS_WOUT_T), NT, DM, DM, pg8::EpiResidSS{a.in[0], a.out, (bf16_t*)(ws + WS_HB), (float*)(ws + WS_SS1)}); }
  if (IN(5) && IN(7)) xcd_barrier(bar);
  if (IN(7)) { run_gemm8(lds, (const bf16_t*)(ws + WS_HB), (const bf16_t*)(ws + WS_WXQ_T), NT, DM, DM, EpiBf16S{(bf16_t*)(ws + WS_QX), DM, (const float*)(ws + WS_SS1)}); } SEAM(7);
#if PROBE_REP == 8
  if (IN(8)) { phase_xattn(a, lds, gw, ngw, wave, lane); grid.sync(); }
#endif
  if (IN(8)) { phase_xattn2(a, lds, tid); } SEAM(8);
  if (IN(9)) { run_gemm_raw(lds, (const bf16_t*)(ws + WS_OX), (const bf16_t*)(ws + WS_WXO_T), NT, DM, DM, pg8::EpiResidSS{a.out, a.out, (bf16_t*)(ws + WS_HB), (float*)(ws + WS_SS2)}); }
  if (IN(9) && IN(11)) xcd_barrier(bar);
  if (IN(11)) { run_gemm8(lds, (const bf16_t*)(ws + WS_HB), (const bf16_t*)(ws + WS_WPQ_T), NT, DM, DM, EpiBf16S{(bf16_t*)(ws + WS_PQ), DM, (const float*)(ws + WS_SS2)}); } SEAM(11);
#if PROBE_REP == 12
  if (IN(12)) { phase_topk(a, lds, tid); grid.sync(); }
#endif
  if (IN(12)) { phase_topk2(a, lds, wave, lane); } SEAM(12);
    if (IN(13)) {
    for (int rep = 0; rep < a.rep_down; ++rep) { phase_exp_down(a, gw, ngw, lane); if (hi - lo > 1) xcd_barrier(bar); }
    phase_exp_up2(a, lds, wave, lane);
  }
#undef IN
#undef SEAM
}

extern "C" void kernel_launch(void* const* d_in, const int* in_sizes, int n_in, void* d_out, int out_size, void* d_ws, size_t ws_size, hipStream_t stream) {
  static int grid = 0;
  if (grid == 0) {
    if (n_in != 22 || out_size != NT * DM || ws_size < WS_END) { fprintf(stderr, "kernel_launch: unexpected shapes (n_in %d out %d ws %zu)\n", n_in, out_size, ws_size); grid = -1; return; }
    int dev = 0, cus = 0, per_cu = 0;
    (void)hipGetDevice(&dev);
    (void)hipDeviceGetAttribute(&cus, hipDeviceAttributeMultiprocessorCount, dev);
    (void)hipFuncSetAttribute((const void*)mega, hipFuncAttributeMaxDynamicSharedMemorySize, LDS_BYTES);
    (void)hipOccupancyMaxActiveBlocksPerMultiprocessor(&per_cu, (const void*)mega, 512, LDS_BYTES);
    if (per_cu < 1) per_cu = 1;
    grid = cus * per_cu;
  }
  if (grid < 0) return;
  (void)hipMemsetAsync(d_ws, 0, CTL_ZERO_BYTES, stream);
  Args a{};
  for (int i = 0; i < 22; ++i) a.in[i] = (const float*)d_in[i];
  a.out = (float*)d_out; a.ws = (unsigned char*)d_ws;
  a.rep_down = REP_DOWN; a.rep_up = REP_UP;
#if MK_N_LAUNCHES == 1
  a.ph_lo = 0; a.ph_hi = NPHASE + 1;
  void* args[] = {&a};
  hipError_t e = hipLaunchCooperativeKernel((const void*)mega, dim3(grid), dim3(512), args, LDS_BYTES, stream);
  if (e != hipSuccess) fprintf(stderr, "cooperative launch failed: %s (grid %d)\n", hipGetErrorString(e), grid);
#else
  for (int p = 0; p <= NPHASE; ++p) { a.ph_lo = p; a.ph_hi = p + 1; hipLaunchKernelGGL(mega, dim3(grid), dim3(512), LDS_BYTES, stream, a); }
#endif
}
```

```cpp
#include <hip/hip_runtime.h>
#include <hip/hip_cooperative_groups.h>
#include <cstdio>
#include <cstdint>
namespace cg = cooperative_groups;

#ifndef USE_PG8
#define USE_PG8 1
#endif
#ifndef USE_ATT2
#define USE_ATT2 1
#endif
#ifndef PROBE_REP
#define PROBE_REP -1
#endif
#ifndef REP_DOWN
#define REP_DOWN 1
#endif
#ifndef REP_UP
#define REP_UP 1
#endif
#ifndef MK_N_LAUNCHES
#define MK_N_LAUNCHES 1
#endif

typedef unsigned short bf16_t;
typedef short bf16x8 __attribute__((ext_vector_type(8)));
typedef float f32x4 __attribute__((ext_vector_type(4)));
typedef unsigned u32x4 __attribute__((ext_vector_type(4)));
typedef unsigned u32x2 __attribute__((ext_vector_type(2)));
typedef float v32f __attribute__((ext_vector_type(32)));
typedef float v16f __attribute__((ext_vector_type(16)));
typedef unsigned v6u __attribute__((ext_vector_type(6)));
typedef float f32x2 __attribute__((ext_vector_type(2)));

constexpr int NB = 8, SEQ = 4096, DM = 1024, NT = NB * SEQ;
constexpr int NQKV = 3072, INW = 3080;
constexpr int NMEM = 256, NMROWS = NB * NMEM;
constexpr int NEXP = 16384;
constexpr float EPS = 1e-6f;
constexpr int NPHASE = 13;
constexpr int LDS_BYTES = 147456;

constexpr size_t MiB = 1u << 20;
constexpr size_t WS_BAR = 65536;
constexpr size_t WS_SS1 = 131072;
constexpr size_t WS_SS2 = 262144;
constexpr size_t WS_SS3 = 393216;
constexpr size_t WS_XCTR = 512;
constexpr size_t CTL_ZERO_BYTES = 524288;
constexpr size_t WS_WIN_T = 2 * MiB;
constexpr size_t WS_WOUT_T = 8 * MiB;
constexpr size_t WS_WXQ_T = 10 * MiB;
constexpr size_t WS_WXKV_T = 12 * MiB;
constexpr size_t WS_WXO_T = 16 * MiB;
constexpr size_t WS_WPQ_T = 18 * MiB;
constexpr size_t WS_SK = 21 * MiB;
constexpr size_t WS_MEMN = 22 * MiB;
constexpr size_t WS_KX = 26 * MiB;
constexpr size_t WS_VXT = 30 * MiB;
constexpr size_t WS_FLOG = 34 * MiB;
constexpr size_t WS_CUM = 35 * MiB;
constexpr size_t WS_KMEAN = 36 * MiB;
constexpr size_t WS_ESC = 38 * MiB;
constexpr size_t WS_EXD = 40 * MiB;
constexpr size_t WS_EXU = 72 * MiB;
constexpr size_t WS_HB = 104 * MiB;
constexpr size_t WS_QKV = 168 * MiB;
constexpr size_t WS_OAB = 360 * MiB;
constexpr size_t WS_QX = 168 * MiB;
constexpr size_t WS_OX = 232 * MiB;
constexpr size_t WS_PQ = 232 * MiB;
constexpr size_t WS_EIDX = 424 * MiB;
constexpr size_t WS_GATE = 440 * MiB;
constexpr size_t WS_W = 456 * MiB;
constexpr size_t WS_END = 472 * MiB;

struct Args {
  const float* in[22];
  float* out;
  unsigned char* ws;
  int ph_lo, ph_hi;
  int rep_down, rep_up;
};

struct XcdBarrier;
__device__ __forceinline__ unsigned f2bf(float f) { unsigned u = __float_as_uint(f); return (u + 0x7fffu + ((u >> 16) & 1u)) >> 16; }
__device__ __forceinline__ unsigned pk2(float lo, float hi) { return f2bf(lo) | (f2bf(hi) << 16); }
__device__ __forceinline__ float bf2f(unsigned short b) { return __uint_as_float(((unsigned)b) << 16); }
__device__ __forceinline__ float bflo(unsigned w) { return __uint_as_float(w << 16); }
__device__ __forceinline__ float bfhi(unsigned w) { return __uint_as_float(w & 0xffff0000u); }
__device__ __forceinline__ float wave_sum(float v) {
#pragma unroll
  for (int o = 1; o < 64; o <<= 1) v += __shfl_xor(v, o);
  return v;
}
template <int O> __device__ __forceinline__ float swz_xor(float v) { return __int_as_float(__builtin_amdgcn_ds_swizzle(__float_as_int(v), (O << 10) | 0x1f)); }
__device__ __forceinline__ float half_sum32(float v) { v += swz_xor<1>(v); v += swz_xor<2>(v); v += swz_xor<4>(v); v += swz_xor<8>(v); v += swz_xor<16>(v); return v; }
__device__ __forceinline__ void unpack8(const u32x4 w, float* f) {
  f[0] = bflo(w.x); f[1] = bfhi(w.x); f[2] = bflo(w.y); f[3] = bfhi(w.y);
  f[4] = bflo(w.z); f[5] = bfhi(w.z); f[6] = bflo(w.w); f[7] = bfhi(w.w);
}

__device__ const unsigned char T5_BUCKET[128] = {
  0, 1, 2, 3, 4, 5, 6, 7, 8, 9, 10, 11, 12, 13, 14, 15, 16, 16, 16, 17, 17, 18, 18, 18, 19, 19, 19, 20, 20, 20, 20, 21,
  21, 21, 21, 22, 22, 22, 22, 22, 23, 23, 23, 23, 23, 23, 24, 24, 24, 24, 24, 24, 25, 25, 25, 25, 25, 25, 25, 26, 26, 26, 26, 26,
  26, 26, 26, 27, 27, 27, 27, 27, 27, 27, 27, 27, 27, 28, 28, 28, 28, 28, 28, 28, 28, 28, 28, 29, 29, 29, 29, 29, 29, 29, 29, 29,
  29, 29, 29, 30, 30, 30, 30, 30, 30, 30, 30, 30, 30, 30, 30, 30, 30, 31, 31, 31, 31, 31, 31, 31, 31, 31, 31, 31, 31, 31, 31, 31};

__device__ __forceinline__ void transpose_item(const float* W, int ldw, const float* gain, bf16_t* WT, int K, int row_off, float* scr, int kb, int nb, int lane) {
  const int k0 = 64 * kb, n0 = 32 * nb;
#pragma unroll 8
  for (int i = 0; i < 32; ++i) {
    const int kk = 2 * i + (lane >> 5);
    const float g = gain ? gain[k0 + kk] : 1.f;
    scr[kk * 33 + (lane & 31)] = W[(size_t)(k0 + kk) * ldw + n0 + (lane & 31)] * g;
  }
  __builtin_amdgcn_wave_barrier();
  const int c = lane & 7;
#pragma unroll
  for (int j = 0; j < 4; ++j) {
    const int n = (lane >> 3) + 8 * j; const float* s = scr + (8 * c) * 33 + n;
    u32x4 o; o.x = pk2(s[0 * 33], s[1 * 33]); o.y = pk2(s[2 * 33], s[3 * 33]); o.z = pk2(s[4 * 33], s[5 * 33]); o.w = pk2(s[6 * 33], s[7 * 33]);
    *(u32x4*)(WT + (size_t)(row_off + n0 + n) * K + k0 + 8 * c) = o;
  }
  __builtin_amdgcn_wave_barrier();
}

__device__ __forceinline__ void rms_row_to_bf16(const float* xrow, bf16_t* orow, int lane) {
  const f32x4* xr = (const f32x4*)xrow + lane;
  f32x4 v[4]; float s = 0.f;
#pragma unroll
  for (int j = 0; j < 4; ++j) { v[j] = xr[64 * j]; s += (v[j].x * v[j].x + v[j].y * v[j].y) + (v[j].z * v[j].z + v[j].w * v[j].w); }
  const float rstd = rsqrtf(wave_sum(s) * (1.f / DM) + EPS);
  u32x2* o = (u32x2*)orow + lane;
#pragma unroll
  for (int j = 0; j < 4; ++j) { u32x2 w; w.x = pk2(v[j].x * rstd, v[j].y * rstd); w.y = pk2(v[j].z * rstd, v[j].w * rstd); o[64 * j] = w; }
}

__device__ __forceinline__ void phase_prep(const Args& a, unsigned char* lds, int gw, int ngw, int wave, int lane, int tid) {
  unsigned char* ws = a.ws;
  float* scr = (float*)(lds + wave * 8448);
  const int I_IN = 16 * 96, I_SQ = 16 * 32;
  const int NITEMS = I_IN + 6 * I_SQ;
  for (int it = gw; it < NITEMS; it += ngw) {
    int r = it;
    if (r < I_IN) { transpose_item(a.in[3], INW, a.in[2], (bf16_t*)(ws + WS_WIN_T), DM, 0, scr, r / 96, r % 96, lane); continue; } r -= I_IN;
    const int which = r / I_SQ; r %= I_SQ; const int kb = r / 32, nb = r % 32;
    if (which == 0) { const float* g = (kb < 8) ? a.in[6] : (a.in[7] - 512); transpose_item(a.in[8], DM, g, (bf16_t*)(ws + WS_WOUT_T), DM, 0, scr, kb, nb, lane); }
    else if (which == 1) transpose_item(a.in[11], DM, a.in[9], (bf16_t*)(ws + WS_WXQ_T), DM, 0, scr, kb, nb, lane);
    else if (which == 2) transpose_item(a.in[12], DM, a.in[10], (bf16_t*)(ws + WS_WXKV_T), DM, 0, scr, kb, nb, lane);
    else if (which == 3) transpose_item(a.in[13], DM, a.in[10], (bf16_t*)(ws + WS_WXKV_T), DM, 1024, scr, kb, nb, lane);
    else if (which == 4) transpose_item(a.in[14], DM, nullptr, (bf16_t*)(ws + WS_WXO_T), DM, 0, scr, kb, nb, lane);
    else transpose_item(a.in[16], DM, a.in[15], (bf16_t*)(ws + WS_WPQ_T), DM, 0, scr, kb, nb, lane);
  }
  for (int it = gw; it < NEXP; it += ngw) {
    const int hi = lane >> 5, l32 = lane & 31; const int r = 2 * it + hi;
    const int tb = r >= NEXP, e = r - tb * NEXP;
    const f32x4* src = (const f32x4*)(a.in[19 + tb] + (size_t)e * DM) + 8 * l32;
    v16f xa, xb; float am = 0.f;
#pragma unroll
    for (int k = 0; k < 4; ++k) { const f32x4 p = src[k], q = src[4 + k];
      xa[2 * k] = p.x; xb[2 * k] = p.y; xa[2 * k + 1] = p.z; xb[2 * k + 1] = p.w; xa[8 + 2 * k] = q.x; xb[8 + 2 * k] = q.y; xa[8 + 2 * k + 1] = q.z; xb[8 + 2 * k + 1] = q.w;
      am = fmaxf(am, fmaxf(fmaxf(fabsf(p.x), fabsf(p.y)), fmaxf(fabsf(p.z), fabsf(p.w)))); am = fmaxf(am, fmaxf(fmaxf(fabsf(q.x), fabsf(q.y)), fmaxf(fabsf(q.z), fabsf(q.w)))); }
#pragma unroll
    for (int o = 1; o < 32; o <<= 1) am = fmaxf(am, __shfl_xor(am, o));
    const float sc = am > 0.f ? 7.0f / am : 1.f;
    xa = xa * sc; xb = xb * sc;
    const v6u w = __builtin_amdgcn_cvt_scalef32_2xpk16_fp6_f32(xa, xb, 1.0f);
    u32x2* dst = tb ? (u32x2*)(ws + WS_EXU + (size_t)(l32 >> 2) * (NEXP * 128) + (size_t)e * 128 + 24 * (l32 & 3)) : (u32x2*)(ws + WS_EXD + (size_t)e * 768 + 24 * l32);
    dst[0] = (u32x2){w[0], w[1]}; dst[1] = (u32x2){w[2], w[3]}; dst[2] = (u32x2){w[4], w[5]};
    if (l32 == 0) ((float*)(ws + WS_ESC))[r] = am > 0.f ? am / 7.0f : 1.f;
  }
  for (int i = blockIdx.x * 512 + tid; i < 2 * 65536; i += gridDim.x * 512) ((bf16_t*)(ws + WS_SK))[i] = (bf16_t)f2bf(a.in[17 + (i >> 16)][i & 65535]);
  for (int r = gw; r < NMROWS; r += ngw) rms_row_to_bf16(a.in[1] + (size_t)r * DM, (bf16_t*)(ws + WS_MEMN) + (size_t)r * DM, lane);
  __syncthreads();
  float* wf = (float*)(lds + 69632);
  for (int k = tid; k < DM; k += 512) {
    const float g = a.in[2][k]; const f32x4* wp = (const f32x4*)(a.in[3] + (size_t)k * INW + NQKV);
    const f32x4 p = wp[0], q = wp[1];
    wf[k] = p.x * g; wf[1024 + k] = p.y * g; wf[2048 + k] = p.z * g; wf[3072 + k] = p.w * g; wf[4096 + k] = q.x * g; wf[5120 + k] = q.y * g; wf[6144 + k] = q.z * g; wf[7168 + k] = q.w * g;
  }
  __syncthreads();
  float* flog = (float*)(ws + WS_FLOG);
  for (int r = gw; r < NT; r += ngw) {
    const f32x4* xr = (const f32x4*)(a.in[0] + (size_t)r * DM) + lane;
    f32x4 v[4]; float s = 0.f; float fa[8];
#pragma unroll
    for (int j = 0; j < 8; ++j) fa[j] = 0.f;
#pragma unroll
    for (int j = 0; j < 4; ++j) {
      v[j] = xr[64 * j]; s += (v[j].x * v[j].x + v[j].y * v[j].y) + (v[j].z * v[j].z + v[j].w * v[j].w);
#pragma unroll
      for (int jj = 0; jj < 8; ++jj) { const f32x4 w4 = *(const f32x4*)(wf + jj * 1024 + 256 * j + 4 * lane); fa[jj] += (v[j].x * w4.x + v[j].y * w4.y) + (v[j].z * w4.z + v[j].w * w4.w); }
    }
    const float rstd = rsqrtf(wave_sum(s) * (1.f / DM) + EPS);
    float mine = 0.f;
#pragma unroll
    for (int j = 0; j < 8; ++j) { const float t = wave_sum(fa[j]); if (lane == j) mine = t; }
    if (lane < 8) {
      const float z = mine * rstd + a.in[4][lane];
      flog[(size_t)r * 8 + lane] = fminf(z, 0.f) - log1pf(expf(-fabsf(z)));
    }
    u32x2* o = (u32x2*)((bf16_t*)(ws + WS_HB) + (size_t)r * DM) + lane;
#pragma unroll
    for (int j = 0; j < 4; ++j) { u32x2 w; w.x = pk2(v[j].x * rstd, v[j].y * rstd); w.y = pk2(v[j].z * rstd, v[j].w * rstd); o[64 * j] = w; }
  }
}

template <class Epi>
__device__ __forceinline__ void gemm_naive(const bf16_t* A, int lda, const bf16_t* Bt, int ldb, int M, int N, int K, const Epi& E, int gw, int ngw, int lane) {
  const int fr = lane & 15, fq = lane >> 4;
  const int tn = N / 64, ntile = (M / 64) * tn;
  for (int tile = gw; tile < ntile; tile += ngw) {
    const int pm = tile / tn, pn = tile % tn;
    f32x4 acc[4][4];
#pragma unroll
    for (int m = 0; m < 4; ++m)
#pragma unroll
      for (int n = 0; n < 4; ++n) acc[m][n] = (f32x4){0.f, 0.f, 0.f, 0.f};
    const bf16_t* Ap = A + (size_t)(pm * 64 + fr) * lda + fq * 8;
    const bf16_t* Bp = Bt + (size_t)(pn * 64 + fr) * ldb + fq * 8;
    for (int k0 = 0; k0 < K; k0 += 32) {
      bf16x8 af[4], bfr[4];
#pragma unroll
      for (int m = 0; m < 4; ++m) af[m] = *(const bf16x8*)(Ap + (size_t)m * 16 * lda + k0);
#pragma unroll
      for (int n = 0; n < 4; ++n) bfr[n] = *(const bf16x8*)(Bp + (size_t)n * 16 * ldb + k0);
#pragma unroll
      for (int m = 0; m < 4; ++m)
#pragma unroll
        for (int n = 0; n < 4; ++n) acc[m][n] = __builtin_amdgcn_mfma_f32_16x16x32_bf16(bfr[n], af[m], acc[m][n], 0, 0, 0);
    }
#pragma unroll
    for (int m = 0; m < 4; ++m)
#pragma unroll
      for (int n = 0; n < 4; ++n) E.store(pm * 64 + m * 16 + fr, pn * 64 + n * 16 + 4 * fq, acc[m][n]);
  }
}

struct EpiBf16 { bf16_t* O; int ldo;
  __device__ __forceinline__ void store8(int row, int col, f32x4 a, f32x4 b) const { u32x4 w; w.x = pk2(a.x, a.y); w.y = pk2(a.z, a.w); w.z = pk2(b.x, b.y); w.w = pk2(b.z, b.w); *(u32x4*)(O + (size_t)row * ldo + col) = w; }
  __device__ __forceinline__ void store(int row, int col, f32x4 v) const { u32x2 w; w.x = pk2(v.x, v.y); w.y = pk2(v.z, v.w); *(u32x2*)(O + (size_t)row * ldo + col) = w; } };
struct EpiQKV { bf16_t* O;
  __device__ __forceinline__ void store8(int row, int col, f32x4 a, f32x4 b) const { const float sc = (col < 512 || (col >= 1536 && col < 2048)) ? 0.18033688011112042f : 1.f;
    u32x4 w; w.x = pk2(a.x * sc, a.y * sc); w.y = pk2(a.z * sc, a.w * sc); w.z = pk2(b.x * sc, b.y * sc); w.w = pk2(b.z * sc, b.w * sc); *(u32x4*)(O + (size_t)row * NQKV + col) = w; }
  __device__ __forceinline__ void store(int row, int col, f32x4 v) const { const float sc = (col < 512 || (col >= 1536 && col < 2048)) ? 0.18033688011112042f : 1.f;
    u32x2 w; w.x = pk2(v.x * sc, v.y * sc); w.y = pk2(v.z * sc, v.w * sc); *(u32x2*)(O + (size_t)row * NQKV + col) = w; } };
struct EpiBf16S { bf16_t* O; int ldo; const float* ss;
  __device__ __forceinline__ void store8(int row, int col, f32x4 a, f32x4 b) const { const float r = rsqrtf(ss[row] * (1.f / DM) + EPS);
    u32x4 w; w.x = pk2(a.x * r, a.y * r); w.y = pk2(a.z * r, a.w * r); w.z = pk2(b.x * r, b.y * r); w.w = pk2(b.z * r, b.w * r); *(u32x4*)(O + (size_t)row * ldo + col) = w; }
  __device__ __forceinline__ void store(int row, int col, f32x4 v) const { const float r = rsqrtf(ss[row] * (1.f / DM) + EPS); u32x2 w; w.x = pk2(v.x * r, v.y * r); w.y = pk2(v.z * r, v.w * r); *(u32x2*)(O + (size_t)row * ldo + col) = w; } };
struct EpiF32S { float* O; int ldo; const float* ss;
  __device__ __forceinline__ void store(int row, int col, f32x4 v) const { const float r = rsqrtf(ss[row] * (1.f / DM) + EPS); *(f32x4*)(O + (size_t)row * ldo + col) = v * r; } };
struct EpiF32 { float* O; int ldo;
  __device__ __forceinline__ void store(int row, int col, f32x4 v) const { *(f32x4*)(O + (size_t)row * ldo + col) = v; } };
struct EpiResid { const float* base; float* out;
  __device__ __forceinline__ void store(int row, int col, f32x4 v) const { const size_t o = (size_t)row * DM + col; const f32x4 b = *(const f32x4*)(base + o); *(f32x4*)(out + o) = b + v; } };
struct EpiKV { bf16_t* KX; bf16_t* VXT;
  __device__ __forceinline__ void store(int row, int col, f32x4 v) const {
    if (col < 1024) { u32x2 w; w.x = pk2(v.x, v.y); w.y = pk2(v.z, v.w); *(u32x2*)(KX + (size_t)row * DM + col) = w; }
    else { const int b = row >> 8, m = row & 255;
#pragma unroll
      for (int r = 0; r < 4; ++r) { const int d = col - 1024 + r; VXT[((size_t)(b * 4 + (d >> 8)) * 256 + (d & 255)) * 256 + m] = (bf16_t)f2bf(v[r]); } } } };

__device__ __forceinline__ void phase_scan(const Args& a, int gw, int ngw, int lane, int tid) {
  unsigned char* ws = a.ws;
  const float* flog = (const float*)(ws + WS_FLOG); float* cum = (float*)(ws + WS_CUM);
  for (int p = gw; p < 64; p += ngw) {
    const int b = p >> 3, j = p & 7;
    const float* src = flog + ((size_t)b * SEQ + lane * 64) * 8 + j;
    float tot = 0.f;
    for (int i = 0; i < 64; ++i) tot += src[i * 8];
    float inc = tot;
#pragma unroll
    for (int o = 1; o < 64; o <<= 1) { const float t = __shfl_up(inc, o); if (lane >= o) inc += t; }
    float run = inc - tot;
    float* dst = cum + ((size_t)(b * 8 + j)) * SEQ + lane * 64;
    for (int i = 0; i < 64; ++i) { run += src[i * 8]; dst[i] = run * 1.4426950408889634f; }
  }
  const bf16_t* qkv = (const bf16_t*)(ws + WS_QKV); float* kmean = (float*)(ws + WS_KMEAN);
  {
    unsigned* kn2 = (unsigned*)(ws + 256);
    for (int item = gw; item < 64 * 16; item += ngw) {
      const int bh = item >> 4, ch = item & 15, b = bh >> 3, h = bh & 7; float m = 0.f;
      for (int rr = 0; rr < 4; ++rr) {
        const u32x4* kp = (const u32x4*)(qkv + ((size_t)b * SEQ + ch * 256 + lane * 4 + rr) * NQKV + 2048 + h * 64); float s = 0.f;
#pragma unroll
        for (int c = 0; c < 8; ++c) { float f[8]; unpack8(kp[c], f);
#pragma unroll
          for (int i = 0; i < 8; ++i) s += f[i] * f[i]; }
        m = fmaxf(m, s);
      }
#pragma unroll
      for (int o = 1; o < 64; o <<= 1) m = fmaxf(m, __shfl_xor(m, o));
      if (lane == 0) atomicMax(kn2 + bh, __float_as_uint(m));
    }
  }
  const int gt = blockIdx.x * 512 + tid, ngt = gridDim.x * 512;
  for (int o = gt; o < NB * 16 * 512; o += ngt) {
    const int c = o & 511, blk = (o >> 9) & 15, b = o >> 13;
    const bf16_t* p = qkv + ((size_t)b * SEQ + blk * 256) * NQKV + 512 + c;
    float s = 0.f;
    for (int r = 0; r < 256; ++r) s += bf2f(p[(size_t)r * NQKV]);
    kmean[o] = s * (1.f / 256.f);
  }
}

template <int MODE>
__device__ __forceinline__ void attn_naive_unit(const Args& a, unsigned char* lds, int b, int h, int sb, int tid) {
  unsigned char* ws = a.ws;
  const bf16_t* qkv = (const bf16_t*)(ws + WS_QKV);
  const int qoff = MODE ? 1536 : 0, koff = qoff + 512, voff = qoff + 1024;
  float* Ks = (float*)lds; float* Vs = Ks + 64 * 64; float* ck = Vs + 64 * 64; float* biasd = ck + 64;
  const int t = sb * 512 + tid; const size_t row = (size_t)b * SEQ + t;
  float q[64], o[64];
  {
    const u32x4* qp = (const u32x4*)(qkv + row * NQKV + qoff + h * 64);
#pragma unroll
    for (int c = 0; c < 8; ++c) { const u32x4 w = qp[c]; unpack8(w, q + 8 * c); }
#pragma unroll
    for (int d = 0; d < 64; ++d) { q[d] *= 0.6931471805599453f; o[d] = 0.f; }
  }
  float m = -1e30f, l = 0.f;
  unsigned selmask = 0u; const int own = t >> 8;
  float cq = 0.f, bfar = 0.f;
  __syncthreads();
  if (MODE == 0) {
    if (tid < 128) biasd[tid] = a.in[5][T5_BUCKET[tid] * 8 + h];
    bfar = a.in[5][31 * 8 + h];
    const float* km = (const float*)(ws + WS_KMEAN) + ((size_t)b * 16) * 512 + h * 64;
    float v0 = -3e38f, v1 = -3e38f, v2 = -3e38f; int i0 = -1, i1 = -1, i2 = -1;
    for (int n = 0; n < 2 * sb + 1; ++n) {
      if (n < own) {
        const float* kp = km + (size_t)n * 512; float s = 0.f;
#pragma unroll
        for (int d = 0; d < 64; ++d) s += q[d] * kp[d];
        if (s > v0) { v2 = v1; i2 = i1; v1 = v0; i1 = i0; v0 = s; i0 = n; }
        else if (s > v1) { v2 = v1; i2 = i1; v1 = s; i1 = n; }
        else if (s > v2) { v2 = s; i2 = n; }
      }
    }
    if (i0 >= 0) selmask |= 1u << i0;
    if (i1 >= 0) selmask |= 1u << i1;
    if (i2 >= 0) selmask |= 1u << i2;
  } else {
    cq = ((const float*)(ws + WS_CUM))[((size_t)(b * 8 + h)) * SEQ + t];
  }
  const int ntile = 8 * (sb + 1);
  for (int kt = 0; kt < ntile; ++kt) {
    __syncthreads();
    {
      const int r = tid >> 3, ch = tid & 7;
      const bf16_t* kp = qkv + ((size_t)b * SEQ + kt * 64 + r) * NQKV + h * 64 + ch * 8;
      const u32x4 kw = *(const u32x4*)(kp + koff), vw = *(const u32x4*)(kp + voff);
      unpack8(kw, Ks + r * 64 + ch * 8); unpack8(vw, Vs + r * 64 + ch * 8);
      if (MODE == 1 && tid < 64) ck[tid] = ((const float*)(ws + WS_CUM))[((size_t)(b * 8 + h)) * SEQ + kt * 64 + tid];
    }
    __syncthreads();
    const int kb = kt >> 2;
    bool act;
    if (MODE == 0) act = (kb == own) || (kb < own && ((selmask >> kb) & 1u));
    else act = (kt * 64 <= t);
    if (act) {
      for (int jj = 0; jj < 64; ++jj) {
        const int sp = kt * 64 + jj;
        if (sp > t) break;
        const f32x4* kr = (const f32x4*)(Ks + jj * 64);
        float s = 0.f;
#pragma unroll
        for (int c = 0; c < 16; ++c) { const f32x4 kv = kr[c]; s += q[4 * c] * kv.x + q[4 * c + 1] * kv.y + q[4 * c + 2] * kv.z + q[4 * c + 3] * kv.w; }
        if (MODE == 0) { const int dist = t - sp; s += (dist < 128) ? biasd[dist] : bfar; }
        else s += (cq - ck[jj]) * 0.6931471805599453f;
        if (s > m) { const float f = __expf(m - s); l *= f;
#pragma unroll
          for (int d = 0; d < 64; ++d) o[d] *= f;
          m = s; }
        const float p = __expf(s - m); l += p;
        const f32x4* vr = (const f32x4*)(Vs + jj * 64);
#pragma unroll
        for (int c = 0; c < 16; ++c) { const f32x4 vv = vr[c]; o[4 * c] += p * vv.x; o[4 * c + 1] += p * vv.y; o[4 * c + 2] += p * vv.z; o[4 * c + 3] += p * vv.w; }
      }
    }
  }
  const float il = 1.f / l;
  u32x4* op = (u32x4*)((bf16_t*)(ws + WS_OAB) + row * DM + (MODE ? 512 : 0) + h * 64);
#pragma unroll
  for (int c = 0; c < 8; ++c) { u32x4 w; w.x = pk2(o[8 * c] * il, o[8 * c + 1] * il); w.y = pk2(o[8 * c + 2] * il, o[8 * c + 3] * il); w.z = pk2(o[8 * c + 4] * il, o[8 * c + 5] * il); w.w = pk2(o[8 * c + 6] * il, o[8 * c + 7] * il); op[c] = w; }
}

__device__ __forceinline__ void phase_attn(const Args& a, unsigned char* lds, int tid) {
  for (int u = blockIdx.x; u < 1024; u += gridDim.x) {
    const int sb = 7 - (u >> 7), r = u & 127, mode = r & 1, bh = r >> 1;
    if (mode == 0) attn_naive_unit<0>(a, lds, bh >> 3, bh & 7, sb, tid);
    else attn_naive_unit<1>(a, lds, bh >> 3, bh & 7, sb, tid);
  }
}

namespace att {
typedef float f32x16 __attribute__((ext_vector_type(16)));
typedef short s16x4 __attribute__((ext_vector_type(4)));
typedef short v4i16_t __attribute__((ext_vector_type(4)));
typedef __attribute__((address_space(3))) const char* lds_cptr;
typedef float f32x2_t __attribute__((ext_vector_type(2))); typedef __bf16 bf16x2_t __attribute__((ext_vector_type(2)));
constexpr int PITCH = NQKV;
constexpr float LOG2E = 1.4426950408889634f;
constexpr float C2 = 0.125f * LOG2E;
constexpr int L_K = 0, L_V = 16384, L_WSF = 32768, L_OST = 34816, L_C2 = 67584, L_KM = 83968, L_BT = 88064, L_MISC = 88704;
__device__ __forceinline__ int crow(int r, int hi) { return (r & 3) + 8 * (r >> 2) + 4 * hi; }
__device__ __forceinline__ unsigned cvtpk(float lo, float hi) { f32x2_t v = {lo, hi}; bf16x2_t b = __builtin_convertvector(v, bf16x2_t); return __builtin_bit_cast(unsigned, b); }
__device__ __forceinline__ s16x4 vtr(lds_cptr p) { return __builtin_bit_cast(s16x4, __builtin_amdgcn_ds_read_tr16_b64_v4i16((__attribute__((address_space(3))) v4i16_t*)p)); }
__device__ __forceinline__ float max3f(float a, float b, float c) { float r; asm("v_max3_f32 %0, %1, %2, %3" : "=v"(r) : "v"(a), "v"(b), "v"(c)); return r; }
__device__ __forceinline__ float xhalf_max(float m) { auto rr = __builtin_amdgcn_permlane32_swap(__float_as_uint(m), __float_as_uint(m), false, false); return fmaxf(__uint_as_float(rr[0]), __uint_as_float(rr[1])); }
__device__ __forceinline__ float xhalf_sum(float m) { auto rr = __builtin_amdgcn_permlane32_swap(__float_as_uint(m), __float_as_uint(m), false, false); return __uint_as_float(rr[0]) + __uint_as_float(rr[1]); }

template <int MODE>
__device__ __forceinline__ void unit(const Args& a, unsigned char* lds, int b, int h, int qb, int tid) {
  unsigned char* ws = a.ws;
  const int lane = tid & 63, r32 = lane & 31, hi = lane >> 5; const int wid = __builtin_amdgcn_readfirstlane(tid >> 6);
  const bf16_t* qkv = (const bf16_t*)(ws + WS_QKV);
  const int qoff = MODE ? 1536 : 0;
  const size_t rowbase = (size_t)b * SEQ; const int q0 = qb * 256;
  const bf16_t* Qw = qkv + (rowbase + q0 + wid * 32) * PITCH + qoff + h * 64;
  const bf16_t* Kh = qkv + rowbase * PITCH + qoff + 512 + h * 64;
  const bf16_t* Vh = qkv + rowbase * PITCH + qoff + 1024 + h * 64;
  float* wsf = (float*)(lds + L_WSF) + wid * 64;
  float* c2s = (float*)(lds + L_C2); float* kms = (float*)(lds + L_KM); float* bts = (float*)(lds + L_BT); unsigned* misc = (unsigned*)(lds + L_MISC);
  const int NTL = 4 * (qb + 1);
  __syncthreads();
  if (MODE == 0) {
    const float* km = (const float*)(ws + WS_KMEAN) + (size_t)b * 16 * 512 + h * 64;
    for (int i = tid; i < 16 * 64; i += 512) kms[i] = km[(size_t)(i >> 6) * 512 + (i & 63)];
    if (tid < 128) bts[tid] = a.in[5][T5_BUCKET[tid] * 8 + h] * LOG2E;
    if (tid == 128) bts[128] = a.in[5][31 * 8 + h] * LOG2E;
  } else {
    const float* cg = (const float*)(ws + WS_CUM) + (size_t)(b * 8 + h) * SEQ;
    for (int i = tid; i < 256 * (qb + 1); i += 512) c2s[i] = cg[i];
    if (tid == 0) misc[0] = 0u;
  }
  bf16x8 qr[4];
#pragma unroll
  for (int d0 = 0; d0 < 4; ++d0) qr[d0] = *(const bf16x8*)(Qw + (size_t)r32 * PITCH + d0 * 16 + hi * 8);
  __syncthreads();
  unsigned selmask = 0u; float cq2 = 0.f, far2 = 0.f, mhat = 0.f; int t0 = 0;
  if (MODE == 0) {
    far2 = bts[128];
    float v0 = -3e38f, v1 = -3e38f, v2 = -3e38f; int i0 = -1, i1 = -1, i2 = -1;
    for (int n = 0; n < qb; ++n) {
      float s = 0.f;
#pragma unroll
      for (int d0 = 0; d0 < 4; ++d0)
#pragma unroll
        for (int j = 0; j < 8; ++j) s += bf2f((unsigned short)qr[d0][j]) * kms[n * 64 + d0 * 16 + hi * 8 + j];
      s = xhalf_sum(s);
      if (s > v0) { v2 = v1; i2 = i1; v1 = v0; i1 = i0; v0 = s; i0 = n; }
      else if (s > v1) { v2 = v1; i2 = i1; v1 = s; i1 = n; }
      else if (s > v2) { v2 = s; i2 = n; }
    }
    if (i0 >= 0) selmask |= 1u << i0;
    if (i1 >= 0) selmask |= 1u << i1;
    if (i2 >= 0) selmask |= 1u << i2;
  } else {
    cq2 = c2s[q0 + wid * 32 + r32];
    float s = 0.f;
#pragma unroll
    for (int d0 = 0; d0 < 4; ++d0)
#pragma unroll
      for (int j = 0; j < 8; ++j) { const float f = bf2f((unsigned short)qr[d0][j]); s += f * f; }
    s = xhalf_sum(s);
    atomicMax(&misc[0], __float_as_uint(s));
    __syncthreads();
    const float kn2 = __uint_as_float(((const unsigned*)(ws + 256))[b * 8 + h]);
    const float qkb = sqrtf(__uint_as_float(misc[0]) * kn2) * 1.0001f + 1e-3f;
    mhat = -qkb;
    const int j = lane; bool skip = false;
    if (j < NTL) skip = (2.f * qkb + c2s[q0] - c2s[64 * j + 63]) < -150.f;
    t0 = __popcll(__ballot(skip));
    if (t0 > NTL - 1) t0 = NTL - 1;
  }
  const bf16_t* ksrc = Kh + (size_t)lane * PITCH + wid * 8;
  const bf16_t* vsrc = Vh + (size_t)(16 * (wid & 3) + (lane >> 2)) * PITCH + (wid >> 2) * 32 + (lane & 3) * 8;
  unsigned char* kdst = lds + L_K + wid * 1024 + lane * 16; unsigned char* vdst = lds + L_V + wid * 1024 + lane * 16;
  const lds_cptr lds3 = (lds_cptr)lds;
  const lds_cptr vp0 = lds3 + L_V + ((lane >> 4) & 1) * 32 + (lane & 3) * 8 + (4 * hi + ((lane & 15) >> 2)) * 64;
  u32x4 kreg = *(const u32x4*)(ksrc + (size_t)t0 * 64 * PITCH), vreg = *(const u32x4*)(vsrc + (size_t)t0 * 64 * PITCH);
  *(u32x4*)(kdst + (t0 & 1) * 8192) = kreg; *(u32x4*)(vdst + (t0 & 1) * 8192) = vreg;
  f32x16 o[2]; o[0] = f32x16{}; o[1] = f32x16{};
  f32x16 ol = f32x16{}, cm = f32x16{}; int cm_nb = -1;
  const int qrel = wid * 32 + r32, qpos = q0 + qrel;
  __syncthreads();
  for (int t = t0; t < NTL; ++t) {
    const int buf = (t & 1) * 8192;
    if (t + 1 < NTL) { kreg = *(const u32x4*)(ksrc + (size_t)(t + 1) * 64 * PITCH); vreg = *(const u32x4*)(vsrc + (size_t)(t + 1) * 64 * PITCH); }
    const int jb = t - (NTL - 4);
    const bool compute = !(jb >= 0 && 64 * jb > wid * 32 + 31);
    if (compute) {
      f32x16 p0, p1;
      bf16x8 kf[8];
      {
        const lds_cptr kb = lds3 + L_K + buf + hi * 1024 + r32 * 16;
#pragma unroll
        for (int d0 = 0; d0 < 4; ++d0) { kf[2 * d0] = *(const __attribute__((address_space(3))) bf16x8*)(kb + d0 * 2048); kf[2 * d0 + 1] = *(const __attribute__((address_space(3))) bf16x8*)(kb + d0 * 2048 + 512); }
      }
      __builtin_amdgcn_sched_barrier(0);
      if (MODE == 0) {
        const int nb = t >> 2;
        const bool near = (jb >= 0) || (t >= NTL - 6 && wid < 4);
        if (near) {
#pragma unroll
          for (int r = 0; r < 16; ++r) { const int d = qpos - (64 * t + crow(r, hi));
            p0[r] = bts[min(max(d, 0), 128)] - mhat; p1[r] = bts[min(max(d - 32, 0), 128)] - mhat; }
          if (jb < 0 && !((selmask >> nb) & 1u)) {
#pragma unroll
            for (int r = 0; r < 16; ++r) { p0[r] = -INFINITY; p1[r] = -INFINITY; }
          }
        } else {
          if (cm_nb != nb) {
            const float base = ((selmask >> nb) & 1u) ? far2 - mhat : -INFINITY;
#pragma unroll
            for (int r = 0; r < 16; ++r) cm[r] = base;
            cm_nb = nb;
          }
          p0 = cm; p1 = cm;
        }
      } else {
        const float cqm = cq2 - mhat;
#pragma unroll
        for (int g = 0; g < 4; ++g) {
          const f32x4 ca = *(const f32x4*)(c2s + 64 * t + 8 * g + 4 * hi), cb = *(const f32x4*)(c2s + 64 * t + 32 + 8 * g + 4 * hi);
#pragma unroll
          for (int i = 0; i < 4; ++i) { p0[4 * g + i] = cqm - ca[i]; p1[4 * g + i] = cqm - cb[i]; }
        }
      }
#pragma unroll
      for (int d0 = 0; d0 < 4; ++d0) {
        p0 = __builtin_amdgcn_mfma_f32_32x32x16_bf16(kf[2 * d0], qr[d0], p0, 0, 0, 0);
        p1 = __builtin_amdgcn_mfma_f32_32x32x16_bf16(kf[2 * d0 + 1], qr[d0], p1, 0, 0, 0);
      }
      if (jb >= 0) {
        asm volatile("" ::: "memory");
        const int kb0 = 64 * jb + 4 * hi;
#pragma unroll
        for (int r = 0; r < 16; ++r) { const int kv = kb0 + (r & 3) + 8 * (r >> 2); if (kv > qrel) p0[r] = -INFINITY; if (kv + 32 > qrel) p1[r] = -INFINITY; }
      }
      asm volatile("s_nop 15\n\ts_nop 7" : "+v"(p0), "+v"(p1));
      float rm, rm2;
      rm = max3f(p0[0], p0[1], p1[0]); rm2 = max3f(p0[2], p0[3], p1[1]); rm = max3f(rm, p1[2], p1[3]);
#pragma unroll
      for (int r = 4; r < 16; r += 4) { rm = max3f(rm, p0[r], p0[r + 1]); rm2 = max3f(rm2, p0[r + 2], p0[r + 3]); rm = max3f(rm, p1[r], p1[r + 1]); rm2 = max3f(rm2, p1[r + 2], p1[r + 3]); }
      rm = xhalf_max(fmaxf(rm, rm2));
      if (__any(rm > 6.0f)) {
        const float dl = fmaxf(rm, 0.f), alpha = __builtin_amdgcn_exp2f(-dl);
        mhat += dl; cm_nb = -1;
#pragma unroll
        for (int r = 0; r < 16; ++r) { p0[r] -= dl; p1[r] -= dl; }
        if (hi == 0) wsf[r32] = alpha;
        __builtin_amdgcn_wave_barrier();
#pragma unroll
        for (int r = 0; r < 16; ++r) { const float f = wsf[crow(r, hi)]; o[0][r] *= f; o[1][r] *= f; ol[r] *= f; }
        __builtin_amdgcn_wave_barrier();
      }
#pragma unroll
      for (int r = 0; r < 16; ++r) { p0[r] = __builtin_amdgcn_exp2f(p0[r]); p1[r] = __builtin_amdgcn_exp2f(p1[r]); }
      u32x4 pw0, pw1, pw2, pw3;
      pw0 = (u32x4){cvtpk(p0[0], p0[1]), cvtpk(p0[2], p0[3]), cvtpk(p0[4], p0[5]), cvtpk(p0[6], p0[7])};
      pw1 = (u32x4){cvtpk(p0[8], p0[9]), cvtpk(p0[10], p0[11]), cvtpk(p0[12], p0[13]), cvtpk(p0[14], p0[15])};
      pw2 = (u32x4){cvtpk(p1[0], p1[1]), cvtpk(p1[2], p1[3]), cvtpk(p1[4], p1[5]), cvtpk(p1[6], p1[7])};
      pw3 = (u32x4){cvtpk(p1[8], p1[9]), cvtpk(p1[10], p1[11]), cvtpk(p1[12], p1[13]), cvtpk(p1[14], p1[15])};
      {
        const bf16x8 ones = (bf16x8){0x3F80, 0x3F80, 0x3F80, 0x3F80, 0x3F80, 0x3F80, 0x3F80, 0x3F80};
        ol = __builtin_amdgcn_mfma_f32_32x32x16_bf16(__builtin_bit_cast(bf16x8, pw0), ones, ol, 0, 0, 0);
        ol = __builtin_amdgcn_mfma_f32_32x32x16_bf16(__builtin_bit_cast(bf16x8, pw1), ones, ol, 0, 0, 0);
        ol = __builtin_amdgcn_mfma_f32_32x32x16_bf16(__builtin_bit_cast(bf16x8, pw2), ones, ol, 0, 0, 0);
        ol = __builtin_amdgcn_mfma_f32_32x32x16_bf16(__builtin_bit_cast(bf16x8, pw3), ones, ol, 0, 0, 0);
      }
      const lds_cptr vp = vp0 + buf;
#pragma unroll
      for (int d0 = 0; d0 < 2; ++d0) {
#define ATT_VF(ks) ({ const s16x4 lo_ = vtr(vp + d0 * 4096 + (ks) * 1024), hi_ = vtr(vp + d0 * 4096 + (ks) * 1024 + 512); (bf16x8){lo_[0], lo_[1], lo_[2], lo_[3], hi_[0], hi_[1], hi_[2], hi_[3]}; })
        o[d0] = __builtin_amdgcn_mfma_f32_32x32x16_bf16(__builtin_bit_cast(bf16x8, pw0), ATT_VF(0), o[d0], 0, 0, 0);
        o[d0] = __builtin_amdgcn_mfma_f32_32x32x16_bf16(__builtin_bit_cast(bf16x8, pw1), ATT_VF(1), o[d0], 0, 0, 0);
        o[d0] = __builtin_amdgcn_mfma_f32_32x32x16_bf16(__builtin_bit_cast(bf16x8, pw2), ATT_VF(2), o[d0], 0, 0, 0);
        o[d0] = __builtin_amdgcn_mfma_f32_32x32x16_bf16(__builtin_bit_cast(bf16x8, pw3), ATT_VF(3), o[d0], 0, 0, 0);
#undef ATT_VF
      }
    }
    if (t + 1 < NTL) { *(u32x4*)(kdst + ((t + 1) & 1) * 8192) = kreg; *(u32x4*)(vdst + ((t + 1) & 1) * 8192) = vreg; }
    __syncthreads();
  }
  bf16_t* stg = (bf16_t*)(lds + L_OST) + wid * 2048;
#pragma unroll
  for (int r = 0; r < 16; ++r) { const int orow = crow(r, hi); const float rl = 1.f / ol[r];
    stg[orow * 64 + r32] = (bf16_t)f2bf(o[0][r] * rl); stg[orow * 64 + 32 + r32] = (bf16_t)f2bf(o[1][r] * rl); }
  __builtin_amdgcn_wave_barrier();
  bf16_t* Ow = (bf16_t*)(ws + WS_OAB) + (rowbase + q0 + wid * 32) * DM + (MODE ? 512 : 0) + h * 64;
#pragma unroll
  for (int i = 0; i < 4; ++i) { const int row = i * 8 + (lane >> 3), ch = lane & 7; const u32x4 v = *(const u32x4*)(stg + row * 64 + ch * 8); *(u32x4*)(Ow + (size_t)row * DM + ch * 8) = v; }
}
}

__device__ __forceinline__ void phase_attn2(const Args& a, unsigned char* lds, int tid) {
  unsigned* ctr = (unsigned*)(a.ws + 0);
  unsigned* slot = (unsigned*)(lds + att::L_MISC + 64);
  for (;;) {
    __syncthreads();
    if (tid == 0) slot[0] = atomicAdd(ctr, 1u);
    __syncthreads();
    const unsigned u = slot[0];
    if (u >= 2048u) break;
    const int qb = 15 - (int)(u >> 7), r = u & 127, mode = r & 1, bh = r >> 1;
    if (mode == 0) att::unit<0>(a, lds, bh >> 3, bh & 7, qb, tid);
    else att::unit<1>(a, lds, bh >> 3, bh & 7, qb, tid);
  }
}

__device__ __forceinline__ void phase_onorm(const Args& a, int gw, int ngw, int lane) {
  bf16_t* oab = (bf16_t*)(a.ws + WS_OAB);
  for (int r = gw; r < NT; r += ngw) {
    u32x4* p = (u32x4*)(oab + (size_t)r * DM) + 2 * lane;
    const u32x4 w0 = p[0], w1 = p[1]; float f[16]; unpack8(w0, f); unpack8(w1, f + 8);
    float s = 0.f;
#pragma unroll
    for (int i = 0; i < 16; ++i) s += f[i] * f[i];
#pragma unroll
    for (int o = 1; o < 32; o <<= 1) s += __shfl_xor(s, o);
    const float rstd = rsqrtf(s * (1.f / 512.f) + EPS);
    u32x4 o0, o1;
    o0.x = pk2(f[0] * rstd, f[1] * rstd); o0.y = pk2(f[2] * rstd, f[3] * rstd); o0.z = pk2(f[4] * rstd, f[5] * rstd); o0.w = pk2(f[6] * rstd, f[7] * rstd);
    o1.x = pk2(f[8] * rstd, f[9] * rstd); o1.y = pk2(f[10] * rstd, f[11] * rstd); o1.z = pk2(f[12] * rstd, f[13] * rstd); o1.w = pk2(f[14] * rstd, f[15] * rstd);
    p[0] = o0; p[1] = o1;
  }
}

__device__ __forceinline__ void phase_rms(const Args& a, int gw, int ngw, int lane) {
  for (int r = gw; r < NT; r += ngw) rms_row_to_bf16(a.out + (size_t)r * DM, (bf16_t*)(a.ws + WS_HB) + (size_t)r * DM, lane);
}

__device__ __forceinline__ void phase_xattn(const Args& a, unsigned char* lds, int gw, int ngw, int wave, int lane) {
  unsigned char* ws = a.ws;
  const bf16_t* qx = (const bf16_t*)(ws + WS_QX); const bf16_t* kx = (const bf16_t*)(ws + WS_KX); const bf16_t* vxt = (const bf16_t*)(ws + WS_VXT);
  bf16_t* ox = (bf16_t*)(ws + WS_OX);
  bf16_t* P = (bf16_t*)(lds + wave * 8192);
  const int fr = lane & 15, fq = lane >> 4;
  for (int u = gw; u < (NT / 16) * 4; u += ngw) {
    const int hd = u & 3, r0 = (u >> 2) * 16, b = r0 / SEQ;
    f32x4 acc[16];
#pragma unroll
    for (int i = 0; i < 16; ++i) acc[i] = (f32x4){0.f, 0.f, 0.f, 0.f};
    const bf16_t* Ap = qx + (size_t)(r0 + fr) * DM + hd * 256 + fq * 8;
    const bf16_t* Bp = kx + (size_t)(b * 256 + fr) * DM + hd * 256 + fq * 8;
    for (int ks = 0; ks < 8; ++ks) {
      const bf16x8 af = *(const bf16x8*)(Ap + ks * 32);
#pragma unroll
      for (int ct = 0; ct < 16; ++ct) { const bf16x8 bfr = *(const bf16x8*)(Bp + (size_t)ct * 16 * DM + ks * 32); acc[ct] = __builtin_amdgcn_mfma_f32_16x16x32_bf16(af, bfr, acc[ct], 0, 0, 0); }
    }
    float mx[4], sm[4];
#pragma unroll
    for (int r = 0; r < 4; ++r) { float m = acc[0][r];
#pragma unroll
      for (int ct = 1; ct < 16; ++ct) m = fmaxf(m, acc[ct][r]);
#pragma unroll
      for (int o = 1; o < 16; o <<= 1) m = fmaxf(m, __shfl_xor(m, o));
      mx[r] = m; sm[r] = 0.f; }
#pragma unroll
    for (int ct = 0; ct < 16; ++ct)
#pragma unroll
      for (int r = 0; r < 4; ++r) { const float p = __expf((acc[ct][r] - mx[r]) * 0.0625f); acc[ct][r] = p; sm[r] += p; }
#pragma unroll
    for (int r = 0; r < 4; ++r) {
#pragma unroll
      for (int o = 1; o < 16; o <<= 1) sm[r] += __shfl_xor(sm[r], o);
      sm[r] = 1.f / sm[r]; }
    __builtin_amdgcn_wave_barrier();
#pragma unroll
    for (int ct = 0; ct < 16; ++ct)
#pragma unroll
      for (int r = 0; r < 4; ++r) P[(4 * fq + r) * 256 + ct * 16 + fr] = (bf16_t)f2bf(acc[ct][r] * sm[r]);
    __builtin_amdgcn_wave_barrier();
    asm volatile("s_waitcnt lgkmcnt(0)" ::: "memory");
#pragma unroll
    for (int i = 0; i < 16; ++i) acc[i] = (f32x4){0.f, 0.f, 0.f, 0.f};
    const bf16_t* Vp = vxt + ((size_t)(b * 4 + hd) * 256 + fr) * 256 + fq * 8;
    for (int ks = 0; ks < 8; ++ks) {
      const bf16x8 pf = *(const bf16x8*)(P + fr * 256 + ks * 32 + fq * 8);
#pragma unroll
      for (int dt = 0; dt < 16; ++dt) { const bf16x8 vf = *(const bf16x8*)(Vp + (size_t)dt * 16 * 256 + ks * 32); acc[dt] = __builtin_amdgcn_mfma_f32_16x16x32_bf16(pf, vf, acc[dt], 0, 0, 0); }
    }
#pragma unroll
    for (int dt = 0; dt < 16; ++dt)
#pragma unroll
      for (int r = 0; r < 4; ++r) ox[(size_t)(r0 + 4 * fq + r) * DM + hd * 256 + dt * 16 + fr] = (bf16_t)f2bf(acc[dt][r]);
    __builtin_amdgcn_wave_barrier();
  }
}

namespace xa {
using att::f32x16; using att::s16x4; using att::lds_cptr; using att::crow; using att::cvtpk; using att::vtr; using att::xhalf_max; using att::xhalf_sum;
constexpr int L_WSF = 65536;
__device__ __forceinline__ void unit(const Args& a, unsigned char* lds, int b, int hd, int qb, int tid) {
  unsigned char* ws = a.ws;
  const int lane = tid & 63, r32 = lane & 31, hi = lane >> 5; const int wid = __builtin_amdgcn_readfirstlane(tid >> 6);
  const bf16_t* qrow = (const bf16_t*)(ws + WS_QX) + ((size_t)b * SEQ + qb * 256 + wid * 32 + r32) * DM + hd * 256;
  const bf16_t* kvb = (const bf16_t*)(ws + WS_KX) + (size_t)b * 256 * 2048 + hd * 256;
  const bf16_t* ksrc = kvb + (size_t)lane * 2048 + wid * 8;
  const bf16_t* vsrc = kvb + 1024 + (size_t)(16 * (wid & 3) + (lane >> 2)) * 2048 + (wid >> 2) * 32 + (lane & 3) * 8;
  unsigned char* sdst = lds + wid * 1024 + lane * 16;
  const lds_cptr lds3 = (lds_cptr)lds;
  const lds_cptr kp0 = lds3 + hi * 1024 + r32 * 16;
  const lds_cptr vp0 = lds3 + ((lane >> 4) & 1) * 32 + (lane & 3) * 8 + (4 * hi + ((lane & 15) >> 2)) * 64;
  float* wsf = (float*)(lds + L_WSF) + wid * 64;
  u32x4 sreg[4];
#define XA_LOADK(c) do { _Pragma("unroll") for (int kt = 0; kt < 4; ++kt) sreg[kt] = *(const u32x4*)(ksrc + (size_t)kt * 64 * 2048 + (c) * 64); } while (0)
#define XA_LOADV(vt) do { _Pragma("unroll") for (int dq = 0; dq < 4; ++dq) sreg[dq] = *(const u32x4*)(vsrc + (size_t)(vt) * 64 * 2048 + dq * 64); } while (0)
#define XA_WRITE(buf) do { _Pragma("unroll") for (int i = 0; i < 4; ++i) *(u32x4*)(sdst + (buf) * 32768 + i * 8192) = sreg[i]; } while (0)
  __syncthreads();
  XA_LOADK(0); XA_WRITE(0);
  f32x16 acc[8];
#pragma unroll
  for (int j = 0; j < 8; ++j) acc[j] = f32x16{};
  __syncthreads();
#pragma unroll
  for (int c = 0; c < 4; ++c) {
    if (c < 3) XA_LOADK(c + 1); else XA_LOADV(0);
    bf16x8 qf[4];
#pragma unroll
    for (int d0 = 0; d0 < 4; ++d0) qf[d0] = *(const bf16x8*)(qrow + c * 64 + d0 * 16 + hi * 8);
    const lds_cptr kp = kp0 + (c & 1) * 32768;
#pragma unroll
    for (int d0 = 0; d0 < 4; ++d0)
#pragma unroll
      for (int j = 0; j < 8; ++j) {
        const bf16x8 kf = *(const __attribute__((address_space(3))) bf16x8*)(kp + (j >> 1) * 8192 + d0 * 2048 + (j & 1) * 512);
        acc[j] = __builtin_amdgcn_mfma_f32_32x32x16_bf16(kf, qf[d0], acc[j], 0, 0, 0);
      }
    XA_WRITE((c + 1) & 1);
    __syncthreads();
  }
  float m = acc[0][0];
#pragma unroll
  for (int j = 0; j < 8; ++j)
#pragma unroll
    for (int r = 0; r < 16; ++r) m = fmaxf(m, acc[j][r]);
  m = xhalf_max(m);
  constexpr float CS = 1.4426950408889634f / 16.f;
  float l = 0.f; u32x4 pw[16];
#pragma unroll
  for (int j = 0; j < 8; ++j) {
#pragma unroll
    for (int r = 0; r < 16; ++r) { const float p = __builtin_amdgcn_exp2f((acc[j][r] - m) * CS); acc[j][r] = p; l += p; }
    pw[2 * j] = (u32x4){cvtpk(acc[j][0], acc[j][1]), cvtpk(acc[j][2], acc[j][3]), cvtpk(acc[j][4], acc[j][5]), cvtpk(acc[j][6], acc[j][7])};
    pw[2 * j + 1] = (u32x4){cvtpk(acc[j][8], acc[j][9]), cvtpk(acc[j][10], acc[j][11]), cvtpk(acc[j][12], acc[j][13]), cvtpk(acc[j][14], acc[j][15])};
  }
  l = xhalf_sum(l);
#pragma unroll
  for (int j = 0; j < 8; ++j) acc[j] = f32x16{};
#pragma unroll
  for (int vt = 0; vt < 4; ++vt) {
    if (vt < 3) XA_LOADV(vt + 1);
    const lds_cptr vp = vp0 + (vt & 1) * 32768;
#pragma unroll
    for (int ks = 0; ks < 4; ++ks)
#pragma unroll
      for (int db = 0; db < 8; ++db) {
        const s16x4 lo_ = vtr(vp + (db >> 1) * 8192 + (db & 1) * 4096 + ks * 1024), hi_ = vtr(vp + (db >> 1) * 8192 + (db & 1) * 4096 + ks * 1024 + 512);
        const bf16x8 vf = (bf16x8){lo_[0], lo_[1], lo_[2], lo_[3], hi_[0], hi_[1], hi_[2], hi_[3]};
        acc[db] = __builtin_amdgcn_mfma_f32_32x32x16_bf16(__builtin_bit_cast(bf16x8, pw[4 * vt + ks]), vf, acc[db], 0, 0, 0);
      }
    if (vt < 3) XA_WRITE((vt + 1) & 1);
    __syncthreads();
  }
  if (hi == 0) wsf[r32] = l;
  __builtin_amdgcn_wave_barrier();
  float rl[16];
#pragma unroll
  for (int r = 0; r < 16; ++r) rl[r] = 1.f / wsf[crow(r, hi)];
  bf16_t* stg = (bf16_t*)(lds + wid * 8192);
  bf16_t* orow0 = (bf16_t*)(ws + WS_OX) + ((size_t)b * SEQ + qb * 256 + wid * 32) * DM + hd * 256;
#pragma unroll
  for (int hf = 0; hf < 2; ++hf) {
#pragma unroll
    for (int db = 0; db < 4; ++db)
#pragma unroll
      for (int r = 0; r < 16; ++r) stg[crow(r, hi) * 128 + db * 32 + r32] = (bf16_t)f2bf(acc[hf * 4 + db][r] * rl[r]);
    __builtin_amdgcn_wave_barrier();
#pragma unroll
    for (int i = 0; i < 8; ++i) { const int row = i * 4 + (lane >> 4), ch = lane & 15; const u32x4 v = *(const u32x4*)(stg + row * 128 + ch * 8); *(u32x4*)(orow0 + (size_t)row * DM + hf * 128 + ch * 8) = v; }
    __builtin_amdgcn_wave_barrier();
  }
#undef XA_LOADK
#undef XA_LOADV
#undef XA_WRITE
}
}

__device__ __forceinline__ void phase_xattn2(const Args& a, unsigned char* lds, int tid) {
  for (int u = blockIdx.x; u < NB * 4 * 16; u += gridDim.x) { const int qb = u & 15, hd = (u >> 4) & 3, b = u >> 6; xa::unit(a, lds, b, hd, qb, tid); }
}

__device__ __forceinline__ unsigned fkey(float s, unsigned idx, unsigned mask) { unsigned u = __float_as_uint(s); u ^= (unsigned)((int)u >> 31) | 0x80000000u; return (u & ~mask) | (mask - idx); }
__device__ __forceinline__ float keyval(unsigned k, unsigned mask) { unsigned u = k & ~mask; u = (u & 0x80000000u) ? (u ^ 0x80000000u) : ~u; return __uint_as_float(u); }
#define KEY_INSERT(KA, key_) do { unsigned k__ = (key_); \
  _Pragma("unroll") for (int s_ = 0; s_ < 16; ++s_) { const unsigned hi_ = max(k__, KA[s_]); k__ = min(k__, KA[s_]); KA[s_] = hi_; } } while (0)

__device__ __forceinline__ void phase_topk(const Args& a, unsigned char* lds, int tid) {
  unsigned char* ws = a.ws;
  const float* pq = (const float*)(ws + WS_PQ);
  int* eidx = (int*)(ws + WS_EIDX); float* gate = (float*)(ws + WS_GATE);
  float* K1 = (float*)lds; float* K2 = K1 + 128 * 64; unsigned* KL = (unsigned*)(lds + 65536);
  for (int u = blockIdx.x; u < 8 * (NT / 512); u += gridDim.x) {
    const int h = u & 7, t = (u >> 3) * 512 + tid;
    __syncthreads();
    for (int i = tid; i < 128 * 64 / 4; i += 512) { ((f32x4*)K1)[i] = ((const f32x4*)(a.in[17] + (size_t)h * 8192))[i]; ((f32x4*)K2)[i] = ((const f32x4*)(a.in[18] + (size_t)h * 8192))[i]; }
    __syncthreads();
    unsigned ka[16], kb[16], kc[16];
#pragma unroll
    for (int k = 0; k < 16; ++k) { ka[k] = 0u; kb[k] = 0u; kc[k] = 0u; }
    float q[64];
    const f32x4* qp = (const f32x4*)(pq + (size_t)t * DM + h * 128);
#pragma unroll
    for (int c = 0; c < 16; ++c) { const f32x4 w = qp[c]; q[4 * c] = w.x; q[4 * c + 1] = w.y; q[4 * c + 2] = w.z; q[4 * c + 3] = w.w; }
    for (int n = 0; n < 128; ++n) {
      const f32x4* kr = (const f32x4*)(K1 + n * 64); float s = 0.f;
#pragma unroll
      for (int c = 0; c < 16; ++c) { const f32x4 kv = kr[c]; s += q[4 * c] * kv.x + q[4 * c + 1] * kv.y + q[4 * c + 2] * kv.z + q[4 * c + 3] * kv.w; }
      KEY_INSERT(ka, fkey(s, (unsigned)n, 127u));
    }
#pragma unroll
    for (int c = 0; c < 16; ++c) { const f32x4 w = qp[16 + c]; q[4 * c] = w.x; q[4 * c + 1] = w.y; q[4 * c + 2] = w.z; q[4 * c + 3] = w.w; }
    for (int n = 0; n < 128; ++n) {
      const f32x4* kr = (const f32x4*)(K2 + n * 64); float s = 0.f;
#pragma unroll
      for (int c = 0; c < 16; ++c) { const f32x4 kv = kr[c]; s += q[4 * c] * kv.x + q[4 * c + 1] * kv.y + q[4 * c + 2] * kv.z + q[4 * c + 3] * kv.w; }
      KEY_INSERT(kb, fkey(s, (unsigned)n, 127u));
    }
#pragma unroll
    for (int x = 0; x < 16; ++x)
#pragma unroll
      for (int y = 0; y < 16; ++y)
        if ((x + 1) * (y + 1) <= 16) { KEY_INSERT(kc, fkey(keyval(ka[x], 127u) + keyval(kb[y], 127u), (unsigned)(x * 16 + y), 255u)); }
#pragma unroll
    for (int k = 0; k < 16; ++k) { KL[k * 512 + tid] = ka[k]; KL[(16 + k) * 512 + tid] = kb[k]; }
    float val[16]; int id[16]; float sum = 0.f;
#pragma unroll
    for (int k = 0; k < 16; ++k) {
      const unsigned flat = 255u - (kc[k] & 255u);
      const unsigned k1 = KL[(flat >> 4) * 512 + tid], k2 = KL[(16 + (flat & 15u)) * 512 + tid];
      val[k] = keyval(k1, 127u) + keyval(k2, 127u);
      id[k] = (int)((127u - (k1 & 127u)) * 128u + (127u - (k2 & 127u)));
    }
    const float vmax = val[0];
#pragma unroll
    for (int k = 0; k < 16; ++k) { val[k] = __expf(val[k] - vmax); sum += val[k]; }
    const float inv = 1.f / sum;
    int* ep = eidx + (size_t)t * 128 + h * 16; float* gp = gate + (size_t)t * 128 + h * 16;
#pragma unroll
    for (int k = 0; k < 16; ++k) { ep[k] = id[k]; gp[k] = val[k] * inv; }
  }
}


namespace tk {
typedef float f32x16 __attribute__((ext_vector_type(16)));
__device__ __forceinline__ void ce(unsigned& a, unsigned& b) { const unsigned h = max(a, b), l = min(a, b); a = h; b = l; }
__device__ __forceinline__ void sort16(unsigned (&v)[16]) {
#pragma unroll
  for (int k = 2; k <= 16; k <<= 1)
#pragma unroll
    for (int j = k >> 1; j > 0; j >>= 1)
#pragma unroll
      for (int i = 0; i < 16; ++i) { const int l = i ^ j; if (l > i) { if ((i & k) == 0) ce(v[i], v[l]); else ce(v[l], v[i]); } }
}
__device__ __forceinline__ void topmerge(unsigned (&a)[16], const unsigned (&b)[16]) {
#pragma unroll
  for (int i = 0; i < 16; ++i) a[i] = max(a[i], b[15 - i]);
#pragma unroll
  for (int j = 8; j > 0; j >>= 1)
#pragma unroll
    for (int i = 0; i < 16; ++i) { const int l = i ^ j; if (l > i) ce(a[i], a[l]); }
}
__device__ __forceinline__ unsigned xswap(unsigned v, int hi) { auto rr = __builtin_amdgcn_permlane32_swap(v, v, false, false); return hi ? rr[0] : rr[1]; }
__device__ __forceinline__ void half_list(unsigned (&L)[16], const bf16_t* skh, const bf16_t* qrow, int r32, int hi) {
  f32x16 acc[4];
#pragma unroll
  for (int i = 0; i < 4; ++i) acc[i] = f32x16{};
#pragma unroll
  for (int ks = 0; ks < 4; ++ks) {
    const bf16x8 qf = *(const bf16x8*)(qrow + ks * 16 + hi * 8);
#pragma unroll
    for (int tl = 0; tl < 4; ++tl) { const bf16x8 kf = *(const bf16x8*)(skh + (size_t)(tl * 32 + r32) * 64 + ks * 16 + hi * 8); acc[tl] = __builtin_amdgcn_mfma_f32_32x32x16_bf16(kf, qf, acc[tl], 0, 0, 0); }
  }
  unsigned g[4][16];
#pragma unroll
  for (int tl = 0; tl < 4; ++tl)
#pragma unroll
    for (int r = 0; r < 16; ++r) g[tl][r] = fkey(acc[tl][r], (unsigned)(32 * tl + (r & 3) + 8 * (r >> 2) + 4 * hi), 127u);
  sort16(g[0]); sort16(g[1]); sort16(g[2]); sort16(g[3]);
  topmerge(g[0], g[1]); topmerge(g[2], g[3]); topmerge(g[0], g[2]);
  unsigned p[16];
#pragma unroll
  for (int k = 0; k < 16; ++k) p[k] = xswap(g[0][k], hi);
  topmerge(g[0], p);
#pragma unroll
  for (int k = 0; k < 16; ++k) L[k] = g[0][k];
}
}

__device__ __forceinline__ void phase_topk2(const Args& a, unsigned char* lds, int wave, int lane) {
  unsigned char* ws = a.ws;
  const bf16_t* pq = (const bf16_t*)(ws + WS_PQ); const bf16_t* sk = (const bf16_t*)(ws + WS_SK);
  int* eidx = (int*)(ws + WS_EIDX); float* gate = (float*)(ws + WS_GATE);
  const int r32 = lane & 31, hi = lane >> 5, h = wave;
  unsigned* KL = (unsigned*)(lds + wave * 4096);
  for (int tt = blockIdx.x; tt < NT / 32; tt += gridDim.x) {
    const int t = tt * 32 + r32;
    unsigned ka[16], kb[16], kc[16];
    tk::half_list(ka, sk + (size_t)(0 * 8 + h) * 8192, pq + (size_t)t * DM + h * 128, r32, hi);
    tk::half_list(kb, sk + (size_t)(1 * 8 + h) * 8192, pq + (size_t)t * DM + h * 128 + 64, r32, hi);
    float va[16], vb[16];
#pragma unroll
    for (int k = 0; k < 16; ++k) { va[k] = keyval(ka[k], 127u); vb[k] = keyval(kb[k], 127u); }
#pragma unroll
    for (int y = 0; y < 16; ++y) kc[y] = hi ? 0u : fkey(va[0] + vb[y], (unsigned)y, 255u);
#define TK_CAND(xa, ya, xb, yb) do { const unsigned kA_ = fkey(va[xa] + vb[ya], (unsigned)((xa) * 16 + (ya)), 255u), kB_ = fkey(va[xb] + vb[yb], (unsigned)((xb) * 16 + (yb)), 255u); KEY_INSERT(kc, hi ? kB_ : kA_); } while (0)
    TK_CAND(1, 0, 1, 1);
    TK_CAND(1, 2, 1, 3);
    TK_CAND(1, 4, 1, 5);
    TK_CAND(1, 6, 1, 7);
    TK_CAND(2, 0, 2, 1);
    TK_CAND(2, 2, 2, 3);
    TK_CAND(2, 4, 3, 0);
    TK_CAND(3, 1, 3, 2);
    TK_CAND(3, 3, 4, 0);
    TK_CAND(4, 1, 4, 2);
    TK_CAND(5, 0, 5, 1);
    TK_CAND(6, 0, 6, 1);
    TK_CAND(7, 0, 7, 1);
    TK_CAND(8, 0, 9, 0);
    TK_CAND(10, 0, 11, 0);
    TK_CAND(12, 0, 13, 0);
    TK_CAND(14, 0, 15, 0);
#undef TK_CAND
    { unsigned p[16];
#pragma unroll
      for (int k = 0; k < 16; ++k) p[k] = tk::xswap(kc[k], hi);
      tk::topmerge(kc, p); }
    if (hi == 0) {
#pragma unroll
      for (int k = 0; k < 16; ++k) { KL[k * 32 + r32] = ka[k]; KL[(16 + k) * 32 + r32] = kb[k]; }
    }
    __builtin_amdgcn_wave_barrier();
    const float vmax = va[0] + vb[0];
    float pv[8]; int id[8]; float s = 0.f;
#pragma unroll
    for (int j = 0; j < 8; ++j) {
      unsigned klo_ = kc[j], khi_ = kc[8 + j]; asm volatile("" : "+v"(klo_), "+v"(khi_));
      const unsigned key = hi ? khi_ : klo_;
      const unsigned flat = 255u - (key & 255u);
      const unsigned k1 = KL[(flat >> 4) * 32 + r32], k2 = KL[(16 + (flat & 15u)) * 32 + r32];
      pv[j] = __expf(keyval(k1, 127u) + keyval(k2, 127u) - vmax); s += pv[j];
      id[j] = (int)((127u - (k1 & 127u)) * 128u + (127u - (k2 & 127u)));
    }
    __builtin_amdgcn_wave_barrier();
    const float inv = 1.f / att::xhalf_sum(s);
    u32x4* ep = (u32x4*)(eidx + (size_t)t * 128 + h * 16 + hi * 8); f32x4* gp = (f32x4*)(gate + (size_t)t * 128 + h * 16 + hi * 8);
    ep[0] = (u32x4){(unsigned)id[0], (unsigned)id[1], (unsigned)id[2], (unsigned)id[3]}; ep[1] = (u32x4){(unsigned)id[4], (unsigned)id[5], (unsigned)id[6], (unsigned)id[7]};
    gp[0] = (f32x4){pv[0] * inv, pv[1] * inv, pv[2] * inv, pv[3] * inv}; gp[1] = (f32x4){pv[4] * inv, pv[5] * inv, pv[6] * inv, pv[7] * inv};
  }
}

__device__ __forceinline__ float gelu_erf(float v) { return 0.5f * v * (1.f + erff(v * 0.70710678118654752f)); }

__device__ __forceinline__ float gelu_as(float v) {
  const float av = fabsf(v), t = __builtin_amdgcn_rcpf(av * 0.2316418882f + 1.0f);
  float q = t * 0.5307027145f + (-0.7265760135f); q = q * t + 0.7107068705f; q = q * t + (-0.142248368f); q = q * t + 0.127414796f; q = q * t;
  const float m = v * (q * __builtin_amdgcn_exp2f((v * v) * (-0.72134752044f)));
  return v < 0.f ? m : v - m;
}
#define PIN16(A, O) asm volatile("" : "+v"(A[O]), "+v"(A[O + 1]), "+v"(A[O + 2]), "+v"(A[O + 3]), "+v"(A[O + 4]), "+v"(A[O + 5]), "+v"(A[O + 6]), "+v"(A[O + 7]), "+v"(A[O + 8]), "+v"(A[O + 9]), "+v"(A[O + 10]), "+v"(A[O + 11]), "+v"(A[O + 12]), "+v"(A[O + 13]), "+v"(A[O + 14]), "+v"(A[O + 15]))
#define PIN6(R) asm volatile("" : "+v"(R[0].x), "+v"(R[0].y), "+v"(R[1].x), "+v"(R[1].y), "+v"(R[2].x), "+v"(R[2].y))
__device__ __forceinline__ void phase_exp_down(const Args& a, int gw, int ngw, int lane) {
  unsigned char* ws = a.ws;
  const int* eidx = (const int*)(ws + WS_EIDX); const float* gate = (const float*)(ws + WS_GATE); float* wout = (float*)(ws + WS_W);
  const unsigned char* exd = ws + WS_EXD; const float* esc = (const float*)(ws + WS_ESC);
  const int l32 = lane & 31, hi = lane >> 5;
  const bool b4 = (l32 & 16) != 0, b3 = (l32 & 8) != 0, b2 = (l32 & 4) != 0;
  for (int t = gw; t < NT; t += ngw) {
    const int e0 = eidx[(size_t)t * 128 + lane], e1 = eidx[(size_t)t * 128 + 64 + lane];
    const float sd0 = esc[e0], sd1 = esc[e1];
    const float gu0 = gate[(size_t)t * 128 + lane] * esc[NEXP + e0], gu1 = gate[(size_t)t * 128 + 64 + lane] * esc[NEXP + e1];
    const f32x4* xr = (const f32x4*)(a.out + (size_t)t * DM) + 8 * l32;
    float hg[32]; float s = 0.f;
#pragma unroll
    for (int k = 0; k < 8; ++k) { const f32x4 x = xr[k]; s += (x.x * x.x + x.y * x.y) + (x.z * x.z + x.w * x.w); hg[4 * k] = x.x; hg[4 * k + 1] = x.y; hg[4 * k + 2] = x.z; hg[4 * k + 3] = x.w; }
    s = half_sum32(s);
    const float rstd = rsqrtf(s * (1.f / DM) + EPS);
#pragma unroll
    for (int k = 0; k < 8; ++k) { const f32x4 g = ((const f32x4*)a.in[15])[8 * l32 + k]; hg[4 * k] *= rstd * g.x; hg[4 * k + 1] *= rstd * g.y; hg[4 * k + 2] *= rstd * g.z; hg[4 * k + 3] *= rstd * g.w; }
    float w0 = 0.f, w1 = 0.f;
    for (int e = 0; e < 128; e += 16) {
      u32x2 ur[8][3];
#pragma unroll
      for (int i = 0; i < 8; ++i) {
        const int pi = (e & 63) + 2 * i + hi; const int id = (e < 64) ? __shfl(e0, pi) : __shfl(e1, pi);
        const u32x2* up = (const u32x2*)(exd + (size_t)id * 768 + 24 * l32);
        ur[i][0] = up[0]; ur[i][1] = up[1]; ur[i][2] = up[2];
      }
      float d[8];
#pragma unroll
      for (int i = 0; i < 8; ++i) {
        const v32f u = __builtin_amdgcn_cvt_scalef32_pk32_f32_fp6((v6u){ur[i][0].x, ur[i][0].y, ur[i][1].x, ur[i][1].y, ur[i][2].x, ur[i][2].y}, 1.0f);
        f32x2 q2 = (f32x2){0.f, 0.f};
#pragma unroll
        for (int k = 0; k < 16; ++k) q2 = __builtin_elementwise_fma((f32x2){u[2 * k], u[2 * k + 1]}, (f32x2){hg[2 * k], hg[2 * k + 1]}, q2);
        d[i] = q2.x + q2.y;
        __builtin_amdgcn_sched_barrier(0);
      }
      float r[4];
#pragma unroll
      for (int j = 0; j < 4; ++j) r[j] = (b4 ? d[j + 4] : d[j]) + swz_xor<16>(b4 ? d[j] : d[j + 4]);
      const float q0 = (b3 ? r[2] : r[0]) + swz_xor<8>(b3 ? r[0] : r[2]);
      const float q1 = (b3 ? r[3] : r[1]) + swz_xor<8>(b3 ? r[1] : r[3]);
      float q = (b2 ? q1 : q0) + swz_xor<4>(b2 ? q0 : q1);
      q += swz_xor<2>(q); q += swz_xor<1>(q);
      const int pr = (e & 63) + 2 * (l32 >> 2) + hi;
      const float sd = (e < 64) ? __shfl(sd0, pr) : __shfl(sd1, pr);
      const float gu = (e < 64) ? __shfl(gu0, pr) : __shfl(gu1, pr);
      const float wl = gu * gelu_as(q * sd);
      const float wsrc = __shfl(wl, ((lane & 1) << 5) | (((lane - (e & 63)) >> 1 & 7) << 2));
      if (lane >= (e & 63) && lane < (e & 63) + 16) { if (e < 64) w0 = wsrc; else w1 = wsrc; }
    }
    wout[(size_t)t * 128 + lane] = w0; wout[(size_t)t * 128 + 64 + lane] = w1;
  }
}

__device__ __forceinline__ void exp_up_item(const Args& a, unsigned char* lds, int xs, int item, int wave, int lane, float* xout, float* ssout) {
  unsigned char* ws = a.ws;
  const int* eidx = (const int*)(ws + WS_EIDX); const float* wgt = (const float*)(ws + WS_W);
  const unsigned char* ups = ws + WS_EXU + (size_t)xs * (NEXP * 128);
  unsigned* L = (unsigned*)(lds + wave * 16640);
  const int g = lane >> 2, c = lane & 3, t0 = item * 128 + wave * 16;
  __builtin_amdgcn_wave_barrier();
#pragma unroll 4
  for (int tk = 0; tk < 16; ++tk) {
    const size_t o = (size_t)(t0 + tk) * 128;
    L[tk * 260 + lane] = (unsigned)eidx[o + lane]; L[tk * 260 + 64 + lane] = (unsigned)eidx[o + 64 + lane];
    L[tk * 260 + 128 + lane] = __float_as_uint(wgt[o + lane]); L[tk * 260 + 192 + lane] = __float_as_uint(wgt[o + 64 + lane]);
  }
  __builtin_amdgcn_wave_barrier();
  float acc[32];
#pragma unroll
  for (int i = 0; i < 32; ++i) acc[i] = 0.f;
  const unsigned* Lg = L + g * 260;
#pragma unroll 1
  for (int p = 0; p < 128; p += 8) {
    u32x2 vr[8][3];
#pragma unroll
    for (int u = 0; u < 8; ++u) {
      const u32x2* vp = (const u32x2*)(ups + (size_t)Lg[p + u] * 128 + 24 * c);
      vr[u][0] = vp[0]; vr[u][1] = vp[1]; vr[u][2] = vp[2];
    }
#pragma unroll
    for (int u = 0; u < 8; ++u) {
      const float w = __uint_as_float(Lg[128 + p + u]);
      PIN6(vr[u]);
      const v32f v = __builtin_amdgcn_cvt_scalef32_pk32_f32_fp6((v6u){vr[u][0].x, vr[u][0].y, vr[u][1].x, vr[u][1].y, vr[u][2].x, vr[u][2].y}, 1.0f);
#pragma unroll
      for (int k = 0; k < 32; ++k) acc[k] += w * v[k];
      PIN16(acc, 0); PIN16(acc, 16);
    }
  }
  const f32x4* xr = (const f32x4*)(a.out + (size_t)(t0 + g) * DM + xs * 128 + c * 32); f32x4* xw = (f32x4*)(xout + (size_t)(t0 + g) * DM + xs * 128 + c * 32);
  float s = 0.f;
#pragma unroll
  for (int k = 0; k < 8; ++k) { f32x4 x = xr[k]; x.x += acc[4 * k]; x.y += acc[4 * k + 1]; x.z += acc[4 * k + 2]; x.w += acc[4 * k + 3]; xw[k] = x; s += (x.x * x.x + x.y * x.y) + (x.z * x.z + x.w * x.w); }
  s += swz_xor<1>(s); s += swz_xor<2>(s);
  if (c == 0) atomicAdd(ssout + t0 + g, s);
}
__device__ __forceinline__ void phase_exp_up(const Args& a, unsigned char* lds, const XcdBarrier& bar, int tid, int wave, int lane, unsigned* ctr, float* xout, float* ssout);
struct UpBuf { u32x2 r[8][3]; };
__device__ __forceinline__ void up2_load(UpBuf& B, const unsigned char* ups, const unsigned* Lg, int ch, int c) {
  const unsigned char* base = ups + (size_t)(ch >> 4) * (NEXP * 128) + 24 * c; const int p = (ch & 15) * 8;
#pragma unroll
  for (int u = 0; u < 8; ++u) { const u32x2* vp = (const u32x2*)(base + (size_t)Lg[p + u] * 128); B.r[u][0] = vp[0]; B.r[u][1] = vp[1]; B.r[u][2] = vp[2]; }
}
__device__ __forceinline__ void up2_math(UpBuf& B, const unsigned* Lg, int ch, f32x2 (&acc)[16]) {
  const int p = (ch & 15) * 8;
#pragma unroll
  for (int u = 0; u < 8; ++u) {
    const float w = __uint_as_float(Lg[128 + p + u]);
    PIN6(B.r[u]);
    const v32f v = __builtin_amdgcn_cvt_scalef32_pk32_f32_fp6((v6u){B.r[u][0].x, B.r[u][0].y, B.r[u][1].x, B.r[u][1].y, B.r[u][2].x, B.r[u][2].y}, 1.0f);
    const f32x2 w2 = (f32x2){w, w};
#pragma unroll
    for (int k = 0; k < 16; ++k) acc[k] = __builtin_elementwise_fma((f32x2){v[2 * k], v[2 * k + 1]}, w2, acc[k]);
    PIN16(acc, 0);
  }
}
__device__ __forceinline__ void up2_slice_end(const Args& a, int t, int xs, int c, f32x2 (&acc)[16], float& ssum) {
  f32x4* xr = (f32x4*)(a.out + (size_t)t * DM + xs * 128 + c * 32);
#pragma unroll
  for (int k = 0; k < 8; ++k) { f32x4 x = xr[k]; x.x += acc[2 * k].x; x.y += acc[2 * k].y; x.z += acc[2 * k + 1].x; x.w += acc[2 * k + 1].y; xr[k] = x; ssum += (x.x * x.x + x.y * x.y) + (x.z * x.z + x.w * x.w);
    acc[2 * k] = (f32x2){0.f, 0.f}; acc[2 * k + 1] = (f32x2){0.f, 0.f}; }
}
__device__ __forceinline__ void phase_exp_up2(const Args& a, unsigned char* lds, int wave, int lane) {
  unsigned char* ws = a.ws;
  const int* eidx = (const int*)(ws + WS_EIDX); const float* wgt = (const float*)(ws + WS_W);
  const unsigned char* ups = ws + WS_EXU;
  unsigned* L = (unsigned*)(lds + wave * 16640);
  const int g = lane >> 2, c = lane & 3;
  for (int blk = blockIdx.x; blk < NT / 128; blk += gridDim.x) {
    const int t0 = blk * 128 + wave * 16, t = t0 + g;
    __builtin_amdgcn_wave_barrier();
#pragma unroll 4
    for (int tk = 0; tk < 16; ++tk) {
      const size_t o = (size_t)(t0 + tk) * 128;
      L[tk * 260 + lane] = (unsigned)eidx[o + lane]; L[tk * 260 + 64 + lane] = (unsigned)eidx[o + 64 + lane];
      L[tk * 260 + 128 + lane] = __float_as_uint(wgt[o + lane]); L[tk * 260 + 192 + lane] = __float_as_uint(wgt[o + 64 + lane]);
    }
    __builtin_amdgcn_wave_barrier();
    const unsigned* Lg = L + g * 260;
    f32x2 acc[16]; float ssum = 0.f;
#pragma unroll
    for (int i = 0; i < 16; ++i) acc[i] = (f32x2){0.f, 0.f};
    UpBuf A, B;
    up2_load(A, ups, Lg, 0, c);
#pragma unroll 1
    for (int ch = 0; ch < 128; ch += 2) {
      up2_load(B, ups, Lg, ch + 1, c);
      up2_math(A, Lg, ch, acc);
      if (ch + 2 < 128) up2_load(A, ups, Lg, ch + 2, c);
      up2_math(B, Lg, ch + 1, acc);
      if ((ch & 15) == 14) up2_slice_end(a, t, ch >> 4, c, acc, ssum);
    }
    ssum += swz_xor<1>(ssum); ssum += swz_xor<2>(ssum);
    const float r2 = rsqrtf(ssum * (1.f / DM) + EPS);
    asm volatile("s_waitcnt vmcnt(0)" ::: "memory");
    __builtin_amdgcn_fence(__ATOMIC_ACQUIRE, "agent");
#pragma unroll 2
    for (int xs = 0; xs < 8; ++xs) {
      f32x4* xr = (f32x4*)(a.out + (size_t)t * DM + xs * 128 + c * 32); const f32x4* gp = (const f32x4*)(a.in[21] + xs * 128 + c * 32);
#pragma unroll
      for (int k = 0; k < 8; ++k) xr[k] = xr[k] * r2 * gp[k];
    }
  }
}

__device__ __forceinline__ void phase_final(const Args& a, int gw, int ngw, int lane) {
  const float* ss = (const float*)(a.ws + WS_SS3);
  for (int r = gw; r < NT; r += ngw) {
    const float r2 = rsqrtf(ss[r] * (1.f / DM) + EPS);
    f32x4* xr = (f32x4*)(a.out + (size_t)r * DM) + lane;
#pragma unroll
    for (int j = 0; j < 4; ++j) { const f32x4 g = ((const f32x4*)a.in[21])[64 * j + lane]; xr[64 * j] = xr[64 * j] * r2 * g; }
  }
}

namespace pg8 {
#define PG8_LAS __attribute__((address_space(3)))
typedef unsigned short bf16_t;
typedef short bf16x8 __attribute__((ext_vector_type(8)));
typedef float f32x4 __attribute__((ext_vector_type(4)));
typedef unsigned u32x4 __attribute__((ext_vector_type(4)));
constexpr int BM = 256, BK = 64, HALF = 128, HTB = HALF * BK * 2  , STAGE_BYTES = 8 * HTB, NXCD = 8, WGM = 8;

__host__ __device__ __forceinline__ int lds_byte(int r, int c) { const int st = (r >> 4) * 2 + (c >> 5), rr = r & 15, cc = c & 31, ob = rr * 64 + cc * 2; return st * 1024 + (ob ^ (((ob >> 9) & 1) << 5)); }
__host__ __device__ __forceinline__ void stage_rc(int b, int& R, int& C) { const int st = b / 1024, sb = b % 1024, swz = sb ^ (((sb >> 9) & 1) << 5); R = (st >> 1) * 16 + swz / 64; C = (st & 1) * 32 + (swz % 64) / 2; }
__host__ __device__ __forceinline__ int perm32(int rho) { const int n = rho >> 4, i = rho & 15; return 8 * (i >> 2) + 4 * n + (i & 3); }

struct Unit { int pm, pn; };
struct Gemm { const bf16_t* A; const bf16_t* Bt; int M, N, K; };

struct StaticOrder {
    int nM, nN, nwg, G, c;
    __host__ __device__ void init(int M, int N, int G_, int c_) { nM = M / BM; nN = N / BM; nwg = nM * nN; G = G_; c = c_; }
    __host__ __device__ bool next(int i, Unit& u) const {
        const long L = (long)i * G + c; if (L >= nwg) return false;
        int wgid = (int)L; { const int q = nwg / NXCD, r = nwg % NXCD, xcd = wgid % NXCD, off = wgid / NXCD; wgid = (xcd < r ? xcd * (q + 1) : r * (q + 1) + (xcd - r) * q) + off; }
        const int nig = WGM * nN, gid = wgid / nig, fm = gid * WGM, gsz = (nM - fm) < WGM ? (nM - fm) : WGM;
        u.pm = fm + ((wgid % nig) % gsz); u.pn = (wgid % nig) / gsz; return true;
    }
    __device__ __forceinline__ void a_ready(const Unit&) const {}
    __device__ __forceinline__ void done(const Unit&) const {}
};

template <class St> struct EpiAdapt8 {
    static constexpr bool PERM = true, AFTER_DRAIN = false; St st;
    __device__ __forceinline__ void operator()(const f32x4 (&acc)[2][2][4][2], const Unit& u, int wr, int wc, int fr, int fq) const {
#pragma unroll
        for (int ai = 0; ai < 2; ++ai)
#pragma unroll
            for (int m = 0; m < 4; ++m)
#pragma unroll
                for (int bj = 0; bj < 2; ++bj) st.store8(u.pm * BM + ai * HALF + wr * 64 + m * 16 + fr, u.pn * BM + bj * HALF + wc * 32 + 8 * fq, acc[ai][bj][m][0], acc[ai][bj][m][1]);
    }
};
template <class St> struct EpiAdapt {
    static constexpr bool PERM = false, AFTER_DRAIN = false; St st;
    __device__ __forceinline__ void operator()(const f32x4 (&acc)[2][2][4][2], const Unit& u, int wr, int wc, int fr, int fq) const {
#pragma unroll
        for (int ai = 0; ai < 2; ++ai)
#pragma unroll
            for (int m = 0; m < 4; ++m)
#pragma unroll
                for (int bj = 0; bj < 2; ++bj)
#pragma unroll
                    for (int n = 0; n < 2; ++n) st.store(u.pm * BM + ai * HALF + wr * 64 + m * 16 + fr, u.pn * BM + bj * HALF + wc * 32 + n * 16 + 4 * fq, acc[ai][bj][m][n]);
    }
};

struct EpiResidSS {
    static constexpr bool PERM = false, AFTER_DRAIN = false; const float* base; float* out; bf16_t* hb; float* ss;
    __device__ __forceinline__ void operator()(const f32x4 (&acc)[2][2][4][2], const Unit& u, int wr, int wc, int fr, int fq) const {
#pragma unroll
        for (int ai = 0; ai < 2; ++ai)
#pragma unroll
            for (int m = 0; m < 4; ++m) {
                const int row = u.pm * BM + ai * HALF + wr * 64 + m * 16 + fr; float s = 0.f;
#pragma unroll
                for (int bj = 0; bj < 2; ++bj)
#pragma unroll
                    for (int n = 0; n < 2; ++n) {
                        const size_t o = (size_t)row * 1024 + u.pn * BM + bj * HALF + wc * 32 + n * 16 + 4 * fq;
                        const f32x4 v = *(const f32x4*)(base + o) + acc[ai][bj][m][n];
                        *(f32x4*)(out + o) = v;
                        typedef unsigned u32x2v __attribute__((ext_vector_type(2)));
                        { const float f0 = v.x, f1 = v.y, f2 = v.z, f3 = v.w; *(u32x2v*)(hb + o) = (u32x2v){::pk2(f0, f1), ::pk2(f2, f3)}; }
                        s += (v.x * v.x + v.y * v.y) + (v.z * v.z + v.w * v.w);
                    }
                s += __shfl_xor(s, 16); s += __shfl_xor(s, 32);
                if (fq == 0) atomicAdd(ss + row, s);
            }
    }
};
template <class Epi, class Sched, bool ALIGN_EPI = false, bool SP2 = false>
__device__ __forceinline__ void gemm_phase(PG8_LAS unsigned char* lds, const Gemm g, const Sched& S, const Epi& E) {
    const int tid = threadIdx.x, wid = __builtin_amdgcn_readfirstlane(tid >> 6), lane = tid & 63, wr = wid >> 2, wc = wid & 3, fr = lane & 15, fq = lane >> 4;
    const int K = g.K, nt = K / BK;
    unsigned voffA[2], voffB[2];
#pragma unroll
    for (int i = 0; i < 2; ++i) { int R, C; stage_rc(tid * 16 + i * 8192, R, C); const int Rb = Epi::PERM ? ((R & ~31) + perm32(R & 31)) : R;
        voffA[i] = (unsigned)(R * K + C) * 2u; voffB[i] = (unsigned)(Rb * K + C) * 2u; }
    const size_t kstep = (size_t)(BK * 2);
    const size_t hstep = (size_t)HALF * K * 2;
    const size_t tstep = 2 * hstep;
    const unsigned ldsw = (unsigned)wid * 1024u;
    const int aoff = lds_byte(wr * 64 + fr, fq * 8), boff = lds_byte(wc * 32 + fr, fq * 8);
#define PG8_SA(b, h) (((b) * 2 + (h)) * HTB)
#define PG8_SB(b, h) ((4 + (b) * 2 + (h)) * HTB)
#define PG8_STAGE(bufoff, gbase, voff) do { _Pragma("unroll") for (int _i = 0; _i < 2; ++_i) \
        __builtin_amdgcn_global_load_lds((const unsigned*)((const char*)(gbase) + (voff)[_i]), (PG8_LAS unsigned*)(lds + (bufoff) + ldsw + _i * 8192), 16, 0, 0); } while (0)
#define PG8_LDA(dst, b, h) do { _Pragma("unroll") for (int m = 0; m < 4; ++m) _Pragma("unroll") for (int k = 0; k < 2; ++k) dst[m][k] = *(const PG8_LAS bf16x8*)(lds + PG8_SA(b, h) + aoff + m * 2048 + k * 1024); } while (0)
#define PG8_LDB(dst, b, h) do { _Pragma("unroll") for (int n = 0; n < 2; ++n) _Pragma("unroll") for (int k = 0; k < 2; ++k) dst[n][k] = *(const PG8_LAS bf16x8*)(lds + PG8_SB(b, h) + boff + n * 2048 + k * 1024); } while (0)
#define PG8_MMA(ai, bj, At, Bt) do { __builtin_amdgcn_s_setprio(1); _Pragma("unroll") for (int m = 0; m < 4; ++m) _Pragma("unroll") for (int n = 0; n < 2; ++n) _Pragma("unroll") for (int k = 0; k < 2; ++k) \
        acc[ai][bj][m][n] = __builtin_amdgcn_mfma_f32_16x16x32_bf16(Bt[n][k], At[m][k], acc[ai][bj][m][n], 0, 0, 0); __builtin_amdgcn_s_setprio(0); } while (0)
#define PG8_WAIT_V(n) asm volatile("s_waitcnt vmcnt(" #n ")" ::: "memory")
#define PG8_WAIT_L(n) asm volatile("s_waitcnt lgkmcnt(" #n ")" ::: "memory")
#define PG8_BAR __builtin_amdgcn_s_barrier()
#define PG8_SCHED __builtin_amdgcn_sched_barrier(0)
    Unit cur, nxt; int ui = 0;
    if (!S.next(0, cur)) return;
    f32x4 acc[2][2][4][2];
#pragma unroll
    for (int a = 0; a < 2; ++a)
#pragma unroll
        for (int b = 0; b < 2; ++b)
#pragma unroll
            for (int m = 0; m < 4; ++m)
#pragma unroll
                for (int n = 0; n < 2; ++n) acc[a][b][m][n] = (f32x4){0.f, 0.f, 0.f, 0.f};
    bf16x8 At[4][2], B0[2][2], B1[2][2];
    const char* cA = (const char*)g.A + (size_t)cur.pm * tstep; const char* cB = (const char*)g.Bt + (size_t)cur.pn * tstep;
    S.a_ready(cur);
    if constexpr (SP2) {
        PG8_STAGE(PG8_SB(0, 0), cB, voffB); PG8_STAGE(PG8_SB(0, 1), cB + hstep, voffB); PG8_STAGE(PG8_SA(0, 0), cA, voffA); PG8_STAGE(PG8_SA(0, 1), cA + hstep, voffA);
        if (wr == 1) PG8_BAR;
        PG8_WAIT_V(2); PG8_BAR;
        PG8_STAGE(PG8_SB(1, 0), cB + kstep, voffB); PG8_STAGE(PG8_SA(1, 0), cA + kstep, voffA); PG8_STAGE(PG8_SB(1, 1), cB + hstep + kstep, voffB);
        PG8_WAIT_V(6); PG8_BAR;
    } else {
        PG8_STAGE(PG8_SB(0, 0), cB, voffB); PG8_STAGE(PG8_SA(0, 0), cA, voffA); PG8_STAGE(PG8_SB(0, 1), cB + hstep, voffB); PG8_STAGE(PG8_SA(0, 1), cA + hstep, voffA);
        if (wr == 1) PG8_BAR;
        PG8_WAIT_V(4); PG8_BAR;
        PG8_STAGE(PG8_SB(1, 0), cB + kstep, voffB); PG8_STAGE(PG8_SA(1, 0), cA + kstep, voffA); PG8_STAGE(PG8_SB(1, 1), cB + hstep + kstep, voffB);
        PG8_WAIT_V(6); PG8_BAR;
    }
    for (;;) {
        const bool has_next = S.next(ui + 1, nxt);
        const char* nA = has_next ? (const char*)g.A + (size_t)nxt.pm * tstep : cA; const char* nB = has_next ? (const char*)g.Bt + (size_t)nxt.pn * tstep : cB;
        for (int t = 0; t < nt; t += 2) {
            const bool last = (t == nt - 2);
            const char* a1 = cA + (size_t)(t + 1) * kstep;
            const char* a2 = last ? nA : cA + (size_t)(t + 2) * kstep; const char* b2 = last ? nB : cB + (size_t)(t + 2) * kstep;
            const char* a3 = a2 + kstep; const char* b3 = b2 + kstep;
            if (last && has_next) S.a_ready(nxt);
            if constexpr (SP2) {
            PG8_LDB(B0, 0, 0); PG8_LDB(B1, 0, 1); PG8_SCHED; PG8_LDA(At, 0, 0); PG8_STAGE(PG8_SA(1, 1), a1 + hstep, voffA);
            PG8_WAIT_V(8); PG8_WAIT_L(0); PG8_BAR; PG8_MMA(0, 0, At, B0); PG8_MMA(0, 1, At, B1); PG8_BAR; PG8_SCHED;
            PG8_LDA(At, 0, 1); PG8_STAGE(PG8_SB(0, 0), b2, voffB); PG8_STAGE(PG8_SB(0, 1), b2 + hstep, voffB); PG8_STAGE(PG8_SA(0, 0), a2, voffA);
            PG8_WAIT_V(8); PG8_WAIT_L(0); PG8_BAR; PG8_MMA(1, 0, At, B0); PG8_MMA(1, 1, At, B1); PG8_BAR; PG8_SCHED;
            PG8_LDB(B0, 1, 0); PG8_LDB(B1, 1, 1); PG8_SCHED; PG8_LDA(At, 1, 0); PG8_STAGE(PG8_SA(0, 1), a2 + hstep, voffA);
            PG8_WAIT_V(8); PG8_WAIT_L(0); PG8_BAR; PG8_MMA(0, 0, At, B0); PG8_MMA(0, 1, At, B1); PG8_BAR; PG8_SCHED;
            PG8_LDA(At, 1, 1); PG8_STAGE(PG8_SB(1, 0), b3, voffB); PG8_STAGE(PG8_SB(1, 1), b3 + hstep, voffB); PG8_STAGE(PG8_SA(1, 0), a3, voffA);
            PG8_WAIT_V(8); PG8_WAIT_L(0); PG8_BAR; PG8_MMA(1, 0, At, B0); PG8_MMA(1, 1, At, B1); PG8_BAR; PG8_SCHED;
            } else {
            PG8_LDB(B0, 0, 0); PG8_SCHED; PG8_LDA(At, 0, 0); PG8_STAGE(PG8_SA(1, 1), a1 + hstep, voffA);
            PG8_WAIT_L(8); PG8_BAR; PG8_WAIT_L(0); PG8_MMA(0, 0, At, B0); PG8_BAR; PG8_SCHED;
            PG8_LDB(B1, 0, 1); PG8_STAGE(PG8_SB(0, 0), b2, voffB);
            PG8_BAR; PG8_WAIT_L(0); PG8_MMA(0, 1, At, B1); PG8_BAR;
            PG8_LDA(At, 0, 1); PG8_STAGE(PG8_SA(0, 0), a2, voffA);
            PG8_BAR; PG8_WAIT_L(0); PG8_MMA(1, 0, At, B0); PG8_BAR; PG8_SCHED;
            PG8_STAGE(PG8_SB(0, 1), b2 + hstep, voffB);
            PG8_WAIT_V(6); PG8_BAR; PG8_MMA(1, 1, At, B1); PG8_BAR;
            PG8_LDB(B0, 1, 0); PG8_SCHED; PG8_LDA(At, 1, 0); PG8_STAGE(PG8_SA(0, 1), a2 + hstep, voffA);
            PG8_WAIT_L(8); PG8_BAR; PG8_WAIT_L(0); PG8_MMA(0, 0, At, B0); PG8_BAR; PG8_SCHED;
            PG8_LDB(B1, 1, 1); PG8_STAGE(PG8_SB(1, 0), b3, voffB);
            PG8_BAR; PG8_WAIT_L(0); PG8_MMA(0, 1, At, B1); PG8_BAR;
            PG8_LDA(At, 1, 1); PG8_STAGE(PG8_SA(1, 0), a3, voffA);
            PG8_BAR; PG8_WAIT_L(0); PG8_MMA(1, 0, At, B0); PG8_BAR; PG8_SCHED;
            PG8_STAGE(PG8_SB(1, 1), b3 + hstep, voffB);
            PG8_WAIT_V(6); PG8_BAR; PG8_MMA(1, 1, At, B1); PG8_BAR;
            }
        }
        if constexpr (ALIGN_EPI) { if (wr == 0) PG8_BAR; }
        if constexpr (!Epi::AFTER_DRAIN) { E(acc, cur, wr, wc, fr, fq); S.done(cur); }
        if (!has_next) break;
#pragma unroll
        for (int a = 0; a < 2; ++a)
#pragma unroll
            for (int b = 0; b < 2; ++b)
#pragma unroll
                for (int m = 0; m < 4; ++m)
#pragma unroll
                    for (int n = 0; n < 2; ++n) acc[a][b][m][n] = (f32x4){0.f, 0.f, 0.f, 0.f};
        cur = nxt; cA = nA; cB = nB; ++ui;
        if constexpr (ALIGN_EPI) { if (wr == 1) PG8_BAR; }
    }
    PG8_WAIT_V(0);
    if constexpr (!ALIGN_EPI) { if (wr == 0) PG8_BAR; }
    PG8_BAR;
    if constexpr (Epi::AFTER_DRAIN) { E.fused(acc, cur, wr, wc, fr, fq, lds, wid, lane); S.done(cur); }
#undef PG8_SA
#undef PG8_SB
#undef PG8_STAGE
#undef PG8_LDA
#undef PG8_LDB
#undef PG8_MMA
#undef PG8_WAIT_V
#undef PG8_WAIT_L
#undef PG8_BAR
#undef PG8_SCHED
}
}


template <class Epi>
__device__ __forceinline__ void run_gemm_raw(unsigned char* lds, const bf16_t* A, const bf16_t* Bt, int M, int N, int K, const Epi& E) {
  pg8::Gemm g{A, Bt, M, N, K}; pg8::StaticOrder S; S.init(M, N, (int)gridDim.x, (int)blockIdx.x);
  pg8::gemm_phase<Epi, pg8::StaticOrder, true, true>((PG8_LAS unsigned char*)lds, g, S, E);
}
template <class St>
__device__ __forceinline__ void run_gemm8(unsigned char* lds, const bf16_t* A, const bf16_t* Bt, int M, int N, int K, const St& st) {
  pg8::Gemm g{A, Bt, M, N, K}; pg8::StaticOrder S; S.init(M, N, (int)gridDim.x, (int)blockIdx.x);
  pg8::EpiAdapt8<St> E{st};
  pg8::gemm_phase<pg8::EpiAdapt8<St>, pg8::StaticOrder, true, true>((PG8_LAS unsigned char*)lds, g, S, E);
}
template <class St>
__device__ __forceinline__ void run_gemm(unsigned char* lds, const bf16_t* A, const bf16_t* Bt, int M, int N, int K, const St& st, int gw, int ngw, int lane) {
#if USE_PG8
  pg8::Gemm g{A, Bt, M, N, K}; pg8::StaticOrder S; S.init(M, N, (int)gridDim.x, (int)blockIdx.x);
  pg8::EpiAdapt<St> E{st};
  pg8::gemm_phase<pg8::EpiAdapt<St>, pg8::StaticOrder, true, true>((PG8_LAS unsigned char*)lds, g, S, E);
#else
  gemm_naive(A, K, Bt, K, M, N, K, st, gw, ngw, lane);
#endif
}

#define GAS __attribute__((address_space(1)))
#define LAS __attribute__((address_space(3)))
#define XB_TMO      128
#define XB_XCNT(j)  (256  + 64 * (j))
#define XB_XSUB(j)  (1280 + 64 * (j))
#define XB_XGEN(j)  (2304 + 64 * (j))
#define XB_TOP      3328
#define XB_TOPGEN   3392
#define XCD_BAR_WORDS 3456
#define XB_SPIN_CAP (1u << 18)

__device__ __forceinline__ unsigned xb_ld(unsigned* p)              { return __hip_atomic_load(p, __ATOMIC_RELAXED, __HIP_MEMORY_SCOPE_AGENT); }
__device__ __forceinline__ unsigned xb_add(unsigned* p, unsigned v) { return __hip_atomic_fetch_add(p, v, __ATOMIC_RELAXED, __HIP_MEMORY_SCOPE_AGENT); }
__device__ __forceinline__ unsigned xb_xcc_id() { return (unsigned)__builtin_amdgcn_s_getreg((3 << 11) | 20) & 0xFu; }
#define XB_SPIN(cond, bar) do { unsigned _sp = 0; while (cond) { __builtin_amdgcn_s_sleep(1); \
    if ((++_sp & 255u) == 0u) { if (xb_ld(&(bar)[XB_TMO])) break; if (_sp > XB_SPIN_CAP) { atomicAdd(&(bar)[XB_TMO], 1u); break; } } } } while (0)

struct XcdBarrier {
    unsigned* bar; unsigned x;
    volatile LAS unsigned* st;
};

__device__ __forceinline__ XcdBarrier xcd_barrier_post(unsigned* bar, volatile LAS unsigned* st) {
    XcdBarrier b; b.bar = bar; b.x = xb_xcc_id(); b.st = st;
    if (threadIdx.x == 0) (void)xb_add(&bar[XB_XCNT(b.x)], 1u);
    return b;
}
__device__ __forceinline__ void xcd_barrier_complete(unsigned* bar, unsigned x, unsigned& nloc, unsigned& nx) {
    const unsigned G = gridDim.x * gridDim.y * gridDim.z;
    unsigned sum, cnt, mine, sp = 0u;
    for (;;) {
        sum = 0u; cnt = 0u; mine = 0u;
#pragma unroll
        for (unsigned j = 0; j < 16; ++j) { const unsigned c = xb_ld(&bar[XB_XCNT(j)]); sum += c; cnt += (c > 0u) ? 1u : 0u; mine = (j == x) ? c : mine; }
        if (sum == G) break;
        __builtin_amdgcn_s_sleep(1);
        if ((++sp & 255u) == 0u) { if (xb_ld(&bar[XB_TMO])) break; if (sp > XB_SPIN_CAP) { atomicAdd(&bar[XB_TMO], 1u); break; } }
    }
    nloc = mine > 0u ? mine : 1u; nx = cnt > 0u ? cnt : 1u;
}

__device__ __forceinline__ void xcd_barrier(const XcdBarrier& b) {
    asm volatile("s_waitcnt vmcnt(0)" ::: "memory");
    __syncthreads();
    if (threadIdx.x == 0) {
        unsigned* bar = b.bar;
        __builtin_amdgcn_s_waitcnt(0);
        unsigned nloc = b.st[0], nx = b.st[1];
        if (nloc == 0u) { xcd_barrier_complete(bar, b.x, nloc, nx); b.st[0] = nloc; b.st[1] = nx; }
        const unsigned old = xb_add(&bar[XB_XSUB(b.x)], 1u);
        const unsigned gen = old / nloc;
        if (old + 1u == (gen + 1u) * nloc) {
            __builtin_amdgcn_fence(__ATOMIC_RELEASE, "agent");
            asm volatile("s_waitcnt vmcnt(0)" ::: "memory");
            const unsigned og = xb_add(&bar[XB_TOP], 1u);
            const unsigned tg = og / nx;
            if (og + 1u == (tg + 1u) * nx) xb_add(&bar[XB_TOPGEN], 1u);
            else XB_SPIN(xb_ld(&bar[XB_TOPGEN]) == tg, bar);
            __builtin_amdgcn_fence(__ATOMIC_ACQUIRE, "agent");
            xb_add(&bar[XB_XGEN(b.x)], 1u);
            asm volatile("s_waitcnt vmcnt(0)" ::: "memory");
        } else {
            XB_SPIN(xb_ld(&bar[XB_XGEN(b.x)]) == gen, bar);
            __builtin_amdgcn_fence(__ATOMIC_ACQUIRE, "agent");
            asm volatile("s_waitcnt vmcnt(0)" ::: "memory");
        }
    }
    __syncthreads();
}

__device__ __forceinline__ void phase_exp_up(const Args& a, unsigned char* lds, const XcdBarrier& bar, int tid, int wave, int lane, unsigned* ctr, float* xout, float* ssout) {
  unsigned* slot = (unsigned*)(lds + 8 * 16640);
  const int x0 = (int)(xb_xcc_id() & 7u);
  for (int k = 0; k < 8; ++k) {
    const int xs = (x0 + k) & 7;
    for (;;) {
      __syncthreads();
      if (tid == 0) slot[0] = atomicAdd(ctr + 16 * xs, 1u);
      __syncthreads();
      const unsigned item = slot[0];
      if (item >= (unsigned)(NT / 128)) break;
      exp_up_item(a, lds, xs, (int)item, wave, lane, xout, ssout);
    }
  }
}

__global__ void __launch_bounds__(512, 2) mega(Args a) {
  extern __shared__ __attribute__((aligned(16))) unsigned char lds[];
  cg::grid_group grid = cg::this_grid();
  const int tid = threadIdx.x, lane = tid & 63, wave = tid >> 6;
  const int gw = blockIdx.x * 8 + wave, ngw = gridDim.x * 8;
  unsigned char* ws = a.ws;
  const int lo = a.ph_lo, hi = a.ph_hi;
#define IN(k) (lo <= (k) && (k) < hi)
  volatile LAS unsigned* MISC = (volatile LAS unsigned*)((LAS unsigned char*)lds + 146944);
  if (tid < 32) MISC[tid] = 0u;
  __syncthreads();
  XcdBarrier bar; bar.bar = (unsigned*)(ws + WS_BAR); bar.x = 0; bar.st = nullptr;
  if (hi - lo > 1) bar = xcd_barrier_post((unsigned*)(ws + WS_BAR), MISC + 8);
  if (lo < -1000000) grid.sync();
#define SEAM(k) do { if (IN(k) && IN((k) + 1)) xcd_barrier(bar); } while (0)
#if PROBE_REP == 0
  if (IN(0)) { phase_prep(a, lds, gw, ngw, wave, lane, tid); grid.sync(); }
#endif
  if (IN(0)) { phase_prep(a, lds, gw, ngw, wave, lane, tid); } SEAM(0);
#if PROBE_REP == 1
  if (IN(1)) {
    run_gemm8(lds, (const bf16_t*)(ws + WS_HB), (const bf16_t*)(ws + WS_WIN_T), NT, NQKV, DM, EpiQKV{(bf16_t*)(ws + WS_QKV)});
    run_gemm8(lds, (const bf16_t*)(ws + WS_MEMN), (const bf16_t*)(ws + WS_WXKV_T), NMROWS, 2048, DM, EpiBf16{(bf16_t*)(ws + WS_KX), 2048});
    xcd_barrier(bar); }
#endif
#if PROBE_REP == 2
  if (IN(2)) { phase_scan(a, gw, ngw, lane, tid); xcd_barrier(bar); phase_rms(a, gw, ngw, lane); xcd_barrier(bar); phase_rms(a, gw, ngw, lane); xcd_barrier(bar); }
#endif
  if (IN(1)) {
    run_gemm8(lds, (const bf16_t*)(ws + WS_HB), (const bf16_t*)(ws + WS_WIN_T), NT, NQKV, DM, EpiQKV{(bf16_t*)(ws + WS_QKV)});
    run_gemm8(lds, (const bf16_t*)(ws + WS_MEMN), (const bf16_t*)(ws + WS_WXKV_T), NMROWS, 2048, DM, EpiBf16{(bf16_t*)(ws + WS_KX), 2048});
  } SEAM(1);
  if (IN(2)) { phase_scan(a, gw, ngw, lane, tid); } SEAM(2);
#if PROBE_REP == 3
  if (IN(3)) { phase_attn2(a, lds, tid); xcd_barrier(bar); if (blockIdx.x == 0 && tid == 0) *(unsigned*)(ws) = 0u; xcd_barrier(bar); }
#endif
  if (IN(3)) {
#if USE_ATT2
    phase_attn2(a, lds, tid);
#else
    phase_attn(a, lds, tid);
#endif
  } SEAM(3);
  if (IN(4)) { phase_onorm(a, gw, ngw, lane); } SEAM(4);
  if (IN(5)) { run_gemm_raw(lds, (const bf16_t*)(ws + WS_OAB), (const bf16_t*)(ws + WS_WOUT_T), NT, DM, DM, pg8::EpiResidSS{a.in[0], a.out, (bf16_t*)(ws + WS_HB), (float*)(ws + WS_SS1)}); }
  if (IN(5) && IN(7)) xcd_barrier(bar);
  if (IN(7)) { run_gemm8(lds, (const bf16_t*)(ws + WS_HB), (const bf16_t*)(ws + WS_WXQ_T), NT, DM, DM, EpiBf16S{(bf16_t*)(ws + WS_QX), DM, (const float*)(ws + WS_SS1)}); } SEAM(7);
#if PROBE_REP == 8
  if (IN(8)) { phase_xattn(a, lds, gw, ngw, wave, lane); grid.sync(); }
#endif
  if (IN(8)) { phase_xattn2(a, lds, tid); } SEAM(8);
  if (IN(9)) { run_gemm_raw(lds, (const bf16_t*)(ws + WS_OX), (const bf16_t*)(ws + WS_WXO_T), NT, DM, DM, pg8::EpiResidSS{a.out, a.out, (bf16_t*)(ws + WS_HB), (float*)(ws + WS_SS2)}); }
  if (IN(9) && IN(11)) xcd_barrier(bar);
  if (IN(11)) { run_gemm8(lds, (const bf16_t*)(ws + WS_HB), (const bf16_t*)(ws + WS_WPQ_T), NT, DM, DM, EpiBf16S{(bf16_t*)(ws + WS_PQ), DM, (const float*)(ws + WS_SS2)}); } SEAM(11);
#if PROBE_REP == 12
  if (IN(12)) { phase_topk(a, lds, tid); grid.sync(); }
#endif
  if (IN(12)) { phase_topk2(a, lds, wave, lane); } SEAM(12);
    if (IN(13)) {
    for (int rep = 0; rep < a.rep_down; ++rep) { phase_exp_down(a, gw, ngw, lane); if (hi - lo > 1) xcd_barrier(bar); }
    phase_exp_up2(a, lds, wave, lane);
  }
#undef IN
#undef SEAM
}

extern "C" void kernel_launch(void* const* d_in, const int* in_sizes, int n_in, void* d_out, int out_size, void* d_ws, size_t ws_size, hipStream_t stream) {
  static int grid = 0;
  if (grid == 0) {
    if (n_in != 22 || out_size != NT * DM || ws_size < WS_END) { fprintf(stderr, "kernel_launch: unexpected shapes (n_in %d out %d ws %zu)\n", n_in, out_size, ws_size); grid = -1; return; }
    int dev = 0, cus = 0, per_cu = 0;
    (void)hipGetDevice(&dev);
    (void)hipDeviceGetAttribute(&cus, hipDeviceAttributeMultiprocessorCount, dev);
    (void)hipFuncSetAttribute((const void*)mega, hipFuncAttributeMaxDynamicSharedMemorySize, LDS_BYTES);
    (void)hipOccupancyMaxActiveBlocksPerMultiprocessor(&per_cu, (const void*)mega, 512, LDS_BYTES);
    if (per_cu < 1) per_cu = 1;
    grid = cus * per_cu;
  }
  if (grid < 0) return;
  (void)hipMemsetAsync(d_ws, 0, CTL_ZERO_BYTES, stream);
  Args a{};
  for (int i = 0; i < 22; ++i) a.in[i] = (const float*)d_in[i];
  a.out = (float*)d_out; a.ws = (unsigned char*)d_ws;
  a.rep_down = REP_DOWN; a.rep_up = REP_UP;
#if MK_N_LAUNCHES == 1
  a.ph_lo = 0; a.ph_hi = NPHASE + 1;
  void* args[] = {&a};
  hipError_t e = hipLaunchCooperativeKernel((const void*)mega, dim3(grid), dim3(512), args, LDS_BYTES, stream);
  if (e != hipSuccess) fprintf(stderr, "cooperative launch failed: %s (grid %d)\n", hipGetErrorString(e), grid);
#else
  for (int p = 0; p <= NPHASE; ++p) { a.ph_lo = p; a.ph_hi = p + 1; hipLaunchKernelGGL(mega, dim3(grid), dim3(512), LDS_BYTES, stream, a); }
#endif
}
```

```cpp
#include <hip/hip_runtime.h>
#include <hip/hip_cooperative_groups.h>
#include <cstdio>
#include <cstdint>
namespace cg = cooperative_groups;

#ifndef USE_PG8
#define USE_PG8 1
#endif
#ifndef USE_ATT2
#define USE_ATT2 1
#endif
#ifndef PROBE_REP
#define PROBE_REP -1
#endif
#ifndef REP_DOWN
#define REP_DOWN 1
#endif
#ifndef REP_UP
#define REP_UP 1
#endif
#ifndef REP_SCAN
#define REP_SCAN 1
#endif
#ifndef MK_N_LAUNCHES
#define MK_N_LAUNCHES 1
#endif

typedef unsigned short bf16_t;
typedef short bf16x8 __attribute__((ext_vector_type(8)));
typedef float f32x4 __attribute__((ext_vector_type(4)));
typedef unsigned u32x4 __attribute__((ext_vector_type(4)));
typedef unsigned u32x2 __attribute__((ext_vector_type(2)));
typedef float v32f __attribute__((ext_vector_type(32)));
typedef float v16f __attribute__((ext_vector_type(16)));
typedef unsigned v6u __attribute__((ext_vector_type(6)));
typedef float f32x2 __attribute__((ext_vector_type(2)));

constexpr int NB = 8, SEQ = 4096, DM = 1024, NT = NB * SEQ;
constexpr int NQKV = 3072, INW = 3080;
constexpr int NMEM = 256, NMROWS = NB * NMEM;
constexpr int NEXP = 16384;
constexpr float EPS = 1e-6f;
constexpr int NPHASE = 13;
constexpr int LDS_BYTES = 147456;

constexpr size_t MiB = 1u << 20;
constexpr size_t WS_BAR = 65536;
constexpr size_t WS_SS1 = 131072;
constexpr size_t WS_SS2 = 262144;
constexpr size_t WS_SS3 = 393216;
constexpr size_t WS_XCTR = 512;
constexpr size_t CTL_ZERO_BYTES = 524288;
constexpr size_t WS_WIN_T = 2 * MiB;
constexpr size_t WS_WOUT_T = 8 * MiB;
constexpr size_t WS_WXQ_T = 10 * MiB;
constexpr size_t WS_WXKV_T = 12 * MiB;
constexpr size_t WS_WXO_T = 16 * MiB;
constexpr size_t WS_WPQ_T = 18 * MiB;
constexpr size_t WS_SK = 21 * MiB;
constexpr size_t WS_MEMN = 22 * MiB;
constexpr size_t WS_KX = 26 * MiB;
constexpr size_t WS_VXT = 30 * MiB;
constexpr size_t WS_FLOG = 34 * MiB;
constexpr size_t WS_CUM = 35 * MiB;
constexpr size_t WS_KMEAN = 36 * MiB;
constexpr size_t WS_ESC = 38 * MiB;
constexpr size_t WS_EXD = 40 * MiB;
constexpr size_t WS_EXU = 72 * MiB;
constexpr size_t WS_HB = 104 * MiB;
constexpr size_t WS_QKV = 168 * MiB;
constexpr size_t WS_OAB = 360 * MiB;
constexpr size_t WS_QX = 168 * MiB;
constexpr size_t WS_OX = 232 * MiB;
constexpr size_t WS_PQ = 232 * MiB;
constexpr size_t WS_EIDX = 424 * MiB;
constexpr size_t WS_GATE = 440 * MiB;
constexpr size_t WS_W = 456 * MiB;
constexpr size_t WS_END = 472 * MiB;

struct Args {
  const float* in[22];
  float* out;
  unsigned char* ws;
  int ph_lo, ph_hi;
  int rep_down, rep_up, rep_scan, pad_;
};

struct XcdBarrier;
__device__ __forceinline__ unsigned f2bf(float f) { unsigned u = __float_as_uint(f); return (u + 0x7fffu + ((u >> 16) & 1u)) >> 16; }
__device__ __forceinline__ unsigned pk2(float lo, float hi) { return f2bf(lo) | (f2bf(hi) << 16); }
__device__ __forceinline__ float bf2f(unsigned short b) { return __uint_as_float(((unsigned)b) << 16); }
__device__ __forceinline__ float bflo(unsigned w) { return __uint_as_float(w << 16); }
__device__ __forceinline__ float bfhi(unsigned w) { return __uint_as_float(w & 0xffff0000u); }
__device__ __forceinline__ float wave_sum(float v) {
#pragma unroll
  for (int o = 1; o < 64; o <<= 1) v += __shfl_xor(v, o);
  return v;
}
template <int O> __device__ __forceinline__ float swz_xor(float v) { return __int_as_float(__builtin_amdgcn_ds_swizzle(__float_as_int(v), (O << 10) | 0x1f)); }
__device__ __forceinline__ float half_sum32(float v) { v += swz_xor<1>(v); v += swz_xor<2>(v); v += swz_xor<4>(v); v += swz_xor<8>(v); v += swz_xor<16>(v); return v; }
__device__ __forceinline__ void unpack8(const u32x4 w, float* f) {
  f[0] = bflo(w.x); f[1] = bfhi(w.x); f[2] = bflo(w.y); f[3] = bfhi(w.y);
  f[4] = bflo(w.z); f[5] = bfhi(w.z); f[6] = bflo(w.w); f[7] = bfhi(w.w);
}

__device__ const unsigned char T5_BUCKET[128] = {
  0, 1, 2, 3, 4, 5, 6, 7, 8, 9, 10, 11, 12, 13, 14, 15, 16, 16, 16, 17, 17, 18, 18, 18, 19, 19, 19, 20, 20, 20, 20, 21,
  21, 21, 21, 22, 22, 22, 22, 22, 23, 23, 23, 23, 23, 23, 24, 24, 24, 24, 24, 24, 25, 25, 25, 25, 25, 25, 25, 26, 26, 26, 26, 26,
  26, 26, 26, 27, 27, 27, 27, 27, 27, 27, 27, 27, 27, 28, 28, 28, 28, 28, 28, 28, 28, 28, 28, 29, 29, 29, 29, 29, 29, 29, 29, 29,
  29, 29, 29, 30, 30, 30, 30, 30, 30, 30, 30, 30, 30, 30, 30, 30, 30, 31, 31, 31, 31, 31, 31, 31, 31, 31, 31, 31, 31, 31, 31, 31};

__device__ __forceinline__ void transpose_item(const float* W, int ldw, const float* gain, bf16_t* WT, int K, int row_off, float* scr, int kb, int nb, int lane) {
  const int k0 = 64 * kb, n0 = 32 * nb;
#pragma unroll 8
  for (int i = 0; i < 32; ++i) {
    const int kk = 2 * i + (lane >> 5);
    const float g = gain ? gain[k0 + kk] : 1.f;
    scr[kk * 33 + (lane & 31)] = W[(size_t)(k0 + kk) * ldw + n0 + (lane & 31)] * g;
  }
  __builtin_amdgcn_wave_barrier();
  const int c = lane & 7;
#pragma unroll
  for (int j = 0; j < 4; ++j) {
    const int n = (lane >> 3) + 8 * j; const float* s = scr + (8 * c) * 33 + n;
    u32x4 o; o.x = pk2(s[0 * 33], s[1 * 33]); o.y = pk2(s[2 * 33], s[3 * 33]); o.z = pk2(s[4 * 33], s[5 * 33]); o.w = pk2(s[6 * 33], s[7 * 33]);
    *(u32x4*)(WT + (size_t)(row_off + n0 + n) * K + k0 + 8 * c) = o;
  }
  __builtin_amdgcn_wave_barrier();
}

__device__ __forceinline__ void rms_row_to_bf16(const float* xrow, bf16_t* orow, int lane) {
  const f32x4* xr = (const f32x4*)xrow + lane;
  f32x4 v[4]; float s = 0.f;
#pragma unroll
  for (int j = 0; j < 4; ++j) { v[j] = xr[64 * j]; s += (v[j].x * v[j].x + v[j].y * v[j].y) + (v[j].z * v[j].z + v[j].w * v[j].w); }
  const float rstd = rsqrtf(wave_sum(s) * (1.f / DM) + EPS);
  u32x2* o = (u32x2*)orow + lane;
#pragma unroll
  for (int j = 0; j < 4; ++j) { u32x2 w; w.x = pk2(v[j].x * rstd, v[j].y * rstd); w.y = pk2(v[j].z * rstd, v[j].w * rstd); o[64 * j] = w; }
}

__device__ __forceinline__ void phase_prep(const Args& a, unsigned char* lds, int gw, int ngw, int wave, int lane, int tid) {
  unsigned char* ws = a.ws;
  float* scr = (float*)(lds + wave * 8448);
  const int I_IN = 16 * 96, I_SQ = 16 * 32;
  const int NITEMS = I_IN + 6 * I_SQ;
  for (int it = gw; it < NITEMS; it += ngw) {
    int r = it;
    if (r < I_IN) { transpose_item(a.in[3], INW, a.in[2], (bf16_t*)(ws + WS_WIN_T), DM, 0, scr, r / 96, r % 96, lane); continue; } r -= I_IN;
    const int which = r / I_SQ; r %= I_SQ; const int kb = r / 32, nb = r % 32;
    if (which == 0) { const float* g = (kb < 8) ? a.in[6] : (a.in[7] - 512); transpose_item(a.in[8], DM, g, (bf16_t*)(ws + WS_WOUT_T), DM, 0, scr, kb, nb, lane); }
    else if (which == 1) transpose_item(a.in[11], DM, a.in[9], (bf16_t*)(ws + WS_WXQ_T), DM, 0, scr, kb, nb, lane);
    else if (which == 2) transpose_item(a.in[12], DM, a.in[10], (bf16_t*)(ws + WS_WXKV_T), DM, 0, scr, kb, nb, lane);
    else if (which == 3) transpose_item(a.in[13], DM, a.in[10], (bf16_t*)(ws + WS_WXKV_T), DM, 1024, scr, kb, nb, lane);
    else if (which == 4) transpose_item(a.in[14], DM, nullptr, (bf16_t*)(ws + WS_WXO_T), DM, 0, scr, kb, nb, lane);
    else transpose_item(a.in[16], DM, a.in[15], (bf16_t*)(ws + WS_WPQ_T), DM, 0, scr, kb, nb, lane);
  }
  for (int it = gw; it < NEXP; it += ngw) {
    const int hi = lane >> 5, l32 = lane & 31; const int r = 2 * it + hi;
    const int tb = r >= NEXP, e = r - tb * NEXP;
    const f32x4* src = (const f32x4*)(a.in[19 + tb] + (size_t)e * DM) + 8 * l32;
    v16f xa, xb; float am = 0.f;
#pragma unroll
    for (int k = 0; k < 4; ++k) { const f32x4 p = src[k], q = src[4 + k];
      xa[2 * k] = p.x; xb[2 * k] = p.y; xa[2 * k + 1] = p.z; xb[2 * k + 1] = p.w; xa[8 + 2 * k] = q.x; xb[8 + 2 * k] = q.y; xa[8 + 2 * k + 1] = q.z; xb[8 + 2 * k + 1] = q.w;
      am = fmaxf(am, fmaxf(fmaxf(fabsf(p.x), fabsf(p.y)), fmaxf(fabsf(p.z), fabsf(p.w)))); am = fmaxf(am, fmaxf(fmaxf(fabsf(q.x), fabsf(q.y)), fmaxf(fabsf(q.z), fabsf(q.w)))); }
#pragma unroll
    for (int o = 1; o < 32; o <<= 1) am = fmaxf(am, __shfl_xor(am, o));
    if (tb == 0) {
      const float sc = am > 0.f ? 7.0f / am : 1.f;
      xa = xa * sc; xb = xb * sc;
      const v6u w = __builtin_amdgcn_cvt_scalef32_2xpk16_fp6_f32(xa, xb, 1.0f);
      u32x2* dst = (u32x2*)(ws + WS_EXD + (size_t)e * 768 + 24 * l32);
      dst[0] = (u32x2){w[0], w[1]}; dst[1] = (u32x2){w[2], w[3]}; dst[2] = (u32x2){w[4], w[5]};
      if (l32 == 0) ((float*)(ws + WS_ESC))[r] = am > 0.f ? am / 7.0f : 1.f;
    } else {
      const float sc = am > 0.f ? 440.f / am : 1.f;
      u32x4 o0, o1;
#pragma unroll
      for (int k = 0; k < 4; ++k) { int w = __builtin_amdgcn_cvt_pk_fp8_f32(xa[2 * k] * sc, xb[2 * k] * sc, 0, false); w = __builtin_amdgcn_cvt_pk_fp8_f32(xa[2 * k + 1] * sc, xb[2 * k + 1] * sc, w, true); o0[k] = (unsigned)w; }
#pragma unroll
      for (int k = 0; k < 4; ++k) { int w = __builtin_amdgcn_cvt_pk_fp8_f32(xa[8 + 2 * k] * sc, xb[8 + 2 * k] * sc, 0, false); w = __builtin_amdgcn_cvt_pk_fp8_f32(xa[8 + 2 * k + 1] * sc, xb[8 + 2 * k + 1] * sc, w, true); o1[k] = (unsigned)w; }
      u32x4* dst = (u32x4*)(ws + WS_EXU + (size_t)(l32 >> 2) * (NEXP * 128) + (size_t)e * 128 + 32 * (l32 & 3));
      dst[0] = o0; dst[1] = o1;
      if (l32 == 0) ((float*)(ws + WS_ESC))[r] = am > 0.f ? am / 440.f : 1.f;
    }
  }
  for (int i = blockIdx.x * 512 + tid; i < 2 * 65536; i += gridDim.x * 512) ((bf16_t*)(ws + WS_SK))[i] = (bf16_t)f2bf(a.in[17 + (i >> 16)][i & 65535]);
  for (int r = gw; r < NMROWS; r += ngw) rms_row_to_bf16(a.in[1] + (size_t)r * DM, (bf16_t*)(ws + WS_MEMN) + (size_t)r * DM, lane);
  __syncthreads();
  float* wf = (float*)(lds + 69632);
  for (int k = tid; k < DM; k += 512) {
    const float g = a.in[2][k]; const f32x4* wp = (const f32x4*)(a.in[3] + (size_t)k * INW + NQKV);
    const f32x4 p = wp[0], q = wp[1];
    wf[k] = p.x * g; wf[1024 + k] = p.y * g; wf[2048 + k] = p.z * g; wf[3072 + k] = p.w * g; wf[4096 + k] = q.x * g; wf[5120 + k] = q.y * g; wf[6144 + k] = q.z * g; wf[7168 + k] = q.w * g;
  }
  __syncthreads();
  float* flog = (float*)(ws + WS_FLOG);
  for (int r = gw; r < NT; r += ngw) {
    const f32x4* xr = (const f32x4*)(a.in[0] + (size_t)r * DM) + lane;
    f32x4 v[4]; float s = 0.f; float fa[8];
#pragma unroll
    for (int j = 0; j < 8; ++j) fa[j] = 0.f;
#pragma unroll
    for (int j = 0; j < 4; ++j) {
      v[j] = xr[64 * j]; s += (v[j].x * v[j].x + v[j].y * v[j].y) + (v[j].z * v[j].z + v[j].w * v[j].w);
#pragma unroll
      for (int jj = 0; jj < 8; ++jj) { const f32x4 w4 = *(const f32x4*)(wf + jj * 1024 + 256 * j + 4 * lane); fa[jj] += (v[j].x * w4.x + v[j].y * w4.y) + (v[j].z * w4.z + v[j].w * w4.w); }
    }
    const float rstd = rsqrtf(wave_sum(s) * (1.f / DM) + EPS);
    float mine = 0.f;
#pragma unroll
    for (int j = 0; j < 8; ++j) { const float t = wave_sum(fa[j]); if (lane == j) mine = t; }
    if (lane < 8) {
      const float z = mine * rstd + a.in[4][lane];
      flog[(size_t)lane * NT + r] = fminf(z, 0.f) - log1pf(expf(-fabsf(z)));
    }
    u32x2* o = (u32x2*)((bf16_t*)(ws + WS_HB) + (size_t)r * DM) + lane;
#pragma unroll
    for (int j = 0; j < 4; ++j) { u32x2 w; w.x = pk2(v[j].x * rstd, v[j].y * rstd); w.y = pk2(v[j].z * rstd, v[j].w * rstd); o[64 * j] = w; }
  }
}

template <class Epi>
__device__ __forceinline__ void gemm_naive(const bf16_t* A, int lda, const bf16_t* Bt, int ldb, int M, int N, int K, const Epi& E, int gw, int ngw, int lane) {
  const int fr = lane & 15, fq = lane >> 4;
  const int tn = N / 64, ntile = (M / 64) * tn;
  for (int tile = gw; tile < ntile; tile += ngw) {
    const int pm = tile / tn, pn = tile % tn;
    f32x4 acc[4][4];
#pragma unroll
    for (int m = 0; m < 4; ++m)
#pragma unroll
      for (int n = 0; n < 4; ++n) acc[m][n] = (f32x4){0.f, 0.f, 0.f, 0.f};
    const bf16_t* Ap = A + (size_t)(pm * 64 + fr) * lda + fq * 8;
    const bf16_t* Bp = Bt + (size_t)(pn * 64 + fr) * ldb + fq * 8;
    for (int k0 = 0; k0 < K; k0 += 32) {
      bf16x8 af[4], bfr[4];
#pragma unroll
      for (int m = 0; m < 4; ++m) af[m] = *(const bf16x8*)(Ap + (size_t)m * 16 * lda + k0);
#pragma unroll
      for (int n = 0; n < 4; ++n) bfr[n] = *(const bf16x8*)(Bp + (size_t)n * 16 * ldb + k0);
#pragma unroll
      for (int m = 0; m < 4; ++m)
#pragma unroll
        for (int n = 0; n < 4; ++n) acc[m][n] = __builtin_amdgcn_mfma_f32_16x16x32_bf16(bfr[n], af[m], acc[m][n], 0, 0, 0);
    }
#pragma unroll
    for (int m = 0; m < 4; ++m)
#pragma unroll
      for (int n = 0; n < 4; ++n) E.store(pm * 64 + m * 16 + fr, pn * 64 + n * 16 + 4 * fq, acc[m][n]);
  }
}

struct EpiBf16 { bf16_t* O; int ldo;
  __device__ __forceinline__ void store8(int row, int col, f32x4 a, f32x4 b) const { u32x4 w; w.x = pk2(a.x, a.y); w.y = pk2(a.z, a.w); w.z = pk2(b.x, b.y); w.w = pk2(b.z, b.w); *(u32x4*)(O + (size_t)row * ldo + col) = w; }
  __device__ __forceinline__ void store(int row, int col, f32x4 v) const { u32x2 w; w.x = pk2(v.x, v.y); w.y = pk2(v.z, v.w); *(u32x2*)(O + (size_t)row * ldo + col) = w; } };
struct EpiQKV { bf16_t* O;
  __device__ __forceinline__ void store8(int row, int col, f32x4 a, f32x4 b) const { const float sc = (col < 512 || (col >= 1536 && col < 2048)) ? 0.18033688011112042f : 1.f;
    u32x4 w; w.x = pk2(a.x * sc, a.y * sc); w.y = pk2(a.z * sc, a.w * sc); w.z = pk2(b.x * sc, b.y * sc); w.w = pk2(b.z * sc, b.w * sc); *(u32x4*)(O + (size_t)row * NQKV + col) = w; }
  __device__ __forceinline__ void store(int row, int col, f32x4 v) const { const float sc = (col < 512 || (col >= 1536 && col < 2048)) ? 0.18033688011112042f : 1.f;
    u32x2 w; w.x = pk2(v.x * sc, v.y * sc); w.y = pk2(v.z * sc, v.w * sc); *(u32x2*)(O + (size_t)row * NQKV + col) = w; } };
struct EpiBf16S { bf16_t* O; int ldo; const float* ss;
  __device__ __forceinline__ void store8(int row, int col, f32x4 a, f32x4 b) const { const float r = rsqrtf(ss[row] * (1.f / DM) + EPS);
    u32x4 w; w.x = pk2(a.x * r, a.y * r); w.y = pk2(a.z * r, a.w * r); w.z = pk2(b.x * r, b.y * r); w.w = pk2(b.z * r, b.w * r); *(u32x4*)(O + (size_t)row * ldo + col) = w; }
  __device__ __forceinline__ void store(int row, int col, f32x4 v) const { const float r = rsqrtf(ss[row] * (1.f / DM) + EPS); u32x2 w; w.x = pk2(v.x * r, v.y * r); w.y = pk2(v.z * r, v.w * r); *(u32x2*)(O + (size_t)row * ldo + col) = w; } };
struct EpiF32S { float* O; int ldo; const float* ss;
  __device__ __forceinline__ void store(int row, int col, f32x4 v) const { const float r = rsqrtf(ss[row] * (1.f / DM) + EPS); *(f32x4*)(O + (size_t)row * ldo + col) = v * r; } };
struct EpiF32 { float* O; int ldo;
  __device__ __forceinline__ void store(int row, int col, f32x4 v) const { *(f32x4*)(O + (size_t)row * ldo + col) = v; } };
struct EpiResid { const float* base; float* out;
  __device__ __forceinline__ void store(int row, int col, f32x4 v) const { const size_t o = (size_t)row * DM + col; const f32x4 b = *(const f32x4*)(base + o); *(f32x4*)(out + o) = b + v; } };
struct EpiKV { bf16_t* KX; bf16_t* VXT;
  __device__ __forceinline__ void store(int row, int col, f32x4 v) const {
    if (col < 1024) { u32x2 w; w.x = pk2(v.x, v.y); w.y = pk2(v.z, v.w); *(u32x2*)(KX + (size_t)row * DM + col) = w; }
    else { const int b = row >> 8, m = row & 255;
#pragma unroll
      for (int r = 0; r < 4; ++r) { const int d = col - 1024 + r; VXT[((size_t)(b * 4 + (d >> 8)) * 256 + (d & 255)) * 256 + m] = (bf16_t)f2bf(v[r]); } } } };

__device__ __forceinline__ void phase_scan(const Args& a, int gw, int ngw, int lane, int tid) {
  unsigned char* ws = a.ws;
  const bf16_t* qkv = (const bf16_t*)(ws + WS_QKV);
  for (int item = gw; item < 64 + 1024 + 1024; item += ngw) {
    if (item < 64) {
      const int b = item >> 3, j = item & 7;
      const f32x4* src = (const f32x4*)((const float*)(ws + WS_FLOG) + (size_t)j * NT + (size_t)b * SEQ + lane * 64);
      f32x4 v[16];
#pragma unroll
      for (int i = 0; i < 16; ++i) v[i] = src[i];
      float tot = 0.f;
#pragma unroll
      for (int i = 0; i < 16; ++i) tot += (v[i].x + v[i].y) + (v[i].z + v[i].w);
      float inc = tot;
#pragma unroll
      for (int o = 1; o < 64; o <<= 1) { const float t = __shfl_up(inc, o); if (lane >= o) inc += t; }
      float run = inc - tot;
      f32x4* dst = (f32x4*)((float*)(ws + WS_CUM) + ((size_t)(b * 8 + j)) * SEQ + lane * 64);
#pragma unroll
      for (int i = 0; i < 16; ++i) { f32x4 o; run += v[i].x; o.x = run * 1.4426950408889634f; run += v[i].y; o.y = run * 1.4426950408889634f; run += v[i].z; o.z = run * 1.4426950408889634f; run += v[i].w; o.w = run * 1.4426950408889634f; dst[i] = o; }
    } else if (item < 64 + 1024) {
      const int it = item - 64, h = it & 7, blk = (it >> 3) & 15, b = it >> 7;
      const bf16_t* p = qkv + ((size_t)b * SEQ + blk * 256 + (lane >> 3)) * NQKV + 512 + h * 64 + (lane & 7) * 8;
      float s[8];
#pragma unroll
      for (int i = 0; i < 8; ++i) s[i] = 0.f;
#pragma unroll 8
      for (int rr = 0; rr < 32; ++rr) { float f[8]; unpack8(*(const u32x4*)(p + (size_t)rr * 8 * NQKV), f);
#pragma unroll
        for (int i = 0; i < 8; ++i) s[i] += f[i]; }
#pragma unroll
      for (int i = 0; i < 8; ++i) { s[i] += __shfl_xor(s[i], 8); s[i] += __shfl_xor(s[i], 16); s[i] += __shfl_xor(s[i], 32); }
      if (lane < 8) { f32x4* d = (f32x4*)((float*)(ws + WS_KMEAN) + ((size_t)(b * 16 + blk) * 8 + h) * 64 + lane * 8);
        d[0] = (f32x4){s[0], s[1], s[2], s[3]} * (1.f / 256.f); d[1] = (f32x4){s[4], s[5], s[6], s[7]} * (1.f / 256.f); }
    } else {
      const int it = item - 64 - 1024, bh = it >> 4, ch = it & 15, b = bh >> 3, h = bh & 7;
      const bf16_t* p = qkv + ((size_t)b * SEQ + ch * 256 + (lane >> 3)) * NQKV + 2048 + h * 64 + (lane & 7) * 8;
      float m = 0.f;
#pragma unroll 8
      for (int rr = 0; rr < 32; ++rr) { float f[8]; unpack8(*(const u32x4*)(p + (size_t)rr * 8 * NQKV), f);
        float s = 0.f;
#pragma unroll
        for (int i = 0; i < 8; ++i) s += f[i] * f[i];
        s += __shfl_xor(s, 1); s += __shfl_xor(s, 2); s += __shfl_xor(s, 4);
        m = fmaxf(m, s); }
#pragma unroll
      for (int o = 8; o < 64; o <<= 1) m = fmaxf(m, __shfl_xor(m, o));
      if (lane == 0) atomicMax((unsigned*)(ws + 256) + bh, __float_as_uint(m));
    }
  }
}

template <int MODE>
__device__ __forceinline__ void attn_naive_unit(const Args& a, unsigned char* lds, int b, int h, int sb, int tid) {
  unsigned char* ws = a.ws;
  const bf16_t* qkv = (const bf16_t*)(ws + WS_QKV);
  const int qoff = MODE ? 1536 : 0, koff = qoff + 512, voff = qoff + 1024;
  float* Ks = (float*)lds; float* Vs = Ks + 64 * 64; float* ck = Vs + 64 * 64; float* biasd = ck + 64;
  const int t = sb * 512 + tid; const size_t row = (size_t)b * SEQ + t;
  float q[64], o[64];
  {
    const u32x4* qp = (const u32x4*)(qkv + row * NQKV + qoff + h * 64);
#pragma unroll
    for (int c = 0; c < 8; ++c) { const u32x4 w = qp[c]; unpack8(w, q + 8 * c); }
#pragma unroll
    for (int d = 0; d < 64; ++d) { q[d] *= 0.6931471805599453f; o[d] = 0.f; }
  }
  float m = -1e30f, l = 0.f;
  unsigned selmask = 0u; const int own = t >> 8;
  float cq = 0.f, bfar = 0.f;
  __syncthreads();
  if (MODE == 0) {
    if (tid < 128) biasd[tid] = a.in[5][T5_BUCKET[tid] * 8 + h];
    bfar = a.in[5][31 * 8 + h];
    const float* km = (const float*)(ws + WS_KMEAN) + ((size_t)b * 16) * 512 + h * 64;
    float v0 = -3e38f, v1 = -3e38f, v2 = -3e38f; int i0 = -1, i1 = -1, i2 = -1;
    for (int n = 0; n < 2 * sb + 1; ++n) {
      if (n < own) {
        const float* kp = km + (size_t)n * 512; float s = 0.f;
#pragma unroll
        for (int d = 0; d < 64; ++d) s += q[d] * kp[d];
        if (s > v0) { v2 = v1; i2 = i1; v1 = v0; i1 = i0; v0 = s; i0 = n; }
        else if (s > v1) { v2 = v1; i2 = i1; v1 = s; i1 = n; }
        else if (s > v2) { v2 = s; i2 = n; }
      }
    }
    if (i0 >= 0) selmask |= 1u << i0;
    if (i1 >= 0) selmask |= 1u << i1;
    if (i2 >= 0) selmask |= 1u << i2;
  } else {
    cq = ((const float*)(ws + WS_CUM))[((size_t)(b * 8 + h)) * SEQ + t];
  }
  const int ntile = 8 * (sb + 1);
  for (int kt = 0; kt < ntile; ++kt) {
    __syncthreads();
    {
      const int r = tid >> 3, ch = tid & 7;
      const bf16_t* kp = qkv + ((size_t)b * SEQ + kt * 64 + r) * NQKV + h * 64 + ch * 8;
      const u32x4 kw = *(const u32x4*)(kp + koff), vw = *(const u32x4*)(kp + voff);
      unpack8(kw, Ks + r * 64 + ch * 8); unpack8(vw, Vs + r * 64 + ch * 8);
      if (MODE == 1 && tid < 64) ck[tid] = ((const float*)(ws + WS_CUM))[((size_t)(b * 8 + h)) * SEQ + kt * 64 + tid];
    }
    __syncthreads();
    const int kb = kt >> 2;
    bool act;
    if (MODE == 0) act = (kb == own) || (kb < own && ((selmask >> kb) & 1u));
    else act = (kt * 64 <= t);
    if (act) {
      for (int jj = 0; jj < 64; ++jj) {
        const int sp = kt * 64 + jj;
        if (sp > t) break;
        const f32x4* kr = (const f32x4*)(Ks + jj * 64);
        float s = 0.f;
#pragma unroll
        for (int c = 0; c < 16; ++c) { const f32x4 kv = kr[c]; s += q[4 * c] * kv.x + q[4 * c + 1] * kv.y + q[4 * c + 2] * kv.z + q[4 * c + 3] * kv.w; }
        if (MODE == 0) { const int dist = t - sp; s += (dist < 128) ? biasd[dist] : bfar; }
        else s += (cq - ck[jj]) * 0.6931471805599453f;
        if (s > m) { const float f = __expf(m - s); l *= f;
#pragma unroll
          for (int d = 0; d < 64; ++d) o[d] *= f;
          m = s; }
        const float p = __expf(s - m); l += p;
        const f32x4* vr = (const f32x4*)(Vs + jj * 64);
#pragma unroll
        for (int c = 0; c < 16; ++c) { const f32x4 vv = vr[c]; o[4 * c] += p * vv.x; o[4 * c + 1] += p * vv.y; o[4 * c + 2] += p * vv.z; o[4 * c + 3] += p * vv.w; }
      }
    }
  }
  const float il = 1.f / l;
  u32x4* op = (u32x4*)((bf16_t*)(ws + WS_OAB) + row * DM + (MODE ? 512 : 0) + h * 64);
#pragma unroll
  for (int c = 0; c < 8; ++c) { u32x4 w; w.x = pk2(o[8 * c] * il, o[8 * c + 1] * il); w.y = pk2(o[8 * c + 2] * il, o[8 * c + 3] * il); w.z = pk2(o[8 * c + 4] * il, o[8 * c + 5] * il); w.w = pk2(o[8 * c + 6] * il, o[8 * c + 7] * il); op[c] = w; }
}

__device__ __forceinline__ void phase_attn(const Args& a, unsigned char* lds, int tid) {
  for (int u = blockIdx.x; u < 1024; u += gridDim.x) {
    const int sb = 7 - (u >> 7), r = u & 127, mode = r & 1, bh = r >> 1;
    if (mode == 0) attn_naive_unit<0>(a, lds, bh >> 3, bh & 7, sb, tid);
    else attn_naive_unit<1>(a, lds, bh >> 3, bh & 7, sb, tid);
  }
}

namespace att {
typedef float f32x16 __attribute__((ext_vector_type(16)));
typedef short s16x4 __attribute__((ext_vector_type(4)));
typedef short v4i16_t __attribute__((ext_vector_type(4)));
typedef __attribute__((address_space(3))) const char* lds_cptr;
typedef float f32x2_t __attribute__((ext_vector_type(2))); typedef __bf16 bf16x2_t __attribute__((ext_vector_type(2)));
constexpr int PITCH = NQKV;
constexpr float LOG2E = 1.4426950408889634f;
constexpr float C2 = 0.125f * LOG2E;
constexpr int L_K = 0, L_V = 16384, L_WSF = 32768, L_OST = 34816, L_C2 = 67584, L_KM = 83968, L_BT = 88064, L_MISC = 88704;
__device__ __forceinline__ int crow(int r, int hi) { return (r & 3) + 8 * (r >> 2) + 4 * hi; }
__device__ __forceinline__ unsigned cvtpk(float lo, float hi) { f32x2_t v = {lo, hi}; bf16x2_t b = __builtin_convertvector(v, bf16x2_t); return __builtin_bit_cast(unsigned, b); }
__device__ __forceinline__ s16x4 vtr(lds_cptr p) { return __builtin_bit_cast(s16x4, __builtin_amdgcn_ds_read_tr16_b64_v4i16((__attribute__((address_space(3))) v4i16_t*)p)); }
__device__ __forceinline__ float max3f(float a, float b, float c) { float r; asm("v_max3_f32 %0, %1, %2, %3" : "=v"(r) : "v"(a), "v"(b), "v"(c)); return r; }
__device__ __forceinline__ float xhalf_max(float m) { auto rr = __builtin_amdgcn_permlane32_swap(__float_as_uint(m), __float_as_uint(m), false, false); return fmaxf(__uint_as_float(rr[0]), __uint_as_float(rr[1])); }
__device__ __forceinline__ float xhalf_sum(float m) { auto rr = __builtin_amdgcn_permlane32_swap(__float_as_uint(m), __float_as_uint(m), false, false); return __uint_as_float(rr[0]) + __uint_as_float(rr[1]); }

template <int MODE>
__device__ __forceinline__ void unit(const Args& a, unsigned char* lds, int b, int h, int qb, int tid) {
  unsigned char* ws = a.ws;
  const int lane = tid & 63, r32 = lane & 31, hi = lane >> 5; const int wid = __builtin_amdgcn_readfirstlane(tid >> 6);
  const bf16_t* qkv = (const bf16_t*)(ws + WS_QKV);
  const int qoff = MODE ? 1536 : 0;
  const size_t rowbase = (size_t)b * SEQ; const int q0 = qb * 256;
  const bf16_t* Qw = qkv + (rowbase + q0 + wid * 32) * PITCH + qoff + h * 64;
  const bf16_t* Kh = qkv + rowbase * PITCH + qoff + 512 + h * 64;
  const bf16_t* Vh = qkv + rowbase * PITCH + qoff + 1024 + h * 64;
  float* wsf = (float*)(lds + L_WSF) + wid * 64;
  float* c2s = (float*)(lds + L_C2); float* kms = (float*)(lds + L_KM); float* bts = (float*)(lds + L_BT); unsigned* misc = (unsigned*)(lds + L_MISC);
  const int NTL = 4 * (qb + 1);
  __syncthreads();
  if (MODE == 0) {
    const float* km = (const float*)(ws + WS_KMEAN) + (size_t)b * 16 * 512 + h * 64;
    for (int i = tid; i < 16 * 64; i += 512) kms[i] = km[(size_t)(i >> 6) * 512 + (i & 63)];
    if (tid < 128) bts[tid] = a.in[5][T5_BUCKET[tid] * 8 + h] * LOG2E;
    if (tid == 128) bts[128] = a.in[5][31 * 8 + h] * LOG2E;
  } else {
    const float* cg = (const float*)(ws + WS_CUM) + (size_t)(b * 8 + h) * SEQ;
    for (int i = tid; i < 256 * (qb + 1); i += 512) c2s[i] = cg[i];
    if (tid == 0) misc[0] = 0u;
  }
  bf16x8 qr[4];
#pragma unroll
  for (int d0 = 0; d0 < 4; ++d0) qr[d0] = *(const bf16x8*)(Qw + (size_t)r32 * PITCH + d0 * 16 + hi * 8);
  __syncthreads();
  unsigned selmask = 0u; float cq2 = 0.f, far2 = 0.f, mhat = 0.f; int t0 = 0;
  if (MODE == 0) {
    far2 = bts[128];
    float v0 = -3e38f, v1 = -3e38f, v2 = -3e38f; int i0 = -1, i1 = -1, i2 = -1;
    for (int n = 0; n < qb; ++n) {
      float s = 0.f;
#pragma unroll
      for (int d0 = 0; d0 < 4; ++d0)
#pragma unroll
        for (int j = 0; j < 8; ++j) s += bf2f((unsigned short)qr[d0][j]) * kms[n * 64 + d0 * 16 + hi * 8 + j];
      s = xhalf_sum(s);
      if (s > v0) { v2 = v1; i2 = i1; v1 = v0; i1 = i0; v0 = s; i0 = n; }
      else if (s > v1) { v2 = v1; i2 = i1; v1 = s; i1 = n; }
      else if (s > v2) { v2 = s; i2 = n; }
    }
    if (i0 >= 0) selmask |= 1u << i0;
    if (i1 >= 0) selmask |= 1u << i1;
    if (i2 >= 0) selmask |= 1u << i2;
  } else {
    cq2 = c2s[q0 + wid * 32 + r32];
    float s = 0.f;
#pragma unroll
    for (int d0 = 0; d0 < 4; ++d0)
#pragma unroll
      for (int j = 0; j < 8; ++j) { const float f = bf2f((unsigned short)qr[d0][j]); s += f * f; }
    s = xhalf_sum(s);
    atomicMax(&misc[0], __float_as_uint(s));
    __syncthreads();
    const float kn2 = __uint_as_float(((const unsigned*)(ws + 256))[b * 8 + h]);
    const float qkb = sqrtf(__uint_as_float(misc[0]) * kn2) * 1.0001f + 1e-3f;
    mhat = -qkb;
    const int j = lane; bool skip = false;
    if (j < NTL) skip = (2.f * qkb + c2s[q0] - c2s[64 * j + 63]) < -150.f;
    t0 = __popcll(__ballot(skip));
    if (t0 > NTL - 1) t0 = NTL - 1;
  }
  const bf16_t* ksrc = Kh + (size_t)lane * PITCH + wid * 8;
  const bf16_t* vsrc = Vh + (size_t)(16 * (wid & 3) + (lane >> 2)) * PITCH + (wid >> 2) * 32 + (lane & 3) * 8;
  unsigned char* kdst = lds + L_K + wid * 1024 + lane * 16; unsigned char* vdst = lds + L_V + wid * 1024 + lane * 16;
  const lds_cptr lds3 = (lds_cptr)lds;
  const lds_cptr vp0 = lds3 + L_V + ((lane >> 4) & 1) * 32 + (lane & 3) * 8 + (4 * hi + ((lane & 15) >> 2)) * 64;
  u32x4 kreg = *(const u32x4*)(ksrc + (size_t)t0 * 64 * PITCH), vreg = *(const u32x4*)(vsrc + (size_t)t0 * 64 * PITCH);
  *(u32x4*)(kdst + (t0 & 1) * 8192) = kreg; *(u32x4*)(vdst + (t0 & 1) * 8192) = vreg;
  f32x16 o[2]; o[0] = f32x16{}; o[1] = f32x16{};
  f32x16 ol = f32x16{}, cm = f32x16{}; int cm_nb = -1;
  const int qrel = wid * 32 + r32, qpos = q0 + qrel;
  __syncthreads();
  for (int t = t0; t < NTL; ++t) {
    const int buf = (t & 1) * 8192;
    if (t + 1 < NTL) { kreg = *(const u32x4*)(ksrc + (size_t)(t + 1) * 64 * PITCH); vreg = *(const u32x4*)(vsrc + (size_t)(t + 1) * 64 * PITCH); }
    const int jb = t - (NTL - 4);
    const bool compute = !(jb >= 0 && 64 * jb > wid * 32 + 31);
    if (compute) {
      f32x16 p0, p1;
      bf16x8 kf[8];
      {
        const lds_cptr kb = lds3 + L_K + buf + hi * 1024 + r32 * 16;
#pragma unroll
        for (int d0 = 0; d0 < 4; ++d0) { kf[2 * d0] = *(const __attribute__((address_space(3))) bf16x8*)(kb + d0 * 2048); kf[2 * d0 + 1] = *(const __attribute__((address_space(3))) bf16x8*)(kb + d0 * 2048 + 512); }
      }
      __builtin_amdgcn_sched_barrier(0);
      if (MODE == 0) {
        const int nb = t >> 2;
        const bool near = (jb >= 0) || (t >= NTL - 6 && wid < 4);
        if (near) {
#pragma unroll
          for (int r = 0; r < 16; ++r) { const int d = qpos - (64 * t + crow(r, hi));
            p0[r] = bts[min(max(d, 0), 128)] - mhat; p1[r] = bts[min(max(d - 32, 0), 128)] - mhat; }
          if (jb < 0 && !((selmask >> nb) & 1u)) {
#pragma unroll
            for (int r = 0; r < 16; ++r) { p0[r] = -INFINITY; p1[r] = -INFINITY; }
          }
        } else {
          if (cm_nb != nb) {
            const float base = ((selmask >> nb) & 1u) ? far2 - mhat : -INFINITY;
#pragma unroll
            for (int r = 0; r < 16; ++r) cm[r] = base;
            cm_nb = nb;
          }
          p0 = cm; p1 = cm;
        }
      } else {
        const float cqm = cq2 - mhat;
#pragma unroll
        for (int g = 0; g < 4; ++g) {
          const f32x4 ca = *(const f32x4*)(c2s + 64 * t + 8 * g + 4 * hi), cb = *(const f32x4*)(c2s + 64 * t + 32 + 8 * g + 4 * hi);
#pragma unroll
          for (int i = 0; i < 4; ++i) { p0[4 * g + i] = cqm - ca[i]; p1[4 * g + i] = cqm - cb[i]; }
        }
      }
#pragma unroll
      for (int d0 = 0; d0 < 4; ++d0) {
        p0 = __builtin_amdgcn_mfma_f32_32x32x16_bf16(kf[2 * d0], qr[d0], p0, 0, 0, 0);
        p1 = __builtin_amdgcn_mfma_f32_32x32x16_bf16(kf[2 * d0 + 1], qr[d0], p1, 0, 0, 0);
      }
      if (jb >= 0) {
        asm volatile("" ::: "memory");
        const int kb0 = 64 * jb + 4 * hi;
#pragma unroll
        for (int r = 0; r < 16; ++r) { const int kv = kb0 + (r & 3) + 8 * (r >> 2); if (kv > qrel) p0[r] = -INFINITY; if (kv + 32 > qrel) p1[r] = -INFINITY; }
      }
      asm volatile("s_nop 15\n\ts_nop 7" : "+v"(p0), "+v"(p1));
      float rm, rm2;
      rm = max3f(p0[0], p0[1], p1[0]); rm2 = max3f(p0[2], p0[3], p1[1]); rm = max3f(rm, p1[2], p1[3]);
#pragma unroll
      for (int r = 4; r < 16; r += 4) { rm = max3f(rm, p0[r], p0[r + 1]); rm2 = max3f(rm2, p0[r + 2], p0[r + 3]); rm = max3f(rm, p1[r], p1[r + 1]); rm2 = max3f(rm2, p1[r + 2], p1[r + 3]); }
      rm = xhalf_max(fmaxf(rm, rm2));
      if (__any(rm > 6.0f)) {
        const float dl = fmaxf(rm, 0.f), alpha = __builtin_amdgcn_exp2f(-dl);
        mhat += dl; cm_nb = -1;
#pragma unroll
        for (int r = 0; r < 16; ++r) { p0[r] -= dl; p1[r] -= dl; }
        if (hi == 0) wsf[r32] = alpha;
        __builtin_amdgcn_wave_barrier();
#pragma unroll
        for (int r = 0; r < 16; ++r) { const float f = wsf[crow(r, hi)]; o[0][r] *= f; o[1][r] *= f; ol[r] *= f; }
        __builtin_amdgcn_wave_barrier();
      }
#pragma unroll
      for (int r = 0; r < 16; ++r) { p0[r] = __builtin_amdgcn_exp2f(p0[r]); p1[r] = __builtin_amdgcn_exp2f(p1[r]); }
      u32x4 pw0, pw1, pw2, pw3;
      pw0 = (u32x4){cvtpk(p0[0], p0[1]), cvtpk(p0[2], p0[3]), cvtpk(p0[4], p0[5]), cvtpk(p0[6], p0[7])};
      pw1 = (u32x4){cvtpk(p0[8], p0[9]), cvtpk(p0[10], p0[11]), cvtpk(p0[12], p0[13]), cvtpk(p0[14], p0[15])};
      pw2 = (u32x4){cvtpk(p1[0], p1[1]), cvtpk(p1[2], p1[3]), cvtpk(p1[4], p1[5]), cvtpk(p1[6], p1[7])};
      pw3 = (u32x4){cvtpk(p1[8], p1[9]), cvtpk(p1[10], p1[11]), cvtpk(p1[12], p1[13]), cvtpk(p1[14], p1[15])};
      {
        const bf16x8 ones = (bf16x8){0x3F80, 0x3F80, 0x3F80, 0x3F80, 0x3F80, 0x3F80, 0x3F80, 0x3F80};
        ol = __builtin_amdgcn_mfma_f32_32x32x16_bf16(__builtin_bit_cast(bf16x8, pw0), ones, ol, 0, 0, 0);
        ol = __builtin_amdgcn_mfma_f32_32x32x16_bf16(__builtin_bit_cast(bf16x8, pw1), ones, ol, 0, 0, 0);
        ol = __builtin_amdgcn_mfma_f32_32x32x16_bf16(__builtin_bit_cast(bf16x8, pw2), ones, ol, 0, 0, 0);
        ol = __builtin_amdgcn_mfma_f32_32x32x16_bf16(__builtin_bit_cast(bf16x8, pw3), ones, ol, 0, 0, 0);
      }
      const lds_cptr vp = vp0 + buf;
#pragma unroll
      for (int d0 = 0; d0 < 2; ++d0) {
#define ATT_VF(ks) ({ const s16x4 lo_ = vtr(vp + d0 * 4096 + (ks) * 1024), hi_ = vtr(vp + d0 * 4096 + (ks) * 1024 + 512); (bf16x8){lo_[0], lo_[1], lo_[2], lo_[3], hi_[0], hi_[1], hi_[2], hi_[3]}; })
        o[d0] = __builtin_amdgcn_mfma_f32_32x32x16_bf16(__builtin_bit_cast(bf16x8, pw0), ATT_VF(0), o[d0], 0, 0, 0);
        o[d0] = __builtin_amdgcn_mfma_f32_32x32x16_bf16(__builtin_bit_cast(bf16x8, pw1), ATT_VF(1), o[d0], 0, 0, 0);
        o[d0] = __builtin_amdgcn_mfma_f32_32x32x16_bf16(__builtin_bit_cast(bf16x8, pw2), ATT_VF(2), o[d0], 0, 0, 0);
        o[d0] = __builtin_amdgcn_mfma_f32_32x32x16_bf16(__builtin_bit_cast(bf16x8, pw3), ATT_VF(3), o[d0], 0, 0, 0);
#undef ATT_VF
      }
    }
    if (t + 1 < NTL) { *(u32x4*)(kdst + ((t + 1) & 1) * 8192) = kreg; *(u32x4*)(vdst + ((t + 1) & 1) * 8192) = vreg; }
    __syncthreads();
  }
  bf16_t* stg = (bf16_t*)(lds + L_OST) + wid * 2048;
#pragma unroll
  for (int r = 0; r < 16; ++r) { const int orow = crow(r, hi); const float rl = 1.f / ol[r];
    stg[orow * 64 + r32] = (bf16_t)f2bf(o[0][r] * rl); stg[orow * 64 + 32 + r32] = (bf16_t)f2bf(o[1][r] * rl); }
  __builtin_amdgcn_wave_barrier();
  bf16_t* Ow = (bf16_t*)(ws + WS_OAB) + (rowbase + q0 + wid * 32) * DM + (MODE ? 512 : 0) + h * 64;
#pragma unroll
  for (int i = 0; i < 4; ++i) { const int row = i * 8 + (lane >> 3), ch = lane & 7; const u32x4 v = *(const u32x4*)(stg + row * 64 + ch * 8); *(u32x4*)(Ow + (size_t)row * DM + ch * 8) = v; }
}
}

__device__ __forceinline__ void phase_attn2(const Args& a, unsigned char* lds, int tid) {
  unsigned* ctr = (unsigned*)(a.ws + 0);
  unsigned* slot = (unsigned*)(lds + att::L_MISC + 64);
  for (;;) {
    __syncthreads();
    if (tid == 0) slot[0] = atomicAdd(ctr, 1u);
    __syncthreads();
    const unsigned u = slot[0];
    if (u >= 2048u) break;
    const int qb = 15 - (int)(u >> 7), r = u & 127, mode = r & 1, bh = r >> 1;
    if (mode == 0) att::unit<0>(a, lds, bh >> 3, bh & 7, qb, tid);
    else att::unit<1>(a, lds, bh >> 3, bh & 7, qb, tid);
  }
}

__device__ __forceinline__ void phase_onorm(const Args& a, int gw, int ngw, int lane) {
  bf16_t* oab = (bf16_t*)(a.ws + WS_OAB);
  for (int r = gw; r < NT; r += ngw) {
    u32x4* p = (u32x4*)(oab + (size_t)r * DM) + 2 * lane;
    const u32x4 w0 = p[0], w1 = p[1]; float f[16]; unpack8(w0, f); unpack8(w1, f + 8);
    float s = 0.f;
#pragma unroll
    for (int i = 0; i < 16; ++i) s += f[i] * f[i];
#pragma unroll
    for (int o = 1; o < 32; o <<= 1) s += __shfl_xor(s, o);
    const float rstd = rsqrtf(s * (1.f / 512.f) + EPS);
    u32x4 o0, o1;
    o0.x = pk2(f[0] * rstd, f[1] * rstd); o0.y = pk2(f[2] * rstd, f[3] * rstd); o0.z = pk2(f[4] * rstd, f[5] * rstd); o0.w = pk2(f[6] * rstd, f[7] * rstd);
    o1.x = pk2(f[8] * rstd, f[9] * rstd); o1.y = pk2(f[10] * rstd, f[11] * rstd); o1.z = pk2(f[12] * rstd, f[13] * rstd); o1.w = pk2(f[14] * rstd, f[15] * rstd);
    p[0] = o0; p[1] = o1;
  }
}

__device__ __forceinline__ void phase_rms(const Args& a, int gw, int ngw, int lane) {
  for (int r = gw; r < NT; r += ngw) rms_row_to_bf16(a.out + (size_t)r * DM, (bf16_t*)(a.ws + WS_HB) + (size_t)r * DM, lane);
}

__device__ __forceinline__ void phase_xattn(const Args& a, unsigned char* lds, int gw, int ngw, int wave, int lane) {
  unsigned char* ws = a.ws;
  const bf16_t* qx = (const bf16_t*)(ws + WS_QX); const bf16_t* kx = (const bf16_t*)(ws + WS_KX); const bf16_t* vxt = (const bf16_t*)(ws + WS_VXT);
  bf16_t* ox = (bf16_t*)(ws + WS_OX);
  bf16_t* P = (bf16_t*)(lds + wave * 8192);
  const int fr = lane & 15, fq = lane >> 4;
  for (int u = gw; u < (NT / 16) * 4; u += ngw) {
    const int hd = u & 3, r0 = (u >> 2) * 16, b = r0 / SEQ;
    f32x4 acc[16];
#pragma unroll
    for (int i = 0; i < 16; ++i) acc[i] = (f32x4){0.f, 0.f, 0.f, 0.f};
    const bf16_t* Ap = qx + (size_t)(r0 + fr) * DM + hd * 256 + fq * 8;
    const bf16_t* Bp = kx + (size_t)(b * 256 + fr) * DM + hd * 256 + fq * 8;
    for (int ks = 0; ks < 8; ++ks) {
      const bf16x8 af = *(const bf16x8*)(Ap + ks * 32);
#pragma unroll
      for (int ct = 0; ct < 16; ++ct) { const bf16x8 bfr = *(const bf16x8*)(Bp + (size_t)ct * 16 * DM + ks * 32); acc[ct] = __builtin_amdgcn_mfma_f32_16x16x32_bf16(af, bfr, acc[ct], 0, 0, 0); }
    }
    float mx[4], sm[4];
#pragma unroll
    for (int r = 0; r < 4; ++r) { float m = acc[0][r];
#pragma unroll
      for (int ct = 1; ct < 16; ++ct) m = fmaxf(m, acc[ct][r]);
#pragma unroll
      for (int o = 1; o < 16; o <<= 1) m = fmaxf(m, __shfl_xor(m, o));
      mx[r] = m; sm[r] = 0.f; }
#pragma unroll
    for (int ct = 0; ct < 16; ++ct)
#pragma unroll
      for (int r = 0; r < 4; ++r) { const float p = __expf((acc[ct][r] - mx[r]) * 0.0625f); acc[ct][r] = p; sm[r] += p; }
#pragma unroll
    for (int r = 0; r < 4; ++r) {
#pragma unroll
      for (int o = 1; o < 16; o <<= 1) sm[r] += __shfl_xor(sm[r], o);
      sm[r] = 1.f / sm[r]; }
    __builtin_amdgcn_wave_barrier();
#pragma unroll
    for (int ct = 0; ct < 16; ++ct)
#pragma unroll
      for (int r = 0; r < 4; ++r) P[(4 * fq + r) * 256 + ct * 16 + fr] = (bf16_t)f2bf(acc[ct][r] * sm[r]);
    __builtin_amdgcn_wave_barrier();
    asm volatile("s_waitcnt lgkmcnt(0)" ::: "memory");
#pragma unroll
    for (int i = 0; i < 16; ++i) acc[i] = (f32x4){0.f, 0.f, 0.f, 0.f};
    const bf16_t* Vp = vxt + ((size_t)(b * 4 + hd) * 256 + fr) * 256 + fq * 8;
    for (int ks = 0; ks < 8; ++ks) {
      const bf16x8 pf = *(const bf16x8*)(P + fr * 256 + ks * 32 + fq * 8);
#pragma unroll
      for (int dt = 0; dt < 16; ++dt) { const bf16x8 vf = *(const bf16x8*)(Vp + (size_t)dt * 16 * 256 + ks * 32); acc[dt] = __builtin_amdgcn_mfma_f32_16x16x32_bf16(pf, vf, acc[dt], 0, 0, 0); }
    }
#pragma unroll
    for (int dt = 0; dt < 16; ++dt)
#pragma unroll
      for (int r = 0; r < 4; ++r) ox[(size_t)(r0 + 4 * fq + r) * DM + hd * 256 + dt * 16 + fr] = (bf16_t)f2bf(acc[dt][r]);
    __builtin_amdgcn_wave_barrier();
  }
}

namespace xa {
using att::f32x16; using att::s16x4; using att::lds_cptr; using att::crow; using att::cvtpk; using att::vtr; using att::xhalf_max; using att::xhalf_sum;
constexpr int L_WSF = 65536;
__device__ __forceinline__ void unit(const Args& a, unsigned char* lds, int b, int hd, int qb, int tid) {
  unsigned char* ws = a.ws;
  const int lane = tid & 63, r32 = lane & 31, hi = lane >> 5; const int wid = __builtin_amdgcn_readfirstlane(tid >> 6);
  const bf16_t* qrow = (const bf16_t*)(ws + WS_QX) + ((size_t)b * SEQ + qb * 256 + wid * 32 + r32) * DM + hd * 256;
  const bf16_t* kvb = (const bf16_t*)(ws + WS_KX) + (size_t)b * 256 * 2048 + hd * 256;
  const bf16_t* ksrc = kvb + (size_t)lane * 2048 + wid * 8;
  const bf16_t* vsrc = kvb + 1024 + (size_t)(16 * (wid & 3) + (lane >> 2)) * 2048 + (wid >> 2) * 32 + (lane & 3) * 8;
  unsigned char* sdst = lds + wid * 1024 + lane * 16;
  const lds_cptr lds3 = (lds_cptr)lds;
  const lds_cptr kp0 = lds3 + hi * 1024 + r32 * 16;
  const lds_cptr vp0 = lds3 + ((lane >> 4) & 1) * 32 + (lane & 3) * 8 + (4 * hi + ((lane & 15) >> 2)) * 64;
  float* wsf = (float*)(lds + L_WSF) + wid * 64;
  u32x4 sreg[4];
#define XA_LOADK(c) do { _Pragma("unroll") for (int kt = 0; kt < 4; ++kt) sreg[kt] = *(const u32x4*)(ksrc + (size_t)kt * 64 * 2048 + (c) * 64); } while (0)
#define XA_LOADV(vt) do { _Pragma("unroll") for (int dq = 0; dq < 4; ++dq) sreg[dq] = *(const u32x4*)(vsrc + (size_t)(vt) * 64 * 2048 + dq * 64); } while (0)
#define XA_WRITE(buf) do { _Pragma("unroll") for (int i = 0; i < 4; ++i) *(u32x4*)(sdst + (buf) * 32768 + i * 8192) = sreg[i]; } while (0)
  __syncthreads();
  XA_LOADK(0); XA_WRITE(0);
  f32x16 acc[8];
#pragma unroll
  for (int j = 0; j < 8; ++j) acc[j] = f32x16{};
  __syncthreads();
#pragma unroll
  for (int c = 0; c < 4; ++c) {
    if (c < 3) XA_LOADK(c + 1); else XA_LOADV(0);
    bf16x8 qf[4];
#pragma unroll
    for (int d0 = 0; d0 < 4; ++d0) qf[d0] = *(const bf16x8*)(qrow + c * 64 + d0 * 16 + hi * 8);
    const lds_cptr kp = kp0 + (c & 1) * 32768;
#pragma unroll
    for (int d0 = 0; d0 < 4; ++d0)
#pragma unroll
      for (int j = 0; j < 8; ++j) {
        const bf16x8 kf = *(const __attribute__((address_space(3))) bf16x8*)(kp + (j >> 1) * 8192 + d0 * 2048 + (j & 1) * 512);
        acc[j] = __builtin_amdgcn_mfma_f32_32x32x16_bf16(kf, qf[d0], acc[j], 0, 0, 0);
      }
    XA_WRITE((c + 1) & 1);
    __syncthreads();
  }
  float m = acc[0][0];
#pragma unroll
  for (int j = 0; j < 8; ++j)
#pragma unroll
    for (int r = 0; r < 16; ++r) m = fmaxf(m, acc[j][r]);
  m = xhalf_max(m);
  constexpr float CS = 1.4426950408889634f / 16.f;
  float l = 0.f; u32x4 pw[16];
#pragma unroll
  for (int j = 0; j < 8; ++j) {
#pragma unroll
    for (int r = 0; r < 16; ++r) { const float p = __builtin_amdgcn_exp2f((acc[j][r] - m) * CS); acc[j][r] = p; l += p; }
    pw[2 * j] = (u32x4){cvtpk(acc[j][0], acc[j][1]), cvtpk(acc[j][2], acc[j][3]), cvtpk(acc[j][4], acc[j][5]), cvtpk(acc[j][6], acc[j][7])};
    pw[2 * j + 1] = (u32x4){cvtpk(acc[j][8], acc[j][9]), cvtpk(acc[j][10], acc[j][11]), cvtpk(acc[j][12], acc[j][13]), cvtpk(acc[j][14], acc[j][15])};
  }
  l = xhalf_sum(l);
#pragma unroll
  for (int j = 0; j < 8; ++j) acc[j] = f32x16{};
#pragma unroll
  for (int vt = 0; vt < 4; ++vt) {
    if (vt < 3) XA_LOADV(vt + 1);
    const lds_cptr vp = vp0 + (vt & 1) * 32768;
#pragma unroll
    for (int ks = 0; ks < 4; ++ks)
#pragma unroll
      for (int db = 0; db < 8; ++db) {
        const s16x4 lo_ = vtr(vp + (db >> 1) * 8192 + (db & 1) * 4096 + ks * 1024), hi_ = vtr(vp + (db >> 1) * 8192 + (db & 1) * 4096 + ks * 1024 + 512);
        const bf16x8 vf = (bf16x8){lo_[0], lo_[1], lo_[2], lo_[3], hi_[0], hi_[1], hi_[2], hi_[3]};
        acc[db] = __builtin_amdgcn_mfma_f32_32x32x16_bf16(__builtin_bit_cast(bf16x8, pw[4 * vt + ks]), vf, acc[db], 0, 0, 0);
      }
    if (vt < 3) XA_WRITE((vt + 1) & 1);
    __syncthreads();
  }
  if (hi == 0) wsf[r32] = l;
  __builtin_amdgcn_wave_barrier();
  float rl[16];
#pragma unroll
  for (int r = 0; r < 16; ++r) rl[r] = 1.f / wsf[crow(r, hi)];
  bf16_t* stg = (bf16_t*)(lds + wid * 8192);
  bf16_t* orow0 = (bf16_t*)(ws + WS_OX) + ((size_t)b * SEQ + qb * 256 + wid * 32) * DM + hd * 256;
#pragma unroll
  for (int hf = 0; hf < 2; ++hf) {
#pragma unroll
    for (int db = 0; db < 4; ++db)
#pragma unroll
      for (int r = 0; r < 16; ++r) stg[crow(r, hi) * 128 + db * 32 + r32] = (bf16_t)f2bf(acc[hf * 4 + db][r] * rl[r]);
    __builtin_amdgcn_wave_barrier();
#pragma unroll
    for (int i = 0; i < 8; ++i) { const int row = i * 4 + (lane >> 4), ch = lane & 15; const u32x4 v = *(const u32x4*)(stg + row * 128 + ch * 8); *(u32x4*)(orow0 + (size_t)row * DM + hf * 128 + ch * 8) = v; }
    __builtin_amdgcn_wave_barrier();
  }
#undef XA_LOADK
#undef XA_LOADV
#undef XA_WRITE
}
}

__device__ __forceinline__ void phase_xattn2(const Args& a, unsigned char* lds, int tid) {
  for (int u = blockIdx.x; u < NB * 4 * 16; u += gridDim.x) { const int qb = u & 15, hd = (u >> 4) & 3, b = u >> 6; xa::unit(a, lds, b, hd, qb, tid); }
}

__device__ __forceinline__ unsigned fkey(float s, unsigned idx, unsigned mask) { unsigned u = __float_as_uint(s); u ^= (unsigned)((int)u >> 31) | 0x80000000u; return (u & ~mask) | (mask - idx); }
__device__ __forceinline__ float keyval(unsigned k, unsigned mask) { unsigned u = k & ~mask; u = (u & 0x80000000u) ? (u ^ 0x80000000u) : ~u; return __uint_as_float(u); }
#define KEY_INSERT(KA, key_) do { unsigned k__ = (key_); \
  _Pragma("unroll") for (int s_ = 0; s_ < 16; ++s_) { const unsigned hi_ = max(k__, KA[s_]); k__ = min(k__, KA[s_]); KA[s_] = hi_; } } while (0)

__device__ __forceinline__ void phase_topk(const Args& a, unsigned char* lds, int tid) {
  unsigned char* ws = a.ws;
  const float* pq = (const float*)(ws + WS_PQ);
  int* eidx = (int*)(ws + WS_EIDX); float* gate = (float*)(ws + WS_GATE);
  float* K1 = (float*)lds; float* K2 = K1 + 128 * 64; unsigned* KL = (unsigned*)(lds + 65536);
  for (int u = blockIdx.x; u < 8 * (NT / 512); u += gridDim.x) {
    const int h = u & 7, t = (u >> 3) * 512 + tid;
    __syncthreads();
    for (int i = tid; i < 128 * 64 / 4; i += 512) { ((f32x4*)K1)[i] = ((const f32x4*)(a.in[17] + (size_t)h * 8192))[i]; ((f32x4*)K2)[i] = ((const f32x4*)(a.in[18] + (size_t)h * 8192))[i]; }
    __syncthreads();
    unsigned ka[16], kb[16], kc[16];
#pragma unroll
    for (int k = 0; k < 16; ++k) { ka[k] = 0u; kb[k] = 0u; kc[k] = 0u; }
    float q[64];
    const f32x4* qp = (const f32x4*)(pq + (size_t)t * DM + h * 128);
#pragma unroll
    for (int c = 0; c < 16; ++c) { const f32x4 w = qp[c]; q[4 * c] = w.x; q[4 * c + 1] = w.y; q[4 * c + 2] = w.z; q[4 * c + 3] = w.w; }
    for (int n = 0; n < 128; ++n) {
      const f32x4* kr = (const f32x4*)(K1 + n * 64); float s = 0.f;
#pragma unroll
      for (int c = 0; c < 16; ++c) { const f32x4 kv = kr[c]; s += q[4 * c] * kv.x + q[4 * c + 1] * kv.y + q[4 * c + 2] * kv.z + q[4 * c + 3] * kv.w; }
      KEY_INSERT(ka, fkey(s, (unsigned)n, 127u));
    }
#pragma unroll
    for (int c = 0; c < 16; ++c) { const f32x4 w = qp[16 + c]; q[4 * c] = w.x; q[4 * c + 1] = w.y; q[4 * c + 2] = w.z; q[4 * c + 3] = w.w; }
    for (int n = 0; n < 128; ++n) {
      const f32x4* kr = (const f32x4*)(K2 + n * 64); float s = 0.f;
#pragma unroll
      for (int c = 0; c < 16; ++c) { const f32x4 kv = kr[c]; s += q[4 * c] * kv.x + q[4 * c + 1] * kv.y + q[4 * c + 2] * kv.z + q[4 * c + 3] * kv.w; }
      KEY_INSERT(kb, fkey(s, (unsigned)n, 127u));
    }
#pragma unroll
    for (int x = 0; x < 16; ++x)
#pragma unroll
      for (int y = 0; y < 16; ++y)
        if ((x + 1) * (y + 1) <= 16) { KEY_INSERT(kc, fkey(keyval(ka[x], 127u) + keyval(kb[y], 127u), (unsigned)(x * 16 + y), 255u)); }
#pragma unroll
    for (int k = 0; k < 16; ++k) { KL[k * 512 + tid] = ka[k]; KL[(16 + k) * 512 + tid] = kb[k]; }
    float val[16]; int id[16]; float sum = 0.f;
#pragma unroll
    for (int k = 0; k < 16; ++k) {
      const unsigned flat = 255u - (kc[k] & 255u);
      const unsigned k1 = KL[(flat >> 4) * 512 + tid], k2 = KL[(16 + (flat & 15u)) * 512 + tid];
      val[k] = keyval(k1, 127u) + keyval(k2, 127u);
      id[k] = (int)((127u - (k1 & 127u)) * 128u + (127u - (k2 & 127u)));
    }
    const float vmax = val[0];
#pragma unroll
    for (int k = 0; k < 16; ++k) { val[k] = __expf(val[k] - vmax); sum += val[k]; }
    const float inv = 1.f / sum;
    int* ep = eidx + (size_t)t * 128 + h * 16; float* gp = gate + (size_t)t * 128 + h * 16;
#pragma unroll
    for (int k = 0; k < 16; ++k) { ep[k] = id[k]; gp[k] = val[k] * inv; }
  }
}


namespace tk {
typedef float f32x16 __attribute__((ext_vector_type(16)));
__device__ __forceinline__ void ce(unsigned& a, unsigned& b) { const unsigned h = max(a, b), l = min(a, b); a = h; b = l; }
__device__ __forceinline__ void sort16(unsigned (&v)[16]) {
#pragma unroll
  for (int k = 2; k <= 16; k <<= 1)
#pragma unroll
    for (int j = k >> 1; j > 0; j >>= 1)
#pragma unroll
      for (int i = 0; i < 16; ++i) { const int l = i ^ j; if (l > i) { if ((i & k) == 0) ce(v[i], v[l]); else ce(v[l], v[i]); } }
}
__device__ __forceinline__ void topmerge(unsigned (&a)[16], const unsigned (&b)[16]) {
#pragma unroll
  for (int i = 0; i < 16; ++i) a[i] = max(a[i], b[15 - i]);
#pragma unroll
  for (int j = 8; j > 0; j >>= 1)
#pragma unroll
    for (int i = 0; i < 16; ++i) { const int l = i ^ j; if (l > i) ce(a[i], a[l]); }
}
__device__ __forceinline__ unsigned xswap(unsigned v, int hi) { auto rr = __builtin_amdgcn_permlane32_swap(v, v, false, false); return hi ? rr[0] : rr[1]; }
__device__ __forceinline__ void half_list(unsigned (&L)[16], const bf16_t* skh, const bf16_t* qrow, int r32, int hi) {
  f32x16 acc[4];
#pragma unroll
  for (int i = 0; i < 4; ++i) acc[i] = f32x16{};
#pragma unroll
  for (int ks = 0; ks < 4; ++ks) {
    const bf16x8 qf = *(const bf16x8*)(qrow + ks * 16 + hi * 8);
#pragma unroll
    for (int tl = 0; tl < 4; ++tl) { const bf16x8 kf = *(const bf16x8*)(skh + (size_t)(tl * 32 + r32) * 64 + ks * 16 + hi * 8); acc[tl] = __builtin_amdgcn_mfma_f32_32x32x16_bf16(kf, qf, acc[tl], 0, 0, 0); }
  }
  unsigned g[4][16];
#pragma unroll
  for (int tl = 0; tl < 4; ++tl)
#pragma unroll
    for (int r = 0; r < 16; ++r) g[tl][r] = fkey(acc[tl][r], (unsigned)(32 * tl + (r & 3) + 8 * (r >> 2) + 4 * hi), 127u);
  sort16(g[0]); sort16(g[1]); sort16(g[2]); sort16(g[3]);
  topmerge(g[0], g[1]); topmerge(g[2], g[3]); topmerge(g[0], g[2]);
  unsigned p[16];
#pragma unroll
  for (int k = 0; k < 16; ++k) p[k] = xswap(g[0][k], hi);
  topmerge(g[0], p);
#pragma unroll
  for (int k = 0; k < 16; ++k) L[k] = g[0][k];
}
}

__device__ __forceinline__ void phase_topk2(const Args& a, unsigned char* lds, int wave, int lane) {
  unsigned char* ws = a.ws;
  const bf16_t* pq = (const bf16_t*)(ws + WS_PQ); const bf16_t* sk = (const bf16_t*)(ws + WS_SK);
  int* eidx = (int*)(ws + WS_EIDX); float* gate = (float*)(ws + WS_GATE);
  const int r32 = lane & 31, hi = lane >> 5, h = wave;
  unsigned* KL = (unsigned*)(lds + wave * 4096);
  for (int tt = blockIdx.x; tt < NT / 32; tt += gridDim.x) {
    const int t = tt * 32 + r32;
    unsigned ka[16], kb[16], kc[16];
    tk::half_list(ka, sk + (size_t)(0 * 8 + h) * 8192, pq + (size_t)t * DM + h * 128, r32, hi);
    tk::half_list(kb, sk + (size_t)(1 * 8 + h) * 8192, pq + (size_t)t * DM + h * 128 + 64, r32, hi);
    float va[16], vb[16];
#pragma unroll
    for (int k = 0; k < 16; ++k) { va[k] = keyval(ka[k], 127u); vb[k] = keyval(kb[k], 127u); }
#pragma unroll
    for (int y = 0; y < 16; ++y) kc[y] = hi ? 0u : fkey(va[0] + vb[y], (unsigned)y, 255u);
#define TK_CAND(xa, ya, xb, yb) do { const unsigned kA_ = fkey(va[xa] + vb[ya], (unsigned)((xa) * 16 + (ya)), 255u), kB_ = fkey(va[xb] + vb[yb], (unsigned)((xb) * 16 + (yb)), 255u); KEY_INSERT(kc, hi ? kB_ : kA_); } while (0)
    TK_CAND(1, 0, 1, 1);
    TK_CAND(1, 2, 1, 3);
    TK_CAND(1, 4, 1, 5);
    TK_CAND(1, 6, 1, 7);
    TK_CAND(2, 0, 2, 1);
    TK_CAND(2, 2, 2, 3);
    TK_CAND(2, 4, 3, 0);
    TK_CAND(3, 1, 3, 2);
    TK_CAND(3, 3, 4, 0);
    TK_CAND(4, 1, 4, 2);
    TK_CAND(5, 0, 5, 1);
    TK_CAND(6, 0, 6, 1);
    TK_CAND(7, 0, 7, 1);
    TK_CAND(8, 0, 9, 0);
    TK_CAND(10, 0, 11, 0);
    TK_CAND(12, 0, 13, 0);
    TK_CAND(14, 0, 15, 0);
#undef TK_CAND
    { unsigned p[16];
#pragma unroll
      for (int k = 0; k < 16; ++k) p[k] = tk::xswap(kc[k], hi);
      tk::topmerge(kc, p); }
    if (hi == 0) {
#pragma unroll
      for (int k = 0; k < 16; ++k) { KL[k * 32 + r32] = ka[k]; KL[(16 + k) * 32 + r32] = kb[k]; }
    }
    __builtin_amdgcn_wave_barrier();
    const float vmax = va[0] + vb[0];
    float pv[8]; int id[8]; float s = 0.f;
#pragma unroll
    for (int j = 0; j < 8; ++j) {
      unsigned klo_ = kc[j], khi_ = kc[8 + j]; asm volatile("" : "+v"(klo_), "+v"(khi_));
      const unsigned key = hi ? khi_ : klo_;
      const unsigned flat = 255u - (key & 255u);
      const unsigned k1 = KL[(flat >> 4) * 32 + r32], k2 = KL[(16 + (flat & 15u)) * 32 + r32];
      pv[j] = __expf(keyval(k1, 127u) + keyval(k2, 127u) - vmax); s += pv[j];
      id[j] = (int)((127u - (k1 & 127u)) * 128u + (127u - (k2 & 127u)));
    }
    __builtin_amdgcn_wave_barrier();
    const float inv = 1.f / att::xhalf_sum(s);
    u32x4* ep = (u32x4*)(eidx + (size_t)t * 128 + h * 16 + hi * 8); f32x4* gp = (f32x4*)(gate + (size_t)t * 128 + h * 16 + hi * 8);
    ep[0] = (u32x4){(unsigned)id[0], (unsigned)id[1], (unsigned)id[2], (unsigned)id[3]}; ep[1] = (u32x4){(unsigned)id[4], (unsigned)id[5], (unsigned)id[6], (unsigned)id[7]};
    gp[0] = (f32x4){pv[0] * inv, pv[1] * inv, pv[2] * inv, pv[3] * inv}; gp[1] = (f32x4){pv[4] * inv, pv[5] * inv, pv[6] * inv, pv[7] * inv};
  }
}

__device__ __forceinline__ float gelu_erf(float v) { return 0.5f * v * (1.f + erff(v * 0.70710678118654752f)); }

__device__ __forceinline__ float gelu_as(float v) {
  const float av = fabsf(v), t = __builtin_amdgcn_rcpf(av * 0.2316418882f + 1.0f);
  float q = t * 0.5307027145f + (-0.7265760135f); q = q * t + 0.7107068705f; q = q * t + (-0.142248368f); q = q * t + 0.127414796f; q = q * t;
  const float m = v * (q * __builtin_amdgcn_exp2f((v * v) * (-0.72134752044f)));
  return v < 0.f ? m : v - m;
}
#define PIN16(A, O) asm volatile("" : "+v"(A[O]), "+v"(A[O + 1]), "+v"(A[O + 2]), "+v"(A[O + 3]), "+v"(A[O + 4]), "+v"(A[O + 5]), "+v"(A[O + 6]), "+v"(A[O + 7]), "+v"(A[O + 8]), "+v"(A[O + 9]), "+v"(A[O + 10]), "+v"(A[O + 11]), "+v"(A[O + 12]), "+v"(A[O + 13]), "+v"(A[O + 14]), "+v"(A[O + 15]))
#define PIN6(R) asm volatile("" : "+v"(R[0].x), "+v"(R[0].y), "+v"(R[1].x), "+v"(R[1].y), "+v"(R[2].x), "+v"(R[2].y))
__device__ __forceinline__ void phase_exp_down(const Args& a, int gw, int ngw, int lane) {
  unsigned char* ws = a.ws;
  const int* eidx = (const int*)(ws + WS_EIDX); const float* gate = (const float*)(ws + WS_GATE); float* wout = (float*)(ws + WS_W);
  const unsigned char* exd = ws + WS_EXD; const float* esc = (const float*)(ws + WS_ESC);
  const int l32 = lane & 31, hi = lane >> 5;
  const bool b4 = (l32 & 16) != 0, b3 = (l32 & 8) != 0, b2 = (l32 & 4) != 0;
  for (int t = gw; t < NT; t += ngw) {
    const int e0 = eidx[(size_t)t * 128 + lane], e1 = eidx[(size_t)t * 128 + 64 + lane];
    const float sd0 = esc[e0], sd1 = esc[e1];
    const float gu0 = gate[(size_t)t * 128 + lane] * esc[NEXP + e0], gu1 = gate[(size_t)t * 128 + 64 + lane] * esc[NEXP + e1];
    const f32x4* xr = (const f32x4*)(a.out + (size_t)t * DM) + 8 * l32;
    float hg[32]; float s = 0.f;
#pragma unroll
    for (int k = 0; k < 8; ++k) { const f32x4 x = xr[k]; s += (x.x * x.x + x.y * x.y) + (x.z * x.z + x.w * x.w); hg[4 * k] = x.x; hg[4 * k + 1] = x.y; hg[4 * k + 2] = x.z; hg[4 * k + 3] = x.w; }
    s = half_sum32(s);
    const float rstd = rsqrtf(s * (1.f / DM) + EPS);
#pragma unroll
    for (int k = 0; k < 8; ++k) { const f32x4 g = ((const f32x4*)a.in[15])[8 * l32 + k]; hg[4 * k] *= rstd * g.x; hg[4 * k + 1] *= rstd * g.y; hg[4 * k + 2] *= rstd * g.z; hg[4 * k + 3] *= rstd * g.w; }
    float w0 = 0.f, w1 = 0.f;
    for (int e = 0; e < 128; e += 16) {
      u32x2 ur[8][3];
#pragma unroll
      for (int i = 0; i < 8; ++i) {
        const int pi = (e & 63) + 2 * i + hi; const int id = (e < 64) ? __shfl(e0, pi) : __shfl(e1, pi);
        const u32x2* up = (const u32x2*)(exd + (size_t)id * 768 + 24 * l32);
        ur[i][0] = up[0]; ur[i][1] = up[1]; ur[i][2] = up[2];
      }
      float d[8];
#pragma unroll
      for (int i = 0; i < 8; ++i) {
        const v32f u = __builtin_amdgcn_cvt_scalef32_pk32_f32_fp6((v6u){ur[i][0].x, ur[i][0].y, ur[i][1].x, ur[i][1].y, ur[i][2].x, ur[i][2].y}, 1.0f);
        f32x2 q2 = (f32x2){0.f, 0.f};
#pragma unroll
        for (int k = 0; k < 16; ++k) q2 = __builtin_elementwise_fma((f32x2){u[2 * k], u[2 * k + 1]}, (f32x2){hg[2 * k], hg[2 * k + 1]}, q2);
        d[i] = q2.x + q2.y;
        __builtin_amdgcn_sched_barrier(0);
      }
      float r[4];
#pragma unroll
      for (int j = 0; j < 4; ++j) r[j] = (b4 ? d[j + 4] : d[j]) + swz_xor<16>(b4 ? d[j] : d[j + 4]);
      const float q0 = (b3 ? r[2] : r[0]) + swz_xor<8>(b3 ? r[0] : r[2]);
      const float q1 = (b3 ? r[3] : r[1]) + swz_xor<8>(b3 ? r[1] : r[3]);
      float q = (b2 ? q1 : q0) + swz_xor<4>(b2 ? q0 : q1);
      q += swz_xor<2>(q); q += swz_xor<1>(q);
      const int pr = (e & 63) + 2 * (l32 >> 2) + hi;
      const float sd = (e < 64) ? __shfl(sd0, pr) : __shfl(sd1, pr);
      const float gu = (e < 64) ? __shfl(gu0, pr) : __shfl(gu1, pr);
      const float wl = gu * gelu_as(q * sd);
      const float wsrc = __shfl(wl, ((lane & 1) << 5) | (((lane - (e & 63)) >> 1 & 7) << 2));
      if (lane >= (e & 63) && lane < (e & 63) + 16) { if (e < 64) w0 = wsrc; else w1 = wsrc; }
    }
    wout[(size_t)t * 128 + lane] = w0; wout[(size_t)t * 128 + 64 + lane] = w1;
  }
}

__device__ __forceinline__ void exp_up_item(const Args& a, unsigned char* lds, int xs, int item, int wave, int lane, float* xout, float* ssout) {
  unsigned char* ws = a.ws;
  const int* eidx = (const int*)(ws + WS_EIDX); const float* wgt = (const float*)(ws + WS_W);
  const unsigned char* ups = ws + WS_EXU + (size_t)xs * (NEXP * 128);
  unsigned* L = (unsigned*)(lds + wave * 16640);
  const int g = lane >> 2, c = lane & 3, t0 = item * 128 + wave * 16;
  __builtin_amdgcn_wave_barrier();
#pragma unroll 4
  for (int tk = 0; tk < 16; ++tk) {
    const size_t o = (size_t)(t0 + tk) * 128;
    L[tk * 260 + lane] = (unsigned)eidx[o + lane]; L[tk * 260 + 64 + lane] = (unsigned)eidx[o + 64 + lane];
    L[tk * 260 + 128 + lane] = __float_as_uint(wgt[o + lane]); L[tk * 260 + 192 + lane] = __float_as_uint(wgt[o + 64 + lane]);
  }
  __builtin_amdgcn_wave_barrier();
  float acc[32];
#pragma unroll
  for (int i = 0; i < 32; ++i) acc[i] = 0.f;
  const unsigned* Lg = L + g * 260;
#pragma unroll 1
  for (int p = 0; p < 128; p += 8) {
    u32x2 vr[8][3];
#pragma unroll
    for (int u = 0; u < 8; ++u) {
      const u32x2* vp = (const u32x2*)(ups + (size_t)Lg[p + u] * 128 + 24 * c);
      vr[u][0] = vp[0]; vr[u][1] = vp[1]; vr[u][2] = vp[2];
    }
#pragma unroll
    for (int u = 0; u < 8; ++u) {
      const float w = __uint_as_float(Lg[128 + p + u]);
      PIN6(vr[u]);
      const v32f v = __builtin_amdgcn_cvt_scalef32_pk32_f32_fp6((v6u){vr[u][0].x, vr[u][0].y, vr[u][1].x, vr[u][1].y, vr[u][2].x, vr[u][2].y}, 1.0f);
#pragma unroll
      for (int k = 0; k < 32; ++k) acc[k] += w * v[k];
      PIN16(acc, 0); PIN16(acc, 16);
    }
  }
  const f32x4* xr = (const f32x4*)(a.out + (size_t)(t0 + g) * DM + xs * 128 + c * 32); f32x4* xw = (f32x4*)(xout + (size_t)(t0 + g) * DM + xs * 128 + c * 32);
  float s = 0.f;
#pragma unroll
  for (int k = 0; k < 8; ++k) { f32x4 x = xr[k]; x.x += acc[4 * k]; x.y += acc[4 * k + 1]; x.z += acc[4 * k + 2]; x.w += acc[4 * k + 3]; xw[k] = x; s += (x.x * x.x + x.y * x.y) + (x.z * x.z + x.w * x.w); }
  s += swz_xor<1>(s); s += swz_xor<2>(s);
  if (c == 0) atomicAdd(ssout + t0 + g, s);
}
__device__ __forceinline__ void phase_exp_up(const Args& a, unsigned char* lds, const XcdBarrier& bar, int tid, int wave, int lane, unsigned* ctr, float* xout, float* ssout);
struct UpBuf { u32x4 r[8][2]; };
__device__ __forceinline__ void up2_load(UpBuf& B, const unsigned char* ups, const unsigned* Lg, int ch, int c) {
  const unsigned char* base = ups + (size_t)(ch >> 4) * (NEXP * 128) + 32 * c; const int p = (ch & 15) * 8;
#pragma unroll
  for (int u = 0; u < 8; ++u) { const u32x4* vp = (const u32x4*)(base + (size_t)Lg[p + u] * 128); B.r[u][0] = vp[0]; B.r[u][1] = vp[1]; }
}
__device__ __forceinline__ void up2_math(UpBuf& B, const unsigned* Lg, int ch, f32x2 (&acc)[16]) {
  const int p = (ch & 15) * 8;
#pragma unroll
  for (int u = 0; u < 8; ++u) {
    const float w = __uint_as_float(Lg[128 + p + u]);
    asm volatile("" : "+v"(B.r[u][0]), "+v"(B.r[u][1]));
    const f32x2 w2 = (f32x2){w, w};
#pragma unroll
    for (int q = 0; q < 2; ++q)
#pragma unroll
      for (int k = 0; k < 4; ++k) {
        const auto lo = __builtin_amdgcn_cvt_pk_f32_fp8((int)B.r[u][q][k], false); const auto hi = __builtin_amdgcn_cvt_pk_f32_fp8((int)B.r[u][q][k], true);
        acc[8 * q + 2 * k] = __builtin_elementwise_fma((f32x2){lo[0], lo[1]}, w2, acc[8 * q + 2 * k]);
        acc[8 * q + 2 * k + 1] = __builtin_elementwise_fma((f32x2){hi[0], hi[1]}, w2, acc[8 * q + 2 * k + 1]);
      }
    PIN16(acc, 0);
  }
}
__device__ __forceinline__ void up2_slice_end(const Args& a, int t, int xs, int c, f32x2 (&acc)[16], float& ssum) {
  f32x4* xr = (f32x4*)(a.out + (size_t)t * DM + xs * 128 + c * 32);
#pragma unroll
  for (int k = 0; k < 8; ++k) { f32x4 x = xr[k]; x.x += acc[2 * k].x; x.y += acc[2 * k].y; x.z += acc[2 * k + 1].x; x.w += acc[2 * k + 1].y; xr[k] = x; ssum += (x.x * x.x + x.y * x.y) + (x.z * x.z + x.w * x.w);
    acc[2 * k] = (f32x2){0.f, 0.f}; acc[2 * k + 1] = (f32x2){0.f, 0.f}; }
}
__device__ __forceinline__ void phase_exp_up2(const Args& a, unsigned char* lds, int wave, int lane) {
  unsigned char* ws = a.ws;
  const int* eidx = (const int*)(ws + WS_EIDX); const float* wgt = (const float*)(ws + WS_W);
  const unsigned char* ups = ws + WS_EXU;
  unsigned* L = (unsigned*)(lds + wave * 16640);
  const int g = lane >> 2, c = lane & 3;
  for (int blk = blockIdx.x; blk < NT / 128; blk += gridDim.x) {
    const int t0 = blk * 128 + wave * 16, t = t0 + g;
    unsigned* H = (unsigned*)(lds + 8 * 16640 + 1024) + wave * 256;
    __builtin_amdgcn_wave_barrier();
    for (int i = lane; i < 256; i += 64) H[i] = 0u;
    __builtin_amdgcn_wave_barrier();
#pragma unroll 4
    for (int tk = 0; tk < 16; ++tk) {
      const size_t o = (size_t)(t0 + tk) * 128;
      const unsigned ea = (unsigned)eidx[o + lane], eb = (unsigned)eidx[o + 64 + lane];
      const unsigned wa = __float_as_uint(wgt[o + lane]), wb = __float_as_uint(wgt[o + 64 + lane]);
      const unsigned ba = ea >> 10, bb = eb >> 10;
      const unsigned ra = atomicAdd(&H[tk * 16 + ba], 1u), rb = atomicAdd(&H[tk * 16 + bb], 1u);
      __builtin_amdgcn_wave_barrier();
      unsigned pa = ra, pb = rb;
#pragma unroll
      for (unsigned b = 0; b < 16; ++b) { const unsigned hb = H[tk * 16 + b]; pa += (b < ba) ? hb : 0u; pb += (b < bb) ? hb : 0u; }
      L[tk * 260 + pa] = ea; L[tk * 260 + 128 + pa] = wa; L[tk * 260 + pb] = eb; L[tk * 260 + 128 + pb] = wb;
    }
    __builtin_amdgcn_wave_barrier();
    const unsigned* Lg = L + g * 260;
    f32x2 acc[16]; float ssum = 0.f;
#pragma unroll
    for (int i = 0; i < 16; ++i) acc[i] = (f32x2){0.f, 0.f};
    UpBuf A, B;
    up2_load(A, ups, Lg, 0, c);
#pragma unroll 1
    for (int ch = 0; ch < 128; ch += 2) {
      up2_load(B, ups, Lg, ch + 1, c);
      up2_math(A, Lg, ch, acc);
      if (ch + 2 < 128) up2_load(A, ups, Lg, ch + 2, c);
      up2_math(B, Lg, ch + 1, acc);
      if ((ch & 15) == 14) up2_slice_end(a, t, ch >> 4, c, acc, ssum);
    }
    ssum += swz_xor<1>(ssum); ssum += swz_xor<2>(ssum);
    const float r2 = rsqrtf(ssum * (1.f / DM) + EPS);
    asm volatile("s_waitcnt vmcnt(0)" ::: "memory");
    __builtin_amdgcn_fence(__ATOMIC_ACQUIRE, "agent");
#pragma unroll 2
    for (int xs = 0; xs < 8; ++xs) {
      f32x4* xr = (f32x4*)(a.out + (size_t)t * DM + xs * 128 + c * 32); const f32x4* gp = (const f32x4*)(a.in[21] + xs * 128 + c * 32);
#pragma unroll
      for (int k = 0; k < 8; ++k) xr[k] = xr[k] * r2 * gp[k];
    }
  }
}

__device__ __forceinline__ void phase_final(const Args& a, int gw, int ngw, int lane) {
  const float* ss = (const float*)(a.ws + WS_SS3);
  for (int r = gw; r < NT; r += ngw) {
    const float r2 = rsqrtf(ss[r] * (1.f / DM) + EPS);
    f32x4* xr = (f32x4*)(a.out + (size_t)r * DM) + lane;
#pragma unroll
    for (int j = 0; j < 4; ++j) { const f32x4 g = ((const f32x4*)a.in[21])[64 * j + lane]; xr[64 * j] = xr[64 * j] * r2 * g; }
  }
}

namespace pg8 {
#define PG8_LAS __attribute__((address_space(3)))
typedef unsigned short bf16_t;
typedef short bf16x8 __attribute__((ext_vector_type(8)));
typedef float f32x4 __attribute__((ext_vector_type(4)));
typedef unsigned u32x4 __attribute__((ext_vector_type(4)));
constexpr int BM = 256, BK = 64, HALF = 128, HTB = HALF * BK * 2  , STAGE_BYTES = 8 * HTB, NXCD = 8, WGM = 8;

__host__ __device__ __forceinline__ int lds_byte(int r, int c) { const int st = (r >> 4) * 2 + (c >> 5), rr = r & 15, cc = c & 31, ob = rr * 64 + cc * 2; return st * 1024 + (ob ^ (((ob >> 9) & 1) << 5)); }
__host__ __device__ __forceinline__ void stage_rc(int b, int& R, int& C) { const int st = b / 1024, sb = b % 1024, swz = sb ^ (((sb >> 9) & 1) << 5); R = (st >> 1) * 16 + swz / 64; C = (st & 1) * 32 + (swz % 64) / 2; }
__host__ __device__ __forceinline__ int perm32(int rho) { const int n = rho >> 4, i = rho & 15; return 8 * (i >> 2) + 4 * n + (i & 3); }

struct Unit { int pm, pn; };
struct Gemm { const bf16_t* A; const bf16_t* Bt; int M, N, K; };

struct StaticOrder {
    int nM, nN, nwg, G, c;
    __host__ __device__ void init(int M, int N, int G_, int c_) { nM = M / BM; nN = N / BM; nwg = nM * nN; G = G_; c = c_; }
    __host__ __device__ bool next(int i, Unit& u) const {
        const long L = (long)i * G + c; if (L >= nwg) return false;
        int wgid = (int)L; { const int q = nwg / NXCD, r = nwg % NXCD, xcd = wgid % NXCD, off = wgid / NXCD; wgid = (xcd < r ? xcd * (q + 1) : r * (q + 1) + (xcd - r) * q) + off; }
        const int nig = WGM * nN, gid = wgid / nig, fm = gid * WGM, gsz = (nM - fm) < WGM ? (nM - fm) : WGM;
        u.pm = fm + ((wgid % nig) % gsz); u.pn = (wgid % nig) / gsz; return true;
    }
    __device__ __forceinline__ void a_ready(const Unit&) const {}
    __device__ __forceinline__ void done(const Unit&) const {}
};

template <class St> struct EpiAdapt8 {
    static constexpr bool PERM = true, AFTER_DRAIN = false; St st;
    __device__ __forceinline__ void operator()(const f32x4 (&acc)[2][2][4][2], const Unit& u, int wr, int wc, int fr, int fq) const {
#pragma unroll
        for (int ai = 0; ai < 2; ++ai)
#pragma unroll
            for (int m = 0; m < 4; ++m)
#pragma unroll
                for (int bj = 0; bj < 2; ++bj) st.store8(u.pm * BM + ai * HALF + wr * 64 + m * 16 + fr, u.pn * BM + bj * HALF + wc * 32 + 8 * fq, acc[ai][bj][m][0], acc[ai][bj][m][1]);
    }
};
template <class St> struct EpiAdapt {
    static constexpr bool PERM = false, AFTER_DRAIN = false; St st;
    __device__ __forceinline__ void operator()(const f32x4 (&acc)[2][2][4][2], const Unit& u, int wr, int wc, int fr, int fq) const {
#pragma unroll
        for (int ai = 0; ai < 2; ++ai)
#pragma unroll
            for (int m = 0; m < 4; ++m)
#pragma unroll
                for (int bj = 0; bj < 2; ++bj)
#pragma unroll
                    for (int n = 0; n < 2; ++n) st.store(u.pm * BM + ai * HALF + wr * 64 + m * 16 + fr, u.pn * BM + bj * HALF + wc * 32 + n * 16 + 4 * fq, acc[ai][bj][m][n]);
    }
};

struct EpiResidSS {
    static constexpr bool PERM = false, AFTER_DRAIN = false; const float* base; float* out; bf16_t* hb; float* ss;
    __device__ __forceinline__ void operator()(const f32x4 (&acc)[2][2][4][2], const Unit& u, int wr, int wc, int fr, int fq) const {
#pragma unroll
        for (int ai = 0; ai < 2; ++ai)
#pragma unroll
            for (int m = 0; m < 4; ++m) {
                const int row = u.pm * BM + ai * HALF + wr * 64 + m * 16 + fr; float s = 0.f;
#pragma unroll
                for (int bj = 0; bj < 2; ++bj)
#pragma unroll
                    for (int n = 0; n < 2; ++n) {
                        const size_t o = (size_t)row * 1024 + u.pn * BM + bj * HALF + wc * 32 + n * 16 + 4 * fq;
                        const f32x4 v = *(const f32x4*)(base + o) + acc[ai][bj][m][n];
                        *(f32x4*)(out + o) = v;
                        typedef unsigned u32x2v __attribute__((ext_vector_type(2)));
                        { const float f0 = v.x, f1 = v.y, f2 = v.z, f3 = v.w; *(u32x2v*)(hb + o) = (u32x2v){::pk2(f0, f1), ::pk2(f2, f3)}; }
                        s += (v.x * v.x + v.y * v.y) + (v.z * v.z + v.w * v.w);
                    }
                s += __shfl_xor(s, 16); s += __shfl_xor(s, 32);
                if (fq == 0) atomicAdd(ss + row, s);
            }
    }
};
template <class Epi, class Sched, bool ALIGN_EPI = false, bool SP2 = false>
__device__ __forceinline__ void gemm_phase(PG8_LAS unsigned char* lds, const Gemm g, const Sched& S, const Epi& E) {
    const int tid = threadIdx.x, wid = __builtin_amdgcn_readfirstlane(tid >> 6), lane = tid & 63, wr = wid >> 2, wc = wid & 3, fr = lane & 15, fq = lane >> 4;
    const int K = g.K, nt = K / BK;
    unsigned voffA[2], voffB[2];
#pragma unroll
    for (int i = 0; i < 2; ++i) { int R, C; stage_rc(tid * 16 + i * 8192, R, C); const int Rb = Epi::PERM ? ((R & ~31) + perm32(R & 31)) : R;
        voffA[i] = (unsigned)(R * K + C) * 2u; voffB[i] = (unsigned)(Rb * K + C) * 2u; }
    const size_t kstep = (size_t)(BK * 2);
    const size_t hstep = (size_t)HALF * K * 2;
    const size_t tstep = 2 * hstep;
    const unsigned ldsw = (unsigned)wid * 1024u;
    const int aoff = lds_byte(wr * 64 + fr, fq * 8), boff = lds_byte(wc * 32 + fr, fq * 8);
#define PG8_SA(b, h) (((b) * 2 + (h)) * HTB)
#define PG8_SB(b, h) ((4 + (b) * 2 + (h)) * HTB)
#define PG8_STAGE(bufoff, gbase, voff) do { _Pragma("unroll") for (int _i = 0; _i < 2; ++_i) \
        __builtin_amdgcn_global_load_lds((const unsigned*)((const char*)(gbase) + (voff)[_i]), (PG8_LAS unsigned*)(lds + (bufoff) + ldsw + _i * 8192), 16, 0, 0); } while (0)
#define PG8_LDA(dst, b, h) do { _Pragma("unroll") for (int m = 0; m < 4; ++m) _Pragma("unroll") for (int k = 0; k < 2; ++k) dst[m][k] = *(const PG8_LAS bf16x8*)(lds + PG8_SA(b, h) + aoff + m * 2048 + k * 1024); } while (0)
#define PG8_LDB(dst, b, h) do { _Pragma("unroll") for (int n = 0; n < 2; ++n) _Pragma("unroll") for (int k = 0; k < 2; ++k) dst[n][k] = *(const PG8_LAS bf16x8*)(lds + PG8_SB(b, h) + boff + n * 2048 + k * 1024); } while (0)
#define PG8_MMA(ai, bj, At, Bt) do { __builtin_amdgcn_s_setprio(1); _Pragma("unroll") for (int m = 0; m < 4; ++m) _Pragma("unroll") for (int n = 0; n < 2; ++n) _Pragma("unroll") for (int k = 0; k < 2; ++k) \
        acc[ai][bj][m][n] = __builtin_amdgcn_mfma_f32_16x16x32_bf16(Bt[n][k], At[m][k], acc[ai][bj][m][n], 0, 0, 0); __builtin_amdgcn_s_setprio(0); } while (0)
#define PG8_WAIT_V(n) asm volatile("s_waitcnt vmcnt(" #n ")" ::: "memory")
#define PG8_WAIT_L(n) asm volatile("s_waitcnt lgkmcnt(" #n ")" ::: "memory")
#define PG8_BAR __builtin_amdgcn_s_barrier()
#define PG8_SCHED __builtin_amdgcn_sched_barrier(0)
    Unit cur, nxt; int ui = 0;
    if (!S.next(0, cur)) return;
    f32x4 acc[2][2][4][2];
#pragma unroll
    for (int a = 0; a < 2; ++a)
#pragma unroll
        for (int b = 0; b < 2; ++b)
#pragma unroll
            for (int m = 0; m < 4; ++m)
#pragma unroll
                for (int n = 0; n < 2; ++n) acc[a][b][m][n] = (f32x4){0.f, 0.f, 0.f, 0.f};
    bf16x8 At[4][2], B0[2][2], B1[2][2];
    const char* cA = (const char*)g.A + (size_t)cur.pm * tstep; const char* cB = (const char*)g.Bt + (size_t)cur.pn * tstep;
    S.a_ready(cur);
    if constexpr (SP2) {
        PG8_STAGE(PG8_SB(0, 0), cB, voffB); PG8_STAGE(PG8_SB(0, 1), cB + hstep, voffB); PG8_STAGE(PG8_SA(0, 0), cA, voffA); PG8_STAGE(PG8_SA(0, 1), cA + hstep, voffA);
        if (wr == 1) PG8_BAR;
        PG8_WAIT_V(2); PG8_BAR;
        PG8_STAGE(PG8_SB(1, 0), cB + kstep, voffB); PG8_STAGE(PG8_SA(1, 0), cA + kstep, voffA); PG8_STAGE(PG8_SB(1, 1), cB + hstep + kstep, voffB);
        PG8_WAIT_V(6); PG8_BAR;
    } else {
        PG8_STAGE(PG8_SB(0, 0), cB, voffB); PG8_STAGE(PG8_SA(0, 0), cA, voffA); PG8_STAGE(PG8_SB(0, 1), cB + hstep, voffB); PG8_STAGE(PG8_SA(0, 1), cA + hstep, voffA);
        if (wr == 1) PG8_BAR;
        PG8_WAIT_V(4); PG8_BAR;
        PG8_STAGE(PG8_SB(1, 0), cB + kstep, voffB); PG8_STAGE(PG8_SA(1, 0), cA + kstep, voffA); PG8_STAGE(PG8_SB(1, 1), cB + hstep + kstep, voffB);
        PG8_WAIT_V(6); PG8_BAR;
    }
    for (;;) {
        const bool has_next = S.next(ui + 1, nxt);
        const char* nA = has_next ? (const char*)g.A + (size_t)nxt.pm * tstep : cA; const char* nB = has_next ? (const char*)g.Bt + (size_t)nxt.pn * tstep : cB;
        for (int t = 0; t < nt; t += 2) {
            const bool last = (t == nt - 2);
            const char* a1 = cA + (size_t)(t + 1) * kstep;
            const char* a2 = last ? nA : cA + (size_t)(t + 2) * kstep; const char* b2 = last ? nB : cB + (size_t)(t + 2) * kstep;
            const char* a3 = a2 + kstep; const char* b3 = b2 + kstep;
            if (last && has_next) S.a_ready(nxt);
            if constexpr (SP2) {
            PG8_LDB(B0, 0, 0); PG8_LDB(B1, 0, 1); PG8_SCHED; PG8_LDA(At, 0, 0); PG8_STAGE(PG8_SA(1, 1), a1 + hstep, voffA);
            PG8_WAIT_V(8); PG8_WAIT_L(0); PG8_BAR; PG8_MMA(0, 0, At, B0); PG8_MMA(0, 1, At, B1); PG8_BAR; PG8_SCHED;
            PG8_LDA(At, 0, 1); PG8_STAGE(PG8_SB(0, 0), b2, voffB); PG8_STAGE(PG8_SB(0, 1), b2 + hstep, voffB); PG8_STAGE(PG8_SA(0, 0), a2, voffA);
            PG8_WAIT_V(8); PG8_WAIT_L(0); PG8_BAR; PG8_MMA(1, 0, At, B0); PG8_MMA(1, 1, At, B1); PG8_BAR; PG8_SCHED;
            PG8_LDB(B0, 1, 0); PG8_LDB(B1, 1, 1); PG8_SCHED; PG8_LDA(At, 1, 0); PG8_STAGE(PG8_SA(0, 1), a2 + hstep, voffA);
            PG8_WAIT_V(8); PG8_WAIT_L(0); PG8_BAR; PG8_MMA(0, 0, At, B0); PG8_MMA(0, 1, At, B1); PG8_BAR; PG8_SCHED;
            PG8_LDA(At, 1, 1); PG8_STAGE(PG8_SB(1, 0), b3, voffB); PG8_STAGE(PG8_SB(1, 1), b3 + hstep, voffB); PG8_STAGE(PG8_SA(1, 0), a3, voffA);
            PG8_WAIT_V(8); PG8_WAIT_L(0); PG8_BAR; PG8_MMA(1, 0, At, B0); PG8_MMA(1, 1, At, B1); PG8_BAR; PG8_SCHED;
            } else {
            PG8_LDB(B0, 0, 0); PG8_SCHED; PG8_LDA(At, 0, 0); PG8_STAGE(PG8_SA(1, 1), a1 + hstep, voffA);
            PG8_WAIT_L(8); PG8_BAR; PG8_WAIT_L(0); PG8_MMA(0, 0, At, B0); PG8_BAR; PG8_SCHED;
            PG8_LDB(B1, 0, 1); PG8_STAGE(PG8_SB(0, 0), b2, voffB);
            PG8_BAR; PG8_WAIT_L(0); PG8_MMA(0, 1, At, B1); PG8_BAR;
            PG8_LDA(At, 0, 1); PG8_STAGE(PG8_SA(0, 0), a2, voffA);
            PG8_BAR; PG8_WAIT_L(0); PG8_MMA(1, 0, At, B0); PG8_BAR; PG8_SCHED;
            PG8_STAGE(PG8_SB(0, 1), b2 + hstep, voffB);
            PG8_WAIT_V(6); PG8_BAR; PG8_MMA(1, 1, At, B1); PG8_BAR;
            PG8_LDB(B0, 1, 0); PG8_SCHED; PG8_LDA(At, 1, 0); PG8_STAGE(PG8_SA(0, 1), a2 + hstep, voffA);
            PG8_WAIT_L(8); PG8_BAR; PG8_WAIT_L(0); PG8_MMA(0, 0, At, B0); PG8_BAR; PG8_SCHED;
            PG8_LDB(B1, 1, 1); PG8_STAGE(PG8_SB(1, 0), b3, voffB);
            PG8_BAR; PG8_WAIT_L(0); PG8_MMA(0, 1, At, B1); PG8_BAR;
            PG8_LDA(At, 1, 1); PG8_STAGE(PG8_SA(1, 0), a3, voffA);
            PG8_BAR; PG8_WAIT_L(0); PG8_MMA(1, 0, At, B0); PG8_BAR; PG8_SCHED;
            PG8_STAGE(PG8_SB(1, 1), b3 + hstep, voffB);
            PG8_WAIT_V(6); PG8_BAR; PG8_MMA(1, 1, At, B1); PG8_BAR;
            }
        }
        if constexpr (ALIGN_EPI) { if (wr == 0) PG8_BAR; }
        if constexpr (!Epi::AFTER_DRAIN) { E(acc, cur, wr, wc, fr, fq); S.done(cur); }
        if (!has_next) break;
#pragma unroll
        for (int a = 0; a < 2; ++a)
#pragma unroll
            for (int b = 0; b < 2; ++b)
#pragma unroll
                for (int m = 0; m < 4; ++m)
#pragma unroll
                    for (int n = 0; n < 2; ++n) acc[a][b][m][n] = (f32x4){0.f, 0.f, 0.f, 0.f};
        cur = nxt; cA = nA; cB = nB; ++ui;
        if constexpr (ALIGN_EPI) { if (wr == 1) PG8_BAR; }
    }
    PG8_WAIT_V(0);
    if constexpr (!ALIGN_EPI) { if (wr == 0) PG8_BAR; }
    PG8_BAR;
    if constexpr (Epi::AFTER_DRAIN) { E.fused(acc, cur, wr, wc, fr, fq, lds, wid, lane); S.done(cur); }
#undef PG8_SA
#undef PG8_SB
#undef PG8_STAGE
#undef PG8_LDA
#undef PG8_LDB
#undef PG8_MMA
#undef PG8_WAIT_V
#undef PG8_WAIT_L
#undef PG8_BAR
#undef PG8_SCHED
}
}


template <class Epi>
__device__ __forceinline__ void run_gemm_raw(unsigned char* lds, const bf16_t* A, const bf16_t* Bt, int M, int N, int K, const Epi& E) {
  pg8::Gemm g{A, Bt, M, N, K}; pg8::StaticOrder S; S.init(M, N, (int)gridDim.x, (int)blockIdx.x);
  pg8::gemm_phase<Epi, pg8::StaticOrder, true, true>((PG8_LAS unsigned char*)lds, g, S, E);
}
template <class St>
__device__ __forceinline__ void run_gemm8(unsigned char* lds, const bf16_t* A, const bf16_t* Bt, int M, int N, int K, const St& st) {
  pg8::Gemm g{A, Bt, M, N, K}; pg8::StaticOrder S; S.init(M, N, (int)gridDim.x, (int)blockIdx.x);
  pg8::EpiAdapt8<St> E{st};
  pg8::gemm_phase<pg8::EpiAdapt8<St>, pg8::StaticOrder, true, true>((PG8_LAS unsigned char*)lds, g, S, E);
}
template <class St>
__device__ __forceinline__ void run_gemm(unsigned char* lds, const bf16_t* A, const bf16_t* Bt, int M, int N, int K, const St& st, int gw, int ngw, int lane) {
#if USE_PG8
  pg8::Gemm g{A, Bt, M, N, K}; pg8::StaticOrder S; S.init(M, N, (int)gridDim.x, (int)blockIdx.x);
  pg8::EpiAdapt<St> E{st};
  pg8::gemm_phase<pg8::EpiAdapt<St>, pg8::StaticOrder, true, true>((PG8_LAS unsigned char*)lds, g, S, E);
#else
  gemm_naive(A, K, Bt, K, M, N, K, st, gw, ngw, lane);
#endif
}

#define GAS __attribute__((address_space(1)))
#define LAS __attribute__((address_space(3)))
#define XB_TMO      128
#define XB_XCNT(j)  (256  + 64 * (j))
#define XB_XSUB(j)  (1280 + 64 * (j))
#define XB_XGEN(j)  (2304 + 64 * (j))
#define XB_TOP      3328
#define XB_TOPGEN   3392
#define XCD_BAR_WORDS 3456
#define XB_SPIN_CAP (1u << 18)

__device__ __forceinline__ unsigned xb_ld(unsigned* p)              { return __hip_atomic_load(p, __ATOMIC_RELAXED, __HIP_MEMORY_SCOPE_AGENT); }
__device__ __forceinline__ unsigned xb_add(unsigned* p, unsigned v) { return __hip_atomic_fetch_add(p, v, __ATOMIC_RELAXED, __HIP_MEMORY_SCOPE_AGENT); }
__device__ __forceinline__ unsigned xb_xcc_id() { return (unsigned)__builtin_amdgcn_s_getreg((3 << 11) | 20) & 0xFu; }
#define XB_SPIN(cond, bar) do { unsigned _sp = 0; while (cond) { __builtin_amdgcn_s_sleep(1); \
    if ((++_sp & 255u) == 0u) { if (xb_ld(&(bar)[XB_TMO])) break; if (_sp > XB_SPIN_CAP) { atomicAdd(&(bar)[XB_TMO], 1u); break; } } } } while (0)

struct XcdBarrier {
    unsigned* bar; unsigned x;
    volatile LAS unsigned* st;
};

__device__ __forceinline__ XcdBarrier xcd_barrier_post(unsigned* bar, volatile LAS unsigned* st) {
    XcdBarrier b; b.bar = bar; b.x = xb_xcc_id(); b.st = st;
    if (threadIdx.x == 0) (void)xb_add(&bar[XB_XCNT(b.x)], 1u);
    return b;
}
__device__ __forceinline__ void xcd_barrier_complete(unsigned* bar, unsigned x, unsigned& nloc, unsigned& nx) {
    const unsigned G = gridDim.x * gridDim.y * gridDim.z;
    unsigned sum, cnt, mine, sp = 0u;
    for (;;) {
        sum = 0u; cnt = 0u; mine = 0u;
#pragma unroll
        for (unsigned j = 0; j < 16; ++j) { const unsigned c = xb_ld(&bar[XB_XCNT(j)]); sum += c; cnt += (c > 0u) ? 1u : 0u; mine = (j == x) ? c : mine; }
        if (sum == G) break;
        __builtin_amdgcn_s_sleep(1);
        if ((++sp & 255u) == 0u) { if (xb_ld(&bar[XB_TMO])) break; if (sp > XB_SPIN_CAP) { atomicAdd(&bar[XB_TMO], 1u); break; } }
    }
    nloc = mine > 0u ? mine : 1u; nx = cnt > 0u ? cnt : 1u;
}

__device__ __forceinline__ void xcd_barrier(const XcdBarrier& b) {
    asm volatile("s_waitcnt vmcnt(0)" ::: "memory");
    __syncthreads();
    if (threadIdx.x == 0) {
        unsigned* bar = b.bar;
        __builtin_amdgcn_s_waitcnt(0);
        unsigned nloc = b.st[0], nx = b.st[1];
        if (nloc == 0u) { xcd_barrier_complete(bar, b.x, nloc, nx); b.st[0] = nloc; b.st[1] = nx; }
        const unsigned old = xb_add(&bar[XB_XSUB(b.x)], 1u);
        const unsigned gen = old / nloc;
        if (old + 1u == (gen + 1u) * nloc) {
            __builtin_amdgcn_fence(__ATOMIC_RELEASE, "agent");
            asm volatile("s_waitcnt vmcnt(0)" ::: "memory");
            const unsigned og = xb_add(&bar[XB_TOP], 1u);
            const unsigned tg = og / nx;
            if (og + 1u == (tg + 1u) * nx) xb_add(&bar[XB_TOPGEN], 1u);
            else XB_SPIN(xb_ld(&bar[XB_TOPGEN]) == tg, bar);
            __builtin_amdgcn_fence(__ATOMIC_ACQUIRE, "agent");
            xb_add(&bar[XB_XGEN(b.x)], 1u);
            asm volatile("s_waitcnt vmcnt(0)" ::: "memory");
        } else {
            XB_SPIN(xb_ld(&bar[XB_XGEN(b.x)]) == gen, bar);
            __builtin_amdgcn_fence(__ATOMIC_ACQUIRE, "agent");
            asm volatile("s_waitcnt vmcnt(0)" ::: "memory");
        }
    }
    __syncthreads();
}

__device__ __forceinline__ void phase_exp_up(const Args& a, unsigned char* lds, const XcdBarrier& bar, int tid, int wave, int lane, unsigned* ctr, float* xout, float* ssout) {
  unsigned* slot = (unsigned*)(lds + 8 * 16640);
  const int x0 = (int)(xb_xcc_id() & 7u);
  for (int k = 0; k < 8; ++k) {
    const int xs = (x0 + k) & 7;
    for (;;) {
      __syncthreads();
      if (tid == 0) slot[0] = atomicAdd(ctr + 16 * xs, 1u);
      __syncthreads();
      const unsigned item = slot[0];
      if (item >= (unsigned)(NT / 128)) break;
      exp_up_item(a, lds, xs, (int)item, wave, lane, xout, ssout);
    }
  }
}

__global__ void __launch_bounds__(512, 2) mega(Args a) {
  extern __shared__ __attribute__((aligned(16))) unsigned char lds[];
  cg::grid_group grid = cg::this_grid();
  const int tid = threadIdx.x, lane = tid & 63, wave = tid >> 6;
  const int gw = blockIdx.x * 8 + wave, ngw = gridDim.x * 8;
  unsigned char* ws = a.ws;
  const int lo = a.ph_lo, hi = a.ph_hi;
#define IN(k) (lo <= (k) && (k) < hi)
  volatile LAS unsigned* MISC = (volatile LAS unsigned*)((LAS unsigned char*)lds + 146944);
  if (tid < 32) MISC[tid] = 0u;
  __syncthreads();
  XcdBarrier bar; bar.bar = (unsigned*)(ws + WS_BAR); bar.x = 0; bar.st = nullptr;
  if (hi - lo > 1) bar = xcd_barrier_post((unsigned*)(ws + WS_BAR), MISC + 8);
  if (lo < -1000000) grid.sync();
#define SEAM(k) do { if (IN(k) && IN((k) + 1)) xcd_barrier(bar); } while (0)
#if PROBE_REP == 0
  if (IN(0)) { phase_prep(a, lds, gw, ngw, wave, lane, tid); grid.sync(); }
#endif
  if (IN(0)) { phase_prep(a, lds, gw, ngw, wave, lane, tid); } SEAM(0);
#if PROBE_REP == 1
  if (IN(1)) {
    run_gemm8(lds, (const bf16_t*)(ws + WS_HB), (const bf16_t*)(ws + WS_WIN_T), NT, NQKV, DM, EpiQKV{(bf16_t*)(ws + WS_QKV)});
    run_gemm8(lds, (const bf16_t*)(ws + WS_MEMN), (const bf16_t*)(ws + WS_WXKV_T), NMROWS, 2048, DM, EpiBf16{(bf16_t*)(ws + WS_KX), 2048});
    xcd_barrier(bar); }
#endif
#if PROBE_REP == 2
  if (IN(2)) { phase_scan(a, gw, ngw, lane, tid); xcd_barrier(bar); phase_rms(a, gw, ngw, lane); xcd_barrier(bar); phase_rms(a, gw, ngw, lane); xcd_barrier(bar); }
#endif
  if (IN(1)) {
    run_gemm8(lds, (const bf16_t*)(ws + WS_HB), (const bf16_t*)(ws + WS_WIN_T), NT, NQKV, DM, EpiQKV{(bf16_t*)(ws + WS_QKV)});
    run_gemm8(lds, (const bf16_t*)(ws + WS_MEMN), (const bf16_t*)(ws + WS_WXKV_T), NMROWS, 2048, DM, EpiBf16{(bf16_t*)(ws + WS_KX), 2048});
  } SEAM(1);
  if (IN(2)) { for (int rep = 0; rep < a.rep_scan; ++rep) { phase_scan(a, gw, ngw, lane, tid); if (rep + 1 < a.rep_scan) xcd_barrier(bar); } } SEAM(2);
#if PROBE_REP == 3
  if (IN(3)) { phase_attn2(a, lds, tid); xcd_barrier(bar); if (blockIdx.x == 0 && tid == 0) *(unsigned*)(ws) = 0u; xcd_barrier(bar); }
#endif
  if (IN(3)) {
#if USE_ATT2
    phase_attn2(a, lds, tid);
#else
    phase_attn(a, lds, tid);
#endif
  } SEAM(3);
  if (IN(4)) { phase_onorm(a, gw, ngw, lane); } SEAM(4);
  if (IN(5)) { run_gemm_raw(lds, (const bf16_t*)(ws + WS_OAB), (const bf16_t*)(ws + WS_WOUT_T), NT, DM, DM, pg8::EpiResidSS{a.in[0], a.out, (bf16_t*)(ws + WS_HB), (float*)(ws + WS_SS1)}); }
  if (IN(5) && IN(7)) xcd_barrier(bar);
  if (IN(7)) { run_gemm8(lds, (const bf16_t*)(ws + WS_HB), (const bf16_t*)(ws + WS_WXQ_T), NT, DM, DM, EpiBf16S{(bf16_t*)(ws + WS_QX), DM, (const float*)(ws + WS_SS1)}); } SEAM(7);
#if PROBE_REP == 8
  if (IN(8)) { phase_xattn(a, lds, gw, ngw, wave, lane); grid.sync(); }
#endif
  if (IN(8)) { phase_xattn2(a, lds, tid); } SEAM(8);
  if (IN(9)) { run_gemm_raw(lds, (const bf16_t*)(ws + WS_OX), (const bf16_t*)(ws + WS_WXO_T), NT, DM, DM, pg8::EpiResidSS{a.out, a.out, (bf16_t*)(ws + WS_HB), (float*)(ws + WS_SS2)}); }
  if (IN(9) && IN(11)) xcd_barrier(bar);
  if (IN(11)) { run_gemm8(lds, (const bf16_t*)(ws + WS_HB), (const bf16_t*)(ws + WS_WPQ_T), NT, DM, DM, EpiBf16S{(bf16_t*)(ws + WS_PQ), DM, (const float*)(ws + WS_SS2)}); } SEAM(11);
#if PROBE_REP == 12
  if (IN(12)) { phase_topk(a, lds, tid); grid.sync(); }
#endif
  if (IN(12)) { phase_topk2(a, lds, wave, lane); } SEAM(12);
    if (IN(13)) {
    for (int rep = 0; rep < a.rep_down; ++rep) { phase_exp_down(a, gw, ngw, lane); if (hi - lo > 1) xcd_barrier(bar); }
    phase_exp_up2(a, lds, wave, lane);
  }
#undef IN
#undef SEAM
}

extern "C" void kernel_launch(void* const* d_in, const int* in_sizes, int n_in, void* d_out, int out_size, void* d_ws, size_t ws_size, hipStream_t stream) {
  static int grid = 0;
  if (grid == 0) {
    if (n_in != 22 || out_size != NT * DM || ws_size < WS_END) { fprintf(stderr, "kernel_launch: unexpected shapes (n_in %d out %d ws %zu)\n", n_in, out_size, ws_size); grid = -1; return; }
    int dev = 0, cus = 0, per_cu = 0;
    (void)hipGetDevice(&dev);
    (void)hipDeviceGetAttribute(&cus, hipDeviceAttributeMultiprocessorCount, dev);
    (void)hipFuncSetAttribute((const void*)mega, hipFuncAttributeMaxDynamicSharedMemorySize, LDS_BYTES);
    (void)hipOccupancyMaxActiveBlocksPerMultiprocessor(&per_cu, (const void*)mega, 512, LDS_BYTES);
    if (per_cu < 1) per_cu = 1;
    grid = cus * per_cu;
  }
  if (grid < 0) return;
  (void)hipMemsetAsync(d_ws, 0, CTL_ZERO_BYTES, stream);
  Args a{};
  for (int i = 0; i < 22; ++i) a.in[i] = (const float*)d_in[i];
  a.out = (float*)d_out; a.ws = (unsigned char*)d_ws;
  a.rep_down = REP_DOWN; a.rep_up = REP_UP; a.rep_scan = REP_SCAN;
#if MK_N_LAUNCHES == 1
  a.ph_lo = 0; a.ph_hi = NPHASE + 1;
  void* args[] = {&a};
  hipError_t e = hipLaunchCooperativeKernel((const void*)mega, dim3(grid), dim3(512), args, LDS_BYTES, stream);
  if (e != hipSuccess) fprintf(stderr, "cooperative launch failed: %s (grid %d)\n", hipGetErrorString(e), grid);
#else
  for (int p = 0; p <= NPHASE; ++p) { a.ph_lo = p; a.ph_hi = p + 1; hipLaunchKernelGGL(mega, dim3(grid), dim3(512), LDS_BYTES, stream, a); }
#endif
}
```

```cpp
#include <hip/hip_runtime.h>
#include <hip/hip_cooperative_groups.h>
#include <cstdio>
#include <cstdint>
namespace cg = cooperative_groups;

#ifndef USE_PG8
#define USE_PG8 1
#endif
#ifndef USE_ATT2
#define USE_ATT2 1
#endif
#ifndef PROBE_REP
#define PROBE_REP -1
#endif
#ifndef REP_DOWN
#define REP_DOWN 1
#endif
#ifndef REP_UP
#define REP_UP 1
#endif
#ifndef REP_SCAN
#define REP_SCAN 1
#endif
#ifndef MK_N_LAUNCHES
#define MK_N_LAUNCHES 1
#endif

typedef unsigned short bf16_t;
typedef short bf16x8 __attribute__((ext_vector_type(8)));
typedef float f32x4 __attribute__((ext_vector_type(4)));
typedef unsigned u32x4 __attribute__((ext_vector_type(4)));
typedef unsigned u32x2 __attribute__((ext_vector_type(2)));
typedef float v32f __attribute__((ext_vector_type(32)));
typedef float v16f __attribute__((ext_vector_type(16)));
typedef unsigned v6u __attribute__((ext_vector_type(6)));
typedef float f32x2 __attribute__((ext_vector_type(2)));

constexpr int NB = 8, SEQ = 4096, DM = 1024, NT = NB * SEQ;
constexpr int NQKV = 3072, INW = 3080;
constexpr int NMEM = 256, NMROWS = NB * NMEM;
constexpr int NEXP = 16384;
constexpr float EPS = 1e-6f;
constexpr int NPHASE = 13;
constexpr int LDS_BYTES = 147456;

constexpr size_t MiB = 1u << 20;
constexpr size_t WS_BAR = 65536;
constexpr size_t WS_SS1 = 131072;
constexpr size_t WS_SS2 = 262144;
constexpr size_t WS_SS3 = 393216;
constexpr size_t WS_XCTR = 512;
constexpr size_t CTL_ZERO_BYTES = 524288;
constexpr size_t WS_WIN_T = 2 * MiB;
constexpr size_t WS_WOUT_T = 8 * MiB;
constexpr size_t WS_WXQ_T = 10 * MiB;
constexpr size_t WS_WXKV_T = 12 * MiB;
constexpr size_t WS_WXO_T = 16 * MiB;
constexpr size_t WS_WPQ_T = 18 * MiB;
constexpr size_t WS_SK = 21 * MiB;
constexpr size_t WS_MEMN = 22 * MiB;
constexpr size_t WS_KX = 26 * MiB;
constexpr size_t WS_VXT = 30 * MiB;
constexpr size_t WS_FLOG = 34 * MiB;
constexpr size_t WS_CUM = 35 * MiB;
constexpr size_t WS_KMEAN = 36 * MiB;
constexpr size_t WS_ESC = 38 * MiB;
constexpr size_t WS_EXD = 40 * MiB;
constexpr size_t WS_EXU = 72 * MiB;
constexpr size_t WS_HB = 104 * MiB;
constexpr size_t WS_QKV = 168 * MiB;
constexpr size_t WS_OAB = 360 * MiB;
constexpr size_t WS_QX = 168 * MiB;
constexpr size_t WS_OX = 232 * MiB;
constexpr size_t WS_PQ = 232 * MiB;
constexpr size_t WS_EIDX = 424 * MiB;
constexpr size_t WS_GATE = 440 * MiB;
constexpr size_t WS_W = 456 * MiB;
constexpr size_t WS_END = 472 * MiB;

struct Args {
  const float* in[22];
  float* out;
  unsigned char* ws;
  int ph_lo, ph_hi;
  int rep_down, rep_up, rep_scan, pad_;
};

struct XcdBarrier;
__device__ __forceinline__ unsigned f2bf(float f) { unsigned u = __float_as_uint(f); return (u + 0x7fffu + ((u >> 16) & 1u)) >> 16; }
__device__ __forceinline__ unsigned pk2(float lo, float hi) { return f2bf(lo) | (f2bf(hi) << 16); }
__device__ __forceinline__ float bf2f(unsigned short b) { return __uint_as_float(((unsigned)b) << 16); }
__device__ __forceinline__ float bflo(unsigned w) { return __uint_as_float(w << 16); }
__device__ __forceinline__ float bfhi(unsigned w) { return __uint_as_float(w & 0xffff0000u); }
__device__ __forceinline__ float wave_sum(float v) {
#pragma unroll
  for (int o = 1; o < 64; o <<= 1) v += __shfl_xor(v, o);
  return v;
}
template <int O> __device__ __forceinline__ float swz_xor(float v) { return __int_as_float(__builtin_amdgcn_ds_swizzle(__float_as_int(v), (O << 10) | 0x1f)); }
__device__ __forceinline__ float half_sum32(float v) { v += swz_xor<1>(v); v += swz_xor<2>(v); v += swz_xor<4>(v); v += swz_xor<8>(v); v += swz_xor<16>(v); return v; }
__device__ __forceinline__ void unpack8(const u32x4 w, float* f) {
  f[0] = bflo(w.x); f[1] = bfhi(w.x); f[2] = bflo(w.y); f[3] = bfhi(w.y);
  f[4] = bflo(w.z); f[5] = bfhi(w.z); f[6] = bflo(w.w); f[7] = bfhi(w.w);
}

__device__ const unsigned char T5_BUCKET[128] = {
  0, 1, 2, 3, 4, 5, 6, 7, 8, 9, 10, 11, 12, 13, 14, 15, 16, 16, 16, 17, 17, 18, 18, 18, 19, 19, 19, 20, 20, 20, 20, 21,
  21, 21, 21, 22, 22, 22, 22, 22, 23, 23, 23, 23, 23, 23, 24, 24, 24, 24, 24, 24, 25, 25, 25, 25, 25, 25, 25, 26, 26, 26, 26, 26,
  26, 26, 26, 27, 27, 27, 27, 27, 27, 27, 27, 27, 27, 28, 28, 28, 28, 28, 28, 28, 28, 28, 28, 29, 29, 29, 29, 29, 29, 29, 29, 29,
  29, 29, 29, 30, 30, 30, 30, 30, 30, 30, 30, 30, 30, 30, 30, 30, 30, 31, 31, 31, 31, 31, 31, 31, 31, 31, 31, 31, 31, 31, 31, 31};

__device__ __forceinline__ void transpose_item(const float* W, int ldw, const float* gain, bf16_t* WT, int K, int row_off, float* scr, int kb, int nb, int lane) {
  const int k0 = 64 * kb, n0 = 32 * nb;
#pragma unroll 8
  for (int i = 0; i < 32; ++i) {
    const int kk = 2 * i + (lane >> 5);
    const float g = gain ? gain[k0 + kk] : 1.f;
    scr[kk * 33 + (lane & 31)] = W[(size_t)(k0 + kk) * ldw + n0 + (lane & 31)] * g;
  }
  __builtin_amdgcn_wave_barrier();
  const int c = lane & 7;
#pragma unroll
  for (int j = 0; j < 4; ++j) {
    const int n = (lane >> 3) + 8 * j; const float* s = scr + (8 * c) * 33 + n;
    u32x4 o; o.x = pk2(s[0 * 33], s[1 * 33]); o.y = pk2(s[2 * 33], s[3 * 33]); o.z = pk2(s[4 * 33], s[5 * 33]); o.w = pk2(s[6 * 33], s[7 * 33]);
    *(u32x4*)(WT + (size_t)(row_off + n0 + n) * K + k0 + 8 * c) = o;
  }
  __builtin_amdgcn_wave_barrier();
}

__device__ __forceinline__ void rms_row_to_bf16(const float* xrow, bf16_t* orow, int lane) {
  const f32x4* xr = (const f32x4*)xrow + lane;
  f32x4 v[4]; float s = 0.f;
#pragma unroll
  for (int j = 0; j < 4; ++j) { v[j] = xr[64 * j]; s += (v[j].x * v[j].x + v[j].y * v[j].y) + (v[j].z * v[j].z + v[j].w * v[j].w); }
  const float rstd = rsqrtf(wave_sum(s) * (1.f / DM) + EPS);
  u32x2* o = (u32x2*)orow + lane;
#pragma unroll
  for (int j = 0; j < 4; ++j) { u32x2 w; w.x = pk2(v[j].x * rstd, v[j].y * rstd); w.y = pk2(v[j].z * rstd, v[j].w * rstd); o[64 * j] = w; }
}

__device__ __forceinline__ void phase_prep(const Args& a, unsigned char* lds, int gw, int ngw, int wave, int lane, int tid) {
  unsigned char* ws = a.ws;
  float* scr = (float*)(lds + wave * 8448);
  const int I_IN = 16 * 96, I_SQ = 16 * 32;
  const int NITEMS = I_IN + 6 * I_SQ;
  for (int it = gw; it < NITEMS; it += ngw) {
    int r = it;
    if (r < I_IN) { transpose_item(a.in[3], INW, a.in[2], (bf16_t*)(ws + WS_WIN_T), DM, 0, scr, r / 96, r % 96, lane); continue; } r -= I_IN;
    const int which = r / I_SQ; r %= I_SQ; const int kb = r / 32, nb = r % 32;
    if (which == 0) { const float* g = (kb < 8) ? a.in[6] : (a.in[7] - 512); transpose_item(a.in[8], DM, g, (bf16_t*)(ws + WS_WOUT_T), DM, 0, scr, kb, nb, lane); }
    else if (which == 1) transpose_item(a.in[11], DM, a.in[9], (bf16_t*)(ws + WS_WXQ_T), DM, 0, scr, kb, nb, lane);
    else if (which == 2) transpose_item(a.in[12], DM, a.in[10], (bf16_t*)(ws + WS_WXKV_T), DM, 0, scr, kb, nb, lane);
    else if (which == 3) transpose_item(a.in[13], DM, a.in[10], (bf16_t*)(ws + WS_WXKV_T), DM, 1024, scr, kb, nb, lane);
    else if (which == 4) transpose_item(a.in[14], DM, nullptr, (bf16_t*)(ws + WS_WXO_T), DM, 0, scr, kb, nb, lane);
    else transpose_item(a.in[16], DM, a.in[15], (bf16_t*)(ws + WS_WPQ_T), DM, 0, scr, kb, nb, lane);
  }
  for (int it = gw; it < NEXP; it += ngw) {
    const int hi = lane >> 5, l32 = lane & 31; const int r = 2 * it + hi;
    const int tb = r >= NEXP, e = r - tb * NEXP;
    const f32x4* src = (const f32x4*)(a.in[19 + tb] + (size_t)e * DM) + 8 * l32;
    v16f xa, xb; float am = 0.f;
#pragma unroll
    for (int k = 0; k < 4; ++k) { const f32x4 p = src[k], q = src[4 + k];
      xa[2 * k] = p.x; xb[2 * k] = p.y; xa[2 * k + 1] = p.z; xb[2 * k + 1] = p.w; xa[8 + 2 * k] = q.x; xb[8 + 2 * k] = q.y; xa[8 + 2 * k + 1] = q.z; xb[8 + 2 * k + 1] = q.w;
      am = fmaxf(am, fmaxf(fmaxf(fabsf(p.x), fabsf(p.y)), fmaxf(fabsf(p.z), fabsf(p.w)))); am = fmaxf(am, fmaxf(fmaxf(fabsf(q.x), fabsf(q.y)), fmaxf(fabsf(q.z), fabsf(q.w)))); }
#pragma unroll
    for (int o = 1; o < 32; o <<= 1) am = fmaxf(am, __shfl_xor(am, o));
    if (tb == 0) {
      const float sc = am > 0.f ? 7.0f / am : 1.f;
      xa = xa * sc; xb = xb * sc;
      const v6u w = __builtin_amdgcn_cvt_scalef32_2xpk16_fp6_f32(xa, xb, 1.0f);
      u32x2* dst = (u32x2*)(ws + WS_EXD + (size_t)e * 768 + 24 * l32);
      dst[0] = (u32x2){w[0], w[1]}; dst[1] = (u32x2){w[2], w[3]}; dst[2] = (u32x2){w[4], w[5]};
      if (l32 == 0) ((float*)(ws + WS_ESC))[r] = am > 0.f ? am / 7.0f : 1.f;
    } else {
      const float sc = am > 0.f ? 440.f / am : 1.f;
      u32x4 o0, o1;
#pragma unroll
      for (int k = 0; k < 4; ++k) { int w = __builtin_amdgcn_cvt_pk_fp8_f32(xa[2 * k] * sc, xb[2 * k] * sc, 0, false); w = __builtin_amdgcn_cvt_pk_fp8_f32(xa[2 * k + 1] * sc, xb[2 * k + 1] * sc, w, true); o0[k] = (unsigned)w; }
#pragma unroll
      for (int k = 0; k < 4; ++k) { int w = __builtin_amdgcn_cvt_pk_fp8_f32(xa[8 + 2 * k] * sc, xb[8 + 2 * k] * sc, 0, false); w = __builtin_amdgcn_cvt_pk_fp8_f32(xa[8 + 2 * k + 1] * sc, xb[8 + 2 * k + 1] * sc, w, true); o1[k] = (unsigned)w; }
      u32x4* dst = (u32x4*)(ws + WS_EXU + (size_t)(l32 >> 2) * (NEXP * 128) + (size_t)e * 128 + 32 * (l32 & 3));
      dst[0] = o0; dst[1] = o1;
      if (l32 == 0) ((float*)(ws + WS_ESC))[r] = am > 0.f ? am / 440.f : 1.f;
    }
  }
  for (int i = blockIdx.x * 512 + tid; i < 2 * 65536; i += gridDim.x * 512) ((bf16_t*)(ws + WS_SK))[i] = (bf16_t)f2bf(a.in[17 + (i >> 16)][i & 65535]);
  for (int r = gw; r < NMROWS; r += ngw) rms_row_to_bf16(a.in[1] + (size_t)r * DM, (bf16_t*)(ws + WS_MEMN) + (size_t)r * DM, lane);
  __syncthreads();
  float* wf = (float*)(lds + 69632);
  for (int k = tid; k < DM; k += 512) {
    const float g = a.in[2][k]; const f32x4* wp = (const f32x4*)(a.in[3] + (size_t)k * INW + NQKV);
    const f32x4 p = wp[0], q = wp[1];
    wf[k] = p.x * g; wf[1024 + k] = p.y * g; wf[2048 + k] = p.z * g; wf[3072 + k] = p.w * g; wf[4096 + k] = q.x * g; wf[5120 + k] = q.y * g; wf[6144 + k] = q.z * g; wf[7168 + k] = q.w * g;
  }
  __syncthreads();
  float* flog = (float*)(ws + WS_FLOG);
  for (int r = gw; r < NT; r += ngw) {
    const f32x4* xr = (const f32x4*)(a.in[0] + (size_t)r * DM) + lane;
    f32x4 v[4]; float s = 0.f; float fa[8];
#pragma unroll
    for (int j = 0; j < 8; ++j) fa[j] = 0.f;
#pragma unroll
    for (int j = 0; j < 4; ++j) {
      v[j] = xr[64 * j]; s += (v[j].x * v[j].x + v[j].y * v[j].y) + (v[j].z * v[j].z + v[j].w * v[j].w);
#pragma unroll
      for (int jj = 0; jj < 8; ++jj) { const f32x4 w4 = *(const f32x4*)(wf + jj * 1024 + 256 * j + 4 * lane); fa[jj] += (v[j].x * w4.x + v[j].y * w4.y) + (v[j].z * w4.z + v[j].w * w4.w); }
    }
    const float rstd = rsqrtf(wave_sum(s) * (1.f / DM) + EPS);
    float mine = 0.f;
#pragma unroll
    for (int j = 0; j < 8; ++j) { const float t = wave_sum(fa[j]); if (lane == j) mine = t; }
    if (lane < 8) {
      const float z = mine * rstd + a.in[4][lane];
      flog[(size_t)lane * NT + r] = fminf(z, 0.f) - log1pf(expf(-fabsf(z)));
    }
    u32x2* o = (u32x2*)((bf16_t*)(ws + WS_HB) + (size_t)r * DM) + lane;
#pragma unroll
    for (int j = 0; j < 4; ++j) { u32x2 w; w.x = pk2(v[j].x * rstd, v[j].y * rstd); w.y = pk2(v[j].z * rstd, v[j].w * rstd); o[64 * j] = w; }
  }
}

template <class Epi>
__device__ __forceinline__ void gemm_naive(const bf16_t* A, int lda, const bf16_t* Bt, int ldb, int M, int N, int K, const Epi& E, int gw, int ngw, int lane) {
  const int fr = lane & 15, fq = lane >> 4;
  const int tn = N / 64, ntile = (M / 64) * tn;
  for (int tile = gw; tile < ntile; tile += ngw) {
    const int pm = tile / tn, pn = tile % tn;
    f32x4 acc[4][4];
#pragma unroll
    for (int m = 0; m < 4; ++m)
#pragma unroll
      for (int n = 0; n < 4; ++n) acc[m][n] = (f32x4){0.f, 0.f, 0.f, 0.f};
    const bf16_t* Ap = A + (size_t)(pm * 64 + fr) * lda + fq * 8;
    const bf16_t* Bp = Bt + (size_t)(pn * 64 + fr) * ldb + fq * 8;
    for (int k0 = 0; k0 < K; k0 += 32) {
      bf16x8 af[4], bfr[4];
#pragma unroll
      for (int m = 0; m < 4; ++m) af[m] = *(const bf16x8*)(Ap + (size_t)m * 16 * lda + k0);
#pragma unroll
      for (int n = 0; n < 4; ++n) bfr[n] = *(const bf16x8*)(Bp + (size_t)n * 16 * ldb + k0);
#pragma unroll
      for (int m = 0; m < 4; ++m)
#pragma unroll
        for (int n = 0; n < 4; ++n) acc[m][n] = __builtin_amdgcn_mfma_f32_16x16x32_bf16(bfr[n], af[m], acc[m][n], 0, 0, 0);
    }
#pragma unroll
    for (int m = 0; m < 4; ++m)
#pragma unroll
      for (int n = 0; n < 4; ++n) E.store(pm * 64 + m * 16 + fr, pn * 64 + n * 16 + 4 * fq, acc[m][n]);
  }
}

struct EpiBf16 { bf16_t* O; int ldo;
  __device__ __forceinline__ void store8(int row, int col, f32x4 a, f32x4 b) const { u32x4 w; w.x = pk2(a.x, a.y); w.y = pk2(a.z, a.w); w.z = pk2(b.x, b.y); w.w = pk2(b.z, b.w); *(u32x4*)(O + (size_t)row * ldo + col) = w; }
  __device__ __forceinline__ void store(int row, int col, f32x4 v) const { u32x2 w; w.x = pk2(v.x, v.y); w.y = pk2(v.z, v.w); *(u32x2*)(O + (size_t)row * ldo + col) = w; } };
struct EpiQKV { bf16_t* O;
  __device__ __forceinline__ void store8(int row, int col, f32x4 a, f32x4 b) const { const float sc = (col < 512 || (col >= 1536 && col < 2048)) ? 0.18033688011112042f : 1.f;
    u32x4 w; w.x = pk2(a.x * sc, a.y * sc); w.y = pk2(a.z * sc, a.w * sc); w.z = pk2(b.x * sc, b.y * sc); w.w = pk2(b.z * sc, b.w * sc); *(u32x4*)(O + (size_t)row * NQKV + col) = w; }
  __device__ __forceinline__ void store(int row, int col, f32x4 v) const { const float sc = (col < 512 || (col >= 1536 && col < 2048)) ? 0.18033688011112042f : 1.f;
    u32x2 w; w.x = pk2(v.x * sc, v.y * sc); w.y = pk2(v.z * sc, v.w * sc); *(u32x2*)(O + (size_t)row * NQKV + col) = w; } };
struct EpiBf16S { bf16_t* O; int ldo; const float* ss;
  __device__ __forceinline__ void store8(int row, int col, f32x4 a, f32x4 b) const { const float r = rsqrtf(ss[row] * (1.f / DM) + EPS);
    u32x4 w; w.x = pk2(a.x * r, a.y * r); w.y = pk2(a.z * r, a.w * r); w.z = pk2(b.x * r, b.y * r); w.w = pk2(b.z * r, b.w * r); *(u32x4*)(O + (size_t)row * ldo + col) = w; }
  __device__ __forceinline__ void store(int row, int col, f32x4 v) const { const float r = rsqrtf(ss[row] * (1.f / DM) + EPS); u32x2 w; w.x = pk2(v.x * r, v.y * r); w.y = pk2(v.z * r, v.w * r); *(u32x2*)(O + (size_t)row * ldo + col) = w; } };
struct EpiF32S { float* O; int ldo; const float* ss;
  __device__ __forceinline__ void store(int row, int col, f32x4 v) const { const float r = rsqrtf(ss[row] * (1.f / DM) + EPS); *(f32x4*)(O + (size_t)row * ldo + col) = v * r; } };
struct EpiF32 { float* O; int ldo;
  __device__ __forceinline__ void store(int row, int col, f32x4 v) const { *(f32x4*)(O + (size_t)row * ldo + col) = v; } };
struct EpiResid { const float* base; float* out;
  __device__ __forceinline__ void store(int row, int col, f32x4 v) const { const size_t o = (size_t)row * DM + col; const f32x4 b = *(const f32x4*)(base + o); *(f32x4*)(out + o) = b + v; } };
struct EpiKV { bf16_t* KX; bf16_t* VXT;
  __device__ __forceinline__ void store(int row, int col, f32x4 v) const {
    if (col < 1024) { u32x2 w; w.x = pk2(v.x, v.y); w.y = pk2(v.z, v.w); *(u32x2*)(KX + (size_t)row * DM + col) = w; }
    else { const int b = row >> 8, m = row & 255;
#pragma unroll
      for (int r = 0; r < 4; ++r) { const int d = col - 1024 + r; VXT[((size_t)(b * 4 + (d >> 8)) * 256 + (d & 255)) * 256 + m] = (bf16_t)f2bf(v[r]); } } } };

__device__ __forceinline__ void phase_scan(const Args& a, int gw, int ngw, int lane, int tid) {
  unsigned char* ws = a.ws;
  const bf16_t* qkv = (const bf16_t*)(ws + WS_QKV);
  for (int item = gw; item < 64 + 1024 + 1024; item += ngw) {
    if (item < 64) {
      const int b = item >> 3, j = item & 7;
      const f32x4* src = (const f32x4*)((const float*)(ws + WS_FLOG) + (size_t)j * NT + (size_t)b * SEQ + lane * 64);
      f32x4 v[16];
#pragma unroll
      for (int i = 0; i < 16; ++i) v[i] = src[i];
      float tot = 0.f;
#pragma unroll
      for (int i = 0; i < 16; ++i) tot += (v[i].x + v[i].y) + (v[i].z + v[i].w);
      float inc = tot;
#pragma unroll
      for (int o = 1; o < 64; o <<= 1) { const float t = __shfl_up(inc, o); if (lane >= o) inc += t; }
      float run = inc - tot;
      f32x4* dst = (f32x4*)((float*)(ws + WS_CUM) + ((size_t)(b * 8 + j)) * SEQ + lane * 64);
#pragma unroll
      for (int i = 0; i < 16; ++i) { f32x4 o; run += v[i].x; o.x = run * 1.4426950408889634f; run += v[i].y; o.y = run * 1.4426950408889634f; run += v[i].z; o.z = run * 1.4426950408889634f; run += v[i].w; o.w = run * 1.4426950408889634f; dst[i] = o; }
    } else if (item < 64 + 1024) {
      const int it = item - 64, h = it & 7, blk = (it >> 3) & 15, b = it >> 7;
      const bf16_t* p = qkv + ((size_t)b * SEQ + blk * 256 + (lane >> 3)) * NQKV + 512 + h * 64 + (lane & 7) * 8;
      float s[8];
#pragma unroll
      for (int i = 0; i < 8; ++i) s[i] = 0.f;
#pragma unroll 8
      for (int rr = 0; rr < 32; ++rr) { float f[8]; unpack8(*(const u32x4*)(p + (size_t)rr * 8 * NQKV), f);
#pragma unroll
        for (int i = 0; i < 8; ++i) s[i] += f[i]; }
#pragma unroll
      for (int i = 0; i < 8; ++i) { s[i] += __shfl_xor(s[i], 8); s[i] += __shfl_xor(s[i], 16); s[i] += __shfl_xor(s[i], 32); }
      if (lane < 8) { f32x4* d = (f32x4*)((float*)(ws + WS_KMEAN) + ((size_t)(b * 16 + blk) * 8 + h) * 64 + lane * 8);
        d[0] = (f32x4){s[0], s[1], s[2], s[3]} * (1.f / 256.f); d[1] = (f32x4){s[4], s[5], s[6], s[7]} * (1.f / 256.f); }
    } else {
      const int it = item - 64 - 1024, bh = it >> 4, ch = it & 15, b = bh >> 3, h = bh & 7;
      const bf16_t* p = qkv + ((size_t)b * SEQ + ch * 256 + (lane >> 3)) * NQKV + 2048 + h * 64 + (lane & 7) * 8;
      float m = 0.f;
#pragma unroll 8
      for (int rr = 0; rr < 32; ++rr) { float f[8]; unpack8(*(const u32x4*)(p + (size_t)rr * 8 * NQKV), f);
        float s = 0.f;
#pragma unroll
        for (int i = 0; i < 8; ++i) s += f[i] * f[i];
        s += __shfl_xor(s, 1); s += __shfl_xor(s, 2); s += __shfl_xor(s, 4);
        m = fmaxf(m, s); }
#pragma unroll
      for (int o = 8; o < 64; o <<= 1) m = fmaxf(m, __shfl_xor(m, o));
      if (lane == 0) atomicMax((unsigned*)(ws + 256) + bh, __float_as_uint(m));
    }
  }
}

template <int MODE>
__device__ __forceinline__ void attn_naive_unit(const Args& a, unsigned char* lds, int b, int h, int sb, int tid) {
  unsigned char* ws = a.ws;
  const bf16_t* qkv = (const bf16_t*)(ws + WS_QKV);
  const int qoff = MODE ? 1536 : 0, koff = qoff + 512, voff = qoff + 1024;
  float* Ks = (float*)lds; float* Vs = Ks + 64 * 64; float* ck = Vs + 64 * 64; float* biasd = ck + 64;
  const int t = sb * 512 + tid; const size_t row = (size_t)b * SEQ + t;
  float q[64], o[64];
  {
    const u32x4* qp = (const u32x4*)(qkv + row * NQKV + qoff + h * 64);
#pragma unroll
    for (int c = 0; c < 8; ++c) { const u32x4 w = qp[c]; unpack8(w, q + 8 * c); }
#pragma unroll
    for (int d = 0; d < 64; ++d) { q[d] *= 0.6931471805599453f; o[d] = 0.f; }
  }
  float m = -1e30f, l = 0.f;
  unsigned selmask = 0u; const int own = t >> 8;
  float cq = 0.f, bfar = 0.f;
  __syncthreads();
  if (MODE == 0) {
    if (tid < 128) biasd[tid] = a.in[5][T5_BUCKET[tid] * 8 + h];
    bfar = a.in[5][31 * 8 + h];
    const float* km = (const float*)(ws + WS_KMEAN) + ((size_t)b * 16) * 512 + h * 64;
    float v0 = -3e38f, v1 = -3e38f, v2 = -3e38f; int i0 = -1, i1 = -1, i2 = -1;
    for (int n = 0; n < 2 * sb + 1; ++n) {
      if (n < own) {
        const float* kp = km + (size_t)n * 512; float s = 0.f;
#pragma unroll
        for (int d = 0; d < 64; ++d) s += q[d] * kp[d];
        if (s > v0) { v2 = v1; i2 = i1; v1 = v0; i1 = i0; v0 = s; i0 = n; }
        else if (s > v1) { v2 = v1; i2 = i1; v1 = s; i1 = n; }
        else if (s > v2) { v2 = s; i2 = n; }
      }
    }
    if (i0 >= 0) selmask |= 1u << i0;
    if (i1 >= 0) selmask |= 1u << i1;
    if (i2 >= 0) selmask |= 1u << i2;
  } else {
    cq = ((const float*)(ws + WS_CUM))[((size_t)(b * 8 + h)) * SEQ + t];
  }
  const int ntile = 8 * (sb + 1);
  for (int kt = 0; kt < ntile; ++kt) {
    __syncthreads();
    {
      const int r = tid >> 3, ch = tid & 7;
      const bf16_t* kp = qkv + ((size_t)b * SEQ + kt * 64 + r) * NQKV + h * 64 + ch * 8;
      const u32x4 kw = *(const u32x4*)(kp + koff), vw = *(const u32x4*)(kp + voff);
      unpack8(kw, Ks + r * 64 + ch * 8); unpack8(vw, Vs + r * 64 + ch * 8);
      if (MODE == 1 && tid < 64) ck[tid] = ((const float*)(ws + WS_CUM))[((size_t)(b * 8 + h)) * SEQ + kt * 64 + tid];
    }
    __syncthreads();
    const int kb = kt >> 2;
    bool act;
    if (MODE == 0) act = (kb == own) || (kb < own && ((selmask >> kb) & 1u));
    else act = (kt * 64 <= t);
    if (act) {
      for (int jj = 0; jj < 64; ++jj) {
        const int sp = kt * 64 + jj;
        if (sp > t) break;
        const f32x4* kr = (const f32x4*)(Ks + jj * 64);
        float s = 0.f;
#pragma unroll
        for (int c = 0; c < 16; ++c) { const f32x4 kv = kr[c]; s += q[4 * c] * kv.x + q[4 * c + 1] * kv.y + q[4 * c + 2] * kv.z + q[4 * c + 3] * kv.w; }
        if (MODE == 0) { const int dist = t - sp; s += (dist < 128) ? biasd[dist] : bfar; }
        else s += (cq - ck[jj]) * 0.6931471805599453f;
        if (s > m) { const float f = __expf(m - s); l *= f;
#pragma unroll
          for (int d = 0; d < 64; ++d) o[d] *= f;
          m = s; }
        const float p = __expf(s - m); l += p;
        const f32x4* vr = (const f32x4*)(Vs + jj * 64);
#pragma unroll
        for (int c = 0; c < 16; ++c) { const f32x4 vv = vr[c]; o[4 * c] += p * vv.x; o[4 * c + 1] += p * vv.y; o[4 * c + 2] += p * vv.z; o[4 * c + 3] += p * vv.w; }
      }
    }
  }
  const float il = 1.f / l;
  u32x4* op = (u32x4*)((bf16_t*)(ws + WS_OAB) + row * DM + (MODE ? 512 : 0) + h * 64);
#pragma unroll
  for (int c = 0; c < 8; ++c) { u32x4 w; w.x = pk2(o[8 * c] * il, o[8 * c + 1] * il); w.y = pk2(o[8 * c + 2] * il, o[8 * c + 3] * il); w.z = pk2(o[8 * c + 4] * il, o[8 * c + 5] * il); w.w = pk2(o[8 * c + 6] * il, o[8 * c + 7] * il); op[c] = w; }
}

__device__ __forceinline__ void phase_attn(const Args& a, unsigned char* lds, int tid) {
  for (int u = blockIdx.x; u < 1024; u += gridDim.x) {
    const int sb = 7 - (u >> 7), r = u & 127, mode = r & 1, bh = r >> 1;
    if (mode == 0) attn_naive_unit<0>(a, lds, bh >> 3, bh & 7, sb, tid);
    else attn_naive_unit<1>(a, lds, bh >> 3, bh & 7, sb, tid);
  }
}

namespace att {
typedef float f32x16 __attribute__((ext_vector_type(16)));
typedef short s16x4 __attribute__((ext_vector_type(4)));
typedef short v4i16_t __attribute__((ext_vector_type(4)));
typedef __attribute__((address_space(3))) const char* lds_cptr;
typedef float f32x2_t __attribute__((ext_vector_type(2))); typedef __bf16 bf16x2_t __attribute__((ext_vector_type(2)));
constexpr int PITCH = NQKV;
constexpr float LOG2E = 1.4426950408889634f;
constexpr float C2 = 0.125f * LOG2E;
constexpr int L_K = 0, L_V = 16384, L_WSF = 32768, L_OST = 34816, L_C2 = 67584, L_KM = 83968, L_BT = 88064, L_MISC = 88704;
__device__ __forceinline__ int crow(int r, int hi) { return (r & 3) + 8 * (r >> 2) + 4 * hi; }
__device__ __forceinline__ unsigned cvtpk(float lo, float hi) { f32x2_t v = {lo, hi}; bf16x2_t b = __builtin_convertvector(v, bf16x2_t); return __builtin_bit_cast(unsigned, b); }
__device__ __forceinline__ s16x4 vtr(lds_cptr p) { return __builtin_bit_cast(s16x4, __builtin_amdgcn_ds_read_tr16_b64_v4i16((__attribute__((address_space(3))) v4i16_t*)p)); }
__device__ __forceinline__ float max3f(float a, float b, float c) { float r; asm("v_max3_f32 %0, %1, %2, %3" : "=v"(r) : "v"(a), "v"(b), "v"(c)); return r; }
__device__ __forceinline__ float xhalf_max(float m) { auto rr = __builtin_amdgcn_permlane32_swap(__float_as_uint(m), __float_as_uint(m), false, false); return fmaxf(__uint_as_float(rr[0]), __uint_as_float(rr[1])); }
__device__ __forceinline__ float xhalf_sum(float m) { auto rr = __builtin_amdgcn_permlane32_swap(__float_as_uint(m), __float_as_uint(m), false, false); return __uint_as_float(rr[0]) + __uint_as_float(rr[1]); }

template <int MODE>
__device__ __forceinline__ void unit(const Args& a, unsigned char* lds, int b, int h, int qb, int tid) {
  unsigned char* ws = a.ws;
  const int lane = tid & 63, r32 = lane & 31, hi = lane >> 5; const int wid = __builtin_amdgcn_readfirstlane(tid >> 6);
  const bf16_t* qkv = (const bf16_t*)(ws + WS_QKV);
  const int qoff = MODE ? 1536 : 0;
  const size_t rowbase = (size_t)b * SEQ; const int q0 = qb * 256;
  const bf16_t* Qw = qkv + (rowbase + q0 + wid * 32) * PITCH + qoff + h * 64;
  const bf16_t* Kh = qkv + rowbase * PITCH + qoff + 512 + h * 64;
  const bf16_t* Vh = qkv + rowbase * PITCH + qoff + 1024 + h * 64;
  float* wsf = (float*)(lds + L_WSF) + wid * 64;
  float* c2s = (float*)(lds + L_C2); float* kms = (float*)(lds + L_KM); float* bts = (float*)(lds + L_BT); unsigned* misc = (unsigned*)(lds + L_MISC);
  const int NTL = 4 * (qb + 1);
  __syncthreads();
  if (MODE == 0) {
    const float* km = (const float*)(ws + WS_KMEAN) + (size_t)b * 16 * 512 + h * 64;
    for (int i = tid; i < 16 * 64; i += 512) kms[i] = km[(size_t)(i >> 6) * 512 + (i & 63)];
    if (tid < 128) bts[tid] = a.in[5][T5_BUCKET[tid] * 8 + h] * LOG2E;
    if (tid == 128) bts[128] = a.in[5][31 * 8 + h] * LOG2E;
  } else {
    const float* cg = (const float*)(ws + WS_CUM) + (size_t)(b * 8 + h) * SEQ;
    for (int i = tid; i < 256 * (qb + 1); i += 512) c2s[i] = cg[i];
    if (tid == 0) misc[0] = 0u;
  }
  bf16x8 qr[4];
#pragma unroll
  for (int d0 = 0; d0 < 4; ++d0) qr[d0] = *(const bf16x8*)(Qw + (size_t)r32 * PITCH + d0 * 16 + hi * 8);
  __syncthreads();
  unsigned selmask = 0u; float cq2 = 0.f, far2 = 0.f, mhat = 0.f; int t0 = 0;
  if (MODE == 0) {
    far2 = bts[128];
    float v0 = -3e38f, v1 = -3e38f, v2 = -3e38f; int i0 = -1, i1 = -1, i2 = -1;
    for (int n = 0; n < qb; ++n) {
      float s = 0.f;
#pragma unroll
      for (int d0 = 0; d0 < 4; ++d0)
#pragma unroll
        for (int j = 0; j < 8; ++j) s += bf2f((unsigned short)qr[d0][j]) * kms[n * 64 + d0 * 16 + hi * 8 + j];
      s = xhalf_sum(s);
      if (s > v0) { v2 = v1; i2 = i1; v1 = v0; i1 = i0; v0 = s; i0 = n; }
      else if (s > v1) { v2 = v1; i2 = i1; v1 = s; i1 = n; }
      else if (s > v2) { v2 = s; i2 = n; }
    }
    if (i0 >= 0) selmask |= 1u << i0;
    if (i1 >= 0) selmask |= 1u << i1;
    if (i2 >= 0) selmask |= 1u << i2;
  } else {
    cq2 = c2s[q0 + wid * 32 + r32];
    float s = 0.f;
#pragma unroll
    for (int d0 = 0; d0 < 4; ++d0)
#pragma unroll
      for (int j = 0; j < 8; ++j) { const float f = bf2f((unsigned short)qr[d0][j]); s += f * f; }
    s = xhalf_sum(s);
    atomicMax(&misc[0], __float_as_uint(s));
    __syncthreads();
    const float kn2 = __uint_as_float(((const unsigned*)(ws + 256))[b * 8 + h]);
    const float qkb = sqrtf(__uint_as_float(misc[0]) * kn2) * 1.0001f + 1e-3f;
    mhat = -qkb;
    const int j = lane; bool skip = false;
    if (j < NTL) skip = (2.f * qkb + c2s[q0] - c2s[64 * j + 63]) < -150.f;
    t0 = __popcll(__ballot(skip));
    if (t0 > NTL - 1) t0 = NTL - 1;
  }
  const bf16_t* ksrc = Kh + (size_t)lane * PITCH + wid * 8;
  const bf16_t* vsrc = Vh + (size_t)(16 * (wid & 3) + (lane >> 2)) * PITCH + (wid >> 2) * 32 + (lane & 3) * 8;
  unsigned char* kdst = lds + L_K + wid * 1024 + lane * 16; unsigned char* vdst = lds + L_V + wid * 1024 + lane * 16;
  const lds_cptr lds3 = (lds_cptr)lds;
  const lds_cptr vp0 = lds3 + L_V + ((lane >> 4) & 1) * 32 + (lane & 3) * 8 + (4 * hi + ((lane & 15) >> 2)) * 64;
  u32x4 kreg = *(const u32x4*)(ksrc + (size_t)t0 * 64 * PITCH), vreg = *(const u32x4*)(vsrc + (size_t)t0 * 64 * PITCH);
  *(u32x4*)(kdst + (t0 & 1) * 8192) = kreg; *(u32x4*)(vdst + (t0 & 1) * 8192) = vreg;
  f32x16 o[2]; o[0] = f32x16{}; o[1] = f32x16{};
  f32x16 ol = f32x16{}, cm = f32x16{}; int cm_nb = -1;
  const int qrel = wid * 32 + r32, qpos = q0 + qrel;
  __syncthreads();
  for (int t = t0; t < NTL; ++t) {
    const int buf = (t & 1) * 8192;
    if (t + 1 < NTL) { kreg = *(const u32x4*)(ksrc + (size_t)(t + 1) * 64 * PITCH); vreg = *(const u32x4*)(vsrc + (size_t)(t + 1) * 64 * PITCH); }
    const int jb = t - (NTL - 4);
    const bool compute = !(jb >= 0 && 64 * jb > wid * 32 + 31);
    if (compute) {
      f32x16 p0, p1;
      bf16x8 kf[8];
      {
        const lds_cptr kb = lds3 + L_K + buf + hi * 1024 + r32 * 16;
#pragma unroll
        for (int d0 = 0; d0 < 4; ++d0) { kf[2 * d0] = *(const __attribute__((address_space(3))) bf16x8*)(kb + d0 * 2048); kf[2 * d0 + 1] = *(const __attribute__((address_space(3))) bf16x8*)(kb + d0 * 2048 + 512); }
      }
      __builtin_amdgcn_sched_barrier(0);
      if (MODE == 0) {
        const int nb = t >> 2;
        const bool near = (jb >= 0) || (t >= NTL - 6 && wid < 4);
        if (near) {
#pragma unroll
          for (int r = 0; r < 16; ++r) { const int d = qpos - (64 * t + crow(r, hi));
            p0[r] = bts[min(max(d, 0), 128)] - mhat; p1[r] = bts[min(max(d - 32, 0), 128)] - mhat; }
          if (jb < 0 && !((selmask >> nb) & 1u)) {
#pragma unroll
            for (int r = 0; r < 16; ++r) { p0[r] = -INFINITY; p1[r] = -INFINITY; }
          }
        } else {
          if (cm_nb != nb) {
            const float base = ((selmask >> nb) & 1u) ? far2 - mhat : -INFINITY;
#pragma unroll
            for (int r = 0; r < 16; ++r) cm[r] = base;
            cm_nb = nb;
          }
          p0 = cm; p1 = cm;
        }
      } else {
        const float cqm = cq2 - mhat;
#pragma unroll
        for (int g = 0; g < 4; ++g) {
          const f32x4 ca = *(const f32x4*)(c2s + 64 * t + 8 * g + 4 * hi), cb = *(const f32x4*)(c2s + 64 * t + 32 + 8 * g + 4 * hi);
#pragma unroll
          for (int i = 0; i < 4; ++i) { p0[4 * g + i] = cqm - ca[i]; p1[4 * g + i] = cqm - cb[i]; }
        }
      }
#pragma unroll
      for (int d0 = 0; d0 < 4; ++d0) {
        p0 = __builtin_amdgcn_mfma_f32_32x32x16_bf16(kf[2 * d0], qr[d0], p0, 0, 0, 0);
        p1 = __builtin_amdgcn_mfma_f32_32x32x16_bf16(kf[2 * d0 + 1], qr[d0], p1, 0, 0, 0);
      }
      if (jb >= 0) {
        asm volatile("" ::: "memory");
        const int kb0 = 64 * jb + 4 * hi;
#pragma unroll
        for (int r = 0; r < 16; ++r) { const int kv = kb0 + (r & 3) + 8 * (r >> 2); if (kv > qrel) p0[r] = -INFINITY; if (kv + 32 > qrel) p1[r] = -INFINITY; }
      }
      asm volatile("s_nop 15\n\ts_nop 7" : "+v"(p0), "+v"(p1));
      float rm, rm2;
      rm = max3f(p0[0], p0[1], p1[0]); rm2 = max3f(p0[2], p0[3], p1[1]); rm = max3f(rm, p1[2], p1[3]);
#pragma unroll
      for (int r = 4; r < 16; r += 4) { rm = max3f(rm, p0[r], p0[r + 1]); rm2 = max3f(rm2, p0[r + 2], p0[r + 3]); rm = max3f(rm, p1[r], p1[r + 1]); rm2 = max3f(rm2, p1[r + 2], p1[r + 3]); }
      rm = xhalf_max(fmaxf(rm, rm2));
      if (__any(rm > 6.0f)) {
        const float dl = fmaxf(rm, 0.f), alpha = __builtin_amdgcn_exp2f(-dl);
        mhat += dl; cm_nb = -1;
#pragma unroll
        for (int r = 0; r < 16; ++r) { p0[r] -= dl; p1[r] -= dl; }
        if (hi == 0) wsf[r32] = alpha;
        __builtin_amdgcn_wave_barrier();
#pragma unroll
        for (int r = 0; r < 16; ++r) { const float f = wsf[crow(r, hi)]; o[0][r] *= f; o[1][r] *= f; ol[r] *= f; }
        __builtin_amdgcn_wave_barrier();
      }
#pragma unroll
      for (int r = 0; r < 16; ++r) { p0[r] = __builtin_amdgcn_exp2f(p0[r]); p1[r] = __builtin_amdgcn_exp2f(p1[r]); }
      u32x4 pw0, pw1, pw2, pw3;
      pw0 = (u32x4){cvtpk(p0[0], p0[1]), cvtpk(p0[2], p0[3]), cvtpk(p0[4], p0[5]), cvtpk(p0[6], p0[7])};
      pw1 = (u32x4){cvtpk(p0[8], p0[9]), cvtpk(p0[10], p0[11]), cvtpk(p0[12], p0[13]), cvtpk(p0[14], p0[15])};
      pw2 = (u32x4){cvtpk(p1[0], p1[1]), cvtpk(p1[2], p1[3]), cvtpk(p1[4], p1[5]), cvtpk(p1[6], p1[7])};
      pw3 = (u32x4){cvtpk(p1[8], p1[9]), cvtpk(p1[10], p1[11]), cvtpk(p1[12], p1[13]), cvtpk(p1[14], p1[15])};
      {
        const bf16x8 ones = (bf16x8){0x3F80, 0x3F80, 0x3F80, 0x3F80, 0x3F80, 0x3F80, 0x3F80, 0x3F80};
        ol = __builtin_amdgcn_mfma_f32_32x32x16_bf16(__builtin_bit_cast(bf16x8, pw0), ones, ol, 0, 0, 0);
        ol = __builtin_amdgcn_mfma_f32_32x32x16_bf16(__builtin_bit_cast(bf16x8, pw1), ones, ol, 0, 0, 0);
        ol = __builtin_amdgcn_mfma_f32_32x32x16_bf16(__builtin_bit_cast(bf16x8, pw2), ones, ol, 0, 0, 0);
        ol = __builtin_amdgcn_mfma_f32_32x32x16_bf16(__builtin_bit_cast(bf16x8, pw3), ones, ol, 0, 0, 0);
      }
      const lds_cptr vp = vp0 + buf;
#pragma unroll
      for (int d0 = 0; d0 < 2; ++d0) {
#define ATT_VF(ks) ({ const s16x4 lo_ = vtr(vp + d0 * 4096 + (ks) * 1024), hi_ = vtr(vp + d0 * 4096 + (ks) * 1024 + 512); (bf16x8){lo_[0], lo_[1], lo_[2], lo_[3], hi_[0], hi_[1], hi_[2], hi_[3]}; })
        o[d0] = __builtin_amdgcn_mfma_f32_32x32x16_bf16(__builtin_bit_cast(bf16x8, pw0), ATT_VF(0), o[d0], 0, 0, 0);
        o[d0] = __builtin_amdgcn_mfma_f32_32x32x16_bf16(__builtin_bit_cast(bf16x8, pw1), ATT_VF(1), o[d0], 0, 0, 0);
        o[d0] = __builtin_amdgcn_mfma_f32_32x32x16_bf16(__builtin_bit_cast(bf16x8, pw2), ATT_VF(2), o[d0], 0, 0, 0);
        o[d0] = __builtin_amdgcn_mfma_f32_32x32x16_bf16(__builtin_bit_cast(bf16x8, pw3), ATT_VF(3), o[d0], 0, 0, 0);
#undef ATT_VF
      }
    }
    if (t + 1 < NTL) { *(u32x4*)(kdst + ((t + 1) & 1) * 8192) = kreg; *(u32x4*)(vdst + ((t + 1) & 1) * 8192) = vreg; }
    __syncthreads();
  }
  bf16_t* stg = (bf16_t*)(lds + L_OST) + wid * 2048;
#pragma unroll
  for (int r = 0; r < 16; ++r) { const int orow = crow(r, hi); const float rl = 1.f / ol[r];
    stg[orow * 64 + r32] = (bf16_t)f2bf(o[0][r] * rl); stg[orow * 64 + 32 + r32] = (bf16_t)f2bf(o[1][r] * rl); }
  __builtin_amdgcn_wave_barrier();
  bf16_t* Ow = (bf16_t*)(ws + WS_OAB) + (rowbase + q0 + wid * 32) * DM + (MODE ? 512 : 0) + h * 64;
#pragma unroll
  for (int i = 0; i < 4; ++i) { const int row = i * 8 + (lane >> 3), ch = lane & 7; const u32x4 v = *(const u32x4*)(stg + row * 64 + ch * 8); *(u32x4*)(Ow + (size_t)row * DM + ch * 8) = v; }
}
}

__device__ __forceinline__ void phase_attn2(const Args& a, unsigned char* lds, int tid) {
  unsigned* ctr = (unsigned*)(a.ws + 0);
  unsigned* slot = (unsigned*)(lds + att::L_MISC + 64);
  for (;;) {
    __syncthreads();
    if (tid == 0) slot[0] = atomicAdd(ctr, 1u);
    __syncthreads();
    const unsigned u = slot[0];
    if (u >= 2048u) break;
    const int qb = 15 - (int)(u >> 7), r = u & 127, mode = r & 1, bh = r >> 1;
    if (mode == 0) att::unit<0>(a, lds, bh >> 3, bh & 7, qb, tid);
    else att::unit<1>(a, lds, bh >> 3, bh & 7, qb, tid);
  }
}

__device__ __forceinline__ void phase_onorm(const Args& a, int gw, int ngw, int lane) {
  bf16_t* oab = (bf16_t*)(a.ws + WS_OAB);
  for (int r = gw; r < NT; r += ngw) {
    u32x4* p = (u32x4*)(oab + (size_t)r * DM) + 2 * lane;
    const u32x4 w0 = p[0], w1 = p[1]; float f[16]; unpack8(w0, f); unpack8(w1, f + 8);
    float s = 0.f;
#pragma unroll
    for (int i = 0; i < 16; ++i) s += f[i] * f[i];
#pragma unroll
    for (int o = 1; o < 32; o <<= 1) s += __shfl_xor(s, o);
    const float rstd = rsqrtf(s * (1.f / 512.f) + EPS);
    u32x4 o0, o1;
    o0.x = pk2(f[0] * rstd, f[1] * rstd); o0.y = pk2(f[2] * rstd, f[3] * rstd); o0.z = pk2(f[4] * rstd, f[5] * rstd); o0.w = pk2(f[6] * rstd, f[7] * rstd);
    o1.x = pk2(f[8] * rstd, f[9] * rstd); o1.y = pk2(f[10] * rstd, f[11] * rstd); o1.z = pk2(f[12] * rstd, f[13] * rstd); o1.w = pk2(f[14] * rstd, f[15] * rstd);
    p[0] = o0; p[1] = o1;
  }
}

__device__ __forceinline__ void phase_rms(const Args& a, int gw, int ngw, int lane) {
  for (int r = gw; r < NT; r += ngw) rms_row_to_bf16(a.out + (size_t)r * DM, (bf16_t*)(a.ws + WS_HB) + (size_t)r * DM, lane);
}

__device__ __forceinline__ void phase_xattn(const Args& a, unsigned char* lds, int gw, int ngw, int wave, int lane) {
  unsigned char* ws = a.ws;
  const bf16_t* qx = (const bf16_t*)(ws + WS_QX); const bf16_t* kx = (const bf16_t*)(ws + WS_KX); const bf16_t* vxt = (const bf16_t*)(ws + WS_VXT);
  bf16_t* ox = (bf16_t*)(ws + WS_OX);
  bf16_t* P = (bf16_t*)(lds + wave * 8192);
  const int fr = lane & 15, fq = lane >> 4;
  for (int u = gw; u < (NT / 16) * 4; u += ngw) {
    const int hd = u & 3, r0 = (u >> 2) * 16, b = r0 / SEQ;
    f32x4 acc[16];
#pragma unroll
    for (int i = 0; i < 16; ++i) acc[i] = (f32x4){0.f, 0.f, 0.f, 0.f};
    const bf16_t* Ap = qx + (size_t)(r0 + fr) * DM + hd * 256 + fq * 8;
    const bf16_t* Bp = kx + (size_t)(b * 256 + fr) * DM + hd * 256 + fq * 8;
    for (int ks = 0; ks < 8; ++ks) {
      const bf16x8 af = *(const bf16x8*)(Ap + ks * 32);
#pragma unroll
      for (int ct = 0; ct < 16; ++ct) { const bf16x8 bfr = *(const bf16x8*)(Bp + (size_t)ct * 16 * DM + ks * 32); acc[ct] = __builtin_amdgcn_mfma_f32_16x16x32_bf16(af, bfr, acc[ct], 0, 0, 0); }
    }
    float mx[4], sm[4];
#pragma unroll
    for (int r = 0; r < 4; ++r) { float m = acc[0][r];
#pragma unroll
      for (int ct = 1; ct < 16; ++ct) m = fmaxf(m, acc[ct][r]);
#pragma unroll
      for (int o = 1; o < 16; o <<= 1) m = fmaxf(m, __shfl_xor(m, o));
      mx[r] = m; sm[r] = 0.f; }
#pragma unroll
    for (int ct = 0; ct < 16; ++ct)
#pragma unroll
      for (int r = 0; r < 4; ++r) { const float p = __expf((acc[ct][r] - mx[r]) * 0.0625f); acc[ct][r] = p; sm[r] += p; }
#pragma unroll
    for (int r = 0; r < 4; ++r) {
#pragma unroll
      for (int o = 1; o < 16; o <<= 1) sm[r] += __shfl_xor(sm[r], o);
      sm[r] = 1.f / sm[r]; }
    __builtin_amdgcn_wave_barrier();
#pragma unroll
    for (int ct = 0; ct < 16; ++ct)
#pragma unroll
      for (int r = 0; r < 4; ++r) P[(4 * fq + r) * 256 + ct * 16 + fr] = (bf16_t)f2bf(acc[ct][r] * sm[r]);
    __builtin_amdgcn_wave_barrier();
    asm volatile("s_waitcnt lgkmcnt(0)" ::: "memory");
#pragma unroll
    for (int i = 0; i < 16; ++i) acc[i] = (f32x4){0.f, 0.f, 0.f, 0.f};
    const bf16_t* Vp = vxt + ((size_t)(b * 4 + hd) * 256 + fr) * 256 + fq * 8;
    for (int ks = 0; ks < 8; ++ks) {
      const bf16x8 pf = *(const bf16x8*)(P + fr * 256 + ks * 32 + fq * 8);
#pragma unroll
      for (int dt = 0; dt < 16; ++dt) { const bf16x8 vf = *(const bf16x8*)(Vp + (size_t)dt * 16 * 256 + ks * 32); acc[dt] = __builtin_amdgcn_mfma_f32_16x16x32_bf16(pf, vf, acc[dt], 0, 0, 0); }
    }
#pragma unroll
    for (int dt = 0; dt < 16; ++dt)
#pragma unroll
      for (int r = 0; r < 4; ++r) ox[(size_t)(r0 + 4 * fq + r) * DM + hd * 256 + dt * 16 + fr] = (bf16_t)f2bf(acc[dt][r]);
    __builtin_amdgcn_wave_barrier();
  }
}

namespace xa {
using att::f32x16; using att::s16x4; using att::lds_cptr; using att::crow; using att::cvtpk; using att::vtr; using att::xhalf_max; using att::xhalf_sum;
constexpr int L_WSF = 65536;
__device__ __forceinline__ void unit(const Args& a, unsigned char* lds, int b, int hd, int qb, int tid) {
  unsigned char* ws = a.ws;
  const int lane = tid & 63, r32 = lane & 31, hi = lane >> 5; const int wid = __builtin_amdgcn_readfirstlane(tid >> 6);
  const bf16_t* qrow = (const bf16_t*)(ws + WS_QX) + ((size_t)b * SEQ + qb * 256 + wid * 32 + r32) * DM + hd * 256;
  const bf16_t* kvb = (const bf16_t*)(ws + WS_KX) + (size_t)b * 256 * 2048 + hd * 256;
  const bf16_t* ksrc = kvb + (size_t)lane * 2048 + wid * 8;
  const bf16_t* vsrc = kvb + 1024 + (size_t)(16 * (wid & 3) + (lane >> 2)) * 2048 + (wid >> 2) * 32 + (lane & 3) * 8;
  unsigned char* sdst = lds + wid * 1024 + lane * 16;
  const lds_cptr lds3 = (lds_cptr)lds;
  const lds_cptr kp0 = lds3 + hi * 1024 + r32 * 16;
  const lds_cptr vp0 = lds3 + ((lane >> 4) & 1) * 32 + (lane & 3) * 8 + (4 * hi + ((lane & 15) >> 2)) * 64;
  float* wsf = (float*)(lds + L_WSF) + wid * 64;
  u32x4 sreg[4];
#define XA_LOADK(c) do { _Pragma("unroll") for (int kt = 0; kt < 4; ++kt) sreg[kt] = *(const u32x4*)(ksrc + (size_t)kt * 64 * 2048 + (c) * 64); } while (0)
#define XA_LOADV(vt) do { _Pragma("unroll") for (int dq = 0; dq < 4; ++dq) sreg[dq] = *(const u32x4*)(vsrc + (size_t)(vt) * 64 * 2048 + dq * 64); } while (0)
#define XA_WRITE(buf) do { _Pragma("unroll") for (int i = 0; i < 4; ++i) *(u32x4*)(sdst + (buf) * 32768 + i * 8192) = sreg[i]; } while (0)
  __syncthreads();
  XA_LOADK(0); XA_WRITE(0);
  f32x16 acc[8];
#pragma unroll
  for (int j = 0; j < 8; ++j) acc[j] = f32x16{};
  __syncthreads();
#pragma unroll
  for (int c = 0; c < 4; ++c) {
    if (c < 3) XA_LOADK(c + 1); else XA_LOADV(0);
    bf16x8 qf[4];
#pragma unroll
    for (int d0 = 0; d0 < 4; ++d0) qf[d0] = *(const bf16x8*)(qrow + c * 64 + d0 * 16 + hi * 8);
    const lds_cptr kp = kp0 + (c & 1) * 32768;
#pragma unroll
    for (int d0 = 0; d0 < 4; ++d0)
#pragma unroll
      for (int j = 0; j < 8; ++j) {
        const bf16x8 kf = *(const __attribute__((address_space(3))) bf16x8*)(kp + (j >> 1) * 8192 + d0 * 2048 + (j & 1) * 512);
        acc[j] = __builtin_amdgcn_mfma_f32_32x32x16_bf16(kf, qf[d0], acc[j], 0, 0, 0);
      }
    XA_WRITE((c + 1) & 1);
    __syncthreads();
  }
  float m = acc[0][0];
#pragma unroll
  for (int j = 0; j < 8; ++j)
#pragma unroll
    for (int r = 0; r < 16; ++r) m = fmaxf(m, acc[j][r]);
  m = xhalf_max(m);
  constexpr float CS = 1.4426950408889634f / 16.f;
  float l = 0.f; u32x4 pw[16];
#pragma unroll
  for (int j = 0; j < 8; ++j) {
#pragma unroll
    for (int r = 0; r < 16; ++r) { const float p = __builtin_amdgcn_exp2f((acc[j][r] - m) * CS); acc[j][r] = p; l += p; }
    pw[2 * j] = (u32x4){cvtpk(acc[j][0], acc[j][1]), cvtpk(acc[j][2], acc[j][3]), cvtpk(acc[j][4], acc[j][5]), cvtpk(acc[j][6], acc[j][7])};
    pw[2 * j + 1] = (u32x4){cvtpk(acc[j][8], acc[j][9]), cvtpk(acc[j][10], acc[j][11]), cvtpk(acc[j][12], acc[j][13]), cvtpk(acc[j][14], acc[j][15])};
  }
  l = xhalf_sum(l);
#pragma unroll
  for (int j = 0; j < 8; ++j) acc[j] = f32x16{};
#pragma unroll
  for (int vt = 0; vt < 4; ++vt) {
    if (vt < 3) XA_LOADV(vt + 1);
    const lds_cptr vp = vp0 + (vt & 1) * 32768;
#pragma unroll
    for (int ks = 0; ks < 4; ++ks)
#pragma unroll
      for (int db = 0; db < 8; ++db) {
        const s16x4 lo_ = vtr(vp + (db >> 1) * 8192 + (db & 1) * 4096 + ks * 1024), hi_ = vtr(vp + (db >> 1) * 8192 + (db & 1) * 4096 + ks * 1024 + 512);
        const bf16x8 vf = (bf16x8){lo_[0], lo_[1], lo_[2], lo_[3], hi_[0], hi_[1], hi_[2], hi_[3]};
        acc[db] = __builtin_amdgcn_mfma_f32_32x32x16_bf16(__builtin_bit_cast(bf16x8, pw[4 * vt + ks]), vf, acc[db], 0, 0, 0);
      }
    if (vt < 3) XA_WRITE((vt + 1) & 1);
    __syncthreads();
  }
  if (hi == 0) wsf[r32] = l;
  __builtin_amdgcn_wave_barrier();
  float rl[16];
#pragma unroll
  for (int r = 0; r < 16; ++r) rl[r] = 1.f / wsf[crow(r, hi)];
  bf16_t* stg = (bf16_t*)(lds + wid * 8192);
  bf16_t* orow0 = (bf16_t*)(ws + WS_OX) + ((size_t)b * SEQ + qb * 256 + wid * 32) * DM + hd * 256;
#pragma unroll
  for (int hf = 0; hf < 2; ++hf) {
#pragma unroll
    for (int db = 0; db < 4; ++db)
#pragma unroll
      for (int r = 0; r < 16; ++r) stg[crow(r, hi) * 128 + db * 32 + r32] = (bf16_t)f2bf(acc[hf * 4 + db][r] * rl[r]);
    __builtin_amdgcn_wave_barrier();
#pragma unroll
    for (int i = 0; i < 8; ++i) { const int row = i * 4 + (lane >> 4), ch = lane & 15; const u32x4 v = *(const u32x4*)(stg + row * 128 + ch * 8); *(u32x4*)(orow0 + (size_t)row * DM + hf * 128 + ch * 8) = v; }
    __builtin_amdgcn_wave_barrier();
  }
#undef XA_LOADK
#undef XA_LOADV
#undef XA_WRITE
}
}

__device__ __forceinline__ void phase_xattn2(const Args& a, unsigned char* lds, int tid) {
  for (int u = blockIdx.x; u < NB * 4 * 16; u += gridDim.x) { const int qb = u & 15, hd = (u >> 4) & 3, b = u >> 6; xa::unit(a, lds, b, hd, qb, tid); }
}

__device__ __forceinline__ unsigned fkey(float s, unsigned idx, unsigned mask) { unsigned u = __float_as_uint(s); u ^= (unsigned)((int)u >> 31) | 0x80000000u; return (u & ~mask) | (mask - idx); }
__device__ __forceinline__ float keyval(unsigned k, unsigned mask) { unsigned u = k & ~mask; u = (u & 0x80000000u) ? (u ^ 0x80000000u) : ~u; return __uint_as_float(u); }
#define KEY_INSERT(KA, key_) do { unsigned k__ = (key_); \
  _Pragma("unroll") for (int s_ = 0; s_ < 16; ++s_) { const unsigned hi_ = max(k__, KA[s_]); k__ = min(k__, KA[s_]); KA[s_] = hi_; } } while (0)

__device__ __forceinline__ void phase_topk(const Args& a, unsigned char* lds, int tid) {
  unsigned char* ws = a.ws;
  const float* pq = (const float*)(ws + WS_PQ);
  int* eidx = (int*)(ws + WS_EIDX); float* gate = (float*)(ws + WS_GATE);
  float* K1 = (float*)lds; float* K2 = K1 + 128 * 64; unsigned* KL = (unsigned*)(lds + 65536);
  for (int u = blockIdx.x; u < 8 * (NT / 512); u += gridDim.x) {
    const int h = u & 7, t = (u >> 3) * 512 + tid;
    __syncthreads();
    for (int i = tid; i < 128 * 64 / 4; i += 512) { ((f32x4*)K1)[i] = ((const f32x4*)(a.in[17] + (size_t)h * 8192))[i]; ((f32x4*)K2)[i] = ((const f32x4*)(a.in[18] + (size_t)h * 8192))[i]; }
    __syncthreads();
    unsigned ka[16], kb[16], kc[16];
#pragma unroll
    for (int k = 0; k < 16; ++k) { ka[k] = 0u; kb[k] = 0u; kc[k] = 0u; }
    float q[64];
    const f32x4* qp = (const f32x4*)(pq + (size_t)t * DM + h * 128);
#pragma unroll
    for (int c = 0; c < 16; ++c) { const f32x4 w = qp[c]; q[4 * c] = w.x; q[4 * c + 1] = w.y; q[4 * c + 2] = w.z; q[4 * c + 3] = w.w; }
    for (int n = 0; n < 128; ++n) {
      const f32x4* kr = (const f32x4*)(K1 + n * 64); float s = 0.f;
#pragma unroll
      for (int c = 0; c < 16; ++c) { const f32x4 kv = kr[c]; s += q[4 * c] * kv.x + q[4 * c + 1] * kv.y + q[4 * c + 2] * kv.z + q[4 * c + 3] * kv.w; }
      KEY_INSERT(ka, fkey(s, (unsigned)n, 127u));
    }
#pragma unroll
    for (int c = 0; c < 16; ++c) { const f32x4 w = qp[16 + c]; q[4 * c] = w.x; q[4 * c + 1] = w.y; q[4 * c + 2] = w.z; q[4 * c + 3] = w.w; }
    for (int n = 0; n < 128; ++n) {
      const f32x4* kr = (const f32x4*)(K2 + n * 64); float s = 0.f;
#pragma unroll
      for (int c = 0; c < 16; ++c) { const f32x4 kv = kr[c]; s += q[4 * c] * kv.x + q[4 * c + 1] * kv.y + q[4 * c + 2] * kv.z + q[4 * c + 3] * kv.w; }
      KEY_INSERT(kb, fkey(s, (unsigned)n, 127u));
    }
#pragma unroll
    for (int x = 0; x < 16; ++x)
#pragma unroll
      for (int y = 0; y < 16; ++y)
        if ((x + 1) * (y + 1) <= 16) { KEY_INSERT(kc, fkey(keyval(ka[x], 127u) + keyval(kb[y], 127u), (unsigned)(x * 16 + y), 255u)); }
#pragma unroll
    for (int k = 0; k < 16; ++k) { KL[k * 512 + tid] = ka[k]; KL[(16 + k) * 512 + tid] = kb[k]; }
    float val[16]; int id[16]; float sum = 0.f;
#pragma unroll
    for (int k = 0; k < 16; ++k) {
      const unsigned flat = 255u - (kc[k] & 255u);
      const unsigned k1 = KL[(flat >> 4) * 512 + tid], k2 = KL[(16 + (flat & 15u)) * 512 + tid];
      val[k] = keyval(k1, 127u) + keyval(k2, 127u);
      id[k] = (int)((127u - (k1 & 127u)) * 128u + (127u - (k2 & 127u)));
    }
    const float vmax = val[0];
#pragma unroll
    for (int k = 0; k < 16; ++k) { val[k] = __expf(val[k] - vmax); sum += val[k]; }
    const float inv = 1.f / sum;
    int* ep = eidx + (size_t)t * 128 + h * 16; float* gp = gate + (size_t)t * 128 + h * 16;
#pragma unroll
    for (int k = 0; k < 16; ++k) { ep[k] = id[k]; gp[k] = val[k] * inv; }
  }
}


namespace tk {
typedef float f32x16 __attribute__((ext_vector_type(16)));
__device__ __forceinline__ void ce(unsigned& a, unsigned& b) { const unsigned h = max(a, b), l = min(a, b); a = h; b = l; }
__device__ __forceinline__ void sort16(unsigned (&v)[16]) {
#pragma unroll
  for (int k = 2; k <= 16; k <<= 1)
#pragma unroll
    for (int j = k >> 1; j > 0; j >>= 1)
#pragma unroll
      for (int i = 0; i < 16; ++i) { const int l = i ^ j; if (l > i) { if ((i & k) == 0) ce(v[i], v[l]); else ce(v[l], v[i]); } }
}
__device__ __forceinline__ void topmerge(unsigned (&a)[16], const unsigned (&b)[16]) {
#pragma unroll
  for (int i = 0; i < 16; ++i) a[i] = max(a[i], b[15 - i]);
#pragma unroll
  for (int j = 8; j > 0; j >>= 1)
#pragma unroll
    for (int i = 0; i < 16; ++i) { const int l = i ^ j; if (l > i) ce(a[i], a[l]); }
}
__device__ __forceinline__ unsigned xswap(unsigned v, int hi) { auto rr = __builtin_amdgcn_permlane32_swap(v, v, false, false); return hi ? rr[0] : rr[1]; }
__device__ __forceinline__ void half_list(unsigned (&L)[16], const bf16_t* skh, const bf16_t* qrow, int r32, int hi) {
  f32x16 acc[4];
#pragma unroll
  for (int i = 0; i < 4; ++i) acc[i] = f32x16{};
#pragma unroll
  for (int ks = 0; ks < 4; ++ks) {
    const bf16x8 qf = *(const bf16x8*)(qrow + ks * 16 + hi * 8);
#pragma unroll
    for (int tl = 0; tl < 4; ++tl) { const bf16x8 kf = *(const bf16x8*)(skh + (size_t)(tl * 32 + r32) * 64 + ks * 16 + hi * 8); acc[tl] = __builtin_amdgcn_mfma_f32_32x32x16_bf16(kf, qf, acc[tl], 0, 0, 0); }
  }
  unsigned g[4][16];
#pragma unroll
  for (int tl = 0; tl < 4; ++tl)
#pragma unroll
    for (int r = 0; r < 16; ++r) g[tl][r] = fkey(acc[tl][r], (unsigned)(32 * tl + (r & 3) + 8 * (r >> 2) + 4 * hi), 127u);
  sort16(g[0]); sort16(g[1]); sort16(g[2]); sort16(g[3]);
  topmerge(g[0], g[1]); topmerge(g[2], g[3]); topmerge(g[0], g[2]);
  unsigned p[16];
#pragma unroll
  for (int k = 0; k < 16; ++k) p[k] = xswap(g[0][k], hi);
  topmerge(g[0], p);
#pragma unroll
  for (int k = 0; k < 16; ++k) L[k] = g[0][k];
}
}

__device__ __forceinline__ void phase_topk2(const Args& a, unsigned char* lds, int wave, int lane) {
  unsigned char* ws = a.ws;
  const bf16_t* pq = (const bf16_t*)(ws + WS_PQ); const bf16_t* sk = (const bf16_t*)(ws + WS_SK);
  int* eidx = (int*)(ws + WS_EIDX); float* gate = (float*)(ws + WS_GATE);
  const int r32 = lane & 31, hi = lane >> 5, h = wave;
  unsigned* KL = (unsigned*)(lds + wave * 4096);
  for (int tt = blockIdx.x; tt < NT / 32; tt += gridDim.x) {
    const int t = tt * 32 + r32;
    unsigned ka[16], kb[16], kc[16];
    tk::half_list(ka, sk + (size_t)(0 * 8 + h) * 8192, pq + (size_t)t * DM + h * 128, r32, hi);
    tk::half_list(kb, sk + (size_t)(1 * 8 + h) * 8192, pq + (size_t)t * DM + h * 128 + 64, r32, hi);
    float va[16], vb[16];
#pragma unroll
    for (int k = 0; k < 16; ++k) { va[k] = keyval(ka[k], 127u); vb[k] = keyval(kb[k], 127u); }
#pragma unroll
    for (int y = 0; y < 16; ++y) kc[y] = hi ? 0u : fkey(va[0] + vb[y], (unsigned)y, 255u);
#define TK_CAND(xa, ya, xb, yb) do { const unsigned kA_ = fkey(va[xa] + vb[ya], (unsigned)((xa) * 16 + (ya)), 255u), kB_ = fkey(va[xb] + vb[yb], (unsigned)((xb) * 16 + (yb)), 255u); KEY_INSERT(kc, hi ? kB_ : kA_); } while (0)
    TK_CAND(1, 0, 1, 1);
    TK_CAND(1, 2, 1, 3);
    TK_CAND(1, 4, 1, 5);
    TK_CAND(1, 6, 1, 7);
    TK_CAND(2, 0, 2, 1);
    TK_CAND(2, 2, 2, 3);
    TK_CAND(2, 4, 3, 0);
    TK_CAND(3, 1, 3, 2);
    TK_CAND(3, 3, 4, 0);
    TK_CAND(4, 1, 4, 2);
    TK_CAND(5, 0, 5, 1);
    TK_CAND(6, 0, 6, 1);
    TK_CAND(7, 0, 7, 1);
    TK_CAND(8, 0, 9, 0);
    TK_CAND(10, 0, 11, 0);
    TK_CAND(12, 0, 13, 0);
    TK_CAND(14, 0, 15, 0);
#undef TK_CAND
    { unsigned p[16];
#pragma unroll
      for (int k = 0; k < 16; ++k) p[k] = tk::xswap(kc[k], hi);
      tk::topmerge(kc, p); }
    if (hi == 0) {
#pragma unroll
      for (int k = 0; k < 16; ++k) { KL[k * 32 + r32] = ka[k]; KL[(16 + k) * 32 + r32] = kb[k]; }
    }
    __builtin_amdgcn_wave_barrier();
    const float vmax = va[0] + vb[0];
    float pv[8]; int id[8]; float s = 0.f;
#pragma unroll
    for (int j = 0; j < 8; ++j) {
      unsigned klo_ = kc[j], khi_ = kc[8 + j]; asm volatile("" : "+v"(klo_), "+v"(khi_));
      const unsigned key = hi ? khi_ : klo_;
      const unsigned flat = 255u - (key & 255u);
      const unsigned k1 = KL[(flat >> 4) * 32 + r32], k2 = KL[(16 + (flat & 15u)) * 32 + r32];
      pv[j] = __expf(keyval(k1, 127u) + keyval(k2, 127u) - vmax); s += pv[j];
      id[j] = (int)((127u - (k1 & 127u)) * 128u + (127u - (k2 & 127u)));
    }
    __builtin_amdgcn_wave_barrier();
    const float inv = 1.f / att::xhalf_sum(s);
    u32x4* ep = (u32x4*)(eidx + (size_t)t * 128 + h * 16 + hi * 8); f32x4* gp = (f32x4*)(gate + (size_t)t * 128 + h * 16 + hi * 8);
    ep[0] = (u32x4){(unsigned)id[0], (unsigned)id[1], (unsigned)id[2], (unsigned)id[3]}; ep[1] = (u32x4){(unsigned)id[4], (unsigned)id[5], (unsigned)id[6], (unsigned)id[7]};
    gp[0] = (f32x4){pv[0] * inv, pv[1] * inv, pv[2] * inv, pv[3] * inv}; gp[1] = (f32x4){pv[4] * inv, pv[5] * inv, pv[6] * inv, pv[7] * inv};
  }
}

__device__ __forceinline__ float gelu_erf(float v) { return 0.5f * v * (1.f + erff(v * 0.70710678118654752f)); }

__device__ __forceinline__ float gelu_as(float v) {
  const float av = fabsf(v), t = __builtin_amdgcn_rcpf(av * 0.2316418882f + 1.0f);
  float q = t * 0.5307027145f + (-0.7265760135f); q = q * t + 0.7107068705f; q = q * t + (-0.142248368f); q = q * t + 0.127414796f; q = q * t;
  const float m = v * (q * __builtin_amdgcn_exp2f((v * v) * (-0.72134752044f)));
  return v < 0.f ? m : v - m;
}
#define PIN16(A, O) asm volatile("" : "+v"(A[O]), "+v"(A[O + 1]), "+v"(A[O + 2]), "+v"(A[O + 3]), "+v"(A[O + 4]), "+v"(A[O + 5]), "+v"(A[O + 6]), "+v"(A[O + 7]), "+v"(A[O + 8]), "+v"(A[O + 9]), "+v"(A[O + 10]), "+v"(A[O + 11]), "+v"(A[O + 12]), "+v"(A[O + 13]), "+v"(A[O + 14]), "+v"(A[O + 15]))
#define PIN6(R) asm volatile("" : "+v"(R[0].x), "+v"(R[0].y), "+v"(R[1].x), "+v"(R[1].y), "+v"(R[2].x), "+v"(R[2].y))
__device__ __forceinline__ void phase_exp_down(const Args& a, int gw, int ngw, int lane) {
  unsigned char* ws = a.ws;
  const int* eidx = (const int*)(ws + WS_EIDX); const float* gate = (const float*)(ws + WS_GATE); float* wout = (float*)(ws + WS_W);
  const unsigned char* exd = ws + WS_EXD; const float* esc = (const float*)(ws + WS_ESC);
  const int l32 = lane & 31, hi = lane >> 5;
  const bool b4 = (l32 & 16) != 0, b3 = (l32 & 8) != 0, b2 = (l32 & 4) != 0;
  for (int t = gw; t < NT; t += ngw) {
    const int e0 = eidx[(size_t)t * 128 + lane], e1 = eidx[(size_t)t * 128 + 64 + lane];
    const float sd0 = esc[e0], sd1 = esc[e1];
    const float gu0 = gate[(size_t)t * 128 + lane] * esc[NEXP + e0], gu1 = gate[(size_t)t * 128 + 64 + lane] * esc[NEXP + e1];
    const f32x4* xr = (const f32x4*)(a.out + (size_t)t * DM) + 8 * l32;
    float hg[32]; float s = 0.f;
#pragma unroll
    for (int k = 0; k < 8; ++k) { const f32x4 x = xr[k]; s += (x.x * x.x + x.y * x.y) + (x.z * x.z + x.w * x.w); hg[4 * k] = x.x; hg[4 * k + 1] = x.y; hg[4 * k + 2] = x.z; hg[4 * k + 3] = x.w; }
    s = half_sum32(s);
    const float rstd = rsqrtf(s * (1.f / DM) + EPS);
#pragma unroll
    for (int k = 0; k < 8; ++k) { const f32x4 g = ((const f32x4*)a.in[15])[8 * l32 + k]; hg[4 * k] *= rstd * g.x; hg[4 * k + 1] *= rstd * g.y; hg[4 * k + 2] *= rstd * g.z; hg[4 * k + 3] *= rstd * g.w; }
    float w0 = 0.f, w1 = 0.f;
    for (int e = 0; e < 128; e += 16) {
      u32x2 ur[8][3];
#pragma unroll
      for (int i = 0; i < 8; ++i) {
        const int pi = (e & 63) + 2 * i + hi; const int id = (e < 64) ? __shfl(e0, pi) : __shfl(e1, pi);
        const u32x2* up = (const u32x2*)(exd + (size_t)id * 768 + 24 * l32);
        ur[i][0] = up[0]; ur[i][1] = up[1]; ur[i][2] = up[2];
      }
      float d[8];
#pragma unroll
      for (int i = 0; i < 8; ++i) {
        const v32f u = __builtin_amdgcn_cvt_scalef32_pk32_f32_fp6((v6u){ur[i][0].x, ur[i][0].y, ur[i][1].x, ur[i][1].y, ur[i][2].x, ur[i][2].y}, 1.0f);
        f32x2 q2 = (f32x2){0.f, 0.f};
#pragma unroll
        for (int k = 0; k < 16; ++k) q2 = __builtin_elementwise_fma((f32x2){u[2 * k], u[2 * k + 1]}, (f32x2){hg[2 * k], hg[2 * k + 1]}, q2);
        d[i] = q2.x + q2.y;
        __builtin_amdgcn_sched_barrier(0);
      }
      float r[4];
#pragma unroll
      for (int j = 0; j < 4; ++j) r[j] = (b4 ? d[j + 4] : d[j]) + swz_xor<16>(b4 ? d[j] : d[j + 4]);
      const float q0 = (b3 ? r[2] : r[0]) + swz_xor<8>(b3 ? r[0] : r[2]);
      const float q1 = (b3 ? r[3] : r[1]) + swz_xor<8>(b3 ? r[1] : r[3]);
      float q = (b2 ? q1 : q0) + swz_xor<4>(b2 ? q0 : q1);
      q += swz_xor<2>(q); q += swz_xor<1>(q);
      const int pr = (e & 63) + 2 * (l32 >> 2) + hi;
      const float sd = (e < 64) ? __shfl(sd0, pr) : __shfl(sd1, pr);
      const float gu = (e < 64) ? __shfl(gu0, pr) : __shfl(gu1, pr);
      const float wl = gu * gelu_as(q * sd);
      const float wsrc = __shfl(wl, ((lane & 1) << 5) | (((lane - (e & 63)) >> 1 & 7) << 2));
      if (lane >= (e & 63) && lane < (e & 63) + 16) { if (e < 64) w0 = wsrc; else w1 = wsrc; }
    }
    wout[(size_t)t * 128 + lane] = w0; wout[(size_t)t * 128 + 64 + lane] = w1;
  }
}

__device__ __forceinline__ void exp_up_item(const Args& a, unsigned char* lds, int xs, int item, int wave, int lane, float* xout, float* ssout) {
  unsigned char* ws = a.ws;
  const int* eidx = (const int*)(ws + WS_EIDX); const float* wgt = (const float*)(ws + WS_W);
  const unsigned char* ups = ws + WS_EXU + (size_t)xs * (NEXP * 128);
  unsigned* L = (unsigned*)(lds + wave * 16640);
  const int g = lane >> 2, c = lane & 3, t0 = item * 128 + wave * 16;
  __builtin_amdgcn_wave_barrier();
#pragma unroll 4
  for (int tk = 0; tk < 16; ++tk) {
    const size_t o = (size_t)(t0 + tk) * 128;
    L[tk * 260 + lane] = (unsigned)eidx[o + lane]; L[tk * 260 + 64 + lane] = (unsigned)eidx[o + 64 + lane];
    L[tk * 260 + 128 + lane] = __float_as_uint(wgt[o + lane]); L[tk * 260 + 192 + lane] = __float_as_uint(wgt[o + 64 + lane]);
  }
  __builtin_amdgcn_wave_barrier();
  float acc[32];
#pragma unroll
  for (int i = 0; i < 32; ++i) acc[i] = 0.f;
  const unsigned* Lg = L + g * 260;
#pragma unroll 1
  for (int p = 0; p < 128; p += 8) {
    u32x2 vr[8][3];
#pragma unroll
    for (int u = 0; u < 8; ++u) {
      const u32x2* vp = (const u32x2*)(ups + (size_t)Lg[p + u] * 128 + 24 * c);
      vr[u][0] = vp[0]; vr[u][1] = vp[1]; vr[u][2] = vp[2];
    }
#pragma unroll
    for (int u = 0; u < 8; ++u) {
      const float w = __uint_as_float(Lg[128 + p + u]);
      PIN6(vr[u]);
      const v32f v = __builtin_amdgcn_cvt_scalef32_pk32_f32_fp6((v6u){vr[u][0].x, vr[u][0].y, vr[u][1].x, vr[u][1].y, vr[u][2].x, vr[u][2].y}, 1.0f);
#pragma unroll
      for (int k = 0; k < 32; ++k) acc[k] += w * v[k];
      PIN16(acc, 0); PIN16(acc, 16);
    }
  }
  const f32x4* xr = (const f32x4*)(a.out + (size_t)(t0 + g) * DM + xs * 128 + c * 32); f32x4* xw = (f32x4*)(xout + (size_t)(t0 + g) * DM + xs * 128 + c * 32);
  float s = 0.f;
#pragma unroll
  for (int k = 0; k < 8; ++k) { f32x4 x = xr[k]; x.x += acc[4 * k]; x.y += acc[4 * k + 1]; x.z += acc[4 * k + 2]; x.w += acc[4 * k + 3]; xw[k] = x; s += (x.x * x.x + x.y * x.y) + (x.z * x.z + x.w * x.w); }
  s += swz_xor<1>(s); s += swz_xor<2>(s);
  if (c == 0) atomicAdd(ssout + t0 + g, s);
}
__device__ __forceinline__ void phase_exp_up(const Args& a, unsigned char* lds, const XcdBarrier& bar, int tid, int wave, int lane, unsigned* ctr, float* xout, float* ssout);
struct UpBuf { u32x4 r[8][2]; };
__device__ __forceinline__ void up2_load(UpBuf& B, const unsigned char* ups, const unsigned* Lg, int ch, int c) {
  const unsigned char* base = ups + (size_t)(ch >> 4) * (NEXP * 128) + 32 * c; const int p = (ch & 15) * 8;
#pragma unroll
  for (int u = 0; u < 8; ++u) { const u32x4* vp = (const u32x4*)(base + (size_t)Lg[p + u] * 128); B.r[u][0] = vp[0]; B.r[u][1] = vp[1]; }
}
__device__ __forceinline__ void up2_math(UpBuf& B, const unsigned* Lg, int ch, f32x2 (&acc)[16]) {
  const int p = (ch & 15) * 8;
#pragma unroll
  for (int u = 0; u < 8; ++u) {
    const float w = __uint_as_float(Lg[128 + p + u]);
    const f32x2 w2 = (f32x2){w, w};
#pragma unroll
    for (int q = 0; q < 2; ++q)
#pragma unroll
      for (int k = 0; k < 4; ++k) {
        const auto lo = __builtin_amdgcn_cvt_pk_f32_fp8((int)B.r[u][q][k], false); const auto hi = __builtin_amdgcn_cvt_pk_f32_fp8((int)B.r[u][q][k], true);
        acc[8 * q + 2 * k] = __builtin_elementwise_fma((f32x2){lo[0], lo[1]}, w2, acc[8 * q + 2 * k]);
        acc[8 * q + 2 * k + 1] = __builtin_elementwise_fma((f32x2){hi[0], hi[1]}, w2, acc[8 * q + 2 * k + 1]);
      }
    if (u & 1) PIN16(acc, 0);
  }
}
__device__ __forceinline__ void up2_slice_end(const Args& a, int t, int xs, int c, f32x2 (&acc)[16], float& ssum) {
  f32x4* xr = (f32x4*)(a.out + (size_t)t * DM + xs * 128 + c * 32);
#pragma unroll
  for (int k = 0; k < 8; ++k) { f32x4 x = xr[k]; x.x += acc[2 * k].x; x.y += acc[2 * k].y; x.z += acc[2 * k + 1].x; x.w += acc[2 * k + 1].y; xr[k] = x; ssum += (x.x * x.x + x.y * x.y) + (x.z * x.z + x.w * x.w);
    acc[2 * k] = (f32x2){0.f, 0.f}; acc[2 * k + 1] = (f32x2){0.f, 0.f}; }
}
__device__ __forceinline__ void phase_exp_up2(const Args& a, unsigned char* lds, int wave, int lane) {
  unsigned char* ws = a.ws;
  const int* eidx = (const int*)(ws + WS_EIDX); const float* wgt = (const float*)(ws + WS_W);
  const unsigned char* ups = ws + WS_EXU;
  unsigned* L = (unsigned*)(lds + wave * 16640);
  const int g = lane >> 2, c = lane & 3;
  for (int blk = blockIdx.x; blk < NT / 128; blk += gridDim.x) {
    const int t0 = blk * 128 + wave * 16, t = t0 + g;
    unsigned* H = (unsigned*)(lds + 8 * 16640 + 1024) + wave * 256;
    __builtin_amdgcn_wave_barrier();
    for (int i = lane; i < 256; i += 64) H[i] = 0u;
    __builtin_amdgcn_wave_barrier();
#pragma unroll 4
    for (int tk = 0; tk < 16; ++tk) {
      const size_t o = (size_t)(t0 + tk) * 128;
      const unsigned ea = (unsigned)eidx[o + lane], eb = (unsigned)eidx[o + 64 + lane];
      const unsigned wa = __float_as_uint(wgt[o + lane]), wb = __float_as_uint(wgt[o + 64 + lane]);
      const unsigned ba = ea >> 10, bb = eb >> 10;
      const unsigned ra = atomicAdd(&H[tk * 16 + ba], 1u), rb = atomicAdd(&H[tk * 16 + bb], 1u);
      __builtin_amdgcn_wave_barrier();
      unsigned pa = ra, pb = rb;
#pragma unroll
      for (unsigned b = 0; b < 16; ++b) { const unsigned hb = H[tk * 16 + b]; pa += (b < ba) ? hb : 0u; pb += (b < bb) ? hb : 0u; }
      L[tk * 260 + pa] = ea; L[tk * 260 + 128 + pa] = wa; L[tk * 260 + pb] = eb; L[tk * 260 + 128 + pb] = wb;
    }
    __builtin_amdgcn_wave_barrier();
    const unsigned* Lg = L + g * 260;
    f32x2 acc[16]; float ssum = 0.f;
#pragma unroll
    for (int i = 0; i < 16; ++i) acc[i] = (f32x2){0.f, 0.f};
    UpBuf A, B;
    up2_load(A, ups, Lg, 0, c);
#pragma unroll 1
    for (int ch = 0; ch < 128; ch += 2) {
      up2_load(B, ups, Lg, ch + 1, c);
      up2_math(A, Lg, ch, acc);
      if (ch + 2 < 128) up2_load(A, ups, Lg, ch + 2, c);
      up2_math(B, Lg, ch + 1, acc);
      if ((ch & 15) == 14) up2_slice_end(a, t, ch >> 4, c, acc, ssum);
    }
    ssum += swz_xor<1>(ssum); ssum += swz_xor<2>(ssum);
    const float r2 = rsqrtf(ssum * (1.f / DM) + EPS);
    asm volatile("s_waitcnt vmcnt(0)" ::: "memory");
    __builtin_amdgcn_fence(__ATOMIC_ACQUIRE, "agent");
#pragma unroll 2
    for (int xs = 0; xs < 8; ++xs) {
      f32x4* xr = (f32x4*)(a.out + (size_t)t * DM + xs * 128 + c * 32); const f32x4* gp = (const f32x4*)(a.in[21] + xs * 128 + c * 32);
#pragma unroll
      for (int k = 0; k < 8; ++k) xr[k] = xr[k] * r2 * gp[k];
    }
  }
}

__device__ __forceinline__ void phase_final(const Args& a, int gw, int ngw, int lane) {
  const float* ss = (const float*)(a.ws + WS_SS3);
  for (int r = gw; r < NT; r += ngw) {
    const float r2 = rsqrtf(ss[r] * (1.f / DM) + EPS);
    f32x4* xr = (f32x4*)(a.out + (size_t)r * DM) + lane;
#pragma unroll
    for (int j = 0; j < 4; ++j) { const f32x4 g = ((const f32x4*)a.in[21])[64 * j + lane]; xr[64 * j] = xr[64 * j] * r2 * g; }
  }
}

namespace pg8 {
#define PG8_LAS __attribute__((address_space(3)))
typedef unsigned short bf16_t;
typedef short bf16x8 __attribute__((ext_vector_type(8)));
typedef float f32x4 __attribute__((ext_vector_type(4)));
typedef unsigned u32x4 __attribute__((ext_vector_type(4)));
constexpr int BM = 256, BK = 64, HALF = 128, HTB = HALF * BK * 2  , STAGE_BYTES = 8 * HTB, NXCD = 8, WGM = 8;

__host__ __device__ __forceinline__ int lds_byte(int r, int c) { const int st = (r >> 4) * 2 + (c >> 5), rr = r & 15, cc = c & 31, ob = rr * 64 + cc * 2; return st * 1024 + (ob ^ (((ob >> 9) & 1) << 5)); }
__host__ __device__ __forceinline__ void stage_rc(int b, int& R, int& C) { const int st = b / 1024, sb = b % 1024, swz = sb ^ (((sb >> 9) & 1) << 5); R = (st >> 1) * 16 + swz / 64; C = (st & 1) * 32 + (swz % 64) / 2; }
__host__ __device__ __forceinline__ int perm32(int rho) { const int n = rho >> 4, i = rho & 15; return 8 * (i >> 2) + 4 * n + (i & 3); }

struct Unit { int pm, pn; };
struct Gemm { const bf16_t* A; const bf16_t* Bt; int M, N, K; };

struct StaticOrder {
    int nM, nN, nwg, G, c;
    __host__ __device__ void init(int M, int N, int G_, int c_) { nM = M / BM; nN = N / BM; nwg = nM * nN; G = G_; c = c_; }
    __host__ __device__ bool next(int i, Unit& u) const {
        const long L = (long)i * G + c; if (L >= nwg) return false;
        int wgid = (int)L; { const int q = nwg / NXCD, r = nwg % NXCD, xcd = wgid % NXCD, off = wgid / NXCD; wgid = (xcd < r ? xcd * (q + 1) : r * (q + 1) + (xcd - r) * q) + off; }
        const int nig = WGM * nN, gid = wgid / nig, fm = gid * WGM, gsz = (nM - fm) < WGM ? (nM - fm) : WGM;
        u.pm = fm + ((wgid % nig) % gsz); u.pn = (wgid % nig) / gsz; return true;
    }
    __device__ __forceinline__ void a_ready(const Unit&) const {}
    __device__ __forceinline__ void done(const Unit&) const {}
};

template <class St> struct EpiAdapt8 {
    static constexpr bool PERM = true, AFTER_DRAIN = false; St st;
    __device__ __forceinline__ void operator()(const f32x4 (&acc)[2][2][4][2], const Unit& u, int wr, int wc, int fr, int fq) const {
#pragma unroll
        for (int ai = 0; ai < 2; ++ai)
#pragma unroll
            for (int m = 0; m < 4; ++m)
#pragma unroll
                for (int bj = 0; bj < 2; ++bj) st.store8(u.pm * BM + ai * HALF + wr * 64 + m * 16 + fr, u.pn * BM + bj * HALF + wc * 32 + 8 * fq, acc[ai][bj][m][0], acc[ai][bj][m][1]);
    }
};
template <class St> struct EpiAdapt {
    static constexpr bool PERM = false, AFTER_DRAIN = false; St st;
    __device__ __forceinline__ void operator()(const f32x4 (&acc)[2][2][4][2], const Unit& u, int wr, int wc, int fr, int fq) const {
#pragma unroll
        for (int ai = 0; ai < 2; ++ai)
#pragma unroll
            for (int m = 0; m < 4; ++m)
#pragma unroll
                for (int bj = 0; bj < 2; ++bj)
#pragma unroll
                    for (int n = 0; n < 2; ++n) st.store(u.pm * BM + ai * HALF + wr * 64 + m * 16 + fr, u.pn * BM + bj * HALF + wc * 32 + n * 16 + 4 * fq, acc[ai][bj][m][n]);
    }
};

struct EpiResidSS {
    static constexpr bool PERM = true, AFTER_DRAIN = false; const float* base; float* out; bf16_t* hb; float* ss;
    __device__ __forceinline__ void operator()(const f32x4 (&acc)[2][2][4][2], const Unit& u, int wr, int wc, int fr, int fq) const {
#pragma unroll
        for (int ai = 0; ai < 2; ++ai)
#pragma unroll
            for (int m = 0; m < 4; ++m) {
                const int row = u.pm * BM + ai * HALF + wr * 64 + m * 16 + fr; float s = 0.f;
#pragma unroll
                for (int bj = 0; bj < 2; ++bj) {
                    const size_t o = (size_t)row * 1024 + u.pn * BM + bj * HALF + wc * 32 + 8 * fq;
                    const f32x4 v0 = *(const f32x4*)(base + o) + acc[ai][bj][m][0], v1 = *(const f32x4*)(base + o + 4) + acc[ai][bj][m][1];
                    *(f32x4*)(out + o) = v0; *(f32x4*)(out + o + 4) = v1;
                    { const float f0 = v0.x, f1 = v0.y, f2 = v0.z, f3 = v0.w, f4 = v1.x, f5 = v1.y, f6 = v1.z, f7 = v1.w;
                      *(u32x4*)(hb + o) = (u32x4){::pk2(f0, f1), ::pk2(f2, f3), ::pk2(f4, f5), ::pk2(f6, f7)}; }
                    s += (v0.x * v0.x + v0.y * v0.y) + (v0.z * v0.z + v0.w * v0.w) + (v1.x * v1.x + v1.y * v1.y) + (v1.z * v1.z + v1.w * v1.w);
                }
                s += __shfl_xor(s, 16); s += __shfl_xor(s, 32);
                if (fq == 0) atomicAdd(ss + row, s);
            }
    }
};
template <class Epi, class Sched, bool ALIGN_EPI = false, bool SP2 = false>
__device__ __forceinline__ void gemm_phase(PG8_LAS unsigned char* lds, const Gemm g, const Sched& S, const Epi& E) {
    const int tid = threadIdx.x, wid = __builtin_amdgcn_readfirstlane(tid >> 6), lane = tid & 63, wr = wid >> 2, wc = wid & 3, fr = lane & 15, fq = lane >> 4;
    const int K = g.K, nt = K / BK;
    unsigned voffA[2], voffB[2];
#pragma unroll
    for (int i = 0; i < 2; ++i) { int R, C; stage_rc(tid * 16 + i * 8192, R, C); const int Rb = Epi::PERM ? ((R & ~31) + perm32(R & 31)) : R;
        voffA[i] = (unsigned)(R * K + C) * 2u; voffB[i] = (unsigned)(Rb * K + C) * 2u; }
    const size_t kstep = (size_t)(BK * 2);
    const size_t hstep = (size_t)HALF * K * 2;
    const size_t tstep = 2 * hstep;
    const unsigned ldsw = (unsigned)wid * 1024u;
    const int aoff = lds_byte(wr * 64 + fr, fq * 8), boff = lds_byte(wc * 32 + fr, fq * 8);
#define PG8_SA(b, h) (((b) * 2 + (h)) * HTB)
#define PG8_SB(b, h) ((4 + (b) * 2 + (h)) * HTB)
#define PG8_STAGE(bufoff, gbase, voff) do { _Pragma("unroll") for (int _i = 0; _i < 2; ++_i) \
        __builtin_amdgcn_global_load_lds((const unsigned*)((const char*)(gbase) + (voff)[_i]), (PG8_LAS unsigned*)(lds + (bufoff) + ldsw + _i * 8192), 16, 0, 0); } while (0)
#define PG8_LDA(dst, b, h) do { _Pragma("unroll") for (int m = 0; m < 4; ++m) _Pragma("unroll") for (int k = 0; k < 2; ++k) dst[m][k] = *(const PG8_LAS bf16x8*)(lds + PG8_SA(b, h) + aoff + m * 2048 + k * 1024); } while (0)
#define PG8_LDB(dst, b, h) do { _Pragma("unroll") for (int n = 0; n < 2; ++n) _Pragma("unroll") for (int k = 0; k < 2; ++k) dst[n][k] = *(const PG8_LAS bf16x8*)(lds + PG8_SB(b, h) + boff + n * 2048 + k * 1024); } while (0)
#define PG8_MMA(ai, bj, At, Bt) do { __builtin_amdgcn_s_setprio(1); _Pragma("unroll") for (int m = 0; m < 4; ++m) _Pragma("unroll") for (int n = 0; n < 2; ++n) _Pragma("unroll") for (int k = 0; k < 2; ++k) \
        acc[ai][bj][m][n] = __builtin_amdgcn_mfma_f32_16x16x32_bf16(Bt[n][k], At[m][k], acc[ai][bj][m][n], 0, 0, 0); __builtin_amdgcn_s_setprio(0); } while (0)
#define PG8_WAIT_V(n) asm volatile("s_waitcnt vmcnt(" #n ")" ::: "memory")
#define PG8_WAIT_L(n) asm volatile("s_waitcnt lgkmcnt(" #n ")" ::: "memory")
#define PG8_BAR __builtin_amdgcn_s_barrier()
#define PG8_SCHED __builtin_amdgcn_sched_barrier(0)
    Unit cur, nxt; int ui = 0;
    if (!S.next(0, cur)) return;
    f32x4 acc[2][2][4][2];
#pragma unroll
    for (int a = 0; a < 2; ++a)
#pragma unroll
        for (int b = 0; b < 2; ++b)
#pragma unroll
            for (int m = 0; m < 4; ++m)
#pragma unroll
                for (int n = 0; n < 2; ++n) acc[a][b][m][n] = (f32x4){0.f, 0.f, 0.f, 0.f};
    bf16x8 At[4][2], B0[2][2], B1[2][2];
    const char* cA = (const char*)g.A + (size_t)cur.pm * tstep; const char* cB = (const char*)g.Bt + (size_t)cur.pn * tstep;
    S.a_ready(cur);
    if constexpr (SP2) {
        PG8_STAGE(PG8_SB(0, 0), cB, voffB); PG8_STAGE(PG8_SB(0, 1), cB + hstep, voffB); PG8_STAGE(PG8_SA(0, 0), cA, voffA); PG8_STAGE(PG8_SA(0, 1), cA + hstep, voffA);
        if (wr == 1) PG8_BAR;
        PG8_WAIT_V(2); PG8_BAR;
        PG8_STAGE(PG8_SB(1, 0), cB + kstep, voffB); PG8_STAGE(PG8_SA(1, 0), cA + kstep, voffA); PG8_STAGE(PG8_SB(1, 1), cB + hstep + kstep, voffB);
        PG8_WAIT_V(6); PG8_BAR;
    } else {
        PG8_STAGE(PG8_SB(0, 0), cB, voffB); PG8_STAGE(PG8_SA(0, 0), cA, voffA); PG8_STAGE(PG8_SB(0, 1), cB + hstep, voffB); PG8_STAGE(PG8_SA(0, 1), cA + hstep, voffA);
        if (wr == 1) PG8_BAR;
        PG8_WAIT_V(4); PG8_BAR;
        PG8_STAGE(PG8_SB(1, 0), cB + kstep, voffB); PG8_STAGE(PG8_SA(1, 0), cA + kstep, voffA); PG8_STAGE(PG8_SB(1, 1), cB + hstep + kstep, voffB);
        PG8_WAIT_V(6); PG8_BAR;
    }
    for (;;) {
        const bool has_next = S.next(ui + 1, nxt);
        const char* nA = has_next ? (const char*)g.A + (size_t)nxt.pm * tstep : cA; const char* nB = has_next ? (const char*)g.Bt + (size_t)nxt.pn * tstep : cB;
        for (int t = 0; t < nt; t += 2) {
            const bool last = (t == nt - 2);
            const char* a1 = cA + (size_t)(t + 1) * kstep;
            const char* a2 = last ? nA : cA + (size_t)(t + 2) * kstep; const char* b2 = last ? nB : cB + (size_t)(t + 2) * kstep;
            const char* a3 = a2 + kstep; const char* b3 = b2 + kstep;
            if (last && has_next) S.a_ready(nxt);
            if constexpr (SP2) {
            PG8_LDB(B0, 0, 0); PG8_LDB(B1, 0, 1); PG8_SCHED; PG8_LDA(At, 0, 0); PG8_STAGE(PG8_SA(1, 1), a1 + hstep, voffA);
            PG8_WAIT_V(8); PG8_WAIT_L(0); PG8_BAR; PG8_MMA(0, 0, At, B0); PG8_MMA(0, 1, At, B1); PG8_BAR; PG8_SCHED;
            PG8_LDA(At, 0, 1); PG8_STAGE(PG8_SB(0, 0), b2, voffB); PG8_STAGE(PG8_SB(0, 1), b2 + hstep, voffB); PG8_STAGE(PG8_SA(0, 0), a2, voffA);
            PG8_WAIT_V(8); PG8_WAIT_L(0); PG8_BAR; PG8_MMA(1, 0, At, B0); PG8_MMA(1, 1, At, B1); PG8_BAR; PG8_SCHED;
            PG8_LDB(B0, 1, 0); PG8_LDB(B1, 1, 1); PG8_SCHED; PG8_LDA(At, 1, 0); PG8_STAGE(PG8_SA(0, 1), a2 + hstep, voffA);
            PG8_WAIT_V(8); PG8_WAIT_L(0); PG8_BAR; PG8_MMA(0, 0, At, B0); PG8_MMA(0, 1, At, B1); PG8_BAR; PG8_SCHED;
            PG8_LDA(At, 1, 1); PG8_STAGE(PG8_SB(1, 0), b3, voffB); PG8_STAGE(PG8_SB(1, 1), b3 + hstep, voffB); PG8_STAGE(PG8_SA(1, 0), a3, voffA);
            PG8_WAIT_V(8); PG8_WAIT_L(0); PG8_BAR; PG8_MMA(1, 0, At, B0); PG8_MMA(1, 1, At, B1); PG8_BAR; PG8_SCHED;
            } else {
            PG8_LDB(B0, 0, 0); PG8_SCHED; PG8_LDA(At, 0, 0); PG8_STAGE(PG8_SA(1, 1), a1 + hstep, voffA);
            PG8_WAIT_L(8); PG8_BAR; PG8_WAIT_L(0); PG8_MMA(0, 0, At, B0); PG8_BAR; PG8_SCHED;
            PG8_LDB(B1, 0, 1); PG8_STAGE(PG8_SB(0, 0), b2, voffB);
            PG8_BAR; PG8_WAIT_L(0); PG8_MMA(0, 1, At, B1); PG8_BAR;
            PG8_LDA(At, 0, 1); PG8_STAGE(PG8_SA(0, 0), a2, voffA);
            PG8_BAR; PG8_WAIT_L(0); PG8_MMA(1, 0, At, B0); PG8_BAR; PG8_SCHED;
            PG8_STAGE(PG8_SB(0, 1), b2 + hstep, voffB);
            PG8_WAIT_V(6); PG8_BAR; PG8_MMA(1, 1, At, B1); PG8_BAR;
            PG8_LDB(B0, 1, 0); PG8_SCHED; PG8_LDA(At, 1, 0); PG8_STAGE(PG8_SA(0, 1), a2 + hstep, voffA);
            PG8_WAIT_L(8); PG8_BAR; PG8_WAIT_L(0); PG8_MMA(0, 0, At, B0); PG8_BAR; PG8_SCHED;
            PG8_LDB(B1, 1, 1); PG8_STAGE(PG8_SB(1, 0), b3, voffB);
            PG8_BAR; PG8_WAIT_L(0); PG8_MMA(0, 1, At, B1); PG8_BAR;
            PG8_LDA(At, 1, 1); PG8_STAGE(PG8_SA(1, 0), a3, voffA);
            PG8_BAR; PG8_WAIT_L(0); PG8_MMA(1, 0, At, B0); PG8_BAR; PG8_SCHED;
            PG8_STAGE(PG8_SB(1, 1), b3 + hstep, voffB);
            PG8_WAIT_V(6); PG8_BAR; PG8_MMA(1, 1, At, B1); PG8_BAR;
            }
        }
        if constexpr (ALIGN_EPI) { if (wr == 0) PG8_BAR; }
        if constexpr (!Epi::AFTER_DRAIN) { E(acc, cur, wr, wc, fr, fq); S.done(cur); }
        if (!has_next) break;
#pragma unroll
        for (int a = 0; a < 2; ++a)
#pragma unroll
            for (int b = 0; b < 2; ++b)
#pragma unroll
                for (int m = 0; m < 4; ++m)
#pragma unroll
                    for (int n = 0; n < 2; ++n) acc[a][b][m][n] = (f32x4){0.f, 0.f, 0.f, 0.f};
        cur = nxt; cA = nA; cB = nB; ++ui;
        if constexpr (ALIGN_EPI) { if (wr == 1) PG8_BAR; }
    }
    PG8_WAIT_V(0);
    if constexpr (!ALIGN_EPI) { if (wr == 0) PG8_BAR; }
    PG8_BAR;
    if constexpr (Epi::AFTER_DRAIN) { E.fused(acc, cur, wr, wc, fr, fq, lds, wid, lane); S.done(cur); }
#undef PG8_SA
#undef PG8_SB
#undef PG8_STAGE
#undef PG8_LDA
#undef PG8_LDB
#undef PG8_MMA
#undef PG8_WAIT_V
#undef PG8_WAIT_L
#undef PG8_BAR
#undef PG8_SCHED
}
}


template <class Epi>
__device__ __forceinline__ void run_gemm_raw(unsigned char* lds, const bf16_t* A, const bf16_t* Bt, int M, int N, int K, const Epi& E) {
  pg8::Gemm g{A, Bt, M, N, K}; pg8::StaticOrder S; S.init(M, N, (int)gridDim.x, (int)blockIdx.x);
  pg8::gemm_phase<Epi, pg8::StaticOrder, true, true>((PG8_LAS unsigned char*)lds, g, S, E);
}
template <class St>
__device__ __forceinline__ void run_gemm8(unsigned char* lds, const bf16_t* A, const bf16_t* Bt, int M, int N, int K, const St& st) {
  pg8::Gemm g{A, Bt, M, N, K}; pg8::StaticOrder S; S.init(M, N, (int)gridDim.x, (int)blockIdx.x);
  pg8::EpiAdapt8<St> E{st};
  pg8::gemm_phase<pg8::EpiAdapt8<St>, pg8::StaticOrder, true, true>((PG8_LAS unsigned char*)lds, g, S, E);
}
template <class St>
__device__ __forceinline__ void run_gemm(unsigned char* lds, const bf16_t* A, const bf16_t* Bt, int M, int N, int K, const St& st, int gw, int ngw, int lane) {
#if USE_PG8
  pg8::Gemm g{A, Bt, M, N, K}; pg8::StaticOrder S; S.init(M, N, (int)gridDim.x, (int)blockIdx.x);
  pg8::EpiAdapt<St> E{st};
  pg8::gemm_phase<pg8::EpiAdapt<St>, pg8::StaticOrder, true, true>((PG8_LAS unsigned char*)lds, g, S, E);
#else
  gemm_naive(A, K, Bt, K, M, N, K, st, gw, ngw, lane);
#endif
}

#define GAS __attribute__((address_space(1)))
#define LAS __attribute__((address_space(3)))
#define XB_TMO      128
#define XB_XCNT(j)  (256  + 64 * (j))
#define XB_XSUB(j)  (1280 + 64 * (j))
#define XB_XGEN(j)  (2304 + 64 * (j))
#define XB_TOP      3328
#define XB_TOPGEN   3392
#define XCD_BAR_WORDS 3456
#define XB_SPIN_CAP (1u << 18)

__device__ __forceinline__ unsigned xb_ld(unsigned* p)              { return __hip_atomic_load(p, __ATOMIC_RELAXED, __HIP_MEMORY_SCOPE_AGENT); }
__device__ __forceinline__ unsigned xb_add(unsigned* p, unsigned v) { return __hip_atomic_fetch_add(p, v, __ATOMIC_RELAXED, __HIP_MEMORY_SCOPE_AGENT); }
__device__ __forceinline__ unsigned xb_xcc_id() { return (unsigned)__builtin_amdgcn_s_getreg((3 << 11) | 20) & 0xFu; }
#define XB_SPIN(cond, bar) do { unsigned _sp = 0; while (cond) { __builtin_amdgcn_s_sleep(1); \
    if ((++_sp & 255u) == 0u) { if (xb_ld(&(bar)[XB_TMO])) break; if (_sp > XB_SPIN_CAP) { atomicAdd(&(bar)[XB_TMO], 1u); break; } } } } while (0)

struct XcdBarrier {
    unsigned* bar; unsigned x;
    volatile LAS unsigned* st;
};

__device__ __forceinline__ XcdBarrier xcd_barrier_post(unsigned* bar, volatile LAS unsigned* st) {
    XcdBarrier b; b.bar = bar; b.x = xb_xcc_id(); b.st = st;
    if (threadIdx.x == 0) (void)xb_add(&bar[XB_XCNT(b.x)], 1u);
    return b;
}
__device__ __forceinline__ void xcd_barrier_complete(unsigned* bar, unsigned x, unsigned& nloc, unsigned& nx) {
    const unsigned G = gridDim.x * gridDim.y * gridDim.z;
    unsigned sum, cnt, mine, sp = 0u;
    for (;;) {
        sum = 0u; cnt = 0u; mine = 0u;
#pragma unroll
        for (unsigned j = 0; j < 16; ++j) { const unsigned c = xb_ld(&bar[XB_XCNT(j)]); sum += c; cnt += (c > 0u) ? 1u : 0u; mine = (j == x) ? c : mine; }
        if (sum == G) break;
        __builtin_amdgcn_s_sleep(1);
        if ((++sp & 255u) == 0u) { if (xb_ld(&bar[XB_TMO])) break; if (sp > XB_SPIN_CAP) { atomicAdd(&bar[XB_TMO], 1u); break; } }
    }
    nloc = mine > 0u ? mine : 1u; nx = cnt > 0u ? cnt : 1u;
}

__device__ __forceinline__ void xcd_barrier(const XcdBarrier& b) {
    asm volatile("s_waitcnt vmcnt(0)" ::: "memory");
    __syncthreads();
    if (threadIdx.x == 0) {
        unsigned* bar = b.bar;
        __builtin_amdgcn_s_waitcnt(0);
        unsigned nloc = b.st[0], nx = b.st[1];
        if (nloc == 0u) { xcd_barrier_complete(bar, b.x, nloc, nx); b.st[0] = nloc; b.st[1] = nx; }
        const unsigned old = xb_add(&bar[XB_XSUB(b.x)], 1u);
        const unsigned gen = old / nloc;
        if (old + 1u == (gen + 1u) * nloc) {
            __builtin_amdgcn_fence(__ATOMIC_RELEASE, "agent");
            asm volatile("s_waitcnt vmcnt(0)" ::: "memory");
            const unsigned og = xb_add(&bar[XB_TOP], 1u);
            const unsigned tg = og / nx;
            if (og + 1u == (tg + 1u) * nx) xb_add(&bar[XB_TOPGEN], 1u);
            else XB_SPIN(xb_ld(&bar[XB_TOPGEN]) == tg, bar);
            __builtin_amdgcn_fence(__ATOMIC_ACQUIRE, "agent");
            xb_add(&bar[XB_XGEN(b.x)], 1u);
            asm volatile("s_waitcnt vmcnt(0)" ::: "memory");
        } else {
            XB_SPIN(xb_ld(&bar[XB_XGEN(b.x)]) == gen, bar);
            __builtin_amdgcn_fence(__ATOMIC_ACQUIRE, "agent");
            asm volatile("s_waitcnt vmcnt(0)" ::: "memory");
        }
    }
    __syncthreads();
}

__device__ __forceinline__ void phase_exp_up(const Args& a, unsigned char* lds, const XcdBarrier& bar, int tid, int wave, int lane, unsigned* ctr, float* xout, float* ssout) {
  unsigned* slot = (unsigned*)(lds + 8 * 16640);
  const int x0 = (int)(xb_xcc_id() & 7u);
  for (int k = 0; k < 8; ++k) {
    const int xs = (x0 + k) & 7;
    for (;;) {
      __syncthreads();
      if (tid == 0) slot[0] = atomicAdd(ctr + 16 * xs, 1u);
      __syncthreads();
      const unsigned item = slot[0];
      if (item >= (unsigned)(NT / 128)) break;
      exp_up_item(a, lds, xs, (int)item, wave, lane, xout, ssout);
    }
  }
}

__global__ void __launch_bounds__(512, 2) mega(Args a) {
  extern __shared__ __attribute__((aligned(16))) unsigned char lds[];
  cg::grid_group grid = cg::this_grid();
  const int tid = threadIdx.x, lane = tid & 63, wave = tid >> 6;
  const int gw = blockIdx.x * 8 + wave, ngw = gridDim.x * 8;
  unsigned char* ws = a.ws;
  const int lo = a.ph_lo, hi = a.ph_hi;
#define IN(k) (lo <= (k) && (k) < hi)
  volatile LAS unsigned* MISC = (volatile LAS unsigned*)((LAS unsigned char*)lds + 146944);
  if (tid < 32) MISC[tid] = 0u;
  __syncthreads();
  XcdBarrier bar; bar.bar = (unsigned*)(ws + WS_BAR); bar.x = 0; bar.st = nullptr;
  if (hi - lo > 1) bar = xcd_barrier_post((unsigned*)(ws + WS_BAR), MISC + 8);
  if (lo < -1000000) grid.sync();
#define SEAM(k) do { if (IN(k) && IN((k) + 1)) xcd_barrier(bar); } while (0)
#if PROBE_REP == 0
  if (IN(0)) { phase_prep(a, lds, gw, ngw, wave, lane, tid); grid.sync(); }
#endif
  if (IN(0)) { phase_prep(a, lds, gw, ngw, wave, lane, tid); } SEAM(0);
#if PROBE_REP == 1
  if (IN(1)) {
    run_gemm8(lds, (const bf16_t*)(ws + WS_HB), (const bf16_t*)(ws + WS_WIN_T), NT, NQKV, DM, EpiQKV{(bf16_t*)(ws + WS_QKV)});
    run_gemm8(lds, (const bf16_t*)(ws + WS_MEMN), (const bf16_t*)(ws + WS_WXKV_T), NMROWS, 2048, DM, EpiBf16{(bf16_t*)(ws + WS_KX), 2048});
    xcd_barrier(bar); }
#endif
#if PROBE_REP == 2
  if (IN(2)) { phase_scan(a, gw, ngw, lane, tid); xcd_barrier(bar); phase_rms(a, gw, ngw, lane); xcd_barrier(bar); phase_rms(a, gw, ngw, lane); xcd_barrier(bar); }
#endif
  if (IN(1)) {
    run_gemm8(lds, (const bf16_t*)(ws + WS_HB), (const bf16_t*)(ws + WS_WIN_T), NT, NQKV, DM, EpiQKV{(bf16_t*)(ws + WS_QKV)});
    run_gemm8(lds, (const bf16_t*)(ws + WS_MEMN), (const bf16_t*)(ws + WS_WXKV_T), NMROWS, 2048, DM, EpiBf16{(bf16_t*)(ws + WS_KX), 2048});
  } SEAM(1);
  if (IN(2)) { for (int rep = 0; rep < a.rep_scan; ++rep) { phase_scan(a, gw, ngw, lane, tid); if (rep + 1 < a.rep_scan) xcd_barrier(bar); } } SEAM(2);
#if PROBE_REP == 3
  if (IN(3)) { phase_attn2(a, lds, tid); xcd_barrier(bar); if (blockIdx.x == 0 && tid == 0) *(unsigned*)(ws) = 0u; xcd_barrier(bar); }
#endif
  if (IN(3)) {
#if USE_ATT2
    phase_attn2(a, lds, tid);
#else
    phase_attn(a, lds, tid);
#endif
  } SEAM(3);
  if (IN(4)) { phase_onorm(a, gw, ngw, lane); } SEAM(4);
  if (IN(5)) { run_gemm_raw(lds, (const bf16_t*)(ws + WS_OAB), (const bf16_t*)(ws + WS_WOUT_T), NT, DM, DM, pg8::EpiResidSS{a.in[0], a.out, (bf16_t*)(ws + WS_HB), (float*)(ws + WS_SS1)}); }
  if (IN(5) && IN(7)) xcd_barrier(bar);
  if (IN(7)) { run_gemm8(lds, (const bf16_t*)(ws + WS_HB), (const bf16_t*)(ws + WS_WXQ_T), NT, DM, DM, EpiBf16S{(bf16_t*)(ws + WS_QX), DM, (const float*)(ws + WS_SS1)}); } SEAM(7);
#if PROBE_REP == 8
  if (IN(8)) { phase_xattn(a, lds, gw, ngw, wave, lane); grid.sync(); }
#endif
  if (IN(8)) { phase_xattn2(a, lds, tid); } SEAM(8);
  if (IN(9)) { run_gemm_raw(lds, (const bf16_t*)(ws + WS_OX), (const bf16_t*)(ws + WS_WXO_T), NT, DM, DM, pg8::EpiResidSS{a.out, a.out, (bf16_t*)(ws + WS_HB), (float*)(ws + WS_SS2)}); }
  if (IN(9) && IN(11)) xcd_barrier(bar);
  if (IN(11)) { run_gemm8(lds, (const bf16_t*)(ws + WS_HB), (const bf16_t*)(ws + WS_WPQ_T), NT, DM, DM, EpiBf16S{(bf16_t*)(ws + WS_PQ), DM, (const float*)(ws + WS_SS2)}); } SEAM(11);
#if PROBE_REP == 12
  if (IN(12)) { phase_topk(a, lds, tid); grid.sync(); }
#endif
  if (IN(12)) { phase_topk2(a, lds, wave, lane); } SEAM(12);
    if (IN(13)) {
    for (int rep = 0; rep < a.rep_down; ++rep) { phase_exp_down(a, gw, ngw, lane); if (hi - lo > 1) xcd_barrier(bar); }
    phase_exp_up2(a, lds, wave, lane);
  }
#undef IN
#undef SEAM
}

extern "C" void kernel_launch(void* const* d_in, const int* in_sizes, int n_in, void* d_out, int out_size, void* d_ws, size_t ws_size, hipStream_t stream) {
  static int grid = 0;
  if (grid == 0) {
    if (n_in != 22 || out_size != NT * DM || ws_size < WS_END) { fprintf(stderr, "kernel_launch: unexpected shapes (n_in %d out %d ws %zu)\n", n_in, out_size, ws_size); grid = -1; return; }
    int dev = 0, cus = 0, per_cu = 0;
    (void)hipGetDevice(&dev);
    (void)hipDeviceGetAttribute(&cus, hipDeviceAttributeMultiprocessorCount, dev);
    (void)hipFuncSetAttribute((const void*)mega, hipFuncAttributeMaxDynamicSharedMemorySize, LDS_BYTES);
    (void)hipOccupancyMaxActiveBlocksPerMultiprocessor(&per_cu, (const void*)mega, 512, LDS_BYTES);
    if (per_cu < 1) per_cu = 1;
    grid = cus * per_cu;
  }
  if (grid < 0) return;
  (void)hipMemsetAsync(d_ws, 0, CTL_ZERO_BYTES, stream);
  Args a{};
  for (int i = 0; i < 22; ++i) a.in[i] = (const float*)d_in[i];
  a.out = (float*)d_out; a.ws = (unsigned char*)d_ws;
  a.rep_down = REP_DOWN; a.rep_up = REP_UP; a.rep_scan = REP_SCAN;
#if MK_N_LAUNCHES == 1
  a.ph_lo = 0; a.ph_hi = NPHASE + 1;
  void* args[] = {&a};
  hipError_t e = hipLaunchCooperativeKernel((const void*)mega, dim3(grid), dim3(512), args, LDS_BYTES, stream);
  if (e != hipSuccess) fprintf(stderr, "cooperative launch failed: %s (grid %d)\n", hipGetErrorString(e), grid);
#else
  for (int p = 0; p <= NPHASE; ++p) { a.ph_lo = p; a.ph_hi = p + 1; hipLaunchKernelGGL(mega, dim3(grid), dim3(512), LDS_BYTES, stream, a); }
#endif
}
```

```cpp
#include <hip/hip_runtime.h>
#include <hip/hip_cooperative_groups.h>
#include <cstdio>
#include <cstdint>
namespace cg = cooperative_groups;

#ifndef USE_PG8
#define USE_PG8 1
#endif
#ifndef USE_ATT2
#define USE_ATT2 1
#endif
#ifndef PROBE_REP
#define PROBE_REP -1
#endif
#ifndef REP_DOWN
#define REP_DOWN 1
#endif
#ifndef REP_UP
#define REP_UP 1
#endif
#ifndef REP_SCAN
#define REP_SCAN 1
#endif
#ifndef MK_N_LAUNCHES
#define MK_N_LAUNCHES 1
#endif

typedef unsigned short bf16_t;
typedef short bf16x8 __attribute__((ext_vector_type(8)));
typedef float f32x4 __attribute__((ext_vector_type(4)));
typedef unsigned u32x4 __attribute__((ext_vector_type(4)));
typedef unsigned u32x2 __attribute__((ext_vector_type(2)));
typedef float v32f __attribute__((ext_vector_type(32)));
typedef float v16f __attribute__((ext_vector_type(16)));
typedef unsigned v6u __attribute__((ext_vector_type(6)));
typedef float f32x2 __attribute__((ext_vector_type(2)));

constexpr int NB = 8, SEQ = 4096, DM = 1024, NT = NB * SEQ;
constexpr int NQKV = 3072, INW = 3080;
constexpr int NMEM = 256, NMROWS = NB * NMEM;
constexpr int NEXP = 16384;
constexpr float EPS = 1e-6f;
constexpr int NPHASE = 13;
constexpr int LDS_BYTES = 147456;

constexpr size_t MiB = 1u << 20;
constexpr size_t WS_BAR = 65536;
constexpr size_t WS_SS1 = 131072;
constexpr size_t WS_SS2 = 262144;
constexpr size_t WS_SS3 = 393216;
constexpr size_t WS_XCTR = 512;
constexpr size_t CTL_ZERO_BYTES = 524288;
constexpr size_t WS_WIN_T = 2 * MiB;
constexpr size_t WS_WOUT_T = 8 * MiB;
constexpr size_t WS_WXQ_T = 10 * MiB;
constexpr size_t WS_WXKV_T = 12 * MiB;
constexpr size_t WS_WXO_T = 16 * MiB;
constexpr size_t WS_WPQ_T = 18 * MiB;
constexpr size_t WS_SK = 21 * MiB;
constexpr size_t WS_MEMN = 22 * MiB;
constexpr size_t WS_KX = 26 * MiB;
constexpr size_t WS_VXT = 30 * MiB;
constexpr size_t WS_FLOG = 34 * MiB;
constexpr size_t WS_CUM = 35 * MiB;
constexpr size_t WS_KMEAN = 36 * MiB;
constexpr size_t WS_ESC = 38 * MiB;
constexpr size_t WS_EXD = 40 * MiB;
constexpr size_t WS_EXU = 72 * MiB;
constexpr size_t WS_HB = 104 * MiB;
constexpr size_t WS_QKV = 168 * MiB;
constexpr size_t WS_OAB = 360 * MiB;
constexpr size_t WS_QX = 168 * MiB;
constexpr size_t WS_OX = 232 * MiB;
constexpr size_t WS_PQ = 232 * MiB;
constexpr size_t WS_EIDX = 424 * MiB;
constexpr size_t WS_GATE = 440 * MiB;
constexpr size_t WS_W = 456 * MiB;
constexpr size_t WS_END = 472 * MiB;

struct Args {
  const float* in[22];
  float* out;
  unsigned char* ws;
  int ph_lo, ph_hi;
  int rep_down, rep_up, rep_scan, pad_;
};

struct XcdBarrier;
__device__ __forceinline__ unsigned f2bf(float f) { unsigned u = __float_as_uint(f); return (u + 0x7fffu + ((u >> 16) & 1u)) >> 16; }
__device__ __forceinline__ unsigned pk2(float lo, float hi) { return f2bf(lo) | (f2bf(hi) << 16); }
__device__ __forceinline__ float bf2f(unsigned short b) { return __uint_as_float(((unsigned)b) << 16); }
__device__ __forceinline__ float bflo(unsigned w) { return __uint_as_float(w << 16); }
__device__ __forceinline__ float bfhi(unsigned w) { return __uint_as_float(w & 0xffff0000u); }
__device__ __forceinline__ float wave_sum(float v) {
#pragma unroll
  for (int o = 1; o < 64; o <<= 1) v += __shfl_xor(v, o);
  return v;
}
template <int O> __device__ __forceinline__ float swz_xor(float v) { return __int_as_float(__builtin_amdgcn_ds_swizzle(__float_as_int(v), (O << 10) | 0x1f)); }
__device__ __forceinline__ float half_sum32(float v) { v += swz_xor<1>(v); v += swz_xor<2>(v); v += swz_xor<4>(v); v += swz_xor<8>(v); v += swz_xor<16>(v); return v; }
__device__ __forceinline__ void unpack8(const u32x4 w, float* f) {
  f[0] = bflo(w.x); f[1] = bfhi(w.x); f[2] = bflo(w.y); f[3] = bfhi(w.y);
  f[4] = bflo(w.z); f[5] = bfhi(w.z); f[6] = bflo(w.w); f[7] = bfhi(w.w);
}

__device__ const unsigned char T5_BUCKET[128] = {
  0, 1, 2, 3, 4, 5, 6, 7, 8, 9, 10, 11, 12, 13, 14, 15, 16, 16, 16, 17, 17, 18, 18, 18, 19, 19, 19, 20, 20, 20, 20, 21,
  21, 21, 21, 22, 22, 22, 22, 22, 23, 23, 23, 23, 23, 23, 24, 24, 24, 24, 24, 24, 25, 25, 25, 25, 25, 25, 25, 26, 26, 26, 26, 26,
  26, 26, 26, 27, 27, 27, 27, 27, 27, 27, 27, 27, 27, 28, 28, 28, 28, 28, 28, 28, 28, 28, 28, 29, 29, 29, 29, 29, 29, 29, 29, 29,
  29, 29, 29, 30, 30, 30, 30, 30, 30, 30, 30, 30, 30, 30, 30, 30, 30, 31, 31, 31, 31, 31, 31, 31, 31, 31, 31, 31, 31, 31, 31, 31};

__device__ __forceinline__ void transpose_item(const float* W, int ldw, const float* gain, bf16_t* WT, int K, int row_off, float* scr, int kb, int nb, int lane) {
  const int k0 = 64 * kb, n0 = 32 * nb;
#pragma unroll 8
  for (int i = 0; i < 32; ++i) {
    const int kk = 2 * i + (lane >> 5);
    const float g = gain ? gain[k0 + kk] : 1.f;
    scr[kk * 33 + (lane & 31)] = W[(size_t)(k0 + kk) * ldw + n0 + (lane & 31)] * g;
  }
  __builtin_amdgcn_wave_barrier();
  const int c = lane & 7;
#pragma unroll
  for (int j = 0; j < 4; ++j) {
    const int n = (lane >> 3) + 8 * j; const float* s = scr + (8 * c) * 33 + n;
    u32x4 o; o.x = pk2(s[0 * 33], s[1 * 33]); o.y = pk2(s[2 * 33], s[3 * 33]); o.z = pk2(s[4 * 33], s[5 * 33]); o.w = pk2(s[6 * 33], s[7 * 33]);
    *(u32x4*)(WT + (size_t)(row_off + n0 + n) * K + k0 + 8 * c) = o;
  }
  __builtin_amdgcn_wave_barrier();
}

__device__ __forceinline__ void rms_row_to_bf16(const float* xrow, bf16_t* orow, int lane) {
  const f32x4* xr = (const f32x4*)xrow + lane;
  f32x4 v[4]; float s = 0.f;
#pragma unroll
  for (int j = 0; j < 4; ++j) { v[j] = xr[64 * j]; s += (v[j].x * v[j].x + v[j].y * v[j].y) + (v[j].z * v[j].z + v[j].w * v[j].w); }
  const float rstd = rsqrtf(wave_sum(s) * (1.f / DM) + EPS);
  u32x2* o = (u32x2*)orow + lane;
#pragma unroll
  for (int j = 0; j < 4; ++j) { u32x2 w; w.x = pk2(v[j].x * rstd, v[j].y * rstd); w.y = pk2(v[j].z * rstd, v[j].w * rstd); o[64 * j] = w; }
}

__device__ __forceinline__ void phase_prep(const Args& a, unsigned char* lds, int gw, int ngw, int wave, int lane, int tid) {
  unsigned char* ws = a.ws;
  float* scr = (float*)(lds + wave * 8448);
  const int I_IN = 16 * 96, I_SQ = 16 * 32;
  const int NITEMS = I_IN + 6 * I_SQ;
  for (int it = gw; it < NITEMS; it += ngw) {
    int r = it;
    if (r < I_IN) { transpose_item(a.in[3], INW, a.in[2], (bf16_t*)(ws + WS_WIN_T), DM, 0, scr, r / 96, r % 96, lane); continue; } r -= I_IN;
    const int which = r / I_SQ; r %= I_SQ; const int kb = r / 32, nb = r % 32;
    if (which == 0) { const float* g = (kb < 8) ? a.in[6] : (a.in[7] - 512); transpose_item(a.in[8], DM, g, (bf16_t*)(ws + WS_WOUT_T), DM, 0, scr, kb, nb, lane); }
    else if (which == 1) transpose_item(a.in[11], DM, a.in[9], (bf16_t*)(ws + WS_WXQ_T), DM, 0, scr, kb, nb, lane);
    else if (which == 2) transpose_item(a.in[12], DM, a.in[10], (bf16_t*)(ws + WS_WXKV_T), DM, 0, scr, kb, nb, lane);
    else if (which == 3) transpose_item(a.in[13], DM, a.in[10], (bf16_t*)(ws + WS_WXKV_T), DM, 1024, scr, kb, nb, lane);
    else if (which == 4) transpose_item(a.in[14], DM, nullptr, (bf16_t*)(ws + WS_WXO_T), DM, 0, scr, kb, nb, lane);
    else transpose_item(a.in[16], DM, a.in[15], (bf16_t*)(ws + WS_WPQ_T), DM, 0, scr, kb, nb, lane);
  }
  for (int it = gw; it < NEXP; it += ngw) {
    const int hi = lane >> 5, l32 = lane & 31; const int r = 2 * it + hi;
    const int tb = r >= NEXP, e = r - tb * NEXP;
    const f32x4* src = (const f32x4*)(a.in[19 + tb] + (size_t)e * DM) + 8 * l32;
    v16f xa, xb; float am = 0.f;
#pragma unroll
    for (int k = 0; k < 4; ++k) { const f32x4 p = src[k], q = src[4 + k];
      xa[2 * k] = p.x; xb[2 * k] = p.y; xa[2 * k + 1] = p.z; xb[2 * k + 1] = p.w; xa[8 + 2 * k] = q.x; xb[8 + 2 * k] = q.y; xa[8 + 2 * k + 1] = q.z; xb[8 + 2 * k + 1] = q.w;
      am = fmaxf(am, fmaxf(fmaxf(fabsf(p.x), fabsf(p.y)), fmaxf(fabsf(p.z), fabsf(p.w)))); am = fmaxf(am, fmaxf(fmaxf(fabsf(q.x), fabsf(q.y)), fmaxf(fabsf(q.z), fabsf(q.w)))); }
#pragma unroll
    for (int o = 1; o < 32; o <<= 1) am = fmaxf(am, __shfl_xor(am, o));
    if (tb == 0) {
      const float sc = am > 0.f ? 7.0f / am : 1.f;
      xa = xa * sc; xb = xb * sc;
      const v6u w = __builtin_amdgcn_cvt_scalef32_2xpk16_fp6_f32(xa, xb, 1.0f);
      u32x2* dst = (u32x2*)(ws + WS_EXD + (size_t)e * 768 + 24 * l32);
      dst[0] = (u32x2){w[0], w[1]}; dst[1] = (u32x2){w[2], w[3]}; dst[2] = (u32x2){w[4], w[5]};
      if (l32 == 0) ((float*)(ws + WS_ESC))[r] = am > 0.f ? am / 7.0f : 1.f;
    } else {
      const float sc = am > 0.f ? 440.f / am : 1.f;
      u32x4 o0, o1;
#pragma unroll
      for (int k = 0; k < 4; ++k) { int w = __builtin_amdgcn_cvt_pk_fp8_f32(xa[2 * k] * sc, xb[2 * k] * sc, 0, false); w = __builtin_amdgcn_cvt_pk_fp8_f32(xa[2 * k + 1] * sc, xb[2 * k + 1] * sc, w, true); o0[k] = (unsigned)w; }
#pragma unroll
      for (int k = 0; k < 4; ++k) { int w = __builtin_amdgcn_cvt_pk_fp8_f32(xa[8 + 2 * k] * sc, xb[8 + 2 * k] * sc, 0, false); w = __builtin_amdgcn_cvt_pk_fp8_f32(xa[8 + 2 * k + 1] * sc, xb[8 + 2 * k + 1] * sc, w, true); o1[k] = (unsigned)w; }
      u32x4* dst = (u32x4*)(ws + WS_EXU + (size_t)(l32 >> 2) * (NEXP * 128) + (size_t)e * 128 + 32 * (l32 & 3));
      dst[0] = o0; dst[1] = o1;
      if (l32 == 0) ((float*)(ws + WS_ESC))[r] = am > 0.f ? am / 440.f : 1.f;
    }
  }
  for (int i = blockIdx.x * 512 + tid; i < 2 * 65536; i += gridDim.x * 512) ((bf16_t*)(ws + WS_SK))[i] = (bf16_t)f2bf(a.in[17 + (i >> 16)][i & 65535]);
  for (int r = gw; r < NMROWS; r += ngw) rms_row_to_bf16(a.in[1] + (size_t)r * DM, (bf16_t*)(ws + WS_MEMN) + (size_t)r * DM, lane);
  __syncthreads();
  float* wf = (float*)(lds + 69632);
  for (int k = tid; k < DM; k += 512) {
    const float g = a.in[2][k]; const f32x4* wp = (const f32x4*)(a.in[3] + (size_t)k * INW + NQKV);
    const f32x4 p = wp[0], q = wp[1];
    wf[k] = p.x * g; wf[1024 + k] = p.y * g; wf[2048 + k] = p.z * g; wf[3072 + k] = p.w * g; wf[4096 + k] = q.x * g; wf[5120 + k] = q.y * g; wf[6144 + k] = q.z * g; wf[7168 + k] = q.w * g;
  }
  __syncthreads();
  float* flog = (float*)(ws + WS_FLOG);
  for (int r = gw; r < NT; r += ngw) {
    const f32x4* xr = (const f32x4*)(a.in[0] + (size_t)r * DM) + lane;
    f32x4 v[4]; float s = 0.f; float fa[8];
#pragma unroll
    for (int j = 0; j < 8; ++j) fa[j] = 0.f;
#pragma unroll
    for (int j = 0; j < 4; ++j) {
      v[j] = xr[64 * j]; s += (v[j].x * v[j].x + v[j].y * v[j].y) + (v[j].z * v[j].z + v[j].w * v[j].w);
#pragma unroll
      for (int jj = 0; jj < 8; ++jj) { const f32x4 w4 = *(const f32x4*)(wf + jj * 1024 + 256 * j + 4 * lane); fa[jj] += (v[j].x * w4.x + v[j].y * w4.y) + (v[j].z * w4.z + v[j].w * w4.w); }
    }
    const float rstd = rsqrtf(wave_sum(s) * (1.f / DM) + EPS);
    float mine = 0.f;
#pragma unroll
    for (int j = 0; j < 8; ++j) { const float t = wave_sum(fa[j]); if (lane == j) mine = t; }
    if (lane < 8) {
      const float z = mine * rstd + a.in[4][lane];
      flog[(size_t)lane * NT + r] = fminf(z, 0.f) - log1pf(expf(-fabsf(z)));
    }
    u32x2* o = (u32x2*)((bf16_t*)(ws + WS_HB) + (size_t)r * DM) + lane;
#pragma unroll
    for (int j = 0; j < 4; ++j) { u32x2 w; w.x = pk2(v[j].x * rstd, v[j].y * rstd); w.y = pk2(v[j].z * rstd, v[j].w * rstd); o[64 * j] = w; }
  }
}

template <class Epi>
__device__ __forceinline__ void gemm_naive(const bf16_t* A, int lda, const bf16_t* Bt, int ldb, int M, int N, int K, const Epi& E, int gw, int ngw, int lane) {
  const int fr = lane & 15, fq = lane >> 4;
  const int tn = N / 64, ntile = (M / 64) * tn;
  for (int tile = gw; tile < ntile; tile += ngw) {
    const int pm = tile / tn, pn = tile % tn;
    f32x4 acc[4][4];
#pragma unroll
    for (int m = 0; m < 4; ++m)
#pragma unroll
      for (int n = 0; n < 4; ++n) acc[m][n] = (f32x4){0.f, 0.f, 0.f, 0.f};
    const bf16_t* Ap = A + (size_t)(pm * 64 + fr) * lda + fq * 8;
    const bf16_t* Bp = Bt + (size_t)(pn * 64 + fr) * ldb + fq * 8;
    for (int k0 = 0; k0 < K; k0 += 32) {
      bf16x8 af[4], bfr[4];
#pragma unroll
      for (int m = 0; m < 4; ++m) af[m] = *(const bf16x8*)(Ap + (size_t)m * 16 * lda + k0);
#pragma unroll
      for (int n = 0; n < 4; ++n) bfr[n] = *(const bf16x8*)(Bp + (size_t)n * 16 * ldb + k0);
#pragma unroll
      for (int m = 0; m < 4; ++m)
#pragma unroll
        for (int n = 0; n < 4; ++n) acc[m][n] = __builtin_amdgcn_mfma_f32_16x16x32_bf16(bfr[n], af[m], acc[m][n], 0, 0, 0);
    }
#pragma unroll
    for (int m = 0; m < 4; ++m)
#pragma unroll
      for (int n = 0; n < 4; ++n) E.store(pm * 64 + m * 16 + fr, pn * 64 + n * 16 + 4 * fq, acc[m][n]);
  }
}

struct EpiBf16 { bf16_t* O; int ldo;
  __device__ __forceinline__ void store8(int row, int col, f32x4 a, f32x4 b) const { u32x4 w; w.x = pk2(a.x, a.y); w.y = pk2(a.z, a.w); w.z = pk2(b.x, b.y); w.w = pk2(b.z, b.w); *(u32x4*)(O + (size_t)row * ldo + col) = w; }
  __device__ __forceinline__ void store(int row, int col, f32x4 v) const { u32x2 w; w.x = pk2(v.x, v.y); w.y = pk2(v.z, v.w); *(u32x2*)(O + (size_t)row * ldo + col) = w; } };
struct EpiQKV { bf16_t* O;
  __device__ __forceinline__ void store8(int row, int col, f32x4 a, f32x4 b) const { const float sc = (col < 512 || (col >= 1536 && col < 2048)) ? 0.18033688011112042f : 1.f;
    u32x4 w; w.x = pk2(a.x * sc, a.y * sc); w.y = pk2(a.z * sc, a.w * sc); w.z = pk2(b.x * sc, b.y * sc); w.w = pk2(b.z * sc, b.w * sc); *(u32x4*)(O + (size_t)row * NQKV + col) = w; }
  __device__ __forceinline__ void store(int row, int col, f32x4 v) const { const float sc = (col < 512 || (col >= 1536 && col < 2048)) ? 0.18033688011112042f : 1.f;
    u32x2 w; w.x = pk2(v.x * sc, v.y * sc); w.y = pk2(v.z * sc, v.w * sc); *(u32x2*)(O + (size_t)row * NQKV + col) = w; } };
struct EpiBf16S { bf16_t* O; int ldo; const float* ss;
  __device__ __forceinline__ void store8(int row, int col, f32x4 a, f32x4 b) const { const float r = rsqrtf(ss[row] * (1.f / DM) + EPS);
    u32x4 w; w.x = pk2(a.x * r, a.y * r); w.y = pk2(a.z * r, a.w * r); w.z = pk2(b.x * r, b.y * r); w.w = pk2(b.z * r, b.w * r); *(u32x4*)(O + (size_t)row * ldo + col) = w; }
  __device__ __forceinline__ void store(int row, int col, f32x4 v) const { const float r = rsqrtf(ss[row] * (1.f / DM) + EPS); u32x2 w; w.x = pk2(v.x * r, v.y * r); w.y = pk2(v.z * r, v.w * r); *(u32x2*)(O + (size_t)row * ldo + col) = w; } };
struct EpiF32S { float* O; int ldo; const float* ss;
  __device__ __forceinline__ void store(int row, int col, f32x4 v) const { const float r = rsqrtf(ss[row] * (1.f / DM) + EPS); *(f32x4*)(O + (size_t)row * ldo + col) = v * r; } };
struct EpiF32 { float* O; int ldo;
  __device__ __forceinline__ void store(int row, int col, f32x4 v) const { *(f32x4*)(O + (size_t)row * ldo + col) = v; } };
struct EpiResid { const float* base; float* out;
  __device__ __forceinline__ void store(int row, int col, f32x4 v) const { const size_t o = (size_t)row * DM + col; const f32x4 b = *(const f32x4*)(base + o); *(f32x4*)(out + o) = b + v; } };
struct EpiKV { bf16_t* KX; bf16_t* VXT;
  __device__ __forceinline__ void store(int row, int col, f32x4 v) const {
    if (col < 1024) { u32x2 w; w.x = pk2(v.x, v.y); w.y = pk2(v.z, v.w); *(u32x2*)(KX + (size_t)row * DM + col) = w; }
    else { const int b = row >> 8, m = row & 255;
#pragma unroll
      for (int r = 0; r < 4; ++r) { const int d = col - 1024 + r; VXT[((size_t)(b * 4 + (d >> 8)) * 256 + (d & 255)) * 256 + m] = (bf16_t)f2bf(v[r]); } } } };

__device__ __forceinline__ void phase_scan(const Args& a, int gw, int ngw, int lane, int tid) {
  unsigned char* ws = a.ws;
  const bf16_t* qkv = (const bf16_t*)(ws + WS_QKV);
  for (int item = gw; item < 64 + 1024 + 1024; item += ngw) {
    if (item < 64) {
      const int b = item >> 3, j = item & 7;
      const f32x4* src = (const f32x4*)((const float*)(ws + WS_FLOG) + (size_t)j * NT + (size_t)b * SEQ + lane * 64);
      f32x4 v[16];
#pragma unroll
      for (int i = 0; i < 16; ++i) v[i] = src[i];
      float tot = 0.f;
#pragma unroll
      for (int i = 0; i < 16; ++i) tot += (v[i].x + v[i].y) + (v[i].z + v[i].w);
      float inc = tot;
#pragma unroll
      for (int o = 1; o < 64; o <<= 1) { const float t = __shfl_up(inc, o); if (lane >= o) inc += t; }
      float run = inc - tot;
      f32x4* dst = (f32x4*)((float*)(ws + WS_CUM) + ((size_t)(b * 8 + j)) * SEQ + lane * 64);
#pragma unroll
      for (int i = 0; i < 16; ++i) { f32x4 o; run += v[i].x; o.x = run * 1.4426950408889634f; run += v[i].y; o.y = run * 1.4426950408889634f; run += v[i].z; o.z = run * 1.4426950408889634f; run += v[i].w; o.w = run * 1.4426950408889634f; dst[i] = o; }
    } else if (item < 64 + 1024) {
      const int it = item - 64, h = it & 7, blk = (it >> 3) & 15, b = it >> 7;
      const bf16_t* p = qkv + ((size_t)b * SEQ + blk * 256 + (lane >> 3)) * NQKV + 512 + h * 64 + (lane & 7) * 8;
      float s[8];
#pragma unroll
      for (int i = 0; i < 8; ++i) s[i] = 0.f;
#pragma unroll 8
      for (int rr = 0; rr < 32; ++rr) { float f[8]; unpack8(*(const u32x4*)(p + (size_t)rr * 8 * NQKV), f);
#pragma unroll
        for (int i = 0; i < 8; ++i) s[i] += f[i]; }
#pragma unroll
      for (int i = 0; i < 8; ++i) { s[i] += __shfl_xor(s[i], 8); s[i] += __shfl_xor(s[i], 16); s[i] += __shfl_xor(s[i], 32); }
      if (lane < 8) { f32x4* d = (f32x4*)((float*)(ws + WS_KMEAN) + ((size_t)(b * 16 + blk) * 8 + h) * 64 + lane * 8);
        d[0] = (f32x4){s[0], s[1], s[2], s[3]} * (1.f / 256.f); d[1] = (f32x4){s[4], s[5], s[6], s[7]} * (1.f / 256.f); }
    } else {
      const int it = item - 64 - 1024, bh = it >> 4, ch = it & 15, b = bh >> 3, h = bh & 7;
      const bf16_t* p = qkv + ((size_t)b * SEQ + ch * 256 + (lane >> 3)) * NQKV + 2048 + h * 64 + (lane & 7) * 8;
      float m = 0.f;
#pragma unroll 8
      for (int rr = 0; rr < 32; ++rr) { float f[8]; unpack8(*(const u32x4*)(p + (size_t)rr * 8 * NQKV), f);
        float s = 0.f;
#pragma unroll
        for (int i = 0; i < 8; ++i) s += f[i] * f[i];
        s += __shfl_xor(s, 1); s += __shfl_xor(s, 2); s += __shfl_xor(s, 4);
        m = fmaxf(m, s); }
#pragma unroll
      for (int o = 8; o < 64; o <<= 1) m = fmaxf(m, __shfl_xor(m, o));
      if (lane == 0) atomicMax((unsigned*)(ws + 256) + bh, __float_as_uint(m));
    }
  }
}

template <int MODE>
__device__ __forceinline__ void attn_naive_unit(const Args& a, unsigned char* lds, int b, int h, int sb, int tid) {
  unsigned char* ws = a.ws;
  const bf16_t* qkv = (const bf16_t*)(ws + WS_QKV);
  const int qoff = MODE ? 1536 : 0, koff = qoff + 512, voff = qoff + 1024;
  float* Ks = (float*)lds; float* Vs = Ks + 64 * 64; float* ck = Vs + 64 * 64; float* biasd = ck + 64;
  const int t = sb * 512 + tid; const size_t row = (size_t)b * SEQ + t;
  float q[64], o[64];
  {
    const u32x4* qp = (const u32x4*)(qkv + row * NQKV + qoff + h * 64);
#pragma unroll
    for (int c = 0; c < 8; ++c) { const u32x4 w = qp[c]; unpack8(w, q + 8 * c); }
#pragma unroll
    for (int d = 0; d < 64; ++d) { q[d] *= 0.6931471805599453f; o[d] = 0.f; }
  }
  float m = -1e30f, l = 0.f;
  unsigned selmask = 0u; const int own = t >> 8;
  float cq = 0.f, bfar = 0.f;
  __syncthreads();
  if (MODE == 0) {
    if (tid < 128) biasd[tid] = a.in[5][T5_BUCKET[tid] * 8 + h];
    bfar = a.in[5][31 * 8 + h];
    const float* km = (const float*)(ws + WS_KMEAN) + ((size_t)b * 16) * 512 + h * 64;
    float v0 = -3e38f, v1 = -3e38f, v2 = -3e38f; int i0 = -1, i1 = -1, i2 = -1;
    for (int n = 0; n < 2 * sb + 1; ++n) {
      if (n < own) {
        const float* kp = km + (size_t)n * 512; float s = 0.f;
#pragma unroll
        for (int d = 0; d < 64; ++d) s += q[d] * kp[d];
        if (s > v0) { v2 = v1; i2 = i1; v1 = v0; i1 = i0; v0 = s; i0 = n; }
        else if (s > v1) { v2 = v1; i2 = i1; v1 = s; i1 = n; }
        else if (s > v2) { v2 = s; i2 = n; }
      }
    }
    if (i0 >= 0) selmask |= 1u << i0;
    if (i1 >= 0) selmask |= 1u << i1;
    if (i2 >= 0) selmask |= 1u << i2;
  } else {
    cq = ((const float*)(ws + WS_CUM))[((size_t)(b * 8 + h)) * SEQ + t];
  }
  const int ntile = 8 * (sb + 1);
  for (int kt = 0; kt < ntile; ++kt) {
    __syncthreads();
    {
      const int r = tid >> 3, ch = tid & 7;
      const bf16_t* kp = qkv + ((size_t)b * SEQ + kt * 64 + r) * NQKV + h * 64 + ch * 8;
      const u32x4 kw = *(const u32x4*)(kp + koff), vw = *(const u32x4*)(kp + voff);
      unpack8(kw, Ks + r * 64 + ch * 8); unpack8(vw, Vs + r * 64 + ch * 8);
      if (MODE == 1 && tid < 64) ck[tid] = ((const float*)(ws + WS_CUM))[((size_t)(b * 8 + h)) * SEQ + kt * 64 + tid];
    }
    __syncthreads();
    const int kb = kt >> 2;
    bool act;
    if (MODE == 0) act = (kb == own) || (kb < own && ((selmask >> kb) & 1u));
    else act = (kt * 64 <= t);
    if (act) {
      for (int jj = 0; jj < 64; ++jj) {
        const int sp = kt * 64 + jj;
        if (sp > t) break;
        const f32x4* kr = (const f32x4*)(Ks + jj * 64);
        float s = 0.f;
#pragma unroll
        for (int c = 0; c < 16; ++c) { const f32x4 kv = kr[c]; s += q[4 * c] * kv.x + q[4 * c + 1] * kv.y + q[4 * c + 2] * kv.z + q[4 * c + 3] * kv.w; }
        if (MODE == 0) { const int dist = t - sp; s += (dist < 128) ? biasd[dist] : bfar; }
        else s += (cq - ck[jj]) * 0.6931471805599453f;
        if (s > m) { const float f = __expf(m - s); l *= f;
#pragma unroll
          for (int d = 0; d < 64; ++d) o[d] *= f;
          m = s; }
        const float p = __expf(s - m); l += p;
        const f32x4* vr = (const f32x4*)(Vs + jj * 64);
#pragma unroll
        for (int c = 0; c < 16; ++c) { const f32x4 vv = vr[c]; o[4 * c] += p * vv.x; o[4 * c + 1] += p * vv.y; o[4 * c + 2] += p * vv.z; o[4 * c + 3] += p * vv.w; }
      }
    }
  }
  const float il = 1.f / l;
  u32x4* op = (u32x4*)((bf16_t*)(ws + WS_OAB) + row * DM + (MODE ? 512 : 0) + h * 64);
#pragma unroll
  for (int c = 0; c < 8; ++c) { u32x4 w; w.x = pk2(o[8 * c] * il, o[8 * c + 1] * il); w.y = pk2(o[8 * c + 2] * il, o[8 * c + 3] * il); w.z = pk2(o[8 * c + 4] * il, o[8 * c + 5] * il); w.w = pk2(o[8 * c + 6] * il, o[8 * c + 7] * il); op[c] = w; }
}

__device__ __forceinline__ void phase_attn(const Args& a, unsigned char* lds, int tid) {
  for (int u = blockIdx.x; u < 1024; u += gridDim.x) {
    const int sb = 7 - (u >> 7), r = u & 127, mode = r & 1, bh = r >> 1;
    if (mode == 0) attn_naive_unit<0>(a, lds, bh >> 3, bh & 7, sb, tid);
    else attn_naive_unit<1>(a, lds, bh >> 3, bh & 7, sb, tid);
  }
}

namespace att {
typedef float f32x16 __attribute__((ext_vector_type(16)));
typedef short s16x4 __attribute__((ext_vector_type(4)));
typedef short v4i16_t __attribute__((ext_vector_type(4)));
typedef __attribute__((address_space(3))) const char* lds_cptr;
typedef float f32x2_t __attribute__((ext_vector_type(2))); typedef __bf16 bf16x2_t __attribute__((ext_vector_type(2)));
constexpr int PITCH = NQKV;
constexpr float LOG2E = 1.4426950408889634f;
constexpr float C2 = 0.125f * LOG2E;
constexpr int L_K = 0, L_V = 16384, L_WSF = 32768, L_OST = 34816, L_C2 = 67584, L_KM = 83968, L_BT = 88064, L_MISC = 88704;
__device__ __forceinline__ int crow(int r, int hi) { return (r & 3) + 8 * (r >> 2) + 4 * hi; }
__device__ __forceinline__ unsigned cvtpk(float lo, float hi) { f32x2_t v = {lo, hi}; bf16x2_t b = __builtin_convertvector(v, bf16x2_t); return __builtin_bit_cast(unsigned, b); }
__device__ __forceinline__ s16x4 vtr(lds_cptr p) { return __builtin_bit_cast(s16x4, __builtin_amdgcn_ds_read_tr16_b64_v4i16((__attribute__((address_space(3))) v4i16_t*)p)); }
__device__ __forceinline__ float max3f(float a, float b, float c) { float r; asm("v_max3_f32 %0, %1, %2, %3" : "=v"(r) : "v"(a), "v"(b), "v"(c)); return r; }
__device__ __forceinline__ float xhalf_max(float m) { auto rr = __builtin_amdgcn_permlane32_swap(__float_as_uint(m), __float_as_uint(m), false, false); return fmaxf(__uint_as_float(rr[0]), __uint_as_float(rr[1])); }
__device__ __forceinline__ float xhalf_sum(float m) { auto rr = __builtin_amdgcn_permlane32_swap(__float_as_uint(m), __float_as_uint(m), false, false); return __uint_as_float(rr[0]) + __uint_as_float(rr[1]); }

template <int MODE>
__device__ __forceinline__ void unit(const Args& a, unsigned char* lds, int b, int h, int qb, int tid) {
  unsigned char* ws = a.ws;
  const int lane = tid & 63, r32 = lane & 31, hi = lane >> 5; const int wid = __builtin_amdgcn_readfirstlane(tid >> 6);
  const bf16_t* qkv = (const bf16_t*)(ws + WS_QKV);
  const int qoff = MODE ? 1536 : 0;
  const size_t rowbase = (size_t)b * SEQ; const int q0 = qb * 256;
  const bf16_t* Qw = qkv + (rowbase + q0 + wid * 32) * PITCH + qoff + h * 64;
  const bf16_t* Kh = qkv + rowbase * PITCH + qoff + 512 + h * 64;
  const bf16_t* Vh = qkv + rowbase * PITCH + qoff + 1024 + h * 64;
  float* wsf = (float*)(lds + L_WSF) + wid * 64;
  float* c2s = (float*)(lds + L_C2); float* kms = (float*)(lds + L_KM); float* bts = (float*)(lds + L_BT); unsigned* misc = (unsigned*)(lds + L_MISC);
  const int NTL = 4 * (qb + 1);
  __syncthreads();
  if (MODE == 0) {
    const float* km = (const float*)(ws + WS_KMEAN) + (size_t)b * 16 * 512 + h * 64;
    for (int i = tid; i < 16 * 64; i += 512) kms[i] = km[(size_t)(i >> 6) * 512 + (i & 63)];
    if (tid < 128) bts[tid] = a.in[5][T5_BUCKET[tid] * 8 + h] * LOG2E;
    if (tid == 128) bts[128] = a.in[5][31 * 8 + h] * LOG2E;
  } else {
    const float* cg = (const float*)(ws + WS_CUM) + (size_t)(b * 8 + h) * SEQ;
    for (int i = tid; i < 256 * (qb + 1); i += 512) c2s[i] = cg[i];
    if (tid == 0) misc[0] = 0u;
  }
  bf16x8 qr[4];
#pragma unroll
  for (int d0 = 0; d0 < 4; ++d0) qr[d0] = *(const bf16x8*)(Qw + (size_t)r32 * PITCH + d0 * 16 + hi * 8);
  __syncthreads();
  unsigned selmask = 0u; float cq2 = 0.f, far2 = 0.f, mhat = 0.f; int t0 = 0;
  if (MODE == 0) {
    far2 = bts[128];
    float v0 = -3e38f, v1 = -3e38f, v2 = -3e38f; int i0 = -1, i1 = -1, i2 = -1;
    for (int n = 0; n < qb; ++n) {
      float s = 0.f;
#pragma unroll
      for (int d0 = 0; d0 < 4; ++d0)
#pragma unroll
        for (int j = 0; j < 8; ++j) s += bf2f((unsigned short)qr[d0][j]) * kms[n * 64 + d0 * 16 + hi * 8 + j];
      s = xhalf_sum(s);
      if (s > v0) { v2 = v1; i2 = i1; v1 = v0; i1 = i0; v0 = s; i0 = n; }
      else if (s > v1) { v2 = v1; i2 = i1; v1 = s; i1 = n; }
      else if (s > v2) { v2 = s; i2 = n; }
    }
    if (i0 >= 0) selmask |= 1u << i0;
    if (i1 >= 0) selmask |= 1u << i1;
    if (i2 >= 0) selmask |= 1u << i2;
  } else {
    cq2 = c2s[q0 + wid * 32 + r32];
    float s = 0.f;
#pragma unroll
    for (int d0 = 0; d0 < 4; ++d0)
#pragma unroll
      for (int j = 0; j < 8; ++j) { const float f = bf2f((unsigned short)qr[d0][j]); s += f * f; }
    s = xhalf_sum(s);
    atomicMax(&misc[0], __float_as_uint(s));
    __syncthreads();
    const float kn2 = __uint_as_float(((const unsigned*)(ws + 256))[b * 8 + h]);
    const float qkb = sqrtf(__uint_as_float(misc[0]) * kn2) * 1.0001f + 1e-3f;
    mhat = -qkb;
    const int j = lane; bool skip = false;
    if (j < NTL) skip = (2.f * qkb + c2s[q0] - c2s[64 * j + 63]) < -150.f;
    t0 = __popcll(__ballot(skip));
    if (t0 > NTL - 1) t0 = NTL - 1;
  }
  const bf16_t* ksrc = Kh + (size_t)lane * PITCH + wid * 8;
  const bf16_t* vsrc = Vh + (size_t)(16 * (wid & 3) + (lane >> 2)) * PITCH + (wid >> 2) * 32 + (lane & 3) * 8;
  unsigned char* kdst = lds + L_K + wid * 1024 + lane * 16; unsigned char* vdst = lds + L_V + wid * 1024 + lane * 16;
  const lds_cptr lds3 = (lds_cptr)lds;
  const lds_cptr vp0 = lds3 + L_V + ((lane >> 4) & 1) * 32 + (lane & 3) * 8 + (4 * hi + ((lane & 15) >> 2)) * 64;
  u32x4 kreg = *(const u32x4*)(ksrc + (size_t)t0 * 64 * PITCH), vreg = *(const u32x4*)(vsrc + (size_t)t0 * 64 * PITCH);
  *(u32x4*)(kdst + (t0 & 1) * 8192) = kreg; *(u32x4*)(vdst + (t0 & 1) * 8192) = vreg;
  f32x16 o[2]; o[0] = f32x16{}; o[1] = f32x16{};
  f32x16 ol = f32x16{}, cm = f32x16{}; int cm_nb = -1;
  const int qrel = wid * 32 + r32, qpos = q0 + qrel;
  __syncthreads();
  for (int t = t0; t < NTL; ++t) {
    const int buf = (t & 1) * 8192;
    if (t + 1 < NTL) { kreg = *(const u32x4*)(ksrc + (size_t)(t + 1) * 64 * PITCH); vreg = *(const u32x4*)(vsrc + (size_t)(t + 1) * 64 * PITCH); }
    const int jb = t - (NTL - 4);
    const bool compute = !(jb >= 0 && 64 * jb > wid * 32 + 31);
    if (compute) {
      f32x16 p0, p1;
      bf16x8 kf[8];
      {
        const lds_cptr kb = lds3 + L_K + buf + hi * 1024 + r32 * 16;
#pragma unroll
        for (int d0 = 0; d0 < 4; ++d0) { kf[2 * d0] = *(const __attribute__((address_space(3))) bf16x8*)(kb + d0 * 2048); kf[2 * d0 + 1] = *(const __attribute__((address_space(3))) bf16x8*)(kb + d0 * 2048 + 512); }
      }
      __builtin_amdgcn_sched_barrier(0);
      if (MODE == 0) {
        const int nb = t >> 2;
        const bool near = (jb >= 0) || (t >= NTL - 6 && wid < 4);
        if (near) {
#pragma unroll
          for (int r = 0; r < 16; ++r) { const int d = qpos - (64 * t + crow(r, hi));
            p0[r] = bts[min(max(d, 0), 128)] - mhat; p1[r] = bts[min(max(d - 32, 0), 128)] - mhat; }
          if (jb < 0 && !((selmask >> nb) & 1u)) {
#pragma unroll
            for (int r = 0; r < 16; ++r) { p0[r] = -INFINITY; p1[r] = -INFINITY; }
          }
        } else {
          if (cm_nb != nb) {
            const float base = ((selmask >> nb) & 1u) ? far2 - mhat : -INFINITY;
#pragma unroll
            for (int r = 0; r < 16; ++r) cm[r] = base;
            cm_nb = nb;
          }
          p0 = cm; p1 = cm;
        }
      } else {
        const float cqm = cq2 - mhat;
#pragma unroll
        for (int g = 0; g < 4; ++g) {
          const f32x4 ca = *(const f32x4*)(c2s + 64 * t + 8 * g + 4 * hi), cb = *(const f32x4*)(c2s + 64 * t + 32 + 8 * g + 4 * hi);
#pragma unroll
          for (int i = 0; i < 4; ++i) { p0[4 * g + i] = cqm - ca[i]; p1[4 * g + i] = cqm - cb[i]; }
        }
      }
#pragma unroll
      for (int d0 = 0; d0 < 4; ++d0) {
        p0 = __builtin_amdgcn_mfma_f32_32x32x16_bf16(kf[2 * d0], qr[d0], p0, 0, 0, 0);
        p1 = __builtin_amdgcn_mfma_f32_32x32x16_bf16(kf[2 * d0 + 1], qr[d0], p1, 0, 0, 0);
      }
      if (jb >= 0) {
        asm volatile("" ::: "memory");
        const int kb0 = 64 * jb + 4 * hi;
#pragma unroll
        for (int r = 0; r < 16; ++r) { const int kv = kb0 + (r & 3) + 8 * (r >> 2); if (kv > qrel) p0[r] = -INFINITY; if (kv + 32 > qrel) p1[r] = -INFINITY; }
      }
      asm volatile("s_nop 15\n\ts_nop 7" : "+v"(p0), "+v"(p1));
      float rm, rm2;
      rm = max3f(p0[0], p0[1], p1[0]); rm2 = max3f(p0[2], p0[3], p1[1]); rm = max3f(rm, p1[2], p1[3]);
#pragma unroll
      for (int r = 4; r < 16; r += 4) { rm = max3f(rm, p0[r], p0[r + 1]); rm2 = max3f(rm2, p0[r + 2], p0[r + 3]); rm = max3f(rm, p1[r], p1[r + 1]); rm2 = max3f(rm2, p1[r + 2], p1[r + 3]); }
      rm = xhalf_max(fmaxf(rm, rm2));
      if (__any(rm > 8.0f)) {
        const float dl = fmaxf(rm, 0.f), alpha = __builtin_amdgcn_exp2f(-dl);
        mhat += dl; cm_nb = -1;
#pragma unroll
        for (int r = 0; r < 16; ++r) { p0[r] -= dl; p1[r] -= dl; }
        if (hi == 0) wsf[r32] = alpha;
        __builtin_amdgcn_wave_barrier();
#pragma unroll
        for (int r = 0; r < 16; ++r) { const float f = wsf[crow(r, hi)]; o[0][r] *= f; o[1][r] *= f; ol[r] *= f; }
        __builtin_amdgcn_wave_barrier();
      }
#pragma unroll
      for (int r = 0; r < 16; ++r) { p0[r] = __builtin_amdgcn_exp2f(p0[r]); p1[r] = __builtin_amdgcn_exp2f(p1[r]); }
      u32x4 pw0, pw1, pw2, pw3;
      pw0 = (u32x4){cvtpk(p0[0], p0[1]), cvtpk(p0[2], p0[3]), cvtpk(p0[4], p0[5]), cvtpk(p0[6], p0[7])};
      pw1 = (u32x4){cvtpk(p0[8], p0[9]), cvtpk(p0[10], p0[11]), cvtpk(p0[12], p0[13]), cvtpk(p0[14], p0[15])};
      pw2 = (u32x4){cvtpk(p1[0], p1[1]), cvtpk(p1[2], p1[3]), cvtpk(p1[4], p1[5]), cvtpk(p1[6], p1[7])};
      pw3 = (u32x4){cvtpk(p1[8], p1[9]), cvtpk(p1[10], p1[11]), cvtpk(p1[12], p1[13]), cvtpk(p1[14], p1[15])};
      {
        const bf16x8 ones = (bf16x8){0x3F80, 0x3F80, 0x3F80, 0x3F80, 0x3F80, 0x3F80, 0x3F80, 0x3F80};
        ol = __builtin_amdgcn_mfma_f32_32x32x16_bf16(__builtin_bit_cast(bf16x8, pw0), ones, ol, 0, 0, 0);
        ol = __builtin_amdgcn_mfma_f32_32x32x16_bf16(__builtin_bit_cast(bf16x8, pw1), ones, ol, 0, 0, 0);
        ol = __builtin_amdgcn_mfma_f32_32x32x16_bf16(__builtin_bit_cast(bf16x8, pw2), ones, ol, 0, 0, 0);
        ol = __builtin_amdgcn_mfma_f32_32x32x16_bf16(__builtin_bit_cast(bf16x8, pw3), ones, ol, 0, 0, 0);
      }
      const lds_cptr vp = vp0 + buf;
#pragma unroll
      for (int d0 = 0; d0 < 2; ++d0) {
#define ATT_VF(ks) ({ const s16x4 lo_ = vtr(vp + d0 * 4096 + (ks) * 1024), hi_ = vtr(vp + d0 * 4096 + (ks) * 1024 + 512); (bf16x8){lo_[0], lo_[1], lo_[2], lo_[3], hi_[0], hi_[1], hi_[2], hi_[3]}; })
        o[d0] = __builtin_amdgcn_mfma_f32_32x32x16_bf16(__builtin_bit_cast(bf16x8, pw0), ATT_VF(0), o[d0], 0, 0, 0);
        o[d0] = __builtin_amdgcn_mfma_f32_32x32x16_bf16(__builtin_bit_cast(bf16x8, pw1), ATT_VF(1), o[d0], 0, 0, 0);
        o[d0] = __builtin_amdgcn_mfma_f32_32x32x16_bf16(__builtin_bit_cast(bf16x8, pw2), ATT_VF(2), o[d0], 0, 0, 0);
        o[d0] = __builtin_amdgcn_mfma_f32_32x32x16_bf16(__builtin_bit_cast(bf16x8, pw3), ATT_VF(3), o[d0], 0, 0, 0);
#undef ATT_VF
      }
    }
    if (t + 1 < NTL) { *(u32x4*)(kdst + ((t + 1) & 1) * 8192) = kreg; *(u32x4*)(vdst + ((t + 1) & 1) * 8192) = vreg; }
    __syncthreads();
  }
  bf16_t* stg = (bf16_t*)(lds + L_OST) + wid * 2048;
#pragma unroll
  for (int r = 0; r < 16; ++r) { const int orow = crow(r, hi); const float rl = 1.f / ol[r];
    stg[orow * 64 + r32] = (bf16_t)f2bf(o[0][r] * rl); stg[orow * 64 + 32 + r32] = (bf16_t)f2bf(o[1][r] * rl); }
  __builtin_amdgcn_wave_barrier();
  bf16_t* Ow = (bf16_t*)(ws + WS_OAB) + (rowbase + q0 + wid * 32) * DM + (MODE ? 512 : 0) + h * 64;
#pragma unroll
  for (int i = 0; i < 4; ++i) { const int row = i * 8 + (lane >> 3), ch = lane & 7; const u32x4 v = *(const u32x4*)(stg + row * 64 + ch * 8); *(u32x4*)(Ow + (size_t)row * DM + ch * 8) = v; }
}
}

__device__ __forceinline__ void phase_attn2(const Args& a, unsigned char* lds, int tid) {
  unsigned* ctr = (unsigned*)(a.ws + 0);
  unsigned* slot = (unsigned*)(lds + att::L_MISC + 64);
  for (;;) {
    __syncthreads();
    if (tid == 0) slot[0] = atomicAdd(ctr, 1u);
    __syncthreads();
    const unsigned u = slot[0];
    if (u >= 2048u) break;
    const int qb = 15 - (int)(u >> 7), r = u & 127, mode = r & 1, bh = r >> 1;
    if (mode == 0) att::unit<0>(a, lds, bh >> 3, bh & 7, qb, tid);
    else att::unit<1>(a, lds, bh >> 3, bh & 7, qb, tid);
  }
}

__device__ __forceinline__ void phase_onorm(const Args& a, int gw, int ngw, int lane) {
  bf16_t* oab = (bf16_t*)(a.ws + WS_OAB);
  for (int r = gw; r < NT; r += ngw) {
    u32x4* p = (u32x4*)(oab + (size_t)r * DM) + 2 * lane;
    const u32x4 w0 = p[0], w1 = p[1]; float f[16]; unpack8(w0, f); unpack8(w1, f + 8);
    float s = 0.f;
#pragma unroll
    for (int i = 0; i < 16; ++i) s += f[i] * f[i];
#pragma unroll
    for (int o = 1; o < 32; o <<= 1) s += __shfl_xor(s, o);
    const float rstd = rsqrtf(s * (1.f / 512.f) + EPS);
    u32x4 o0, o1;
    o0.x = pk2(f[0] * rstd, f[1] * rstd); o0.y = pk2(f[2] * rstd, f[3] * rstd); o0.z = pk2(f[4] * rstd, f[5] * rstd); o0.w = pk2(f[6] * rstd, f[7] * rstd);
    o1.x = pk2(f[8] * rstd, f[9] * rstd); o1.y = pk2(f[10] * rstd, f[11] * rstd); o1.z = pk2(f[12] * rstd, f[13] * rstd); o1.w = pk2(f[14] * rstd, f[15] * rstd);
    p[0] = o0; p[1] = o1;
  }
}

__device__ __forceinline__ void phase_rms(const Args& a, int gw, int ngw, int lane) {
  for (int r = gw; r < NT; r += ngw) rms_row_to_bf16(a.out + (size_t)r * DM, (bf16_t*)(a.ws + WS_HB) + (size_t)r * DM, lane);
}

__device__ __forceinline__ void phase_xattn(const Args& a, unsigned char* lds, int gw, int ngw, int wave, int lane) {
  unsigned char* ws = a.ws;
  const bf16_t* qx = (const bf16_t*)(ws + WS_QX); const bf16_t* kx = (const bf16_t*)(ws + WS_KX); const bf16_t* vxt = (const bf16_t*)(ws + WS_VXT);
  bf16_t* ox = (bf16_t*)(ws + WS_OX);
  bf16_t* P = (bf16_t*)(lds + wave * 8192);
  const int fr = lane & 15, fq = lane >> 4;
  for (int u = gw; u < (NT / 16) * 4; u += ngw) {
    const int hd = u & 3, r0 = (u >> 2) * 16, b = r0 / SEQ;
    f32x4 acc[16];
#pragma unroll
    for (int i = 0; i < 16; ++i) acc[i] = (f32x4){0.f, 0.f, 0.f, 0.f};
    const bf16_t* Ap = qx + (size_t)(r0 + fr) * DM + hd * 256 + fq * 8;
    const bf16_t* Bp = kx + (size_t)(b * 256 + fr) * DM + hd * 256 + fq * 8;
    for (int ks = 0; ks < 8; ++ks) {
      const bf16x8 af = *(const bf16x8*)(Ap + ks * 32);
#pragma unroll
      for (int ct = 0; ct < 16; ++ct) { const bf16x8 bfr = *(const bf16x8*)(Bp + (size_t)ct * 16 * DM + ks * 32); acc[ct] = __builtin_amdgcn_mfma_f32_16x16x32_bf16(af, bfr, acc[ct], 0, 0, 0); }
    }
    float mx[4], sm[4];
#pragma unroll
    for (int r = 0; r < 4; ++r) { float m = acc[0][r];
#pragma unroll
      for (int ct = 1; ct < 16; ++ct) m = fmaxf(m, acc[ct][r]);
#pragma unroll
      for (int o = 1; o < 16; o <<= 1) m = fmaxf(m, __shfl_xor(m, o));
      mx[r] = m; sm[r] = 0.f; }
#pragma unroll
    for (int ct = 0; ct < 16; ++ct)
#pragma unroll
      for (int r = 0; r < 4; ++r) { const float p = __expf((acc[ct][r] - mx[r]) * 0.0625f); acc[ct][r] = p; sm[r] += p; }
#pragma unroll
    for (int r = 0; r < 4; ++r) {
#pragma unroll
      for (int o = 1; o < 16; o <<= 1) sm[r] += __shfl_xor(sm[r], o);
      sm[r] = 1.f / sm[r]; }
    __builtin_amdgcn_wave_barrier();
#pragma unroll
    for (int ct = 0; ct < 16; ++ct)
#pragma unroll
      for (int r = 0; r < 4; ++r) P[(4 * fq + r) * 256 + ct * 16 + fr] = (bf16_t)f2bf(acc[ct][r] * sm[r]);
    __builtin_amdgcn_wave_barrier();
    asm volatile("s_waitcnt lgkmcnt(0)" ::: "memory");
#pragma unroll
    for (int i = 0; i < 16; ++i) acc[i] = (f32x4){0.f, 0.f, 0.f, 0.f};
    const bf16_t* Vp = vxt + ((size_t)(b * 4 + hd) * 256 + fr) * 256 + fq * 8;
    for (int ks = 0; ks < 8; ++ks) {
      const bf16x8 pf = *(const bf16x8*)(P + fr * 256 + ks * 32 + fq * 8);
#pragma unroll
      for (int dt = 0; dt < 16; ++dt) { const bf16x8 vf = *(const bf16x8*)(Vp + (size_t)dt * 16 * 256 + ks * 32); acc[dt] = __builtin_amdgcn_mfma_f32_16x16x32_bf16(pf, vf, acc[dt], 0, 0, 0); }
    }
#pragma unroll
    for (int dt = 0; dt < 16; ++dt)
#pragma unroll
      for (int r = 0; r < 4; ++r) ox[(size_t)(r0 + 4 * fq + r) * DM + hd * 256 + dt * 16 + fr] = (bf16_t)f2bf(acc[dt][r]);
    __builtin_amdgcn_wave_barrier();
  }
}

namespace xa {
using att::f32x16; using att::s16x4; using att::lds_cptr; using att::crow; using att::cvtpk; using att::vtr; using att::xhalf_max; using att::xhalf_sum;
constexpr int L_WSF = 65536;
__device__ __forceinline__ void unit(const Args& a, unsigned char* lds, int b, int hd, int qb, int tid) {
  unsigned char* ws = a.ws;
  const int lane = tid & 63, r32 = lane & 31, hi = lane >> 5; const int wid = __builtin_amdgcn_readfirstlane(tid >> 6);
  const bf16_t* qrow = (const bf16_t*)(ws + WS_QX) + ((size_t)b * SEQ + qb * 256 + wid * 32 + r32) * DM + hd * 256;
  const bf16_t* kvb = (const bf16_t*)(ws + WS_KX) + (size_t)b * 256 * 2048 + hd * 256;
  const bf16_t* ksrc = kvb + (size_t)lane * 2048 + wid * 8;
  const bf16_t* vsrc = kvb + 1024 + (size_t)(16 * (wid & 3) + (lane >> 2)) * 2048 + (wid >> 2) * 32 + (lane & 3) * 8;
  unsigned char* sdst = lds + wid * 1024 + lane * 16;
  const lds_cptr lds3 = (lds_cptr)lds;
  const lds_cptr kp0 = lds3 + hi * 1024 + r32 * 16;
  const lds_cptr vp0 = lds3 + ((lane >> 4) & 1) * 32 + (lane & 3) * 8 + (4 * hi + ((lane & 15) >> 2)) * 64;
  float* wsf = (float*)(lds + L_WSF) + wid * 64;
  u32x4 sreg[4];
#define XA_LOADK(c) do { _Pragma("unroll") for (int kt = 0; kt < 4; ++kt) sreg[kt] = *(const u32x4*)(ksrc + (size_t)kt * 64 * 2048 + (c) * 64); } while (0)
#define XA_LOADV(vt) do { _Pragma("unroll") for (int dq = 0; dq < 4; ++dq) sreg[dq] = *(const u32x4*)(vsrc + (size_t)(vt) * 64 * 2048 + dq * 64); } while (0)
#define XA_WRITE(buf) do { _Pragma("unroll") for (int i = 0; i < 4; ++i) *(u32x4*)(sdst + (buf) * 32768 + i * 8192) = sreg[i]; } while (0)
  __syncthreads();
  XA_LOADK(0); XA_WRITE(0);
  f32x16 acc[8];
#pragma unroll
  for (int j = 0; j < 8; ++j) acc[j] = f32x16{};
  __syncthreads();
#pragma unroll
  for (int c = 0; c < 4; ++c) {
    if (c < 3) XA_LOADK(c + 1); else XA_LOADV(0);
    bf16x8 qf[4];
#pragma unroll
    for (int d0 = 0; d0 < 4; ++d0) qf[d0] = *(const bf16x8*)(qrow + c * 64 + d0 * 16 + hi * 8);
    const lds_cptr kp = kp0 + (c & 1) * 32768;
#pragma unroll
    for (int d0 = 0; d0 < 4; ++d0)
#pragma unroll
      for (int j = 0; j < 8; ++j) {
        const bf16x8 kf = *(const __attribute__((address_space(3))) bf16x8*)(kp + (j >> 1) * 8192 + d0 * 2048 + (j & 1) * 512);
        acc[j] = __builtin_amdgcn_mfma_f32_32x32x16_bf16(kf, qf[d0], acc[j], 0, 0, 0);
      }
    XA_WRITE((c + 1) & 1);
    __syncthreads();
  }
  float m = acc[0][0];
#pragma unroll
  for (int j = 0; j < 8; ++j)
#pragma unroll
    for (int r = 0; r < 16; ++r) m = fmaxf(m, acc[j][r]);
  m = xhalf_max(m);
  constexpr float CS = 1.4426950408889634f / 16.f;
  float l = 0.f; u32x4 pw[16];
#pragma unroll
  for (int j = 0; j < 8; ++j) {
#pragma unroll
    for (int r = 0; r < 16; ++r) { const float p = __builtin_amdgcn_exp2f((acc[j][r] - m) * CS); acc[j][r] = p; l += p; }
    pw[2 * j] = (u32x4){cvtpk(acc[j][0], acc[j][1]), cvtpk(acc[j][2], acc[j][3]), cvtpk(acc[j][4], acc[j][5]), cvtpk(acc[j][6], acc[j][7])};
    pw[2 * j + 1] = (u32x4){cvtpk(acc[j][8], acc[j][9]), cvtpk(acc[j][10], acc[j][11]), cvtpk(acc[j][12], acc[j][13]), cvtpk(acc[j][14], acc[j][15])};
  }
  l = xhalf_sum(l);
#pragma unroll
  for (int j = 0; j < 8; ++j) acc[j] = f32x16{};
#pragma unroll
  for (int vt = 0; vt < 4; ++vt) {
    if (vt < 3) XA_LOADV(vt + 1);
    const lds_cptr vp = vp0 + (vt & 1) * 32768;
#pragma unroll
    for (int ks = 0; ks < 4; ++ks)
#pragma unroll
      for (int db = 0; db < 8; ++db) {
        const s16x4 lo_ = vtr(vp + (db >> 1) * 8192 + (db & 1) * 4096 + ks * 1024), hi_ = vtr(vp + (db >> 1) * 8192 + (db & 1) * 4096 + ks * 1024 + 512);
        const bf16x8 vf = (bf16x8){lo_[0], lo_[1], lo_[2], lo_[3], hi_[0], hi_[1], hi_[2], hi_[3]};
        acc[db] = __builtin_amdgcn_mfma_f32_32x32x16_bf16(__builtin_bit_cast(bf16x8, pw[4 * vt + ks]), vf, acc[db], 0, 0, 0);
      }
    if (vt < 3) XA_WRITE((vt + 1) & 1);
    __syncthreads();
  }
  if (hi == 0) wsf[r32] = l;
  __builtin_amdgcn_wave_barrier();
  float rl[16];
#pragma unroll
  for (int r = 0; r < 16; ++r) rl[r] = 1.f / wsf[crow(r, hi)];
  bf16_t* stg = (bf16_t*)(lds + wid * 8192);
  bf16_t* orow0 = (bf16_t*)(ws + WS_OX) + ((size_t)b * SEQ + qb * 256 + wid * 32) * DM + hd * 256;
#pragma unroll
  for (int hf = 0; hf < 2; ++hf) {
#pragma unroll
    for (int db = 0; db < 4; ++db)
#pragma unroll
      for (int r = 0; r < 16; ++r) stg[crow(r, hi) * 128 + db * 32 + r32] = (bf16_t)f2bf(acc[hf * 4 + db][r] * rl[r]);
    __builtin_amdgcn_wave_barrier();
#pragma unroll
    for (int i = 0; i < 8; ++i) { const int row = i * 4 + (lane >> 4), ch = lane & 15; const u32x4 v = *(const u32x4*)(stg + row * 128 + ch * 8); *(u32x4*)(orow0 + (size_t)row * DM + hf * 128 + ch * 8) = v; }
    __builtin_amdgcn_wave_barrier();
  }
#undef XA_LOADK
#undef XA_LOADV
#undef XA_WRITE
}
}

__device__ __forceinline__ void phase_xattn2(const Args& a, unsigned char* lds, int tid) {
  for (int u = blockIdx.x; u < NB * 4 * 16; u += gridDim.x) { const int qb = u & 15, hd = (u >> 4) & 3, b = u >> 6; xa::unit(a, lds, b, hd, qb, tid); }
}

__device__ __forceinline__ unsigned fkey(float s, unsigned idx, unsigned mask) { unsigned u = __float_as_uint(s); u ^= (unsigned)((int)u >> 31) | 0x80000000u; return (u & ~mask) | (mask - idx); }
__device__ __forceinline__ float keyval(unsigned k, unsigned mask) { unsigned u = k & ~mask; u = (u & 0x80000000u) ? (u ^ 0x80000000u) : ~u; return __uint_as_float(u); }
#define KEY_INSERT(KA, key_) do { unsigned k__ = (key_); \
  _Pragma("unroll") for (int s_ = 0; s_ < 16; ++s_) { const unsigned hi_ = max(k__, KA[s_]); k__ = min(k__, KA[s_]); KA[s_] = hi_; } } while (0)

__device__ __forceinline__ void phase_topk(const Args& a, unsigned char* lds, int tid) {
  unsigned char* ws = a.ws;
  const float* pq = (const float*)(ws + WS_PQ);
  int* eidx = (int*)(ws + WS_EIDX); float* gate = (float*)(ws + WS_GATE);
  float* K1 = (float*)lds; float* K2 = K1 + 128 * 64; unsigned* KL = (unsigned*)(lds + 65536);
  for (int u = blockIdx.x; u < 8 * (NT / 512); u += gridDim.x) {
    const int h = u & 7, t = (u >> 3) * 512 + tid;
    __syncthreads();
    for (int i = tid; i < 128 * 64 / 4; i += 512) { ((f32x4*)K1)[i] = ((const f32x4*)(a.in[17] + (size_t)h * 8192))[i]; ((f32x4*)K2)[i] = ((const f32x4*)(a.in[18] + (size_t)h * 8192))[i]; }
    __syncthreads();
    unsigned ka[16], kb[16], kc[16];
#pragma unroll
    for (int k = 0; k < 16; ++k) { ka[k] = 0u; kb[k] = 0u; kc[k] = 0u; }
    float q[64];
    const f32x4* qp = (const f32x4*)(pq + (size_t)t * DM + h * 128);
#pragma unroll
    for (int c = 0; c < 16; ++c) { const f32x4 w = qp[c]; q[4 * c] = w.x; q[4 * c + 1] = w.y; q[4 * c + 2] = w.z; q[4 * c + 3] = w.w; }
    for (int n = 0; n < 128; ++n) {
      const f32x4* kr = (const f32x4*)(K1 + n * 64); float s = 0.f;
#pragma unroll
      for (int c = 0; c < 16; ++c) { const f32x4 kv = kr[c]; s += q[4 * c] * kv.x + q[4 * c + 1] * kv.y + q[4 * c + 2] * kv.z + q[4 * c + 3] * kv.w; }
      KEY_INSERT(ka, fkey(s, (unsigned)n, 127u));
    }
#pragma unroll
    for (int c = 0; c < 16; ++c) { const f32x4 w = qp[16 + c]; q[4 * c] = w.x; q[4 * c + 1] = w.y; q[4 * c + 2] = w.z; q[4 * c + 3] = w.w; }
    for (int n = 0; n < 128; ++n) {
      const f32x4* kr = (const f32x4*)(K2 + n * 64); float s = 0.f;
#pragma unroll
      for (int c = 0; c < 16; ++c) { const f32x4 kv = kr[c]; s += q[4 * c] * kv.x + q[4 * c + 1] * kv.y + q[4 * c + 2] * kv.z + q[4 * c + 3] * kv.w; }
      KEY_INSERT(kb, fkey(s, (unsigned)n, 127u));
    }
#pragma unroll
    for (int x = 0; x < 16; ++x)
#pragma unroll
      for (int y = 0; y < 16; ++y)
        if ((x + 1) * (y + 1) <= 16) { KEY_INSERT(kc, fkey(keyval(ka[x], 127u) + keyval(kb[y], 127u), (unsigned)(x * 16 + y), 255u)); }
#pragma unroll
    for (int k = 0; k < 16; ++k) { KL[k * 512 + tid] = ka[k]; KL[(16 + k) * 512 + tid] = kb[k]; }
    float val[16]; int id[16]; float sum = 0.f;
#pragma unroll
    for (int k = 0; k < 16; ++k) {
      const unsigned flat = 255u - (kc[k] & 255u);
      const unsigned k1 = KL[(flat >> 4) * 512 + tid], k2 = KL[(16 + (flat & 15u)) * 512 + tid];
      val[k] = keyval(k1, 127u) + keyval(k2, 127u);
      id[k] = (int)((127u - (k1 & 127u)) * 128u + (127u - (k2 & 127u)));
    }
    const float vmax = val[0];
#pragma unroll
    for (int k = 0; k < 16; ++k) { val[k] = __expf(val[k] - vmax); sum += val[k]; }
    const float inv = 1.f / sum;
    int* ep = eidx + (size_t)t * 128 + h * 16; float* gp = gate + (size_t)t * 128 + h * 16;
#pragma unroll
    for (int k = 0; k < 16; ++k) { ep[k] = id[k]; gp[k] = val[k] * inv; }
  }
}


namespace tk {
typedef float f32x16 __attribute__((ext_vector_type(16)));
__device__ __forceinline__ void ce(unsigned& a, unsigned& b) { const unsigned h = max(a, b), l = min(a, b); a = h; b = l; }
__device__ __forceinline__ void sort16(unsigned (&v)[16]) {
#pragma unroll
  for (int k = 2; k <= 16; k <<= 1)
#pragma unroll
    for (int j = k >> 1; j > 0; j >>= 1)
#pragma unroll
      for (int i = 0; i < 16; ++i) { const int l = i ^ j; if (l > i) { if ((i & k) == 0) ce(v[i], v[l]); else ce(v[l], v[i]); } }
}
__device__ __forceinline__ void topmerge(unsigned (&a)[16], const unsigned (&b)[16]) {
#pragma unroll
  for (int i = 0; i < 16; ++i) a[i] = max(a[i], b[15 - i]);
#pragma unroll
  for (int j = 8; j > 0; j >>= 1)
#pragma unroll
    for (int i = 0; i < 16; ++i) { const int l = i ^ j; if (l > i) ce(a[i], a[l]); }
}
__device__ __forceinline__ unsigned xswap(unsigned v, int hi) { auto rr = __builtin_amdgcn_permlane32_swap(v, v, false, false); return hi ? rr[0] : rr[1]; }
__device__ __forceinline__ void half_list(unsigned (&L)[16], const bf16_t* skh, const bf16_t* qrow, int r32, int hi) {
  f32x16 acc[4];
#pragma unroll
  for (int i = 0; i < 4; ++i) acc[i] = f32x16{};
#pragma unroll
  for (int ks = 0; ks < 4; ++ks) {
    const bf16x8 qf = *(const bf16x8*)(qrow + ks * 16 + hi * 8);
#pragma unroll
    for (int tl = 0; tl < 4; ++tl) { const bf16x8 kf = *(const bf16x8*)(skh + (size_t)(tl * 32 + r32) * 64 + ks * 16 + hi * 8); acc[tl] = __builtin_amdgcn_mfma_f32_32x32x16_bf16(kf, qf, acc[tl], 0, 0, 0); }
  }
  unsigned g[4][16];
#pragma unroll
  for (int tl = 0; tl < 4; ++tl)
#pragma unroll
    for (int r = 0; r < 16; ++r) g[tl][r] = fkey(acc[tl][r], (unsigned)(32 * tl + (r & 3) + 8 * (r >> 2) + 4 * hi), 127u);
  sort16(g[0]); sort16(g[1]); sort16(g[2]); sort16(g[3]);
  topmerge(g[0], g[1]); topmerge(g[2], g[3]); topmerge(g[0], g[2]);
  unsigned p[16];
#pragma unroll
  for (int k = 0; k < 16; ++k) p[k] = xswap(g[0][k], hi);
  topmerge(g[0], p);
#pragma unroll
  for (int k = 0; k < 16; ++k) L[k] = g[0][k];
}
}

__device__ __forceinline__ void phase_topk2(const Args& a, unsigned char* lds, int wave, int lane) {
  unsigned char* ws = a.ws;
  const bf16_t* pq = (const bf16_t*)(ws + WS_PQ); const bf16_t* sk = (const bf16_t*)(ws + WS_SK);
  int* eidx = (int*)(ws + WS_EIDX); float* gate = (float*)(ws + WS_GATE);
  const int r32 = lane & 31, hi = lane >> 5, h = wave;
  unsigned* KL = (unsigned*)(lds + wave * 4096);
  for (int tt = blockIdx.x; tt < NT / 32; tt += gridDim.x) {
    const int t = tt * 32 + r32;
    unsigned ka[16], kb[16], kc[16];
    tk::half_list(ka, sk + (size_t)(0 * 8 + h) * 8192, pq + (size_t)t * DM + h * 128, r32, hi);
    tk::half_list(kb, sk + (size_t)(1 * 8 + h) * 8192, pq + (size_t)t * DM + h * 128 + 64, r32, hi);
    float va[16], vb[16];
#pragma unroll
    for (int k = 0; k < 16; ++k) { va[k] = keyval(ka[k], 127u); vb[k] = keyval(kb[k], 127u); }
#pragma unroll
    for (int y = 0; y < 16; ++y) kc[y] = hi ? 0u : fkey(va[0] + vb[y], (unsigned)y, 255u);
#define TK_CAND(xa, ya, xb, yb) do { const unsigned kA_ = fkey(va[xa] + vb[ya], (unsigned)((xa) * 16 + (ya)), 255u), kB_ = fkey(va[xb] + vb[yb], (unsigned)((xb) * 16 + (yb)), 255u); KEY_INSERT(kc, hi ? kB_ : kA_); } while (0)
    TK_CAND(1, 0, 1, 1);
    TK_CAND(1, 2, 1, 3);
    TK_CAND(1, 4, 1, 5);
    TK_CAND(1, 6, 1, 7);
    TK_CAND(2, 0, 2, 1);
    TK_CAND(2, 2, 2, 3);
    TK_CAND(2, 4, 3, 0);
    TK_CAND(3, 1, 3, 2);
    TK_CAND(3, 3, 4, 0);
    TK_CAND(4, 1, 4, 2);
    TK_CAND(5, 0, 5, 1);
    TK_CAND(6, 0, 6, 1);
    TK_CAND(7, 0, 7, 1);
    TK_CAND(8, 0, 9, 0);
    TK_CAND(10, 0, 11, 0);
    TK_CAND(12, 0, 13, 0);
    TK_CAND(14, 0, 15, 0);
#undef TK_CAND
    { unsigned p[16];
#pragma unroll
      for (int k = 0; k < 16; ++k) p[k] = tk::xswap(kc[k], hi);
      tk::topmerge(kc, p); }
    if (hi == 0) {
#pragma unroll
      for (int k = 0; k < 16; ++k) { KL[k * 32 + r32] = ka[k]; KL[(16 + k) * 32 + r32] = kb[k]; }
    }
    __builtin_amdgcn_wave_barrier();
    const float vmax = va[0] + vb[0];
    float pv[8]; int id[8]; float s = 0.f;
#pragma unroll
    for (int j = 0; j < 8; ++j) {
      unsigned klo_ = kc[j], khi_ = kc[8 + j]; asm volatile("" : "+v"(klo_), "+v"(khi_));
      const unsigned key = hi ? khi_ : klo_;
      const unsigned flat = 255u - (key & 255u);
      const unsigned k1 = KL[(flat >> 4) * 32 + r32], k2 = KL[(16 + (flat & 15u)) * 32 + r32];
      pv[j] = __expf(keyval(k1, 127u) + keyval(k2, 127u) - vmax); s += pv[j];
      id[j] = (int)((127u - (k1 & 127u)) * 128u + (127u - (k2 & 127u)));
    }
    __builtin_amdgcn_wave_barrier();
    const float inv = 1.f / att::xhalf_sum(s);
    u32x4* ep = (u32x4*)(eidx + (size_t)t * 128 + h * 16 + hi * 8); f32x4* gp = (f32x4*)(gate + (size_t)t * 128 + h * 16 + hi * 8);
    ep[0] = (u32x4){(unsigned)id[0], (unsigned)id[1], (unsigned)id[2], (unsigned)id[3]}; ep[1] = (u32x4){(unsigned)id[4], (unsigned)id[5], (unsigned)id[6], (unsigned)id[7]};
    gp[0] = (f32x4){pv[0] * inv, pv[1] * inv, pv[2] * inv, pv[3] * inv}; gp[1] = (f32x4){pv[4] * inv, pv[5] * inv, pv[6] * inv, pv[7] * inv};
  }
}

__device__ __forceinline__ float gelu_erf(float v) { return 0.5f * v * (1.f + erff(v * 0.70710678118654752f)); }

__device__ __forceinline__ float gelu_as(float v) {
  const float av = fabsf(v), t = __builtin_amdgcn_rcpf(av * 0.2316418882f + 1.0f);
  float q = t * 0.5307027145f + (-0.7265760135f); q = q * t + 0.7107068705f; q = q * t + (-0.142248368f); q = q * t + 0.127414796f; q = q * t;
  const float m = v * (q * __builtin_amdgcn_exp2f((v * v) * (-0.72134752044f)));
  return v < 0.f ? m : v - m;
}
#define PIN16(A, O) asm volatile("" : "+v"(A[O]), "+v"(A[O + 1]), "+v"(A[O + 2]), "+v"(A[O + 3]), "+v"(A[O + 4]), "+v"(A[O + 5]), "+v"(A[O + 6]), "+v"(A[O + 7]), "+v"(A[O + 8]), "+v"(A[O + 9]), "+v"(A[O + 10]), "+v"(A[O + 11]), "+v"(A[O + 12]), "+v"(A[O + 13]), "+v"(A[O + 14]), "+v"(A[O + 15]))
#define PIN6(R) asm volatile("" : "+v"(R[0].x), "+v"(R[0].y), "+v"(R[1].x), "+v"(R[1].y), "+v"(R[2].x), "+v"(R[2].y))
__device__ __forceinline__ void phase_exp_down(const Args& a, int gw, int ngw, int lane) {
  unsigned char* ws = a.ws;
  const int* eidx = (const int*)(ws + WS_EIDX); const float* gate = (const float*)(ws + WS_GATE); float* wout = (float*)(ws + WS_W);
  const unsigned char* exd = ws + WS_EXD; const float* esc = (const float*)(ws + WS_ESC);
  const int l32 = lane & 31, hi = lane >> 5;
  const bool b4 = (l32 & 16) != 0, b3 = (l32 & 8) != 0, b2 = (l32 & 4) != 0;
  for (int t = gw; t < NT; t += ngw) {
    const int e0 = eidx[(size_t)t * 128 + lane], e1 = eidx[(size_t)t * 128 + 64 + lane];
    const float sd0 = esc[e0], sd1 = esc[e1];
    const float gu0 = gate[(size_t)t * 128 + lane] * esc[NEXP + e0], gu1 = gate[(size_t)t * 128 + 64 + lane] * esc[NEXP + e1];
    const f32x4* xr = (const f32x4*)(a.out + (size_t)t * DM) + 8 * l32;
    float hg[32]; float s = 0.f;
#pragma unroll
    for (int k = 0; k < 8; ++k) { const f32x4 x = xr[k]; s += (x.x * x.x + x.y * x.y) + (x.z * x.z + x.w * x.w); hg[4 * k] = x.x; hg[4 * k + 1] = x.y; hg[4 * k + 2] = x.z; hg[4 * k + 3] = x.w; }
    s = half_sum32(s);
    const float rstd = rsqrtf(s * (1.f / DM) + EPS);
#pragma unroll
    for (int k = 0; k < 8; ++k) { const f32x4 g = ((const f32x4*)a.in[15])[8 * l32 + k]; hg[4 * k] *= rstd * g.x; hg[4 * k + 1] *= rstd * g.y; hg[4 * k + 2] *= rstd * g.z; hg[4 * k + 3] *= rstd * g.w; }
    float w0 = 0.f, w1 = 0.f;
    for (int e = 0; e < 128; e += 16) {
      u32x2 ur[8][3];
#pragma unroll
      for (int i = 0; i < 8; ++i) {
        const int pi = (e & 63) + 2 * i + hi; const int id = (e < 64) ? __shfl(e0, pi) : __shfl(e1, pi);
        const u32x2* up = (const u32x2*)(exd + (size_t)id * 768 + 24 * l32);
        ur[i][0] = up[0]; ur[i][1] = up[1]; ur[i][2] = up[2];
      }
      float d[8];
#pragma unroll
      for (int i = 0; i < 8; ++i) {
        const v32f u = __builtin_amdgcn_cvt_scalef32_pk32_f32_fp6((v6u){ur[i][0].x, ur[i][0].y, ur[i][1].x, ur[i][1].y, ur[i][2].x, ur[i][2].y}, 1.0f);
        f32x2 q2 = (f32x2){0.f, 0.f};
#pragma unroll
        for (int k = 0; k < 16; ++k) q2 = __builtin_elementwise_fma((f32x2){u[2 * k], u[2 * k + 1]}, (f32x2){hg[2 * k], hg[2 * k + 1]}, q2);
        d[i] = q2.x + q2.y;
        __builtin_amdgcn_sched_barrier(0);
      }
      float r[4];
#pragma unroll
      for (int j = 0; j < 4; ++j) r[j] = (b4 ? d[j + 4] : d[j]) + swz_xor<16>(b4 ? d[j] : d[j + 4]);
      const float q0 = (b3 ? r[2] : r[0]) + swz_xor<8>(b3 ? r[0] : r[2]);
      const float q1 = (b3 ? r[3] : r[1]) + swz_xor<8>(b3 ? r[1] : r[3]);
      float q = (b2 ? q1 : q0) + swz_xor<4>(b2 ? q0 : q1);
      q += swz_xor<2>(q); q += swz_xor<1>(q);
      const int pr = (e & 63) + 2 * (l32 >> 2) + hi;
      const float sd = (e < 64) ? __shfl(sd0, pr) : __shfl(sd1, pr);
      const float gu = (e < 64) ? __shfl(gu0, pr) : __shfl(gu1, pr);
      const float wl = gu * gelu_as(q * sd);
      const float wsrc = __shfl(wl, ((lane & 1) << 5) | (((lane - (e & 63)) >> 1 & 7) << 2));
      if (lane >= (e & 63) && lane < (e & 63) + 16) { if (e < 64) w0 = wsrc; else w1 = wsrc; }
    }
    wout[(size_t)t * 128 + lane] = w0; wout[(size_t)t * 128 + 64 + lane] = w1;
  }
}

__device__ __forceinline__ void exp_up_item(const Args& a, unsigned char* lds, int xs, int item, int wave, int lane, float* xout, float* ssout) {
  unsigned char* ws = a.ws;
  const int* eidx = (const int*)(ws + WS_EIDX); const float* wgt = (const float*)(ws + WS_W);
  const unsigned char* ups = ws + WS_EXU + (size_t)xs * (NEXP * 128);
  unsigned* L = (unsigned*)(lds + wave * 16640);
  const int g = lane >> 2, c = lane & 3, t0 = item * 128 + wave * 16;
  __builtin_amdgcn_wave_barrier();
#pragma unroll 4
  for (int tk = 0; tk < 16; ++tk) {
    const size_t o = (size_t)(t0 + tk) * 128;
    L[tk * 260 + lane] = (unsigned)eidx[o + lane]; L[tk * 260 + 64 + lane] = (unsigned)eidx[o + 64 + lane];
    L[tk * 260 + 128 + lane] = __float_as_uint(wgt[o + lane]); L[tk * 260 + 192 + lane] = __float_as_uint(wgt[o + 64 + lane]);
  }
  __builtin_amdgcn_wave_barrier();
  float acc[32];
#pragma unroll
  for (int i = 0; i < 32; ++i) acc[i] = 0.f;
  const unsigned* Lg = L + g * 260;
#pragma unroll 1
  for (int p = 0; p < 128; p += 8) {
    u32x2 vr[8][3];
#pragma unroll
    for (int u = 0; u < 8; ++u) {
      const u32x2* vp = (const u32x2*)(ups + (size_t)Lg[p + u] * 128 + 24 * c);
      vr[u][0] = vp[0]; vr[u][1] = vp[1]; vr[u][2] = vp[2];
    }
#pragma unroll
    for (int u = 0; u < 8; ++u) {
      const float w = __uint_as_float(Lg[128 + p + u]);
      PIN6(vr[u]);
      const v32f v = __builtin_amdgcn_cvt_scalef32_pk32_f32_fp6((v6u){vr[u][0].x, vr[u][0].y, vr[u][1].x, vr[u][1].y, vr[u][2].x, vr[u][2].y}, 1.0f);
#pragma unroll
      for (int k = 0; k < 32; ++k) acc[k] += w * v[k];
      PIN16(acc, 0); PIN16(acc, 16);
    }
  }
  const f32x4* xr = (const f32x4*)(a.out + (size_t)(t0 + g) * DM + xs * 128 + c * 32); f32x4* xw = (f32x4*)(xout + (size_t)(t0 + g) * DM + xs * 128 + c * 32);
  float s = 0.f;
#pragma unroll
  for (int k = 0; k < 8; ++k) { f32x4 x = xr[k]; x.x += acc[4 * k]; x.y += acc[4 * k + 1]; x.z += acc[4 * k + 2]; x.w += acc[4 * k + 3]; xw[k] = x; s += (x.x * x.x + x.y * x.y) + (x.z * x.z + x.w * x.w); }
  s += swz_xor<1>(s); s += swz_xor<2>(s);
  if (c == 0) atomicAdd(ssout + t0 + g, s);
}
__device__ __forceinline__ void phase_exp_up(const Args& a, unsigned char* lds, const XcdBarrier& bar, int tid, int wave, int lane, unsigned* ctr, float* xout, float* ssout);
struct UpBuf { u32x4 r[8][2]; };
__device__ __forceinline__ void up2_load(UpBuf& B, const unsigned char* ups, const unsigned* Lg, int ch, int c) {
  const unsigned char* base = ups + (size_t)(ch >> 4) * (NEXP * 128) + 32 * c; const int p = (ch & 15) * 8;
#pragma unroll
  for (int u = 0; u < 8; ++u) { const u32x4* vp = (const u32x4*)(base + (size_t)Lg[p + u] * 128); B.r[u][0] = vp[0]; B.r[u][1] = vp[1]; }
}
__device__ __forceinline__ void up2_math(UpBuf& B, const unsigned* Lg, int ch, f32x2 (&acc)[16]) {
  const int p = (ch & 15) * 8;
#pragma unroll
  for (int u = 0; u < 8; ++u) {
    const float w = __uint_as_float(Lg[128 + p + u]);
    const f32x2 w2 = (f32x2){w, w};
#pragma unroll
    for (int q = 0; q < 2; ++q)
#pragma unroll
      for (int k = 0; k < 4; ++k) {
        const auto lo = __builtin_amdgcn_cvt_pk_f32_fp8((int)B.r[u][q][k], false); const auto hi = __builtin_amdgcn_cvt_pk_f32_fp8((int)B.r[u][q][k], true);
        acc[8 * q + 2 * k] = __builtin_elementwise_fma((f32x2){lo[0], lo[1]}, w2, acc[8 * q + 2 * k]);
        acc[8 * q + 2 * k + 1] = __builtin_elementwise_fma((f32x2){hi[0], hi[1]}, w2, acc[8 * q + 2 * k + 1]);
      }
    if (u & 1) PIN16(acc, 0);
  }
}
__device__ __forceinline__ void up2_slice_end(const Args& a, int t, int xs, int c, f32x2 (&acc)[16], float& ssum) {
  f32x4* xr = (f32x4*)(a.out + (size_t)t * DM + xs * 128 + c * 32);
#pragma unroll
  for (int k = 0; k < 8; ++k) { f32x4 x = xr[k]; x.x += acc[2 * k].x; x.y += acc[2 * k].y; x.z += acc[2 * k + 1].x; x.w += acc[2 * k + 1].y; xr[k] = x; ssum += (x.x * x.x + x.y * x.y) + (x.z * x.z + x.w * x.w);
    acc[2 * k] = (f32x2){0.f, 0.f}; acc[2 * k + 1] = (f32x2){0.f, 0.f}; }
}
__device__ __forceinline__ void phase_exp_up2(const Args& a, unsigned char* lds, int wave, int lane) {
  unsigned char* ws = a.ws;
  const int* eidx = (const int*)(ws + WS_EIDX); const float* wgt = (const float*)(ws + WS_W);
  const unsigned char* ups = ws + WS_EXU;
  unsigned* L = (unsigned*)(lds + wave * 16640);
  const int g = lane >> 2, c = lane & 3;
  for (int blk = blockIdx.x; blk < NT / 128; blk += gridDim.x) {
    const int t0 = blk * 128 + wave * 16, t = t0 + g;
    unsigned* H = (unsigned*)(lds + 8 * 16640 + 1024) + wave * 256;
    __builtin_amdgcn_wave_barrier();
    for (int i = lane; i < 256; i += 64) H[i] = 0u;
    __builtin_amdgcn_wave_barrier();
#pragma unroll 4
    for (int tk = 0; tk < 16; ++tk) {
      const size_t o = (size_t)(t0 + tk) * 128;
      const unsigned ea = (unsigned)eidx[o + lane], eb = (unsigned)eidx[o + 64 + lane];
      const unsigned wa = __float_as_uint(wgt[o + lane]), wb = __float_as_uint(wgt[o + 64 + lane]);
      const unsigned ba = ea >> 10, bb = eb >> 10;
      const unsigned ra = atomicAdd(&H[tk * 16 + ba], 1u), rb = atomicAdd(&H[tk * 16 + bb], 1u);
      __builtin_amdgcn_wave_barrier();
      unsigned pa = ra, pb = rb;
#pragma unroll
      for (unsigned b = 0; b < 16; ++b) { const unsigned hb = H[tk * 16 + b]; pa += (b < ba) ? hb : 0u; pb += (b < bb) ? hb : 0u; }
      L[tk * 260 + pa] = ea; L[tk * 260 + 128 + pa] = wa; L[tk * 260 + pb] = eb; L[tk * 260 + 128 + pb] = wb;
    }
    __builtin_amdgcn_wave_barrier();
    const unsigned* Lg = L + g * 260;
    f32x2 acc[16]; float ssum = 0.f;
#pragma unroll
    for (int i = 0; i < 16; ++i) acc[i] = (f32x2){0.f, 0.f};
    UpBuf A, B;
    up2_load(A, ups, Lg, 0, c);
#pragma unroll 1
    for (int ch = 0; ch < 128; ch += 2) {
      up2_load(B, ups, Lg, ch + 1, c);
      up2_math(A, Lg, ch, acc);
      if (ch + 2 < 128) up2_load(A, ups, Lg, ch + 2, c);
      up2_math(B, Lg, ch + 1, acc);
      if ((ch & 15) == 14) up2_slice_end(a, t, ch >> 4, c, acc, ssum);
    }
    ssum += swz_xor<1>(ssum); ssum += swz_xor<2>(ssum);
    const float r2 = rsqrtf(ssum * (1.f / DM) + EPS);
    asm volatile("s_waitcnt vmcnt(0)" ::: "memory");
    __builtin_amdgcn_fence(__ATOMIC_ACQUIRE, "agent");
#pragma unroll 2
    for (int xs = 0; xs < 8; ++xs) {
      f32x4* xr = (f32x4*)(a.out + (size_t)t * DM + xs * 128 + c * 32); const f32x4* gp = (const f32x4*)(a.in[21] + xs * 128 + c * 32);
#pragma unroll
      for (int k = 0; k < 8; ++k) xr[k] = xr[k] * r2 * gp[k];
    }
  }
}

__device__ __forceinline__ void phase_final(const Args& a, int gw, int ngw, int lane) {
  const float* ss = (const float*)(a.ws + WS_SS3);
  for (int r = gw; r < NT; r += ngw) {
    const float r2 = rsqrtf(ss[r] * (1.f / DM) + EPS);
    f32x4* xr = (f32x4*)(a.out + (size_t)r * DM) + lane;
#pragma unroll
    for (int j = 0; j < 4; ++j) { const f32x4 g = ((const f32x4*)a.in[21])[64 * j + lane]; xr[64 * j] = xr[64 * j] * r2 * g; }
  }
}

namespace pg8 {
#define PG8_LAS __attribute__((address_space(3)))
typedef unsigned short bf16_t;
typedef short bf16x8 __attribute__((ext_vector_type(8)));
typedef float f32x4 __attribute__((ext_vector_type(4)));
typedef unsigned u32x4 __attribute__((ext_vector_type(4)));
constexpr int BM = 256, BK = 64, HALF = 128, HTB = HALF * BK * 2  , STAGE_BYTES = 8 * HTB, NXCD = 8, WGM = 8;

__host__ __device__ __forceinline__ int lds_byte(int r, int c) { const int st = (r >> 4) * 2 + (c >> 5), rr = r & 15, cc = c & 31, ob = rr * 64 + cc * 2; return st * 1024 + (ob ^ (((ob >> 9) & 1) << 5)); }
__host__ __device__ __forceinline__ void stage_rc(int b, int& R, int& C) { const int st = b / 1024, sb = b % 1024, swz = sb ^ (((sb >> 9) & 1) << 5); R = (st >> 1) * 16 + swz / 64; C = (st & 1) * 32 + (swz % 64) / 2; }
__host__ __device__ __forceinline__ int perm32(int rho) { const int n = rho >> 4, i = rho & 15; return 8 * (i >> 2) + 4 * n + (i & 3); }

struct Unit { int pm, pn; };
struct Gemm { const bf16_t* A; const bf16_t* Bt; int M, N, K; };

struct StaticOrder {
    int nM, nN, nwg, G, c;
    __host__ __device__ void init(int M, int N, int G_, int c_) { nM = M / BM; nN = N / BM; nwg = nM * nN; G = G_; c = c_; }
    __host__ __device__ bool next(int i, Unit& u) const {
        const long L = (long)i * G + c; if (L >= nwg) return false;
        int wgid = (int)L; { const int q = nwg / NXCD, r = nwg % NXCD, xcd = wgid % NXCD, off = wgid / NXCD; wgid = (xcd < r ? xcd * (q + 1) : r * (q + 1) + (xcd - r) * q) + off; }
        const int nig = WGM * nN, gid = wgid / nig, fm = gid * WGM, gsz = (nM - fm) < WGM ? (nM - fm) : WGM;
        u.pm = fm + ((wgid % nig) % gsz); u.pn = (wgid % nig) / gsz; return true;
    }
    __device__ __forceinline__ void a_ready(const Unit&) const {}
    __device__ __forceinline__ void done(const Unit&) const {}
};

template <class St> struct EpiAdapt8 {
    static constexpr bool PERM = true, AFTER_DRAIN = false; St st;
    __device__ __forceinline__ void operator()(const f32x4 (&acc)[2][2][4][2], const Unit& u, int wr, int wc, int fr, int fq) const {
#pragma unroll
        for (int ai = 0; ai < 2; ++ai)
#pragma unroll
            for (int m = 0; m < 4; ++m)
#pragma unroll
                for (int bj = 0; bj < 2; ++bj) st.store8(u.pm * BM + ai * HALF + wr * 64 + m * 16 + fr, u.pn * BM + bj * HALF + wc * 32 + 8 * fq, acc[ai][bj][m][0], acc[ai][bj][m][1]);
    }
};
template <class St> struct EpiAdapt {
    static constexpr bool PERM = false, AFTER_DRAIN = false; St st;
    __device__ __forceinline__ void operator()(const f32x4 (&acc)[2][2][4][2], const Unit& u, int wr, int wc, int fr, int fq) const {
#pragma unroll
        for (int ai = 0; ai < 2; ++ai)
#pragma unroll
            for (int m = 0; m < 4; ++m)
#pragma unroll
                for (int bj = 0; bj < 2; ++bj)
#pragma unroll
                    for (int n = 0; n < 2; ++n) st.store(u.pm * BM + ai * HALF + wr * 64 + m * 16 + fr, u.pn * BM + bj * HALF + wc * 32 + n * 16 + 4 * fq, acc[ai][bj][m][n]);
    }
};

struct EpiResidSS {
    static constexpr bool PERM = true, AFTER_DRAIN = false; const float* base; float* out; bf16_t* hb; float* ss;
    __device__ __forceinline__ void operator()(const f32x4 (&acc)[2][2][4][2], const Unit& u, int wr, int wc, int fr, int fq) const {
#pragma unroll
        for (int ai = 0; ai < 2; ++ai)
#pragma unroll
            for (int m = 0; m < 4; ++m) {
                const int row = u.pm * BM + ai * HALF + wr * 64 + m * 16 + fr; float s = 0.f;
#pragma unroll
                for (int bj = 0; bj < 2; ++bj) {
                    const size_t o = (size_t)row * 1024 + u.pn * BM + bj * HALF + wc * 32 + 8 * fq;
                    const f32x4 v0 = *(const f32x4*)(base + o) + acc[ai][bj][m][0], v1 = *(const f32x4*)(base + o + 4) + acc[ai][bj][m][1];
                    *(f32x4*)(out + o) = v0; *(f32x4*)(out + o + 4) = v1;
                    { const float f0 = v0.x, f1 = v0.y, f2 = v0.z, f3 = v0.w, f4 = v1.x, f5 = v1.y, f6 = v1.z, f7 = v1.w;
                      *(u32x4*)(hb + o) = (u32x4){::pk2(f0, f1), ::pk2(f2, f3), ::pk2(f4, f5), ::pk2(f6, f7)}; }
                    s += (v0.x * v0.x + v0.y * v0.y) + (v0.z * v0.z + v0.w * v0.w) + (v1.x * v1.x + v1.y * v1.y) + (v1.z * v1.z + v1.w * v1.w);
                }
                s += __shfl_xor(s, 16); s += __shfl_xor(s, 32);
                if (fq == 0) atomicAdd(ss + row, s);
            }
    }
};
template <class Epi, class Sched, bool ALIGN_EPI = false, bool SP2 = false>
__device__ __forceinline__ void gemm_phase(PG8_LAS unsigned char* lds, const Gemm g, const Sched& S, const Epi& E) {
    const int tid = threadIdx.x, wid = __builtin_amdgcn_readfirstlane(tid >> 6), lane = tid & 63, wr = wid >> 2, wc = wid & 3, fr = lane & 15, fq = lane >> 4;
    const int K = g.K, nt = K / BK;
    unsigned voffA[2], voffB[2];
#pragma unroll
    for (int i = 0; i < 2; ++i) { int R, C; stage_rc(tid * 16 + i * 8192, R, C); const int Rb = Epi::PERM ? ((R & ~31) + perm32(R & 31)) : R;
        voffA[i] = (unsigned)(R * K + C) * 2u; voffB[i] = (unsigned)(Rb * K + C) * 2u; }
    const size_t kstep = (size_t)(BK * 2);
    const size_t hstep = (size_t)HALF * K * 2;
    const size_t tstep = 2 * hstep;
    const unsigned ldsw = (unsigned)wid * 1024u;
    const int aoff = lds_byte(wr * 64 + fr, fq * 8), boff = lds_byte(wc * 32 + fr, fq * 8);
#define PG8_SA(b, h) (((b) * 2 + (h)) * HTB)
#define PG8_SB(b, h) ((4 + (b) * 2 + (h)) * HTB)
#define PG8_STAGE(bufoff, gbase, voff) do { _Pragma("unroll") for (int _i = 0; _i < 2; ++_i) \
        __builtin_amdgcn_global_load_lds((const unsigned*)((const char*)(gbase) + (voff)[_i]), (PG8_LAS unsigned*)(lds + (bufoff) + ldsw + _i * 8192), 16, 0, 0); } while (0)
#define PG8_LDA(dst, b, h) do { _Pragma("unroll") for (int m = 0; m < 4; ++m) _Pragma("unroll") for (int k = 0; k < 2; ++k) dst[m][k] = *(const PG8_LAS bf16x8*)(lds + PG8_SA(b, h) + aoff + m * 2048 + k * 1024); } while (0)
#define PG8_LDB(dst, b, h) do { _Pragma("unroll") for (int n = 0; n < 2; ++n) _Pragma("unroll") for (int k = 0; k < 2; ++k) dst[n][k] = *(const PG8_LAS bf16x8*)(lds + PG8_SB(b, h) + boff + n * 2048 + k * 1024); } while (0)
#define PG8_MMA(ai, bj, At, Bt) do { __builtin_amdgcn_s_setprio(1); _Pragma("unroll") for (int m = 0; m < 4; ++m) _Pragma("unroll") for (int n = 0; n < 2; ++n) _Pragma("unroll") for (int k = 0; k < 2; ++k) \
        acc[ai][bj][m][n] = __builtin_amdgcn_mfma_f32_16x16x32_bf16(Bt[n][k], At[m][k], acc[ai][bj][m][n], 0, 0, 0); __builtin_amdgcn_s_setprio(0); } while (0)
#define PG8_WAIT_V(n) asm volatile("s_waitcnt vmcnt(" #n ")" ::: "memory")
#define PG8_WAIT_L(n) asm volatile("s_waitcnt lgkmcnt(" #n ")" ::: "memory")
#define PG8_BAR __builtin_amdgcn_s_barrier()
#define PG8_SCHED __builtin_amdgcn_sched_barrier(0)
    Unit cur, nxt; int ui = 0;
    if (!S.next(0, cur)) return;
    f32x4 acc[2][2][4][2];
#pragma unroll
    for (int a = 0; a < 2; ++a)
#pragma unroll
        for (int b = 0; b < 2; ++b)
#pragma unroll
            for (int m = 0; m < 4; ++m)
#pragma unroll
                for (int n = 0; n < 2; ++n) acc[a][b][m][n] = (f32x4){0.f, 0.f, 0.f, 0.f};
    bf16x8 At[4][2], B0[2][2], B1[2][2];
    const char* cA = (const char*)g.A + (size_t)cur.pm * tstep; const char* cB = (const char*)g.Bt + (size_t)cur.pn * tstep;
    S.a_ready(cur);
    if constexpr (SP2) {
        PG8_STAGE(PG8_SB(0, 0), cB, voffB); PG8_STAGE(PG8_SB(0, 1), cB + hstep, voffB); PG8_STAGE(PG8_SA(0, 0), cA, voffA); PG8_STAGE(PG8_SA(0, 1), cA + hstep, voffA);
        if (wr == 1) PG8_BAR;
        PG8_WAIT_V(2); PG8_BAR;
        PG8_STAGE(PG8_SB(1, 0), cB + kstep, voffB); PG8_STAGE(PG8_SA(1, 0), cA + kstep, voffA); PG8_STAGE(PG8_SB(1, 1), cB + hstep + kstep, voffB);
        PG8_WAIT_V(6); PG8_BAR;
    } else {
        PG8_STAGE(PG8_SB(0, 0), cB, voffB); PG8_STAGE(PG8_SA(0, 0), cA, voffA); PG8_STAGE(PG8_SB(0, 1), cB + hstep, voffB); PG8_STAGE(PG8_SA(0, 1), cA + hstep, voffA);
        if (wr == 1) PG8_BAR;
        PG8_WAIT_V(4); PG8_BAR;
        PG8_STAGE(PG8_SB(1, 0), cB + kstep, voffB); PG8_STAGE(PG8_SA(1, 0), cA + kstep, voffA); PG8_STAGE(PG8_SB(1, 1), cB + hstep + kstep, voffB);
        PG8_WAIT_V(6); PG8_BAR;
    }
    for (;;) {
        const bool has_next = S.next(ui + 1, nxt);
        const char* nA = has_next ? (const char*)g.A + (size_t)nxt.pm * tstep : cA; const char* nB = has_next ? (const char*)g.Bt + (size_t)nxt.pn * tstep : cB;
        for (int t = 0; t < nt; t += 2) {
            const bool last = (t == nt - 2);
            const char* a1 = cA + (size_t)(t + 1) * kstep;
            const char* a2 = last ? nA : cA + (size_t)(t + 2) * kstep; const char* b2 = last ? nB : cB + (size_t)(t + 2) * kstep;
            const char* a3 = a2 + kstep; const char* b3 = b2 + kstep;
            if (last && has_next) S.a_ready(nxt);
            if constexpr (SP2) {
            PG8_LDB(B0, 0, 0); PG8_LDB(B1, 0, 1); PG8_SCHED; PG8_LDA(At, 0, 0); PG8_STAGE(PG8_SA(1, 1), a1 + hstep, voffA);
            PG8_WAIT_V(8); PG8_WAIT_L(0); PG8_BAR; PG8_MMA(0, 0, At, B0); PG8_MMA(0, 1, At, B1); PG8_BAR; PG8_SCHED;
            PG8_LDA(At, 0, 1); PG8_STAGE(PG8_SB(0, 0), b2, voffB); PG8_STAGE(PG8_SB(0, 1), b2 + hstep, voffB); PG8_STAGE(PG8_SA(0, 0), a2, voffA);
            PG8_WAIT_V(8); PG8_WAIT_L(0); PG8_BAR; PG8_MMA(1, 0, At, B0); PG8_MMA(1, 1, At, B1); PG8_BAR; PG8_SCHED;
            PG8_LDB(B0, 1, 0); PG8_LDB(B1, 1, 1); PG8_SCHED; PG8_LDA(At, 1, 0); PG8_STAGE(PG8_SA(0, 1), a2 + hstep, voffA);
            PG8_WAIT_V(8); PG8_WAIT_L(0); PG8_BAR; PG8_MMA(0, 0, At, B0); PG8_MMA(0, 1, At, B1); PG8_BAR; PG8_SCHED;
            PG8_LDA(At, 1, 1); PG8_STAGE(PG8_SB(1, 0), b3, voffB); PG8_STAGE(PG8_SB(1, 1), b3 + hstep, voffB); PG8_STAGE(PG8_SA(1, 0), a3, voffA);
            PG8_WAIT_V(8); PG8_WAIT_L(0); PG8_BAR; PG8_MMA(1, 0, At, B0); PG8_MMA(1, 1, At, B1); PG8_BAR; PG8_SCHED;
            } else {
            PG8_LDB(B0, 0, 0); PG8_SCHED; PG8_LDA(At, 0, 0); PG8_STAGE(PG8_SA(1, 1), a1 + hstep, voffA);
            PG8_WAIT_L(8); PG8_BAR; PG8_WAIT_L(0); PG8_MMA(0, 0, At, B0); PG8_BAR; PG8_SCHED;
            PG8_LDB(B1, 0, 1); PG8_STAGE(PG8_SB(0, 0), b2, voffB);
            PG8_BAR; PG8_WAIT_L(0); PG8_MMA(0, 1, At, B1); PG8_BAR;
            PG8_LDA(At, 0, 1); PG8_STAGE(PG8_SA(0, 0), a2, voffA);
            PG8_BAR; PG8_WAIT_L(0); PG8_MMA(1, 0, At, B0); PG8_BAR; PG8_SCHED;
            PG8_STAGE(PG8_SB(0, 1), b2 + hstep, voffB);
            PG8_WAIT_V(6); PG8_BAR; PG8_MMA(1, 1, At, B1); PG8_BAR;
            PG8_LDB(B0, 1, 0); PG8_SCHED; PG8_LDA(At, 1, 0); PG8_STAGE(PG8_SA(0, 1), a2 + hstep, voffA);
            PG8_WAIT_L(8); PG8_BAR; PG8_WAIT_L(0); PG8_MMA(0, 0, At, B0); PG8_BAR; PG8_SCHED;
            PG8_LDB(B1, 1, 1); PG8_STAGE(PG8_SB(1, 0), b3, voffB);
            PG8_BAR; PG8_WAIT_L(0); PG8_MMA(0, 1, At, B1); PG8_BAR;
            PG8_LDA(At, 1, 1); PG8_STAGE(PG8_SA(1, 0), a3, voffA);
            PG8_BAR; PG8_WAIT_L(0); PG8_MMA(1, 0, At, B0); PG8_BAR; PG8_SCHED;
            PG8_STAGE(PG8_SB(1, 1), b3 + hstep, voffB);
            PG8_WAIT_V(6); PG8_BAR; PG8_MMA(1, 1, At, B1); PG8_BAR;
            }
        }
        if constexpr (ALIGN_EPI) { if (wr == 0) PG8_BAR; }
        if constexpr (!Epi::AFTER_DRAIN) { E(acc, cur, wr, wc, fr, fq); S.done(cur); }
        if (!has_next) break;
#pragma unroll
        for (int a = 0; a < 2; ++a)
#pragma unroll
            for (int b = 0; b < 2; ++b)
#pragma unroll
                for (int m = 0; m < 4; ++m)
#pragma unroll
                    for (int n = 0; n < 2; ++n) acc[a][b][m][n] = (f32x4){0.f, 0.f, 0.f, 0.f};
        cur = nxt; cA = nA; cB = nB; ++ui;
        if constexpr (ALIGN_EPI) { if (wr == 1) PG8_BAR; }
    }
    PG8_WAIT_V(0);
    if constexpr (!ALIGN_EPI) { if (wr == 0) PG8_BAR; }
    PG8_BAR;
    if constexpr (Epi::AFTER_DRAIN) { E.fused(acc, cur, wr, wc, fr, fq, lds, wid, lane); S.done(cur); }
#undef PG8_SA
#undef PG8_SB
#undef PG8_STAGE
#undef PG8_LDA
#undef PG8_LDB
#undef PG8_MMA
#undef PG8_WAIT_V
#undef PG8_WAIT_L
#undef PG8_BAR
#undef PG8_SCHED
}
}


template <class Epi>
__device__ __forceinline__ void run_gemm_raw(unsigned char* lds, const bf16_t* A, const bf16_t* Bt, int M, int N, int K, const Epi& E) {
  pg8::Gemm g{A, Bt, M, N, K}; pg8::StaticOrder S; S.init(M, N, (int)gridDim.x, (int)blockIdx.x);
  pg8::gemm_phase<Epi, pg8::StaticOrder, true, true>((PG8_LAS unsigned char*)lds, g, S, E);
}
template <class St>
__device__ __forceinline__ void run_gemm8(unsigned char* lds, const bf16_t* A, const bf16_t* Bt, int M, int N, int K, const St& st) {
  pg8::Gemm g{A, Bt, M, N, K}; pg8::StaticOrder S; S.init(M, N, (int)gridDim.x, (int)blockIdx.x);
  pg8::EpiAdapt8<St> E{st};
  pg8::gemm_phase<pg8::EpiAdapt8<St>, pg8::StaticOrder, true, true>((PG8_LAS unsigned char*)lds, g, S, E);
}
template <class St>
__device__ __forceinline__ void run_gemm(unsigned char* lds, const bf16_t* A, const bf16_t* Bt, int M, int N, int K, const St& st, int gw, int ngw, int lane) {
#if USE_PG8
  pg8::Gemm g{A, Bt, M, N, K}; pg8::StaticOrder S; S.init(M, N, (int)gridDim.x, (int)blockIdx.x);
  pg8::EpiAdapt<St> E{st};
  pg8::gemm_phase<pg8::EpiAdapt<St>, pg8::StaticOrder, true, true>((PG8_LAS unsigned char*)lds, g, S, E);
#else
  gemm_naive(A, K, Bt, K, M, N, K, st, gw, ngw, lane);
#endif
}

#define GAS __attribute__((address_space(1)))
#define LAS __attribute__((address_space(3)))
#define XB_TMO      128
#define XB_XCNT(j)  (256  + 64 * (j))
#define XB_XSUB(j)  (1280 + 64 * (j))
#define XB_XGEN(j)  (2304 + 64 * (j))
#define XB_TOP      3328
#define XB_TOPGEN   3392
#define XCD_BAR_WORDS 3456
#define XB_SPIN_CAP (1u << 18)

__device__ __forceinline__ unsigned xb_ld(unsigned* p)              { return __hip_atomic_load(p, __ATOMIC_RELAXED, __HIP_MEMORY_SCOPE_AGENT); }
__device__ __forceinline__ unsigned xb_add(unsigned* p, unsigned v) { return __hip_atomic_fetch_add(p, v, __ATOMIC_RELAXED, __HIP_MEMORY_SCOPE_AGENT); }
__device__ __forceinline__ unsigned xb_xcc_id() { return (unsigned)__builtin_amdgcn_s_getreg((3 << 11) | 20) & 0xFu; }
#define XB_SPIN(cond, bar) do { unsigned _sp = 0; while (cond) { __builtin_amdgcn_s_sleep(1); \
    if ((++_sp & 255u) == 0u) { if (xb_ld(&(bar)[XB_TMO])) break; if (_sp > XB_SPIN_CAP) { atomicAdd(&(bar)[XB_TMO], 1u); break; } } } } while (0)

struct XcdBarrier {
    unsigned* bar; unsigned x;
    volatile LAS unsigned* st;
};

__device__ __forceinline__ XcdBarrier xcd_barrier_post(unsigned* bar, volatile LAS unsigned* st) {
    XcdBarrier b; b.bar = bar; b.x = xb_xcc_id(); b.st = st;
    if (threadIdx.x == 0) (void)xb_add(&bar[XB_XCNT(b.x)], 1u);
    return b;
}
__device__ __forceinline__ void xcd_barrier_complete(unsigned* bar, unsigned x, unsigned& nloc, unsigned& nx) {
    const unsigned G = gridDim.x * gridDim.y * gridDim.z;
    unsigned sum, cnt, mine, sp = 0u;
    for (;;) {
        sum = 0u; cnt = 0u; mine = 0u;
#pragma unroll
        for (unsigned j = 0; j < 16; ++j) { const unsigned c = xb_ld(&bar[XB_XCNT(j)]); sum += c; cnt += (c > 0u) ? 1u : 0u; mine = (j == x) ? c : mine; }
        if (sum == G) break;
        __builtin_amdgcn_s_sleep(1);
        if ((++sp & 255u) == 0u) { if (xb_ld(&bar[XB_TMO])) break; if (sp > XB_SPIN_CAP) { atomicAdd(&bar[XB_TMO], 1u); break; } }
    }
    nloc = mine > 0u ? mine : 1u; nx = cnt > 0u ? cnt : 1u;
}

__device__ __forceinline__ void xcd_barrier(const XcdBarrier& b) {
    asm volatile("s_waitcnt vmcnt(0)" ::: "memory");
    __syncthreads();
    if (threadIdx.x == 0) {
        unsigned* bar = b.bar;
        __builtin_amdgcn_s_waitcnt(0);
        unsigned nloc = b.st[0], nx = b.st[1];
        if (nloc == 0u) { xcd_barrier_complete(bar, b.x, nloc, nx); b.st[0] = nloc; b.st[1] = nx; }
        const unsigned old = xb_add(&bar[XB_XSUB(b.x)], 1u);
        const unsigned gen = old / nloc;
        if (old + 1u == (gen + 1u) * nloc) {
            __builtin_amdgcn_fence(__ATOMIC_RELEASE, "agent");
            asm volatile("s_waitcnt vmcnt(0)" ::: "memory");
            const unsigned og = xb_add(&bar[XB_TOP], 1u);
            const unsigned tg = og / nx;
            if (og + 1u == (tg + 1u) * nx) xb_add(&bar[XB_TOPGEN], 1u);
            else XB_SPIN(xb_ld(&bar[XB_TOPGEN]) == tg, bar);
            __builtin_amdgcn_fence(__ATOMIC_ACQUIRE, "agent");
            xb_add(&bar[XB_XGEN(b.x)], 1u);
            asm volatile("s_waitcnt vmcnt(0)" ::: "memory");
        } else {
            XB_SPIN(xb_ld(&bar[XB_XGEN(b.x)]) == gen, bar);
            __builtin_amdgcn_fence(__ATOMIC_ACQUIRE, "agent");
            asm volatile("s_waitcnt vmcnt(0)" ::: "memory");
        }
    }
    __syncthreads();
}

__device__ __forceinline__ void phase_exp_up(const Args& a, unsigned char* lds, const XcdBarrier& bar, int tid, int wave, int lane, unsigned* ctr, float* xout, float* ssout) {
  unsigned* slot = (unsigned*)(lds + 8 * 16640);
  const int x0 = (int)(xb_xcc_id() & 7u);
  for (int k = 0; k < 8; ++k) {
    const int xs = (x0 + k) & 7;
    for (;;) {
      __syncthreads();
      if (tid == 0) slot[0] = atomicAdd(ctr + 16 * xs, 1u);
      __syncthreads();
      const unsigned item = slot[0];
      if (item >= (unsigned)(NT / 128)) break;
      exp_up_item(a, lds, xs, (int)item, wave, lane, xout, ssout);
    }
  }
}

__global__ void __launch_bounds__(512, 2) mega(Args a) {
  extern __shared__ __attribute__((aligned(16))) unsigned char lds[];
  cg::grid_group grid = cg::this_grid();
  const int tid = threadIdx.x, lane = tid & 63, wave = tid >> 6;
  const int gw = blockIdx.x * 8 + wave, ngw = gridDim.x * 8;
  unsigned char* ws = a.ws;
  const int lo = a.ph_lo, hi = a.ph_hi;
#define IN(k) (lo <= (k) && (k) < hi)
  volatile LAS unsigned* MISC = (volatile LAS unsigned*)((LAS unsigned char*)lds + 146944);
  if (tid < 32) MISC[tid] = 0u;
  __syncthreads();
  XcdBarrier bar; bar.bar = (unsigned*)(ws + WS_BAR); bar.x = 0; bar.st = nullptr;
  if (hi - lo > 1) bar = xcd_barrier_post((unsigned*)(ws + WS_BAR), MISC + 8);
  if (lo < -1000000) grid.sync();
#define SEAM(k) do { if (IN(k) && IN((k) + 1)) xcd_barrier(bar); } while (0)
#if PROBE_REP == 0
  if (IN(0)) { phase_prep(a, lds, gw, ngw, wave, lane, tid); grid.sync(); }
#endif
  if (IN(0)) { phase_prep(a, lds, gw, ngw, wave, lane, tid); } SEAM(0);
#if PROBE_REP == 1
  if (IN(1)) {
    run_gemm8(lds, (const bf16_t*)(ws + WS_HB), (const bf16_t*)(ws + WS_WIN_T), NT, NQKV, DM, EpiQKV{(bf16_t*)(ws + WS_QKV)});
    run_gemm8(lds, (const bf16_t*)(ws + WS_MEMN), (const bf16_t*)(ws + WS_WXKV_T), NMROWS, 2048, DM, EpiBf16{(bf16_t*)(ws + WS_KX), 2048});
    xcd_barrier(bar); }
#endif
#if PROBE_REP == 2
  if (IN(2)) { phase_scan(a, gw, ngw, lane, tid); xcd_barrier(bar); phase_rms(a, gw, ngw, lane); xcd_barrier(bar); phase_rms(a, gw, ngw, lane); xcd_barrier(bar); }
#endif
  if (IN(1)) {
    run_gemm8(lds, (const bf16_t*)(ws + WS_HB), (const bf16_t*)(ws + WS_WIN_T), NT, NQKV, DM, EpiQKV{(bf16_t*)(ws + WS_QKV)});
    run_gemm8(lds, (const bf16_t*)(ws + WS_MEMN), (const bf16_t*)(ws + WS_WXKV_T), NMROWS, 2048, DM, EpiBf16{(bf16_t*)(ws + WS_KX), 2048});
  } SEAM(1);
  if (IN(2)) { for (int rep = 0; rep < a.rep_scan; ++rep) { phase_scan(a, gw, ngw, lane, tid); if (rep + 1 < a.rep_scan) xcd_barrier(bar); } } SEAM(2);
#if PROBE_REP == 3
  if (IN(3)) { phase_attn2(a, lds, tid); xcd_barrier(bar); if (blockIdx.x == 0 && tid == 0) *(unsigned*)(ws) = 0u; xcd_barrier(bar); }
#endif
  if (IN(3)) {
#if USE_ATT2
    phase_attn2(a, lds, tid);
#else
    phase_attn(a, lds, tid);
#endif
  } SEAM(3);
  if (IN(4)) { phase_onorm(a, gw, ngw, lane); } SEAM(4);
  if (IN(5)) { run_gemm_raw(lds, (const bf16_t*)(ws + WS_OAB), (const bf16_t*)(ws + WS_WOUT_T), NT, DM, DM, pg8::EpiResidSS{a.in[0], a.out, (bf16_t*)(ws + WS_HB), (float*)(ws + WS_SS1)}); }
  if (IN(5) && IN(7)) xcd_barrier(bar);
  if (IN(7)) { run_gemm8(lds, (const bf16_t*)(ws + WS_HB), (const bf16_t*)(ws + WS_WXQ_T), NT, DM, DM, EpiBf16S{(bf16_t*)(ws + WS_QX), DM, (const float*)(ws + WS_SS1)}); } SEAM(7);
#if PROBE_REP == 8
  if (IN(8)) { phase_xattn(a, lds, gw, ngw, wave, lane); grid.sync(); }
#endif
  if (IN(8)) { phase_xattn2(a, lds, tid); } SEAM(8);
  if (IN(9)) { run_gemm_raw(lds, (const bf16_t*)(ws + WS_OX), (const bf16_t*)(ws + WS_WXO_T), NT, DM, DM, pg8::EpiResidSS{a.out, a.out, (bf16_t*)(ws + WS_HB), (float*)(ws + WS_SS2)}); }
  if (IN(9) && IN(11)) xcd_barrier(bar);
  if (IN(11)) { run_gemm8(lds, (const bf16_t*)(ws + WS_HB), (const bf16_t*)(ws + WS_WPQ_T), NT, DM, DM, EpiBf16S{(bf16_t*)(ws + WS_PQ), DM, (const float*)(ws + WS_SS2)}); } SEAM(11);
#if PROBE_REP == 12
  if (IN(12)) { phase_topk(a, lds, tid); grid.sync(); }
#endif
  if (IN(12)) { phase_topk2(a, lds, wave, lane); } SEAM(12);
    if (IN(13)) {
    for (int rep = 0; rep < a.rep_down; ++rep) { phase_exp_down(a, gw, ngw, lane); if (hi - lo > 1) xcd_barrier(bar); }
    phase_exp_up2(a, lds, wave, lane);
  }
#undef IN
#undef SEAM
}

extern "C" void kernel_launch(void* const* d_in, const int* in_sizes, int n_in, void* d_out, int out_size, void* d_ws, size_t ws_size, hipStream_t stream) {
  static int grid = 0;
  if (grid == 0) {
    if (n_in != 22 || out_size != NT * DM || ws_size < WS_END) { fprintf(stderr, "kernel_launch: unexpected shapes (n_in %d out %d ws %zu)\n", n_in, out_size, ws_size); grid = -1; return; }
    int dev = 0, cus = 0, per_cu = 0;
    (void)hipGetDevice(&dev);
    (void)hipDeviceGetAttribute(&cus, hipDeviceAttributeMultiprocessorCount, dev);
    (void)hipFuncSetAttribute((const void*)mega, hipFuncAttributeMaxDynamicSharedMemorySize, LDS_BYTES);
    (void)hipOccupancyMaxActiveBlocksPerMultiprocessor(&per_cu, (const void*)mega, 512, LDS_BYTES);
    if (per_cu < 1) per_cu = 1;
    grid = cus * per_cu;
  }
  if (grid < 0) return;
  (void)hipMemsetAsync(d_ws, 0, CTL_ZERO_BYTES, stream);
  Args a{};
  for (int i = 0; i < 22; ++i) a.in[i] = (const float*)d_in[i];
  a.out = (float*)d_out; a.ws = (unsigned char*)d_ws;
  a.rep_down = REP_DOWN; a.rep_up = REP_UP; a.rep_scan = REP_SCAN;
#if MK_N_LAUNCHES == 1
  a.ph_lo = 0; a.ph_hi = NPHASE + 1;
  void* args[] = {&a};
  hipError_t e = hipLaunchCooperativeKernel((const void*)mega, dim3(grid), dim3(512), args, LDS_BYTES, stream);
  if (e != hipSuccess) fprintf(stderr, "cooperative launch failed: %s (grid %d)\n", hipGetErrorString(e), grid);
#else
  for (int p = 0; p <= NPHASE; ++p) { a.ph_lo = p; a.ph_hi = p + 1; hipLaunchKernelGGL(mega, dim3(grid), dim3(512), LDS_BYTES, stream, a); }
#endif
}
```

```cpp
#include <hip/hip_runtime.h>
#include <hip/hip_cooperative_groups.h>
#include <cstdio>
#include <cstdint>
namespace cg = cooperative_groups;

#ifndef USE_PG8
#define USE_PG8 1
#endif
#ifndef USE_ATT2
#define USE_ATT2 1
#endif
#ifndef PROBE_REP
#define PROBE_REP -1
#endif
#ifndef REP_DOWN
#define REP_DOWN 1
#endif
#ifndef REP_UP
#define REP_UP 1
#endif
#ifndef REP_SCAN
#define REP_SCAN 1
#endif
#ifndef MK_N_LAUNCHES
#define MK_N_LAUNCHES 1
#endif

typedef unsigned short bf16_t;
typedef short bf16x8 __attribute__((ext_vector_type(8)));
typedef float f32x4 __attribute__((ext_vector_type(4)));
typedef unsigned u32x4 __attribute__((ext_vector_type(4)));
typedef unsigned u32x2 __attribute__((ext_vector_type(2)));
typedef float v32f __attribute__((ext_vector_type(32)));
typedef float v16f __attribute__((ext_vector_type(16)));
typedef unsigned v6u __attribute__((ext_vector_type(6)));
typedef float f32x2 __attribute__((ext_vector_type(2)));

constexpr int NB = 8, SEQ = 4096, DM = 1024, NT = NB * SEQ;
constexpr int NQKV = 3072, INW = 3080;
constexpr int NMEM = 256, NMROWS = NB * NMEM;
constexpr int NEXP = 16384;
constexpr float EPS = 1e-6f;
constexpr int NPHASE = 13;
constexpr int LDS_BYTES = 147456;

constexpr size_t MiB = 1u << 20;
constexpr size_t WS_BAR = 65536;
constexpr size_t WS_SS1 = 131072;
constexpr size_t WS_SS2 = 262144;
constexpr size_t WS_SS3 = 393216;
constexpr size_t WS_XCTR = 512;
constexpr size_t CTL_ZERO_BYTES = 524288;
constexpr size_t WS_WIN_T = 2 * MiB;
constexpr size_t WS_WOUT_T = 8 * MiB;
constexpr size_t WS_WXQ_T = 10 * MiB;
constexpr size_t WS_WXKV_T = 12 * MiB;
constexpr size_t WS_WXO_T = 16 * MiB;
constexpr size_t WS_WPQ_T = 18 * MiB;
constexpr size_t WS_SK = 21 * MiB;
constexpr size_t WS_MEMN = 22 * MiB;
constexpr size_t WS_KX = 26 * MiB;
constexpr size_t WS_VXT = 30 * MiB;
constexpr size_t WS_FLOG = 34 * MiB;
constexpr size_t WS_CUM = 35 * MiB;
constexpr size_t WS_KMEAN = 36 * MiB;
constexpr size_t WS_ESC = 38 * MiB;
constexpr size_t WS_EXD = 40 * MiB;
constexpr size_t WS_EXU = 72 * MiB;
constexpr size_t WS_HB = 104 * MiB;
constexpr size_t WS_QKV = 168 * MiB;
constexpr size_t WS_OAB = 360 * MiB;
constexpr size_t WS_QX = 168 * MiB;
constexpr size_t WS_OX = 232 * MiB;
constexpr size_t WS_PQ = 232 * MiB;
constexpr size_t WS_EIDX = 424 * MiB;
constexpr size_t WS_GATE = 440 * MiB;
constexpr size_t WS_W = 456 * MiB;
constexpr size_t WS_END = 472 * MiB;

struct Args {
  const float* in[22];
  float* out;
  unsigned char* ws;
  int ph_lo, ph_hi;
  int rep_down, rep_up, rep_scan, pad_;
};

struct XcdBarrier;
__device__ __forceinline__ unsigned f2bf(float f) { unsigned u = __float_as_uint(f); return (u + 0x7fffu + ((u >> 16) & 1u)) >> 16; }
__device__ __forceinline__ unsigned pk2(float lo, float hi) { return f2bf(lo) | (f2bf(hi) << 16); }
__device__ __forceinline__ float bf2f(unsigned short b) { return __uint_as_float(((unsigned)b) << 16); }
__device__ __forceinline__ float bflo(unsigned w) { return __uint_as_float(w << 16); }
__device__ __forceinline__ float bfhi(unsigned w) { return __uint_as_float(w & 0xffff0000u); }
__device__ __forceinline__ float wave_sum(float v) {
#pragma unroll
  for (int o = 1; o < 64; o <<= 1) v += __shfl_xor(v, o);
  return v;
}
template <int O> __device__ __forceinline__ float swz_xor(float v) { return __int_as_float(__builtin_amdgcn_ds_swizzle(__float_as_int(v), (O << 10) | 0x1f)); }
__device__ __forceinline__ float half_sum32(float v) { v += swz_xor<1>(v); v += swz_xor<2>(v); v += swz_xor<4>(v); v += swz_xor<8>(v); v += swz_xor<16>(v); return v; }
__device__ __forceinline__ void unpack8(const u32x4 w, float* f) {
  f[0] = bflo(w.x); f[1] = bfhi(w.x); f[2] = bflo(w.y); f[3] = bfhi(w.y);
  f[4] = bflo(w.z); f[5] = bfhi(w.z); f[6] = bflo(w.w); f[7] = bfhi(w.w);
}

__device__ const unsigned char T5_BUCKET[128] = {
  0, 1, 2, 3, 4, 5, 6, 7, 8, 9, 10, 11, 12, 13, 14, 15, 16, 16, 16, 17, 17, 18, 18, 18, 19, 19, 19, 20, 20, 20, 20, 21,
  21, 21, 21, 22, 22, 22, 22, 22, 23, 23, 23, 23, 23, 23, 24, 24, 24, 24, 24, 24, 25, 25, 25, 25, 25, 25, 25, 26, 26, 26, 26, 26,
  26, 26, 26, 27, 27, 27, 27, 27, 27, 27, 27, 27, 27, 28, 28, 28, 28, 28, 28, 28, 28, 28, 28, 29, 29, 29, 29, 29, 29, 29, 29, 29,
  29, 29, 29, 30, 30, 30, 30, 30, 30, 30, 30, 30, 30, 30, 30, 30, 30, 31, 31, 31, 31, 31, 31, 31, 31, 31, 31, 31, 31, 31, 31, 31};

__device__ __forceinline__ void transpose_item(const float* W, int ldw, const float* gain, bf16_t* WT, int K, int row_off, float* scr, int kb, int nb, int lane) {
  const int k0 = 64 * kb, n0 = 32 * nb;
#pragma unroll 8
  for (int i = 0; i < 32; ++i) {
    const int kk = 2 * i + (lane >> 5);
    const float g = gain ? gain[k0 + kk] : 1.f;
    scr[kk * 33 + (lane & 31)] = W[(size_t)(k0 + kk) * ldw + n0 + (lane & 31)] * g;
  }
  __builtin_amdgcn_wave_barrier();
  const int c = lane & 7;
#pragma unroll
  for (int j = 0; j < 4; ++j) {
    const int n = (lane >> 3) + 8 * j; const float* s = scr + (8 * c) * 33 + n;
    u32x4 o; o.x = pk2(s[0 * 33], s[1 * 33]); o.y = pk2(s[2 * 33], s[3 * 33]); o.z = pk2(s[4 * 33], s[5 * 33]); o.w = pk2(s[6 * 33], s[7 * 33]);
    *(u32x4*)(WT + (size_t)(row_off + n0 + n) * K + k0 + 8 * c) = o;
  }
  __builtin_amdgcn_wave_barrier();
}

__device__ __forceinline__ void rms_row_to_bf16(const float* xrow, bf16_t* orow, int lane) {
  const f32x4* xr = (const f32x4*)xrow + lane;
  f32x4 v[4]; float s = 0.f;
#pragma unroll
  for (int j = 0; j < 4; ++j) { v[j] = xr[64 * j]; s += (v[j].x * v[j].x + v[j].y * v[j].y) + (v[j].z * v[j].z + v[j].w * v[j].w); }
  const float rstd = rsqrtf(wave_sum(s) * (1.f / DM) + EPS);
  u32x2* o = (u32x2*)orow + lane;
#pragma unroll
  for (int j = 0; j < 4; ++j) { u32x2 w; w.x = pk2(v[j].x * rstd, v[j].y * rstd); w.y = pk2(v[j].z * rstd, v[j].w * rstd); o[64 * j] = w; }
}

__device__ __forceinline__ void phase_prep(const Args& a, unsigned char* lds, int gw, int ngw, int wave, int lane, int tid) {
  unsigned char* ws = a.ws;
  float* scr = (float*)(lds + wave * 8448);
  const int I_IN = 16 * 96, I_SQ = 16 * 32;
  const int NITEMS = I_IN + 6 * I_SQ;
  for (int it = gw; it < NITEMS; it += ngw) {
    int r = it;
    if (r < I_IN) { transpose_item(a.in[3], INW, a.in[2], (bf16_t*)(ws + WS_WIN_T), DM, 0, scr, r / 96, r % 96, lane); continue; } r -= I_IN;
    const int which = r / I_SQ; r %= I_SQ; const int kb = r / 32, nb = r % 32;
    if (which == 0) { const float* g = (kb < 8) ? a.in[6] : (a.in[7] - 512); transpose_item(a.in[8], DM, g, (bf16_t*)(ws + WS_WOUT_T), DM, 0, scr, kb, nb, lane); }
    else if (which == 1) transpose_item(a.in[11], DM, a.in[9], (bf16_t*)(ws + WS_WXQ_T), DM, 0, scr, kb, nb, lane);
    else if (which == 2) transpose_item(a.in[12], DM, a.in[10], (bf16_t*)(ws + WS_WXKV_T), DM, 0, scr, kb, nb, lane);
    else if (which == 3) transpose_item(a.in[13], DM, a.in[10], (bf16_t*)(ws + WS_WXKV_T), DM, 1024, scr, kb, nb, lane);
    else if (which == 4) transpose_item(a.in[14], DM, nullptr, (bf16_t*)(ws + WS_WXO_T), DM, 0, scr, kb, nb, lane);
    else transpose_item(a.in[16], DM, a.in[15], (bf16_t*)(ws + WS_WPQ_T), DM, 0, scr, kb, nb, lane);
  }
  for (int it = gw; it < NEXP; it += ngw) {
    const int hi = lane >> 5, l32 = lane & 31; const int r = 2 * it + hi;
    const int tb = r >= NEXP, e = r - tb * NEXP;
    const f32x4* src = (const f32x4*)(a.in[19 + tb] + (size_t)e * DM) + 8 * l32;
    v16f xa, xb; float am = 0.f;
#pragma unroll
    for (int k = 0; k < 4; ++k) { const f32x4 p = src[k], q = src[4 + k];
      xa[2 * k] = p.x; xb[2 * k] = p.y; xa[2 * k + 1] = p.z; xb[2 * k + 1] = p.w; xa[8 + 2 * k] = q.x; xb[8 + 2 * k] = q.y; xa[8 + 2 * k + 1] = q.z; xb[8 + 2 * k + 1] = q.w;
      am = fmaxf(am, fmaxf(fmaxf(fabsf(p.x), fabsf(p.y)), fmaxf(fabsf(p.z), fabsf(p.w)))); am = fmaxf(am, fmaxf(fmaxf(fabsf(q.x), fabsf(q.y)), fmaxf(fabsf(q.z), fabsf(q.w)))); }
#pragma unroll
    for (int o = 1; o < 32; o <<= 1) am = fmaxf(am, __shfl_xor(am, o));
    if (tb == 0) {
      const float sc = am > 0.f ? 7.0f / am : 1.f;
      xa = xa * sc; xb = xb * sc;
      const v6u w = __builtin_amdgcn_cvt_scalef32_2xpk16_fp6_f32(xa, xb, 1.0f);
      u32x2* dst = (u32x2*)(ws + WS_EXD + (size_t)e * 768 + 24 * l32);
      dst[0] = (u32x2){w[0], w[1]}; dst[1] = (u32x2){w[2], w[3]}; dst[2] = (u32x2){w[4], w[5]};
      if (l32 == 0) ((float*)(ws + WS_ESC))[r] = am > 0.f ? am / 7.0f : 1.f;
    } else {
      const float sc = am > 0.f ? 440.f / am : 1.f;
      u32x4 o0, o1;
#pragma unroll
      for (int k = 0; k < 4; ++k) { int w = __builtin_amdgcn_cvt_pk_fp8_f32(xa[2 * k] * sc, xb[2 * k] * sc, 0, false); w = __builtin_amdgcn_cvt_pk_fp8_f32(xa[2 * k + 1] * sc, xb[2 * k + 1] * sc, w, true); o0[k] = (unsigned)w; }
#pragma unroll
      for (int k = 0; k < 4; ++k) { int w = __builtin_amdgcn_cvt_pk_fp8_f32(xa[8 + 2 * k] * sc, xb[8 + 2 * k] * sc, 0, false); w = __builtin_amdgcn_cvt_pk_fp8_f32(xa[8 + 2 * k + 1] * sc, xb[8 + 2 * k + 1] * sc, w, true); o1[k] = (unsigned)w; }
      u32x4* dst = (u32x4*)(ws + WS_EXU + (size_t)(l32 >> 2) * (NEXP * 128) + (size_t)e * 128 + 32 * (l32 & 3));
      dst[0] = o0; dst[1] = o1;
      if (l32 == 0) ((float*)(ws + WS_ESC))[r] = am > 0.f ? am / 440.f : 1.f;
    }
  }
  for (int i = blockIdx.x * 512 + tid; i < 2 * 65536; i += gridDim.x * 512) ((bf16_t*)(ws + WS_SK))[i] = (bf16_t)f2bf(a.in[17 + (i >> 16)][i & 65535]);
  for (int r = gw; r < NMROWS; r += ngw) rms_row_to_bf16(a.in[1] + (size_t)r * DM, (bf16_t*)(ws + WS_MEMN) + (size_t)r * DM, lane);
  __syncthreads();
  float* wf = (float*)(lds + 69632);
  for (int k = tid; k < DM; k += 512) {
    const float g = a.in[2][k]; const f32x4* wp = (const f32x4*)(a.in[3] + (size_t)k * INW + NQKV);
    const f32x4 p = wp[0], q = wp[1];
    wf[k] = p.x * g; wf[1024 + k] = p.y * g; wf[2048 + k] = p.z * g; wf[3072 + k] = p.w * g; wf[4096 + k] = q.x * g; wf[5120 + k] = q.y * g; wf[6144 + k] = q.z * g; wf[7168 + k] = q.w * g;
  }
  __syncthreads();
  float* flog = (float*)(ws + WS_FLOG);
  for (int r = gw; r < NT; r += ngw) {
    const f32x4* xr = (const f32x4*)(a.in[0] + (size_t)r * DM) + lane;
    f32x4 v[4]; float s = 0.f; float fa[8];
#pragma unroll
    for (int j = 0; j < 8; ++j) fa[j] = 0.f;
#pragma unroll
    for (int j = 0; j < 4; ++j) {
      v[j] = xr[64 * j]; s += (v[j].x * v[j].x + v[j].y * v[j].y) + (v[j].z * v[j].z + v[j].w * v[j].w);
#pragma unroll
      for (int jj = 0; jj < 8; ++jj) { const f32x4 w4 = *(const f32x4*)(wf + jj * 1024 + 256 * j + 4 * lane); fa[jj] += (v[j].x * w4.x + v[j].y * w4.y) + (v[j].z * w4.z + v[j].w * w4.w); }
    }
    const float rstd = rsqrtf(wave_sum(s) * (1.f / DM) + EPS);
    float mine = 0.f;
#pragma unroll
    for (int j = 0; j < 8; ++j) { const float t = wave_sum(fa[j]); if (lane == j) mine = t; }
    if (lane < 8) {
      const float z = mine * rstd + a.in[4][lane];
      flog[(size_t)lane * NT + r] = fminf(z, 0.f) - log1pf(expf(-fabsf(z)));
    }
    u32x2* o = (u32x2*)((bf16_t*)(ws + WS_HB) + (size_t)r * DM) + lane;
#pragma unroll
    for (int j = 0; j < 4; ++j) { u32x2 w; w.x = pk2(v[j].x * rstd, v[j].y * rstd); w.y = pk2(v[j].z * rstd, v[j].w * rstd); o[64 * j] = w; }
  }
}

template <class Epi>
__device__ __forceinline__ void gemm_naive(const bf16_t* A, int lda, const bf16_t* Bt, int ldb, int M, int N, int K, const Epi& E, int gw, int ngw, int lane) {
  const int fr = lane & 15, fq = lane >> 4;
  const int tn = N / 64, ntile = (M / 64) * tn;
  for (int tile = gw; tile < ntile; tile += ngw) {
    const int pm = tile / tn, pn = tile % tn;
    f32x4 acc[4][4];
#pragma unroll
    for (int m = 0; m < 4; ++m)
#pragma unroll
      for (int n = 0; n < 4; ++n) acc[m][n] = (f32x4){0.f, 0.f, 0.f, 0.f};
    const bf16_t* Ap = A + (size_t)(pm * 64 + fr) * lda + fq * 8;
    const bf16_t* Bp = Bt + (size_t)(pn * 64 + fr) * ldb + fq * 8;
    for (int k0 = 0; k0 < K; k0 += 32) {
      bf16x8 af[4], bfr[4];
#pragma unroll
      for (int m = 0; m < 4; ++m) af[m] = *(const bf16x8*)(Ap + (size_t)m * 16 * lda + k0);
#pragma unroll
      for (int n = 0; n < 4; ++n) bfr[n] = *(const bf16x8*)(Bp + (size_t)n * 16 * ldb + k0);
#pragma unroll
      for (int m = 0; m < 4; ++m)
#pragma unroll
        for (int n = 0; n < 4; ++n) acc[m][n] = __builtin_amdgcn_mfma_f32_16x16x32_bf16(bfr[n], af[m], acc[m][n], 0, 0, 0);
    }
#pragma unroll
    for (int m = 0; m < 4; ++m)
#pragma unroll
      for (int n = 0; n < 4; ++n) E.store(pm * 64 + m * 16 + fr, pn * 64 + n * 16 + 4 * fq, acc[m][n]);
  }
}

struct EpiBf16 { bf16_t* O; int ldo;
  __device__ __forceinline__ void store8(int row, int col, f32x4 a, f32x4 b) const { u32x4 w; w.x = pk2(a.x, a.y); w.y = pk2(a.z, a.w); w.z = pk2(b.x, b.y); w.w = pk2(b.z, b.w); *(u32x4*)(O + (size_t)row * ldo + col) = w; }
  __device__ __forceinline__ void store(int row, int col, f32x4 v) const { u32x2 w; w.x = pk2(v.x, v.y); w.y = pk2(v.z, v.w); *(u32x2*)(O + (size_t)row * ldo + col) = w; } };
struct EpiQKV { bf16_t* O;
  __device__ __forceinline__ void store8(int row, int col, f32x4 a, f32x4 b) const { const float sc = (col < 512 || (col >= 1536 && col < 2048)) ? 0.18033688011112042f : 1.f;
    u32x4 w; w.x = pk2(a.x * sc, a.y * sc); w.y = pk2(a.z * sc, a.w * sc); w.z = pk2(b.x * sc, b.y * sc); w.w = pk2(b.z * sc, b.w * sc); *(u32x4*)(O + (size_t)row * NQKV + col) = w; }
  __device__ __forceinline__ void store(int row, int col, f32x4 v) const { const float sc = (col < 512 || (col >= 1536 && col < 2048)) ? 0.18033688011112042f : 1.f;
    u32x2 w; w.x = pk2(v.x * sc, v.y * sc); w.y = pk2(v.z * sc, v.w * sc); *(u32x2*)(O + (size_t)row * NQKV + col) = w; } };
struct EpiBf16S { bf16_t* O; int ldo; const float* ss;
  __device__ __forceinline__ void store8(int row, int col, f32x4 a, f32x4 b) const { const float r = rsqrtf(ss[row] * (1.f / DM) + EPS);
    u32x4 w; w.x = pk2(a.x * r, a.y * r); w.y = pk2(a.z * r, a.w * r); w.z = pk2(b.x * r, b.y * r); w.w = pk2(b.z * r, b.w * r); *(u32x4*)(O + (size_t)row * ldo + col) = w; }
  __device__ __forceinline__ void store(int row, int col, f32x4 v) const { const float r = rsqrtf(ss[row] * (1.f / DM) + EPS); u32x2 w; w.x = pk2(v.x * r, v.y * r); w.y = pk2(v.z * r, v.w * r); *(u32x2*)(O + (size_t)row * ldo + col) = w; } };
struct EpiF32S { float* O; int ldo; const float* ss;
  __device__ __forceinline__ void store(int row, int col, f32x4 v) const { const float r = rsqrtf(ss[row] * (1.f / DM) + EPS); *(f32x4*)(O + (size_t)row * ldo + col) = v * r; } };
struct EpiF32 { float* O; int ldo;
  __device__ __forceinline__ void store(int row, int col, f32x4 v) const { *(f32x4*)(O + (size_t)row * ldo + col) = v; } };
struct EpiResid { const float* base; float* out;
  __device__ __forceinline__ void store(int row, int col, f32x4 v) const { const size_t o = (size_t)row * DM + col; const f32x4 b = *(const f32x4*)(base + o); *(f32x4*)(out + o) = b + v; } };
struct EpiKV { bf16_t* KX; bf16_t* VXT;
  __device__ __forceinline__ void store(int row, int col, f32x4 v) const {
    if (col < 1024) { u32x2 w; w.x = pk2(v.x, v.y); w.y = pk2(v.z, v.w); *(u32x2*)(KX + (size_t)row * DM + col) = w; }
    else { const int b = row >> 8, m = row & 255;
#pragma unroll
      for (int r = 0; r < 4; ++r) { const int d = col - 1024 + r; VXT[((size_t)(b * 4 + (d >> 8)) * 256 + (d & 255)) * 256 + m] = (bf16_t)f2bf(v[r]); } } } };

__device__ __forceinline__ void phase_scan(const Args& a, int gw, int ngw, int lane, int tid) {
  unsigned char* ws = a.ws;
  const bf16_t* qkv = (const bf16_t*)(ws + WS_QKV);
  for (int item = gw; item < 64 + 1024 + 1024; item += ngw) {
    if (item < 64) {
      const int b = item >> 3, j = item & 7;
      const f32x4* src = (const f32x4*)((const float*)(ws + WS_FLOG) + (size_t)j * NT + (size_t)b * SEQ + lane * 64);
      f32x4 v[16];
#pragma unroll
      for (int i = 0; i < 16; ++i) v[i] = src[i];
      float tot = 0.f;
#pragma unroll
      for (int i = 0; i < 16; ++i) tot += (v[i].x + v[i].y) + (v[i].z + v[i].w);
      float inc = tot;
#pragma unroll
      for (int o = 1; o < 64; o <<= 1) { const float t = __shfl_up(inc, o); if (lane >= o) inc += t; }
      float run = inc - tot;
      f32x4* dst = (f32x4*)((float*)(ws + WS_CUM) + ((size_t)(b * 8 + j)) * SEQ + lane * 64);
#pragma unroll
      for (int i = 0; i < 16; ++i) { f32x4 o; run += v[i].x; o.x = run * 1.4426950408889634f; run += v[i].y; o.y = run * 1.4426950408889634f; run += v[i].z; o.z = run * 1.4426950408889634f; run += v[i].w; o.w = run * 1.4426950408889634f; dst[i] = o; }
    } else if (item < 64 + 1024) {
      const int it = item - 64, h = it & 7, blk = (it >> 3) & 15, b = it >> 7;
      const bf16_t* p = qkv + ((size_t)b * SEQ + blk * 256 + (lane >> 3)) * NQKV + 512 + h * 64 + (lane & 7) * 8;
      float s[8];
#pragma unroll
      for (int i = 0; i < 8; ++i) s[i] = 0.f;
#pragma unroll 8
      for (int rr = 0; rr < 32; ++rr) { float f[8]; unpack8(*(const u32x4*)(p + (size_t)rr * 8 * NQKV), f);
#pragma unroll
        for (int i = 0; i < 8; ++i) s[i] += f[i]; }
#pragma unroll
      for (int i = 0; i < 8; ++i) { s[i] += __shfl_xor(s[i], 8); s[i] += __shfl_xor(s[i], 16); s[i] += __shfl_xor(s[i], 32); }
      if (lane < 8) { f32x4* d = (f32x4*)((float*)(ws + WS_KMEAN) + ((size_t)(b * 16 + blk) * 8 + h) * 64 + lane * 8);
        d[0] = (f32x4){s[0], s[1], s[2], s[3]} * (1.f / 256.f); d[1] = (f32x4){s[4], s[5], s[6], s[7]} * (1.f / 256.f); }
    } else {
      const int it = item - 64 - 1024, bh = it >> 4, ch = it & 15, b = bh >> 3, h = bh & 7;
      const bf16_t* p = qkv + ((size_t)b * SEQ + ch * 256 + (lane >> 3)) * NQKV + 2048 + h * 64 + (lane & 7) * 8;
      float m = 0.f;
#pragma unroll 8
      for (int rr = 0; rr < 32; ++rr) { float f[8]; unpack8(*(const u32x4*)(p + (size_t)rr * 8 * NQKV), f);
        float s = 0.f;
#pragma unroll
        for (int i = 0; i < 8; ++i) s += f[i] * f[i];
        s += __shfl_xor(s, 1); s += __shfl_xor(s, 2); s += __shfl_xor(s, 4);
        m = fmaxf(m, s); }
#pragma unroll
      for (int o = 8; o < 64; o <<= 1) m = fmaxf(m, __shfl_xor(m, o));
      if (lane == 0) atomicMax((unsigned*)(ws + 256) + bh, __float_as_uint(m));
    }
  }
}

template <int MODE>
__device__ __forceinline__ void attn_naive_unit(const Args& a, unsigned char* lds, int b, int h, int sb, int tid) {
  unsigned char* ws = a.ws;
  const bf16_t* qkv = (const bf16_t*)(ws + WS_QKV);
  const int qoff = MODE ? 1536 : 0, koff = qoff + 512, voff = qoff + 1024;
  float* Ks = (float*)lds; float* Vs = Ks + 64 * 64; float* ck = Vs + 64 * 64; float* biasd = ck + 64;
  const int t = sb * 512 + tid; const size_t row = (size_t)b * SEQ + t;
  float q[64], o[64];
  {
    const u32x4* qp = (const u32x4*)(qkv + row * NQKV + qoff + h * 64);
#pragma unroll
    for (int c = 0; c < 8; ++c) { const u32x4 w = qp[c]; unpack8(w, q + 8 * c); }
#pragma unroll
    for (int d = 0; d < 64; ++d) { q[d] *= 0.6931471805599453f; o[d] = 0.f; }
  }
  float m = -1e30f, l = 0.f;
  unsigned selmask = 0u; const int own = t >> 8;
  float cq = 0.f, bfar = 0.f;
  __syncthreads();
  if (MODE == 0) {
    if (tid < 128) biasd[tid] = a.in[5][T5_BUCKET[tid] * 8 + h];
    bfar = a.in[5][31 * 8 + h];
    const float* km = (const float*)(ws + WS_KMEAN) + ((size_t)b * 16) * 512 + h * 64;
    float v0 = -3e38f, v1 = -3e38f, v2 = -3e38f; int i0 = -1, i1 = -1, i2 = -1;
    for (int n = 0; n < 2 * sb + 1; ++n) {
      if (n < own) {
        const float* kp = km + (size_t)n * 512; float s = 0.f;
#pragma unroll
        for (int d = 0; d < 64; ++d) s += q[d] * kp[d];
        if (s > v0) { v2 = v1; i2 = i1; v1 = v0; i1 = i0; v0 = s; i0 = n; }
        else if (s > v1) { v2 = v1; i2 = i1; v1 = s; i1 = n; }
        else if (s > v2) { v2 = s; i2 = n; }
      }
    }
    if (i0 >= 0) selmask |= 1u << i0;
    if (i1 >= 0) selmask |= 1u << i1;
    if (i2 >= 0) selmask |= 1u << i2;
  } else {
    cq = ((const float*)(ws + WS_CUM))[((size_t)(b * 8 + h)) * SEQ + t];
  }
  const int ntile = 8 * (sb + 1);
  for (int kt = 0; kt < ntile; ++kt) {
    __syncthreads();
    {
      const int r = tid >> 3, ch = tid & 7;
      const bf16_t* kp = qkv + ((size_t)b * SEQ + kt * 64 + r) * NQKV + h * 64 + ch * 8;
      const u32x4 kw = *(const u32x4*)(kp + koff), vw = *(const u32x4*)(kp + voff);
      unpack8(kw, Ks + r * 64 + ch * 8); unpack8(vw, Vs + r * 64 + ch * 8);
      if (MODE == 1 && tid < 64) ck[tid] = ((const float*)(ws + WS_CUM))[((size_t)(b * 8 + h)) * SEQ + kt * 64 + tid];
    }
    __syncthreads();
    const int kb = kt >> 2;
    bool act;
    if (MODE == 0) act = (kb == own) || (kb < own && ((selmask >> kb) & 1u));
    else act = (kt * 64 <= t);
    if (act) {
      for (int jj = 0; jj < 64; ++jj) {
        const int sp = kt * 64 + jj;
        if (sp > t) break;
        const f32x4* kr = (const f32x4*)(Ks + jj * 64);
        float s = 0.f;
#pragma unroll
        for (int c = 0; c < 16; ++c) { const f32x4 kv = kr[c]; s += q[4 * c] * kv.x + q[4 * c + 1] * kv.y + q[4 * c + 2] * kv.z + q[4 * c + 3] * kv.w; }
        if (MODE == 0) { const int dist = t - sp; s += (dist < 128) ? biasd[dist] : bfar; }
        else s += (cq - ck[jj]) * 0.6931471805599453f;
        if (s > m) { const float f = __expf(m - s); l *= f;
#pragma unroll
          for (int d = 0; d < 64; ++d) o[d] *= f;
          m = s; }
        const float p = __expf(s - m); l += p;
        const f32x4* vr = (const f32x4*)(Vs + jj * 64);
#pragma unroll
        for (int c = 0; c < 16; ++c) { const f32x4 vv = vr[c]; o[4 * c] += p * vv.x; o[4 * c + 1] += p * vv.y; o[4 * c + 2] += p * vv.z; o[4 * c + 3] += p * vv.w; }
      }
    }
  }
  const float il = 1.f / l;
  u32x4* op = (u32x4*)((bf16_t*)(ws + WS_OAB) + row * DM + (MODE ? 512 : 0) + h * 64);
#pragma unroll
  for (int c = 0; c < 8; ++c) { u32x4 w; w.x = pk2(o[8 * c] * il, o[8 * c + 1] * il); w.y = pk2(o[8 * c + 2] * il, o[8 * c + 3] * il); w.z = pk2(o[8 * c + 4] * il, o[8 * c + 5] * il); w.w = pk2(o[8 * c + 6] * il, o[8 * c + 7] * il); op[c] = w; }
}

__device__ __forceinline__ void phase_attn(const Args& a, unsigned char* lds, int tid) {
  for (int u = blockIdx.x; u < 1024; u += gridDim.x) {
    const int sb = 7 - (u >> 7), r = u & 127, mode = r & 1, bh = r >> 1;
    if (mode == 0) attn_naive_unit<0>(a, lds, bh >> 3, bh & 7, sb, tid);
    else attn_naive_unit<1>(a, lds, bh >> 3, bh & 7, sb, tid);
  }
}

namespace att {
typedef float f32x16 __attribute__((ext_vector_type(16)));
typedef short s16x4 __attribute__((ext_vector_type(4)));
typedef short v4i16_t __attribute__((ext_vector_type(4)));
typedef __attribute__((address_space(3))) const char* lds_cptr;
typedef float f32x2_t __attribute__((ext_vector_type(2))); typedef __bf16 bf16x2_t __attribute__((ext_vector_type(2)));
constexpr int PITCH = NQKV;
constexpr float LOG2E = 1.4426950408889634f;
constexpr float C2 = 0.125f * LOG2E;
constexpr int L_K = 0, L_V = 16384, L_WSF = 32768, L_OST = 34816, L_C2 = 67584, L_KM = 83968, L_BT = 88064, L_MISC = 88704;
__device__ __forceinline__ int crow(int r, int hi) { return (r & 3) + 8 * (r >> 2) + 4 * hi; }
__device__ __forceinline__ unsigned cvtpk(float lo, float hi) { f32x2_t v = {lo, hi}; bf16x2_t b = __builtin_convertvector(v, bf16x2_t); return __builtin_bit_cast(unsigned, b); }
__device__ __forceinline__ s16x4 vtr(lds_cptr p) { return __builtin_bit_cast(s16x4, __builtin_amdgcn_ds_read_tr16_b64_v4i16((__attribute__((address_space(3))) v4i16_t*)p)); }
__device__ __forceinline__ float max3f(float a, float b, float c) { float r; asm("v_max3_f32 %0, %1, %2, %3" : "=v"(r) : "v"(a), "v"(b), "v"(c)); return r; }
__device__ __forceinline__ float xhalf_max(float m) { auto rr = __builtin_amdgcn_permlane32_swap(__float_as_uint(m), __float_as_uint(m), false, false); return fmaxf(__uint_as_float(rr[0]), __uint_as_float(rr[1])); }
__device__ __forceinline__ float xhalf_sum(float m) { auto rr = __builtin_amdgcn_permlane32_swap(__float_as_uint(m), __float_as_uint(m), false, false); return __uint_as_float(rr[0]) + __uint_as_float(rr[1]); }

template <int MODE>
__device__ __forceinline__ void unit(const Args& a, unsigned char* lds, int b, int h, int qb, int tid) {
  unsigned char* ws = a.ws;
  const int lane = tid & 63, r32 = lane & 31, hi = lane >> 5; const int wid = __builtin_amdgcn_readfirstlane(tid >> 6);
  const bf16_t* qkv = (const bf16_t*)(ws + WS_QKV);
  const int qoff = MODE ? 1536 : 0;
  const size_t rowbase = (size_t)b * SEQ; const int q0 = qb * 256;
  const bf16_t* Qw = qkv + (rowbase + q0 + wid * 32) * PITCH + qoff + h * 64;
  const bf16_t* Kh = qkv + rowbase * PITCH + qoff + 512 + h * 64;
  const bf16_t* Vh = qkv + rowbase * PITCH + qoff + 1024 + h * 64;
  float* wsf = (float*)(lds + L_WSF) + wid * 64;
  float* c2s = (float*)(lds + L_C2); float* kms = (float*)(lds + L_KM); float* bts = (float*)(lds + L_BT); unsigned* misc = (unsigned*)(lds + L_MISC);
  const int NTL = 4 * (qb + 1);
  __syncthreads();
  if (MODE == 0) {
    const float* km = (const float*)(ws + WS_KMEAN) + (size_t)b * 16 * 512 + h * 64;
    for (int i = tid; i < 16 * 64; i += 512) kms[i] = km[(size_t)(i >> 6) * 512 + (i & 63)];
    if (tid < 128) bts[tid] = a.in[5][T5_BUCKET[tid] * 8 + h] * LOG2E;
    if (tid == 128) bts[128] = a.in[5][31 * 8 + h] * LOG2E;
  } else {
    const float* cg = (const float*)(ws + WS_CUM) + (size_t)(b * 8 + h) * SEQ;
    for (int i = tid; i < 256 * (qb + 1); i += 512) c2s[i] = cg[i];
    if (tid == 0) misc[0] = 0u;
  }
  bf16x8 qr[4];
#pragma unroll
  for (int d0 = 0; d0 < 4; ++d0) qr[d0] = *(const bf16x8*)(Qw + (size_t)r32 * PITCH + d0 * 16 + hi * 8);
  __syncthreads();
  unsigned selmask = 0u; float cq2 = 0.f, far2 = 0.f, mhat = 0.f; int t0 = 0;
  if (MODE == 0) {
    far2 = bts[128];
    float v0 = -3e38f, v1 = -3e38f, v2 = -3e38f; int i0 = -1, i1 = -1, i2 = -1;
    for (int n = 0; n < qb; ++n) {
      float s = 0.f;
#pragma unroll
      for (int d0 = 0; d0 < 4; ++d0)
#pragma unroll
        for (int j = 0; j < 8; ++j) s += bf2f((unsigned short)qr[d0][j]) * kms[n * 64 + d0 * 16 + hi * 8 + j];
      s = xhalf_sum(s);
      if (s > v0) { v2 = v1; i2 = i1; v1 = v0; i1 = i0; v0 = s; i0 = n; }
      else if (s > v1) { v2 = v1; i2 = i1; v1 = s; i1 = n; }
      else if (s > v2) { v2 = s; i2 = n; }
    }
    if (i0 >= 0) selmask |= 1u << i0;
    if (i1 >= 0) selmask |= 1u << i1;
    if (i2 >= 0) selmask |= 1u << i2;
  } else {
    cq2 = c2s[q0 + wid * 32 + r32];
    float s = 0.f;
#pragma unroll
    for (int d0 = 0; d0 < 4; ++d0)
#pragma unroll
      for (int j = 0; j < 8; ++j) { const float f = bf2f((unsigned short)qr[d0][j]); s += f * f; }
    s = xhalf_sum(s);
    atomicMax(&misc[0], __float_as_uint(s));
    __syncthreads();
    const float kn2 = __uint_as_float(((const unsigned*)(ws + 256))[b * 8 + h]);
    const float qkb = sqrtf(__uint_as_float(misc[0]) * kn2) * 1.0001f + 1e-3f;
    mhat = -qkb;
    const int j = lane; bool skip = false;
    if (j < NTL) skip = (2.f * qkb + c2s[q0] - c2s[64 * j + 63]) < -150.f;
    t0 = __popcll(__ballot(skip));
    if (t0 > NTL - 1) t0 = NTL - 1;
  }
  const bf16_t* ksrc = Kh + (size_t)lane * PITCH + wid * 8;
  const bf16_t* vsrc = Vh + (size_t)(16 * (wid & 3) + (lane >> 2)) * PITCH + (wid >> 2) * 32 + (lane & 3) * 8;
  unsigned char* kdst = lds + L_K + wid * 1024 + lane * 16; unsigned char* vdst = lds + L_V + wid * 1024 + lane * 16;
  const lds_cptr lds3 = (lds_cptr)lds;
  const lds_cptr vp0 = lds3 + L_V + ((lane >> 4) & 1) * 32 + (lane & 3) * 8 + (4 * hi + ((lane & 15) >> 2)) * 64;
  u32x4 kreg = *(const u32x4*)(ksrc + (size_t)t0 * 64 * PITCH), vreg = *(const u32x4*)(vsrc + (size_t)t0 * 64 * PITCH);
  *(u32x4*)(kdst + (t0 & 1) * 8192) = kreg; *(u32x4*)(vdst + (t0 & 1) * 8192) = vreg;
  f32x16 o[2]; o[0] = f32x16{}; o[1] = f32x16{};
  f32x16 ol = f32x16{}, cm = f32x16{}; int cm_nb = -1;
  const int qrel = wid * 32 + r32, qpos = q0 + qrel;
  __syncthreads();
  for (int t = t0; t < NTL; ++t) {
    const int buf = (t & 1) * 8192;
    if (t + 1 < NTL) { kreg = *(const u32x4*)(ksrc + (size_t)(t + 1) * 64 * PITCH); vreg = *(const u32x4*)(vsrc + (size_t)(t + 1) * 64 * PITCH); }
    const int jb = t - (NTL - 4);
    const bool compute = !(jb >= 0 && 64 * jb > wid * 32 + 31);
    if (compute) {
      f32x16 p0, p1;
      bf16x8 kf[8];
      {
        const lds_cptr kb = lds3 + L_K + buf + hi * 1024 + r32 * 16;
#pragma unroll
        for (int d0 = 0; d0 < 4; ++d0) { kf[2 * d0] = *(const __attribute__((address_space(3))) bf16x8*)(kb + d0 * 2048); kf[2 * d0 + 1] = *(const __attribute__((address_space(3))) bf16x8*)(kb + d0 * 2048 + 512); }
      }
      __builtin_amdgcn_sched_barrier(0);
      if (MODE == 0) {
        const int nb = t >> 2;
        const bool near = (jb >= 0) || (t >= NTL - 6 && wid < 4);
        if (near) {
#pragma unroll
          for (int r = 0; r < 16; ++r) { const int d = qpos - (64 * t + crow(r, hi));
            p0[r] = bts[min(max(d, 0), 128)] - mhat; p1[r] = bts[min(max(d - 32, 0), 128)] - mhat; }
          if (jb < 0 && !((selmask >> nb) & 1u)) {
#pragma unroll
            for (int r = 0; r < 16; ++r) { p0[r] = -INFINITY; p1[r] = -INFINITY; }
          }
        } else {
          if (cm_nb != nb) {
            const float base = ((selmask >> nb) & 1u) ? far2 - mhat : -INFINITY;
#pragma unroll
            for (int r = 0; r < 16; ++r) cm[r] = base;
            cm_nb = nb;
          }
          p0 = cm; p1 = cm;
        }
      } else {
        const float cqm = cq2 - mhat;
#pragma unroll
        for (int g = 0; g < 4; ++g) {
          const f32x4 ca = *(const f32x4*)(c2s + 64 * t + 8 * g + 4 * hi), cb = *(const f32x4*)(c2s + 64 * t + 32 + 8 * g + 4 * hi);
#pragma unroll
          for (int i = 0; i < 4; ++i) { p0[4 * g + i] = cqm - ca[i]; p1[4 * g + i] = cqm - cb[i]; }
        }
      }
#pragma unroll
      for (int d0 = 0; d0 < 4; ++d0) {
        p0 = __builtin_amdgcn_mfma_f32_32x32x16_bf16(kf[2 * d0], qr[d0], p0, 0, 0, 0);
        p1 = __builtin_amdgcn_mfma_f32_32x32x16_bf16(kf[2 * d0 + 1], qr[d0], p1, 0, 0, 0);
      }
      if (jb >= 0) {
        asm volatile("" ::: "memory");
        const int kb0 = 64 * jb + 4 * hi;
#pragma unroll
        for (int r = 0; r < 16; ++r) { const int kv = kb0 + (r & 3) + 8 * (r >> 2); if (kv > qrel) p0[r] = -INFINITY; if (kv + 32 > qrel) p1[r] = -INFINITY; }
      }
      asm volatile("s_nop 15\n\ts_nop 7" : "+v"(p0), "+v"(p1));
      float rm, rm2;
      rm = max3f(p0[0], p0[1], p1[0]); rm2 = max3f(p0[2], p0[3], p1[1]); rm = max3f(rm, p1[2], p1[3]);
#pragma unroll
      for (int r = 4; r < 16; r += 4) { rm = max3f(rm, p0[r], p0[r + 1]); rm2 = max3f(rm2, p0[r + 2], p0[r + 3]); rm = max3f(rm, p1[r], p1[r + 1]); rm2 = max3f(rm2, p1[r + 2], p1[r + 3]); }
      rm = xhalf_max(fmaxf(rm, rm2));
      if (__any(rm > 8.0f)) {
        const float dl = fmaxf(rm, 0.f), alpha = __builtin_amdgcn_exp2f(-dl);
        mhat += dl; cm_nb = -1;
#pragma unroll
        for (int r = 0; r < 16; ++r) { p0[r] -= dl; p1[r] -= dl; }
        if (hi == 0) wsf[r32] = alpha;
        __builtin_amdgcn_wave_barrier();
#pragma unroll
        for (int r = 0; r < 16; ++r) { const float f = wsf[crow(r, hi)]; o[0][r] *= f; o[1][r] *= f; ol[r] *= f; }
        __builtin_amdgcn_wave_barrier();
      }
#pragma unroll
      for (int r = 0; r < 16; ++r) { p0[r] = __builtin_amdgcn_exp2f(p0[r]); p1[r] = __builtin_amdgcn_exp2f(p1[r]); }
      u32x4 pw0, pw1, pw2, pw3;
      pw0 = (u32x4){cvtpk(p0[0], p0[1]), cvtpk(p0[2], p0[3]), cvtpk(p0[4], p0[5]), cvtpk(p0[6], p0[7])};
      pw1 = (u32x4){cvtpk(p0[8], p0[9]), cvtpk(p0[10], p0[11]), cvtpk(p0[12], p0[13]), cvtpk(p0[14], p0[15])};
      pw2 = (u32x4){cvtpk(p1[0], p1[1]), cvtpk(p1[2], p1[3]), cvtpk(p1[4], p1[5]), cvtpk(p1[6], p1[7])};
      pw3 = (u32x4){cvtpk(p1[8], p1[9]), cvtpk(p1[10], p1[11]), cvtpk(p1[12], p1[13]), cvtpk(p1[14], p1[15])};
      {
        const bf16x8 ones = (bf16x8){0x3F80, 0x3F80, 0x3F80, 0x3F80, 0x3F80, 0x3F80, 0x3F80, 0x3F80};
        ol = __builtin_amdgcn_mfma_f32_32x32x16_bf16(__builtin_bit_cast(bf16x8, pw0), ones, ol, 0, 0, 0);
        ol = __builtin_amdgcn_mfma_f32_32x32x16_bf16(__builtin_bit_cast(bf16x8, pw1), ones, ol, 0, 0, 0);
        ol = __builtin_amdgcn_mfma_f32_32x32x16_bf16(__builtin_bit_cast(bf16x8, pw2), ones, ol, 0, 0, 0);
        ol = __builtin_amdgcn_mfma_f32_32x32x16_bf16(__builtin_bit_cast(bf16x8, pw3), ones, ol, 0, 0, 0);
      }
      const lds_cptr vp = vp0 + buf;
#pragma unroll
      for (int d0 = 0; d0 < 2; ++d0) {
#define ATT_VF(ks) ({ const s16x4 lo_ = vtr(vp + d0 * 4096 + (ks) * 1024), hi_ = vtr(vp + d0 * 4096 + (ks) * 1024 + 512); (bf16x8){lo_[0], lo_[1], lo_[2], lo_[3], hi_[0], hi_[1], hi_[2], hi_[3]}; })
        o[d0] = __builtin_amdgcn_mfma_f32_32x32x16_bf16(__builtin_bit_cast(bf16x8, pw0), ATT_VF(0), o[d0], 0, 0, 0);
        o[d0] = __builtin_amdgcn_mfma_f32_32x32x16_bf16(__builtin_bit_cast(bf16x8, pw1), ATT_VF(1), o[d0], 0, 0, 0);
        o[d0] = __builtin_amdgcn_mfma_f32_32x32x16_bf16(__builtin_bit_cast(bf16x8, pw2), ATT_VF(2), o[d0], 0, 0, 0);
        o[d0] = __builtin_amdgcn_mfma_f32_32x32x16_bf16(__builtin_bit_cast(bf16x8, pw3), ATT_VF(3), o[d0], 0, 0, 0);
#undef ATT_VF
      }
    }
    if (t + 1 < NTL) { *(u32x4*)(kdst + ((t + 1) & 1) * 8192) = kreg; *(u32x4*)(vdst + ((t + 1) & 1) * 8192) = vreg; }
    __syncthreads();
  }
  bf16_t* stg = (bf16_t*)(lds + L_OST) + wid * 2048;
#pragma unroll
  for (int r = 0; r < 16; ++r) { const int orow = crow(r, hi); const float rl = 1.f / ol[r];
    stg[orow * 64 + r32] = (bf16_t)f2bf(o[0][r] * rl); stg[orow * 64 + 32 + r32] = (bf16_t)f2bf(o[1][r] * rl); }
  __builtin_amdgcn_wave_barrier();
  bf16_t* Ow = (bf16_t*)(ws + WS_OAB) + (rowbase + q0 + wid * 32) * DM + (MODE ? 512 : 0) + h * 64;
#pragma unroll
  for (int i = 0; i < 4; ++i) { const int row = i * 8 + (lane >> 3), ch = lane & 7; const u32x4 v = *(const u32x4*)(stg + row * 64 + ch * 8); *(u32x4*)(Ow + (size_t)row * DM + ch * 8) = v; }
}
}

__device__ __forceinline__ void phase_attn2(const Args& a, unsigned char* lds, int tid) {
  unsigned* ctr = (unsigned*)(a.ws + 0);
  unsigned* slot = (unsigned*)(lds + att::L_MISC + 64);
  for (;;) {
    __syncthreads();
    if (tid == 0) slot[0] = atomicAdd(ctr, 1u);
    __syncthreads();
    const unsigned u = slot[0];
    if (u >= 2048u) break;
    const int qb = 15 - (int)(u >> 7), r = u & 127, mode = r & 1, bh = r >> 1;
    if (mode == 0) att::unit<0>(a, lds, bh >> 3, bh & 7, qb, tid);
    else att::unit<1>(a, lds, bh >> 3, bh & 7, qb, tid);
  }
}

__device__ __forceinline__ void phase_onorm(const Args& a, int gw, int ngw, int lane) {
  bf16_t* oab = (bf16_t*)(a.ws + WS_OAB);
  for (int r = gw; r < NT; r += ngw) {
    u32x4* p = (u32x4*)(oab + (size_t)r * DM) + 2 * lane;
    const u32x4 w0 = p[0], w1 = p[1]; float f[16]; unpack8(w0, f); unpack8(w1, f + 8);
    float s = 0.f;
#pragma unroll
    for (int i = 0; i < 16; ++i) s += f[i] * f[i];
#pragma unroll
    for (int o = 1; o < 32; o <<= 1) s += __shfl_xor(s, o);
    const float rstd = rsqrtf(s * (1.f / 512.f) + EPS);
    u32x4 o0, o1;
    o0.x = pk2(f[0] * rstd, f[1] * rstd); o0.y = pk2(f[2] * rstd, f[3] * rstd); o0.z = pk2(f[4] * rstd, f[5] * rstd); o0.w = pk2(f[6] * rstd, f[7] * rstd);
    o1.x = pk2(f[8] * rstd, f[9] * rstd); o1.y = pk2(f[10] * rstd, f[11] * rstd); o1.z = pk2(f[12] * rstd, f[13] * rstd); o1.w = pk2(f[14] * rstd, f[15] * rstd);
    p[0] = o0; p[1] = o1;
  }
}

__device__ __forceinline__ void phase_rms(const Args& a, int gw, int ngw, int lane) {
  for (int r = gw; r < NT; r += ngw) rms_row_to_bf16(a.out + (size_t)r * DM, (bf16_t*)(a.ws + WS_HB) + (size_t)r * DM, lane);
}

__device__ __forceinline__ void phase_xattn(const Args& a, unsigned char* lds, int gw, int ngw, int wave, int lane) {
  unsigned char* ws = a.ws;
  const bf16_t* qx = (const bf16_t*)(ws + WS_QX); const bf16_t* kx = (const bf16_t*)(ws + WS_KX); const bf16_t* vxt = (const bf16_t*)(ws + WS_VXT);
  bf16_t* ox = (bf16_t*)(ws + WS_OX);
  bf16_t* P = (bf16_t*)(lds + wave * 8192);
  const int fr = lane & 15, fq = lane >> 4;
  for (int u = gw; u < (NT / 16) * 4; u += ngw) {
    const int hd = u & 3, r0 = (u >> 2) * 16, b = r0 / SEQ;
    f32x4 acc[16];
#pragma unroll
    for (int i = 0; i < 16; ++i) acc[i] = (f32x4){0.f, 0.f, 0.f, 0.f};
    const bf16_t* Ap = qx + (size_t)(r0 + fr) * DM + hd * 256 + fq * 8;
    const bf16_t* Bp = kx + (size_t)(b * 256 + fr) * DM + hd * 256 + fq * 8;
    for (int ks = 0; ks < 8; ++ks) {
      const bf16x8 af = *(const bf16x8*)(Ap + ks * 32);
#pragma unroll
      for (int ct = 0; ct < 16; ++ct) { const bf16x8 bfr = *(const bf16x8*)(Bp + (size_t)ct * 16 * DM + ks * 32); acc[ct] = __builtin_amdgcn_mfma_f32_16x16x32_bf16(af, bfr, acc[ct], 0, 0, 0); }
    }
    float mx[4], sm[4];
#pragma unroll
    for (int r = 0; r < 4; ++r) { float m = acc[0][r];
#pragma unroll
      for (int ct = 1; ct < 16; ++ct) m = fmaxf(m, acc[ct][r]);
#pragma unroll
      for (int o = 1; o < 16; o <<= 1) m = fmaxf(m, __shfl_xor(m, o));
      mx[r] = m; sm[r] = 0.f; }
#pragma unroll
    for (int ct = 0; ct < 16; ++ct)
#pragma unroll
      for (int r = 0; r < 4; ++r) { const float p = __expf((acc[ct][r] - mx[r]) * 0.0625f); acc[ct][r] = p; sm[r] += p; }
#pragma unroll
    for (int r = 0; r < 4; ++r) {
#pragma unroll
      for (int o = 1; o < 16; o <<= 1) sm[r] += __shfl_xor(sm[r], o);
      sm[r] = 1.f / sm[r]; }
    __builtin_amdgcn_wave_barrier();
#pragma unroll
    for (int ct = 0; ct < 16; ++ct)
#pragma unroll
      for (int r = 0; r < 4; ++r) P[(4 * fq + r) * 256 + ct * 16 + fr] = (bf16_t)f2bf(acc[ct][r] * sm[r]);
    __builtin_amdgcn_wave_barrier();
    asm volatile("s_waitcnt lgkmcnt(0)" ::: "memory");
#pragma unroll
    for (int i = 0; i < 16; ++i) acc[i] = (f32x4){0.f, 0.f, 0.f, 0.f};
    const bf16_t* Vp = vxt + ((size_t)(b * 4 + hd) * 256 + fr) * 256 + fq * 8;
    for (int ks = 0; ks < 8; ++ks) {
      const bf16x8 pf = *(const bf16x8*)(P + fr * 256 + ks * 32 + fq * 8);
#pragma unroll
      for (int dt = 0; dt < 16; ++dt) { const bf16x8 vf = *(const bf16x8*)(Vp + (size_t)dt * 16 * 256 + ks * 32); acc[dt] = __builtin_amdgcn_mfma_f32_16x16x32_bf16(pf, vf, acc[dt], 0, 0, 0); }
    }
#pragma unroll
    for (int dt = 0; dt < 16; ++dt)
#pragma unroll
      for (int r = 0; r < 4; ++r) ox[(size_t)(r0 + 4 * fq + r) * DM + hd * 256 + dt * 16 + fr] = (bf16_t)f2bf(acc[dt][r]);
    __builtin_amdgcn_wave_barrier();
  }
}

namespace xa {
using att::f32x16; using att::s16x4; using att::lds_cptr; using att::crow; using att::cvtpk; using att::vtr; using att::xhalf_max; using att::xhalf_sum;
constexpr int L_WSF = 65536;
__device__ __forceinline__ void unit(const Args& a, unsigned char* lds, int b, int hd, int qb, int tid) {
  unsigned char* ws = a.ws;
  const int lane = tid & 63, r32 = lane & 31, hi = lane >> 5; const int wid = __builtin_amdgcn_readfirstlane(tid >> 6);
  const bf16_t* qrow = (const bf16_t*)(ws + WS_QX) + ((size_t)b * SEQ + qb * 256 + wid * 32 + r32) * DM + hd * 256;
  const bf16_t* kvb = (const bf16_t*)(ws + WS_KX) + (size_t)b * 256 * 2048 + hd * 256;
  const bf16_t* ksrc = kvb + (size_t)lane * 2048 + wid * 8;
  const bf16_t* vsrc = kvb + 1024 + (size_t)(16 * (wid & 3) + (lane >> 2)) * 2048 + (wid >> 2) * 32 + (lane & 3) * 8;
  unsigned char* sdst = lds + wid * 1024 + lane * 16;
  const lds_cptr lds3 = (lds_cptr)lds;
  const lds_cptr kp0 = lds3 + hi * 1024 + r32 * 16;
  const lds_cptr vp0 = lds3 + ((lane >> 4) & 1) * 32 + (lane & 3) * 8 + (4 * hi + ((lane & 15) >> 2)) * 64;
  float* wsf = (float*)(lds + L_WSF) + wid * 64;
  u32x4 sreg[4];
#define XA_LOADK(c) do { _Pragma("unroll") for (int kt = 0; kt < 4; ++kt) sreg[kt] = *(const u32x4*)(ksrc + (size_t)kt * 64 * 2048 + (c) * 64); } while (0)
#define XA_LOADV(vt) do { _Pragma("unroll") for (int dq = 0; dq < 4; ++dq) sreg[dq] = *(const u32x4*)(vsrc + (size_t)(vt) * 64 * 2048 + dq * 64); } while (0)
#define XA_WRITE(buf) do { _Pragma("unroll") for (int i = 0; i < 4; ++i) *(u32x4*)(sdst + (buf) * 32768 + i * 8192) = sreg[i]; } while (0)
  __syncthreads();
  XA_LOADK(0); XA_WRITE(0);
  f32x16 acc[8];
#pragma unroll
  for (int j = 0; j < 8; ++j) acc[j] = f32x16{};
  __syncthreads();
#pragma unroll
  for (int c = 0; c < 4; ++c) {
    if (c < 3) XA_LOADK(c + 1); else XA_LOADV(0);
    bf16x8 qf[4];
#pragma unroll
    for (int d0 = 0; d0 < 4; ++d0) qf[d0] = *(const bf16x8*)(qrow + c * 64 + d0 * 16 + hi * 8);
    const lds_cptr kp = kp0 + (c & 1) * 32768;
#pragma unroll
    for (int d0 = 0; d0 < 4; ++d0)
#pragma unroll
      for (int j = 0; j < 8; ++j) {
        const bf16x8 kf = *(const __attribute__((address_space(3))) bf16x8*)(kp + (j >> 1) * 8192 + d0 * 2048 + (j & 1) * 512);
        acc[j] = __builtin_amdgcn_mfma_f32_32x32x16_bf16(kf, qf[d0], acc[j], 0, 0, 0);
      }
    XA_WRITE((c + 1) & 1);
    __syncthreads();
  }
  float m = acc[0][0];
#pragma unroll
  for (int j = 0; j < 8; ++j)
#pragma unroll
    for (int r = 0; r < 16; ++r) m = fmaxf(m, acc[j][r]);
  m = xhalf_max(m);
  constexpr float CS = 1.4426950408889634f / 16.f;
  float l = 0.f; u32x4 pw[16];
#pragma unroll
  for (int j = 0; j < 8; ++j) {
#pragma unroll
    for (int r = 0; r < 16; ++r) { const float p = __builtin_amdgcn_exp2f((acc[j][r] - m) * CS); acc[j][r] = p; l += p; }
    pw[2 * j] = (u32x4){cvtpk(acc[j][0], acc[j][1]), cvtpk(acc[j][2], acc[j][3]), cvtpk(acc[j][4], acc[j][5]), cvtpk(acc[j][6], acc[j][7])};
    pw[2 * j + 1] = (u32x4){cvtpk(acc[j][8], acc[j][9]), cvtpk(acc[j][10], acc[j][11]), cvtpk(acc[j][12], acc[j][13]), cvtpk(acc[j][14], acc[j][15])};
  }
  l = xhalf_sum(l);
#pragma unroll
  for (int j = 0; j < 8; ++j) acc[j] = f32x16{};
#pragma unroll
  for (int vt = 0; vt < 4; ++vt) {
    if (vt < 3) XA_LOADV(vt + 1);
    const lds_cptr vp = vp0 + (vt & 1) * 32768;
#pragma unroll
    for (int ks = 0; ks < 4; ++ks)
#pragma unroll
      for (int db = 0; db < 8; ++db) {
        const s16x4 lo_ = vtr(vp + (db >> 1) * 8192 + (db & 1) * 4096 + ks * 1024), hi_ = vtr(vp + (db >> 1) * 8192 + (db & 1) * 4096 + ks * 1024 + 512);
        const bf16x8 vf = (bf16x8){lo_[0], lo_[1], lo_[2], lo_[3], hi_[0], hi_[1], hi_[2], hi_[3]};
        acc[db] = __builtin_amdgcn_mfma_f32_32x32x16_bf16(__builtin_bit_cast(bf16x8, pw[4 * vt + ks]), vf, acc[db], 0, 0, 0);
      }
    if (vt < 3) XA_WRITE((vt + 1) & 1);
    __syncthreads();
  }
  if (hi == 0) wsf[r32] = l;
  __builtin_amdgcn_wave_barrier();
  float rl[16];
#pragma unroll
  for (int r = 0; r < 16; ++r) rl[r] = 1.f / wsf[crow(r, hi)];
  bf16_t* stg = (bf16_t*)(lds + wid * 8192);
  bf16_t* orow0 = (bf16_t*)(ws + WS_OX) + ((size_t)b * SEQ + qb * 256 + wid * 32) * DM + hd * 256;
#pragma unroll
  for (int hf = 0; hf < 2; ++hf) {
#pragma unroll
    for (int db = 0; db < 4; ++db)
#pragma unroll
      for (int r = 0; r < 16; ++r) stg[crow(r, hi) * 128 + db * 32 + r32] = (bf16_t)f2bf(acc[hf * 4 + db][r] * rl[r]);
    __builtin_amdgcn_wave_barrier();
#pragma unroll
    for (int i = 0; i < 8; ++i) { const int row = i * 4 + (lane >> 4), ch = lane & 15; const u32x4 v = *(const u32x4*)(stg + row * 128 + ch * 8); *(u32x4*)(orow0 + (size_t)row * DM + hf * 128 + ch * 8) = v; }
    __builtin_amdgcn_wave_barrier();
  }
#undef XA_LOADK
#undef XA_LOADV
#undef XA_WRITE
}
}

__device__ __forceinline__ void phase_xattn2(const Args& a, unsigned char* lds, int tid) {
  for (int u = blockIdx.x; u < NB * 4 * 16; u += gridDim.x) { const int qb = u & 15, hd = (u >> 4) & 3, b = u >> 6; xa::unit(a, lds, b, hd, qb, tid); }
}

__device__ __forceinline__ unsigned fkey(float s, unsigned idx, unsigned mask) { unsigned u = __float_as_uint(s); u ^= (unsigned)((int)u >> 31) | 0x80000000u; return (u & ~mask) | (mask - idx); }
__device__ __forceinline__ float keyval(unsigned k, unsigned mask) { unsigned u = k & ~mask; u = (u & 0x80000000u) ? (u ^ 0x80000000u) : ~u; return __uint_as_float(u); }
#define KEY_INSERT(KA, key_) do { unsigned k__ = (key_); \
  _Pragma("unroll") for (int s_ = 0; s_ < 16; ++s_) { const unsigned hi_ = max(k__, KA[s_]); k__ = min(k__, KA[s_]); KA[s_] = hi_; } } while (0)

__device__ __forceinline__ void phase_topk(const Args& a, unsigned char* lds, int tid) {
  unsigned char* ws = a.ws;
  const float* pq = (const float*)(ws + WS_PQ);
  int* eidx = (int*)(ws + WS_EIDX); float* gate = (float*)(ws + WS_GATE);
  float* K1 = (float*)lds; float* K2 = K1 + 128 * 64; unsigned* KL = (unsigned*)(lds + 65536);
  for (int u = blockIdx.x; u < 8 * (NT / 512); u += gridDim.x) {
    const int h = u & 7, t = (u >> 3) * 512 + tid;
    __syncthreads();
    for (int i = tid; i < 128 * 64 / 4; i += 512) { ((f32x4*)K1)[i] = ((const f32x4*)(a.in[17] + (size_t)h * 8192))[i]; ((f32x4*)K2)[i] = ((const f32x4*)(a.in[18] + (size_t)h * 8192))[i]; }
    __syncthreads();
    unsigned ka[16], kb[16], kc[16];
#pragma unroll
    for (int k = 0; k < 16; ++k) { ka[k] = 0u; kb[k] = 0u; kc[k] = 0u; }
    float q[64];
    const f32x4* qp = (const f32x4*)(pq + (size_t)t * DM + h * 128);
#pragma unroll
    for (int c = 0; c < 16; ++c) { const f32x4 w = qp[c]; q[4 * c] = w.x; q[4 * c + 1] = w.y; q[4 * c + 2] = w.z; q[4 * c + 3] = w.w; }
    for (int n = 0; n < 128; ++n) {
      const f32x4* kr = (const f32x4*)(K1 + n * 64); float s = 0.f;
#pragma unroll
      for (int c = 0; c < 16; ++c) { const f32x4 kv = kr[c]; s += q[4 * c] * kv.x + q[4 * c + 1] * kv.y + q[4 * c + 2] * kv.z + q[4 * c + 3] * kv.w; }
      KEY_INSERT(ka, fkey(s, (unsigned)n, 127u));
    }
#pragma unroll
    for (int c = 0; c < 16; ++c) { const f32x4 w = qp[16 + c]; q[4 * c] = w.x; q[4 * c + 1] = w.y; q[4 * c + 2] = w.z; q[4 * c + 3] = w.w; }
    for (int n = 0; n < 128; ++n) {
      const f32x4* kr = (const f32x4*)(K2 + n * 64); float s = 0.f;
#pragma unroll
      for (int c = 0; c < 16; ++c) { const f32x4 kv = kr[c]; s += q[4 * c] * kv.x + q[4 * c + 1] * kv.y + q[4 * c + 2] * kv.z + q[4 * c + 3] * kv.w; }
      KEY_INSERT(kb, fkey(s, (unsigned)n, 127u));
    }
#pragma unroll
    for (int x = 0; x < 16; ++x)
#pragma unroll
      for (int y = 0; y < 16; ++y)
        if ((x + 1) * (y + 1) <= 16) { KEY_INSERT(kc, fkey(keyval(ka[x], 127u) + keyval(kb[y], 127u), (unsigned)(x * 16 + y), 255u)); }
#pragma unroll
    for (int k = 0; k < 16; ++k) { KL[k * 512 + tid] = ka[k]; KL[(16 + k) * 512 + tid] = kb[k]; }
    float val[16]; int id[16]; float sum = 0.f;
#pragma unroll
    for (int k = 0; k < 16; ++k) {
      const unsigned flat = 255u - (kc[k] & 255u);
      const unsigned k1 = KL[(flat >> 4) * 512 + tid], k2 = KL[(16 + (flat & 15u)) * 512 + tid];
      val[k] = keyval(k1, 127u) + keyval(k2, 127u);
      id[k] = (int)((127u - (k1 & 127u)) * 128u + (127u - (k2 & 127u)));
    }
    const float vmax = val[0];
#pragma unroll
    for (int k = 0; k < 16; ++k) { val[k] = __expf(val[k] - vmax); sum += val[k]; }
    const float inv = 1.f / sum;
    int* ep = eidx + (size_t)t * 128 + h * 16; float* gp = gate + (size_t)t * 128 + h * 16;
#pragma unroll
    for (int k = 0; k < 16; ++k) { ep[k] = id[k]; gp[k] = val[k] * inv; }
  }
}


namespace tk {
typedef float f32x16 __attribute__((ext_vector_type(16)));
__device__ __forceinline__ void ce(unsigned& a, unsigned& b) { const unsigned h = max(a, b), l = min(a, b); a = h; b = l; }
__device__ __forceinline__ void sort16(unsigned (&v)[16]) {
#pragma unroll
  for (int k = 2; k <= 16; k <<= 1)
#pragma unroll
    for (int j = k >> 1; j > 0; j >>= 1)
#pragma unroll
      for (int i = 0; i < 16; ++i) { const int l = i ^ j; if (l > i) { if ((i & k) == 0) ce(v[i], v[l]); else ce(v[l], v[i]); } }
}
__device__ __forceinline__ void topmerge(unsigned (&a)[16], const unsigned (&b)[16]) {
#pragma unroll
  for (int i = 0; i < 16; ++i) a[i] = max(a[i], b[15 - i]);
#pragma unroll
  for (int j = 8; j > 0; j >>= 1)
#pragma unroll
    for (int i = 0; i < 16; ++i) { const int l = i ^ j; if (l > i) ce(a[i], a[l]); }
}
__device__ __forceinline__ unsigned xswap(unsigned v, int hi) { auto rr = __builtin_amdgcn_permlane32_swap(v, v, false, false); return hi ? rr[0] : rr[1]; }
__device__ __forceinline__ void half_list(unsigned (&L)[16], const bf16_t* skh, const bf16_t* qrow, int r32, int hi) {
  f32x16 acc[4];
#pragma unroll
  for (int i = 0; i < 4; ++i) acc[i] = f32x16{};
#pragma unroll
  for (int ks = 0; ks < 4; ++ks) {
    const bf16x8 qf = *(const bf16x8*)(qrow + ks * 16 + hi * 8);
#pragma unroll
    for (int tl = 0; tl < 4; ++tl) { const bf16x8 kf = *(const bf16x8*)(skh + (size_t)(tl * 32 + r32) * 64 + ks * 16 + hi * 8); acc[tl] = __builtin_amdgcn_mfma_f32_32x32x16_bf16(kf, qf, acc[tl], 0, 0, 0); }
  }
  unsigned g[4][16];
#pragma unroll
  for (int tl = 0; tl < 4; ++tl)
#pragma unroll
    for (int r = 0; r < 16; ++r) g[tl][r] = fkey(acc[tl][r], (unsigned)(32 * tl + (r & 3) + 8 * (r >> 2) + 4 * hi), 127u);
  sort16(g[0]); sort16(g[1]); sort16(g[2]); sort16(g[3]);
  topmerge(g[0], g[1]); topmerge(g[2], g[3]); topmerge(g[0], g[2]);
  unsigned p[16];
#pragma unroll
  for (int k = 0; k < 16; ++k) p[k] = xswap(g[0][k], hi);
  topmerge(g[0], p);
#pragma unroll
  for (int k = 0; k < 16; ++k) L[k] = g[0][k];
}
}

__device__ __forceinline__ void phase_topk2(const Args& a, unsigned char* lds, int wave, int lane) {
  unsigned char* ws = a.ws;
  const bf16_t* pq = (const bf16_t*)(ws + WS_PQ); const bf16_t* sk = (const bf16_t*)(ws + WS_SK);
  int* eidx = (int*)(ws + WS_EIDX); float* gate = (float*)(ws + WS_GATE);
  const int r32 = lane & 31, hi = lane >> 5, h = wave;
  unsigned* KL = (unsigned*)(lds + wave * 4096);
  for (int tt = blockIdx.x; tt < NT / 32; tt += gridDim.x) {
    const int t = tt * 32 + r32;
    unsigned ka[16], kb[16], kc[16];
    tk::half_list(ka, sk + (size_t)(0 * 8 + h) * 8192, pq + (size_t)t * DM + h * 128, r32, hi);
    tk::half_list(kb, sk + (size_t)(1 * 8 + h) * 8192, pq + (size_t)t * DM + h * 128 + 64, r32, hi);
    float va[16], vb[16];
#pragma unroll
    for (int k = 0; k < 16; ++k) { va[k] = keyval(ka[k], 127u); vb[k] = keyval(kb[k], 127u); }
#pragma unroll
    for (int y = 0; y < 16; ++y) kc[y] = hi ? 0u : fkey(va[0] + vb[y], (unsigned)y, 255u);
#define TK_CAND(xa, ya, xb, yb) do { const unsigned kA_ = fkey(va[xa] + vb[ya], (unsigned)((xa) * 16 + (ya)), 255u), kB_ = fkey(va[xb] + vb[yb], (unsigned)((xb) * 16 + (yb)), 255u); KEY_INSERT(kc, hi ? kB_ : kA_); } while (0)
    TK_CAND(1, 0, 1, 1);
    TK_CAND(1, 2, 1, 3);
    TK_CAND(1, 4, 1, 5);
    TK_CAND(1, 6, 1, 7);
    TK_CAND(2, 0, 2, 1);
    TK_CAND(2, 2, 2, 3);
    TK_CAND(2, 4, 3, 0);
    TK_CAND(3, 1, 3, 2);
    TK_CAND(3, 3, 4, 0);
    TK_CAND(4, 1, 4, 2);
    TK_CAND(5, 0, 5, 1);
    TK_CAND(6, 0, 6, 1);
    TK_CAND(7, 0, 7, 1);
    TK_CAND(8, 0, 9, 0);
    TK_CAND(10, 0, 11, 0);
    TK_CAND(12, 0, 13, 0);
    TK_CAND(14, 0, 15, 0);
#undef TK_CAND
    { unsigned p[16];
#pragma unroll
      for (int k = 0; k < 16; ++k) p[k] = tk::xswap(kc[k], hi);
      tk::topmerge(kc, p); }
    if (hi == 0) {
#pragma unroll
      for (int k = 0; k < 16; ++k) { KL[k * 32 + r32] = ka[k]; KL[(16 + k) * 32 + r32] = kb[k]; }
    }
    __builtin_amdgcn_wave_barrier();
    const float vmax = va[0] + vb[0];
    float pv[8]; int id[8]; float s = 0.f;
#pragma unroll
    for (int j = 0; j < 8; ++j) {
      unsigned klo_ = kc[j], khi_ = kc[8 + j]; asm volatile("" : "+v"(klo_), "+v"(khi_));
      const unsigned key = hi ? khi_ : klo_;
      const unsigned flat = 255u - (key & 255u);
      const unsigned k1 = KL[(flat >> 4) * 32 + r32], k2 = KL[(16 + (flat & 15u)) * 32 + r32];
      pv[j] = __expf(keyval(k1, 127u) + keyval(k2, 127u) - vmax); s += pv[j];
      id[j] = (int)((127u - (k1 & 127u)) * 128u + (127u - (k2 & 127u)));
    }
    __builtin_amdgcn_wave_barrier();
    const float inv = 1.f / att::xhalf_sum(s);
    u32x4* ep = (u32x4*)(eidx + (size_t)t * 128 + h * 16 + hi * 8); f32x4* gp = (f32x4*)(gate + (size_t)t * 128 + h * 16 + hi * 8);
    ep[0] = (u32x4){(unsigned)id[0], (unsigned)id[1], (unsigned)id[2], (unsigned)id[3]}; ep[1] = (u32x4){(unsigned)id[4], (unsigned)id[5], (unsigned)id[6], (unsigned)id[7]};
    gp[0] = (f32x4){pv[0] * inv, pv[1] * inv, pv[2] * inv, pv[3] * inv}; gp[1] = (f32x4){pv[4] * inv, pv[5] * inv, pv[6] * inv, pv[7] * inv};
  }
}

__device__ __forceinline__ float gelu_erf(float v) { return 0.5f * v * (1.f + erff(v * 0.70710678118654752f)); }

__device__ __forceinline__ float gelu_as(float v) {
  const float av = fabsf(v), t = __builtin_amdgcn_rcpf(av * 0.2316418882f + 1.0f);
  float q = t * 0.5307027145f + (-0.7265760135f); q = q * t + 0.7107068705f; q = q * t + (-0.142248368f); q = q * t + 0.127414796f; q = q * t;
  const float m = v * (q * __builtin_amdgcn_exp2f((v * v) * (-0.72134752044f)));
  return v < 0.f ? m : v - m;
}
#define PIN16(A, O) asm volatile("" : "+v"(A[O]), "+v"(A[O + 1]), "+v"(A[O + 2]), "+v"(A[O + 3]), "+v"(A[O + 4]), "+v"(A[O + 5]), "+v"(A[O + 6]), "+v"(A[O + 7]), "+v"(A[O + 8]), "+v"(A[O + 9]), "+v"(A[O + 10]), "+v"(A[O + 11]), "+v"(A[O + 12]), "+v"(A[O + 13]), "+v"(A[O + 14]), "+v"(A[O + 15]))
#define PIN6(R) asm volatile("" : "+v"(R[0].x), "+v"(R[0].y), "+v"(R[1].x), "+v"(R[1].y), "+v"(R[2].x), "+v"(R[2].y))
__device__ __forceinline__ void phase_exp_down(const Args& a, int gw, int ngw, int lane) {
  unsigned char* ws = a.ws;
  const int* eidx = (const int*)(ws + WS_EIDX); const float* gate = (const float*)(ws + WS_GATE); float* wout = (float*)(ws + WS_W);
  const unsigned char* exd = ws + WS_EXD; const float* esc = (const float*)(ws + WS_ESC);
  const int l32 = lane & 31, hi = lane >> 5;
  const bool b4 = (l32 & 16) != 0, b3 = (l32 & 8) != 0, b2 = (l32 & 4) != 0;
  const bf16_t* hb = (const bf16_t*)(ws + WS_HB); const float* ss2 = (const float*)(ws + WS_SS2);
  int ne0 = 0, ne1 = 0; float ng0 = 0.f, ng1 = 0.f, nss = 0.f; u32x4 nh[4];
  if (gw < NT) { ne0 = eidx[(size_t)gw * 128 + lane]; ne1 = eidx[(size_t)gw * 128 + 64 + lane]; ng0 = gate[(size_t)gw * 128 + lane]; ng1 = gate[(size_t)gw * 128 + 64 + lane]; nss = ss2[gw];
    const u32x4* hp = (const u32x4*)(hb + (size_t)gw * DM + 32 * l32);
#pragma unroll
    for (int k = 0; k < 4; ++k) nh[k] = hp[k]; }
  for (int t = gw; t < NT; t += ngw) {
    const int e0 = ne0, e1 = ne1;
    const float sd0 = esc[e0], sd1 = esc[e1];
    const float gu0 = ng0 * esc[NEXP + e0], gu1 = ng1 * esc[NEXP + e1];
    float hg[32];
    unpack8(nh[0], hg); unpack8(nh[1], hg + 8); unpack8(nh[2], hg + 16); unpack8(nh[3], hg + 24);
    const float rstd = rsqrtf(nss * (1.f / DM) + EPS);
    if (t + ngw < NT) { const size_t tn = (size_t)(t + ngw); ne0 = eidx[tn * 128 + lane]; ne1 = eidx[tn * 128 + 64 + lane]; ng0 = gate[tn * 128 + lane]; ng1 = gate[tn * 128 + 64 + lane]; nss = ss2[tn];
      const u32x4* hp = (const u32x4*)(hb + tn * DM + 32 * l32);
#pragma unroll
      for (int k = 0; k < 4; ++k) nh[k] = hp[k]; }
#pragma unroll
    for (int k = 0; k < 8; ++k) { const f32x4 g = ((const f32x4*)a.in[15])[8 * l32 + k]; hg[4 * k] *= rstd * g.x; hg[4 * k + 1] *= rstd * g.y; hg[4 * k + 2] *= rstd * g.z; hg[4 * k + 3] *= rstd * g.w; }
    float w0 = 0.f, w1 = 0.f;
    for (int e = 0; e < 128; e += 16) {
      u32x2 ur[8][3];
#pragma unroll
      for (int i = 0; i < 8; ++i) {
        const int pi = (e & 63) + 2 * i + hi; const int id = (e < 64) ? __shfl(e0, pi) : __shfl(e1, pi);
        const u32x2* up = (const u32x2*)(exd + (size_t)id * 768 + 24 * l32);
        ur[i][0] = up[0]; ur[i][1] = up[1]; ur[i][2] = up[2];
      }
      float d[8];
#pragma unroll
      for (int i = 0; i < 8; ++i) {
        const v32f u = __builtin_amdgcn_cvt_scalef32_pk32_f32_fp6((v6u){ur[i][0].x, ur[i][0].y, ur[i][1].x, ur[i][1].y, ur[i][2].x, ur[i][2].y}, 1.0f);
        f32x2 q2 = (f32x2){0.f, 0.f};
#pragma unroll
        for (int k = 0; k < 16; ++k) q2 = __builtin_elementwise_fma((f32x2){u[2 * k], u[2 * k + 1]}, (f32x2){hg[2 * k], hg[2 * k + 1]}, q2);
        d[i] = q2.x + q2.y;
        __builtin_amdgcn_sched_barrier(0);
      }
      float r[4];
#pragma unroll
      for (int j = 0; j < 4; ++j) r[j] = (b4 ? d[j + 4] : d[j]) + swz_xor<16>(b4 ? d[j] : d[j + 4]);
      const float q0 = (b3 ? r[2] : r[0]) + swz_xor<8>(b3 ? r[0] : r[2]);
      const float q1 = (b3 ? r[3] : r[1]) + swz_xor<8>(b3 ? r[1] : r[3]);
      float q = (b2 ? q1 : q0) + swz_xor<4>(b2 ? q0 : q1);
      q += swz_xor<2>(q); q += swz_xor<1>(q);
      const int pr = (e & 63) + 2 * (l32 >> 2) + hi;
      const float sd = (e < 64) ? __shfl(sd0, pr) : __shfl(sd1, pr);
      const float gu = (e < 64) ? __shfl(gu0, pr) : __shfl(gu1, pr);
      const float wl = gu * gelu_as(q * sd);
      const float wsrc = __shfl(wl, ((lane & 1) << 5) | (((lane - (e & 63)) >> 1 & 7) << 2));
      if (lane >= (e & 63) && lane < (e & 63) + 16) { if (e < 64) w0 = wsrc; else w1 = wsrc; }
    }
    wout[(size_t)t * 128 + lane] = w0; wout[(size_t)t * 128 + 64 + lane] = w1;
  }
}

__device__ __forceinline__ void exp_up_item(const Args& a, unsigned char* lds, int xs, int item, int wave, int lane, float* xout, float* ssout) {
  unsigned char* ws = a.ws;
  const int* eidx = (const int*)(ws + WS_EIDX); const float* wgt = (const float*)(ws + WS_W);
  const unsigned char* ups = ws + WS_EXU + (size_t)xs * (NEXP * 128);
  unsigned* L = (unsigned*)(lds + wave * 16640);
  const int g = lane >> 2, c = lane & 3, t0 = item * 128 + wave * 16;
  __builtin_amdgcn_wave_barrier();
#pragma unroll 4
  for (int tk = 0; tk < 16; ++tk) {
    const size_t o = (size_t)(t0 + tk) * 128;
    L[tk * 260 + lane] = (unsigned)eidx[o + lane]; L[tk * 260 + 64 + lane] = (unsigned)eidx[o + 64 + lane];
    L[tk * 260 + 128 + lane] = __float_as_uint(wgt[o + lane]); L[tk * 260 + 192 + lane] = __float_as_uint(wgt[o + 64 + lane]);
  }
  __builtin_amdgcn_wave_barrier();
  float acc[32];
#pragma unroll
  for (int i = 0; i < 32; ++i) acc[i] = 0.f;
  const unsigned* Lg = L + g * 260;
#pragma unroll 1
  for (int p = 0; p < 128; p += 8) {
    u32x2 vr[8][3];
#pragma unroll
    for (int u = 0; u < 8; ++u) {
      const u32x2* vp = (const u32x2*)(ups + (size_t)Lg[p + u] * 128 + 24 * c);
      vr[u][0] = vp[0]; vr[u][1] = vp[1]; vr[u][2] = vp[2];
    }
#pragma unroll
    for (int u = 0; u < 8; ++u) {
      const float w = __uint_as_float(Lg[128 + p + u]);
      PIN6(vr[u]);
      const v32f v = __builtin_amdgcn_cvt_scalef32_pk32_f32_fp6((v6u){vr[u][0].x, vr[u][0].y, vr[u][1].x, vr[u][1].y, vr[u][2].x, vr[u][2].y}, 1.0f);
#pragma unroll
      for (int k = 0; k < 32; ++k) acc[k] += w * v[k];
      PIN16(acc, 0); PIN16(acc, 16);
    }
  }
  const f32x4* xr = (const f32x4*)(a.out + (size_t)(t0 + g) * DM + xs * 128 + c * 32); f32x4* xw = (f32x4*)(xout + (size_t)(t0 + g) * DM + xs * 128 + c * 32);
  float s = 0.f;
#pragma unroll
  for (int k = 0; k < 8; ++k) { f32x4 x = xr[k]; x.x += acc[4 * k]; x.y += acc[4 * k + 1]; x.z += acc[4 * k + 2]; x.w += acc[4 * k + 3]; xw[k] = x; s += (x.x * x.x + x.y * x.y) + (x.z * x.z + x.w * x.w); }
  s += swz_xor<1>(s); s += swz_xor<2>(s);
  if (c == 0) atomicAdd(ssout + t0 + g, s);
}
__device__ __forceinline__ void phase_exp_up(const Args& a, unsigned char* lds, const XcdBarrier& bar, int tid, int wave, int lane, unsigned* ctr, float* xout, float* ssout);
struct UpBuf { u32x4 r[8][2]; };
__device__ __forceinline__ void up2_load(UpBuf& B, const unsigned char* ups, const unsigned* Lg, int ch, int c) {
  const unsigned char* base = ups + (size_t)(ch >> 4) * (NEXP * 128) + 32 * c; const int p = (ch & 15) * 8;
#pragma unroll
  for (int u = 0; u < 8; ++u) { const u32x4* vp = (const u32x4*)(base + (size_t)Lg[p + u] * 128); B.r[u][0] = vp[0]; B.r[u][1] = vp[1]; }
}
__device__ __forceinline__ void up2_math(UpBuf& B, const unsigned* Lg, int ch, f32x2 (&acc)[16]) {
  const int p = (ch & 15) * 8;
#pragma unroll
  for (int u = 0; u < 8; ++u) {
    const float w = __uint_as_float(Lg[128 + p + u]);
    const f32x2 w2 = (f32x2){w, w};
#pragma unroll
    for (int q = 0; q < 2; ++q)
#pragma unroll
      for (int k = 0; k < 4; ++k) {
        const auto lo = __builtin_amdgcn_cvt_pk_f32_fp8((int)B.r[u][q][k], false); const auto hi = __builtin_amdgcn_cvt_pk_f32_fp8((int)B.r[u][q][k], true);
        acc[8 * q + 2 * k] = __builtin_elementwise_fma((f32x2){lo[0], lo[1]}, w2, acc[8 * q + 2 * k]);
        acc[8 * q + 2 * k + 1] = __builtin_elementwise_fma((f32x2){hi[0], hi[1]}, w2, acc[8 * q + 2 * k + 1]);
      }
    if (u & 1) PIN16(acc, 0);
  }
}
__device__ __forceinline__ void up2_slice_end(const Args& a, int t, int xs, int c, f32x2 (&acc)[16], float& ssum) {
  f32x4* xr = (f32x4*)(a.out + (size_t)t * DM + xs * 128 + c * 32);
#pragma unroll
  for (int k = 0; k < 8; ++k) { f32x4 x = xr[k]; x.x += acc[2 * k].x; x.y += acc[2 * k].y; x.z += acc[2 * k + 1].x; x.w += acc[2 * k + 1].y; xr[k] = x; ssum += (x.x * x.x + x.y * x.y) + (x.z * x.z + x.w * x.w);
    acc[2 * k] = (f32x2){0.f, 0.f}; acc[2 * k + 1] = (f32x2){0.f, 0.f}; }
}
__device__ __forceinline__ void phase_exp_up2(const Args& a, unsigned char* lds, int wave, int lane) {
  unsigned char* ws = a.ws;
  const int* eidx = (const int*)(ws + WS_EIDX); const float* wgt = (const float*)(ws + WS_W);
  const unsigned char* ups = ws + WS_EXU;
  unsigned* L = (unsigned*)(lds + wave * 16640);
  const int g = lane >> 2, c = lane & 3;
  for (int blk = blockIdx.x; blk < NT / 128; blk += gridDim.x) {
    const int t0 = blk * 128 + wave * 16, t = t0 + g;
    unsigned* H = (unsigned*)(lds + 8 * 16640 + 1024) + wave * 256;
    __builtin_amdgcn_wave_barrier();
    for (int i = lane; i < 256; i += 64) H[i] = 0u;
    __builtin_amdgcn_wave_barrier();
#pragma unroll 4
    for (int tk = 0; tk < 16; ++tk) {
      const size_t o = (size_t)(t0 + tk) * 128;
      const unsigned ea = (unsigned)eidx[o + lane], eb = (unsigned)eidx[o + 64 + lane];
      const unsigned wa = __float_as_uint(wgt[o + lane]), wb = __float_as_uint(wgt[o + 64 + lane]);
      const unsigned ba = ea >> 10, bb = eb >> 10;
      const unsigned ra = atomicAdd(&H[tk * 16 + ba], 1u), rb = atomicAdd(&H[tk * 16 + bb], 1u);
      __builtin_amdgcn_wave_barrier();
      unsigned pa = ra, pb = rb;
#pragma unroll
      for (unsigned b = 0; b < 16; ++b) { const unsigned hb = H[tk * 16 + b]; pa += (b < ba) ? hb : 0u; pb += (b < bb) ? hb : 0u; }
      L[tk * 260 + pa] = ea; L[tk * 260 + 128 + pa] = wa; L[tk * 260 + pb] = eb; L[tk * 260 + 128 + pb] = wb;
    }
    __builtin_amdgcn_wave_barrier();
    const unsigned* Lg = L + g * 260;
    f32x2 acc[16]; float ssum = 0.f;
#pragma unroll
    for (int i = 0; i < 16; ++i) acc[i] = (f32x2){0.f, 0.f};
    UpBuf A, B;
    up2_load(A, ups, Lg, 0, c);
#pragma unroll 1
    for (int ch = 0; ch < 128; ch += 2) {
      up2_load(B, ups, Lg, ch + 1, c);
      up2_math(A, Lg, ch, acc);
      if (ch + 2 < 128) up2_load(A, ups, Lg, ch + 2, c);
      up2_math(B, Lg, ch + 1, acc);
      if ((ch & 15) == 14) up2_slice_end(a, t, ch >> 4, c, acc, ssum);
    }
    ssum += swz_xor<1>(ssum); ssum += swz_xor<2>(ssum);
    const float r2 = rsqrtf(ssum * (1.f / DM) + EPS);
    asm volatile("s_waitcnt vmcnt(0)" ::: "memory");
    __builtin_amdgcn_fence(__ATOMIC_ACQUIRE, "agent");
#pragma unroll 2
    for (int xs = 0; xs < 8; ++xs) {
      f32x4* xr = (f32x4*)(a.out + (size_t)t * DM + xs * 128 + c * 32); const f32x4* gp = (const f32x4*)(a.in[21] + xs * 128 + c * 32);
#pragma unroll
      for (int k = 0; k < 8; ++k) xr[k] = xr[k] * r2 * gp[k];
    }
  }
}

__device__ __forceinline__ void phase_final(const Args& a, int gw, int ngw, int lane) {
  const float* ss = (const float*)(a.ws + WS_SS3);
  for (int r = gw; r < NT; r += ngw) {
    const float r2 = rsqrtf(ss[r] * (1.f / DM) + EPS);
    f32x4* xr = (f32x4*)(a.out + (size_t)r * DM) + lane;
#pragma unroll
    for (int j = 0; j < 4; ++j) { const f32x4 g = ((const f32x4*)a.in[21])[64 * j + lane]; xr[64 * j] = xr[64 * j] * r2 * g; }
  }
}

namespace pg8 {
#define PG8_LAS __attribute__((address_space(3)))
typedef unsigned short bf16_t;
typedef short bf16x8 __attribute__((ext_vector_type(8)));
typedef float f32x4 __attribute__((ext_vector_type(4)));
typedef unsigned u32x4 __attribute__((ext_vector_type(4)));
constexpr int BM = 256, BK = 64, HALF = 128, HTB = HALF * BK * 2  , STAGE_BYTES = 8 * HTB, NXCD = 8, WGM = 8;

__host__ __device__ __forceinline__ int lds_byte(int r, int c) { const int st = (r >> 4) * 2 + (c >> 5), rr = r & 15, cc = c & 31, ob = rr * 64 + cc * 2; return st * 1024 + (ob ^ (((ob >> 9) & 1) << 5)); }
__host__ __device__ __forceinline__ void stage_rc(int b, int& R, int& C) { const int st = b / 1024, sb = b % 1024, swz = sb ^ (((sb >> 9) & 1) << 5); R = (st >> 1) * 16 + swz / 64; C = (st & 1) * 32 + (swz % 64) / 2; }
__host__ __device__ __forceinline__ int perm32(int rho) { const int n = rho >> 4, i = rho & 15; return 8 * (i >> 2) + 4 * n + (i & 3); }

struct Unit { int pm, pn; };
struct Gemm { const bf16_t* A; const bf16_t* Bt; int M, N, K; };

struct StaticOrder {
    int nM, nN, nwg, G, c;
    __host__ __device__ void init(int M, int N, int G_, int c_) { nM = M / BM; nN = N / BM; nwg = nM * nN; G = G_; c = c_; }
    __host__ __device__ bool next(int i, Unit& u) const {
        const long L = (long)i * G + c; if (L >= nwg) return false;
        int wgid = (int)L; { const int q = nwg / NXCD, r = nwg % NXCD, xcd = wgid % NXCD, off = wgid / NXCD; wgid = (xcd < r ? xcd * (q + 1) : r * (q + 1) + (xcd - r) * q) + off; }
        const int nig = WGM * nN, gid = wgid / nig, fm = gid * WGM, gsz = (nM - fm) < WGM ? (nM - fm) : WGM;
        u.pm = fm + ((wgid % nig) % gsz); u.pn = (wgid % nig) / gsz; return true;
    }
    __device__ __forceinline__ void a_ready(const Unit&) const {}
    __device__ __forceinline__ void done(const Unit&) const {}
};

template <class St> struct EpiAdapt8 {
    static constexpr bool PERM = true, AFTER_DRAIN = false; St st;
    __device__ __forceinline__ void operator()(const f32x4 (&acc)[2][2][4][2], const Unit& u, int wr, int wc, int fr, int fq) const {
#pragma unroll
        for (int ai = 0; ai < 2; ++ai)
#pragma unroll
            for (int m = 0; m < 4; ++m)
#pragma unroll
                for (int bj = 0; bj < 2; ++bj) st.store8(u.pm * BM + ai * HALF + wr * 64 + m * 16 + fr, u.pn * BM + bj * HALF + wc * 32 + 8 * fq, acc[ai][bj][m][0], acc[ai][bj][m][1]);
    }
};
template <class St> struct EpiAdapt {
    static constexpr bool PERM = false, AFTER_DRAIN = false; St st;
    __device__ __forceinline__ void operator()(const f32x4 (&acc)[2][2][4][2], const Unit& u, int wr, int wc, int fr, int fq) const {
#pragma unroll
        for (int ai = 0; ai < 2; ++ai)
#pragma unroll
            for (int m = 0; m < 4; ++m)
#pragma unroll
                for (int bj = 0; bj < 2; ++bj)
#pragma unroll
                    for (int n = 0; n < 2; ++n) st.store(u.pm * BM + ai * HALF + wr * 64 + m * 16 + fr, u.pn * BM + bj * HALF + wc * 32 + n * 16 + 4 * fq, acc[ai][bj][m][n]);
    }
};

struct EpiResidSS {
    static constexpr bool PERM = true, AFTER_DRAIN = false; const float* base; float* out; bf16_t* hb; float* ss;
    __device__ __forceinline__ void operator()(const f32x4 (&acc)[2][2][4][2], const Unit& u, int wr, int wc, int fr, int fq) const {
#pragma unroll
        for (int ai = 0; ai < 2; ++ai)
#pragma unroll
            for (int m = 0; m < 4; ++m) {
                const int row = u.pm * BM + ai * HALF + wr * 64 + m * 16 + fr; float s = 0.f;
#pragma unroll
                for (int bj = 0; bj < 2; ++bj) {
                    const size_t o = (size_t)row * 1024 + u.pn * BM + bj * HALF + wc * 32 + 8 * fq;
                    const f32x4 v0 = *(const f32x4*)(base + o) + acc[ai][bj][m][0], v1 = *(const f32x4*)(base + o + 4) + acc[ai][bj][m][1];
                    *(f32x4*)(out + o) = v0; *(f32x4*)(out + o + 4) = v1;
                    { const float f0 = v0.x, f1 = v0.y, f2 = v0.z, f3 = v0.w, f4 = v1.x, f5 = v1.y, f6 = v1.z, f7 = v1.w;
                      *(u32x4*)(hb + o) = (u32x4){::pk2(f0, f1), ::pk2(f2, f3), ::pk2(f4, f5), ::pk2(f6, f7)}; }
                    s += (v0.x * v0.x + v0.y * v0.y) + (v0.z * v0.z + v0.w * v0.w) + (v1.x * v1.x + v1.y * v1.y) + (v1.z * v1.z + v1.w * v1.w);
                }
                s += __shfl_xor(s, 16); s += __shfl_xor(s, 32);
                if (fq == 0) atomicAdd(ss + row, s);
            }
    }
};
template <class Epi, class Sched, bool ALIGN_EPI = false, bool SP2 = false>
__device__ __forceinline__ void gemm_phase(PG8_LAS unsigned char* lds, const Gemm g, const Sched& S, const Epi& E) {
    const int tid = threadIdx.x, wid = __builtin_amdgcn_readfirstlane(tid >> 6), lane = tid & 63, wr = wid >> 2, wc = wid & 3, fr = lane & 15, fq = lane >> 4;
    const int K = g.K, nt = K / BK;
    unsigned voffA[2], voffB[2];
#pragma unroll
    for (int i = 0; i < 2; ++i) { int R, C; stage_rc(tid * 16 + i * 8192, R, C); const int Rb = Epi::PERM ? ((R & ~31) + perm32(R & 31)) : R;
        voffA[i] = (unsigned)(R * K + C) * 2u; voffB[i] = (unsigned)(Rb * K + C) * 2u; }
    const size_t kstep = (size_t)(BK * 2);
    const size_t hstep = (size_t)HALF * K * 2;
    const size_t tstep = 2 * hstep;
    const unsigned ldsw = (unsigned)wid * 1024u;
    const int aoff = lds_byte(wr * 64 + fr, fq * 8), boff = lds_byte(wc * 32 + fr, fq * 8);
#define PG8_SA(b, h) (((b) * 2 + (h)) * HTB)
#define PG8_SB(b, h) ((4 + (b) * 2 + (h)) * HTB)
#define PG8_STAGE(bufoff, gbase, voff) do { _Pragma("unroll") for (int _i = 0; _i < 2; ++_i) \
        __builtin_amdgcn_global_load_lds((const unsigned*)((const char*)(gbase) + (voff)[_i]), (PG8_LAS unsigned*)(lds + (bufoff) + ldsw + _i * 8192), 16, 0, 0); } while (0)
#define PG8_LDA(dst, b, h) do { _Pragma("unroll") for (int m = 0; m < 4; ++m) _Pragma("unroll") for (int k = 0; k < 2; ++k) dst[m][k] = *(const PG8_LAS bf16x8*)(lds + PG8_SA(b, h) + aoff + m * 2048 + k * 1024); } while (0)
#define PG8_LDB(dst, b, h) do { _Pragma("unroll") for (int n = 0; n < 2; ++n) _Pragma("unroll") for (int k = 0; k < 2; ++k) dst[n][k] = *(const PG8_LAS bf16x8*)(lds + PG8_SB(b, h) + boff + n * 2048 + k * 1024); } while (0)
#define PG8_MMA(ai, bj, At, Bt) do { __builtin_amdgcn_s_setprio(1); _Pragma("unroll") for (int m = 0; m < 4; ++m) _Pragma("unroll") for (int n = 0; n < 2; ++n) _Pragma("unroll") for (int k = 0; k < 2; ++k) \
        acc[ai][bj][m][n] = __builtin_amdgcn_mfma_f32_16x16x32_bf16(Bt[n][k], At[m][k], acc[ai][bj][m][n], 0, 0, 0); __builtin_amdgcn_s_setprio(0); } while (0)
#define PG8_WAIT_V(n) asm volatile("s_waitcnt vmcnt(" #n ")" ::: "memory")
#define PG8_WAIT_L(n) asm volatile("s_waitcnt lgkmcnt(" #n ")" ::: "memory")
#define PG8_BAR __builtin_amdgcn_s_barrier()
#define PG8_SCHED __builtin_amdgcn_sched_barrier(0)
    Unit cur, nxt; int ui = 0;
    if (!S.next(0, cur)) return;
    f32x4 acc[2][2][4][2];
#pragma unroll
    for (int a = 0; a < 2; ++a)
#pragma unroll
        for (int b = 0; b < 2; ++b)
#pragma unroll
            for (int m = 0; m < 4; ++m)
#pragma unroll
                for (int n = 0; n < 2; ++n) acc[a][b][m][n] = (f32x4){0.f, 0.f, 0.f, 0.f};
    bf16x8 At[4][2], B0[2][2], B1[2][2];
    const char* cA = (const char*)g.A + (size_t)cur.pm * tstep; const char* cB = (const char*)g.Bt + (size_t)cur.pn * tstep;
    S.a_ready(cur);
    if constexpr (SP2) {
        PG8_STAGE(PG8_SB(0, 0), cB, voffB); PG8_STAGE(PG8_SB(0, 1), cB + hstep, voffB); PG8_STAGE(PG8_SA(0, 0), cA, voffA); PG8_STAGE(PG8_SA(0, 1), cA + hstep, voffA);
        if (wr == 1) PG8_BAR;
        PG8_WAIT_V(2); PG8_BAR;
        PG8_STAGE(PG8_SB(1, 0), cB + kstep, voffB); PG8_STAGE(PG8_SA(1, 0), cA + kstep, voffA); PG8_STAGE(PG8_SB(1, 1), cB + hstep + kstep, voffB);
        PG8_WAIT_V(6); PG8_BAR;
    } else {
        PG8_STAGE(PG8_SB(0, 0), cB, voffB); PG8_STAGE(PG8_SA(0, 0), cA, voffA); PG8_STAGE(PG8_SB(0, 1), cB + hstep, voffB); PG8_STAGE(PG8_SA(0, 1), cA + hstep, voffA);
        if (wr == 1) PG8_BAR;
        PG8_WAIT_V(4); PG8_BAR;
        PG8_STAGE(PG8_SB(1, 0), cB + kstep, voffB); PG8_STAGE(PG8_SA(1, 0), cA + kstep, voffA); PG8_STAGE(PG8_SB(1, 1), cB + hstep + kstep, voffB);
        PG8_WAIT_V(6); PG8_BAR;
    }
    for (;;) {
        const bool has_next = S.next(ui + 1, nxt);
        const char* nA = has_next ? (const char*)g.A + (size_t)nxt.pm * tstep : cA; const char* nB = has_next ? (const char*)g.Bt + (size_t)nxt.pn * tstep : cB;
        for (int t = 0; t < nt; t += 2) {
            const bool last = (t == nt - 2);
            const char* a1 = cA + (size_t)(t + 1) * kstep;
            const char* a2 = last ? nA : cA + (size_t)(t + 2) * kstep; const char* b2 = last ? nB : cB + (size_t)(t + 2) * kstep;
            const char* a3 = a2 + kstep; const char* b3 = b2 + kstep;
            if (last && has_next) S.a_ready(nxt);
            if constexpr (SP2) {
            PG8_LDB(B0, 0, 0); PG8_LDB(B1, 0, 1); PG8_SCHED; PG8_LDA(At, 0, 0); PG8_STAGE(PG8_SA(1, 1), a1 + hstep, voffA);
            PG8_WAIT_V(8); PG8_WAIT_L(0); PG8_BAR; PG8_MMA(0, 0, At, B0); PG8_MMA(0, 1, At, B1); PG8_BAR; PG8_SCHED;
            PG8_LDA(At, 0, 1); PG8_STAGE(PG8_SB(0, 0), b2, voffB); PG8_STAGE(PG8_SB(0, 1), b2 + hstep, voffB); PG8_STAGE(PG8_SA(0, 0), a2, voffA);
            PG8_WAIT_V(8); PG8_WAIT_L(0); PG8_BAR; PG8_MMA(1, 0, At, B0); PG8_MMA(1, 1, At, B1); PG8_BAR; PG8_SCHED;
            PG8_LDB(B0, 1, 0); PG8_LDB(B1, 1, 1); PG8_SCHED; PG8_LDA(At, 1, 0); PG8_STAGE(PG8_SA(0, 1), a2 + hstep, voffA);
            PG8_WAIT_V(8); PG8_WAIT_L(0); PG8_BAR; PG8_MMA(0, 0, At, B0); PG8_MMA(0, 1, At, B1); PG8_BAR; PG8_SCHED;
            PG8_LDA(At, 1, 1); PG8_STAGE(PG8_SB(1, 0), b3, voffB); PG8_STAGE(PG8_SB(1, 1), b3 + hstep, voffB); PG8_STAGE(PG8_SA(1, 0), a3, voffA);
            PG8_WAIT_V(8); PG8_WAIT_L(0); PG8_BAR; PG8_MMA(1, 0, At, B0); PG8_MMA(1, 1, At, B1); PG8_BAR; PG8_SCHED;
            } else {
            PG8_LDB(B0, 0, 0); PG8_SCHED; PG8_LDA(At, 0, 0); PG8_STAGE(PG8_SA(1, 1), a1 + hstep, voffA);
            PG8_WAIT_L(8); PG8_BAR; PG8_WAIT_L(0); PG8_MMA(0, 0, At, B0); PG8_BAR; PG8_SCHED;
            PG8_LDB(B1, 0, 1); PG8_STAGE(PG8_SB(0, 0), b2, voffB);
            PG8_BAR; PG8_WAIT_L(0); PG8_MMA(0, 1, At, B1); PG8_BAR;
            PG8_LDA(At, 0, 1); PG8_STAGE(PG8_SA(0, 0), a2, voffA);
            PG8_BAR; PG8_WAIT_L(0); PG8_MMA(1, 0, At, B0); PG8_BAR; PG8_SCHED;
            PG8_STAGE(PG8_SB(0, 1), b2 + hstep, voffB);
            PG8_WAIT_V(6); PG8_BAR; PG8_MMA(1, 1, At, B1); PG8_BAR;
            PG8_LDB(B0, 1, 0); PG8_SCHED; PG8_LDA(At, 1, 0); PG8_STAGE(PG8_SA(0, 1), a2 + hstep, voffA);
            PG8_WAIT_L(8); PG8_BAR; PG8_WAIT_L(0); PG8_MMA(0, 0, At, B0); PG8_BAR; PG8_SCHED;
            PG8_LDB(B1, 1, 1); PG8_STAGE(PG8_SB(1, 0), b3, voffB);
            PG8_BAR; PG8_WAIT_L(0); PG8_MMA(0, 1, At, B1); PG8_BAR;
            PG8_LDA(At, 1, 1); PG8_STAGE(PG8_SA(1, 0), a3, voffA);
            PG8_BAR; PG8_WAIT_L(0); PG8_MMA(1, 0, At, B0); PG8_BAR; PG8_SCHED;
            PG8_STAGE(PG8_SB(1, 1), b3 + hstep, voffB);
            PG8_WAIT_V(6); PG8_BAR; PG8_MMA(1, 1, At, B1); PG8_BAR;
            }
        }
        if constexpr (ALIGN_EPI) { if (wr == 0) PG8_BAR; }
        if constexpr (!Epi::AFTER_DRAIN) { E(acc, cur, wr, wc, fr, fq); S.done(cur); }
        if (!has_next) break;
#pragma unroll
        for (int a = 0; a < 2; ++a)
#pragma unroll
            for (int b = 0; b < 2; ++b)
#pragma unroll
                for (int m = 0; m < 4; ++m)
#pragma unroll
                    for (int n = 0; n < 2; ++n) acc[a][b][m][n] = (f32x4){0.f, 0.f, 0.f, 0.f};
        cur = nxt; cA = nA; cB = nB; ++ui;
        if constexpr (ALIGN_EPI) { if (wr == 1) PG8_BAR; }
    }
    PG8_WAIT_V(0);
    if constexpr (!ALIGN_EPI) { if (wr == 0) PG8_BAR; }
    PG8_BAR;
    if constexpr (Epi::AFTER_DRAIN) { E.fused(acc, cur, wr, wc, fr, fq, lds, wid, lane); S.done(cur); }
#undef PG8_SA
#undef PG8_SB
#undef PG8_STAGE
#undef PG8_LDA
#undef PG8_LDB
#undef PG8_MMA
#undef PG8_WAIT_V
#undef PG8_WAIT_L
#undef PG8_BAR
#undef PG8_SCHED
}
}


template <class Epi>
__device__ __forceinline__ void run_gemm_raw(unsigned char* lds, const bf16_t* A, const bf16_t* Bt, int M, int N, int K, const Epi& E) {
  pg8::Gemm g{A, Bt, M, N, K}; pg8::StaticOrder S; S.init(M, N, (int)gridDim.x, (int)blockIdx.x);
  pg8::gemm_phase<Epi, pg8::StaticOrder, true, true>((PG8_LAS unsigned char*)lds, g, S, E);
}
template <class St>
__device__ __forceinline__ void run_gemm8(unsigned char* lds, const bf16_t* A, const bf16_t* Bt, int M, int N, int K, const St& st) {
  pg8::Gemm g{A, Bt, M, N, K}; pg8::StaticOrder S; S.init(M, N, (int)gridDim.x, (int)blockIdx.x);
  pg8::EpiAdapt8<St> E{st};
  pg8::gemm_phase<pg8::EpiAdapt8<St>, pg8::StaticOrder, true, true>((PG8_LAS unsigned char*)lds, g, S, E);
}
template <class St>
__device__ __forceinline__ void run_gemm(unsigned char* lds, const bf16_t* A, const bf16_t* Bt, int M, int N, int K, const St& st, int gw, int ngw, int lane) {
#if USE_PG8
  pg8::Gemm g{A, Bt, M, N, K}; pg8::StaticOrder S; S.init(M, N, (int)gridDim.x, (int)blockIdx.x);
  pg8::EpiAdapt<St> E{st};
  pg8::gemm_phase<pg8::EpiAdapt<St>, pg8::StaticOrder, true, true>((PG8_LAS unsigned char*)lds, g, S, E);
#else
  gemm_naive(A, K, Bt, K, M, N, K, st, gw, ngw, lane);
#endif
}

#define GAS __attribute__((address_space(1)))
#define LAS __attribute__((address_space(3)))
#define XB_TMO      128
#define XB_XCNT(j)  (256  + 64 * (j))
#define XB_XSUB(j)  (1280 + 64 * (j))
#define XB_XGEN(j)  (2304 + 64 * (j))
#define XB_TOP      3328
#define XB_TOPGEN   3392
#define XCD_BAR_WORDS 3456
#define XB_SPIN_CAP (1u << 18)

__device__ __forceinline__ unsigned xb_ld(unsigned* p)              { return __hip_atomic_load(p, __ATOMIC_RELAXED, __HIP_MEMORY_SCOPE_AGENT); }
__device__ __forceinline__ unsigned xb_add(unsigned* p, unsigned v) { return __hip_atomic_fetch_add(p, v, __ATOMIC_RELAXED, __HIP_MEMORY_SCOPE_AGENT); }
__device__ __forceinline__ unsigned xb_xcc_id() { return (unsigned)__builtin_amdgcn_s_getreg((3 << 11) | 20) & 0xFu; }
#define XB_SPIN(cond, bar) do { unsigned _sp = 0; while (cond) { __builtin_amdgcn_s_sleep(1); \
    if ((++_sp & 255u) == 0u) { if (xb_ld(&(bar)[XB_TMO])) break; if (_sp > XB_SPIN_CAP) { atomicAdd(&(bar)[XB_TMO], 1u); break; } } } } while (0)

struct XcdBarrier {
    unsigned* bar; unsigned x;
    volatile LAS unsigned* st;
};

__device__ __forceinline__ XcdBarrier xcd_barrier_post(unsigned* bar, volatile LAS unsigned* st) {
    XcdBarrier b; b.bar = bar; b.x = xb_xcc_id(); b.st = st;
    if (threadIdx.x == 0) (void)xb_add(&bar[XB_XCNT(b.x)], 1u);
    return b;
}
__device__ __forceinline__ void xcd_barrier_complete(unsigned* bar, unsigned x, unsigned& nloc, unsigned& nx) {
    const unsigned G = gridDim.x * gridDim.y * gridDim.z;
    unsigned sum, cnt, mine, sp = 0u;
    for (;;) {
        sum = 0u; cnt = 0u; mine = 0u;
#pragma unroll
        for (unsigned j = 0; j < 16; ++j) { const unsigned c = xb_ld(&bar[XB_XCNT(j)]); sum += c; cnt += (c > 0u) ? 1u : 0u; mine = (j == x) ? c : mine; }
        if (sum == G) break;
        __builtin_amdgcn_s_sleep(1);
        if ((++sp & 255u) == 0u) { if (xb_ld(&bar[XB_TMO])) break; if (sp > XB_SPIN_CAP) { atomicAdd(&bar[XB_TMO], 1u); break; } }
    }
    nloc = mine > 0u ? mine : 1u; nx = cnt > 0u ? cnt : 1u;
}

__device__ __forceinline__ void xcd_barrier(const XcdBarrier& b) {
    asm volatile("s_waitcnt vmcnt(0)" ::: "memory");
    __syncthreads();
    if (threadIdx.x == 0) {
        unsigned* bar = b.bar;
        __builtin_amdgcn_s_waitcnt(0);
        unsigned nloc = b.st[0], nx = b.st[1];
        if (nloc == 0u) { xcd_barrier_complete(bar, b.x, nloc, nx); b.st[0] = nloc; b.st[1] = nx; }
        const unsigned old = xb_add(&bar[XB_XSUB(b.x)], 1u);
        const unsigned gen = old / nloc;
        if (old + 1u == (gen + 1u) * nloc) {
            __builtin_amdgcn_fence(__ATOMIC_RELEASE, "agent");
            asm volatile("s_waitcnt vmcnt(0)" ::: "memory");
            const unsigned og = xb_add(&bar[XB_TOP], 1u);
            const unsigned tg = og / nx;
            if (og + 1u == (tg + 1u) * nx) xb_add(&bar[XB_TOPGEN], 1u);
            else XB_SPIN(xb_ld(&bar[XB_TOPGEN]) == tg, bar);
            __builtin_amdgcn_fence(__ATOMIC_ACQUIRE, "agent");
            xb_add(&bar[XB_XGEN(b.x)], 1u);
            asm volatile("s_waitcnt vmcnt(0)" ::: "memory");
        } else {
            XB_SPIN(xb_ld(&bar[XB_XGEN(b.x)]) == gen, bar);
            __builtin_amdgcn_fence(__ATOMIC_ACQUIRE, "agent");
            asm volatile("s_waitcnt vmcnt(0)" ::: "memory");
        }
    }
    __syncthreads();
}

__device__ __forceinline__ void phase_exp_up(const Args& a, unsigned char* lds, const XcdBarrier& bar, int tid, int wave, int lane, unsigned* ctr, float* xout, float* ssout) {
  unsigned* slot = (unsigned*)(lds + 8 * 16640);
  const int x0 = (int)(xb_xcc_id() & 7u);
  for (int k = 0; k < 8; ++k) {
    const int xs = (x0 + k) & 7;
    for (;;) {
      __syncthreads();
      if (tid == 0) slot[0] = atomicAdd(ctr + 16 * xs, 1u);
      __syncthreads();
      const unsigned item = slot[0];
      if (item >= (unsigned)(NT / 128)) break;
      exp_up_item(a, lds, xs, (int)item, wave, lane, xout, ssout);
    }
  }
}

__global__ void __launch_bounds__(512, 2) mega(Args a) {
  extern __shared__ __attribute__((aligned(16))) unsigned char lds[];
  cg::grid_group grid = cg::this_grid();
  const int tid = threadIdx.x, lane = tid & 63, wave = tid >> 6;
  const int gw = blockIdx.x * 8 + wave, ngw = gridDim.x * 8;
  unsigned char* ws = a.ws;
  const int lo = a.ph_lo, hi = a.ph_hi;
#define IN(k) (lo <= (k) && (k) < hi)
  volatile LAS unsigned* MISC = (volatile LAS unsigned*)((LAS unsigned char*)lds + 146944);
  if (tid < 32) MISC[tid] = 0u;
  __syncthreads();
  XcdBarrier bar; bar.bar = (unsigned*)(ws + WS_BAR); bar.x = 0; bar.st = nullptr;
  if (hi - lo > 1) bar = xcd_barrier_post((unsigned*)(ws + WS_BAR), MISC + 8);
  if (lo < -1000000) grid.sync();
#define SEAM(k) do { if (IN(k) && IN((k) + 1)) xcd_barrier(bar); } while (0)
#if PROBE_REP == 0
  if (IN(0)) { phase_prep(a, lds, gw, ngw, wave, lane, tid); grid.sync(); }
#endif
  if (IN(0)) { phase_prep(a, lds, gw, ngw, wave, lane, tid); } SEAM(0);
#if PROBE_REP == 1
  if (IN(1)) {
    run_gemm8(lds, (const bf16_t*)(ws + WS_HB), (const bf16_t*)(ws + WS_WIN_T), NT, NQKV, DM, EpiQKV{(bf16_t*)(ws + WS_QKV)});
    run_gemm8(lds, (const bf16_t*)(ws + WS_MEMN), (const bf16_t*)(ws + WS_WXKV_T), NMROWS, 2048, DM, EpiBf16{(bf16_t*)(ws + WS_KX), 2048});
    xcd_barrier(bar); }
#endif
#if PROBE_REP == 2
  if (IN(2)) { phase_scan(a, gw, ngw, lane, tid); xcd_barrier(bar); phase_rms(a, gw, ngw, lane); xcd_barrier(bar); phase_rms(a, gw, ngw, lane); xcd_barrier(bar); }
#endif
  if (IN(1)) {
    run_gemm8(lds, (const bf16_t*)(ws + WS_HB), (const bf16_t*)(ws + WS_WIN_T), NT, NQKV, DM, EpiQKV{(bf16_t*)(ws + WS_QKV)});
    run_gemm8(lds, (const bf16_t*)(ws + WS_MEMN), (const bf16_t*)(ws + WS_WXKV_T), NMROWS, 2048, DM, EpiBf16{(bf16_t*)(ws + WS_KX), 2048});
  } SEAM(1);
  if (IN(2)) { for (int rep = 0; rep < a.rep_scan; ++rep) { phase_scan(a, gw, ngw, lane, tid); if (rep + 1 < a.rep_scan) xcd_barrier(bar); } } SEAM(2);
#if PROBE_REP == 3
  if (IN(3)) { phase_attn2(a, lds, tid); xcd_barrier(bar); if (blockIdx.x == 0 && tid == 0) *(unsigned*)(ws) = 0u; xcd_barrier(bar); }
#endif
  if (IN(3)) {
#if USE_ATT2
    phase_attn2(a, lds, tid);
#else
    phase_attn(a, lds, tid);
#endif
  } SEAM(3);
  if (IN(4)) { phase_onorm(a, gw, ngw, lane); } SEAM(4);
  if (IN(5)) { run_gemm_raw(lds, (const bf16_t*)(ws + WS_OAB), (const bf16_t*)(ws + WS_WOUT_T), NT, DM, DM, pg8::EpiResidSS{a.in[0], a.out, (bf16_t*)(ws + WS_HB), (float*)(ws + WS_SS1)}); }
  if (IN(5) && IN(7)) xcd_barrier(bar);
  if (IN(7)) { run_gemm8(lds, (const bf16_t*)(ws + WS_HB), (const bf16_t*)(ws + WS_WXQ_T), NT, DM, DM, EpiBf16S{(bf16_t*)(ws + WS_QX), DM, (const float*)(ws + WS_SS1)}); } SEAM(7);
#if PROBE_REP == 8
  if (IN(8)) { phase_xattn(a, lds, gw, ngw, wave, lane); grid.sync(); }
#endif
  if (IN(8)) { phase_xattn2(a, lds, tid); } SEAM(8);
  if (IN(9)) { run_gemm_raw(lds, (const bf16_t*)(ws + WS_OX), (const bf16_t*)(ws + WS_WXO_T), NT, DM, DM, pg8::EpiResidSS{a.out, a.out, (bf16_t*)(ws + WS_HB), (float*)(ws + WS_SS2)}); }
  if (IN(9) && IN(11)) xcd_barrier(bar);
  if (IN(11)) { run_gemm8(lds, (const bf16_t*)(ws + WS_HB), (const bf16_t*)(ws + WS_WPQ_T), NT, DM, DM, EpiBf16S{(bf16_t*)(ws + WS_PQ), DM, (const float*)(ws + WS_SS2)}); } SEAM(11);
#if PROBE_REP == 12
  if (IN(12)) { phase_topk(a, lds, tid); grid.sync(); }
#endif
  if (IN(12)) { phase_topk2(a, lds, wave, lane); } SEAM(12);
    if (IN(13)) {
    for (int rep = 0; rep < a.rep_down; ++rep) { phase_exp_down(a, gw, ngw, lane); if (hi - lo > 1) xcd_barrier(bar); }
    phase_exp_up2(a, lds, wave, lane);
  }
#undef IN
#undef SEAM
}

extern "C" void kernel_launch(void* const* d_in, const int* in_sizes, int n_in, void* d_out, int out_size, void* d_ws, size_t ws_size, hipStream_t stream) {
  static int grid = 0;
  if (grid == 0) {
    if (n_in != 22 || out_size != NT * DM || ws_size < WS_END) { fprintf(stderr, "kernel_launch: unexpected shapes (n_in %d out %d ws %zu)\n", n_in, out_size, ws_size); grid = -1; return; }
    int dev = 0, cus = 0, per_cu = 0;
    (void)hipGetDevice(&dev);
    (void)hipDeviceGetAttribute(&cus, hipDeviceAttributeMultiprocessorCount, dev);
    (void)hipFuncSetAttribute((const void*)mega, hipFuncAttributeMaxDynamicSharedMemorySize, LDS_BYTES);
    (void)hipOccupancyMaxActiveBlocksPerMultiprocessor(&per_cu, (const void*)mega, 512, LDS_BYTES);
    if (per_cu < 1) per_cu = 1;
    grid = cus * per_cu;
  }
  if (grid < 0) return;
  (void)hipMemsetAsync(d_ws, 0, CTL_ZERO_BYTES, stream);
  Args a{};
  for (int i = 0; i < 22; ++i) a.in[i] = (const float*)d_in[i];
  a.out = (float*)d_out; a.ws = (unsigned char*)d_ws;
  a.rep_down = REP_DOWN; a.rep_up = REP_UP; a.rep_scan = REP_SCAN;
#if MK_N_LAUNCHES == 1
  a.ph_lo = 0; a.ph_hi = NPHASE + 1;
  void* args[] = {&a};
  hipError_t e = hipLaunchCooperativeKernel((const void*)mega, dim3(grid), dim3(512), args, LDS_BYTES, stream);
  if (e != hipSuccess) fprintf(stderr, "cooperative launch failed: %s (grid %d)\n", hipGetErrorString(e), grid);
#else
  for (int p = 0; p <= NPHASE; ++p) { a.ph_lo = p; a.ph_hi = p + 1; hipLaunchKernelGGL(mega, dim3(grid), dim3(512), LDS_BYTES, stream, a); }
#endif
}
```

```cpp
#include <hip/hip_runtime.h>
#include <hip/hip_cooperative_groups.h>
#include <cstdio>
#include <cstdint>
namespace cg = cooperative_groups;

#ifndef USE_PG8
#define USE_PG8 1
#endif
#ifndef USE_ATT2
#define USE_ATT2 1
#endif
#ifndef PROBE_REP
#define PROBE_REP -1
#endif
#ifndef REP_DOWN
#define REP_DOWN 1
#endif
#ifndef REP_UP
#define REP_UP 1
#endif
#ifndef REP_SCAN
#define REP_SCAN 1
#endif
#ifndef MK_N_LAUNCHES
#define MK_N_LAUNCHES 1
#endif

typedef unsigned short bf16_t;
typedef short bf16x8 __attribute__((ext_vector_type(8)));
typedef float f32x4 __attribute__((ext_vector_type(4)));
typedef unsigned u32x4 __attribute__((ext_vector_type(4)));
typedef unsigned u32x2 __attribute__((ext_vector_type(2)));
typedef float v32f __attribute__((ext_vector_type(32)));
typedef float v16f __attribute__((ext_vector_type(16)));
typedef unsigned v6u __attribute__((ext_vector_type(6)));
typedef float f32x2 __attribute__((ext_vector_type(2)));

constexpr int NB = 8, SEQ = 4096, DM = 1024, NT = NB * SEQ;
constexpr int NQKV = 3072, INW = 3080;
constexpr int NMEM = 256, NMROWS = NB * NMEM;
constexpr int NEXP = 16384;
constexpr float EPS = 1e-6f;
constexpr int NPHASE = 13;
constexpr int LDS_BYTES = 147456;

constexpr size_t MiB = 1u << 20;
constexpr size_t WS_BAR = 65536;
constexpr size_t WS_SS1 = 131072;
constexpr size_t WS_SS2 = 262144;
constexpr size_t WS_SS3 = 393216;
constexpr size_t WS_XCTR = 512;
constexpr size_t CTL_ZERO_BYTES = 524288;
constexpr size_t WS_WIN_T = 2 * MiB;
constexpr size_t WS_WOUT_T = 8 * MiB;
constexpr size_t WS_WXQ_T = 10 * MiB;
constexpr size_t WS_WXKV_T = 12 * MiB;
constexpr size_t WS_WXO_T = 16 * MiB;
constexpr size_t WS_WPQ_T = 18 * MiB;
constexpr size_t WS_SK = 21 * MiB;
constexpr size_t WS_MEMN = 22 * MiB;
constexpr size_t WS_KX = 26 * MiB;
constexpr size_t WS_VXT = 30 * MiB;
constexpr size_t WS_FLOG = 34 * MiB;
constexpr size_t WS_CUM = 35 * MiB;
constexpr size_t WS_KMEAN = 36 * MiB;
constexpr size_t WS_ESC = 38 * MiB;
constexpr size_t WS_EXD = 40 * MiB;
constexpr size_t WS_EXU = 72 * MiB;
constexpr size_t WS_HB = 104 * MiB;
constexpr size_t WS_QKV = 168 * MiB;
constexpr size_t WS_OAB = 360 * MiB;
constexpr size_t WS_QX = 168 * MiB;
constexpr size_t WS_OX = 232 * MiB;
constexpr size_t WS_PQ = 232 * MiB;
constexpr size_t WS_EIDX = 424 * MiB;
constexpr size_t WS_GATE = 440 * MiB;
constexpr size_t WS_W = 456 * MiB;
constexpr size_t WS_END = 472 * MiB;

struct Args {
  const float* in[22];
  float* out;
  unsigned char* ws;
  int ph_lo, ph_hi;
  int rep_down, rep_up, rep_scan, pad_;
};

struct XcdBarrier;
__device__ __forceinline__ unsigned f2bf(float f) { unsigned u = __float_as_uint(f); return (u + 0x7fffu + ((u >> 16) & 1u)) >> 16; }
__device__ __forceinline__ unsigned pk2(float lo, float hi) { return f2bf(lo) | (f2bf(hi) << 16); }
__device__ __forceinline__ float bf2f(unsigned short b) { return __uint_as_float(((unsigned)b) << 16); }
__device__ __forceinline__ float bflo(unsigned w) { return __uint_as_float(w << 16); }
__device__ __forceinline__ float bfhi(unsigned w) { return __uint_as_float(w & 0xffff0000u); }
__device__ __forceinline__ float wave_sum(float v) {
#pragma unroll
  for (int o = 1; o < 64; o <<= 1) v += __shfl_xor(v, o);
  return v;
}
template <int O> __device__ __forceinline__ float swz_xor(float v) { return __int_as_float(__builtin_amdgcn_ds_swizzle(__float_as_int(v), (O << 10) | 0x1f)); }
__device__ __forceinline__ float half_sum32(float v) { v += swz_xor<1>(v); v += swz_xor<2>(v); v += swz_xor<4>(v); v += swz_xor<8>(v); v += swz_xor<16>(v); return v; }
__device__ __forceinline__ void unpack8(const u32x4 w, float* f) {
  f[0] = bflo(w.x); f[1] = bfhi(w.x); f[2] = bflo(w.y); f[3] = bfhi(w.y);
  f[4] = bflo(w.z); f[5] = bfhi(w.z); f[6] = bflo(w.w); f[7] = bfhi(w.w);
}

__device__ const unsigned char T5_BUCKET[128] = {
  0, 1, 2, 3, 4, 5, 6, 7, 8, 9, 10, 11, 12, 13, 14, 15, 16, 16, 16, 17, 17, 18, 18, 18, 19, 19, 19, 20, 20, 20, 20, 21,
  21, 21, 21, 22, 22, 22, 22, 22, 23, 23, 23, 23, 23, 23, 24, 24, 24, 24, 24, 24, 25, 25, 25, 25, 25, 25, 25, 26, 26, 26, 26, 26,
  26, 26, 26, 27, 27, 27, 27, 27, 27, 27, 27, 27, 27, 28, 28, 28, 28, 28, 28, 28, 28, 28, 28, 29, 29, 29, 29, 29, 29, 29, 29, 29,
  29, 29, 29, 30, 30, 30, 30, 30, 30, 30, 30, 30, 30, 30, 30, 30, 30, 31, 31, 31, 31, 31, 31, 31, 31, 31, 31, 31, 31, 31, 31, 31};

__device__ __forceinline__ void transpose_item(const float* W, int ldw, const float* gain, bf16_t* WT, int K, int row_off, float* scr, int kb, int nb, int lane) {
  const int k0 = 64 * kb, n0 = 32 * nb;
#pragma unroll 8
  for (int i = 0; i < 32; ++i) {
    const int kk = 2 * i + (lane >> 5);
    const float g = gain ? gain[k0 + kk] : 1.f;
    scr[kk * 33 + (lane & 31)] = W[(size_t)(k0 + kk) * ldw + n0 + (lane & 31)] * g;
  }
  __builtin_amdgcn_wave_barrier();
  const int c = lane & 7;
#pragma unroll
  for (int j = 0; j < 4; ++j) {
    const int n = (lane >> 3) + 8 * j; const float* s = scr + (8 * c) * 33 + n;
    u32x4 o; o.x = pk2(s[0 * 33], s[1 * 33]); o.y = pk2(s[2 * 33], s[3 * 33]); o.z = pk2(s[4 * 33], s[5 * 33]); o.w = pk2(s[6 * 33], s[7 * 33]);
    *(u32x4*)(WT + (size_t)(row_off + n0 + n) * K + k0 + 8 * c) = o;
  }
  __builtin_amdgcn_wave_barrier();
}

__device__ __forceinline__ void rms_row_to_bf16(const float* xrow, bf16_t* orow, int lane) {
  const f32x4* xr = (const f32x4*)xrow + lane;
  f32x4 v[4]; float s = 0.f;
#pragma unroll
  for (int j = 0; j < 4; ++j) { v[j] = xr[64 * j]; s += (v[j].x * v[j].x + v[j].y * v[j].y) + (v[j].z * v[j].z + v[j].w * v[j].w); }
  const float rstd = rsqrtf(wave_sum(s) * (1.f / DM) + EPS);
  u32x2* o = (u32x2*)orow + lane;
#pragma unroll
  for (int j = 0; j < 4; ++j) { u32x2 w; w.x = pk2(v[j].x * rstd, v[j].y * rstd); w.y = pk2(v[j].z * rstd, v[j].w * rstd); o[64 * j] = w; }
}

__device__ __forceinline__ void phase_prep(const Args& a, unsigned char* lds, int gw, int ngw, int wave, int lane, int tid) {
  unsigned char* ws = a.ws;
  float* scr = (float*)(lds + wave * 8448);
  const int I_IN = 16 * 96, I_SQ = 16 * 32;
  const int NITEMS = I_IN + 6 * I_SQ;
  for (int it = gw; it < NITEMS; it += ngw) {
    int r = it;
    if (r < I_IN) { transpose_item(a.in[3], INW, a.in[2], (bf16_t*)(ws + WS_WIN_T), DM, 0, scr, r / 96, r % 96, lane); continue; } r -= I_IN;
    const int which = r / I_SQ; r %= I_SQ; const int kb = r / 32, nb = r % 32;
    if (which == 0) { const float* g = (kb < 8) ? a.in[6] : (a.in[7] - 512); transpose_item(a.in[8], DM, g, (bf16_t*)(ws + WS_WOUT_T), DM, 0, scr, kb, nb, lane); }
    else if (which == 1) transpose_item(a.in[11], DM, a.in[9], (bf16_t*)(ws + WS_WXQ_T), DM, 0, scr, kb, nb, lane);
    else if (which == 2) transpose_item(a.in[12], DM, a.in[10], (bf16_t*)(ws + WS_WXKV_T), DM, 0, scr, kb, nb, lane);
    else if (which == 3) transpose_item(a.in[13], DM, a.in[10], (bf16_t*)(ws + WS_WXKV_T), DM, 1024, scr, kb, nb, lane);
    else if (which == 4) transpose_item(a.in[14], DM, nullptr, (bf16_t*)(ws + WS_WXO_T), DM, 0, scr, kb, nb, lane);
    else transpose_item(a.in[16], DM, a.in[15], (bf16_t*)(ws + WS_WPQ_T), DM, 0, scr, kb, nb, lane);
  }
  for (int it = gw; it < NEXP; it += ngw) {
    const int hi = lane >> 5, l32 = lane & 31; const int r = 2 * it + hi;
    const int tb = r >= NEXP, e = r - tb * NEXP;
    const f32x4* src = (const f32x4*)(a.in[19 + tb] + (size_t)e * DM) + 8 * l32;
    v16f xa, xb; float am = 0.f;
#pragma unroll
    for (int k = 0; k < 4; ++k) { const f32x4 p = src[k], q = src[4 + k];
      xa[2 * k] = p.x; xb[2 * k] = p.y; xa[2 * k + 1] = p.z; xb[2 * k + 1] = p.w; xa[8 + 2 * k] = q.x; xb[8 + 2 * k] = q.y; xa[8 + 2 * k + 1] = q.z; xb[8 + 2 * k + 1] = q.w;
      am = fmaxf(am, fmaxf(fmaxf(fabsf(p.x), fabsf(p.y)), fmaxf(fabsf(p.z), fabsf(p.w)))); am = fmaxf(am, fmaxf(fmaxf(fabsf(q.x), fabsf(q.y)), fmaxf(fabsf(q.z), fabsf(q.w)))); }
#pragma unroll
    for (int o = 1; o < 32; o <<= 1) am = fmaxf(am, __shfl_xor(am, o));
    if (tb == 0) {
      const float sc = am > 0.f ? 7.0f / am : 1.f;
      xa = xa * sc; xb = xb * sc;
      const v6u w = __builtin_amdgcn_cvt_scalef32_2xpk16_fp6_f32(xa, xb, 1.0f);
      u32x2* dst = (u32x2*)(ws + WS_EXD + (size_t)e * 768 + 24 * l32);
      dst[0] = (u32x2){w[0], w[1]}; dst[1] = (u32x2){w[2], w[3]}; dst[2] = (u32x2){w[4], w[5]};
      if (l32 == 0) ((float*)(ws + WS_ESC))[r] = am > 0.f ? am / 7.0f : 1.f;
    } else {
      const float sc = am > 0.f ? 440.f / am : 1.f;
      u32x4 o0, o1;
#pragma unroll
      for (int k = 0; k < 4; ++k) { int w = __builtin_amdgcn_cvt_pk_fp8_f32(xa[2 * k] * sc, xb[2 * k] * sc, 0, false); w = __builtin_amdgcn_cvt_pk_fp8_f32(xa[2 * k + 1] * sc, xb[2 * k + 1] * sc, w, true); o0[k] = (unsigned)w; }
#pragma unroll
      for (int k = 0; k < 4; ++k) { int w = __builtin_amdgcn_cvt_pk_fp8_f32(xa[8 + 2 * k] * sc, xb[8 + 2 * k] * sc, 0, false); w = __builtin_amdgcn_cvt_pk_fp8_f32(xa[8 + 2 * k + 1] * sc, xb[8 + 2 * k + 1] * sc, w, true); o1[k] = (unsigned)w; }
      u32x4* dst = (u32x4*)(ws + WS_EXU + (size_t)(l32 >> 2) * (NEXP * 128) + (size_t)e * 128 + 32 * (l32 & 3));
      dst[0] = o0; dst[1] = o1;
      if (l32 == 0) ((float*)(ws + WS_ESC))[r] = am > 0.f ? am / 440.f : 1.f;
    }
  }
  for (int i = blockIdx.x * 512 + tid; i < 2 * 65536; i += gridDim.x * 512) ((bf16_t*)(ws + WS_SK))[i] = (bf16_t)f2bf(a.in[17 + (i >> 16)][i & 65535]);
  for (int r = gw; r < NMROWS; r += ngw) rms_row_to_bf16(a.in[1] + (size_t)r * DM, (bf16_t*)(ws + WS_MEMN) + (size_t)r * DM, lane);
  __syncthreads();
  float* wf = (float*)(lds + 69632);
  for (int k = tid; k < DM; k += 512) {
    const float g = a.in[2][k]; const f32x4* wp = (const f32x4*)(a.in[3] + (size_t)k * INW + NQKV);
    const f32x4 p = wp[0], q = wp[1];
    wf[k] = p.x * g; wf[1024 + k] = p.y * g; wf[2048 + k] = p.z * g; wf[3072 + k] = p.w * g; wf[4096 + k] = q.x * g; wf[5120 + k] = q.y * g; wf[6144 + k] = q.z * g; wf[7168 + k] = q.w * g;
  }
  __syncthreads();
  float* flog = (float*)(ws + WS_FLOG);
  for (int r = gw; r < NT; r += ngw) {
    const f32x4* xr = (const f32x4*)(a.in[0] + (size_t)r * DM) + lane;
    f32x4 v[4]; float s = 0.f; float fa[8];
#pragma unroll
    for (int j = 0; j < 8; ++j) fa[j] = 0.f;
#pragma unroll
    for (int j = 0; j < 4; ++j) {
      v[j] = xr[64 * j]; s += (v[j].x * v[j].x + v[j].y * v[j].y) + (v[j].z * v[j].z + v[j].w * v[j].w);
#pragma unroll
      for (int jj = 0; jj < 8; ++jj) { const f32x4 w4 = *(const f32x4*)(wf + jj * 1024 + 256 * j + 4 * lane); fa[jj] += (v[j].x * w4.x + v[j].y * w4.y) + (v[j].z * w4.z + v[j].w * w4.w); }
    }
    const float rstd = rsqrtf(wave_sum(s) * (1.f / DM) + EPS);
    float mine = 0.f;
#pragma unroll
    for (int j = 0; j < 8; ++j) { const float t = wave_sum(fa[j]); if (lane == j) mine = t; }
    if (lane < 8) {
      const float z = mine * rstd + a.in[4][lane];
      flog[(size_t)lane * NT + r] = fminf(z, 0.f) - log1pf(expf(-fabsf(z)));
    }
    u32x2* o = (u32x2*)((bf16_t*)(ws + WS_HB) + (size_t)r * DM) + lane;
#pragma unroll
    for (int j = 0; j < 4; ++j) { u32x2 w; w.x = pk2(v[j].x * rstd, v[j].y * rstd); w.y = pk2(v[j].z * rstd, v[j].w * rstd); o[64 * j] = w; }
  }
}

template <class Epi>
__device__ __forceinline__ void gemm_naive(const bf16_t* A, int lda, const bf16_t* Bt, int ldb, int M, int N, int K, const Epi& E, int gw, int ngw, int lane) {
  const int fr = lane & 15, fq = lane >> 4;
  const int tn = N / 64, ntile = (M / 64) * tn;
  for (int tile = gw; tile < ntile; tile += ngw) {
    const int pm = tile / tn, pn = tile % tn;
    f32x4 acc[4][4];
#pragma unroll
    for (int m = 0; m < 4; ++m)
#pragma unroll
      for (int n = 0; n < 4; ++n) acc[m][n] = (f32x4){0.f, 0.f, 0.f, 0.f};
    const bf16_t* Ap = A + (size_t)(pm * 64 + fr) * lda + fq * 8;
    const bf16_t* Bp = Bt + (size_t)(pn * 64 + fr) * ldb + fq * 8;
    for (int k0 = 0; k0 < K; k0 += 32) {
      bf16x8 af[4], bfr[4];
#pragma unroll
      for (int m = 0; m < 4; ++m) af[m] = *(const bf16x8*)(Ap + (size_t)m * 16 * lda + k0);
#pragma unroll
      for (int n = 0; n < 4; ++n) bfr[n] = *(const bf16x8*)(Bp + (size_t)n * 16 * ldb + k0);
#pragma unroll
      for (int m = 0; m < 4; ++m)
#pragma unroll
        for (int n = 0; n < 4; ++n) acc[m][n] = __builtin_amdgcn_mfma_f32_16x16x32_bf16(bfr[n], af[m], acc[m][n], 0, 0, 0);
    }
#pragma unroll
    for (int m = 0; m < 4; ++m)
#pragma unroll
      for (int n = 0; n < 4; ++n) E.store(pm * 64 + m * 16 + fr, pn * 64 + n * 16 + 4 * fq, acc[m][n]);
  }
}

struct EpiBf16 { bf16_t* O; int ldo;
  __device__ __forceinline__ void store8(int row, int col, f32x4 a, f32x4 b) const { u32x4 w; w.x = pk2(a.x, a.y); w.y = pk2(a.z, a.w); w.z = pk2(b.x, b.y); w.w = pk2(b.z, b.w); *(u32x4*)(O + (size_t)row * ldo + col) = w; }
  __device__ __forceinline__ void store(int row, int col, f32x4 v) const { u32x2 w; w.x = pk2(v.x, v.y); w.y = pk2(v.z, v.w); *(u32x2*)(O + (size_t)row * ldo + col) = w; } };
struct EpiQKV { bf16_t* O;
  __device__ __forceinline__ void store8(int row, int col, f32x4 a, f32x4 b) const { const float sc = (col < 512 || (col >= 1536 && col < 2048)) ? 0.18033688011112042f : 1.f;
    u32x4 w; w.x = pk2(a.x * sc, a.y * sc); w.y = pk2(a.z * sc, a.w * sc); w.z = pk2(b.x * sc, b.y * sc); w.w = pk2(b.z * sc, b.w * sc); *(u32x4*)(O + (size_t)row * NQKV + col) = w; }
  __device__ __forceinline__ void store(int row, int col, f32x4 v) const { const float sc = (col < 512 || (col >= 1536 && col < 2048)) ? 0.18033688011112042f : 1.f;
    u32x2 w; w.x = pk2(v.x * sc, v.y * sc); w.y = pk2(v.z * sc, v.w * sc); *(u32x2*)(O + (size_t)row * NQKV + col) = w; } };
struct EpiBf16S { bf16_t* O; int ldo; const float* ss;
  __device__ __forceinline__ void store8(int row, int col, f32x4 a, f32x4 b) const { const float r = rsqrtf(ss[row] * (1.f / DM) + EPS);
    u32x4 w; w.x = pk2(a.x * r, a.y * r); w.y = pk2(a.z * r, a.w * r); w.z = pk2(b.x * r, b.y * r); w.w = pk2(b.z * r, b.w * r); *(u32x4*)(O + (size_t)row * ldo + col) = w; }
  __device__ __forceinline__ void store(int row, int col, f32x4 v) const { const float r = rsqrtf(ss[row] * (1.f / DM) + EPS); u32x2 w; w.x = pk2(v.x * r, v.y * r); w.y = pk2(v.z * r, v.w * r); *(u32x2*)(O + (size_t)row * ldo + col) = w; } };
struct EpiF32S { float* O; int ldo; const float* ss;
  __device__ __forceinline__ void store(int row, int col, f32x4 v) const { const float r = rsqrtf(ss[row] * (1.f / DM) + EPS); *(f32x4*)(O + (size_t)row * ldo + col) = v * r; } };
struct EpiF32 { float* O; int ldo;
  __device__ __forceinline__ void store(int row, int col, f32x4 v) const { *(f32x4*)(O + (size_t)row * ldo + col) = v; } };
struct EpiResid { const float* base; float* out;
  __device__ __forceinline__ void store(int row, int col, f32x4 v) const { const size_t o = (size_t)row * DM + col; const f32x4 b = *(const f32x4*)(base + o); *(f32x4*)(out + o) = b + v; } };
struct EpiKV { bf16_t* KX; bf16_t* VXT;
  __device__ __forceinline__ void store(int row, int col, f32x4 v) const {
    if (col < 1024) { u32x2 w; w.x = pk2(v.x, v.y); w.y = pk2(v.z, v.w); *(u32x2*)(KX + (size_t)row * DM + col) = w; }
    else { const int b = row >> 8, m = row & 255;
#pragma unroll
      for (int r = 0; r < 4; ++r) { const int d = col - 1024 + r; VXT[((size_t)(b * 4 + (d >> 8)) * 256 + (d & 255)) * 256 + m] = (bf16_t)f2bf(v[r]); } } } };

__device__ __forceinline__ void phase_scan(const Args& a, int gw, int ngw, int lane, int tid) {
  unsigned char* ws = a.ws;
  const bf16_t* qkv = (const bf16_t*)(ws + WS_QKV);
  for (int item = gw; item < 64 + 1024 + 1024; item += ngw) {
    if (item < 64) {
      const int b = item >> 3, j = item & 7;
      const f32x4* src = (const f32x4*)((const float*)(ws + WS_FLOG) + (size_t)j * NT + (size_t)b * SEQ + lane * 64);
      f32x4 v[16];
#pragma unroll
      for (int i = 0; i < 16; ++i) v[i] = src[i];
      float tot = 0.f;
#pragma unroll
      for (int i = 0; i < 16; ++i) tot += (v[i].x + v[i].y) + (v[i].z + v[i].w);
      float inc = tot;
#pragma unroll
      for (int o = 1; o < 64; o <<= 1) { const float t = __shfl_up(inc, o); if (lane >= o) inc += t; }
      float run = inc - tot;
      f32x4* dst = (f32x4*)((float*)(ws + WS_CUM) + ((size_t)(b * 8 + j)) * SEQ + lane * 64);
#pragma unroll
      for (int i = 0; i < 16; ++i) { f32x4 o; run += v[i].x; o.x = run * 1.4426950408889634f; run += v[i].y; o.y = run * 1.4426950408889634f; run += v[i].z; o.z = run * 1.4426950408889634f; run += v[i].w; o.w = run * 1.4426950408889634f; dst[i] = o; }
    } else if (item < 64 + 1024) {
      const int it = item - 64, h = it & 7, blk = (it >> 3) & 15, b = it >> 7;
      const bf16_t* p = qkv + ((size_t)b * SEQ + blk * 256 + (lane >> 3)) * NQKV + 512 + h * 64 + (lane & 7) * 8;
      float s[8];
#pragma unroll
      for (int i = 0; i < 8; ++i) s[i] = 0.f;
#pragma unroll 8
      for (int rr = 0; rr < 32; ++rr) { float f[8]; unpack8(*(const u32x4*)(p + (size_t)rr * 8 * NQKV), f);
#pragma unroll
        for (int i = 0; i < 8; ++i) s[i] += f[i]; }
#pragma unroll
      for (int i = 0; i < 8; ++i) { s[i] += __shfl_xor(s[i], 8); s[i] += __shfl_xor(s[i], 16); s[i] += __shfl_xor(s[i], 32); }
      if (lane < 8) { f32x4* d = (f32x4*)((float*)(ws + WS_KMEAN) + ((size_t)(b * 16 + blk) * 8 + h) * 64 + lane * 8);
        d[0] = (f32x4){s[0], s[1], s[2], s[3]} * (1.f / 256.f); d[1] = (f32x4){s[4], s[5], s[6], s[7]} * (1.f / 256.f); }
    } else {
      const int it = item - 64 - 1024, bh = it >> 4, ch = it & 15, b = bh >> 3, h = bh & 7;
      const bf16_t* p = qkv + ((size_t)b * SEQ + ch * 256 + (lane >> 3)) * NQKV + 2048 + h * 64 + (lane & 7) * 8;
      float m = 0.f;
#pragma unroll 8
      for (int rr = 0; rr < 32; ++rr) { float f[8]; unpack8(*(const u32x4*)(p + (size_t)rr * 8 * NQKV), f);
        float s = 0.f;
#pragma unroll
        for (int i = 0; i < 8; ++i) s += f[i] * f[i];
        s += __shfl_xor(s, 1); s += __shfl_xor(s, 2); s += __shfl_xor(s, 4);
        m = fmaxf(m, s); }
#pragma unroll
      for (int o = 8; o < 64; o <<= 1) m = fmaxf(m, __shfl_xor(m, o));
      if (lane == 0) atomicMax((unsigned*)(ws + 256) + bh, __float_as_uint(m));
    }
  }
}

template <int MODE>
__device__ __forceinline__ void attn_naive_unit(const Args& a, unsigned char* lds, int b, int h, int sb, int tid) {
  unsigned char* ws = a.ws;
  const bf16_t* qkv = (const bf16_t*)(ws + WS_QKV);
  const int qoff = MODE ? 1536 : 0, koff = qoff + 512, voff = qoff + 1024;
  float* Ks = (float*)lds; float* Vs = Ks + 64 * 64; float* ck = Vs + 64 * 64; float* biasd = ck + 64;
  const int t = sb * 512 + tid; const size_t row = (size_t)b * SEQ + t;
  float q[64], o[64];
  {
    const u32x4* qp = (const u32x4*)(qkv + row * NQKV + qoff + h * 64);
#pragma unroll
    for (int c = 0; c < 8; ++c) { const u32x4 w = qp[c]; unpack8(w, q + 8 * c); }
#pragma unroll
    for (int d = 0; d < 64; ++d) { q[d] *= 0.6931471805599453f; o[d] = 0.f; }
  }
  float m = -1e30f, l = 0.f;
  unsigned selmask = 0u; const int own = t >> 8;
  float cq = 0.f, bfar = 0.f;
  __syncthreads();
  if (MODE == 0) {
    if (tid < 128) biasd[tid] = a.in[5][T5_BUCKET[tid] * 8 + h];
    bfar = a.in[5][31 * 8 + h];
    const float* km = (const float*)(ws + WS_KMEAN) + ((size_t)b * 16) * 512 + h * 64;
    float v0 = -3e38f, v1 = -3e38f, v2 = -3e38f; int i0 = -1, i1 = -1, i2 = -1;
    for (int n = 0; n < 2 * sb + 1; ++n) {
      if (n < own) {
        const float* kp = km + (size_t)n * 512; float s = 0.f;
#pragma unroll
        for (int d = 0; d < 64; ++d) s += q[d] * kp[d];
        if (s > v0) { v2 = v1; i2 = i1; v1 = v0; i1 = i0; v0 = s; i0 = n; }
        else if (s > v1) { v2 = v1; i2 = i1; v1 = s; i1 = n; }
        else if (s > v2) { v2 = s; i2 = n; }
      }
    }
    if (i0 >= 0) selmask |= 1u << i0;
    if (i1 >= 0) selmask |= 1u << i1;
    if (i2 >= 0) selmask |= 1u << i2;
  } else {
    cq = ((const float*)(ws + WS_CUM))[((size_t)(b * 8 + h)) * SEQ + t];
  }
  const int ntile = 8 * (sb + 1);
  for (int kt = 0; kt < ntile; ++kt) {
    __syncthreads();
    {
      const int r = tid >> 3, ch = tid & 7;
      const bf16_t* kp = qkv + ((size_t)b * SEQ + kt * 64 + r) * NQKV + h * 64 + ch * 8;
      const u32x4 kw = *(const u32x4*)(kp + koff), vw = *(const u32x4*)(kp + voff);
      unpack8(kw, Ks + r * 64 + ch * 8); unpack8(vw, Vs + r * 64 + ch * 8);
      if (MODE == 1 && tid < 64) ck[tid] = ((const float*)(ws + WS_CUM))[((size_t)(b * 8 + h)) * SEQ + kt * 64 + tid];
    }
    __syncthreads();
    const int kb = kt >> 2;
    bool act;
    if (MODE == 0) act = (kb == own) || (kb < own && ((selmask >> kb) & 1u));
    else act = (kt * 64 <= t);
    if (act) {
      for (int jj = 0; jj < 64; ++jj) {
        const int sp = kt * 64 + jj;
        if (sp > t) break;
        const f32x4* kr = (const f32x4*)(Ks + jj * 64);
        float s = 0.f;
#pragma unroll
        for (int c = 0; c < 16; ++c) { const f32x4 kv = kr[c]; s += q[4 * c] * kv.x + q[4 * c + 1] * kv.y + q[4 * c + 2] * kv.z + q[4 * c + 3] * kv.w; }
        if (MODE == 0) { const int dist = t - sp; s += (dist < 128) ? biasd[dist] : bfar; }
        else s += (cq - ck[jj]) * 0.6931471805599453f;
        if (s > m) { const float f = __expf(m - s); l *= f;
#pragma unroll
          for (int d = 0; d < 64; ++d) o[d] *= f;
          m = s; }
        const float p = __expf(s - m); l += p;
        const f32x4* vr = (const f32x4*)(Vs + jj * 64);
#pragma unroll
        for (int c = 0; c < 16; ++c) { const f32x4 vv = vr[c]; o[4 * c] += p * vv.x; o[4 * c + 1] += p * vv.y; o[4 * c + 2] += p * vv.z; o[4 * c + 3] += p * vv.w; }
      }
    }
  }
  const float il = 1.f / l;
  u32x4* op = (u32x4*)((bf16_t*)(ws + WS_OAB) + row * DM + (MODE ? 512 : 0) + h * 64);
#pragma unroll
  for (int c = 0; c < 8; ++c) { u32x4 w; w.x = pk2(o[8 * c] * il, o[8 * c + 1] * il); w.y = pk2(o[8 * c + 2] * il, o[8 * c + 3] * il); w.z = pk2(o[8 * c + 4] * il, o[8 * c + 5] * il); w.w = pk2(o[8 * c + 6] * il, o[8 * c + 7] * il); op[c] = w; }
}

__device__ __forceinline__ void phase_attn(const Args& a, unsigned char* lds, int tid) {
  for (int u = blockIdx.x; u < 1024; u += gridDim.x) {
    const int sb = 7 - (u >> 7), r = u & 127, mode = r & 1, bh = r >> 1;
    if (mode == 0) attn_naive_unit<0>(a, lds, bh >> 3, bh & 7, sb, tid);
    else attn_naive_unit<1>(a, lds, bh >> 3, bh & 7, sb, tid);
  }
}

namespace att {
typedef float f32x16 __attribute__((ext_vector_type(16)));
typedef short s16x4 __attribute__((ext_vector_type(4)));
typedef short v4i16_t __attribute__((ext_vector_type(4)));
typedef __attribute__((address_space(3))) const char* lds_cptr;
typedef float f32x2_t __attribute__((ext_vector_type(2))); typedef __bf16 bf16x2_t __attribute__((ext_vector_type(2)));
constexpr int PITCH = NQKV;
constexpr float LOG2E = 1.4426950408889634f;
constexpr float C2 = 0.125f * LOG2E;
constexpr int L_K = 0, L_V = 16384, L_WSF = 32768, L_OST = 34816, L_C2 = 67584, L_KM = 83968, L_BT = 88064, L_MISC = 88704;
__device__ __forceinline__ int crow(int r, int hi) { return (r & 3) + 8 * (r >> 2) + 4 * hi; }
__device__ __forceinline__ unsigned cvtpk(float lo, float hi) { f32x2_t v = {lo, hi}; bf16x2_t b = __builtin_convertvector(v, bf16x2_t); return __builtin_bit_cast(unsigned, b); }
__device__ __forceinline__ s16x4 vtr(lds_cptr p) { return __builtin_bit_cast(s16x4, __builtin_amdgcn_ds_read_tr16_b64_v4i16((__attribute__((address_space(3))) v4i16_t*)p)); }
__device__ __forceinline__ float max3f(float a, float b, float c) { float r; asm("v_max3_f32 %0, %1, %2, %3" : "=v"(r) : "v"(a), "v"(b), "v"(c)); return r; }
__device__ __forceinline__ float xhalf_max(float m) { auto rr = __builtin_amdgcn_permlane32_swap(__float_as_uint(m), __float_as_uint(m), false, false); return fmaxf(__uint_as_float(rr[0]), __uint_as_float(rr[1])); }
__device__ __forceinline__ float xhalf_sum(float m) { auto rr = __builtin_amdgcn_permlane32_swap(__float_as_uint(m), __float_as_uint(m), false, false); return __uint_as_float(rr[0]) + __uint_as_float(rr[1]); }

template <int MODE>
__device__ __forceinline__ void unit(const Args& a, unsigned char* lds, int b, int h, int qb, int tid) {
  unsigned char* ws = a.ws;
  const int lane = tid & 63, r32 = lane & 31, hi = lane >> 5; const int wid = __builtin_amdgcn_readfirstlane(tid >> 6);
  const bf16_t* qkv = (const bf16_t*)(ws + WS_QKV);
  const int qoff = MODE ? 1536 : 0;
  const size_t rowbase = (size_t)b * SEQ; const int q0 = qb * 256;
  const bf16_t* Qw = qkv + (rowbase + q0 + wid * 32) * PITCH + qoff + h * 64;
  const bf16_t* Kh = qkv + rowbase * PITCH + qoff + 512 + h * 64;
  const bf16_t* Vh = qkv + rowbase * PITCH + qoff + 1024 + h * 64;
  float* wsf = (float*)(lds + L_WSF) + wid * 64;
  float* c2s = (float*)(lds + L_C2); float* kms = (float*)(lds + L_KM); float* bts = (float*)(lds + L_BT); unsigned* misc = (unsigned*)(lds + L_MISC);
  const int NTL = 4 * (qb + 1);
  __syncthreads();
  if (MODE == 0) {
    const float* km = (const float*)(ws + WS_KMEAN) + (size_t)b * 16 * 512 + h * 64;
    for (int i = tid; i < 16 * 64; i += 512) kms[i] = km[(size_t)(i >> 6) * 512 + (i & 63)];
    if (tid < 128) bts[tid] = a.in[5][T5_BUCKET[tid] * 8 + h] * LOG2E;
    if (tid == 128) bts[128] = a.in[5][31 * 8 + h] * LOG2E;
  } else {
    const float* cg = (const float*)(ws + WS_CUM) + (size_t)(b * 8 + h) * SEQ;
    for (int i = tid; i < 256 * (qb + 1); i += 512) c2s[i] = cg[i];
    if (tid == 0) misc[0] = 0u;
  }
  bf16x8 qr[4];
#pragma unroll
  for (int d0 = 0; d0 < 4; ++d0) qr[d0] = *(const bf16x8*)(Qw + (size_t)r32 * PITCH + d0 * 16 + hi * 8);
  __syncthreads();
  unsigned selmask = 0u; float cq2 = 0.f, far2 = 0.f, mhat = 0.f; int t0 = 0;
  if (MODE == 0) {
    far2 = bts[128];
    float v0 = -3e38f, v1 = -3e38f, v2 = -3e38f; int i0 = -1, i1 = -1, i2 = -1;
    for (int n = 0; n < qb; ++n) {
      float s = 0.f;
#pragma unroll
      for (int d0 = 0; d0 < 4; ++d0)
#pragma unroll
        for (int j = 0; j < 8; ++j) s += bf2f((unsigned short)qr[d0][j]) * kms[n * 64 + d0 * 16 + hi * 8 + j];
      s = xhalf_sum(s);
      if (s > v0) { v2 = v1; i2 = i1; v1 = v0; i1 = i0; v0 = s; i0 = n; }
      else if (s > v1) { v2 = v1; i2 = i1; v1 = s; i1 = n; }
      else if (s > v2) { v2 = s; i2 = n; }
    }
    if (i0 >= 0) selmask |= 1u << i0;
    if (i1 >= 0) selmask |= 1u << i1;
    if (i2 >= 0) selmask |= 1u << i2;
  } else {
    cq2 = c2s[q0 + wid * 32 + r32];
    float s = 0.f;
#pragma unroll
    for (int d0 = 0; d0 < 4; ++d0)
#pragma unroll
      for (int j = 0; j < 8; ++j) { const float f = bf2f((unsigned short)qr[d0][j]); s += f * f; }
    s = xhalf_sum(s);
    atomicMax(&misc[0], __float_as_uint(s));
    __syncthreads();
    const float kn2 = __uint_as_float(((const unsigned*)(ws + 256))[b * 8 + h]);
    const float qkb = sqrtf(__uint_as_float(misc[0]) * kn2) * 1.0001f + 1e-3f;
    mhat = -qkb;
    const int j = lane; bool skip = false;
    if (j < NTL) skip = (2.f * qkb + c2s[q0] - c2s[64 * j + 63]) < -150.f;
    t0 = __popcll(__ballot(skip));
    if (t0 > NTL - 1) t0 = NTL - 1;
  }
  const bf16_t* ksrc = Kh + (size_t)lane * PITCH + wid * 8;
  const bf16_t* vsrc = Vh + (size_t)(16 * (wid & 3) + (lane >> 2)) * PITCH + (wid >> 2) * 32 + (lane & 3) * 8;
  unsigned char* kdst = lds + L_K + wid * 1024 + lane * 16; unsigned char* vdst = lds + L_V + wid * 1024 + lane * 16;
  const lds_cptr lds3 = (lds_cptr)lds;
  const lds_cptr vp0 = lds3 + L_V + ((lane >> 4) & 1) * 32 + (lane & 3) * 8 + (4 * hi + ((lane & 15) >> 2)) * 64;
  u32x4 kreg = *(const u32x4*)(ksrc + (size_t)t0 * 64 * PITCH), vreg = *(const u32x4*)(vsrc + (size_t)t0 * 64 * PITCH);
  *(u32x4*)(kdst + (t0 & 1) * 8192) = kreg; *(u32x4*)(vdst + (t0 & 1) * 8192) = vreg;
  f32x16 o[2]; o[0] = f32x16{}; o[1] = f32x16{};
  f32x16 ol = f32x16{}, cm = f32x16{}; int cm_nb = -1;
  const int qrel = wid * 32 + r32, qpos = q0 + qrel;
  __syncthreads();
  for (int t = t0; t < NTL; ++t) {
    const int buf = (t & 1) * 8192;
    if (t + 1 < NTL) { kreg = *(const u32x4*)(ksrc + (size_t)(t + 1) * 64 * PITCH); vreg = *(const u32x4*)(vsrc + (size_t)(t + 1) * 64 * PITCH); }
    const int jb = t - (NTL - 4);
    const bool compute = !(jb >= 0 && 64 * jb > wid * 32 + 31);
    if (compute) {
      f32x16 p0, p1;
      bf16x8 kf[8];
      {
        const lds_cptr kb = lds3 + L_K + buf + hi * 1024 + r32 * 16;
#pragma unroll
        for (int d0 = 0; d0 < 4; ++d0) { kf[2 * d0] = *(const __attribute__((address_space(3))) bf16x8*)(kb + d0 * 2048); kf[2 * d0 + 1] = *(const __attribute__((address_space(3))) bf16x8*)(kb + d0 * 2048 + 512); }
      }
      __builtin_amdgcn_sched_barrier(0);
      if (MODE == 0) {
        const int nb = t >> 2;
        const bool near = (jb >= 0) || (t >= NTL - 6 && wid < 4);
        if (near) {
#pragma unroll
          for (int r = 0; r < 16; ++r) { const int d = qpos - (64 * t + crow(r, hi));
            p0[r] = bts[min(max(d, 0), 128)] - mhat; p1[r] = bts[min(max(d - 32, 0), 128)] - mhat; }
          if (jb < 0 && !((selmask >> nb) & 1u)) {
#pragma unroll
            for (int r = 0; r < 16; ++r) { p0[r] = -INFINITY; p1[r] = -INFINITY; }
          }
        } else {
          if (cm_nb != nb) {
            const float base = ((selmask >> nb) & 1u) ? far2 - mhat : -INFINITY;
#pragma unroll
            for (int r = 0; r < 16; ++r) cm[r] = base;
            cm_nb = nb;
          }
          p0 = cm; p1 = cm;
        }
      } else {
        const float cqm = cq2 - mhat;
#pragma unroll
        for (int g = 0; g < 4; ++g) {
          const f32x4 ca = *(const f32x4*)(c2s + 64 * t + 8 * g + 4 * hi), cb = *(const f32x4*)(c2s + 64 * t + 32 + 8 * g + 4 * hi);
#pragma unroll
          for (int i = 0; i < 4; ++i) { p0[4 * g + i] = cqm - ca[i]; p1[4 * g + i] = cqm - cb[i]; }
        }
      }
#pragma unroll
      for (int d0 = 0; d0 < 4; ++d0) {
        p0 = __builtin_amdgcn_mfma_f32_32x32x16_bf16(kf[2 * d0], qr[d0], p0, 0, 0, 0);
        p1 = __builtin_amdgcn_mfma_f32_32x32x16_bf16(kf[2 * d0 + 1], qr[d0], p1, 0, 0, 0);
      }
      if (jb >= 0) {
        asm volatile("" ::: "memory");
        const int kb0 = 64 * jb + 4 * hi;
#pragma unroll
        for (int r = 0; r < 16; ++r) { const int kv = kb0 + (r & 3) + 8 * (r >> 2); if (kv > qrel) p0[r] = -INFINITY; if (kv + 32 > qrel) p1[r] = -INFINITY; }
      }
      asm volatile("s_nop 15\n\ts_nop 7" : "+v"(p0), "+v"(p1));
      float rm, rm2;
      rm = max3f(p0[0], p0[1], p1[0]); rm2 = max3f(p0[2], p0[3], p1[1]); rm = max3f(rm, p1[2], p1[3]);
#pragma unroll
      for (int r = 4; r < 16; r += 4) { rm = max3f(rm, p0[r], p0[r + 1]); rm2 = max3f(rm2, p0[r + 2], p0[r + 3]); rm = max3f(rm, p1[r], p1[r + 1]); rm2 = max3f(rm2, p1[r + 2], p1[r + 3]); }
      rm = xhalf_max(fmaxf(rm, rm2));
      if (__any(rm > 8.0f)) {
        const float dl = fmaxf(rm, 0.f), alpha = __builtin_amdgcn_exp2f(-dl);
        mhat += dl; cm_nb = -1;
#pragma unroll
        for (int r = 0; r < 16; ++r) { p0[r] -= dl; p1[r] -= dl; }
        if (hi == 0) wsf[r32] = alpha;
        __builtin_amdgcn_wave_barrier();
#pragma unroll
        for (int r = 0; r < 16; ++r) { const float f = wsf[crow(r, hi)]; o[0][r] *= f; o[1][r] *= f; ol[r] *= f; }
        __builtin_amdgcn_wave_barrier();
      }
#pragma unroll
      for (int r = 0; r < 16; ++r) { p0[r] = __builtin_amdgcn_exp2f(p0[r]); p1[r] = __builtin_amdgcn_exp2f(p1[r]); }
      u32x4 pw0, pw1, pw2, pw3;
      pw0 = (u32x4){cvtpk(p0[0], p0[1]), cvtpk(p0[2], p0[3]), cvtpk(p0[4], p0[5]), cvtpk(p0[6], p0[7])};
      pw1 = (u32x4){cvtpk(p0[8], p0[9]), cvtpk(p0[10], p0[11]), cvtpk(p0[12], p0[13]), cvtpk(p0[14], p0[15])};
      pw2 = (u32x4){cvtpk(p1[0], p1[1]), cvtpk(p1[2], p1[3]), cvtpk(p1[4], p1[5]), cvtpk(p1[6], p1[7])};
      pw3 = (u32x4){cvtpk(p1[8], p1[9]), cvtpk(p1[10], p1[11]), cvtpk(p1[12], p1[13]), cvtpk(p1[14], p1[15])};
      {
        const bf16x8 ones = (bf16x8){0x3F80, 0x3F80, 0x3F80, 0x3F80, 0x3F80, 0x3F80, 0x3F80, 0x3F80};
        ol = __builtin_amdgcn_mfma_f32_32x32x16_bf16(__builtin_bit_cast(bf16x8, pw0), ones, ol, 0, 0, 0);
        ol = __builtin_amdgcn_mfma_f32_32x32x16_bf16(__builtin_bit_cast(bf16x8, pw1), ones, ol, 0, 0, 0);
        ol = __builtin_amdgcn_mfma_f32_32x32x16_bf16(__builtin_bit_cast(bf16x8, pw2), ones, ol, 0, 0, 0);
        ol = __builtin_amdgcn_mfma_f32_32x32x16_bf16(__builtin_bit_cast(bf16x8, pw3), ones, ol, 0, 0, 0);
      }
      const lds_cptr vp = vp0 + buf;
#pragma unroll
      for (int d0 = 0; d0 < 2; ++d0) {
#define ATT_VF(ks) ({ const s16x4 lo_ = vtr(vp + d0 * 4096 + (ks) * 1024), hi_ = vtr(vp + d0 * 4096 + (ks) * 1024 + 512); (bf16x8){lo_[0], lo_[1], lo_[2], lo_[3], hi_[0], hi_[1], hi_[2], hi_[3]}; })
        o[d0] = __builtin_amdgcn_mfma_f32_32x32x16_bf16(__builtin_bit_cast(bf16x8, pw0), ATT_VF(0), o[d0], 0, 0, 0);
        o[d0] = __builtin_amdgcn_mfma_f32_32x32x16_bf16(__builtin_bit_cast(bf16x8, pw1), ATT_VF(1), o[d0], 0, 0, 0);
        o[d0] = __builtin_amdgcn_mfma_f32_32x32x16_bf16(__builtin_bit_cast(bf16x8, pw2), ATT_VF(2), o[d0], 0, 0, 0);
        o[d0] = __builtin_amdgcn_mfma_f32_32x32x16_bf16(__builtin_bit_cast(bf16x8, pw3), ATT_VF(3), o[d0], 0, 0, 0);
#undef ATT_VF
      }
    }
    if (t + 1 < NTL) { *(u32x4*)(kdst + ((t + 1) & 1) * 8192) = kreg; *(u32x4*)(vdst + ((t + 1) & 1) * 8192) = vreg; }
    __syncthreads();
  }
  bf16_t* stg = (bf16_t*)(lds + L_OST) + wid * 2048;
#pragma unroll
  for (int r = 0; r < 16; ++r) { const int orow = crow(r, hi); const float rl = 1.f / ol[r];
    stg[orow * 64 + r32] = (bf16_t)f2bf(o[0][r] * rl); stg[orow * 64 + 32 + r32] = (bf16_t)f2bf(o[1][r] * rl); }
  __builtin_amdgcn_wave_barrier();
  bf16_t* Ow = (bf16_t*)(ws + WS_OAB) + (rowbase + q0 + wid * 32) * DM + (MODE ? 512 : 0) + h * 64;
#pragma unroll
  for (int i = 0; i < 4; ++i) { const int row = i * 8 + (lane >> 3), ch = lane & 7; const u32x4 v = *(const u32x4*)(stg + row * 64 + ch * 8); *(u32x4*)(Ow + (size_t)row * DM + ch * 8) = v; }
}
}

__device__ __forceinline__ void phase_attn2(const Args& a, unsigned char* lds, int tid) {
  unsigned* ctr = (unsigned*)(a.ws + 0);
  unsigned* slot = (unsigned*)(lds + att::L_MISC + 64);
  for (;;) {
    __syncthreads();
    if (tid == 0) slot[0] = atomicAdd(ctr, 1u);
    __syncthreads();
    const unsigned u = slot[0];
    if (u >= 2048u) break;
    const int qb = 15 - (int)(u >> 7), r = u & 127, mode = r & 1, bh = r >> 1;
    if (mode == 0) att::unit<0>(a, lds, bh >> 3, bh & 7, qb, tid);
    else att::unit<1>(a, lds, bh >> 3, bh & 7, qb, tid);
  }
}

__device__ __forceinline__ void phase_onorm(const Args& a, int gw, int ngw, int lane) {
  bf16_t* oab = (bf16_t*)(a.ws + WS_OAB);
  for (int r = gw; r < NT; r += ngw) {
    u32x4* p = (u32x4*)(oab + (size_t)r * DM) + 2 * lane;
    const u32x4 w0 = p[0], w1 = p[1]; float f[16]; unpack8(w0, f); unpack8(w1, f + 8);
    float s = 0.f;
#pragma unroll
    for (int i = 0; i < 16; ++i) s += f[i] * f[i];
#pragma unroll
    for (int o = 1; o < 32; o <<= 1) s += __shfl_xor(s, o);
    const float rstd = rsqrtf(s * (1.f / 512.f) + EPS);
    u32x4 o0, o1;
    o0.x = pk2(f[0] * rstd, f[1] * rstd); o0.y = pk2(f[2] * rstd, f[3] * rstd); o0.z = pk2(f[4] * rstd, f[5] * rstd); o0.w = pk2(f[6] * rstd, f[7] * rstd);
    o1.x = pk2(f[8] * rstd, f[9] * rstd); o1.y = pk2(f[10] * rstd, f[11] * rstd); o1.z = pk2(f[12] * rstd, f[13] * rstd); o1.w = pk2(f[14] * rstd, f[15] * rstd);
    p[0] = o0; p[1] = o1;
  }
}

__device__ __forceinline__ void phase_rms(const Args& a, int gw, int ngw, int lane) {
  for (int r = gw; r < NT; r += ngw) rms_row_to_bf16(a.out + (size_t)r * DM, (bf16_t*)(a.ws + WS_HB) + (size_t)r * DM, lane);
}

__device__ __forceinline__ void phase_xattn(const Args& a, unsigned char* lds, int gw, int ngw, int wave, int lane) {
  unsigned char* ws = a.ws;
  const bf16_t* qx = (const bf16_t*)(ws + WS_QX); const bf16_t* kx = (const bf16_t*)(ws + WS_KX); const bf16_t* vxt = (const bf16_t*)(ws + WS_VXT);
  bf16_t* ox = (bf16_t*)(ws + WS_OX);
  bf16_t* P = (bf16_t*)(lds + wave * 8192);
  const int fr = lane & 15, fq = lane >> 4;
  for (int u = gw; u < (NT / 16) * 4; u += ngw) {
    const int hd = u & 3, r0 = (u >> 2) * 16, b = r0 / SEQ;
    f32x4 acc[16];
#pragma unroll
    for (int i = 0; i < 16; ++i) acc[i] = (f32x4){0.f, 0.f, 0.f, 0.f};
    const bf16_t* Ap = qx + (size_t)(r0 + fr) * DM + hd * 256 + fq * 8;
    const bf16_t* Bp = kx + (size_t)(b * 256 + fr) * DM + hd * 256 + fq * 8;
    for (int ks = 0; ks < 8; ++ks) {
      const bf16x8 af = *(const bf16x8*)(Ap + ks * 32);
#pragma unroll
      for (int ct = 0; ct < 16; ++ct) { const bf16x8 bfr = *(const bf16x8*)(Bp + (size_t)ct * 16 * DM + ks * 32); acc[ct] = __builtin_amdgcn_mfma_f32_16x16x32_bf16(af, bfr, acc[ct], 0, 0, 0); }
    }
    float mx[4], sm[4];
#pragma unroll
    for (int r = 0; r < 4; ++r) { float m = acc[0][r];
#pragma unroll
      for (int ct = 1; ct < 16; ++ct) m = fmaxf(m, acc[ct][r]);
#pragma unroll
      for (int o = 1; o < 16; o <<= 1) m = fmaxf(m, __shfl_xor(m, o));
      mx[r] = m; sm[r] = 0.f; }
#pragma unroll
    for (int ct = 0; ct < 16; ++ct)
#pragma unroll
      for (int r = 0; r < 4; ++r) { const float p = __expf((acc[ct][r] - mx[r]) * 0.0625f); acc[ct][r] = p; sm[r] += p; }
#pragma unroll
    for (int r = 0; r < 4; ++r) {
#pragma unroll
      for (int o = 1; o < 16; o <<= 1) sm[r] += __shfl_xor(sm[r], o);
      sm[r] = 1.f / sm[r]; }
    __builtin_amdgcn_wave_barrier();
#pragma unroll
    for (int ct = 0; ct < 16; ++ct)
#pragma unroll
      for (int r = 0; r < 4; ++r) P[(4 * fq + r) * 256 + ct * 16 + fr] = (bf16_t)f2bf(acc[ct][r] * sm[r]);
    __builtin_amdgcn_wave_barrier();
    asm volatile("s_waitcnt lgkmcnt(0)" ::: "memory");
#pragma unroll
    for (int i = 0; i < 16; ++i) acc[i] = (f32x4){0.f, 0.f, 0.f, 0.f};
    const bf16_t* Vp = vxt + ((size_t)(b * 4 + hd) * 256 + fr) * 256 + fq * 8;
    for (int ks = 0; ks < 8; ++ks) {
      const bf16x8 pf = *(const bf16x8*)(P + fr * 256 + ks * 32 + fq * 8);
#pragma unroll
      for (int dt = 0; dt < 16; ++dt) { const bf16x8 vf = *(const bf16x8*)(Vp + (size_t)dt * 16 * 256 + ks * 32); acc[dt] = __builtin_amdgcn_mfma_f32_16x16x32_bf16(pf, vf, acc[dt], 0, 0, 0); }
    }
#pragma unroll
    for (int dt = 0; dt < 16; ++dt)
#pragma unroll
      for (int r = 0; r < 4; ++r) ox[(size_t)(r0 + 4 * fq + r) * DM + hd * 256 + dt * 16 + fr] = (bf16_t)f2bf(acc[dt][r]);
    __builtin_amdgcn_wave_barrier();
  }
}

namespace xa {
using att::f32x16; using att::s16x4; using att::lds_cptr; using att::crow; using att::cvtpk; using att::vtr; using att::xhalf_max; using att::xhalf_sum;
constexpr int L_WSF = 98304;
__device__ __forceinline__ void glds16(const void* gsrc, unsigned lds_dst) { unsigned keep;
  asm volatile("s_mov_b32 %0, m0\n\ts_mov_b32 m0, %2\n\ts_nop 0\n\tglobal_load_lds_dwordx4 %1, off\n\ts_mov_b32 m0, %0" : "=&s"(keep) : "v"(gsrc), "s"(lds_dst) : "memory"); }
__device__ __forceinline__ void unit(const Args& a, unsigned char* lds, int b, int hd, int qb, int tid) {
  unsigned char* ws = a.ws;
  const int lane = tid & 63, r32 = lane & 31, hi = lane >> 5; const int wid = __builtin_amdgcn_readfirstlane(tid >> 6);
  const bf16_t* qrow = (const bf16_t*)(ws + WS_QX) + ((size_t)b * SEQ + qb * 256 + wid * 32 + r32) * DM + hd * 256;
  const bf16_t* kvb = (const bf16_t*)(ws + WS_KX) + (size_t)b * 256 * 2048 + hd * 256;
  const bf16_t* ksrc = kvb + (size_t)lane * 2048 + wid * 8;
  const bf16_t* vsrc = kvb + 1024 + (size_t)(16 * (wid & 3) + (lane >> 2)) * 2048 + (wid >> 2) * 32 + (lane & 3) * 8;
  const unsigned sdst = (unsigned)(uintptr_t)lds + wid * 1024;
  const lds_cptr lds3 = (lds_cptr)lds;
  const lds_cptr kp0 = lds3 + hi * 1024 + r32 * 16;
  const lds_cptr vp0 = lds3 + ((lane >> 4) & 1) * 32 + (lane & 3) * 8 + (4 * hi + ((lane & 15) >> 2)) * 64;
  float* wsf = (float*)(lds + L_WSF) + wid * 64;
#define XA_DMA(s) do { const unsigned db_ = (unsigned)__builtin_amdgcn_readfirstlane(sdst + ((s) % 3) * 32768); \
    const bf16_t* kq_ = ksrc; const bf16_t* vq_ = vsrc; asm volatile("" : "+v"(kq_), "+v"(vq_));        \
    if ((s) < 4) { _Pragma("unroll") for (int kt = 0; kt < 4; ++kt) glds16(kq_ + (size_t)kt * 64 * 2048 + (s) * 64, db_ + kt * 8192); } \
    else { _Pragma("unroll") for (int dq = 0; dq < 4; ++dq) glds16(vq_ + (size_t)((s) - 4) * 64 * 2048 + dq * 64, db_ + dq * 8192); } } while (0)
#define XA_CLOSE(s) do { if ((s) + 2 < 8) asm volatile("s_waitcnt vmcnt(4) lgkmcnt(0)\n\ts_barrier" ::: "memory"); else asm volatile("s_waitcnt vmcnt(0) lgkmcnt(0)\n\ts_barrier" ::: "memory"); } while (0)
  __syncthreads();
  asm volatile("s_waitcnt vmcnt(0)" ::: "memory");
  XA_DMA(0); XA_DMA(1);
  f32x16 acc[8];
#pragma unroll
  for (int j = 0; j < 8; ++j) acc[j] = f32x16{};
  asm volatile("s_waitcnt vmcnt(4) lgkmcnt(0)\n\ts_barrier" ::: "memory");
#pragma unroll
  for (int c = 0; c < 4; ++c) {
    XA_DMA(c + 2);
    bf16x8 qf[4];
#pragma unroll
    for (int d0 = 0; d0 < 4; ++d0) qf[d0] = *(const bf16x8*)(qrow + c * 64 + d0 * 16 + hi * 8);
    int koff_ = (c % 3) * 32768; asm volatile("" : "+v"(koff_));
    const lds_cptr kp = kp0 + koff_;
#pragma unroll
    for (int d0 = 0; d0 < 4; ++d0)
#pragma unroll
      for (int j = 0; j < 8; ++j) {
        const bf16x8 kf = *(const __attribute__((address_space(3))) bf16x8*)(kp + (j >> 1) * 8192 + d0 * 2048 + (j & 1) * 512);
        acc[j] = __builtin_amdgcn_mfma_f32_32x32x16_bf16(kf, qf[d0], acc[j], 0, 0, 0);
      }
    XA_CLOSE(c);
  }
  float m = acc[0][0];
#pragma unroll
  for (int j = 0; j < 8; ++j)
#pragma unroll
    for (int r = 0; r < 16; ++r) m = fmaxf(m, acc[j][r]);
  m = xhalf_max(m);
  constexpr float CS = 1.4426950408889634f / 16.f;
  float l = 0.f; u32x4 pw[16];
#pragma unroll
  for (int j = 0; j < 8; ++j) {
#pragma unroll
    for (int r = 0; r < 16; ++r) { const float p = __builtin_amdgcn_exp2f((acc[j][r] - m) * CS); acc[j][r] = p; l += p; }
    pw[2 * j] = (u32x4){cvtpk(acc[j][0], acc[j][1]), cvtpk(acc[j][2], acc[j][3]), cvtpk(acc[j][4], acc[j][5]), cvtpk(acc[j][6], acc[j][7])};
    pw[2 * j + 1] = (u32x4){cvtpk(acc[j][8], acc[j][9]), cvtpk(acc[j][10], acc[j][11]), cvtpk(acc[j][12], acc[j][13]), cvtpk(acc[j][14], acc[j][15])};
  }
  l = xhalf_sum(l);
#pragma unroll
  for (int j = 0; j < 8; ++j) acc[j] = f32x16{};
#pragma unroll
  for (int vt = 0; vt < 4; ++vt) {
    if (vt + 6 < 8) XA_DMA(vt + 6);
    int voff_ = ((vt + 4) % 3) * 32768; asm volatile("" : "+v"(voff_));
    const lds_cptr vp = vp0 + voff_;
#pragma unroll
    for (int ks = 0; ks < 4; ++ks)
#pragma unroll
      for (int db = 0; db < 8; ++db) {
        const s16x4 lo_ = vtr(vp + (db >> 1) * 8192 + (db & 1) * 4096 + ks * 1024), hi_ = vtr(vp + (db >> 1) * 8192 + (db & 1) * 4096 + ks * 1024 + 512);
        const bf16x8 vf = (bf16x8){lo_[0], lo_[1], lo_[2], lo_[3], hi_[0], hi_[1], hi_[2], hi_[3]};
        acc[db] = __builtin_amdgcn_mfma_f32_32x32x16_bf16(__builtin_bit_cast(bf16x8, pw[4 * vt + ks]), vf, acc[db], 0, 0, 0);
      }
    XA_CLOSE(vt + 4);
  }
  if (hi == 0) wsf[r32] = l;
  __builtin_amdgcn_wave_barrier();
  float rl[16];
#pragma unroll
  for (int r = 0; r < 16; ++r) rl[r] = 1.f / wsf[crow(r, hi)];
  int sbase = (4 * hi) * 128 + r32, lbase = (lane >> 4) * 128 + (lane & 15) * 8;
  asm volatile("" : "+v"(sbase), "+v"(lbase));
  bf16_t* stg = (bf16_t*)(lds + wid * 8192);
  bf16_t* orow0 = (bf16_t*)(ws + WS_OX) + ((size_t)b * SEQ + qb * 256 + wid * 32) * DM + hd * 256 + (size_t)(lane >> 4) * DM + (lane & 15) * 8;
#pragma unroll
  for (int hf = 0; hf < 2; ++hf) {
#pragma unroll
    for (int db = 0; db < 4; ++db)
#pragma unroll
      for (int r = 0; r < 16; ++r) stg[sbase + ((r & 3) + 8 * (r >> 2)) * 128 + db * 32] = (bf16_t)f2bf(acc[hf * 4 + db][r] * rl[r]);
    __builtin_amdgcn_wave_barrier();
#pragma unroll
    for (int i = 0; i < 8; ++i) { const u32x4 v = *(const u32x4*)(stg + lbase + i * 4 * 128); *(u32x4*)(orow0 + (size_t)(i * 4) * DM + hf * 128) = v; }
    __builtin_amdgcn_wave_barrier();
  }
#undef XA_DMA
#undef XA_CLOSE
}
}

__device__ __forceinline__ void phase_xattn2(const Args& a, unsigned char* lds, int tid) {
  for (int u = blockIdx.x; u < NB * 4 * 16; u += gridDim.x) { const int qb = u & 15, hd = (u >> 4) & 3, b = u >> 6; xa::unit(a, lds, b, hd, qb, tid); }
}

__device__ __forceinline__ unsigned fkey(float s, unsigned idx, unsigned mask) { unsigned u = __float_as_uint(s); u ^= (unsigned)((int)u >> 31) | 0x80000000u; return (u & ~mask) | (mask - idx); }
__device__ __forceinline__ float keyval(unsigned k, unsigned mask) { unsigned u = k & ~mask; u = (u & 0x80000000u) ? (u ^ 0x80000000u) : ~u; return __uint_as_float(u); }
#define KEY_INSERT(KA, key_) do { unsigned k__ = (key_); \
  _Pragma("unroll") for (int s_ = 0; s_ < 16; ++s_) { const unsigned hi_ = max(k__, KA[s_]); k__ = min(k__, KA[s_]); KA[s_] = hi_; } } while (0)

__device__ __forceinline__ void phase_topk(const Args& a, unsigned char* lds, int tid) {
  unsigned char* ws = a.ws;
  const float* pq = (const float*)(ws + WS_PQ);
  int* eidx = (int*)(ws + WS_EIDX); float* gate = (float*)(ws + WS_GATE);
  float* K1 = (float*)lds; float* K2 = K1 + 128 * 64; unsigned* KL = (unsigned*)(lds + 65536);
  for (int u = blockIdx.x; u < 8 * (NT / 512); u += gridDim.x) {
    const int h = u & 7, t = (u >> 3) * 512 + tid;
    __syncthreads();
    for (int i = tid; i < 128 * 64 / 4; i += 512) { ((f32x4*)K1)[i] = ((const f32x4*)(a.in[17] + (size_t)h * 8192))[i]; ((f32x4*)K2)[i] = ((const f32x4*)(a.in[18] + (size_t)h * 8192))[i]; }
    __syncthreads();
    unsigned ka[16], kb[16], kc[16];
#pragma unroll
    for (int k = 0; k < 16; ++k) { ka[k] = 0u; kb[k] = 0u; kc[k] = 0u; }
    float q[64];
    const f32x4* qp = (const f32x4*)(pq + (size_t)t * DM + h * 128);
#pragma unroll
    for (int c = 0; c < 16; ++c) { const f32x4 w = qp[c]; q[4 * c] = w.x; q[4 * c + 1] = w.y; q[4 * c + 2] = w.z; q[4 * c + 3] = w.w; }
    for (int n = 0; n < 128; ++n) {
      const f32x4* kr = (const f32x4*)(K1 + n * 64); float s = 0.f;
#pragma unroll
      for (int c = 0; c < 16; ++c) { const f32x4 kv = kr[c]; s += q[4 * c] * kv.x + q[4 * c + 1] * kv.y + q[4 * c + 2] * kv.z + q[4 * c + 3] * kv.w; }
      KEY_INSERT(ka, fkey(s, (unsigned)n, 127u));
    }
#pragma unroll
    for (int c = 0; c < 16; ++c) { const f32x4 w = qp[16 + c]; q[4 * c] = w.x; q[4 * c + 1] = w.y; q[4 * c + 2] = w.z; q[4 * c + 3] = w.w; }
    for (int n = 0; n < 128; ++n) {
      const f32x4* kr = (const f32x4*)(K2 + n * 64); float s = 0.f;
#pragma unroll
      for (int c = 0; c < 16; ++c) { const f32x4 kv = kr[c]; s += q[4 * c] * kv.x + q[4 * c + 1] * kv.y + q[4 * c + 2] * kv.z + q[4 * c + 3] * kv.w; }
      KEY_INSERT(kb, fkey(s, (unsigned)n, 127u));
    }
#pragma unroll
    for (int x = 0; x < 16; ++x)
#pragma unroll
      for (int y = 0; y < 16; ++y)
        if ((x + 1) * (y + 1) <= 16) { KEY_INSERT(kc, fkey(keyval(ka[x], 127u) + keyval(kb[y], 127u), (unsigned)(x * 16 + y), 255u)); }
#pragma unroll
    for (int k = 0; k < 16; ++k) { KL[k * 512 + tid] = ka[k]; KL[(16 + k) * 512 + tid] = kb[k]; }
    float val[16]; int id[16]; float sum = 0.f;
#pragma unroll
    for (int k = 0; k < 16; ++k) {
      const unsigned flat = 255u - (kc[k] & 255u);
      const unsigned k1 = KL[(flat >> 4) * 512 + tid], k2 = KL[(16 + (flat & 15u)) * 512 + tid];
      val[k] = keyval(k1, 127u) + keyval(k2, 127u);
      id[k] = (int)((127u - (k1 & 127u)) * 128u + (127u - (k2 & 127u)));
    }
    const float vmax = val[0];
#pragma unroll
    for (int k = 0; k < 16; ++k) { val[k] = __expf(val[k] - vmax); sum += val[k]; }
    const float inv = 1.f / sum;
    int* ep = eidx + (size_t)t * 128 + h * 16; float* gp = gate + (size_t)t * 128 + h * 16;
#pragma unroll
    for (int k = 0; k < 16; ++k) { ep[k] = id[k]; gp[k] = val[k] * inv; }
  }
}


namespace tk {
typedef float f32x16 __attribute__((ext_vector_type(16)));
__device__ __forceinline__ void ce(unsigned& a, unsigned& b) { const unsigned h = max(a, b), l = min(a, b); a = h; b = l; }
__device__ __forceinline__ void sort16(unsigned (&v)[16]) {
#pragma unroll
  for (int k = 2; k <= 16; k <<= 1)
#pragma unroll
    for (int j = k >> 1; j > 0; j >>= 1)
#pragma unroll
      for (int i = 0; i < 16; ++i) { const int l = i ^ j; if (l > i) { if ((i & k) == 0) ce(v[i], v[l]); else ce(v[l], v[i]); } }
}
__device__ __forceinline__ void topmerge(unsigned (&a)[16], const unsigned (&b)[16]) {
#pragma unroll
  for (int i = 0; i < 16; ++i) a[i] = max(a[i], b[15 - i]);
#pragma unroll
  for (int j = 8; j > 0; j >>= 1)
#pragma unroll
    for (int i = 0; i < 16; ++i) { const int l = i ^ j; if (l > i) ce(a[i], a[l]); }
}
__device__ __forceinline__ unsigned xswap(unsigned v, int hi) { auto rr = __builtin_amdgcn_permlane32_swap(v, v, false, false); return hi ? rr[0] : rr[1]; }
__device__ __forceinline__ void half_list(unsigned (&L)[16], const bf16_t* skh, const bf16_t* qrow, int r32, int hi) {
  f32x16 acc[4];
#pragma unroll
  for (int i = 0; i < 4; ++i) acc[i] = f32x16{};
#pragma unroll
  for (int ks = 0; ks < 4; ++ks) {
    const bf16x8 qf = *(const bf16x8*)(qrow + ks * 16 + hi * 8);
#pragma unroll
    for (int tl = 0; tl < 4; ++tl) { const bf16x8 kf = *(const bf16x8*)(skh + (size_t)(tl * 32 + r32) * 64 + ks * 16 + hi * 8); acc[tl] = __builtin_amdgcn_mfma_f32_32x32x16_bf16(kf, qf, acc[tl], 0, 0, 0); }
  }
  unsigned g[4][16];
#pragma unroll
  for (int tl = 0; tl < 4; ++tl)
#pragma unroll
    for (int r = 0; r < 16; ++r) g[tl][r] = fkey(acc[tl][r], (unsigned)(32 * tl + (r & 3) + 8 * (r >> 2) + 4 * hi), 127u);
  sort16(g[0]); sort16(g[1]); sort16(g[2]); sort16(g[3]);
  topmerge(g[0], g[1]); topmerge(g[2], g[3]); topmerge(g[0], g[2]);
  unsigned p[16];
#pragma unroll
  for (int k = 0; k < 16; ++k) p[k] = xswap(g[0][k], hi);
  topmerge(g[0], p);
#pragma unroll
  for (int k = 0; k < 16; ++k) L[k] = g[0][k];
}
}

__device__ __forceinline__ void phase_topk2(const Args& a, unsigned char* lds, int wave, int lane) {
  unsigned char* ws = a.ws;
  const bf16_t* pq = (const bf16_t*)(ws + WS_PQ); const bf16_t* sk = (const bf16_t*)(ws + WS_SK);
  int* eidx = (int*)(ws + WS_EIDX); float* gate = (float*)(ws + WS_GATE);
  const int r32 = lane & 31, hi = lane >> 5, h = wave;
  unsigned* KL = (unsigned*)(lds + wave * 4096);
  for (int tt = blockIdx.x; tt < NT / 32; tt += gridDim.x) {
    const int t = tt * 32 + r32;
    unsigned ka[16], kb[16], kc[16];
    tk::half_list(ka, sk + (size_t)(0 * 8 + h) * 8192, pq + (size_t)t * DM + h * 128, r32, hi);
    tk::half_list(kb, sk + (size_t)(1 * 8 + h) * 8192, pq + (size_t)t * DM + h * 128 + 64, r32, hi);
    float va[16], vb[16];
#pragma unroll
    for (int k = 0; k < 16; ++k) { va[k] = keyval(ka[k], 127u); vb[k] = keyval(kb[k], 127u); }
#pragma unroll
    for (int y = 0; y < 16; ++y) kc[y] = hi ? 0u : fkey(va[0] + vb[y], (unsigned)y, 255u);
#define TK_CAND(xa, ya, xb, yb) do { const unsigned kA_ = fkey(va[xa] + vb[ya], (unsigned)((xa) * 16 + (ya)), 255u), kB_ = fkey(va[xb] + vb[yb], (unsigned)((xb) * 16 + (yb)), 255u); KEY_INSERT(kc, hi ? kB_ : kA_); } while (0)
    TK_CAND(1, 0, 1, 1);
    TK_CAND(1, 2, 1, 3);
    TK_CAND(1, 4, 1, 5);
    TK_CAND(1, 6, 1, 7);
    TK_CAND(2, 0, 2, 1);
    TK_CAND(2, 2, 2, 3);
    TK_CAND(2, 4, 3, 0);
    TK_CAND(3, 1, 3, 2);
    TK_CAND(3, 3, 4, 0);
    TK_CAND(4, 1, 4, 2);
    TK_CAND(5, 0, 5, 1);
    TK_CAND(6, 0, 6, 1);
    TK_CAND(7, 0, 7, 1);
    TK_CAND(8, 0, 9, 0);
    TK_CAND(10, 0, 11, 0);
    TK_CAND(12, 0, 13, 0);
    TK_CAND(14, 0, 15, 0);
#undef TK_CAND
    { unsigned p[16];
#pragma unroll
      for (int k = 0; k < 16; ++k) p[k] = tk::xswap(kc[k], hi);
      tk::topmerge(kc, p); }
    if (hi == 0) {
#pragma unroll
      for (int k = 0; k < 16; ++k) { KL[k * 32 + r32] = ka[k]; KL[(16 + k) * 32 + r32] = kb[k]; }
    }
    __builtin_amdgcn_wave_barrier();
    const float vmax = va[0] + vb[0];
    float pv[8]; int id[8]; float s = 0.f;
#pragma unroll
    for (int j = 0; j < 8; ++j) {
      unsigned klo_ = kc[j], khi_ = kc[8 + j]; asm volatile("" : "+v"(klo_), "+v"(khi_));
      const unsigned key = hi ? khi_ : klo_;
      const unsigned flat = 255u - (key & 255u);
      const unsigned k1 = KL[(flat >> 4) * 32 + r32], k2 = KL[(16 + (flat & 15u)) * 32 + r32];
      pv[j] = __expf(keyval(k1, 127u) + keyval(k2, 127u) - vmax); s += pv[j];
      id[j] = (int)((127u - (k1 & 127u)) * 128u + (127u - (k2 & 127u)));
    }
    __builtin_amdgcn_wave_barrier();
    const float inv = 1.f / att::xhalf_sum(s);
    u32x4* ep = (u32x4*)(eidx + (size_t)t * 128 + h * 16 + hi * 8); f32x4* gp = (f32x4*)(gate + (size_t)t * 128 + h * 16 + hi * 8);
    ep[0] = (u32x4){(unsigned)id[0], (unsigned)id[1], (unsigned)id[2], (unsigned)id[3]}; ep[1] = (u32x4){(unsigned)id[4], (unsigned)id[5], (unsigned)id[6], (unsigned)id[7]};
    gp[0] = (f32x4){pv[0] * inv, pv[1] * inv, pv[2] * inv, pv[3] * inv}; gp[1] = (f32x4){pv[4] * inv, pv[5] * inv, pv[6] * inv, pv[7] * inv};
  }
}

__device__ __forceinline__ float gelu_erf(float v) { return 0.5f * v * (1.f + erff(v * 0.70710678118654752f)); }

__device__ __forceinline__ float gelu_as(float v) {
  const float av = fabsf(v), t = __builtin_amdgcn_rcpf(av * 0.2316418882f + 1.0f);
  float q = t * 0.5307027145f + (-0.7265760135f); q = q * t + 0.7107068705f; q = q * t + (-0.142248368f); q = q * t + 0.127414796f; q = q * t;
  const float m = v * (q * __builtin_amdgcn_exp2f((v * v) * (-0.72134752044f)));
  return v < 0.f ? m : v - m;
}
#define PIN16(A, O) asm volatile("" : "+v"(A[O]), "+v"(A[O + 1]), "+v"(A[O + 2]), "+v"(A[O + 3]), "+v"(A[O + 4]), "+v"(A[O + 5]), "+v"(A[O + 6]), "+v"(A[O + 7]), "+v"(A[O + 8]), "+v"(A[O + 9]), "+v"(A[O + 10]), "+v"(A[O + 11]), "+v"(A[O + 12]), "+v"(A[O + 13]), "+v"(A[O + 14]), "+v"(A[O + 15]))
#define PIN6(R) asm volatile("" : "+v"(R[0].x), "+v"(R[0].y), "+v"(R[1].x), "+v"(R[1].y), "+v"(R[2].x), "+v"(R[2].y))
__device__ __forceinline__ void phase_exp_down(const Args& a, int gw, int ngw, int lane) {
  unsigned char* ws = a.ws;
  const int* eidx = (const int*)(ws + WS_EIDX); const float* gate = (const float*)(ws + WS_GATE); float* wout = (float*)(ws + WS_W);
  const unsigned char* exd = ws + WS_EXD; const float* esc = (const float*)(ws + WS_ESC);
  const int l32 = lane & 31, hi = lane >> 5;
  const bool b4 = (l32 & 16) != 0, b3 = (l32 & 8) != 0, b2 = (l32 & 4) != 0;
  const bf16_t* hb = (const bf16_t*)(ws + WS_HB); const float* ss2 = (const float*)(ws + WS_SS2);
  int ne0 = 0, ne1 = 0; float ng0 = 0.f, ng1 = 0.f, nss = 0.f; u32x4 nh[4];
  if (gw < NT) { ne0 = eidx[(size_t)gw * 128 + lane]; ne1 = eidx[(size_t)gw * 128 + 64 + lane]; ng0 = gate[(size_t)gw * 128 + lane]; ng1 = gate[(size_t)gw * 128 + 64 + lane]; nss = ss2[gw];
    const u32x4* hp = (const u32x4*)(hb + (size_t)gw * DM + 32 * l32);
#pragma unroll
    for (int k = 0; k < 4; ++k) nh[k] = hp[k]; }
  for (int t = gw; t < NT; t += ngw) {
    const int e0 = ne0, e1 = ne1;
    const float sd0 = esc[e0], sd1 = esc[e1];
    const float gu0 = ng0 * esc[NEXP + e0], gu1 = ng1 * esc[NEXP + e1];
    float hg[32];
    unpack8(nh[0], hg); unpack8(nh[1], hg + 8); unpack8(nh[2], hg + 16); unpack8(nh[3], hg + 24);
    const float rstd = rsqrtf(nss * (1.f / DM) + EPS);
    if (t + ngw < NT) { const size_t tn = (size_t)(t + ngw); ne0 = eidx[tn * 128 + lane]; ne1 = eidx[tn * 128 + 64 + lane]; ng0 = gate[tn * 128 + lane]; ng1 = gate[tn * 128 + 64 + lane]; nss = ss2[tn];
      const u32x4* hp = (const u32x4*)(hb + tn * DM + 32 * l32);
#pragma unroll
      for (int k = 0; k < 4; ++k) nh[k] = hp[k]; }
#pragma unroll
    for (int k = 0; k < 8; ++k) { const f32x4 g = ((const f32x4*)a.in[15])[8 * l32 + k]; hg[4 * k] *= rstd * g.x; hg[4 * k + 1] *= rstd * g.y; hg[4 * k + 2] *= rstd * g.z; hg[4 * k + 3] *= rstd * g.w; }
    float w0 = 0.f, w1 = 0.f;
    for (int e = 0; e < 128; e += 16) {
      u32x2 ur[8][3];
#pragma unroll
      for (int i = 0; i < 8; ++i) {
        const int pi = (e & 63) + 2 * i + hi; const int id = (e < 64) ? __shfl(e0, pi) : __shfl(e1, pi);
        const u32x2* up = (const u32x2*)(exd + (size_t)id * 768 + 24 * l32);
        ur[i][0] = up[0]; ur[i][1] = up[1]; ur[i][2] = up[2];
      }
      float d[8];
#pragma unroll
      for (int i = 0; i < 8; ++i) {
        const v32f u = __builtin_amdgcn_cvt_scalef32_pk32_f32_fp6((v6u){ur[i][0].x, ur[i][0].y, ur[i][1].x, ur[i][1].y, ur[i][2].x, ur[i][2].y}, 1.0f);
        f32x2 q2 = (f32x2){0.f, 0.f};
#pragma unroll
        for (int k = 0; k < 16; ++k) q2 = __builtin_elementwise_fma((f32x2){u[2 * k], u[2 * k + 1]}, (f32x2){hg[2 * k], hg[2 * k + 1]}, q2);
        d[i] = q2.x + q2.y;
        __builtin_amdgcn_sched_barrier(0);
      }
      float r[4];
#pragma unroll
      for (int j = 0; j < 4; ++j) r[j] = (b4 ? d[j + 4] : d[j]) + swz_xor<16>(b4 ? d[j] : d[j + 4]);
      const float q0 = (b3 ? r[2] : r[0]) + swz_xor<8>(b3 ? r[0] : r[2]);
      const float q1 = (b3 ? r[3] : r[1]) + swz_xor<8>(b3 ? r[1] : r[3]);
      float q = (b2 ? q1 : q0) + swz_xor<4>(b2 ? q0 : q1);
      q += swz_xor<2>(q); q += swz_xor<1>(q);
      const int pr = (e & 63) + 2 * (l32 >> 2) + hi;
      const float sd = (e < 64) ? __shfl(sd0, pr) : __shfl(sd1, pr);
      const float gu = (e < 64) ? __shfl(gu0, pr) : __shfl(gu1, pr);
      const float wl = gu * gelu_as(q * sd);
      const float wsrc = __shfl(wl, ((lane & 1) << 5) | (((lane - (e & 63)) >> 1 & 7) << 2));
      if (lane >= (e & 63) && lane < (e & 63) + 16) { if (e < 64) w0 = wsrc; else w1 = wsrc; }
    }
    wout[(size_t)t * 128 + lane] = w0; wout[(size_t)t * 128 + 64 + lane] = w1;
  }
}

__device__ __forceinline__ void exp_up_item(const Args& a, unsigned char* lds, int xs, int item, int wave, int lane, float* xout, float* ssout) {
  unsigned char* ws = a.ws;
  const int* eidx = (const int*)(ws + WS_EIDX); const float* wgt = (const float*)(ws + WS_W);
  const unsigned char* ups = ws + WS_EXU + (size_t)xs * (NEXP * 128);
  unsigned* L = (unsigned*)(lds + wave * 16640);
  const int g = lane >> 2, c = lane & 3, t0 = item * 128 + wave * 16;
  __builtin_amdgcn_wave_barrier();
#pragma unroll 4
  for (int tk = 0; tk < 16; ++tk) {
    const size_t o = (size_t)(t0 + tk) * 128;
    L[tk * 260 + lane] = (unsigned)eidx[o + lane]; L[tk * 260 + 64 + lane] = (unsigned)eidx[o + 64 + lane];
    L[tk * 260 + 128 + lane] = __float_as_uint(wgt[o + lane]); L[tk * 260 + 192 + lane] = __float_as_uint(wgt[o + 64 + lane]);
  }
  __builtin_amdgcn_wave_barrier();
  float acc[32];
#pragma unroll
  for (int i = 0; i < 32; ++i) acc[i] = 0.f;
  const unsigned* Lg = L + g * 260;
#pragma unroll 1
  for (int p = 0; p < 128; p += 8) {
    u32x2 vr[8][3];
#pragma unroll
    for (int u = 0; u < 8; ++u) {
      const u32x2* vp = (const u32x2*)(ups + (size_t)Lg[p + u] * 128 + 24 * c);
      vr[u][0] = vp[0]; vr[u][1] = vp[1]; vr[u][2] = vp[2];
    }
#pragma unroll
    for (int u = 0; u < 8; ++u) {
      const float w = __uint_as_float(Lg[128 + p + u]);
      PIN6(vr[u]);
      const v32f v = __builtin_amdgcn_cvt_scalef32_pk32_f32_fp6((v6u){vr[u][0].x, vr[u][0].y, vr[u][1].x, vr[u][1].y, vr[u][2].x, vr[u][2].y}, 1.0f);
#pragma unroll
      for (int k = 0; k < 32; ++k) acc[k] += w * v[k];
      PIN16(acc, 0); PIN16(acc, 16);
    }
  }
  const f32x4* xr = (const f32x4*)(a.out + (size_t)(t0 + g) * DM + xs * 128 + c * 32); f32x4* xw = (f32x4*)(xout + (size_t)(t0 + g) * DM + xs * 128 + c * 32);
  float s = 0.f;
#pragma unroll
  for (int k = 0; k < 8; ++k) { f32x4 x = xr[k]; x.x += acc[4 * k]; x.y += acc[4 * k + 1]; x.z += acc[4 * k + 2]; x.w += acc[4 * k + 3]; xw[k] = x; s += (x.x * x.x + x.y * x.y) + (x.z * x.z + x.w * x.w); }
  s += swz_xor<1>(s); s += swz_xor<2>(s);
  if (c == 0) atomicAdd(ssout + t0 + g, s);
}
__device__ __forceinline__ void phase_exp_up(const Args& a, unsigned char* lds, const XcdBarrier& bar, int tid, int wave, int lane, unsigned* ctr, float* xout, float* ssout);
struct UpBuf { u32x4 r[8][2]; };
__device__ __forceinline__ void up2_load(UpBuf& B, const unsigned char* ups, const unsigned* Lg, int ch, int c) {
  const unsigned char* base = ups + (size_t)(ch >> 4) * (NEXP * 128) + 32 * c; const int p = (ch & 15) * 8;
#pragma unroll
  for (int u = 0; u < 8; ++u) { const u32x4* vp = (const u32x4*)(base + (size_t)Lg[p + u] * 128); B.r[u][0] = vp[0]; B.r[u][1] = vp[1]; }
}
__device__ __forceinline__ void up2_math(UpBuf& B, const unsigned* Lg, int ch, f32x2 (&acc)[16]) {
  const int p = (ch & 15) * 8;
#pragma unroll
  for (int u = 0; u < 8; ++u) {
    const float w = __uint_as_float(Lg[128 + p + u]);
    const f32x2 w2 = (f32x2){w, w};
#pragma unroll
    for (int q = 0; q < 2; ++q)
#pragma unroll
      for (int k = 0; k < 4; ++k) {
        const auto lo = __builtin_amdgcn_cvt_pk_f32_fp8((int)B.r[u][q][k], false); const auto hi = __builtin_amdgcn_cvt_pk_f32_fp8((int)B.r[u][q][k], true);
        acc[8 * q + 2 * k] = __builtin_elementwise_fma((f32x2){lo[0], lo[1]}, w2, acc[8 * q + 2 * k]);
        acc[8 * q + 2 * k + 1] = __builtin_elementwise_fma((f32x2){hi[0], hi[1]}, w2, acc[8 * q + 2 * k + 1]);
      }
    if (u & 1) PIN16(acc, 0);
  }
}
__device__ __forceinline__ void up2_slice_end(const Args& a, int t, int xs, int c, f32x2 (&acc)[16], float& ssum) {
  f32x4* xr = (f32x4*)(a.out + (size_t)t * DM + xs * 128 + c * 32);
#pragma unroll
  for (int k = 0; k < 8; ++k) { f32x4 x = xr[k]; x.x += acc[2 * k].x; x.y += acc[2 * k].y; x.z += acc[2 * k + 1].x; x.w += acc[2 * k + 1].y; xr[k] = x; ssum += (x.x * x.x + x.y * x.y) + (x.z * x.z + x.w * x.w);
    acc[2 * k] = (f32x2){0.f, 0.f}; acc[2 * k + 1] = (f32x2){0.f, 0.f}; }
}
__device__ __forceinline__ void phase_exp_up2(const Args& a, unsigned char* lds, int wave, int lane) {
  unsigned char* ws = a.ws;
  const int* eidx = (const int*)(ws + WS_EIDX); const float* wgt = (const float*)(ws + WS_W);
  const unsigned char* ups = ws + WS_EXU;
  unsigned* L = (unsigned*)(lds + wave * 16640);
  const int g = lane >> 2, c = lane & 3;
  for (int blk = blockIdx.x; blk < NT / 128; blk += gridDim.x) {
    const int t0 = blk * 128 + wave * 16, t = t0 + g;
    unsigned* H = (unsigned*)(lds + 8 * 16640 + 1024) + wave * 256;
    __builtin_amdgcn_wave_barrier();
    for (int i = lane; i < 256; i += 64) H[i] = 0u;
    __builtin_amdgcn_wave_barrier();
#pragma unroll 4
    for (int tk = 0; tk < 16; ++tk) {
      const size_t o = (size_t)(t0 + tk) * 128;
      const unsigned ea = (unsigned)eidx[o + lane], eb = (unsigned)eidx[o + 64 + lane];
      const unsigned wa = __float_as_uint(wgt[o + lane]), wb = __float_as_uint(wgt[o + 64 + lane]);
      const unsigned ba = ea >> 10, bb = eb >> 10;
      const unsigned ra = atomicAdd(&H[tk * 16 + ba], 1u), rb = atomicAdd(&H[tk * 16 + bb], 1u);
      __builtin_amdgcn_wave_barrier();
      unsigned pa = ra, pb = rb;
#pragma unroll
      for (unsigned b = 0; b < 16; ++b) { const unsigned hb = H[tk * 16 + b]; pa += (b < ba) ? hb : 0u; pb += (b < bb) ? hb : 0u; }
      L[tk * 260 + pa] = ea; L[tk * 260 + 128 + pa] = wa; L[tk * 260 + pb] = eb; L[tk * 260 + 128 + pb] = wb;
    }
    __builtin_amdgcn_wave_barrier();
    const unsigned* Lg = L + g * 260;
    f32x2 acc[16]; float ssum = 0.f;
#pragma unroll
    for (int i = 0; i < 16; ++i) acc[i] = (f32x2){0.f, 0.f};
    UpBuf A, B;
    up2_load(A, ups, Lg, 0, c);
#pragma unroll 1
    for (int ch = 0; ch < 128; ch += 2) {
      up2_load(B, ups, Lg, ch + 1, c);
      up2_math(A, Lg, ch, acc);
      if (ch + 2 < 128) up2_load(A, ups, Lg, ch + 2, c);
      up2_math(B, Lg, ch + 1, acc);
      if ((ch & 15) == 14) up2_slice_end(a, t, ch >> 4, c, acc, ssum);
    }
    ssum += swz_xor<1>(ssum); ssum += swz_xor<2>(ssum);
    const float r2 = rsqrtf(ssum * (1.f / DM) + EPS);
    asm volatile("s_waitcnt vmcnt(0)" ::: "memory");
    __builtin_amdgcn_fence(__ATOMIC_ACQUIRE, "agent");
#pragma unroll 2
    for (int xs = 0; xs < 8; ++xs) {
      f32x4* xr = (f32x4*)(a.out + (size_t)t * DM + xs * 128 + c * 32); const f32x4* gp = (const f32x4*)(a.in[21] + xs * 128 + c * 32);
#pragma unroll
      for (int k = 0; k < 8; ++k) xr[k] = xr[k] * r2 * gp[k];
    }
  }
}

__device__ __forceinline__ void phase_final(const Args& a, int gw, int ngw, int lane) {
  const float* ss = (const float*)(a.ws + WS_SS3);
  for (int r = gw; r < NT; r += ngw) {
    const float r2 = rsqrtf(ss[r] * (1.f / DM) + EPS);
    f32x4* xr = (f32x4*)(a.out + (size_t)r * DM) + lane;
#pragma unroll
    for (int j = 0; j < 4; ++j) { const f32x4 g = ((const f32x4*)a.in[21])[64 * j + lane]; xr[64 * j] = xr[64 * j] * r2 * g; }
  }
}

namespace pg8 {
#define PG8_LAS __attribute__((address_space(3)))
typedef unsigned short bf16_t;
typedef short bf16x8 __attribute__((ext_vector_type(8)));
typedef float f32x4 __attribute__((ext_vector_type(4)));
typedef unsigned u32x4 __attribute__((ext_vector_type(4)));
constexpr int BM = 256, BK = 64, HALF = 128, HTB = HALF * BK * 2  , STAGE_BYTES = 8 * HTB, NXCD = 8, WGM = 8;

__host__ __device__ __forceinline__ int lds_byte(int r, int c) { const int st = (r >> 4) * 2 + (c >> 5), rr = r & 15, cc = c & 31, ob = rr * 64 + cc * 2; return st * 1024 + (ob ^ (((ob >> 9) & 1) << 5)); }
__host__ __device__ __forceinline__ void stage_rc(int b, int& R, int& C) { const int st = b / 1024, sb = b % 1024, swz = sb ^ (((sb >> 9) & 1) << 5); R = (st >> 1) * 16 + swz / 64; C = (st & 1) * 32 + (swz % 64) / 2; }
__host__ __device__ __forceinline__ int perm32(int rho) { const int n = rho >> 4, i = rho & 15; return 8 * (i >> 2) + 4 * n + (i & 3); }

struct Unit { int pm, pn; };
struct Gemm { const bf16_t* A; const bf16_t* Bt; int M, N, K; };

struct StaticOrder {
    int nM, nN, nwg, G, c;
    __host__ __device__ void init(int M, int N, int G_, int c_) { nM = M / BM; nN = N / BM; nwg = nM * nN; G = G_; c = c_; }
    __host__ __device__ bool next(int i, Unit& u) const {
        const long L = (long)i * G + c; if (L >= nwg) return false;
        int wgid = (int)L; { const int q = nwg / NXCD, r = nwg % NXCD, xcd = wgid % NXCD, off = wgid / NXCD; wgid = (xcd < r ? xcd * (q + 1) : r * (q + 1) + (xcd - r) * q) + off; }
        const int nig = WGM * nN, gid = wgid / nig, fm = gid * WGM, gsz = (nM - fm) < WGM ? (nM - fm) : WGM;
        u.pm = fm + ((wgid % nig) % gsz); u.pn = (wgid % nig) / gsz; return true;
    }
    __device__ __forceinline__ void a_ready(const Unit&) const {}
    __device__ __forceinline__ void done(const Unit&) const {}
};

template <class St> struct EpiAdapt8 {
    static constexpr bool PERM = true, AFTER_DRAIN = false; St st;
    __device__ __forceinline__ void operator()(const f32x4 (&acc)[2][2][4][2], const Unit& u, int wr, int wc, int fr, int fq) const {
#pragma unroll
        for (int ai = 0; ai < 2; ++ai)
#pragma unroll
            for (int m = 0; m < 4; ++m)
#pragma unroll
                for (int bj = 0; bj < 2; ++bj) st.store8(u.pm * BM + ai * HALF + wr * 64 + m * 16 + fr, u.pn * BM + bj * HALF + wc * 32 + 8 * fq, acc[ai][bj][m][0], acc[ai][bj][m][1]);
    }
};
template <class St> struct EpiAdapt {
    static constexpr bool PERM = false, AFTER_DRAIN = false; St st;
    __device__ __forceinline__ void operator()(const f32x4 (&acc)[2][2][4][2], const Unit& u, int wr, int wc, int fr, int fq) const {
#pragma unroll
        for (int ai = 0; ai < 2; ++ai)
#pragma unroll
            for (int m = 0; m < 4; ++m)
#pragma unroll
                for (int bj = 0; bj < 2; ++bj)
#pragma unroll
                    for (int n = 0; n < 2; ++n) st.store(u.pm * BM + ai * HALF + wr * 64 + m * 16 + fr, u.pn * BM + bj * HALF + wc * 32 + n * 16 + 4 * fq, acc[ai][bj][m][n]);
    }
};

struct EpiResidSS {
    static constexpr bool PERM = true, AFTER_DRAIN = false; const float* base; float* out; bf16_t* hb; float* ss;
    __device__ __forceinline__ void operator()(const f32x4 (&acc)[2][2][4][2], const Unit& u, int wr, int wc, int fr, int fq) const {
#pragma unroll
        for (int ai = 0; ai < 2; ++ai)
#pragma unroll
            for (int m = 0; m < 4; ++m) {
                const int row = u.pm * BM + ai * HALF + wr * 64 + m * 16 + fr; float s = 0.f;
#pragma unroll
                for (int bj = 0; bj < 2; ++bj) {
                    const size_t o = (size_t)row * 1024 + u.pn * BM + bj * HALF + wc * 32 + 8 * fq;
                    const f32x4 v0 = *(const f32x4*)(base + o) + acc[ai][bj][m][0], v1 = *(const f32x4*)(base + o + 4) + acc[ai][bj][m][1];
                    *(f32x4*)(out + o) = v0; *(f32x4*)(out + o + 4) = v1;
                    { const float f0 = v0.x, f1 = v0.y, f2 = v0.z, f3 = v0.w, f4 = v1.x, f5 = v1.y, f6 = v1.z, f7 = v1.w;
                      *(u32x4*)(hb + o) = (u32x4){::pk2(f0, f1), ::pk2(f2, f3), ::pk2(f4, f5), ::pk2(f6, f7)}; }
                    s += (v0.x * v0.x + v0.y * v0.y) + (v0.z * v0.z + v0.w * v0.w) + (v1.x * v1.x + v1.y * v1.y) + (v1.z * v1.z + v1.w * v1.w);
                }
                s += __shfl_xor(s, 16); s += __shfl_xor(s, 32);
                if (fq == 0) atomicAdd(ss + row, s);
            }
    }
};
template <class Epi, class Sched, bool ALIGN_EPI = false, bool SP2 = false>
__device__ __forceinline__ void gemm_phase(PG8_LAS unsigned char* lds, const Gemm g, const Sched& S, const Epi& E) {
    const int tid = threadIdx.x, wid = __builtin_amdgcn_readfirstlane(tid >> 6), lane = tid & 63, wr = wid >> 2, wc = wid & 3, fr = lane & 15, fq = lane >> 4;
    const int K = g.K, nt = K / BK;
    unsigned voffA[2], voffB[2];
#pragma unroll
    for (int i = 0; i < 2; ++i) { int R, C; stage_rc(tid * 16 + i * 8192, R, C); const int Rb = Epi::PERM ? ((R & ~31) + perm32(R & 31)) : R;
        voffA[i] = (unsigned)(R * K + C) * 2u; voffB[i] = (unsigned)(Rb * K + C) * 2u; }
    const size_t kstep = (size_t)(BK * 2);
    const size_t hstep = (size_t)HALF * K * 2;
    const size_t tstep = 2 * hstep;
    const unsigned ldsw = (unsigned)wid * 1024u;
    const int aoff = lds_byte(wr * 64 + fr, fq * 8), boff = lds_byte(wc * 32 + fr, fq * 8);
#define PG8_SA(b, h) (((b) * 2 + (h)) * HTB)
#define PG8_SB(b, h) ((4 + (b) * 2 + (h)) * HTB)
#define PG8_STAGE(bufoff, gbase, voff) do { _Pragma("unroll") for (int _i = 0; _i < 2; ++_i) \
        __builtin_amdgcn_global_load_lds((const unsigned*)((const char*)(gbase) + (voff)[_i]), (PG8_LAS unsigned*)(lds + (bufoff) + ldsw + _i * 8192), 16, 0, 0); } while (0)
#define PG8_LDA(dst, b, h) do { _Pragma("unroll") for (int m = 0; m < 4; ++m) _Pragma("unroll") for (int k = 0; k < 2; ++k) dst[m][k] = *(const PG8_LAS bf16x8*)(lds + PG8_SA(b, h) + aoff + m * 2048 + k * 1024); } while (0)
#define PG8_LDB(dst, b, h) do { _Pragma("unroll") for (int n = 0; n < 2; ++n) _Pragma("unroll") for (int k = 0; k < 2; ++k) dst[n][k] = *(const PG8_LAS bf16x8*)(lds + PG8_SB(b, h) + boff + n * 2048 + k * 1024); } while (0)
#define PG8_MMA(ai, bj, At, Bt) do { __builtin_amdgcn_s_setprio(1); _Pragma("unroll") for (int m = 0; m < 4; ++m) _Pragma("unroll") for (int n = 0; n < 2; ++n) _Pragma("unroll") for (int k = 0; k < 2; ++k) \
        acc[ai][bj][m][n] = __builtin_amdgcn_mfma_f32_16x16x32_bf16(Bt[n][k], At[m][k], acc[ai][bj][m][n], 0, 0, 0); __builtin_amdgcn_s_setprio(0); } while (0)
#define PG8_WAIT_V(n) asm volatile("s_waitcnt vmcnt(" #n ")" ::: "memory")
#define PG8_WAIT_L(n) asm volatile("s_waitcnt lgkmcnt(" #n ")" ::: "memory")
#define PG8_BAR __builtin_amdgcn_s_barrier()
#define PG8_SCHED __builtin_amdgcn_sched_barrier(0)
    Unit cur, nxt; int ui = 0;
    if (!S.next(0, cur)) return;
    f32x4 acc[2][2][4][2];
#pragma unroll
    for (int a = 0; a < 2; ++a)
#pragma unroll
        for (int b = 0; b < 2; ++b)
#pragma unroll
            for (int m = 0; m < 4; ++m)
#pragma unroll
                for (int n = 0; n < 2; ++n) acc[a][b][m][n] = (f32x4){0.f, 0.f, 0.f, 0.f};
    bf16x8 At[4][2], B0[2][2], B1[2][2];
    const char* cA = (const char*)g.A + (size_t)cur.pm * tstep; const char* cB = (const char*)g.Bt + (size_t)cur.pn * tstep;
    S.a_ready(cur);
    if constexpr (SP2) {
        PG8_STAGE(PG8_SB(0, 0), cB, voffB); PG8_STAGE(PG8_SB(0, 1), cB + hstep, voffB); PG8_STAGE(PG8_SA(0, 0), cA, voffA); PG8_STAGE(PG8_SA(0, 1), cA + hstep, voffA);
        if (wr == 1) PG8_BAR;
        PG8_WAIT_V(2); PG8_BAR;
        PG8_STAGE(PG8_SB(1, 0), cB + kstep, voffB); PG8_STAGE(PG8_SA(1, 0), cA + kstep, voffA); PG8_STAGE(PG8_SB(1, 1), cB + hstep + kstep, voffB);
        PG8_WAIT_V(6); PG8_BAR;
    } else {
        PG8_STAGE(PG8_SB(0, 0), cB, voffB); PG8_STAGE(PG8_SA(0, 0), cA, voffA); PG8_STAGE(PG8_SB(0, 1), cB + hstep, voffB); PG8_STAGE(PG8_SA(0, 1), cA + hstep, voffA);
        if (wr == 1) PG8_BAR;
        PG8_WAIT_V(4); PG8_BAR;
        PG8_STAGE(PG8_SB(1, 0), cB + kstep, voffB); PG8_STAGE(PG8_SA(1, 0), cA + kstep, voffA); PG8_STAGE(PG8_SB(1, 1), cB + hstep + kstep, voffB);
        PG8_WAIT_V(6); PG8_BAR;
    }
    for (;;) {
        const bool has_next = S.next(ui + 1, nxt);
        const char* nA = has_next ? (const char*)g.A + (size_t)nxt.pm * tstep : cA; const char* nB = has_next ? (const char*)g.Bt + (size_t)nxt.pn * tstep : cB;
        for (int t = 0; t < nt; t += 2) {
            const bool last = (t == nt - 2);
            const char* a1 = cA + (size_t)(t + 1) * kstep;
            const char* a2 = last ? nA : cA + (size_t)(t + 2) * kstep; const char* b2 = last ? nB : cB + (size_t)(t + 2) * kstep;
            const char* a3 = a2 + kstep; const char* b3 = b2 + kstep;
            if (last && has_next) S.a_ready(nxt);
            if constexpr (SP2) {
            PG8_LDB(B0, 0, 0); PG8_LDB(B1, 0, 1); PG8_SCHED; PG8_LDA(At, 0, 0); PG8_STAGE(PG8_SA(1, 1), a1 + hstep, voffA);
            PG8_WAIT_V(8); PG8_WAIT_L(0); PG8_BAR; PG8_MMA(0, 0, At, B0); PG8_MMA(0, 1, At, B1); PG8_BAR; PG8_SCHED;
            PG8_LDA(At, 0, 1); PG8_STAGE(PG8_SB(0, 0), b2, voffB); PG8_STAGE(PG8_SB(0, 1), b2 + hstep, voffB); PG8_STAGE(PG8_SA(0, 0), a2, voffA);
            PG8_WAIT_V(8); PG8_WAIT_L(0); PG8_BAR; PG8_MMA(1, 0, At, B0); PG8_MMA(1, 1, At, B1); PG8_BAR; PG8_SCHED;
            PG8_LDB(B0, 1, 0); PG8_LDB(B1, 1, 1); PG8_SCHED; PG8_LDA(At, 1, 0); PG8_STAGE(PG8_SA(0, 1), a2 + hstep, voffA);
            PG8_WAIT_V(8); PG8_WAIT_L(0); PG8_BAR; PG8_MMA(0, 0, At, B0); PG8_MMA(0, 1, At, B1); PG8_BAR; PG8_SCHED;
            PG8_LDA(At, 1, 1); PG8_STAGE(PG8_SB(1, 0), b3, voffB); PG8_STAGE(PG8_SB(1, 1), b3 + hstep, voffB); PG8_STAGE(PG8_SA(1, 0), a3, voffA);
            PG8_WAIT_V(8); PG8_WAIT_L(0); PG8_BAR; PG8_MMA(1, 0, At, B0); PG8_MMA(1, 1, At, B1); PG8_BAR; PG8_SCHED;
            } else {
            PG8_LDB(B0, 0, 0); PG8_SCHED; PG8_LDA(At, 0, 0); PG8_STAGE(PG8_SA(1, 1), a1 + hstep, voffA);
            PG8_WAIT_L(8); PG8_BAR; PG8_WAIT_L(0); PG8_MMA(0, 0, At, B0); PG8_BAR; PG8_SCHED;
            PG8_LDB(B1, 0, 1); PG8_STAGE(PG8_SB(0, 0), b2, voffB);
            PG8_BAR; PG8_WAIT_L(0); PG8_MMA(0, 1, At, B1); PG8_BAR;
            PG8_LDA(At, 0, 1); PG8_STAGE(PG8_SA(0, 0), a2, voffA);
            PG8_BAR; PG8_WAIT_L(0); PG8_MMA(1, 0, At, B0); PG8_BAR; PG8_SCHED;
            PG8_STAGE(PG8_SB(0, 1), b2 + hstep, voffB);
            PG8_WAIT_V(6); PG8_BAR; PG8_MMA(1, 1, At, B1); PG8_BAR;
            PG8_LDB(B0, 1, 0); PG8_SCHED; PG8_LDA(At, 1, 0); PG8_STAGE(PG8_SA(0, 1), a2 + hstep, voffA);
            PG8_WAIT_L(8); PG8_BAR; PG8_WAIT_L(0); PG8_MMA(0, 0, At, B0); PG8_BAR; PG8_SCHED;
            PG8_LDB(B1, 1, 1); PG8_STAGE(PG8_SB(1, 0), b3, voffB);
            PG8_BAR; PG8_WAIT_L(0); PG8_MMA(0, 1, At, B1); PG8_BAR;
            PG8_LDA(At, 1, 1); PG8_STAGE(PG8_SA(1, 0), a3, voffA);
            PG8_BAR; PG8_WAIT_L(0); PG8_MMA(1, 0, At, B0); PG8_BAR; PG8_SCHED;
            PG8_STAGE(PG8_SB(1, 1), b3 + hstep, voffB);
            PG8_WAIT_V(6); PG8_BAR; PG8_MMA(1, 1, At, B1); PG8_BAR;
            }
        }
        if constexpr (ALIGN_EPI) { if (wr == 0) PG8_BAR; }
        if constexpr (!Epi::AFTER_DRAIN) { E(acc, cur, wr, wc, fr, fq); S.done(cur); }
        if (!has_next) break;
#pragma unroll
        for (int a = 0; a < 2; ++a)
#pragma unroll
            for (int b = 0; b < 2; ++b)
#pragma unroll
                for (int m = 0; m < 4; ++m)
#pragma unroll
                    for (int n = 0; n < 2; ++n) acc[a][b][m][n] = (f32x4){0.f, 0.f, 0.f, 0.f};
        cur = nxt; cA = nA; cB = nB; ++ui;
        if constexpr (ALIGN_EPI) { if (wr == 1) PG8_BAR; }
    }
    PG8_WAIT_V(0);
    if constexpr (!ALIGN_EPI) { if (wr == 0) PG8_BAR; }
    PG8_BAR;
    if constexpr (Epi::AFTER_DRAIN) { E.fused(acc, cur, wr, wc, fr, fq, lds, wid, lane); S.done(cur); }
#undef PG8_SA
#undef PG8_SB
#undef PG8_STAGE
#undef PG8_LDA
#undef PG8_LDB
#undef PG8_MMA
#undef PG8_WAIT_V
#undef PG8_WAIT_L
#undef PG8_BAR
#undef PG8_SCHED
}
}


template <class Epi>
__device__ __forceinline__ void run_gemm_raw(unsigned char* lds, const bf16_t* A, const bf16_t* Bt, int M, int N, int K, const Epi& E) {
  pg8::Gemm g{A, Bt, M, N, K}; pg8::StaticOrder S; S.init(M, N, (int)gridDim.x, (int)blockIdx.x);
  pg8::gemm_phase<Epi, pg8::StaticOrder, true, true>((PG8_LAS unsigned char*)lds, g, S, E);
}
template <class St>
__device__ __forceinline__ void run_gemm8(unsigned char* lds, const bf16_t* A, const bf16_t* Bt, int M, int N, int K, const St& st) {
  pg8::Gemm g{A, Bt, M, N, K}; pg8::StaticOrder S; S.init(M, N, (int)gridDim.x, (int)blockIdx.x);
  pg8::EpiAdapt8<St> E{st};
  pg8::gemm_phase<pg8::EpiAdapt8<St>, pg8::StaticOrder, true, true>((PG8_LAS unsigned char*)lds, g, S, E);
}
template <class St>
__device__ __forceinline__ void run_gemm(unsigned char* lds, const bf16_t* A, const bf16_t* Bt, int M, int N, int K, const St& st, int gw, int ngw, int lane) {
#if USE_PG8
  pg8::Gemm g{A, Bt, M, N, K}; pg8::StaticOrder S; S.init(M, N, (int)gridDim.x, (int)blockIdx.x);
  pg8::EpiAdapt<St> E{st};
  pg8::gemm_phase<pg8::EpiAdapt<St>, pg8::StaticOrder, true, true>((PG8_LAS unsigned char*)lds, g, S, E);
#else
  gemm_naive(A, K, Bt, K, M, N, K, st, gw, ngw, lane);
#endif
}

#define GAS __attribute__((address_space(1)))
#define LAS __attribute__((address_space(3)))
#define XB_TMO      128
#define XB_XCNT(j)  (256  + 64 * (j))
#define XB_XSUB(j)  (1280 + 64 * (j))
#define XB_XGEN(j)  (2304 + 64 * (j))
#define XB_TOP      3328
#define XB_TOPGEN   3392
#define XCD_BAR_WORDS 3456
#define XB_SPIN_CAP (1u << 18)

__device__ __forceinline__ unsigned xb_ld(unsigned* p)              { return __hip_atomic_load(p, __ATOMIC_RELAXED, __HIP_MEMORY_SCOPE_AGENT); }
__device__ __forceinline__ unsigned xb_add(unsigned* p, unsigned v) { return __hip_atomic_fetch_add(p, v, __ATOMIC_RELAXED, __HIP_MEMORY_SCOPE_AGENT); }
__device__ __forceinline__ unsigned xb_xcc_id() { return (unsigned)__builtin_amdgcn_s_getreg((3 << 11) | 20) & 0xFu; }
#define XB_SPIN(cond, bar) do { unsigned _sp = 0; while (cond) { __builtin_amdgcn_s_sleep(1); \
    if ((++_sp & 255u) == 0u) { if (xb_ld(&(bar)[XB_TMO])) break; if (_sp > XB_SPIN_CAP) { atomicAdd(&(bar)[XB_TMO], 1u); break; } } } } while (0)

struct XcdBarrier {
    unsigned* bar; unsigned x;
    volatile LAS unsigned* st;
};

__device__ __forceinline__ XcdBarrier xcd_barrier_post(unsigned* bar, volatile LAS unsigned* st) {
    XcdBarrier b; b.bar = bar; b.x = xb_xcc_id(); b.st = st;
    if (threadIdx.x == 0) (void)xb_add(&bar[XB_XCNT(b.x)], 1u);
    return b;
}
__device__ __forceinline__ void xcd_barrier_complete(unsigned* bar, unsigned x, unsigned& nloc, unsigned& nx) {
    const unsigned G = gridDim.x * gridDim.y * gridDim.z;
    unsigned sum, cnt, mine, sp = 0u;
    for (;;) {
        sum = 0u; cnt = 0u; mine = 0u;
#pragma unroll
        for (unsigned j = 0; j < 16; ++j) { const unsigned c = xb_ld(&bar[XB_XCNT(j)]); sum += c; cnt += (c > 0u) ? 1u : 0u; mine = (j == x) ? c : mine; }
        if (sum == G) break;
        __builtin_amdgcn_s_sleep(1);
        if ((++sp & 255u) == 0u) { if (xb_ld(&bar[XB_TMO])) break; if (sp > XB_SPIN_CAP) { atomicAdd(&bar[XB_TMO], 1u); break; } }
    }
    nloc = mine > 0u ? mine : 1u; nx = cnt > 0u ? cnt : 1u;
}

__device__ __forceinline__ void xcd_barrier(const XcdBarrier& b) {
    asm volatile("s_waitcnt vmcnt(0)" ::: "memory");
    __syncthreads();
    if (threadIdx.x == 0) {
        unsigned* bar = b.bar;
        __builtin_amdgcn_s_waitcnt(0);
        unsigned nloc = b.st[0], nx = b.st[1];
        if (nloc == 0u) { xcd_barrier_complete(bar, b.x, nloc, nx); b.st[0] = nloc; b.st[1] = nx; }
        const unsigned old = xb_add(&bar[XB_XSUB(b.x)], 1u);
        const unsigned gen = old / nloc;
        if (old + 1u == (gen + 1u) * nloc) {
            __builtin_amdgcn_fence(__ATOMIC_RELEASE, "agent");
            asm volatile("s_waitcnt vmcnt(0)" ::: "memory");
            const unsigned og = xb_add(&bar[XB_TOP], 1u);
            const unsigned tg = og / nx;
            if (og + 1u == (tg + 1u) * nx) xb_add(&bar[XB_TOPGEN], 1u);
            else XB_SPIN(xb_ld(&bar[XB_TOPGEN]) == tg, bar);
            __builtin_amdgcn_fence(__ATOMIC_ACQUIRE, "agent");
            xb_add(&bar[XB_XGEN(b.x)], 1u);
            asm volatile("s_waitcnt vmcnt(0)" ::: "memory");
        } else {
            XB_SPIN(xb_ld(&bar[XB_XGEN(b.x)]) == gen, bar);
            __builtin_amdgcn_fence(__ATOMIC_ACQUIRE, "agent");
            asm volatile("s_waitcnt vmcnt(0)" ::: "memory");
        }
    }
    __syncthreads();
}

__device__ __forceinline__ void phase_exp_up(const Args& a, unsigned char* lds, const XcdBarrier& bar, int tid, int wave, int lane, unsigned* ctr, float* xout, float* ssout) {
  unsigned* slot = (unsigned*)(lds + 8 * 16640);
  const int x0 = (int)(xb_xcc_id() & 7u);
  for (int k = 0; k < 8; ++k) {
    const int xs = (x0 + k) & 7;
    for (;;) {
      __syncthreads();
      if (tid == 0) slot[0] = atomicAdd(ctr + 16 * xs, 1u);
      __syncthreads();
      const unsigned item = slot[0];
      if (item >= (unsigned)(NT / 128)) break;
      exp_up_item(a, lds, xs, (int)item, wave, lane, xout, ssout);
    }
  }
}

__global__ void __launch_bounds__(512, 2) mega(Args a) {
  extern __shared__ __attribute__((aligned(16))) unsigned char lds[];
  cg::grid_group grid = cg::this_grid();
  const int tid = threadIdx.x, lane = tid & 63, wave = tid >> 6;
  const int gw = blockIdx.x * 8 + wave, ngw = gridDim.x * 8;
  unsigned char* ws = a.ws;
  const int lo = a.ph_lo, hi = a.ph_hi;
#define IN(k) (lo <= (k) && (k) < hi)
  volatile LAS unsigned* MISC = (volatile LAS unsigned*)((LAS unsigned char*)lds + 146944);
  if (tid < 32) MISC[tid] = 0u;
  __syncthreads();
  XcdBarrier bar; bar.bar = (unsigned*)(ws + WS_BAR); bar.x = 0; bar.st = nullptr;
  if (hi - lo > 1) bar = xcd_barrier_post((unsigned*)(ws + WS_BAR), MISC + 8);
  if (lo < -1000000) grid.sync();
#define SEAM(k) do { if (IN(k) && IN((k) + 1)) xcd_barrier(bar); } while (0)
#if PROBE_REP == 0
  if (IN(0)) { phase_prep(a, lds, gw, ngw, wave, lane, tid); grid.sync(); }
#endif
  if (IN(0)) { phase_prep(a, lds, gw, ngw, wave, lane, tid); } SEAM(0);
#if PROBE_REP == 1
  if (IN(1)) {
    run_gemm8(lds, (const bf16_t*)(ws + WS_HB), (const bf16_t*)(ws + WS_WIN_T), NT, NQKV, DM, EpiQKV{(bf16_t*)(ws + WS_QKV)});
    run_gemm8(lds, (const bf16_t*)(ws + WS_MEMN), (const bf16_t*)(ws + WS_WXKV_T), NMROWS, 2048, DM, EpiBf16{(bf16_t*)(ws + WS_KX), 2048});
    xcd_barrier(bar); }
#endif
#if PROBE_REP == 2
  if (IN(2)) { phase_scan(a, gw, ngw, lane, tid); xcd_barrier(bar); phase_rms(a, gw, ngw, lane); xcd_barrier(bar); phase_rms(a, gw, ngw, lane); xcd_barrier(bar); }
#endif
  if (IN(1)) {
    run_gemm8(lds, (const bf16_t*)(ws + WS_HB), (const bf16_t*)(ws + WS_WIN_T), NT, NQKV, DM, EpiQKV{(bf16_t*)(ws + WS_QKV)});
    run_gemm8(lds, (const bf16_t*)(ws + WS_MEMN), (const bf16_t*)(ws + WS_WXKV_T), NMROWS, 2048, DM, EpiBf16{(bf16_t*)(ws + WS_KX), 2048});
  } SEAM(1);
  if (IN(2)) { for (int rep = 0; rep < a.rep_scan; ++rep) { phase_scan(a, gw, ngw, lane, tid); if (rep + 1 < a.rep_scan) xcd_barrier(bar); } } SEAM(2);
#if PROBE_REP == 3
  if (IN(3)) { phase_attn2(a, lds, tid); xcd_barrier(bar); if (blockIdx.x == 0 && tid == 0) *(unsigned*)(ws) = 0u; xcd_barrier(bar); }
#endif
  if (IN(3)) {
#if USE_ATT2
    phase_attn2(a, lds, tid);
#else
    phase_attn(a, lds, tid);
#endif
  } SEAM(3);
  if (IN(4)) { phase_onorm(a, gw, ngw, lane); } SEAM(4);
  if (IN(5)) { run_gemm_raw(lds, (const bf16_t*)(ws + WS_OAB), (const bf16_t*)(ws + WS_WOUT_T), NT, DM, DM, pg8::EpiResidSS{a.in[0], a.out, (bf16_t*)(ws + WS_HB), (float*)(ws + WS_SS1)}); }
  if (IN(5) && IN(7)) xcd_barrier(bar);
  if (IN(7)) { run_gemm8(lds, (const bf16_t*)(ws + WS_HB), (const bf16_t*)(ws + WS_WXQ_T), NT, DM, DM, EpiBf16S{(bf16_t*)(ws + WS_QX), DM, (const float*)(ws + WS_SS1)}); } SEAM(7);
#if PROBE_REP == 8
  if (IN(8)) { phase_xattn(a, lds, gw, ngw, wave, lane); grid.sync(); }
#endif
  if (IN(8)) { phase_xattn2(a, lds, tid); } SEAM(8);
  if (IN(9)) { run_gemm_raw(lds, (const bf16_t*)(ws + WS_OX), (const bf16_t*)(ws + WS_WXO_T), NT, DM, DM, pg8::EpiResidSS{a.out, a.out, (bf16_t*)(ws + WS_HB), (float*)(ws + WS_SS2)}); }
  if (IN(9) && IN(11)) xcd_barrier(bar);
  if (IN(11)) { run_gemm8(lds, (const bf16_t*)(ws + WS_HB), (const bf16_t*)(ws + WS_WPQ_T), NT, DM, DM, EpiBf16S{(bf16_t*)(ws + WS_PQ), DM, (const float*)(ws + WS_SS2)}); } SEAM(11);
#if PROBE_REP == 12
  if (IN(12)) { phase_topk(a, lds, tid); grid.sync(); }
#endif
  if (IN(12)) { phase_topk2(a, lds, wave, lane); } SEAM(12);
    if (IN(13)) {
    for (int rep = 0; rep < a.rep_down; ++rep) { phase_exp_down(a, gw, ngw, lane); if (hi - lo > 1) xcd_barrier(bar); }
    phase_exp_up2(a, lds, wave, lane);
  }
#undef IN
#undef SEAM
}

extern "C" void kernel_launch(void* const* d_in, const int* in_sizes, int n_in, void* d_out, int out_size, void* d_ws, size_t ws_size, hipStream_t stream) {
  static int grid = 0;
  if (grid == 0) {
    if (n_in != 22 || out_size != NT * DM || ws_size < WS_END) { fprintf(stderr, "kernel_launch: unexpected shapes (n_in %d out %d ws %zu)\n", n_in, out_size, ws_size); grid = -1; return; }
    int dev = 0, cus = 0, per_cu = 0;
    (void)hipGetDevice(&dev);
    (void)hipDeviceGetAttribute(&cus, hipDeviceAttributeMultiprocessorCount, dev);
    (void)hipFuncSetAttribute((const void*)mega, hipFuncAttributeMaxDynamicSharedMemorySize, LDS_BYTES);
    (void)hipOccupancyMaxActiveBlocksPerMultiprocessor(&per_cu, (const void*)mega, 512, LDS_BYTES);
    if (per_cu < 1) per_cu = 1;
    grid = cus * per_cu;
  }
  if (grid < 0) return;
  (void)hipMemsetAsync(d_ws, 0, CTL_ZERO_BYTES, stream);
  Args a{};
  for (int i = 0; i < 22; ++i) a.in[i] = (const float*)d_in[i];
  a.out = (float*)d_out; a.ws = (unsigned char*)d_ws;
  a.rep_down = REP_DOWN; a.rep_up = REP_UP; a.rep_scan = REP_SCAN;
#if MK_N_LAUNCHES == 1
  a.ph_lo = 0; a.ph_hi = NPHASE + 1;
  void* args[] = {&a};
  hipError_t e = hipLaunchCooperativeKernel((const void*)mega, dim3(grid), dim3(512), args, LDS_BYTES, stream);
  if (e != hipSuccess) fprintf(stderr, "cooperative launch failed: %s (grid %d)\n", hipGetErrorString(e), grid);
#else
  for (int p = 0; p <= NPHASE; ++p) { a.ph_lo = p; a.ph_hi = p + 1; hipLaunchKernelGGL(mega, dim3(grid), dim3(512), LDS_BYTES, stream, a); }
#endif
}
```

```cpp
#include <hip/hip_runtime.h>
#include <hip/hip_cooperative_groups.h>
#include <cstdio>
#include <cstdint>
namespace cg = cooperative_groups;

#ifndef USE_PG8
#define USE_PG8 1
#endif
#ifndef USE_ATT2
#define USE_ATT2 1
#endif
#ifndef PROBE_REP
#define PROBE_REP -1
#endif
#ifndef REP_DOWN
#define REP_DOWN 1
#endif
#ifndef REP_UP
#define REP_UP 1
#endif
#ifndef REP_SCAN
#define REP_SCAN 1
#endif
#ifndef MK_N_LAUNCHES
#define MK_N_LAUNCHES 1
#endif

typedef unsigned short bf16_t;
typedef short bf16x8 __attribute__((ext_vector_type(8)));
typedef float f32x4 __attribute__((ext_vector_type(4)));
typedef unsigned u32x4 __attribute__((ext_vector_type(4)));
typedef unsigned u32x2 __attribute__((ext_vector_type(2)));
typedef float v32f __attribute__((ext_vector_type(32)));
typedef float v16f __attribute__((ext_vector_type(16)));
typedef unsigned v6u __attribute__((ext_vector_type(6)));
typedef float f32x2 __attribute__((ext_vector_type(2)));

constexpr int NB = 8, SEQ = 4096, DM = 1024, NT = NB * SEQ;
constexpr int NQKV = 3072, INW = 3080;
constexpr int NMEM = 256, NMROWS = NB * NMEM;
constexpr int NEXP = 16384;
constexpr float EPS = 1e-6f;
constexpr int NPHASE = 13;
constexpr int LDS_BYTES = 147456;

constexpr size_t MiB = 1u << 20;
constexpr size_t WS_BAR = 65536;
constexpr size_t WS_SS1 = 131072;
constexpr size_t WS_SS2 = 262144;
constexpr size_t WS_SS3 = 393216;
constexpr size_t WS_XCTR = 512;
constexpr size_t CTL_ZERO_BYTES = 524288;
constexpr size_t WS_WIN_T = 2 * MiB;
constexpr size_t WS_WOUT_T = 8 * MiB;
constexpr size_t WS_WXQ_T = 10 * MiB;
constexpr size_t WS_WXKV_T = 12 * MiB;
constexpr size_t WS_WXO_T = 16 * MiB;
constexpr size_t WS_WPQ_T = 18 * MiB;
constexpr size_t WS_SK = 21 * MiB;
constexpr size_t WS_MEMN = 22 * MiB;
constexpr size_t WS_KX = 26 * MiB;
constexpr size_t WS_VXT = 30 * MiB;
constexpr size_t WS_FLOG = 34 * MiB;
constexpr size_t WS_CUM = 35 * MiB;
constexpr size_t WS_KMEAN = 36 * MiB;
constexpr size_t WS_ESC = 38 * MiB;
constexpr size_t WS_EXD = 40 * MiB;
constexpr size_t WS_EXU = 72 * MiB;
constexpr size_t WS_HB = 104 * MiB;
constexpr size_t WS_QKV = 168 * MiB;
constexpr size_t WS_OAB = 360 * MiB;
constexpr size_t WS_QX = 168 * MiB;
constexpr size_t WS_OX = 232 * MiB;
constexpr size_t WS_PQ = 232 * MiB;
constexpr size_t WS_EIDX = 424 * MiB;
constexpr size_t WS_GATE = 440 * MiB;
constexpr size_t WS_W = 456 * MiB;
constexpr size_t WS_END = 472 * MiB;

struct Args {
  const float* in[22];
  float* out;
  unsigned char* ws;
  int ph_lo, ph_hi;
  int rep_down, rep_up, rep_scan, pad_;
};

struct XcdBarrier;
__device__ __forceinline__ unsigned f2bf(float f) { unsigned u = __float_as_uint(f); return (u + 0x7fffu + ((u >> 16) & 1u)) >> 16; }
__device__ __forceinline__ unsigned pk2(float lo, float hi) { return f2bf(lo) | (f2bf(hi) << 16); }
__device__ __forceinline__ float bf2f(unsigned short b) { return __uint_as_float(((unsigned)b) << 16); }
__device__ __forceinline__ float bflo(unsigned w) { return __uint_as_float(w << 16); }
__device__ __forceinline__ float bfhi(unsigned w) { return __uint_as_float(w & 0xffff0000u); }
__device__ __forceinline__ float wave_sum(float v) {
#pragma unroll
  for (int o = 1; o < 64; o <<= 1) v += __shfl_xor(v, o);
  return v;
}
template <int O> __device__ __forceinline__ float swz_xor(float v) { return __int_as_float(__builtin_amdgcn_ds_swizzle(__float_as_int(v), (O << 10) | 0x1f)); }
__device__ __forceinline__ float half_sum32(float v) { v += swz_xor<1>(v); v += swz_xor<2>(v); v += swz_xor<4>(v); v += swz_xor<8>(v); v += swz_xor<16>(v); return v; }
__device__ __forceinline__ void unpack8(const u32x4 w, float* f) {
  f[0] = bflo(w.x); f[1] = bfhi(w.x); f[2] = bflo(w.y); f[3] = bfhi(w.y);
  f[4] = bflo(w.z); f[5] = bfhi(w.z); f[6] = bflo(w.w); f[7] = bfhi(w.w);
}

__device__ const unsigned char T5_BUCKET[128] = {
  0, 1, 2, 3, 4, 5, 6, 7, 8, 9, 10, 11, 12, 13, 14, 15, 16, 16, 16, 17, 17, 18, 18, 18, 19, 19, 19, 20, 20, 20, 20, 21,
  21, 21, 21, 22, 22, 22, 22, 22, 23, 23, 23, 23, 23, 23, 24, 24, 24, 24, 24, 24, 25, 25, 25, 25, 25, 25, 25, 26, 26, 26, 26, 26,
  26, 26, 26, 27, 27, 27, 27, 27, 27, 27, 27, 27, 27, 28, 28, 28, 28, 28, 28, 28, 28, 28, 28, 29, 29, 29, 29, 29, 29, 29, 29, 29,
  29, 29, 29, 30, 30, 30, 30, 30, 30, 30, 30, 30, 30, 30, 30, 30, 30, 31, 31, 31, 31, 31, 31, 31, 31, 31, 31, 31, 31, 31, 31, 31};

__device__ __forceinline__ void transpose_item(const float* W, int ldw, const float* gain, bf16_t* WT, int K, int row_off, float* scr, int kb, int nb, int lane) {
  const int k0 = 64 * kb, n0 = 32 * nb;
#pragma unroll 8
  for (int i = 0; i < 32; ++i) {
    const int kk = 2 * i + (lane >> 5);
    const float g = gain ? gain[k0 + kk] : 1.f;
    scr[kk * 33 + (lane & 31)] = W[(size_t)(k0 + kk) * ldw + n0 + (lane & 31)] * g;
  }
  __builtin_amdgcn_wave_barrier();
  const int c = lane & 7;
#pragma unroll
  for (int j = 0; j < 4; ++j) {
    const int n = (lane >> 3) + 8 * j; const float* s = scr + (8 * c) * 33 + n;
    u32x4 o; o.x = pk2(s[0 * 33], s[1 * 33]); o.y = pk2(s[2 * 33], s[3 * 33]); o.z = pk2(s[4 * 33], s[5 * 33]); o.w = pk2(s[6 * 33], s[7 * 33]);
    *(u32x4*)(WT + (size_t)(row_off + n0 + n) * K + k0 + 8 * c) = o;
  }
  __builtin_amdgcn_wave_barrier();
}

__device__ __forceinline__ void rms_row_to_bf16(const float* xrow, bf16_t* orow, int lane) {
  const f32x4* xr = (const f32x4*)xrow + lane;
  f32x4 v[4]; float s = 0.f;
#pragma unroll
  for (int j = 0; j < 4; ++j) { v[j] = xr[64 * j]; s += (v[j].x * v[j].x + v[j].y * v[j].y) + (v[j].z * v[j].z + v[j].w * v[j].w); }
  const float rstd = rsqrtf(wave_sum(s) * (1.f / DM) + EPS);
  u32x2* o = (u32x2*)orow + lane;
#pragma unroll
  for (int j = 0; j < 4; ++j) { u32x2 w; w.x = pk2(v[j].x * rstd, v[j].y * rstd); w.y = pk2(v[j].z * rstd, v[j].w * rstd); o[64 * j] = w; }
}

__device__ __forceinline__ void phase_prep(const Args& a, unsigned char* lds, int gw, int ngw, int wave, int lane, int tid) {
  unsigned char* ws = a.ws;
  float* scr = (float*)(lds + wave * 8448);
  const int I_IN = 16 * 96, I_SQ = 16 * 32;
  const int NITEMS = I_IN + 6 * I_SQ;
  for (int it = gw; it < NITEMS; it += ngw) {
    int r = it;
    if (r < I_IN) { transpose_item(a.in[3], INW, a.in[2], (bf16_t*)(ws + WS_WIN_T), DM, 0, scr, r / 96, r % 96, lane); continue; } r -= I_IN;
    const int which = r / I_SQ; r %= I_SQ; const int kb = r / 32, nb = r % 32;
    if (which == 0) { const float* g = (kb < 8) ? a.in[6] : (a.in[7] - 512); transpose_item(a.in[8], DM, g, (bf16_t*)(ws + WS_WOUT_T), DM, 0, scr, kb, nb, lane); }
    else if (which == 1) transpose_item(a.in[11], DM, a.in[9], (bf16_t*)(ws + WS_WXQ_T), DM, 0, scr, kb, nb, lane);
    else if (which == 2) transpose_item(a.in[12], DM, a.in[10], (bf16_t*)(ws + WS_WXKV_T), DM, 0, scr, kb, nb, lane);
    else if (which == 3) transpose_item(a.in[13], DM, a.in[10], (bf16_t*)(ws + WS_WXKV_T), DM, 1024, scr, kb, nb, lane);
    else if (which == 4) transpose_item(a.in[14], DM, nullptr, (bf16_t*)(ws + WS_WXO_T), DM, 0, scr, kb, nb, lane);
    else transpose_item(a.in[16], DM, a.in[15], (bf16_t*)(ws + WS_WPQ_T), DM, 0, scr, kb, nb, lane);
  }
  for (int it = gw; it < NEXP; it += ngw) {
    const int hi = lane >> 5, l32 = lane & 31; const int r = 2 * it + hi;
    const int tb = r >= NEXP, e = r - tb * NEXP;
    const f32x4* src = (const f32x4*)(a.in[19 + tb] + (size_t)e * DM) + 8 * l32;
    v16f xa, xb; float am = 0.f;
#pragma unroll
    for (int k = 0; k < 4; ++k) { const f32x4 p = src[k], q = src[4 + k];
      xa[2 * k] = p.x; xb[2 * k] = p.y; xa[2 * k + 1] = p.z; xb[2 * k + 1] = p.w; xa[8 + 2 * k] = q.x; xb[8 + 2 * k] = q.y; xa[8 + 2 * k + 1] = q.z; xb[8 + 2 * k + 1] = q.w;
      am = fmaxf(am, fmaxf(fmaxf(fabsf(p.x), fabsf(p.y)), fmaxf(fabsf(p.z), fabsf(p.w)))); am = fmaxf(am, fmaxf(fmaxf(fabsf(q.x), fabsf(q.y)), fmaxf(fabsf(q.z), fabsf(q.w)))); }
#pragma unroll
    for (int o = 1; o < 32; o <<= 1) am = fmaxf(am, __shfl_xor(am, o));
    if (tb == 0) {
      const float sc = am > 0.f ? 7.0f / am : 1.f;
      xa = xa * sc; xb = xb * sc;
      const v6u w = __builtin_amdgcn_cvt_scalef32_2xpk16_fp6_f32(xa, xb, 1.0f);
      u32x2* dst = (u32x2*)(ws + WS_EXD + (size_t)e * 768 + 24 * l32);
      dst[0] = (u32x2){w[0], w[1]}; dst[1] = (u32x2){w[2], w[3]}; dst[2] = (u32x2){w[4], w[5]};
      if (l32 == 0) ((float*)(ws + WS_ESC))[r] = am > 0.f ? am / 7.0f : 1.f;
    } else {
      const float sc = am > 0.f ? 440.f / am : 1.f;
      u32x4 o0, o1;
#pragma unroll
      for (int k = 0; k < 4; ++k) { int w = __builtin_amdgcn_cvt_pk_fp8_f32(xa[2 * k] * sc, xb[2 * k] * sc, 0, false); w = __builtin_amdgcn_cvt_pk_fp8_f32(xa[2 * k + 1] * sc, xb[2 * k + 1] * sc, w, true); o0[k] = (unsigned)w; }
#pragma unroll
      for (int k = 0; k < 4; ++k) { int w = __builtin_amdgcn_cvt_pk_fp8_f32(xa[8 + 2 * k] * sc, xb[8 + 2 * k] * sc, 0, false); w = __builtin_amdgcn_cvt_pk_fp8_f32(xa[8 + 2 * k + 1] * sc, xb[8 + 2 * k + 1] * sc, w, true); o1[k] = (unsigned)w; }
      u32x4* dst = (u32x4*)(ws + WS_EXU + (size_t)(l32 >> 2) * (NEXP * 128) + (size_t)e * 128 + 32 * (l32 & 3));
      dst[0] = o0; dst[1] = o1;
      if (l32 == 0) ((float*)(ws + WS_ESC))[r] = am > 0.f ? am / 440.f : 1.f;
    }
  }
  for (int i = blockIdx.x * 512 + tid; i < 2 * 65536; i += gridDim.x * 512) ((bf16_t*)(ws + WS_SK))[i] = (bf16_t)f2bf(a.in[17 + (i >> 16)][i & 65535]);
  for (int r = gw; r < NMROWS; r += ngw) rms_row_to_bf16(a.in[1] + (size_t)r * DM, (bf16_t*)(ws + WS_MEMN) + (size_t)r * DM, lane);
  __syncthreads();
  float* wf = (float*)(lds + 69632);
  for (int k = tid; k < DM; k += 512) {
    const float g = a.in[2][k]; const f32x4* wp = (const f32x4*)(a.in[3] + (size_t)k * INW + NQKV);
    const f32x4 p = wp[0], q = wp[1];
    wf[k] = p.x * g; wf[1024 + k] = p.y * g; wf[2048 + k] = p.z * g; wf[3072 + k] = p.w * g; wf[4096 + k] = q.x * g; wf[5120 + k] = q.y * g; wf[6144 + k] = q.z * g; wf[7168 + k] = q.w * g;
  }
  __syncthreads();
  float* flog = (float*)(ws + WS_FLOG);
  for (int r = gw; r < NT; r += ngw) {
    const f32x4* xr = (const f32x4*)(a.in[0] + (size_t)r * DM) + lane;
    f32x4 v[4]; float s = 0.f; float fa[8];
#pragma unroll
    for (int j = 0; j < 8; ++j) fa[j] = 0.f;
#pragma unroll
    for (int j = 0; j < 4; ++j) {
      v[j] = xr[64 * j]; s += (v[j].x * v[j].x + v[j].y * v[j].y) + (v[j].z * v[j].z + v[j].w * v[j].w);
#pragma unroll
      for (int jj = 0; jj < 8; ++jj) { const f32x4 w4 = *(const f32x4*)(wf + jj * 1024 + 256 * j + 4 * lane); fa[jj] += (v[j].x * w4.x + v[j].y * w4.y) + (v[j].z * w4.z + v[j].w * w4.w); }
    }
    const float rstd = rsqrtf(wave_sum(s) * (1.f / DM) + EPS);
    float mine = 0.f;
#pragma unroll
    for (int j = 0; j < 8; ++j) { const float t = wave_sum(fa[j]); if (lane == j) mine = t; }
    if (lane < 8) {
      const float z = mine * rstd + a.in[4][lane];
      flog[(size_t)lane * NT + r] = fminf(z, 0.f) - log1pf(expf(-fabsf(z)));
    }
    u32x2* o = (u32x2*)((bf16_t*)(ws + WS_HB) + (size_t)r * DM) + lane;
#pragma unroll
    for (int j = 0; j < 4; ++j) { u32x2 w; w.x = pk2(v[j].x * rstd, v[j].y * rstd); w.y = pk2(v[j].z * rstd, v[j].w * rstd); o[64 * j] = w; }
  }
}

template <class Epi>
__device__ __forceinline__ void gemm_naive(const bf16_t* A, int lda, const bf16_t* Bt, int ldb, int M, int N, int K, const Epi& E, int gw, int ngw, int lane) {
  const int fr = lane & 15, fq = lane >> 4;
  const int tn = N / 64, ntile = (M / 64) * tn;
  for (int tile = gw; tile < ntile; tile += ngw) {
    const int pm = tile / tn, pn = tile % tn;
    f32x4 acc[4][4];
#pragma unroll
    for (int m = 0; m < 4; ++m)
#pragma unroll
      for (int n = 0; n < 4; ++n) acc[m][n] = (f32x4){0.f, 0.f, 0.f, 0.f};
    const bf16_t* Ap = A + (size_t)(pm * 64 + fr) * lda + fq * 8;
    const bf16_t* Bp = Bt + (size_t)(pn * 64 + fr) * ldb + fq * 8;
    for (int k0 = 0; k0 < K; k0 += 32) {
      bf16x8 af[4], bfr[4];
#pragma unroll
      for (int m = 0; m < 4; ++m) af[m] = *(const bf16x8*)(Ap + (size_t)m * 16 * lda + k0);
#pragma unroll
      for (int n = 0; n < 4; ++n) bfr[n] = *(const bf16x8*)(Bp + (size_t)n * 16 * ldb + k0);
#pragma unroll
      for (int m = 0; m < 4; ++m)
#pragma unroll
        for (int n = 0; n < 4; ++n) acc[m][n] = __builtin_amdgcn_mfma_f32_16x16x32_bf16(bfr[n], af[m], acc[m][n], 0, 0, 0);
    }
#pragma unroll
    for (int m = 0; m < 4; ++m)
#pragma unroll
      for (int n = 0; n < 4; ++n) E.store(pm * 64 + m * 16 + fr, pn * 64 + n * 16 + 4 * fq, acc[m][n]);
  }
}

struct EpiBf16 { bf16_t* O; int ldo;
  __device__ __forceinline__ void store8(int row, int col, f32x4 a, f32x4 b) const { u32x4 w; w.x = pk2(a.x, a.y); w.y = pk2(a.z, a.w); w.z = pk2(b.x, b.y); w.w = pk2(b.z, b.w); *(u32x4*)(O + (size_t)row * ldo + col) = w; }
  __device__ __forceinline__ void store(int row, int col, f32x4 v) const { u32x2 w; w.x = pk2(v.x, v.y); w.y = pk2(v.z, v.w); *(u32x2*)(O + (size_t)row * ldo + col) = w; } };
struct EpiQKV { bf16_t* O;
  __device__ __forceinline__ void store8(int row, int col, f32x4 a, f32x4 b) const { const float sc = (col < 512 || (col >= 1536 && col < 2048)) ? 0.18033688011112042f : 1.f;
    u32x4 w; w.x = pk2(a.x * sc, a.y * sc); w.y = pk2(a.z * sc, a.w * sc); w.z = pk2(b.x * sc, b.y * sc); w.w = pk2(b.z * sc, b.w * sc); *(u32x4*)(O + (size_t)row * NQKV + col) = w; }
  __device__ __forceinline__ void store(int row, int col, f32x4 v) const { const float sc = (col < 512 || (col >= 1536 && col < 2048)) ? 0.18033688011112042f : 1.f;
    u32x2 w; w.x = pk2(v.x * sc, v.y * sc); w.y = pk2(v.z * sc, v.w * sc); *(u32x2*)(O + (size_t)row * NQKV + col) = w; } };
struct EpiBf16S { bf16_t* O; int ldo; const float* ss;
  __device__ __forceinline__ void store8(int row, int col, f32x4 a, f32x4 b) const { const float r = rsqrtf(ss[row] * (1.f / DM) + EPS);
    u32x4 w; w.x = pk2(a.x * r, a.y * r); w.y = pk2(a.z * r, a.w * r); w.z = pk2(b.x * r, b.y * r); w.w = pk2(b.z * r, b.w * r); *(u32x4*)(O + (size_t)row * ldo + col) = w; }
  __device__ __forceinline__ void store(int row, int col, f32x4 v) const { const float r = rsqrtf(ss[row] * (1.f / DM) + EPS); u32x2 w; w.x = pk2(v.x * r, v.y * r); w.y = pk2(v.z * r, v.w * r); *(u32x2*)(O + (size_t)row * ldo + col) = w; } };
struct EpiF32S { float* O; int ldo; const float* ss;
  __device__ __forceinline__ void store(int row, int col, f32x4 v) const { const float r = rsqrtf(ss[row] * (1.f / DM) + EPS); *(f32x4*)(O + (size_t)row * ldo + col) = v * r; } };
struct EpiF32 { float* O; int ldo;
  __device__ __forceinline__ void store(int row, int col, f32x4 v) const { *(f32x4*)(O + (size_t)row * ldo + col) = v; } };
struct EpiResid { const float* base; float* out;
  __device__ __forceinline__ void store(int row, int col, f32x4 v) const { const size_t o = (size_t)row * DM + col; const f32x4 b = *(const f32x4*)(base + o); *(f32x4*)(out + o) = b + v; } };
struct EpiKV { bf16_t* KX; bf16_t* VXT;
  __device__ __forceinline__ void store(int row, int col, f32x4 v) const {
    if (col < 1024) { u32x2 w; w.x = pk2(v.x, v.y); w.y = pk2(v.z, v.w); *(u32x2*)(KX + (size_t)row * DM + col) = w; }
    else { const int b = row >> 8, m = row & 255;
#pragma unroll
      for (int r = 0; r < 4; ++r) { const int d = col - 1024 + r; VXT[((size_t)(b * 4 + (d >> 8)) * 256 + (d & 255)) * 256 + m] = (bf16_t)f2bf(v[r]); } } } };

__device__ __forceinline__ void phase_scan(const Args& a, int gw, int ngw, int lane, int tid) {
  unsigned char* ws = a.ws;
  const bf16_t* qkv = (const bf16_t*)(ws + WS_QKV);
  for (int item = gw; item < 64 + 1024 + 1024; item += ngw) {
    if (item < 64) {
      const int b = item >> 3, j = item & 7;
      const f32x4* src = (const f32x4*)((const float*)(ws + WS_FLOG) + (size_t)j * NT + (size_t)b * SEQ + lane * 64);
      f32x4 v[16];
#pragma unroll
      for (int i = 0; i < 16; ++i) v[i] = src[i];
      float tot = 0.f;
#pragma unroll
      for (int i = 0; i < 16; ++i) tot += (v[i].x + v[i].y) + (v[i].z + v[i].w);
      float inc = tot;
#pragma unroll
      for (int o = 1; o < 64; o <<= 1) { const float t = __shfl_up(inc, o); if (lane >= o) inc += t; }
      float run = inc - tot;
      f32x4* dst = (f32x4*)((float*)(ws + WS_CUM) + ((size_t)(b * 8 + j)) * SEQ + lane * 64);
#pragma unroll
      for (int i = 0; i < 16; ++i) { f32x4 o; run += v[i].x; o.x = run * 1.4426950408889634f; run += v[i].y; o.y = run * 1.4426950408889634f; run += v[i].z; o.z = run * 1.4426950408889634f; run += v[i].w; o.w = run * 1.4426950408889634f; dst[i] = o; }
    } else if (item < 64 + 1024) {
      const int it = item - 64, h = it & 7, blk = (it >> 3) & 15, b = it >> 7;
      const bf16_t* p = qkv + ((size_t)b * SEQ + blk * 256 + (lane >> 3)) * NQKV + 512 + h * 64 + (lane & 7) * 8;
      float s[8];
#pragma unroll
      for (int i = 0; i < 8; ++i) s[i] = 0.f;
#pragma unroll 8
      for (int rr = 0; rr < 32; ++rr) { float f[8]; unpack8(*(const u32x4*)(p + (size_t)rr * 8 * NQKV), f);
#pragma unroll
        for (int i = 0; i < 8; ++i) s[i] += f[i]; }
#pragma unroll
      for (int i = 0; i < 8; ++i) { s[i] += __shfl_xor(s[i], 8); s[i] += __shfl_xor(s[i], 16); s[i] += __shfl_xor(s[i], 32); }
      if (lane < 8) { f32x4* d = (f32x4*)((float*)(ws + WS_KMEAN) + ((size_t)(b * 16 + blk) * 8 + h) * 64 + lane * 8);
        d[0] = (f32x4){s[0], s[1], s[2], s[3]} * (1.f / 256.f); d[1] = (f32x4){s[4], s[5], s[6], s[7]} * (1.f / 256.f); }
    } else {
      const int it = item - 64 - 1024, bh = it >> 4, ch = it & 15, b = bh >> 3, h = bh & 7;
      const bf16_t* p = qkv + ((size_t)b * SEQ + ch * 256 + (lane >> 3)) * NQKV + 2048 + h * 64 + (lane & 7) * 8;
      float m = 0.f;
#pragma unroll 8
      for (int rr = 0; rr < 32; ++rr) { float f[8]; unpack8(*(const u32x4*)(p + (size_t)rr * 8 * NQKV), f);
        float s = 0.f;
#pragma unroll
        for (int i = 0; i < 8; ++i) s += f[i] * f[i];
        s += __shfl_xor(s, 1); s += __shfl_xor(s, 2); s += __shfl_xor(s, 4);
        m = fmaxf(m, s); }
#pragma unroll
      for (int o = 8; o < 64; o <<= 1) m = fmaxf(m, __shfl_xor(m, o));
      if (lane == 0) atomicMax((unsigned*)(ws + 256) + bh, __float_as_uint(m));
    }
  }
}

template <int MODE>
__device__ __forceinline__ void attn_naive_unit(const Args& a, unsigned char* lds, int b, int h, int sb, int tid) {
  unsigned char* ws = a.ws;
  const bf16_t* qkv = (const bf16_t*)(ws + WS_QKV);
  const int qoff = MODE ? 1536 : 0, koff = qoff + 512, voff = qoff + 1024;
  float* Ks = (float*)lds; float* Vs = Ks + 64 * 64; float* ck = Vs + 64 * 64; float* biasd = ck + 64;
  const int t = sb * 512 + tid; const size_t row = (size_t)b * SEQ + t;
  float q[64], o[64];
  {
    const u32x4* qp = (const u32x4*)(qkv + row * NQKV + qoff + h * 64);
#pragma unroll
    for (int c = 0; c < 8; ++c) { const u32x4 w = qp[c]; unpack8(w, q + 8 * c); }
#pragma unroll
    for (int d = 0; d < 64; ++d) { q[d] *= 0.6931471805599453f; o[d] = 0.f; }
  }
  float m = -1e30f, l = 0.f;
  unsigned selmask = 0u; const int own = t >> 8;
  float cq = 0.f, bfar = 0.f;
  __syncthreads();
  if (MODE == 0) {
    if (tid < 128) biasd[tid] = a.in[5][T5_BUCKET[tid] * 8 + h];
    bfar = a.in[5][31 * 8 + h];
    const float* km = (const float*)(ws + WS_KMEAN) + ((size_t)b * 16) * 512 + h * 64;
    float v0 = -3e38f, v1 = -3e38f, v2 = -3e38f; int i0 = -1, i1 = -1, i2 = -1;
    for (int n = 0; n < 2 * sb + 1; ++n) {
      if (n < own) {
        const float* kp = km + (size_t)n * 512; float s = 0.f;
#pragma unroll
        for (int d = 0; d < 64; ++d) s += q[d] * kp[d];
        if (s > v0) { v2 = v1; i2 = i1; v1 = v0; i1 = i0; v0 = s; i0 = n; }
        else if (s > v1) { v2 = v1; i2 = i1; v1 = s; i1 = n; }
        else if (s > v2) { v2 = s; i2 = n; }
      }
    }
    if (i0 >= 0) selmask |= 1u << i0;
    if (i1 >= 0) selmask |= 1u << i1;
    if (i2 >= 0) selmask |= 1u << i2;
  } else {
    cq = ((const float*)(ws + WS_CUM))[((size_t)(b * 8 + h)) * SEQ + t];
  }
  const int ntile = 8 * (sb + 1);
  for (int kt = 0; kt < ntile; ++kt) {
    __syncthreads();
    {
      const int r = tid >> 3, ch = tid & 7;
      const bf16_t* kp = qkv + ((size_t)b * SEQ + kt * 64 + r) * NQKV + h * 64 + ch * 8;
      const u32x4 kw = *(const u32x4*)(kp + koff), vw = *(const u32x4*)(kp + voff);
      unpack8(kw, Ks + r * 64 + ch * 8); unpack8(vw, Vs + r * 64 + ch * 8);
      if (MODE == 1 && tid < 64) ck[tid] = ((const float*)(ws + WS_CUM))[((size_t)(b * 8 + h)) * SEQ + kt * 64 + tid];
    }
    __syncthreads();
    const int kb = kt >> 2;
    bool act;
    if (MODE == 0) act = (kb == own) || (kb < own && ((selmask >> kb) & 1u));
    else act = (kt * 64 <= t);
    if (act) {
      for (int jj = 0; jj < 64; ++jj) {
        const int sp = kt * 64 + jj;
        if (sp > t) break;
        const f32x4* kr = (const f32x4*)(Ks + jj * 64);
        float s = 0.f;
#pragma unroll
        for (int c = 0; c < 16; ++c) { const f32x4 kv = kr[c]; s += q[4 * c] * kv.x + q[4 * c + 1] * kv.y + q[4 * c + 2] * kv.z + q[4 * c + 3] * kv.w; }
        if (MODE == 0) { const int dist = t - sp; s += (dist < 128) ? biasd[dist] : bfar; }
        else s += (cq - ck[jj]) * 0.6931471805599453f;
        if (s > m) { const float f = __expf(m - s); l *= f;
#pragma unroll
          for (int d = 0; d < 64; ++d) o[d] *= f;
          m = s; }
        const float p = __expf(s - m); l += p;
        const f32x4* vr = (const f32x4*)(Vs + jj * 64);
#pragma unroll
        for (int c = 0; c < 16; ++c) { const f32x4 vv = vr[c]; o[4 * c] += p * vv.x; o[4 * c + 1] += p * vv.y; o[4 * c + 2] += p * vv.z; o[4 * c + 3] += p * vv.w; }
      }
    }
  }
  const float il = 1.f / l;
  u32x4* op = (u32x4*)((bf16_t*)(ws + WS_OAB) + row * DM + (MODE ? 512 : 0) + h * 64);
#pragma unroll
  for (int c = 0; c < 8; ++c) { u32x4 w; w.x = pk2(o[8 * c] * il, o[8 * c + 1] * il); w.y = pk2(o[8 * c + 2] * il, o[8 * c + 3] * il); w.z = pk2(o[8 * c + 4] * il, o[8 * c + 5] * il); w.w = pk2(o[8 * c + 6] * il, o[8 * c + 7] * il); op[c] = w; }
}

__device__ __forceinline__ void phase_attn(const Args& a, unsigned char* lds, int tid) {
  for (int u = blockIdx.x; u < 1024; u += gridDim.x) {
    const int sb = 7 - (u >> 7), r = u & 127, mode = r & 1, bh = r >> 1;
    if (mode == 0) attn_naive_unit<0>(a, lds, bh >> 3, bh & 7, sb, tid);
    else attn_naive_unit<1>(a, lds, bh >> 3, bh & 7, sb, tid);
  }
}

namespace att {
typedef float f32x16 __attribute__((ext_vector_type(16)));
typedef short s16x4 __attribute__((ext_vector_type(4)));
typedef short v4i16_t __attribute__((ext_vector_type(4)));
typedef __attribute__((address_space(3))) const char* lds_cptr;
typedef float f32x2_t __attribute__((ext_vector_type(2))); typedef __bf16 bf16x2_t __attribute__((ext_vector_type(2)));
constexpr int PITCH = NQKV;
constexpr float LOG2E = 1.4426950408889634f;
constexpr float C2 = 0.125f * LOG2E;
constexpr int L_K = 0, L_V = 16384, L_WSF = 32768, L_OST = 34816, L_C2 = 67584, L_KM = 83968, L_BT = 88064, L_MISC = 88704;
__device__ __forceinline__ int crow(int r, int hi) { return (r & 3) + 8 * (r >> 2) + 4 * hi; }
__device__ __forceinline__ unsigned cvtpk(float lo, float hi) { f32x2_t v = {lo, hi}; bf16x2_t b = __builtin_convertvector(v, bf16x2_t); return __builtin_bit_cast(unsigned, b); }
__device__ __forceinline__ s16x4 vtr(lds_cptr p) { return __builtin_bit_cast(s16x4, __builtin_amdgcn_ds_read_tr16_b64_v4i16((__attribute__((address_space(3))) v4i16_t*)p)); }
__device__ __forceinline__ float max3f(float a, float b, float c) { float r; asm("v_max3_f32 %0, %1, %2, %3" : "=v"(r) : "v"(a), "v"(b), "v"(c)); return r; }
__device__ __forceinline__ float xhalf_max(float m) { auto rr = __builtin_amdgcn_permlane32_swap(__float_as_uint(m), __float_as_uint(m), false, false); return fmaxf(__uint_as_float(rr[0]), __uint_as_float(rr[1])); }
__device__ __forceinline__ float xhalf_sum(float m) { auto rr = __builtin_amdgcn_permlane32_swap(__float_as_uint(m), __float_as_uint(m), false, false); return __uint_as_float(rr[0]) + __uint_as_float(rr[1]); }

template <int MODE>
__device__ __forceinline__ void unit(const Args& a, unsigned char* lds, int b, int h, int qb, int tid) {
  unsigned char* ws = a.ws;
  const int lane = tid & 63, r32 = lane & 31, hi = lane >> 5; const int wid = __builtin_amdgcn_readfirstlane(tid >> 6);
  const bf16_t* qkv = (const bf16_t*)(ws + WS_QKV);
  const int qoff = MODE ? 1536 : 0;
  const size_t rowbase = (size_t)b * SEQ; const int q0 = qb * 256;
  const bf16_t* Qw = qkv + (rowbase + q0 + wid * 32) * PITCH + qoff + h * 64;
  const bf16_t* Kh = qkv + rowbase * PITCH + qoff + 512 + h * 64;
  const bf16_t* Vh = qkv + rowbase * PITCH + qoff + 1024 + h * 64;
  float* wsf = (float*)(lds + L_WSF) + wid * 64;
  float* c2s = (float*)(lds + L_C2); float* kms = (float*)(lds + L_KM); float* bts = (float*)(lds + L_BT); unsigned* misc = (unsigned*)(lds + L_MISC);
  const int NTL = 4 * (qb + 1);
  __syncthreads();
  if (MODE == 0) {
    const float* km = (const float*)(ws + WS_KMEAN) + (size_t)b * 16 * 512 + h * 64;
    for (int i = tid; i < 16 * 64; i += 512) kms[i] = km[(size_t)(i >> 6) * 512 + (i & 63)];
    if (tid < 128) bts[tid] = a.in[5][T5_BUCKET[tid] * 8 + h] * LOG2E;
    if (tid == 128) bts[128] = a.in[5][31 * 8 + h] * LOG2E;
  } else {
    const float* cg = (const float*)(ws + WS_CUM) + (size_t)(b * 8 + h) * SEQ;
    for (int i = tid; i < 256 * (qb + 1); i += 512) c2s[i] = cg[i];
    if (tid == 0) misc[0] = 0u;
  }
  bf16x8 qr[4];
#pragma unroll
  for (int d0 = 0; d0 < 4; ++d0) qr[d0] = *(const bf16x8*)(Qw + (size_t)r32 * PITCH + d0 * 16 + hi * 8);
  __syncthreads();
  unsigned selmask = 0u; float cq2 = 0.f, far2 = 0.f, mhat = 0.f; int t0 = 0;
  if (MODE == 0) {
    far2 = bts[128];
    float v0 = -3e38f, v1 = -3e38f, v2 = -3e38f; int i0 = -1, i1 = -1, i2 = -1;
    for (int n = 0; n < qb; ++n) {
      float s = 0.f;
#pragma unroll
      for (int d0 = 0; d0 < 4; ++d0)
#pragma unroll
        for (int j = 0; j < 8; ++j) s += bf2f((unsigned short)qr[d0][j]) * kms[n * 64 + d0 * 16 + hi * 8 + j];
      s = xhalf_sum(s);
      if (s > v0) { v2 = v1; i2 = i1; v1 = v0; i1 = i0; v0 = s; i0 = n; }
      else if (s > v1) { v2 = v1; i2 = i1; v1 = s; i1 = n; }
      else if (s > v2) { v2 = s; i2 = n; }
    }
    if (i0 >= 0) selmask |= 1u << i0;
    if (i1 >= 0) selmask |= 1u << i1;
    if (i2 >= 0) selmask |= 1u << i2;
  } else {
    cq2 = c2s[q0 + wid * 32 + r32];
    float s = 0.f;
#pragma unroll
    for (int d0 = 0; d0 < 4; ++d0)
#pragma unroll
      for (int j = 0; j < 8; ++j) { const float f = bf2f((unsigned short)qr[d0][j]); s += f * f; }
    s = xhalf_sum(s);
    atomicMax(&misc[0], __float_as_uint(s));
    __syncthreads();
    const float kn2 = __uint_as_float(((const unsigned*)(ws + 256))[b * 8 + h]);
    const float qkb = sqrtf(__uint_as_float(misc[0]) * kn2) * 1.0001f + 1e-3f;
    mhat = -qkb;
    const int j = lane; bool skip = false;
    if (j < NTL) skip = (2.f * qkb + c2s[q0] - c2s[64 * j + 63]) < -150.f;
    t0 = __popcll(__ballot(skip));
    if (t0 > NTL - 1) t0 = NTL - 1;
  }
  const bf16_t* ksrc = Kh + (size_t)lane * PITCH + wid * 8;
  const bf16_t* vsrc = Vh + (size_t)(16 * (wid & 3) + (lane >> 2)) * PITCH + (wid >> 2) * 32 + (lane & 3) * 8;
  unsigned char* kdst = lds + L_K + wid * 1024 + lane * 16; unsigned char* vdst = lds + L_V + wid * 1024 + lane * 16;
  const lds_cptr lds3 = (lds_cptr)lds;
  const lds_cptr vp0 = lds3 + L_V + ((lane >> 4) & 1) * 32 + (lane & 3) * 8 + (4 * hi + ((lane & 15) >> 2)) * 64;
  u32x4 kreg = *(const u32x4*)(ksrc + (size_t)t0 * 64 * PITCH), vreg = *(const u32x4*)(vsrc + (size_t)t0 * 64 * PITCH);
  *(u32x4*)(kdst + (t0 & 1) * 8192) = kreg; *(u32x4*)(vdst + (t0 & 1) * 8192) = vreg;
  f32x16 o[2]; o[0] = f32x16{}; o[1] = f32x16{};
  f32x16 ol = f32x16{}, cm = f32x16{}; int cm_nb = -1;
  const int qrel = wid * 32 + r32, qpos = q0 + qrel;
  __syncthreads();
  for (int t = t0; t < NTL; ++t) {
    const int buf = (t & 1) * 8192;
    if (t + 1 < NTL) { kreg = *(const u32x4*)(ksrc + (size_t)(t + 1) * 64 * PITCH); vreg = *(const u32x4*)(vsrc + (size_t)(t + 1) * 64 * PITCH); }
    const int jb = t - (NTL - 4);
    const bool compute = !(jb >= 0 && 64 * jb > wid * 32 + 31);
    if (compute) {
      f32x16 p0, p1;
      bf16x8 kf[8];
      {
        const lds_cptr kb = lds3 + L_K + buf + hi * 1024 + r32 * 16;
#pragma unroll
        for (int d0 = 0; d0 < 4; ++d0) { kf[2 * d0] = *(const __attribute__((address_space(3))) bf16x8*)(kb + d0 * 2048); kf[2 * d0 + 1] = *(const __attribute__((address_space(3))) bf16x8*)(kb + d0 * 2048 + 512); }
      }
      __builtin_amdgcn_sched_barrier(0);
      if (MODE == 0) {
        const int nb = t >> 2;
        const bool near = (jb >= 0) || (t >= NTL - 6 && wid < 4);
        if (near) {
#pragma unroll
          for (int r = 0; r < 16; ++r) { const int d = qpos - (64 * t + crow(r, hi));
            p0[r] = bts[min(max(d, 0), 128)] - mhat; p1[r] = bts[min(max(d - 32, 0), 128)] - mhat; }
          if (jb < 0 && !((selmask >> nb) & 1u)) {
#pragma unroll
            for (int r = 0; r < 16; ++r) { p0[r] = -INFINITY; p1[r] = -INFINITY; }
          }
        } else {
          if (cm_nb != nb) {
            const float base = ((selmask >> nb) & 1u) ? far2 - mhat : -INFINITY;
#pragma unroll
            for (int r = 0; r < 16; ++r) cm[r] = base;
            cm_nb = nb;
          }
          p0 = cm; p1 = cm;
        }
      } else {
        const float cqm = cq2 - mhat;
#pragma unroll
        for (int g = 0; g < 4; ++g) {
          const f32x4 ca = *(const f32x4*)(c2s + 64 * t + 8 * g + 4 * hi), cb = *(const f32x4*)(c2s + 64 * t + 32 + 8 * g + 4 * hi);
#pragma unroll
          for (int i = 0; i < 4; ++i) { p0[4 * g + i] = cqm - ca[i]; p1[4 * g + i] = cqm - cb[i]; }
        }
      }
#pragma unroll
      for (int d0 = 0; d0 < 4; ++d0) {
        p0 = __builtin_amdgcn_mfma_f32_32x32x16_bf16(kf[2 * d0], qr[d0], p0, 0, 0, 0);
        p1 = __builtin_amdgcn_mfma_f32_32x32x16_bf16(kf[2 * d0 + 1], qr[d0], p1, 0, 0, 0);
      }
      if (jb >= 0) {
        asm volatile("" ::: "memory");
        const int kb0 = 64 * jb + 4 * hi;
#pragma unroll
        for (int r = 0; r < 16; ++r) { const int kv = kb0 + (r & 3) + 8 * (r >> 2); if (kv > qrel) p0[r] = -INFINITY; if (kv + 32 > qrel) p1[r] = -INFINITY; }
      }
      asm volatile("s_nop 15\n\ts_nop 7" : "+v"(p0), "+v"(p1));
      float rm, rm2;
      rm = max3f(p0[0], p0[1], p1[0]); rm2 = max3f(p0[2], p0[3], p1[1]); rm = max3f(rm, p1[2], p1[3]);
#pragma unroll
      for (int r = 4; r < 16; r += 4) { rm = max3f(rm, p0[r], p0[r + 1]); rm2 = max3f(rm2, p0[r + 2], p0[r + 3]); rm = max3f(rm, p1[r], p1[r + 1]); rm2 = max3f(rm2, p1[r + 2], p1[r + 3]); }
      rm = xhalf_max(fmaxf(rm, rm2));
      if (__any(rm > 8.0f)) {
        const float dl = fmaxf(rm, 0.f), alpha = __builtin_amdgcn_exp2f(-dl);
        mhat += dl; cm_nb = -1;
#pragma unroll
        for (int r = 0; r < 16; ++r) { p0[r] -= dl; p1[r] -= dl; }
        if (hi == 0) wsf[r32] = alpha;
        __builtin_amdgcn_wave_barrier();
#pragma unroll
        for (int r = 0; r < 16; ++r) { const float f = wsf[crow(r, hi)]; o[0][r] *= f; o[1][r] *= f; ol[r] *= f; }
        __builtin_amdgcn_wave_barrier();
      }
#pragma unroll
      for (int r = 0; r < 16; ++r) { p0[r] = __builtin_amdgcn_exp2f(p0[r]); p1[r] = __builtin_amdgcn_exp2f(p1[r]); }
      u32x4 pw0, pw1, pw2, pw3;
      pw0 = (u32x4){cvtpk(p0[0], p0[1]), cvtpk(p0[2], p0[3]), cvtpk(p0[4], p0[5]), cvtpk(p0[6], p0[7])};
      pw1 = (u32x4){cvtpk(p0[8], p0[9]), cvtpk(p0[10], p0[11]), cvtpk(p0[12], p0[13]), cvtpk(p0[14], p0[15])};
      pw2 = (u32x4){cvtpk(p1[0], p1[1]), cvtpk(p1[2], p1[3]), cvtpk(p1[4], p1[5]), cvtpk(p1[6], p1[7])};
      pw3 = (u32x4){cvtpk(p1[8], p1[9]), cvtpk(p1[10], p1[11]), cvtpk(p1[12], p1[13]), cvtpk(p1[14], p1[15])};
      {
        const bf16x8 ones = (bf16x8){0x3F80, 0x3F80, 0x3F80, 0x3F80, 0x3F80, 0x3F80, 0x3F80, 0x3F80};
        ol = __builtin_amdgcn_mfma_f32_32x32x16_bf16(__builtin_bit_cast(bf16x8, pw0), ones, ol, 0, 0, 0);
        ol = __builtin_amdgcn_mfma_f32_32x32x16_bf16(__builtin_bit_cast(bf16x8, pw1), ones, ol, 0, 0, 0);
        ol = __builtin_amdgcn_mfma_f32_32x32x16_bf16(__builtin_bit_cast(bf16x8, pw2), ones, ol, 0, 0, 0);
        ol = __builtin_amdgcn_mfma_f32_32x32x16_bf16(__builtin_bit_cast(bf16x8, pw3), ones, ol, 0, 0, 0);
      }
      const lds_cptr vp = vp0 + buf;
#pragma unroll
      for (int d0 = 0; d0 < 2; ++d0) {
#define ATT_VF(ks) ({ const s16x4 lo_ = vtr(vp + d0 * 4096 + (ks) * 1024), hi_ = vtr(vp + d0 * 4096 + (ks) * 1024 + 512); (bf16x8){lo_[0], lo_[1], lo_[2], lo_[3], hi_[0], hi_[1], hi_[2], hi_[3]}; })
        o[d0] = __builtin_amdgcn_mfma_f32_32x32x16_bf16(__builtin_bit_cast(bf16x8, pw0), ATT_VF(0), o[d0], 0, 0, 0);
        o[d0] = __builtin_amdgcn_mfma_f32_32x32x16_bf16(__builtin_bit_cast(bf16x8, pw1), ATT_VF(1), o[d0], 0, 0, 0);
        o[d0] = __builtin_amdgcn_mfma_f32_32x32x16_bf16(__builtin_bit_cast(bf16x8, pw2), ATT_VF(2), o[d0], 0, 0, 0);
        o[d0] = __builtin_amdgcn_mfma_f32_32x32x16_bf16(__builtin_bit_cast(bf16x8, pw3), ATT_VF(3), o[d0], 0, 0, 0);
#undef ATT_VF
      }
    }
    if (t + 1 < NTL) { *(u32x4*)(kdst + ((t + 1) & 1) * 8192) = kreg; *(u32x4*)(vdst + ((t + 1) & 1) * 8192) = vreg; }
    __syncthreads();
  }
  bf16_t* stg = (bf16_t*)(lds + L_OST) + wid * 2048;
#pragma unroll
  for (int r = 0; r < 16; ++r) { const int orow = crow(r, hi); const float rl = 1.f / ol[r];
    stg[orow * 64 + r32] = (bf16_t)f2bf(o[0][r] * rl); stg[orow * 64 + 32 + r32] = (bf16_t)f2bf(o[1][r] * rl); }
  __builtin_amdgcn_wave_barrier();
  bf16_t* Ow = (bf16_t*)(ws + WS_OAB) + (rowbase + q0 + wid * 32) * DM + (MODE ? 512 : 0) + h * 64;
#pragma unroll
  for (int i = 0; i < 4; ++i) { const int row = i * 8 + (lane >> 3), ch = lane & 7; const u32x4 v = *(const u32x4*)(stg + row * 64 + ch * 8); *(u32x4*)(Ow + (size_t)row * DM + ch * 8) = v; }
}
}

__device__ __forceinline__ void phase_attn2(const Args& a, unsigned char* lds, int tid) {
  unsigned* ctr = (unsigned*)(a.ws + 0);
  unsigned* slot = (unsigned*)(lds + att::L_MISC + 64);
  for (;;) {
    __syncthreads();
    if (tid == 0) slot[0] = atomicAdd(ctr, 1u);
    __syncthreads();
    const unsigned u = slot[0];
    if (u >= 2048u) break;
    const int qb = 15 - (int)(u >> 7), r = u & 127, mode = r & 1, bh = r >> 1;
    if (mode == 0) att::unit<0>(a, lds, bh >> 3, bh & 7, qb, tid);
    else att::unit<1>(a, lds, bh >> 3, bh & 7, qb, tid);
  }
}

__device__ __forceinline__ void phase_onorm(const Args& a, int gw, int ngw, int lane) {
  bf16_t* oab = (bf16_t*)(a.ws + WS_OAB);
  for (int r = gw; r < NT; r += ngw) {
    u32x4* p = (u32x4*)(oab + (size_t)r * DM) + 2 * lane;
    const u32x4 w0 = p[0], w1 = p[1]; float f[16]; unpack8(w0, f); unpack8(w1, f + 8);
    float s = 0.f;
#pragma unroll
    for (int i = 0; i < 16; ++i) s += f[i] * f[i];
#pragma unroll
    for (int o = 1; o < 32; o <<= 1) s += __shfl_xor(s, o);
    const float rstd = rsqrtf(s * (1.f / 512.f) + EPS);
    u32x4 o0, o1;
    o0.x = pk2(f[0] * rstd, f[1] * rstd); o0.y = pk2(f[2] * rstd, f[3] * rstd); o0.z = pk2(f[4] * rstd, f[5] * rstd); o0.w = pk2(f[6] * rstd, f[7] * rstd);
    o1.x = pk2(f[8] * rstd, f[9] * rstd); o1.y = pk2(f[10] * rstd, f[11] * rstd); o1.z = pk2(f[12] * rstd, f[13] * rstd); o1.w = pk2(f[14] * rstd, f[15] * rstd);
    p[0] = o0; p[1] = o1;
  }
}

__device__ __forceinline__ void phase_rms(const Args& a, int gw, int ngw, int lane) {
  for (int r = gw; r < NT; r += ngw) rms_row_to_bf16(a.out + (size_t)r * DM, (bf16_t*)(a.ws + WS_HB) + (size_t)r * DM, lane);
}

__device__ __forceinline__ void phase_xattn(const Args& a, unsigned char* lds, int gw, int ngw, int wave, int lane) {
  unsigned char* ws = a.ws;
  const bf16_t* qx = (const bf16_t*)(ws + WS_QX); const bf16_t* kx = (const bf16_t*)(ws + WS_KX); const bf16_t* vxt = (const bf16_t*)(ws + WS_VXT);
  bf16_t* ox = (bf16_t*)(ws + WS_OX);
  bf16_t* P = (bf16_t*)(lds + wave * 8192);
  const int fr = lane & 15, fq = lane >> 4;
  for (int u = gw; u < (NT / 16) * 4; u += ngw) {
    const int hd = u & 3, r0 = (u >> 2) * 16, b = r0 / SEQ;
    f32x4 acc[16];
#pragma unroll
    for (int i = 0; i < 16; ++i) acc[i] = (f32x4){0.f, 0.f, 0.f, 0.f};
    const bf16_t* Ap = qx + (size_t)(r0 + fr) * DM + hd * 256 + fq * 8;
    const bf16_t* Bp = kx + (size_t)(b * 256 + fr) * DM + hd * 256 + fq * 8;
    for (int ks = 0; ks < 8; ++ks) {
      const bf16x8 af = *(const bf16x8*)(Ap + ks * 32);
#pragma unroll
      for (int ct = 0; ct < 16; ++ct) { const bf16x8 bfr = *(const bf16x8*)(Bp + (size_t)ct * 16 * DM + ks * 32); acc[ct] = __builtin_amdgcn_mfma_f32_16x16x32_bf16(af, bfr, acc[ct], 0, 0, 0); }
    }
    float mx[4], sm[4];
#pragma unroll
    for (int r = 0; r < 4; ++r) { float m = acc[0][r];
#pragma unroll
      for (int ct = 1; ct < 16; ++ct) m = fmaxf(m, acc[ct][r]);
#pragma unroll
      for (int o = 1; o < 16; o <<= 1) m = fmaxf(m, __shfl_xor(m, o));
      mx[r] = m; sm[r] = 0.f; }
#pragma unroll
    for (int ct = 0; ct < 16; ++ct)
#pragma unroll
      for (int r = 0; r < 4; ++r) { const float p = __expf((acc[ct][r] - mx[r]) * 0.0625f); acc[ct][r] = p; sm[r] += p; }
#pragma unroll
    for (int r = 0; r < 4; ++r) {
#pragma unroll
      for (int o = 1; o < 16; o <<= 1) sm[r] += __shfl_xor(sm[r], o);
      sm[r] = 1.f / sm[r]; }
    __builtin_amdgcn_wave_barrier();
#pragma unroll
    for (int ct = 0; ct < 16; ++ct)
#pragma unroll
      for (int r = 0; r < 4; ++r) P[(4 * fq + r) * 256 + ct * 16 + fr] = (bf16_t)f2bf(acc[ct][r] * sm[r]);
    __builtin_amdgcn_wave_barrier();
    asm volatile("s_waitcnt lgkmcnt(0)" ::: "memory");
#pragma unroll
    for (int i = 0; i < 16; ++i) acc[i] = (f32x4){0.f, 0.f, 0.f, 0.f};
    const bf16_t* Vp = vxt + ((size_t)(b * 4 + hd) * 256 + fr) * 256 + fq * 8;
    for (int ks = 0; ks < 8; ++ks) {
      const bf16x8 pf = *(const bf16x8*)(P + fr * 256 + ks * 32 + fq * 8);
#pragma unroll
      for (int dt = 0; dt < 16; ++dt) { const bf16x8 vf = *(const bf16x8*)(Vp + (size_t)dt * 16 * 256 + ks * 32); acc[dt] = __builtin_amdgcn_mfma_f32_16x16x32_bf16(pf, vf, acc[dt], 0, 0, 0); }
    }
#pragma unroll
    for (int dt = 0; dt < 16; ++dt)
#pragma unroll
      for (int r = 0; r < 4; ++r) ox[(size_t)(r0 + 4 * fq + r) * DM + hd * 256 + dt * 16 + fr] = (bf16_t)f2bf(acc[dt][r]);
    __builtin_amdgcn_wave_barrier();
  }
}

namespace xa {
using att::f32x16; using att::s16x4; using att::lds_cptr; using att::crow; using att::cvtpk; using att::vtr; using att::xhalf_max; using att::xhalf_sum;
constexpr int L_WSF = 98304;
__device__ __forceinline__ void glds16(const void* gsrc, unsigned lds_dst) { unsigned keep;
  asm volatile("s_mov_b32 %0, m0\n\ts_mov_b32 m0, %2\n\ts_nop 0\n\tglobal_load_lds_dwordx4 %1, off\n\ts_mov_b32 m0, %0" : "=&s"(keep) : "v"(gsrc), "s"(lds_dst) : "memory"); }
__device__ __forceinline__ void unit(const Args& a, unsigned char* lds, int b, int hd, int qb, int tid) {
  unsigned char* ws = a.ws;
  const int lane = tid & 63, r32 = lane & 31, hi = lane >> 5; const int wid = __builtin_amdgcn_readfirstlane(tid >> 6);
  const bf16_t* qrow = (const bf16_t*)(ws + WS_QX) + ((size_t)b * SEQ + qb * 256 + wid * 32 + r32) * DM + hd * 256;
  const bf16_t* kvb = (const bf16_t*)(ws + WS_KX) + (size_t)b * 256 * 2048 + hd * 256;
  const bf16_t* ksrc = kvb + (size_t)lane * 2048 + wid * 8;
  const bf16_t* vsrc = kvb + 1024 + (size_t)(16 * (wid & 3) + (lane >> 2)) * 2048 + (wid >> 2) * 32 + (lane & 3) * 8;
  const unsigned sdst = (unsigned)(uintptr_t)lds + wid * 1024;
  const lds_cptr lds3 = (lds_cptr)lds;
  const lds_cptr kp0 = lds3 + hi * 1024 + r32 * 16;
  const lds_cptr vp0 = lds3 + ((lane >> 4) & 1) * 32 + (lane & 3) * 8 + (4 * hi + ((lane & 15) >> 2)) * 64;
  float* wsf = (float*)(lds + L_WSF) + wid * 64;
#define XA_DMA(s) do { const unsigned db_ = (unsigned)__builtin_amdgcn_readfirstlane(sdst + ((s) % 3) * 32768); \
    const bf16_t* kq_ = ksrc; const bf16_t* vq_ = vsrc; asm volatile("" : "+v"(kq_), "+v"(vq_));        \
    if ((s) < 4) { _Pragma("unroll") for (int kt = 0; kt < 4; ++kt) glds16(kq_ + (size_t)kt * 64 * 2048 + (s) * 64, db_ + kt * 8192); } \
    else { _Pragma("unroll") for (int dq = 0; dq < 4; ++dq) glds16(vq_ + (size_t)((s) - 4) * 64 * 2048 + dq * 64, db_ + dq * 8192); } } while (0)
#define XA_CLOSE(s) do { if ((s) + 2 < 8) asm volatile("s_waitcnt vmcnt(4) lgkmcnt(0)\n\ts_barrier" ::: "memory"); else asm volatile("s_waitcnt vmcnt(0) lgkmcnt(0)\n\ts_barrier" ::: "memory"); } while (0)
  __syncthreads();
  asm volatile("s_waitcnt vmcnt(0)" ::: "memory");
  XA_DMA(0); XA_DMA(1);
  f32x16 acc[8];
#pragma unroll
  for (int j = 0; j < 8; ++j) acc[j] = f32x16{};
  asm volatile("s_waitcnt vmcnt(4) lgkmcnt(0)\n\ts_barrier" ::: "memory");
#pragma unroll
  for (int c = 0; c < 4; ++c) {
    XA_DMA(c + 2);
    bf16x8 qf[4];
#pragma unroll
    for (int d0 = 0; d0 < 4; ++d0) qf[d0] = *(const bf16x8*)(qrow + c * 64 + d0 * 16 + hi * 8);
    int koff_ = (c % 3) * 32768; asm volatile("" : "+v"(koff_));
    const lds_cptr kp = kp0 + koff_;
#pragma unroll
    for (int d0 = 0; d0 < 4; ++d0)
#pragma unroll
      for (int j = 0; j < 8; ++j) {
        const bf16x8 kf = *(const __attribute__((address_space(3))) bf16x8*)(kp + (j >> 1) * 8192 + d0 * 2048 + (j & 1) * 512);
        acc[j] = __builtin_amdgcn_mfma_f32_32x32x16_bf16(kf, qf[d0], acc[j], 0, 0, 0);
      }
    XA_CLOSE(c);
  }
  float m = acc[0][0];
#pragma unroll
  for (int j = 0; j < 8; ++j)
#pragma unroll
    for (int r = 0; r < 16; ++r) m = fmaxf(m, acc[j][r]);
  m = xhalf_max(m);
  constexpr float CS = 1.4426950408889634f / 16.f;
  float l = 0.f; u32x4 pw[16];
#pragma unroll
  for (int j = 0; j < 8; ++j) {
#pragma unroll
    for (int r = 0; r < 16; ++r) { const float p = __builtin_amdgcn_exp2f((acc[j][r] - m) * CS); acc[j][r] = p; l += p; }
    pw[2 * j] = (u32x4){cvtpk(acc[j][0], acc[j][1]), cvtpk(acc[j][2], acc[j][3]), cvtpk(acc[j][4], acc[j][5]), cvtpk(acc[j][6], acc[j][7])};
    pw[2 * j + 1] = (u32x4){cvtpk(acc[j][8], acc[j][9]), cvtpk(acc[j][10], acc[j][11]), cvtpk(acc[j][12], acc[j][13]), cvtpk(acc[j][14], acc[j][15])};
  }
  l = xhalf_sum(l);
#pragma unroll
  for (int j = 0; j < 8; ++j) acc[j] = f32x16{};
#pragma unroll
  for (int vt = 0; vt < 4; ++vt) {
    if (vt + 6 < 8) XA_DMA(vt + 6);
    int voff_ = ((vt + 4) % 3) * 32768; asm volatile("" : "+v"(voff_));
    const lds_cptr vp = vp0 + voff_;
#pragma unroll
    for (int ks = 0; ks < 4; ++ks)
#pragma unroll
      for (int db = 0; db < 8; ++db) {
        const s16x4 lo_ = vtr(vp + (db >> 1) * 8192 + (db & 1) * 4096 + ks * 1024), hi_ = vtr(vp + (db >> 1) * 8192 + (db & 1) * 4096 + ks * 1024 + 512);
        const bf16x8 vf = (bf16x8){lo_[0], lo_[1], lo_[2], lo_[3], hi_[0], hi_[1], hi_[2], hi_[3]};
        acc[db] = __builtin_amdgcn_mfma_f32_32x32x16_bf16(__builtin_bit_cast(bf16x8, pw[4 * vt + ks]), vf, acc[db], 0, 0, 0);
      }
    XA_CLOSE(vt + 4);
  }
  if (hi == 0) wsf[r32] = l;
  __builtin_amdgcn_wave_barrier();
  float rl[16];
#pragma unroll
  for (int r = 0; r < 16; ++r) rl[r] = 1.f / wsf[crow(r, hi)];
  int sbase = (4 * hi) * 128 + r32, lbase = (lane >> 4) * 128 + (lane & 15) * 8;
  asm volatile("" : "+v"(sbase), "+v"(lbase));
  bf16_t* stg = (bf16_t*)(lds + wid * 8192);
  bf16_t* orow0 = (bf16_t*)(ws + WS_OX) + ((size_t)b * SEQ + qb * 256 + wid * 32) * DM + hd * 256 + (size_t)(lane >> 4) * DM + (lane & 15) * 8;
#pragma unroll
  for (int hf = 0; hf < 2; ++hf) {
#pragma unroll
    for (int db = 0; db < 4; ++db)
#pragma unroll
      for (int r = 0; r < 16; ++r) stg[sbase + ((r & 3) + 8 * (r >> 2)) * 128 + db * 32] = (bf16_t)f2bf(acc[hf * 4 + db][r] * rl[r]);
    __builtin_amdgcn_wave_barrier();
#pragma unroll
    for (int i = 0; i < 8; ++i) { const u32x4 v = *(const u32x4*)(stg + lbase + i * 4 * 128); *(u32x4*)(orow0 + (size_t)(i * 4) * DM + hf * 128) = v; }
    __builtin_amdgcn_wave_barrier();
  }
#undef XA_DMA
#undef XA_CLOSE
}
}

__device__ __forceinline__ void phase_xattn2(const Args& a, unsigned char* lds, int tid) {
  for (int u = blockIdx.x; u < NB * 4 * 16; u += gridDim.x) { const int qb = u & 15, hd = (u >> 4) & 3, b = u >> 6; xa::unit(a, lds, b, hd, qb, tid); }
}

__device__ __forceinline__ unsigned fkey(float s, unsigned idx, unsigned mask) { unsigned u = __float_as_uint(s); u ^= (unsigned)((int)u >> 31) | 0x80000000u; return (u & ~mask) | (mask - idx); }
__device__ __forceinline__ float keyval(unsigned k, unsigned mask) { unsigned u = k & ~mask; u = (u & 0x80000000u) ? (u ^ 0x80000000u) : ~u; return __uint_as_float(u); }
#define KEY_INSERT(KA, key_) do { unsigned k__ = (key_); \
  _Pragma("unroll") for (int s_ = 0; s_ < 16; ++s_) { const unsigned hi_ = max(k__, KA[s_]); k__ = min(k__, KA[s_]); KA[s_] = hi_; } } while (0)

__device__ __forceinline__ void phase_topk(const Args& a, unsigned char* lds, int tid) {
  unsigned char* ws = a.ws;
  const float* pq = (const float*)(ws + WS_PQ);
  int* eidx = (int*)(ws + WS_EIDX); float* gate = (float*)(ws + WS_GATE);
  float* K1 = (float*)lds; float* K2 = K1 + 128 * 64; unsigned* KL = (unsigned*)(lds + 65536);
  for (int u = blockIdx.x; u < 8 * (NT / 512); u += gridDim.x) {
    const int h = u & 7, t = (u >> 3) * 512 + tid;
    __syncthreads();
    for (int i = tid; i < 128 * 64 / 4; i += 512) { ((f32x4*)K1)[i] = ((const f32x4*)(a.in[17] + (size_t)h * 8192))[i]; ((f32x4*)K2)[i] = ((const f32x4*)(a.in[18] + (size_t)h * 8192))[i]; }
    __syncthreads();
    unsigned ka[16], kb[16], kc[16];
#pragma unroll
    for (int k = 0; k < 16; ++k) { ka[k] = 0u; kb[k] = 0u; kc[k] = 0u; }
    float q[64];
    const f32x4* qp = (const f32x4*)(pq + (size_t)t * DM + h * 128);
#pragma unroll
    for (int c = 0; c < 16; ++c) { const f32x4 w = qp[c]; q[4 * c] = w.x; q[4 * c + 1] = w.y; q[4 * c + 2] = w.z; q[4 * c + 3] = w.w; }
    for (int n = 0; n < 128; ++n) {
      const f32x4* kr = (const f32x4*)(K1 + n * 64); float s = 0.f;
#pragma unroll
      for (int c = 0; c < 16; ++c) { const f32x4 kv = kr[c]; s += q[4 * c] * kv.x + q[4 * c + 1] * kv.y + q[4 * c + 2] * kv.z + q[4 * c + 3] * kv.w; }
      KEY_INSERT(ka, fkey(s, (unsigned)n, 127u));
    }
#pragma unroll
    for (int c = 0; c < 16; ++c) { const f32x4 w = qp[16 + c]; q[4 * c] = w.x; q[4 * c + 1] = w.y; q[4 * c + 2] = w.z; q[4 * c + 3] = w.w; }
    for (int n = 0; n < 128; ++n) {
      const f32x4* kr = (const f32x4*)(K2 + n * 64); float s = 0.f;
#pragma unroll
      for (int c = 0; c < 16; ++c) { const f32x4 kv = kr[c]; s += q[4 * c] * kv.x + q[4 * c + 1] * kv.y + q[4 * c + 2] * kv.z + q[4 * c + 3] * kv.w; }
      KEY_INSERT(kb, fkey(s, (unsigned)n, 127u));
    }
#pragma unroll
    for (int x = 0; x < 16; ++x)
#pragma unroll
      for (int y = 0; y < 16; ++y)
        if ((x + 1) * (y + 1) <= 16) { KEY_INSERT(kc, fkey(keyval(ka[x], 127u) + keyval(kb[y], 127u), (unsigned)(x * 16 + y), 255u)); }
#pragma unroll
    for (int k = 0; k < 16; ++k) { KL[k * 512 + tid] = ka[k]; KL[(16 + k) * 512 + tid] = kb[k]; }
    float val[16]; int id[16]; float sum = 0.f;
#pragma unroll
    for (int k = 0; k < 16; ++k) {
      const unsigned flat = 255u - (kc[k] & 255u);
      const unsigned k1 = KL[(flat >> 4) * 512 + tid], k2 = KL[(16 + (flat & 15u)) * 512 + tid];
      val[k] = keyval(k1, 127u) + keyval(k2, 127u);
      id[k] = (int)((127u - (k1 & 127u)) * 128u + (127u - (k2 & 127u)));
    }
    const float vmax = val[0];
#pragma unroll
    for (int k = 0; k < 16; ++k) { val[k] = __expf(val[k] - vmax); sum += val[k]; }
    const float inv = 1.f / sum;
    int* ep = eidx + (size_t)t * 128 + h * 16; float* gp = gate + (size_t)t * 128 + h * 16;
#pragma unroll
    for (int k = 0; k < 16; ++k) { ep[k] = id[k]; gp[k] = val[k] * inv; }
  }
}


namespace tk {
typedef float f32x16 __attribute__((ext_vector_type(16)));
__device__ __forceinline__ void ce(unsigned& a, unsigned& b) { const unsigned h = max(a, b), l = min(a, b); a = h; b = l; }
__device__ __forceinline__ void sort16(unsigned (&v)[16]) {
#pragma unroll
  for (int k = 2; k <= 16; k <<= 1)
#pragma unroll
    for (int j = k >> 1; j > 0; j >>= 1)
#pragma unroll
      for (int i = 0; i < 16; ++i) { const int l = i ^ j; if (l > i) { if ((i & k) == 0) ce(v[i], v[l]); else ce(v[l], v[i]); } }
}
__device__ __forceinline__ void topmerge(unsigned (&a)[16], const unsigned (&b)[16]) {
#pragma unroll
  for (int i = 0; i < 16; ++i) a[i] = max(a[i], b[15 - i]);
#pragma unroll
  for (int j = 8; j > 0; j >>= 1)
#pragma unroll
    for (int i = 0; i < 16; ++i) { const int l = i ^ j; if (l > i) ce(a[i], a[l]); }
}
__device__ __forceinline__ unsigned xswap(unsigned v, int hi) { auto rr = __builtin_amdgcn_permlane32_swap(v, v, false, false); return hi ? rr[0] : rr[1]; }
__device__ __forceinline__ void half_list(unsigned (&L)[16], const bf16_t* skh, const bf16_t* qrow, int r32, int hi) {
  f32x16 acc[4];
#pragma unroll
  for (int i = 0; i < 4; ++i) acc[i] = f32x16{};
#pragma unroll
  for (int ks = 0; ks < 4; ++ks) {
    const bf16x8 qf = *(const bf16x8*)(qrow + ks * 16 + hi * 8);
#pragma unroll
    for (int tl = 0; tl < 4; ++tl) { const bf16x8 kf = *(const bf16x8*)(skh + (size_t)(tl * 32 + r32) * 64 + ks * 16 + hi * 8); acc[tl] = __builtin_amdgcn_mfma_f32_32x32x16_bf16(kf, qf, acc[tl], 0, 0, 0); }
  }
  unsigned g[4][16];
#pragma unroll
  for (int tl = 0; tl < 4; ++tl)
#pragma unroll
    for (int r = 0; r < 16; ++r) g[tl][r] = fkey(acc[tl][r], (unsigned)(32 * tl + (r & 3) + 8 * (r >> 2) + 4 * hi), 127u);
  sort16(g[0]); sort16(g[1]); sort16(g[2]); sort16(g[3]);
  topmerge(g[0], g[1]); topmerge(g[2], g[3]); topmerge(g[0], g[2]);
  unsigned p[16];
#pragma unroll
  for (int k = 0; k < 16; ++k) p[k] = xswap(g[0][k], hi);
  topmerge(g[0], p);
#pragma unroll
  for (int k = 0; k < 16; ++k) L[k] = g[0][k];
}
}

__device__ __forceinline__ void phase_topk2(const Args& a, unsigned char* lds, int wave, int lane) {
  unsigned char* ws = a.ws;
  const bf16_t* pq = (const bf16_t*)(ws + WS_PQ); const bf16_t* sk = (const bf16_t*)(ws + WS_SK);
  int* eidx = (int*)(ws + WS_EIDX); float* gate = (float*)(ws + WS_GATE);
  const int r32 = lane & 31, hi = lane >> 5, h = wave;
  unsigned* KL = (unsigned*)(lds + wave * 4096);
  for (int tt = blockIdx.x; tt < NT / 32; tt += gridDim.x) {
    const int t = tt * 32 + r32;
    unsigned ka[16], kb[16], kc[16];
    tk::half_list(ka, sk + (size_t)(0 * 8 + h) * 8192, pq + (size_t)t * DM + h * 128, r32, hi);
    tk::half_list(kb, sk + (size_t)(1 * 8 + h) * 8192, pq + (size_t)t * DM + h * 128 + 64, r32, hi);
    float va[16], vb[16];
#pragma unroll
    for (int k = 0; k < 16; ++k) { va[k] = keyval(ka[k], 127u); vb[k] = keyval(kb[k], 127u); }
#pragma unroll
    for (int y = 0; y < 16; ++y) kc[y] = hi ? 0u : fkey(va[0] + vb[y], (unsigned)y, 255u);
#define TK_CAND(xa, ya, xb, yb) do { const unsigned kA_ = fkey(va[xa] + vb[ya], (unsigned)((xa) * 16 + (ya)), 255u), kB_ = fkey(va[xb] + vb[yb], (unsigned)((xb) * 16 + (yb)), 255u); KEY_INSERT(kc, hi ? kB_ : kA_); } while (0)
    TK_CAND(1, 0, 1, 1);
    TK_CAND(1, 2, 1, 3);
    TK_CAND(1, 4, 1, 5);
    TK_CAND(1, 6, 1, 7);
    TK_CAND(2, 0, 2, 1);
    TK_CAND(2, 2, 2, 3);
    TK_CAND(2, 4, 3, 0);
    TK_CAND(3, 1, 3, 2);
    TK_CAND(3, 3, 4, 0);
    TK_CAND(4, 1, 4, 2);
    TK_CAND(5, 0, 5, 1);
    TK_CAND(6, 0, 6, 1);
    TK_CAND(7, 0, 7, 1);
    TK_CAND(8, 0, 9, 0);
    TK_CAND(10, 0, 11, 0);
    TK_CAND(12, 0, 13, 0);
    TK_CAND(14, 0, 15, 0);
#undef TK_CAND
    { unsigned p[16];
#pragma unroll
      for (int k = 0; k < 16; ++k) p[k] = tk::xswap(kc[k], hi);
      tk::topmerge(kc, p); }
    if (hi == 0) {
#pragma unroll
      for (int k = 0; k < 16; ++k) { KL[k * 32 + r32] = ka[k]; KL[(16 + k) * 32 + r32] = kb[k]; }
    }
    __builtin_amdgcn_wave_barrier();
    const float vmax = va[0] + vb[0];
    float pv[8]; int id[8]; float s = 0.f;
#pragma unroll
    for (int j = 0; j < 8; ++j) {
      unsigned klo_ = kc[j], khi_ = kc[8 + j]; asm volatile("" : "+v"(klo_), "+v"(khi_));
      const unsigned key = hi ? khi_ : klo_;
      const unsigned flat = 255u - (key & 255u);
      const unsigned k1 = KL[(flat >> 4) * 32 + r32], k2 = KL[(16 + (flat & 15u)) * 32 + r32];
      pv[j] = __expf(keyval(k1, 127u) + keyval(k2, 127u) - vmax); s += pv[j];
      id[j] = (int)((127u - (k1 & 127u)) * 128u + (127u - (k2 & 127u)));
    }
    __builtin_amdgcn_wave_barrier();
    const float inv = 1.f / att::xhalf_sum(s);
    u32x4* ep = (u32x4*)(eidx + (size_t)t * 128 + h * 16 + hi * 8); f32x4* gp = (f32x4*)(gate + (size_t)t * 128 + h * 16 + hi * 8);
    ep[0] = (u32x4){(unsigned)id[0], (unsigned)id[1], (unsigned)id[2], (unsigned)id[3]}; ep[1] = (u32x4){(unsigned)id[4], (unsigned)id[5], (unsigned)id[6], (unsigned)id[7]};
    gp[0] = (f32x4){pv[0] * inv, pv[1] * inv, pv[2] * inv, pv[3] * inv}; gp[1] = (f32x4){pv[4] * inv, pv[5] * inv, pv[6] * inv, pv[7] * inv};
  }
}

__device__ __forceinline__ float gelu_erf(float v) { return 0.5f * v * (1.f + erff(v * 0.70710678118654752f)); }

__device__ __forceinline__ float gelu_as(float v) {
  const float av = fabsf(v), t = __builtin_amdgcn_rcpf(av * 0.2316418882f + 1.0f);
  float q = t * 0.5307027145f + (-0.7265760135f); q = q * t + 0.7107068705f; q = q * t + (-0.142248368f); q = q * t + 0.127414796f; q = q * t;
  const float m = v * (q * __builtin_amdgcn_exp2f((v * v) * (-0.72134752044f)));
  return v < 0.f ? m : v - m;
}
#define PIN16(A, O) asm volatile("" : "+v"(A[O]), "+v"(A[O + 1]), "+v"(A[O + 2]), "+v"(A[O + 3]), "+v"(A[O + 4]), "+v"(A[O + 5]), "+v"(A[O + 6]), "+v"(A[O + 7]), "+v"(A[O + 8]), "+v"(A[O + 9]), "+v"(A[O + 10]), "+v"(A[O + 11]), "+v"(A[O + 12]), "+v"(A[O + 13]), "+v"(A[O + 14]), "+v"(A[O + 15]))
#define PIN6(R) asm volatile("" : "+v"(R[0].x), "+v"(R[0].y), "+v"(R[1].x), "+v"(R[1].y), "+v"(R[2].x), "+v"(R[2].y))
__device__ __forceinline__ void phase_exp_down(const Args& a, int wave, int lane) {
  const int nblk_ = (NT / 128 - (int)blockIdx.x + (int)gridDim.x - 1) / (int)gridDim.x, ntok = nblk_ > 0 ? 16 * nblk_ : 0;
#define DOWN_TOK(i) ((((int)blockIdx.x + ((i) >> 4) * (int)gridDim.x) * 128) + wave * 16 + ((i) & 15))
  unsigned char* ws = a.ws;
  const int* eidx = (const int*)(ws + WS_EIDX); const float* gate = (const float*)(ws + WS_GATE); float* wout = (float*)(ws + WS_W);
  const unsigned char* exd = ws + WS_EXD; const float* esc = (const float*)(ws + WS_ESC);
  const int l32 = lane & 31, hi = lane >> 5;
  const bool b4 = (l32 & 16) != 0, b3 = (l32 & 8) != 0, b2 = (l32 & 4) != 0;
  const bf16_t* hb = (const bf16_t*)(ws + WS_HB); const float* ss2 = (const float*)(ws + WS_SS2);
  int ne0 = 0, ne1 = 0; float ng0 = 0.f, ng1 = 0.f, nss = 0.f; u32x4 nh[4];
  if (ntok > 0) { const size_t tf = (size_t)DOWN_TOK(0); ne0 = eidx[tf * 128 + lane]; ne1 = eidx[tf * 128 + 64 + lane]; ng0 = gate[tf * 128 + lane]; ng1 = gate[tf * 128 + 64 + lane]; nss = ss2[tf];
    const u32x4* hp = (const u32x4*)(hb + tf * DM + 32 * l32);
#pragma unroll
    for (int k = 0; k < 4; ++k) nh[k] = hp[k]; }
  for (int ti = 0; ti < ntok; ++ti) {
    const int t = DOWN_TOK(ti);
    const int e0 = ne0, e1 = ne1;
    const float sd0 = esc[e0], sd1 = esc[e1];
    const float gu0 = ng0 * esc[NEXP + e0], gu1 = ng1 * esc[NEXP + e1];
    float hg[32];
    unpack8(nh[0], hg); unpack8(nh[1], hg + 8); unpack8(nh[2], hg + 16); unpack8(nh[3], hg + 24);
    const float rstd = rsqrtf(nss * (1.f / DM) + EPS);
    if (ti + 1 < ntok) { const size_t tn = (size_t)DOWN_TOK(ti + 1); ne0 = eidx[tn * 128 + lane]; ne1 = eidx[tn * 128 + 64 + lane]; ng0 = gate[tn * 128 + lane]; ng1 = gate[tn * 128 + 64 + lane]; nss = ss2[tn];
      const u32x4* hp = (const u32x4*)(hb + tn * DM + 32 * l32);
#pragma unroll
      for (int k = 0; k < 4; ++k) nh[k] = hp[k]; }
#pragma unroll
    for (int k = 0; k < 8; ++k) { const f32x4 g = ((const f32x4*)a.in[15])[8 * l32 + k]; hg[4 * k] *= rstd * g.x; hg[4 * k + 1] *= rstd * g.y; hg[4 * k + 2] *= rstd * g.z; hg[4 * k + 3] *= rstd * g.w; }
    float w0 = 0.f, w1 = 0.f;
    for (int e = 0; e < 128; e += 16) {
      u32x2 ur[8][3];
#pragma unroll
      for (int i = 0; i < 8; ++i) {
        const int pi = (e & 63) + 2 * i + hi; const int id = (e < 64) ? __shfl(e0, pi) : __shfl(e1, pi);
        const u32x2* up = (const u32x2*)(exd + (size_t)id * 768 + 24 * l32);
        ur[i][0] = up[0]; ur[i][1] = up[1]; ur[i][2] = up[2];
      }
      float d[8];
#pragma unroll
      for (int i = 0; i < 8; ++i) {
        const v32f u = __builtin_amdgcn_cvt_scalef32_pk32_f32_fp6((v6u){ur[i][0].x, ur[i][0].y, ur[i][1].x, ur[i][1].y, ur[i][2].x, ur[i][2].y}, 1.0f);
        f32x2 q2 = (f32x2){0.f, 0.f};
#pragma unroll
        for (int k = 0; k < 16; ++k) q2 = __builtin_elementwise_fma((f32x2){u[2 * k], u[2 * k + 1]}, (f32x2){hg[2 * k], hg[2 * k + 1]}, q2);
        d[i] = q2.x + q2.y;
        __builtin_amdgcn_sched_barrier(0);
      }
      float r[4];
#pragma unroll
      for (int j = 0; j < 4; ++j) r[j] = (b4 ? d[j + 4] : d[j]) + swz_xor<16>(b4 ? d[j] : d[j + 4]);
      const float q0 = (b3 ? r[2] : r[0]) + swz_xor<8>(b3 ? r[0] : r[2]);
      const float q1 = (b3 ? r[3] : r[1]) + swz_xor<8>(b3 ? r[1] : r[3]);
      float q = (b2 ? q1 : q0) + swz_xor<4>(b2 ? q0 : q1);
      q += swz_xor<2>(q); q += swz_xor<1>(q);
      const int pr = (e & 63) + 2 * (l32 >> 2) + hi;
      const float sd = (e < 64) ? __shfl(sd0, pr) : __shfl(sd1, pr);
      const float gu = (e < 64) ? __shfl(gu0, pr) : __shfl(gu1, pr);
      const float wl = gu * gelu_as(q * sd);
      const float wsrc = __shfl(wl, ((lane & 1) << 5) | (((lane - (e & 63)) >> 1 & 7) << 2));
      if (lane >= (e & 63) && lane < (e & 63) + 16) { if (e < 64) w0 = wsrc; else w1 = wsrc; }
    }
    wout[(size_t)t * 128 + lane] = w0; wout[(size_t)t * 128 + 64 + lane] = w1;
  }
#undef DOWN_TOK
}

__device__ __forceinline__ void exp_up_item(const Args& a, unsigned char* lds, int xs, int item, int wave, int lane, float* xout, float* ssout) {
  unsigned char* ws = a.ws;
  const int* eidx = (const int*)(ws + WS_EIDX); const float* wgt = (const float*)(ws + WS_W);
  const unsigned char* ups = ws + WS_EXU + (size_t)xs * (NEXP * 128);
  unsigned* L = (unsigned*)(lds + wave * 16640);
  const int g = lane >> 2, c = lane & 3, t0 = item * 128 + wave * 16;
  __builtin_amdgcn_wave_barrier();
#pragma unroll 4
  for (int tk = 0; tk < 16; ++tk) {
    const size_t o = (size_t)(t0 + tk) * 128;
    L[tk * 260 + lane] = (unsigned)eidx[o + lane]; L[tk * 260 + 64 + lane] = (unsigned)eidx[o + 64 + lane];
    L[tk * 260 + 128 + lane] = __float_as_uint(wgt[o + lane]); L[tk * 260 + 192 + lane] = __float_as_uint(wgt[o + 64 + lane]);
  }
  __builtin_amdgcn_wave_barrier();
  float acc[32];
#pragma unroll
  for (int i = 0; i < 32; ++i) acc[i] = 0.f;
  const unsigned* Lg = L + g * 260;
#pragma unroll 1
  for (int p = 0; p < 128; p += 8) {
    u32x2 vr[8][3];
#pragma unroll
    for (int u = 0; u < 8; ++u) {
      const u32x2* vp = (const u32x2*)(ups + (size_t)Lg[p + u] * 128 + 24 * c);
      vr[u][0] = vp[0]; vr[u][1] = vp[1]; vr[u][2] = vp[2];
    }
#pragma unroll
    for (int u = 0; u < 8; ++u) {
      const float w = __uint_as_float(Lg[128 + p + u]);
      PIN6(vr[u]);
      const v32f v = __builtin_amdgcn_cvt_scalef32_pk32_f32_fp6((v6u){vr[u][0].x, vr[u][0].y, vr[u][1].x, vr[u][1].y, vr[u][2].x, vr[u][2].y}, 1.0f);
#pragma unroll
      for (int k = 0; k < 32; ++k) acc[k] += w * v[k];
      PIN16(acc, 0); PIN16(acc, 16);
    }
  }
  const f32x4* xr = (const f32x4*)(a.out + (size_t)(t0 + g) * DM + xs * 128 + c * 32); f32x4* xw = (f32x4*)(xout + (size_t)(t0 + g) * DM + xs * 128 + c * 32);
  float s = 0.f;
#pragma unroll
  for (int k = 0; k < 8; ++k) { f32x4 x = xr[k]; x.x += acc[4 * k]; x.y += acc[4 * k + 1]; x.z += acc[4 * k + 2]; x.w += acc[4 * k + 3]; xw[k] = x; s += (x.x * x.x + x.y * x.y) + (x.z * x.z + x.w * x.w); }
  s += swz_xor<1>(s); s += swz_xor<2>(s);
  if (c == 0) atomicAdd(ssout + t0 + g, s);
}
__device__ __forceinline__ void phase_exp_up(const Args& a, unsigned char* lds, const XcdBarrier& bar, int tid, int wave, int lane, unsigned* ctr, float* xout, float* ssout);
struct UpBuf { u32x4 r[8][2]; };
__device__ __forceinline__ void up2_load(UpBuf& B, const unsigned char* ups, const unsigned* Lg, int ch, int c) {
  const unsigned char* base = ups + (size_t)(ch >> 4) * (NEXP * 128) + 32 * c; const int p = (ch & 15) * 8;
#pragma unroll
  for (int u = 0; u < 8; ++u) { const u32x4* vp = (const u32x4*)(base + (size_t)Lg[p + u] * 128); B.r[u][0] = vp[0]; B.r[u][1] = vp[1]; }
}
__device__ __forceinline__ void up2_math(UpBuf& B, const unsigned* Lg, int ch, f32x2 (&acc)[16]) {
  const int p = (ch & 15) * 8;
#pragma unroll
  for (int u = 0; u < 8; ++u) {
    const float w = __uint_as_float(Lg[128 + p + u]);
    const f32x2 w2 = (f32x2){w, w};
#pragma unroll
    for (int q = 0; q < 2; ++q)
#pragma unroll
      for (int k = 0; k < 4; ++k) {
        const auto lo = __builtin_amdgcn_cvt_pk_f32_fp8((int)B.r[u][q][k], false); const auto hi = __builtin_amdgcn_cvt_pk_f32_fp8((int)B.r[u][q][k], true);
        acc[8 * q + 2 * k] = __builtin_elementwise_fma((f32x2){lo[0], lo[1]}, w2, acc[8 * q + 2 * k]);
        acc[8 * q + 2 * k + 1] = __builtin_elementwise_fma((f32x2){hi[0], hi[1]}, w2, acc[8 * q + 2 * k + 1]);
      }
    if (u & 1) PIN16(acc, 0);
  }
}
__device__ __forceinline__ void up2_slice_end(const Args& a, int t, int xs, int c, f32x2 (&acc)[16], float& ssum) {
  f32x4* xr = (f32x4*)(a.out + (size_t)t * DM + xs * 128 + c * 32);
#pragma unroll
  for (int k = 0; k < 8; ++k) { f32x4 x = xr[k]; x.x += acc[2 * k].x; x.y += acc[2 * k].y; x.z += acc[2 * k + 1].x; x.w += acc[2 * k + 1].y; xr[k] = x; ssum += (x.x * x.x + x.y * x.y) + (x.z * x.z + x.w * x.w);
    acc[2 * k] = (f32x2){0.f, 0.f}; acc[2 * k + 1] = (f32x2){0.f, 0.f}; }
}
__device__ __forceinline__ void phase_exp_up2(const Args& a, unsigned char* lds, int wave, int lane) {
  unsigned char* ws = a.ws;
  const int* eidx = (const int*)(ws + WS_EIDX); const float* wgt = (const float*)(ws + WS_W);
  const unsigned char* ups = ws + WS_EXU;
  unsigned* L = (unsigned*)(lds + wave * 16640);
  const int g = lane >> 2, c = lane & 3;
  for (int blk = blockIdx.x; blk < NT / 128; blk += gridDim.x) {
    const int t0 = blk * 128 + wave * 16, t = t0 + g;
    unsigned* H = (unsigned*)(lds + 8 * 16640 + 1024) + wave * 256;
    __builtin_amdgcn_wave_barrier();
    for (int i = lane; i < 256; i += 64) H[i] = 0u;
    __builtin_amdgcn_wave_barrier();
#pragma unroll 4
    for (int tk = 0; tk < 16; ++tk) {
      const size_t o = (size_t)(t0 + tk) * 128;
      const unsigned ea = (unsigned)eidx[o + lane], eb = (unsigned)eidx[o + 64 + lane];
      const unsigned wa = __float_as_uint(wgt[o + lane]), wb = __float_as_uint(wgt[o + 64 + lane]);
      const unsigned ba = ea >> 10, bb = eb >> 10;
      const unsigned ra = atomicAdd(&H[tk * 16 + ba], 1u), rb = atomicAdd(&H[tk * 16 + bb], 1u);
      __builtin_amdgcn_wave_barrier();
      unsigned pa = ra, pb = rb;
#pragma unroll
      for (unsigned b = 0; b < 16; ++b) { const unsigned hb = H[tk * 16 + b]; pa += (b < ba) ? hb : 0u; pb += (b < bb) ? hb : 0u; }
      L[tk * 260 + pa] = ea; L[tk * 260 + 128 + pa] = wa; L[tk * 260 + pb] = eb; L[tk * 260 + 128 + pb] = wb;
    }
    __builtin_amdgcn_wave_barrier();
    const unsigned* Lg = L + g * 260;
    f32x2 acc[16]; float ssum = 0.f;
#pragma unroll
    for (int i = 0; i < 16; ++i) acc[i] = (f32x2){0.f, 0.f};
    UpBuf A, B;
    up2_load(A, ups, Lg, 0, c);
#pragma unroll 1
    for (int ch = 0; ch < 128; ch += 2) {
      up2_load(B, ups, Lg, ch + 1, c);
      up2_math(A, Lg, ch, acc);
      if (ch + 2 < 128) up2_load(A, ups, Lg, ch + 2, c);
      up2_math(B, Lg, ch + 1, acc);
      if ((ch & 15) == 14) up2_slice_end(a, t, ch >> 4, c, acc, ssum);
    }
    ssum += swz_xor<1>(ssum); ssum += swz_xor<2>(ssum);
    const float r2 = rsqrtf(ssum * (1.f / DM) + EPS);
    asm volatile("s_waitcnt vmcnt(0)" ::: "memory");
    __builtin_amdgcn_fence(__ATOMIC_ACQUIRE, "agent");
#pragma unroll 2
    for (int xs = 0; xs < 8; ++xs) {
      f32x4* xr = (f32x4*)(a.out + (size_t)t * DM + xs * 128 + c * 32); const f32x4* gp = (const f32x4*)(a.in[21] + xs * 128 + c * 32);
#pragma unroll
      for (int k = 0; k < 8; ++k) xr[k] = xr[k] * r2 * gp[k];
    }
  }
}

__device__ __forceinline__ void phase_final(const Args& a, int gw, int ngw, int lane) {
  const float* ss = (const float*)(a.ws + WS_SS3);
  for (int r = gw; r < NT; r += ngw) {
    const float r2 = rsqrtf(ss[r] * (1.f / DM) + EPS);
    f32x4* xr = (f32x4*)(a.out + (size_t)r * DM) + lane;
#pragma unroll
    for (int j = 0; j < 4; ++j) { const f32x4 g = ((const f32x4*)a.in[21])[64 * j + lane]; xr[64 * j] = xr[64 * j] * r2 * g; }
  }
}

namespace pg8 {
#define PG8_LAS __attribute__((address_space(3)))
typedef unsigned short bf16_t;
typedef short bf16x8 __attribute__((ext_vector_type(8)));
typedef float f32x4 __attribute__((ext_vector_type(4)));
typedef unsigned u32x4 __attribute__((ext_vector_type(4)));
constexpr int BM = 256, BK = 64, HALF = 128, HTB = HALF * BK * 2  , STAGE_BYTES = 8 * HTB, NXCD = 8, WGM = 8;

__host__ __device__ __forceinline__ int lds_byte(int r, int c) { const int st = (r >> 4) * 2 + (c >> 5), rr = r & 15, cc = c & 31, ob = rr * 64 + cc * 2; return st * 1024 + (ob ^ (((ob >> 9) & 1) << 5)); }
__host__ __device__ __forceinline__ void stage_rc(int b, int& R, int& C) { const int st = b / 1024, sb = b % 1024, swz = sb ^ (((sb >> 9) & 1) << 5); R = (st >> 1) * 16 + swz / 64; C = (st & 1) * 32 + (swz % 64) / 2; }
__host__ __device__ __forceinline__ int perm32(int rho) { const int n = rho >> 4, i = rho & 15; return 8 * (i >> 2) + 4 * n + (i & 3); }

struct Unit { int pm, pn; };
struct Gemm { const bf16_t* A; const bf16_t* Bt; int M, N, K; };

struct StaticOrder {
    int nM, nN, nwg, G, c;
    __host__ __device__ void init(int M, int N, int G_, int c_) { nM = M / BM; nN = N / BM; nwg = nM * nN; G = G_; c = c_; }
    __host__ __device__ bool next(int i, Unit& u) const {
        const long L = (long)i * G + c; if (L >= nwg) return false;
        int wgid = (int)L; { const int q = nwg / NXCD, r = nwg % NXCD, xcd = wgid % NXCD, off = wgid / NXCD; wgid = (xcd < r ? xcd * (q + 1) : r * (q + 1) + (xcd - r) * q) + off; }
        const int nig = WGM * nN, gid = wgid / nig, fm = gid * WGM, gsz = (nM - fm) < WGM ? (nM - fm) : WGM;
        u.pm = fm + ((wgid % nig) % gsz); u.pn = (wgid % nig) / gsz; return true;
    }
    __device__ __forceinline__ void a_ready(const Unit&) const {}
    __device__ __forceinline__ void done(const Unit&) const {}
};

template <class St> struct EpiAdapt8 {
    static constexpr bool PERM = true, AFTER_DRAIN = false; St st;
    __device__ __forceinline__ void operator()(const f32x4 (&acc)[2][2][4][2], const Unit& u, int wr, int wc, int fr, int fq) const {
#pragma unroll
        for (int ai = 0; ai < 2; ++ai)
#pragma unroll
            for (int m = 0; m < 4; ++m)
#pragma unroll
                for (int bj = 0; bj < 2; ++bj) st.store8(u.pm * BM + ai * HALF + wr * 64 + m * 16 + fr, u.pn * BM + bj * HALF + wc * 32 + 8 * fq, acc[ai][bj][m][0], acc[ai][bj][m][1]);
    }
};
template <class St> struct EpiAdapt {
    static constexpr bool PERM = false, AFTER_DRAIN = false; St st;
    __device__ __forceinline__ void operator()(const f32x4 (&acc)[2][2][4][2], const Unit& u, int wr, int wc, int fr, int fq) const {
#pragma unroll
        for (int ai = 0; ai < 2; ++ai)
#pragma unroll
            for (int m = 0; m < 4; ++m)
#pragma unroll
                for (int bj = 0; bj < 2; ++bj)
#pragma unroll
                    for (int n = 0; n < 2; ++n) st.store(u.pm * BM + ai * HALF + wr * 64 + m * 16 + fr, u.pn * BM + bj * HALF + wc * 32 + n * 16 + 4 * fq, acc[ai][bj][m][n]);
    }
};

struct EpiResidSS {
    static constexpr bool PERM = true, AFTER_DRAIN = false; const float* base; float* out; bf16_t* hb; float* ss;
    __device__ __forceinline__ void operator()(const f32x4 (&acc)[2][2][4][2], const Unit& u, int wr, int wc, int fr, int fq) const {
#pragma unroll
        for (int ai = 0; ai < 2; ++ai)
#pragma unroll
            for (int m = 0; m < 4; ++m) {
                const int row = u.pm * BM + ai * HALF + wr * 64 + m * 16 + fr; float s = 0.f;
#pragma unroll
                for (int bj = 0; bj < 2; ++bj) {
                    const size_t o = (size_t)row * 1024 + u.pn * BM + bj * HALF + wc * 32 + 8 * fq;
                    const f32x4 v0 = *(const f32x4*)(base + o) + acc[ai][bj][m][0], v1 = *(const f32x4*)(base + o + 4) + acc[ai][bj][m][1];
                    *(f32x4*)(out + o) = v0; *(f32x4*)(out + o + 4) = v1;
                    { const float f0 = v0.x, f1 = v0.y, f2 = v0.z, f3 = v0.w, f4 = v1.x, f5 = v1.y, f6 = v1.z, f7 = v1.w;
                      *(u32x4*)(hb + o) = (u32x4){::pk2(f0, f1), ::pk2(f2, f3), ::pk2(f4, f5), ::pk2(f6, f7)}; }
                    s += (v0.x * v0.x + v0.y * v0.y) + (v0.z * v0.z + v0.w * v0.w) + (v1.x * v1.x + v1.y * v1.y) + (v1.z * v1.z + v1.w * v1.w);
                }
                s += __shfl_xor(s, 16); s += __shfl_xor(s, 32);
                if (fq == 0) atomicAdd(ss + row, s);
            }
    }
};
template <class Epi, class Sched, bool ALIGN_EPI = false, bool SP2 = false>
__device__ __forceinline__ void gemm_phase(PG8_LAS unsigned char* lds, const Gemm g, const Sched& S, const Epi& E) {
    const int tid = threadIdx.x, wid = __builtin_amdgcn_readfirstlane(tid >> 6), lane = tid & 63, wr = wid >> 2, wc = wid & 3, fr = lane & 15, fq = lane >> 4;
    const int K = g.K, nt = K / BK;
    unsigned voffA[2], voffB[2];
#pragma unroll
    for (int i = 0; i < 2; ++i) { int R, C; stage_rc(tid * 16 + i * 8192, R, C); const int Rb = Epi::PERM ? ((R & ~31) + perm32(R & 31)) : R;
        voffA[i] = (unsigned)(R * K + C) * 2u; voffB[i] = (unsigned)(Rb * K + C) * 2u; }
    const size_t kstep = (size_t)(BK * 2);
    const size_t hstep = (size_t)HALF * K * 2;
    const size_t tstep = 2 * hstep;
    const unsigned ldsw = (unsigned)wid * 1024u;
    const int aoff = lds_byte(wr * 64 + fr, fq * 8), boff = lds_byte(wc * 32 + fr, fq * 8);
#define PG8_SA(b, h) (((b) * 2 + (h)) * HTB)
#define PG8_SB(b, h) ((4 + (b) * 2 + (h)) * HTB)
#define PG8_STAGE(bufoff, gbase, voff) do { _Pragma("unroll") for (int _i = 0; _i < 2; ++_i) \
        __builtin_amdgcn_global_load_lds((const unsigned*)((const char*)(gbase) + (voff)[_i]), (PG8_LAS unsigned*)(lds + (bufoff) + ldsw + _i * 8192), 16, 0, 0); } while (0)
#define PG8_LDA(dst, b, h) do { _Pragma("unroll") for (int m = 0; m < 4; ++m) _Pragma("unroll") for (int k = 0; k < 2; ++k) dst[m][k] = *(const PG8_LAS bf16x8*)(lds + PG8_SA(b, h) + aoff + m * 2048 + k * 1024); } while (0)
#define PG8_LDB(dst, b, h) do { _Pragma("unroll") for (int n = 0; n < 2; ++n) _Pragma("unroll") for (int k = 0; k < 2; ++k) dst[n][k] = *(const PG8_LAS bf16x8*)(lds + PG8_SB(b, h) + boff + n * 2048 + k * 1024); } while (0)
#define PG8_MMA(ai, bj, At, Bt) do { __builtin_amdgcn_s_setprio(1); _Pragma("unroll") for (int m = 0; m < 4; ++m) _Pragma("unroll") for (int n = 0; n < 2; ++n) _Pragma("unroll") for (int k = 0; k < 2; ++k) \
        acc[ai][bj][m][n] = __builtin_amdgcn_mfma_f32_16x16x32_bf16(Bt[n][k], At[m][k], acc[ai][bj][m][n], 0, 0, 0); __builtin_amdgcn_s_setprio(0); } while (0)
#define PG8_WAIT_V(n) asm volatile("s_waitcnt vmcnt(" #n ")" ::: "memory")
#define PG8_WAIT_L(n) asm volatile("s_waitcnt lgkmcnt(" #n ")" ::: "memory")
#define PG8_BAR __builtin_amdgcn_s_barrier()
#define PG8_SCHED __builtin_amdgcn_sched_barrier(0)
    Unit cur, nxt; int ui = 0;
    if (!S.next(0, cur)) return;
    f32x4 acc[2][2][4][2];
#pragma unroll
    for (int a = 0; a < 2; ++a)
#pragma unroll
        for (int b = 0; b < 2; ++b)
#pragma unroll
            for (int m = 0; m < 4; ++m)
#pragma unroll
                for (int n = 0; n < 2; ++n) acc[a][b][m][n] = (f32x4){0.f, 0.f, 0.f, 0.f};
    bf16x8 At[4][2], B0[2][2], B1[2][2];
    const char* cA = (const char*)g.A + (size_t)cur.pm * tstep; const char* cB = (const char*)g.Bt + (size_t)cur.pn * tstep;
    S.a_ready(cur);
    if constexpr (SP2) {
        PG8_STAGE(PG8_SB(0, 0), cB, voffB); PG8_STAGE(PG8_SB(0, 1), cB + hstep, voffB); PG8_STAGE(PG8_SA(0, 0), cA, voffA); PG8_STAGE(PG8_SA(0, 1), cA + hstep, voffA);
        if (wr == 1) PG8_BAR;
        PG8_WAIT_V(2); PG8_BAR;
        PG8_STAGE(PG8_SB(1, 0), cB + kstep, voffB); PG8_STAGE(PG8_SA(1, 0), cA + kstep, voffA); PG8_STAGE(PG8_SB(1, 1), cB + hstep + kstep, voffB);
        PG8_WAIT_V(6); PG8_BAR;
    } else {
        PG8_STAGE(PG8_SB(0, 0), cB, voffB); PG8_STAGE(PG8_SA(0, 0), cA, voffA); PG8_STAGE(PG8_SB(0, 1), cB + hstep, voffB); PG8_STAGE(PG8_SA(0, 1), cA + hstep, voffA);
        if (wr == 1) PG8_BAR;
        PG8_WAIT_V(4); PG8_BAR;
        PG8_STAGE(PG8_SB(1, 0), cB + kstep, voffB); PG8_STAGE(PG8_SA(1, 0), cA + kstep, voffA); PG8_STAGE(PG8_SB(1, 1), cB + hstep + kstep, voffB);
        PG8_WAIT_V(6); PG8_BAR;
    }
    for (;;) {
        const bool has_next = S.next(ui + 1, nxt);
        const char* nA = has_next ? (const char*)g.A + (size_t)nxt.pm * tstep : cA; const char* nB = has_next ? (const char*)g.Bt + (size_t)nxt.pn * tstep : cB;
        for (int t = 0; t < nt; t += 2) {
            const bool last = (t == nt - 2);
            const char* a1 = cA + (size_t)(t + 1) * kstep;
            const char* a2 = last ? nA : cA + (size_t)(t + 2) * kstep; const char* b2 = last ? nB : cB + (size_t)(t + 2) * kstep;
            const char* a3 = a2 + kstep; const char* b3 = b2 + kstep;
            if (last && has_next) S.a_ready(nxt);
            if constexpr (SP2) {
            PG8_LDB(B0, 0, 0); PG8_LDB(B1, 0, 1); PG8_SCHED; PG8_LDA(At, 0, 0); PG8_STAGE(PG8_SA(1, 1), a1 + hstep, voffA);
            PG8_WAIT_V(8); PG8_WAIT_L(0); PG8_BAR; PG8_MMA(0, 0, At, B0); PG8_MMA(0, 1, At, B1); PG8_BAR; PG8_SCHED;
            PG8_LDA(At, 0, 1); PG8_STAGE(PG8_SB(0, 0), b2, voffB); PG8_STAGE(PG8_SB(0, 1), b2 + hstep, voffB); PG8_STAGE(PG8_SA(0, 0), a2, voffA);
            PG8_WAIT_V(8); PG8_WAIT_L(0); PG8_BAR; PG8_MMA(1, 0, At, B0); PG8_MMA(1, 1, At, B1); PG8_BAR; PG8_SCHED;
            PG8_LDB(B0, 1, 0); PG8_LDB(B1, 1, 1); PG8_SCHED; PG8_LDA(At, 1, 0); PG8_STAGE(PG8_SA(0, 1), a2 + hstep, voffA);
            PG8_WAIT_V(8); PG8_WAIT_L(0); PG8_BAR; PG8_MMA(0, 0, At, B0); PG8_MMA(0, 1, At, B1); PG8_BAR; PG8_SCHED;
            PG8_LDA(At, 1, 1); PG8_STAGE(PG8_SB(1, 0), b3, voffB); PG8_STAGE(PG8_SB(1, 1), b3 + hstep, voffB); PG8_STAGE(PG8_SA(1, 0), a3, voffA);
            PG8_WAIT_V(8); PG8_WAIT_L(0); PG8_BAR; PG8_MMA(1, 0, At, B0); PG8_MMA(1, 1, At, B1); PG8_BAR; PG8_SCHED;
            } else {
            PG8_LDB(B0, 0, 0); PG8_SCHED; PG8_LDA(At, 0, 0); PG8_STAGE(PG8_SA(1, 1), a1 + hstep, voffA);
            PG8_WAIT_L(8); PG8_BAR; PG8_WAIT_L(0); PG8_MMA(0, 0, At, B0); PG8_BAR; PG8_SCHED;
            PG8_LDB(B1, 0, 1); PG8_STAGE(PG8_SB(0, 0), b2, voffB);
            PG8_BAR; PG8_WAIT_L(0); PG8_MMA(0, 1, At, B1); PG8_BAR;
            PG8_LDA(At, 0, 1); PG8_STAGE(PG8_SA(0, 0), a2, voffA);
            PG8_BAR; PG8_WAIT_L(0); PG8_MMA(1, 0, At, B0); PG8_BAR; PG8_SCHED;
            PG8_STAGE(PG8_SB(0, 1), b2 + hstep, voffB);
            PG8_WAIT_V(6); PG8_BAR; PG8_MMA(1, 1, At, B1); PG8_BAR;
            PG8_LDB(B0, 1, 0); PG8_SCHED; PG8_LDA(At, 1, 0); PG8_STAGE(PG8_SA(0, 1), a2 + hstep, voffA);
            PG8_WAIT_L(8); PG8_BAR; PG8_WAIT_L(0); PG8_MMA(0, 0, At, B0); PG8_BAR; PG8_SCHED;
            PG8_LDB(B1, 1, 1); PG8_STAGE(PG8_SB(1, 0), b3, voffB);
            PG8_BAR; PG8_WAIT_L(0); PG8_MMA(0, 1, At, B1); PG8_BAR;
            PG8_LDA(At, 1, 1); PG8_STAGE(PG8_SA(1, 0), a3, voffA);
            PG8_BAR; PG8_WAIT_L(0); PG8_MMA(1, 0, At, B0); PG8_BAR; PG8_SCHED;
            PG8_STAGE(PG8_SB(1, 1), b3 + hstep, voffB);
            PG8_WAIT_V(6); PG8_BAR; PG8_MMA(1, 1, At, B1); PG8_BAR;
            }
        }
        if constexpr (ALIGN_EPI) { if (wr == 0) PG8_BAR; }
        if constexpr (!Epi::AFTER_DRAIN) { E(acc, cur, wr, wc, fr, fq); S.done(cur); }
        if (!has_next) break;
#pragma unroll
        for (int a = 0; a < 2; ++a)
#pragma unroll
            for (int b = 0; b < 2; ++b)
#pragma unroll
                for (int m = 0; m < 4; ++m)
#pragma unroll
                    for (int n = 0; n < 2; ++n) acc[a][b][m][n] = (f32x4){0.f, 0.f, 0.f, 0.f};
        cur = nxt; cA = nA; cB = nB; ++ui;
        if constexpr (ALIGN_EPI) { if (wr == 1) PG8_BAR; }
    }
    PG8_WAIT_V(0);
    if constexpr (!ALIGN_EPI) { if (wr == 0) PG8_BAR; }
    PG8_BAR;
    if constexpr (Epi::AFTER_DRAIN) { E.fused(acc, cur, wr, wc, fr, fq, lds, wid, lane); S.done(cur); }
#undef PG8_SA
#undef PG8_SB
#undef PG8_STAGE
#undef PG8_LDA
#undef PG8_LDB
#undef PG8_MMA
#undef PG8_WAIT_V
#undef PG8_WAIT_L
#undef PG8_BAR
#undef PG8_SCHED
}
}


template <class Epi>
__device__ __forceinline__ void run_gemm_raw(unsigned char* lds, const bf16_t* A, const bf16_t* Bt, int M, int N, int K, const Epi& E) {
  pg8::Gemm g{A, Bt, M, N, K}; pg8::StaticOrder S; S.init(M, N, (int)gridDim.x, (int)blockIdx.x);
  pg8::gemm_phase<Epi, pg8::StaticOrder, true, true>((PG8_LAS unsigned char*)lds, g, S, E);
}
template <class St>
__device__ __forceinline__ void run_gemm8(unsigned char* lds, const bf16_t* A, const bf16_t* Bt, int M, int N, int K, const St& st) {
  pg8::Gemm g{A, Bt, M, N, K}; pg8::StaticOrder S; S.init(M, N, (int)gridDim.x, (int)blockIdx.x);
  pg8::EpiAdapt8<St> E{st};
  pg8::gemm_phase<pg8::EpiAdapt8<St>, pg8::StaticOrder, true, true>((PG8_LAS unsigned char*)lds, g, S, E);
}
template <class St>
__device__ __forceinline__ void run_gemm(unsigned char* lds, const bf16_t* A, const bf16_t* Bt, int M, int N, int K, const St& st, int gw, int ngw, int lane) {
#if USE_PG8
  pg8::Gemm g{A, Bt, M, N, K}; pg8::StaticOrder S; S.init(M, N, (int)gridDim.x, (int)blockIdx.x);
  pg8::EpiAdapt<St> E{st};
  pg8::gemm_phase<pg8::EpiAdapt<St>, pg8::StaticOrder, true, true>((PG8_LAS unsigned char*)lds, g, S, E);
#else
  gemm_naive(A, K, Bt, K, M, N, K, st, gw, ngw, lane);
#endif
}

#define GAS __attribute__((address_space(1)))
#define LAS __attribute__((address_space(3)))
#define XB_TMO      128
#define XB_XCNT(j)  (256  + 64 * (j))
#define XB_XSUB(j)  (1280 + 64 * (j))
#define XB_XGEN(j)  (2304 + 64 * (j))
#define XB_TOP      3328
#define XB_TOPGEN   3392
#define XCD_BAR_WORDS 3456
#define XB_SPIN_CAP (1u << 18)

__device__ __forceinline__ unsigned xb_ld(unsigned* p)              { return __hip_atomic_load(p, __ATOMIC_RELAXED, __HIP_MEMORY_SCOPE_AGENT); }
__device__ __forceinline__ unsigned xb_add(unsigned* p, unsigned v) { return __hip_atomic_fetch_add(p, v, __ATOMIC_RELAXED, __HIP_MEMORY_SCOPE_AGENT); }
__device__ __forceinline__ unsigned xb_xcc_id() { return (unsigned)__builtin_amdgcn_s_getreg((3 << 11) | 20) & 0xFu; }
#define XB_SPIN(cond, bar) do { unsigned _sp = 0; while (cond) { __builtin_amdgcn_s_sleep(1); \
    if ((++_sp & 255u) == 0u) { if (xb_ld(&(bar)[XB_TMO])) break; if (_sp > XB_SPIN_CAP) { atomicAdd(&(bar)[XB_TMO], 1u); break; } } } } while (0)

struct XcdBarrier {
    unsigned* bar; unsigned x;
    volatile LAS unsigned* st;
};

__device__ __forceinline__ XcdBarrier xcd_barrier_post(unsigned* bar, volatile LAS unsigned* st) {
    XcdBarrier b; b.bar = bar; b.x = xb_xcc_id(); b.st = st;
    if (threadIdx.x == 0) (void)xb_add(&bar[XB_XCNT(b.x)], 1u);
    return b;
}
__device__ __forceinline__ void xcd_barrier_complete(unsigned* bar, unsigned x, unsigned& nloc, unsigned& nx) {
    const unsigned G = gridDim.x * gridDim.y * gridDim.z;
    unsigned sum, cnt, mine, sp = 0u;
    for (;;) {
        sum = 0u; cnt = 0u; mine = 0u;
#pragma unroll
        for (unsigned j = 0; j < 16; ++j) { const unsigned c = xb_ld(&bar[XB_XCNT(j)]); sum += c; cnt += (c > 0u) ? 1u : 0u; mine = (j == x) ? c : mine; }
        if (sum == G) break;
        __builtin_amdgcn_s_sleep(1);
        if ((++sp & 255u) == 0u) { if (xb_ld(&bar[XB_TMO])) break; if (sp > XB_SPIN_CAP) { atomicAdd(&bar[XB_TMO], 1u); break; } }
    }
    nloc = mine > 0u ? mine : 1u; nx = cnt > 0u ? cnt : 1u;
}

__device__ __forceinline__ void xcd_barrier(const XcdBarrier& b) {
    asm volatile("s_waitcnt vmcnt(0)" ::: "memory");
    __syncthreads();
    if (threadIdx.x == 0) {
        unsigned* bar = b.bar;
        __builtin_amdgcn_s_waitcnt(0);
        unsigned nloc = b.st[0], nx = b.st[1];
        if (nloc == 0u) { xcd_barrier_complete(bar, b.x, nloc, nx); b.st[0] = nloc; b.st[1] = nx; }
        const unsigned old = xb_add(&bar[XB_XSUB(b.x)], 1u);
        const unsigned gen = old / nloc;
        if (old + 1u == (gen + 1u) * nloc) {
            __builtin_amdgcn_fence(__ATOMIC_RELEASE, "agent");
            asm volatile("s_waitcnt vmcnt(0)" ::: "memory");
            const unsigned og = xb_add(&bar[XB_TOP], 1u);
            const unsigned tg = og / nx;
            if (og + 1u == (tg + 1u) * nx) xb_add(&bar[XB_TOPGEN], 1u);
            else XB_SPIN(xb_ld(&bar[XB_TOPGEN]) == tg, bar);
            __builtin_amdgcn_fence(__ATOMIC_ACQUIRE, "agent");
            xb_add(&bar[XB_XGEN(b.x)], 1u);
            asm volatile("s_waitcnt vmcnt(0)" ::: "memory");
        } else {
            XB_SPIN(xb_ld(&bar[XB_XGEN(b.x)]) == gen, bar);
            __builtin_amdgcn_fence(__ATOMIC_ACQUIRE, "agent");
            asm volatile("s_waitcnt vmcnt(0)" ::: "memory");
        }
    }
    __syncthreads();
}

__device__ __forceinline__ void phase_exp_up(const Args& a, unsigned char* lds, const XcdBarrier& bar, int tid, int wave, int lane, unsigned* ctr, float* xout, float* ssout) {
  unsigned* slot = (unsigned*)(lds + 8 * 16640);
  const int x0 = (int)(xb_xcc_id() & 7u);
  for (int k = 0; k < 8; ++k) {
    const int xs = (x0 + k) & 7;
    for (;;) {
      __syncthreads();
      if (tid == 0) slot[0] = atomicAdd(ctr + 16 * xs, 1u);
      __syncthreads();
      const unsigned item = slot[0];
      if (item >= (unsigned)(NT / 128)) break;
      exp_up_item(a, lds, xs, (int)item, wave, lane, xout, ssout);
    }
  }
}

__global__ void __launch_bounds__(512, 2) mega(Args a) {
  extern __shared__ __attribute__((aligned(16))) unsigned char lds[];
  cg::grid_group grid = cg::this_grid();
  const int tid = threadIdx.x, lane = tid & 63, wave = tid >> 6;
  const int gw = blockIdx.x * 8 + wave, ngw = gridDim.x * 8;
  unsigned char* ws = a.ws;
  const int lo = a.ph_lo, hi = a.ph_hi;
#define IN(k) (lo <= (k) && (k) < hi)
  volatile LAS unsigned* MISC = (volatile LAS unsigned*)((LAS unsigned char*)lds + 146944);
  if (tid < 32) MISC[tid] = 0u;
  __syncthreads();
  XcdBarrier bar; bar.bar = (unsigned*)(ws + WS_BAR); bar.x = 0; bar.st = nullptr;
  if (hi - lo > 1) bar = xcd_barrier_post((unsigned*)(ws + WS_BAR), MISC + 8);
  if (lo < -1000000) grid.sync();
#define SEAM(k) do { if (IN(k) && IN((k) + 1)) xcd_barrier(bar); } while (0)
#if PROBE_REP == 0
  if (IN(0)) { phase_prep(a, lds, gw, ngw, wave, lane, tid); grid.sync(); }
#endif
  if (IN(0)) { phase_prep(a, lds, gw, ngw, wave, lane, tid); } SEAM(0);
#if PROBE_REP == 1
  if (IN(1)) {
    run_gemm8(lds, (const bf16_t*)(ws + WS_HB), (const bf16_t*)(ws + WS_WIN_T), NT, NQKV, DM, EpiQKV{(bf16_t*)(ws + WS_QKV)});
    run_gemm8(lds, (const bf16_t*)(ws + WS_MEMN), (const bf16_t*)(ws + WS_WXKV_T), NMROWS, 2048, DM, EpiBf16{(bf16_t*)(ws + WS_KX), 2048});
    xcd_barrier(bar); }
#endif
#if PROBE_REP == 2
  if (IN(2)) { phase_scan(a, gw, ngw, lane, tid); xcd_barrier(bar); phase_rms(a, gw, ngw, lane); xcd_barrier(bar); phase_rms(a, gw, ngw, lane); xcd_barrier(bar); }
#endif
  if (IN(1)) {
    run_gemm8(lds, (const bf16_t*)(ws + WS_HB), (const bf16_t*)(ws + WS_WIN_T), NT, NQKV, DM, EpiQKV{(bf16_t*)(ws + WS_QKV)});
    run_gemm8(lds, (const bf16_t*)(ws + WS_MEMN), (const bf16_t*)(ws + WS_WXKV_T), NMROWS, 2048, DM, EpiBf16{(bf16_t*)(ws + WS_KX), 2048});
  } SEAM(1);
  if (IN(2)) { for (int rep = 0; rep < a.rep_scan; ++rep) { phase_scan(a, gw, ngw, lane, tid); if (rep + 1 < a.rep_scan) xcd_barrier(bar); } } SEAM(2);
#if PROBE_REP == 3
  if (IN(3)) { phase_attn2(a, lds, tid); xcd_barrier(bar); if (blockIdx.x == 0 && tid == 0) *(unsigned*)(ws) = 0u; xcd_barrier(bar); }
#endif
  if (IN(3)) {
#if USE_ATT2
    phase_attn2(a, lds, tid);
#else
    phase_attn(a, lds, tid);
#endif
  } SEAM(3);
  if (IN(4)) { phase_onorm(a, gw, ngw, lane); } SEAM(4);
  if (IN(5)) { run_gemm_raw(lds, (const bf16_t*)(ws + WS_OAB), (const bf16_t*)(ws + WS_WOUT_T), NT, DM, DM, pg8::EpiResidSS{a.in[0], a.out, (bf16_t*)(ws + WS_HB), (float*)(ws + WS_SS1)}); }
  if (IN(5) && IN(7)) xcd_barrier(bar);
  if (IN(7)) { run_gemm8(lds, (const bf16_t*)(ws + WS_HB), (const bf16_t*)(ws + WS_WXQ_T), NT, DM, DM, EpiBf16S{(bf16_t*)(ws + WS_QX), DM, (const float*)(ws + WS_SS1)}); } SEAM(7);
#if PROBE_REP == 8
  if (IN(8)) { phase_xattn(a, lds, gw, ngw, wave, lane); grid.sync(); }
#endif
  if (IN(8)) { phase_xattn2(a, lds, tid); } SEAM(8);
  if (IN(9)) { run_gemm_raw(lds, (const bf16_t*)(ws + WS_OX), (const bf16_t*)(ws + WS_WXO_T), NT, DM, DM, pg8::EpiResidSS{a.out, a.out, (bf16_t*)(ws + WS_HB), (float*)(ws + WS_SS2)}); }
  if (IN(9) && IN(11)) xcd_barrier(bar);
  if (IN(11)) { run_gemm8(lds, (const bf16_t*)(ws + WS_HB), (const bf16_t*)(ws + WS_WPQ_T), NT, DM, DM, EpiBf16S{(bf16_t*)(ws + WS_PQ), DM, (const float*)(ws + WS_SS2)}); } SEAM(11);
#if PROBE_REP == 12
  if (IN(12)) { phase_topk(a, lds, tid); grid.sync(); }
#endif
  if (IN(12)) { phase_topk2(a, lds, wave, lane); } SEAM(12);
    if (IN(13)) {
    for (int rep = 0; rep < a.rep_down; ++rep) phase_exp_down(a, wave, lane);
    asm volatile("s_waitcnt vmcnt(0)" ::: "memory"); __builtin_amdgcn_fence(__ATOMIC_ACQUIRE, "agent");
    phase_exp_up2(a, lds, wave, lane);
  }
#undef IN
#undef SEAM
}

extern "C" void kernel_launch(void* const* d_in, const int* in_sizes, int n_in, void* d_out, int out_size, void* d_ws, size_t ws_size, hipStream_t stream) {
  static int grid = 0;
  if (grid == 0) {
    if (n_in != 22 || out_size != NT * DM || ws_size < WS_END) { fprintf(stderr, "kernel_launch: unexpected shapes (n_in %d out %d ws %zu)\n", n_in, out_size, ws_size); grid = -1; return; }
    int dev = 0, cus = 0, per_cu = 0;
    (void)hipGetDevice(&dev);
    (void)hipDeviceGetAttribute(&cus, hipDeviceAttributeMultiprocessorCount, dev);
    (void)hipFuncSetAttribute((const void*)mega, hipFuncAttributeMaxDynamicSharedMemorySize, LDS_BYTES);
    (void)hipOccupancyMaxActiveBlocksPerMultiprocessor(&per_cu, (const void*)mega, 512, LDS_BYTES);
    if (per_cu < 1) per_cu = 1;
    grid = cus * per_cu;
  }
  if (grid < 0) return;
  (void)hipMemsetAsync(d_ws, 0, CTL_ZERO_BYTES, stream);
  Args a{};
  for (int i = 0; i < 22; ++i) a.in[i] = (const float*)d_in[i];
  a.out = (float*)d_out; a.ws = (unsigned char*)d_ws;
  a.rep_down = REP_DOWN; a.rep_up = REP_UP; a.rep_scan = REP_SCAN;
#if MK_N_LAUNCHES == 1
  a.ph_lo = 0; a.ph_hi = NPHASE + 1;
  void* args[] = {&a};
  hipError_t e = hipLaunchCooperativeKernel((const void*)mega, dim3(grid), dim3(512), args, LDS_BYTES, stream);
  if (e != hipSuccess) fprintf(stderr, "cooperative launch failed: %s (grid %d)\n", hipGetErrorString(e), grid);
#else
  for (int p = 0; p <= NPHASE; ++p) { a.ph_lo = p; a.ph_hi = p + 1; hipLaunchKernelGGL(mega, dim3(grid), dim3(512), LDS_BYTES, stream, a); }
#endif
}
```

```cpp
#include <hip/hip_runtime.h>
#include <hip/hip_cooperative_groups.h>
#include <cstdio>
#include <cstdint>
namespace cg = cooperative_groups;

#ifndef USE_PG8
#define USE_PG8 1
#endif
#ifndef USE_ATT2
#define USE_ATT2 1
#endif
#ifndef PROBE_REP
#define PROBE_REP -1
#endif
#ifndef REP_DOWN
#define REP_DOWN 1
#endif
#ifndef REP_UP
#define REP_UP 1
#endif
#ifndef REP_SCAN
#define REP_SCAN 1
#endif
#ifndef MK_N_LAUNCHES
#define MK_N_LAUNCHES 1
#endif

typedef unsigned short bf16_t;
typedef short bf16x8 __attribute__((ext_vector_type(8)));
typedef float f32x4 __attribute__((ext_vector_type(4)));
typedef unsigned u32x4 __attribute__((ext_vector_type(4)));
typedef unsigned u32x2 __attribute__((ext_vector_type(2)));
typedef float v32f __attribute__((ext_vector_type(32)));
typedef float v16f __attribute__((ext_vector_type(16)));
typedef unsigned v6u __attribute__((ext_vector_type(6)));
typedef float f32x2 __attribute__((ext_vector_type(2)));

constexpr int NB = 8, SEQ = 4096, DM = 1024, NT = NB * SEQ;
constexpr int NQKV = 3072, INW = 3080;
constexpr int NMEM = 256, NMROWS = NB * NMEM;
constexpr int NEXP = 16384;
constexpr float EPS = 1e-6f;
constexpr int NPHASE = 13;
constexpr int LDS_BYTES = 147456;

constexpr size_t MiB = 1u << 20;
constexpr size_t WS_BAR = 65536;
constexpr size_t WS_SS1 = 131072;
constexpr size_t WS_SS2 = 262144;
constexpr size_t WS_SS3 = 393216;
constexpr size_t WS_XCTR = 512;
constexpr size_t CTL_ZERO_BYTES = 524288;
constexpr size_t WS_WIN_T = 2 * MiB;
constexpr size_t WS_WOUT_T = 8 * MiB;
constexpr size_t WS_WXQ_T = 10 * MiB;
constexpr size_t WS_WXKV_T = 12 * MiB;
constexpr size_t WS_WXO_T = 16 * MiB;
constexpr size_t WS_WPQ_T = 18 * MiB;
constexpr size_t WS_SK = 21 * MiB;
constexpr size_t WS_MEMN = 22 * MiB;
constexpr size_t WS_KX = 26 * MiB;
constexpr size_t WS_VXT = 30 * MiB;
constexpr size_t WS_FLOG = 34 * MiB;
constexpr size_t WS_CUM = 35 * MiB;
constexpr size_t WS_KMEAN = 36 * MiB;
constexpr size_t WS_ESC = 38 * MiB;
constexpr size_t WS_EXD = 40 * MiB;
constexpr size_t WS_EXU = 72 * MiB;
constexpr size_t WS_HB = 104 * MiB;
constexpr size_t WS_QKV = 168 * MiB;
constexpr size_t WS_OAB = 360 * MiB;
constexpr size_t WS_QX = 168 * MiB;
constexpr size_t WS_OX = 232 * MiB;
constexpr size_t WS_PQ = 232 * MiB;
constexpr size_t WS_EIDX = 424 * MiB;
constexpr size_t WS_GATE = 440 * MiB;
constexpr size_t WS_W = 456 * MiB;
constexpr size_t WS_END = 472 * MiB;

struct Args {
  const float* in[22];
  float* out;
  unsigned char* ws;
  int ph_lo, ph_hi;
  int rep_down, rep_up, rep_scan, pad_;
};

struct XcdBarrier;
__device__ __forceinline__ unsigned f2bf(float f) { unsigned u = __float_as_uint(f); return (u + 0x7fffu + ((u >> 16) & 1u)) >> 16; }
__device__ __forceinline__ unsigned pk2(float lo, float hi) { return f2bf(lo) | (f2bf(hi) << 16); }
__device__ __forceinline__ float bf2f(unsigned short b) { return __uint_as_float(((unsigned)b) << 16); }
__device__ __forceinline__ float bflo(unsigned w) { return __uint_as_float(w << 16); }
__device__ __forceinline__ float bfhi(unsigned w) { return __uint_as_float(w & 0xffff0000u); }
__device__ __forceinline__ float wave_sum(float v) {
#pragma unroll
  for (int o = 1; o < 64; o <<= 1) v += __shfl_xor(v, o);
  return v;
}
template <int O> __device__ __forceinline__ float swz_xor(float v) { return __int_as_float(__builtin_amdgcn_ds_swizzle(__float_as_int(v), (O << 10) | 0x1f)); }
__device__ __forceinline__ float half_sum32(float v) { v += swz_xor<1>(v); v += swz_xor<2>(v); v += swz_xor<4>(v); v += swz_xor<8>(v); v += swz_xor<16>(v); return v; }
__device__ __forceinline__ void unpack8(const u32x4 w, float* f) {
  f[0] = bflo(w.x); f[1] = bfhi(w.x); f[2] = bflo(w.y); f[3] = bfhi(w.y);
  f[4] = bflo(w.z); f[5] = bfhi(w.z); f[6] = bflo(w.w); f[7] = bfhi(w.w);
}

__device__ const unsigned char T5_BUCKET[128] = {
  0, 1, 2, 3, 4, 5, 6, 7, 8, 9, 10, 11, 12, 13, 14, 15, 16, 16, 16, 17, 17, 18, 18, 18, 19, 19, 19, 20, 20, 20, 20, 21,
  21, 21, 21, 22, 22, 22, 22, 22, 23, 23, 23, 23, 23, 23, 24, 24, 24, 24, 24, 24, 25, 25, 25, 25, 25, 25, 25, 26, 26, 26, 26, 26,
  26, 26, 26, 27, 27, 27, 27, 27, 27, 27, 27, 27, 27, 28, 28, 28, 28, 28, 28, 28, 28, 28, 28, 29, 29, 29, 29, 29, 29, 29, 29, 29,
  29, 29, 29, 30, 30, 30, 30, 30, 30, 30, 30, 30, 30, 30, 30, 30, 30, 31, 31, 31, 31, 31, 31, 31, 31, 31, 31, 31, 31, 31, 31, 31};

__device__ __forceinline__ void transpose_item(const float* W, int ldw, const float* gain, bf16_t* WT, int K, int row_off, float* scr, int kb, int nb, int lane) {
  const int k0 = 64 * kb, n0 = 32 * nb;
#pragma unroll 8
  for (int i = 0; i < 32; ++i) {
    const int kk = 2 * i + (lane >> 5);
    const float g = gain ? gain[k0 + kk] : 1.f;
    scr[kk * 33 + (lane & 31)] = W[(size_t)(k0 + kk) * ldw + n0 + (lane & 31)] * g;
  }
  __builtin_amdgcn_wave_barrier();
  const int c = lane & 7;
#pragma unroll
  for (int j = 0; j < 4; ++j) {
    const int n = (lane >> 3) + 8 * j; const float* s = scr + (8 * c) * 33 + n;
    u32x4 o; o.x = pk2(s[0 * 33], s[1 * 33]); o.y = pk2(s[2 * 33], s[3 * 33]); o.z = pk2(s[4 * 33], s[5 * 33]); o.w = pk2(s[6 * 33], s[7 * 33]);
    *(u32x4*)(WT + (size_t)(row_off + n0 + n) * K + k0 + 8 * c) = o;
  }
  __builtin_amdgcn_wave_barrier();
}

__device__ __forceinline__ void rms_row_to_bf16(const float* xrow, bf16_t* orow, int lane) {
  const f32x4* xr = (const f32x4*)xrow + lane;
  f32x4 v[4]; float s = 0.f;
#pragma unroll
  for (int j = 0; j < 4; ++j) { v[j] = xr[64 * j]; s += (v[j].x * v[j].x + v[j].y * v[j].y) + (v[j].z * v[j].z + v[j].w * v[j].w); }
  const float rstd = rsqrtf(wave_sum(s) * (1.f / DM) + EPS);
  u32x2* o = (u32x2*)orow + lane;
#pragma unroll
  for (int j = 0; j < 4; ++j) { u32x2 w; w.x = pk2(v[j].x * rstd, v[j].y * rstd); w.y = pk2(v[j].z * rstd, v[j].w * rstd); o[64 * j] = w; }
}

__device__ __forceinline__ void phase_prep(const Args& a, unsigned char* lds, int gw, int ngw, int wave, int lane, int tid) {
  unsigned char* ws = a.ws;
  float* scr = (float*)(lds + wave * 8448);
  const int I_IN = 16 * 96, I_SQ = 16 * 32;
  const int NITEMS = I_IN + 6 * I_SQ;
  for (int it = gw; it < NITEMS; it += ngw) {
    int r = it;
    if (r < I_IN) { transpose_item(a.in[3], INW, a.in[2], (bf16_t*)(ws + WS_WIN_T), DM, 0, scr, r / 96, r % 96, lane); continue; } r -= I_IN;
    const int which = r / I_SQ; r %= I_SQ; const int kb = r / 32, nb = r % 32;
    if (which == 0) { const float* g = (kb < 8) ? a.in[6] : (a.in[7] - 512); transpose_item(a.in[8], DM, g, (bf16_t*)(ws + WS_WOUT_T), DM, 0, scr, kb, nb, lane); }
    else if (which == 1) transpose_item(a.in[11], DM, a.in[9], (bf16_t*)(ws + WS_WXQ_T), DM, 0, scr, kb, nb, lane);
    else if (which == 2) transpose_item(a.in[12], DM, a.in[10], (bf16_t*)(ws + WS_WXKV_T), DM, 0, scr, kb, nb, lane);
    else if (which == 3) transpose_item(a.in[13], DM, a.in[10], (bf16_t*)(ws + WS_WXKV_T), DM, 1024, scr, kb, nb, lane);
    else if (which == 4) transpose_item(a.in[14], DM, nullptr, (bf16_t*)(ws + WS_WXO_T), DM, 0, scr, kb, nb, lane);
    else transpose_item(a.in[16], DM, a.in[15], (bf16_t*)(ws + WS_WPQ_T), DM, 0, scr, kb, nb, lane);
  }
  for (int it = gw; it < NEXP; it += ngw) {
    const int hi = lane >> 5, l32 = lane & 31; const int r = 2 * it + hi;
    const int tb = r >= NEXP, e = r - tb * NEXP;
    const f32x4* src = (const f32x4*)(a.in[19 + tb] + (size_t)e * DM) + 8 * l32;
    v16f xa, xb; float am = 0.f;
#pragma unroll
    for (int k = 0; k < 4; ++k) { const f32x4 p = src[k], q = src[4 + k];
      xa[2 * k] = p.x; xb[2 * k] = p.y; xa[2 * k + 1] = p.z; xb[2 * k + 1] = p.w; xa[8 + 2 * k] = q.x; xb[8 + 2 * k] = q.y; xa[8 + 2 * k + 1] = q.z; xb[8 + 2 * k + 1] = q.w;
      am = fmaxf(am, fmaxf(fmaxf(fabsf(p.x), fabsf(p.y)), fmaxf(fabsf(p.z), fabsf(p.w)))); am = fmaxf(am, fmaxf(fmaxf(fabsf(q.x), fabsf(q.y)), fmaxf(fabsf(q.z), fabsf(q.w)))); }
#pragma unroll
    for (int o = 1; o < 32; o <<= 1) am = fmaxf(am, __shfl_xor(am, o));
    if (tb == 0) {
      const float sc = am > 0.f ? 7.0f / am : 1.f;
      xa = xa * sc; xb = xb * sc;
      const v6u w = __builtin_amdgcn_cvt_scalef32_2xpk16_fp6_f32(xa, xb, 1.0f);
      u32x2* dst = (u32x2*)(ws + WS_EXD + (size_t)e * 768 + 24 * l32);
      dst[0] = (u32x2){w[0], w[1]}; dst[1] = (u32x2){w[2], w[3]}; dst[2] = (u32x2){w[4], w[5]};
      if (l32 == 0) ((float*)(ws + WS_ESC))[r] = am > 0.f ? am / 7.0f : 1.f;
    } else {
      const float sc = am > 0.f ? 440.f / am : 1.f;
      u32x4 o0, o1;
#pragma unroll
      for (int k = 0; k < 4; ++k) { int w = __builtin_amdgcn_cvt_pk_fp8_f32(xa[2 * k] * sc, xb[2 * k] * sc, 0, false); w = __builtin_amdgcn_cvt_pk_fp8_f32(xa[2 * k + 1] * sc, xb[2 * k + 1] * sc, w, true); o0[k] = (unsigned)w; }
#pragma unroll
      for (int k = 0; k < 4; ++k) { int w = __builtin_amdgcn_cvt_pk_fp8_f32(xa[8 + 2 * k] * sc, xb[8 + 2 * k] * sc, 0, false); w = __builtin_amdgcn_cvt_pk_fp8_f32(xa[8 + 2 * k + 1] * sc, xb[8 + 2 * k + 1] * sc, w, true); o1[k] = (unsigned)w; }
      u32x4* dst = (u32x4*)(ws + WS_EXU + (size_t)(l32 >> 2) * (NEXP * 128) + (size_t)e * 128 + 32 * (l32 & 3));
      dst[0] = o0; dst[1] = o1;
      if (l32 == 0) ((float*)(ws + WS_ESC))[r] = am > 0.f ? am / 440.f : 1.f;
    }
  }
  for (int i = blockIdx.x * 512 + tid; i < 2 * 65536; i += gridDim.x * 512) ((bf16_t*)(ws + WS_SK))[i] = (bf16_t)f2bf(a.in[17 + (i >> 16)][i & 65535]);
  for (int r = gw; r < NMROWS; r += ngw) rms_row_to_bf16(a.in[1] + (size_t)r * DM, (bf16_t*)(ws + WS_MEMN) + (size_t)r * DM, lane);
  __syncthreads();
  float* wf = (float*)(lds + 69632);
  for (int k = tid; k < DM; k += 512) {
    const float g = a.in[2][k]; const f32x4* wp = (const f32x4*)(a.in[3] + (size_t)k * INW + NQKV);
    const f32x4 p = wp[0], q = wp[1];
    wf[k] = p.x * g; wf[1024 + k] = p.y * g; wf[2048 + k] = p.z * g; wf[3072 + k] = p.w * g; wf[4096 + k] = q.x * g; wf[5120 + k] = q.y * g; wf[6144 + k] = q.z * g; wf[7168 + k] = q.w * g;
  }
  __syncthreads();
  float* flog = (float*)(ws + WS_FLOG);
  for (int r = gw; r < NT; r += ngw) {
    const f32x4* xr = (const f32x4*)(a.in[0] + (size_t)r * DM) + lane;
    f32x4 v[4]; float s = 0.f; float fa[8];
#pragma unroll
    for (int j = 0; j < 8; ++j) fa[j] = 0.f;
#pragma unroll
    for (int j = 0; j < 4; ++j) {
      v[j] = xr[64 * j]; s += (v[j].x * v[j].x + v[j].y * v[j].y) + (v[j].z * v[j].z + v[j].w * v[j].w);
#pragma unroll
      for (int jj = 0; jj < 8; ++jj) { const f32x4 w4 = *(const f32x4*)(wf + jj * 1024 + 256 * j + 4 * lane); fa[jj] += (v[j].x * w4.x + v[j].y * w4.y) + (v[j].z * w4.z + v[j].w * w4.w); }
    }
    const float rstd = rsqrtf(wave_sum(s) * (1.f / DM) + EPS);
    float mine = 0.f;
#pragma unroll
    for (int j = 0; j < 8; ++j) { const float t = wave_sum(fa[j]); if (lane == j) mine = t; }
    if (lane < 8) {
      const float z = mine * rstd + a.in[4][lane];
      flog[(size_t)lane * NT + r] = fminf(z, 0.f) - log1pf(expf(-fabsf(z)));
    }
    u32x2* o = (u32x2*)((bf16_t*)(ws + WS_HB) + (size_t)r * DM) + lane;
#pragma unroll
    for (int j = 0; j < 4; ++j) { u32x2 w; w.x = pk2(v[j].x * rstd, v[j].y * rstd); w.y = pk2(v[j].z * rstd, v[j].w * rstd); o[64 * j] = w; }
  }
}

template <class Epi>
__device__ __forceinline__ void gemm_naive(const bf16_t* A, int lda, const bf16_t* Bt, int ldb, int M, int N, int K, const Epi& E, int gw, int ngw, int lane) {
  const int fr = lane & 15, fq = lane >> 4;
  const int tn = N / 64, ntile = (M / 64) * tn;
  for (int tile = gw; tile < ntile; tile += ngw) {
    const int pm = tile / tn, pn = tile % tn;
    f32x4 acc[4][4];
#pragma unroll
    for (int m = 0; m < 4; ++m)
#pragma unroll
      for (int n = 0; n < 4; ++n) acc[m][n] = (f32x4){0.f, 0.f, 0.f, 0.f};
    const bf16_t* Ap = A + (size_t)(pm * 64 + fr) * lda + fq * 8;
    const bf16_t* Bp = Bt + (size_t)(pn * 64 + fr) * ldb + fq * 8;
    for (int k0 = 0; k0 < K; k0 += 32) {
      bf16x8 af[4], bfr[4];
#pragma unroll
      for (int m = 0; m < 4; ++m) af[m] = *(const bf16x8*)(Ap + (size_t)m * 16 * lda + k0);
#pragma unroll
      for (int n = 0; n < 4; ++n) bfr[n] = *(const bf16x8*)(Bp + (size_t)n * 16 * ldb + k0);
#pragma unroll
      for (int m = 0; m < 4; ++m)
#pragma unroll
        for (int n = 0; n < 4; ++n) acc[m][n] = __builtin_amdgcn_mfma_f32_16x16x32_bf16(bfr[n], af[m], acc[m][n], 0, 0, 0);
    }
#pragma unroll
    for (int m = 0; m < 4; ++m)
#pragma unroll
      for (int n = 0; n < 4; ++n) E.store(pm * 64 + m * 16 + fr, pn * 64 + n * 16 + 4 * fq, acc[m][n]);
  }
}

struct EpiBf16 { bf16_t* O; int ldo;
  __device__ __forceinline__ void store8(int row, int col, f32x4 a, f32x4 b) const { u32x4 w; w.x = pk2(a.x, a.y); w.y = pk2(a.z, a.w); w.z = pk2(b.x, b.y); w.w = pk2(b.z, b.w); *(u32x4*)(O + (size_t)row * ldo + col) = w; }
  __device__ __forceinline__ void store(int row, int col, f32x4 v) const { u32x2 w; w.x = pk2(v.x, v.y); w.y = pk2(v.z, v.w); *(u32x2*)(O + (size_t)row * ldo + col) = w; } };
struct EpiQKV { bf16_t* O;
  __device__ __forceinline__ void store8(int row, int col, f32x4 a, f32x4 b) const { const float sc = (col < 512 || (col >= 1536 && col < 2048)) ? 0.18033688011112042f : 1.f;
    u32x4 w; w.x = pk2(a.x * sc, a.y * sc); w.y = pk2(a.z * sc, a.w * sc); w.z = pk2(b.x * sc, b.y * sc); w.w = pk2(b.z * sc, b.w * sc); *(u32x4*)(O + (size_t)row * NQKV + col) = w; }
  __device__ __forceinline__ void store(int row, int col, f32x4 v) const { const float sc = (col < 512 || (col >= 1536 && col < 2048)) ? 0.18033688011112042f : 1.f;
    u32x2 w; w.x = pk2(v.x * sc, v.y * sc); w.y = pk2(v.z * sc, v.w * sc); *(u32x2*)(O + (size_t)row * NQKV + col) = w; } };
struct EpiBf16S { bf16_t* O; int ldo; const float* ss;
  __device__ __forceinline__ void store8(int row, int col, f32x4 a, f32x4 b) const { const float r = rsqrtf(ss[row] * (1.f / DM) + EPS);
    u32x4 w; w.x = pk2(a.x * r, a.y * r); w.y = pk2(a.z * r, a.w * r); w.z = pk2(b.x * r, b.y * r); w.w = pk2(b.z * r, b.w * r); *(u32x4*)(O + (size_t)row * ldo + col) = w; }
  __device__ __forceinline__ void store(int row, int col, f32x4 v) const { const float r = rsqrtf(ss[row] * (1.f / DM) + EPS); u32x2 w; w.x = pk2(v.x * r, v.y * r); w.y = pk2(v.z * r, v.w * r); *(u32x2*)(O + (size_t)row * ldo + col) = w; } };
struct EpiF32S { float* O; int ldo; const float* ss;
  __device__ __forceinline__ void store(int row, int col, f32x4 v) const { const float r = rsqrtf(ss[row] * (1.f / DM) + EPS); *(f32x4*)(O + (size_t)row * ldo + col) = v * r; } };
struct EpiF32 { float* O; int ldo;
  __device__ __forceinline__ void store(int row, int col, f32x4 v) const { *(f32x4*)(O + (size_t)row * ldo + col) = v; } };
struct EpiResid { const float* base; float* out;
  __device__ __forceinline__ void store(int row, int col, f32x4 v) const { const size_t o = (size_t)row * DM + col; const f32x4 b = *(const f32x4*)(base + o); *(f32x4*)(out + o) = b + v; } };
struct EpiKV { bf16_t* KX; bf16_t* VXT;
  __device__ __forceinline__ void store(int row, int col, f32x4 v) const {
    if (col < 1024) { u32x2 w; w.x = pk2(v.x, v.y); w.y = pk2(v.z, v.w); *(u32x2*)(KX + (size_t)row * DM + col) = w; }
    else { const int b = row >> 8, m = row & 255;
#pragma unroll
      for (int r = 0; r < 4; ++r) { const int d = col - 1024 + r; VXT[((size_t)(b * 4 + (d >> 8)) * 256 + (d & 255)) * 256 + m] = (bf16_t)f2bf(v[r]); } } } };

__device__ __forceinline__ void phase_scan(const Args& a, int gw, int ngw, int lane, int tid) {
  unsigned char* ws = a.ws;
  const bf16_t* qkv = (const bf16_t*)(ws + WS_QKV);
  for (int item = gw; item < 64 + 1024 + 1024; item += ngw) {
    if (item < 64) {
      const int b = item >> 3, j = item & 7;
      const f32x4* src = (const f32x4*)((const float*)(ws + WS_FLOG) + (size_t)j * NT + (size_t)b * SEQ + lane * 64);
      f32x4 v[16];
#pragma unroll
      for (int i = 0; i < 16; ++i) v[i] = src[i];
      float tot = 0.f;
#pragma unroll
      for (int i = 0; i < 16; ++i) tot += (v[i].x + v[i].y) + (v[i].z + v[i].w);
      float inc = tot;
#pragma unroll
      for (int o = 1; o < 64; o <<= 1) { const float t = __shfl_up(inc, o); if (lane >= o) inc += t; }
      float run = inc - tot;
      f32x4* dst = (f32x4*)((float*)(ws + WS_CUM) + ((size_t)(b * 8 + j)) * SEQ + lane * 64);
#pragma unroll
      for (int i = 0; i < 16; ++i) { f32x4 o; run += v[i].x; o.x = run * 1.4426950408889634f; run += v[i].y; o.y = run * 1.4426950408889634f; run += v[i].z; o.z = run * 1.4426950408889634f; run += v[i].w; o.w = run * 1.4426950408889634f; dst[i] = o; }
    } else if (item < 64 + 1024) {
      const int it = item - 64, h = it & 7, blk = (it >> 3) & 15, b = it >> 7;
      const bf16_t* p = qkv + ((size_t)b * SEQ + blk * 256 + (lane >> 3)) * NQKV + 512 + h * 64 + (lane & 7) * 8;
      float s[8];
#pragma unroll
      for (int i = 0; i < 8; ++i) s[i] = 0.f;
#pragma unroll 8
      for (int rr = 0; rr < 32; ++rr) { float f[8]; unpack8(*(const u32x4*)(p + (size_t)rr * 8 * NQKV), f);
#pragma unroll
        for (int i = 0; i < 8; ++i) s[i] += f[i]; }
#pragma unroll
      for (int i = 0; i < 8; ++i) { s[i] += __shfl_xor(s[i], 8); s[i] += __shfl_xor(s[i], 16); s[i] += __shfl_xor(s[i], 32); }
      if (lane < 8) { f32x4* d = (f32x4*)((float*)(ws + WS_KMEAN) + ((size_t)(b * 16 + blk) * 8 + h) * 64 + lane * 8);
        d[0] = (f32x4){s[0], s[1], s[2], s[3]} * (1.f / 256.f); d[1] = (f32x4){s[4], s[5], s[6], s[7]} * (1.f / 256.f); }
    } else {
      const int it = item - 64 - 1024, bh = it >> 4, ch = it & 15, b = bh >> 3, h = bh & 7;
      const bf16_t* p = qkv + ((size_t)b * SEQ + ch * 256 + (lane >> 3)) * NQKV + 2048 + h * 64 + (lane & 7) * 8;
      float m = 0.f;
#pragma unroll 8
      for (int rr = 0; rr < 32; ++rr) { float f[8]; unpack8(*(const u32x4*)(p + (size_t)rr * 8 * NQKV), f);
        float s = 0.f;
#pragma unroll
        for (int i = 0; i < 8; ++i) s += f[i] * f[i];
        s += __shfl_xor(s, 1); s += __shfl_xor(s, 2); s += __shfl_xor(s, 4);
        m = fmaxf(m, s); }
#pragma unroll
      for (int o = 8; o < 64; o <<= 1) m = fmaxf(m, __shfl_xor(m, o));
      if (lane == 0) atomicMax((unsigned*)(ws + 256) + bh, __float_as_uint(m));
    }
  }
}

template <int MODE>
__device__ __forceinline__ void attn_naive_unit(const Args& a, unsigned char* lds, int b, int h, int sb, int tid) {
  unsigned char* ws = a.ws;
  const bf16_t* qkv = (const bf16_t*)(ws + WS_QKV);
  const int qoff = MODE ? 1536 : 0, koff = qoff + 512, voff = qoff + 1024;
  float* Ks = (float*)lds; float* Vs = Ks + 64 * 64; float* ck = Vs + 64 * 64; float* biasd = ck + 64;
  const int t = sb * 512 + tid; const size_t row = (size_t)b * SEQ + t;
  float q[64], o[64];
  {
    const u32x4* qp = (const u32x4*)(qkv + row * NQKV + qoff + h * 64);
#pragma unroll
    for (int c = 0; c < 8; ++c) { const u32x4 w = qp[c]; unpack8(w, q + 8 * c); }
#pragma unroll
    for (int d = 0; d < 64; ++d) { q[d] *= 0.6931471805599453f; o[d] = 0.f; }
  }
  float m = -1e30f, l = 0.f;
  unsigned selmask = 0u; const int own = t >> 8;
  float cq = 0.f, bfar = 0.f;
  __syncthreads();
  if (MODE == 0) {
    if (tid < 128) biasd[tid] = a.in[5][T5_BUCKET[tid] * 8 + h];
    bfar = a.in[5][31 * 8 + h];
    const float* km = (const float*)(ws + WS_KMEAN) + ((size_t)b * 16) * 512 + h * 64;
    float v0 = -3e38f, v1 = -3e38f, v2 = -3e38f; int i0 = -1, i1 = -1, i2 = -1;
    for (int n = 0; n < 2 * sb + 1; ++n) {
      if (n < own) {
        const float* kp = km + (size_t)n * 512; float s = 0.f;
#pragma unroll
        for (int d = 0; d < 64; ++d) s += q[d] * kp[d];
        if (s > v0) { v2 = v1; i2 = i1; v1 = v0; i1 = i0; v0 = s; i0 = n; }
        else if (s > v1) { v2 = v1; i2 = i1; v1 = s; i1 = n; }
        else if (s > v2) { v2 = s; i2 = n; }
      }
    }
    if (i0 >= 0) selmask |= 1u << i0;
    if (i1 >= 0) selmask |= 1u << i1;
    if (i2 >= 0) selmask |= 1u << i2;
  } else {
    cq = ((const float*)(ws + WS_CUM))[((size_t)(b * 8 + h)) * SEQ + t];
  }
  const int ntile = 8 * (sb + 1);
  for (int kt = 0; kt < ntile; ++kt) {
    __syncthreads();
    {
      const int r = tid >> 3, ch = tid & 7;
      const bf16_t* kp = qkv + ((size_t)b * SEQ + kt * 64 + r) * NQKV + h * 64 + ch * 8;
      const u32x4 kw = *(const u32x4*)(kp + koff), vw = *(const u32x4*)(kp + voff);
      unpack8(kw, Ks + r * 64 + ch * 8); unpack8(vw, Vs + r * 64 + ch * 8);
      if (MODE == 1 && tid < 64) ck[tid] = ((const float*)(ws + WS_CUM))[((size_t)(b * 8 + h)) * SEQ + kt * 64 + tid];
    }
    __syncthreads();
    const int kb = kt >> 2;
    bool act;
    if (MODE == 0) act = (kb == own) || (kb < own && ((selmask >> kb) & 1u));
    else act = (kt * 64 <= t);
    if (act) {
      for (int jj = 0; jj < 64; ++jj) {
        const int sp = kt * 64 + jj;
        if (sp > t) break;
        const f32x4* kr = (const f32x4*)(Ks + jj * 64);
        float s = 0.f;
#pragma unroll
        for (int c = 0; c < 16; ++c) { const f32x4 kv = kr[c]; s += q[4 * c] * kv.x + q[4 * c + 1] * kv.y + q[4 * c + 2] * kv.z + q[4 * c + 3] * kv.w; }
        if (MODE == 0) { const int dist = t - sp; s += (dist < 128) ? biasd[dist] : bfar; }
        else s += (cq - ck[jj]) * 0.6931471805599453f;
        if (s > m) { const float f = __expf(m - s); l *= f;
#pragma unroll
          for (int d = 0; d < 64; ++d) o[d] *= f;
          m = s; }
        const float p = __expf(s - m); l += p;
        const f32x4* vr = (const f32x4*)(Vs + jj * 64);
#pragma unroll
        for (int c = 0; c < 16; ++c) { const f32x4 vv = vr[c]; o[4 * c] += p * vv.x; o[4 * c + 1] += p * vv.y; o[4 * c + 2] += p * vv.z; o[4 * c + 3] += p * vv.w; }
      }
    }
  }
  const float il = 1.f / l;
  u32x4* op = (u32x4*)((bf16_t*)(ws + WS_OAB) + row * DM + (MODE ? 512 : 0) + h * 64);
#pragma unroll
  for (int c = 0; c < 8; ++c) { u32x4 w; w.x = pk2(o[8 * c] * il, o[8 * c + 1] * il); w.y = pk2(o[8 * c + 2] * il, o[8 * c + 3] * il); w.z = pk2(o[8 * c + 4] * il, o[8 * c + 5] * il); w.w = pk2(o[8 * c + 6] * il, o[8 * c + 7] * il); op[c] = w; }
}

__device__ __forceinline__ void phase_attn(const Args& a, unsigned char* lds, int tid) {
  for (int u = blockIdx.x; u < 1024; u += gridDim.x) {
    const int sb = 7 - (u >> 7), r = u & 127, mode = r & 1, bh = r >> 1;
    if (mode == 0) attn_naive_unit<0>(a, lds, bh >> 3, bh & 7, sb, tid);
    else attn_naive_unit<1>(a, lds, bh >> 3, bh & 7, sb, tid);
  }
}

namespace att {
typedef float f32x16 __attribute__((ext_vector_type(16)));
typedef short s16x4 __attribute__((ext_vector_type(4)));
typedef short v4i16_t __attribute__((ext_vector_type(4)));
typedef __attribute__((address_space(3))) const char* lds_cptr;
typedef float f32x2_t __attribute__((ext_vector_type(2))); typedef __bf16 bf16x2_t __attribute__((ext_vector_type(2)));
constexpr int PITCH = NQKV;
constexpr float LOG2E = 1.4426950408889634f;
constexpr float C2 = 0.125f * LOG2E;
constexpr int L_K = 0, L_V = 16384, L_WSF = 32768, L_OST = 34816, L_C2 = 67584, L_KM = 83968, L_BT = 88064, L_MISC = 88704;
__device__ __forceinline__ int crow(int r, int hi) { return (r & 3) + 8 * (r >> 2) + 4 * hi; }
__device__ __forceinline__ unsigned cvtpk(float lo, float hi) { f32x2_t v = {lo, hi}; bf16x2_t b = __builtin_convertvector(v, bf16x2_t); return __builtin_bit_cast(unsigned, b); }
__device__ __forceinline__ s16x4 vtr(lds_cptr p) { return __builtin_bit_cast(s16x4, __builtin_amdgcn_ds_read_tr16_b64_v4i16((__attribute__((address_space(3))) v4i16_t*)p)); }
__device__ __forceinline__ float max3f(float a, float b, float c) { float r; asm("v_max3_f32 %0, %1, %2, %3" : "=v"(r) : "v"(a), "v"(b), "v"(c)); return r; }
__device__ __forceinline__ float xhalf_max(float m) { auto rr = __builtin_amdgcn_permlane32_swap(__float_as_uint(m), __float_as_uint(m), false, false); return fmaxf(__uint_as_float(rr[0]), __uint_as_float(rr[1])); }
__device__ __forceinline__ float xhalf_sum(float m) { auto rr = __builtin_amdgcn_permlane32_swap(__float_as_uint(m), __float_as_uint(m), false, false); return __uint_as_float(rr[0]) + __uint_as_float(rr[1]); }

template <int MODE>
__device__ __forceinline__ void unit(const Args& a, unsigned char* lds, int b, int h, int qb, int tid) {
  unsigned char* ws = a.ws;
  const int lane = tid & 63, r32 = lane & 31, hi = lane >> 5; const int wid = __builtin_amdgcn_readfirstlane(tid >> 6);
  const bf16_t* qkv = (const bf16_t*)(ws + WS_QKV);
  const int qoff = MODE ? 1536 : 0;
  const size_t rowbase = (size_t)b * SEQ; const int q0 = qb * 256;
  const bf16_t* Qw = qkv + (rowbase + q0 + wid * 32) * PITCH + qoff + h * 64;
  const bf16_t* Kh = qkv + rowbase * PITCH + qoff + 512 + h * 64;
  const bf16_t* Vh = qkv + rowbase * PITCH + qoff + 1024 + h * 64;
  float* wsf = (float*)(lds + L_WSF) + wid * 64;
  float* c2s = (float*)(lds + L_C2); float* kms = (float*)(lds + L_KM); float* bts = (float*)(lds + L_BT); unsigned* misc = (unsigned*)(lds + L_MISC);
  const int NTL = 4 * (qb + 1);
  __syncthreads();
  if (MODE == 0) {
    const float* km = (const float*)(ws + WS_KMEAN) + (size_t)b * 16 * 512 + h * 64;
    for (int i = tid; i < 16 * 64; i += 512) kms[i] = km[(size_t)(i >> 6) * 512 + (i & 63)];
    if (tid < 128) bts[tid] = a.in[5][T5_BUCKET[tid] * 8 + h] * LOG2E;
    if (tid == 128) bts[128] = a.in[5][31 * 8 + h] * LOG2E;
  } else {
    const float* cg = (const float*)(ws + WS_CUM) + (size_t)(b * 8 + h) * SEQ;
    for (int i = tid; i < 256 * (qb + 1); i += 512) c2s[i] = cg[i];
    if (tid == 0) misc[0] = 0u;
  }
  bf16x8 qr[4];
#pragma unroll
  for (int d0 = 0; d0 < 4; ++d0) qr[d0] = *(const bf16x8*)(Qw + (size_t)r32 * PITCH + d0 * 16 + hi * 8);
  __syncthreads();
  unsigned selmask = 0u; float cq2 = 0.f, far2 = 0.f, mhat = 0.f; int t0 = 0;
  if (MODE == 0) {
    far2 = bts[128];
    float v0 = -3e38f, v1 = -3e38f, v2 = -3e38f; int i0 = -1, i1 = -1, i2 = -1;
    for (int n = 0; n < qb; ++n) {
      float s = 0.f;
#pragma unroll
      for (int d0 = 0; d0 < 4; ++d0)
#pragma unroll
        for (int j = 0; j < 8; ++j) s += bf2f((unsigned short)qr[d0][j]) * kms[n * 64 + d0 * 16 + hi * 8 + j];
      s = xhalf_sum(s);
      if (s > v0) { v2 = v1; i2 = i1; v1 = v0; i1 = i0; v0 = s; i0 = n; }
      else if (s > v1) { v2 = v1; i2 = i1; v1 = s; i1 = n; }
      else if (s > v2) { v2 = s; i2 = n; }
    }
    if (i0 >= 0) selmask |= 1u << i0;
    if (i1 >= 0) selmask |= 1u << i1;
    if (i2 >= 0) selmask |= 1u << i2;
  } else {
    cq2 = c2s[q0 + wid * 32 + r32];
    float s = 0.f;
#pragma unroll
    for (int d0 = 0; d0 < 4; ++d0)
#pragma unroll
      for (int j = 0; j < 8; ++j) { const float f = bf2f((unsigned short)qr[d0][j]); s += f * f; }
    s = xhalf_sum(s);
    atomicMax(&misc[0], __float_as_uint(s));
    __syncthreads();
    const float kn2 = __uint_as_float(((const unsigned*)(ws + 256))[b * 8 + h]);
    const float qkb = sqrtf(__uint_as_float(misc[0]) * kn2) * 1.0001f + 1e-3f;
    mhat = -qkb;
    const int j = lane; bool skip = false;
    if (j < NTL) skip = (2.f * qkb + c2s[q0] - c2s[64 * j + 63]) < -150.f;
    t0 = __popcll(__ballot(skip));
    if (t0 > NTL - 1) t0 = NTL - 1;
  }
  const bf16_t* ksrc = Kh + (size_t)lane * PITCH + wid * 8;
  const bf16_t* vsrc = Vh + (size_t)(16 * (wid & 3) + (lane >> 2)) * PITCH + (wid >> 2) * 32 + (lane & 3) * 8;
  unsigned char* kdst = lds + L_K + wid * 1024 + lane * 16; unsigned char* vdst = lds + L_V + wid * 1024 + lane * 16;
  const lds_cptr lds3 = (lds_cptr)lds;
  const lds_cptr vp0 = lds3 + L_V + ((lane >> 4) & 1) * 32 + (lane & 3) * 8 + (4 * hi + ((lane & 15) >> 2)) * 64;
  u32x4 kreg = *(const u32x4*)(ksrc + (size_t)t0 * 64 * PITCH), vreg = *(const u32x4*)(vsrc + (size_t)t0 * 64 * PITCH);
  *(u32x4*)(kdst + (t0 & 1) * 8192) = kreg; *(u32x4*)(vdst + (t0 & 1) * 8192) = vreg;
  f32x16 o[2]; o[0] = f32x16{}; o[1] = f32x16{};
  f32x16 ol = f32x16{}, cm = f32x16{}; int cm_nb = -1;
  const int qrel = wid * 32 + r32, qpos = q0 + qrel;
  __syncthreads();
  for (int t = t0; t < NTL; ++t) {
    const int buf = (t & 1) * 8192;
    if (t + 1 < NTL) { kreg = *(const u32x4*)(ksrc + (size_t)(t + 1) * 64 * PITCH); vreg = *(const u32x4*)(vsrc + (size_t)(t + 1) * 64 * PITCH); }
    const int jb = t - (NTL - 4);
    const bool compute = !(jb >= 0 && 64 * jb > wid * 32 + 31);
    if (compute) {
      f32x16 p0, p1;
      bf16x8 kf[8];
      {
        const lds_cptr kb = lds3 + L_K + buf + hi * 1024 + r32 * 16;
#pragma unroll
        for (int d0 = 0; d0 < 4; ++d0) { kf[2 * d0] = *(const __attribute__((address_space(3))) bf16x8*)(kb + d0 * 2048); kf[2 * d0 + 1] = *(const __attribute__((address_space(3))) bf16x8*)(kb + d0 * 2048 + 512); }
      }
      __builtin_amdgcn_sched_barrier(0);
      if (MODE == 0) {
        const int nb = t >> 2;
        const bool near = (jb >= 0) || (t >= NTL - 6 && wid < 4);
        if (near) {
#pragma unroll
          for (int r = 0; r < 16; ++r) { const int d = qpos - (64 * t + crow(r, hi));
            p0[r] = bts[min(max(d, 0), 128)] - mhat; p1[r] = bts[min(max(d - 32, 0), 128)] - mhat; }
          if (jb < 0 && !((selmask >> nb) & 1u)) {
#pragma unroll
            for (int r = 0; r < 16; ++r) { p0[r] = -INFINITY; p1[r] = -INFINITY; }
          }
        } else {
          if (cm_nb != nb) {
            const float base = ((selmask >> nb) & 1u) ? far2 - mhat : -INFINITY;
#pragma unroll
            for (int r = 0; r < 16; ++r) cm[r] = base;
            cm_nb = nb;
          }
          p0 = cm; p1 = cm;
        }
      } else {
        const float cqm = cq2 - mhat;
#pragma unroll
        for (int g = 0; g < 4; ++g) {
          const f32x4 ca = *(const f32x4*)(c2s + 64 * t + 8 * g + 4 * hi), cb = *(const f32x4*)(c2s + 64 * t + 32 + 8 * g + 4 * hi);
#pragma unroll
          for (int i = 0; i < 4; ++i) { p0[4 * g + i] = cqm - ca[i]; p1[4 * g + i] = cqm - cb[i]; }
        }
      }
#pragma unroll
      for (int d0 = 0; d0 < 4; ++d0) {
        p0 = __builtin_amdgcn_mfma_f32_32x32x16_bf16(kf[2 * d0], qr[d0], p0, 0, 0, 0);
        p1 = __builtin_amdgcn_mfma_f32_32x32x16_bf16(kf[2 * d0 + 1], qr[d0], p1, 0, 0, 0);
      }
      if (jb >= 0) {
        asm volatile("" ::: "memory");
        const int kb0 = 64 * jb + 4 * hi;
#pragma unroll
        for (int r = 0; r < 16; ++r) { const int kv = kb0 + (r & 3) + 8 * (r >> 2); if (kv > qrel) p0[r] = -INFINITY; if (kv + 32 > qrel) p1[r] = -INFINITY; }
      }
      asm volatile("s_nop 15\n\ts_nop 7" : "+v"(p0), "+v"(p1));
      float rm, rm2;
      rm = max3f(p0[0], p0[1], p1[0]); rm2 = max3f(p0[2], p0[3], p1[1]); rm = max3f(rm, p1[2], p1[3]);
#pragma unroll
      for (int r = 4; r < 16; r += 4) { rm = max3f(rm, p0[r], p0[r + 1]); rm2 = max3f(rm2, p0[r + 2], p0[r + 3]); rm = max3f(rm, p1[r], p1[r + 1]); rm2 = max3f(rm2, p1[r + 2], p1[r + 3]); }
      rm = xhalf_max(fmaxf(rm, rm2));
      if (__any(rm > 8.0f)) {
        const float dl = fmaxf(rm, 0.f), alpha = __builtin_amdgcn_exp2f(-dl);
        mhat += dl; cm_nb = -1;
#pragma unroll
        for (int r = 0; r < 16; ++r) { p0[r] -= dl; p1[r] -= dl; }
        if (hi == 0) wsf[r32] = alpha;
        __builtin_amdgcn_wave_barrier();
#pragma unroll
        for (int r = 0; r < 16; ++r) { const float f = wsf[crow(r, hi)]; o[0][r] *= f; o[1][r] *= f; ol[r] *= f; }
        __builtin_amdgcn_wave_barrier();
      }
#pragma unroll
      for (int r = 0; r < 16; ++r) { p0[r] = __builtin_amdgcn_exp2f(p0[r]); p1[r] = __builtin_amdgcn_exp2f(p1[r]); }
      u32x4 pw0, pw1, pw2, pw3;
      pw0 = (u32x4){cvtpk(p0[0], p0[1]), cvtpk(p0[2], p0[3]), cvtpk(p0[4], p0[5]), cvtpk(p0[6], p0[7])};
      pw1 = (u32x4){cvtpk(p0[8], p0[9]), cvtpk(p0[10], p0[11]), cvtpk(p0[12], p0[13]), cvtpk(p0[14], p0[15])};
      pw2 = (u32x4){cvtpk(p1[0], p1[1]), cvtpk(p1[2], p1[3]), cvtpk(p1[4], p1[5]), cvtpk(p1[6], p1[7])};
      pw3 = (u32x4){cvtpk(p1[8], p1[9]), cvtpk(p1[10], p1[11]), cvtpk(p1[12], p1[13]), cvtpk(p1[14], p1[15])};
      {
        const bf16x8 ones = (bf16x8){0x3F80, 0x3F80, 0x3F80, 0x3F80, 0x3F80, 0x3F80, 0x3F80, 0x3F80};
        ol = __builtin_amdgcn_mfma_f32_32x32x16_bf16(__builtin_bit_cast(bf16x8, pw0), ones, ol, 0, 0, 0);
        ol = __builtin_amdgcn_mfma_f32_32x32x16_bf16(__builtin_bit_cast(bf16x8, pw1), ones, ol, 0, 0, 0);
        ol = __builtin_amdgcn_mfma_f32_32x32x16_bf16(__builtin_bit_cast(bf16x8, pw2), ones, ol, 0, 0, 0);
        ol = __builtin_amdgcn_mfma_f32_32x32x16_bf16(__builtin_bit_cast(bf16x8, pw3), ones, ol, 0, 0, 0);
      }
      const lds_cptr vp = vp0 + buf;
#pragma unroll
      for (int d0 = 0; d0 < 2; ++d0) {
#define ATT_VF(ks) ({ const s16x4 lo_ = vtr(vp + d0 * 4096 + (ks) * 1024), hi_ = vtr(vp + d0 * 4096 + (ks) * 1024 + 512); (bf16x8){lo_[0], lo_[1], lo_[2], lo_[3], hi_[0], hi_[1], hi_[2], hi_[3]}; })
        o[d0] = __builtin_amdgcn_mfma_f32_32x32x16_bf16(__builtin_bit_cast(bf16x8, pw0), ATT_VF(0), o[d0], 0, 0, 0);
        o[d0] = __builtin_amdgcn_mfma_f32_32x32x16_bf16(__builtin_bit_cast(bf16x8, pw1), ATT_VF(1), o[d0], 0, 0, 0);
        o[d0] = __builtin_amdgcn_mfma_f32_32x32x16_bf16(__builtin_bit_cast(bf16x8, pw2), ATT_VF(2), o[d0], 0, 0, 0);
        o[d0] = __builtin_amdgcn_mfma_f32_32x32x16_bf16(__builtin_bit_cast(bf16x8, pw3), ATT_VF(3), o[d0], 0, 0, 0);
#undef ATT_VF
      }
    }
    if (t + 1 < NTL) { *(u32x4*)(kdst + ((t + 1) & 1) * 8192) = kreg; *(u32x4*)(vdst + ((t + 1) & 1) * 8192) = vreg; }
    __syncthreads();
  }
  bf16_t* stg = (bf16_t*)(lds + L_OST) + wid * 2048;
#pragma unroll
  for (int r = 0; r < 16; ++r) { const int orow = crow(r, hi); const float rl = 1.f / ol[r];
    stg[orow * 64 + r32] = (bf16_t)f2bf(o[0][r] * rl); stg[orow * 64 + 32 + r32] = (bf16_t)f2bf(o[1][r] * rl); }
  __builtin_amdgcn_wave_barrier();
  bf16_t* Ow = (bf16_t*)(ws + WS_OAB) + (rowbase + q0 + wid * 32) * DM + (MODE ? 512 : 0) + h * 64;
#pragma unroll
  for (int i = 0; i < 4; ++i) { const int row = i * 8 + (lane >> 3), ch = lane & 7; const u32x4 v = *(const u32x4*)(stg + row * 64 + ch * 8); *(u32x4*)(Ow + (size_t)row * DM + ch * 8) = v; }
}
}

__device__ __forceinline__ void phase_attn2(const Args& a, unsigned char* lds, int tid) {
  unsigned* ctr = (unsigned*)(a.ws + 0);
  unsigned* slot = (unsigned*)(lds + att::L_MISC + 64);
  for (;;) {
    __syncthreads();
    if (tid == 0) slot[0] = atomicAdd(ctr, 1u);
    __syncthreads();
    const unsigned u = slot[0];
    if (u >= 2048u) break;
    const int qb = 15 - (int)(u >> 7), r = u & 127, mode = r & 1, bh = r >> 1;
    if (mode == 0) att::unit<0>(a, lds, bh >> 3, bh & 7, qb, tid);
    else att::unit<1>(a, lds, bh >> 3, bh & 7, qb, tid);
  }
}

__device__ __forceinline__ void phase_onorm(const Args& a, int gw, int ngw, int lane) {
  bf16_t* oab = (bf16_t*)(a.ws + WS_OAB);
  for (int r = gw; r < NT; r += ngw) {
    u32x4* p = (u32x4*)(oab + (size_t)r * DM) + 2 * lane;
    const u32x4 w0 = p[0], w1 = p[1]; float f[16]; unpack8(w0, f); unpack8(w1, f + 8);
    float s = 0.f;
#pragma unroll
    for (int i = 0; i < 16; ++i) s += f[i] * f[i];
#pragma unroll
    for (int o = 1; o < 32; o <<= 1) s += __shfl_xor(s, o);
    const float rstd = rsqrtf(s * (1.f / 512.f) + EPS);
    u32x4 o0, o1;
    o0.x = pk2(f[0] * rstd, f[1] * rstd); o0.y = pk2(f[2] * rstd, f[3] * rstd); o0.z = pk2(f[4] * rstd, f[5] * rstd); o0.w = pk2(f[6] * rstd, f[7] * rstd);
    o1.x = pk2(f[8] * rstd, f[9] * rstd); o1.y = pk2(f[10] * rstd, f[11] * rstd); o1.z = pk2(f[12] * rstd, f[13] * rstd); o1.w = pk2(f[14] * rstd, f[15] * rstd);
    p[0] = o0; p[1] = o1;
  }
}

__device__ __forceinline__ void phase_rms(const Args& a, int gw, int ngw, int lane) {
  for (int r = gw; r < NT; r += ngw) rms_row_to_bf16(a.out + (size_t)r * DM, (bf16_t*)(a.ws + WS_HB) + (size_t)r * DM, lane);
}

__device__ __forceinline__ void phase_xattn(const Args& a, unsigned char* lds, int gw, int ngw, int wave, int lane) {
  unsigned char* ws = a.ws;
  const bf16_t* qx = (const bf16_t*)(ws + WS_QX); const bf16_t* kx = (const bf16_t*)(ws + WS_KX); const bf16_t* vxt = (const bf16_t*)(ws + WS_VXT);
  bf16_t* ox = (bf16_t*)(ws + WS_OX);
  bf16_t* P = (bf16_t*)(lds + wave * 8192);
  const int fr = lane & 15, fq = lane >> 4;
  for (int u = gw; u < (NT / 16) * 4; u += ngw) {
    const int hd = u & 3, r0 = (u >> 2) * 16, b = r0 / SEQ;
    f32x4 acc[16];
#pragma unroll
    for (int i = 0; i < 16; ++i) acc[i] = (f32x4){0.f, 0.f, 0.f, 0.f};
    const bf16_t* Ap = qx + (size_t)(r0 + fr) * DM + hd * 256 + fq * 8;
    const bf16_t* Bp = kx + (size_t)(b * 256 + fr) * DM + hd * 256 + fq * 8;
    for (int ks = 0; ks < 8; ++ks) {
      const bf16x8 af = *(const bf16x8*)(Ap + ks * 32);
#pragma unroll
      for (int ct = 0; ct < 16; ++ct) { const bf16x8 bfr = *(const bf16x8*)(Bp + (size_t)ct * 16 * DM + ks * 32); acc[ct] = __builtin_amdgcn_mfma_f32_16x16x32_bf16(af, bfr, acc[ct], 0, 0, 0); }
    }
    float mx[4], sm[4];
#pragma unroll
    for (int r = 0; r < 4; ++r) { float m = acc[0][r];
#pragma unroll
      for (int ct = 1; ct < 16; ++ct) m = fmaxf(m, acc[ct][r]);
#pragma unroll
      for (int o = 1; o < 16; o <<= 1) m = fmaxf(m, __shfl_xor(m, o));
      mx[r] = m; sm[r] = 0.f; }
#pragma unroll
    for (int ct = 0; ct < 16; ++ct)
#pragma unroll
      for (int r = 0; r < 4; ++r) { const float p = __expf((acc[ct][r] - mx[r]) * 0.0625f); acc[ct][r] = p; sm[r] += p; }
#pragma unroll
    for (int r = 0; r < 4; ++r) {
#pragma unroll
      for (int o = 1; o < 16; o <<= 1) sm[r] += __shfl_xor(sm[r], o);
      sm[r] = 1.f / sm[r]; }
    __builtin_amdgcn_wave_barrier();
#pragma unroll
    for (int ct = 0; ct < 16; ++ct)
#pragma unroll
      for (int r = 0; r < 4; ++r) P[(4 * fq + r) * 256 + ct * 16 + fr] = (bf16_t)f2bf(acc[ct][r] * sm[r]);
    __builtin_amdgcn_wave_barrier();
    asm volatile("s_waitcnt lgkmcnt(0)" ::: "memory");
#pragma unroll
    for (int i = 0; i < 16; ++i) acc[i] = (f32x4){0.f, 0.f, 0.f, 0.f};
    const bf16_t* Vp = vxt + ((size_t)(b * 4 + hd) * 256 + fr) * 256 + fq * 8;
    for (int ks = 0; ks < 8; ++ks) {
      const bf16x8 pf = *(const bf16x8*)(P + fr * 256 + ks * 32 + fq * 8);
#pragma unroll
      for (int dt = 0; dt < 16; ++dt) { const bf16x8 vf = *(const bf16x8*)(Vp + (size_t)dt * 16 * 256 + ks * 32); acc[dt] = __builtin_amdgcn_mfma_f32_16x16x32_bf16(pf, vf, acc[dt], 0, 0, 0); }
    }
#pragma unroll
    for (int dt = 0; dt < 16; ++dt)
#pragma unroll
      for (int r = 0; r < 4; ++r) ox[(size_t)(r0 + 4 * fq + r) * DM + hd * 256 + dt * 16 + fr] = (bf16_t)f2bf(acc[dt][r]);
    __builtin_amdgcn_wave_barrier();
  }
}

namespace xa {
using att::f32x16; using att::s16x4; using att::lds_cptr; using att::crow; using att::cvtpk; using att::vtr; using att::xhalf_max; using att::xhalf_sum;
constexpr int L_WSF = 98304;
__device__ __forceinline__ void glds16(const void* gsrc, unsigned lds_dst) { unsigned keep;
  asm volatile("s_mov_b32 %0, m0\n\ts_mov_b32 m0, %2\n\ts_nop 0\n\tglobal_load_lds_dwordx4 %1, off\n\ts_mov_b32 m0, %0" : "=&s"(keep) : "v"(gsrc), "s"(lds_dst) : "memory"); }
__device__ __forceinline__ void unit(const Args& a, unsigned char* lds, int b, int hd, int qb, int tid) {
  unsigned char* ws = a.ws;
  const int lane = tid & 63, r32 = lane & 31, hi = lane >> 5; const int wid = __builtin_amdgcn_readfirstlane(tid >> 6);
  const bf16_t* qrow = (const bf16_t*)(ws + WS_QX) + ((size_t)b * SEQ + qb * 256 + wid * 32 + r32) * DM + hd * 256;
  const bf16_t* kvb = (const bf16_t*)(ws + WS_KX) + (size_t)b * 256 * 2048 + hd * 256;
  const bf16_t* ksrc = kvb + (size_t)lane * 2048 + wid * 8;
  const bf16_t* vsrc = kvb + 1024 + (size_t)(16 * (wid & 3) + (lane >> 2)) * 2048 + (wid >> 2) * 32 + (lane & 3) * 8;
  const unsigned sdst = (unsigned)(uintptr_t)lds + wid * 1024;
  const lds_cptr lds3 = (lds_cptr)lds;
  const lds_cptr kp0 = lds3 + hi * 1024 + r32 * 16;
  const lds_cptr vp0 = lds3 + ((lane >> 4) & 1) * 32 + (lane & 3) * 8 + (4 * hi + ((lane & 15) >> 2)) * 64;
  float* wsf = (float*)(lds + L_WSF) + wid * 64;
#define XA_DMA(s) do { const unsigned db_ = (unsigned)__builtin_amdgcn_readfirstlane(sdst + ((s) % 3) * 32768); \
    const bf16_t* kq_ = ksrc; const bf16_t* vq_ = vsrc; asm volatile("" : "+v"(kq_), "+v"(vq_));        \
    if ((s) < 4) { _Pragma("unroll") for (int kt = 0; kt < 4; ++kt) glds16(kq_ + (size_t)kt * 64 * 2048 + (s) * 64, db_ + kt * 8192); } \
    else { _Pragma("unroll") for (int dq = 0; dq < 4; ++dq) glds16(vq_ + (size_t)((s) - 4) * 64 * 2048 + dq * 64, db_ + dq * 8192); } } while (0)
#define XA_CLOSE(s) do { if ((s) + 2 < 8) asm volatile("s_waitcnt vmcnt(4) lgkmcnt(0)\n\ts_barrier" ::: "memory"); else asm volatile("s_waitcnt vmcnt(0) lgkmcnt(0)\n\ts_barrier" ::: "memory"); } while (0)
  __syncthreads();
  asm volatile("s_waitcnt vmcnt(0)" ::: "memory");
  XA_DMA(0); XA_DMA(1);
  f32x16 acc[8];
#pragma unroll
  for (int j = 0; j < 8; ++j) acc[j] = f32x16{};
  asm volatile("s_waitcnt vmcnt(4) lgkmcnt(0)\n\ts_barrier" ::: "memory");
#pragma unroll
  for (int c = 0; c < 4; ++c) {
    XA_DMA(c + 2);
    bf16x8 qf[4];
#pragma unroll
    for (int d0 = 0; d0 < 4; ++d0) qf[d0] = *(const bf16x8*)(qrow + c * 64 + d0 * 16 + hi * 8);
    int koff_ = (c % 3) * 32768; asm volatile("" : "+v"(koff_));
    const lds_cptr kp = kp0 + koff_;
#pragma unroll
    for (int d0 = 0; d0 < 4; ++d0)
#pragma unroll
      for (int j = 0; j < 8; ++j) {
        const bf16x8 kf = *(const __attribute__((address_space(3))) bf16x8*)(kp + (j >> 1) * 8192 + d0 * 2048 + (j & 1) * 512);
        acc[j] = __builtin_amdgcn_mfma_f32_32x32x16_bf16(kf, qf[d0], acc[j], 0, 0, 0);
      }
    XA_CLOSE(c);
  }
  float m = acc[0][0];
#pragma unroll
  for (int j = 0; j < 8; ++j)
#pragma unroll
    for (int r = 0; r < 16; ++r) m = fmaxf(m, acc[j][r]);
  m = xhalf_max(m);
  constexpr float CS = 1.4426950408889634f / 16.f;
  float l = 0.f; u32x4 pw[16];
#pragma unroll
  for (int j = 0; j < 8; ++j) {
#pragma unroll
    for (int r = 0; r < 16; ++r) { const float p = __builtin_amdgcn_exp2f((acc[j][r] - m) * CS); acc[j][r] = p; l += p; }
    pw[2 * j] = (u32x4){cvtpk(acc[j][0], acc[j][1]), cvtpk(acc[j][2], acc[j][3]), cvtpk(acc[j][4], acc[j][5]), cvtpk(acc[j][6], acc[j][7])};
    pw[2 * j + 1] = (u32x4){cvtpk(acc[j][8], acc[j][9]), cvtpk(acc[j][10], acc[j][11]), cvtpk(acc[j][12], acc[j][13]), cvtpk(acc[j][14], acc[j][15])};
  }
  l = xhalf_sum(l);
#pragma unroll
  for (int j = 0; j < 8; ++j) acc[j] = f32x16{};
#pragma unroll
  for (int vt = 0; vt < 4; ++vt) {
    if (vt + 6 < 8) XA_DMA(vt + 6);
    int voff_ = ((vt + 4) % 3) * 32768; asm volatile("" : "+v"(voff_));
    const lds_cptr vp = vp0 + voff_;
#pragma unroll
    for (int ks = 0; ks < 4; ++ks)
#pragma unroll
      for (int db = 0; db < 8; ++db) {
        const s16x4 lo_ = vtr(vp + (db >> 1) * 8192 + (db & 1) * 4096 + ks * 1024), hi_ = vtr(vp + (db >> 1) * 8192 + (db & 1) * 4096 + ks * 1024 + 512);
        const bf16x8 vf = (bf16x8){lo_[0], lo_[1], lo_[2], lo_[3], hi_[0], hi_[1], hi_[2], hi_[3]};
        acc[db] = __builtin_amdgcn_mfma_f32_32x32x16_bf16(__builtin_bit_cast(bf16x8, pw[4 * vt + ks]), vf, acc[db], 0, 0, 0);
      }
    XA_CLOSE(vt + 4);
  }
  if (hi == 0) wsf[r32] = l;
  __builtin_amdgcn_wave_barrier();
  float rl[16];
#pragma unroll
  for (int r = 0; r < 16; ++r) rl[r] = 1.f / wsf[crow(r, hi)];
  int sbase = (4 * hi) * 128 + r32, lbase = (lane >> 4) * 128 + (lane & 15) * 8;
  asm volatile("" : "+v"(sbase), "+v"(lbase));
  bf16_t* stg = (bf16_t*)(lds + wid * 8192);
  bf16_t* orow0 = (bf16_t*)(ws + WS_OX) + ((size_t)b * SEQ + qb * 256 + wid * 32) * DM + hd * 256 + (size_t)(lane >> 4) * DM + (lane & 15) * 8;
#pragma unroll
  for (int hf = 0; hf < 2; ++hf) {
#pragma unroll
    for (int db = 0; db < 4; ++db)
#pragma unroll
      for (int r = 0; r < 16; ++r) stg[sbase + ((r & 3) + 8 * (r >> 2)) * 128 + db * 32] = (bf16_t)f2bf(acc[hf * 4 + db][r] * rl[r]);
    __builtin_amdgcn_wave_barrier();
#pragma unroll
    for (int i = 0; i < 8; ++i) { const u32x4 v = *(const u32x4*)(stg + lbase + i * 4 * 128); *(u32x4*)(orow0 + (size_t)(i * 4) * DM + hf * 128) = v; }
    __builtin_amdgcn_wave_barrier();
  }
#undef XA_DMA
#undef XA_CLOSE
}
}

__device__ __forceinline__ void phase_xattn2(const Args& a, unsigned char* lds, int tid) {
  for (int u = blockIdx.x; u < NB * 4 * 16; u += gridDim.x) { const int qb = u & 15, hd = (u >> 4) & 3, b = u >> 6; xa::unit(a, lds, b, hd, qb, tid); }
}

__device__ __forceinline__ unsigned fkey(float s, unsigned idx, unsigned mask) { unsigned u = __float_as_uint(s); u ^= (unsigned)((int)u >> 31) | 0x80000000u; return (u & ~mask) | (mask - idx); }
__device__ __forceinline__ float keyval(unsigned k, unsigned mask) { unsigned u = k & ~mask; u = (u & 0x80000000u) ? (u ^ 0x80000000u) : ~u; return __uint_as_float(u); }
#define KEY_INSERT(KA, key_) do { unsigned k__ = (key_); \
  _Pragma("unroll") for (int s_ = 0; s_ < 16; ++s_) { const unsigned hi_ = max(k__, KA[s_]); k__ = min(k__, KA[s_]); KA[s_] = hi_; } } while (0)

__device__ __forceinline__ void phase_topk(const Args& a, unsigned char* lds, int tid) {
  unsigned char* ws = a.ws;
  const float* pq = (const float*)(ws + WS_PQ);
  int* eidx = (int*)(ws + WS_EIDX); float* gate = (float*)(ws + WS_GATE);
  float* K1 = (float*)lds; float* K2 = K1 + 128 * 64; unsigned* KL = (unsigned*)(lds + 65536);
  for (int u = blockIdx.x; u < 8 * (NT / 512); u += gridDim.x) {
    const int h = u & 7, t = (u >> 3) * 512 + tid;
    __syncthreads();
    for (int i = tid; i < 128 * 64 / 4; i += 512) { ((f32x4*)K1)[i] = ((const f32x4*)(a.in[17] + (size_t)h * 8192))[i]; ((f32x4*)K2)[i] = ((const f32x4*)(a.in[18] + (size_t)h * 8192))[i]; }
    __syncthreads();
    unsigned ka[16], kb[16], kc[16];
#pragma unroll
    for (int k = 0; k < 16; ++k) { ka[k] = 0u; kb[k] = 0u; kc[k] = 0u; }
    float q[64];
    const f32x4* qp = (const f32x4*)(pq + (size_t)t * DM + h * 128);
#pragma unroll
    for (int c = 0; c < 16; ++c) { const f32x4 w = qp[c]; q[4 * c] = w.x; q[4 * c + 1] = w.y; q[4 * c + 2] = w.z; q[4 * c + 3] = w.w; }
    for (int n = 0; n < 128; ++n) {
      const f32x4* kr = (const f32x4*)(K1 + n * 64); float s = 0.f;
#pragma unroll
      for (int c = 0; c < 16; ++c) { const f32x4 kv = kr[c]; s += q[4 * c] * kv.x + q[4 * c + 1] * kv.y + q[4 * c + 2] * kv.z + q[4 * c + 3] * kv.w; }
      KEY_INSERT(ka, fkey(s, (unsigned)n, 127u));
    }
#pragma unroll
    for (int c = 0; c < 16; ++c) { const f32x4 w = qp[16 + c]; q[4 * c] = w.x; q[4 * c + 1] = w.y; q[4 * c + 2] = w.z; q[4 * c + 3] = w.w; }
    for (int n = 0; n < 128; ++n) {
      const f32x4* kr = (const f32x4*)(K2 + n * 64); float s = 0.f;
#pragma unroll
      for (int c = 0; c < 16; ++c) { const f32x4 kv = kr[c]; s += q[4 * c] * kv.x + q[4 * c + 1] * kv.y + q[4 * c + 2] * kv.z + q[4 * c + 3] * kv.w; }
      KEY_INSERT(kb, fkey(s, (unsigned)n, 127u));
    }
#pragma unroll
    for (int x = 0; x < 16; ++x)
#pragma unroll
      for (int y = 0; y < 16; ++y)
        if ((x + 1) * (y + 1) <= 16) { KEY_INSERT(kc, fkey(keyval(ka[x], 127u) + keyval(kb[y], 127u), (unsigned)(x * 16 + y), 255u)); }
#pragma unroll
    for (int k = 0; k < 16; ++k) { KL[k * 512 + tid] = ka[k]; KL[(16 + k) * 512 + tid] = kb[k]; }
    float val[16]; int id[16]; float sum = 0.f;
#pragma unroll
    for (int k = 0; k < 16; ++k) {
      const unsigned flat = 255u - (kc[k] & 255u);
      const unsigned k1 = KL[(flat >> 4) * 512 + tid], k2 = KL[(16 + (flat & 15u)) * 512 + tid];
      val[k] = keyval(k1, 127u) + keyval(k2, 127u);
      id[k] = (int)((127u - (k1 & 127u)) * 128u + (127u - (k2 & 127u)));
    }
    const float vmax = val[0];
#pragma unroll
    for (int k = 0; k < 16; ++k) { val[k] = __expf(val[k] - vmax); sum += val[k]; }
    const float inv = 1.f / sum;
    int* ep = eidx + (size_t)t * 128 + h * 16; float* gp = gate + (size_t)t * 128 + h * 16;
#pragma unroll
    for (int k = 0; k < 16; ++k) { ep[k] = id[k]; gp[k] = val[k] * inv; }
  }
}


namespace tk {
typedef float f32x16 __attribute__((ext_vector_type(16)));
__device__ __forceinline__ void ce(unsigned& a, unsigned& b) { const unsigned h = max(a, b), l = min(a, b); a = h; b = l; }
__device__ __forceinline__ void sort16(unsigned (&v)[16]) {
#pragma unroll
  for (int k = 2; k <= 16; k <<= 1)
#pragma unroll
    for (int j = k >> 1; j > 0; j >>= 1)
#pragma unroll
      for (int i = 0; i < 16; ++i) { const int l = i ^ j; if (l > i) { if ((i & k) == 0) ce(v[i], v[l]); else ce(v[l], v[i]); } }
}
__device__ __forceinline__ void topmerge(unsigned (&a)[16], const unsigned (&b)[16]) {
#pragma unroll
  for (int i = 0; i < 16; ++i) a[i] = max(a[i], b[15 - i]);
#pragma unroll
  for (int j = 8; j > 0; j >>= 1)
#pragma unroll
    for (int i = 0; i < 16; ++i) { const int l = i ^ j; if (l > i) ce(a[i], a[l]); }
}
__device__ __forceinline__ unsigned xswap(unsigned v, int hi) { auto rr = __builtin_amdgcn_permlane32_swap(v, v, false, false); return hi ? rr[0] : rr[1]; }
__device__ __forceinline__ void half_list(unsigned (&L)[16], const bf16_t* skh, const bf16_t* qrow, int r32, int hi) {
  f32x16 acc[4];
#pragma unroll
  for (int i = 0; i < 4; ++i) acc[i] = f32x16{};
#pragma unroll
  for (int ks = 0; ks < 4; ++ks) {
    const bf16x8 qf = *(const bf16x8*)(qrow + ks * 16 + hi * 8);
#pragma unroll
    for (int tl = 0; tl < 4; ++tl) { const bf16x8 kf = *(const bf16x8*)(skh + (size_t)(tl * 32 + r32) * 64 + ks * 16 + hi * 8); acc[tl] = __builtin_amdgcn_mfma_f32_32x32x16_bf16(kf, qf, acc[tl], 0, 0, 0); }
  }
  unsigned g[4][16];
#pragma unroll
  for (int tl = 0; tl < 4; ++tl)
#pragma unroll
    for (int r = 0; r < 16; ++r) g[tl][r] = fkey(acc[tl][r], (unsigned)(32 * tl + (r & 3) + 8 * (r >> 2) + 4 * hi), 127u);
  sort16(g[0]); sort16(g[1]); sort16(g[2]); sort16(g[3]);
  topmerge(g[0], g[1]); topmerge(g[2], g[3]); topmerge(g[0], g[2]);
  unsigned p[16];
#pragma unroll
  for (int k = 0; k < 16; ++k) p[k] = xswap(g[0][k], hi);
  topmerge(g[0], p);
#pragma unroll
  for (int k = 0; k < 16; ++k) L[k] = g[0][k];
}
}

__device__ __forceinline__ void phase_topk2(const Args& a, unsigned char* lds, int wave, int lane) {
  unsigned char* ws = a.ws;
  const bf16_t* pq = (const bf16_t*)(ws + WS_PQ); const bf16_t* sk = (const bf16_t*)(ws + WS_SK);
  int* eidx = (int*)(ws + WS_EIDX); float* gate = (float*)(ws + WS_GATE);
  const int r32 = lane & 31, hi = lane >> 5, h = wave;
  unsigned* KL = (unsigned*)(lds + wave * 4096);
  for (int t4 = blockIdx.x * 4; t4 < NT / 32; t4 += gridDim.x * 4)
  for (int tt = t4; tt < t4 + 4; ++tt) {
    const int t = tt * 32 + r32;
    unsigned ka[16], kb[16], kc[16];
    tk::half_list(ka, sk + (size_t)(0 * 8 + h) * 8192, pq + (size_t)t * DM + h * 128, r32, hi);
    tk::half_list(kb, sk + (size_t)(1 * 8 + h) * 8192, pq + (size_t)t * DM + h * 128 + 64, r32, hi);
    float va[16], vb[16];
#pragma unroll
    for (int k = 0; k < 16; ++k) { va[k] = keyval(ka[k], 127u); vb[k] = keyval(kb[k], 127u); }
#pragma unroll
    for (int y = 0; y < 16; ++y) kc[y] = hi ? 0u : fkey(va[0] + vb[y], (unsigned)y, 255u);
#define TK_CAND(xa, ya, xb, yb) do { const unsigned kA_ = fkey(va[xa] + vb[ya], (unsigned)((xa) * 16 + (ya)), 255u), kB_ = fkey(va[xb] + vb[yb], (unsigned)((xb) * 16 + (yb)), 255u); KEY_INSERT(kc, hi ? kB_ : kA_); } while (0)
    TK_CAND(1, 0, 1, 1);
    TK_CAND(1, 2, 1, 3);
    TK_CAND(1, 4, 1, 5);
    TK_CAND(1, 6, 1, 7);
    TK_CAND(2, 0, 2, 1);
    TK_CAND(2, 2, 2, 3);
    TK_CAND(2, 4, 3, 0);
    TK_CAND(3, 1, 3, 2);
    TK_CAND(3, 3, 4, 0);
    TK_CAND(4, 1, 4, 2);
    TK_CAND(5, 0, 5, 1);
    TK_CAND(6, 0, 6, 1);
    TK_CAND(7, 0, 7, 1);
    TK_CAND(8, 0, 9, 0);
    TK_CAND(10, 0, 11, 0);
    TK_CAND(12, 0, 13, 0);
    TK_CAND(14, 0, 15, 0);
#undef TK_CAND
    { unsigned p[16];
#pragma unroll
      for (int k = 0; k < 16; ++k) p[k] = tk::xswap(kc[k], hi);
      tk::topmerge(kc, p); }
    if (hi == 0) {
#pragma unroll
      for (int k = 0; k < 16; ++k) { KL[k * 32 + r32] = ka[k]; KL[(16 + k) * 32 + r32] = kb[k]; }
    }
    __builtin_amdgcn_wave_barrier();
    const float vmax = va[0] + vb[0];
    float pv[8]; int id[8]; float s = 0.f;
#pragma unroll
    for (int j = 0; j < 8; ++j) {
      unsigned klo_ = kc[j], khi_ = kc[8 + j]; asm volatile("" : "+v"(klo_), "+v"(khi_));
      const unsigned key = hi ? khi_ : klo_;
      const unsigned flat = 255u - (key & 255u);
      const unsigned k1 = KL[(flat >> 4) * 32 + r32], k2 = KL[(16 + (flat & 15u)) * 32 + r32];
      pv[j] = __expf(keyval(k1, 127u) + keyval(k2, 127u) - vmax); s += pv[j];
      id[j] = (int)((127u - (k1 & 127u)) * 128u + (127u - (k2 & 127u)));
    }
    __builtin_amdgcn_wave_barrier();
    const float inv = 1.f / att::xhalf_sum(s);
    u32x4* ep = (u32x4*)(eidx + (size_t)t * 128 + h * 16 + hi * 8); f32x4* gp = (f32x4*)(gate + (size_t)t * 128 + h * 16 + hi * 8);
    ep[0] = (u32x4){(unsigned)id[0], (unsigned)id[1], (unsigned)id[2], (unsigned)id[3]}; ep[1] = (u32x4){(unsigned)id[4], (unsigned)id[5], (unsigned)id[6], (unsigned)id[7]};
    gp[0] = (f32x4){pv[0] * inv, pv[1] * inv, pv[2] * inv, pv[3] * inv}; gp[1] = (f32x4){pv[4] * inv, pv[5] * inv, pv[6] * inv, pv[7] * inv};
  }
}

__device__ __forceinline__ float gelu_erf(float v) { return 0.5f * v * (1.f + erff(v * 0.70710678118654752f)); }

__device__ __forceinline__ float gelu_as(float v) {
  const float av = fabsf(v), t = __builtin_amdgcn_rcpf(av * 0.2316418882f + 1.0f);
  float q = t * 0.5307027145f + (-0.7265760135f); q = q * t + 0.7107068705f; q = q * t + (-0.142248368f); q = q * t + 0.127414796f; q = q * t;
  const float m = v * (q * __builtin_amdgcn_exp2f((v * v) * (-0.72134752044f)));
  return v < 0.f ? m : v - m;
}
#define PIN16(A, O) asm volatile("" : "+v"(A[O]), "+v"(A[O + 1]), "+v"(A[O + 2]), "+v"(A[O + 3]), "+v"(A[O + 4]), "+v"(A[O + 5]), "+v"(A[O + 6]), "+v"(A[O + 7]), "+v"(A[O + 8]), "+v"(A[O + 9]), "+v"(A[O + 10]), "+v"(A[O + 11]), "+v"(A[O + 12]), "+v"(A[O + 13]), "+v"(A[O + 14]), "+v"(A[O + 15]))
#define PIN6(R) asm volatile("" : "+v"(R[0].x), "+v"(R[0].y), "+v"(R[1].x), "+v"(R[1].y), "+v"(R[2].x), "+v"(R[2].y))
__device__ __forceinline__ void phase_exp_down(const Args& a, int wave, int lane) {
  const int nblk_ = (NT / 128 - (int)blockIdx.x + (int)gridDim.x - 1) / (int)gridDim.x, ntok = nblk_ > 0 ? 16 * nblk_ : 0;
#define DOWN_TOK(i) ((((int)blockIdx.x + ((i) >> 4) * (int)gridDim.x) * 128) + wave * 16 + ((i) & 15))
  unsigned char* ws = a.ws;
  const int* eidx = (const int*)(ws + WS_EIDX); const float* gate = (const float*)(ws + WS_GATE); float* wout = (float*)(ws + WS_W);
  const unsigned char* exd = ws + WS_EXD; const float* esc = (const float*)(ws + WS_ESC);
  const int l32 = lane & 31, hi = lane >> 5;
  const bool b4 = (l32 & 16) != 0, b3 = (l32 & 8) != 0, b2 = (l32 & 4) != 0;
  const bf16_t* hb = (const bf16_t*)(ws + WS_HB); const float* ss2 = (const float*)(ws + WS_SS2);
  int ne0 = 0, ne1 = 0; float ng0 = 0.f, ng1 = 0.f, nss = 0.f; u32x4 nh[4];
  if (ntok > 0) { const size_t tf = (size_t)DOWN_TOK(0); ne0 = eidx[tf * 128 + lane]; ne1 = eidx[tf * 128 + 64 + lane]; ng0 = gate[tf * 128 + lane]; ng1 = gate[tf * 128 + 64 + lane]; nss = ss2[tf];
    const u32x4* hp = (const u32x4*)(hb + tf * DM + 32 * l32);
#pragma unroll
    for (int k = 0; k < 4; ++k) nh[k] = hp[k]; }
  for (int ti = 0; ti < ntok; ++ti) {
    const int t = DOWN_TOK(ti);
    const int e0 = ne0, e1 = ne1;
    const float sd0 = esc[e0], sd1 = esc[e1];
    const float gu0 = ng0 * esc[NEXP + e0], gu1 = ng1 * esc[NEXP + e1];
    float hg[32];
    unpack8(nh[0], hg); unpack8(nh[1], hg + 8); unpack8(nh[2], hg + 16); unpack8(nh[3], hg + 24);
    const float rstd = rsqrtf(nss * (1.f / DM) + EPS);
    if (ti + 1 < ntok) { const size_t tn = (size_t)DOWN_TOK(ti + 1); ne0 = eidx[tn * 128 + lane]; ne1 = eidx[tn * 128 + 64 + lane]; ng0 = gate[tn * 128 + lane]; ng1 = gate[tn * 128 + 64 + lane]; nss = ss2[tn];
      const u32x4* hp = (const u32x4*)(hb + tn * DM + 32 * l32);
#pragma unroll
      for (int k = 0; k < 4; ++k) nh[k] = hp[k]; }
#pragma unroll
    for (int k = 0; k < 8; ++k) { const f32x4 g = ((const f32x4*)a.in[15])[8 * l32 + k]; hg[4 * k] *= rstd * g.x; hg[4 * k + 1] *= rstd * g.y; hg[4 * k + 2] *= rstd * g.z; hg[4 * k + 3] *= rstd * g.w; }
    float w0 = 0.f, w1 = 0.f;
    for (int e = 0; e < 128; e += 16) {
      u32x2 ur[8][3];
#pragma unroll
      for (int i = 0; i < 8; ++i) {
        const int pi = (e & 63) + 2 * i + hi; const int id = (e < 64) ? __shfl(e0, pi) : __shfl(e1, pi);
        const u32x2* up = (const u32x2*)(exd + (size_t)id * 768 + 24 * l32);
        ur[i][0] = up[0]; ur[i][1] = up[1]; ur[i][2] = up[2];
      }
      float d[8];
#pragma unroll
      for (int i = 0; i < 8; ++i) {
        const v32f u = __builtin_amdgcn_cvt_scalef32_pk32_f32_fp6((v6u){ur[i][0].x, ur[i][0].y, ur[i][1].x, ur[i][1].y, ur[i][2].x, ur[i][2].y}, 1.0f);
        f32x2 q2 = (f32x2){0.f, 0.f};
#pragma unroll
        for (int k = 0; k < 16; ++k) q2 = __builtin_elementwise_fma((f32x2){u[2 * k], u[2 * k + 1]}, (f32x2){hg[2 * k], hg[2 * k + 1]}, q2);
        d[i] = q2.x + q2.y;
        __builtin_amdgcn_sched_barrier(0);
      }
      float r[4];
#pragma unroll
      for (int j = 0; j < 4; ++j) r[j] = (b4 ? d[j + 4] : d[j]) + swz_xor<16>(b4 ? d[j] : d[j + 4]);
      const float q0 = (b3 ? r[2] : r[0]) + swz_xor<8>(b3 ? r[0] : r[2]);
      const float q1 = (b3 ? r[3] : r[1]) + swz_xor<8>(b3 ? r[1] : r[3]);
      float q = (b2 ? q1 : q0) + swz_xor<4>(b2 ? q0 : q1);
      q += swz_xor<2>(q); q += swz_xor<1>(q);
      const int pr = (e & 63) + 2 * (l32 >> 2) + hi;
      const float sd = (e < 64) ? __shfl(sd0, pr) : __shfl(sd1, pr);
      const float gu = (e < 64) ? __shfl(gu0, pr) : __shfl(gu1, pr);
      const float wl = gu * gelu_as(q * sd);
      const float wsrc = __shfl(wl, ((lane & 1) << 5) | (((lane - (e & 63)) >> 1 & 7) << 2));
      if (lane >= (e & 63) && lane < (e & 63) + 16) { if (e < 64) w0 = wsrc; else w1 = wsrc; }
    }
    wout[(size_t)t * 128 + lane] = w0; wout[(size_t)t * 128 + 64 + lane] = w1;
  }
#undef DOWN_TOK
}

__device__ __forceinline__ void exp_up_item(const Args& a, unsigned char* lds, int xs, int item, int wave, int lane, float* xout, float* ssout) {
  unsigned char* ws = a.ws;
  const int* eidx = (const int*)(ws + WS_EIDX); const float* wgt = (const float*)(ws + WS_W);
  const unsigned char* ups = ws + WS_EXU + (size_t)xs * (NEXP * 128);
  unsigned* L = (unsigned*)(lds + wave * 16640);
  const int g = lane >> 2, c = lane & 3, t0 = item * 128 + wave * 16;
  __builtin_amdgcn_wave_barrier();
#pragma unroll 4
  for (int tk = 0; tk < 16; ++tk) {
    const size_t o = (size_t)(t0 + tk) * 128;
    L[tk * 260 + lane] = (unsigned)eidx[o + lane]; L[tk * 260 + 64 + lane] = (unsigned)eidx[o + 64 + lane];
    L[tk * 260 + 128 + lane] = __float_as_uint(wgt[o + lane]); L[tk * 260 + 192 + lane] = __float_as_uint(wgt[o + 64 + lane]);
  }
  __builtin_amdgcn_wave_barrier();
  float acc[32];
#pragma unroll
  for (int i = 0; i < 32; ++i) acc[i] = 0.f;
  const unsigned* Lg = L + g * 260;
#pragma unroll 1
  for (int p = 0; p < 128; p += 8) {
    u32x2 vr[8][3];
#pragma unroll
    for (int u = 0; u < 8; ++u) {
      const u32x2* vp = (const u32x2*)(ups + (size_t)Lg[p + u] * 128 + 24 * c);
      vr[u][0] = vp[0]; vr[u][1] = vp[1]; vr[u][2] = vp[2];
    }
#pragma unroll
    for (int u = 0; u < 8; ++u) {
      const float w = __uint_as_float(Lg[128 + p + u]);
      PIN6(vr[u]);
      const v32f v = __builtin_amdgcn_cvt_scalef32_pk32_f32_fp6((v6u){vr[u][0].x, vr[u][0].y, vr[u][1].x, vr[u][1].y, vr[u][2].x, vr[u][2].y}, 1.0f);
#pragma unroll
      for (int k = 0; k < 32; ++k) acc[k] += w * v[k];
      PIN16(acc, 0); PIN16(acc, 16);
    }
  }
  const f32x4* xr = (const f32x4*)(a.out + (size_t)(t0 + g) * DM + xs * 128 + c * 32); f32x4* xw = (f32x4*)(xout + (size_t)(t0 + g) * DM + xs * 128 + c * 32);
  float s = 0.f;
#pragma unroll
  for (int k = 0; k < 8; ++k) { f32x4 x = xr[k]; x.x += acc[4 * k]; x.y += acc[4 * k + 1]; x.z += acc[4 * k + 2]; x.w += acc[4 * k + 3]; xw[k] = x; s += (x.x * x.x + x.y * x.y) + (x.z * x.z + x.w * x.w); }
  s += swz_xor<1>(s); s += swz_xor<2>(s);
  if (c == 0) atomicAdd(ssout + t0 + g, s);
}
__device__ __forceinline__ void phase_exp_up(const Args& a, unsigned char* lds, const XcdBarrier& bar, int tid, int wave, int lane, unsigned* ctr, float* xout, float* ssout);
struct UpBuf { u32x4 r[8][2]; };
__device__ __forceinline__ void up2_load(UpBuf& B, const unsigned char* ups, const unsigned* Lg, int ch, int c) {
  const unsigned char* base = ups + (size_t)(ch >> 4) * (NEXP * 128) + 32 * c; const int p = (ch & 15) * 8;
#pragma unroll
  for (int u = 0; u < 8; ++u) { const u32x4* vp = (const u32x4*)(base + (size_t)Lg[p + u] * 128); B.r[u][0] = vp[0]; B.r[u][1] = vp[1]; }
}
__device__ __forceinline__ void up2_math(UpBuf& B, const unsigned* Lg, int ch, f32x2 (&acc)[16]) {
  const int p = (ch & 15) * 8;
#pragma unroll
  for (int u = 0; u < 8; ++u) {
    const float w = __uint_as_float(Lg[128 + p + u]);
    const f32x2 w2 = (f32x2){w, w};
#pragma unroll
    for (int q = 0; q < 2; ++q)
#pragma unroll
      for (int k = 0; k < 4; ++k) {
        const auto lo = __builtin_amdgcn_cvt_pk_f32_fp8((int)B.r[u][q][k], false); const auto hi = __builtin_amdgcn_cvt_pk_f32_fp8((int)B.r[u][q][k], true);
        acc[8 * q + 2 * k] = __builtin_elementwise_fma((f32x2){lo[0], lo[1]}, w2, acc[8 * q + 2 * k]);
        acc[8 * q + 2 * k + 1] = __builtin_elementwise_fma((f32x2){hi[0], hi[1]}, w2, acc[8 * q + 2 * k + 1]);
      }
    if (u & 1) PIN16(acc, 0);
  }
}
__device__ __forceinline__ void up2_slice_end(const Args& a, int t, int xs, int c, f32x2 (&acc)[16], float& ssum) {
  f32x4* xr = (f32x4*)(a.out + (size_t)t * DM + xs * 128 + c * 32);
#pragma unroll
  for (int k = 0; k < 8; ++k) { f32x4 x = xr[k]; x.x += acc[2 * k].x; x.y += acc[2 * k].y; x.z += acc[2 * k + 1].x; x.w += acc[2 * k + 1].y; xr[k] = x; ssum += (x.x * x.x + x.y * x.y) + (x.z * x.z + x.w * x.w);
    acc[2 * k] = (f32x2){0.f, 0.f}; acc[2 * k + 1] = (f32x2){0.f, 0.f}; }
}
__device__ __forceinline__ void phase_exp_up2(const Args& a, unsigned char* lds, int wave, int lane) {
  unsigned char* ws = a.ws;
  const int* eidx = (const int*)(ws + WS_EIDX); const float* wgt = (const float*)(ws + WS_W);
  const unsigned char* ups = ws + WS_EXU;
  unsigned* L = (unsigned*)(lds + wave * 16640);
  const int g = lane >> 2, c = lane & 3;
  for (int blk = blockIdx.x; blk < NT / 128; blk += gridDim.x) {
    const int t0 = blk * 128 + wave * 16, t = t0 + g;
    unsigned* H = (unsigned*)(lds + 8 * 16640 + 1024) + wave * 256;
    __builtin_amdgcn_wave_barrier();
    for (int i = lane; i < 256; i += 64) H[i] = 0u;
    __builtin_amdgcn_wave_barrier();
#pragma unroll 4
    for (int tk = 0; tk < 16; ++tk) {
      const size_t o = (size_t)(t0 + tk) * 128;
      const unsigned ea = (unsigned)eidx[o + lane], eb = (unsigned)eidx[o + 64 + lane];
      const unsigned wa = __float_as_uint(wgt[o + lane]), wb = __float_as_uint(wgt[o + 64 + lane]);
      const unsigned ba = ea >> 10, bb = eb >> 10;
      const unsigned ra = atomicAdd(&H[tk * 16 + ba], 1u), rb = atomicAdd(&H[tk * 16 + bb], 1u);
      __builtin_amdgcn_wave_barrier();
      unsigned pa = ra, pb = rb;
#pragma unroll
      for (unsigned b = 0; b < 16; ++b) { const unsigned hb = H[tk * 16 + b]; pa += (b < ba) ? hb : 0u; pb += (b < bb) ? hb : 0u; }
      L[tk * 260 + pa] = ea; L[tk * 260 + 128 + pa] = wa; L[tk * 260 + pb] = eb; L[tk * 260 + 128 + pb] = wb;
    }
    __builtin_amdgcn_wave_barrier();
    const unsigned* Lg = L + g * 260;
    f32x2 acc[16]; float ssum = 0.f;
#pragma unroll
    for (int i = 0; i < 16; ++i) acc[i] = (f32x2){0.f, 0.f};
    UpBuf A, B;
    up2_load(A, ups, Lg, 0, c);
#pragma unroll 1
    for (int ch = 0; ch < 128; ch += 2) {
      up2_load(B, ups, Lg, ch + 1, c);
      up2_math(A, Lg, ch, acc);
      if (ch + 2 < 128) up2_load(A, ups, Lg, ch + 2, c);
      up2_math(B, Lg, ch + 1, acc);
      if ((ch & 15) == 14) up2_slice_end(a, t, ch >> 4, c, acc, ssum);
    }
    ssum += swz_xor<1>(ssum); ssum += swz_xor<2>(ssum);
    const float r2 = rsqrtf(ssum * (1.f / DM) + EPS);
    asm volatile("s_waitcnt vmcnt(0)" ::: "memory");
    __builtin_amdgcn_fence(__ATOMIC_ACQUIRE, "agent");
#pragma unroll 2
    for (int xs = 0; xs < 8; ++xs) {
      f32x4* xr = (f32x4*)(a.out + (size_t)t * DM + xs * 128 + c * 32); const f32x4* gp = (const f32x4*)(a.in[21] + xs * 128 + c * 32);
#pragma unroll
      for (int k = 0; k < 8; ++k) xr[k] = xr[k] * r2 * gp[k];
    }
  }
}

__device__ __forceinline__ void phase_final(const Args& a, int gw, int ngw, int lane) {
  const float* ss = (const float*)(a.ws + WS_SS3);
  for (int r = gw; r < NT; r += ngw) {
    const float r2 = rsqrtf(ss[r] * (1.f / DM) + EPS);
    f32x4* xr = (f32x4*)(a.out + (size_t)r * DM) + lane;
#pragma unroll
    for (int j = 0; j < 4; ++j) { const f32x4 g = ((const f32x4*)a.in[21])[64 * j + lane]; xr[64 * j] = xr[64 * j] * r2 * g; }
  }
}

namespace pg8 {
#define PG8_LAS __attribute__((address_space(3)))
typedef unsigned short bf16_t;
typedef short bf16x8 __attribute__((ext_vector_type(8)));
typedef float f32x4 __attribute__((ext_vector_type(4)));
typedef unsigned u32x4 __attribute__((ext_vector_type(4)));
constexpr int BM = 256, BK = 64, HALF = 128, HTB = HALF * BK * 2  , STAGE_BYTES = 8 * HTB, NXCD = 8, WGM = 8;

__host__ __device__ __forceinline__ int lds_byte(int r, int c) { const int st = (r >> 4) * 2 + (c >> 5), rr = r & 15, cc = c & 31, ob = rr * 64 + cc * 2; return st * 1024 + (ob ^ (((ob >> 9) & 1) << 5)); }
__host__ __device__ __forceinline__ void stage_rc(int b, int& R, int& C) { const int st = b / 1024, sb = b % 1024, swz = sb ^ (((sb >> 9) & 1) << 5); R = (st >> 1) * 16 + swz / 64; C = (st & 1) * 32 + (swz % 64) / 2; }
__host__ __device__ __forceinline__ int perm32(int rho) { const int n = rho >> 4, i = rho & 15; return 8 * (i >> 2) + 4 * n + (i & 3); }

struct Unit { int pm, pn; };
struct Gemm { const bf16_t* A; const bf16_t* Bt; int M, N, K; };

struct StaticOrder {
    int nM, nN, nwg, G, c;
    __host__ __device__ void init(int M, int N, int G_, int c_) { nM = M / BM; nN = N / BM; nwg = nM * nN; G = G_; c = c_; }
    __host__ __device__ bool next(int i, Unit& u) const {
        const long L = (long)i * G + c; if (L >= nwg) return false;
        int wgid = (int)L; { const int q = nwg / NXCD, r = nwg % NXCD, xcd = wgid % NXCD, off = wgid / NXCD; wgid = (xcd < r ? xcd * (q + 1) : r * (q + 1) + (xcd - r) * q) + off; }
        const int nig = WGM * nN, gid = wgid / nig, fm = gid * WGM, gsz = (nM - fm) < WGM ? (nM - fm) : WGM;
        u.pm = fm + ((wgid % nig) % gsz); u.pn = (wgid % nig) / gsz; return true;
    }
    __device__ __forceinline__ void a_ready(const Unit&) const {}
    __device__ __forceinline__ void done(const Unit&) const {}
};

template <class St> struct EpiAdapt8 {
    static constexpr bool PERM = true, AFTER_DRAIN = false; St st;
    __device__ __forceinline__ void operator()(const f32x4 (&acc)[2][2][4][2], const Unit& u, int wr, int wc, int fr, int fq) const {
#pragma unroll
        for (int ai = 0; ai < 2; ++ai)
#pragma unroll
            for (int m = 0; m < 4; ++m)
#pragma unroll
                for (int bj = 0; bj < 2; ++bj) st.store8(u.pm * BM + ai * HALF + wr * 64 + m * 16 + fr, u.pn * BM + bj * HALF + wc * 32 + 8 * fq, acc[ai][bj][m][0], acc[ai][bj][m][1]);
    }
};
template <class St> struct EpiAdapt {
    static constexpr bool PERM = false, AFTER_DRAIN = false; St st;
    __device__ __forceinline__ void operator()(const f32x4 (&acc)[2][2][4][2], const Unit& u, int wr, int wc, int fr, int fq) const {
#pragma unroll
        for (int ai = 0; ai < 2; ++ai)
#pragma unroll
            for (int m = 0; m < 4; ++m)
#pragma unroll
                for (int bj = 0; bj < 2; ++bj)
#pragma unroll
                    for (int n = 0; n < 2; ++n) st.store(u.pm * BM + ai * HALF + wr * 64 + m * 16 + fr, u.pn * BM + bj * HALF + wc * 32 + n * 16 + 4 * fq, acc[ai][bj][m][n]);
    }
};

struct EpiResidSS {
    static constexpr bool PERM = true, AFTER_DRAIN = false; const float* base; float* out; bf16_t* hb; float* ss;
    __device__ __forceinline__ void operator()(const f32x4 (&acc)[2][2][4][2], const Unit& u, int wr, int wc, int fr, int fq) const {
#pragma unroll
        for (int ai = 0; ai < 2; ++ai)
#pragma unroll
            for (int m = 0; m < 4; ++m) {
                const int row = u.pm * BM + ai * HALF + wr * 64 + m * 16 + fr; float s = 0.f;
#pragma unroll
                for (int bj = 0; bj < 2; ++bj) {
                    const size_t o = (size_t)row * 1024 + u.pn * BM + bj * HALF + wc * 32 + 8 * fq;
                    const f32x4 v0 = *(const f32x4*)(base + o) + acc[ai][bj][m][0], v1 = *(const f32x4*)(base + o + 4) + acc[ai][bj][m][1];
                    *(f32x4*)(out + o) = v0; *(f32x4*)(out + o + 4) = v1;
                    { const float f0 = v0.x, f1 = v0.y, f2 = v0.z, f3 = v0.w, f4 = v1.x, f5 = v1.y, f6 = v1.z, f7 = v1.w;
                      *(u32x4*)(hb + o) = (u32x4){::pk2(f0, f1), ::pk2(f2, f3), ::pk2(f4, f5), ::pk2(f6, f7)}; }
                    s += (v0.x * v0.x + v0.y * v0.y) + (v0.z * v0.z + v0.w * v0.w) + (v1.x * v1.x + v1.y * v1.y) + (v1.z * v1.z + v1.w * v1.w);
                }
                s += __shfl_xor(s, 16); s += __shfl_xor(s, 32);
                if (fq == 0) atomicAdd(ss + row, s);
            }
    }
};
template <class Epi, class Sched, bool ALIGN_EPI = false, bool SP2 = false>
__device__ __forceinline__ void gemm_phase(PG8_LAS unsigned char* lds, const Gemm g, const Sched& S, const Epi& E) {
    const int tid = threadIdx.x, wid = __builtin_amdgcn_readfirstlane(tid >> 6), lane = tid & 63, wr = wid >> 2, wc = wid & 3, fr = lane & 15, fq = lane >> 4;
    const int K = g.K, nt = K / BK;
    unsigned voffA[2], voffB[2];
#pragma unroll
    for (int i = 0; i < 2; ++i) { int R, C; stage_rc(tid * 16 + i * 8192, R, C); const int Rb = Epi::PERM ? ((R & ~31) + perm32(R & 31)) : R;
        voffA[i] = (unsigned)(R * K + C) * 2u; voffB[i] = (unsigned)(Rb * K + C) * 2u; }
    const size_t kstep = (size_t)(BK * 2);
    const size_t hstep = (size_t)HALF * K * 2;
    const size_t tstep = 2 * hstep;
    const unsigned ldsw = (unsigned)wid * 1024u;
    const int aoff = lds_byte(wr * 64 + fr, fq * 8), boff = lds_byte(wc * 32 + fr, fq * 8);
#define PG8_SA(b, h) (((b) * 2 + (h)) * HTB)
#define PG8_SB(b, h) ((4 + (b) * 2 + (h)) * HTB)
#define PG8_STAGE(bufoff, gbase, voff) do { _Pragma("unroll") for (int _i = 0; _i < 2; ++_i) \
        __builtin_amdgcn_global_load_lds((const unsigned*)((const char*)(gbase) + (voff)[_i]), (PG8_LAS unsigned*)(lds + (bufoff) + ldsw + _i * 8192), 16, 0, 0); } while (0)
#define PG8_LDA(dst, b, h) do { _Pragma("unroll") for (int m = 0; m < 4; ++m) _Pragma("unroll") for (int k = 0; k < 2; ++k) dst[m][k] = *(const PG8_LAS bf16x8*)(lds + PG8_SA(b, h) + aoff + m * 2048 + k * 1024); } while (0)
#define PG8_LDB(dst, b, h) do { _Pragma("unroll") for (int n = 0; n < 2; ++n) _Pragma("unroll") for (int k = 0; k < 2; ++k) dst[n][k] = *(const PG8_LAS bf16x8*)(lds + PG8_SB(b, h) + boff + n * 2048 + k * 1024); } while (0)
#define PG8_MMA(ai, bj, At, Bt) do { __builtin_amdgcn_s_setprio(1); _Pragma("unroll") for (int m = 0; m < 4; ++m) _Pragma("unroll") for (int n = 0; n < 2; ++n) _Pragma("unroll") for (int k = 0; k < 2; ++k) \
        acc[ai][bj][m][n] = __builtin_amdgcn_mfma_f32_16x16x32_bf16(Bt[n][k], At[m][k], acc[ai][bj][m][n], 0, 0, 0); __builtin_amdgcn_s_setprio(0); } while (0)
#define PG8_WAIT_V(n) asm volatile("s_waitcnt vmcnt(" #n ")" ::: "memory")
#define PG8_WAIT_L(n) asm volatile("s_waitcnt lgkmcnt(" #n ")" ::: "memory")
#define PG8_BAR __builtin_amdgcn_s_barrier()
#define PG8_SCHED __builtin_amdgcn_sched_barrier(0)
    Unit cur, nxt; int ui = 0;
    if (!S.next(0, cur)) return;
    f32x4 acc[2][2][4][2];
#pragma unroll
    for (int a = 0; a < 2; ++a)
#pragma unroll
        for (int b = 0; b < 2; ++b)
#pragma unroll
            for (int m = 0; m < 4; ++m)
#pragma unroll
                for (int n = 0; n < 2; ++n) acc[a][b][m][n] = (f32x4){0.f, 0.f, 0.f, 0.f};
    bf16x8 At[4][2], B0[2][2], B1[2][2];
    const char* cA = (const char*)g.A + (size_t)cur.pm * tstep; const char* cB = (const char*)g.Bt + (size_t)cur.pn * tstep;
    S.a_ready(cur);
    if constexpr (SP2) {
        PG8_STAGE(PG8_SB(0, 0), cB, voffB); PG8_STAGE(PG8_SB(0, 1), cB + hstep, voffB); PG8_STAGE(PG8_SA(0, 0), cA, voffA); PG8_STAGE(PG8_SA(0, 1), cA + hstep, voffA);
        if (wr == 1) PG8_BAR;
        PG8_WAIT_V(2); PG8_BAR;
        PG8_STAGE(PG8_SB(1, 0), cB + kstep, voffB); PG8_STAGE(PG8_SA(1, 0), cA + kstep, voffA); PG8_STAGE(PG8_SB(1, 1), cB + hstep + kstep, voffB);
        PG8_WAIT_V(6); PG8_BAR;
    } else {
        PG8_STAGE(PG8_SB(0, 0), cB, voffB); PG8_STAGE(PG8_SA(0, 0), cA, voffA); PG8_STAGE(PG8_SB(0, 1), cB + hstep, voffB); PG8_STAGE(PG8_SA(0, 1), cA + hstep, voffA);
        if (wr == 1) PG8_BAR;
        PG8_WAIT_V(4); PG8_BAR;
        PG8_STAGE(PG8_SB(1, 0), cB + kstep, voffB); PG8_STAGE(PG8_SA(1, 0), cA + kstep, voffA); PG8_STAGE(PG8_SB(1, 1), cB + hstep + kstep, voffB);
        PG8_WAIT_V(6); PG8_BAR;
    }
    for (;;) {
        const bool has_next = S.next(ui + 1, nxt);
        const char* nA = has_next ? (const char*)g.A + (size_t)nxt.pm * tstep : cA; const char* nB = has_next ? (const char*)g.Bt + (size_t)nxt.pn * tstep : cB;
        for (int t = 0; t < nt; t += 2) {
            const bool last = (t == nt - 2);
            const char* a1 = cA + (size_t)(t + 1) * kstep;
            const char* a2 = last ? nA : cA + (size_t)(t + 2) * kstep; const char* b2 = last ? nB : cB + (size_t)(t + 2) * kstep;
            const char* a3 = a2 + kstep; const char* b3 = b2 + kstep;
            if (last && has_next) S.a_ready(nxt);
            if constexpr (SP2) {
            PG8_LDB(B0, 0, 0); PG8_LDB(B1, 0, 1); PG8_SCHED; PG8_LDA(At, 0, 0); PG8_STAGE(PG8_SA(1, 1), a1 + hstep, voffA);
            PG8_WAIT_V(8); PG8_WAIT_L(0); PG8_BAR; PG8_MMA(0, 0, At, B0); PG8_MMA(0, 1, At, B1); PG8_BAR; PG8_SCHED;
            PG8_LDA(At, 0, 1); PG8_STAGE(PG8_SB(0, 0), b2, voffB); PG8_STAGE(PG8_SB(0, 1), b2 + hstep, voffB); PG8_STAGE(PG8_SA(0, 0), a2, voffA);
            PG8_WAIT_V(8); PG8_WAIT_L(0); PG8_BAR; PG8_MMA(1, 0, At, B0); PG8_MMA(1, 1, At, B1); PG8_BAR; PG8_SCHED;
            PG8_LDB(B0, 1, 0); PG8_LDB(B1, 1, 1); PG8_SCHED; PG8_LDA(At, 1, 0); PG8_STAGE(PG8_SA(0, 1), a2 + hstep, voffA);
            PG8_WAIT_V(8); PG8_WAIT_L(0); PG8_BAR; PG8_MMA(0, 0, At, B0); PG8_MMA(0, 1, At, B1); PG8_BAR; PG8_SCHED;
            PG8_LDA(At, 1, 1); PG8_STAGE(PG8_SB(1, 0), b3, voffB); PG8_STAGE(PG8_SB(1, 1), b3 + hstep, voffB); PG8_STAGE(PG8_SA(1, 0), a3, voffA);
            PG8_WAIT_V(8); PG8_WAIT_L(0); PG8_BAR; PG8_MMA(1, 0, At, B0); PG8_MMA(1, 1, At, B1); PG8_BAR; PG8_SCHED;
            } else {
            PG8_LDB(B0, 0, 0); PG8_SCHED; PG8_LDA(At, 0, 0); PG8_STAGE(PG8_SA(1, 1), a1 + hstep, voffA);
            PG8_WAIT_L(8); PG8_BAR; PG8_WAIT_L(0); PG8_MMA(0, 0, At, B0); PG8_BAR; PG8_SCHED;
            PG8_LDB(B1, 0, 1); PG8_STAGE(PG8_SB(0, 0), b2, voffB);
            PG8_BAR; PG8_WAIT_L(0); PG8_MMA(0, 1, At, B1); PG8_BAR;
            PG8_LDA(At, 0, 1); PG8_STAGE(PG8_SA(0, 0), a2, voffA);
            PG8_BAR; PG8_WAIT_L(0); PG8_MMA(1, 0, At, B0); PG8_BAR; PG8_SCHED;
            PG8_STAGE(PG8_SB(0, 1), b2 + hstep, voffB);
            PG8_WAIT_V(6); PG8_BAR; PG8_MMA(1, 1, At, B1); PG8_BAR;
            PG8_LDB(B0, 1, 0); PG8_SCHED; PG8_LDA(At, 1, 0); PG8_STAGE(PG8_SA(0, 1), a2 + hstep, voffA);
            PG8_WAIT_L(8); PG8_BAR; PG8_WAIT_L(0); PG8_MMA(0, 0, At, B0); PG8_BAR; PG8_SCHED;
            PG8_LDB(B1, 1, 1); PG8_STAGE(PG8_SB(1, 0), b3, voffB);
            PG8_BAR; PG8_WAIT_L(0); PG8_MMA(0, 1, At, B1); PG8_BAR;
            PG8_LDA(At, 1, 1); PG8_STAGE(PG8_SA(1, 0), a3, voffA);
            PG8_BAR; PG8_WAIT_L(0); PG8_MMA(1, 0, At, B0); PG8_BAR; PG8_SCHED;
            PG8_STAGE(PG8_SB(1, 1), b3 + hstep, voffB);
            PG8_WAIT_V(6); PG8_BAR; PG8_MMA(1, 1, At, B1); PG8_BAR;
            }
        }
        if constexpr (ALIGN_EPI) { if (wr == 0) PG8_BAR; }
        if constexpr (!Epi::AFTER_DRAIN) { E(acc, cur, wr, wc, fr, fq); S.done(cur); }
        if (!has_next) break;
#pragma unroll
        for (int a = 0; a < 2; ++a)
#pragma unroll
            for (int b = 0; b < 2; ++b)
#pragma unroll
                for (int m = 0; m < 4; ++m)
#pragma unroll
                    for (int n = 0; n < 2; ++n) acc[a][b][m][n] = (f32x4){0.f, 0.f, 0.f, 0.f};
        cur = nxt; cA = nA; cB = nB; ++ui;
        if constexpr (ALIGN_EPI) { if (wr == 1) PG8_BAR; }
    }
    PG8_WAIT_V(0);
    if constexpr (!ALIGN_EPI) { if (wr == 0) PG8_BAR; }
    PG8_BAR;
    if constexpr (Epi::AFTER_DRAIN) { E.fused(acc, cur, wr, wc, fr, fq, lds, wid, lane); S.done(cur); }
#undef PG8_SA
#undef PG8_SB
#undef PG8_STAGE
#undef PG8_LDA
#undef PG8_LDB
#undef PG8_MMA
#undef PG8_WAIT_V
#undef PG8_WAIT_L
#undef PG8_BAR
#undef PG8_SCHED
}
}


template <class Epi>
__device__ __forceinline__ void run_gemm_raw(unsigned char* lds, const bf16_t* A, const bf16_t* Bt, int M, int N, int K, const Epi& E) {
  pg8::Gemm g{A, Bt, M, N, K}; pg8::StaticOrder S; S.init(M, N, (int)gridDim.x, (int)blockIdx.x);
  pg8::gemm_phase<Epi, pg8::StaticOrder, true, true>((PG8_LAS unsigned char*)lds, g, S, E);
}
template <class St>
__device__ __forceinline__ void run_gemm8(unsigned char* lds, const bf16_t* A, const bf16_t* Bt, int M, int N, int K, const St& st) {
  pg8::Gemm g{A, Bt, M, N, K}; pg8::StaticOrder S; S.init(M, N, (int)gridDim.x, (int)blockIdx.x);
  pg8::EpiAdapt8<St> E{st};
  pg8::gemm_phase<pg8::EpiAdapt8<St>, pg8::StaticOrder, true, true>((PG8_LAS unsigned char*)lds, g, S, E);
}
template <class St>
__device__ __forceinline__ void run_gemm(unsigned char* lds, const bf16_t* A, const bf16_t* Bt, int M, int N, int K, const St& st, int gw, int ngw, int lane) {
#if USE_PG8
  pg8::Gemm g{A, Bt, M, N, K}; pg8::StaticOrder S; S.init(M, N, (int)gridDim.x, (int)blockIdx.x);
  pg8::EpiAdapt<St> E{st};
  pg8::gemm_phase<pg8::EpiAdapt<St>, pg8::StaticOrder, true, true>((PG8_LAS unsigned char*)lds, g, S, E);
#else
  gemm_naive(A, K, Bt, K, M, N, K, st, gw, ngw, lane);
#endif
}

#define GAS __attribute__((address_space(1)))
#define LAS __attribute__((address_space(3)))
#define XB_TMO      128
#define XB_XCNT(j)  (256  + 64 * (j))
#define XB_XSUB(j)  (1280 + 64 * (j))
#define XB_XGEN(j)  (2304 + 64 * (j))
#define XB_TOP      3328
#define XB_TOPGEN   3392
#define XCD_BAR_WORDS 3456
#define XB_SPIN_CAP (1u << 18)

__device__ __forceinline__ unsigned xb_ld(unsigned* p)              { return __hip_atomic_load(p, __ATOMIC_RELAXED, __HIP_MEMORY_SCOPE_AGENT); }
__device__ __forceinline__ unsigned xb_add(unsigned* p, unsigned v) { return __hip_atomic_fetch_add(p, v, __ATOMIC_RELAXED, __HIP_MEMORY_SCOPE_AGENT); }
__device__ __forceinline__ unsigned xb_xcc_id() { return (unsigned)__builtin_amdgcn_s_getreg((3 << 11) | 20) & 0xFu; }
#define XB_SPIN(cond, bar) do { unsigned _sp = 0; while (cond) { __builtin_amdgcn_s_sleep(1); \
    if ((++_sp & 255u) == 0u) { if (xb_ld(&(bar)[XB_TMO])) break; if (_sp > XB_SPIN_CAP) { atomicAdd(&(bar)[XB_TMO], 1u); break; } } } } while (0)

struct XcdBarrier {
    unsigned* bar; unsigned x;
    volatile LAS unsigned* st;
};

__device__ __forceinline__ XcdBarrier xcd_barrier_post(unsigned* bar, volatile LAS unsigned* st) {
    XcdBarrier b; b.bar = bar; b.x = xb_xcc_id(); b.st = st;
    if (threadIdx.x == 0) (void)xb_add(&bar[XB_XCNT(b.x)], 1u);
    return b;
}
__device__ __forceinline__ void xcd_barrier_complete(unsigned* bar, unsigned x, unsigned& nloc, unsigned& nx) {
    const unsigned G = gridDim.x * gridDim.y * gridDim.z;
    unsigned sum, cnt, mine, sp = 0u;
    for (;;) {
        sum = 0u; cnt = 0u; mine = 0u;
#pragma unroll
        for (unsigned j = 0; j < 16; ++j) { const unsigned c = xb_ld(&bar[XB_XCNT(j)]); sum += c; cnt += (c > 0u) ? 1u : 0u; mine = (j == x) ? c : mine; }
        if (sum == G) break;
        __builtin_amdgcn_s_sleep(1);
        if ((++sp & 255u) == 0u) { if (xb_ld(&bar[XB_TMO])) break; if (sp > XB_SPIN_CAP) { atomicAdd(&bar[XB_TMO], 1u); break; } }
    }
    nloc = mine > 0u ? mine : 1u; nx = cnt > 0u ? cnt : 1u;
}

__device__ __forceinline__ void xcd_barrier(const XcdBarrier& b) {
    asm volatile("s_waitcnt vmcnt(0)" ::: "memory");
    __syncthreads();
    if (threadIdx.x == 0) {
        unsigned* bar = b.bar;
        __builtin_amdgcn_s_waitcnt(0);
        unsigned nloc = b.st[0], nx = b.st[1];
        if (nloc == 0u) { xcd_barrier_complete(bar, b.x, nloc, nx); b.st[0] = nloc; b.st[1] = nx; }
        const unsigned old = xb_add(&bar[XB_XSUB(b.x)], 1u);
        const unsigned gen = old / nloc;
        if (old + 1u == (gen + 1u) * nloc) {
            __builtin_amdgcn_fence(__ATOMIC_RELEASE, "agent");
            asm volatile("s_waitcnt vmcnt(0)" ::: "memory");
            const unsigned og = xb_add(&bar[XB_TOP], 1u);
            const unsigned tg = og / nx;
            if (og + 1u == (tg + 1u) * nx) xb_add(&bar[XB_TOPGEN], 1u);
            else XB_SPIN(xb_ld(&bar[XB_TOPGEN]) == tg, bar);
            __builtin_amdgcn_fence(__ATOMIC_ACQUIRE, "agent");
            xb_add(&bar[XB_XGEN(b.x)], 1u);
            asm volatile("s_waitcnt vmcnt(0)" ::: "memory");
        } else {
            XB_SPIN(xb_ld(&bar[XB_XGEN(b.x)]) == gen, bar);
            __builtin_amdgcn_fence(__ATOMIC_ACQUIRE, "agent");
            asm volatile("s_waitcnt vmcnt(0)" ::: "memory");
        }
    }
    __syncthreads();
}

__device__ __forceinline__ void phase_exp_up(const Args& a, unsigned char* lds, const XcdBarrier& bar, int tid, int wave, int lane, unsigned* ctr, float* xout, float* ssout) {
  unsigned* slot = (unsigned*)(lds + 8 * 16640);
  const int x0 = (int)(xb_xcc_id() & 7u);
  for (int k = 0; k < 8; ++k) {
    const int xs = (x0 + k) & 7;
    for (;;) {
      __syncthreads();
      if (tid == 0) slot[0] = atomicAdd(ctr + 16 * xs, 1u);
      __syncthreads();
      const unsigned item = slot[0];
      if (item >= (unsigned)(NT / 128)) break;
      exp_up_item(a, lds, xs, (int)item, wave, lane, xout, ssout);
    }
  }
}

__device__ __forceinline__ void phase_xattn3(const Args& a, unsigned char* lds, int tid) {
  pg8::StaticOrder S; S.init(NT, DM, (int)gridDim.x, (int)blockIdx.x); pg8::Unit u;
  for (int i = 0; S.next(i, u); ++i) xa::unit(a, lds, u.pm >> 4, u.pn, u.pm & 15, tid);
}

__global__ void __launch_bounds__(512, 2) mega(Args a) {
  extern __shared__ __attribute__((aligned(16))) unsigned char lds[];
  cg::grid_group grid = cg::this_grid();
  const int tid = threadIdx.x, lane = tid & 63, wave = tid >> 6;
  const int gw = blockIdx.x * 8 + wave, ngw = gridDim.x * 8;
  unsigned char* ws = a.ws;
  const int lo = a.ph_lo, hi = a.ph_hi;
#define IN(k) (lo <= (k) && (k) < hi)
  volatile LAS unsigned* MISC = (volatile LAS unsigned*)((LAS unsigned char*)lds + 146944);
  if (tid < 32) MISC[tid] = 0u;
  __syncthreads();
  XcdBarrier bar; bar.bar = (unsigned*)(ws + WS_BAR); bar.x = 0; bar.st = nullptr;
  if (hi - lo > 1) bar = xcd_barrier_post((unsigned*)(ws + WS_BAR), MISC + 8);
  if (lo < -1000000) grid.sync();
#define SEAM(k) do { if (IN(k) && IN((k) + 1)) xcd_barrier(bar); } while (0)
#if PROBE_REP == 0
  if (IN(0)) { phase_prep(a, lds, gw, ngw, wave, lane, tid); grid.sync(); }
#endif
  if (IN(0)) { phase_prep(a, lds, gw, ngw, wave, lane, tid); } SEAM(0);
#if PROBE_REP == 1
  if (IN(1)) {
    run_gemm8(lds, (const bf16_t*)(ws + WS_HB), (const bf16_t*)(ws + WS_WIN_T), NT, NQKV, DM, EpiQKV{(bf16_t*)(ws + WS_QKV)});
    run_gemm8(lds, (const bf16_t*)(ws + WS_MEMN), (const bf16_t*)(ws + WS_WXKV_T), NMROWS, 2048, DM, EpiBf16{(bf16_t*)(ws + WS_KX), 2048});
    xcd_barrier(bar); }
#endif
#if PROBE_REP == 2
  if (IN(2)) { phase_scan(a, gw, ngw, lane, tid); xcd_barrier(bar); phase_rms(a, gw, ngw, lane); xcd_barrier(bar); phase_rms(a, gw, ngw, lane); xcd_barrier(bar); }
#endif
  if (IN(1)) {
    run_gemm8(lds, (const bf16_t*)(ws + WS_HB), (const bf16_t*)(ws + WS_WIN_T), NT, NQKV, DM, EpiQKV{(bf16_t*)(ws + WS_QKV)});
    run_gemm8(lds, (const bf16_t*)(ws + WS_MEMN), (const bf16_t*)(ws + WS_WXKV_T), NMROWS, 2048, DM, EpiBf16{(bf16_t*)(ws + WS_KX), 2048});
  } SEAM(1);
  if (IN(2)) { for (int rep = 0; rep < a.rep_scan; ++rep) { phase_scan(a, gw, ngw, lane, tid); if (rep + 1 < a.rep_scan) xcd_barrier(bar); } } SEAM(2);
#if PROBE_REP == 3
  if (IN(3)) { phase_attn2(a, lds, tid); xcd_barrier(bar); if (blockIdx.x == 0 && tid == 0) *(unsigned*)(ws) = 0u; xcd_barrier(bar); }
#endif
  if (IN(3)) {
#if USE_ATT2
    phase_attn2(a, lds, tid);
#else
    phase_attn(a, lds, tid);
#endif
  } SEAM(3);
  if (IN(4)) { phase_onorm(a, gw, ngw, lane); } SEAM(4);
  if (IN(5)) { run_gemm_raw(lds, (const bf16_t*)(ws + WS_OAB), (const bf16_t*)(ws + WS_WOUT_T), NT, DM, DM, pg8::EpiResidSS{a.in[0], a.out, (bf16_t*)(ws + WS_HB), (float*)(ws + WS_SS1)}); }
  if (IN(5) && IN(7)) xcd_barrier(bar);
  if (IN(7)) { run_gemm8(lds, (const bf16_t*)(ws + WS_HB), (const bf16_t*)(ws + WS_WXQ_T), NT, DM, DM, EpiBf16S{(bf16_t*)(ws + WS_QX), DM, (const float*)(ws + WS_SS1)}); }
  if (IN(7) && IN(8)) { asm volatile("s_waitcnt vmcnt(0)" ::: "memory"); __syncthreads(); if (tid == 0) { __builtin_amdgcn_fence(__ATOMIC_ACQUIRE, "agent"); asm volatile("s_waitcnt vmcnt(0)" ::: "memory"); } __syncthreads(); }
#if PROBE_REP == 8
  if (IN(8)) { phase_xattn(a, lds, gw, ngw, wave, lane); grid.sync(); }
#endif
  if (IN(8)) { phase_xattn3(a, lds, tid); } SEAM(8);
  if (IN(9)) { run_gemm_raw(lds, (const bf16_t*)(ws + WS_OX), (const bf16_t*)(ws + WS_WXO_T), NT, DM, DM, pg8::EpiResidSS{a.out, a.out, (bf16_t*)(ws + WS_HB), (float*)(ws + WS_SS2)}); }
  if (IN(9) && IN(11)) xcd_barrier(bar);
  if (IN(11)) { run_gemm8(lds, (const bf16_t*)(ws + WS_HB), (const bf16_t*)(ws + WS_WPQ_T), NT, DM, DM, EpiBf16S{(bf16_t*)(ws + WS_PQ), DM, (const float*)(ws + WS_SS2)}); } SEAM(11);
#if PROBE_REP == 12
  if (IN(12)) { phase_topk(a, lds, tid); grid.sync(); }
#endif
  if (IN(12)) { phase_topk2(a, lds, wave, lane); }
  if (IN(12) && IN(13)) { asm volatile("s_waitcnt vmcnt(0)" ::: "memory"); __syncthreads(); if (tid == 0) { __builtin_amdgcn_fence(__ATOMIC_ACQUIRE, "agent"); asm volatile("s_waitcnt vmcnt(0)" ::: "memory"); } __syncthreads(); }
    if (IN(13)) {
    for (int rep = 0; rep < a.rep_down; ++rep) phase_exp_down(a, wave, lane);
    asm volatile("s_waitcnt vmcnt(0)" ::: "memory"); __builtin_amdgcn_fence(__ATOMIC_ACQUIRE, "agent");
    phase_exp_up2(a, lds, wave, lane);
  }
#undef IN
#undef SEAM
}

extern "C" void kernel_launch(void* const* d_in, const int* in_sizes, int n_in, void* d_out, int out_size, void* d_ws, size_t ws_size, hipStream_t stream) {
  static int grid = 0;
  if (grid == 0) {
    if (n_in != 22 || out_size != NT * DM || ws_size < WS_END) { fprintf(stderr, "kernel_launch: unexpected shapes (n_in %d out %d ws %zu)\n", n_in, out_size, ws_size); grid = -1; return; }
    int dev = 0, cus = 0, per_cu = 0;
    (void)hipGetDevice(&dev);
    (void)hipDeviceGetAttribute(&cus, hipDeviceAttributeMultiprocessorCount, dev);
    (void)hipFuncSetAttribute((const void*)mega, hipFuncAttributeMaxDynamicSharedMemorySize, LDS_BYTES);
    (void)hipOccupancyMaxActiveBlocksPerMultiprocessor(&per_cu, (const void*)mega, 512, LDS_BYTES);
    if (per_cu < 1) per_cu = 1;
    grid = cus * per_cu;
  }
  if (grid < 0) return;
  (void)hipMemsetAsync(d_ws, 0, CTL_ZERO_BYTES, stream);
  Args a{};
  for (int i = 0; i < 22; ++i) a.in[i] = (const float*)d_in[i];
  a.out = (float*)d_out; a.ws = (unsigned char*)d_ws;
  a.rep_down = REP_DOWN; a.rep_up = REP_UP; a.rep_scan = REP_SCAN;
#if MK_N_LAUNCHES == 1
  a.ph_lo = 0; a.ph_hi = NPHASE + 1;
  void* args[] = {&a};
  hipError_t e = hipLaunchCooperativeKernel((const void*)mega, dim3(grid), dim3(512), args, LDS_BYTES, stream);
  if (e != hipSuccess) fprintf(stderr, "cooperative launch failed: %s (grid %d)\n", hipGetErrorString(e), grid);
#else
  for (int p = 0; p <= NPHASE; ++p) { a.ph_lo = p; a.ph_hi = p + 1; hipLaunchKernelGGL(mega, dim3(grid), dim3(512), LDS_BYTES, stream, a); }
#endif
}
```

```cpp
#include <hip/hip_runtime.h>
#include <hip/hip_cooperative_groups.h>
#include <cstdio>
#include <cstdint>
namespace cg = cooperative_groups;

#ifndef USE_PG8
#define USE_PG8 1
#endif
#ifndef USE_ATT2
#define USE_ATT2 1
#endif
#ifndef PROBE_REP
#define PROBE_REP -1
#endif
#ifndef REP_DOWN
#define REP_DOWN 1
#endif
#ifndef REP_UP
#define REP_UP 1
#endif
#ifndef REP_SCAN
#define REP_SCAN 1
#endif
#ifndef MK_N_LAUNCHES
#define MK_N_LAUNCHES 1
#endif

typedef unsigned short bf16_t;
typedef short bf16x8 __attribute__((ext_vector_type(8)));
typedef float f32x4 __attribute__((ext_vector_type(4)));
typedef unsigned u32x4 __attribute__((ext_vector_type(4)));
typedef unsigned u32x2 __attribute__((ext_vector_type(2)));
typedef float v32f __attribute__((ext_vector_type(32)));
typedef float v16f __attribute__((ext_vector_type(16)));
typedef unsigned v6u __attribute__((ext_vector_type(6)));
typedef float f32x2 __attribute__((ext_vector_type(2)));

constexpr int NB = 8, SEQ = 4096, DM = 1024, NT = NB * SEQ;
constexpr int NQKV = 3072, INW = 3080;
constexpr int NMEM = 256, NMROWS = NB * NMEM;
constexpr int NEXP = 16384;
constexpr float EPS = 1e-6f;
constexpr int NPHASE = 13;
constexpr int LDS_BYTES = 147456;

constexpr size_t MiB = 1u << 20;
constexpr size_t WS_BAR = 65536;
constexpr size_t WS_SS1 = 131072;
constexpr size_t WS_SS2 = 262144;
constexpr size_t WS_SS3 = 393216;
constexpr size_t WS_XCTR = 512;
constexpr size_t WS_SSO = 524288;
constexpr size_t CTL_ZERO_BYTES = 1048576;
constexpr size_t WS_WIN_T = 2 * MiB;
constexpr size_t WS_WOUT_T = 8 * MiB;
constexpr size_t WS_WXQ_T = 10 * MiB;
constexpr size_t WS_WXKV_T = 12 * MiB;
constexpr size_t WS_WXO_T = 16 * MiB;
constexpr size_t WS_WPQ_T = 18 * MiB;
constexpr size_t WS_SK = 21 * MiB;
constexpr size_t WS_MEMN = 22 * MiB;
constexpr size_t WS_KX = 26 * MiB;
constexpr size_t WS_VXT = 30 * MiB;
constexpr size_t WS_FLOG = 34 * MiB;
constexpr size_t WS_CUM = 35 * MiB;
constexpr size_t WS_KMEAN = 786432;
constexpr size_t WS_ESC = 38 * MiB;
constexpr size_t WS_EXD = 40 * MiB;
constexpr size_t WS_EXU = 72 * MiB;
constexpr size_t WS_HB = 104 * MiB;
constexpr size_t WS_QKV = 168 * MiB;
constexpr size_t WS_OAB = 360 * MiB;
constexpr size_t WS_QX = 168 * MiB;
constexpr size_t WS_OX = 232 * MiB;
constexpr size_t WS_PQ = 232 * MiB;
constexpr size_t WS_EIDX = 424 * MiB;
constexpr size_t WS_GATE = 440 * MiB;
constexpr size_t WS_W = 456 * MiB;
constexpr size_t WS_END = 472 * MiB;

struct Args {
  const float* in[22];
  float* out;
  unsigned char* ws;
  int ph_lo, ph_hi;
  int rep_down, rep_up, rep_scan, pad_;
};

struct XcdBarrier;
__device__ __forceinline__ unsigned f2bf(float f) { unsigned u = __float_as_uint(f); return (u + 0x7fffu + ((u >> 16) & 1u)) >> 16; }
__device__ __forceinline__ unsigned pk2(float lo, float hi) { return f2bf(lo) | (f2bf(hi) << 16); }
__device__ __forceinline__ float bf2f(unsigned short b) { return __uint_as_float(((unsigned)b) << 16); }
__device__ __forceinline__ float bflo(unsigned w) { return __uint_as_float(w << 16); }
__device__ __forceinline__ float bfhi(unsigned w) { return __uint_as_float(w & 0xffff0000u); }
__device__ __forceinline__ float wave_sum(float v) {
#pragma unroll
  for (int o = 1; o < 64; o <<= 1) v += __shfl_xor(v, o);
  return v;
}
template <int O> __device__ __forceinline__ float swz_xor(float v) { return __int_as_float(__builtin_amdgcn_ds_swizzle(__float_as_int(v), (O << 10) | 0x1f)); }
__device__ __forceinline__ float half_sum32(float v) { v += swz_xor<1>(v); v += swz_xor<2>(v); v += swz_xor<4>(v); v += swz_xor<8>(v); v += swz_xor<16>(v); return v; }
__device__ __forceinline__ void unpack8(const u32x4 w, float* f) {
  f[0] = bflo(w.x); f[1] = bfhi(w.x); f[2] = bflo(w.y); f[3] = bfhi(w.y);
  f[4] = bflo(w.z); f[5] = bfhi(w.z); f[6] = bflo(w.w); f[7] = bfhi(w.w);
}

__device__ const unsigned char T5_BUCKET[128] = {
  0, 1, 2, 3, 4, 5, 6, 7, 8, 9, 10, 11, 12, 13, 14, 15, 16, 16, 16, 17, 17, 18, 18, 18, 19, 19, 19, 20, 20, 20, 20, 21,
  21, 21, 21, 22, 22, 22, 22, 22, 23, 23, 23, 23, 23, 23, 24, 24, 24, 24, 24, 24, 25, 25, 25, 25, 25, 25, 25, 26, 26, 26, 26, 26,
  26, 26, 26, 27, 27, 27, 27, 27, 27, 27, 27, 27, 27, 28, 28, 28, 28, 28, 28, 28, 28, 28, 28, 29, 29, 29, 29, 29, 29, 29, 29, 29,
  29, 29, 29, 30, 30, 30, 30, 30, 30, 30, 30, 30, 30, 30, 30, 30, 30, 31, 31, 31, 31, 31, 31, 31, 31, 31, 31, 31, 31, 31, 31, 31};

__device__ __forceinline__ void transpose_item(const float* W, int ldw, const float* gain, bf16_t* WT, int K, int row_off, float* scr, int kb, int nb, int lane) {
  const int k0 = 64 * kb, n0 = 32 * nb;
  const int c = lane & 7;
  float t[32];
  const float* wp = W + (size_t)(k0 + (lane >> 5)) * ldw + n0 + (lane & 31);
#pragma unroll
  for (int i = 0; i < 32; ++i) t[i] = wp[(size_t)(2 * i) * ldw];
  f32x4 g0 = (f32x4){1.f, 1.f, 1.f, 1.f}, g1 = g0;
  if (gain) { g0 = *(const f32x4*)(gain + k0 + 8 * c); g1 = *(const f32x4*)(gain + k0 + 8 * c + 4); }
#pragma unroll
  for (int i = 0; i < 32; ++i) scr[(2 * i + (lane >> 5)) * 33 + (lane & 31)] = t[i];
  __builtin_amdgcn_wave_barrier();
#pragma unroll
  for (int j = 0; j < 4; ++j) {
    const int n = (lane >> 3) + 8 * j; const float* s = scr + (8 * c) * 33 + n;
    u32x4 o; o.x = pk2(s[0 * 33] * g0.x, s[1 * 33] * g0.y); o.y = pk2(s[2 * 33] * g0.z, s[3 * 33] * g0.w); o.z = pk2(s[4 * 33] * g1.x, s[5 * 33] * g1.y); o.w = pk2(s[6 * 33] * g1.z, s[7 * 33] * g1.w);
    *(u32x4*)(WT + (size_t)(row_off + n0 + n) * K + k0 + 8 * c) = o;
  }
  __builtin_amdgcn_wave_barrier();
}

__device__ __forceinline__ void rms_row_to_bf16(const float* xrow, bf16_t* orow, int lane) {
  const f32x4* xr = (const f32x4*)xrow + lane;
  f32x4 v[4]; float s = 0.f;
#pragma unroll
  for (int j = 0; j < 4; ++j) { v[j] = xr[64 * j]; s += (v[j].x * v[j].x + v[j].y * v[j].y) + (v[j].z * v[j].z + v[j].w * v[j].w); }
  const float rstd = rsqrtf(wave_sum(s) * (1.f / DM) + EPS);
  u32x2* o = (u32x2*)orow + lane;
#pragma unroll
  for (int j = 0; j < 4; ++j) { u32x2 w; w.x = pk2(v[j].x * rstd, v[j].y * rstd); w.y = pk2(v[j].z * rstd, v[j].w * rstd); o[64 * j] = w; }
}

__device__ __forceinline__ void exp_item_load(f32x4 (&nx)[8], const Args& a, int it, int lane) {
  asm volatile("" : "+v"(lane));
  const int hi = lane >> 5, l32 = lane & 31; const int r = 2 * it + hi; const int tb = r >= NEXP, e = r - tb * NEXP;
  const f32x4* src = (const f32x4*)(a.in[19 + tb] + (size_t)e * DM) + 8 * l32;
#pragma unroll
  for (int k = 0; k < 8; ++k) nx[k] = src[k];
}
__device__ __forceinline__ void exp_item_finish(const f32x4 (&cur)[8], const Args& a, int it, int lane) {
  unsigned char* ws = a.ws;
  asm volatile("" : "+v"(lane));
  const int hi = lane >> 5, l32 = lane & 31; const int r = 2 * it + hi;
  const int tb = r >= NEXP, e = r - tb * NEXP;
    v16f xa, xb; float am = 0.f;
#pragma unroll
    for (int k = 0; k < 4; ++k) { f32x4 p = cur[k], q = cur[4 + k];
      if (tb == 0) { const f32x4* gp = (const f32x4*)a.in[15] + 8 * l32; p = p * gp[k]; q = q * gp[4 + k]; }
      xa[2 * k] = p.x; xb[2 * k] = p.y; xa[2 * k + 1] = p.z; xb[2 * k + 1] = p.w; xa[8 + 2 * k] = q.x; xb[8 + 2 * k] = q.y; xa[8 + 2 * k + 1] = q.z; xb[8 + 2 * k + 1] = q.w;
      am = fmaxf(am, fmaxf(fmaxf(fabsf(p.x), fabsf(p.y)), fmaxf(fabsf(p.z), fabsf(p.w)))); am = fmaxf(am, fmaxf(fmaxf(fabsf(q.x), fabsf(q.y)), fmaxf(fabsf(q.z), fabsf(q.w)))); }
#pragma unroll
    for (int o = 1; o < 32; o <<= 1) am = fmaxf(am, __shfl_xor(am, o));
    if (tb == 0) {
      const float sc = am > 0.f ? 7.0f / am : 1.f;
      xa = xa * sc; xb = xb * sc;
      const v6u w = __builtin_amdgcn_cvt_scalef32_2xpk16_fp6_f32(xa, xb, 1.0f);
      u32x2* dst = (u32x2*)(ws + WS_EXD + (size_t)e * 768 + 24 * l32);
      dst[0] = (u32x2){w[0], w[1]}; dst[1] = (u32x2){w[2], w[3]}; dst[2] = (u32x2){w[4], w[5]};
      if (l32 == 0) ((float*)(ws + WS_ESC))[r] = am > 0.f ? am / 7.0f : 1.f;
    } else {
      const float sc = am > 0.f ? 440.f / am : 1.f;
      u32x4 o0, o1;
#pragma unroll
      for (int k = 0; k < 4; ++k) { int w = __builtin_amdgcn_cvt_pk_fp8_f32(xa[2 * k] * sc, xb[2 * k] * sc, 0, false); w = __builtin_amdgcn_cvt_pk_fp8_f32(xa[2 * k + 1] * sc, xb[2 * k + 1] * sc, w, true); o0[k] = (unsigned)w; }
#pragma unroll
      for (int k = 0; k < 4; ++k) { int w = __builtin_amdgcn_cvt_pk_fp8_f32(xa[8 + 2 * k] * sc, xb[8 + 2 * k] * sc, 0, false); w = __builtin_amdgcn_cvt_pk_fp8_f32(xa[8 + 2 * k + 1] * sc, xb[8 + 2 * k + 1] * sc, w, true); o1[k] = (unsigned)w; }
      u32x4* dst = (u32x4*)(ws + WS_EXU + (size_t)(l32 >> 2) * (NEXP * 128) + (size_t)e * 128 + 32 * (l32 & 3));
      dst[0] = o0; dst[1] = o1;
      if (l32 == 0) ((float*)(ws + WS_ESC))[r] = am > 0.f ? am / 440.f : 1.f;
    }
}

__device__ __forceinline__ void phase_prep(const Args& a, unsigned char* lds, int gw, int ngw, int wave, int lane, int tid) {
  unsigned char* ws = a.ws;
  float* scr = (float*)(lds + wave * 8448);
  const int I_IN = 16 * 96, I_SQ = 16 * 32;
  const int NITEMS = I_IN + 6 * I_SQ;
  for (int it = gw; it < NITEMS; it += ngw) {
    int r = it;
    if (r < I_IN) { transpose_item(a.in[3], INW, a.in[2], (bf16_t*)(ws + WS_WIN_T), DM, 0, scr, r / 96, r % 96, lane); continue; } r -= I_IN;
    const int which = r / I_SQ; r %= I_SQ; const int kb = r / 32, nb = r % 32;
    if (which == 0) { const float* g = (kb < 8) ? a.in[6] : (a.in[7] - 512); transpose_item(a.in[8], DM, g, (bf16_t*)(ws + WS_WOUT_T), DM, 0, scr, kb, nb, lane); }
    else if (which == 1) transpose_item(a.in[11], DM, a.in[9], (bf16_t*)(ws + WS_WXQ_T), DM, 0, scr, kb, nb, lane);
    else if (which == 2) transpose_item(a.in[12], DM, a.in[10], (bf16_t*)(ws + WS_WXKV_T), DM, 0, scr, kb, nb, lane);
    else if (which == 3) transpose_item(a.in[13], DM, a.in[10], (bf16_t*)(ws + WS_WXKV_T), DM, 1024, scr, kb, nb, lane);
    else if (which == 4) transpose_item(a.in[14], DM, nullptr, (bf16_t*)(ws + WS_WXO_T), DM, 0, scr, kb, nb, lane);
    else transpose_item(a.in[16], DM, a.in[15], (bf16_t*)(ws + WS_WPQ_T), DM, 0, scr, kb, nb, lane);
  }
  for (int i = blockIdx.x * 512 + tid; i < 2 * 65536; i += gridDim.x * 512) ((bf16_t*)(ws + WS_SK))[i] = (bf16_t)f2bf(a.in[17 + (i >> 16)][i & 65535]);
  for (int r = gw; r < NMROWS; r += ngw) rms_row_to_bf16(a.in[1] + (size_t)r * DM, (bf16_t*)(ws + WS_MEMN) + (size_t)r * DM, lane);
  __syncthreads();
  float* wf = (float*)(lds + 69632);
  for (int k = tid; k < DM; k += 512) {
    const float g = a.in[2][k]; const f32x4* wp = (const f32x4*)(a.in[3] + (size_t)k * INW + NQKV);
    const f32x4 p = wp[0], q = wp[1];
    wf[k] = p.x * g; wf[1024 + k] = p.y * g; wf[2048 + k] = p.z * g; wf[3072 + k] = p.w * g; wf[4096 + k] = q.x * g; wf[5120 + k] = q.y * g; wf[6144 + k] = q.z * g; wf[7168 + k] = q.w * g;
  }
  __syncthreads();
  float* flog = (float*)(ws + WS_FLOG);
  const bool b5 = (lane & 32) != 0, b4 = (lane & 16) != 0, b3 = (lane & 8) != 0;
  for (int r = gw; r < NT; r += 2 * ngw) {
    const int r1 = r + ngw; const bool two = r1 < NT;
    const f32x4* xr0 = (const f32x4*)(a.in[0] + (size_t)r * DM) + lane; const f32x4* xr1 = (const f32x4*)(a.in[0] + (size_t)(two ? r1 : r) * DM) + lane;
    f32x4 va[4], vb[4];
#pragma unroll
    for (int j = 0; j < 4; ++j) { va[j] = xr0[64 * j]; vb[j] = xr1[64 * j]; }
#pragma unroll
    for (int h = 0; h < 2; ++h) {
      const f32x4 (&v)[4] = h ? vb : va; const int rr = h ? r1 : r;
      float s = 0.f; float fa[8];
#pragma unroll
      for (int j = 0; j < 8; ++j) fa[j] = 0.f;
#pragma unroll
      for (int j = 0; j < 4; ++j) {
        s += (v[j].x * v[j].x + v[j].y * v[j].y) + (v[j].z * v[j].z + v[j].w * v[j].w);
#pragma unroll
        for (int jj = 0; jj < 8; ++jj) { const f32x4 w4 = *(const f32x4*)(wf + jj * 1024 + 256 * j + 4 * lane); fa[jj] += (v[j].x * w4.x + v[j].y * w4.y) + (v[j].z * w4.z + v[j].w * w4.w); }
      }
      const float rstd = rsqrtf(wave_sum(s) * (1.f / DM) + EPS);
      float q4[4], q2[2];
#pragma unroll
      for (int j = 0; j < 4; ++j) q4[j] = (b5 ? fa[4 + j] : fa[j]) + __shfl_xor(b5 ? fa[j] : fa[4 + j], 32);
#pragma unroll
      for (int j = 0; j < 2; ++j) q2[j] = (b4 ? q4[2 + j] : q4[j]) + swz_xor<16>(b4 ? q4[j] : q4[2 + j]);
      float q1 = (b3 ? q2[1] : q2[0]) + swz_xor<8>(b3 ? q2[0] : q2[1]);
      q1 += swz_xor<4>(q1); q1 += swz_xor<2>(q1); q1 += swz_xor<1>(q1);
      if ((lane & 7) == 0 && (h == 0 || two)) {
        const int gj = lane >> 3;
        const float z = q1 * rstd + a.in[4][gj];
        flog[(size_t)gj * NT + rr] = fminf(z, 0.f) - log1pf(expf(-fabsf(z)));
      }
      if (h == 0 || two) {
        u32x2* o = (u32x2*)((bf16_t*)(ws + WS_HB) + (size_t)rr * DM) + lane;
#pragma unroll
        for (int j = 0; j < 4; ++j) { u32x2 w; w.x = pk2(v[j].x * rstd, v[j].y * rstd); w.y = pk2(v[j].z * rstd, v[j].w * rstd); o[64 * j] = w; }
      }
    }
  }
}

template <class Epi>
__device__ __forceinline__ void gemm_naive(const bf16_t* A, int lda, const bf16_t* Bt, int ldb, int M, int N, int K, const Epi& E, int gw, int ngw, int lane) {
  const int fr = lane & 15, fq = lane >> 4;
  const int tn = N / 64, ntile = (M / 64) * tn;
  for (int tile = gw; tile < ntile; tile += ngw) {
    const int pm = tile / tn, pn = tile % tn;
    f32x4 acc[4][4];
#pragma unroll
    for (int m = 0; m < 4; ++m)
#pragma unroll
      for (int n = 0; n < 4; ++n) acc[m][n] = (f32x4){0.f, 0.f, 0.f, 0.f};
    const bf16_t* Ap = A + (size_t)(pm * 64 + fr) * lda + fq * 8;
    const bf16_t* Bp = Bt + (size_t)(pn * 64 + fr) * ldb + fq * 8;
    for (int k0 = 0; k0 < K; k0 += 32) {
      bf16x8 af[4], bfr[4];
#pragma unroll
      for (int m = 0; m < 4; ++m) af[m] = *(const bf16x8*)(Ap + (size_t)m * 16 * lda + k0);
#pragma unroll
      for (int n = 0; n < 4; ++n) bfr[n] = *(const bf16x8*)(Bp + (size_t)n * 16 * ldb + k0);
#pragma unroll
      for (int m = 0; m < 4; ++m)
#pragma unroll
        for (int n = 0; n < 4; ++n) acc[m][n] = __builtin_amdgcn_mfma_f32_16x16x32_bf16(bfr[n], af[m], acc[m][n], 0, 0, 0);
    }
#pragma unroll
    for (int m = 0; m < 4; ++m)
#pragma unroll
      for (int n = 0; n < 4; ++n) E.store(pm * 64 + m * 16 + fr, pn * 64 + n * 16 + 4 * fq, acc[m][n]);
  }
}

struct EpiBf16 { bf16_t* O; int ldo;
  __device__ __forceinline__ void store8(int row, int col, f32x4 a, f32x4 b) const { u32x4 w; w.x = pk2(a.x, a.y); w.y = pk2(a.z, a.w); w.z = pk2(b.x, b.y); w.w = pk2(b.z, b.w); *(u32x4*)(O + (size_t)row * ldo + col) = w; }
  __device__ __forceinline__ void store(int row, int col, f32x4 v) const { u32x2 w; w.x = pk2(v.x, v.y); w.y = pk2(v.z, v.w); *(u32x2*)(O + (size_t)row * ldo + col) = w; } };
struct EpiQKV { bf16_t* O;
  __device__ __forceinline__ void store8(int row, int col, f32x4 a, f32x4 b) const { const float sc = (col < 512 || (col >= 1536 && col < 2048)) ? 0.18033688011112042f : 1.f;
    u32x4 w; w.x = pk2(a.x * sc, a.y * sc); w.y = pk2(a.z * sc, a.w * sc); w.z = pk2(b.x * sc, b.y * sc); w.w = pk2(b.z * sc, b.w * sc); *(u32x4*)(O + (size_t)row * NQKV + col) = w; }
  __device__ __forceinline__ void store(int row, int col, f32x4 v) const { const float sc = (col < 512 || (col >= 1536 && col < 2048)) ? 0.18033688011112042f : 1.f;
    u32x2 w; w.x = pk2(v.x * sc, v.y * sc); w.y = pk2(v.z * sc, v.w * sc); *(u32x2*)(O + (size_t)row * NQKV + col) = w; } };
struct EpiBf16S { bf16_t* O; int ldo; const float* ss;
  __device__ __forceinline__ void store8(int row, int col, f32x4 a, f32x4 b) const { const float r = rsqrtf(ss[row] * (1.f / DM) + EPS);
    u32x4 w; w.x = pk2(a.x * r, a.y * r); w.y = pk2(a.z * r, a.w * r); w.z = pk2(b.x * r, b.y * r); w.w = pk2(b.z * r, b.w * r); *(u32x4*)(O + (size_t)row * ldo + col) = w; }
  __device__ __forceinline__ void store(int row, int col, f32x4 v) const { const float r = rsqrtf(ss[row] * (1.f / DM) + EPS); u32x2 w; w.x = pk2(v.x * r, v.y * r); w.y = pk2(v.z * r, v.w * r); *(u32x2*)(O + (size_t)row * ldo + col) = w; } };
struct EpiF32S { float* O; int ldo; const float* ss;
  __device__ __forceinline__ void store(int row, int col, f32x4 v) const { const float r = rsqrtf(ss[row] * (1.f / DM) + EPS); *(f32x4*)(O + (size_t)row * ldo + col) = v * r; } };
struct EpiF32 { float* O; int ldo;
  __device__ __forceinline__ void store(int row, int col, f32x4 v) const { *(f32x4*)(O + (size_t)row * ldo + col) = v; } };
struct EpiResid { const float* base; float* out;
  __device__ __forceinline__ void store(int row, int col, f32x4 v) const { const size_t o = (size_t)row * DM + col; const f32x4 b = *(const f32x4*)(base + o); *(f32x4*)(out + o) = b + v; } };
struct EpiKV { bf16_t* KX; bf16_t* VXT;
  __device__ __forceinline__ void store(int row, int col, f32x4 v) const {
    if (col < 1024) { u32x2 w; w.x = pk2(v.x, v.y); w.y = pk2(v.z, v.w); *(u32x2*)(KX + (size_t)row * DM + col) = w; }
    else { const int b = row >> 8, m = row & 255;
#pragma unroll
      for (int r = 0; r < 4; ++r) { const int d = col - 1024 + r; VXT[((size_t)(b * 4 + (d >> 8)) * 256 + (d & 255)) * 256 + m] = (bf16_t)f2bf(v[r]); } } } };

__device__ __forceinline__ void phase_scan(const Args& a, int gw, int ngw, int lane, int tid) {
  unsigned char* ws = a.ws;
  const bf16_t* qkv = (const bf16_t*)(ws + WS_QKV);
  for (int item = gw; item < 64 + 1024 + 1024; item += ngw) {
    if (item < 64) {
      const int b = item >> 3, j = item & 7;
      const f32x4* src = (const f32x4*)((const float*)(ws + WS_FLOG) + (size_t)j * NT + (size_t)b * SEQ + lane * 64);
      f32x4 v[16];
#pragma unroll
      for (int i = 0; i < 16; ++i) v[i] = src[i];
      float tot = 0.f;
#pragma unroll
      for (int i = 0; i < 16; ++i) tot += (v[i].x + v[i].y) + (v[i].z + v[i].w);
      float inc = tot;
#pragma unroll
      for (int o = 1; o < 64; o <<= 1) { const float t = __shfl_up(inc, o); if (lane >= o) inc += t; }
      float run = inc - tot;
      f32x4* dst = (f32x4*)((float*)(ws + WS_CUM) + ((size_t)(b * 8 + j)) * SEQ + lane * 64);
#pragma unroll
      for (int i = 0; i < 16; ++i) { f32x4 o; run += v[i].x; o.x = run * 1.4426950408889634f; run += v[i].y; o.y = run * 1.4426950408889634f; run += v[i].z; o.z = run * 1.4426950408889634f; run += v[i].w; o.w = run * 1.4426950408889634f; dst[i] = o; }
    } else if (item < 64 + 1024) {
      const int it = item - 64, h = it & 7, blk = (it >> 3) & 15, b = it >> 7;
      const bf16_t* p = qkv + ((size_t)b * SEQ + blk * 256 + (lane >> 3)) * NQKV + 512 + h * 64 + (lane & 7) * 8;
      float s[8];
#pragma unroll
      for (int i = 0; i < 8; ++i) s[i] = 0.f;
#pragma unroll 8
      for (int rr = 0; rr < 32; ++rr) { float f[8]; unpack8(*(const u32x4*)(p + (size_t)rr * 8 * NQKV), f);
#pragma unroll
        for (int i = 0; i < 8; ++i) s[i] += f[i]; }
#pragma unroll
      for (int i = 0; i < 8; ++i) { s[i] += __shfl_xor(s[i], 8); s[i] += __shfl_xor(s[i], 16); s[i] += __shfl_xor(s[i], 32); }
      if (lane < 8) { f32x4* d = (f32x4*)((float*)(ws + WS_KMEAN) + ((size_t)(b * 16 + blk) * 8 + h) * 64 + lane * 8);
        d[0] = (f32x4){s[0], s[1], s[2], s[3]} * (1.f / 256.f); d[1] = (f32x4){s[4], s[5], s[6], s[7]} * (1.f / 256.f); }
    } else {
      const int it = item - 64 - 1024, bh = it >> 4, ch = it & 15, b = bh >> 3, h = bh & 7;
      const bf16_t* p = qkv + ((size_t)b * SEQ + ch * 256 + (lane >> 3)) * NQKV + 2048 + h * 64 + (lane & 7) * 8;
      float m = 0.f;
#pragma unroll 8
      for (int rr = 0; rr < 32; ++rr) { float f[8]; unpack8(*(const u32x4*)(p + (size_t)rr * 8 * NQKV), f);
        float s = 0.f;
#pragma unroll
        for (int i = 0; i < 8; ++i) s += f[i] * f[i];
        s += __shfl_xor(s, 1); s += __shfl_xor(s, 2); s += __shfl_xor(s, 4);
        m = fmaxf(m, s); }
#pragma unroll
      for (int o = 8; o < 64; o <<= 1) m = fmaxf(m, __shfl_xor(m, o));
      if (lane == 0) atomicMax((unsigned*)(ws + 256) + bh, __float_as_uint(m));
    }
  }
}

template <int MODE>
__device__ __forceinline__ void attn_naive_unit(const Args& a, unsigned char* lds, int b, int h, int sb, int tid) {
  unsigned char* ws = a.ws;
  const bf16_t* qkv = (const bf16_t*)(ws + WS_QKV);
  const int qoff = MODE ? 1536 : 0, koff = qoff + 512, voff = qoff + 1024;
  float* Ks = (float*)lds; float* Vs = Ks + 64 * 64; float* ck = Vs + 64 * 64; float* biasd = ck + 64;
  const int t = sb * 512 + tid; const size_t row = (size_t)b * SEQ + t;
  float q[64], o[64];
  {
    const u32x4* qp = (const u32x4*)(qkv + row * NQKV + qoff + h * 64);
#pragma unroll
    for (int c = 0; c < 8; ++c) { const u32x4 w = qp[c]; unpack8(w, q + 8 * c); }
#pragma unroll
    for (int d = 0; d < 64; ++d) { q[d] *= 0.6931471805599453f; o[d] = 0.f; }
  }
  float m = -1e30f, l = 0.f;
  unsigned selmask = 0u; const int own = t >> 8;
  float cq = 0.f, bfar = 0.f;
  __syncthreads();
  if (MODE == 0) {
    if (tid < 128) biasd[tid] = a.in[5][T5_BUCKET[tid] * 8 + h];
    bfar = a.in[5][31 * 8 + h];
    const float* km = (const float*)(ws + WS_KMEAN) + ((size_t)b * 16) * 512 + h * 64;
    float v0 = -3e38f, v1 = -3e38f, v2 = -3e38f; int i0 = -1, i1 = -1, i2 = -1;
    for (int n = 0; n < 2 * sb + 1; ++n) {
      if (n < own) {
        const float* kp = km + (size_t)n * 512; float s = 0.f;
#pragma unroll
        for (int d = 0; d < 64; ++d) s += q[d] * kp[d];
        if (s > v0) { v2 = v1; i2 = i1; v1 = v0; i1 = i0; v0 = s; i0 = n; }
        else if (s > v1) { v2 = v1; i2 = i1; v1 = s; i1 = n; }
        else if (s > v2) { v2 = s; i2 = n; }
      }
    }
    if (i0 >= 0) selmask |= 1u << i0;
    if (i1 >= 0) selmask |= 1u << i1;
    if (i2 >= 0) selmask |= 1u << i2;
  } else {
    cq = ((const float*)(ws + WS_CUM))[((size_t)(b * 8 + h)) * SEQ + t];
  }
  const int ntile = 8 * (sb + 1);
  for (int kt = 0; kt < ntile; ++kt) {
    __syncthreads();
    {
      const int r = tid >> 3, ch = tid & 7;
      const bf16_t* kp = qkv + ((size_t)b * SEQ + kt * 64 + r) * NQKV + h * 64 + ch * 8;
      const u32x4 kw = *(const u32x4*)(kp + koff), vw = *(const u32x4*)(kp + voff);
      unpack8(kw, Ks + r * 64 + ch * 8); unpack8(vw, Vs + r * 64 + ch * 8);
      if (MODE == 1 && tid < 64) ck[tid] = ((const float*)(ws + WS_CUM))[((size_t)(b * 8 + h)) * SEQ + kt * 64 + tid];
    }
    __syncthreads();
    const int kb = kt >> 2;
    bool act;
    if (MODE == 0) act = (kb == own) || (kb < own && ((selmask >> kb) & 1u));
    else act = (kt * 64 <= t);
    if (act) {
      for (int jj = 0; jj < 64; ++jj) {
        const int sp = kt * 64 + jj;
        if (sp > t) break;
        const f32x4* kr = (const f32x4*)(Ks + jj * 64);
        float s = 0.f;
#pragma unroll
        for (int c = 0; c < 16; ++c) { const f32x4 kv = kr[c]; s += q[4 * c] * kv.x + q[4 * c + 1] * kv.y + q[4 * c + 2] * kv.z + q[4 * c + 3] * kv.w; }
        if (MODE == 0) { const int dist = t - sp; s += (dist < 128) ? biasd[dist] : bfar; }
        else s += (cq - ck[jj]) * 0.6931471805599453f;
        if (s > m) { const float f = __expf(m - s); l *= f;
#pragma unroll
          for (int d = 0; d < 64; ++d) o[d] *= f;
          m = s; }
        const float p = __expf(s - m); l += p;
        const f32x4* vr = (const f32x4*)(Vs + jj * 64);
#pragma unroll
        for (int c = 0; c < 16; ++c) { const f32x4 vv = vr[c]; o[4 * c] += p * vv.x; o[4 * c + 1] += p * vv.y; o[4 * c + 2] += p * vv.z; o[4 * c + 3] += p * vv.w; }
      }
    }
  }
  const float il = 1.f / l;
  u32x4* op = (u32x4*)((bf16_t*)(ws + WS_OAB) + row * DM + (MODE ? 512 : 0) + h * 64);
#pragma unroll
  for (int c = 0; c < 8; ++c) { u32x4 w; w.x = pk2(o[8 * c] * il, o[8 * c + 1] * il); w.y = pk2(o[8 * c + 2] * il, o[8 * c + 3] * il); w.z = pk2(o[8 * c + 4] * il, o[8 * c + 5] * il); w.w = pk2(o[8 * c + 6] * il, o[8 * c + 7] * il); op[c] = w; }
}

__device__ __forceinline__ void phase_attn(const Args& a, unsigned char* lds, int tid) {
  for (int u = blockIdx.x; u < 1024; u += gridDim.x) {
    const int sb = 7 - (u >> 7), r = u & 127, mode = r & 1, bh = r >> 1;
    if (mode == 0) attn_naive_unit<0>(a, lds, bh >> 3, bh & 7, sb, tid);
    else attn_naive_unit<1>(a, lds, bh >> 3, bh & 7, sb, tid);
  }
}

namespace att {
typedef float f32x16 __attribute__((ext_vector_type(16)));
typedef short s16x4 __attribute__((ext_vector_type(4)));
typedef short v4i16_t __attribute__((ext_vector_type(4)));
typedef __attribute__((address_space(3))) const char* lds_cptr;
typedef float f32x2_t __attribute__((ext_vector_type(2))); typedef __bf16 bf16x2_t __attribute__((ext_vector_type(2)));
constexpr int PITCH = NQKV;
constexpr float LOG2E = 1.4426950408889634f;
constexpr float C2 = 0.125f * LOG2E;
constexpr int L_K = 0, L_V = 16384, L_WSF = 32768, L_OST = 34816, L_C2 = 67584, L_KM = 83968, L_BT = 88064, L_MISC = 88704;
__device__ __forceinline__ int crow(int r, int hi) { return (r & 3) + 8 * (r >> 2) + 4 * hi; }
__device__ __forceinline__ unsigned cvtpk(float lo, float hi) { f32x2_t v = {lo, hi}; bf16x2_t b = __builtin_convertvector(v, bf16x2_t); return __builtin_bit_cast(unsigned, b); }
__device__ __forceinline__ s16x4 vtr(lds_cptr p) { return __builtin_bit_cast(s16x4, __builtin_amdgcn_ds_read_tr16_b64_v4i16((__attribute__((address_space(3))) v4i16_t*)p)); }
__device__ __forceinline__ float max3f(float a, float b, float c) { float r; asm("v_max3_f32 %0, %1, %2, %3" : "=v"(r) : "v"(a), "v"(b), "v"(c)); return r; }
__device__ __forceinline__ float xhalf_max(float m) { auto rr = __builtin_amdgcn_permlane32_swap(__float_as_uint(m), __float_as_uint(m), false, false); return fmaxf(__uint_as_float(rr[0]), __uint_as_float(rr[1])); }
__device__ __forceinline__ float xhalf_sum(float m) { auto rr = __builtin_amdgcn_permlane32_swap(__float_as_uint(m), __float_as_uint(m), false, false); return __uint_as_float(rr[0]) + __uint_as_float(rr[1]); }

template <int MODE>
__device__ __forceinline__ void unit(const Args& a, unsigned char* lds, int b, int h, int qb, int tid, int xit) {
  unsigned char* ws = a.ws;
  const int lane = tid & 63, r32 = lane & 31, hi = lane >> 5; const int wid = __builtin_amdgcn_readfirstlane(tid >> 6);
  const bf16_t* qkv = (const bf16_t*)(ws + WS_QKV);
  const int qoff = MODE ? 1536 : 0;
  const size_t rowbase = (size_t)b * SEQ; const int q0 = qb * 256;
  const bf16_t* Qw = qkv + (rowbase + q0 + wid * 32) * PITCH + qoff + h * 64;
  const bf16_t* Kh = qkv + rowbase * PITCH + qoff + 512 + h * 64;
  const bf16_t* Vh = qkv + rowbase * PITCH + qoff + 1024 + h * 64;
  float* wsf = (float*)(lds + L_WSF) + wid * 64;
  float* c2s = (float*)(lds + L_C2); float* kms = (float*)(lds + L_KM); float* bts = (float*)(lds + L_BT); unsigned* misc = (unsigned*)(lds + L_MISC);
  const int NTL = 4 * (qb + 1);
  __syncthreads();
  if (MODE == 0) {
    const float* km = (const float*)(ws + WS_KMEAN) + (size_t)b * 16 * 512 + h * 64;
    for (int i = tid; i < 16 * 64; i += 512) kms[i] = km[(size_t)(i >> 6) * 512 + (i & 63)];
    if (tid < 128) bts[tid] = a.in[5][T5_BUCKET[tid] * 8 + h] * LOG2E;
    if (tid == 128) bts[128] = a.in[5][31 * 8 + h] * LOG2E;
  }
  float ce[8], cexcl = 0.f; float* wtot = (float*)(lds + L_MISC) + 4;
  if (MODE == 1) {
    const f32x4* fl = (const f32x4*)((const float*)(ws + WS_FLOG) + (size_t)h * NT + rowbase) + 2 * tid;
    f32x4 a0 = (f32x4){0.f, 0.f, 0.f, 0.f}, a1 = a0;
    if (8 * tid < 256 * (qb + 1)) { a0 = fl[0]; a1 = fl[1]; }
    ce[0] = a0.x; ce[1] = ce[0] + a0.y; ce[2] = ce[1] + a0.z; ce[3] = ce[2] + a0.w; ce[4] = ce[3] + a1.x; ce[5] = ce[4] + a1.y; ce[6] = ce[5] + a1.z; ce[7] = ce[6] + a1.w;
    float inc = ce[7];
#pragma unroll
    for (int of = 1; of < 64; of <<= 1) { const float t = __shfl_up(inc, of); if (lane >= of) inc += t; }
    cexcl = inc - ce[7];
    if (lane == 63) wtot[wid] = inc;
    if (tid == 0) misc[0] = 0u;
  }
  bf16x8 qr[4];
#pragma unroll
  for (int d0 = 0; d0 < 4; ++d0) qr[d0] = *(const bf16x8*)(Qw + (size_t)r32 * PITCH + d0 * 16 + hi * 8);
  __syncthreads();
  unsigned selmask = 0u; float cq2 = 0.f, far2 = 0.f, mhat = 0.f; int t0 = 0;
  if (MODE == 0) {
    far2 = bts[128];
    float v0 = -3e38f, v1 = -3e38f, v2 = -3e38f; int i0 = -1, i1 = -1, i2 = -1;
    for (int n = 0; n < qb; ++n) {
      float s = 0.f;
#pragma unroll
      for (int d0 = 0; d0 < 4; ++d0)
#pragma unroll
        for (int j = 0; j < 8; ++j) s += bf2f((unsigned short)qr[d0][j]) * kms[n * 64 + d0 * 16 + hi * 8 + j];
      s = xhalf_sum(s);
      if (s > v0) { v2 = v1; i2 = i1; v1 = v0; i1 = i0; v0 = s; i0 = n; }
      else if (s > v1) { v2 = v1; i2 = i1; v1 = s; i1 = n; }
      else if (s > v2) { v2 = s; i2 = n; }
    }
    if (i0 >= 0) selmask |= 1u << i0;
    if (i1 >= 0) selmask |= 1u << i1;
    if (i2 >= 0) selmask |= 1u << i2;
  } else {
    {
      float base = cexcl;
      for (int w = 0; w < wid; ++w) base += wtot[w];
      if (8 * tid < 256 * (qb + 1)) {
        f32x4* cd = (f32x4*)(c2s + 8 * tid);
        cd[0] = (f32x4){base + ce[0], base + ce[1], base + ce[2], base + ce[3]} * LOG2E; cd[1] = (f32x4){base + ce[4], base + ce[5], base + ce[6], base + ce[7]} * LOG2E;
      }
    }
    float s = 0.f;
#pragma unroll
    for (int d0 = 0; d0 < 4; ++d0)
#pragma unroll
      for (int j = 0; j < 8; ++j) { const float f = bf2f((unsigned short)qr[d0][j]); s += f * f; }
    s = xhalf_sum(s);
    atomicMax(&misc[0], __float_as_uint(s));
    __syncthreads();
    cq2 = c2s[q0 + wid * 32 + r32];
    const float kn2 = (__uint_as_float(((const unsigned*)(ws + 2048))[(b * 8 + h) * 2]) + __uint_as_float(((const unsigned*)(ws + 2048))[(b * 8 + h) * 2 + 1])) * 1.01f;
    const float qkb = sqrtf(__uint_as_float(misc[0]) * kn2) * 1.0001f + 1e-3f;
    mhat = -qkb;
    const int j = lane; bool skip = false;
    if (j < NTL) skip = (2.f * qkb + c2s[q0] - c2s[64 * j + 63]) < -150.f;
    t0 = __popcll(__ballot(skip));
    if (t0 > NTL - 1) t0 = NTL - 1;
  }
  const bf16_t* ksrc = Kh + (size_t)lane * PITCH + wid * 8;
  const bf16_t* vsrc = Vh + (size_t)(16 * (wid & 3) + (lane >> 2)) * PITCH + (wid >> 2) * 32 + (lane & 3) * 8;
  unsigned char* kdst = lds + L_K + wid * 1024 + lane * 16; unsigned char* vdst = lds + L_V + wid * 1024 + lane * 16;
  const lds_cptr lds3 = (lds_cptr)lds;
  const lds_cptr vp0 = lds3 + L_V + ((lane >> 4) & 1) * 32 + (lane & 3) * 8 + (4 * hi + ((lane & 15) >> 2)) * 64;
  u32x4 kreg = *(const u32x4*)(ksrc + (size_t)t0 * 64 * PITCH), vreg = *(const u32x4*)(vsrc + (size_t)t0 * 64 * PITCH);
  *(u32x4*)(kdst + (t0 & 1) * 8192) = kreg; *(u32x4*)(vdst + (t0 & 1) * 8192) = vreg;
  f32x16 o[2]; o[0] = f32x16{}; o[1] = f32x16{};
  f32x16 ol = f32x16{}, cm = f32x16{}; int cm_nb = -1;
  const int qrel = wid * 32 + r32, qpos = q0 + qrel;
  __syncthreads();
  for (int t = t0; t < NTL; ++t) {
    const int buf = (t & 1) * 8192;
    if (t + 1 < NTL) { kreg = *(const u32x4*)(ksrc + (size_t)(t + 1) * 64 * PITCH); vreg = *(const u32x4*)(vsrc + (size_t)(t + 1) * 64 * PITCH); }
    const int jb = t - (NTL - 4);
    const bool compute = !(jb >= 0 && 64 * jb > wid * 32 + 31);
    if (compute) {
      f32x16 p0, p1;
      bf16x8 kf[8];
      {
        const lds_cptr kb = lds3 + L_K + buf + hi * 1024 + r32 * 16;
#pragma unroll
        for (int d0 = 0; d0 < 4; ++d0) { kf[2 * d0] = *(const __attribute__((address_space(3))) bf16x8*)(kb + d0 * 2048); kf[2 * d0 + 1] = *(const __attribute__((address_space(3))) bf16x8*)(kb + d0 * 2048 + 512); }
      }
      __builtin_amdgcn_sched_barrier(0);
      if (MODE == 0) {
        const int nb = t >> 2;
        const bool near = (jb >= 0) || (t >= NTL - 6 && wid < 4);
        if (near) {
#pragma unroll
          for (int r = 0; r < 16; ++r) { const int d = qpos - (64 * t + crow(r, hi));
            p0[r] = bts[min(max(d, 0), 128)] - mhat; p1[r] = bts[min(max(d - 32, 0), 128)] - mhat; }
          if (jb < 0 && !((selmask >> nb) & 1u)) {
#pragma unroll
            for (int r = 0; r < 16; ++r) { p0[r] = -INFINITY; p1[r] = -INFINITY; }
          }
        } else {
          if (cm_nb != nb) {
            const float base = ((selmask >> nb) & 1u) ? far2 - mhat : -INFINITY;
#pragma unroll
            for (int r = 0; r < 16; ++r) cm[r] = base;
            cm_nb = nb;
          }
          p0 = cm; p1 = cm;
        }
      } else {
        const float cqm = cq2 - mhat;
#pragma unroll
        for (int g = 0; g < 4; ++g) {
          const f32x4 ca = *(const f32x4*)(c2s + 64 * t + 8 * g + 4 * hi), cb = *(const f32x4*)(c2s + 64 * t + 32 + 8 * g + 4 * hi);
#pragma unroll
          for (int i = 0; i < 4; ++i) { p0[4 * g + i] = cqm - ca[i]; p1[4 * g + i] = cqm - cb[i]; }
        }
      }
#pragma unroll
      for (int d0 = 0; d0 < 4; ++d0) {
        p0 = __builtin_amdgcn_mfma_f32_32x32x16_bf16(kf[2 * d0], qr[d0], p0, 0, 0, 0);
        p1 = __builtin_amdgcn_mfma_f32_32x32x16_bf16(kf[2 * d0 + 1], qr[d0], p1, 0, 0, 0);
      }
      if (jb >= 0) {
        asm volatile("" ::: "memory");
        const int kb0 = 64 * jb + 4 * hi;
#pragma unroll
        for (int r = 0; r < 16; ++r) { const int kv = kb0 + (r & 3) + 8 * (r >> 2); if (kv > qrel) p0[r] = -INFINITY; if (kv + 32 > qrel) p1[r] = -INFINITY; }
      }
      asm volatile("s_nop 15\n\ts_nop 7" : "+v"(p0), "+v"(p1));
      float rm, rm2;
      rm = max3f(p0[0], p0[1], p1[0]); rm2 = max3f(p0[2], p0[3], p1[1]); rm = max3f(rm, p1[2], p1[3]);
#pragma unroll
      for (int r = 4; r < 16; r += 4) { rm = max3f(rm, p0[r], p0[r + 1]); rm2 = max3f(rm2, p0[r + 2], p0[r + 3]); rm = max3f(rm, p1[r], p1[r + 1]); rm2 = max3f(rm2, p1[r + 2], p1[r + 3]); }
      rm = xhalf_max(fmaxf(rm, rm2));
      if (__any(rm > 8.0f)) {
        const float dl = fmaxf(rm, 0.f), alpha = __builtin_amdgcn_exp2f(-dl);
        mhat += dl; cm_nb = -1;
#pragma unroll
        for (int r = 0; r < 16; ++r) { p0[r] -= dl; p1[r] -= dl; }
        if (hi == 0) wsf[r32] = alpha;
        __builtin_amdgcn_wave_barrier();
#pragma unroll
        for (int r = 0; r < 16; ++r) { const float f = wsf[crow(r, hi)]; o[0][r] *= f; o[1][r] *= f; ol[r] *= f; }
        __builtin_amdgcn_wave_barrier();
      }
#pragma unroll
      for (int r = 0; r < 16; ++r) { p0[r] = __builtin_amdgcn_exp2f(p0[r]); p1[r] = __builtin_amdgcn_exp2f(p1[r]); }
      u32x4 pw0, pw1, pw2, pw3;
      pw0 = (u32x4){cvtpk(p0[0], p0[1]), cvtpk(p0[2], p0[3]), cvtpk(p0[4], p0[5]), cvtpk(p0[6], p0[7])};
      pw1 = (u32x4){cvtpk(p0[8], p0[9]), cvtpk(p0[10], p0[11]), cvtpk(p0[12], p0[13]), cvtpk(p0[14], p0[15])};
      pw2 = (u32x4){cvtpk(p1[0], p1[1]), cvtpk(p1[2], p1[3]), cvtpk(p1[4], p1[5]), cvtpk(p1[6], p1[7])};
      pw3 = (u32x4){cvtpk(p1[8], p1[9]), cvtpk(p1[10], p1[11]), cvtpk(p1[12], p1[13]), cvtpk(p1[14], p1[15])};
      {
        const bf16x8 ones = (bf16x8){0x3F80, 0x3F80, 0x3F80, 0x3F80, 0x3F80, 0x3F80, 0x3F80, 0x3F80};
        ol = __builtin_amdgcn_mfma_f32_32x32x16_bf16(__builtin_bit_cast(bf16x8, pw0), ones, ol, 0, 0, 0);
        ol = __builtin_amdgcn_mfma_f32_32x32x16_bf16(__builtin_bit_cast(bf16x8, pw1), ones, ol, 0, 0, 0);
        ol = __builtin_amdgcn_mfma_f32_32x32x16_bf16(__builtin_bit_cast(bf16x8, pw2), ones, ol, 0, 0, 0);
        ol = __builtin_amdgcn_mfma_f32_32x32x16_bf16(__builtin_bit_cast(bf16x8, pw3), ones, ol, 0, 0, 0);
      }
      const lds_cptr vp = vp0 + buf;
#pragma unroll
      for (int d0 = 0; d0 < 2; ++d0) {
#define ATT_VF(ks) ({ const s16x4 lo_ = vtr(vp + d0 * 4096 + (ks) * 1024), hi_ = vtr(vp + d0 * 4096 + (ks) * 1024 + 512); (bf16x8){lo_[0], lo_[1], lo_[2], lo_[3], hi_[0], hi_[1], hi_[2], hi_[3]}; })
        o[d0] = __builtin_amdgcn_mfma_f32_32x32x16_bf16(__builtin_bit_cast(bf16x8, pw0), ATT_VF(0), o[d0], 0, 0, 0);
        o[d0] = __builtin_amdgcn_mfma_f32_32x32x16_bf16(__builtin_bit_cast(bf16x8, pw1), ATT_VF(1), o[d0], 0, 0, 0);
        o[d0] = __builtin_amdgcn_mfma_f32_32x32x16_bf16(__builtin_bit_cast(bf16x8, pw2), ATT_VF(2), o[d0], 0, 0, 0);
        o[d0] = __builtin_amdgcn_mfma_f32_32x32x16_bf16(__builtin_bit_cast(bf16x8, pw3), ATT_VF(3), o[d0], 0, 0, 0);
#undef ATT_VF
      }
    }
    if (t + 1 < NTL) { *(u32x4*)(kdst + ((t + 1) & 1) * 8192) = kreg; *(u32x4*)(vdst + ((t + 1) & 1) * 8192) = vreg; }
    __syncthreads();
  }
  bf16_t* stg = (bf16_t*)(lds + L_OST) + wid * 2048;
#pragma unroll
  for (int r = 0; r < 16; ++r) { const int orow = crow(r, hi); const float rl = 1.f / ol[r];
    stg[orow * 64 + r32] = (bf16_t)f2bf(o[0][r] * rl); stg[orow * 64 + 32 + r32] = (bf16_t)f2bf(o[1][r] * rl); }
  __builtin_amdgcn_wave_barrier();
  f32x4 xnx[8];
  if (xit >= 0) exp_item_load(xnx, a, xit, lane);
  bf16_t* Ow = (bf16_t*)(ws + WS_OAB) + (rowbase + q0 + wid * 32) * DM + (MODE ? 512 : 0) + h * 64;
  float* sso = (float*)(ws + WS_SSO) + (size_t)(MODE ? NT : 0) + rowbase + q0 + wid * 32;
#pragma unroll
  for (int i = 0; i < 4; ++i) { const int row = i * 8 + (lane >> 3), ch = lane & 7; const u32x4 v = *(const u32x4*)(stg + row * 64 + ch * 8); *(u32x4*)(Ow + (size_t)row * DM + ch * 8) = v;
    float f[8]; unpack8(v, f); float s = 0.f;
#pragma unroll
    for (int k = 0; k < 8; ++k) s += f[k] * f[k];
    s += swz_xor<1>(s); s += swz_xor<2>(s); s += swz_xor<4>(s);
    if (ch == 0) atomicAdd(sso + row, s); }
  if (xit >= 0) exp_item_finish(xnx, a, xit, lane);
}
}

__device__ __forceinline__ void phase_attn2(const Args& a, unsigned char* lds, int tid) {
  unsigned* ctr = (unsigned*)(a.ws + 0);
  unsigned* slot = (unsigned*)(lds + att::L_MISC + 64);
  const int ngw = (int)gridDim.x * 8; int xnext = (int)blockIdx.x * 8 + (tid >> 6);
  unsigned nxt = 0u;
  if (tid == 0) nxt = atomicAdd(ctr, 1u);
  for (;;) {
    __syncthreads();
    if (tid == 0) slot[0] = nxt;
    __syncthreads();
    const unsigned u = slot[0];
    if (u >= 2048u) break;
    if (tid == 0) nxt = atomicAdd(ctr, 1u);
    const int qb = 15 - (int)(u >> 7), r = u & 127, mode = r & 1, bh = r >> 1;
    const int xit = xnext < NEXP ? xnext : -1; xnext += ngw;
    if (mode == 0) att::unit<0>(a, lds, bh >> 3, bh & 7, qb, tid, xit);
    else att::unit<1>(a, lds, bh >> 3, bh & 7, qb, tid, xit);
  }
  for (; xnext < NEXP; xnext += ngw) { f32x4 nx[8]; exp_item_load(nx, a, xnext, tid & 63); exp_item_finish(nx, a, xnext, tid & 63); }
}

__device__ __forceinline__ void phase_onorm(const Args& a, int gw, int ngw, int lane) {
  bf16_t* oab = (bf16_t*)(a.ws + WS_OAB);
  for (int r = gw; r < NT; r += ngw) {
    u32x4* p = (u32x4*)(oab + (size_t)r * DM) + 2 * lane;
    const u32x4 w0 = p[0], w1 = p[1]; float f[16]; unpack8(w0, f); unpack8(w1, f + 8);
    float s = 0.f;
#pragma unroll
    for (int i = 0; i < 16; ++i) s += f[i] * f[i];
#pragma unroll
    for (int o = 1; o < 32; o <<= 1) s += __shfl_xor(s, o);
    const float rstd = rsqrtf(s * (1.f / 512.f) + EPS);
    u32x4 o0, o1;
    o0.x = pk2(f[0] * rstd, f[1] * rstd); o0.y = pk2(f[2] * rstd, f[3] * rstd); o0.z = pk2(f[4] * rstd, f[5] * rstd); o0.w = pk2(f[6] * rstd, f[7] * rstd);
    o1.x = pk2(f[8] * rstd, f[9] * rstd); o1.y = pk2(f[10] * rstd, f[11] * rstd); o1.z = pk2(f[12] * rstd, f[13] * rstd); o1.w = pk2(f[14] * rstd, f[15] * rstd);
    p[0] = o0; p[1] = o1;
  }
}

__device__ __forceinline__ void phase_rms(const Args& a, int gw, int ngw, int lane) {
  for (int r = gw; r < NT; r += ngw) rms_row_to_bf16(a.out + (size_t)r * DM, (bf16_t*)(a.ws + WS_HB) + (size_t)r * DM, lane);
}

__device__ __forceinline__ void phase_xattn(const Args& a, unsigned char* lds, int gw, int ngw, int wave, int lane) {
  unsigned char* ws = a.ws;
  const bf16_t* qx = (const bf16_t*)(ws + WS_QX); const bf16_t* kx = (const bf16_t*)(ws + WS_KX); const bf16_t* vxt = (const bf16_t*)(ws + WS_VXT);
  bf16_t* ox = (bf16_t*)(ws + WS_OX);
  bf16_t* P = (bf16_t*)(lds + wave * 8192);
  const int fr = lane & 15, fq = lane >> 4;
  for (int u = gw; u < (NT / 16) * 4; u += ngw) {
    const int hd = u & 3, r0 = (u >> 2) * 16, b = r0 / SEQ;
    f32x4 acc[16];
#pragma unroll
    for (int i = 0; i < 16; ++i) acc[i] = (f32x4){0.f, 0.f, 0.f, 0.f};
    const bf16_t* Ap = qx + (size_t)(r0 + fr) * DM + hd * 256 + fq * 8;
    const bf16_t* Bp = kx + (size_t)(b * 256 + fr) * DM + hd * 256 + fq * 8;
    for (int ks = 0; ks < 8; ++ks) {
      const bf16x8 af = *(const bf16x8*)(Ap + ks * 32);
#pragma unroll
      for (int ct = 0; ct < 16; ++ct) { const bf16x8 bfr = *(const bf16x8*)(Bp + (size_t)ct * 16 * DM + ks * 32); acc[ct] = __builtin_amdgcn_mfma_f32_16x16x32_bf16(af, bfr, acc[ct], 0, 0, 0); }
    }
    float mx[4], sm[4];
#pragma unroll
    for (int r = 0; r < 4; ++r) { float m = acc[0][r];
#pragma unroll
      for (int ct = 1; ct < 16; ++ct) m = fmaxf(m, acc[ct][r]);
#pragma unroll
      for (int o = 1; o < 16; o <<= 1) m = fmaxf(m, __shfl_xor(m, o));
      mx[r] = m; sm[r] = 0.f; }
#pragma unroll
    for (int ct = 0; ct < 16; ++ct)
#pragma unroll
      for (int r = 0; r < 4; ++r) { const float p = __expf((acc[ct][r] - mx[r]) * 0.0625f); acc[ct][r] = p; sm[r] += p; }
#pragma unroll
    for (int r = 0; r < 4; ++r) {
#pragma unroll
      for (int o = 1; o < 16; o <<= 1) sm[r] += __shfl_xor(sm[r], o);
      sm[r] = 1.f / sm[r]; }
    __builtin_amdgcn_wave_barrier();
#pragma unroll
    for (int ct = 0; ct < 16; ++ct)
#pragma unroll
      for (int r = 0; r < 4; ++r) P[(4 * fq + r) * 256 + ct * 16 + fr] = (bf16_t)f2bf(acc[ct][r] * sm[r]);
    __builtin_amdgcn_wave_barrier();
    asm volatile("s_waitcnt lgkmcnt(0)" ::: "memory");
#pragma unroll
    for (int i = 0; i < 16; ++i) acc[i] = (f32x4){0.f, 0.f, 0.f, 0.f};
    const bf16_t* Vp = vxt + ((size_t)(b * 4 + hd) * 256 + fr) * 256 + fq * 8;
    for (int ks = 0; ks < 8; ++ks) {
      const bf16x8 pf = *(const bf16x8*)(P + fr * 256 + ks * 32 + fq * 8);
#pragma unroll
      for (int dt = 0; dt < 16; ++dt) { const bf16x8 vf = *(const bf16x8*)(Vp + (size_t)dt * 16 * 256 + ks * 32); acc[dt] = __builtin_amdgcn_mfma_f32_16x16x32_bf16(pf, vf, acc[dt], 0, 0, 0); }
    }
#pragma unroll
    for (int dt = 0; dt < 16; ++dt)
#pragma unroll
      for (int r = 0; r < 4; ++r) ox[(size_t)(r0 + 4 * fq + r) * DM + hd * 256 + dt * 16 + fr] = (bf16_t)f2bf(acc[dt][r]);
    __builtin_amdgcn_wave_barrier();
  }
}

namespace xa {
using att::f32x16; using att::s16x4; using att::lds_cptr; using att::crow; using att::cvtpk; using att::vtr; using att::xhalf_max; using att::xhalf_sum;
constexpr int L_WSF = 98304;
__device__ __forceinline__ void glds16(const void* gsrc, unsigned lds_dst) { unsigned keep;
  asm volatile("s_mov_b32 %0, m0\n\ts_mov_b32 m0, %2\n\ts_nop 0\n\tglobal_load_lds_dwordx4 %1, off\n\ts_mov_b32 m0, %0" : "=&s"(keep) : "v"(gsrc), "s"(lds_dst) : "memory"); }
__device__ __forceinline__ void unit(const Args& a, unsigned char* lds, int b, int hd, int qb, int tid) {
  unsigned char* ws = a.ws;
  const int lane = tid & 63, r32 = lane & 31, hi = lane >> 5; const int wid = __builtin_amdgcn_readfirstlane(tid >> 6);
  const bf16_t* qrow = (const bf16_t*)(ws + WS_QX) + ((size_t)b * SEQ + qb * 256 + wid * 32 + r32) * DM + hd * 256;
  const bf16_t* kvb = (const bf16_t*)(ws + WS_KX) + (size_t)b * 256 * 2048 + hd * 256;
  const bf16_t* ksrc = kvb + (size_t)lane * 2048 + wid * 8;
  const bf16_t* vsrc = kvb + 1024 + (size_t)(16 * (wid & 3) + (lane >> 2)) * 2048 + (wid >> 2) * 32 + (lane & 3) * 8;
  const unsigned sdst = (unsigned)(uintptr_t)lds + wid * 1024;
  const lds_cptr lds3 = (lds_cptr)lds;
  const lds_cptr kp0 = lds3 + hi * 1024 + r32 * 16;
  const lds_cptr vp0 = lds3 + ((lane >> 4) & 1) * 32 + (lane & 3) * 8 + (4 * hi + ((lane & 15) >> 2)) * 64;
  float* wsf = (float*)(lds + L_WSF) + wid * 64;
#define XA_DMA(s) do { const unsigned db_ = (unsigned)__builtin_amdgcn_readfirstlane(sdst + ((s) % 3) * 32768); \
    const bf16_t* kq_ = ksrc; const bf16_t* vq_ = vsrc; asm volatile("" : "+v"(kq_), "+v"(vq_));        \
    if ((s) < 4) { _Pragma("unroll") for (int kt = 0; kt < 4; ++kt) glds16(kq_ + (size_t)kt * 64 * 2048 + (s) * 64, db_ + kt * 8192); } \
    else { _Pragma("unroll") for (int dq = 0; dq < 4; ++dq) glds16(vq_ + (size_t)((s) - 4) * 64 * 2048 + dq * 64, db_ + dq * 8192); } } while (0)
#define XA_CLOSE(s) do { if ((s) + 2 < 8) asm volatile("s_waitcnt vmcnt(4) lgkmcnt(0)\n\ts_barrier" ::: "memory"); else asm volatile("s_waitcnt vmcnt(0) lgkmcnt(0)\n\ts_barrier" ::: "memory"); } while (0)
  __syncthreads();
  asm volatile("s_waitcnt vmcnt(0)" ::: "memory");
  XA_DMA(0); XA_DMA(1);
  f32x16 acc[8];
#pragma unroll
  for (int j = 0; j < 8; ++j) acc[j] = f32x16{};
  asm volatile("s_waitcnt vmcnt(4) lgkmcnt(0)\n\ts_barrier" ::: "memory");
#pragma unroll
  for (int c = 0; c < 4; ++c) {
    XA_DMA(c + 2);
    bf16x8 qf[4];
#pragma unroll
    for (int d0 = 0; d0 < 4; ++d0) qf[d0] = *(const bf16x8*)(qrow + c * 64 + d0 * 16 + hi * 8);
    int koff_ = (c % 3) * 32768; asm volatile("" : "+v"(koff_));
    const lds_cptr kp = kp0 + koff_;
#pragma unroll
    for (int d0 = 0; d0 < 4; ++d0)
#pragma unroll
      for (int j = 0; j < 8; ++j) {
        const bf16x8 kf = *(const __attribute__((address_space(3))) bf16x8*)(kp + (j >> 1) * 8192 + d0 * 2048 + (j & 1) * 512);
        acc[j] = __builtin_amdgcn_mfma_f32_32x32x16_bf16(kf, qf[d0], acc[j], 0, 0, 0);
      }
    XA_CLOSE(c);
  }
  float m = acc[0][0];
#pragma unroll
  for (int j = 0; j < 8; ++j)
#pragma unroll
    for (int r = 0; r < 16; ++r) m = fmaxf(m, acc[j][r]);
  m = xhalf_max(m);
  constexpr float CS = 1.4426950408889634f / 16.f;
  float l = 0.f; u32x4 pw[16];
#pragma unroll
  for (int j = 0; j < 8; ++j) {
#pragma unroll
    for (int r = 0; r < 16; ++r) { const float p = __builtin_amdgcn_exp2f((acc[j][r] - m) * CS); acc[j][r] = p; l += p; }
    pw[2 * j] = (u32x4){cvtpk(acc[j][0], acc[j][1]), cvtpk(acc[j][2], acc[j][3]), cvtpk(acc[j][4], acc[j][5]), cvtpk(acc[j][6], acc[j][7])};
    pw[2 * j + 1] = (u32x4){cvtpk(acc[j][8], acc[j][9]), cvtpk(acc[j][10], acc[j][11]), cvtpk(acc[j][12], acc[j][13]), cvtpk(acc[j][14], acc[j][15])};
  }
  l = xhalf_sum(l);
#pragma unroll
  for (int j = 0; j < 8; ++j) acc[j] = f32x16{};
#pragma unroll
  for (int vt = 0; vt < 4; ++vt) {
    if (vt + 6 < 8) XA_DMA(vt + 6);
    int voff_ = ((vt + 4) % 3) * 32768; asm volatile("" : "+v"(voff_));
    const lds_cptr vp = vp0 + voff_;
#pragma unroll
    for (int ks = 0; ks < 4; ++ks)
#pragma unroll
      for (int db = 0; db < 8; ++db) {
        const s16x4 lo_ = vtr(vp + (db >> 1) * 8192 + (db & 1) * 4096 + ks * 1024), hi_ = vtr(vp + (db >> 1) * 8192 + (db & 1) * 4096 + ks * 1024 + 512);
        const bf16x8 vf = (bf16x8){lo_[0], lo_[1], lo_[2], lo_[3], hi_[0], hi_[1], hi_[2], hi_[3]};
        acc[db] = __builtin_amdgcn_mfma_f32_32x32x16_bf16(__builtin_bit_cast(bf16x8, pw[4 * vt + ks]), vf, acc[db], 0, 0, 0);
      }
    XA_CLOSE(vt + 4);
  }
  if (hi == 0) wsf[r32] = l;
  __builtin_amdgcn_wave_barrier();
  float rl[16];
#pragma unroll
  for (int r = 0; r < 16; ++r) rl[r] = 1.f / wsf[crow(r, hi)];
  int sbase = (4 * hi) * 128 + r32, lbase = (lane >> 4) * 128 + (lane & 15) * 8;
  asm volatile("" : "+v"(sbase), "+v"(lbase));
  bf16_t* stg = (bf16_t*)(lds + wid * 8192);
  bf16_t* orow0 = (bf16_t*)(ws + WS_OX) + ((size_t)b * SEQ + qb * 256 + wid * 32) * DM + hd * 256 + (size_t)(lane >> 4) * DM + (lane & 15) * 8;
#pragma unroll
  for (int hf = 0; hf < 2; ++hf) {
#pragma unroll
    for (int db = 0; db < 4; ++db)
#pragma unroll
      for (int r = 0; r < 16; ++r) stg[sbase + ((r & 3) + 8 * (r >> 2)) * 128 + db * 32] = (bf16_t)f2bf(acc[hf * 4 + db][r] * rl[r]);
    __builtin_amdgcn_wave_barrier();
#pragma unroll
    for (int i = 0; i < 8; ++i) { const u32x4 v = *(const u32x4*)(stg + lbase + i * 4 * 128); *(u32x4*)(orow0 + (size_t)(i * 4) * DM + hf * 128) = v; }
    __builtin_amdgcn_wave_barrier();
  }
#undef XA_DMA
#undef XA_CLOSE
}
}

__device__ __forceinline__ void phase_xattn2(const Args& a, unsigned char* lds, int tid) {
  for (int u = blockIdx.x; u < NB * 4 * 16; u += gridDim.x) { const int qb = u & 15, hd = (u >> 4) & 3, b = u >> 6; xa::unit(a, lds, b, hd, qb, tid); }
}

__device__ __forceinline__ unsigned fkey(float s, unsigned idx, unsigned mask) { unsigned u = __float_as_uint(s); u ^= (unsigned)((int)u >> 31) | 0x80000000u; return (u & ~mask) | (mask - idx); }
__device__ __forceinline__ float keyval(unsigned k, unsigned mask) { unsigned u = k & ~mask; u = (u & 0x80000000u) ? (u ^ 0x80000000u) : ~u; return __uint_as_float(u); }
#define KEY_INSERT(KA, key_) do { unsigned k__ = (key_); \
  _Pragma("unroll") for (int s_ = 0; s_ < 16; ++s_) { const unsigned hi_ = max(k__, KA[s_]); k__ = min(k__, KA[s_]); KA[s_] = hi_; } } while (0)

__device__ __forceinline__ void phase_topk(const Args& a, unsigned char* lds, int tid) {
  unsigned char* ws = a.ws;
  const float* pq = (const float*)(ws + WS_PQ);
  int* eidx = (int*)(ws + WS_EIDX); float* gate = (float*)(ws + WS_GATE);
  float* K1 = (float*)lds; float* K2 = K1 + 128 * 64; unsigned* KL = (unsigned*)(lds + 65536);
  for (int u = blockIdx.x; u < 8 * (NT / 512); u += gridDim.x) {
    const int h = u & 7, t = (u >> 3) * 512 + tid;
    __syncthreads();
    for (int i = tid; i < 128 * 64 / 4; i += 512) { ((f32x4*)K1)[i] = ((const f32x4*)(a.in[17] + (size_t)h * 8192))[i]; ((f32x4*)K2)[i] = ((const f32x4*)(a.in[18] + (size_t)h * 8192))[i]; }
    __syncthreads();
    unsigned ka[16], kb[16], kc[16];
#pragma unroll
    for (int k = 0; k < 16; ++k) { ka[k] = 0u; kb[k] = 0u; kc[k] = 0u; }
    float q[64];
    const f32x4* qp = (const f32x4*)(pq + (size_t)t * DM + h * 128);
#pragma unroll
    for (int c = 0; c < 16; ++c) { const f32x4 w = qp[c]; q[4 * c] = w.x; q[4 * c + 1] = w.y; q[4 * c + 2] = w.z; q[4 * c + 3] = w.w; }
    for (int n = 0; n < 128; ++n) {
      const f32x4* kr = (const f32x4*)(K1 + n * 64); float s = 0.f;
#pragma unroll
      for (int c = 0; c < 16; ++c) { const f32x4 kv = kr[c]; s += q[4 * c] * kv.x + q[4 * c + 1] * kv.y + q[4 * c + 2] * kv.z + q[4 * c + 3] * kv.w; }
      KEY_INSERT(ka, fkey(s, (unsigned)n, 127u));
    }
#pragma unroll
    for (int c = 0; c < 16; ++c) { const f32x4 w = qp[16 + c]; q[4 * c] = w.x; q[4 * c + 1] = w.y; q[4 * c + 2] = w.z; q[4 * c + 3] = w.w; }
    for (int n = 0; n < 128; ++n) {
      const f32x4* kr = (const f32x4*)(K2 + n * 64); float s = 0.f;
#pragma unroll
      for (int c = 0; c < 16; ++c) { const f32x4 kv = kr[c]; s += q[4 * c] * kv.x + q[4 * c + 1] * kv.y + q[4 * c + 2] * kv.z + q[4 * c + 3] * kv.w; }
      KEY_INSERT(kb, fkey(s, (unsigned)n, 127u));
    }
#pragma unroll
    for (int x = 0; x < 16; ++x)
#pragma unroll
      for (int y = 0; y < 16; ++y)
        if ((x + 1) * (y + 1) <= 16) { KEY_INSERT(kc, fkey(keyval(ka[x], 127u) + keyval(kb[y], 127u), (unsigned)(x * 16 + y), 255u)); }
#pragma unroll
    for (int k = 0; k < 16; ++k) { KL[k * 512 + tid] = ka[k]; KL[(16 + k) * 512 + tid] = kb[k]; }
    float val[16]; int id[16]; float sum = 0.f;
#pragma unroll
    for (int k = 0; k < 16; ++k) {
      const unsigned flat = 255u - (kc[k] & 255u);
      const unsigned k1 = KL[(flat >> 4) * 512 + tid], k2 = KL[(16 + (flat & 15u)) * 512 + tid];
      val[k] = keyval(k1, 127u) + keyval(k2, 127u);
      id[k] = (int)((127u - (k1 & 127u)) * 128u + (127u - (k2 & 127u)));
    }
    const float vmax = val[0];
#pragma unroll
    for (int k = 0; k < 16; ++k) { val[k] = __expf(val[k] - vmax); sum += val[k]; }
    const float inv = 1.f / sum;
    int* ep = eidx + (size_t)t * 128 + h * 16; float* gp = gate + (size_t)t * 128 + h * 16;
#pragma unroll
    for (int k = 0; k < 16; ++k) { ep[k] = id[k]; gp[k] = val[k] * inv; }
  }
}


namespace tk {
typedef float f32x16 __attribute__((ext_vector_type(16)));
__device__ __forceinline__ void ce(unsigned& a, unsigned& b) { const unsigned h = max(a, b), l = min(a, b); a = h; b = l; }
__device__ __forceinline__ void sort16(unsigned (&v)[16]) {
#pragma unroll
  for (int k = 2; k <= 16; k <<= 1)
#pragma unroll
    for (int j = k >> 1; j > 0; j >>= 1)
#pragma unroll
      for (int i = 0; i < 16; ++i) { const int l = i ^ j; if (l > i) { if ((i & k) == 0) ce(v[i], v[l]); else ce(v[l], v[i]); } }
}
__device__ __forceinline__ void topmerge(unsigned (&a)[16], const unsigned (&b)[16]) {
#pragma unroll
  for (int i = 0; i < 16; ++i) a[i] = max(a[i], b[15 - i]);
#pragma unroll
  for (int j = 8; j > 0; j >>= 1)
#pragma unroll
    for (int i = 0; i < 16; ++i) { const int l = i ^ j; if (l > i) ce(a[i], a[l]); }
}
__device__ __forceinline__ unsigned xswap(unsigned v, int hi) { auto rr = __builtin_amdgcn_permlane32_swap(v, v, false, false); return hi ? rr[0] : rr[1]; }
__device__ __forceinline__ void half_list(unsigned (&L)[16], const bf16_t* skh, const bf16_t* qrow, int r32, int hi) {
  f32x16 acc[4];
#pragma unroll
  for (int i = 0; i < 4; ++i) acc[i] = f32x16{};
#pragma unroll
  for (int ks = 0; ks < 4; ++ks) {
    const bf16x8 qf = *(const bf16x8*)(qrow + ks * 16 + hi * 8);
#pragma unroll
    for (int tl = 0; tl < 4; ++tl) { const bf16x8 kf = *(const bf16x8*)(skh + (size_t)(tl * 32 + r32) * 64 + ks * 16 + hi * 8); acc[tl] = __builtin_amdgcn_mfma_f32_32x32x16_bf16(kf, qf, acc[tl], 0, 0, 0); }
  }
  unsigned g[4][16];
#pragma unroll
  for (int tl = 0; tl < 4; ++tl)
#pragma unroll
    for (int r = 0; r < 16; ++r) g[tl][r] = fkey(acc[tl][r], (unsigned)(32 * tl + (r & 3) + 8 * (r >> 2) + 4 * hi), 127u);
  sort16(g[0]); sort16(g[1]); sort16(g[2]); sort16(g[3]);
  topmerge(g[0], g[1]); topmerge(g[2], g[3]); topmerge(g[0], g[2]);
  unsigned p[16];
#pragma unroll
  for (int k = 0; k < 16; ++k) p[k] = xswap(g[0][k], hi);
  topmerge(g[0], p);
#pragma unroll
  for (int k = 0; k < 16; ++k) L[k] = g[0][k];
}
}

__device__ __forceinline__ void phase_topk2(const Args& a, unsigned char* lds, int wave, int lane) {
  unsigned char* ws = a.ws;
  const bf16_t* pq = (const bf16_t*)(ws + WS_PQ); const bf16_t* sk = (const bf16_t*)(ws + WS_SK);
  int* eidx = (int*)(ws + WS_EIDX); float* gate = (float*)(ws + WS_GATE);
  const int r32 = lane & 31, hi = lane >> 5, h = wave;
  unsigned* KL = (unsigned*)(lds + wave * 4096);
  for (int t4 = blockIdx.x * 4; t4 < NT / 32; t4 += gridDim.x * 4)
  for (int tt = t4; tt < t4 + 4; ++tt) {
    const int t = tt * 32 + r32;
    unsigned ka[16], kb[16], kc[16];
    tk::half_list(ka, sk + (size_t)(0 * 8 + h) * 8192, pq + (size_t)t * DM + h * 128, r32, hi);
    tk::half_list(kb, sk + (size_t)(1 * 8 + h) * 8192, pq + (size_t)t * DM + h * 128 + 64, r32, hi);
    float va[16], vb[16];
#pragma unroll
    for (int k = 0; k < 16; ++k) { va[k] = keyval(ka[k], 127u); vb[k] = keyval(kb[k], 127u); }
#pragma unroll
    for (int y = 0; y < 16; ++y) kc[y] = hi ? 0u : fkey(va[0] + vb[y], (unsigned)y, 255u);
#define TK_CAND(xa, ya, xb, yb) do { const unsigned kA_ = fkey(va[xa] + vb[ya], (unsigned)((xa) * 16 + (ya)), 255u), kB_ = fkey(va[xb] + vb[yb], (unsigned)((xb) * 16 + (yb)), 255u); KEY_INSERT(kc, hi ? kB_ : kA_); } while (0)
    TK_CAND(1, 0, 1, 1);
    TK_CAND(1, 2, 1, 3);
    TK_CAND(1, 4, 1, 5);
    TK_CAND(1, 6, 1, 7);
    TK_CAND(2, 0, 2, 1);
    TK_CAND(2, 2, 2, 3);
    TK_CAND(2, 4, 3, 0);
    TK_CAND(3, 1, 3, 2);
    TK_CAND(3, 3, 4, 0);
    TK_CAND(4, 1, 4, 2);
    TK_CAND(5, 0, 5, 1);
    TK_CAND(6, 0, 6, 1);
    TK_CAND(7, 0, 7, 1);
    TK_CAND(8, 0, 9, 0);
    TK_CAND(10, 0, 11, 0);
    TK_CAND(12, 0, 13, 0);
    TK_CAND(14, 0, 15, 0);
#undef TK_CAND
    { unsigned p[16];
#pragma unroll
      for (int k = 0; k < 16; ++k) p[k] = tk::xswap(kc[k], hi);
      tk::topmerge(kc, p); }
    if (hi == 0) {
#pragma unroll
      for (int k = 0; k < 16; ++k) { KL[k * 32 + r32] = ka[k]; KL[(16 + k) * 32 + r32] = kb[k]; }
    }
    __builtin_amdgcn_wave_barrier();
    const float vmax = va[0] + vb[0];
    float pv[8]; int id[8]; float s = 0.f;
#pragma unroll
    for (int j = 0; j < 8; ++j) {
      unsigned klo_ = kc[j], khi_ = kc[8 + j]; asm volatile("" : "+v"(klo_), "+v"(khi_));
      const unsigned key = hi ? khi_ : klo_;
      const unsigned flat = 255u - (key & 255u);
      const unsigned k1 = KL[(flat >> 4) * 32 + r32], k2 = KL[(16 + (flat & 15u)) * 32 + r32];
      pv[j] = __expf(keyval(k1, 127u) + keyval(k2, 127u) - vmax); s += pv[j];
      id[j] = (int)((127u - (k1 & 127u)) * 128u + (127u - (k2 & 127u)));
    }
    __builtin_amdgcn_wave_barrier();
    const float inv = 1.f / att::xhalf_sum(s);
    u32x4* ep = (u32x4*)(eidx + (size_t)t * 128 + h * 16 + hi * 8); f32x4* gp = (f32x4*)(gate + (size_t)t * 128 + h * 16 + hi * 8);
    ep[0] = (u32x4){(unsigned)id[0], (unsigned)id[1], (unsigned)id[2], (unsigned)id[3]}; ep[1] = (u32x4){(unsigned)id[4], (unsigned)id[5], (unsigned)id[6], (unsigned)id[7]};
    gp[0] = (f32x4){pv[0] * inv, pv[1] * inv, pv[2] * inv, pv[3] * inv}; gp[1] = (f32x4){pv[4] * inv, pv[5] * inv, pv[6] * inv, pv[7] * inv};
  }
}

__device__ __forceinline__ float gelu_erf(float v) { return 0.5f * v * (1.f + erff(v * 0.70710678118654752f)); }

__device__ __forceinline__ float gelu_as(float v) {
  const float av = fabsf(v), t = __builtin_amdgcn_rcpf(av * 0.2316418882f + 1.0f);
  float q = t * 0.5307027145f + (-0.7265760135f); q = q * t + 0.7107068705f; q = q * t + (-0.142248368f); q = q * t + 0.127414796f; q = q * t;
  const float m = v * (q * __builtin_amdgcn_exp2f((v * v) * (-0.72134752044f)));
  return v < 0.f ? m : v - m;
}
#define PIN16(A, O) asm volatile("" : "+v"(A[O]), "+v"(A[O + 1]), "+v"(A[O + 2]), "+v"(A[O + 3]), "+v"(A[O + 4]), "+v"(A[O + 5]), "+v"(A[O + 6]), "+v"(A[O + 7]), "+v"(A[O + 8]), "+v"(A[O + 9]), "+v"(A[O + 10]), "+v"(A[O + 11]), "+v"(A[O + 12]), "+v"(A[O + 13]), "+v"(A[O + 14]), "+v"(A[O + 15]))
#define PIN6(R) asm volatile("" : "+v"(R[0].x), "+v"(R[0].y), "+v"(R[1].x), "+v"(R[1].y), "+v"(R[2].x), "+v"(R[2].y))
__device__ __forceinline__ void phase_exp_down(const Args& a, int wave, int lane) {
  const int nblk_ = (NT / 128 - (int)blockIdx.x + (int)gridDim.x - 1) / (int)gridDim.x, ntok = nblk_ > 0 ? 16 * nblk_ : 0;
#define DOWN_TOK(i) ((((int)blockIdx.x + ((i) >> 4) * (int)gridDim.x) * 128) + wave * 16 + ((i) & 15))
  unsigned char* ws = a.ws;
  const int* eidx = (const int*)(ws + WS_EIDX); const float* gate = (const float*)(ws + WS_GATE); float* wout = (float*)(ws + WS_W);
  const unsigned char* exd = ws + WS_EXD; const float* esc = (const float*)(ws + WS_ESC);
  const int l32 = lane & 31, hi = lane >> 5;
  const bool b4 = (l32 & 16) != 0, b3 = (l32 & 8) != 0, b2 = (l32 & 4) != 0;
  const bf16_t* hb = (const bf16_t*)(ws + WS_HB); const float* ss2 = (const float*)(ws + WS_SS2);
  int ne0 = 0, ne1 = 0; float ng0 = 0.f, ng1 = 0.f, nss = 0.f; u32x4 nh[4];
  if (ntok > 0) { const size_t tf = (size_t)DOWN_TOK(0); ne0 = eidx[tf * 128 + lane]; ne1 = eidx[tf * 128 + 64 + lane]; ng0 = gate[tf * 128 + lane]; ng1 = gate[tf * 128 + 64 + lane]; nss = ss2[tf];
    const u32x4* hp = (const u32x4*)(hb + tf * DM + 32 * l32);
#pragma unroll
    for (int k = 0; k < 4; ++k) nh[k] = hp[k]; }
  for (int ti = 0; ti < ntok; ++ti) {
    const int t = DOWN_TOK(ti);
    const int e0 = ne0, e1 = ne1;
    const float sd0 = esc[e0], sd1 = esc[e1];
    const float gu0 = ng0 * esc[NEXP + e0], gu1 = ng1 * esc[NEXP + e1];
    float hg[32];
    unpack8(nh[0], hg); unpack8(nh[1], hg + 8); unpack8(nh[2], hg + 16); unpack8(nh[3], hg + 24);
    const float rstd = rsqrtf(nss * (1.f / DM) + EPS);
    if (ti + 1 < ntok) { const size_t tn = (size_t)DOWN_TOK(ti + 1); ne0 = eidx[tn * 128 + lane]; ne1 = eidx[tn * 128 + 64 + lane]; ng0 = gate[tn * 128 + lane]; ng1 = gate[tn * 128 + 64 + lane]; nss = ss2[tn];
      const u32x4* hp = (const u32x4*)(hb + tn * DM + 32 * l32);
#pragma unroll
      for (int k = 0; k < 4; ++k) nh[k] = hp[k]; }
#pragma unroll
    for (int k = 0; k < 8; ++k) { const f32x4 g = ((const f32x4*)a.in[15])[8 * l32 + k]; hg[4 * k] *= rstd * g.x; hg[4 * k + 1] *= rstd * g.y; hg[4 * k + 2] *= rstd * g.z; hg[4 * k + 3] *= rstd * g.w; }
    float w0 = 0.f, w1 = 0.f;
    for (int e = 0; e < 128; e += 16) {
      u32x2 ur[8][3];
#pragma unroll
      for (int i = 0; i < 8; ++i) {
        const int pi = (e & 63) + 2 * i + hi; const int id = (e < 64) ? __shfl(e0, pi) : __shfl(e1, pi);
        const u32x2* up = (const u32x2*)(exd + (size_t)id * 768 + 24 * l32);
        ur[i][0] = up[0]; ur[i][1] = up[1]; ur[i][2] = up[2];
      }
      float d[8];
#pragma unroll
      for (int i = 0; i < 8; ++i) {
        const v32f u = __builtin_amdgcn_cvt_scalef32_pk32_f32_fp6((v6u){ur[i][0].x, ur[i][0].y, ur[i][1].x, ur[i][1].y, ur[i][2].x, ur[i][2].y}, 1.0f);
        f32x2 q2 = (f32x2){0.f, 0.f};
#pragma unroll
        for (int k = 0; k < 16; ++k) q2 = __builtin_elementwise_fma((f32x2){u[2 * k], u[2 * k + 1]}, (f32x2){hg[2 * k], hg[2 * k + 1]}, q2);
        d[i] = q2.x + q2.y;
        __builtin_amdgcn_sched_barrier(0);
      }
      float r[4];
#pragma unroll
      for (int j = 0; j < 4; ++j) r[j] = (b4 ? d[j + 4] : d[j]) + swz_xor<16>(b4 ? d[j] : d[j + 4]);
      const float q0 = (b3 ? r[2] : r[0]) + swz_xor<8>(b3 ? r[0] : r[2]);
      const float q1 = (b3 ? r[3] : r[1]) + swz_xor<8>(b3 ? r[1] : r[3]);
      float q = (b2 ? q1 : q0) + swz_xor<4>(b2 ? q0 : q1);
      q += swz_xor<2>(q); q += swz_xor<1>(q);
      const int pr = (e & 63) + 2 * (l32 >> 2) + hi;
      const float sd = (e < 64) ? __shfl(sd0, pr) : __shfl(sd1, pr);
      const float gu = (e < 64) ? __shfl(gu0, pr) : __shfl(gu1, pr);
      const float wl = gu * gelu_as(q * sd);
      const float wsrc = __shfl(wl, ((lane & 1) << 5) | (((lane - (e & 63)) >> 1 & 7) << 2));
      if (lane >= (e & 63) && lane < (e & 63) + 16) { if (e < 64) w0 = wsrc; else w1 = wsrc; }
    }
    wout[(size_t)t * 128 + lane] = w0; wout[(size_t)t * 128 + 64 + lane] = w1;
  }
#undef DOWN_TOK
}

namespace dnm {
typedef int v8i __attribute__((ext_vector_type(8)));
constexpr int PITCH = 800  , CAPE = 688, CAP = CAPE + 16, L_LIST = 16 * PITCH, L_DV = L_LIST + 4 * CAP, WAVE_LDS = L_DV + 256;
static_assert(WAVE_LDS <= 16384, "per-wave LDS window");
struct RBuf { u32x4 a[8]; u32x2 b[8]; };
__device__ __forceinline__ void gather(RBuf& R, const unsigned char* exd, const unsigned* list, int e0, int hi, unsigned l32) {
#pragma unroll
  for (int i = 0; i < 8; ++i) { const unsigned ent = list[e0 + 2 * i + hi]; const unsigned eid = (ent >> 11) & 16383u; const unsigned char* p = exd + (eid * 768u + 16u * l32); R.a[i] = *(const u32x4*)p; R.b[i] = *(const u32x2*)(p + 512 - 8 * l32); }
}
struct Pend { unsigned ent; float d, gate, sd, su; };
__device__ __forceinline__ void finish(const Pend& P, float* wout, int t0, float rstd_l) {
  const unsigned tk = (P.ent >> 7) & 15u, slot = P.ent & 127u;
  const float rs = __shfl(rstd_l, (int)tk);
  if (!(P.ent >> 31)) wout[(size_t)(t0 + (int)tk) * 128 + slot] = P.gate * P.su * gelu_as(P.d * rs * P.sd);
}
__device__ __forceinline__ void start(Pend& P, const unsigned* list, const float* dv, int e0, int n, int lane, const float* gate, const float* esc, int t0) {
  unsigned ent = 0x80000000u; float d = 0.f;
  if (lane < n) { ent = list[e0 + lane]; d = dv[lane]; }
  const unsigned eid = (ent >> 11) & 16383u, tk = (ent >> 7) & 15u, slot = ent & 127u;
  P.ent = ent; P.d = d; P.gate = gate[(size_t)(t0 + (int)tk) * 128 + slot]; P.sd = esc[eid]; P.su = esc[NEXP + eid];
}
}
__device__ __forceinline__ void phase_exp_down2(const Args& a, unsigned char* lds, int wave, int lane) {
  using namespace dnm;
  unsigned char* ws = a.ws;
  const int* eidx = (const int*)(ws + WS_EIDX); const float* gate = (const float*)(ws + WS_GATE); float* wout = (float*)(ws + WS_W);
  const unsigned char* exd = ws + WS_EXD; const float* esc = (const float*)(ws + WS_ESC);
  const bf16_t* hb = (const bf16_t*)(ws + WS_HB); const float* ss2 = (const float*)(ws + WS_SS2);
  unsigned char* wl = lds + wave * 16384;
  unsigned* list = (unsigned*)(wl + L_LIST); float* dv = (float*)(wl + L_DV);
  const int l32 = lane & 31, hi = lane >> 5, m = lane & 15, kg = lane >> 4;
  unsigned char* wbase = wl + hi * PITCH + 16 * l32;
  const unsigned char* rbase = wl + m * PITCH + 48 * kg;
  for (int blk = blockIdx.x; blk < NT / 128; blk += gridDim.x) {
    const int t0 = blk * 128 + wave * 16;
    v8i B[8];
    float rstd_l;
    {
      const bf16_t* hp = hb + (size_t)(t0 + m) * DM + 64 * kg;
      float mx = 0.f;
#pragma unroll 4
      for (int c = 0; c < 32; ++c) { const u32x4 v = *(const u32x4*)(hp + (c >> 3) * 256 + (c & 7) * 8); float f[8]; unpack8(v, f);
#pragma unroll
        for (int k = 0; k < 8; ++k) mx = fmaxf(mx, fabsf(f[k])); }
      mx = fmaxf(mx, __shfl_xor(mx, 16)); mx = fmaxf(mx, __shfl_xor(mx, 32));
      const float s = mx > 0.f ? 7.0f / mx : 1.f;
      rstd_l = rsqrtf(ss2[t0 + m] * (1.f / DM) + EPS) * (mx > 0.f ? mx * (1.f / 7.0f) : 1.f);
#pragma unroll
      for (int j = 0; j < 8; ++j) {
        const u32x4* p = (const u32x4*)(hp + 256 * (j >> 1) + 32 * (j & 1));
        v16f xa, xb;
#pragma unroll
        for (int q = 0; q < 4; ++q) { const u32x4 v = p[q]; float f[8]; unpack8(v, f);
#pragma unroll
          for (int k = 0; k < 4; ++k) { xa[4 * q + k] = f[2 * k] * s; xb[4 * q + k] = f[2 * k + 1] * s; } }
        const v6u w = __builtin_amdgcn_cvt_scalef32_2xpk16_fp6_f32(xa, xb, 1.0f);
        B[j] = (v8i){(int)w[0], (int)w[1], (int)w[2], (int)w[3], (int)w[4], (int)w[5], 0, 0};
      }
    }
    Pend P; P.ent = 0x80000000u; P.d = 0.f; P.gate = 0.f; P.sd = 0.f; P.su = 0.f;
    unsigned ea[16], eb[16];
#pragma unroll
    for (int tk = 0; tk < 16; ++tk) { const size_t o = (size_t)(t0 + tk) * 128; ea[tk] = (unsigned)eidx[o + lane]; eb[tk] = (unsigned)eidx[o + 64 + lane]; }
#pragma unroll 1
    for (int r = 0; r < 8; ++r) {
      int S = 0, total = 0;
      do {
        int cnt = 0;
        __builtin_amdgcn_wave_barrier();
#pragma unroll
        for (int tk = 0; tk < 16; ++tk) {
          const bool ia = (int)(ea[tk] >> 11) == r, ib = (int)(eb[tk] >> 11) == r;
          const unsigned long long ma = __ballot(ia), mb = __ballot(ib);
          const int pa = __builtin_amdgcn_mbcnt_hi((unsigned)(ma >> 32), __builtin_amdgcn_mbcnt_lo((unsigned)ma, 0u));
          const int na = __popcll(ma);
          const int pb = __builtin_amdgcn_mbcnt_hi((unsigned)(mb >> 32), __builtin_amdgcn_mbcnt_lo((unsigned)mb, 0u));
          const int ra = cnt + pa - S, rb = cnt + na + pb - S;
          if (ia && (unsigned)ra < (unsigned)CAPE) list[ra] = (ea[tk] << 11) | ((unsigned)tk << 7) | (unsigned)lane;
          if (ib && (unsigned)rb < (unsigned)CAPE) list[rb] = (eb[tk] << 11) | ((unsigned)tk << 7) | (unsigned)(64 + lane);
          cnt += na + __popcll(mb);
        }
        total = cnt;
        cnt = min(total - S, CAPE);
        S += CAPE;
        __builtin_amdgcn_wave_barrier();
        asm volatile("" ::: "memory");
        if (cnt <= 0) continue;
        const int npad = (cnt + 15) & ~15;
        if (lane < npad - cnt) list[cnt + lane] = list[0] | 0x80000000u;
        __builtin_amdgcn_wave_barrier();
        asm volatile("" ::: "memory");
        const int ntile = npad >> 4;
        RBuf GA, GB;
        gather(GA, exd, list, 0, hi, (unsigned)l32);
#define DN_TILE(G, MT) do { \
          asm volatile("" ::: "memory"); \
          _Pragma("unroll") for (int i = 0; i < 8; ++i) { unsigned char* wp = wbase + 2 * PITCH * i; *(u32x4*)wp = G.a[i]; *(u32x2*)(wp + 512 - 8 * l32) = G.b[i]; } \
          asm volatile("" ::: "memory"); \
          f32x4 C = (f32x4){0.f, 0.f, 0.f, 0.f}; \
          _Pragma("unroll") for (int jj = 0; jj < 4; ++jj) { const u32x4* ap = (const u32x4*)(rbase + 192 * jj); const u32x4 a0 = ap[0], a1 = ap[1], a2 = ap[2]; \
            const v8i A0 = (v8i){(int)a0.x, (int)a0.y, (int)a0.z, (int)a0.w, (int)a1.x, (int)a1.y, 0, 0}, A1 = (v8i){(int)a1.z, (int)a1.w, (int)a2.x, (int)a2.y, (int)a2.z, (int)a2.w, 0, 0}; \
            C = __builtin_amdgcn_mfma_scale_f32_16x16x128_f8f6f4(A0, B[2 * jj], C, 2, 2, 0, 127, 0, 127); \
            C = __builtin_amdgcn_mfma_scale_f32_16x16x128_f8f6f4(A1, B[2 * jj + 1], C, 2, 2, 0, 127, 0, 127); } \
          const u32x4 e4 = *(const u32x4*)(list + 16 * (MT) + 4 * kg); \
          float* dvp = dv + ((16 * (MT) + 4 * kg) & 63); \
          if ((int)((e4.x >> 7) & 15u) == m) dvp[0] = C[0]; \
          if ((int)((e4.y >> 7) & 15u) == m) dvp[1] = C[1]; \
          if ((int)((e4.z >> 7) & 15u) == m) dvp[2] = C[2]; \
          if ((int)((e4.w >> 7) & 15u) == m) dvp[3] = C[3]; \
        } while (0)
#pragma unroll 1
        for (int mt = 0; mt < ntile; mt += 4) {
          const int last = ntile - 1;
          const int m1 = min(mt + 1, last), m2 = min(mt + 2, last), m3 = min(mt + 3, last), m4 = min(mt + 4, last);
          gather(GB, exd, list, 16 * m1, hi, (unsigned)l32);
          __builtin_amdgcn_sched_barrier(0);
          DN_TILE(GA, mt);
          gather(GA, exd, list, 16 * m2, hi, (unsigned)l32);
          __builtin_amdgcn_sched_barrier(0);
          if (mt + 1 < ntile) DN_TILE(GB, m1);
          gather(GB, exd, list, 16 * m3, hi, (unsigned)l32);
          __builtin_amdgcn_sched_barrier(0);
          if (mt + 2 < ntile) DN_TILE(GA, m2);
          gather(GA, exd, list, 16 * m4, hi, (unsigned)l32);
          __builtin_amdgcn_sched_barrier(0);
          if (mt + 3 < ntile) DN_TILE(GB, m3);
          asm volatile("" ::: "memory"); __builtin_amdgcn_wave_barrier();
          finish(P, wout, t0, rstd_l);
          start(P, list, dv, 16 * mt, min(npad - 16 * mt, 64), lane, gate, esc, t0);
          asm volatile("" ::: "memory"); __builtin_amdgcn_wave_barrier();
        }
#undef DN_TILE
      } while (S < total);
    }
    dnm::finish(P, wout, t0, rstd_l);
  }
}

#ifndef PROBE_G
#define PROBE_G 0
#endif
#if PROBE_G
template <int MODE>
__device__ __forceinline__ void probe_gather(const Args& a, int wave, int lane, unsigned mask) {
  unsigned char* ws = a.ws;
  const int* eidx = (const int*)(ws + WS_EIDX); const unsigned char* exd = ws + WS_EXD;
  const int l32 = lane & 31, hi = lane >> 5;
  unsigned x = 0u;
  for (int ti = 0; ti < 16; ++ti) {
    const size_t t = (size_t)blockIdx.x * 128 + wave * 16 + ti;
    const int e0 = eidx[t * 128 + lane] & (int)mask, e1 = eidx[t * 128 + 64 + lane] & (int)mask;
    if (MODE == 0) {
      for (int e = 0; e < 128; e += 16) {
        u32x2 ur[8][3];
#pragma unroll
        for (int i = 0; i < 8; ++i) {
          const int pi = (e & 63) + 2 * i + hi; const int id = (e < 64) ? __shfl(e0, pi) : __shfl(e1, pi);
          const u32x2* up = (const u32x2*)(exd + (size_t)id * 768 + 24 * l32);
          ur[i][0] = up[0]; ur[i][1] = up[1]; ur[i][2] = up[2];
        }
#pragma unroll
        for (int i = 0; i < 8; ++i) x ^= ur[i][0].x ^ ur[i][0].y ^ ur[i][1].x ^ ur[i][1].y ^ ur[i][2].x ^ ur[i][2].y;
      }
    } else {
      for (int mt = 0; mt < 8; ++mt) {
        const int id = (mt < 4) ? __shfl(e0, 16 * mt + (lane & 15)) : __shfl(e1, 16 * (mt - 4) + (lane & 15));
        const u32x2* rp = (const u32x2*)(exd + (size_t)id * 768 + 24 * (lane >> 4));
        u32x2 r[8][3];
#pragma unroll
        for (int j = 0; j < 8; ++j) { r[j][0] = rp[12 * j]; r[j][1] = rp[12 * j + 1]; r[j][2] = rp[12 * j + 2]; }
#pragma unroll
        for (int j = 0; j < 8; ++j) x ^= r[j][0].x ^ r[j][0].y ^ r[j][1].x ^ r[j][1].y ^ r[j][2].x ^ r[j][2].y;
      }
    }
  }
  ((unsigned*)(ws + WS_QKV))[(size_t)blockIdx.x * 512 + wave * 64 + lane] = x;
}
#endif
__device__ __forceinline__ void exp_up_item(const Args& a, unsigned char* lds, int xs, int item, int wave, int lane, float* xout, float* ssout) {
  unsigned char* ws = a.ws;
  const int* eidx = (const int*)(ws + WS_EIDX); const float* wgt = (const float*)(ws + WS_W);
  const unsigned char* ups = ws + WS_EXU + (size_t)xs * (NEXP * 128);
  unsigned* L = (unsigned*)(lds + wave * 16640);
  const int g = lane >> 2, c = lane & 3, t0 = item * 128 + wave * 16;
  __builtin_amdgcn_wave_barrier();
#pragma unroll 4
  for (int tk = 0; tk < 16; ++tk) {
    const size_t o = (size_t)(t0 + tk) * 128;
    L[tk * 260 + lane] = (unsigned)eidx[o + lane]; L[tk * 260 + 64 + lane] = (unsigned)eidx[o + 64 + lane];
    L[tk * 260 + 128 + lane] = __float_as_uint(wgt[o + lane]); L[tk * 260 + 192 + lane] = __float_as_uint(wgt[o + 64 + lane]);
  }
  __builtin_amdgcn_wave_barrier();
  float acc[32];
#pragma unroll
  for (int i = 0; i < 32; ++i) acc[i] = 0.f;
  const unsigned* Lg = L + g * 260;
#pragma unroll 1
  for (int p = 0; p < 128; p += 8) {
    u32x2 vr[8][3];
#pragma unroll
    for (int u = 0; u < 8; ++u) {
      const u32x2* vp = (const u32x2*)(ups + (size_t)Lg[p + u] * 128 + 24 * c);
      vr[u][0] = vp[0]; vr[u][1] = vp[1]; vr[u][2] = vp[2];
    }
#pragma unroll
    for (int u = 0; u < 8; ++u) {
      const float w = __uint_as_float(Lg[128 + p + u]);
      PIN6(vr[u]);
      const v32f v = __builtin_amdgcn_cvt_scalef32_pk32_f32_fp6((v6u){vr[u][0].x, vr[u][0].y, vr[u][1].x, vr[u][1].y, vr[u][2].x, vr[u][2].y}, 1.0f);
#pragma unroll
      for (int k = 0; k < 32; ++k) acc[k] += w * v[k];
      PIN16(acc, 0); PIN16(acc, 16);
    }
  }
  const f32x4* xr = (const f32x4*)(a.out + (size_t)(t0 + g) * DM + xs * 128 + c * 32); f32x4* xw = (f32x4*)(xout + (size_t)(t0 + g) * DM + xs * 128 + c * 32);
  float s = 0.f;
#pragma unroll
  for (int k = 0; k < 8; ++k) { f32x4 x = xr[k]; x.x += acc[4 * k]; x.y += acc[4 * k + 1]; x.z += acc[4 * k + 2]; x.w += acc[4 * k + 3]; xw[k] = x; s += (x.x * x.x + x.y * x.y) + (x.z * x.z + x.w * x.w); }
  s += swz_xor<1>(s); s += swz_xor<2>(s);
  if (c == 0) atomicAdd(ssout + t0 + g, s);
}
__device__ __forceinline__ void phase_exp_up(const Args& a, unsigned char* lds, const XcdBarrier& bar, int tid, int wave, int lane, unsigned* ctr, float* xout, float* ssout);
struct UpBuf { u32x4 r[8][2]; };
__device__ __forceinline__ void up2_load(UpBuf& B, const unsigned char* ups, const unsigned* Lg, int ch, int c) {
  const unsigned char* base = ups + (size_t)(ch >> 4) * (NEXP * 128) + 32 * c; const int p = (ch & 15) * 8;
#pragma unroll
  for (int u = 0; u < 8; ++u) { const u32x4* vp = (const u32x4*)(base + (size_t)Lg[p + u] * 128); B.r[u][0] = vp[0]; B.r[u][1] = vp[1]; }
}
__device__ __forceinline__ void up2_math(UpBuf& B, const unsigned* Lg, int ch, f32x2 (&acc)[16]) {
  const int p = (ch & 15) * 8;
#pragma unroll
  for (int u = 0; u < 8; ++u) {
    const float w = __uint_as_float(Lg[128 + p + u]);
    const f32x2 w2 = (f32x2){w, w};
#pragma unroll
    for (int q = 0; q < 2; ++q)
#pragma unroll
      for (int k = 0; k < 4; ++k) {
        const auto lo = __builtin_amdgcn_cvt_pk_f32_fp8((int)B.r[u][q][k], false); const auto hi = __builtin_amdgcn_cvt_pk_f32_fp8((int)B.r[u][q][k], true);
        acc[8 * q + 2 * k] = __builtin_elementwise_fma((f32x2){lo[0], lo[1]}, w2, acc[8 * q + 2 * k]);
        acc[8 * q + 2 * k + 1] = __builtin_elementwise_fma((f32x2){hi[0], hi[1]}, w2, acc[8 * q + 2 * k + 1]);
      }
    if (u & 1) PIN16(acc, 0);
  }
}
__device__ __forceinline__ void up2_slice_end(const Args& a, int t, int xs, int c, f32x2 (&acc)[16], float& ssum) {
  f32x4* xr = (f32x4*)(a.out + (size_t)t * DM + xs * 128 + c * 32);
#pragma unroll
  for (int k = 0; k < 8; ++k) { f32x4 x = xr[k]; x.x += acc[2 * k].x; x.y += acc[2 * k].y; x.z += acc[2 * k + 1].x; x.w += acc[2 * k + 1].y; xr[k] = x; ssum += (x.x * x.x + x.y * x.y) + (x.z * x.z + x.w * x.w);
    acc[2 * k] = (f32x2){0.f, 0.f}; acc[2 * k + 1] = (f32x2){0.f, 0.f}; }
}
__device__ __forceinline__ void phase_exp_up2(const Args& a, unsigned char* lds, int wave, int lane) {
  unsigned char* ws = a.ws;
  const int* eidx = (const int*)(ws + WS_EIDX); const float* wgt = (const float*)(ws + WS_W);
  const unsigned char* ups = ws + WS_EXU;
  unsigned* L = (unsigned*)(lds + wave * 16640);
  const int g = lane >> 2, c = lane & 3;
  for (int blk = blockIdx.x; blk < NT / 128; blk += gridDim.x) {
    const int t0 = blk * 128 + wave * 16, t = t0 + g;
    unsigned* H = (unsigned*)(lds + 8 * 16640 + 1024) + wave * 256;
    __builtin_amdgcn_wave_barrier();
    for (int i = lane; i < 256; i += 64) H[i] = 0u;
    __builtin_amdgcn_wave_barrier();
#pragma unroll 4
    for (int tk = 0; tk < 16; ++tk) {
      const size_t o = (size_t)(t0 + tk) * 128;
      const unsigned ea = (unsigned)eidx[o + lane], eb = (unsigned)eidx[o + 64 + lane];
      const unsigned wa = __float_as_uint(wgt[o + lane]), wb = __float_as_uint(wgt[o + 64 + lane]);
      const unsigned ba = ea >> 10, bb = eb >> 10;
      const unsigned ra = atomicAdd(&H[tk * 16 + ba], 1u), rb = atomicAdd(&H[tk * 16 + bb], 1u);
      __builtin_amdgcn_wave_barrier();
      unsigned pa = ra, pb = rb;
#pragma unroll
      for (unsigned b = 0; b < 16; ++b) { const unsigned hb = H[tk * 16 + b]; pa += (b < ba) ? hb : 0u; pb += (b < bb) ? hb : 0u; }
      L[tk * 260 + pa] = ea; L[tk * 260 + 128 + pa] = wa; L[tk * 260 + pb] = eb; L[tk * 260 + 128 + pb] = wb;
    }
    __builtin_amdgcn_wave_barrier();
    const unsigned* Lg = L + g * 260;
    f32x2 acc[16]; float ssum = 0.f;
#pragma unroll
    for (int i = 0; i < 16; ++i) acc[i] = (f32x2){0.f, 0.f};
    UpBuf A, B;
    up2_load(A, ups, Lg, 0, c);
#pragma unroll 1
    for (int ch = 0; ch < 128; ch += 2) {
      up2_load(B, ups, Lg, ch + 1, c);
      up2_math(A, Lg, ch, acc);
      if (ch + 2 < 128) up2_load(A, ups, Lg, ch + 2, c);
      up2_math(B, Lg, ch + 1, acc);
      if ((ch & 15) == 14) up2_slice_end(a, t, ch >> 4, c, acc, ssum);
    }
    ssum += swz_xor<1>(ssum); ssum += swz_xor<2>(ssum);
    const float r2 = rsqrtf(ssum * (1.f / DM) + EPS);
    asm volatile("s_waitcnt vmcnt(0)" ::: "memory");
    __builtin_amdgcn_fence(__ATOMIC_ACQUIRE, "agent");
#pragma unroll 2
    for (int xs = 0; xs < 8; ++xs) {
      f32x4* xr = (f32x4*)(a.out + (size_t)t * DM + xs * 128 + c * 32); const f32x4* gp = (const f32x4*)(a.in[21] + xs * 128 + c * 32);
#pragma unroll
      for (int k = 0; k < 8; ++k) xr[k] = xr[k] * r2 * gp[k];
    }
  }
}

namespace upm {
typedef int v8i __attribute__((ext_vector_type(8)));
struct GBuf { u32x4 r[16]; };
__device__ __forceinline__ void issue(GBuf& G, const unsigned char* ups, const unsigned char* wl, int u, int lane) {
  const unsigned char* sl = ups + (size_t)(u >> 4) * (NEXP * 128);
  const unsigned short* ip = (const unsigned short*)(wl + 12288 + (u & 15) * 256) + (lane >> 3);
  const unsigned lp = (unsigned)(lane & 7) * 16u;
#pragma unroll
  for (int i = 0; i < 16; ++i) { const unsigned id = ip[8 * i]; G.r[i] = *(const u32x4*)(sl + ((id << 7) | lp)); }
}
__device__ __forceinline__ size_t xoff(int u, int t0, int lane) { return (size_t)(t0 + (u & 15)) * DM + (u >> 4) * 128 + (lane >> 4) * 32 + 2 * (lane & 15); }
__device__ __forceinline__ void process(const Args& a, GBuf& G, unsigned char* wl, int u, int t0, int lane, float inv_s_l, unsigned selE, unsigned selO, int wa0, int wa1, const int (&ta)[4], const unsigned xold2) {
  const int tk = u & 15, g = lane >> 4, n = lane & 15;
  unsigned* xp = (unsigned*)((bf16_t*)(a.ws + WS_HB) + xoff(u, t0, lane));
  const f32x2 xold = (f32x2){bflo(xold2), bfhi(xold2)};
  const float inv_s = __uint_as_float(__builtin_amdgcn_readlane(__float_as_uint(inv_s_l), tk));
  const att::lds_cptr wl3 = (att::lds_cptr)wl;
  f32x4 C[4];
#pragma unroll
  for (int kh = 0; kh < 2; ++kh) {
    asm volatile("" ::: "memory");
#pragma unroll
    for (int i = 0; i < 8; ++i) *(u32x4*)(wl + (((i >> 1) & 1) ? wa1 : wa0) + 1024 * i) = G.r[8 * kh + i];
    asm volatile("" ::: "memory");
    const u32x4 S = *(const u32x4*)(wl + 8192 + tk * 256 + ((n >> 1) & 1) * 128 + 64 * kh + 16 * g);
    v8i A;
#pragma unroll
    for (int j = 0; j < 8; ++j) { const unsigned s = (j >> 1) == 0 ? S.x : (j >> 1) == 1 ? S.y : (j >> 1) == 2 ? S.z : S.w; A[j] = (int)__builtin_amdgcn_perm(s, s, (j & 1) ? selO : selE); }
    v8i B[4];
#pragma unroll
    for (int ng = 0; ng < 4; ++ng)
#pragma unroll
      for (int q = 0; q < 4; ++q) { const u32x2 v = __builtin_bit_cast(u32x2, att::vtr(wl3 + ta[ng] + 512 * q)); B[ng][2 * q] = (int)v.x; B[ng][2 * q + 1] = (int)v.y; }
#pragma unroll
    for (int ng = 0; ng < 4; ++ng) {
      const f32x4 c0 = kh ? C[ng] : (f32x4){0.f, 0.f, 0.f, 0.f};
      C[ng] = __builtin_amdgcn_mfma_scale_f32_16x16x128_f8f6f4(A, B[ng], c0, 0, 0, 0, 127, 0, 127);
    }
  }
  const f32x4 c = g == 0 ? C[0] : g == 1 ? C[1] : g == 2 ? C[2] : C[3];
  f32x2 y; y.x = (c[0] + c[2] * 0.0625f) * inv_s; y.y = (c[1] + c[3] * 0.0625f) * inv_s;
  *xp = pk2(xold.x + y.x, xold.y + y.y);
}
}
__device__ __forceinline__ void phase_exp_up3(const Args& a, unsigned char* lds, int wave, int lane) {
  unsigned char* ws = a.ws;
  const int* eidx = (const int*)(ws + WS_EIDX); const float* wgt = (const float*)(ws + WS_W);
  const unsigned char* ups = ws + WS_EXU;
  unsigned char* wl = lds + wave * 16384;
  const int g = lane >> 4, rq = (lane & 15) >> 2, cq = lane & 3;
  const unsigned selE = (lane & 1) ? 0x010c000cu : 0x0c010c00u, selO = (lane & 1) ? 0x030c020cu : 0x0c030c02u;
  const int wpos = (lane & 7) ^ (2 * ((lane >> 4) & 1));
  const int wa0 = (lane >> 3) * 128 + wpos * 16, wa1 = (lane >> 3) * 128 + (wpos ^ 4) * 16;
  const int fl = ((rq >> 1) & 1) + 2 * (g & 1);
  int ta[4];
#pragma unroll
  for (int ng = 0; ng < 4; ++ng) ta[ng] = (16 * g + rq) * 128 + (2 * (ng ^ fl) + (cq >> 1)) * 16 + (cq & 1) * 8;
  for (int blk = blockIdx.x; blk < NT / 128; blk += gridDim.x) {
    const int t0 = blk * 128 + wave * 16;
    float inv_s_l = 1.f;
    __builtin_amdgcn_wave_barrier();
#pragma unroll 2
    for (int tk = 0; tk < 16; ++tk) {
      const size_t o = (size_t)(t0 + tk) * 128;
      const unsigned ea = (unsigned)eidx[o + lane], eb = (unsigned)eidx[o + 64 + lane];
      const float wa = wgt[o + lane], wb = wgt[o + 64 + lane];
      float mx = fmaxf(fabsf(wa), fabsf(wb));
#pragma unroll
      for (int of = 1; of < 64; of <<= 1) mx = fmaxf(mx, __shfl_xor(mx, of));
      const float s = mx > 0.f ? 256.f / mx : 1.f;
      if (lane == tk) inv_s_l = mx > 0.f ? mx * (1.f / 256.f) : 1.f;
      const float fa = wa * s, fb = wb * s;
      const int pk = __builtin_amdgcn_cvt_pk_fp8_f32(fa, fb, 0, false);
      const float da = __builtin_amdgcn_cvt_f32_fp8(pk, 0), db = __builtin_amdgcn_cvt_f32_fp8(pk, 1);
      const int pl = __builtin_amdgcn_cvt_pk_fp8_f32((fa - da) * 16.f, (fb - db) * 16.f, 0, false);
      unsigned char* wq = wl + 8192 + tk * 256;
      wq[lane] = (unsigned char)(pk & 0xff); wq[64 + lane] = (unsigned char)((pk >> 8) & 0xff); wq[128 + lane] = (unsigned char)(pl & 0xff); wq[192 + lane] = (unsigned char)((pl >> 8) & 0xff);
      unsigned short* ix = (unsigned short*)(wl + 12288 + tk * 256);
      ix[lane] = (unsigned short)ea; ix[64 + lane] = (unsigned short)eb;
    }
    __builtin_amdgcn_wave_barrier();
    asm volatile("" ::: "memory");
    upm::GBuf GA, GB;
    upm::issue(GA, ups, wl, 0, lane);
#pragma unroll 1
    for (int u = 0; u < 128; u += 2) {
      const unsigned xa = *(const unsigned*)((const bf16_t*)(ws + WS_HB) + upm::xoff(u, t0, lane));
      __builtin_amdgcn_sched_barrier(0);
      upm::issue(GB, ups, wl, u + 1, lane);
      __builtin_amdgcn_sched_barrier(0);
      upm::process(a, GA, wl, u, t0, lane, inv_s_l, selE, selO, wa0, wa1, ta, xa);
      const unsigned xb = *(const unsigned*)((const bf16_t*)(ws + WS_HB) + upm::xoff(u + 1, t0, lane));
      __builtin_amdgcn_sched_barrier(0);
      if (u + 2 < 128) upm::issue(GA, ups, wl, u + 2, lane);
      __builtin_amdgcn_sched_barrier(0);
      upm::process(a, GB, wl, u + 1, t0, lane, inv_s_l, selE, selO, wa0, wa1, ta, xb);
    }
    asm volatile("s_waitcnt vmcnt(0)" ::: "memory");
    __builtin_amdgcn_fence(__ATOMIC_ACQUIRE, "agent");
#pragma unroll 2
    for (int tk = 0; tk < 16; ++tk) {
      const u32x4* hr = (const u32x4*)((const bf16_t*)(ws + WS_HB) + (size_t)(t0 + tk) * DM) + lane;
      f32x4* xr = (f32x4*)(a.out + (size_t)(t0 + tk) * DM) + 2 * lane;
      float v[16]; float s = 0.f;
      unpack8(hr[0], v); unpack8(hr[64], v + 8);
#pragma unroll
      for (int j = 0; j < 16; ++j) s += v[j] * v[j];
      const float r2 = rsqrtf(wave_sum(s) * (1.f / DM) + EPS);
      const f32x4* gp = (const f32x4*)a.in[21] + 2 * lane;
      xr[0] = (f32x4){v[0], v[1], v[2], v[3]} * r2 * gp[0]; xr[1] = (f32x4){v[4], v[5], v[6], v[7]} * r2 * gp[1];
      xr[128] = (f32x4){v[8], v[9], v[10], v[11]} * r2 * gp[128]; xr[129] = (f32x4){v[12], v[13], v[14], v[15]} * r2 * gp[129];
    }
  }
}

__device__ __forceinline__ void phase_final(const Args& a, int gw, int ngw, int lane) {
  const float* ss = (const float*)(a.ws + WS_SS3);
  for (int r = gw; r < NT; r += ngw) {
    const float r2 = rsqrtf(ss[r] * (1.f / DM) + EPS);
    f32x4* xr = (f32x4*)(a.out + (size_t)r * DM) + lane;
#pragma unroll
    for (int j = 0; j < 4; ++j) { const f32x4 g = ((const f32x4*)a.in[21])[64 * j + lane]; xr[64 * j] = xr[64 * j] * r2 * g; }
  }
}

namespace pg8 {
#define PG8_LAS __attribute__((address_space(3)))
typedef unsigned short bf16_t;
typedef short bf16x8 __attribute__((ext_vector_type(8)));
typedef float f32x4 __attribute__((ext_vector_type(4)));
typedef unsigned u32x4 __attribute__((ext_vector_type(4)));
constexpr int BM = 256, BK = 64, HALF = 128, HTB = HALF * BK * 2  , STAGE_BYTES = 8 * HTB, NXCD = 8, WGM = 8;

__host__ __device__ __forceinline__ int lds_byte(int r, int c) { const int st = (r >> 4) * 2 + (c >> 5), rr = r & 15, cc = c & 31, ob = rr * 64 + cc * 2; return st * 1024 + (ob ^ (((ob >> 9) & 1) << 5)); }
__host__ __device__ __forceinline__ void stage_rc(int b, int& R, int& C) { const int st = b / 1024, sb = b % 1024, swz = sb ^ (((sb >> 9) & 1) << 5); R = (st >> 1) * 16 + swz / 64; C = (st & 1) * 32 + (swz % 64) / 2; }
__host__ __device__ __forceinline__ int perm32(int rho) { const int n = rho >> 4, i = rho & 15; return 8 * (i >> 2) + 4 * n + (i & 3); }

struct Unit { int pm, pn; };
struct Gemm { const bf16_t* A; const bf16_t* Bt; int M, N, K; };

struct StaticOrder {
    int nM, nN, nwg, G, c;
    __host__ __device__ void init(int M, int N, int G_, int c_) { nM = M / BM; nN = N / BM; nwg = nM * nN; G = G_; c = c_; }
    __host__ __device__ bool next(int i, Unit& u) const {
        const long L = (long)i * G + c; if (L >= nwg) return false;
        int wgid = (int)L; { const int q = nwg / NXCD, r = nwg % NXCD, xcd = wgid % NXCD, off = wgid / NXCD; wgid = (xcd < r ? xcd * (q + 1) : r * (q + 1) + (xcd - r) * q) + off; }
        const int nig = WGM * nN, gid = wgid / nig, fm = gid * WGM, gsz = (nM - fm) < WGM ? (nM - fm) : WGM;
        u.pm = fm + ((wgid % nig) % gsz); u.pn = (wgid % nig) / gsz; return true;
    }
    __device__ __forceinline__ void a_ready(const Unit&) const {}
    __device__ __forceinline__ void done(const Unit&) const {}
};

template <class St> struct EpiAdapt8 {
    static constexpr bool PERM = true, AFTER_DRAIN = false; St st;
    __device__ __forceinline__ void operator()(const f32x4 (&acc)[2][2][4][2], const Unit& u, int wr, int wc, int fr, int fq) const {
#pragma unroll
        for (int ai = 0; ai < 2; ++ai)
#pragma unroll
            for (int m = 0; m < 4; ++m)
#pragma unroll
                for (int bj = 0; bj < 2; ++bj) st.store8(u.pm * BM + ai * HALF + wr * 64 + m * 16 + fr, u.pn * BM + bj * HALF + wc * 32 + 8 * fq, acc[ai][bj][m][0], acc[ai][bj][m][1]);
    }
};
struct EpiQKVx {
    static constexpr bool PERM = true, AFTER_DRAIN = false; bf16_t* O; float* kmean; unsigned* kn2p;
    __device__ __forceinline__ void operator()(const f32x4 (&acc)[2][2][4][2], const Unit& u, int wr, int wc, int fr, int fq) const {
        const int pn = u.pn;
        const float sc = (pn < 2 || pn == 6 || pn == 7) ? 0.18033688011112042f : 1.f;
#pragma unroll
        for (int ai = 0; ai < 2; ++ai)
#pragma unroll
            for (int m = 0; m < 4; ++m)
#pragma unroll
                for (int bj = 0; bj < 2; ++bj) {
                    const int row = u.pm * BM + ai * HALF + wr * 64 + m * 16 + fr, col = pn * BM + bj * HALF + wc * 32 + 8 * fq;
                    const f32x4 a = acc[ai][bj][m][0] * sc, b = acc[ai][bj][m][1] * sc;
                    const float f0 = a.x, f1 = a.y, f2 = a.z, f3 = a.w, f4 = b.x, f5 = b.y, f6 = b.z, f7 = b.w;
                    *(u32x4*)(O + (size_t)row * 3072 + col) = (u32x4){::pk2(f0, f1), ::pk2(f2, f3), ::pk2(f4, f5), ::pk2(f6, f7)};
                }
        if (pn == 2 || pn == 3) {
#pragma unroll
            for (int bj = 0; bj < 2; ++bj) {
                f32x4 s0 = (f32x4){0.f, 0.f, 0.f, 0.f}, s1 = s0;
#pragma unroll
                for (int ai = 0; ai < 2; ++ai)
#pragma unroll
                    for (int m = 0; m < 4; ++m) { s0 = s0 + acc[ai][bj][m][0]; s1 = s1 + acc[ai][bj][m][1]; }
                float v[8] = {s0.x, s0.y, s0.z, s0.w, s1.x, s1.y, s1.z, s1.w};
#pragma unroll
                for (int k = 0; k < 8; ++k) { v[k] += ::swz_xor<1>(v[k]); v[k] += ::swz_xor<2>(v[k]); v[k] += ::swz_xor<4>(v[k]); v[k] += ::swz_xor<8>(v[k]); }
                if (fr == 0) {
                    const int c = (pn - 2) * BM + bj * HALF + wc * 32 + 8 * fq;
                    float* d = kmean + ((size_t)u.pm * 8 + (c >> 6)) * 64 + (c & 63);
#pragma unroll
                    for (int k = 0; k < 8; ++k) atomicAdd(d + k, v[k] * (1.f / 256.f));
                }
            }
        } else if (pn == 8 || pn == 9) {
#pragma unroll
            for (int bj = 0; bj < 2; ++bj) {
                float mx = 0.f;
#pragma unroll
                for (int ai = 0; ai < 2; ++ai)
#pragma unroll
                    for (int m = 0; m < 4; ++m) { const f32x4 a = acc[ai][bj][m][0], b = acc[ai][bj][m][1];
                        float s = (a.x * a.x + a.y * a.y) + (a.z * a.z + a.w * a.w) + (b.x * b.x + b.y * b.y) + (b.z * b.z + b.w * b.w);
                        s += __shfl_xor(s, 16); s += __shfl_xor(s, 32);
                        mx = fmaxf(mx, s); }
                mx = fmaxf(mx, ::swz_xor<1>(mx)); mx = fmaxf(mx, ::swz_xor<2>(mx)); mx = fmaxf(mx, ::swz_xor<4>(mx)); mx = fmaxf(mx, ::swz_xor<8>(mx));
                if (fr == 0 && fq == 0) {
                    const int c = (pn - 8) * BM + bj * HALF + wc * 32;
                    atomicMax(kn2p + ((u.pm >> 4) * 8 + (c >> 6)) * 2 + ((c >> 5) & 1), __float_as_uint(mx));
                }
            }
        }
    }
};
template <class St> struct EpiAdapt {
    static constexpr bool PERM = false, AFTER_DRAIN = false; St st;
    __device__ __forceinline__ void operator()(const f32x4 (&acc)[2][2][4][2], const Unit& u, int wr, int wc, int fr, int fq) const {
#pragma unroll
        for (int ai = 0; ai < 2; ++ai)
#pragma unroll
            for (int m = 0; m < 4; ++m)
#pragma unroll
                for (int bj = 0; bj < 2; ++bj)
#pragma unroll
                    for (int n = 0; n < 2; ++n) st.store(u.pm * BM + ai * HALF + wr * 64 + m * 16 + fr, u.pn * BM + bj * HALF + wc * 32 + n * 16 + 4 * fq, acc[ai][bj][m][n]);
    }
};

struct MidONorm { static constexpr int AT = 8; const float* sso;
    __device__ __forceinline__ void scale(f32x4 (&acc)[2][2][4][2], const Unit& u, int wr, int fr) const {
        int row0 = u.pm * BM + wr * 64 + fr;
        asm volatile("" : "+v"(row0));
#pragma unroll
        for (int ai = 0; ai < 2; ++ai)
#pragma unroll
            for (int m = 0; m < 4; ++m) { const int row = row0 + ai * HALF + m * 16;
                const float f = __builtin_amdgcn_rsqf(sso[row] * (1.f / 512.f) + 1e-6f) * __builtin_amdgcn_sqrtf(sso[32768 + row] * (1.f / 512.f) + 1e-6f);
#pragma unroll
                for (int bj = 0; bj < 2; ++bj)
#pragma unroll
                    for (int n = 0; n < 2; ++n) acc[ai][bj][m][n] *= f; }
    }
};
struct EpiResidSS {
    static constexpr bool PERM = true, AFTER_DRAIN = false; const float* basef; bf16_t* hb; float* ss; const float* rs2;
    __device__ __forceinline__ void operator()(const f32x4 (&acc)[2][2][4][2], const Unit& u, int wr, int wc, int fr, int fq) const {
#pragma unroll
        for (int ai = 0; ai < 2; ++ai)
#pragma unroll
            for (int m = 0; m < 4; ++m) {
                const int row = u.pm * BM + ai * HALF + wr * 64 + m * 16 + fr; float s = 0.f;
                const float rsc = rs2 ? __builtin_amdgcn_rsqf(rs2[row] * (1.f / 512.f) + 1e-6f) : 1.f;
#pragma unroll
                for (int bj = 0; bj < 2; ++bj) {
                    const size_t o = (size_t)row * 1024 + u.pn * BM + bj * HALF + wc * 32 + 8 * fq;
                    f32x4 b0, b1;
                    if (basef) { b0 = *(const f32x4*)(basef + o); b1 = *(const f32x4*)(basef + o + 4); }
                    else { const u32x4 w = *(const u32x4*)(hb + o); b0 = (f32x4){::bflo(w.x), ::bfhi(w.x), ::bflo(w.y), ::bfhi(w.y)}; b1 = (f32x4){::bflo(w.z), ::bfhi(w.z), ::bflo(w.w), ::bfhi(w.w)}; }
                    const f32x4 v0 = b0 + acc[ai][bj][m][0] * rsc, v1 = b1 + acc[ai][bj][m][1] * rsc;
                    { const float f0 = v0.x, f1 = v0.y, f2 = v0.z, f3 = v0.w, f4 = v1.x, f5 = v1.y, f6 = v1.z, f7 = v1.w;
                      *(u32x4*)(hb + o) = (u32x4){::pk2(f0, f1), ::pk2(f2, f3), ::pk2(f4, f5), ::pk2(f6, f7)}; }
                    s += (v0.x * v0.x + v0.y * v0.y) + (v0.z * v0.z + v0.w * v0.w) + (v1.x * v1.x + v1.y * v1.y) + (v1.z * v1.z + v1.w * v1.w);
                }
                s += __shfl_xor(s, 16); s += __shfl_xor(s, 32);
                if (fq == 0) atomicAdd(ss + row, s);
            }
    }
};
struct NoMid { static constexpr int AT = 0; __device__ __forceinline__ void scale(f32x4 (&)[2][2][4][2], const Unit&, int, int) const {} };
template <class Epi, class Sched, bool ALIGN_EPI = false, bool SP2 = false, class Mid = NoMid>
__device__ __forceinline__ void gemm_phase(PG8_LAS unsigned char* lds, const Gemm g, const Sched& S, const Epi& E, const Mid MID = Mid()) {
    const int tid = threadIdx.x, wid = __builtin_amdgcn_readfirstlane(tid >> 6), lane = tid & 63, wr = wid >> 2, wc = wid & 3, fr = lane & 15, fq = lane >> 4;
    const int K = g.K, nt = K / BK;
    unsigned voffA[2], voffB[2];
#pragma unroll
    for (int i = 0; i < 2; ++i) { int R, C; stage_rc(tid * 16 + i * 8192, R, C); const int Rb = Epi::PERM ? ((R & ~31) + perm32(R & 31)) : R;
        voffA[i] = (unsigned)(R * K + C) * 2u; voffB[i] = (unsigned)(Rb * K + C) * 2u; }
    const size_t kstep = (size_t)(BK * 2);
    const size_t hstep = (size_t)HALF * K * 2;
    const size_t tstep = 2 * hstep;
    const unsigned ldsw = (unsigned)wid * 1024u;
    const int aoff = lds_byte(wr * 64 + fr, fq * 8), boff = lds_byte(wc * 32 + fr, fq * 8);
#define PG8_SA(b, h) (((b) * 2 + (h)) * HTB)
#define PG8_SB(b, h) ((4 + (b) * 2 + (h)) * HTB)
#define PG8_STAGE(bufoff, gbase, voff) do { _Pragma("unroll") for (int _i = 0; _i < 2; ++_i) \
        __builtin_amdgcn_global_load_lds((const unsigned*)((const char*)(gbase) + (voff)[_i]), (PG8_LAS unsigned*)(lds + (bufoff) + ldsw + _i * 8192), 16, 0, 0); } while (0)
#define PG8_LDA(dst, b, h) do { _Pragma("unroll") for (int m = 0; m < 4; ++m) _Pragma("unroll") for (int k = 0; k < 2; ++k) dst[m][k] = *(const PG8_LAS bf16x8*)(lds + PG8_SA(b, h) + aoff + m * 2048 + k * 1024); } while (0)
#define PG8_LDB(dst, b, h) do { _Pragma("unroll") for (int n = 0; n < 2; ++n) _Pragma("unroll") for (int k = 0; k < 2; ++k) dst[n][k] = *(const PG8_LAS bf16x8*)(lds + PG8_SB(b, h) + boff + n * 2048 + k * 1024); } while (0)
#define PG8_MMA(ai, bj, At, Bt) do { __builtin_amdgcn_s_setprio(1); _Pragma("unroll") for (int m = 0; m < 4; ++m) _Pragma("unroll") for (int n = 0; n < 2; ++n) _Pragma("unroll") for (int k = 0; k < 2; ++k) \
        acc[ai][bj][m][n] = __builtin_amdgcn_mfma_f32_16x16x32_bf16(Bt[n][k], At[m][k], acc[ai][bj][m][n], 0, 0, 0); __builtin_amdgcn_s_setprio(0); } while (0)
#define PG8_WAIT_V(n) asm volatile("s_waitcnt vmcnt(" #n ")" ::: "memory")
#define PG8_WAIT_L(n) asm volatile("s_waitcnt lgkmcnt(" #n ")" ::: "memory")
#define PG8_BAR __builtin_amdgcn_s_barrier()
#define PG8_SCHED __builtin_amdgcn_sched_barrier(0)
    Unit cur, nxt; int ui = 0;
    if (!S.next(0, cur)) return;
    f32x4 acc[2][2][4][2];
#pragma unroll
    for (int a = 0; a < 2; ++a)
#pragma unroll
        for (int b = 0; b < 2; ++b)
#pragma unroll
            for (int m = 0; m < 4; ++m)
#pragma unroll
                for (int n = 0; n < 2; ++n) acc[a][b][m][n] = (f32x4){0.f, 0.f, 0.f, 0.f};
    bf16x8 At[4][2], B0[2][2], B1[2][2];
    const char* cA = (const char*)g.A + (size_t)cur.pm * tstep; const char* cB = (const char*)g.Bt + (size_t)cur.pn * tstep;
    S.a_ready(cur);
    if constexpr (SP2) {
        PG8_STAGE(PG8_SB(0, 0), cB, voffB); PG8_STAGE(PG8_SB(0, 1), cB + hstep, voffB); PG8_STAGE(PG8_SA(0, 0), cA, voffA); PG8_STAGE(PG8_SA(0, 1), cA + hstep, voffA);
        if (wr == 1) PG8_BAR;
        PG8_WAIT_V(2); PG8_BAR;
        PG8_STAGE(PG8_SB(1, 0), cB + kstep, voffB); PG8_STAGE(PG8_SA(1, 0), cA + kstep, voffA); PG8_STAGE(PG8_SB(1, 1), cB + hstep + kstep, voffB);
        PG8_WAIT_V(6); PG8_BAR;
    } else {
        PG8_STAGE(PG8_SB(0, 0), cB, voffB); PG8_STAGE(PG8_SA(0, 0), cA, voffA); PG8_STAGE(PG8_SB(0, 1), cB + hstep, voffB); PG8_STAGE(PG8_SA(0, 1), cA + hstep, voffA);
        if (wr == 1) PG8_BAR;
        PG8_WAIT_V(4); PG8_BAR;
        PG8_STAGE(PG8_SB(1, 0), cB + kstep, voffB); PG8_STAGE(PG8_SA(1, 0), cA + kstep, voffA); PG8_STAGE(PG8_SB(1, 1), cB + hstep + kstep, voffB);
        PG8_WAIT_V(6); PG8_BAR;
    }
    for (;;) {
        const bool has_next = S.next(ui + 1, nxt);
        const char* nA = has_next ? (const char*)g.A + (size_t)nxt.pm * tstep : cA; const char* nB = has_next ? (const char*)g.Bt + (size_t)nxt.pn * tstep : cB;
        for (int t = 0; t < nt; t += 2) {
            if (Mid::AT != 0 && t == Mid::AT) MID.scale(acc, cur, wr, fr);
            const bool last = (t == nt - 2);
            const char* a1 = cA + (size_t)(t + 1) * kstep;
            const char* a2 = last ? nA : cA + (size_t)(t + 2) * kstep; const char* b2 = last ? nB : cB + (size_t)(t + 2) * kstep;
            const char* a3 = a2 + kstep; const char* b3 = b2 + kstep;
            if (last && has_next) S.a_ready(nxt);
            if constexpr (SP2) {
            PG8_LDB(B0, 0, 0); PG8_LDB(B1, 0, 1); PG8_SCHED; PG8_LDA(At, 0, 0); PG8_STAGE(PG8_SA(1, 1), a1 + hstep, voffA);
            PG8_WAIT_V(8); PG8_WAIT_L(0); PG8_BAR; PG8_MMA(0, 0, At, B0); PG8_MMA(0, 1, At, B1); PG8_BAR; PG8_SCHED;
            PG8_LDA(At, 0, 1); PG8_STAGE(PG8_SB(0, 0), b2, voffB); PG8_STAGE(PG8_SB(0, 1), b2 + hstep, voffB); PG8_STAGE(PG8_SA(0, 0), a2, voffA);
            PG8_WAIT_V(8); PG8_WAIT_L(0); PG8_BAR; PG8_MMA(1, 0, At, B0); PG8_MMA(1, 1, At, B1); PG8_BAR; PG8_SCHED;
            PG8_LDB(B0, 1, 0); PG8_LDB(B1, 1, 1); PG8_SCHED; PG8_LDA(At, 1, 0); PG8_STAGE(PG8_SA(0, 1), a2 + hstep, voffA);
            PG8_WAIT_V(8); PG8_WAIT_L(0); PG8_BAR; PG8_MMA(0, 0, At, B0); PG8_MMA(0, 1, At, B1); PG8_BAR; PG8_SCHED;
            PG8_LDA(At, 1, 1); PG8_STAGE(PG8_SB(1, 0), b3, voffB); PG8_STAGE(PG8_SB(1, 1), b3 + hstep, voffB); PG8_STAGE(PG8_SA(1, 0), a3, voffA);
            PG8_WAIT_V(8); PG8_WAIT_L(0); PG8_BAR; PG8_MMA(1, 0, At, B0); PG8_MMA(1, 1, At, B1); PG8_BAR; PG8_SCHED;
            } else {
            PG8_LDB(B0, 0, 0); PG8_SCHED; PG8_LDA(At, 0, 0); PG8_STAGE(PG8_SA(1, 1), a1 + hstep, voffA);
            PG8_WAIT_L(8); PG8_BAR; PG8_WAIT_L(0); PG8_MMA(0, 0, At, B0); PG8_BAR; PG8_SCHED;
            PG8_LDB(B1, 0, 1); PG8_STAGE(PG8_SB(0, 0), b2, voffB);
            PG8_BAR; PG8_WAIT_L(0); PG8_MMA(0, 1, At, B1); PG8_BAR;
            PG8_LDA(At, 0, 1); PG8_STAGE(PG8_SA(0, 0), a2, voffA);
            PG8_BAR; PG8_WAIT_L(0); PG8_MMA(1, 0, At, B0); PG8_BAR; PG8_SCHED;
            PG8_STAGE(PG8_SB(0, 1), b2 + hstep, voffB);
            PG8_WAIT_V(6); PG8_BAR; PG8_MMA(1, 1, At, B1); PG8_BAR;
            PG8_LDB(B0, 1, 0); PG8_SCHED; PG8_LDA(At, 1, 0); PG8_STAGE(PG8_SA(0, 1), a2 + hstep, voffA);
            PG8_WAIT_L(8); PG8_BAR; PG8_WAIT_L(0); PG8_MMA(0, 0, At, B0); PG8_BAR; PG8_SCHED;
            PG8_LDB(B1, 1, 1); PG8_STAGE(PG8_SB(1, 0), b3, voffB);
            PG8_BAR; PG8_WAIT_L(0); PG8_MMA(0, 1, At, B1); PG8_BAR;
            PG8_LDA(At, 1, 1); PG8_STAGE(PG8_SA(1, 0), a3, voffA);
            PG8_BAR; PG8_WAIT_L(0); PG8_MMA(1, 0, At, B0); PG8_BAR; PG8_SCHED;
            PG8_STAGE(PG8_SB(1, 1), b3 + hstep, voffB);
            PG8_WAIT_V(6); PG8_BAR; PG8_MMA(1, 1, At, B1); PG8_BAR;
            }
        }
        if constexpr (ALIGN_EPI) { if (wr == 0) PG8_BAR; }
        if constexpr (!Epi::AFTER_DRAIN) { E(acc, cur, wr, wc, fr, fq); S.done(cur); }
        if (!has_next) break;
#pragma unroll
        for (int a = 0; a < 2; ++a)
#pragma unroll
            for (int b = 0; b < 2; ++b)
#pragma unroll
                for (int m = 0; m < 4; ++m)
#pragma unroll
                    for (int n = 0; n < 2; ++n) acc[a][b][m][n] = (f32x4){0.f, 0.f, 0.f, 0.f};
        cur = nxt; cA = nA; cB = nB; ++ui;
        if constexpr (ALIGN_EPI) { if (wr == 1) PG8_BAR; }
    }
    PG8_WAIT_V(0);
    if constexpr (!ALIGN_EPI) { if (wr == 0) PG8_BAR; }
    PG8_BAR;
    if constexpr (Epi::AFTER_DRAIN) { E.fused(acc, cur, wr, wc, fr, fq, lds, wid, lane); S.done(cur); }
#undef PG8_SA
#undef PG8_SB
#undef PG8_STAGE
#undef PG8_LDA
#undef PG8_LDB
#undef PG8_MMA
#undef PG8_WAIT_V
#undef PG8_WAIT_L
#undef PG8_BAR
#undef PG8_SCHED
}
}


template <class Epi, class Mid>
__device__ __forceinline__ void run_gemm_mid(unsigned char* lds, const bf16_t* A, const bf16_t* Bt, int M, int N, int K, const Epi& E, const Mid& MD) {
  pg8::Gemm g{A, Bt, M, N, K}; pg8::StaticOrder S; S.init(M, N, (int)gridDim.x, (int)blockIdx.x);
  pg8::gemm_phase<Epi, pg8::StaticOrder, true, true, Mid>((PG8_LAS unsigned char*)lds, g, S, E, MD);
}
template <class Epi>
__device__ __forceinline__ void run_gemm_raw(unsigned char* lds, const bf16_t* A, const bf16_t* Bt, int M, int N, int K, const Epi& E) {
  pg8::Gemm g{A, Bt, M, N, K}; pg8::StaticOrder S; S.init(M, N, (int)gridDim.x, (int)blockIdx.x);
  pg8::gemm_phase<Epi, pg8::StaticOrder, true, true>((PG8_LAS unsigned char*)lds, g, S, E);
}
template <class St>
__device__ __forceinline__ void run_gemm8(unsigned char* lds, const bf16_t* A, const bf16_t* Bt, int M, int N, int K, const St& st) {
  pg8::Gemm g{A, Bt, M, N, K}; pg8::StaticOrder S; S.init(M, N, (int)gridDim.x, (int)blockIdx.x);
  pg8::EpiAdapt8<St> E{st};
  pg8::gemm_phase<pg8::EpiAdapt8<St>, pg8::StaticOrder, true, true>((PG8_LAS unsigned char*)lds, g, S, E);
}
template <class St>
__device__ __forceinline__ void run_gemm(unsigned char* lds, const bf16_t* A, const bf16_t* Bt, int M, int N, int K, const St& st, int gw, int ngw, int lane) {
#if USE_PG8
  pg8::Gemm g{A, Bt, M, N, K}; pg8::StaticOrder S; S.init(M, N, (int)gridDim.x, (int)blockIdx.x);
  pg8::EpiAdapt<St> E{st};
  pg8::gemm_phase<pg8::EpiAdapt<St>, pg8::StaticOrder, true, true>((PG8_LAS unsigned char*)lds, g, S, E);
#else
  gemm_naive(A, K, Bt, K, M, N, K, st, gw, ngw, lane);
#endif
}

#define GAS __attribute__((address_space(1)))
#define LAS __attribute__((address_space(3)))
#define XB_TMO      128
#define XB_XCNT(j)  (256  + 64 * (j))
#define XB_XSUB(j)  (1280 + 64 * (j))
#define XB_XGEN(j)  (2304 + 64 * (j))
#define XB_TOP      3328
#define XB_TOPGEN   3392
#define XCD_BAR_WORDS 3456
#define XB_SPIN_CAP (1u << 18)

__device__ __forceinline__ unsigned xb_ld(unsigned* p)              { return __hip_atomic_load(p, __ATOMIC_RELAXED, __HIP_MEMORY_SCOPE_AGENT); }
__device__ __forceinline__ unsigned xb_add(unsigned* p, unsigned v) { return __hip_atomic_fetch_add(p, v, __ATOMIC_RELAXED, __HIP_MEMORY_SCOPE_AGENT); }
__device__ __forceinline__ unsigned xb_xcc_id() { return (unsigned)__builtin_amdgcn_s_getreg((3 << 11) | 20) & 0xFu; }
#define XB_SPIN(cond, bar) do { unsigned _sp = 0; while (cond) { __builtin_amdgcn_s_sleep(1); \
    if ((++_sp & 255u) == 0u) { if (xb_ld(&(bar)[XB_TMO])) break; if (_sp > XB_SPIN_CAP) { atomicAdd(&(bar)[XB_TMO], 1u); break; } } } } while (0)

struct XcdBarrier {
    unsigned* bar; unsigned x;
    volatile LAS unsigned* st;
};

__device__ __forceinline__ XcdBarrier xcd_barrier_post(unsigned* bar, volatile LAS unsigned* st) {
    XcdBarrier b; b.bar = bar; b.x = xb_xcc_id(); b.st = st;
    if (threadIdx.x == 0) (void)xb_add(&bar[XB_XCNT(b.x)], 1u);
    return b;
}
__device__ __forceinline__ void xcd_barrier_complete(unsigned* bar, unsigned x, unsigned& nloc, unsigned& nx) {
    const unsigned G = gridDim.x * gridDim.y * gridDim.z;
    unsigned sum, cnt, mine, sp = 0u;
    for (;;) {
        sum = 0u; cnt = 0u; mine = 0u;
#pragma unroll
        for (unsigned j = 0; j < 16; ++j) { const unsigned c = xb_ld(&bar[XB_XCNT(j)]); sum += c; cnt += (c > 0u) ? 1u : 0u; mine = (j == x) ? c : mine; }
        if (sum == G) break;
        __builtin_amdgcn_s_sleep(1);
        if ((++sp & 255u) == 0u) { if (xb_ld(&bar[XB_TMO])) break; if (sp > XB_SPIN_CAP) { atomicAdd(&bar[XB_TMO], 1u); break; } }
    }
    nloc = mine > 0u ? mine : 1u; nx = cnt > 0u ? cnt : 1u;
}

__device__ __forceinline__ void xcd_barrier(const XcdBarrier& b) {
    asm volatile("s_waitcnt vmcnt(0)" ::: "memory");
    __syncthreads();
    if (threadIdx.x == 0) {
        unsigned* bar = b.bar;
        __builtin_amdgcn_s_waitcnt(0);
        unsigned nloc = b.st[0], nx = b.st[1];
        if (nloc == 0u) { xcd_barrier_complete(bar, b.x, nloc, nx); b.st[0] = nloc; b.st[1] = nx; }
        const unsigned old = xb_add(&bar[XB_XSUB(b.x)], 1u);
        const unsigned gen = old / nloc;
        if (old + 1u == (gen + 1u) * nloc) {
            __builtin_amdgcn_fence(__ATOMIC_RELEASE, "agent");
            asm volatile("s_waitcnt vmcnt(0)" ::: "memory");
            const unsigned og = xb_add(&bar[XB_TOP], 1u);
            const unsigned tg = og / nx;
            if (og + 1u == (tg + 1u) * nx) xb_add(&bar[XB_TOPGEN], 1u);
            else XB_SPIN(xb_ld(&bar[XB_TOPGEN]) == tg, bar);
            __builtin_amdgcn_fence(__ATOMIC_ACQUIRE, "agent");
            xb_add(&bar[XB_XGEN(b.x)], 1u);
            asm volatile("s_waitcnt vmcnt(0)" ::: "memory");
        } else {
            XB_SPIN(xb_ld(&bar[XB_XGEN(b.x)]) == gen, bar);
            __builtin_amdgcn_fence(__ATOMIC_ACQUIRE, "agent");
            asm volatile("s_waitcnt vmcnt(0)" ::: "memory");
        }
    }
    __syncthreads();
}

__device__ __forceinline__ void phase_exp_up(const Args& a, unsigned char* lds, const XcdBarrier& bar, int tid, int wave, int lane, unsigned* ctr, float* xout, float* ssout) {
  unsigned* slot = (unsigned*)(lds + 8 * 16640);
  const int x0 = (int)(xb_xcc_id() & 7u);
  for (int k = 0; k < 8; ++k) {
    const int xs = (x0 + k) & 7;
    for (;;) {
      __syncthreads();
      if (tid == 0) slot[0] = atomicAdd(ctr + 16 * xs, 1u);
      __syncthreads();
      const unsigned item = slot[0];
      if (item >= (unsigned)(NT / 128)) break;
      exp_up_item(a, lds, xs, (int)item, wave, lane, xout, ssout);
    }
  }
}

__device__ __forceinline__ void phase_xattn3(const Args& a, unsigned char* lds, int tid) {
  pg8::StaticOrder S; S.init(NT, DM, (int)gridDim.x, (int)blockIdx.x); pg8::Unit u;
  for (int i = 0; S.next(i, u); ++i) xa::unit(a, lds, u.pm >> 4, u.pn, u.pm & 15, tid);
}

__global__ void __launch_bounds__(512, 2) mega(Args a) {
  extern __shared__ __attribute__((aligned(16))) unsigned char lds[];
  cg::grid_group grid = cg::this_grid();
  const int tid = threadIdx.x, lane = tid & 63, wave = tid >> 6;
  const int gw = blockIdx.x * 8 + wave, ngw = gridDim.x * 8;
  unsigned char* ws = a.ws;
  const int lo = a.ph_lo, hi = a.ph_hi;
#define IN(k) (lo <= (k) && (k) < hi)
  volatile LAS unsigned* MISC = (volatile LAS unsigned*)((LAS unsigned char*)lds + 146944);
  if (tid < 32) MISC[tid] = 0u;
  __syncthreads();
  XcdBarrier bar; bar.bar = (unsigned*)(ws + WS_BAR); bar.x = 0; bar.st = nullptr;
  if (hi - lo > 1) bar = xcd_barrier_post((unsigned*)(ws + WS_BAR), MISC + 8);
  if (lo < -1000000) grid.sync();
#define SEAM(k) do { if (IN(k) && IN((k) + 1)) xcd_barrier(bar); } while (0)
#if PROBE_REP == 0
  if (IN(0)) { phase_prep(a, lds, gw, ngw, wave, lane, tid); grid.sync(); }
#endif
  if (IN(0)) { phase_prep(a, lds, gw, ngw, wave, lane, tid); } SEAM(0);
#if PROBE_REP == 1
  if (IN(1)) {
    run_gemm8(lds, (const bf16_t*)(ws + WS_HB), (const bf16_t*)(ws + WS_WIN_T), NT, NQKV, DM, EpiQKV{(bf16_t*)(ws + WS_QKV)});
    run_gemm8(lds, (const bf16_t*)(ws + WS_MEMN), (const bf16_t*)(ws + WS_WXKV_T), NMROWS, 2048, DM, EpiBf16{(bf16_t*)(ws + WS_KX), 2048});
    xcd_barrier(bar); }
#endif
#if PROBE_REP == 2
  if (IN(2)) { phase_scan(a, gw, ngw, lane, tid); xcd_barrier(bar); phase_rms(a, gw, ngw, lane); xcd_barrier(bar); phase_rms(a, gw, ngw, lane); xcd_barrier(bar); }
#endif
  if (IN(1)) {
    run_gemm_raw(lds, (const bf16_t*)(ws + WS_HB), (const bf16_t*)(ws + WS_WIN_T), NT, NQKV, DM, pg8::EpiQKVx{(bf16_t*)(ws + WS_QKV), (float*)(ws + WS_KMEAN), (unsigned*)(ws + 2048)});
    run_gemm8(lds, (const bf16_t*)(ws + WS_MEMN), (const bf16_t*)(ws + WS_WXKV_T), NMROWS, 2048, DM, EpiBf16{(bf16_t*)(ws + WS_KX), 2048});
  }
  if (IN(1) && IN(3)) xcd_barrier(bar);
#if PROBE_REP == 3
  if (IN(3)) { phase_attn2(a, lds, tid); xcd_barrier(bar); if (blockIdx.x == 0 && tid == 0) *(unsigned*)(ws) = 0u; xcd_barrier(bar); }
#endif
  if (IN(3)) {
#if USE_ATT2
    phase_attn2(a, lds, tid);
#else
    phase_attn(a, lds, tid);
#endif
  }
  if (IN(3) && IN(5)) xcd_barrier(bar);
  if (IN(5)) { run_gemm_mid(lds, (const bf16_t*)(ws + WS_OAB), (const bf16_t*)(ws + WS_WOUT_T), NT, DM, DM, pg8::EpiResidSS{a.in[0], (bf16_t*)(ws + WS_HB), (float*)(ws + WS_SS1), (const float*)(ws + WS_SSO) + NT}, pg8::MidONorm{(const float*)(ws + WS_SSO)}); }
  if (IN(5) && IN(7)) xcd_barrier(bar);
  if (IN(7)) { run_gemm8(lds, (const bf16_t*)(ws + WS_HB), (const bf16_t*)(ws + WS_WXQ_T), NT, DM, DM, EpiBf16S{(bf16_t*)(ws + WS_QX), DM, (const float*)(ws + WS_SS1)}); }
  if (IN(7) && IN(8)) { asm volatile("s_waitcnt vmcnt(0)" ::: "memory"); __syncthreads(); if (tid == 0) { __builtin_amdgcn_fence(__ATOMIC_ACQUIRE, "agent"); asm volatile("s_waitcnt vmcnt(0)" ::: "memory"); } __syncthreads(); }
#if PROBE_REP == 8
  if (IN(8)) { phase_xattn(a, lds, gw, ngw, wave, lane); grid.sync(); }
#endif
  if (IN(8)) { phase_xattn3(a, lds, tid); } SEAM(8);
  if (IN(9)) { run_gemm_raw(lds, (const bf16_t*)(ws + WS_OX), (const bf16_t*)(ws + WS_WXO_T), NT, DM, DM, pg8::EpiResidSS{nullptr, (bf16_t*)(ws + WS_HB), (float*)(ws + WS_SS2), nullptr}); }
  if (IN(9) && IN(11)) xcd_barrier(bar);
  if (IN(11)) { run_gemm8(lds, (const bf16_t*)(ws + WS_HB), (const bf16_t*)(ws + WS_WPQ_T), NT, DM, DM, EpiBf16S{(bf16_t*)(ws + WS_PQ), DM, (const float*)(ws + WS_SS2)}); } SEAM(11);
#if PROBE_REP == 12
  if (IN(12)) { phase_topk(a, lds, tid); grid.sync(); }
#endif
  if (IN(12)) { phase_topk2(a, lds, wave, lane); }
  if (IN(12) && IN(13)) { asm volatile("s_waitcnt vmcnt(0)" ::: "memory"); __syncthreads(); if (tid == 0) { __builtin_amdgcn_fence(__ATOMIC_ACQUIRE, "agent"); asm volatile("s_waitcnt vmcnt(0)" ::: "memory"); } __syncthreads(); }
    if (IN(13)) {
#if PROBE_G == 1
    probe_gather<0>(a, wave, lane, 2047u);
#elif PROBE_G == 2
    probe_gather<1>(a, wave, lane, 2047u);
#elif PROBE_G == 3
    probe_gather<1>(a, wave, lane, 16383u);
#elif PROBE_G == 4
    probe_gather<0>(a, wave, lane, 16383u);
#endif
    phase_exp_down2(a, lds, wave, lane);
    __builtin_amdgcn_wave_barrier();
    asm volatile("s_waitcnt vmcnt(0)" ::: "memory"); __builtin_amdgcn_fence(__ATOMIC_ACQUIRE, "agent");
    phase_exp_up3(a, lds, wave, lane);
  }
#undef IN
#undef SEAM
}

extern "C" void kernel_launch(void* const* d_in, const int* in_sizes, int n_in, void* d_out, int out_size, void* d_ws, size_t ws_size, hipStream_t stream) {
  static int grid = 0;
  if (grid == 0) {
    if (n_in != 22 || out_size != NT * DM || ws_size < WS_END) { fprintf(stderr, "kernel_launch: unexpected shapes (n_in %d out %d ws %zu)\n", n_in, out_size, ws_size); grid = -1; return; }
    int dev = 0, cus = 0, per_cu = 0;
    (void)hipGetDevice(&dev);
    (void)hipDeviceGetAttribute(&cus, hipDeviceAttributeMultiprocessorCount, dev);
    (void)hipFuncSetAttribute((const void*)mega, hipFuncAttributeMaxDynamicSharedMemorySize, LDS_BYTES);
    (void)hipOccupancyMaxActiveBlocksPerMultiprocessor(&per_cu, (const void*)mega, 512, LDS_BYTES);
    if (per_cu < 1) per_cu = 1;
    grid = cus * per_cu;
  }
  if (grid < 0) return;
  (void)hipMemsetAsync(d_ws, 0, CTL_ZERO_BYTES, stream);
  Args a{};
  for (int i = 0; i < 22; ++i) a.in[i] = (const float*)d_in[i];
  a.out = (float*)d_out; a.ws = (unsigned char*)d_ws;
  a.rep_down = REP_DOWN; a.rep_up = REP_UP; a.rep_scan = REP_SCAN;
#if MK_N_LAUNCHES == 1
  a.ph_lo = 0; a.ph_hi = NPHASE + 1;
  void* args[] = {&a};
  hipError_t e = hipLaunchCooperativeKernel((const void*)mega, dim3(grid), dim3(512), args, LDS_BYTES, stream);
  if (e != hipSuccess) fprintf(stderr, "cooperative launch failed: %s (grid %d)\n", hipGetErrorString(e), grid);
#else
  for (int p = 0; p <= NPHASE; ++p) { a.ph_lo = p; a.ph_hi = p + 1; hipLaunchKernelGGL(mega, dim3(grid), dim3(512), LDS_BYTES, stream, a); }
#endif
}
```

```cpp
#include <hip/hip_runtime.h>
#include <hip/hip_cooperative_groups.h>
#include <cstdio>
#include <cstdint>
namespace cg = cooperative_groups;

#ifndef USE_PG8
#define USE_PG8 1
#endif
#ifndef USE_ATT2
#define USE_ATT2 1
#endif
#ifndef PROBE_REP
#define PROBE_REP -1
#endif
#ifndef REP_DOWN
#define REP_DOWN 1
#endif
#ifndef REP_UP
#define REP_UP 1
#endif
#ifndef REP_SCAN
#define REP_SCAN 1
#endif
#ifndef MK_N_LAUNCHES
#define MK_N_LAUNCHES 1
#endif

typedef unsigned short bf16_t;
typedef short bf16x8 __attribute__((ext_vector_type(8)));
typedef float f32x4 __attribute__((ext_vector_type(4)));
typedef unsigned u32x4 __attribute__((ext_vector_type(4)));
typedef unsigned u32x2 __attribute__((ext_vector_type(2)));
typedef float v32f __attribute__((ext_vector_type(32)));
typedef float v16f __attribute__((ext_vector_type(16)));
typedef unsigned v6u __attribute__((ext_vector_type(6)));
typedef float f32x2 __attribute__((ext_vector_type(2)));

constexpr int NB = 8, SEQ = 4096, DM = 1024, NT = NB * SEQ;
constexpr int NQKV = 3072, INW = 3080;
constexpr int NMEM = 256, NMROWS = NB * NMEM;
constexpr int NEXP = 16384;
constexpr float EPS = 1e-6f;
constexpr int NPHASE = 13;
constexpr int LDS_BYTES = 147456;

constexpr size_t MiB = 1u << 20;
constexpr size_t WS_BAR = 65536;
constexpr size_t WS_SS1 = 131072;
constexpr size_t WS_SS2 = 262144;
constexpr size_t WS_SS3 = 393216;
constexpr size_t WS_XCTR = 512;
constexpr size_t WS_SSO = 524288;
constexpr size_t CTL_ZERO_BYTES = 1048576;
constexpr size_t WS_WIN_T = 2 * MiB;
constexpr size_t WS_WOUT_T = 8 * MiB;
constexpr size_t WS_WXQ_T = 10 * MiB;
constexpr size_t WS_WXKV_T = 12 * MiB;
constexpr size_t WS_WXO_T = 16 * MiB;
constexpr size_t WS_WPQ_T = 18 * MiB;
constexpr size_t WS_SK = 21 * MiB;
constexpr size_t WS_MEMN = 22 * MiB;
constexpr size_t WS_KX = 26 * MiB;
constexpr size_t WS_VXT = 30 * MiB;
constexpr size_t WS_FLOG = 34 * MiB;
constexpr size_t WS_CUM = 35 * MiB;
constexpr size_t WS_KMEAN = 786432;
constexpr size_t WS_ESC = 38 * MiB;
constexpr size_t WS_EXD = 40 * MiB;
constexpr size_t WS_EXU = 72 * MiB;
constexpr size_t WS_HB = 104 * MiB;
constexpr size_t WS_QKV = 168 * MiB;
constexpr size_t WS_OAB = 360 * MiB;
constexpr size_t WS_QX = 168 * MiB;
constexpr size_t WS_OX = 232 * MiB;
constexpr size_t WS_PQ = 232 * MiB;
constexpr size_t WS_EIDX = 424 * MiB;
constexpr size_t WS_GATE = 440 * MiB;
constexpr size_t WS_W = 456 * MiB;
constexpr size_t WS_END = 472 * MiB;

struct Args {
  const float* in[22];
  float* out;
  unsigned char* ws;
  int ph_lo, ph_hi;
  int rep_down, rep_up, rep_scan, pad_;
};

struct XcdBarrier;
__device__ __forceinline__ unsigned f2bf(float f) { unsigned u = __float_as_uint(f); return (u + 0x7fffu + ((u >> 16) & 1u)) >> 16; }
__device__ __forceinline__ unsigned pk2(float lo, float hi) { return f2bf(lo) | (f2bf(hi) << 16); }
__device__ __forceinline__ float bf2f(unsigned short b) { return __uint_as_float(((unsigned)b) << 16); }
__device__ __forceinline__ float bflo(unsigned w) { return __uint_as_float(w << 16); }
__device__ __forceinline__ float bfhi(unsigned w) { return __uint_as_float(w & 0xffff0000u); }
__device__ __forceinline__ float wave_sum(float v) {
#pragma unroll
  for (int o = 1; o < 64; o <<= 1) v += __shfl_xor(v, o);
  return v;
}
template <int O> __device__ __forceinline__ float swz_xor(float v) { return __int_as_float(__builtin_amdgcn_ds_swizzle(__float_as_int(v), (O << 10) | 0x1f)); }
__device__ __forceinline__ float half_sum32(float v) { v += swz_xor<1>(v); v += swz_xor<2>(v); v += swz_xor<4>(v); v += swz_xor<8>(v); v += swz_xor<16>(v); return v; }
__device__ __forceinline__ void unpack8(const u32x4 w, float* f) {
  f[0] = bflo(w.x); f[1] = bfhi(w.x); f[2] = bflo(w.y); f[3] = bfhi(w.y);
  f[4] = bflo(w.z); f[5] = bfhi(w.z); f[6] = bflo(w.w); f[7] = bfhi(w.w);
}

__device__ const unsigned char T5_BUCKET[128] = {
  0, 1, 2, 3, 4, 5, 6, 7, 8, 9, 10, 11, 12, 13, 14, 15, 16, 16, 16, 17, 17, 18, 18, 18, 19, 19, 19, 20, 20, 20, 20, 21,
  21, 21, 21, 22, 22, 22, 22, 22, 23, 23, 23, 23, 23, 23, 24, 24, 24, 24, 24, 24, 25, 25, 25, 25, 25, 25, 25, 26, 26, 26, 26, 26,
  26, 26, 26, 27, 27, 27, 27, 27, 27, 27, 27, 27, 27, 28, 28, 28, 28, 28, 28, 28, 28, 28, 28, 29, 29, 29, 29, 29, 29, 29, 29, 29,
  29, 29, 29, 30, 30, 30, 30, 30, 30, 30, 30, 30, 30, 30, 30, 30, 30, 31, 31, 31, 31, 31, 31, 31, 31, 31, 31, 31, 31, 31, 31, 31};

__device__ __forceinline__ void transpose_item(const float* W, int ldw, const float* gain, bf16_t* WT, int K, int row_off, float* scr, int kb, int nb, int lane) {
  const int k0 = 64 * kb, n0 = 32 * nb;
  const int c = lane & 7;
  float t[32];
  const float* wp = W + (size_t)(k0 + (lane >> 5)) * ldw + n0 + (lane & 31);
#pragma unroll
  for (int i = 0; i < 32; ++i) t[i] = wp[(size_t)(2 * i) * ldw];
  f32x4 g0 = (f32x4){1.f, 1.f, 1.f, 1.f}, g1 = g0;
  if (gain) { g0 = *(const f32x4*)(gain + k0 + 8 * c); g1 = *(const f32x4*)(gain + k0 + 8 * c + 4); }
#pragma unroll
  for (int i = 0; i < 32; ++i) scr[(2 * i + (lane >> 5)) * 33 + (lane & 31)] = t[i];
  __builtin_amdgcn_wave_barrier();
#pragma unroll
  for (int j = 0; j < 4; ++j) {
    const int n = (lane >> 3) + 8 * j; const float* s = scr + (8 * c) * 33 + n;
    u32x4 o; o.x = pk2(s[0 * 33] * g0.x, s[1 * 33] * g0.y); o.y = pk2(s[2 * 33] * g0.z, s[3 * 33] * g0.w); o.z = pk2(s[4 * 33] * g1.x, s[5 * 33] * g1.y); o.w = pk2(s[6 * 33] * g1.z, s[7 * 33] * g1.w);
    *(u32x4*)(WT + (size_t)(row_off + n0 + n) * K + k0 + 8 * c) = o;
  }
  __builtin_amdgcn_wave_barrier();
}

__device__ __forceinline__ void rms_row_to_bf16(const float* xrow, bf16_t* orow, int lane) {
  const f32x4* xr = (const f32x4*)xrow + lane;
  f32x4 v[4]; float s = 0.f;
#pragma unroll
  for (int j = 0; j < 4; ++j) { v[j] = xr[64 * j]; s += (v[j].x * v[j].x + v[j].y * v[j].y) + (v[j].z * v[j].z + v[j].w * v[j].w); }
  const float rstd = rsqrtf(wave_sum(s) * (1.f / DM) + EPS);
  u32x2* o = (u32x2*)orow + lane;
#pragma unroll
  for (int j = 0; j < 4; ++j) { u32x2 w; w.x = pk2(v[j].x * rstd, v[j].y * rstd); w.y = pk2(v[j].z * rstd, v[j].w * rstd); o[64 * j] = w; }
}

__device__ __forceinline__ void exp_item_load(f32x4 (&nx)[8], const Args& a, int it, int lane) {
  asm volatile("" : "+v"(lane));
  const int hi = lane >> 5, l32 = lane & 31; const int r = 2 * it + hi; const int tb = r >= NEXP, e = r - tb * NEXP;
  const f32x4* src = (const f32x4*)(a.in[19 + tb] + (size_t)e * DM) + 8 * l32;
#pragma unroll
  for (int k = 0; k < 8; ++k) nx[k] = src[k];
}
__device__ __forceinline__ void exp_item_finish(const f32x4 (&cur)[8], const Args& a, int it, int lane) {
  unsigned char* ws = a.ws;
  asm volatile("" : "+v"(lane));
  const int hi = lane >> 5, l32 = lane & 31; const int r = 2 * it + hi;
  const int tb = r >= NEXP, e = r - tb * NEXP;
    v16f xa, xb; float am = 0.f;
#pragma unroll
    for (int k = 0; k < 4; ++k) { f32x4 p = cur[k], q = cur[4 + k];
      if (tb == 0) { const f32x4* gp = (const f32x4*)a.in[15] + 8 * l32; p = p * gp[k]; q = q * gp[4 + k]; }
      xa[2 * k] = p.x; xb[2 * k] = p.y; xa[2 * k + 1] = p.z; xb[2 * k + 1] = p.w; xa[8 + 2 * k] = q.x; xb[8 + 2 * k] = q.y; xa[8 + 2 * k + 1] = q.z; xb[8 + 2 * k + 1] = q.w;
      am = fmaxf(am, fmaxf(fmaxf(fabsf(p.x), fabsf(p.y)), fmaxf(fabsf(p.z), fabsf(p.w)))); am = fmaxf(am, fmaxf(fmaxf(fabsf(q.x), fabsf(q.y)), fmaxf(fabsf(q.z), fabsf(q.w)))); }
#pragma unroll
    for (int o = 1; o < 32; o <<= 1) am = fmaxf(am, __shfl_xor(am, o));
    if (tb == 0) {
      const float sc = am > 0.f ? 7.0f / am : 1.f;
      xa = xa * sc; xb = xb * sc;
      const v6u w = __builtin_amdgcn_cvt_scalef32_2xpk16_fp6_f32(xa, xb, 1.0f);
      u32x2* dst = (u32x2*)(ws + WS_EXD + (size_t)e * 768 + 24 * l32);
      dst[0] = (u32x2){w[0], w[1]}; dst[1] = (u32x2){w[2], w[3]}; dst[2] = (u32x2){w[4], w[5]};
      if (l32 == 0) ((float*)(ws + WS_ESC))[r] = am > 0.f ? am / 7.0f : 1.f;
    } else {
      const float sc = am > 0.f ? 440.f / am : 1.f;
      u32x4 o0, o1;
#pragma unroll
      for (int k = 0; k < 4; ++k) { int w = __builtin_amdgcn_cvt_pk_fp8_f32(xa[2 * k] * sc, xb[2 * k] * sc, 0, false); w = __builtin_amdgcn_cvt_pk_fp8_f32(xa[2 * k + 1] * sc, xb[2 * k + 1] * sc, w, true); o0[k] = (unsigned)w; }
#pragma unroll
      for (int k = 0; k < 4; ++k) { int w = __builtin_amdgcn_cvt_pk_fp8_f32(xa[8 + 2 * k] * sc, xb[8 + 2 * k] * sc, 0, false); w = __builtin_amdgcn_cvt_pk_fp8_f32(xa[8 + 2 * k + 1] * sc, xb[8 + 2 * k + 1] * sc, w, true); o1[k] = (unsigned)w; }
      u32x4* dst = (u32x4*)(ws + WS_EXU + (size_t)(l32 >> 2) * (NEXP * 128) + (size_t)e * 128 + 32 * (l32 & 3));
      dst[0] = o0; dst[1] = o1;
      if (l32 == 0) ((float*)(ws + WS_ESC))[r] = am > 0.f ? am / 440.f : 1.f;
    }
}

__device__ __forceinline__ void phase_prep(const Args& a, unsigned char* lds, int gw, int ngw, int wave, int lane, int tid) {
  unsigned char* ws = a.ws;
  float* scr = (float*)(lds + wave * 8448);
  const int I_IN = 16 * 96, I_SQ = 16 * 32;
  const int NITEMS = I_IN + 6 * I_SQ;
  for (int it = gw; it < NITEMS; it += ngw) {
    int r = it;
    if (r < I_IN) { transpose_item(a.in[3], INW, a.in[2], (bf16_t*)(ws + WS_WIN_T), DM, 0, scr, r / 96, r % 96, lane); continue; } r -= I_IN;
    const int which = r / I_SQ; r %= I_SQ; const int kb = r / 32, nb = r % 32;
    if (which == 0) { const float* g = (kb < 8) ? a.in[6] : (a.in[7] - 512); transpose_item(a.in[8], DM, g, (bf16_t*)(ws + WS_WOUT_T), DM, 0, scr, kb, nb, lane); }
    else if (which == 1) transpose_item(a.in[11], DM, a.in[9], (bf16_t*)(ws + WS_WXQ_T), DM, 0, scr, kb, nb, lane);
    else if (which == 2) transpose_item(a.in[12], DM, a.in[10], (bf16_t*)(ws + WS_WXKV_T), DM, 0, scr, kb, nb, lane);
    else if (which == 3) transpose_item(a.in[13], DM, a.in[10], (bf16_t*)(ws + WS_WXKV_T), DM, 1024, scr, kb, nb, lane);
    else if (which == 4) transpose_item(a.in[14], DM, nullptr, (bf16_t*)(ws + WS_WXO_T), DM, 0, scr, kb, nb, lane);
    else transpose_item(a.in[16], DM, a.in[15], (bf16_t*)(ws + WS_WPQ_T), DM, 0, scr, kb, nb, lane);
  }
  for (int i = blockIdx.x * 512 + tid; i < 2 * 65536; i += gridDim.x * 512) ((bf16_t*)(ws + WS_SK))[i] = (bf16_t)f2bf(a.in[17 + (i >> 16)][i & 65535]);
  for (int r = gw; r < NMROWS; r += ngw) rms_row_to_bf16(a.in[1] + (size_t)r * DM, (bf16_t*)(ws + WS_MEMN) + (size_t)r * DM, lane);
  __syncthreads();
  float* wf = (float*)(lds + 69632);
  for (int k = tid; k < DM; k += 512) {
    const float g = a.in[2][k]; const f32x4* wp = (const f32x4*)(a.in[3] + (size_t)k * INW + NQKV);
    const f32x4 p = wp[0], q = wp[1];
    wf[k] = p.x * g; wf[1024 + k] = p.y * g; wf[2048 + k] = p.z * g; wf[3072 + k] = p.w * g; wf[4096 + k] = q.x * g; wf[5120 + k] = q.y * g; wf[6144 + k] = q.z * g; wf[7168 + k] = q.w * g;
  }
  __syncthreads();
  float* flog = (float*)(ws + WS_FLOG);
  const bool b5 = (lane & 32) != 0, b4 = (lane & 16) != 0, b3 = (lane & 8) != 0;
  for (int r = gw; r < NT; r += 2 * ngw) {
    const int r1 = r + ngw; const bool two = r1 < NT;
    const f32x4* xr0 = (const f32x4*)(a.in[0] + (size_t)r * DM) + lane; const f32x4* xr1 = (const f32x4*)(a.in[0] + (size_t)(two ? r1 : r) * DM) + lane;
    f32x4 va[4], vb[4];
#pragma unroll
    for (int j = 0; j < 4; ++j) { va[j] = xr0[64 * j]; vb[j] = xr1[64 * j]; }
#pragma unroll
    for (int h = 0; h < 2; ++h) {
      const f32x4 (&v)[4] = h ? vb : va; const int rr = h ? r1 : r;
      float s = 0.f; float fa[8];
#pragma unroll
      for (int j = 0; j < 8; ++j) fa[j] = 0.f;
#pragma unroll
      for (int j = 0; j < 4; ++j) {
        s += (v[j].x * v[j].x + v[j].y * v[j].y) + (v[j].z * v[j].z + v[j].w * v[j].w);
#pragma unroll
        for (int jj = 0; jj < 8; ++jj) { const f32x4 w4 = *(const f32x4*)(wf + jj * 1024 + 256 * j + 4 * lane); fa[jj] += (v[j].x * w4.x + v[j].y * w4.y) + (v[j].z * w4.z + v[j].w * w4.w); }
      }
      const float rstd = rsqrtf(wave_sum(s) * (1.f / DM) + EPS);
      float q4[4], q2[2];
#pragma unroll
      for (int j = 0; j < 4; ++j) q4[j] = (b5 ? fa[4 + j] : fa[j]) + __shfl_xor(b5 ? fa[j] : fa[4 + j], 32);
#pragma unroll
      for (int j = 0; j < 2; ++j) q2[j] = (b4 ? q4[2 + j] : q4[j]) + swz_xor<16>(b4 ? q4[j] : q4[2 + j]);
      float q1 = (b3 ? q2[1] : q2[0]) + swz_xor<8>(b3 ? q2[0] : q2[1]);
      q1 += swz_xor<4>(q1); q1 += swz_xor<2>(q1); q1 += swz_xor<1>(q1);
      if ((lane & 7) == 0 && (h == 0 || two)) {
        const int gj = lane >> 3;
        const float z = q1 * rstd + a.in[4][gj];
        flog[(size_t)gj * NT + rr] = fminf(z, 0.f) - log1pf(expf(-fabsf(z)));
      }
      if (h == 0 || two) {
        u32x2* o = (u32x2*)((bf16_t*)(ws + WS_HB) + (size_t)rr * DM) + lane;
#pragma unroll
        for (int j = 0; j < 4; ++j) { u32x2 w; w.x = pk2(v[j].x * rstd, v[j].y * rstd); w.y = pk2(v[j].z * rstd, v[j].w * rstd); o[64 * j] = w; }
      }
    }
  }
}

template <class Epi>
__device__ __forceinline__ void gemm_naive(const bf16_t* A, int lda, const bf16_t* Bt, int ldb, int M, int N, int K, const Epi& E, int gw, int ngw, int lane) {
  const int fr = lane & 15, fq = lane >> 4;
  const int tn = N / 64, ntile = (M / 64) * tn;
  for (int tile = gw; tile < ntile; tile += ngw) {
    const int pm = tile / tn, pn = tile % tn;
    f32x4 acc[4][4];
#pragma unroll
    for (int m = 0; m < 4; ++m)
#pragma unroll
      for (int n = 0; n < 4; ++n) acc[m][n] = (f32x4){0.f, 0.f, 0.f, 0.f};
    const bf16_t* Ap = A + (size_t)(pm * 64 + fr) * lda + fq * 8;
    const bf16_t* Bp = Bt + (size_t)(pn * 64 + fr) * ldb + fq * 8;
    for (int k0 = 0; k0 < K; k0 += 32) {
      bf16x8 af[4], bfr[4];
#pragma unroll
      for (int m = 0; m < 4; ++m) af[m] = *(const bf16x8*)(Ap + (size_t)m * 16 * lda + k0);
#pragma unroll
      for (int n = 0; n < 4; ++n) bfr[n] = *(const bf16x8*)(Bp + (size_t)n * 16 * ldb + k0);
#pragma unroll
      for (int m = 0; m < 4; ++m)
#pragma unroll
        for (int n = 0; n < 4; ++n) acc[m][n] = __builtin_amdgcn_mfma_f32_16x16x32_bf16(bfr[n], af[m], acc[m][n], 0, 0, 0);
    }
#pragma unroll
    for (int m = 0; m < 4; ++m)
#pragma unroll
      for (int n = 0; n < 4; ++n) E.store(pm * 64 + m * 16 + fr, pn * 64 + n * 16 + 4 * fq, acc[m][n]);
  }
}

struct EpiBf16 { bf16_t* O; int ldo;
  __device__ __forceinline__ void store8(int row, int col, f32x4 a, f32x4 b) const { u32x4 w; w.x = pk2(a.x, a.y); w.y = pk2(a.z, a.w); w.z = pk2(b.x, b.y); w.w = pk2(b.z, b.w); *(u32x4*)(O + (size_t)row * ldo + col) = w; }
  __device__ __forceinline__ void store(int row, int col, f32x4 v) const { u32x2 w; w.x = pk2(v.x, v.y); w.y = pk2(v.z, v.w); *(u32x2*)(O + (size_t)row * ldo + col) = w; } };
struct EpiQKV { bf16_t* O;
  __device__ __forceinline__ void store8(int row, int col, f32x4 a, f32x4 b) const { const float sc = (col < 512 || (col >= 1536 && col < 2048)) ? 0.18033688011112042f : 1.f;
    u32x4 w; w.x = pk2(a.x * sc, a.y * sc); w.y = pk2(a.z * sc, a.w * sc); w.z = pk2(b.x * sc, b.y * sc); w.w = pk2(b.z * sc, b.w * sc); *(u32x4*)(O + (size_t)row * NQKV + col) = w; }
  __device__ __forceinline__ void store(int row, int col, f32x4 v) const { const float sc = (col < 512 || (col >= 1536 && col < 2048)) ? 0.18033688011112042f : 1.f;
    u32x2 w; w.x = pk2(v.x * sc, v.y * sc); w.y = pk2(v.z * sc, v.w * sc); *(u32x2*)(O + (size_t)row * NQKV + col) = w; } };
struct EpiBf16S { bf16_t* O; int ldo; const float* ss;
  __device__ __forceinline__ void store8(int row, int col, f32x4 a, f32x4 b) const { const float r = rsqrtf(ss[row] * (1.f / DM) + EPS);
    u32x4 w; w.x = pk2(a.x * r, a.y * r); w.y = pk2(a.z * r, a.w * r); w.z = pk2(b.x * r, b.y * r); w.w = pk2(b.z * r, b.w * r); *(u32x4*)(O + (size_t)row * ldo + col) = w; }
  __device__ __forceinline__ void store(int row, int col, f32x4 v) const { const float r = rsqrtf(ss[row] * (1.f / DM) + EPS); u32x2 w; w.x = pk2(v.x * r, v.y * r); w.y = pk2(v.z * r, v.w * r); *(u32x2*)(O + (size_t)row * ldo + col) = w; } };
struct EpiF32S { float* O; int ldo; const float* ss;
  __device__ __forceinline__ void store(int row, int col, f32x4 v) const { const float r = rsqrtf(ss[row] * (1.f / DM) + EPS); *(f32x4*)(O + (size_t)row * ldo + col) = v * r; } };
struct EpiF32 { float* O; int ldo;
  __device__ __forceinline__ void store(int row, int col, f32x4 v) const { *(f32x4*)(O + (size_t)row * ldo + col) = v; } };
struct EpiResid { const float* base; float* out;
  __device__ __forceinline__ void store(int row, int col, f32x4 v) const { const size_t o = (size_t)row * DM + col; const f32x4 b = *(const f32x4*)(base + o); *(f32x4*)(out + o) = b + v; } };
struct EpiKV { bf16_t* KX; bf16_t* VXT;
  __device__ __forceinline__ void store(int row, int col, f32x4 v) const {
    if (col < 1024) { u32x2 w; w.x = pk2(v.x, v.y); w.y = pk2(v.z, v.w); *(u32x2*)(KX + (size_t)row * DM + col) = w; }
    else { const int b = row >> 8, m = row & 255;
#pragma unroll
      for (int r = 0; r < 4; ++r) { const int d = col - 1024 + r; VXT[((size_t)(b * 4 + (d >> 8)) * 256 + (d & 255)) * 256 + m] = (bf16_t)f2bf(v[r]); } } } };

__device__ __forceinline__ void phase_scan(const Args& a, int gw, int ngw, int lane, int tid) {
  unsigned char* ws = a.ws;
  const bf16_t* qkv = (const bf16_t*)(ws + WS_QKV);
  for (int item = gw; item < 64 + 1024 + 1024; item += ngw) {
    if (item < 64) {
      const int b = item >> 3, j = item & 7;
      const f32x4* src = (const f32x4*)((const float*)(ws + WS_FLOG) + (size_t)j * NT + (size_t)b * SEQ + lane * 64);
      f32x4 v[16];
#pragma unroll
      for (int i = 0; i < 16; ++i) v[i] = src[i];
      float tot = 0.f;
#pragma unroll
      for (int i = 0; i < 16; ++i) tot += (v[i].x + v[i].y) + (v[i].z + v[i].w);
      float inc = tot;
#pragma unroll
      for (int o = 1; o < 64; o <<= 1) { const float t = __shfl_up(inc, o); if (lane >= o) inc += t; }
      float run = inc - tot;
      f32x4* dst = (f32x4*)((float*)(ws + WS_CUM) + ((size_t)(b * 8 + j)) * SEQ + lane * 64);
#pragma unroll
      for (int i = 0; i < 16; ++i) { f32x4 o; run += v[i].x; o.x = run * 1.4426950408889634f; run += v[i].y; o.y = run * 1.4426950408889634f; run += v[i].z; o.z = run * 1.4426950408889634f; run += v[i].w; o.w = run * 1.4426950408889634f; dst[i] = o; }
    } else if (item < 64 + 1024) {
      const int it = item - 64, h = it & 7, blk = (it >> 3) & 15, b = it >> 7;
      const bf16_t* p = qkv + ((size_t)b * SEQ + blk * 256 + (lane >> 3)) * NQKV + 512 + h * 64 + (lane & 7) * 8;
      float s[8];
#pragma unroll
      for (int i = 0; i < 8; ++i) s[i] = 0.f;
#pragma unroll 8
      for (int rr = 0; rr < 32; ++rr) { float f[8]; unpack8(*(const u32x4*)(p + (size_t)rr * 8 * NQKV), f);
#pragma unroll
        for (int i = 0; i < 8; ++i) s[i] += f[i]; }
#pragma unroll
      for (int i = 0; i < 8; ++i) { s[i] += __shfl_xor(s[i], 8); s[i] += __shfl_xor(s[i], 16); s[i] += __shfl_xor(s[i], 32); }
      if (lane < 8) { f32x4* d = (f32x4*)((float*)(ws + WS_KMEAN) + ((size_t)(b * 16 + blk) * 8 + h) * 64 + lane * 8);
        d[0] = (f32x4){s[0], s[1], s[2], s[3]} * (1.f / 256.f); d[1] = (f32x4){s[4], s[5], s[6], s[7]} * (1.f / 256.f); }
    } else {
      const int it = item - 64 - 1024, bh = it >> 4, ch = it & 15, b = bh >> 3, h = bh & 7;
      const bf16_t* p = qkv + ((size_t)b * SEQ + ch * 256 + (lane >> 3)) * NQKV + 2048 + h * 64 + (lane & 7) * 8;
      float m = 0.f;
#pragma unroll 8
      for (int rr = 0; rr < 32; ++rr) { float f[8]; unpack8(*(const u32x4*)(p + (size_t)rr * 8 * NQKV), f);
        float s = 0.f;
#pragma unroll
        for (int i = 0; i < 8; ++i) s += f[i] * f[i];
        s += __shfl_xor(s, 1); s += __shfl_xor(s, 2); s += __shfl_xor(s, 4);
        m = fmaxf(m, s); }
#pragma unroll
      for (int o = 8; o < 64; o <<= 1) m = fmaxf(m, __shfl_xor(m, o));
      if (lane == 0) atomicMax((unsigned*)(ws + 256) + bh, __float_as_uint(m));
    }
  }
}

template <int MODE>
__device__ __forceinline__ void attn_naive_unit(const Args& a, unsigned char* lds, int b, int h, int sb, int tid) {
  unsigned char* ws = a.ws;
  const bf16_t* qkv = (const bf16_t*)(ws + WS_QKV);
  const int qoff = MODE ? 1536 : 0, koff = qoff + 512, voff = qoff + 1024;
  float* Ks = (float*)lds; float* Vs = Ks + 64 * 64; float* ck = Vs + 64 * 64; float* biasd = ck + 64;
  const int t = sb * 512 + tid; const size_t row = (size_t)b * SEQ + t;
  float q[64], o[64];
  {
    const u32x4* qp = (const u32x4*)(qkv + row * NQKV + qoff + h * 64);
#pragma unroll
    for (int c = 0; c < 8; ++c) { const u32x4 w = qp[c]; unpack8(w, q + 8 * c); }
#pragma unroll
    for (int d = 0; d < 64; ++d) { q[d] *= 0.6931471805599453f; o[d] = 0.f; }
  }
  float m = -1e30f, l = 0.f;
  unsigned selmask = 0u; const int own = t >> 8;
  float cq = 0.f, bfar = 0.f;
  __syncthreads();
  if (MODE == 0) {
    if (tid < 128) biasd[tid] = a.in[5][T5_BUCKET[tid] * 8 + h];
    bfar = a.in[5][31 * 8 + h];
    const float* km = (const float*)(ws + WS_KMEAN) + ((size_t)b * 16) * 512 + h * 64;
    float v0 = -3e38f, v1 = -3e38f, v2 = -3e38f; int i0 = -1, i1 = -1, i2 = -1;
    for (int n = 0; n < 2 * sb + 1; ++n) {
      if (n < own) {
        const float* kp = km + (size_t)n * 512; float s = 0.f;
#pragma unroll
        for (int d = 0; d < 64; ++d) s += q[d] * kp[d];
        if (s > v0) { v2 = v1; i2 = i1; v1 = v0; i1 = i0; v0 = s; i0 = n; }
        else if (s > v1) { v2 = v1; i2 = i1; v1 = s; i1 = n; }
        else if (s > v2) { v2 = s; i2 = n; }
      }
    }
    if (i0 >= 0) selmask |= 1u << i0;
    if (i1 >= 0) selmask |= 1u << i1;
    if (i2 >= 0) selmask |= 1u << i2;
  } else {
    cq = ((const float*)(ws + WS_CUM))[((size_t)(b * 8 + h)) * SEQ + t];
  }
  const int ntile = 8 * (sb + 1);
  for (int kt = 0; kt < ntile; ++kt) {
    __syncthreads();
    {
      const int r = tid >> 3, ch = tid & 7;
      const bf16_t* kp = qkv + ((size_t)b * SEQ + kt * 64 + r) * NQKV + h * 64 + ch * 8;
      const u32x4 kw = *(const u32x4*)(kp + koff), vw = *(const u32x4*)(kp + voff);
      unpack8(kw, Ks + r * 64 + ch * 8); unpack8(vw, Vs + r * 64 + ch * 8);
      if (MODE == 1 && tid < 64) ck[tid] = ((const float*)(ws + WS_CUM))[((size_t)(b * 8 + h)) * SEQ + kt * 64 + tid];
    }
    __syncthreads();
    const int kb = kt >> 2;
    bool act;
    if (MODE == 0) act = (kb == own) || (kb < own && ((selmask >> kb) & 1u));
    else act = (kt * 64 <= t);
    if (act) {
      for (int jj = 0; jj < 64; ++jj) {
        const int sp = kt * 64 + jj;
        if (sp > t) break;
        const f32x4* kr = (const f32x4*)(Ks + jj * 64);
        float s = 0.f;
#pragma unroll
        for (int c = 0; c < 16; ++c) { const f32x4 kv = kr[c]; s += q[4 * c] * kv.x + q[4 * c + 1] * kv.y + q[4 * c + 2] * kv.z + q[4 * c + 3] * kv.w; }
        if (MODE == 0) { const int dist = t - sp; s += (dist < 128) ? biasd[dist] : bfar; }
        else s += (cq - ck[jj]) * 0.6931471805599453f;
        if (s > m) { const float f = __expf(m - s); l *= f;
#pragma unroll
          for (int d = 0; d < 64; ++d) o[d] *= f;
          m = s; }
        const float p = __expf(s - m); l += p;
        const f32x4* vr = (const f32x4*)(Vs + jj * 64);
#pragma unroll
        for (int c = 0; c < 16; ++c) { const f32x4 vv = vr[c]; o[4 * c] += p * vv.x; o[4 * c + 1] += p * vv.y; o[4 * c + 2] += p * vv.z; o[4 * c + 3] += p * vv.w; }
      }
    }
  }
  const float il = 1.f / l;
  u32x4* op = (u32x4*)((bf16_t*)(ws + WS_OAB) + row * DM + (MODE ? 512 : 0) + h * 64);
#pragma unroll
  for (int c = 0; c < 8; ++c) { u32x4 w; w.x = pk2(o[8 * c] * il, o[8 * c + 1] * il); w.y = pk2(o[8 * c + 2] * il, o[8 * c + 3] * il); w.z = pk2(o[8 * c + 4] * il, o[8 * c + 5] * il); w.w = pk2(o[8 * c + 6] * il, o[8 * c + 7] * il); op[c] = w; }
}

__device__ __forceinline__ void phase_attn(const Args& a, unsigned char* lds, int tid) {
  for (int u = blockIdx.x; u < 1024; u += gridDim.x) {
    const int sb = 7 - (u >> 7), r = u & 127, mode = r & 1, bh = r >> 1;
    if (mode == 0) attn_naive_unit<0>(a, lds, bh >> 3, bh & 7, sb, tid);
    else attn_naive_unit<1>(a, lds, bh >> 3, bh & 7, sb, tid);
  }
}

namespace att {
typedef float f32x16 __attribute__((ext_vector_type(16)));
typedef short s16x4 __attribute__((ext_vector_type(4)));
typedef short v4i16_t __attribute__((ext_vector_type(4)));
typedef __attribute__((address_space(3))) const char* lds_cptr;
typedef float f32x2_t __attribute__((ext_vector_type(2))); typedef __bf16 bf16x2_t __attribute__((ext_vector_type(2)));
constexpr int PITCH = NQKV;
constexpr float LOG2E = 1.4426950408889634f;
constexpr float C2 = 0.125f * LOG2E;
constexpr int L_K = 0, L_V = 16384, L_WSF = 32768, L_OST = 34816, L_C2 = 67584, L_KM = 83968, L_BT = 88064, L_MISC = 88704;
__device__ __forceinline__ int crow(int r, int hi) { return (r & 3) + 8 * (r >> 2) + 4 * hi; }
__device__ __forceinline__ unsigned cvtpk(float lo, float hi) { f32x2_t v = {lo, hi}; bf16x2_t b = __builtin_convertvector(v, bf16x2_t); return __builtin_bit_cast(unsigned, b); }
__device__ __forceinline__ s16x4 vtr(lds_cptr p) { return __builtin_bit_cast(s16x4, __builtin_amdgcn_ds_read_tr16_b64_v4i16((__attribute__((address_space(3))) v4i16_t*)p)); }
__device__ __forceinline__ float max3f(float a, float b, float c) { float r; asm("v_max3_f32 %0, %1, %2, %3" : "=v"(r) : "v"(a), "v"(b), "v"(c)); return r; }
__device__ __forceinline__ float xhalf_max(float m) { auto rr = __builtin_amdgcn_permlane32_swap(__float_as_uint(m), __float_as_uint(m), false, false); return fmaxf(__uint_as_float(rr[0]), __uint_as_float(rr[1])); }
__device__ __forceinline__ float xhalf_sum(float m) { auto rr = __builtin_amdgcn_permlane32_swap(__float_as_uint(m), __float_as_uint(m), false, false); return __uint_as_float(rr[0]) + __uint_as_float(rr[1]); }

template <int MODE>
__device__ __forceinline__ void unit(const Args& a, unsigned char* lds, int b, int h, int qb, int tid, int xit) {
  unsigned char* ws = a.ws;
  const int lane = tid & 63, r32 = lane & 31, hi = lane >> 5; const int wid = __builtin_amdgcn_readfirstlane(tid >> 6);
  const bf16_t* qkv = (const bf16_t*)(ws + WS_QKV);
  const int qoff = MODE ? 1536 : 0;
  const size_t rowbase = (size_t)b * SEQ; const int q0 = qb * 256;
  const bf16_t* Qw = qkv + (rowbase + q0 + wid * 32) * PITCH + qoff + h * 64;
  const bf16_t* Kh = qkv + rowbase * PITCH + qoff + 512 + h * 64;
  const bf16_t* Vh = qkv + rowbase * PITCH + qoff + 1024 + h * 64;
  float* wsf = (float*)(lds + L_WSF) + wid * 64;
  float* c2s = (float*)(lds + L_C2); float* kms = (float*)(lds + L_KM); float* bts = (float*)(lds + L_BT); unsigned* misc = (unsigned*)(lds + L_MISC);
  const int NTL = 4 * (qb + 1);
  __syncthreads();
  if (MODE == 0) {
    const float* km = (const float*)(ws + WS_KMEAN) + (size_t)b * 16 * 512 + h * 64;
    for (int i = tid; i < 16 * 64; i += 512) kms[i] = km[(size_t)(i >> 6) * 512 + (i & 63)];
    if (tid < 128) bts[tid] = a.in[5][T5_BUCKET[tid] * 8 + h] * LOG2E;
    if (tid == 128) bts[128] = a.in[5][31 * 8 + h] * LOG2E;
  }
  float ce[8], cexcl = 0.f; float* wtot = (float*)(lds + L_MISC) + 4;
  if (MODE == 1) {
    const f32x4* fl = (const f32x4*)((const float*)(ws + WS_FLOG) + (size_t)h * NT + rowbase) + 2 * tid;
    f32x4 a0 = (f32x4){0.f, 0.f, 0.f, 0.f}, a1 = a0;
    if (8 * tid < 256 * (qb + 1)) { a0 = fl[0]; a1 = fl[1]; }
    ce[0] = a0.x; ce[1] = ce[0] + a0.y; ce[2] = ce[1] + a0.z; ce[3] = ce[2] + a0.w; ce[4] = ce[3] + a1.x; ce[5] = ce[4] + a1.y; ce[6] = ce[5] + a1.z; ce[7] = ce[6] + a1.w;
    float inc = ce[7];
#pragma unroll
    for (int of = 1; of < 64; of <<= 1) { const float t = __shfl_up(inc, of); if (lane >= of) inc += t; }
    cexcl = inc - ce[7];
    if (lane == 63) wtot[wid] = inc;
    if (tid == 0) misc[0] = 0u;
  }
  bf16x8 qr[4];
#pragma unroll
  for (int d0 = 0; d0 < 4; ++d0) qr[d0] = *(const bf16x8*)(Qw + (size_t)r32 * PITCH + d0 * 16 + hi * 8);
  __syncthreads();
  unsigned selmask = 0u; float cq2 = 0.f, far2 = 0.f, mhat = 0.f; int t0 = 0;
  if (MODE == 0) {
    far2 = bts[128];
    float v0 = -3e38f, v1 = -3e38f, v2 = -3e38f; int i0 = -1, i1 = -1, i2 = -1;
    for (int n = 0; n < qb; ++n) {
      float s = 0.f;
#pragma unroll
      for (int d0 = 0; d0 < 4; ++d0)
#pragma unroll
        for (int j = 0; j < 8; ++j) s += bf2f((unsigned short)qr[d0][j]) * kms[n * 64 + d0 * 16 + hi * 8 + j];
      s = xhalf_sum(s);
      if (s > v0) { v2 = v1; i2 = i1; v1 = v0; i1 = i0; v0 = s; i0 = n; }
      else if (s > v1) { v2 = v1; i2 = i1; v1 = s; i1 = n; }
      else if (s > v2) { v2 = s; i2 = n; }
    }
    if (i0 >= 0) selmask |= 1u << i0;
    if (i1 >= 0) selmask |= 1u << i1;
    if (i2 >= 0) selmask |= 1u << i2;
  } else {
    {
      float base = cexcl;
      for (int w = 0; w < wid; ++w) base += wtot[w];
      if (8 * tid < 256 * (qb + 1)) {
        f32x4* cd = (f32x4*)(c2s + 8 * tid);
        cd[0] = (f32x4){base + ce[0], base + ce[1], base + ce[2], base + ce[3]} * LOG2E; cd[1] = (f32x4){base + ce[4], base + ce[5], base + ce[6], base + ce[7]} * LOG2E;
      }
    }
    float s = 0.f;
#pragma unroll
    for (int d0 = 0; d0 < 4; ++d0)
#pragma unroll
      for (int j = 0; j < 8; ++j) { const float f = bf2f((unsigned short)qr[d0][j]); s += f * f; }
    s = xhalf_sum(s);
    atomicMax(&misc[0], __float_as_uint(s));
    __syncthreads();
    cq2 = c2s[q0 + wid * 32 + r32];
    const float kn2 = (__uint_as_float(((const unsigned*)(ws + 2048))[(b * 8 + h) * 2]) + __uint_as_float(((const unsigned*)(ws + 2048))[(b * 8 + h) * 2 + 1])) * 1.01f;
    const float qkb = sqrtf(__uint_as_float(misc[0]) * kn2) * 1.0001f + 1e-3f;
    mhat = -qkb;
    const int j = lane; bool skip = false;
    if (j < NTL) skip = (2.f * qkb + c2s[q0] - c2s[64 * j + 63]) < -150.f;
    t0 = __popcll(__ballot(skip));
    if (t0 > NTL - 1) t0 = NTL - 1;
  }
  const bf16_t* ksrc = Kh + (size_t)lane * PITCH + wid * 8;
  const bf16_t* vsrc = Vh + (size_t)(16 * (wid & 3) + (lane >> 2)) * PITCH + (wid >> 2) * 32 + (lane & 3) * 8;
  unsigned char* kdst = lds + L_K + wid * 1024 + lane * 16; unsigned char* vdst = lds + L_V + wid * 1024 + lane * 16;
  const lds_cptr lds3 = (lds_cptr)lds;
  const lds_cptr vp0 = lds3 + L_V + ((lane >> 4) & 1) * 32 + (lane & 3) * 8 + (4 * hi + ((lane & 15) >> 2)) * 64;
  u32x4 kreg = *(const u32x4*)(ksrc + (size_t)t0 * 64 * PITCH), vreg = *(const u32x4*)(vsrc + (size_t)t0 * 64 * PITCH);
  *(u32x4*)(kdst + (t0 & 1) * 8192) = kreg; *(u32x4*)(vdst + (t0 & 1) * 8192) = vreg;
  f32x16 o[2]; o[0] = f32x16{}; o[1] = f32x16{};
  f32x16 ol = f32x16{}, cm = f32x16{}; int cm_nb = -1;
  const int qrel = wid * 32 + r32, qpos = q0 + qrel;
  __syncthreads();
  for (int t = t0; t < NTL; ++t) {
    const int buf = (t & 1) * 8192;
    if (t + 1 < NTL) { kreg = *(const u32x4*)(ksrc + (size_t)(t + 1) * 64 * PITCH); vreg = *(const u32x4*)(vsrc + (size_t)(t + 1) * 64 * PITCH); }
    const int jb = t - (NTL - 4);
    const bool compute = !(jb >= 0 && 64 * jb > wid * 32 + 31);
    if (compute) {
      f32x16 p0, p1;
      bf16x8 kf[8];
      {
        const lds_cptr kb = lds3 + L_K + buf + hi * 1024 + r32 * 16;
#pragma unroll
        for (int d0 = 0; d0 < 4; ++d0) { kf[2 * d0] = *(const __attribute__((address_space(3))) bf16x8*)(kb + d0 * 2048); kf[2 * d0 + 1] = *(const __attribute__((address_space(3))) bf16x8*)(kb + d0 * 2048 + 512); }
      }
      __builtin_amdgcn_sched_barrier(0);
      if (MODE == 0) {
        const int nb = t >> 2;
        const bool near = (jb >= 0) || (t >= NTL - 6 && wid < 4);
        if (near) {
#pragma unroll
          for (int r = 0; r < 16; ++r) { const int d = qpos - (64 * t + crow(r, hi));
            p0[r] = bts[min(max(d, 0), 128)] - mhat; p1[r] = bts[min(max(d - 32, 0), 128)] - mhat; }
          if (jb < 0 && !((selmask >> nb) & 1u)) {
#pragma unroll
            for (int r = 0; r < 16; ++r) { p0[r] = -INFINITY; p1[r] = -INFINITY; }
          }
        } else {
          if (cm_nb != nb) {
            const float base = ((selmask >> nb) & 1u) ? far2 - mhat : -INFINITY;
#pragma unroll
            for (int r = 0; r < 16; ++r) cm[r] = base;
            cm_nb = nb;
          }
          p0 = cm; p1 = cm;
        }
      } else {
        const float cqm = cq2 - mhat;
#pragma unroll
        for (int g = 0; g < 4; ++g) {
          const f32x4 ca = *(const f32x4*)(c2s + 64 * t + 8 * g + 4 * hi), cb = *(const f32x4*)(c2s + 64 * t + 32 + 8 * g + 4 * hi);
#pragma unroll
          for (int i = 0; i < 4; ++i) { p0[4 * g + i] = cqm - ca[i]; p1[4 * g + i] = cqm - cb[i]; }
        }
      }
#pragma unroll
      for (int d0 = 0; d0 < 4; ++d0) {
        p0 = __builtin_amdgcn_mfma_f32_32x32x16_bf16(kf[2 * d0], qr[d0], p0, 0, 0, 0);
        p1 = __builtin_amdgcn_mfma_f32_32x32x16_bf16(kf[2 * d0 + 1], qr[d0], p1, 0, 0, 0);
      }
      if (jb >= 0) {
        asm volatile("" ::: "memory");
        const int kb0 = 64 * jb + 4 * hi;
#pragma unroll
        for (int r = 0; r < 16; ++r) { const int kv = kb0 + (r & 3) + 8 * (r >> 2); if (kv > qrel) p0[r] = -INFINITY; if (kv + 32 > qrel) p1[r] = -INFINITY; }
      }
      asm volatile("s_nop 15\n\ts_nop 7" : "+v"(p0), "+v"(p1));
      float rm, rm2;
      rm = max3f(p0[0], p0[1], p1[0]); rm2 = max3f(p0[2], p0[3], p1[1]); rm = max3f(rm, p1[2], p1[3]);
#pragma unroll
      for (int r = 4; r < 16; r += 4) { rm = max3f(rm, p0[r], p0[r + 1]); rm2 = max3f(rm2, p0[r + 2], p0[r + 3]); rm = max3f(rm, p1[r], p1[r + 1]); rm2 = max3f(rm2, p1[r + 2], p1[r + 3]); }
      rm = xhalf_max(fmaxf(rm, rm2));
      if (__any(rm > 8.0f)) {
        const float dl = fmaxf(rm, 0.f), alpha = __builtin_amdgcn_exp2f(-dl);
        mhat += dl; cm_nb = -1;
#pragma unroll
        for (int r = 0; r < 16; ++r) { p0[r] -= dl; p1[r] -= dl; }
        if (hi == 0) wsf[r32] = alpha;
        __builtin_amdgcn_wave_barrier();
#pragma unroll
        for (int r = 0; r < 16; ++r) { const float f = wsf[crow(r, hi)]; o[0][r] *= f; o[1][r] *= f; ol[r] *= f; }
        __builtin_amdgcn_wave_barrier();
      }
#pragma unroll
      for (int r = 0; r < 16; ++r) { p0[r] = __builtin_amdgcn_exp2f(p0[r]); p1[r] = __builtin_amdgcn_exp2f(p1[r]); }
      u32x4 pw0, pw1, pw2, pw3;
      pw0 = (u32x4){cvtpk(p0[0], p0[1]), cvtpk(p0[2], p0[3]), cvtpk(p0[4], p0[5]), cvtpk(p0[6], p0[7])};
      pw1 = (u32x4){cvtpk(p0[8], p0[9]), cvtpk(p0[10], p0[11]), cvtpk(p0[12], p0[13]), cvtpk(p0[14], p0[15])};
      pw2 = (u32x4){cvtpk(p1[0], p1[1]), cvtpk(p1[2], p1[3]), cvtpk(p1[4], p1[5]), cvtpk(p1[6], p1[7])};
      pw3 = (u32x4){cvtpk(p1[8], p1[9]), cvtpk(p1[10], p1[11]), cvtpk(p1[12], p1[13]), cvtpk(p1[14], p1[15])};
      {
        const bf16x8 ones = (bf16x8){0x3F80, 0x3F80, 0x3F80, 0x3F80, 0x3F80, 0x3F80, 0x3F80, 0x3F80};
        ol = __builtin_amdgcn_mfma_f32_32x32x16_bf16(__builtin_bit_cast(bf16x8, pw0), ones, ol, 0, 0, 0);
        ol = __builtin_amdgcn_mfma_f32_32x32x16_bf16(__builtin_bit_cast(bf16x8, pw1), ones, ol, 0, 0, 0);
        ol = __builtin_amdgcn_mfma_f32_32x32x16_bf16(__builtin_bit_cast(bf16x8, pw2), ones, ol, 0, 0, 0);
        ol = __builtin_amdgcn_mfma_f32_32x32x16_bf16(__builtin_bit_cast(bf16x8, pw3), ones, ol, 0, 0, 0);
      }
      const lds_cptr vp = vp0 + buf;
#pragma unroll
      for (int d0 = 0; d0 < 2; ++d0) {
#define ATT_VF(ks) ({ const s16x4 lo_ = vtr(vp + d0 * 4096 + (ks) * 1024), hi_ = vtr(vp + d0 * 4096 + (ks) * 1024 + 512); (bf16x8){lo_[0], lo_[1], lo_[2], lo_[3], hi_[0], hi_[1], hi_[2], hi_[3]}; })
        o[d0] = __builtin_amdgcn_mfma_f32_32x32x16_bf16(__builtin_bit_cast(bf16x8, pw0), ATT_VF(0), o[d0], 0, 0, 0);
        o[d0] = __builtin_amdgcn_mfma_f32_32x32x16_bf16(__builtin_bit_cast(bf16x8, pw1), ATT_VF(1), o[d0], 0, 0, 0);
        o[d0] = __builtin_amdgcn_mfma_f32_32x32x16_bf16(__builtin_bit_cast(bf16x8, pw2), ATT_VF(2), o[d0], 0, 0, 0);
        o[d0] = __builtin_amdgcn_mfma_f32_32x32x16_bf16(__builtin_bit_cast(bf16x8, pw3), ATT_VF(3), o[d0], 0, 0, 0);
#undef ATT_VF
      }
    }
    if (t + 1 < NTL) { *(u32x4*)(kdst + ((t + 1) & 1) * 8192) = kreg; *(u32x4*)(vdst + ((t + 1) & 1) * 8192) = vreg; }
    __syncthreads();
  }
  bf16_t* stg = (bf16_t*)(lds + L_OST) + wid * 2048;
#pragma unroll
  for (int r = 0; r < 16; ++r) { const int orow = crow(r, hi); const float rl = 1.f / ol[r];
    stg[orow * 64 + r32] = (bf16_t)f2bf(o[0][r] * rl); stg[orow * 64 + 32 + r32] = (bf16_t)f2bf(o[1][r] * rl); }
  __builtin_amdgcn_wave_barrier();
  f32x4 xnx[8];
  if (xit >= 0) exp_item_load(xnx, a, xit, lane);
  bf16_t* Ow = (bf16_t*)(ws + WS_OAB) + (rowbase + q0 + wid * 32) * DM + (MODE ? 512 : 0) + h * 64;
  float* sso = (float*)(ws + WS_SSO) + (size_t)(MODE ? NT : 0) + rowbase + q0 + wid * 32;
#pragma unroll
  for (int i = 0; i < 4; ++i) { const int row = i * 8 + (lane >> 3), ch = lane & 7; const u32x4 v = *(const u32x4*)(stg + row * 64 + ch * 8); *(u32x4*)(Ow + (size_t)row * DM + ch * 8) = v;
    float f[8]; unpack8(v, f); float s = 0.f;
#pragma unroll
    for (int k = 0; k < 8; ++k) s += f[k] * f[k];
    s += swz_xor<1>(s); s += swz_xor<2>(s); s += swz_xor<4>(s);
    if (ch == 0) atomicAdd(sso + row, s); }
  if (xit >= 0) exp_item_finish(xnx, a, xit, lane);
}
}

__device__ __forceinline__ void phase_attn2(const Args& a, unsigned char* lds, int tid) {
  unsigned* ctr = (unsigned*)(a.ws + 0);
  unsigned* slot = (unsigned*)(lds + att::L_MISC + 64);
  const int ngw = (int)gridDim.x * 8; int xnext = (int)blockIdx.x * 8 + (tid >> 6);
  unsigned nxt = 0u;
  if (tid == 0) nxt = atomicAdd(ctr, 1u);
  for (;;) {
    __syncthreads();
    if (tid == 0) slot[0] = nxt;
    __syncthreads();
    const unsigned u = slot[0];
    if (u >= 2048u) break;
    if (tid == 0) nxt = atomicAdd(ctr, 1u);
    const int qb = 15 - (int)(u >> 7), r = u & 127, mode = r & 1, bh = r >> 1;
    const int xit = xnext < NEXP ? xnext : -1; xnext += ngw;
    if (mode == 0) att::unit<0>(a, lds, bh >> 3, bh & 7, qb, tid, xit);
    else att::unit<1>(a, lds, bh >> 3, bh & 7, qb, tid, xit);
  }
  for (; xnext < NEXP; xnext += ngw) { f32x4 nx[8]; exp_item_load(nx, a, xnext, tid & 63); exp_item_finish(nx, a, xnext, tid & 63); }
}

__device__ __forceinline__ void phase_onorm(const Args& a, int gw, int ngw, int lane) {
  bf16_t* oab = (bf16_t*)(a.ws + WS_OAB);
  for (int r = gw; r < NT; r += ngw) {
    u32x4* p = (u32x4*)(oab + (size_t)r * DM) + 2 * lane;
    const u32x4 w0 = p[0], w1 = p[1]; float f[16]; unpack8(w0, f); unpack8(w1, f + 8);
    float s = 0.f;
#pragma unroll
    for (int i = 0; i < 16; ++i) s += f[i] * f[i];
#pragma unroll
    for (int o = 1; o < 32; o <<= 1) s += __shfl_xor(s, o);
    const float rstd = rsqrtf(s * (1.f / 512.f) + EPS);
    u32x4 o0, o1;
    o0.x = pk2(f[0] * rstd, f[1] * rstd); o0.y = pk2(f[2] * rstd, f[3] * rstd); o0.z = pk2(f[4] * rstd, f[5] * rstd); o0.w = pk2(f[6] * rstd, f[7] * rstd);
    o1.x = pk2(f[8] * rstd, f[9] * rstd); o1.y = pk2(f[10] * rstd, f[11] * rstd); o1.z = pk2(f[12] * rstd, f[13] * rstd); o1.w = pk2(f[14] * rstd, f[15] * rstd);
    p[0] = o0; p[1] = o1;
  }
}

__device__ __forceinline__ void phase_rms(const Args& a, int gw, int ngw, int lane) {
  for (int r = gw; r < NT; r += ngw) rms_row_to_bf16(a.out + (size_t)r * DM, (bf16_t*)(a.ws + WS_HB) + (size_t)r * DM, lane);
}

__device__ __forceinline__ void phase_xattn(const Args& a, unsigned char* lds, int gw, int ngw, int wave, int lane) {
  unsigned char* ws = a.ws;
  const bf16_t* qx = (const bf16_t*)(ws + WS_QX); const bf16_t* kx = (const bf16_t*)(ws + WS_KX); const bf16_t* vxt = (const bf16_t*)(ws + WS_VXT);
  bf16_t* ox = (bf16_t*)(ws + WS_OX);
  bf16_t* P = (bf16_t*)(lds + wave * 8192);
  const int fr = lane & 15, fq = lane >> 4;
  for (int u = gw; u < (NT / 16) * 4; u += ngw) {
    const int hd = u & 3, r0 = (u >> 2) * 16, b = r0 / SEQ;
    f32x4 acc[16];
#pragma unroll
    for (int i = 0; i < 16; ++i) acc[i] = (f32x4){0.f, 0.f, 0.f, 0.f};
    const bf16_t* Ap = qx + (size_t)(r0 + fr) * DM + hd * 256 + fq * 8;
    const bf16_t* Bp = kx + (size_t)(b * 256 + fr) * DM + hd * 256 + fq * 8;
    for (int ks = 0; ks < 8; ++ks) {
      const bf16x8 af = *(const bf16x8*)(Ap + ks * 32);
#pragma unroll
      for (int ct = 0; ct < 16; ++ct) { const bf16x8 bfr = *(const bf16x8*)(Bp + (size_t)ct * 16 * DM + ks * 32); acc[ct] = __builtin_amdgcn_mfma_f32_16x16x32_bf16(af, bfr, acc[ct], 0, 0, 0); }
    }
    float mx[4], sm[4];
#pragma unroll
    for (int r = 0; r < 4; ++r) { float m = acc[0][r];
#pragma unroll
      for (int ct = 1; ct < 16; ++ct) m = fmaxf(m, acc[ct][r]);
#pragma unroll
      for (int o = 1; o < 16; o <<= 1) m = fmaxf(m, __shfl_xor(m, o));
      mx[r] = m; sm[r] = 0.f; }
#pragma unroll
    for (int ct = 0; ct < 16; ++ct)
#pragma unroll
      for (int r = 0; r < 4; ++r) { const float p = __expf((acc[ct][r] - mx[r]) * 0.0625f); acc[ct][r] = p; sm[r] += p; }
#pragma unroll
    for (int r = 0; r < 4; ++r) {
#pragma unroll
      for (int o = 1; o < 16; o <<= 1) sm[r] += __shfl_xor(sm[r], o);
      sm[r] = 1.f / sm[r]; }
    __builtin_amdgcn_wave_barrier();
#pragma unroll
    for (int ct = 0; ct < 16; ++ct)
#pragma unroll
      for (int r = 0; r < 4; ++r) P[(4 * fq + r) * 256 + ct * 16 + fr] = (bf16_t)f2bf(acc[ct][r] * sm[r]);
    __builtin_amdgcn_wave_barrier();
    asm volatile("s_waitcnt lgkmcnt(0)" ::: "memory");
#pragma unroll
    for (int i = 0; i < 16; ++i) acc[i] = (f32x4){0.f, 0.f, 0.f, 0.f};
    const bf16_t* Vp = vxt + ((size_t)(b * 4 + hd) * 256 + fr) * 256 + fq * 8;
    for (int ks = 0; ks < 8; ++ks) {
      const bf16x8 pf = *(const bf16x8*)(P + fr * 256 + ks * 32 + fq * 8);
#pragma unroll
      for (int dt = 0; dt < 16; ++dt) { const bf16x8 vf = *(const bf16x8*)(Vp + (size_t)dt * 16 * 256 + ks * 32); acc[dt] = __builtin_amdgcn_mfma_f32_16x16x32_bf16(pf, vf, acc[dt], 0, 0, 0); }
    }
#pragma unroll
    for (int dt = 0; dt < 16; ++dt)
#pragma unroll
      for (int r = 0; r < 4; ++r) ox[(size_t)(r0 + 4 * fq + r) * DM + hd * 256 + dt * 16 + fr] = (bf16_t)f2bf(acc[dt][r]);
    __builtin_amdgcn_wave_barrier();
  }
}

namespace xa {
using att::f32x16; using att::s16x4; using att::lds_cptr; using att::crow; using att::cvtpk; using att::vtr; using att::xhalf_max; using att::xhalf_sum;
constexpr int L_WSF = 98304;
__device__ __forceinline__ void glds16(const void* gsrc, unsigned lds_dst) { unsigned keep;
  asm volatile("s_mov_b32 %0, m0\n\ts_mov_b32 m0, %2\n\ts_nop 0\n\tglobal_load_lds_dwordx4 %1, off\n\ts_mov_b32 m0, %0" : "=&s"(keep) : "v"(gsrc), "s"(lds_dst) : "memory"); }
__device__ __forceinline__ void unit(const Args& a, unsigned char* lds, int b, int hd, int qb, int tid) {
  unsigned char* ws = a.ws;
  const int lane = tid & 63, r32 = lane & 31, hi = lane >> 5; const int wid = __builtin_amdgcn_readfirstlane(tid >> 6);
  const bf16_t* qrow = (const bf16_t*)(ws + WS_QX) + ((size_t)b * SEQ + qb * 256 + wid * 32 + r32) * DM + hd * 256;
  const bf16_t* kvb = (const bf16_t*)(ws + WS_KX) + (size_t)b * 256 * 2048 + hd * 256;
  const bf16_t* ksrc = kvb + (size_t)lane * 2048 + wid * 8;
  const bf16_t* vsrc = kvb + 1024 + (size_t)(16 * (wid & 3) + (lane >> 2)) * 2048 + (wid >> 2) * 32 + (lane & 3) * 8;
  const unsigned sdst = (unsigned)(uintptr_t)lds + wid * 1024;
  const lds_cptr lds3 = (lds_cptr)lds;
  const lds_cptr kp0 = lds3 + hi * 1024 + r32 * 16;
  const lds_cptr vp0 = lds3 + ((lane >> 4) & 1) * 32 + (lane & 3) * 8 + (4 * hi + ((lane & 15) >> 2)) * 64;
  float* wsf = (float*)(lds + L_WSF) + wid * 64;
#define XA_DMA(s) do { const unsigned db_ = (unsigned)__builtin_amdgcn_readfirstlane(sdst + ((s) % 3) * 32768); \
    const bf16_t* kq_ = ksrc; const bf16_t* vq_ = vsrc; asm volatile("" : "+v"(kq_), "+v"(vq_));        \
    if ((s) < 4) { _Pragma("unroll") for (int kt = 0; kt < 4; ++kt) glds16(kq_ + (size_t)kt * 64 * 2048 + (s) * 64, db_ + kt * 8192); } \
    else { _Pragma("unroll") for (int dq = 0; dq < 4; ++dq) glds16(vq_ + (size_t)((s) - 4) * 64 * 2048 + dq * 64, db_ + dq * 8192); } } while (0)
#define XA_CLOSE(s) do { if ((s) + 2 < 8) asm volatile("s_waitcnt vmcnt(4) lgkmcnt(0)\n\ts_barrier" ::: "memory"); else asm volatile("s_waitcnt vmcnt(0) lgkmcnt(0)\n\ts_barrier" ::: "memory"); } while (0)
  __syncthreads();
  asm volatile("s_waitcnt vmcnt(0)" ::: "memory");
  XA_DMA(0); XA_DMA(1);
  f32x16 acc[8];
#pragma unroll
  for (int j = 0; j < 8; ++j) acc[j] = f32x16{};
  asm volatile("s_waitcnt vmcnt(4) lgkmcnt(0)\n\ts_barrier" ::: "memory");
#pragma unroll
  for (int c = 0; c < 4; ++c) {
    XA_DMA(c + 2);
    bf16x8 qf[4];
#pragma unroll
    for (int d0 = 0; d0 < 4; ++d0) qf[d0] = *(const bf16x8*)(qrow + c * 64 + d0 * 16 + hi * 8);
    int koff_ = (c % 3) * 32768; asm volatile("" : "+v"(koff_));
    const lds_cptr kp = kp0 + koff_;
#pragma unroll
    for (int d0 = 0; d0 < 4; ++d0)
#pragma unroll
      for (int j = 0; j < 8; ++j) {
        const bf16x8 kf = *(const __attribute__((address_space(3))) bf16x8*)(kp + (j >> 1) * 8192 + d0 * 2048 + (j & 1) * 512);
        acc[j] = __builtin_amdgcn_mfma_f32_32x32x16_bf16(kf, qf[d0], acc[j], 0, 0, 0);
      }
    XA_CLOSE(c);
  }
  float m = acc[0][0];
#pragma unroll
  for (int j = 0; j < 8; ++j)
#pragma unroll
    for (int r = 0; r < 16; ++r) m = fmaxf(m, acc[j][r]);
  m = xhalf_max(m);
  constexpr float CS = 1.4426950408889634f / 16.f;
  float l = 0.f; u32x4 pw[16];
#pragma unroll
  for (int j = 0; j < 8; ++j) {
#pragma unroll
    for (int r = 0; r < 16; ++r) { const float p = __builtin_amdgcn_exp2f((acc[j][r] - m) * CS); acc[j][r] = p; l += p; }
    pw[2 * j] = (u32x4){cvtpk(acc[j][0], acc[j][1]), cvtpk(acc[j][2], acc[j][3]), cvtpk(acc[j][4], acc[j][5]), cvtpk(acc[j][6], acc[j][7])};
    pw[2 * j + 1] = (u32x4){cvtpk(acc[j][8], acc[j][9]), cvtpk(acc[j][10], acc[j][11]), cvtpk(acc[j][12], acc[j][13]), cvtpk(acc[j][14], acc[j][15])};
  }
  l = xhalf_sum(l);
#pragma unroll
  for (int j = 0; j < 8; ++j) acc[j] = f32x16{};
#pragma unroll
  for (int vt = 0; vt < 4; ++vt) {
    if (vt + 6 < 8) XA_DMA(vt + 6);
    int voff_ = ((vt + 4) % 3) * 32768; asm volatile("" : "+v"(voff_));
    const lds_cptr vp = vp0 + voff_;
#pragma unroll
    for (int ks = 0; ks < 4; ++ks)
#pragma unroll
      for (int db = 0; db < 8; ++db) {
        const s16x4 lo_ = vtr(vp + (db >> 1) * 8192 + (db & 1) * 4096 + ks * 1024), hi_ = vtr(vp + (db >> 1) * 8192 + (db & 1) * 4096 + ks * 1024 + 512);
        const bf16x8 vf = (bf16x8){lo_[0], lo_[1], lo_[2], lo_[3], hi_[0], hi_[1], hi_[2], hi_[3]};
        acc[db] = __builtin_amdgcn_mfma_f32_32x32x16_bf16(__builtin_bit_cast(bf16x8, pw[4 * vt + ks]), vf, acc[db], 0, 0, 0);
      }
    XA_CLOSE(vt + 4);
  }
  if (hi == 0) wsf[r32] = l;
  __builtin_amdgcn_wave_barrier();
  float rl[16];
#pragma unroll
  for (int r = 0; r < 16; ++r) rl[r] = 1.f / wsf[crow(r, hi)];
  int sbase = (4 * hi) * 128 + r32, lbase = (lane >> 4) * 128 + (lane & 15) * 8;
  asm volatile("" : "+v"(sbase), "+v"(lbase));
  bf16_t* stg = (bf16_t*)(lds + wid * 8192);
  bf16_t* orow0 = (bf16_t*)(ws + WS_OX) + ((size_t)b * SEQ + qb * 256 + wid * 32) * DM + hd * 256 + (size_t)(lane >> 4) * DM + (lane & 15) * 8;
#pragma unroll
  for (int hf = 0; hf < 2; ++hf) {
#pragma unroll
    for (int db = 0; db < 4; ++db)
#pragma unroll
      for (int r = 0; r < 16; ++r) stg[sbase + ((r & 3) + 8 * (r >> 2)) * 128 + db * 32] = (bf16_t)f2bf(acc[hf * 4 + db][r] * rl[r]);
    __builtin_amdgcn_wave_barrier();
#pragma unroll
    for (int i = 0; i < 8; ++i) { const u32x4 v = *(const u32x4*)(stg + lbase + i * 4 * 128); *(u32x4*)(orow0 + (size_t)(i * 4) * DM + hf * 128) = v; }
    __builtin_amdgcn_wave_barrier();
  }
#undef XA_DMA
#undef XA_CLOSE
}
}

__device__ __forceinline__ void phase_xattn2(const Args& a, unsigned char* lds, int tid) {
  for (int u = blockIdx.x; u < NB * 4 * 16; u += gridDim.x) { const int qb = u & 15, hd = (u >> 4) & 3, b = u >> 6; xa::unit(a, lds, b, hd, qb, tid); }
}

__device__ __forceinline__ unsigned fkey(float s, unsigned idx, unsigned mask) { unsigned u = __float_as_uint(s); u ^= (unsigned)((int)u >> 31) | 0x80000000u; return (u & ~mask) | (mask - idx); }
__device__ __forceinline__ float keyval(unsigned k, unsigned mask) { unsigned u = k & ~mask; u = (u & 0x80000000u) ? (u ^ 0x80000000u) : ~u; return __uint_as_float(u); }
#define KEY_INSERT(KA, key_) do { unsigned k__ = (key_); \
  _Pragma("unroll") for (int s_ = 0; s_ < 16; ++s_) { const unsigned hi_ = max(k__, KA[s_]); k__ = min(k__, KA[s_]); KA[s_] = hi_; } } while (0)

__device__ __forceinline__ void phase_topk(const Args& a, unsigned char* lds, int tid) {
  unsigned char* ws = a.ws;
  const float* pq = (const float*)(ws + WS_PQ);
  int* eidx = (int*)(ws + WS_EIDX); float* gate = (float*)(ws + WS_GATE);
  float* K1 = (float*)lds; float* K2 = K1 + 128 * 64; unsigned* KL = (unsigned*)(lds + 65536);
  for (int u = blockIdx.x; u < 8 * (NT / 512); u += gridDim.x) {
    const int h = u & 7, t = (u >> 3) * 512 + tid;
    __syncthreads();
    for (int i = tid; i < 128 * 64 / 4; i += 512) { ((f32x4*)K1)[i] = ((const f32x4*)(a.in[17] + (size_t)h * 8192))[i]; ((f32x4*)K2)[i] = ((const f32x4*)(a.in[18] + (size_t)h * 8192))[i]; }
    __syncthreads();
    unsigned ka[16], kb[16], kc[16];
#pragma unroll
    for (int k = 0; k < 16; ++k) { ka[k] = 0u; kb[k] = 0u; kc[k] = 0u; }
    float q[64];
    const f32x4* qp = (const f32x4*)(pq + (size_t)t * DM + h * 128);
#pragma unroll
    for (int c = 0; c < 16; ++c) { const f32x4 w = qp[c]; q[4 * c] = w.x; q[4 * c + 1] = w.y; q[4 * c + 2] = w.z; q[4 * c + 3] = w.w; }
    for (int n = 0; n < 128; ++n) {
      const f32x4* kr = (const f32x4*)(K1 + n * 64); float s = 0.f;
#pragma unroll
      for (int c = 0; c < 16; ++c) { const f32x4 kv = kr[c]; s += q[4 * c] * kv.x + q[4 * c + 1] * kv.y + q[4 * c + 2] * kv.z + q[4 * c + 3] * kv.w; }
      KEY_INSERT(ka, fkey(s, (unsigned)n, 127u));
    }
#pragma unroll
    for (int c = 0; c < 16; ++c) { const f32x4 w = qp[16 + c]; q[4 * c] = w.x; q[4 * c + 1] = w.y; q[4 * c + 2] = w.z; q[4 * c + 3] = w.w; }
    for (int n = 0; n < 128; ++n) {
      const f32x4* kr = (const f32x4*)(K2 + n * 64); float s = 0.f;
#pragma unroll
      for (int c = 0; c < 16; ++c) { const f32x4 kv = kr[c]; s += q[4 * c] * kv.x + q[4 * c + 1] * kv.y + q[4 * c + 2] * kv.z + q[4 * c + 3] * kv.w; }
      KEY_INSERT(kb, fkey(s, (unsigned)n, 127u));
    }
#pragma unroll
    for (int x = 0; x < 16; ++x)
#pragma unroll
      for (int y = 0; y < 16; ++y)
        if ((x + 1) * (y + 1) <= 16) { KEY_INSERT(kc, fkey(keyval(ka[x], 127u) + keyval(kb[y], 127u), (unsigned)(x * 16 + y), 255u)); }
#pragma unroll
    for (int k = 0; k < 16; ++k) { KL[k * 512 + tid] = ka[k]; KL[(16 + k) * 512 + tid] = kb[k]; }
    float val[16]; int id[16]; float sum = 0.f;
#pragma unroll
    for (int k = 0; k < 16; ++k) {
      const unsigned flat = 255u - (kc[k] & 255u);
      const unsigned k1 = KL[(flat >> 4) * 512 + tid], k2 = KL[(16 + (flat & 15u)) * 512 + tid];
      val[k] = keyval(k1, 127u) + keyval(k2, 127u);
      id[k] = (int)((127u - (k1 & 127u)) * 128u + (127u - (k2 & 127u)));
    }
    const float vmax = val[0];
#pragma unroll
    for (int k = 0; k < 16; ++k) { val[k] = __expf(val[k] - vmax); sum += val[k]; }
    const float inv = 1.f / sum;
    int* ep = eidx + (size_t)t * 128 + h * 16; float* gp = gate + (size_t)t * 128 + h * 16;
#pragma unroll
    for (int k = 0; k < 16; ++k) { ep[k] = id[k]; gp[k] = val[k] * inv; }
  }
}


namespace tk {
typedef float f32x16 __attribute__((ext_vector_type(16)));
__device__ __forceinline__ void ce(unsigned& a, unsigned& b) { const unsigned h = max(a, b), l = min(a, b); a = h; b = l; }
__device__ __forceinline__ void sort16(unsigned (&v)[16]) {
#pragma unroll
  for (int k = 2; k <= 16; k <<= 1)
#pragma unroll
    for (int j = k >> 1; j > 0; j >>= 1)
#pragma unroll
      for (int i = 0; i < 16; ++i) { const int l = i ^ j; if (l > i) { if ((i & k) == 0) ce(v[i], v[l]); else ce(v[l], v[i]); } }
}
__device__ __forceinline__ void topmerge(unsigned (&a)[16], const unsigned (&b)[16]) {
#pragma unroll
  for (int i = 0; i < 16; ++i) a[i] = max(a[i], b[15 - i]);
#pragma unroll
  for (int j = 8; j > 0; j >>= 1)
#pragma unroll
    for (int i = 0; i < 16; ++i) { const int l = i ^ j; if (l > i) ce(a[i], a[l]); }
}
__device__ __forceinline__ unsigned xswap(unsigned v, int hi) { auto rr = __builtin_amdgcn_permlane32_swap(v, v, false, false); return hi ? rr[0] : rr[1]; }
__device__ __forceinline__ void half_list(unsigned (&L)[16], const bf16_t* skh, const bf16_t* qrow, int r32, int hi) {
  f32x16 acc[4];
#pragma unroll
  for (int i = 0; i < 4; ++i) acc[i] = f32x16{};
#pragma unroll
  for (int ks = 0; ks < 4; ++ks) {
    const bf16x8 qf = *(const bf16x8*)(qrow + ks * 16 + hi * 8);
#pragma unroll
    for (int tl = 0; tl < 4; ++tl) { const bf16x8 kf = *(const bf16x8*)(skh + (size_t)(tl * 32 + r32) * 64 + ks * 16 + hi * 8); acc[tl] = __builtin_amdgcn_mfma_f32_32x32x16_bf16(kf, qf, acc[tl], 0, 0, 0); }
  }
  unsigned g[4][16];
#pragma unroll
  for (int tl = 0; tl < 4; ++tl)
#pragma unroll
    for (int r = 0; r < 16; ++r) g[tl][r] = fkey(acc[tl][r], (unsigned)(32 * tl + (r & 3) + 8 * (r >> 2) + 4 * hi), 127u);
  sort16(g[0]); sort16(g[1]); sort16(g[2]); sort16(g[3]);
  topmerge(g[0], g[1]); topmerge(g[2], g[3]); topmerge(g[0], g[2]);
  unsigned p[16];
#pragma unroll
  for (int k = 0; k < 16; ++k) p[k] = xswap(g[0][k], hi);
  topmerge(g[0], p);
#pragma unroll
  for (int k = 0; k < 16; ++k) L[k] = g[0][k];
}
}

__device__ __forceinline__ void phase_topk2(const Args& a, unsigned char* lds, int wave, int lane) {
  unsigned char* ws = a.ws;
  const bf16_t* pq = (const bf16_t*)(ws + WS_PQ); const bf16_t* sk = (const bf16_t*)(ws + WS_SK);
  int* eidx = (int*)(ws + WS_EIDX); float* gate = (float*)(ws + WS_GATE);
  const int r32 = lane & 31, hi = lane >> 5, h = wave;
  unsigned* KL = (unsigned*)(lds + wave * 4096);
  for (int t4 = blockIdx.x * 4; t4 < NT / 32; t4 += gridDim.x * 4)
  for (int tt = t4; tt < t4 + 4; ++tt) {
    const int t = tt * 32 + r32;
    unsigned ka[16], kb[16], kc[16];
    tk::half_list(ka, sk + (size_t)(0 * 8 + h) * 8192, pq + (size_t)t * DM + h * 128, r32, hi);
    tk::half_list(kb, sk + (size_t)(1 * 8 + h) * 8192, pq + (size_t)t * DM + h * 128 + 64, r32, hi);
    float va[16], vb[16];
#pragma unroll
    for (int k = 0; k < 16; ++k) { va[k] = keyval(ka[k], 127u); vb[k] = keyval(kb[k], 127u); }
#pragma unroll
    for (int y = 0; y < 16; ++y) kc[y] = hi ? 0u : fkey(va[0] + vb[y], (unsigned)y, 255u);
#define TK_CAND(xa, ya, xb, yb) do { const unsigned kA_ = fkey(va[xa] + vb[ya], (unsigned)((xa) * 16 + (ya)), 255u), kB_ = fkey(va[xb] + vb[yb], (unsigned)((xb) * 16 + (yb)), 255u); KEY_INSERT(kc, hi ? kB_ : kA_); } while (0)
    TK_CAND(1, 0, 1, 1);
    TK_CAND(1, 2, 1, 3);
    TK_CAND(1, 4, 1, 5);
    TK_CAND(1, 6, 1, 7);
    TK_CAND(2, 0, 2, 1);
    TK_CAND(2, 2, 2, 3);
    TK_CAND(2, 4, 3, 0);
    TK_CAND(3, 1, 3, 2);
    TK_CAND(3, 3, 4, 0);
    TK_CAND(4, 1, 4, 2);
    TK_CAND(5, 0, 5, 1);
    TK_CAND(6, 0, 6, 1);
    TK_CAND(7, 0, 7, 1);
    TK_CAND(8, 0, 9, 0);
    TK_CAND(10, 0, 11, 0);
    TK_CAND(12, 0, 13, 0);
    TK_CAND(14, 0, 15, 0);
#undef TK_CAND
    { unsigned p[16];
#pragma unroll
      for (int k = 0; k < 16; ++k) p[k] = tk::xswap(kc[k], hi);
      tk::topmerge(kc, p); }
    if (hi == 0) {
#pragma unroll
      for (int k = 0; k < 16; ++k) { KL[k * 32 + r32] = ka[k]; KL[(16 + k) * 32 + r32] = kb[k]; }
    }
    __builtin_amdgcn_wave_barrier();
    const float vmax = va[0] + vb[0];
    float pv[8]; int id[8]; float s = 0.f;
#pragma unroll
    for (int j = 0; j < 8; ++j) {
      unsigned klo_ = kc[j], khi_ = kc[8 + j]; asm volatile("" : "+v"(klo_), "+v"(khi_));
      const unsigned key = hi ? khi_ : klo_;
      const unsigned flat = 255u - (key & 255u);
      const unsigned k1 = KL[(flat >> 4) * 32 + r32], k2 = KL[(16 + (flat & 15u)) * 32 + r32];
      pv[j] = __expf(keyval(k1, 127u) + keyval(k2, 127u) - vmax); s += pv[j];
      id[j] = (int)((127u - (k1 & 127u)) * 128u + (127u - (k2 & 127u)));
    }
    __builtin_amdgcn_wave_barrier();
    const float inv = 1.f / att::xhalf_sum(s);
    u32x4* ep = (u32x4*)(eidx + (size_t)t * 128 + h * 16 + hi * 8); f32x4* gp = (f32x4*)(gate + (size_t)t * 128 + h * 16 + hi * 8);
    ep[0] = (u32x4){(unsigned)id[0], (unsigned)id[1], (unsigned)id[2], (unsigned)id[3]}; ep[1] = (u32x4){(unsigned)id[4], (unsigned)id[5], (unsigned)id[6], (unsigned)id[7]};
    gp[0] = (f32x4){pv[0] * inv, pv[1] * inv, pv[2] * inv, pv[3] * inv}; gp[1] = (f32x4){pv[4] * inv, pv[5] * inv, pv[6] * inv, pv[7] * inv};
  }
}

__device__ __forceinline__ float gelu_erf(float v) { return 0.5f * v * (1.f + erff(v * 0.70710678118654752f)); }

__device__ __forceinline__ float gelu_as(float v) {
  const float av = fabsf(v), t = __builtin_amdgcn_rcpf(av * 0.2316418882f + 1.0f);
  float q = t * 0.5307027145f + (-0.7265760135f); q = q * t + 0.7107068705f; q = q * t + (-0.142248368f); q = q * t + 0.127414796f; q = q * t;
  const float m = v * (q * __builtin_amdgcn_exp2f((v * v) * (-0.72134752044f)));
  return v < 0.f ? m : v - m;
}
#define PIN16(A, O) asm volatile("" : "+v"(A[O]), "+v"(A[O + 1]), "+v"(A[O + 2]), "+v"(A[O + 3]), "+v"(A[O + 4]), "+v"(A[O + 5]), "+v"(A[O + 6]), "+v"(A[O + 7]), "+v"(A[O + 8]), "+v"(A[O + 9]), "+v"(A[O + 10]), "+v"(A[O + 11]), "+v"(A[O + 12]), "+v"(A[O + 13]), "+v"(A[O + 14]), "+v"(A[O + 15]))
#define PIN6(R) asm volatile("" : "+v"(R[0].x), "+v"(R[0].y), "+v"(R[1].x), "+v"(R[1].y), "+v"(R[2].x), "+v"(R[2].y))
__device__ __forceinline__ void phase_exp_down(const Args& a, int wave, int lane) {
  const int nblk_ = (NT / 128 - (int)blockIdx.x + (int)gridDim.x - 1) / (int)gridDim.x, ntok = nblk_ > 0 ? 16 * nblk_ : 0;
#define DOWN_TOK(i) ((((int)blockIdx.x + ((i) >> 4) * (int)gridDim.x) * 128) + wave * 16 + ((i) & 15))
  unsigned char* ws = a.ws;
  const int* eidx = (const int*)(ws + WS_EIDX); const float* gate = (const float*)(ws + WS_GATE); float* wout = (float*)(ws + WS_W);
  const unsigned char* exd = ws + WS_EXD; const float* esc = (const float*)(ws + WS_ESC);
  const int l32 = lane & 31, hi = lane >> 5;
  const bool b4 = (l32 & 16) != 0, b3 = (l32 & 8) != 0, b2 = (l32 & 4) != 0;
  const bf16_t* hb = (const bf16_t*)(ws + WS_HB); const float* ss2 = (const float*)(ws + WS_SS2);
  int ne0 = 0, ne1 = 0; float ng0 = 0.f, ng1 = 0.f, nss = 0.f; u32x4 nh[4];
  if (ntok > 0) { const size_t tf = (size_t)DOWN_TOK(0); ne0 = eidx[tf * 128 + lane]; ne1 = eidx[tf * 128 + 64 + lane]; ng0 = gate[tf * 128 + lane]; ng1 = gate[tf * 128 + 64 + lane]; nss = ss2[tf];
    const u32x4* hp = (const u32x4*)(hb + tf * DM + 32 * l32);
#pragma unroll
    for (int k = 0; k < 4; ++k) nh[k] = hp[k]; }
  for (int ti = 0; ti < ntok; ++ti) {
    const int t = DOWN_TOK(ti);
    const int e0 = ne0, e1 = ne1;
    const float sd0 = esc[e0], sd1 = esc[e1];
    const float gu0 = ng0 * esc[NEXP + e0], gu1 = ng1 * esc[NEXP + e1];
    float hg[32];
    unpack8(nh[0], hg); unpack8(nh[1], hg + 8); unpack8(nh[2], hg + 16); unpack8(nh[3], hg + 24);
    const float rstd = rsqrtf(nss * (1.f / DM) + EPS);
    if (ti + 1 < ntok) { const size_t tn = (size_t)DOWN_TOK(ti + 1); ne0 = eidx[tn * 128 + lane]; ne1 = eidx[tn * 128 + 64 + lane]; ng0 = gate[tn * 128 + lane]; ng1 = gate[tn * 128 + 64 + lane]; nss = ss2[tn];
      const u32x4* hp = (const u32x4*)(hb + tn * DM + 32 * l32);
#pragma unroll
      for (int k = 0; k < 4; ++k) nh[k] = hp[k]; }
#pragma unroll
    for (int k = 0; k < 8; ++k) { const f32x4 g = ((const f32x4*)a.in[15])[8 * l32 + k]; hg[4 * k] *= rstd * g.x; hg[4 * k + 1] *= rstd * g.y; hg[4 * k + 2] *= rstd * g.z; hg[4 * k + 3] *= rstd * g.w; }
    float w0 = 0.f, w1 = 0.f;
    for (int e = 0; e < 128; e += 16) {
      u32x2 ur[8][3];
#pragma unroll
      for (int i = 0; i < 8; ++i) {
        const int pi = (e & 63) + 2 * i + hi; const int id = (e < 64) ? __shfl(e0, pi) : __shfl(e1, pi);
        const u32x2* up = (const u32x2*)(exd + (size_t)id * 768 + 24 * l32);
        ur[i][0] = up[0]; ur[i][1] = up[1]; ur[i][2] = up[2];
      }
      float d[8];
#pragma unroll
      for (int i = 0; i < 8; ++i) {
        const v32f u = __builtin_amdgcn_cvt_scalef32_pk32_f32_fp6((v6u){ur[i][0].x, ur[i][0].y, ur[i][1].x, ur[i][1].y, ur[i][2].x, ur[i][2].y}, 1.0f);
        f32x2 q2 = (f32x2){0.f, 0.f};
#pragma unroll
        for (int k = 0; k < 16; ++k) q2 = __builtin_elementwise_fma((f32x2){u[2 * k], u[2 * k + 1]}, (f32x2){hg[2 * k], hg[2 * k + 1]}, q2);
        d[i] = q2.x + q2.y;
        __builtin_amdgcn_sched_barrier(0);
      }
      float r[4];
#pragma unroll
      for (int j = 0; j < 4; ++j) r[j] = (b4 ? d[j + 4] : d[j]) + swz_xor<16>(b4 ? d[j] : d[j + 4]);
      const float q0 = (b3 ? r[2] : r[0]) + swz_xor<8>(b3 ? r[0] : r[2]);
      const float q1 = (b3 ? r[3] : r[1]) + swz_xor<8>(b3 ? r[1] : r[3]);
      float q = (b2 ? q1 : q0) + swz_xor<4>(b2 ? q0 : q1);
      q += swz_xor<2>(q); q += swz_xor<1>(q);
      const int pr = (e & 63) + 2 * (l32 >> 2) + hi;
      const float sd = (e < 64) ? __shfl(sd0, pr) : __shfl(sd1, pr);
      const float gu = (e < 64) ? __shfl(gu0, pr) : __shfl(gu1, pr);
      const float wl = gu * gelu_as(q * sd);
      const float wsrc = __shfl(wl, ((lane & 1) << 5) | (((lane - (e & 63)) >> 1 & 7) << 2));
      if (lane >= (e & 63) && lane < (e & 63) + 16) { if (e < 64) w0 = wsrc; else w1 = wsrc; }
    }
    wout[(size_t)t * 128 + lane] = w0; wout[(size_t)t * 128 + 64 + lane] = w1;
  }
#undef DOWN_TOK
}

namespace dnm {
typedef int v8i __attribute__((ext_vector_type(8)));
constexpr int PITCH = 800  , CAPE = 688, CAP = CAPE + 16, L_LIST = 16 * PITCH, L_DV = L_LIST + 4 * CAP, WAVE_LDS = L_DV + 256;
static_assert(WAVE_LDS <= 16384, "per-wave LDS window");
struct RBuf { u32x4 a[8]; u32x2 b[8]; };
__device__ __forceinline__ void gather(RBuf& R, const unsigned char* exd, const unsigned* list, int e0, int hi, unsigned l32) {
#pragma unroll
  for (int i = 0; i < 8; ++i) { const unsigned ent = list[e0 + 2 * i + hi]; const unsigned eid = (ent >> 11) & 16383u; const unsigned char* p = exd + (eid * 768u + 16u * l32); R.a[i] = *(const u32x4*)p; R.b[i] = *(const u32x2*)(p + 512 - 8 * l32); }
}
struct Pend { unsigned ent; float d, gate, sd, su; };
__device__ __forceinline__ void finish(const Pend& P, float* wout, int t0, float rstd_l) {
  const unsigned tk = (P.ent >> 7) & 15u, slot = P.ent & 127u;
  const float rs = __shfl(rstd_l, (int)tk);
  if (!(P.ent >> 31)) wout[(size_t)(t0 + (int)tk) * 128 + slot] = P.gate * P.su * gelu_as(P.d * rs * P.sd);
}
__device__ __forceinline__ void start(Pend& P, const unsigned* list, const float* dv, int e0, int n, int lane, const float* gate, const float* esc, int t0) {
  unsigned ent = 0x80000000u; float d = 0.f;
  if (lane < n) { ent = list[e0 + lane]; d = dv[lane]; }
  const unsigned eid = (ent >> 11) & 16383u, tk = (ent >> 7) & 15u, slot = ent & 127u;
  P.ent = ent; P.d = d; P.gate = gate[(size_t)(t0 + (int)tk) * 128 + slot]; P.sd = esc[eid]; P.su = esc[NEXP + eid];
}
}
__device__ __forceinline__ void phase_exp_down2(const Args& a, unsigned char* lds, int wave, int lane) {
  using namespace dnm;
  unsigned char* ws = a.ws;
  const int* eidx = (const int*)(ws + WS_EIDX); const float* gate = (const float*)(ws + WS_GATE); float* wout = (float*)(ws + WS_W);
  const unsigned char* exd = ws + WS_EXD; const float* esc = (const float*)(ws + WS_ESC);
  const bf16_t* hb = (const bf16_t*)(ws + WS_HB); const float* ss2 = (const float*)(ws + WS_SS2);
  unsigned char* wl = lds + wave * 16384;
  unsigned* list = (unsigned*)(wl + L_LIST); float* dv = (float*)(wl + L_DV);
  const int l32 = lane & 31, hi = lane >> 5, m = lane & 15, kg = lane >> 4;
  unsigned char* wbase = wl + hi * PITCH + 16 * l32;
  const unsigned char* rbase = wl + m * PITCH + 48 * kg;
  for (int blk = blockIdx.x; blk < NT / 128; blk += gridDim.x) {
    const int t0 = blk * 128 + wave * 16;
    v8i B[8];
    float rstd_l;
    {
      const bf16_t* hp = hb + (size_t)(t0 + m) * DM + 64 * kg;
      float mx = 0.f;
#pragma unroll 4
      for (int c = 0; c < 32; ++c) { const u32x4 v = *(const u32x4*)(hp + (c >> 3) * 256 + (c & 7) * 8); float f[8]; unpack8(v, f);
#pragma unroll
        for (int k = 0; k < 8; ++k) mx = fmaxf(mx, fabsf(f[k])); }
      mx = fmaxf(mx, __shfl_xor(mx, 16)); mx = fmaxf(mx, __shfl_xor(mx, 32));
      const float s = mx > 0.f ? 7.0f / mx : 1.f;
      rstd_l = rsqrtf(ss2[t0 + m] * (1.f / DM) + EPS) * (mx > 0.f ? mx * (1.f / 7.0f) : 1.f);
#pragma unroll
      for (int j = 0; j < 8; ++j) {
        const u32x4* p = (const u32x4*)(hp + 256 * (j >> 1) + 32 * (j & 1));
        v16f xa, xb;
#pragma unroll
        for (int q = 0; q < 4; ++q) { const u32x4 v = p[q]; float f[8]; unpack8(v, f);
#pragma unroll
          for (int k = 0; k < 4; ++k) { xa[4 * q + k] = f[2 * k] * s; xb[4 * q + k] = f[2 * k + 1] * s; } }
        const v6u w = __builtin_amdgcn_cvt_scalef32_2xpk16_fp6_f32(xa, xb, 1.0f);
        B[j] = (v8i){(int)w[0], (int)w[1], (int)w[2], (int)w[3], (int)w[4], (int)w[5], 0, 0};
      }
    }
    Pend P; P.ent = 0x80000000u; P.d = 0.f; P.gate = 0.f; P.sd = 0.f; P.su = 0.f;
    unsigned ea[16], eb[16];
#pragma unroll
    for (int tk = 0; tk < 16; ++tk) { const size_t o = (size_t)(t0 + tk) * 128; ea[tk] = (unsigned)eidx[o + lane]; eb[tk] = (unsigned)eidx[o + 64 + lane]; }
#pragma unroll 1
    for (int r = 0; r < 8; ++r) {
      int S = 0, total = 0;
      do {
        int cnt = 0;
        __builtin_amdgcn_wave_barrier();
#pragma unroll
        for (int tk = 0; tk < 16; ++tk) {
          const bool ia = (int)(ea[tk] >> 11) == r, ib = (int)(eb[tk] >> 11) == r;
          const unsigned long long ma = __ballot(ia), mb = __ballot(ib);
          const int pa = __builtin_amdgcn_mbcnt_hi((unsigned)(ma >> 32), __builtin_amdgcn_mbcnt_lo((unsigned)ma, 0u));
          const int na = __popcll(ma);
          const int pb = __builtin_amdgcn_mbcnt_hi((unsigned)(mb >> 32), __builtin_amdgcn_mbcnt_lo((unsigned)mb, 0u));
          const int ra = cnt + pa - S, rb = cnt + na + pb - S;
          if (ia && (unsigned)ra < (unsigned)CAPE) list[ra] = (ea[tk] << 11) | ((unsigned)tk << 7) | (unsigned)lane;
          if (ib && (unsigned)rb < (unsigned)CAPE) list[rb] = (eb[tk] << 11) | ((unsigned)tk << 7) | (unsigned)(64 + lane);
          cnt += na + __popcll(mb);
        }
        total = cnt;
        cnt = min(total - S, CAPE);
        S += CAPE;
        __builtin_amdgcn_wave_barrier();
        asm volatile("" ::: "memory");
        if (cnt <= 0) continue;
        const int npad = (cnt + 15) & ~15;
        if (lane < npad - cnt) list[cnt + lane] = list[0] | 0x80000000u;
        __builtin_amdgcn_wave_barrier();
        asm volatile("" ::: "memory");
        const int ntile = npad >> 4;
        RBuf GA, GB;
        gather(GA, exd, list, 0, hi, (unsigned)l32);
#define DN_TILE(G, MT) do { \
          asm volatile("" ::: "memory"); \
          _Pragma("unroll") for (int i = 0; i < 8; ++i) { unsigned char* wp = wbase + 2 * PITCH * i; *(u32x4*)wp = G.a[i]; *(u32x2*)(wp + 512 - 8 * l32) = G.b[i]; } \
          asm volatile("" ::: "memory"); \
          f32x4 C = (f32x4){0.f, 0.f, 0.f, 0.f}; \
          _Pragma("unroll") for (int jj = 0; jj < 4; ++jj) { const u32x4* ap = (const u32x4*)(rbase + 192 * jj); const u32x4 a0 = ap[0], a1 = ap[1], a2 = ap[2]; \
            const v8i A0 = (v8i){(int)a0.x, (int)a0.y, (int)a0.z, (int)a0.w, (int)a1.x, (int)a1.y, 0, 0}, A1 = (v8i){(int)a1.z, (int)a1.w, (int)a2.x, (int)a2.y, (int)a2.z, (int)a2.w, 0, 0}; \
            C = __builtin_amdgcn_mfma_scale_f32_16x16x128_f8f6f4(A0, B[2 * jj], C, 2, 2, 0, 127, 0, 127); \
            C = __builtin_amdgcn_mfma_scale_f32_16x16x128_f8f6f4(A1, B[2 * jj + 1], C, 2, 2, 0, 127, 0, 127); } \
          const u32x4 e4 = *(const u32x4*)(list + 16 * (MT) + 4 * kg); \
          float* dvp = dv + ((16 * (MT) + 4 * kg) & 63); \
          if ((int)((e4.x >> 7) & 15u) == m) dvp[0] = C[0]; \
          if ((int)((e4.y >> 7) & 15u) == m) dvp[1] = C[1]; \
          if ((int)((e4.z >> 7) & 15u) == m) dvp[2] = C[2]; \
          if ((int)((e4.w >> 7) & 15u) == m) dvp[3] = C[3]; \
        } while (0)
#pragma unroll 1
        for (int mt = 0; mt < ntile; mt += 4) {
          const int last = ntile - 1;
          const int m1 = min(mt + 1, last), m2 = min(mt + 2, last), m3 = min(mt + 3, last), m4 = min(mt + 4, last);
          gather(GB, exd, list, 16 * m1, hi, (unsigned)l32);
          __builtin_amdgcn_sched_barrier(0);
          DN_TILE(GA, mt);
          gather(GA, exd, list, 16 * m2, hi, (unsigned)l32);
          __builtin_amdgcn_sched_barrier(0);
          if (mt + 1 < ntile) DN_TILE(GB, m1);
          gather(GB, exd, list, 16 * m3, hi, (unsigned)l32);
          __builtin_amdgcn_sched_barrier(0);
          if (mt + 2 < ntile) DN_TILE(GA, m2);
          gather(GA, exd, list, 16 * m4, hi, (unsigned)l32);
          __builtin_amdgcn_sched_barrier(0);
          if (mt + 3 < ntile) DN_TILE(GB, m3);
          asm volatile("" ::: "memory"); __builtin_amdgcn_wave_barrier();
          finish(P, wout, t0, rstd_l);
          start(P, list, dv, 16 * mt, min(npad - 16 * mt, 64), lane, gate, esc, t0);
          asm volatile("" ::: "memory"); __builtin_amdgcn_wave_barrier();
        }
#undef DN_TILE
      } while (S < total);
    }
    dnm::finish(P, wout, t0, rstd_l);
  }
}

#ifndef PROBE_G
#define PROBE_G 0
#endif
#if PROBE_G
template <int MODE>
__device__ __forceinline__ void probe_gather(const Args& a, int wave, int lane, unsigned mask) {
  unsigned char* ws = a.ws;
  const int* eidx = (const int*)(ws + WS_EIDX); const unsigned char* exd = ws + WS_EXD;
  const int l32 = lane & 31, hi = lane >> 5;
  unsigned x = 0u;
  for (int ti = 0; ti < 16; ++ti) {
    const size_t t = (size_t)blockIdx.x * 128 + wave * 16 + ti;
    const int e0 = eidx[t * 128 + lane] & (int)mask, e1 = eidx[t * 128 + 64 + lane] & (int)mask;
    if (MODE == 0) {
      for (int e = 0; e < 128; e += 16) {
        u32x2 ur[8][3];
#pragma unroll
        for (int i = 0; i < 8; ++i) {
          const int pi = (e & 63) + 2 * i + hi; const int id = (e < 64) ? __shfl(e0, pi) : __shfl(e1, pi);
          const u32x2* up = (const u32x2*)(exd + (size_t)id * 768 + 24 * l32);
          ur[i][0] = up[0]; ur[i][1] = up[1]; ur[i][2] = up[2];
        }
#pragma unroll
        for (int i = 0; i < 8; ++i) x ^= ur[i][0].x ^ ur[i][0].y ^ ur[i][1].x ^ ur[i][1].y ^ ur[i][2].x ^ ur[i][2].y;
      }
    } else {
      for (int mt = 0; mt < 8; ++mt) {
        const int id = (mt < 4) ? __shfl(e0, 16 * mt + (lane & 15)) : __shfl(e1, 16 * (mt - 4) + (lane & 15));
        const u32x2* rp = (const u32x2*)(exd + (size_t)id * 768 + 24 * (lane >> 4));
        u32x2 r[8][3];
#pragma unroll
        for (int j = 0; j < 8; ++j) { r[j][0] = rp[12 * j]; r[j][1] = rp[12 * j + 1]; r[j][2] = rp[12 * j + 2]; }
#pragma unroll
        for (int j = 0; j < 8; ++j) x ^= r[j][0].x ^ r[j][0].y ^ r[j][1].x ^ r[j][1].y ^ r[j][2].x ^ r[j][2].y;
      }
    }
  }
  ((unsigned*)(ws + WS_QKV))[(size_t)blockIdx.x * 512 + wave * 64 + lane] = x;
}
#endif
__device__ __forceinline__ void exp_up_item(const Args& a, unsigned char* lds, int xs, int item, int wave, int lane, float* xout, float* ssout) {
  unsigned char* ws = a.ws;
  const int* eidx = (const int*)(ws + WS_EIDX); const float* wgt = (const float*)(ws + WS_W);
  const unsigned char* ups = ws + WS_EXU + (size_t)xs * (NEXP * 128);
  unsigned* L = (unsigned*)(lds + wave * 16640);
  const int g = lane >> 2, c = lane & 3, t0 = item * 128 + wave * 16;
  __builtin_amdgcn_wave_barrier();
#pragma unroll 4
  for (int tk = 0; tk < 16; ++tk) {
    const size_t o = (size_t)(t0 + tk) * 128;
    L[tk * 260 + lane] = (unsigned)eidx[o + lane]; L[tk * 260 + 64 + lane] = (unsigned)eidx[o + 64 + lane];
    L[tk * 260 + 128 + lane] = __float_as_uint(wgt[o + lane]); L[tk * 260 + 192 + lane] = __float_as_uint(wgt[o + 64 + lane]);
  }
  __builtin_amdgcn_wave_barrier();
  float acc[32];
#pragma unroll
  for (int i = 0; i < 32; ++i) acc[i] = 0.f;
  const unsigned* Lg = L + g * 260;
#pragma unroll 1
  for (int p = 0; p < 128; p += 8) {
    u32x2 vr[8][3];
#pragma unroll
    for (int u = 0; u < 8; ++u) {
      const u32x2* vp = (const u32x2*)(ups + (size_t)Lg[p + u] * 128 + 24 * c);
      vr[u][0] = vp[0]; vr[u][1] = vp[1]; vr[u][2] = vp[2];
    }
#pragma unroll
    for (int u = 0; u < 8; ++u) {
      const float w = __uint_as_float(Lg[128 + p + u]);
      PIN6(vr[u]);
      const v32f v = __builtin_amdgcn_cvt_scalef32_pk32_f32_fp6((v6u){vr[u][0].x, vr[u][0].y, vr[u][1].x, vr[u][1].y, vr[u][2].x, vr[u][2].y}, 1.0f);
#pragma unroll
      for (int k = 0; k < 32; ++k) acc[k] += w * v[k];
      PIN16(acc, 0); PIN16(acc, 16);
    }
  }
  const f32x4* xr = (const f32x4*)(a.out + (size_t)(t0 + g) * DM + xs * 128 + c * 32); f32x4* xw = (f32x4*)(xout + (size_t)(t0 + g) * DM + xs * 128 + c * 32);
  float s = 0.f;
#pragma unroll
  for (int k = 0; k < 8; ++k) { f32x4 x = xr[k]; x.x += acc[4 * k]; x.y += acc[4 * k + 1]; x.z += acc[4 * k + 2]; x.w += acc[4 * k + 3]; xw[k] = x; s += (x.x * x.x + x.y * x.y) + (x.z * x.z + x.w * x.w); }
  s += swz_xor<1>(s); s += swz_xor<2>(s);
  if (c == 0) atomicAdd(ssout + t0 + g, s);
}
__device__ __forceinline__ void phase_exp_up(const Args& a, unsigned char* lds, const XcdBarrier& bar, int tid, int wave, int lane, unsigned* ctr, float* xout, float* ssout);
struct UpBuf { u32x4 r[8][2]; };
__device__ __forceinline__ void up2_load(UpBuf& B, const unsigned char* ups, const unsigned* Lg, int ch, int c) {
  const unsigned char* base = ups + (size_t)(ch >> 4) * (NEXP * 128) + 32 * c; const int p = (ch & 15) * 8;
#pragma unroll
  for (int u = 0; u < 8; ++u) { const u32x4* vp = (const u32x4*)(base + (size_t)Lg[p + u] * 128); B.r[u][0] = vp[0]; B.r[u][1] = vp[1]; }
}
__device__ __forceinline__ void up2_math(UpBuf& B, const unsigned* Lg, int ch, f32x2 (&acc)[16]) {
  const int p = (ch & 15) * 8;
#pragma unroll
  for (int u = 0; u < 8; ++u) {
    const float w = __uint_as_float(Lg[128 + p + u]);
    const f32x2 w2 = (f32x2){w, w};
#pragma unroll
    for (int q = 0; q < 2; ++q)
#pragma unroll
      for (int k = 0; k < 4; ++k) {
        const auto lo = __builtin_amdgcn_cvt_pk_f32_fp8((int)B.r[u][q][k], false); const auto hi = __builtin_amdgcn_cvt_pk_f32_fp8((int)B.r[u][q][k], true);
        acc[8 * q + 2 * k] = __builtin_elementwise_fma((f32x2){lo[0], lo[1]}, w2, acc[8 * q + 2 * k]);
        acc[8 * q + 2 * k + 1] = __builtin_elementwise_fma((f32x2){hi[0], hi[1]}, w2, acc[8 * q + 2 * k + 1]);
      }
    if (u & 1) PIN16(acc, 0);
  }
}
__device__ __forceinline__ void up2_slice_end(const Args& a, int t, int xs, int c, f32x2 (&acc)[16], float& ssum) {
  f32x4* xr = (f32x4*)(a.out + (size_t)t * DM + xs * 128 + c * 32);
#pragma unroll
  for (int k = 0; k < 8; ++k) { f32x4 x = xr[k]; x.x += acc[2 * k].x; x.y += acc[2 * k].y; x.z += acc[2 * k + 1].x; x.w += acc[2 * k + 1].y; xr[k] = x; ssum += (x.x * x.x + x.y * x.y) + (x.z * x.z + x.w * x.w);
    acc[2 * k] = (f32x2){0.f, 0.f}; acc[2 * k + 1] = (f32x2){0.f, 0.f}; }
}
__device__ __forceinline__ void phase_exp_up2(const Args& a, unsigned char* lds, int wave, int lane) {
  unsigned char* ws = a.ws;
  const int* eidx = (const int*)(ws + WS_EIDX); const float* wgt = (const float*)(ws + WS_W);
  const unsigned char* ups = ws + WS_EXU;
  unsigned* L = (unsigned*)(lds + wave * 16640);
  const int g = lane >> 2, c = lane & 3;
  for (int blk = blockIdx.x; blk < NT / 128; blk += gridDim.x) {
    const int t0 = blk * 128 + wave * 16, t = t0 + g;
    unsigned* H = (unsigned*)(lds + 8 * 16640 + 1024) + wave * 256;
    __builtin_amdgcn_wave_barrier();
    for (int i = lane; i < 256; i += 64) H[i] = 0u;
    __builtin_amdgcn_wave_barrier();
#pragma unroll 4
    for (int tk = 0; tk < 16; ++tk) {
      const size_t o = (size_t)(t0 + tk) * 128;
      const unsigned ea = (unsigned)eidx[o + lane], eb = (unsigned)eidx[o + 64 + lane];
      const unsigned wa = __float_as_uint(wgt[o + lane]), wb = __float_as_uint(wgt[o + 64 + lane]);
      const unsigned ba = ea >> 10, bb = eb >> 10;
      const unsigned ra = atomicAdd(&H[tk * 16 + ba], 1u), rb = atomicAdd(&H[tk * 16 + bb], 1u);
      __builtin_amdgcn_wave_barrier();
      unsigned pa = ra, pb = rb;
#pragma unroll
      for (unsigned b = 0; b < 16; ++b) { const unsigned hb = H[tk * 16 + b]; pa += (b < ba) ? hb : 0u; pb += (b < bb) ? hb : 0u; }
      L[tk * 260 + pa] = ea; L[tk * 260 + 128 + pa] = wa; L[tk * 260 + pb] = eb; L[tk * 260 + 128 + pb] = wb;
    }
    __builtin_amdgcn_wave_barrier();
    const unsigned* Lg = L + g * 260;
    f32x2 acc[16]; float ssum = 0.f;
#pragma unroll
    for (int i = 0; i < 16; ++i) acc[i] = (f32x2){0.f, 0.f};
    UpBuf A, B;
    up2_load(A, ups, Lg, 0, c);
#pragma unroll 1
    for (int ch = 0; ch < 128; ch += 2) {
      up2_load(B, ups, Lg, ch + 1, c);
      up2_math(A, Lg, ch, acc);
      if (ch + 2 < 128) up2_load(A, ups, Lg, ch + 2, c);
      up2_math(B, Lg, ch + 1, acc);
      if ((ch & 15) == 14) up2_slice_end(a, t, ch >> 4, c, acc, ssum);
    }
    ssum += swz_xor<1>(ssum); ssum += swz_xor<2>(ssum);
    const float r2 = rsqrtf(ssum * (1.f / DM) + EPS);
    asm volatile("s_waitcnt vmcnt(0)" ::: "memory");
    __builtin_amdgcn_fence(__ATOMIC_ACQUIRE, "agent");
#pragma unroll 2
    for (int xs = 0; xs < 8; ++xs) {
      f32x4* xr = (f32x4*)(a.out + (size_t)t * DM + xs * 128 + c * 32); const f32x4* gp = (const f32x4*)(a.in[21] + xs * 128 + c * 32);
#pragma unroll
      for (int k = 0; k < 8; ++k) xr[k] = xr[k] * r2 * gp[k];
    }
  }
}

namespace upm {
typedef int v8i __attribute__((ext_vector_type(8)));
struct GBuf { u32x4 r[16]; };
__device__ __forceinline__ void issue(GBuf& G, const unsigned char* ups, const unsigned char* wl, int u, int lane) {
  const unsigned char* sl = ups + (size_t)(u >> 4) * (NEXP * 128);
  const unsigned short* ip = (const unsigned short*)(wl + 12288 + (u & 15) * 256) + (lane >> 3);
  const unsigned lp = (unsigned)(lane & 7) * 16u;
#pragma unroll
  for (int i = 0; i < 16; ++i) { const unsigned id = ip[8 * i]; G.r[i] = *(const u32x4*)(sl + ((id << 7) | lp)); }
}
__device__ __forceinline__ size_t xoff(int u, int t0, int lane) { return (size_t)(t0 + (u & 15)) * DM + (u >> 4) * 128 + (lane >> 4) * 32 + 2 * (lane & 15); }
__device__ __forceinline__ void process(const Args& a, GBuf& G, unsigned char* wl, int u, int t0, int lane, float inv_s_l, unsigned selE, unsigned selO, int wa0, int wa1, const int (&ta)[4], const unsigned xold2, const unsigned (&hp)[7]) {
  const int tk = u & 15, g = lane >> 4, n = lane & 15;
  unsigned* xp = (unsigned*)((bf16_t*)(a.ws + WS_HB) + xoff(u, t0, lane));
  const f32x2 xold = (f32x2){bflo(xold2), bfhi(xold2)};
  const float inv_s = __uint_as_float(__builtin_amdgcn_readlane(__float_as_uint(inv_s_l), tk));
  const att::lds_cptr wl3 = (att::lds_cptr)wl;
  f32x4 C[4];
#pragma unroll
  for (int kh = 0; kh < 2; ++kh) {
    asm volatile("" ::: "memory");
#pragma unroll
    for (int i = 0; i < 8; ++i) *(u32x4*)(wl + (((i >> 1) & 1) ? wa1 : wa0) + 1024 * i) = G.r[8 * kh + i];
    asm volatile("" ::: "memory");
    const u32x4 S = *(const u32x4*)(wl + 8192 + tk * 256 + ((n >> 1) & 1) * 128 + 64 * kh + 16 * g);
    v8i A;
#pragma unroll
    for (int j = 0; j < 8; ++j) { const unsigned s = (j >> 1) == 0 ? S.x : (j >> 1) == 1 ? S.y : (j >> 1) == 2 ? S.z : S.w; A[j] = (int)__builtin_amdgcn_perm(s, s, (j & 1) ? selO : selE); }
    v8i B[4];
#pragma unroll
    for (int ng = 0; ng < 4; ++ng)
#pragma unroll
      for (int q = 0; q < 4; ++q) { const u32x2 v = __builtin_bit_cast(u32x2, att::vtr(wl3 + ta[ng] + 512 * q)); B[ng][2 * q] = (int)v.x; B[ng][2 * q + 1] = (int)v.y; }
#pragma unroll
    for (int ng = 0; ng < 4; ++ng) {
      const f32x4 c0 = kh ? C[ng] : (f32x4){0.f, 0.f, 0.f, 0.f};
      C[ng] = __builtin_amdgcn_mfma_scale_f32_16x16x128_f8f6f4(A, B[ng], c0, 0, 0, 0, 127, 0, 127);
    }
  }
  const f32x4 c = g == 0 ? C[0] : g == 1 ? C[1] : g == 2 ? C[2] : C[3];
  f32x2 y; y.x = (c[0] + c[2] * 0.0625f) * inv_s; y.y = (c[1] + c[3] * 0.0625f) * inv_s;
  if ((u >> 4) < 7) { *xp = pk2(xold.x + y.x, xold.y + y.y); return; }
  const float xa_ = xold.x + y.x, xb_ = xold.y + y.y;
  float ss = xa_ * xa_ + xb_ * xb_;
#pragma unroll
  for (int s = 0; s < 7; ++s) { const float f0 = bflo(hp[s]), f1 = bfhi(hp[s]); ss += f0 * f0 + f1 * f1; }
  const float r2 = rsqrtf(wave_sum(ss) * (1.f / DM) + EPS);
  float* orow = a.out + (size_t)(t0 + tk) * DM + g * 32 + 2 * n; const float* gp = a.in[21] + g * 32 + 2 * n;
#pragma unroll
  for (int s = 0; s < 7; ++s) { const f32x2 gg = *(const f32x2*)(gp + 128 * s); *(f32x2*)(orow + 128 * s) = (f32x2){bflo(hp[s]) * r2 * gg.x, bfhi(hp[s]) * r2 * gg.y}; }
  { const f32x2 gg = *(const f32x2*)(gp + 896); *(f32x2*)(orow + 896) = (f32x2){xa_ * r2 * gg.x, xb_ * r2 * gg.y}; }
}
}
__device__ __forceinline__ void phase_exp_up3(const Args& a, unsigned char* lds, int wave, int lane) {
  unsigned char* ws = a.ws;
  { int tid_ = (int)threadIdx.x; asm volatile("" : "+v"(tid_)); wave = tid_ >> 6; lane = tid_ & 63; }
  const int* eidx = (const int*)(ws + WS_EIDX); const float* wgt = (const float*)(ws + WS_W);
  const unsigned char* ups = ws + WS_EXU;
  unsigned char* wl = lds + wave * 16384;
  const int g = lane >> 4, rq = (lane & 15) >> 2, cq = lane & 3;
  const unsigned selE = (lane & 1) ? 0x010c000cu : 0x0c010c00u, selO = (lane & 1) ? 0x030c020cu : 0x0c030c02u;
  const int wpos = (lane & 7) ^ (2 * ((lane >> 4) & 1));
  const int wa0 = (lane >> 3) * 128 + wpos * 16, wa1 = (lane >> 3) * 128 + (wpos ^ 4) * 16;
  const int fl = ((rq >> 1) & 1) + 2 * (g & 1);
  int ta[4];
#pragma unroll
  for (int ng = 0; ng < 4; ++ng) ta[ng] = (16 * g + rq) * 128 + (2 * (ng ^ fl) + (cq >> 1)) * 16 + (cq & 1) * 8;
  for (int blk = blockIdx.x; blk < NT / 128; blk += gridDim.x) {
    const int t0 = blk * 128 + wave * 16;
    float inv_s_l = 1.f;
    __builtin_amdgcn_wave_barrier();
#pragma unroll 2
    for (int tk = 0; tk < 16; ++tk) {
      const size_t o = (size_t)(t0 + tk) * 128;
      const unsigned ea = (unsigned)eidx[o + lane], eb = (unsigned)eidx[o + 64 + lane];
      const float wa = wgt[o + lane], wb = wgt[o + 64 + lane];
      float mx = fmaxf(fabsf(wa), fabsf(wb));
#pragma unroll
      for (int of = 1; of < 64; of <<= 1) mx = fmaxf(mx, __shfl_xor(mx, of));
      const float s = mx > 0.f ? 256.f / mx : 1.f;
      if (lane == tk) inv_s_l = mx > 0.f ? mx * (1.f / 256.f) : 1.f;
      const float fa = wa * s, fb = wb * s;
      const int pk = __builtin_amdgcn_cvt_pk_fp8_f32(fa, fb, 0, false);
      const float da = __builtin_amdgcn_cvt_f32_fp8(pk, 0), db = __builtin_amdgcn_cvt_f32_fp8(pk, 1);
      const int pl = __builtin_amdgcn_cvt_pk_fp8_f32((fa - da) * 16.f, (fb - db) * 16.f, 0, false);
      unsigned char* wq = wl + 8192 + tk * 256;
      wq[lane] = (unsigned char)(pk & 0xff); wq[64 + lane] = (unsigned char)((pk >> 8) & 0xff); wq[128 + lane] = (unsigned char)(pl & 0xff); wq[192 + lane] = (unsigned char)((pl >> 8) & 0xff);
      unsigned short* ix = (unsigned short*)(wl + 12288 + tk * 256);
      ix[lane] = (unsigned short)ea; ix[64 + lane] = (unsigned short)eb;
    }
    __builtin_amdgcn_wave_barrier();
    asm volatile("" ::: "memory");
    upm::GBuf GA, GB;
    upm::issue(GA, ups, wl, 0, lane);
#pragma unroll 1
    for (int u = 0; u < 128; u += 2) {
      const unsigned xa = *(const unsigned*)((const bf16_t*)(ws + WS_HB) + upm::xoff(u, t0, lane));
      unsigned ha[7] = {0u, 0u, 0u, 0u, 0u, 0u, 0u}, hb7[7] = {0u, 0u, 0u, 0u, 0u, 0u, 0u};
      if (u >= 112) {
#pragma unroll
        for (int s = 0; s < 7; ++s) ha[s] = __hip_atomic_load((unsigned*)((bf16_t*)(ws + WS_HB) + upm::xoff(16 * s + (u & 15), t0, lane)), __ATOMIC_RELAXED, __HIP_MEMORY_SCOPE_AGENT);
      }
      __builtin_amdgcn_sched_barrier(0);
      upm::issue(GB, ups, wl, u + 1, lane);
      __builtin_amdgcn_sched_barrier(0);
      upm::process(a, GA, wl, u, t0, lane, inv_s_l, selE, selO, wa0, wa1, ta, xa, ha);
      const unsigned xb = *(const unsigned*)((const bf16_t*)(ws + WS_HB) + upm::xoff(u + 1, t0, lane));
      if (u >= 112) {
#pragma unroll
        for (int s = 0; s < 7; ++s) hb7[s] = __hip_atomic_load((unsigned*)((bf16_t*)(ws + WS_HB) + upm::xoff(16 * s + ((u + 1) & 15), t0, lane)), __ATOMIC_RELAXED, __HIP_MEMORY_SCOPE_AGENT);
      }
      __builtin_amdgcn_sched_barrier(0);
      if (u + 2 < 128) upm::issue(GA, ups, wl, u + 2, lane);
      __builtin_amdgcn_sched_barrier(0);
      upm::process(a, GB, wl, u + 1, t0, lane, inv_s_l, selE, selO, wa0, wa1, ta, xb, hb7);
    }
  }
}

__device__ __forceinline__ void phase_final(const Args& a, int gw, int ngw, int lane) {
  const float* ss = (const float*)(a.ws + WS_SS3);
  for (int r = gw; r < NT; r += ngw) {
    const float r2 = rsqrtf(ss[r] * (1.f / DM) + EPS);
    f32x4* xr = (f32x4*)(a.out + (size_t)r * DM) + lane;
#pragma unroll
    for (int j = 0; j < 4; ++j) { const f32x4 g = ((const f32x4*)a.in[21])[64 * j + lane]; xr[64 * j] = xr[64 * j] * r2 * g; }
  }
}

namespace pg8 {
#define PG8_LAS __attribute__((address_space(3)))
typedef unsigned short bf16_t;
typedef short bf16x8 __attribute__((ext_vector_type(8)));
typedef float f32x4 __attribute__((ext_vector_type(4)));
typedef unsigned u32x4 __attribute__((ext_vector_type(4)));
constexpr int BM = 256, BK = 64, HALF = 128, HTB = HALF * BK * 2  , STAGE_BYTES = 8 * HTB, NXCD = 8, WGM = 8;

__host__ __device__ __forceinline__ int lds_byte(int r, int c) { const int st = (r >> 4) * 2 + (c >> 5), rr = r & 15, cc = c & 31, ob = rr * 64 + cc * 2; return st * 1024 + (ob ^ (((ob >> 9) & 1) << 5)); }
__host__ __device__ __forceinline__ void stage_rc(int b, int& R, int& C) { const int st = b / 1024, sb = b % 1024, swz = sb ^ (((sb >> 9) & 1) << 5); R = (st >> 1) * 16 + swz / 64; C = (st & 1) * 32 + (swz % 64) / 2; }
__host__ __device__ __forceinline__ int perm32(int rho) { const int n = rho >> 4, i = rho & 15; return 8 * (i >> 2) + 4 * n + (i & 3); }

struct Unit { int pm, pn; };
struct Gemm { const bf16_t* A; const bf16_t* Bt; int M, N, K; };

struct StaticOrder {
    int nM, nN, nwg, G, c;
    __host__ __device__ void init(int M, int N, int G_, int c_) { nM = M / BM; nN = N / BM; nwg = nM * nN; G = G_; c = c_; }
    __host__ __device__ bool next(int i, Unit& u) const {
        const long L = (long)i * G + c; if (L >= nwg) return false;
        int wgid = (int)L; { const int q = nwg / NXCD, r = nwg % NXCD, xcd = wgid % NXCD, off = wgid / NXCD; wgid = (xcd < r ? xcd * (q + 1) : r * (q + 1) + (xcd - r) * q) + off; }
        const int nig = WGM * nN, gid = wgid / nig, fm = gid * WGM, gsz = (nM - fm) < WGM ? (nM - fm) : WGM;
        u.pm = fm + ((wgid % nig) % gsz); u.pn = (wgid % nig) / gsz; return true;
    }
    __device__ __forceinline__ void a_ready(const Unit&) const {}
    __device__ __forceinline__ void done(const Unit&) const {}
};

template <class St> struct EpiAdapt8 {
    static constexpr bool PERM = true, AFTER_DRAIN = false; St st;
    __device__ __forceinline__ void operator()(const f32x4 (&acc)[2][2][4][2], const Unit& u, int wr, int wc, int fr, int fq) const {
#pragma unroll
        for (int ai = 0; ai < 2; ++ai)
#pragma unroll
            for (int m = 0; m < 4; ++m)
#pragma unroll
                for (int bj = 0; bj < 2; ++bj) st.store8(u.pm * BM + ai * HALF + wr * 64 + m * 16 + fr, u.pn * BM + bj * HALF + wc * 32 + 8 * fq, acc[ai][bj][m][0], acc[ai][bj][m][1]);
    }
};
struct EpiQKVx {
    static constexpr bool PERM = true, AFTER_DRAIN = false; bf16_t* O; float* kmean; unsigned* kn2p;
    __device__ __forceinline__ void operator()(const f32x4 (&acc)[2][2][4][2], const Unit& u, int wr, int wc, int fr, int fq) const {
        const int pn = u.pn;
        const float sc = (pn < 2 || pn == 6 || pn == 7) ? 0.18033688011112042f : 1.f;
#pragma unroll
        for (int ai = 0; ai < 2; ++ai)
#pragma unroll
            for (int m = 0; m < 4; ++m)
#pragma unroll
                for (int bj = 0; bj < 2; ++bj) {
                    const int row = u.pm * BM + ai * HALF + wr * 64 + m * 16 + fr, col = pn * BM + bj * HALF + wc * 32 + 8 * fq;
                    const f32x4 a = acc[ai][bj][m][0] * sc, b = acc[ai][bj][m][1] * sc;
                    const float f0 = a.x, f1 = a.y, f2 = a.z, f3 = a.w, f4 = b.x, f5 = b.y, f6 = b.z, f7 = b.w;
                    *(u32x4*)(O + (size_t)row * 3072 + col) = (u32x4){::pk2(f0, f1), ::pk2(f2, f3), ::pk2(f4, f5), ::pk2(f6, f7)};
                }
        if (pn == 2 || pn == 3) {
#pragma unroll
            for (int bj = 0; bj < 2; ++bj) {
                f32x4 s0 = (f32x4){0.f, 0.f, 0.f, 0.f}, s1 = s0;
#pragma unroll
                for (int ai = 0; ai < 2; ++ai)
#pragma unroll
                    for (int m = 0; m < 4; ++m) { s0 = s0 + acc[ai][bj][m][0]; s1 = s1 + acc[ai][bj][m][1]; }
                float v[8] = {s0.x, s0.y, s0.z, s0.w, s1.x, s1.y, s1.z, s1.w};
#pragma unroll
                for (int k = 0; k < 8; ++k) { v[k] += ::swz_xor<1>(v[k]); v[k] += ::swz_xor<2>(v[k]); v[k] += ::swz_xor<4>(v[k]); v[k] += ::swz_xor<8>(v[k]); }
                if (fr == 0) {
                    const int c = (pn - 2) * BM + bj * HALF + wc * 32 + 8 * fq;
                    float* d = kmean + ((size_t)u.pm * 8 + (c >> 6)) * 64 + (c & 63);
#pragma unroll
                    for (int k = 0; k < 8; ++k) atomicAdd(d + k, v[k] * (1.f / 256.f));
                }
            }
        } else if (pn == 8 || pn == 9) {
#pragma unroll
            for (int bj = 0; bj < 2; ++bj) {
                float mx = 0.f;
#pragma unroll
                for (int ai = 0; ai < 2; ++ai)
#pragma unroll
                    for (int m = 0; m < 4; ++m) { const f32x4 a = acc[ai][bj][m][0], b = acc[ai][bj][m][1];
                        float s = (a.x * a.x + a.y * a.y) + (a.z * a.z + a.w * a.w) + (b.x * b.x + b.y * b.y) + (b.z * b.z + b.w * b.w);
                        s += __shfl_xor(s, 16); s += __shfl_xor(s, 32);
                        mx = fmaxf(mx, s); }
                mx = fmaxf(mx, ::swz_xor<1>(mx)); mx = fmaxf(mx, ::swz_xor<2>(mx)); mx = fmaxf(mx, ::swz_xor<4>(mx)); mx = fmaxf(mx, ::swz_xor<8>(mx));
                if (fr == 0 && fq == 0) {
                    const int c = (pn - 8) * BM + bj * HALF + wc * 32;
                    atomicMax(kn2p + ((u.pm >> 4) * 8 + (c >> 6)) * 2 + ((c >> 5) & 1), __float_as_uint(mx));
                }
            }
        }
    }
};
template <class St> struct EpiAdapt {
    static constexpr bool PERM = false, AFTER_DRAIN = false; St st;
    __device__ __forceinline__ void operator()(const f32x4 (&acc)[2][2][4][2], const Unit& u, int wr, int wc, int fr, int fq) const {
#pragma unroll
        for (int ai = 0; ai < 2; ++ai)
#pragma unroll
            for (int m = 0; m < 4; ++m)
#pragma unroll
                for (int bj = 0; bj < 2; ++bj)
#pragma unroll
                    for (int n = 0; n < 2; ++n) st.store(u.pm * BM + ai * HALF + wr * 64 + m * 16 + fr, u.pn * BM + bj * HALF + wc * 32 + n * 16 + 4 * fq, acc[ai][bj][m][n]);
    }
};

struct MidONorm { static constexpr int AT = 8; const float* sso;
    __device__ __forceinline__ void scale(f32x4 (&acc)[2][2][4][2], const Unit& u, int wr, int fr) const {
        int row0 = u.pm * BM + wr * 64 + fr;
        asm volatile("" : "+v"(row0));
#pragma unroll
        for (int ai = 0; ai < 2; ++ai)
#pragma unroll
            for (int m = 0; m < 4; ++m) { const int row = row0 + ai * HALF + m * 16;
                const float f = __builtin_amdgcn_rsqf(sso[row] * (1.f / 512.f) + 1e-6f) * __builtin_amdgcn_sqrtf(sso[32768 + row] * (1.f / 512.f) + 1e-6f);
#pragma unroll
                for (int bj = 0; bj < 2; ++bj)
#pragma unroll
                    for (int n = 0; n < 2; ++n) acc[ai][bj][m][n] *= f; }
    }
};
struct EpiResidSS {
    static constexpr bool PERM = true, AFTER_DRAIN = false; const float* basef; bf16_t* hb; float* ss; const float* rs2;
    __device__ __forceinline__ void operator()(const f32x4 (&acc)[2][2][4][2], const Unit& u, int wr, int wc, int fr, int fq) const {
#pragma unroll
        for (int ai = 0; ai < 2; ++ai)
#pragma unroll
            for (int m = 0; m < 4; ++m) {
                const int row = u.pm * BM + ai * HALF + wr * 64 + m * 16 + fr; float s = 0.f;
                const float rsc = rs2 ? __builtin_amdgcn_rsqf(rs2[row] * (1.f / 512.f) + 1e-6f) : 1.f;
#pragma unroll
                for (int bj = 0; bj < 2; ++bj) {
                    const size_t o = (size_t)row * 1024 + u.pn * BM + bj * HALF + wc * 32 + 8 * fq;
                    f32x4 b0, b1;
                    if (basef) { b0 = *(const f32x4*)(basef + o); b1 = *(const f32x4*)(basef + o + 4); }
                    else { const u32x4 w = *(const u32x4*)(hb + o); b0 = (f32x4){::bflo(w.x), ::bfhi(w.x), ::bflo(w.y), ::bfhi(w.y)}; b1 = (f32x4){::bflo(w.z), ::bfhi(w.z), ::bflo(w.w), ::bfhi(w.w)}; }
                    const f32x4 v0 = b0 + acc[ai][bj][m][0] * rsc, v1 = b1 + acc[ai][bj][m][1] * rsc;
                    { const float f0 = v0.x, f1 = v0.y, f2 = v0.z, f3 = v0.w, f4 = v1.x, f5 = v1.y, f6 = v1.z, f7 = v1.w;
                      *(u32x4*)(hb + o) = (u32x4){::pk2(f0, f1), ::pk2(f2, f3), ::pk2(f4, f5), ::pk2(f6, f7)}; }
                    s += (v0.x * v0.x + v0.y * v0.y) + (v0.z * v0.z + v0.w * v0.w) + (v1.x * v1.x + v1.y * v1.y) + (v1.z * v1.z + v1.w * v1.w);
                }
                s += __shfl_xor(s, 16); s += __shfl_xor(s, 32);
                if (fq == 0) atomicAdd(ss + row, s);
            }
    }
};
struct NoMid { static constexpr int AT = 0; __device__ __forceinline__ void scale(f32x4 (&)[2][2][4][2], const Unit&, int, int) const {} };
template <class Epi, class Sched, bool ALIGN_EPI = false, bool SP2 = false, class Mid = NoMid>
__device__ __forceinline__ void gemm_phase(PG8_LAS unsigned char* lds, const Gemm g, const Sched& S, const Epi& E, const Mid MID = Mid()) {
    const int tid = threadIdx.x, wid = __builtin_amdgcn_readfirstlane(tid >> 6), lane = tid & 63, wr = wid >> 2, wc = wid & 3, fr = lane & 15, fq = lane >> 4;
    const int K = g.K, nt = K / BK;
    unsigned voffA[2], voffB[2];
#pragma unroll
    for (int i = 0; i < 2; ++i) { int R, C; stage_rc(tid * 16 + i * 8192, R, C); const int Rb = Epi::PERM ? ((R & ~31) + perm32(R & 31)) : R;
        voffA[i] = (unsigned)(R * K + C) * 2u; voffB[i] = (unsigned)(Rb * K + C) * 2u; }
    const size_t kstep = (size_t)(BK * 2);
    const size_t hstep = (size_t)HALF * K * 2;
    const size_t tstep = 2 * hstep;
    const unsigned ldsw = (unsigned)wid * 1024u;
    const int aoff = lds_byte(wr * 64 + fr, fq * 8), boff = lds_byte(wc * 32 + fr, fq * 8);
#define PG8_SA(b, h) (((b) * 2 + (h)) * HTB)
#define PG8_SB(b, h) ((4 + (b) * 2 + (h)) * HTB)
#define PG8_STAGE(bufoff, gbase, voff) do { _Pragma("unroll") for (int _i = 0; _i < 2; ++_i) \
        __builtin_amdgcn_global_load_lds((const unsigned*)((const char*)(gbase) + (voff)[_i]), (PG8_LAS unsigned*)(lds + (bufoff) + ldsw + _i * 8192), 16, 0, 0); } while (0)
#define PG8_LDA(dst, b, h) do { _Pragma("unroll") for (int m = 0; m < 4; ++m) _Pragma("unroll") for (int k = 0; k < 2; ++k) dst[m][k] = *(const PG8_LAS bf16x8*)(lds + PG8_SA(b, h) + aoff + m * 2048 + k * 1024); } while (0)
#define PG8_LDB(dst, b, h) do { _Pragma("unroll") for (int n = 0; n < 2; ++n) _Pragma("unroll") for (int k = 0; k < 2; ++k) dst[n][k] = *(const PG8_LAS bf16x8*)(lds + PG8_SB(b, h) + boff + n * 2048 + k * 1024); } while (0)
#define PG8_MMA(ai, bj, At, Bt) do { __builtin_amdgcn_s_setprio(1); _Pragma("unroll") for (int m = 0; m < 4; ++m) _Pragma("unroll") for (int n = 0; n < 2; ++n) _Pragma("unroll") for (int k = 0; k < 2; ++k) \
        acc[ai][bj][m][n] = __builtin_amdgcn_mfma_f32_16x16x32_bf16(Bt[n][k], At[m][k], acc[ai][bj][m][n], 0, 0, 0); __builtin_amdgcn_s_setprio(0); } while (0)
#define PG8_WAIT_V(n) asm volatile("s_waitcnt vmcnt(" #n ")" ::: "memory")
#define PG8_WAIT_L(n) asm volatile("s_waitcnt lgkmcnt(" #n ")" ::: "memory")
#define PG8_BAR __builtin_amdgcn_s_barrier()
#define PG8_SCHED __builtin_amdgcn_sched_barrier(0)
    Unit cur, nxt; int ui = 0;
    if (!S.next(0, cur)) return;
    f32x4 acc[2][2][4][2];
#pragma unroll
    for (int a = 0; a < 2; ++a)
#pragma unroll
        for (int b = 0; b < 2; ++b)
#pragma unroll
            for (int m = 0; m < 4; ++m)
#pragma unroll
                for (int n = 0; n < 2; ++n) acc[a][b][m][n] = (f32x4){0.f, 0.f, 0.f, 0.f};
    bf16x8 At[4][2], B0[2][2], B1[2][2];
    const char* cA = (const char*)g.A + (size_t)cur.pm * tstep; const char* cB = (const char*)g.Bt + (size_t)cur.pn * tstep;
    S.a_ready(cur);
    if constexpr (SP2) {
        PG8_STAGE(PG8_SB(0, 0), cB, voffB); PG8_STAGE(PG8_SB(0, 1), cB + hstep, voffB); PG8_STAGE(PG8_SA(0, 0), cA, voffA); PG8_STAGE(PG8_SA(0, 1), cA + hstep, voffA);
        if (wr == 1) PG8_BAR;
        PG8_WAIT_V(2); PG8_BAR;
        PG8_STAGE(PG8_SB(1, 0), cB + kstep, voffB); PG8_STAGE(PG8_SA(1, 0), cA + kstep, voffA); PG8_STAGE(PG8_SB(1, 1), cB + hstep + kstep, voffB);
        PG8_WAIT_V(6); PG8_BAR;
    } else {
        PG8_STAGE(PG8_SB(0, 0), cB, voffB); PG8_STAGE(PG8_SA(0, 0), cA, voffA); PG8_STAGE(PG8_SB(0, 1), cB + hstep, voffB); PG8_STAGE(PG8_SA(0, 1), cA + hstep, voffA);
        if (wr == 1) PG8_BAR;
        PG8_WAIT_V(4); PG8_BAR;
        PG8_STAGE(PG8_SB(1, 0), cB + kstep, voffB); PG8_STAGE(PG8_SA(1, 0), cA + kstep, voffA); PG8_STAGE(PG8_SB(1, 1), cB + hstep + kstep, voffB);
        PG8_WAIT_V(6); PG8_BAR;
    }
    for (;;) {
        const bool has_next = S.next(ui + 1, nxt);
        const char* nA = has_next ? (const char*)g.A + (size_t)nxt.pm * tstep : cA; const char* nB = has_next ? (const char*)g.Bt + (size_t)nxt.pn * tstep : cB;
        for (int t = 0; t < nt; t += 2) {
            if (Mid::AT != 0 && t == Mid::AT) MID.scale(acc, cur, wr, fr);
            const bool last = (t == nt - 2);
            const char* a1 = cA + (size_t)(t + 1) * kstep;
            const char* a2 = last ? nA : cA + (size_t)(t + 2) * kstep; const char* b2 = last ? nB : cB + (size_t)(t + 2) * kstep;
            const char* a3 = a2 + kstep; const char* b3 = b2 + kstep;
            if (last && has_next) S.a_ready(nxt);
            if constexpr (SP2) {
            PG8_LDB(B0, 0, 0); PG8_LDB(B1, 0, 1); PG8_SCHED; PG8_LDA(At, 0, 0); PG8_STAGE(PG8_SA(1, 1), a1 + hstep, voffA);
            PG8_WAIT_V(8); PG8_WAIT_L(0); PG8_BAR; PG8_MMA(0, 0, At, B0); PG8_MMA(0, 1, At, B1); PG8_BAR; PG8_SCHED;
            PG8_LDA(At, 0, 1); PG8_STAGE(PG8_SB(0, 0), b2, voffB); PG8_STAGE(PG8_SB(0, 1), b2 + hstep, voffB); PG8_STAGE(PG8_SA(0, 0), a2, voffA);
            PG8_WAIT_V(8); PG8_WAIT_L(0); PG8_BAR; PG8_MMA(1, 0, At, B0); PG8_MMA(1, 1, At, B1); PG8_BAR; PG8_SCHED;
            PG8_LDB(B0, 1, 0); PG8_LDB(B1, 1, 1); PG8_SCHED; PG8_LDA(At, 1, 0); PG8_STAGE(PG8_SA(0, 1), a2 + hstep, voffA);
            PG8_WAIT_V(8); PG8_WAIT_L(0); PG8_BAR; PG8_MMA(0, 0, At, B0); PG8_MMA(0, 1, At, B1); PG8_BAR; PG8_SCHED;
            PG8_LDA(At, 1, 1); PG8_STAGE(PG8_SB(1, 0), b3, voffB); PG8_STAGE(PG8_SB(1, 1), b3 + hstep, voffB); PG8_STAGE(PG8_SA(1, 0), a3, voffA);
            PG8_WAIT_V(8); PG8_WAIT_L(0); PG8_BAR; PG8_MMA(1, 0, At, B0); PG8_MMA(1, 1, At, B1); PG8_BAR; PG8_SCHED;
            } else {
            PG8_LDB(B0, 0, 0); PG8_SCHED; PG8_LDA(At, 0, 0); PG8_STAGE(PG8_SA(1, 1), a1 + hstep, voffA);
            PG8_WAIT_L(8); PG8_BAR; PG8_WAIT_L(0); PG8_MMA(0, 0, At, B0); PG8_BAR; PG8_SCHED;
            PG8_LDB(B1, 0, 1); PG8_STAGE(PG8_SB(0, 0), b2, voffB);
            PG8_BAR; PG8_WAIT_L(0); PG8_MMA(0, 1, At, B1); PG8_BAR;
            PG8_LDA(At, 0, 1); PG8_STAGE(PG8_SA(0, 0), a2, voffA);
            PG8_BAR; PG8_WAIT_L(0); PG8_MMA(1, 0, At, B0); PG8_BAR; PG8_SCHED;
            PG8_STAGE(PG8_SB(0, 1), b2 + hstep, voffB);
            PG8_WAIT_V(6); PG8_BAR; PG8_MMA(1, 1, At, B1); PG8_BAR;
            PG8_LDB(B0, 1, 0); PG8_SCHED; PG8_LDA(At, 1, 0); PG8_STAGE(PG8_SA(0, 1), a2 + hstep, voffA);
            PG8_WAIT_L(8); PG8_BAR; PG8_WAIT_L(0); PG8_MMA(0, 0, At, B0); PG8_BAR; PG8_SCHED;
            PG8_LDB(B1, 1, 1); PG8_STAGE(PG8_SB(1, 0), b3, voffB);
            PG8_BAR; PG8_WAIT_L(0); PG8_MMA(0, 1, At, B1); PG8_BAR;
            PG8_LDA(At, 1, 1); PG8_STAGE(PG8_SA(1, 0), a3, voffA);
            PG8_BAR; PG8_WAIT_L(0); PG8_MMA(1, 0, At, B0); PG8_BAR; PG8_SCHED;
            PG8_STAGE(PG8_SB(1, 1), b3 + hstep, voffB);
            PG8_WAIT_V(6); PG8_BAR; PG8_MMA(1, 1, At, B1); PG8_BAR;
            }
        }
        if constexpr (ALIGN_EPI) { if (wr == 0) PG8_BAR; }
        if constexpr (!Epi::AFTER_DRAIN) { E(acc, cur, wr, wc, fr, fq); S.done(cur); }
        if (!has_next) break;
#pragma unroll
        for (int a = 0; a < 2; ++a)
#pragma unroll
            for (int b = 0; b < 2; ++b)
#pragma unroll
                for (int m = 0; m < 4; ++m)
#pragma unroll
                    for (int n = 0; n < 2; ++n) acc[a][b][m][n] = (f32x4){0.f, 0.f, 0.f, 0.f};
        cur = nxt; cA = nA; cB = nB; ++ui;
        if constexpr (ALIGN_EPI) { if (wr == 1) PG8_BAR; }
    }
    PG8_WAIT_V(0);
    if constexpr (!ALIGN_EPI) { if (wr == 0) PG8_BAR; }
    PG8_BAR;
    if constexpr (Epi::AFTER_DRAIN) { E.fused(acc, cur, wr, wc, fr, fq, lds, wid, lane); S.done(cur); }
#undef PG8_SA
#undef PG8_SB
#undef PG8_STAGE
#undef PG8_LDA
#undef PG8_LDB
#undef PG8_MMA
#undef PG8_WAIT_V
#undef PG8_WAIT_L
#undef PG8_BAR
#undef PG8_SCHED
}
}


template <class Epi, class Mid>
__device__ __forceinline__ void run_gemm_mid(unsigned char* lds, const bf16_t* A, const bf16_t* Bt, int M, int N, int K, const Epi& E, const Mid& MD) {
  pg8::Gemm g{A, Bt, M, N, K}; pg8::StaticOrder S; S.init(M, N, (int)gridDim.x, (int)blockIdx.x);
  pg8::gemm_phase<Epi, pg8::StaticOrder, true, true, Mid>((PG8_LAS unsigned char*)lds, g, S, E, MD);
}
template <class Epi>
__device__ __forceinline__ void run_gemm_raw(unsigned char* lds, const bf16_t* A, const bf16_t* Bt, int M, int N, int K, const Epi& E) {
  pg8::Gemm g{A, Bt, M, N, K}; pg8::StaticOrder S; S.init(M, N, (int)gridDim.x, (int)blockIdx.x);
  pg8::gemm_phase<Epi, pg8::StaticOrder, true, true>((PG8_LAS unsigned char*)lds, g, S, E);
}
template <class St>
__device__ __forceinline__ void run_gemm8(unsigned char* lds, const bf16_t* A, const bf16_t* Bt, int M, int N, int K, const St& st) {
  pg8::Gemm g{A, Bt, M, N, K}; pg8::StaticOrder S; S.init(M, N, (int)gridDim.x, (int)blockIdx.x);
  pg8::EpiAdapt8<St> E{st};
  pg8::gemm_phase<pg8::EpiAdapt8<St>, pg8::StaticOrder, true, true>((PG8_LAS unsigned char*)lds, g, S, E);
}
template <class St>
__device__ __forceinline__ void run_gemm(unsigned char* lds, const bf16_t* A, const bf16_t* Bt, int M, int N, int K, const St& st, int gw, int ngw, int lane) {
#if USE_PG8
  pg8::Gemm g{A, Bt, M, N, K}; pg8::StaticOrder S; S.init(M, N, (int)gridDim.x, (int)blockIdx.x);
  pg8::EpiAdapt<St> E{st};
  pg8::gemm_phase<pg8::EpiAdapt<St>, pg8::StaticOrder, true, true>((PG8_LAS unsigned char*)lds, g, S, E);
#else
  gemm_naive(A, K, Bt, K, M, N, K, st, gw, ngw, lane);
#endif
}

#define GAS __attribute__((address_space(1)))
#define LAS __attribute__((address_space(3)))
#define XB_TMO      128
#define XB_XCNT(j)  (256  + 64 * (j))
#define XB_XSUB(j)  (1280 + 64 * (j))
#define XB_XGEN(j)  (2304 + 64 * (j))
#define XB_TOP      3328
#define XB_TOPGEN   3392
#define XCD_BAR_WORDS 3456
#define XB_SPIN_CAP (1u << 18)

__device__ __forceinline__ unsigned xb_ld(unsigned* p)              { return __hip_atomic_load(p, __ATOMIC_RELAXED, __HIP_MEMORY_SCOPE_AGENT); }
__device__ __forceinline__ unsigned xb_add(unsigned* p, unsigned v) { return __hip_atomic_fetch_add(p, v, __ATOMIC_RELAXED, __HIP_MEMORY_SCOPE_AGENT); }
__device__ __forceinline__ unsigned xb_xcc_id() { return (unsigned)__builtin_amdgcn_s_getreg((3 << 11) | 20) & 0xFu; }
#define XB_SPIN(cond, bar) do { unsigned _sp = 0; while (cond) { __builtin_amdgcn_s_sleep(1); \
    if ((++_sp & 255u) == 0u) { if (xb_ld(&(bar)[XB_TMO])) break; if (_sp > XB_SPIN_CAP) { atomicAdd(&(bar)[XB_TMO], 1u); break; } } } } while (0)

struct XcdBarrier {
    unsigned* bar; unsigned x;
    volatile LAS unsigned* st;
};

__device__ __forceinline__ XcdBarrier xcd_barrier_post(unsigned* bar, volatile LAS unsigned* st) {
    XcdBarrier b; b.bar = bar; b.x = xb_xcc_id(); b.st = st;
    if (threadIdx.x == 0) (void)xb_add(&bar[XB_XCNT(b.x)], 1u);
    return b;
}
__device__ __forceinline__ void xcd_barrier_complete(unsigned* bar, unsigned x, unsigned& nloc, unsigned& nx) {
    const unsigned G = gridDim.x * gridDim.y * gridDim.z;
    unsigned sum, cnt, mine, sp = 0u;
    for (;;) {
        sum = 0u; cnt = 0u; mine = 0u;
#pragma unroll
        for (unsigned j = 0; j < 16; ++j) { const unsigned c = xb_ld(&bar[XB_XCNT(j)]); sum += c; cnt += (c > 0u) ? 1u : 0u; mine = (j == x) ? c : mine; }
        if (sum == G) break;
        __builtin_amdgcn_s_sleep(1);
        if ((++sp & 255u) == 0u) { if (xb_ld(&bar[XB_TMO])) break; if (sp > XB_SPIN_CAP) { atomicAdd(&bar[XB_TMO], 1u); break; } }
    }
    nloc = mine > 0u ? mine : 1u; nx = cnt > 0u ? cnt : 1u;
}

__device__ __forceinline__ void xcd_barrier(const XcdBarrier& b) {
    asm volatile("s_waitcnt vmcnt(0)" ::: "memory");
    __syncthreads();
    if (threadIdx.x == 0) {
        unsigned* bar = b.bar;
        __builtin_amdgcn_s_waitcnt(0);
        unsigned nloc = b.st[0], nx = b.st[1];
        if (nloc == 0u) { xcd_barrier_complete(bar, b.x, nloc, nx); b.st[0] = nloc; b.st[1] = nx; }
        const unsigned old = xb_add(&bar[XB_XSUB(b.x)], 1u);
        const unsigned gen = old / nloc;
        if (old + 1u == (gen + 1u) * nloc) {
            __builtin_amdgcn_fence(__ATOMIC_RELEASE, "agent");
            asm volatile("s_waitcnt vmcnt(0)" ::: "memory");
            const unsigned og = xb_add(&bar[XB_TOP], 1u);
            const unsigned tg = og / nx;
            if (og + 1u == (tg + 1u) * nx) xb_add(&bar[XB_TOPGEN], 1u);
            else XB_SPIN(xb_ld(&bar[XB_TOPGEN]) == tg, bar);
            __builtin_amdgcn_fence(__ATOMIC_ACQUIRE, "agent");
            xb_add(&bar[XB_XGEN(b.x)], 1u);
            asm volatile("s_waitcnt vmcnt(0)" ::: "memory");
        } else {
            XB_SPIN(xb_ld(&bar[XB_XGEN(b.x)]) == gen, bar);
            __builtin_amdgcn_fence(__ATOMIC_ACQUIRE, "agent");
            asm volatile("s_waitcnt vmcnt(0)" ::: "memory");
        }
    }
    __syncthreads();
}

__device__ __forceinline__ void phase_exp_up(const Args& a, unsigned char* lds, const XcdBarrier& bar, int tid, int wave, int lane, unsigned* ctr, float* xout, float* ssout) {
  unsigned* slot = (unsigned*)(lds + 8 * 16640);
  const int x0 = (int)(xb_xcc_id() & 7u);
  for (int k = 0; k < 8; ++k) {
    const int xs = (x0 + k) & 7;
    for (;;) {
      __syncthreads();
      if (tid == 0) slot[0] = atomicAdd(ctr + 16 * xs, 1u);
      __syncthreads();
      const unsigned item = slot[0];
      if (item >= (unsigned)(NT / 128)) break;
      exp_up_item(a, lds, xs, (int)item, wave, lane, xout, ssout);
    }
  }
}

__device__ __forceinline__ void phase_xattn3(const Args& a, unsigned char* lds, int tid) {
  pg8::StaticOrder S; S.init(NT, DM, (int)gridDim.x, (int)blockIdx.x); pg8::Unit u;
  for (int i = 0; S.next(i, u); ++i) xa::unit(a, lds, u.pm >> 4, u.pn, u.pm & 15, tid);
}

__global__ void __launch_bounds__(512, 2) mega(Args a) {
  extern __shared__ __attribute__((aligned(16))) unsigned char lds[];
  cg::grid_group grid = cg::this_grid();
  const int tid = threadIdx.x, lane = tid & 63, wave = tid >> 6;
  const int gw = blockIdx.x * 8 + wave, ngw = gridDim.x * 8;
  unsigned char* ws = a.ws;
  const int lo = a.ph_lo, hi = a.ph_hi;
#define IN(k) (lo <= (k) && (k) < hi)
  volatile LAS unsigned* MISC = (volatile LAS unsigned*)((LAS unsigned char*)lds + 146944);
  if (tid < 32) MISC[tid] = 0u;
  __syncthreads();
  XcdBarrier bar; bar.bar = (unsigned*)(ws + WS_BAR); bar.x = 0; bar.st = nullptr;
  if (hi - lo > 1) bar = xcd_barrier_post((unsigned*)(ws + WS_BAR), MISC + 8);
  if (lo < -1000000) grid.sync();
#define SEAM(k) do { if (IN(k) && IN((k) + 1)) xcd_barrier(bar); } while (0)
#if PROBE_REP == 0
  if (IN(0)) { phase_prep(a, lds, gw, ngw, wave, lane, tid); grid.sync(); }
#endif
  if (IN(0)) { phase_prep(a, lds, gw, ngw, wave, lane, tid); } SEAM(0);
#if PROBE_REP == 1
  if (IN(1)) {
    run_gemm8(lds, (const bf16_t*)(ws + WS_HB), (const bf16_t*)(ws + WS_WIN_T), NT, NQKV, DM, EpiQKV{(bf16_t*)(ws + WS_QKV)});
    run_gemm8(lds, (const bf16_t*)(ws + WS_MEMN), (const bf16_t*)(ws + WS_WXKV_T), NMROWS, 2048, DM, EpiBf16{(bf16_t*)(ws + WS_KX), 2048});
    xcd_barrier(bar); }
#endif
#if PROBE_REP == 2
  if (IN(2)) { phase_scan(a, gw, ngw, lane, tid); xcd_barrier(bar); phase_rms(a, gw, ngw, lane); xcd_barrier(bar); phase_rms(a, gw, ngw, lane); xcd_barrier(bar); }
#endif
  if (IN(1)) {
    run_gemm_raw(lds, (const bf16_t*)(ws + WS_HB), (const bf16_t*)(ws + WS_WIN_T), NT, NQKV, DM, pg8::EpiQKVx{(bf16_t*)(ws + WS_QKV), (float*)(ws + WS_KMEAN), (unsigned*)(ws + 2048)});
    run_gemm8(lds, (const bf16_t*)(ws + WS_MEMN), (const bf16_t*)(ws + WS_WXKV_T), NMROWS, 2048, DM, EpiBf16{(bf16_t*)(ws + WS_KX), 2048});
  }
  if (IN(1) && IN(3)) xcd_barrier(bar);
#if PROBE_REP == 3
  if (IN(3)) { phase_attn2(a, lds, tid); xcd_barrier(bar); if (blockIdx.x == 0 && tid == 0) *(unsigned*)(ws) = 0u; xcd_barrier(bar); }
#endif
  if (IN(3)) {
#if USE_ATT2
    phase_attn2(a, lds, tid);
#else
    phase_attn(a, lds, tid);
#endif
  }
  if (IN(3) && IN(5)) xcd_barrier(bar);
  if (IN(5)) { run_gemm_mid(lds, (const bf16_t*)(ws + WS_OAB), (const bf16_t*)(ws + WS_WOUT_T), NT, DM, DM, pg8::EpiResidSS{a.in[0], (bf16_t*)(ws + WS_HB), (float*)(ws + WS_SS1), (const float*)(ws + WS_SSO) + NT}, pg8::MidONorm{(const float*)(ws + WS_SSO)}); }
  if (IN(5) && IN(7)) xcd_barrier(bar);
  if (IN(7)) { run_gemm8(lds, (const bf16_t*)(ws + WS_HB), (const bf16_t*)(ws + WS_WXQ_T), NT, DM, DM, EpiBf16S{(bf16_t*)(ws + WS_QX), DM, (const float*)(ws + WS_SS1)}); }
  if (IN(7) && IN(8)) { asm volatile("s_waitcnt vmcnt(0)" ::: "memory"); __syncthreads(); if (tid == 0) { __builtin_amdgcn_fence(__ATOMIC_ACQUIRE, "agent"); asm volatile("s_waitcnt vmcnt(0)" ::: "memory"); } __syncthreads(); }
#if PROBE_REP == 8
  if (IN(8)) { phase_xattn(a, lds, gw, ngw, wave, lane); grid.sync(); }
#endif
  if (IN(8)) { phase_xattn3(a, lds, tid); } SEAM(8);
  if (IN(9)) { run_gemm_raw(lds, (const bf16_t*)(ws + WS_OX), (const bf16_t*)(ws + WS_WXO_T), NT, DM, DM, pg8::EpiResidSS{nullptr, (bf16_t*)(ws + WS_HB), (float*)(ws + WS_SS2), nullptr}); }
  if (IN(9) && IN(11)) xcd_barrier(bar);
  if (IN(11)) { run_gemm8(lds, (const bf16_t*)(ws + WS_HB), (const bf16_t*)(ws + WS_WPQ_T), NT, DM, DM, EpiBf16S{(bf16_t*)(ws + WS_PQ), DM, (const float*)(ws + WS_SS2)}); } SEAM(11);
#if PROBE_REP == 12
  if (IN(12)) { phase_topk(a, lds, tid); grid.sync(); }
#endif
  if (IN(12)) { phase_topk2(a, lds, wave, lane); }
  if (IN(12) && IN(13)) { asm volatile("s_waitcnt vmcnt(0)" ::: "memory"); __syncthreads(); if (tid == 0) { __builtin_amdgcn_fence(__ATOMIC_ACQUIRE, "agent"); asm volatile("s_waitcnt vmcnt(0)" ::: "memory"); } __syncthreads(); }
    if (IN(13)) {
#if PROBE_G == 1
    probe_gather<0>(a, wave, lane, 2047u);
#elif PROBE_G == 2
    probe_gather<1>(a, wave, lane, 2047u);
#elif PROBE_G == 3
    probe_gather<1>(a, wave, lane, 16383u);
#elif PROBE_G == 4
    probe_gather<0>(a, wave, lane, 16383u);
#endif
    phase_exp_down2(a, lds, wave, lane);
    __builtin_amdgcn_wave_barrier();
    asm volatile("s_waitcnt vmcnt(0)" ::: "memory"); __builtin_amdgcn_fence(__ATOMIC_ACQUIRE, "agent");
    phase_exp_up3(a, lds, wave, lane);
  }
#undef IN
#undef SEAM
}

extern "C" void kernel_launch(void* const* d_in, const int* in_sizes, int n_in, void* d_out, int out_size, void* d_ws, size_t ws_size, hipStream_t stream) {
  static int grid = 0;
  if (grid == 0) {
    if (n_in != 22 || out_size != NT * DM || ws_size < WS_END) { fprintf(stderr, "kernel_launch: unexpected shapes (n_in %d out %d ws %zu)\n", n_in, out_size, ws_size); grid = -1; return; }
    int dev = 0, cus = 0, per_cu = 0;
    (void)hipGetDevice(&dev);
    (void)hipDeviceGetAttribute(&cus, hipDeviceAttributeMultiprocessorCount, dev);
    (void)hipFuncSetAttribute((const void*)mega, hipFuncAttributeMaxDynamicSharedMemorySize, LDS_BYTES);
    (void)hipOccupancyMaxActiveBlocksPerMultiprocessor(&per_cu, (const void*)mega, 512, LDS_BYTES);
    if (per_cu < 1) per_cu = 1;
    grid = cus * per_cu;
  }
  if (grid < 0) return;
  (void)hipMemsetAsync(d_ws, 0, CTL_ZERO_BYTES, stream);
  Args a{};
  for (int i = 0; i < 22; ++i) a.in[i] = (const float*)d_in[i];
  a.out = (float*)d_out; a.ws = (unsigned char*)d_ws;
  a.rep_down = REP_DOWN; a.rep_up = REP_UP; a.rep_scan = REP_SCAN;
#if MK_N_LAUNCHES == 1
  a.ph_lo = 0; a.ph_hi = NPHASE + 1;
  void* args[] = {&a};
  hipError_t e = hipLaunchCooperativeKernel((const void*)mega, dim3(grid), dim3(512), args, LDS_BYTES, stream);
  if (e != hipSuccess) fprintf(stderr, "cooperative launch failed: %s (grid %d)\n", hipGetErrorString(e), grid);
#else
  for (int p = 0; p <= NPHASE; ++p) { a.ph_lo = p; a.ph_hi = p + 1; hipLaunchKernelGGL(mega, dim3(grid), dim3(512), LDS_BYTES, stream, a); }
#endif
}
```
